# Optimizing an MI355X kernel written in HIP

```python
import math
import jax
import jax.numpy as jnp
from jax import lax
import numpy as np


D_MODEL = 1024
BATCH = 8
SEQ = 4096
DEPTH = 4

HEAD_DIM = 64
NSA_HEADS = D_MODEL // (2 * HEAD_DIM)
NSA_KV_HEADS = 2
NSA_GROUP = NSA_HEADS // NSA_KV_HEADS
CMP_LEN = 32
CMP_STRIDE = 16
CMP_HIDDEN = 128
SEL_BLOCK = 64
N_SEL = 16
WINDOW = 512
Q_BLOCK = 128
FORCE_BONUS = 1.0e4
ROPE_THETA = 500000.0
ROPE_DIM = HEAD_DIM // 4

GDN_HEADS = D_MODEL // (4 * HEAD_DIM)
GDN_CONV = 4
GDN_CHUNK = 64

CONF_CH = D_MODEL // 4
CONF_WIDTH = 31

N_GROUPS = 4
EXPERTS_PER_GROUP = 8
N_EXPERTS = N_GROUPS * EXPERTS_PER_GROUP
TOP_K_IN_GROUP = 2
EXPERT_FF = 512
MOE_BLOCK = 256

NSA_WIDTH = NSA_HEADS * HEAD_DIM
KV_WIDTH = NSA_KV_HEADS * HEAD_DIM
GDN_WIDTH = GDN_HEADS * HEAD_DIM
MIX_WIDTH = NSA_WIDTH + GDN_WIDTH + CONF_CH
SPLIT_SIZES = (NSA_WIDTH, 6 * KV_WIDTH, 3 * NSA_HEADS, 3 * GDN_WIDTH, GDN_WIDTH, GDN_HEADS, GDN_HEADS, 2 * CONF_CH)
D_IN = NSA_WIDTH + 6 * KV_WIDTH + 3 * NSA_HEADS + 4 * GDN_WIDTH + 2 * GDN_HEADS + 2 * CONF_CH

DEEPNORM_ALPHA = (2.0 * DEPTH) ** 0.25
DEEPNORM_BETA = (8.0 * DEPTH) ** -0.25

kernel_name = 'hybrid_nsa_gdn_conformer_hmoe'


def _layer_norm(x, w, b, eps=1e-5):
    xf = x.astype(jnp.float32)
    mu = jnp.mean(xf, axis=-1, keepdims=True)
    var = jnp.mean(jnp.square(xf - mu), axis=-1, keepdims=True)
    return ((xf - mu) * lax.rsqrt(var + eps) * w + b).astype(x.dtype)


def _l2norm(x, eps=1e-6):
    xf = x.astype(jnp.float32)
    return xf * lax.rsqrt(jnp.sum(xf * xf, axis=-1, keepdims=True) + eps)


def _rope_tables(seq):
    inv = ROPE_THETA ** (-jnp.arange(0, ROPE_DIM, 2, dtype=jnp.float32) / ROPE_DIM)
    ang = jnp.arange(seq, dtype=jnp.float32)[:, None] * inv[None, :]
    return jnp.cos(ang), jnp.sin(ang)


def _partial_rope(x, cos, sin):
    half = ROPE_DIM // 2
    x1 = x[..., :half].astype(jnp.float32)
    x2 = x[..., half:ROPE_DIM].astype(jnp.float32)
    c = cos[:, None, :]
    s = sin[:, None, :]
    rot = jnp.concatenate([x1 * c - x2 * s, x2 * c + x1 * s], axis=-1).astype(x.dtype)
    return jnp.concatenate([rot, x[..., ROPE_DIM:]], axis=-1)


def _causal_depthwise_conv(x, w):
    k = w.shape[0]
    return lax.conv_general_dilated(
        x, w[:, None, :].astype(x.dtype), window_strides=(1,), padding=((k - 1, 0),),
        dimension_numbers=('NWC', 'WIO', 'NWC'), feature_group_count=x.shape[-1])


def _masked_softmax(s, mask):
    s = jnp.where(mask, s.astype(jnp.float32), -jnp.inf)
    m = jnp.max(s, axis=-1, keepdims=True)
    m = jnp.where(jnp.isfinite(m), m, 0.0)
    e = jnp.exp(s - m)
    return e / jnp.maximum(jnp.sum(e, axis=-1, keepdims=True), 1e-30)


def _compress(t, pe, w1, w2):
    B, S = t.shape[:2]
    n_chunk = S // CMP_STRIDE
    r = CMP_LEN // CMP_STRIDE
    n_cmp = n_chunk - r + 1
    ch = t.reshape(B, n_chunk, CMP_STRIDE, NSA_KV_HEADS, HEAD_DIM)
    blk = jnp.concatenate([ch[:, i:i + n_cmp] for i in range(r)], axis=2)
    blk = blk + pe[None, None, :, None, :]
    blk = blk.transpose(0, 1, 3, 2, 4).reshape(B, n_cmp, NSA_KV_HEADS, CMP_LEN * HEAD_DIM)
    return jax.nn.silu(blk @ w1) @ w2


def _overlap_matrix(n_cmp, n_sb):
    c0 = jnp.arange(n_cmp)[:, None] * CMP_STRIDE
    s0 = jnp.arange(n_sb)[None, :] * SEL_BLOCK
    ov = jnp.minimum(c0 + CMP_LEN, s0 + SEL_BLOCK) - jnp.maximum(c0, s0)
    return (jnp.maximum(ov, 0) / CMP_STRIDE).astype(jnp.float32)


def _nsa(q, k_cmp, v_cmp, k_sel, v_sel, k_win, v_win, gates, cmp_pe, cmp_w1, cmp_w2):
    B, S = q.shape[:2]
    n_sb = S // SEL_BLOCK
    n_sel = min(N_SEL, n_sb)
    n_qb = S // Q_BLOCK
    kc = _compress(k_cmp, cmp_pe[0], cmp_w1[0], cmp_w2[0])
    vc = _compress(v_cmp, cmp_pe[1], cmp_w1[1], cmp_w2[1])
    n_cmp = kc.shape[1]
    cmp_end = jnp.arange(n_cmp) * CMP_STRIDE + (CMP_LEN - 1)
    overlap = _overlap_matrix(n_cmp, n_sb)
    ks_blk = k_sel.reshape(B, n_sb, SEL_BLOCK, NSA_KV_HEADS, HEAD_DIM).transpose(0, 3, 1, 2, 4)
    vs_blk = v_sel.reshape(B, n_sb, SEL_BLOCK, NSA_KV_HEADS, HEAD_DIM).transpose(0, 3, 1, 2, 4)
    pad = ((0, 0), (WINDOW, 0), (0, 0), (0, 0))
    kw_pad = jnp.pad(k_win, pad)
    vw_pad = jnp.pad(v_win, pad)
    b_ix = jnp.arange(B)[:, None, None, None]
    h_ix = jnp.arange(NSA_KV_HEADS)[None, :, None, None]
    blk_ids = jnp.arange(n_sb)
    scale = HEAD_DIM ** -0.5

    def query_block(args):
        qb, gb, s0 = args
        t = s0 + jnp.arange(Q_BLOCK)
        qg = qb.reshape(B, Q_BLOCK, NSA_KV_HEADS, NSA_GROUP, HEAD_DIM) * scale
        sc = jnp.einsum('bqhgd,bchd->bhgqc', qg, kc)
        pc = _masked_softmax(sc, cmp_end[None, :] <= t[:, None])
        o_cmp = jnp.einsum('bhgqc,bchd->bqhgd', pc.astype(vc.dtype), vc)
        imp = jnp.einsum('bhgqc,cj->bhqj', pc, overlap)
        cur = t // SEL_BLOCK
        forced = (blk_ids[None, :] == 0) | (blk_ids[None, :] == cur[:, None]) | (blk_ids[None, :] == cur[:, None] - 1)
        causal_blk = blk_ids[None, :] <= cur[:, None]
        imp = jnp.where(causal_blk, imp + jnp.where(forced, FORCE_BONUS, 0.0), -jnp.inf)
        _, idx = lax.top_k(imp, n_sel)
        valid = idx <= cur[None, None, :, None]
        kg = ks_blk[b_ix, h_ix, idx]
        vg = vs_blk[b_ix, h_ix, idx]
        ss = jnp.einsum('bqhgd,bhqnkd->bhgqnk', qg, kg)
        tok = idx[..., None] * SEL_BLOCK + jnp.arange(SEL_BLOCK)
        smask = valid[..., None] & (tok <= t[None, None, :, None, None])
        ps = _masked_softmax(ss.reshape(B, NSA_KV_HEADS, NSA_GROUP, Q_BLOCK, n_sel * SEL_BLOCK),
                             smask.reshape(B, NSA_KV_HEADS, 1, Q_BLOCK, n_sel * SEL_BLOCK))
        o_sel = jnp.einsum('bhgqnk,bhqnkd->bqhgd', ps.reshape(ss.shape).astype(vg.dtype), vg)
        kw = lax.dynamic_slice_in_dim(kw_pad, s0, Q_BLOCK + WINDOW, axis=1)
        vw = lax.dynamic_slice_in_dim(vw_pad, s0, Q_BLOCK + WINDOW, axis=1)
        p = s0 - WINDOW + jnp.arange(Q_BLOCK + WINDOW)
        wmask = (p[None, :] <= t[:, None]) & (p[None, :] > t[:, None] - WINDOW) & (p[None, :] >= 0)
        sw = jnp.einsum('bqhgd,bkhd->bhgqk', qg, kw)
        pw = _masked_softmax(sw, wmask)
        o_win = jnp.einsum('bhgqk,bkhd->bqhgd', pw.astype(vw.dtype), vw)
        o = jnp.stack([o_cmp, o_sel, o_win], axis=-1).reshape(B, Q_BLOCK, NSA_HEADS, HEAD_DIM, 3)
        return jnp.einsum('bqhdr,bqhr->bqhd', o, gb.astype(o.dtype))

    q_blocks = q.reshape(B, n_qb, Q_BLOCK, NSA_HEADS, HEAD_DIM).swapaxes(0, 1)
    g_blocks = gates.reshape(B, n_qb, Q_BLOCK, NSA_HEADS, 3).swapaxes(0, 1)
    starts = jnp.arange(n_qb) * Q_BLOCK
    out = lax.map(query_block, (q_blocks, g_blocks, starts))
    return out.swapaxes(0, 1).reshape(B, S, NSA_WIDTH).astype(q.dtype)


def _chunked_gated_delta_rule(q, k, v, g, beta):
    B, S, H, Dk = q.shape
    C = GDN_CHUNK
    N = S // C

    def chunks(t):
        t = t.astype(jnp.float32)
        return jnp.moveaxis(t.reshape((B, N, C, H) + t.shape[3:]), 3, 1)

    q, k, v, g, beta = chunks(q), chunks(k), chunks(v), chunks(g), chunks(beta)
    q = q * Dk ** -0.5
    g = jnp.cumsum(g, axis=-1)
    tri = jnp.tril(jnp.ones((C, C), dtype=bool))
    tri_strict = jnp.tril(jnp.ones((C, C), dtype=bool), -1)
    decay = jnp.exp(jnp.where(tri, g[..., :, None] - g[..., None, :], -jnp.inf))
    kb = k * beta[..., None]
    a = jnp.where(tri_strict, jnp.einsum('bhnid,bhnjd->bhnij', kb, k) * decay, 0.0)
    t_mat = jnp.eye(C, dtype=jnp.float32) + a
    u = lax.linalg.triangular_solve(t_mat, v * beta[..., None], left_side=True, lower=True)
    w = lax.linalg.triangular_solve(t_mat, kb * jnp.exp(g)[..., None], left_side=True, lower=True)
    qk = jnp.einsum('bhnid,bhnjd->bhnij', q, k) * decay
    q_dec = q * jnp.exp(g)[..., None]
    g_last = g[..., -1]
    k_dec = k * jnp.exp(g_last[..., None] - g)[..., None]

    def step(state, xs):
        qk_n, q_n, k_n, u_n, w_n, gl_n = xs
        v_new = u_n - jnp.einsum('bhcd,bhde->bhce', w_n, state)
        o = jnp.einsum('bhcd,bhde->bhce', q_n, state) + jnp.einsum('bhij,bhje->bhie', qk_n, v_new)
        state = state * jnp.exp(gl_n)[..., None, None] + jnp.einsum('bhcd,bhce->bhde', k_n, v_new)
        return state, o

    xs = tuple(jnp.moveaxis(t, 2, 0) for t in (qk, q_dec, k_dec, u, w, g_last))
    s0 = jnp.zeros((B, H, Dk, v.shape[-1]), jnp.float32)
    _, o = lax.scan(step, s0, xs)
    return o.transpose(1, 0, 3, 2, 4).reshape(B, S, H, v.shape[-1])


def _gated_deltanet(qkv, z, b, a, conv_w, a_log, dt_bias, norm_w):
    B, S, _ = qkv.shape
    h = jax.nn.silu(_causal_depthwise_conv(qkv, conv_w)).reshape(B, S, 3, GDN_HEADS, HEAD_DIM)
    q = _l2norm(h[:, :, 0])
    k = _l2norm(h[:, :, 1])
    v = h[:, :, 2].astype(jnp.float32)
    beta = jax.nn.sigmoid(b.astype(jnp.float32))
    g = -jnp.exp(a_log.astype(jnp.float32)) * jax.nn.softplus(a.astype(jnp.float32) + dt_bias.astype(jnp.float32))
    o = _chunked_gated_delta_rule(q, k, v, g, beta)
    o = o * lax.rsqrt(jnp.mean(o * o, axis=-1, keepdims=True) + 1e-6) * norm_w.astype(jnp.float32)
    o = o * jax.nn.silu(z.astype(jnp.float32).reshape(B, S, GDN_HEADS, HEAD_DIM))
    return o.reshape(B, S, GDN_WIDTH).astype(qkv.dtype)


def _conformer_conv(h, dw_w, dw_b, ln_w, ln_b):
    val, gate = jnp.split(h, 2, axis=-1)
    u = val * jax.nn.sigmoid(gate)
    u = _causal_depthwise_conv(u, dw_w) + dw_b
    return jax.nn.silu(_layer_norm(u, ln_w, ln_b))


def _hier_moe(x, w_group, b_group, w_expert, b_expert, w_gate, w_up, w_down):
    B, S, D = x.shape
    T = B * S
    K = TOP_K_IN_GROUP
    xt = x.reshape(T, D)
    g_prob = jax.nn.softmax((xt @ w_group + b_group).astype(jnp.float32), axis=-1)
    g_w, g_idx = lax.top_k(g_prob, 1)
    e_logits = (xt @ w_expert + b_expert).astype(jnp.float32).reshape(T, N_GROUPS, EXPERTS_PER_GROUP)
    e_in = jnp.take_along_axis(e_logits, g_idx[:, :, None], axis=1)[:, 0]
    e_val, e_loc = lax.top_k(e_in, K)
    e_w = jax.nn.softmax(e_val, axis=-1) * g_w
    e_id = g_idx * EXPERTS_PER_GROUP + e_loc
    TK = T * K
    flat_id = e_id.reshape(TK)
    order = jnp.argsort(flat_id)
    sorted_id = flat_id[order]
    counts = jnp.bincount(flat_id, length=N_EXPERTS)
    padded = (counts + MOE_BLOCK - 1) // MOE_BLOCK * MOE_BLOCK
    seg_start = jnp.cumsum(counts) - counts
    pad_end = jnp.cumsum(padded)
    pad_start = pad_end - padded
    dest = pad_start[sorted_id] + jnp.arange(TK) - seg_start[sorted_id]
    n_blocks = -(-TK // MOE_BLOCK) + N_EXPERTS
    src_tok = order // K
    buf = jnp.zeros((n_blocks * MOE_BLOCK, D), x.dtype).at[dest].set(xt[src_tok])
    blk_expert = jnp.minimum(jnp.searchsorted(pad_end, jnp.arange(n_blocks) * MOE_BLOCK, side='right'), N_EXPERTS - 1)

    def expert_block(args):
        xb, e = args
        hid = jax.nn.silu(xb @ w_gate[e]) * (xb @ w_up[e])
        return hid @ w_down[e]

    y_buf = lax.map(expert_block, (buf.reshape(n_blocks, MOE_BLOCK, D), blk_expert)).reshape(-1, D)
    y = y_buf[dest] * e_w.reshape(TK)[order][:, None].astype(x.dtype)
    return jnp.zeros((T, D), x.dtype).at[src_tok].add(y).reshape(B, S, D)


def setup_inputs(seed: int = 0) -> dict:
    key = jax.random.key(seed)
    ks = jax.random.split(key, 26)
    L = DEPTH

    def nrm(k, shape, scale):
        return jax.random.normal(k, shape, jnp.float32) * scale

    dt = jnp.exp(jax.random.uniform(ks[8], (L, GDN_HEADS), jnp.float32, math.log(1e-3), math.log(1e-1)))
    return {
        'x': nrm(ks[0], (BATCH, SEQ, D_MODEL), 1.0),
        'w_in': nrm(ks[1], (L, D_MODEL, D_IN), D_MODEL ** -0.5),
        'w_out': nrm(ks[2], (L, MIX_WIDTH, D_MODEL), MIX_WIDTH ** -0.5 * DEEPNORM_BETA),
        'nsa_cmp_pe': nrm(ks[3], (L, 2, CMP_LEN, HEAD_DIM), 0.1),
        'nsa_cmp_w1': nrm(ks[4], (L, 2, CMP_LEN * HEAD_DIM, CMP_HIDDEN), (CMP_LEN * HEAD_DIM) ** -0.5),
        'nsa_cmp_w2': nrm(ks[5], (L, 2, CMP_HIDDEN, HEAD_DIM), CMP_HIDDEN ** -0.5),
        'gdn_conv_w': nrm(ks[6], (L, GDN_CONV, 3 * GDN_WIDTH), GDN_CONV ** -0.5),
        'gdn_a_log': jnp.log(jax.random.uniform(ks[7], (L, GDN_HEADS), jnp.float32, 1.0, 16.0)),
        'gdn_dt_bias': dt + jnp.log(-jnp.expm1(-dt)),
        'gdn_norm_w': 1.0 + nrm(ks[9], (L, HEAD_DIM), 0.02),
        'conf_dw_w': nrm(ks[10], (L, CONF_WIDTH, CONF_CH), CONF_WIDTH ** -0.5),
        'conf_dw_b': nrm(ks[11], (L, CONF_CH), 0.02),
        'conf_ln_w': 1.0 + nrm(ks[12], (L, CONF_CH), 0.02),
        'conf_ln_b': nrm(ks[13], (L, CONF_CH), 0.02),
        'ln1_w': 1.0 + nrm(ks[14], (L, D_MODEL), 0.02),
        'ln1_b': nrm(ks[15], (L, D_MODEL), 0.02),
        'ln2_w': 1.0 + nrm(ks[16], (L, D_MODEL), 0.02),
        'ln2_b': nrm(ks[17], (L, D_MODEL), 0.02),
        'moe_w_group': nrm(ks[18], (L, D_MODEL, N_GROUPS), D_MODEL ** -0.5),
        'moe_b_group': nrm(ks[19], (L, N_GROUPS), 0.01),
        'moe_w_expert': nrm(ks[20], (L, D_MODEL, N_EXPERTS), D_MODEL ** -0.5),
        'moe_b_expert': nrm(ks[21], (L, N_EXPERTS), 0.01),
        'moe_w_gate': nrm(ks[22], (L, N_EXPERTS, D_MODEL, EXPERT_FF), D_MODEL ** -0.5),
        'moe_w_up': nrm(ks[23], (L, N_EXPERTS, D_MODEL, EXPERT_FF), D_MODEL ** -0.5),
        'moe_w_down': nrm(ks[24], (L, N_EXPERTS, EXPERT_FF, D_MODEL), EXPERT_FF ** -0.5 * DEEPNORM_BETA),
    }


def reference(x, w_in, w_out, nsa_cmp_pe, nsa_cmp_w1, nsa_cmp_w2, gdn_conv_w, gdn_a_log, gdn_dt_bias,
              gdn_norm_w, conf_dw_w, conf_dw_b, conf_ln_w, conf_ln_b, ln1_w, ln1_b, ln2_w, ln2_b,
              moe_w_group, moe_b_group, moe_w_expert, moe_b_expert, moe_w_gate, moe_w_up, moe_w_down):
    B, S, _ = x.shape
    cos, sin = _rope_tables(S)
    split_points = [int(p) for p in np.cumsum(SPLIT_SIZES)[:-1]]
    for l in range(DEPTH):
        h = x @ w_in[l]
        q, kv, gate_logits, gdn_qkv, gdn_z, gdn_b, gdn_a, conf_in = jnp.split(h, split_points, axis=-1)
        q = _partial_rope(q.reshape(B, S, NSA_HEADS, HEAD_DIM), cos, sin)
        kv = kv.reshape(B, S, 6, NSA_KV_HEADS, HEAD_DIM)
        k_cmp = _partial_rope(kv[:, :, 0], cos, sin)
        k_sel = _partial_rope(kv[:, :, 2], cos, sin)
        k_win = _partial_rope(kv[:, :, 4], cos, sin)
        gates = jax.nn.sigmoid(gate_logits).reshape(B, S, NSA_HEADS, 3)
        y_nsa = _nsa(q, k_cmp, kv[:, :, 1], k_sel, kv[:, :, 3], k_win, kv[:, :, 5], gates,
                     nsa_cmp_pe[l], nsa_cmp_w1[l], nsa_cmp_w2[l])
        y_gdn = _gated_deltanet(gdn_qkv, gdn_z, gdn_b, gdn_a, gdn_conv_w[l], gdn_a_log[l], gdn_dt_bias[l], gdn_norm_w[l])
        y_conf = _conformer_conv(conf_in, conf_dw_w[l], conf_dw_b[l], conf_ln_w[l], conf_ln_b[l])
        mix = jnp.concatenate([y_nsa, y_gdn, y_conf], axis=-1) @ w_out[l]
        x = _layer_norm(DEEPNORM_ALPHA * x + mix, ln1_w[l], ln1_b[l])
        moe = _hier_moe(x, moe_w_group[l], moe_b_group[l], moe_w_expert[l], moe_b_expert[l],
                        moe_w_gate[l], moe_w_up[l], moe_w_down[l])
        x = _layer_norm(DEEPNORM_ALPHA * x + moe, ln2_w[l], ln2_b[l])
    return x
```

```cpp
#include <hip/hip_runtime.h>
#include <cstdio>
#include <cstdint>
namespace pg8 {
#define PG8_LAS __attribute__((address_space(3)))
typedef unsigned short bf16_t;
typedef short bf16x8 __attribute__((ext_vector_type(8)));
typedef float f32x4 __attribute__((ext_vector_type(4)));
typedef unsigned u32x4 __attribute__((ext_vector_type(4)));
constexpr int BM = 256, BK = 64, HALF = 128, HTB = HALF * BK * 2  , STAGE_BYTES = 8 * HTB, NXCD = 8, WGM = 8;

__host__ __device__ __forceinline__ int lds_byte(int r, int c) { const int st = (r >> 4) * 2 + (c >> 5), rr = r & 15, cc = c & 31, ob = rr * 64 + cc * 2; return st * 1024 + (ob ^ (((ob >> 9) & 1) << 5)); }
__host__ __device__ __forceinline__ void stage_rc(int b, int& R, int& C) { const int st = b / 1024, sb = b % 1024, swz = sb ^ (((sb >> 9) & 1) << 5); R = (st >> 1) * 16 + swz / 64; C = (st & 1) * 32 + (swz % 64) / 2; }
__host__ __device__ __forceinline__ int perm32(int rho) { const int n = rho >> 4, i = rho & 15; return 8 * (i >> 2) + 4 * n + (i & 3); }

struct Unit { int pm, pn; };
struct Gemm { const bf16_t* A; const bf16_t* Bt; int M, N, K; };

struct StaticOrder {
    int nM, nN, nwg, G, c;
    __host__ __device__ void init(int M, int N, int G_, int c_) { nM = M / BM; nN = N / BM; nwg = nM * nN; G = G_; c = c_; }
    __host__ __device__ bool next(int i, Unit& u) const {
        const long L = (long)i * G + c; if (L >= nwg) return false;
        int wgid = (int)L; { const int q = nwg / NXCD, r = nwg % NXCD, xcd = wgid % NXCD, off = wgid / NXCD; wgid = (xcd < r ? xcd * (q + 1) : r * (q + 1) + (xcd - r) * q) + off; }
        const int nig = WGM * nN, gid = wgid / nig, fm = gid * WGM, gsz = (nM - fm) < WGM ? (nM - fm) : WGM;
        u.pm = fm + ((wgid % nig) % gsz); u.pn = (wgid % nig) / gsz; return true;
    }
    __device__ __forceinline__ void a_ready(const Unit&) const {}
    __device__ __forceinline__ void done(const Unit&) const {}
};

__device__ __forceinline__ unsigned cvt_pk_bf16(float lo, float hi) { unsigned r; asm volatile("v_cvt_pk_bf16_f32 %0, %1, %2" : "=v"(r) : "v"(lo), "v"(hi)); return r; }
__device__ __forceinline__ float fast_sigmoid(float x) { return __builtin_amdgcn_rcpf(1.0f + __builtin_amdgcn_exp2f(-1.44269504089f * x)); }

constexpr int HLD = 2816;
constexpr float QSCALE = 0.125f * 1.44269504089f;

struct EpiInProj {
    static constexpr bool PERM = true, AFTER_DRAIN = false;
    bf16_t* H; float* side; const float* rope;
    __device__ __forceinline__ void operator()(const f32x4 (&acc)[2][2][4][2], const Unit& u, int wr, int wc, int fr, int fq) const {
        const int row0 = u.pm * BM + wr * 64 + fr; const int pn = u.pn;
        if (pn <= 4) {
#pragma unroll
            for (int ai = 0; ai < 2; ++ai)
#pragma unroll
                for (int m = 0; m < 4; ++m) {
                    const int row = row0 + ai * HALF + m * 16; const float* rp = rope + (size_t)(row & 4095) * 16;
                    const f32x4 c0 = *(const f32x4*)(rp), c1 = *(const f32x4*)(rp + 4), s0 = *(const f32x4*)(rp + 8), s1 = *(const f32x4*)(rp + 12);
#pragma unroll
                    for (int bj = 0; bj < 2; ++bj) {
                        f32x4 v0 = acc[ai][bj][m][0], v1 = acc[ai][bj][m][1];
                        const bool ropeb = (pn < 2) || (bj == 0);
                        if (ropeb) {
                            f32x4 p0, p1;
#pragma unroll
                            for (int e = 0; e < 4; ++e) { p0[e] = __shfl_xor(v0[e], 16); p1[e] = __shfl_xor(v1[e], 16); }
                            if (((wc & 1) == 0) && fq < 2) { const float sg = fq ? 1.f : -1.f; v0 = v0 * c0 + (p0 * s0) * sg; v1 = v1 * c1 + (p1 * s1) * sg; }
                        }
                        if (pn < 2) { v0 = v0 * QSCALE; v1 = v1 * QSCALE; }
                        u32x4 w; w.x = cvt_pk_bf16(v0[0], v0[1]); w.y = cvt_pk_bf16(v0[2], v0[3]); w.z = cvt_pk_bf16(v1[0], v1[1]); w.w = cvt_pk_bf16(v1[2], v1[3]);
                        *(u32x4*)(H + (size_t)row * HLD + pn * BM + bj * HALF + wc * 32 + 8 * fq) = w;
                    }
                }
        } else if (pn < 11) {
#pragma unroll
            for (int ai = 0; ai < 2; ++ai)
#pragma unroll
                for (int m = 0; m < 4; ++m) {
                    const int row = row0 + ai * HALF + m * 16;
#pragma unroll
                    for (int bj = 0; bj < 2; ++bj) {
                        const f32x4 v0 = acc[ai][bj][m][0], v1 = acc[ai][bj][m][1];
                        u32x4 w; w.x = cvt_pk_bf16(v0[0], v0[1]); w.y = cvt_pk_bf16(v0[2], v0[3]); w.z = cvt_pk_bf16(v1[0], v1[1]); w.w = cvt_pk_bf16(v1[2], v1[3]);
                        *(u32x4*)(H + (size_t)row * HLD + pn * BM + bj * HALF + wc * 32 + 8 * fq) = w;
                    }
                }
        } else if (wc == 0) {
#pragma unroll
            for (int ai = 0; ai < 2; ++ai)
#pragma unroll
                for (int m = 0; m < 4; ++m) {
                    const int row = row0 + ai * HALF + m * 16;
                    f32x4 v0 = acc[ai][0][m][0], v1 = acc[ai][0][m][1];
#pragma unroll
                    for (int e = 0; e < 4; ++e) { v0[e] = fast_sigmoid(v0[e]); if (fq < 3) v1[e] = fast_sigmoid(v1[e]); }
                    *(f32x4*)(side + (size_t)row * 32 + 8 * fq) = v0; *(f32x4*)(side + (size_t)row * 32 + 8 * fq + 4) = v1;
                }
        }
    }
};
struct EpiOutProj {
    static constexpr bool PERM = false, AFTER_DRAIN = false;
    const float* res; float* out; float alpha;
    __device__ __forceinline__ void operator()(const f32x4 (&acc)[2][2][4][2], const Unit& u, int wr, int wc, int fr, int fq) const {
        const int row0 = u.pm * BM + wr * 64 + fr, col0 = u.pn * BM + wc * 32 + 4 * fq;
#pragma unroll
        for (int ai = 0; ai < 2; ++ai)
#pragma unroll
            for (int m = 0; m < 4; ++m) { const size_t off = (size_t)(row0 + ai * HALF + m * 16) * 1024 + col0;
#pragma unroll
                for (int bj = 0; bj < 2; ++bj)
#pragma unroll
                    for (int n = 0; n < 2; ++n) { const f32x4 r = *(const f32x4*)(res + off + bj * HALF + n * 16); *(f32x4*)(out + off + bj * HALF + n * 16) = r * alpha + acc[ai][bj][m][n]; }
                asm volatile("" ::: "memory"); }
    }
};
struct EpiSwiGLU {
    static constexpr bool PERM = true, AFTER_DRAIN = false;
    bf16_t* hid;
    __device__ __forceinline__ void operator()(const f32x4 (&acc)[2][2][4][2], const Unit& u, int wr, int wc, int fr, int fq) const {
        const int row0 = u.pm * BM + wr * 64 + fr, hc0 = (u.pn & 3) * 128 + wc * 16 + 4 * fq;
#pragma unroll
        for (int ai = 0; ai < 2; ++ai)
#pragma unroll
            for (int m = 0; m < 4; ++m) { bf16_t* rowp = hid + (size_t)(row0 + ai * HALF + m * 16) * 512 + hc0;
#pragma unroll
                for (int bj = 0; bj < 2; ++bj) { const f32x4 g = acc[ai][bj][m][0], up = acc[ai][bj][m][1]; f32x4 h;
#pragma unroll
                    for (int e = 0; e < 4; ++e) h[e] = g[e] * fast_sigmoid(g[e]) * up[e];
                    typedef unsigned u32x2 __attribute__((ext_vector_type(2)));
                    u32x2 w; w.x = cvt_pk_bf16(h[0], h[1]); w.y = cvt_pk_bf16(h[2], h[3]);
                    *(u32x2*)(rowp + bj * 64) = w; } }
    }
};
struct EpiDown {
    static constexpr bool PERM = true, AFTER_DRAIN = false;
    bf16_t* y2; const int* slot_tok; const float* slot_w;
    __device__ __forceinline__ void operator()(const f32x4 (&acc)[2][2][4][2], const Unit& u, int wr, int wc, int fr, int fq) const {
        const int row0 = u.pm * BM + wr * 64 + fr, col0 = (u.pn & 3) * BM + wc * 32 + 8 * fq;
#pragma unroll
        for (int ai = 0; ai < 2; ++ai)
#pragma unroll
            for (int m = 0; m < 4; ++m) { const int row = row0 + ai * HALF + m * 16; const int st = slot_tok[row]; const float sw = slot_w[row];
                if (st >= 0) { bf16_t* rowp = y2 + (size_t)st * 1024 + col0;
#pragma unroll
                    for (int bj = 0; bj < 2; ++bj) { const f32x4 v0 = acc[ai][bj][m][0] * sw, v1 = acc[ai][bj][m][1] * sw;
                        u32x4 w; w.x = cvt_pk_bf16(v0[0], v0[1]); w.y = cvt_pk_bf16(v0[2], v0[3]); w.z = cvt_pk_bf16(v1[0], v1[1]); w.w = cvt_pk_bf16(v1[2], v1[3]);
                        *(u32x4*)(rowp + bj * HALF) = w; } } }
    }
};
struct MoeOrder {
    const int* meta; int G, c;
    __device__ __forceinline__ bool next(int i, Unit& u) const {
        const int per = G >> 3; const int idx = (G & 7) ? (i * G + c) : ((i * 8 + (c & 7)) * per + (c >> 3));
        const int nt = meta[0]; if (idx >= nt * 4) return false;
        const int pm = idx >> 2; u.pm = pm; u.pn = meta[64 + pm] * 4 + (idx & 3); return true;
    }
    __device__ __forceinline__ void a_ready(const Unit&) const {}
    __device__ __forceinline__ void done(const Unit&) const {}
};
template <class Epi, class Sched, bool STAMP = false>
__device__ __forceinline__ void gemm_phase(PG8_LAS unsigned char* lds, const Gemm g, const Sched& S, const Epi& E, unsigned long long* stamps) {
    int tid_ = threadIdx.x; asm volatile("" : "+v"(tid_));
    const int tid = tid_, wid = __builtin_amdgcn_readfirstlane(tid >> 6), lane = tid & 63, wr = wid >> 2, wc = wid & 3, fr = lane & 15, fq = lane >> 4;
    const int K = g.K, nt = K / BK;
    int ts_lo = 0, ts_hi = 0, nts = 0; const unsigned long long rt_entry = STAMP ? (unsigned long long)wall_clock64() : 0ull;
#define PG8_STAMP() do { if (STAMP && wid == 0 && nts < 64) { const unsigned long long _c = (unsigned long long)clock64(); \
        ts_lo = (lane == nts) ? (int)(unsigned)_c : ts_lo; ts_hi = (lane == nts) ? (int)(unsigned)(_c >> 32) : ts_hi; ++nts; } } while (0)
    PG8_STAMP();
    unsigned voffA[2], voffB[2];
#pragma unroll
    for (int i = 0; i < 2; ++i) { int R, C; stage_rc(tid * 16 + i * 8192, R, C); const int Rb = Epi::PERM ? ((R & ~31) + perm32(R & 31)) : R;
        voffA[i] = (unsigned)(R * K + C) * 2u; voffB[i] = (unsigned)(Rb * K + C) * 2u; }
    const size_t kstep = (size_t)(BK * 2);
    const size_t hstep = (size_t)HALF * K * 2;
    const size_t tstep = 2 * hstep;
    const unsigned ldsw = (unsigned)wid * 1024u;
    const int aoff = lds_byte(wr * 64 + fr, fq * 8), boff = lds_byte(wc * 32 + fr, fq * 8);
#define PG8_SA(b, h) (((b) * 2 + (h)) * HTB)
#define PG8_SB(b, h) ((4 + (b) * 2 + (h)) * HTB)
#define PG8_STAGE(bufoff, gbase, voff) do { _Pragma("unroll") for (int _i = 0; _i < 2; ++_i) \
        __builtin_amdgcn_global_load_lds((const unsigned*)((const char*)(gbase) + (voff)[_i]), (PG8_LAS unsigned*)(lds + (bufoff) + ldsw + _i * 8192), 16, 0, 0); } while (0)
#define PG8_LDA(dst, b, h) do { _Pragma("unroll") for (int m = 0; m < 4; ++m) _Pragma("unroll") for (int k = 0; k < 2; ++k) dst[m][k] = *(const PG8_LAS bf16x8*)(lds + PG8_SA(b, h) + aoff + m * 2048 + k * 1024); } while (0)
#define PG8_LDB(dst, b, h) do { _Pragma("unroll") for (int n = 0; n < 2; ++n) _Pragma("unroll") for (int k = 0; k < 2; ++k) dst[n][k] = *(const PG8_LAS bf16x8*)(lds + PG8_SB(b, h) + boff + n * 2048 + k * 1024); } while (0)
#define PG8_MMA(ai, bj, At, Bt) do { __builtin_amdgcn_s_setprio(1); _Pragma("unroll") for (int m = 0; m < 4; ++m) _Pragma("unroll") for (int n = 0; n < 2; ++n) _Pragma("unroll") for (int k = 0; k < 2; ++k) \
        acc[ai][bj][m][n] = __builtin_amdgcn_mfma_f32_16x16x32_bf16(Bt[n][k], At[m][k], acc[ai][bj][m][n], 0, 0, 0); __builtin_amdgcn_s_setprio(0); } while (0)
#define PG8_WAIT_V(n) asm volatile("s_waitcnt vmcnt(" #n ")" ::: "memory")
#define PG8_WAIT_L(n) asm volatile("s_waitcnt lgkmcnt(" #n ")" ::: "memory")
#define PG8_BAR __builtin_amdgcn_s_barrier()
#define PG8_SCHED __builtin_amdgcn_sched_barrier(0)
    Unit cur, nxt; int ui = 0;
    if (!S.next(0, cur)) return;
    f32x4 acc[2][2][4][2];
#pragma unroll
    for (int a = 0; a < 2; ++a)
#pragma unroll
        for (int b = 0; b < 2; ++b)
#pragma unroll
            for (int m = 0; m < 4; ++m)
#pragma unroll
                for (int n = 0; n < 2; ++n) acc[a][b][m][n] = (f32x4){0.f, 0.f, 0.f, 0.f};
    bf16x8 At[4][2], B0[2][2], B1[2][2];
    const char* cA = (const char*)g.A + (size_t)cur.pm * tstep; const char* cB = (const char*)g.Bt + (size_t)cur.pn * tstep;
    S.a_ready(cur);
    PG8_STAGE(PG8_SB(0, 0), cB, voffB); PG8_STAGE(PG8_SA(0, 0), cA, voffA); PG8_STAGE(PG8_SB(0, 1), cB + hstep, voffB); PG8_STAGE(PG8_SA(0, 1), cA + hstep, voffA);
    if (wr == 1) PG8_BAR;
    PG8_WAIT_V(4); PG8_BAR;
    PG8_STAGE(PG8_SB(1, 0), cB + kstep, voffB); PG8_STAGE(PG8_SA(1, 0), cA + kstep, voffA); PG8_STAGE(PG8_SB(1, 1), cB + hstep + kstep, voffB);
    PG8_WAIT_V(6); PG8_BAR;
    PG8_STAMP();
    for (;;) {
        const bool has_next = S.next(ui + 1, nxt);
        const char* nA = has_next ? (const char*)g.A + (size_t)nxt.pm * tstep : cA; const char* nB = has_next ? (const char*)g.Bt + (size_t)nxt.pn * tstep : cB;
        for (int t = 0; t < nt; t += 2) {
            const bool last = (t == nt - 2);
            const char* a1 = cA + (size_t)(t + 1) * kstep;
            const char* a2 = last ? nA : cA + (size_t)(t + 2) * kstep; const char* b2 = last ? nB : cB + (size_t)(t + 2) * kstep;
            const char* a3 = a2 + kstep; const char* b3 = b2 + kstep;
            if (last && has_next) S.a_ready(nxt);
            PG8_LDB(B0, 0, 0); PG8_SCHED; PG8_LDA(At, 0, 0); PG8_STAGE(PG8_SA(1, 1), a1 + hstep, voffA);
            PG8_WAIT_L(8); PG8_BAR; PG8_WAIT_L(0); PG8_MMA(0, 0, At, B0); PG8_BAR; PG8_SCHED;
            PG8_LDB(B1, 0, 1); PG8_STAGE(PG8_SB(0, 0), b2, voffB);
            PG8_BAR; PG8_WAIT_L(0); PG8_MMA(0, 1, At, B1); PG8_BAR;
            PG8_LDA(At, 0, 1); PG8_STAGE(PG8_SA(0, 0), a2, voffA);
            PG8_BAR; PG8_WAIT_L(0); PG8_MMA(1, 0, At, B0); PG8_BAR; PG8_SCHED;
            PG8_STAGE(PG8_SB(0, 1), b2 + hstep, voffB);
            PG8_WAIT_V(6); PG8_BAR; PG8_MMA(1, 1, At, B1); PG8_BAR;
            PG8_LDB(B0, 1, 0); PG8_SCHED; PG8_LDA(At, 1, 0); PG8_STAGE(PG8_SA(0, 1), a2 + hstep, voffA);
            PG8_WAIT_L(8); PG8_BAR; PG8_WAIT_L(0); PG8_MMA(0, 0, At, B0); PG8_BAR; PG8_SCHED;
            PG8_LDB(B1, 1, 1); PG8_STAGE(PG8_SB(1, 0), b3, voffB);
            PG8_BAR; PG8_WAIT_L(0); PG8_MMA(0, 1, At, B1); PG8_BAR;
            PG8_LDA(At, 1, 1); PG8_STAGE(PG8_SA(1, 0), a3, voffA);
            PG8_BAR; PG8_WAIT_L(0); PG8_MMA(1, 0, At, B0); PG8_BAR; PG8_SCHED;
            PG8_STAGE(PG8_SB(1, 1), b3 + hstep, voffB);
            PG8_WAIT_V(6); PG8_BAR; PG8_MMA(1, 1, At, B1); PG8_BAR;
        }
        PG8_STAMP();
        if constexpr (!Epi::AFTER_DRAIN) { E(acc, cur, wr, wc, fr, fq); S.done(cur); }
        PG8_STAMP();
        if (!has_next) break;
#pragma unroll
        for (int a = 0; a < 2; ++a)
#pragma unroll
            for (int b = 0; b < 2; ++b)
#pragma unroll
                for (int m = 0; m < 4; ++m)
#pragma unroll
                    for (int n = 0; n < 2; ++n) acc[a][b][m][n] = (f32x4){0.f, 0.f, 0.f, 0.f};
        cur = nxt; cA = nA; cB = nB; ++ui;
    }
    PG8_WAIT_V(0);
    if (wr == 0) PG8_BAR;
    PG8_BAR;
    if constexpr (Epi::AFTER_DRAIN) { E.fused(acc, cur, wr, wc, fr, fq, lds, wid, lane); S.done(cur); }
    PG8_STAMP();
    if (STAMP && wid == 0) { stamps[lane] = lane < nts ? (((unsigned long long)(unsigned)ts_hi << 32) | (unsigned)ts_lo) : 0ull;
        if (lane == 62) stamps[62] = rt_entry; if (lane == 63) stamps[63] = (unsigned long long)wall_clock64(); }
#undef PG8_STAMP
#undef PG8_SA
#undef PG8_SB
#undef PG8_STAGE
#undef PG8_LDA
#undef PG8_LDB
#undef PG8_MMA
#undef PG8_WAIT_V
#undef PG8_WAIT_L
#undef PG8_BAR
#undef PG8_SCHED
}
}

constexpr int NB = 8, SEQ = 4096, DM = 1024, NL = 4, T = NB * SEQ;
constexpr int DIN = 2848, DINP = 3072, HLD = pg8::HLD;
constexpr int NEXP = 32, FF = 512, NTILE_MAX = 288;
constexpr float LN_EPS = 1e-5f;
constexpr float DN_ALPHA = 1.6817928305074290f;
constexpr int NWAVES = 8, NTHR = 512;

constexpr size_t MiB = 1u << 20, KiB = 1u << 10;
constexpr size_t WS_CTL = 0, CTL_ZERO_BYTES = 128 * KiB;
constexpr size_t WS_ROPE = 1 * MiB;
constexpr size_t WS_META = 1 * MiB + 512 * KiB;
constexpr size_t WS_GL = WS_META + 16 * KiB;
constexpr size_t WS_WL = 2 * MiB;
constexpr size_t WL_WIN = 0, WL_WOUT = 6 * MiB, WL_WGU = 8 * MiB, WL_WDN = 72 * MiB, WL_W1 = 104 * MiB, WL_W2 = 105 * MiB, WL_BIAS1 = 105 * MiB + 64 * KiB, WL_WR = 105 * MiB + 128 * KiB;
constexpr size_t WS_XB = 108 * MiB;
constexpr size_t WS_X1 = 172 * MiB;
constexpr size_t WS_H = 300 * MiB;
constexpr size_t WS_SIDE = 476 * MiB;
constexpr size_t WS_Y = 480 * MiB;
constexpr size_t WS_GPREP = 544 * MiB;
constexpr size_t WS_Y2 = 624 * MiB;
constexpr size_t WS_HID = 752 * MiB;
constexpr size_t WS_KC = 824 * MiB, WS_VC = WS_KC + 512 * KiB;
constexpr size_t WS_SLOT = 825 * MiB;
constexpr size_t SL_TOK = 0, SL_W = 512 * KiB, SL_RE = 1024 * KiB, SL_RP = 1280 * KiB, SL_RW = 1536 * KiB;
constexpr size_t WS_END = 828 * MiB;
constexpr int GCH = 40960;
constexpr int GC_UT = 0, GC_W = 8192, GC_QK = 16384, GC_QD = 24576, GC_KDT = 32768;
constexpr int CW_TMO = 0;
constexpr int CW_BAR = 4096;
constexpr int CW_CNT = 8192;
constexpr int CW_QUEUE = 12288;
static_assert((CW_QUEUE + NL * 64) * 4 <= (int)CTL_ZERO_BYTES, "CTL words inside the memset region");

constexpr int SCR_BYTES = 143360;
constexpr int MISC_OFF = SCR_BYTES;
constexpr int LDS_BYTES = 147456;

#define GAS __attribute__((address_space(1)))
#define LAS __attribute__((address_space(3)))
typedef unsigned short bf16;
typedef float f32x4 __attribute__((ext_vector_type(4)));
typedef float f32x2 __attribute__((ext_vector_type(2)));
typedef float f32x16 __attribute__((ext_vector_type(16)));
typedef short bf16x8 __attribute__((ext_vector_type(8)));
typedef short s16x4 __attribute__((ext_vector_type(4)));
typedef unsigned u32x4 __attribute__((ext_vector_type(4)));
typedef unsigned u32x2 __attribute__((ext_vector_type(2)));
#define LDS_WAIT() asm volatile("s_waitcnt lgkmcnt(0)" ::: "memory")
#define VM_WAIT() asm volatile("s_waitcnt vmcnt(0)" ::: "memory")
#define SBAR() __builtin_amdgcn_sched_barrier(0)
__device__ __forceinline__ float bf2f(unsigned b) { return __uint_as_float(b << 16); }
__device__ __forceinline__ unsigned f2bf(float f) { unsigned u = __float_as_uint(f); return (u + 0x7fffu + ((u >> 16) & 1u)) >> 16; }
__device__ __forceinline__ unsigned pk2(float lo, float hi) { return pg8::cvt_pk_bf16(lo, hi); }
__device__ __forceinline__ float wave_sum(float v) {
#pragma unroll
    for (int o = 1; o < 64; o <<= 1) v += __shfl_xor(v, o);
    return v;
}
__device__ __forceinline__ float fsigmoid(float x) { return pg8::fast_sigmoid(x); }
__device__ __forceinline__ float fsilu(float x) { return x * pg8::fast_sigmoid(x); }
__device__ __forceinline__ float fexp2(float x) { return __builtin_amdgcn_exp2f(x); }

#define XB_TMO      128
#define XB_XCNT(j)  (256  + 64 * (j))
#define XB_XSUB(j)  (1280 + 64 * (j))
#define XB_XGEN(j)  (2304 + 64 * (j))
#define XB_TOP      3328
#define XB_TOPGEN   3392
#define XCD_BAR_WORDS 3456
#define XB_SPIN_CAP (1u << 18)
#define LAS __attribute__((address_space(3)))

__device__ __forceinline__ unsigned xb_ld(unsigned* p)              { return __hip_atomic_load(p, __ATOMIC_RELAXED, __HIP_MEMORY_SCOPE_AGENT); }
__device__ __forceinline__ unsigned xb_add(unsigned* p, unsigned v) { return __hip_atomic_fetch_add(p, v, __ATOMIC_RELAXED, __HIP_MEMORY_SCOPE_AGENT); }
__device__ __forceinline__ unsigned xb_xcc_id() { return (unsigned)__builtin_amdgcn_s_getreg((3 << 11) | 20) & 0xFu; }
#define XB_SPIN(cond, bar) do { unsigned _sp = 0; while (cond) { __builtin_amdgcn_s_sleep(1); \
    if ((++_sp & 255u) == 0u) { if (xb_ld(&(bar)[XB_TMO])) break; if (_sp > XB_SPIN_CAP) { atomicAdd(&(bar)[XB_TMO], 1u); break; } } } } while (0)

struct XcdBarrier {
    unsigned* bar; unsigned x;
    volatile LAS unsigned* st;
};

__device__ __forceinline__ XcdBarrier xcd_barrier_post(unsigned* bar, volatile LAS unsigned* st) {
    XcdBarrier b; b.bar = bar; b.x = xb_xcc_id(); b.st = st;
    if (threadIdx.x == 0) (void)xb_add(&bar[XB_XCNT(b.x)], 1u);
    return b;
}
__device__ __forceinline__ void xcd_barrier_complete(unsigned* bar, unsigned x, unsigned& nloc, unsigned& nx) {
    const unsigned G = gridDim.x * gridDim.y * gridDim.z;
    unsigned sum, cnt, mine, sp = 0u;
    for (;;) {
        sum = 0u; cnt = 0u; mine = 0u;
#pragma unroll
        for (unsigned j = 0; j < 16; ++j) { const unsigned c = xb_ld(&bar[XB_XCNT(j)]); sum += c; cnt += (c > 0u) ? 1u : 0u; mine = (j == x) ? c : mine; }
        if (sum == G) break;
        __builtin_amdgcn_s_sleep(1);
        if ((++sp & 255u) == 0u) { if (xb_ld(&bar[XB_TMO])) break; if (sp > XB_SPIN_CAP) { atomicAdd(&bar[XB_TMO], 1u); break; } }
    }
    nloc = mine > 0u ? mine : 1u; nx = cnt > 0u ? cnt : 1u;
}

__device__ __forceinline__ void xcd_barrier(const XcdBarrier& b) {
    asm volatile("s_waitcnt vmcnt(0)" ::: "memory");
    __syncthreads();
    if (threadIdx.x == 0) {
        unsigned* bar = b.bar;
        __builtin_amdgcn_s_waitcnt(0);
        unsigned nloc = b.st[0], nx = b.st[1];
        if (nloc == 0u) { xcd_barrier_complete(bar, b.x, nloc, nx); b.st[0] = nloc; b.st[1] = nx; }
        const unsigned old = xb_add(&bar[XB_XSUB(b.x)], 1u);
        const unsigned gen = old / nloc;
        if (old + 1u == (gen + 1u) * nloc) {
            __builtin_amdgcn_fence(__ATOMIC_RELEASE, "agent");
            asm volatile("s_waitcnt vmcnt(0)" ::: "memory");
            const unsigned og = xb_add(&bar[XB_TOP], 1u);
            const unsigned tg = og / nx;
            if (og + 1u == (tg + 1u) * nx) xb_add(&bar[XB_TOPGEN], 1u);
            else XB_SPIN(xb_ld(&bar[XB_TOPGEN]) == tg, bar);
            __builtin_amdgcn_fence(__ATOMIC_ACQUIRE, "agent");
            xb_add(&bar[XB_XGEN(b.x)], 1u);
            asm volatile("s_waitcnt vmcnt(0)" ::: "memory");
        } else {
            XB_SPIN(xb_ld(&bar[XB_XGEN(b.x)]) == gen, bar);
            __builtin_amdgcn_fence(__ATOMIC_ACQUIRE, "agent");
            asm volatile("s_waitcnt vmcnt(0)" ::: "memory");
        }
    }
    __syncthreads();
}

struct Args { const float* in[25]; float* out; unsigned char* ws; int ph_lo, ph_hi; };
typedef const __attribute__((address_space(4))) Args* ArgsP;
__device__ __forceinline__ ArgsP args_here() { ArgsP p = (ArgsP)__builtin_amdgcn_kernarg_segment_ptr(); asm volatile("" : "+s"(p)); return p; }
struct Frame { LAS unsigned char* lds; volatile LAS unsigned* MISC; unsigned* ctl; int tid, lane, wave, G, bid; };

template <class Src>
__device__ __forceinline__ void tr_item(const Src src, int K, int N, bf16* WT, LAS float* scr, int item, int lane) {
    const int nblk = N >> 5, kb = item / nblk, nb = item - kb * nblk, k0 = kb << 6, n0 = nb << 5;
#pragma unroll 8
    for (int i = 0; i < 32; ++i) { const int kk = 2 * i + (lane >> 5); scr[kk * 33 + (lane & 31)] = src(k0 + kk, n0 + (lane & 31)); }
    LDS_WAIT();
    const int c = lane & 7;
#pragma unroll
    for (int j = 0; j < 4; ++j) { const int n = (lane >> 3) + 8 * j; const LAS float* s = scr + (8 * c) * 33 + n;
        u32x4 o; o.x = pk2(s[0], s[33]); o.y = pk2(s[66], s[99]); o.z = pk2(s[132], s[165]); o.w = pk2(s[198], s[231]);
        *(u32x4*)(WT + (size_t)(n0 + n) * K + k0 + 8 * c) = o; }
    LDS_WAIT();
}
struct SrcPlain { const float* p; int ld; __device__ __forceinline__ float operator()(int k, int n) const { return p[(size_t)k * ld + n]; } };
struct SrcWin { const float* p;
    __device__ __forceinline__ float operator()(int k, int n) const {
        int c;
        if (n < 1280) c = n; else if (n < 2048) c = n + 24; else if (n < 2304) c = n + 24; else if (n < 2816) c = n + 32;
        else if (n < 2840) c = n - 2816 + 1280; else if (n < 2844) c = n - 2840 + 2328; else if (n < 2848) c = n - 2844 + 2332; else return 0.f;
        return p[(size_t)k * DIN + c]; } };
struct SrcGU { const float* wg; const float* wu;
    __device__ __forceinline__ float operator()(int k, int n) const { const int q = n >> 3, r = n & 7; const ptrdiff_t d = (r < 4) ? (ptrdiff_t)0 : (wu - wg); return wg[d + (ptrdiff_t)k * FF + 4 * q + (r & 3)]; } };

__device__ __forceinline__ void phase_weights(const Frame& F, ArgsP a, int l) {
    unsigned char* wl = a->ws + WS_WL;
    LAS float* scr = (LAS float*)(F.lds + F.wave * 16384);
    const int gw = F.bid * NWAVES + F.wave, NGW = F.G * NWAVES;
    constexpr int I_WIN = 16 * 96, I_WOUT = 16 * 32, I_GU1 = 16 * 32, I_GU = NEXP * I_GU1, I_DN1 = 8 * 32, I_DN = NEXP * I_DN1, I_W1 = 2 * 32 * 4, I_W2 = 2 * 2 * 2, I_WR = 36, I_B1 = 256;
    constexpr int NITEMS = I_WIN + I_WOUT + I_GU + I_DN + I_W1 + I_W2 + I_WR + I_B1;
    for (int it = gw; it < NITEMS; it += NGW) {
        int r = it;
        if (r < I_GU) { const int e = r / I_GU1; SrcGU s{a->in[22] + ((size_t)l * NEXP + e) * DM * FF, a->in[23] + ((size_t)l * NEXP + e) * DM * FF};
            tr_item(s, DM, 1024, (bf16*)(wl + WL_WGU) + (size_t)e * 1024 * DM, scr, r - e * I_GU1, F.lane); continue; } r -= I_GU;
        if (r < I_DN) { const int e = r / I_DN1; SrcPlain s{a->in[24] + ((size_t)l * NEXP + e) * FF * DM, DM};
            tr_item(s, FF, DM, (bf16*)(wl + WL_WDN) + (size_t)e * DM * FF, scr, r - e * I_DN1, F.lane); continue; } r -= I_DN;
        if (r < I_WIN) { SrcWin s{a->in[1] + (size_t)l * DM * DIN}; tr_item(s, DM, DINP, (bf16*)(wl + WL_WIN), scr, r, F.lane); continue; } r -= I_WIN;
        if (r < I_WOUT) { SrcPlain s{a->in[2] + (size_t)l * DM * DM, DM}; tr_item(s, DM, DM, (bf16*)(wl + WL_WOUT), scr, r, F.lane); continue; } r -= I_WOUT;
        if (r < I_W1) { const int kv = r / 128; SrcPlain s{a->in[4] + ((size_t)l * 2 + kv) * 2048 * 128, 128};
            tr_item(s, 2048, 128, (bf16*)(wl + WL_W1) + (size_t)kv * 128 * 2048, scr, r - kv * 128, F.lane); continue; } r -= I_W1;
        if (r < I_W2) { const int kv = r / 4; SrcPlain s{a->in[5] + ((size_t)l * 2 + kv) * 128 * 64, 64};
            tr_item(s, 128, 64, (bf16*)(wl + WL_W2) + (size_t)kv * 64 * 128, scr, r - kv * 4, F.lane); continue; } r -= I_W2;
        if (r < I_WR) {
            float* wr = (float*)(wl + WL_WR) + (size_t)r * DM;
            for (int k = F.lane; k < DM; k += 64) wr[k] = (r < 4) ? a->in[18][((size_t)l * DM + k) * 4 + r] : a->in[20][((size_t)l * DM + k) * NEXP + (r - 4)];
            continue; } r -= I_WR;
        {
            const int kv = r >> 7, n = r & 127; const float* pe = a->in[3] + ((size_t)l * 2 + kv) * 2048; const float* w1 = a->in[4] + ((size_t)l * 2 + kv) * 2048 * 128;
            float s = 0.f; for (int k = F.lane; k < 2048; k += 64) s += pe[k] * w1[(size_t)k * 128 + n];
            s = wave_sum(s); if (F.lane == 0) ((float*)(wl + WL_BIAS1))[r] = s;
        }
    }
}

__device__ __forceinline__ void phase_prologue(const Frame& F, ArgsP a) {
    const size_t gt = (size_t)F.bid * NTHR + F.tid, NGT = (size_t)F.G * NTHR;
    float* rope = (float*)(a->ws + WS_ROPE);
    for (size_t i = gt; i < (size_t)SEQ * 8; i += NGT) { const int t = (int)(i >> 3), f = (int)(i & 7);
        const float invt[8] = {1.0f, 0.19392274f, 0.03760603f, 0.0072926646f, 0.0014142136f, 0.0002742482f, 5.3182957e-05f, 1.0313385e-05f};
        float inv = invt[0];
#pragma unroll
        for (int q = 1; q < 8; ++q) inv = (f == q) ? invt[q] : inv;
        const float ang = (float)t * inv;
        const double rev = (double)ang * 0.15915494309189535; const float fr = (float)(rev - __builtin_rint(rev));
        rope[t * 16 + f] = __builtin_amdgcn_cosf(fr); rope[t * 16 + 8 + f] = __builtin_amdgcn_sinf(fr); }
    const f32x4* x4 = (const f32x4*)a->in[0]; u32x4* xb = (u32x4*)(a->ws + WS_XB);
    for (size_t i = gt; i < (size_t)T * DM / 8; i += NGT) { const f32x4 v0 = x4[2 * i], v1 = x4[2 * i + 1];
        u32x4 w; w.x = pk2(v0[0], v0[1]); w.y = pk2(v0[2], v0[3]); w.z = pk2(v1[0], v1[1]); w.w = pk2(v1[2], v1[3]); xb[i] = w; }
}

__device__ __forceinline__ void phase_ln1_router(const Frame& F, ArgsP a, int l) {
    float* X1 = (float*)(a->ws + WS_X1); bf16* XB = (bf16*)(a->ws + WS_XB);
    const float* WR = (const float*)(a->ws + WS_WL + WL_WR);
    const float* lw = a->in[14] + (size_t)l * DM; const float* lb = a->in[15] + (size_t)l * DM;
    const float* bg = a->in[19] + l * 4; const float* be = a->in[21] + l * NEXP;
    int* route_e = (int*)(a->ws + WS_SLOT + SL_RE); int* route_p = (int*)(a->ws + WS_SLOT + SL_RP); float* route_w = (float*)(a->ws + WS_SLOT + SL_RW);
    unsigned* cnt = F.ctl + CW_CNT + l * 512;
    const int gw = F.bid * NWAVES + F.wave, NGW = F.G * NWAVES, lane = F.lane;
    const float mybias = lane < 4 ? bg[lane] : (lane < 36 ? be[lane - 4] : 0.f);
    for (int tg = gw; tg < T / 4; tg += NGW) {
        f32x4 v[4][4];
#pragma unroll
        for (int tk = 0; tk < 4; ++tk) { const f32x4* row = (const f32x4*)(X1 + (size_t)(4 * tg + tk) * DM) + lane;
#pragma unroll
            for (int j = 0; j < 4; ++j) v[tk][j] = row[64 * j]; }
#pragma unroll
        for (int tk = 0; tk < 4; ++tk) {
            float s = 0.f;
#pragma unroll
            for (int j = 0; j < 4; ++j) s += (v[tk][j][0] + v[tk][j][1]) + (v[tk][j][2] + v[tk][j][3]);
            const float mean = wave_sum(s) * (1.f / DM); float q = 0.f;
#pragma unroll
            for (int j = 0; j < 4; ++j) { v[tk][j] = v[tk][j] - mean; q += (v[tk][j][0] * v[tk][j][0] + v[tk][j][1] * v[tk][j][1]) + (v[tk][j][2] * v[tk][j][2] + v[tk][j][3] * v[tk][j][3]); }
            const float rstd = 1.f / sqrtf(wave_sum(q) * (1.f / DM) + LN_EPS);
            f32x4* orow = (f32x4*)(X1 + (size_t)(4 * tg + tk) * DM) + lane; u32x2* brow = (u32x2*)(XB + (size_t)(4 * tg + tk) * DM) + lane;
#pragma unroll
            for (int j = 0; j < 4; ++j) { const f32x4 w4 = ((const f32x4*)lw)[lane + 64 * j], b4 = ((const f32x4*)lb)[lane + 64 * j];
                v[tk][j] = v[tk][j] * rstd * w4 + b4; orow[64 * j] = v[tk][j];
                u32x2 w; w.x = pk2(v[tk][j][0], v[tk][j][1]); w.y = pk2(v[tk][j][2], v[tk][j][3]); brow[64 * j] = w; }
        }
        float lg[4] = {0.f, 0.f, 0.f, 0.f};
#pragma unroll 4
        for (int j36 = 0; j36 < 36; ++j36) {
            const f32x4* wr = (const f32x4*)(WR + (size_t)j36 * DM) + lane;
            const f32x4 w0 = wr[0], w1 = wr[64], w2 = wr[128], w3 = wr[192];
#pragma unroll
            for (int tk = 0; tk < 4; ++tk) {
                f32x4 p = v[tk][0] * w0; p = p + v[tk][1] * w1; p = p + v[tk][2] * w2; p = p + v[tk][3] * w3;
                const float d = wave_sum((p[0] + p[1]) + (p[2] + p[3]));
                lg[tk] = (lane == j36) ? d : lg[tk];
            }
        }
        int my_e = 0; float my_w = 0.f;
#pragma unroll
        for (int tk = 0; tk < 4; ++tk) {
            const float lgb = lg[tk] + mybias;
            float gl[4];
#pragma unroll
            for (int i = 0; i < 4; ++i) gl[i] = __int_as_float(__builtin_amdgcn_readlane(__float_as_int(lgb), i));
            int gi = 0; float gm = gl[0];
#pragma unroll
            for (int i = 1; i < 4; ++i) if (gl[i] > gm) { gm = gl[i]; gi = i; }
            float gs = 0.f;
#pragma unroll
            for (int i = 0; i < 4; ++i) gs += __expf(gl[i] - gm);
            const float g_w = 1.f / gs;
            float ev[8];
#pragma unroll
            for (int i = 0; i < 8; ++i) ev[i] = __int_as_float(__builtin_amdgcn_readlane(__float_as_int(lgb), 4 + gi * 8 + i));
            int i1 = 0; float v1 = ev[0];
#pragma unroll
            for (int i = 1; i < 8; ++i) if (ev[i] > v1) { v1 = ev[i]; i1 = i; }
            int i2 = -1; float v2 = -3.0e38f;
#pragma unroll
            for (int i = 0; i < 8; ++i) if (i != i1 && ev[i] > v2) { v2 = ev[i]; i2 = i; }
            const float e2 = __expf(v2 - v1), w1 = g_w / (1.f + e2), w2 = g_w - w1;
            if (lane == 2 * tk) { my_e = gi * 8 + i1; my_w = w1; }
            if (lane == 2 * tk + 1) { my_e = gi * 8 + i2; my_w = w2; }
        }
        if (lane < 8) {
            const unsigned pos = __hip_atomic_fetch_add(cnt + my_e * 16, 1u, __ATOMIC_RELAXED, __HIP_MEMORY_SCOPE_AGENT);
            const size_t si = (size_t)tg * 8 + lane; route_e[si] = my_e; route_p[si] = (int)pos; route_w[si] = my_w;
        }
    }
}

__device__ __forceinline__ void phase_gather(const Frame& F, ArgsP a, int l) {
    LAS int* pstart = (LAS int*)F.lds;
    unsigned* cnt = F.ctl + CW_CNT + l * 512;
    int* meta = (int*)(a->ws + WS_META) + l * 512;
    int* slot_tok = (int*)(a->ws + WS_SLOT + SL_TOK); float* slot_w = (float*)(a->ws + WS_SLOT + SL_W);
    const int* route_e = (const int*)(a->ws + WS_SLOT + SL_RE); const int* route_p = (const int*)(a->ws + WS_SLOT + SL_RP); const float* route_w = (const float*)(a->ws + WS_SLOT + SL_RW);
    if (F.tid < 64) {
        const int c = F.tid < 32 ? (int)__hip_atomic_load(cnt + F.tid * 16, __ATOMIC_RELAXED, __HIP_MEMORY_SCOPE_AGENT) : 0;
        const int pad = (c + 255) & ~255; int inc = pad;
#pragma unroll
        for (int o = 1; o < 64; o <<= 1) { const int t = __shfl_up(inc, o); if (F.lane >= o) inc += t; }
        const int st = inc - pad;
        if (F.tid < 32) { pstart[F.tid] = st;
            if (F.bid == 0) { for (int t = st >> 8; t < (st + pad) >> 8; ++t) meta[64 + t] = F.tid; if (F.tid == 31) meta[0] = (st + pad) >> 8; }
            if ((F.tid % F.G) == F.bid) for (int r = st + c; r < st + pad; ++r) { slot_tok[r] = -1; slot_w[r] = 0.f; }
        }
    }
    __syncthreads();
    const bf16* XB = (const bf16*)(a->ws + WS_XB); bf16* BUF = (bf16*)(a->ws + WS_H);
    const int gw = F.bid * NWAVES + F.wave, NGW = F.G * NWAVES;
    for (int s = gw; s < T * 2; s += NGW) {
        const int e = route_e[s], dest = pstart[e] + route_p[s];
        const u32x4* src = (const u32x4*)(XB + (size_t)(s >> 1) * DM) + F.lane; u32x4* dst = (u32x4*)(BUF + (size_t)dest * DM) + F.lane;
        const u32x4 v0 = src[0], v1 = src[64]; dst[0] = v0; dst[64] = v1;
        if (F.lane == 0) { slot_tok[dest] = s; slot_w[dest] = route_w[s]; }
    }
    __syncthreads();
}

__device__ __forceinline__ void phase_ln2(const Frame& F, ArgsP a, int l) {
    const float* X1 = (const float*)(a->ws + WS_X1); const bf16* Y2 = (const bf16*)(a->ws + WS_Y2); bf16* XB = (bf16*)(a->ws + WS_XB); float* out = a->out;
    const float* lw = a->in[16] + (size_t)l * DM; const float* lb = a->in[17] + (size_t)l * DM;
    const int gw = F.bid * NWAVES + F.wave, NGW = F.G * NWAVES, lane = F.lane;
    for (int t = gw; t < T; t += NGW) {
        const f32x4* row = (const f32x4*)(X1 + (size_t)t * DM) + lane; const u32x2* ya = (const u32x2*)(Y2 + (size_t)(2 * t) * DM) + lane; const u32x2* yb = (const u32x2*)(Y2 + (size_t)(2 * t + 1) * DM) + lane;
        f32x4 v[4]; float s = 0.f;
#pragma unroll
        for (int j = 0; j < 4; ++j) { const f32x4 x = row[64 * j]; const u32x2 p = ya[64 * j], q = yb[64 * j];
            v[j][0] = x[0] * DN_ALPHA + (bf2f(p.x & 0xffffu) + bf2f(q.x & 0xffffu)); v[j][1] = x[1] * DN_ALPHA + (bf2f(p.x >> 16) + bf2f(q.x >> 16));
            v[j][2] = x[2] * DN_ALPHA + (bf2f(p.y & 0xffffu) + bf2f(q.y & 0xffffu)); v[j][3] = x[3] * DN_ALPHA + (bf2f(p.y >> 16) + bf2f(q.y >> 16));
            s += (v[j][0] + v[j][1]) + (v[j][2] + v[j][3]); }
        const float mean = wave_sum(s) * (1.f / DM); float q2 = 0.f;
#pragma unroll
        for (int j = 0; j < 4; ++j) { v[j] = v[j] - mean; q2 += (v[j][0] * v[j][0] + v[j][1] * v[j][1]) + (v[j][2] * v[j][2] + v[j][3] * v[j][3]); }
        const float rstd = 1.f / sqrtf(wave_sum(q2) * (1.f / DM) + LN_EPS);
        f32x4* orow = (f32x4*)(out + (size_t)t * DM) + lane; u32x2* brow = (u32x2*)(XB + (size_t)t * DM) + lane;
#pragma unroll
        for (int j = 0; j < 4; ++j) { const f32x4 w4 = ((const f32x4*)lw)[lane + 64 * j], b4 = ((const f32x4*)lb)[lane + 64 * j];
            const f32x4 o = v[j] * rstd * w4 + b4; orow[64 * j] = o; u32x2 w; w.x = pk2(o[0], o[1]); w.y = pk2(o[2], o[3]); brow[64 * j] = w; }
    }
}

__device__ __forceinline__ int tsw(int row, int col) { return row * 128 + ((((col >> 3) ^ (row >> 1)) & 7) << 4) + ((col & 7) << 1); }
__device__ __forceinline__ f32x4 mfma16(bf16x8 a, bf16x8 b, f32x4 c) { return __builtin_amdgcn_mfma_f32_16x16x32_bf16(a, b, c, 0, 0, 0); }
__device__ __forceinline__ f32x16 mfma32(bf16x8 a, bf16x8 b, f32x16 c) { return __builtin_amdgcn_mfma_f32_32x32x16_bf16(a, b, c, 0, 0, 0); }
__device__ __forceinline__ bf16x8 as_bf16x8(u32x4 v) { return __builtin_bit_cast(bf16x8, v); }

__device__ __forceinline__ void conformer_item(const Frame& F, ArgsP a, int l, int it) {
    const int b = it >> 6, s0 = (it & 63) * 64; const size_t tok0 = (size_t)b * SEQ + s0;
    const bf16* H = (const bf16*)(a->ws + WS_H); bf16* Y = (bf16*)(a->ws + WS_Y);
    LAS bf16* ut = (LAS bf16*)F.lds;
    LAS float* co = (LAS float*)(F.lds + 49152);
    for (int idx = F.tid; idx < 94 * 32; idx += NTHR) {
        const int r = idx >> 5, c8 = (idx & 31) * 8, s = s0 - 30 + r; u32x4 w = {0u, 0u, 0u, 0u};
        if (s >= 0) { const bf16* hp = H + ((size_t)b * SEQ + s) * HLD + 2304 + c8; const u32x4 v = *(const u32x4*)hp, g = *(const u32x4*)(hp + 256);
#pragma unroll
            for (int e = 0; e < 4; ++e) { const float v0 = bf2f(v[e] & 0xffffu) * fsigmoid(bf2f(g[e] & 0xffffu)), v1 = bf2f(v[e] >> 16) * fsigmoid(bf2f(g[e] >> 16)); w[e] = pk2(v0, v1); } }
        *(LAS u32x4*)(ut + r * 256 + c8) = w;
    }
    __syncthreads();
    {
        const int c = F.tid & 255, half = F.tid >> 8; const float* dw = a->in[10] + (size_t)l * 31 * 256 + c; const float bias = a->in[11][l * 256 + c];
        float w[31], ur[62];
#pragma unroll
        for (int k = 0; k < 31; ++k) w[k] = dw[k * 256];
#pragma unroll
        for (int i = 0; i < 62; ++i) ur[i] = bf2f(ut[(32 * half + i) * 256 + c]);
#pragma unroll
        for (int tt = 0; tt < 32; ++tt) { float acc = bias;
#pragma unroll
            for (int k = 0; k < 31; ++k) acc += w[k] * ur[tt + k];
            co[(32 * half + tt) * 256 + c] = acc; }
    }
    __syncthreads();
    {
        const float* lw = a->in[12] + l * 256; const float* lb = a->in[13] + l * 256; const f32x4 w4 = ((const f32x4*)lw)[F.lane], b4 = ((const f32x4*)lb)[F.lane];
#pragma unroll
        for (int i = 0; i < 8; ++i) { const int tl = 8 * F.wave + i; f32x4 v = *(LAS f32x4*)(co + tl * 256 + 4 * F.lane);
            const float mean = wave_sum((v[0] + v[1]) + (v[2] + v[3])) * (1.f / 256.f); v = v - mean;
            const float rstd = 1.f / sqrtf(wave_sum((v[0] * v[0] + v[1] * v[1]) + (v[2] * v[2] + v[3] * v[3])) * (1.f / 256.f) + LN_EPS);
            v = v * rstd * w4 + b4; u32x2 o; o.x = pk2(fsilu(v[0]), fsilu(v[1])); o.y = pk2(fsilu(v[2]), fsilu(v[3]));
            *(u32x2*)(Y + (tok0 + tl) * DM + 768 + 4 * F.lane) = o; }
    }
    __syncthreads();
}

__device__ __forceinline__ void compress_item(const Frame& F, ArgsP a, int it) {
    const int kv = it >> 6, bh = (it >> 2) & 15, b = bh >> 1, hh = bh & 1, i0 = (it & 3) * 64;
    const bf16* H = (const bf16*)(a->ws + WS_H); const bf16* w1t = (const bf16*)(a->ws + WS_WL + WL_W1) + (size_t)kv * 128 * 2048; const bf16* w2t = (const bf16*)(a->ws + WS_WL + WL_W2) + (size_t)kv * 64 * 128;
    const float* bias1 = (const float*)(a->ws + WS_WL + WL_BIAS1) + kv * 128; bf16* outp = (bf16*)(a->ws + (kv ? WS_VC : WS_KC)) + (size_t)bh * 256 * 64;
    LAS bf16* hid = (LAS bf16*)F.lds;
    const int lane = F.lane, li = lane & 15, g = lane >> 4, rt = F.wave & 3, ch = F.wave >> 2;
    const int i = i0 + 16 * rt + li; const bf16* arow = H + (size_t)b * SEQ * HLD + 512 + kv * 128 + hh * 64 + 8 * g;
    const bf16* brow = w1t + (size_t)(64 * ch + li) * 2048 + 8 * g;
    f32x4 acc[4] = {{0.f, 0.f, 0.f, 0.f}, {0.f, 0.f, 0.f, 0.f}, {0.f, 0.f, 0.f, 0.f}, {0.f, 0.f, 0.f, 0.f}};
#pragma unroll 4
    for (int ks = 0; ks < 64; ++ks) {
        int s = 16 * i + (ks >> 1); s = s > SEQ - 1 ? SEQ - 1 : s;
        const bf16x8 af = *(const bf16x8*)(arow + (size_t)s * HLD + (ks & 1) * 32);
#pragma unroll
        for (int nt = 0; nt < 4; ++nt) { const bf16x8 bfr = *(const bf16x8*)(brow + (size_t)nt * 16 * 2048 + ks * 32); acc[nt] = mfma16(af, bfr, acc[nt]); }
    }
#pragma unroll
    for (int nt = 0; nt < 4; ++nt) { const int n = 64 * ch + 16 * nt + li; const float bs = bias1[n];
#pragma unroll
        for (int r = 0; r < 4; ++r) hid[(16 * rt + 4 * g + r) * 136 + n] = (bf16)f2bf(fsilu(acc[nt][r] + bs)); }
    __syncthreads();
    f32x4 o2[2] = {{0.f, 0.f, 0.f, 0.f}, {0.f, 0.f, 0.f, 0.f}};
#pragma unroll
    for (int ks = 0; ks < 4; ++ks) { const bf16x8 af = *(LAS bf16x8*)(hid + (16 * rt + li) * 136 + 32 * ks + 8 * g);
#pragma unroll
        for (int nt = 0; nt < 2; ++nt) { const bf16x8 bfr = *(const bf16x8*)(w2t + (size_t)(32 * ch + 16 * nt + li) * 128 + 32 * ks + 8 * g); o2[nt] = mfma16(af, bfr, o2[nt]); } }
#pragma unroll
    for (int nt = 0; nt < 2; ++nt)
#pragma unroll
        for (int r = 0; r < 4; ++r) { const int io = i0 + 16 * rt + 4 * g + r; outp[(size_t)io * 64 + 32 * ch + 16 * nt + li] = (bf16)(io < 255 ? f2bf(o2[nt][r]) : 0u); }
    __syncthreads();
}

__host__ __device__ constexpr int tri_off(int i) { int s = 0; for (int k = 0; k < i; ++k) s += (k + 3) >> 2; return 4 * s; }
__device__ __forceinline__ int tri_off_rt(int i) { const int m = i - 1, V = (m + 3) >> 2; return i <= 0 ? 0 : 4 * (2 * V * (V - 1) + V * (m - 4 * V + 4)); }

template <int I> struct GdnSolveRow {
    __device__ static __forceinline__ void run(const LAS float* Ap, float (&x)[64]) {
        if constexpr (I < 64) {
            constexpr int off = tri_off(I), nb = (I + 3) >> 2;
            float a0 = x[I];
#pragma unroll
            for (int jb = 0; jb < nb; ++jb) { const f32x4 a4 = *(const LAS f32x4*)(Ap + off + 4 * jb);
#pragma unroll
                for (int jj = 0; jj < 4; ++jj) { if (4 * jb + jj < I) a0 -= a4[jj] * x[4 * jb + jj]; } }
            x[I] = a0;
            GdnSolveRow<I + 1>::run(Ap, x);
        }
    }
};

__device__ __forceinline__ void gdn_prep_chunk(const Frame& F, ArgsP a, int l, int ci, LAS unsigned char* wl) {
    const int lane = F.lane, li = lane & 15, g = lane >> 4; const int bh = ci >> 6, n = ci & 63, b = bh >> 2, h = bh & 3; const size_t tok0 = (size_t)b * SEQ + 64 * n;
    const bf16* H = (const bf16*)(a->ws + WS_H); const float* side = (const float*)(a->ws + WS_SIDE);
    unsigned char* rec = a->ws + WS_GPREP + (size_t)ci * GCH;
    bf16* R0 = (bf16*)(rec + GC_UT); bf16* R1 = (bf16*)(rec + GC_W); bf16* QKm = (bf16*)(rec + GC_QK); bf16* QD = (bf16*)(rec + GC_QD); bf16* KDT = (bf16*)(rec + GC_KDT);
    LAS unsigned char* qt = wl; LAS unsigned char* kt = wl + 8192; LAS float* Ap = (LAS float*)wl;
    const float beta = side[(tok0 + lane) * 32 + 24 + h]; const float av = side[(tok0 + lane) * 32 + 28 + h] + a->in[8][l * 4 + h];
    const float sp = av > 20.f ? av : log1pf(__expf(av)); float gc = -__expf(a->in[7][l * 4 + h]) * sp;
#pragma unroll
    for (int o = 1; o < 64; o <<= 1) { const float t = __shfl_up(gc, o); if (lane >= o) gc += t; }
    const float gl = __shfl(gc, 63); const float eg = __expf(gc), ekd = __expf(gl - gc);
    if (lane == 0) ((float*)(a->ws + WS_GL))[ci] = __expf(gl);
    const float* cw = a->in[6] + (size_t)l * 4 * 768 + h * 64 + lane; float wq[4], wk[4], wv[4];
#pragma unroll
    for (int k = 0; k < 4; ++k) { wq[k] = cw[k * 768]; wk[k] = cw[k * 768 + 256]; wv[k] = cw[k * 768 + 512]; }
    const bf16* hp = H + tok0 * HLD + 1280 + h * 64 + lane; float hq[3], hk[3], hv[3];
#pragma unroll
    for (int j = 0; j < 3; ++j) { const bool ok = (64 * n - 3 + j) >= 0; const bf16* p = hp + (ptrdiff_t)(j - 3) * HLD;
        hq[j] = ok ? bf2f(p[0]) : 0.f; hk[j] = ok ? bf2f(p[256]) : 0.f; hv[j] = ok ? bf2f(p[512]) : 0.f; }
    for (int t8 = 0; t8 < 8; ++t8) {
        unsigned kdp[4];
#pragma unroll
        for (int tt = 0; tt < 8; ++tt) { const int t = 8 * t8 + tt; const bf16* p = hp + (size_t)t * HLD;
            const float rq = bf2f(p[0]), rk = bf2f(p[256]), rv = bf2f(p[512]);
            const float cq = wq[0] * hq[0] + wq[1] * hq[1] + wq[2] * hq[2] + wq[3] * rq, ck = wk[0] * hk[0] + wk[1] * hk[1] + wk[2] * hk[2] + wk[3] * rk, cv = wv[0] * hv[0] + wv[1] * hv[1] + wv[2] * hv[2] + wv[3] * rv;
            hq[0] = hq[1]; hq[1] = hq[2]; hq[2] = rq; hk[0] = hk[1]; hk[1] = hk[2]; hk[2] = rk; hv[0] = hv[1]; hv[1] = hv[2]; hv[2] = rv;
            const float qs = fsilu(cq), ks_ = fsilu(ck), vs = fsilu(cv);
            const float qn = qs * __builtin_amdgcn_rsqf(wave_sum(qs * qs) + 1e-6f) * 0.125f, kn = ks_ * __builtin_amdgcn_rsqf(wave_sum(ks_ * ks_) + 1e-6f);
            const float bt = __shfl(beta, t), egt = __shfl(eg, t), ekt = __shfl(ekd, t);
            *(LAS bf16*)(qt + tsw(t, lane)) = (bf16)f2bf(qn); *(LAS bf16*)(kt + tsw(t, lane)) = (bf16)f2bf(kn);
            QD[t * 64 + lane] = (bf16)f2bf(qn * egt); R0[t * 64 + lane] = (bf16)f2bf(bt * vs); R1[t * 64 + lane] = (bf16)f2bf(bt * egt * kn);
            const unsigned kd = f2bf(kn * ekt); if (tt & 1) kdp[tt >> 1] |= kd << 16; else kdp[tt >> 1] = kd; }
        u32x4 w; w.x = kdp[0]; w.y = kdp[1]; w.z = kdp[2]; w.w = kdp[3]; *(u32x4*)(KDT + lane * 64 + 8 * t8) = w;
    }
    LDS_WAIT();
    float gcj[4][4];
#pragma unroll
    for (int mt = 0; mt < 4; ++mt)
#pragma unroll
        for (int r = 0; r < 4; ++r) gcj[mt][r] = __shfl(gc, 16 * mt + 4 * g + r);
    f32x4 ahold[4][4];
#pragma unroll
    for (int nt = 0; nt < 4; ++nt) {
        const int i = 16 * nt + li; const float gci = __shfl(gc, i), bi = __shfl(beta, i);
        bf16x8 kB[2], qB[2];
#pragma unroll
        for (int ks = 0; ks < 2; ++ks) { kB[ks] = *(LAS bf16x8*)(kt + tsw(i, 32 * ks + 8 * g)); qB[ks] = *(LAS bf16x8*)(qt + tsw(i, 32 * ks + 8 * g)); }
#pragma unroll
        for (int mt = 0; mt < 4; ++mt) {
            u32x2 qw = {0u, 0u};
            if (mt <= nt) {
                const bf16x8 kA0 = *(LAS bf16x8*)(kt + tsw(16 * mt + li, 8 * g)), kA1 = *(LAS bf16x8*)(kt + tsw(16 * mt + li, 32 + 8 * g));
                f32x4 ckk = {0.f, 0.f, 0.f, 0.f}, cqk = {0.f, 0.f, 0.f, 0.f};
                ckk = mfma16(kA0, kB[0], ckk); ckk = mfma16(kA1, kB[1], ckk); cqk = mfma16(kA0, qB[0], cqk); cqk = mfma16(kA1, qB[1], cqk);
                float qv[4];
#pragma unroll
                for (int r = 0; r < 4; ++r) { const int j = 16 * mt + 4 * g + r; const float dec = __expf(fminf(gci - gcj[mt][r], 0.f));
                    ahold[nt][mt][r] = bi * ckk[r] * dec; qv[r] = (j <= i) ? cqk[r] * dec : 0.f; }
                qw.x = pk2(qv[0], qv[1]); qw.y = pk2(qv[2], qv[3]);
            }
            *(u32x2*)(QKm + i * 64 + 16 * mt + 4 * g) = qw;
        }
    }
    LDS_WAIT(); SBAR();
#pragma unroll
    for (int nt = 0; nt < 4; ++nt) { const int i = 16 * nt + li; const int ro = tri_off_rt(i);
#pragma unroll
        for (int mt = 0; mt < 4; ++mt) if (mt <= nt) {
#pragma unroll
            for (int r = 0; r < 4; ++r) { const int j = 16 * mt + 4 * g + r; if (j < i) Ap[ro + j] = ahold[nt][mt][r]; } } }
    VM_WAIT(); LDS_WAIT();
#pragma unroll 1
    for (int pass = 0; pass < 2; ++pass) {
        bf16* Rp = pass ? R1 : R0; float x[64];
#pragma unroll
        for (int i = 0; i < 64; ++i) x[i] = bf2f(Rp[i * 64 + lane]);
        VM_WAIT();
        GdnSolveRow<1>::run(Ap, x);
        if (pass == 0) {
#pragma unroll
            for (int i8 = 0; i8 < 8; ++i8) { u32x4 w; w.x = pk2(x[8 * i8], x[8 * i8 + 1]); w.y = pk2(x[8 * i8 + 2], x[8 * i8 + 3]); w.z = pk2(x[8 * i8 + 4], x[8 * i8 + 5]); w.w = pk2(x[8 * i8 + 6], x[8 * i8 + 7]);
                *(u32x4*)(Rp + lane * 64 + 8 * i8) = w; }
        } else {
#pragma unroll
            for (int i = 0; i < 64; ++i) Rp[i * 64 + lane] = (bf16)f2bf(x[i]);
        }
    }
    LDS_WAIT();
}

__device__ __forceinline__ bf16x8 scan_frag(const unsigned char* mat, int mt, int ks, int li, int g) {
    const unsigned char* p = mat + (16 * mt + li) * 128 + (32 * ks + 4 * g) * 2; const u32x2 lo = *(const u32x2*)p, hi = *(const u32x2*)(p + 32);
    u32x4 w; w.x = lo.x; w.y = lo.y; w.z = hi.x; w.w = hi.y; return as_bf16x8(w);
}
__device__ __forceinline__ bf16x8 pack_c2(f32x4 a, f32x4 b) { u32x4 w; w.x = pk2(a[0], a[1]); w.y = pk2(a[2], a[3]); w.z = pk2(b[0], b[1]); w.w = pk2(b[2], b[3]); return as_bf16x8(w); }
__device__ __forceinline__ void gdn_scan(const Frame& F, ArgsP a, int l) {
    const int lane = F.lane, li = lane & 15, g = lane >> 4, pr = F.wave >> 2, sl = F.wave & 3; const int bh = F.bid * 2 + pr, b = bh >> 2, h = bh & 3, dv0 = 16 * sl;
    const bf16* H = (const bf16*)(a->ws + WS_H); bf16* Y = (bf16*)(a->ws + WS_Y); const float* GL = (const float*)(a->ws + WS_GL);
    LAS float* part = (LAS float*)F.lds;
    const float nw = a->in[9][l * 64 + dv0 + li];
    f32x4 S[4] = {{0.f, 0.f, 0.f, 0.f}, {0.f, 0.f, 0.f, 0.f}, {0.f, 0.f, 0.f, 0.f}, {0.f, 0.f, 0.f, 0.f}};
    for (int n = 0; n < 64; ++n) {
        const int ci = bh * 64 + n; const unsigned char* rec = a->ws + WS_GPREP + (size_t)ci * GCH; const float egl = GL[ci];
        const bf16x8 Sb0 = pack_c2(S[0], S[1]), Sb1 = pack_c2(S[2], S[3]);
        f32x4 vn[4], o[4];
#pragma unroll
        for (int mt = 0; mt < 4; ++mt) {
            f32x4 acc = {0.f, 0.f, 0.f, 0.f};
            acc = mfma16(scan_frag(rec + GC_W, mt, 0, li, g), Sb0, acc); acc = mfma16(scan_frag(rec + GC_W, mt, 1, li, g), Sb1, acc);
            const u32x2 uu = *(const u32x2*)(rec + GC_UT + (dv0 + li) * 128 + (16 * mt + 4 * g) * 2);
            vn[mt][0] = bf2f(uu.x & 0xffffu) - acc[0]; vn[mt][1] = bf2f(uu.x >> 16) - acc[1]; vn[mt][2] = bf2f(uu.y & 0xffffu) - acc[2]; vn[mt][3] = bf2f(uu.y >> 16) - acc[3];
        }
        const bf16x8 Vb0 = pack_c2(vn[0], vn[1]), Vb1 = pack_c2(vn[2], vn[3]);
#pragma unroll
        for (int mt = 0; mt < 4; ++mt) {
            f32x4 acc = {0.f, 0.f, 0.f, 0.f};
            acc = mfma16(scan_frag(rec + GC_QD, mt, 0, li, g), Sb0, acc); acc = mfma16(scan_frag(rec + GC_QD, mt, 1, li, g), Sb1, acc);
            acc = mfma16(scan_frag(rec + GC_QK, mt, 0, li, g), Vb0, acc); acc = mfma16(scan_frag(rec + GC_QK, mt, 1, li, g), Vb1, acc);
            o[mt] = acc;
        }
#pragma unroll
        for (int mt = 0; mt < 4; ++mt) { f32x4 acc = S[mt] * egl;
            acc = mfma16(scan_frag(rec + GC_KDT, mt, 0, li, g), Vb0, acc); acc = mfma16(scan_frag(rec + GC_KDT, mt, 1, li, g), Vb1, acc); S[mt] = acc; }
        LAS float* pp = part + (n & 1) * 512 + pr * 256;
#pragma unroll
        for (int mt = 0; mt < 4; ++mt)
#pragma unroll
            for (int r = 0; r < 4; ++r) { float ss = o[mt][r] * o[mt][r]; ss += __shfl_xor(ss, 1); ss += __shfl_xor(ss, 2); ss += __shfl_xor(ss, 4); ss += __shfl_xor(ss, 8);
                if (li == 0) pp[sl * 64 + 16 * mt + 4 * g + r] = ss; }
        __syncthreads();
        const size_t tokb = (size_t)b * SEQ + 64 * n;
#pragma unroll
        for (int mt = 0; mt < 4; ++mt)
#pragma unroll
            for (int r = 0; r < 4; ++r) { const int tk = 16 * mt + 4 * g + r; const float tot = (pp[tk] + pp[64 + tk]) + (pp[128 + tk] + pp[192 + tk]);
                const float rs = __builtin_amdgcn_rsqf(tot * (1.f / 64.f) + 1e-6f); const float z = bf2f(H[(tokb + tk) * HLD + 2048 + h * 64 + dv0 + li]);
                Y[(tokb + tk) * DM + 512 + h * 64 + dv0 + li] = (bf16)f2bf(o[mt][r] * rs * nw * fsilu(z)); }
    }
    __syncthreads();
}

constexpr int AT_K = 0, AT_V = 16384, AT_IMP = 32768, AT_SELM = AT_IMP + 64 * 68 * 4, AT_UNI = AT_SELM + 512;
__device__ __forceinline__ s16x4 tr_read0(unsigned addr) { s16x4 r; asm volatile("ds_read_b64_tr_b16 %0, %1" : "=&v"(r) : "v"(addr) : "memory"); return r; }

struct AttnStage { u32x4 kr, vr; };
__device__ __forceinline__ void at_gload(AttnStage& st, const bf16* Kb, const bf16* Vb, size_t stride, int j, int tid) {
    const int row = tid >> 3, ch = tid & 7; const size_t off = (size_t)(64 * j + row) * stride + 8 * ch;
    st.kr = *(const u32x4*)(Kb + off); st.vr = *(const u32x4*)(Vb + off);
}
__device__ __forceinline__ void at_swrite(const AttnStage& st, LAS unsigned char* lds, int buf, int tid) {
    const int row = tid >> 3, ch = tid & 7; const int o = row * 128 + (((ch ^ (row >> 1)) & 7) << 4);
    *(LAS u32x4*)(lds + AT_K + buf * 8192 + o) = st.kr; *(LAS u32x4*)(lds + AT_V + buf * 8192 + o) = st.vr;
}
__device__ __forceinline__ void at_qk(const LAS unsigned char* Kt, const bf16x8 (&Qf)[4], int r, int hf, f32x16 (&s)[2]) {
    const int swz = (r >> 1) & 7;
#pragma unroll
    for (int kt = 0; kt < 2; ++kt) {
        f32x16 acc;
#pragma unroll
        for (int e = 0; e < 16; ++e) acc[e] = 0.f;
#pragma unroll
        for (int ks = 0; ks < 4; ++ks) { const bf16x8 kf = *(const LAS bf16x8*)(Kt + (32 * kt + r) * 128 + (((2 * ks + hf) ^ swz) << 4)); acc = mfma32(kf, Qf[ks], acc); }
        s[kt] = acc;
    }
}
__device__ __forceinline__ void at_pv(unsigned vbase, const unsigned (&voff)[2][2], const f32x16 (&p)[2], f32x16 (&o)[2]) {
#pragma unroll
    for (int kt = 0; kt < 2; ++kt)
#pragma unroll
        for (int s = 0; s < 2; ++s) {
            u32x4 pw; pw.x = pk2(p[kt][8 * s + 0], p[kt][8 * s + 1]); pw.y = pk2(p[kt][8 * s + 2], p[kt][8 * s + 3]); pw.z = pk2(p[kt][8 * s + 4], p[kt][8 * s + 5]); pw.w = pk2(p[kt][8 * s + 6], p[kt][8 * s + 7]);
            const bf16x8 pb = as_bf16x8(pw); const unsigned co = vbase + (unsigned)(4096 * kt + 2048 * s);
            const s16x4 l0 = tr_read0(co + voff[0][0]), h0 = tr_read0(co + voff[1][0]), l1 = tr_read0(co + voff[0][1]), h1 = tr_read0(co + voff[1][1]);
            asm volatile("s_waitcnt lgkmcnt(0)" ::: "memory"); SBAR();
            const bf16x8 v0 = {l0[0], l0[1], l0[2], l0[3], h0[0], h0[1], h0[2], h0[3]}, v1 = {l1[0], l1[1], l1[2], l1[3], h1[0], h1[1], h1[2], h1[3]};
            o[0] = mfma32(v0, pb, o[0]); o[1] = mfma32(v1, pb, o[1]);
        }
}

struct AttnRow { int r, hf, tt, t, qb, wave; unsigned long long wave_union; float m, lpart; };
template <int MODE>
__device__ __forceinline__ void at_branch(const Frame& F, unsigned long long mask, const bf16* Kb, const bf16* Vb, size_t stride, const bf16x8 (&Qf)[4], AttnRow& R, const unsigned (&voff)[2][2],
                                          f32x16 (&o)[2], float mfin, float invl) {
    LAS unsigned char* lds = F.lds; const int tid = F.tid;
    if (mask == 0ull) return;
    AttnStage st; int buf = 0;
    { const int j0 = __builtin_ctzll(mask); at_gload(st, Kb, Vb, stride, j0, tid); at_swrite(st, lds, 0, tid); }
    __syncthreads();
    while (mask) {
        const int j = __builtin_ctzll(mask); mask &= mask - 1ull; const int jn = mask ? __builtin_ctzll(mask) : -1;
        if (jn >= 0) at_gload(st, Kb, Vb, stride, jn, tid);
        bool work = true;
        if (MODE == 2) work = (R.wave_union >> j) & 1ull;
        if (work) {
            f32x16 s[2]; at_qk(lds + AT_K + buf * 8192, Qf, R.r, R.hf, s);
            int hi = 1000, lo = -1000; bool rowok = true;
            if (MODE <= 1) hi = ((R.t - 31) >> 4) - 64 * j - 4 * R.hf;
            if (MODE == 2) { const unsigned long long sm = *(const LAS unsigned long long*)(lds + AT_SELM + 8 * R.tt); rowok = (sm >> j) & 1ull; if (j == R.qb) hi = R.tt - 4 * R.hf; }
            if (MODE == 3) { if (j == R.qb) hi = R.tt - 4 * R.hf; if (j == R.qb - 8) lo = R.tt + 1 - 4 * R.hf; }
            if (!rowok) hi = -1000;
            if (MODE == 1) {
#pragma unroll
                for (int kt = 0; kt < 2; ++kt)
#pragma unroll
                    for (int e = 0; e < 16; ++e) { const int cst = 32 * kt + (e & 3) + 8 * (e >> 2); s[kt][e] = (cst <= hi) ? fexp2(s[kt][e] - mfin) * invl : 0.f; }
                LAS float* imp = (LAS float*)(lds + AT_IMP) + R.tt * 68;
#pragma unroll
                for (int kt = 0; kt < 2; ++kt)
#pragma unroll
                    for (int rg = 0; rg < 4; ++rg) {
                        float av = 2.f * (s[kt][4 * rg] + s[kt][4 * rg + 1] + s[kt][4 * rg + 2]) + s[kt][4 * rg + 3], bv = s[kt][4 * rg + 3];
                        av += __shfl_xor(av, 1); av += __shfl_xor(av, 2); bv += __shfl_xor(bv, 1); bv += __shfl_xor(bv, 2);
                        if ((R.r & 3) == 0) { const int jb = 16 * j + 8 * kt + 2 * rg + R.hf; __hip_atomic_fetch_add(imp + jb, av, __ATOMIC_RELAXED, __HIP_MEMORY_SCOPE_WORKGROUP); __hip_atomic_fetch_add(imp + jb + 1, bv, __ATOMIC_RELAXED, __HIP_MEMORY_SCOPE_WORKGROUP); }
                    }
                at_pv((unsigned)(size_t)(lds + AT_V + buf * 8192), voff, s, o);
            } else {
                float tmax = -INFINITY;
#pragma unroll
                for (int kt = 0; kt < 2; ++kt)
#pragma unroll
                    for (int e = 0; e < 16; ++e) { const int cst = 32 * kt + (e & 3) + 8 * (e >> 2); const bool ok = (cst <= hi) && (cst >= lo); s[kt][e] = ok ? s[kt][e] : -INFINITY; tmax = fmaxf(tmax, s[kt][e]); }
                tmax = fmaxf(tmax, __shfl_xor(tmax, 32));
                const float mn = fmaxf(R.m, tmax), alpha = fexp2(R.m - mn); R.m = mn;
                float ps = 0.f;
#pragma unroll
                for (int kt = 0; kt < 2; ++kt)
#pragma unroll
                    for (int e = 0; e < 16; ++e) { s[kt][e] = fexp2(s[kt][e] - mn); ps += s[kt][e]; }
                R.lpart = R.lpart * alpha + ps;
                if (MODE >= 2) {
                    if (__any(alpha < 1.f)) {
#pragma unroll
                        for (int e = 0; e < 16; ++e) { o[0][e] *= alpha; o[1][e] *= alpha; } }
                    at_pv((unsigned)(size_t)(lds + AT_V + buf * 8192), voff, s, o);
                }
            }
        }
        if (jn >= 0) at_swrite(st, lds, buf ^ 1, tid);
        __syncthreads();
        buf ^= 1;
    }
}

__device__ __forceinline__ void attn_item(const Frame& F, ArgsP a, int l, int item) {
    const int qb = 63 - (item >> 4), bh = item & 15, b = bh >> 1, hk = bh & 1; const int lane = F.lane, wave = F.wave;
    const bf16* H = (const bf16*)(a->ws + WS_H); const float* side = (const float*)(a->ws + WS_SIDE); bf16* Y = (bf16*)(a->ws + WS_Y);
    LAS unsigned char* lds = F.lds;
    AttnRow R; R.r = lane & 31; R.hf = lane >> 5; R.tt = 8 * wave + (R.r >> 2); R.t = 64 * qb + R.tt; R.qb = qb; R.wave = wave; R.wave_union = 0ull;
    const int head = hk * 4 + (R.r & 3); const size_t tok = (size_t)b * SEQ + R.t;
    bf16x8 Qf[4];
#pragma unroll
    for (int ks = 0; ks < 4; ++ks) Qf[ks] = *(const bf16x8*)(H + tok * HLD + head * 64 + 16 * ks + 8 * R.hf);
    const float g_cmp = side[tok * 32 + head * 3], g_sel = side[tok * 32 + head * 3 + 1], g_win = side[tok * 32 + head * 3 + 2];
    unsigned voff[2][2];
    { const int li = lane & 15, q = li >> 2, p = li & 3, gi1 = (lane >> 4) & 1;
#pragma unroll
      for (int jh = 0; jh < 2; ++jh)
#pragma unroll
          for (int dt = 0; dt < 2; ++dt) voff[jh][dt] = (unsigned)((8 * jh + 4 * R.hf + q) * 128 + ((((4 * dt + 2 * gi1 + (p >> 1)) ^ (4 * jh + 2 * R.hf + (q >> 1))) & 7) << 4) + (p & 1) * 8); }
    { LAS float* imp = (LAS float*)(lds + AT_IMP) + (8 * wave) * 68; for (int i = lane; i < 8 * 68; i += 64) imp[i] = 0.f; if (F.tid == 0) { *(LAS unsigned*)(lds + AT_UNI) = 0u; *(LAS unsigned*)(lds + AT_UNI + 4) = 0u; } }
    f32x16 ysum[2], o[2];
#pragma unroll
    for (int e = 0; e < 16; ++e) { ysum[0][e] = 0.f; ysum[1][e] = 0.f; o[0][e] = 0.f; o[1][e] = 0.f; }
    {
        const bf16* Kc = (const bf16*)(a->ws + WS_KC) + (size_t)bh * 256 * 64; const bf16* Vc = (const bf16*)(a->ws + WS_VC) + (size_t)bh * 256 * 64;
        const int ntc = (4 * qb + 3 + 63) >> 6; const unsigned long long mc = (ntc >= 64) ? ~0ull : ((1ull << ntc) - 1ull);
        R.m = -1e30f; R.lpart = 0.f;
        at_branch<0>(F, mc, Kc, Vc, 64, Qf, R, voff, o, 0.f, 0.f);
        const float lsum = R.lpart + __shfl_xor(R.lpart, 32); const float invl = 1.f / fmaxf(lsum, 1e-30f);
        at_branch<1>(F, mc, Kc, Vc, 64, Qf, R, voff, o, R.m, invl);
#pragma unroll
        for (int e = 0; e < 16; ++e) { ysum[0][e] = g_cmp * o[0][e]; ysum[1][e] = g_cmp * o[1][e]; o[0][e] = 0.f; o[1][e] = 0.f; }
    }
    LDS_WAIT();
    {
        unsigned long long wu = 0ull;
        for (int qi = 0; qi < 8; ++qi) {
            unsigned long long selm;
            if (qb < 16) selm = (2ull << qb) - 1ull;
            else {
                const float v = ((const LAS float*)(lds + AT_IMP))[(8 * wave + qi) * 68 + lane];
                const bool cand = (lane >= 1) && (lane <= qb - 2); const unsigned key = cand ? __float_as_uint(fmaxf(v, 0.f)) : 0u;
                unsigned thr = 0u;
                for (int bit = 30; bit >= 0; --bit) { const unsigned tr = thr | (1u << bit); const int c = __popcll(__ballot(cand && key >= tr)); if (c >= 13) thr = tr; }
                const unsigned long long gt = __ballot(cand && key > thr), eq = __ballot(cand && key == thr);
                int need = 13 - __popcll(gt); unsigned long long eqs = 0ull, e2 = eq;
                while (need > 0 && e2) { const unsigned long long low = e2 & (~e2 + 1ull); eqs |= low; e2 ^= low; --need; }
                selm = gt | eqs | 1ull | (1ull << qb) | (1ull << (qb - 1));
            }
            if (lane == 0) *(LAS unsigned long long*)(lds + AT_SELM + 8 * (8 * wave + qi)) = selm;
            wu |= selm;
        }
        R.wave_union = wu;
        if (lane == 0) { __hip_atomic_fetch_or((LAS unsigned*)(lds + AT_UNI), (unsigned)wu, __ATOMIC_RELAXED, __HIP_MEMORY_SCOPE_WORKGROUP); __hip_atomic_fetch_or((LAS unsigned*)(lds + AT_UNI + 4), (unsigned)(wu >> 32), __ATOMIC_RELAXED, __HIP_MEMORY_SCOPE_WORKGROUP); }
    }
    __syncthreads();
    const unsigned long long bunion = (unsigned long long)*(const LAS unsigned*)(lds + AT_UNI) | ((unsigned long long)*(const LAS unsigned*)(lds + AT_UNI + 4) << 32);
    const bf16* Hb = H + (size_t)b * SEQ * HLD;
    {
        R.m = -1e30f; R.lpart = 0.f;
        at_branch<2>(F, bunion, Hb + 512 + 2 * 128 + hk * 64, Hb + 512 + 3 * 128 + hk * 64, HLD, Qf, R, voff, o, 0.f, 0.f);
        const float lsum = R.lpart + __shfl_xor(R.lpart, 32); const float sc = g_sel / fmaxf(lsum, 1e-30f);
#pragma unroll
        for (int e = 0; e < 16; ++e) { ysum[0][e] += sc * o[0][e]; ysum[1][e] += sc * o[1][e]; o[0][e] = 0.f; o[1][e] = 0.f; }
    }
    {
        const int lo = qb - 8 > 0 ? qb - 8 : 0; const unsigned long long mw = ((2ull << qb) - 1ull) & ~((1ull << lo) - 1ull);
        R.m = -1e30f; R.lpart = 0.f;
        at_branch<3>(F, mw, Hb + 512 + 4 * 128 + hk * 64, Hb + 512 + 5 * 128 + hk * 64, HLD, Qf, R, voff, o, 0.f, 0.f);
        const float lsum = R.lpart + __shfl_xor(R.lpart, 32); const float sc = g_win / fmaxf(lsum, 1e-30f);
#pragma unroll
        for (int e = 0; e < 16; ++e) { ysum[0][e] += sc * o[0][e]; ysum[1][e] += sc * o[1][e]; }
    }
    bf16* yrow = Y + tok * DM + head * 64 + 4 * R.hf;
#pragma unroll
    for (int dt = 0; dt < 2; ++dt)
#pragma unroll
        for (int rg = 0; rg < 4; ++rg) { u32x2 w; w.x = pk2(ysum[dt][4 * rg], ysum[dt][4 * rg + 1]); w.y = pk2(ysum[dt][4 * rg + 2], ysum[dt][4 * rg + 3]); *(u32x2*)(yrow + 32 * dt + 8 * rg) = w; }
}

__device__ __forceinline__ void phase_mix_a(const Frame& F, ArgsP a, int l) {
    constexpr int N_CMP = 128, N_GDN = 256, N_CONF = 512;
    for (int it = F.bid; it < N_CMP + N_GDN + N_CONF; it += F.G) {
        if (it < N_CMP) compress_item(F, a, it);
        else if (it < N_CMP + N_GDN) { gdn_prep_chunk(F, a, l, (it - N_CMP) * 8 + F.wave, F.lds + F.wave * 16384); __syncthreads(); }
        else conformer_item(F, a, l, it - N_CMP - N_GDN);
    }
}
__device__ __forceinline__ void phase_mix_b(const Frame& F, ArgsP a, int l) {
    unsigned* q = F.ctl + CW_QUEUE + l * 64;
    for (;;) {
        if (F.tid == 0) F.MISC[0] = __hip_atomic_fetch_add(q, 1u, __ATOMIC_RELAXED, __HIP_MEMORY_SCOPE_AGENT);
        __syncthreads();
        const int item = (int)F.MISC[0];
        __syncthreads();
        if (item >= 1024) break;
        attn_item(F, a, l, item);
    }
}

#ifndef MK_MULTI
#define MK_MULTI 1
#endif
constexpr int N_PHASES = 1 + 9 * NL;
__device__ __forceinline__ Frame make_frame() {
    extern __shared__ __attribute__((aligned(16))) unsigned char lds_raw[];
    Frame F; F.lds = (LAS unsigned char*)lds_raw; F.MISC = (volatile LAS unsigned*)(F.lds + MISC_OFF);
    int tid = threadIdx.x, G = gridDim.x, bid = blockIdx.x; unsigned lb = (unsigned)(size_t)F.lds;
    asm volatile("" : "+v"(tid), "+s"(G), "+s"(bid), "+s"(lb));
    F.lds = (LAS unsigned char*)(size_t)lb; F.MISC = (volatile LAS unsigned*)(F.lds + MISC_OFF);
    F.tid = tid; F.lane = F.tid & 63; F.wave = __builtin_amdgcn_readfirstlane(F.tid >> 6); F.G = G; F.bid = bid;
    F.ctl = (unsigned*)(args_here()->ws + WS_CTL); return F;
}
__device__ __forceinline__ void ph_prologue(int) { const Frame F = make_frame(); phase_prologue(F, args_here()); phase_weights(F, args_here(), 0); }
__device__ __forceinline__ void ph_inproj(int) { const Frame F = make_frame(); unsigned char* ws = args_here()->ws;
    pg8::Gemm g{(const bf16*)(ws + WS_XB), (const bf16*)(ws + WS_WL + WL_WIN), T, DINP, DM}; pg8::StaticOrder S; S.init(T, DINP, F.G, F.bid);
    pg8::EpiInProj E{(bf16*)(ws + WS_H), (float*)(ws + WS_SIDE), (const float*)(ws + WS_ROPE)};
    pg8::gemm_phase<pg8::EpiInProj, pg8::StaticOrder, false>(F.lds, g, S, E, nullptr); }
__device__ __forceinline__ void ph_compress(int l) { const Frame F = make_frame(); for (int it = F.bid; it < 128; it += F.G) compress_item(F, args_here(), it); }
__device__ __forceinline__ void ph_gdnprep(int l) { const Frame F = make_frame(); for (int it = (F.bid + 128) % F.G; it < 256; it += F.G) { gdn_prep_chunk(F, args_here(), l, it * 8 + F.wave, F.lds + F.wave * 16384); __syncthreads(); } }
__device__ __forceinline__ void ph_conformer(int l) { const Frame F = make_frame(); for (int it = F.bid; it < 512; it += F.G) conformer_item(F, args_here(), l, it); }
__device__ __forceinline__ void ph_scan(int l) { const Frame F = make_frame(); if (F.bid < 16) gdn_scan(F, args_here(), l); }
__device__ __forceinline__ void ph_attn(int l) { const Frame F = make_frame(); phase_mix_b(F, args_here(), l); }
__device__ __forceinline__ void ph_outproj(int l) { const Frame F = make_frame(); ArgsP ap = args_here(); unsigned char* ws = ap->ws;
    pg8::Gemm g{(const bf16*)(ws + WS_Y), (const bf16*)(ws + WS_WL + WL_WOUT), T, DM, DM}; pg8::StaticOrder S; S.init(T, DM, F.G, F.bid);
    pg8::EpiOutProj E{l == 0 ? ap->in[0] : (const float*)ap->out, (float*)(ws + WS_X1), DN_ALPHA};
    pg8::gemm_phase<pg8::EpiOutProj, pg8::StaticOrder, false>(F.lds, g, S, E, nullptr); }
__device__ __forceinline__ void ph_ln1(int l) { const Frame F = make_frame(); phase_ln1_router(F, args_here(), l); }
__device__ __forceinline__ void ph_gather(int l) { const Frame F = make_frame(); phase_gather(F, args_here(), l); }
__device__ __forceinline__ void ph_moeup(int l) { const Frame F = make_frame(); unsigned char* ws = args_here()->ws;
    pg8::Gemm g{(const bf16*)(ws + WS_H), (const bf16*)(ws + WS_WL + WL_WGU), 0, 0, DM}; pg8::MoeOrder S{(const int*)(ws + WS_META) + l * 512, F.G, F.bid};
    pg8::EpiSwiGLU E{(bf16*)(ws + WS_HID)};
    pg8::gemm_phase<pg8::EpiSwiGLU, pg8::MoeOrder, false>(F.lds, g, S, E, nullptr); }
__device__ __forceinline__ void ph_moedown(int l) { const Frame F = make_frame(); unsigned char* ws = args_here()->ws;
    pg8::Gemm g{(const bf16*)(ws + WS_HID), (const bf16*)(ws + WS_WL + WL_WDN), 0, 0, FF}; pg8::MoeOrder S{(const int*)(ws + WS_META) + l * 512, F.G, F.bid};
    pg8::EpiDown E{(bf16*)(ws + WS_Y2), (const int*)(ws + WS_SLOT + SL_TOK), (const float*)(ws + WS_SLOT + SL_W)};
    pg8::gemm_phase<pg8::EpiDown, pg8::MoeOrder, false>(F.lds, g, S, E, nullptr); }
__device__ __forceinline__ void ph_ln2(int l) { const Frame F = make_frame(); phase_ln2(F, args_here(), l); if (l + 1 < NL) phase_weights(F, args_here(), l + 1); }

__global__ void __launch_bounds__(NTHR, 2) fwd_kernel(Args args) {
    extern __shared__ __attribute__((aligned(16))) unsigned char lds_raw[];
    (void)lds_raw; const Frame F = make_frame();
    if (F.tid < 64) F.MISC[F.tid] = 0u;
    __syncthreads();
    XcdBarrier bar = xcd_barrier_post(F.ctl + CW_BAR, F.MISC + 8);
    const int lo = args_here()->ph_lo, hi = args_here()->ph_hi;
#define IN(k) (lo <= (k) && (k) < hi)
#define SEAM(k) do { if (IN(k) && IN((k) + 1)) { XcdBarrier bb = bar; asm volatile("" : "+s"(bb.bar)); xcd_barrier(bb); } } while (0)
    if (IN(0)) ph_prologue(0);
    SEAM(0);
    for (int l = 0; l < NL; ++l) {
        const int pb = 1 + 9 * l;
        if (IN(pb + 0)) ph_inproj(l);
        SEAM(pb + 0);
        if (IN(pb + 1)) { ph_compress(l); ph_gdnprep(l); ph_conformer(l); }
        SEAM(pb + 1);
        if (IN(pb + 2)) { ph_scan(l); ph_attn(l); }
        SEAM(pb + 2);
        if (IN(pb + 3)) ph_outproj(l);
        SEAM(pb + 3);
        if (IN(pb + 4)) ph_ln1(l);
        SEAM(pb + 4);
        if (IN(pb + 5)) ph_gather(l);
        SEAM(pb + 5);
        if (IN(pb + 6)) ph_moeup(l);
        SEAM(pb + 6);
        if (IN(pb + 7)) ph_moedown(l);
        SEAM(pb + 7);
        if (IN(pb + 8)) ph_ln2(l);
        SEAM(pb + 8);
    }
#undef IN
#undef SEAM
}

extern "C" void kernel_launch(void* const* d_in, const int* in_sizes, int n_in, void* d_out, int out_size, void* d_ws, size_t ws_size, hipStream_t stream) {
    static int grid = 0;
    if (grid == 0) {
        if (n_in != 25 || in_sizes[0] != T * DM || out_size != T * DM || ws_size < WS_END) { fprintf(stderr, "kernel_launch: shape/workspace mismatch (n_in %d, in0 %d, out %d, ws %zu < %zu); nothing launched\n", n_in, n_in > 0 ? in_sizes[0] : -1, out_size, ws_size, (size_t)WS_END); grid = -1; return; }
        int dev = 0, cus = 0, per_cu = 0;
        if (hipGetDevice(&dev) != hipSuccess || hipDeviceGetAttribute(&cus, hipDeviceAttributeMultiprocessorCount, dev) != hipSuccess) { grid = -1; return; }
        if (hipFuncSetAttribute((const void*)fwd_kernel, hipFuncAttributeMaxDynamicSharedMemorySize, LDS_BYTES) != hipSuccess) { fprintf(stderr, "kernel_launch: hipFuncSetAttribute failed\n"); grid = -1; return; }
        if (hipOccupancyMaxActiveBlocksPerMultiprocessor(&per_cu, (const void*)fwd_kernel, NTHR, LDS_BYTES) != hipSuccess || per_cu < 1)
            fprintf(stderr, "kernel_launch: note: occupancy query reports %d workgroups per CU\n", per_cu);
        (void)hipGetLastError();
        grid = cus;
        if (grid < 32 || (grid & 7)) { fprintf(stderr, "kernel_launch: unexpected CU count %d\n", cus); }
    }
    if (grid < 0) return;
    if (hipMemsetAsync((char*)d_ws + WS_CTL, 0, CTL_ZERO_BYTES, stream) != hipSuccess) return;
    Args a{};
    for (int i = 0; i < 25; ++i) a.in[i] = (const float*)d_in[i];
    a.out = (float*)d_out; a.ws = (unsigned char*)d_ws;
#if MK_MULTI
    for (int p = 0; p < N_PHASES; ++p) { a.ph_lo = p; a.ph_hi = p + 1; hipLaunchKernelGGL(fwd_kernel, dim3(grid), dim3(NTHR), LDS_BYTES, stream, a); }
#else
    a.ph_lo = 0; a.ph_hi = N_PHASES;
    hipLaunchKernelGGL(fwd_kernel, dim3(grid), dim3(NTHR), LDS_BYTES, stream, a);
#endif
}
```

```cpp
#include <hip/hip_runtime.h>
#include <cstdio>
#include <cstdint>
namespace pg8 {
#define PG8_LAS __attribute__((address_space(3)))
typedef unsigned short bf16_t;
typedef short bf16x8 __attribute__((ext_vector_type(8)));
typedef float f32x4 __attribute__((ext_vector_type(4)));
typedef unsigned u32x4 __attribute__((ext_vector_type(4)));
constexpr int BM = 256, BK = 64, HALF = 128, HTB = HALF * BK * 2  , STAGE_BYTES = 8 * HTB, NXCD = 8, WGM = 8;

__host__ __device__ __forceinline__ int lds_byte(int r, int c) { const int st = (r >> 4) * 2 + (c >> 5), rr = r & 15, cc = c & 31, ob = rr * 64 + cc * 2; return st * 1024 + (ob ^ (((ob >> 9) & 1) << 5)); }
__host__ __device__ __forceinline__ void stage_rc(int b, int& R, int& C) { const int st = b / 1024, sb = b % 1024, swz = sb ^ (((sb >> 9) & 1) << 5); R = (st >> 1) * 16 + swz / 64; C = (st & 1) * 32 + (swz % 64) / 2; }
__host__ __device__ __forceinline__ int perm32(int rho) { const int n = rho >> 4, i = rho & 15; return 8 * (i >> 2) + 4 * n + (i & 3); }

struct Unit { int pm, pn; };
struct Gemm { const bf16_t* A; const bf16_t* Bt; int M, N, K; };

struct StaticOrder {
    int nM, nN, nwg, G, c;
    __host__ __device__ void init(int M, int N, int G_, int c_) { nM = M / BM; nN = N / BM; nwg = nM * nN; G = G_; c = c_; }
    __host__ __device__ bool next(int i, Unit& u) const {
        const long L = (long)i * G + c; if (L >= nwg) return false;
        int wgid = (int)L; { const int q = nwg / NXCD, r = nwg % NXCD, xcd = wgid % NXCD, off = wgid / NXCD; wgid = (xcd < r ? xcd * (q + 1) : r * (q + 1) + (xcd - r) * q) + off; }
        const int nig = WGM * nN, gid = wgid / nig, fm = gid * WGM, gsz = (nM - fm) < WGM ? (nM - fm) : WGM;
        u.pm = fm + ((wgid % nig) % gsz); u.pn = (wgid % nig) / gsz; return true;
    }
    __device__ __forceinline__ void a_ready(const Unit&) const {}
    __device__ __forceinline__ void done(const Unit&) const {}
};

__device__ __forceinline__ unsigned cvt_pk_bf16(float lo, float hi) { unsigned r; asm volatile("v_cvt_pk_bf16_f32 %0, %1, %2" : "=v"(r) : "v"(lo), "v"(hi)); return r; }
__device__ __forceinline__ float fast_sigmoid(float x) { return __builtin_amdgcn_rcpf(1.0f + __builtin_amdgcn_exp2f(-1.44269504089f * x)); }

constexpr int HLD = 2816;
constexpr float QSCALE = 0.125f * 1.44269504089f;

struct EpiInProj {
    static constexpr bool PERM = true, AFTER_DRAIN = false;
    bf16_t* H; float* side; const float* rope;
    __device__ __forceinline__ void operator()(const f32x4 (&acc)[2][2][4][2], const Unit& u, int wr, int wc, int fr, int fq) const {
        const int row0 = u.pm * BM + wr * 64 + fr; const int pn = u.pn;
        if (pn <= 4) {
#pragma unroll
            for (int ai = 0; ai < 2; ++ai)
#pragma unroll
                for (int m = 0; m < 4; ++m) {
                    const int row = row0 + ai * HALF + m * 16; const float* rp = rope + (size_t)(row & 4095) * 16;
                    const f32x4 c0 = *(const f32x4*)(rp), c1 = *(const f32x4*)(rp + 4), s0 = *(const f32x4*)(rp + 8), s1 = *(const f32x4*)(rp + 12);
#pragma unroll
                    for (int bj = 0; bj < 2; ++bj) {
                        f32x4 v0 = acc[ai][bj][m][0], v1 = acc[ai][bj][m][1];
                        const bool ropeb = (pn < 2) || (bj == 0);
                        if (ropeb) {
                            f32x4 p0, p1;
#pragma unroll
                            for (int e = 0; e < 4; ++e) { p0[e] = __shfl_xor(v0[e], 16); p1[e] = __shfl_xor(v1[e], 16); }
                            if (((wc & 1) == 0) && fq < 2) { const float sg = fq ? 1.f : -1.f; v0 = v0 * c0 + (p0 * s0) * sg; v1 = v1 * c1 + (p1 * s1) * sg; }
                        }
                        if (pn < 2) { v0 = v0 * QSCALE; v1 = v1 * QSCALE; }
                        u32x4 w; w.x = cvt_pk_bf16(v0[0], v0[1]); w.y = cvt_pk_bf16(v0[2], v0[3]); w.z = cvt_pk_bf16(v1[0], v1[1]); w.w = cvt_pk_bf16(v1[2], v1[3]);
                        *(u32x4*)(H + (size_t)row * HLD + pn * BM + bj * HALF + wc * 32 + 8 * fq) = w;
                    }
                }
        } else if (pn < 11) {
#pragma unroll
            for (int ai = 0; ai < 2; ++ai)
#pragma unroll
                for (int m = 0; m < 4; ++m) {
                    const int row = row0 + ai * HALF + m * 16;
#pragma unroll
                    for (int bj = 0; bj < 2; ++bj) {
                        const f32x4 v0 = acc[ai][bj][m][0], v1 = acc[ai][bj][m][1];
                        u32x4 w; w.x = cvt_pk_bf16(v0[0], v0[1]); w.y = cvt_pk_bf16(v0[2], v0[3]); w.z = cvt_pk_bf16(v1[0], v1[1]); w.w = cvt_pk_bf16(v1[2], v1[3]);
                        *(u32x4*)(H + (size_t)row * HLD + pn * BM + bj * HALF + wc * 32 + 8 * fq) = w;
                    }
                }
        } else if (wc == 0) {
#pragma unroll
            for (int ai = 0; ai < 2; ++ai)
#pragma unroll
                for (int m = 0; m < 4; ++m) {
                    const int row = row0 + ai * HALF + m * 16;
                    f32x4 v0 = acc[ai][0][m][0], v1 = acc[ai][0][m][1];
#pragma unroll
                    for (int e = 0; e < 4; ++e) { v0[e] = fast_sigmoid(v0[e]); if (fq < 3) v1[e] = fast_sigmoid(v1[e]); }
                    *(f32x4*)(side + (size_t)row * 32 + 8 * fq) = v0; *(f32x4*)(side + (size_t)row * 32 + 8 * fq + 4) = v1;
                }
        }
    }
};
struct EpiOutProj {
    static constexpr bool PERM = false, AFTER_DRAIN = false;
    const float* res; float* out; float alpha;
    __device__ __forceinline__ void operator()(const f32x4 (&acc)[2][2][4][2], const Unit& u, int wr, int wc, int fr, int fq) const {
        const int row0 = u.pm * BM + wr * 64 + fr, col0 = u.pn * BM + wc * 32 + 4 * fq;
#pragma unroll
        for (int ai = 0; ai < 2; ++ai)
#pragma unroll
            for (int m = 0; m < 4; ++m) { const size_t off = (size_t)(row0 + ai * HALF + m * 16) * 1024 + col0;
#pragma unroll
                for (int bj = 0; bj < 2; ++bj)
#pragma unroll
                    for (int n = 0; n < 2; ++n) { const f32x4 r = *(const f32x4*)(res + off + bj * HALF + n * 16); *(f32x4*)(out + off + bj * HALF + n * 16) = r * alpha + acc[ai][bj][m][n]; }
                asm volatile("" ::: "memory"); }
    }
};
struct EpiSwiGLU {
    static constexpr bool PERM = true, AFTER_DRAIN = false;
    bf16_t* hid;
    __device__ __forceinline__ void operator()(const f32x4 (&acc)[2][2][4][2], const Unit& u, int wr, int wc, int fr, int fq) const {
        const int row0 = u.pm * BM + wr * 64 + fr, hc0 = (u.pn & 3) * 128 + wc * 16 + 4 * fq;
#pragma unroll
        for (int ai = 0; ai < 2; ++ai)
#pragma unroll
            for (int m = 0; m < 4; ++m) { bf16_t* rowp = hid + (size_t)(row0 + ai * HALF + m * 16) * 512 + hc0;
#pragma unroll
                for (int bj = 0; bj < 2; ++bj) { const f32x4 g = acc[ai][bj][m][0], up = acc[ai][bj][m][1]; f32x4 h;
#pragma unroll
                    for (int e = 0; e < 4; ++e) h[e] = g[e] * fast_sigmoid(g[e]) * up[e];
                    typedef unsigned u32x2 __attribute__((ext_vector_type(2)));
                    u32x2 w; w.x = cvt_pk_bf16(h[0], h[1]); w.y = cvt_pk_bf16(h[2], h[3]);
                    *(u32x2*)(rowp + bj * 64) = w; } }
    }
};
struct EpiDown {
    static constexpr bool PERM = true, AFTER_DRAIN = false;
    bf16_t* y2; const int* slot_tok; const float* slot_w;
    __device__ __forceinline__ void operator()(const f32x4 (&acc)[2][2][4][2], const Unit& u, int wr, int wc, int fr, int fq) const {
        const int row0 = u.pm * BM + wr * 64 + fr, col0 = (u.pn & 3) * BM + wc * 32 + 8 * fq;
#pragma unroll
        for (int ai = 0; ai < 2; ++ai)
#pragma unroll
            for (int m = 0; m < 4; ++m) { const int row = row0 + ai * HALF + m * 16; const int st = slot_tok[row]; const float sw = slot_w[row];
                if (st >= 0) { bf16_t* rowp = y2 + (size_t)st * 1024 + col0;
#pragma unroll
                    for (int bj = 0; bj < 2; ++bj) { const f32x4 v0 = acc[ai][bj][m][0] * sw, v1 = acc[ai][bj][m][1] * sw;
                        u32x4 w; w.x = cvt_pk_bf16(v0[0], v0[1]); w.y = cvt_pk_bf16(v0[2], v0[3]); w.z = cvt_pk_bf16(v1[0], v1[1]); w.w = cvt_pk_bf16(v1[2], v1[3]);
                        *(u32x4*)(rowp + bj * HALF) = w; } } }
    }
};
struct MoeOrder {
    const int* meta; int G, c;
    __device__ __forceinline__ bool next(int i, Unit& u) const {
        const int per = G >> 3; const int idx = (G & 7) ? (i * G + c) : ((i * 8 + (c & 7)) * per + (c >> 3));
        const int nt = meta[0]; if (idx >= nt * 4) return false;
        const int pm = idx >> 2; u.pm = pm; u.pn = meta[64 + pm] * 4 + (idx & 3); return true;
    }
    __device__ __forceinline__ void a_ready(const Unit&) const {}
    __device__ __forceinline__ void done(const Unit&) const {}
};
template <class Epi, class Sched, bool STAMP = false>
__device__ __forceinline__ void gemm_phase(PG8_LAS unsigned char* lds, const Gemm g, const Sched& S, const Epi& E, unsigned long long* stamps) {
    int tid_ = threadIdx.x; asm volatile("" : "+v"(tid_));
    const int tid = tid_, wid = __builtin_amdgcn_readfirstlane(tid >> 6), lane = tid & 63, wr = wid >> 2, wc = wid & 3, fr = lane & 15, fq = lane >> 4;
    const int K = g.K, nt = K / BK;
    int ts_lo = 0, ts_hi = 0, nts = 0; const unsigned long long rt_entry = STAMP ? (unsigned long long)wall_clock64() : 0ull;
#define PG8_STAMP() do { if (STAMP && wid == 0 && nts < 64) { const unsigned long long _c = (unsigned long long)clock64(); \
        ts_lo = (lane == nts) ? (int)(unsigned)_c : ts_lo; ts_hi = (lane == nts) ? (int)(unsigned)(_c >> 32) : ts_hi; ++nts; } } while (0)
    PG8_STAMP();
    unsigned voffA[2], voffB[2];
#pragma unroll
    for (int i = 0; i < 2; ++i) { int R, C; stage_rc(tid * 16 + i * 8192, R, C); const int Rb = Epi::PERM ? ((R & ~31) + perm32(R & 31)) : R;
        voffA[i] = (unsigned)(R * K + C) * 2u; voffB[i] = (unsigned)(Rb * K + C) * 2u; }
    const size_t kstep = (size_t)(BK * 2);
    const size_t hstep = (size_t)HALF * K * 2;
    const size_t tstep = 2 * hstep;
    const unsigned ldsw = (unsigned)wid * 1024u;
    const int aoff = lds_byte(wr * 64 + fr, fq * 8), boff = lds_byte(wc * 32 + fr, fq * 8);
#define PG8_SA(b, h) (((b) * 2 + (h)) * HTB)
#define PG8_SB(b, h) ((4 + (b) * 2 + (h)) * HTB)
#define PG8_STAGE(bufoff, gbase, voff) do { _Pragma("unroll") for (int _i = 0; _i < 2; ++_i) \
        __builtin_amdgcn_global_load_lds((const unsigned*)((const char*)(gbase) + (voff)[_i]), (PG8_LAS unsigned*)(lds + (bufoff) + ldsw + _i * 8192), 16, 0, 0); } while (0)
#define PG8_LDA(dst, b, h) do { _Pragma("unroll") for (int m = 0; m < 4; ++m) _Pragma("unroll") for (int k = 0; k < 2; ++k) dst[m][k] = *(const PG8_LAS bf16x8*)(lds + PG8_SA(b, h) + aoff + m * 2048 + k * 1024); } while (0)
#define PG8_LDB(dst, b, h) do { _Pragma("unroll") for (int n = 0; n < 2; ++n) _Pragma("unroll") for (int k = 0; k < 2; ++k) dst[n][k] = *(const PG8_LAS bf16x8*)(lds + PG8_SB(b, h) + boff + n * 2048 + k * 1024); } while (0)
#define PG8_MMA(ai, bj, At, Bt) do { __builtin_amdgcn_s_setprio(1); _Pragma("unroll") for (int m = 0; m < 4; ++m) _Pragma("unroll") for (int n = 0; n < 2; ++n) _Pragma("unroll") for (int k = 0; k < 2; ++k) \
        acc[ai][bj][m][n] = __builtin_amdgcn_mfma_f32_16x16x32_bf16(Bt[n][k], At[m][k], acc[ai][bj][m][n], 0, 0, 0); __builtin_amdgcn_s_setprio(0); } while (0)
#define PG8_WAIT_V(n) asm volatile("s_waitcnt vmcnt(" #n ")" ::: "memory")
#define PG8_WAIT_L(n) asm volatile("s_waitcnt lgkmcnt(" #n ")" ::: "memory")
#define PG8_BAR __builtin_amdgcn_s_barrier()
#define PG8_SCHED __builtin_amdgcn_sched_barrier(0)
    Unit cur, nxt; int ui = 0;
    if (!S.next(0, cur)) return;
    f32x4 acc[2][2][4][2];
#pragma unroll
    for (int a = 0; a < 2; ++a)
#pragma unroll
        for (int b = 0; b < 2; ++b)
#pragma unroll
            for (int m = 0; m < 4; ++m)
#pragma unroll
                for (int n = 0; n < 2; ++n) acc[a][b][m][n] = (f32x4){0.f, 0.f, 0.f, 0.f};
    bf16x8 At[4][2], B0[2][2], B1[2][2];
    const char* cA = (const char*)g.A + (size_t)cur.pm * tstep; const char* cB = (const char*)g.Bt + (size_t)cur.pn * tstep;
    S.a_ready(cur);
    PG8_STAGE(PG8_SB(0, 0), cB, voffB); PG8_STAGE(PG8_SA(0, 0), cA, voffA); PG8_STAGE(PG8_SB(0, 1), cB + hstep, voffB); PG8_STAGE(PG8_SA(0, 1), cA + hstep, voffA);
    if (wr == 1) PG8_BAR;
    PG8_WAIT_V(4); PG8_BAR;
    PG8_STAGE(PG8_SB(1, 0), cB + kstep, voffB); PG8_STAGE(PG8_SA(1, 0), cA + kstep, voffA); PG8_STAGE(PG8_SB(1, 1), cB + hstep + kstep, voffB);
    PG8_WAIT_V(6); PG8_BAR;
    PG8_STAMP();
    for (;;) {
        const bool has_next = S.next(ui + 1, nxt);
        const char* nA = has_next ? (const char*)g.A + (size_t)nxt.pm * tstep : cA; const char* nB = has_next ? (const char*)g.Bt + (size_t)nxt.pn * tstep : cB;
        for (int t = 0; t < nt; t += 2) {
            const bool last = (t == nt - 2);
            const char* a1 = cA + (size_t)(t + 1) * kstep;
            const char* a2 = last ? nA : cA + (size_t)(t + 2) * kstep; const char* b2 = last ? nB : cB + (size_t)(t + 2) * kstep;
            const char* a3 = a2 + kstep; const char* b3 = b2 + kstep;
            if (last && has_next) S.a_ready(nxt);
            PG8_LDB(B0, 0, 0); PG8_SCHED; PG8_LDA(At, 0, 0); PG8_STAGE(PG8_SA(1, 1), a1 + hstep, voffA);
            PG8_WAIT_L(8); PG8_BAR; PG8_WAIT_L(0); PG8_MMA(0, 0, At, B0); PG8_BAR; PG8_SCHED;
            PG8_LDB(B1, 0, 1); PG8_STAGE(PG8_SB(0, 0), b2, voffB);
            PG8_BAR; PG8_WAIT_L(0); PG8_MMA(0, 1, At, B1); PG8_BAR;
            PG8_LDA(At, 0, 1); PG8_STAGE(PG8_SA(0, 0), a2, voffA);
            PG8_BAR; PG8_WAIT_L(0); PG8_MMA(1, 0, At, B0); PG8_BAR; PG8_SCHED;
            PG8_STAGE(PG8_SB(0, 1), b2 + hstep, voffB);
            PG8_WAIT_V(6); PG8_BAR; PG8_MMA(1, 1, At, B1); PG8_BAR;
            PG8_LDB(B0, 1, 0); PG8_SCHED; PG8_LDA(At, 1, 0); PG8_STAGE(PG8_SA(0, 1), a2 + hstep, voffA);
            PG8_WAIT_L(8); PG8_BAR; PG8_WAIT_L(0); PG8_MMA(0, 0, At, B0); PG8_BAR; PG8_SCHED;
            PG8_LDB(B1, 1, 1); PG8_STAGE(PG8_SB(1, 0), b3, voffB);
            PG8_BAR; PG8_WAIT_L(0); PG8_MMA(0, 1, At, B1); PG8_BAR;
            PG8_LDA(At, 1, 1); PG8_STAGE(PG8_SA(1, 0), a3, voffA);
            PG8_BAR; PG8_WAIT_L(0); PG8_MMA(1, 0, At, B0); PG8_BAR; PG8_SCHED;
            PG8_STAGE(PG8_SB(1, 1), b3 + hstep, voffB);
            PG8_WAIT_V(6); PG8_BAR; PG8_MMA(1, 1, At, B1); PG8_BAR;
        }
        PG8_STAMP();
        if constexpr (!Epi::AFTER_DRAIN) { E(acc, cur, wr, wc, fr, fq); S.done(cur); }
        PG8_STAMP();
        if (!has_next) break;
#pragma unroll
        for (int a = 0; a < 2; ++a)
#pragma unroll
            for (int b = 0; b < 2; ++b)
#pragma unroll
                for (int m = 0; m < 4; ++m)
#pragma unroll
                    for (int n = 0; n < 2; ++n) acc[a][b][m][n] = (f32x4){0.f, 0.f, 0.f, 0.f};
        cur = nxt; cA = nA; cB = nB; ++ui;
    }
    PG8_WAIT_V(0);
    if (wr == 0) PG8_BAR;
    PG8_BAR;
    if constexpr (Epi::AFTER_DRAIN) { E.fused(acc, cur, wr, wc, fr, fq, lds, wid, lane); S.done(cur); }
    PG8_STAMP();
    if (STAMP && wid == 0) { stamps[lane] = lane < nts ? (((unsigned long long)(unsigned)ts_hi << 32) | (unsigned)ts_lo) : 0ull;
        if (lane == 62) stamps[62] = rt_entry; if (lane == 63) stamps[63] = (unsigned long long)wall_clock64(); }
#undef PG8_STAMP
#undef PG8_SA
#undef PG8_SB
#undef PG8_STAGE
#undef PG8_LDA
#undef PG8_LDB
#undef PG8_MMA
#undef PG8_WAIT_V
#undef PG8_WAIT_L
#undef PG8_BAR
#undef PG8_SCHED
}
}

constexpr int NB = 8, SEQ = 4096, DM = 1024, NL = 4, T = NB * SEQ;
constexpr int DIN = 2848, DINP = 3072, HLD = pg8::HLD;
constexpr int NEXP = 32, FF = 512, NTILE_MAX = 288;
constexpr float LN_EPS = 1e-5f;
constexpr float DN_ALPHA = 1.6817928305074290f;
constexpr int NWAVES = 8, NTHR = 512;

constexpr size_t MiB = 1u << 20, KiB = 1u << 10;
constexpr size_t WS_CTL = 0, CTL_ZERO_BYTES = 128 * KiB;
constexpr size_t WS_ROPE = 1 * MiB;
constexpr size_t WS_META = 1 * MiB + 512 * KiB;
constexpr size_t WS_GL = WS_META + 16 * KiB;
constexpr size_t WS_WL = 2 * MiB;
constexpr size_t WL_WIN = 0, WL_WOUT = 6 * MiB, WL_WGU = 8 * MiB, WL_WDN = 72 * MiB, WL_W1 = 104 * MiB, WL_W2 = 105 * MiB, WL_BIAS1 = 105 * MiB + 64 * KiB, WL_WR = 105 * MiB + 128 * KiB;
constexpr size_t WS_XB = 108 * MiB;
constexpr size_t WS_X1 = 172 * MiB;
constexpr size_t WS_H = 300 * MiB;
constexpr size_t WS_SIDE = 476 * MiB;
constexpr size_t WS_Y = 480 * MiB;
constexpr size_t WS_GPREP = 544 * MiB;
constexpr size_t WS_Y2 = 624 * MiB;
constexpr size_t WS_HID = 752 * MiB;
constexpr size_t WS_KC = 824 * MiB, WS_VC = WS_KC + 512 * KiB;
constexpr size_t WS_SLOT = 825 * MiB;
constexpr size_t SL_TOK = 0, SL_W = 512 * KiB, SL_RE = 1024 * KiB, SL_RP = 1280 * KiB, SL_RW = 1536 * KiB;
constexpr size_t WS_END = 828 * MiB;
constexpr int GCH = 40960;
constexpr int GC_UT = 0, GC_W = 8192, GC_QK = 16384, GC_QD = 24576, GC_KDT = 32768;
constexpr int CW_TMO = 0;
constexpr int CW_BAR = 4096;
constexpr int CW_CNT = 8192;
constexpr int CW_QUEUE = 12288;
static_assert((CW_QUEUE + NL * 64) * 4 <= (int)CTL_ZERO_BYTES, "CTL words inside the memset region");

constexpr int SCR_BYTES = 143360;
constexpr int MISC_OFF = SCR_BYTES;
constexpr int LDS_BYTES = 147456;

#define GAS __attribute__((address_space(1)))
#define LAS __attribute__((address_space(3)))
typedef unsigned short bf16;
typedef float f32x4 __attribute__((ext_vector_type(4)));
typedef float f32x2 __attribute__((ext_vector_type(2)));
typedef float f32x16 __attribute__((ext_vector_type(16)));
typedef short bf16x8 __attribute__((ext_vector_type(8)));
typedef short s16x4 __attribute__((ext_vector_type(4)));
typedef unsigned u32x4 __attribute__((ext_vector_type(4)));
typedef unsigned u32x2 __attribute__((ext_vector_type(2)));
#define LDS_WAIT() asm volatile("s_waitcnt lgkmcnt(0)" ::: "memory")
#define VM_WAIT() asm volatile("s_waitcnt vmcnt(0)" ::: "memory")
#define SBAR() __builtin_amdgcn_sched_barrier(0)
__device__ __forceinline__ float bf2f(unsigned b) { return __uint_as_float(b << 16); }
__device__ __forceinline__ unsigned f2bf(float f) { unsigned u = __float_as_uint(f); return (u + 0x7fffu + ((u >> 16) & 1u)) >> 16; }
__device__ __forceinline__ unsigned pk2(float lo, float hi) { return pg8::cvt_pk_bf16(lo, hi); }
__device__ __forceinline__ float wave_sum(float v) {
#pragma unroll
    for (int o = 1; o < 64; o <<= 1) v += __shfl_xor(v, o);
    return v;
}
__device__ __forceinline__ float fsigmoid(float x) { return pg8::fast_sigmoid(x); }
__device__ __forceinline__ float fsilu(float x) { return x * pg8::fast_sigmoid(x); }
__device__ __forceinline__ float fexp2(float x) { return __builtin_amdgcn_exp2f(x); }

#define XB_TMO      128
#define XB_XCNT(j)  (256  + 64 * (j))
#define XB_XSUB(j)  (1280 + 64 * (j))
#define XB_XGEN(j)  (2304 + 64 * (j))
#define XB_TOP      3328
#define XB_TOPGEN   3392
#define XCD_BAR_WORDS 3456
#define XB_SPIN_CAP (1u << 18)
#define LAS __attribute__((address_space(3)))

__device__ __forceinline__ unsigned xb_ld(unsigned* p)              { return __hip_atomic_load(p, __ATOMIC_RELAXED, __HIP_MEMORY_SCOPE_AGENT); }
__device__ __forceinline__ unsigned xb_add(unsigned* p, unsigned v) { return __hip_atomic_fetch_add(p, v, __ATOMIC_RELAXED, __HIP_MEMORY_SCOPE_AGENT); }
__device__ __forceinline__ unsigned xb_xcc_id() { return (unsigned)__builtin_amdgcn_s_getreg((3 << 11) | 20) & 0xFu; }
#define XB_SPIN(cond, bar) do { unsigned _sp = 0; while (cond) { __builtin_amdgcn_s_sleep(1); \
    if ((++_sp & 255u) == 0u) { if (xb_ld(&(bar)[XB_TMO])) break; if (_sp > XB_SPIN_CAP) { atomicAdd(&(bar)[XB_TMO], 1u); break; } } } } while (0)

struct XcdBarrier {
    unsigned* bar; unsigned x;
    volatile LAS unsigned* st;
};

__device__ __forceinline__ XcdBarrier xcd_barrier_post(unsigned* bar, volatile LAS unsigned* st) {
    XcdBarrier b; b.bar = bar; b.x = xb_xcc_id(); b.st = st;
    if (threadIdx.x == 0) (void)xb_add(&bar[XB_XCNT(b.x)], 1u);
    return b;
}
__device__ __forceinline__ void xcd_barrier_complete(unsigned* bar, unsigned x, unsigned& nloc, unsigned& nx) {
    const unsigned G = gridDim.x * gridDim.y * gridDim.z;
    unsigned sum, cnt, mine, sp = 0u;
    for (;;) {
        sum = 0u; cnt = 0u; mine = 0u;
#pragma unroll
        for (unsigned j = 0; j < 16; ++j) { const unsigned c = xb_ld(&bar[XB_XCNT(j)]); sum += c; cnt += (c > 0u) ? 1u : 0u; mine = (j == x) ? c : mine; }
        if (sum == G) break;
        __builtin_amdgcn_s_sleep(1);
        if ((++sp & 255u) == 0u) { if (xb_ld(&bar[XB_TMO])) break; if (sp > XB_SPIN_CAP) { atomicAdd(&bar[XB_TMO], 1u); break; } }
    }
    nloc = mine > 0u ? mine : 1u; nx = cnt > 0u ? cnt : 1u;
}

__device__ __forceinline__ void xcd_barrier(const XcdBarrier& b) {
    asm volatile("s_waitcnt vmcnt(0)" ::: "memory");
    __syncthreads();
    if (threadIdx.x == 0) {
        unsigned* bar = b.bar;
        __builtin_amdgcn_s_waitcnt(0);
        unsigned nloc = b.st[0], nx = b.st[1];
        if (nloc == 0u) { xcd_barrier_complete(bar, b.x, nloc, nx); b.st[0] = nloc; b.st[1] = nx; }
        const unsigned old = xb_add(&bar[XB_XSUB(b.x)], 1u);
        const unsigned gen = old / nloc;
        if (old + 1u == (gen + 1u) * nloc) {
            __builtin_amdgcn_fence(__ATOMIC_RELEASE, "agent");
            asm volatile("s_waitcnt vmcnt(0)" ::: "memory");
            const unsigned og = xb_add(&bar[XB_TOP], 1u);
            const unsigned tg = og / nx;
            if (og + 1u == (tg + 1u) * nx) xb_add(&bar[XB_TOPGEN], 1u);
            else XB_SPIN(xb_ld(&bar[XB_TOPGEN]) == tg, bar);
            __builtin_amdgcn_fence(__ATOMIC_ACQUIRE, "agent");
            xb_add(&bar[XB_XGEN(b.x)], 1u);
            asm volatile("s_waitcnt vmcnt(0)" ::: "memory");
        } else {
            XB_SPIN(xb_ld(&bar[XB_XGEN(b.x)]) == gen, bar);
            __builtin_amdgcn_fence(__ATOMIC_ACQUIRE, "agent");
            asm volatile("s_waitcnt vmcnt(0)" ::: "memory");
        }
    }
    __syncthreads();
}

struct Args { const float* in[25]; float* out; unsigned char* ws; int ph_lo, ph_hi; };
typedef const __attribute__((address_space(4))) Args* ArgsP;
__device__ __forceinline__ ArgsP args_here() { ArgsP p = (ArgsP)__builtin_amdgcn_kernarg_segment_ptr(); asm volatile("" : "+s"(p)); return p; }
struct Frame { LAS unsigned char* lds; volatile LAS unsigned* MISC; unsigned* ctl; int tid, lane, wave, G, bid; };

template <class Src>
__device__ __forceinline__ void tr_item(const Src src, int K, int N, bf16* WT, LAS float* scr, int item, int lane) {
    const int nblk = N >> 5, kb = item / nblk, nb = item - kb * nblk, k0 = kb << 6, n0 = nb << 5;
#pragma unroll 8
    for (int i = 0; i < 32; ++i) { const int kk = 2 * i + (lane >> 5); scr[kk * 33 + (lane & 31)] = src(k0 + kk, n0 + (lane & 31)); }
    LDS_WAIT();
    const int c = lane & 7;
#pragma unroll
    for (int j = 0; j < 4; ++j) { const int n = (lane >> 3) + 8 * j; const LAS float* s = scr + (8 * c) * 33 + n;
        u32x4 o; o.x = pk2(s[0], s[33]); o.y = pk2(s[66], s[99]); o.z = pk2(s[132], s[165]); o.w = pk2(s[198], s[231]);
        *(u32x4*)(WT + (size_t)(n0 + n) * K + k0 + 8 * c) = o; }
    LDS_WAIT();
}
struct SrcPlain { const float* p; int ld; __device__ __forceinline__ float operator()(int k, int n) const { return p[(size_t)k * ld + n]; } };
struct SrcWin { const float* p;
    __device__ __forceinline__ float operator()(int k, int n) const {
        int c;
        if (n < 1280) c = n; else if (n < 2048) c = n + 24; else if (n < 2304) c = n + 24; else if (n < 2816) c = n + 32;
        else if (n < 2840) c = n - 2816 + 1280; else if (n < 2844) c = n - 2840 + 2328; else if (n < 2848) c = n - 2844 + 2332; else return 0.f;
        return p[(size_t)k * DIN + c]; } };
struct SrcGU { const float* wg; const float* wu;
    __device__ __forceinline__ float operator()(int k, int n) const { const int q = n >> 3, r = n & 7; const ptrdiff_t d = (r < 4) ? (ptrdiff_t)0 : (wu - wg); return wg[d + (ptrdiff_t)k * FF + 4 * q + (r & 3)]; } };

__device__ __forceinline__ void phase_weights(const Frame& F, ArgsP a, int l) {
    unsigned char* wl = a->ws + WS_WL;
    LAS float* scr = (LAS float*)(F.lds + F.wave * 16384);
    const int gw = F.bid * NWAVES + F.wave, NGW = F.G * NWAVES;
    constexpr int I_WIN = 16 * 96, I_WOUT = 16 * 32, I_GU1 = 16 * 32, I_GU = NEXP * I_GU1, I_DN1 = 8 * 32, I_DN = NEXP * I_DN1, I_W1 = 2 * 32 * 4, I_W2 = 2 * 2 * 2, I_WR = 36, I_B1 = 256;
    constexpr int NITEMS = I_WIN + I_WOUT + I_GU + I_DN + I_W1 + I_W2 + I_WR + I_B1;
    for (int it = gw; it < NITEMS; it += NGW) {
        int r = it;
        if (r < I_GU) { const int e = r / I_GU1; SrcGU s{a->in[22] + ((size_t)l * NEXP + e) * DM * FF, a->in[23] + ((size_t)l * NEXP + e) * DM * FF};
            tr_item(s, DM, 1024, (bf16*)(wl + WL_WGU) + (size_t)e * 1024 * DM, scr, r - e * I_GU1, F.lane); continue; } r -= I_GU;
        if (r < I_DN) { const int e = r / I_DN1; SrcPlain s{a->in[24] + ((size_t)l * NEXP + e) * FF * DM, DM};
            tr_item(s, FF, DM, (bf16*)(wl + WL_WDN) + (size_t)e * DM * FF, scr, r - e * I_DN1, F.lane); continue; } r -= I_DN;
        if (r < I_WIN) { SrcWin s{a->in[1] + (size_t)l * DM * DIN}; tr_item(s, DM, DINP, (bf16*)(wl + WL_WIN), scr, r, F.lane); continue; } r -= I_WIN;
        if (r < I_WOUT) { SrcPlain s{a->in[2] + (size_t)l * DM * DM, DM}; tr_item(s, DM, DM, (bf16*)(wl + WL_WOUT), scr, r, F.lane); continue; } r -= I_WOUT;
        if (r < I_W1) { const int kv = r / 128; SrcPlain s{a->in[4] + ((size_t)l * 2 + kv) * 2048 * 128, 128};
            tr_item(s, 2048, 128, (bf16*)(wl + WL_W1) + (size_t)kv * 128 * 2048, scr, r - kv * 128, F.lane); continue; } r -= I_W1;
        if (r < I_W2) { const int kv = r / 4; SrcPlain s{a->in[5] + ((size_t)l * 2 + kv) * 128 * 64, 64};
            tr_item(s, 128, 64, (bf16*)(wl + WL_W2) + (size_t)kv * 64 * 128, scr, r - kv * 4, F.lane); continue; } r -= I_W2;
        if (r < I_WR) {
            float* wr = (float*)(wl + WL_WR) + (size_t)r * DM;
            for (int k = F.lane; k < DM; k += 64) wr[k] = (r < 4) ? a->in[18][((size_t)l * DM + k) * 4 + r] : a->in[20][((size_t)l * DM + k) * NEXP + (r - 4)];
            continue; } r -= I_WR;
        {
            const int kv = r >> 7, n = r & 127; const float* pe = a->in[3] + ((size_t)l * 2 + kv) * 2048; const float* w1 = a->in[4] + ((size_t)l * 2 + kv) * 2048 * 128;
            float s = 0.f; for (int k = F.lane; k < 2048; k += 64) s += pe[k] * w1[(size_t)k * 128 + n];
            s = wave_sum(s); if (F.lane == 0) ((float*)(wl + WL_BIAS1))[r] = s;
        }
    }
}

__device__ __forceinline__ void phase_prologue(const Frame& F, ArgsP a) {
    const size_t gt = (size_t)F.bid * NTHR + F.tid, NGT = (size_t)F.G * NTHR;
    float* rope = (float*)(a->ws + WS_ROPE);
    for (size_t i = gt; i < (size_t)SEQ * 8; i += NGT) { const int t = (int)(i >> 3), f = (int)(i & 7);
        const float invt[8] = {1.0f, 0.19392274f, 0.03760603f, 0.0072926646f, 0.0014142136f, 0.0002742482f, 5.3182957e-05f, 1.0313385e-05f};
        float inv = invt[0];
#pragma unroll
        for (int q = 1; q < 8; ++q) inv = (f == q) ? invt[q] : inv;
        const float ang = (float)t * inv;
        const double rev = (double)ang * 0.15915494309189535; const float fr = (float)(rev - __builtin_rint(rev));
        rope[t * 16 + f] = __builtin_amdgcn_cosf(fr); rope[t * 16 + 8 + f] = __builtin_amdgcn_sinf(fr); }
    const f32x4* x4 = (const f32x4*)a->in[0]; u32x4* xb = (u32x4*)(a->ws + WS_XB);
    for (size_t i = gt; i < (size_t)T * DM / 8; i += NGT) { const f32x4 v0 = x4[2 * i], v1 = x4[2 * i + 1];
        u32x4 w; w.x = pk2(v0[0], v0[1]); w.y = pk2(v0[2], v0[3]); w.z = pk2(v1[0], v1[1]); w.w = pk2(v1[2], v1[3]); xb[i] = w; }
}

__device__ __forceinline__ void phase_ln1_router(const Frame& F, ArgsP a, int l) {
    float* X1 = (float*)(a->ws + WS_X1); bf16* XB = (bf16*)(a->ws + WS_XB);
    const float* WR = (const float*)(a->ws + WS_WL + WL_WR);
    const float* lw = a->in[14] + (size_t)l * DM; const float* lb = a->in[15] + (size_t)l * DM;
    const float* bg = a->in[19] + l * 4; const float* be = a->in[21] + l * NEXP;
    int* route_e = (int*)(a->ws + WS_SLOT + SL_RE); int* route_p = (int*)(a->ws + WS_SLOT + SL_RP); float* route_w = (float*)(a->ws + WS_SLOT + SL_RW);
    unsigned* cnt = F.ctl + CW_CNT + l * 512;
    const int gw = F.bid * NWAVES + F.wave, NGW = F.G * NWAVES, lane = F.lane;
    const float mybias = lane < 4 ? bg[lane] : (lane < 36 ? be[lane - 4] : 0.f);
    for (int tg = gw; tg < T / 4; tg += NGW) {
        f32x4 v[4][4];
#pragma unroll
        for (int tk = 0; tk < 4; ++tk) { const f32x4* row = (const f32x4*)(X1 + (size_t)(4 * tg + tk) * DM) + lane;
#pragma unroll
            for (int j = 0; j < 4; ++j) v[tk][j] = row[64 * j]; }
#pragma unroll
        for (int tk = 0; tk < 4; ++tk) {
            float s = 0.f;
#pragma unroll
            for (int j = 0; j < 4; ++j) s += (v[tk][j][0] + v[tk][j][1]) + (v[tk][j][2] + v[tk][j][3]);
            const float mean = wave_sum(s) * (1.f / DM); float q = 0.f;
#pragma unroll
            for (int j = 0; j < 4; ++j) { v[tk][j] = v[tk][j] - mean; q += (v[tk][j][0] * v[tk][j][0] + v[tk][j][1] * v[tk][j][1]) + (v[tk][j][2] * v[tk][j][2] + v[tk][j][3] * v[tk][j][3]); }
            const float rstd = 1.f / sqrtf(wave_sum(q) * (1.f / DM) + LN_EPS);
            f32x4* orow = (f32x4*)(X1 + (size_t)(4 * tg + tk) * DM) + lane; u32x2* brow = (u32x2*)(XB + (size_t)(4 * tg + tk) * DM) + lane;
#pragma unroll
            for (int j = 0; j < 4; ++j) { const f32x4 w4 = ((const f32x4*)lw)[lane + 64 * j], b4 = ((const f32x4*)lb)[lane + 64 * j];
                v[tk][j] = v[tk][j] * rstd * w4 + b4; orow[64 * j] = v[tk][j];
                u32x2 w; w.x = pk2(v[tk][j][0], v[tk][j][1]); w.y = pk2(v[tk][j][2], v[tk][j][3]); brow[64 * j] = w; }
        }
        float lg[4] = {0.f, 0.f, 0.f, 0.f};
#pragma unroll 4
        for (int j36 = 0; j36 < 36; ++j36) {
            const f32x4* wr = (const f32x4*)(WR + (size_t)j36 * DM) + lane;
            const f32x4 w0 = wr[0], w1 = wr[64], w2 = wr[128], w3 = wr[192];
#pragma unroll
            for (int tk = 0; tk < 4; ++tk) {
                f32x4 p = v[tk][0] * w0; p = p + v[tk][1] * w1; p = p + v[tk][2] * w2; p = p + v[tk][3] * w3;
                const float d = wave_sum((p[0] + p[1]) + (p[2] + p[3]));
                lg[tk] = (lane == j36) ? d : lg[tk];
            }
        }
        int my_e = 0; float my_w = 0.f;
#pragma unroll
        for (int tk = 0; tk < 4; ++tk) {
            const float lgb = lg[tk] + mybias;
            float gl[4];
#pragma unroll
            for (int i = 0; i < 4; ++i) gl[i] = __int_as_float(__builtin_amdgcn_readlane(__float_as_int(lgb), i));
            int gi = 0; float gm = gl[0];
#pragma unroll
            for (int i = 1; i < 4; ++i) if (gl[i] > gm) { gm = gl[i]; gi = i; }
            float gs = 0.f;
#pragma unroll
            for (int i = 0; i < 4; ++i) gs += __expf(gl[i] - gm);
            const float g_w = 1.f / gs;
            float ev[8];
#pragma unroll
            for (int i = 0; i < 8; ++i) ev[i] = __int_as_float(__builtin_amdgcn_readlane(__float_as_int(lgb), 4 + gi * 8 + i));
            int i1 = 0; float v1 = ev[0];
#pragma unroll
            for (int i = 1; i < 8; ++i) if (ev[i] > v1) { v1 = ev[i]; i1 = i; }
            int i2 = -1; float v2 = -3.0e38f;
#pragma unroll
            for (int i = 0; i < 8; ++i) if (i != i1 && ev[i] > v2) { v2 = ev[i]; i2 = i; }
            const float e2 = __expf(v2 - v1), w1 = g_w / (1.f + e2), w2 = g_w - w1;
            if (lane == 2 * tk) { my_e = gi * 8 + i1; my_w = w1; }
            if (lane == 2 * tk + 1) { my_e = gi * 8 + i2; my_w = w2; }
        }
        if (lane < 8) {
            const unsigned pos = __hip_atomic_fetch_add(cnt + my_e * 16, 1u, __ATOMIC_RELAXED, __HIP_MEMORY_SCOPE_AGENT);
            const size_t si = (size_t)tg * 8 + lane; route_e[si] = my_e; route_p[si] = (int)pos; route_w[si] = my_w;
        }
    }
}

__device__ __forceinline__ void phase_gather(const Frame& F, ArgsP a, int l) {
    LAS int* pstart = (LAS int*)F.lds;
    unsigned* cnt = F.ctl + CW_CNT + l * 512;
    int* meta = (int*)(a->ws + WS_META) + l * 512;
    int* slot_tok = (int*)(a->ws + WS_SLOT + SL_TOK); float* slot_w = (float*)(a->ws + WS_SLOT + SL_W);
    const int* route_e = (const int*)(a->ws + WS_SLOT + SL_RE); const int* route_p = (const int*)(a->ws + WS_SLOT + SL_RP); const float* route_w = (const float*)(a->ws + WS_SLOT + SL_RW);
    if (F.tid < 64) {
        const int c = F.tid < 32 ? (int)__hip_atomic_load(cnt + F.tid * 16, __ATOMIC_RELAXED, __HIP_MEMORY_SCOPE_AGENT) : 0;
        const int pad = (c + 255) & ~255; int inc = pad;
#pragma unroll
        for (int o = 1; o < 64; o <<= 1) { const int t = __shfl_up(inc, o); if (F.lane >= o) inc += t; }
        const int st = inc - pad;
        if (F.tid < 32) { pstart[F.tid] = st;
            if (F.bid == 0) { for (int t = st >> 8; t < (st + pad) >> 8; ++t) meta[64 + t] = F.tid; if (F.tid == 31) meta[0] = (st + pad) >> 8; }
            if ((F.tid % F.G) == F.bid) for (int r = st + c; r < st + pad; ++r) { slot_tok[r] = -1; slot_w[r] = 0.f; }
        }
    }
    __syncthreads();
    const bf16* XB = (const bf16*)(a->ws + WS_XB); bf16* BUF = (bf16*)(a->ws + WS_H);
    const int gw = F.bid * NWAVES + F.wave, NGW = F.G * NWAVES;
    for (int s = gw; s < T * 2; s += NGW) {
        const int e = route_e[s], dest = pstart[e] + route_p[s];
        const u32x4* src = (const u32x4*)(XB + (size_t)(s >> 1) * DM) + F.lane; u32x4* dst = (u32x4*)(BUF + (size_t)dest * DM) + F.lane;
        const u32x4 v0 = src[0], v1 = src[64]; dst[0] = v0; dst[64] = v1;
        if (F.lane == 0) { slot_tok[dest] = s; slot_w[dest] = route_w[s]; }
    }
    __syncthreads();
}

__device__ __forceinline__ void phase_ln2(const Frame& F, ArgsP a, int l) {
    const float* X1 = (const float*)(a->ws + WS_X1); const bf16* Y2 = (const bf16*)(a->ws + WS_Y2); bf16* XB = (bf16*)(a->ws + WS_XB); float* out = a->out;
    const float* lw = a->in[16] + (size_t)l * DM; const float* lb = a->in[17] + (size_t)l * DM;
    const int gw = F.bid * NWAVES + F.wave, NGW = F.G * NWAVES, lane = F.lane;
    for (int t = gw; t < T; t += NGW) {
        const f32x4* row = (const f32x4*)(X1 + (size_t)t * DM) + lane; const u32x2* ya = (const u32x2*)(Y2 + (size_t)(2 * t) * DM) + lane; const u32x2* yb = (const u32x2*)(Y2 + (size_t)(2 * t + 1) * DM) + lane;
        f32x4 v[4]; float s = 0.f;
#pragma unroll
        for (int j = 0; j < 4; ++j) { const f32x4 x = row[64 * j]; const u32x2 p = ya[64 * j], q = yb[64 * j];
            v[j][0] = x[0] * DN_ALPHA + (bf2f(p.x & 0xffffu) + bf2f(q.x & 0xffffu)); v[j][1] = x[1] * DN_ALPHA + (bf2f(p.x >> 16) + bf2f(q.x >> 16));
            v[j][2] = x[2] * DN_ALPHA + (bf2f(p.y & 0xffffu) + bf2f(q.y & 0xffffu)); v[j][3] = x[3] * DN_ALPHA + (bf2f(p.y >> 16) + bf2f(q.y >> 16));
            s += (v[j][0] + v[j][1]) + (v[j][2] + v[j][3]); }
        const float mean = wave_sum(s) * (1.f / DM); float q2 = 0.f;
#pragma unroll
        for (int j = 0; j < 4; ++j) { v[j] = v[j] - mean; q2 += (v[j][0] * v[j][0] + v[j][1] * v[j][1]) + (v[j][2] * v[j][2] + v[j][3] * v[j][3]); }
        const float rstd = 1.f / sqrtf(wave_sum(q2) * (1.f / DM) + LN_EPS);
        f32x4* orow = (f32x4*)(out + (size_t)t * DM) + lane; u32x2* brow = (u32x2*)(XB + (size_t)t * DM) + lane;
#pragma unroll
        for (int j = 0; j < 4; ++j) { const f32x4 w4 = ((const f32x4*)lw)[lane + 64 * j], b4 = ((const f32x4*)lb)[lane + 64 * j];
            const f32x4 o = v[j] * rstd * w4 + b4; orow[64 * j] = o; u32x2 w; w.x = pk2(o[0], o[1]); w.y = pk2(o[2], o[3]); brow[64 * j] = w; }
    }
}

__device__ __forceinline__ int tsw(int row, int col) { return row * 128 + ((((col >> 3) ^ (row >> 1)) & 7) << 4) + ((col & 7) << 1); }
__device__ __forceinline__ f32x4 mfma16(bf16x8 a, bf16x8 b, f32x4 c) { return __builtin_amdgcn_mfma_f32_16x16x32_bf16(a, b, c, 0, 0, 0); }
__device__ __forceinline__ f32x16 mfma32(bf16x8 a, bf16x8 b, f32x16 c) { return __builtin_amdgcn_mfma_f32_32x32x16_bf16(a, b, c, 0, 0, 0); }
__device__ __forceinline__ bf16x8 as_bf16x8(u32x4 v) { return __builtin_bit_cast(bf16x8, v); }

__device__ __forceinline__ void conformer_item(const Frame& F, ArgsP a, int l, int it) {
    const int b = it >> 6, s0 = (it & 63) * 64; const size_t tok0 = (size_t)b * SEQ + s0;
    const bf16* H = (const bf16*)(a->ws + WS_H); bf16* Y = (bf16*)(a->ws + WS_Y);
    LAS bf16* ut = (LAS bf16*)F.lds;
    LAS float* co = (LAS float*)(F.lds + 49152);
    for (int idx = F.tid; idx < 94 * 32; idx += NTHR) {
        const int r = idx >> 5, c8 = (idx & 31) * 8, s = s0 - 30 + r; u32x4 w = {0u, 0u, 0u, 0u};
        if (s >= 0) { const bf16* hp = H + ((size_t)b * SEQ + s) * HLD + 2304 + c8; const u32x4 v = *(const u32x4*)hp, g = *(const u32x4*)(hp + 256);
#pragma unroll
            for (int e = 0; e < 4; ++e) { const float v0 = bf2f(v[e] & 0xffffu) * fsigmoid(bf2f(g[e] & 0xffffu)), v1 = bf2f(v[e] >> 16) * fsigmoid(bf2f(g[e] >> 16)); w[e] = pk2(v0, v1); } }
        *(LAS u32x4*)(ut + r * 256 + c8) = w;
    }
    __syncthreads();
    {
        const int c = F.tid & 255, half = F.tid >> 8; const float* dw = a->in[10] + (size_t)l * 31 * 256 + c; const float bias = a->in[11][l * 256 + c];
        float w[31], ur[62];
#pragma unroll
        for (int k = 0; k < 31; ++k) w[k] = dw[k * 256];
#pragma unroll
        for (int i = 0; i < 62; ++i) ur[i] = bf2f(ut[(32 * half + i) * 256 + c]);
#pragma unroll
        for (int tt = 0; tt < 32; ++tt) { float acc = bias;
#pragma unroll
            for (int k = 0; k < 31; ++k) acc += w[k] * ur[tt + k];
            co[(32 * half + tt) * 256 + c] = acc; }
    }
    __syncthreads();
    {
        const float* lw = a->in[12] + l * 256; const float* lb = a->in[13] + l * 256; const f32x4 w4 = ((const f32x4*)lw)[F.lane], b4 = ((const f32x4*)lb)[F.lane];
#pragma unroll
        for (int i = 0; i < 8; ++i) { const int tl = 8 * F.wave + i; f32x4 v = *(LAS f32x4*)(co + tl * 256 + 4 * F.lane);
            const float mean = wave_sum((v[0] + v[1]) + (v[2] + v[3])) * (1.f / 256.f); v = v - mean;
            const float rstd = 1.f / sqrtf(wave_sum((v[0] * v[0] + v[1] * v[1]) + (v[2] * v[2] + v[3] * v[3])) * (1.f / 256.f) + LN_EPS);
            v = v * rstd * w4 + b4; u32x2 o; o.x = pk2(fsilu(v[0]), fsilu(v[1])); o.y = pk2(fsilu(v[2]), fsilu(v[3]));
            *(u32x2*)(Y + (tok0 + tl) * DM + 768 + 4 * F.lane) = o; }
    }
    __syncthreads();
}

__device__ __forceinline__ void compress_item(const Frame& F, ArgsP a, int it) {
    const int kv = it >> 6, bh = (it >> 2) & 15, b = bh >> 1, hh = bh & 1, i0 = (it & 3) * 64;
    const bf16* H = (const bf16*)(a->ws + WS_H); const bf16* w1t = (const bf16*)(a->ws + WS_WL + WL_W1) + (size_t)kv * 128 * 2048; const bf16* w2t = (const bf16*)(a->ws + WS_WL + WL_W2) + (size_t)kv * 64 * 128;
    const float* bias1 = (const float*)(a->ws + WS_WL + WL_BIAS1) + kv * 128; bf16* outp = (bf16*)(a->ws + (kv ? WS_VC : WS_KC)) + (size_t)bh * 256 * 64;
    LAS bf16* hid = (LAS bf16*)F.lds;
    const int lane = F.lane, li = lane & 15, g = lane >> 4, rt = F.wave & 3, ch = F.wave >> 2;
    const int i = i0 + 16 * rt + li; const bf16* arow = H + (size_t)b * SEQ * HLD + 512 + kv * 128 + hh * 64 + 8 * g;
    const bf16* brow = w1t + (size_t)(64 * ch + li) * 2048 + 8 * g;
    f32x4 acc[4] = {{0.f, 0.f, 0.f, 0.f}, {0.f, 0.f, 0.f, 0.f}, {0.f, 0.f, 0.f, 0.f}, {0.f, 0.f, 0.f, 0.f}};
#pragma unroll 4
    for (int ks = 0; ks < 64; ++ks) {
        int s = 16 * i + (ks >> 1); s = s > SEQ - 1 ? SEQ - 1 : s;
        const bf16x8 af = *(const bf16x8*)(arow + (size_t)s * HLD + (ks & 1) * 32);
#pragma unroll
        for (int nt = 0; nt < 4; ++nt) { const bf16x8 bfr = *(const bf16x8*)(brow + (size_t)nt * 16 * 2048 + ks * 32); acc[nt] = mfma16(af, bfr, acc[nt]); }
    }
#pragma unroll
    for (int nt = 0; nt < 4; ++nt) { const int n = 64 * ch + 16 * nt + li; const float bs = bias1[n];
#pragma unroll
        for (int r = 0; r < 4; ++r) hid[(16 * rt + 4 * g + r) * 136 + n] = (bf16)f2bf(fsilu(acc[nt][r] + bs)); }
    __syncthreads();
    f32x4 o2[2] = {{0.f, 0.f, 0.f, 0.f}, {0.f, 0.f, 0.f, 0.f}};
#pragma unroll
    for (int ks = 0; ks < 4; ++ks) { const bf16x8 af = *(LAS bf16x8*)(hid + (16 * rt + li) * 136 + 32 * ks + 8 * g);
#pragma unroll
        for (int nt = 0; nt < 2; ++nt) { const bf16x8 bfr = *(const bf16x8*)(w2t + (size_t)(32 * ch + 16 * nt + li) * 128 + 32 * ks + 8 * g); o2[nt] = mfma16(af, bfr, o2[nt]); } }
#pragma unroll
    for (int nt = 0; nt < 2; ++nt)
#pragma unroll
        for (int r = 0; r < 4; ++r) { const int io = i0 + 16 * rt + 4 * g + r; outp[(size_t)io * 64 + 32 * ch + 16 * nt + li] = (bf16)(io < 255 ? f2bf(o2[nt][r]) : 0u); }
    __syncthreads();
}

__host__ __device__ constexpr int tri_off(int i) { int s = 0; for (int k = 0; k < i; ++k) s += (k + 3) >> 2; return 4 * s; }
__device__ __forceinline__ int tri_off_rt(int i) { const int m = i - 1, V = (m + 3) >> 2; return i <= 0 ? 0 : 4 * (2 * V * (V - 1) + V * (m - 4 * V + 4)); }

template <int I> struct GdnSolveRow {
    __device__ static __forceinline__ void run(const LAS float* Ap, float (&x)[64]) {
        if constexpr (I < 64) {
            constexpr int off = tri_off(I), nb = (I + 3) >> 2;
            float a0 = x[I];
#pragma unroll
            for (int jb = 0; jb < nb; ++jb) { const f32x4 a4 = *(const LAS f32x4*)(Ap + off + 4 * jb);
#pragma unroll
                for (int jj = 0; jj < 4; ++jj) { if (4 * jb + jj < I) a0 -= a4[jj] * x[4 * jb + jj]; } }
            x[I] = a0;
            GdnSolveRow<I + 1>::run(Ap, x);
        }
    }
};

__device__ __forceinline__ void gdn_prep_chunk(const Frame& F, ArgsP a, int l, int ci, LAS unsigned char* wl) {
    const int lane = F.lane, li = lane & 15, g = lane >> 4; const int bh = ci >> 6, n = ci & 63, b = bh >> 2, h = bh & 3; const size_t tok0 = (size_t)b * SEQ + 64 * n;
    const bf16* H = (const bf16*)(a->ws + WS_H); const float* side = (const float*)(a->ws + WS_SIDE);
    unsigned char* rec = a->ws + WS_GPREP + (size_t)ci * GCH;
    bf16* R0 = (bf16*)(rec + GC_UT); bf16* R1 = (bf16*)(rec + GC_W); bf16* QKm = (bf16*)(rec + GC_QK); bf16* QD = (bf16*)(rec + GC_QD); bf16* KDT = (bf16*)(rec + GC_KDT);
    LAS unsigned char* qt = wl; LAS unsigned char* kt = wl + 8192; LAS float* Ap = (LAS float*)wl;
    const float beta = side[(tok0 + lane) * 32 + 24 + h]; const float av = side[(tok0 + lane) * 32 + 28 + h] + a->in[8][l * 4 + h];
    const float sp = av > 20.f ? av : log1pf(__expf(av)); float gc = -__expf(a->in[7][l * 4 + h]) * sp;
#pragma unroll
    for (int o = 1; o < 64; o <<= 1) { const float t = __shfl_up(gc, o); if (lane >= o) gc += t; }
    const float gl = __shfl(gc, 63); const float eg = __expf(gc), ekd = __expf(gl - gc);
    if (lane == 0) ((float*)(a->ws + WS_GL))[ci] = __expf(gl);
    const float* cw = a->in[6] + (size_t)l * 4 * 768 + h * 64 + lane; float wq[4], wk[4], wv[4];
#pragma unroll
    for (int k = 0; k < 4; ++k) { wq[k] = cw[k * 768]; wk[k] = cw[k * 768 + 256]; wv[k] = cw[k * 768 + 512]; }
    const bf16* hp = H + tok0 * HLD + 1280 + h * 64 + lane; float hq[3], hk[3], hv[3];
#pragma unroll
    for (int j = 0; j < 3; ++j) { const bool ok = (64 * n - 3 + j) >= 0; const bf16* p = hp + (ptrdiff_t)(j - 3) * HLD;
        hq[j] = ok ? bf2f(p[0]) : 0.f; hk[j] = ok ? bf2f(p[256]) : 0.f; hv[j] = ok ? bf2f(p[512]) : 0.f; }
    for (int t8 = 0; t8 < 8; ++t8) {
        unsigned kdp[4];
#pragma unroll
        for (int tt = 0; tt < 8; ++tt) { const int t = 8 * t8 + tt; const bf16* p = hp + (size_t)t * HLD;
            const float rq = bf2f(p[0]), rk = bf2f(p[256]), rv = bf2f(p[512]);
            const float cq = wq[0] * hq[0] + wq[1] * hq[1] + wq[2] * hq[2] + wq[3] * rq, ck = wk[0] * hk[0] + wk[1] * hk[1] + wk[2] * hk[2] + wk[3] * rk, cv = wv[0] * hv[0] + wv[1] * hv[1] + wv[2] * hv[2] + wv[3] * rv;
            hq[0] = hq[1]; hq[1] = hq[2]; hq[2] = rq; hk[0] = hk[1]; hk[1] = hk[2]; hk[2] = rk; hv[0] = hv[1]; hv[1] = hv[2]; hv[2] = rv;
            const float qs = fsilu(cq), ks_ = fsilu(ck), vs = fsilu(cv);
            const float qn = qs * __builtin_amdgcn_rsqf(wave_sum(qs * qs) + 1e-6f) * 0.125f, kn = ks_ * __builtin_amdgcn_rsqf(wave_sum(ks_ * ks_) + 1e-6f);
            const float bt = __shfl(beta, t), egt = __shfl(eg, t), ekt = __shfl(ekd, t);
            *(LAS bf16*)(qt + tsw(t, lane)) = (bf16)f2bf(qn); *(LAS bf16*)(kt + tsw(t, lane)) = (bf16)f2bf(kn);
            QD[t * 64 + lane] = (bf16)f2bf(qn * egt); R0[t * 64 + lane] = (bf16)f2bf(bt * vs); R1[t * 64 + lane] = (bf16)f2bf(bt * egt * kn);
            const unsigned kd = f2bf(kn * ekt); if (tt & 1) kdp[tt >> 1] |= kd << 16; else kdp[tt >> 1] = kd; }
        u32x4 w; w.x = kdp[0]; w.y = kdp[1]; w.z = kdp[2]; w.w = kdp[3]; *(u32x4*)(KDT + lane * 64 + 8 * t8) = w;
    }
    LDS_WAIT();
    float gcj[4][4];
#pragma unroll
    for (int mt = 0; mt < 4; ++mt)
#pragma unroll
        for (int r = 0; r < 4; ++r) gcj[mt][r] = __shfl(gc, 16 * mt + 4 * g + r);
    f32x4 ahold[4][4];
#pragma unroll
    for (int nt = 0; nt < 4; ++nt) {
        const int i = 16 * nt + li; const float gci = __shfl(gc, i), bi = __shfl(beta, i);
        bf16x8 kB[2], qB[2];
#pragma unroll
        for (int ks = 0; ks < 2; ++ks) { kB[ks] = *(LAS bf16x8*)(kt + tsw(i, 32 * ks + 8 * g)); qB[ks] = *(LAS bf16x8*)(qt + tsw(i, 32 * ks + 8 * g)); }
#pragma unroll
        for (int mt = 0; mt < 4; ++mt) {
            u32x2 qw = {0u, 0u};
            if (mt <= nt) {
                const bf16x8 kA0 = *(LAS bf16x8*)(kt + tsw(16 * mt + li, 8 * g)), kA1 = *(LAS bf16x8*)(kt + tsw(16 * mt + li, 32 + 8 * g));
                f32x4 ckk = {0.f, 0.f, 0.f, 0.f}, cqk = {0.f, 0.f, 0.f, 0.f};
                ckk = mfma16(kA0, kB[0], ckk); ckk = mfma16(kA1, kB[1], ckk); cqk = mfma16(kA0, qB[0], cqk); cqk = mfma16(kA1, qB[1], cqk);
                float qv[4];
#pragma unroll
                for (int r = 0; r < 4; ++r) { const int j = 16 * mt + 4 * g + r; const float dec = __expf(fminf(gci - gcj[mt][r], 0.f));
                    ahold[nt][mt][r] = bi * ckk[r] * dec; qv[r] = (j <= i) ? cqk[r] * dec : 0.f; }
                qw.x = pk2(qv[0], qv[1]); qw.y = pk2(qv[2], qv[3]);
            }
            *(u32x2*)(QKm + i * 64 + 16 * mt + 4 * g) = qw;
        }
    }
    LDS_WAIT(); SBAR();
#pragma unroll
    for (int nt = 0; nt < 4; ++nt) { const int i = 16 * nt + li; const int ro = tri_off_rt(i);
#pragma unroll
        for (int mt = 0; mt < 4; ++mt) if (mt <= nt) {
#pragma unroll
            for (int r = 0; r < 4; ++r) { const int j = 16 * mt + 4 * g + r; if (j < i) Ap[ro + j] = ahold[nt][mt][r]; } } }
    VM_WAIT(); LDS_WAIT();
#pragma unroll 1
    for (int pass = 0; pass < 2; ++pass) {
        bf16* Rp = pass ? R1 : R0; float x[64];
#pragma unroll
        for (int i = 0; i < 64; ++i) x[i] = bf2f(Rp[i * 64 + lane]);
        VM_WAIT();
        GdnSolveRow<1>::run(Ap, x);
        if (pass == 0) {
#pragma unroll
            for (int i8 = 0; i8 < 8; ++i8) { u32x4 w; w.x = pk2(x[8 * i8], x[8 * i8 + 1]); w.y = pk2(x[8 * i8 + 2], x[8 * i8 + 3]); w.z = pk2(x[8 * i8 + 4], x[8 * i8 + 5]); w.w = pk2(x[8 * i8 + 6], x[8 * i8 + 7]);
                *(u32x4*)(Rp + lane * 64 + 8 * i8) = w; }
        } else {
#pragma unroll
            for (int i = 0; i < 64; ++i) Rp[i * 64 + lane] = (bf16)f2bf(x[i]);
        }
    }
    LDS_WAIT();
}

__device__ __forceinline__ bf16x8 scan_frag(const unsigned char* mat, int mt, int ks, int li, int g) {
    const unsigned char* p = mat + (16 * mt + li) * 128 + (32 * ks + 4 * g) * 2; const u32x2 lo = *(const u32x2*)p, hi = *(const u32x2*)(p + 32);
    u32x4 w; w.x = lo.x; w.y = lo.y; w.z = hi.x; w.w = hi.y; return as_bf16x8(w);
}
__device__ __forceinline__ bf16x8 pack_c2(f32x4 a, f32x4 b) { u32x4 w; w.x = pk2(a[0], a[1]); w.y = pk2(a[2], a[3]); w.z = pk2(b[0], b[1]); w.w = pk2(b[2], b[3]); return as_bf16x8(w); }
__device__ __forceinline__ void gdn_scan(const Frame& F, ArgsP a, int l) {
    const int lane = F.lane, li = lane & 15, g = lane >> 4, pr = F.wave >> 2, sl = F.wave & 3; const int bh = F.bid * 2 + pr, b = bh >> 2, h = bh & 3, dv0 = 16 * sl;
    const bf16* H = (const bf16*)(a->ws + WS_H); bf16* Y = (bf16*)(a->ws + WS_Y); const float* GL = (const float*)(a->ws + WS_GL);
    LAS float* part = (LAS float*)F.lds;
    const float nw = a->in[9][l * 64 + dv0 + li];
    f32x4 S[4] = {{0.f, 0.f, 0.f, 0.f}, {0.f, 0.f, 0.f, 0.f}, {0.f, 0.f, 0.f, 0.f}, {0.f, 0.f, 0.f, 0.f}};
    for (int n = 0; n < 64; ++n) {
        const int ci = bh * 64 + n; const unsigned char* rec = a->ws + WS_GPREP + (size_t)ci * GCH; const float egl = GL[ci];
        const bf16x8 Sb0 = pack_c2(S[0], S[1]), Sb1 = pack_c2(S[2], S[3]);
        f32x4 vn[4], o[4];
#pragma unroll
        for (int mt = 0; mt < 4; ++mt) {
            f32x4 acc = {0.f, 0.f, 0.f, 0.f};
            acc = mfma16(scan_frag(rec + GC_W, mt, 0, li, g), Sb0, acc); acc = mfma16(scan_frag(rec + GC_W, mt, 1, li, g), Sb1, acc);
            const u32x2 uu = *(const u32x2*)(rec + GC_UT + (dv0 + li) * 128 + (16 * mt + 4 * g) * 2);
            vn[mt][0] = bf2f(uu.x & 0xffffu) - acc[0]; vn[mt][1] = bf2f(uu.x >> 16) - acc[1]; vn[mt][2] = bf2f(uu.y & 0xffffu) - acc[2]; vn[mt][3] = bf2f(uu.y >> 16) - acc[3];
        }
        const bf16x8 Vb0 = pack_c2(vn[0], vn[1]), Vb1 = pack_c2(vn[2], vn[3]);
#pragma unroll
        for (int mt = 0; mt < 4; ++mt) {
            f32x4 acc = {0.f, 0.f, 0.f, 0.f};
            acc = mfma16(scan_frag(rec + GC_QD, mt, 0, li, g), Sb0, acc); acc = mfma16(scan_frag(rec + GC_QD, mt, 1, li, g), Sb1, acc);
            acc = mfma16(scan_frag(rec + GC_QK, mt, 0, li, g), Vb0, acc); acc = mfma16(scan_frag(rec + GC_QK, mt, 1, li, g), Vb1, acc);
            o[mt] = acc;
        }
#pragma unroll
        for (int mt = 0; mt < 4; ++mt) { f32x4 acc = S[mt] * egl;
            acc = mfma16(scan_frag(rec + GC_KDT, mt, 0, li, g), Vb0, acc); acc = mfma16(scan_frag(rec + GC_KDT, mt, 1, li, g), Vb1, acc); S[mt] = acc; }
        LAS float* pp = part + (n & 1) * 512 + pr * 256;
#pragma unroll
        for (int mt = 0; mt < 4; ++mt)
#pragma unroll
            for (int r = 0; r < 4; ++r) { float ss = o[mt][r] * o[mt][r]; ss += __shfl_xor(ss, 1); ss += __shfl_xor(ss, 2); ss += __shfl_xor(ss, 4); ss += __shfl_xor(ss, 8);
                if (li == 0) pp[sl * 64 + 16 * mt + 4 * g + r] = ss; }
        __syncthreads();
        const size_t tokb = (size_t)b * SEQ + 64 * n;
#pragma unroll
        for (int mt = 0; mt < 4; ++mt)
#pragma unroll
            for (int r = 0; r < 4; ++r) { const int tk = 16 * mt + 4 * g + r; const float tot = (pp[tk] + pp[64 + tk]) + (pp[128 + tk] + pp[192 + tk]);
                const float rs = __builtin_amdgcn_rsqf(tot * (1.f / 64.f) + 1e-6f); const float z = bf2f(H[(tokb + tk) * HLD + 2048 + h * 64 + dv0 + li]);
                Y[(tokb + tk) * DM + 512 + h * 64 + dv0 + li] = (bf16)f2bf(o[mt][r] * rs * nw * fsilu(z)); }
    }
    __syncthreads();
}

constexpr int AT_K = 0, AT_V = 16384, AT_IMP = 32768, AT_SELM = AT_IMP + 64 * 68 * 4, AT_UNI = AT_SELM + 512;
__device__ __forceinline__ s16x4 tr_read0(unsigned addr) { s16x4 r; asm volatile("ds_read_b64_tr_b16 %0, %1" : "=&v"(r) : "v"(addr) : "memory"); return r; }

struct AttnStage { u32x4 kr, vr; };
__device__ __forceinline__ void at_gload(AttnStage& st, const bf16* Kb, const bf16* Vb, size_t stride, int j, int tid) {
    const int row = tid >> 3, ch = tid & 7; const size_t off = (size_t)(64 * j + row) * stride + 8 * ch;
    st.kr = *(const u32x4*)(Kb + off); st.vr = *(const u32x4*)(Vb + off);
}
__device__ __forceinline__ void at_swrite(const AttnStage& st, LAS unsigned char* lds, int buf, int tid) {
    const int row = tid >> 3, ch = tid & 7; const int o = row * 128 + (((ch ^ (row >> 1)) & 7) << 4);
    *(LAS u32x4*)(lds + AT_K + buf * 8192 + o) = st.kr; *(LAS u32x4*)(lds + AT_V + buf * 8192 + o) = st.vr;
}
__device__ __forceinline__ void at_qk(const LAS unsigned char* Kt, const bf16x8 (&Qf)[4], int r, int hf, f32x16 (&s)[2]) {
    const int swz = (r >> 1) & 7;
#pragma unroll
    for (int kt = 0; kt < 2; ++kt) {
        f32x16 acc;
#pragma unroll
        for (int e = 0; e < 16; ++e) acc[e] = 0.f;
#pragma unroll
        for (int ks = 0; ks < 4; ++ks) { const bf16x8 kf = *(const LAS bf16x8*)(Kt + (32 * kt + r) * 128 + (((2 * ks + hf) ^ swz) << 4)); acc = mfma32(kf, Qf[ks], acc); }
        s[kt] = acc;
    }
}
__device__ __forceinline__ void at_pv(unsigned vbase, const unsigned (&voff)[2][2], const f32x16 (&p)[2], f32x16 (&o)[2]) {
#pragma unroll
    for (int kt = 0; kt < 2; ++kt)
#pragma unroll
        for (int s = 0; s < 2; ++s) {
            u32x4 pw; pw.x = pk2(p[kt][8 * s + 0], p[kt][8 * s + 1]); pw.y = pk2(p[kt][8 * s + 2], p[kt][8 * s + 3]); pw.z = pk2(p[kt][8 * s + 4], p[kt][8 * s + 5]); pw.w = pk2(p[kt][8 * s + 6], p[kt][8 * s + 7]);
            const bf16x8 pb = as_bf16x8(pw); const unsigned co = vbase + (unsigned)(4096 * kt + 2048 * s);
            const s16x4 l0 = tr_read0(co + voff[0][0]), h0 = tr_read0(co + voff[1][0]), l1 = tr_read0(co + voff[0][1]), h1 = tr_read0(co + voff[1][1]);
            asm volatile("s_waitcnt lgkmcnt(0)" ::: "memory"); SBAR();
            const bf16x8 v0 = {l0[0], l0[1], l0[2], l0[3], h0[0], h0[1], h0[2], h0[3]}, v1 = {l1[0], l1[1], l1[2], l1[3], h1[0], h1[1], h1[2], h1[3]};
            o[0] = mfma32(v0, pb, o[0]); o[1] = mfma32(v1, pb, o[1]);
        }
}

struct AttnRow { int r, hf, tt, t, qb, wave; unsigned long long wave_union; float m, lpart; };
template <int MODE>
__device__ __forceinline__ void at_branch(const Frame& F, unsigned long long mask, const bf16* Kb, const bf16* Vb, size_t stride, const bf16x8 (&Qf)[4], AttnRow& R, const unsigned (&voff)[2][2],
                                          f32x16 (&o)[2], float mfin, float invl) {
    LAS unsigned char* lds = F.lds; const int tid = F.tid;
    if (mask == 0ull) return;
    AttnStage st; int buf = 0;
    { const int j0 = __builtin_ctzll(mask); at_gload(st, Kb, Vb, stride, j0, tid); at_swrite(st, lds, 0, tid); }
    __syncthreads();
    while (mask) {
        const int j = __builtin_ctzll(mask); mask &= mask - 1ull; const int jn = mask ? __builtin_ctzll(mask) : -1;
        if (jn >= 0) at_gload(st, Kb, Vb, stride, jn, tid);
        bool work = true;
        if (MODE == 2) work = (R.wave_union >> j) & 1ull;
        if (work) {
            f32x16 s[2]; at_qk(lds + AT_K + buf * 8192, Qf, R.r, R.hf, s);
            int hi = 1000, lo = -1000; bool rowok = true;
            if (MODE <= 1) hi = ((R.t - 31) >> 4) - 64 * j - 4 * R.hf;
            if (MODE == 2) { const unsigned long long sm = *(const LAS unsigned long long*)(lds + AT_SELM + 8 * R.tt); rowok = (sm >> j) & 1ull; if (j == R.qb) hi = R.tt - 4 * R.hf; }
            if (MODE == 3) { if (j == R.qb) hi = R.tt - 4 * R.hf; if (j == R.qb - 8) lo = R.tt + 1 - 4 * R.hf; }
            if (!rowok) hi = -1000;
            if (MODE == 1) {
#pragma unroll
                for (int kt = 0; kt < 2; ++kt)
#pragma unroll
                    for (int e = 0; e < 16; ++e) { const int cst = 32 * kt + (e & 3) + 8 * (e >> 2); s[kt][e] = (cst <= hi) ? fexp2(s[kt][e] - mfin) * invl : 0.f; }
                LAS float* imp = (LAS float*)(lds + AT_IMP) + R.tt * 68;
#pragma unroll
                for (int kt = 0; kt < 2; ++kt)
#pragma unroll
                    for (int rg = 0; rg < 4; ++rg) {
                        float av = 2.f * (s[kt][4 * rg] + s[kt][4 * rg + 1] + s[kt][4 * rg + 2]) + s[kt][4 * rg + 3], bv = s[kt][4 * rg + 3];
                        av += __shfl_xor(av, 1); av += __shfl_xor(av, 2); bv += __shfl_xor(bv, 1); bv += __shfl_xor(bv, 2);
                        if ((R.r & 3) == 0) { const int jb = 16 * j + 8 * kt + 2 * rg + R.hf; __hip_atomic_fetch_add(imp + jb, av, __ATOMIC_RELAXED, __HIP_MEMORY_SCOPE_WORKGROUP); __hip_atomic_fetch_add(imp + jb + 1, bv, __ATOMIC_RELAXED, __HIP_MEMORY_SCOPE_WORKGROUP); }
                    }
                at_pv((unsigned)(size_t)(lds + AT_V + buf * 8192), voff, s, o);
            } else {
                float tmax = -INFINITY;
#pragma unroll
                for (int kt = 0; kt < 2; ++kt)
#pragma unroll
                    for (int e = 0; e < 16; ++e) { const int cst = 32 * kt + (e & 3) + 8 * (e >> 2); const bool ok = (cst <= hi) && (cst >= lo); s[kt][e] = ok ? s[kt][e] : -INFINITY; tmax = fmaxf(tmax, s[kt][e]); }
                tmax = fmaxf(tmax, __shfl_xor(tmax, 32));
                const float mn = fmaxf(R.m, tmax), alpha = fexp2(R.m - mn); R.m = mn;
                float ps = 0.f;
#pragma unroll
                for (int kt = 0; kt < 2; ++kt)
#pragma unroll
                    for (int e = 0; e < 16; ++e) { s[kt][e] = fexp2(s[kt][e] - mn); ps += s[kt][e]; }
                R.lpart = R.lpart * alpha + ps;
                if (MODE >= 2) {
                    if (__any(alpha < 1.f)) {
#pragma unroll
                        for (int e = 0; e < 16; ++e) { o[0][e] *= alpha; o[1][e] *= alpha; } }
                    at_pv((unsigned)(size_t)(lds + AT_V + buf * 8192), voff, s, o);
                }
            }
        }
        if (jn >= 0) at_swrite(st, lds, buf ^ 1, tid);
        __syncthreads();
        buf ^= 1;
    }
}

__device__ __forceinline__ void attn_item(const Frame& F, ArgsP a, int l, int item) {
    const int qb = 63 - (item >> 4), bh = item & 15, b = bh >> 1, hk = bh & 1; const int lane = F.lane, wave = F.wave;
    const bf16* H = (const bf16*)(a->ws + WS_H); const float* side = (const float*)(a->ws + WS_SIDE); bf16* Y = (bf16*)(a->ws + WS_Y);
    LAS unsigned char* lds = F.lds;
    AttnRow R; R.r = lane & 31; R.hf = lane >> 5; R.tt = 8 * wave + (R.r >> 2); R.t = 64 * qb + R.tt; R.qb = qb; R.wave = wave; R.wave_union = 0ull;
    const int head = hk * 4 + (R.r & 3); const size_t tok = (size_t)b * SEQ + R.t;
    bf16x8 Qf[4];
#pragma unroll
    for (int ks = 0; ks < 4; ++ks) Qf[ks] = *(const bf16x8*)(H + tok * HLD + head * 64 + 16 * ks + 8 * R.hf);
    const float g_cmp = side[tok * 32 + head * 3], g_sel = side[tok * 32 + head * 3 + 1], g_win = side[tok * 32 + head * 3 + 2];
    unsigned voff[2][2];
    { const int li = lane & 15, q = li >> 2, p = li & 3, gi1 = (lane >> 4) & 1;
#pragma unroll
      for (int jh = 0; jh < 2; ++jh)
#pragma unroll
          for (int dt = 0; dt < 2; ++dt) voff[jh][dt] = (unsigned)((8 * jh + 4 * R.hf + q) * 128 + ((((4 * dt + 2 * gi1 + (p >> 1)) ^ (4 * jh + 2 * R.hf + (q >> 1))) & 7) << 4) + (p & 1) * 8); }
    { LAS float* imp = (LAS float*)(lds + AT_IMP) + (8 * wave) * 68; for (int i = lane; i < 8 * 68; i += 64) imp[i] = 0.f; if (F.tid == 0) { *(LAS unsigned*)(lds + AT_UNI) = 0u; *(LAS unsigned*)(lds + AT_UNI + 4) = 0u; } }
    f32x16 ysum[2], o[2];
#pragma unroll
    for (int e = 0; e < 16; ++e) { ysum[0][e] = 0.f; ysum[1][e] = 0.f; o[0][e] = 0.f; o[1][e] = 0.f; }
    {
        const bf16* Kc = (const bf16*)(a->ws + WS_KC) + (size_t)bh * 256 * 64; const bf16* Vc = (const bf16*)(a->ws + WS_VC) + (size_t)bh * 256 * 64;
        const int ntc = (4 * qb + 3 + 63) >> 6; const unsigned long long mc = (ntc >= 64) ? ~0ull : ((1ull << ntc) - 1ull);
        R.m = -1e30f; R.lpart = 0.f;
        at_branch<0>(F, mc, Kc, Vc, 64, Qf, R, voff, o, 0.f, 0.f);
        const float lsum = R.lpart + __shfl_xor(R.lpart, 32); const float invl = 1.f / fmaxf(lsum, 1e-30f);
        at_branch<1>(F, mc, Kc, Vc, 64, Qf, R, voff, o, R.m, invl);
#pragma unroll
        for (int e = 0; e < 16; ++e) { ysum[0][e] = g_cmp * o[0][e]; ysum[1][e] = g_cmp * o[1][e]; o[0][e] = 0.f; o[1][e] = 0.f; }
    }
    LDS_WAIT();
    {
        unsigned long long wu = 0ull;
        for (int qi = 0; qi < 8; ++qi) {
            unsigned long long selm;
            if (qb < 16) selm = (2ull << qb) - 1ull;
            else {
                const float v = ((const LAS float*)(lds + AT_IMP))[(8 * wave + qi) * 68 + lane];
                const bool cand = (lane >= 1) && (lane <= qb - 2); const unsigned key = cand ? __float_as_uint(fmaxf(v, 0.f)) : 0u;
                unsigned thr = 0u;
                for (int bit = 30; bit >= 0; --bit) { const unsigned tr = thr | (1u << bit); const int c = __popcll(__ballot(cand && key >= tr)); if (c >= 13) thr = tr; }
                const unsigned long long gt = __ballot(cand && key > thr), eq = __ballot(cand && key == thr);
                int need = 13 - __popcll(gt); unsigned long long eqs = 0ull, e2 = eq;
                while (need > 0 && e2) { const unsigned long long low = e2 & (~e2 + 1ull); eqs |= low; e2 ^= low; --need; }
                selm = gt | eqs | 1ull | (1ull << qb) | (1ull << (qb - 1));
            }
            if (lane == 0) *(LAS unsigned long long*)(lds + AT_SELM + 8 * (8 * wave + qi)) = selm;
            wu |= selm;
        }
        R.wave_union = wu;
        if (lane == 0) { __hip_atomic_fetch_or((LAS unsigned*)(lds + AT_UNI), (unsigned)wu, __ATOMIC_RELAXED, __HIP_MEMORY_SCOPE_WORKGROUP); __hip_atomic_fetch_or((LAS unsigned*)(lds + AT_UNI + 4), (unsigned)(wu >> 32), __ATOMIC_RELAXED, __HIP_MEMORY_SCOPE_WORKGROUP); }
    }
    __syncthreads();
    const unsigned long long bunion = (unsigned long long)*(const LAS unsigned*)(lds + AT_UNI) | ((unsigned long long)*(const LAS unsigned*)(lds + AT_UNI + 4) << 32);
    const bf16* Hb = H + (size_t)b * SEQ * HLD;
    {
        R.m = -1e30f; R.lpart = 0.f;
        at_branch<2>(F, bunion, Hb + 512 + 2 * 128 + hk * 64, Hb + 512 + 3 * 128 + hk * 64, HLD, Qf, R, voff, o, 0.f, 0.f);
        const float lsum = R.lpart + __shfl_xor(R.lpart, 32); const float sc = g_sel / fmaxf(lsum, 1e-30f);
#pragma unroll
        for (int e = 0; e < 16; ++e) { ysum[0][e] += sc * o[0][e]; ysum[1][e] += sc * o[1][e]; o[0][e] = 0.f; o[1][e] = 0.f; }
    }
    {
        const int lo = qb - 8 > 0 ? qb - 8 : 0; const unsigned long long mw = ((2ull << qb) - 1ull) & ~((1ull << lo) - 1ull);
        R.m = -1e30f; R.lpart = 0.f;
        at_branch<3>(F, mw, Hb + 512 + 4 * 128 + hk * 64, Hb + 512 + 5 * 128 + hk * 64, HLD, Qf, R, voff, o, 0.f, 0.f);
        const float lsum = R.lpart + __shfl_xor(R.lpart, 32); const float sc = g_win / fmaxf(lsum, 1e-30f);
#pragma unroll
        for (int e = 0; e < 16; ++e) { ysum[0][e] += sc * o[0][e]; ysum[1][e] += sc * o[1][e]; }
    }
    bf16* yrow = Y + tok * DM + head * 64 + 4 * R.hf;
#pragma unroll
    for (int dt = 0; dt < 2; ++dt)
#pragma unroll
        for (int rg = 0; rg < 4; ++rg) { u32x2 w; w.x = pk2(ysum[dt][4 * rg], ysum[dt][4 * rg + 1]); w.y = pk2(ysum[dt][4 * rg + 2], ysum[dt][4 * rg + 3]); *(u32x2*)(yrow + 32 * dt + 8 * rg) = w; }
}

__device__ __forceinline__ void phase_mix_a(const Frame& F, ArgsP a, int l) {
    constexpr int N_CMP = 128, N_GDN = 256, N_CONF = 512;
    for (int it = F.bid; it < N_CMP + N_GDN + N_CONF; it += F.G) {
        if (it < N_CMP) compress_item(F, a, it);
        else if (it < N_CMP + N_GDN) { gdn_prep_chunk(F, a, l, (it - N_CMP) * 8 + F.wave, F.lds + F.wave * 16384); __syncthreads(); }
        else conformer_item(F, a, l, it - N_CMP - N_GDN);
    }
}
__device__ __forceinline__ void phase_mix_b(const Frame& F, ArgsP a, int l) {
    unsigned* q = F.ctl + CW_QUEUE + l * 64;
    for (;;) {
        if (F.tid == 0) F.MISC[0] = __hip_atomic_fetch_add(q, 1u, __ATOMIC_RELAXED, __HIP_MEMORY_SCOPE_AGENT);
        __syncthreads();
        const int item = (int)F.MISC[0];
        __syncthreads();
        if (item >= 1024) break;
        attn_item(F, a, l, item);
    }
}

#ifndef MK_MULTI
#define MK_MULTI 0
#endif
constexpr int N_PHASES = 1 + 9 * NL;
__device__ __forceinline__ Frame make_frame() {
    extern __shared__ __attribute__((aligned(16))) unsigned char lds_raw[];
    Frame F; F.lds = (LAS unsigned char*)lds_raw; F.MISC = (volatile LAS unsigned*)(F.lds + MISC_OFF);
    int tid = threadIdx.x, G = gridDim.x, bid = blockIdx.x; unsigned lb = (unsigned)(size_t)F.lds;
    asm volatile("" : "+v"(tid), "+s"(G), "+s"(bid), "+s"(lb));
    F.lds = (LAS unsigned char*)(size_t)lb; F.MISC = (volatile LAS unsigned*)(F.lds + MISC_OFF);
    F.tid = tid; F.lane = F.tid & 63; F.wave = __builtin_amdgcn_readfirstlane(F.tid >> 6); F.G = G; F.bid = bid;
    F.ctl = (unsigned*)(args_here()->ws + WS_CTL); return F;
}
__device__ __forceinline__ void ph_prologue(int) { const Frame F = make_frame(); phase_prologue(F, args_here()); phase_weights(F, args_here(), 0); }
__device__ __forceinline__ void ph_inproj(int) { const Frame F = make_frame(); unsigned char* ws = args_here()->ws;
    pg8::Gemm g{(const bf16*)(ws + WS_XB), (const bf16*)(ws + WS_WL + WL_WIN), T, DINP, DM}; pg8::StaticOrder S; S.init(T, DINP, F.G, F.bid);
    pg8::EpiInProj E{(bf16*)(ws + WS_H), (float*)(ws + WS_SIDE), (const float*)(ws + WS_ROPE)};
    pg8::gemm_phase<pg8::EpiInProj, pg8::StaticOrder, false>(F.lds, g, S, E, nullptr); }
__device__ __forceinline__ void ph_compress(int l) { const Frame F = make_frame(); for (int it = F.bid; it < 128; it += F.G) compress_item(F, args_here(), it); }
__device__ __forceinline__ void ph_gdnprep(int l) { const Frame F = make_frame(); for (int it = (F.bid + 128) % F.G; it < 256; it += F.G) { gdn_prep_chunk(F, args_here(), l, it * 8 + F.wave, F.lds + F.wave * 16384); __syncthreads(); } }
__device__ __forceinline__ void ph_conformer(int l) { const Frame F = make_frame(); for (int it = F.bid; it < 512; it += F.G) conformer_item(F, args_here(), l, it); }
__device__ __forceinline__ void ph_scan(int l) { const Frame F = make_frame(); if (F.bid < 16) gdn_scan(F, args_here(), l); }
__device__ __forceinline__ void ph_attn(int l) { const Frame F = make_frame(); phase_mix_b(F, args_here(), l); }
__device__ __forceinline__ void ph_outproj(int l) { const Frame F = make_frame(); ArgsP ap = args_here(); unsigned char* ws = ap->ws;
    pg8::Gemm g{(const bf16*)(ws + WS_Y), (const bf16*)(ws + WS_WL + WL_WOUT), T, DM, DM}; pg8::StaticOrder S; S.init(T, DM, F.G, F.bid);
    pg8::EpiOutProj E{l == 0 ? ap->in[0] : (const float*)ap->out, (float*)(ws + WS_X1), DN_ALPHA};
    pg8::gemm_phase<pg8::EpiOutProj, pg8::StaticOrder, false>(F.lds, g, S, E, nullptr); }
__device__ __forceinline__ void ph_ln1(int l) { const Frame F = make_frame(); phase_ln1_router(F, args_here(), l); }
__device__ __forceinline__ void ph_gather(int l) { const Frame F = make_frame(); phase_gather(F, args_here(), l); }
__device__ __forceinline__ void ph_moeup(int l) { const Frame F = make_frame(); unsigned char* ws = args_here()->ws;
    pg8::Gemm g{(const bf16*)(ws + WS_H), (const bf16*)(ws + WS_WL + WL_WGU), 0, 0, DM}; pg8::MoeOrder S{(const int*)(ws + WS_META) + l * 512, F.G, F.bid};
    pg8::EpiSwiGLU E{(bf16*)(ws + WS_HID)};
    pg8::gemm_phase<pg8::EpiSwiGLU, pg8::MoeOrder, false>(F.lds, g, S, E, nullptr); }
__device__ __forceinline__ void ph_moedown(int l) { const Frame F = make_frame(); unsigned char* ws = args_here()->ws;
    pg8::Gemm g{(const bf16*)(ws + WS_HID), (const bf16*)(ws + WS_WL + WL_WDN), 0, 0, FF}; pg8::MoeOrder S{(const int*)(ws + WS_META) + l * 512, F.G, F.bid};
    pg8::EpiDown E{(bf16*)(ws + WS_Y2), (const int*)(ws + WS_SLOT + SL_TOK), (const float*)(ws + WS_SLOT + SL_W)};
    pg8::gemm_phase<pg8::EpiDown, pg8::MoeOrder, false>(F.lds, g, S, E, nullptr); }
__device__ __forceinline__ void ph_ln2(int l) { const Frame F = make_frame(); phase_ln2(F, args_here(), l); if (l + 1 < NL) phase_weights(F, args_here(), l + 1); }

__global__ void __launch_bounds__(NTHR, 2) fwd_kernel(Args args) {
    extern __shared__ __attribute__((aligned(16))) unsigned char lds_raw[];
    (void)lds_raw; const Frame F = make_frame();
    if (F.tid < 64) F.MISC[F.tid] = 0u;
    __syncthreads();
    XcdBarrier bar = xcd_barrier_post(F.ctl + CW_BAR, F.MISC + 8);
    const int lo = args_here()->ph_lo, hi = args_here()->ph_hi;
#define IN(k) (lo <= (k) && (k) < hi)
#define SEAM(k) do { if (IN(k) && IN((k) + 1)) { XcdBarrier bb = bar; asm volatile("" : "+s"(bb.bar)); xcd_barrier(bb); } } while (0)
    if (IN(0)) ph_prologue(0);
    SEAM(0);
    for (int l = 0; l < NL; ++l) {
        const int pb = 1 + 9 * l;
        if (IN(pb + 0)) ph_inproj(l);
        SEAM(pb + 0);
        if (IN(pb + 1)) { ph_compress(l); ph_gdnprep(l); ph_conformer(l); }
        SEAM(pb + 1);
        if (IN(pb + 2)) { ph_scan(l); ph_attn(l); }
        SEAM(pb + 2);
        if (IN(pb + 3)) ph_outproj(l);
        SEAM(pb + 3);
        if (IN(pb + 4)) ph_ln1(l);
        SEAM(pb + 4);
        if (IN(pb + 5)) ph_gather(l);
        SEAM(pb + 5);
        if (IN(pb + 6)) ph_moeup(l);
        SEAM(pb + 6);
        if (IN(pb + 7)) ph_moedown(l);
        SEAM(pb + 7);
        if (IN(pb + 8)) ph_ln2(l);
        SEAM(pb + 8);
    }
#undef IN
#undef SEAM
}

extern "C" void kernel_launch(void* const* d_in, const int* in_sizes, int n_in, void* d_out, int out_size, void* d_ws, size_t ws_size, hipStream_t stream) {
    static int grid = 0;
    if (grid == 0) {
        if (n_in != 25 || in_sizes[0] != T * DM || out_size != T * DM || ws_size < WS_END) { fprintf(stderr, "kernel_launch: shape/workspace mismatch (n_in %d, in0 %d, out %d, ws %zu < %zu); nothing launched\n", n_in, n_in > 0 ? in_sizes[0] : -1, out_size, ws_size, (size_t)WS_END); grid = -1; return; }
        int dev = 0, cus = 0, per_cu = 0;
        if (hipGetDevice(&dev) != hipSuccess || hipDeviceGetAttribute(&cus, hipDeviceAttributeMultiprocessorCount, dev) != hipSuccess) { grid = -1; return; }
        if (hipFuncSetAttribute((const void*)fwd_kernel, hipFuncAttributeMaxDynamicSharedMemorySize, LDS_BYTES) != hipSuccess) { fprintf(stderr, "kernel_launch: hipFuncSetAttribute failed\n"); grid = -1; return; }
        if (hipOccupancyMaxActiveBlocksPerMultiprocessor(&per_cu, (const void*)fwd_kernel, NTHR, LDS_BYTES) != hipSuccess || per_cu < 1)
            fprintf(stderr, "kernel_launch: note: occupancy query reports %d workgroups per CU\n", per_cu);
        (void)hipGetLastError();
        grid = cus;
        if (grid < 32 || (grid & 7)) { fprintf(stderr, "kernel_launch: unexpected CU count %d\n", cus); }
    }
    if (grid < 0) return;
    if (hipMemsetAsync((char*)d_ws + WS_CTL, 0, CTL_ZERO_BYTES, stream) != hipSuccess) return;
    Args a{};
    for (int i = 0; i < 25; ++i) a.in[i] = (const float*)d_in[i];
    a.out = (float*)d_out; a.ws = (unsigned char*)d_ws;
#if MK_MULTI
    for (int p = 0; p < N_PHASES; ++p) { a.ph_lo = p; a.ph_hi = p + 1; hipLaunchKernelGGL(fwd_kernel, dim3(grid), dim3(NTHR), LDS_BYTES, stream, a); }
#else
    a.ph_lo = 0; a.ph_hi = N_PHASES;
    hipLaunchKernelGGL(fwd_kernel, dim3(grid), dim3(NTHR), LDS_BYTES, stream, a);
#endif
}
```

```cpp
#include <hip/hip_runtime.h>
#include <cstdio>
#include <cstdint>
namespace pg8 {
#define PG8_LAS __attribute__((address_space(3)))
typedef unsigned short bf16_t;
typedef short bf16x8 __attribute__((ext_vector_type(8)));
typedef float f32x4 __attribute__((ext_vector_type(4)));
typedef unsigned u32x4 __attribute__((ext_vector_type(4)));
constexpr int BM = 256, BK = 64, HALF = 128, HTB = HALF * BK * 2  , STAGE_BYTES = 8 * HTB, NXCD = 8, WGM = 8;

__host__ __device__ __forceinline__ int lds_byte(int r, int c) { const int st = (r >> 4) * 2 + (c >> 5), rr = r & 15, cc = c & 31, ob = rr * 64 + cc * 2; return st * 1024 + (ob ^ (((ob >> 9) & 1) << 5)); }
__host__ __device__ __forceinline__ void stage_rc(int b, int& R, int& C) { const int st = b / 1024, sb = b % 1024, swz = sb ^ (((sb >> 9) & 1) << 5); R = (st >> 1) * 16 + swz / 64; C = (st & 1) * 32 + (swz % 64) / 2; }
__host__ __device__ __forceinline__ int perm32(int rho) { const int n = rho >> 4, i = rho & 15; return 8 * (i >> 2) + 4 * n + (i & 3); }

struct Unit { int pm, pn; };
struct Gemm { const bf16_t* A; const bf16_t* Bt; int M, N, K; };

struct StaticOrder {
    int nM, nN, nwg, G, c;
    __host__ __device__ void init(int M, int N, int G_, int c_) { nM = M / BM; nN = N / BM; nwg = nM * nN; G = G_; c = c_; }
    __host__ __device__ bool next(int i, Unit& u) const {
        const long L = (long)i * G + c; if (L >= nwg) return false;
        int wgid = (int)L; { const int q = nwg / NXCD, r = nwg % NXCD, xcd = wgid % NXCD, off = wgid / NXCD; wgid = (xcd < r ? xcd * (q + 1) : r * (q + 1) + (xcd - r) * q) + off; }
        const int nig = WGM * nN, gid = wgid / nig, fm = gid * WGM, gsz = (nM - fm) < WGM ? (nM - fm) : WGM;
        u.pm = fm + ((wgid % nig) % gsz); u.pn = (wgid % nig) / gsz; return true;
    }
    __device__ __forceinline__ void a_ready(const Unit&) const {}
    __device__ __forceinline__ void done(const Unit&) const {}
};

__device__ __forceinline__ unsigned cvt_pk_bf16(float lo, float hi) { unsigned r; asm volatile("v_cvt_pk_bf16_f32 %0, %1, %2" : "=v"(r) : "v"(lo), "v"(hi)); return r; }
__device__ __forceinline__ float fast_sigmoid(float x) { return __builtin_amdgcn_rcpf(1.0f + __builtin_amdgcn_exp2f(-1.44269504089f * x)); }

constexpr int HLD = 2816;
constexpr float QSCALE = 0.125f * 1.44269504089f;

struct EpiInProj {
    static constexpr bool PERM = true, AFTER_DRAIN = false;
    bf16_t* H; float* side; const float* rope;
    __device__ __forceinline__ void operator()(const f32x4 (&acc)[2][2][4][2], const Unit& u, int wr, int wc, int fr, int fq) const {
        const int row0 = u.pm * BM + wr * 64 + fr; const int pn = u.pn;
        if (pn <= 4) {
#pragma unroll
            for (int ai = 0; ai < 2; ++ai)
#pragma unroll
                for (int m = 0; m < 4; ++m) {
                    const int row = row0 + ai * HALF + m * 16; const float* rp = rope + (size_t)(row & 4095) * 16;
                    const f32x4 c0 = *(const f32x4*)(rp), c1 = *(const f32x4*)(rp + 4), s0 = *(const f32x4*)(rp + 8), s1 = *(const f32x4*)(rp + 12);
#pragma unroll
                    for (int bj = 0; bj < 2; ++bj) {
                        f32x4 v0 = acc[ai][bj][m][0], v1 = acc[ai][bj][m][1];
                        const bool ropeb = (pn < 2) || (bj == 0);
                        if (ropeb) {
                            f32x4 p0, p1;
#pragma unroll
                            for (int e = 0; e < 4; ++e) { p0[e] = __shfl_xor(v0[e], 16); p1[e] = __shfl_xor(v1[e], 16); }
                            if (((wc & 1) == 0) && fq < 2) { const float sg = fq ? 1.f : -1.f; v0 = v0 * c0 + (p0 * s0) * sg; v1 = v1 * c1 + (p1 * s1) * sg; }
                        }
                        if (pn < 2) { v0 = v0 * QSCALE; v1 = v1 * QSCALE; }
                        u32x4 w; w.x = cvt_pk_bf16(v0[0], v0[1]); w.y = cvt_pk_bf16(v0[2], v0[3]); w.z = cvt_pk_bf16(v1[0], v1[1]); w.w = cvt_pk_bf16(v1[2], v1[3]);
                        *(u32x4*)(H + (size_t)row * HLD + pn * BM + bj * HALF + wc * 32 + 8 * fq) = w;
                    }
                }
        } else if (pn < 11) {
#pragma unroll
            for (int ai = 0; ai < 2; ++ai)
#pragma unroll
                for (int m = 0; m < 4; ++m) {
                    const int row = row0 + ai * HALF + m * 16;
#pragma unroll
                    for (int bj = 0; bj < 2; ++bj) {
                        const f32x4 v0 = acc[ai][bj][m][0], v1 = acc[ai][bj][m][1];
                        u32x4 w; w.x = cvt_pk_bf16(v0[0], v0[1]); w.y = cvt_pk_bf16(v0[2], v0[3]); w.z = cvt_pk_bf16(v1[0], v1[1]); w.w = cvt_pk_bf16(v1[2], v1[3]);
                        *(u32x4*)(H + (size_t)row * HLD + pn * BM + bj * HALF + wc * 32 + 8 * fq) = w;
                    }
                }
        } else if (wc == 0) {
#pragma unroll
            for (int ai = 0; ai < 2; ++ai)
#pragma unroll
                for (int m = 0; m < 4; ++m) {
                    const int row = row0 + ai * HALF + m * 16;
                    f32x4 v0 = acc[ai][0][m][0], v1 = acc[ai][0][m][1];
#pragma unroll
                    for (int e = 0; e < 4; ++e) { v0[e] = fast_sigmoid(v0[e]); if (fq < 3) v1[e] = fast_sigmoid(v1[e]); }
                    *(f32x4*)(side + (size_t)row * 32 + 8 * fq) = v0; *(f32x4*)(side + (size_t)row * 32 + 8 * fq + 4) = v1;
                }
        }
    }
};
struct EpiOutProj {
    static constexpr bool PERM = false, AFTER_DRAIN = false;
    const float* res; float* out; float alpha;
    __device__ __forceinline__ void operator()(const f32x4 (&acc)[2][2][4][2], const Unit& u, int wr, int wc, int fr, int fq) const {
        const int row0 = u.pm * BM + wr * 64 + fr, col0 = u.pn * BM + wc * 32 + 4 * fq;
#pragma unroll
        for (int ai = 0; ai < 2; ++ai)
#pragma unroll
            for (int m = 0; m < 4; ++m) { const size_t off = (size_t)(row0 + ai * HALF + m * 16) * 1024 + col0;
#pragma unroll
                for (int bj = 0; bj < 2; ++bj)
#pragma unroll
                    for (int n = 0; n < 2; ++n) { const f32x4 r = *(const f32x4*)(res + off + bj * HALF + n * 16); *(f32x4*)(out + off + bj * HALF + n * 16) = r * alpha + acc[ai][bj][m][n]; }
                asm volatile("" ::: "memory"); }
    }
};
struct EpiSwiGLU {
    static constexpr bool PERM = true, AFTER_DRAIN = false;
    bf16_t* hid;
    __device__ __forceinline__ void operator()(const f32x4 (&acc)[2][2][4][2], const Unit& u, int wr, int wc, int fr, int fq) const {
        const int row0 = u.pm * BM + wr * 64 + fr, hc0 = (u.pn & 3) * 128 + wc * 16 + 4 * fq;
#pragma unroll
        for (int ai = 0; ai < 2; ++ai)
#pragma unroll
            for (int m = 0; m < 4; ++m) { bf16_t* rowp = hid + (size_t)(row0 + ai * HALF + m * 16) * 512 + hc0;
#pragma unroll
                for (int bj = 0; bj < 2; ++bj) { const f32x4 g = acc[ai][bj][m][0], up = acc[ai][bj][m][1]; f32x4 h;
#pragma unroll
                    for (int e = 0; e < 4; ++e) h[e] = g[e] * fast_sigmoid(g[e]) * up[e];
                    typedef unsigned u32x2 __attribute__((ext_vector_type(2)));
                    u32x2 w; w.x = cvt_pk_bf16(h[0], h[1]); w.y = cvt_pk_bf16(h[2], h[3]);
                    *(u32x2*)(rowp + bj * 64) = w; } }
    }
};
struct EpiDown {
    static constexpr bool PERM = true, AFTER_DRAIN = false;
    bf16_t* y2; const int* slot_tok; const float* slot_w;
    __device__ __forceinline__ void operator()(const f32x4 (&acc)[2][2][4][2], const Unit& u, int wr, int wc, int fr, int fq) const {
        const int row0 = u.pm * BM + wr * 64 + fr, col0 = (u.pn & 3) * BM + wc * 32 + 8 * fq;
#pragma unroll
        for (int ai = 0; ai < 2; ++ai)
#pragma unroll
            for (int m = 0; m < 4; ++m) { const int row = row0 + ai * HALF + m * 16; const int st = slot_tok[row]; const float sw = slot_w[row];
                if (st >= 0) { bf16_t* rowp = y2 + (size_t)st * 1024 + col0;
#pragma unroll
                    for (int bj = 0; bj < 2; ++bj) { const f32x4 v0 = acc[ai][bj][m][0] * sw, v1 = acc[ai][bj][m][1] * sw;
                        u32x4 w; w.x = cvt_pk_bf16(v0[0], v0[1]); w.y = cvt_pk_bf16(v0[2], v0[3]); w.z = cvt_pk_bf16(v1[0], v1[1]); w.w = cvt_pk_bf16(v1[2], v1[3]);
                        *(u32x4*)(rowp + bj * HALF) = w; } } }
    }
};
struct MoeOrder {
    const int* meta; int G, c;
    __device__ __forceinline__ bool next(int i, Unit& u) const {
        const int per = G >> 3; const int idx = (G & 7) ? (i * G + c) : ((i * 8 + (c & 7)) * per + (c >> 3));
        const int nt = meta[0]; if (idx >= nt * 4) return false;
        const int pm = idx >> 2; u.pm = pm; u.pn = meta[64 + pm] * 4 + (idx & 3); return true;
    }
    __device__ __forceinline__ void a_ready(const Unit&) const {}
    __device__ __forceinline__ void done(const Unit&) const {}
};
template <class Epi, class Sched, bool STAMP = false>
__device__ __forceinline__ void gemm_phase(PG8_LAS unsigned char* lds, const Gemm g, const Sched& S, const Epi& E, unsigned long long* stamps) {
    int tid_ = threadIdx.x; asm volatile("" : "+v"(tid_));
    const int tid = tid_, wid = __builtin_amdgcn_readfirstlane(tid >> 6), lane = tid & 63, wr = wid >> 2, wc = wid & 3, fr = lane & 15, fq = lane >> 4;
    const int K = g.K, nt = K / BK;
    int ts_lo = 0, ts_hi = 0, nts = 0; const unsigned long long rt_entry = STAMP ? (unsigned long long)wall_clock64() : 0ull;
#define PG8_STAMP() do { if (STAMP && wid == 0 && nts < 64) { const unsigned long long _c = (unsigned long long)clock64(); \
        ts_lo = (lane == nts) ? (int)(unsigned)_c : ts_lo; ts_hi = (lane == nts) ? (int)(unsigned)(_c >> 32) : ts_hi; ++nts; } } while (0)
    PG8_STAMP();
    unsigned voffA[2], voffB[2];
#pragma unroll
    for (int i = 0; i < 2; ++i) { int R, C; stage_rc(tid * 16 + i * 8192, R, C); const int Rb = Epi::PERM ? ((R & ~31) + perm32(R & 31)) : R;
        voffA[i] = (unsigned)(R * K + C) * 2u; voffB[i] = (unsigned)(Rb * K + C) * 2u; }
    const size_t kstep = (size_t)(BK * 2);
    const size_t hstep = (size_t)HALF * K * 2;
    const size_t tstep = 2 * hstep;
    const unsigned ldsw = (unsigned)wid * 1024u;
    const int aoff = lds_byte(wr * 64 + fr, fq * 8), boff = lds_byte(wc * 32 + fr, fq * 8);
#define PG8_SA(b, h) (((b) * 2 + (h)) * HTB)
#define PG8_SB(b, h) ((4 + (b) * 2 + (h)) * HTB)
#define PG8_STAGE(bufoff, gbase, voff) do { _Pragma("unroll") for (int _i = 0; _i < 2; ++_i) \
        __builtin_amdgcn_global_load_lds((const unsigned*)((const char*)(gbase) + (voff)[_i]), (PG8_LAS unsigned*)(lds + (bufoff) + ldsw + _i * 8192), 16, 0, 0); } while (0)
#define PG8_LDA(dst, b, h) do { _Pragma("unroll") for (int m = 0; m < 4; ++m) _Pragma("unroll") for (int k = 0; k < 2; ++k) dst[m][k] = *(const PG8_LAS bf16x8*)(lds + PG8_SA(b, h) + aoff + m * 2048 + k * 1024); } while (0)
#define PG8_LDB(dst, b, h) do { _Pragma("unroll") for (int n = 0; n < 2; ++n) _Pragma("unroll") for (int k = 0; k < 2; ++k) dst[n][k] = *(const PG8_LAS bf16x8*)(lds + PG8_SB(b, h) + boff + n * 2048 + k * 1024); } while (0)
#define PG8_MMA(ai, bj, At, Bt) do { __builtin_amdgcn_s_setprio(1); _Pragma("unroll") for (int m = 0; m < 4; ++m) _Pragma("unroll") for (int n = 0; n < 2; ++n) _Pragma("unroll") for (int k = 0; k < 2; ++k) \
        acc[ai][bj][m][n] = __builtin_amdgcn_mfma_f32_16x16x32_bf16(Bt[n][k], At[m][k], acc[ai][bj][m][n], 0, 0, 0); __builtin_amdgcn_s_setprio(0); } while (0)
#define PG8_WAIT_V(n) asm volatile("s_waitcnt vmcnt(" #n ")" ::: "memory")
#define PG8_WAIT_L(n) asm volatile("s_waitcnt lgkmcnt(" #n ")" ::: "memory")
#define PG8_BAR __builtin_amdgcn_s_barrier()
#define PG8_SCHED __builtin_amdgcn_sched_barrier(0)
    Unit cur, nxt; int ui = 0;
    if (!S.next(0, cur)) return;
    f32x4 acc[2][2][4][2];
#pragma unroll
    for (int a = 0; a < 2; ++a)
#pragma unroll
        for (int b = 0; b < 2; ++b)
#pragma unroll
            for (int m = 0; m < 4; ++m)
#pragma unroll
                for (int n = 0; n < 2; ++n) acc[a][b][m][n] = (f32x4){0.f, 0.f, 0.f, 0.f};
    bf16x8 At[4][2], B0[2][2], B1[2][2];
    const char* cA = (const char*)g.A + (size_t)cur.pm * tstep; const char* cB = (const char*)g.Bt + (size_t)cur.pn * tstep;
    S.a_ready(cur);
    PG8_STAGE(PG8_SB(0, 0), cB, voffB); PG8_STAGE(PG8_SA(0, 0), cA, voffA); PG8_STAGE(PG8_SB(0, 1), cB + hstep, voffB); PG8_STAGE(PG8_SA(0, 1), cA + hstep, voffA);
    if (wr == 1) PG8_BAR;
    PG8_WAIT_V(4); PG8_BAR;
    PG8_STAGE(PG8_SB(1, 0), cB + kstep, voffB); PG8_STAGE(PG8_SA(1, 0), cA + kstep, voffA); PG8_STAGE(PG8_SB(1, 1), cB + hstep + kstep, voffB);
    PG8_WAIT_V(6); PG8_BAR;
    PG8_STAMP();
    for (;;) {
        const bool has_next = S.next(ui + 1, nxt);
        const char* nA = has_next ? (const char*)g.A + (size_t)nxt.pm * tstep : cA; const char* nB = has_next ? (const char*)g.Bt + (size_t)nxt.pn * tstep : cB;
        for (int t = 0; t < nt; t += 2) {
            const bool last = (t == nt - 2);
            const char* a1 = cA + (size_t)(t + 1) * kstep;
            const char* a2 = last ? nA : cA + (size_t)(t + 2) * kstep; const char* b2 = last ? nB : cB + (size_t)(t + 2) * kstep;
            const char* a3 = a2 + kstep; const char* b3 = b2 + kstep;
            if (last && has_next) S.a_ready(nxt);
            PG8_LDB(B0, 0, 0); PG8_SCHED; PG8_LDA(At, 0, 0); PG8_STAGE(PG8_SA(1, 1), a1 + hstep, voffA);
            PG8_WAIT_L(8); PG8_BAR; PG8_WAIT_L(0); PG8_MMA(0, 0, At, B0); PG8_BAR; PG8_SCHED;
            PG8_LDB(B1, 0, 1); PG8_STAGE(PG8_SB(0, 0), b2, voffB);
            PG8_BAR; PG8_WAIT_L(0); PG8_MMA(0, 1, At, B1); PG8_BAR;
            PG8_LDA(At, 0, 1); PG8_STAGE(PG8_SA(0, 0), a2, voffA);
            PG8_BAR; PG8_WAIT_L(0); PG8_MMA(1, 0, At, B0); PG8_BAR; PG8_SCHED;
            PG8_STAGE(PG8_SB(0, 1), b2 + hstep, voffB);
            PG8_WAIT_V(6); PG8_BAR; PG8_MMA(1, 1, At, B1); PG8_BAR;
            PG8_LDB(B0, 1, 0); PG8_SCHED; PG8_LDA(At, 1, 0); PG8_STAGE(PG8_SA(0, 1), a2 + hstep, voffA);
            PG8_WAIT_L(8); PG8_BAR; PG8_WAIT_L(0); PG8_MMA(0, 0, At, B0); PG8_BAR; PG8_SCHED;
            PG8_LDB(B1, 1, 1); PG8_STAGE(PG8_SB(1, 0), b3, voffB);
            PG8_BAR; PG8_WAIT_L(0); PG8_MMA(0, 1, At, B1); PG8_BAR;
            PG8_LDA(At, 1, 1); PG8_STAGE(PG8_SA(1, 0), a3, voffA);
            PG8_BAR; PG8_WAIT_L(0); PG8_MMA(1, 0, At, B0); PG8_BAR; PG8_SCHED;
            PG8_STAGE(PG8_SB(1, 1), b3 + hstep, voffB);
            PG8_WAIT_V(6); PG8_BAR; PG8_MMA(1, 1, At, B1); PG8_BAR;
        }
        PG8_STAMP();
        if constexpr (!Epi::AFTER_DRAIN) { E(acc, cur, wr, wc, fr, fq); S.done(cur); }
        PG8_STAMP();
        if (!has_next) break;
#pragma unroll
        for (int a = 0; a < 2; ++a)
#pragma unroll
            for (int b = 0; b < 2; ++b)
#pragma unroll
                for (int m = 0; m < 4; ++m)
#pragma unroll
                    for (int n = 0; n < 2; ++n) acc[a][b][m][n] = (f32x4){0.f, 0.f, 0.f, 0.f};
        cur = nxt; cA = nA; cB = nB; ++ui;
    }
    PG8_WAIT_V(0);
    if (wr == 0) PG8_BAR;
    PG8_BAR;
    if constexpr (Epi::AFTER_DRAIN) { E.fused(acc, cur, wr, wc, fr, fq, lds, wid, lane); S.done(cur); }
    PG8_STAMP();
    if (STAMP && wid == 0) { stamps[lane] = lane < nts ? (((unsigned long long)(unsigned)ts_hi << 32) | (unsigned)ts_lo) : 0ull;
        if (lane == 62) stamps[62] = rt_entry; if (lane == 63) stamps[63] = (unsigned long long)wall_clock64(); }
#undef PG8_STAMP
#undef PG8_SA
#undef PG8_SB
#undef PG8_STAGE
#undef PG8_LDA
#undef PG8_LDB
#undef PG8_MMA
#undef PG8_WAIT_V
#undef PG8_WAIT_L
#undef PG8_BAR
#undef PG8_SCHED
}
}

constexpr int NB = 8, SEQ = 4096, DM = 1024, NL = 4, T = NB * SEQ;
constexpr int DIN = 2848, DINP = 3072, HLD = pg8::HLD;
constexpr int NEXP = 32, FF = 512, NTILE_MAX = 288;
constexpr float LN_EPS = 1e-5f;
constexpr float DN_ALPHA = 1.6817928305074290f;
constexpr int NWAVES = 8, NTHR = 512;

constexpr size_t MiB = 1u << 20, KiB = 1u << 10;
constexpr size_t WS_CTL = 0, CTL_ZERO_BYTES = 128 * KiB;
constexpr size_t WS_ROPE = 1 * MiB;
constexpr size_t WS_META = 1 * MiB + 512 * KiB;
constexpr size_t WS_GL = WS_META + 16 * KiB;
constexpr size_t WS_WL = 2 * MiB;
constexpr size_t WL_WIN = 0, WL_WOUT = 6 * MiB, WL_WGU = 8 * MiB, WL_WDN = 72 * MiB, WL_W1 = 104 * MiB, WL_W2 = 105 * MiB, WL_BIAS1 = 105 * MiB + 64 * KiB, WL_WR = 105 * MiB + 128 * KiB;
constexpr size_t WS_XB = 108 * MiB;
constexpr size_t WS_X1 = 172 * MiB;
constexpr size_t WS_H = 300 * MiB;
constexpr size_t WS_SIDE = 476 * MiB;
constexpr size_t WS_Y = 480 * MiB;
constexpr size_t WS_GPREP = 544 * MiB;
constexpr size_t WS_Y2 = 672 * MiB;
constexpr size_t WS_HID = 800 * MiB;
constexpr size_t WS_KC = 872 * MiB, WS_VC = WS_KC + 512 * KiB;
constexpr size_t WS_SLOT = 873 * MiB;
constexpr size_t SL_TOK = 0, SL_W = 512 * KiB, SL_RE = 1024 * KiB, SL_RP = 1280 * KiB, SL_RW = 1536 * KiB;
constexpr size_t WS_END = 876 * MiB;
constexpr int GCH = 65536;
constexpr int GC_UT = 0, GC_W = 8192, GC_QK = 16384, GC_QD = 24576, GC_KDT = 32768, GC_ZT = 40960, GC_SS = 49152, GC_VB = 57344;
constexpr int CW_TMO = 0;
constexpr int CW_BAR = 4096;
constexpr int CW_CNT = 8192;
constexpr int CW_QUEUE = 12288;
static_assert((CW_QUEUE + NL * 64) * 4 <= (int)CTL_ZERO_BYTES, "CTL words inside the memset region");

constexpr int SCR_BYTES = 143360;
constexpr int MISC_OFF = SCR_BYTES;
constexpr int LDS_BYTES = 147456;

#define GAS __attribute__((address_space(1)))
#define LAS __attribute__((address_space(3)))
typedef unsigned short bf16;
typedef float f32x4 __attribute__((ext_vector_type(4)));
typedef float f32x2 __attribute__((ext_vector_type(2)));
typedef float f32x16 __attribute__((ext_vector_type(16)));
typedef short bf16x8 __attribute__((ext_vector_type(8)));
typedef short s16x4 __attribute__((ext_vector_type(4)));
typedef unsigned u32x4 __attribute__((ext_vector_type(4)));
typedef unsigned u32x2 __attribute__((ext_vector_type(2)));
#define LDS_WAIT() asm volatile("s_waitcnt lgkmcnt(0)" ::: "memory")
#define VM_WAIT() asm volatile("s_waitcnt vmcnt(0)" ::: "memory")
#define SBAR() __builtin_amdgcn_sched_barrier(0)
__device__ __forceinline__ float bf2f(unsigned b) { return __uint_as_float(b << 16); }
__device__ __forceinline__ unsigned f2bf(float f) { unsigned u = __float_as_uint(f); return (u + 0x7fffu + ((u >> 16) & 1u)) >> 16; }
__device__ __forceinline__ unsigned pk2(float lo, float hi) { return pg8::cvt_pk_bf16(lo, hi); }
__device__ __forceinline__ float wave_sum(float v) {
#pragma unroll
    for (int o = 1; o < 64; o <<= 1) v += __shfl_xor(v, o);
    return v;
}
__device__ __forceinline__ float fsigmoid(float x) { return pg8::fast_sigmoid(x); }
__device__ __forceinline__ float fsilu(float x) { return x * pg8::fast_sigmoid(x); }
__device__ __forceinline__ float fexp2(float x) { return __builtin_amdgcn_exp2f(x); }

#define XB_TMO      128
#define XB_XCNT(j)  (256  + 64 * (j))
#define XB_XSUB(j)  (1280 + 64 * (j))
#define XB_XGEN(j)  (2304 + 64 * (j))
#define XB_TOP      3328
#define XB_TOPGEN   3392
#define XCD_BAR_WORDS 3456
#define XB_SPIN_CAP (1u << 18)
#define LAS __attribute__((address_space(3)))

__device__ __forceinline__ unsigned xb_ld(unsigned* p)              { return __hip_atomic_load(p, __ATOMIC_RELAXED, __HIP_MEMORY_SCOPE_AGENT); }
__device__ __forceinline__ unsigned xb_add(unsigned* p, unsigned v) { return __hip_atomic_fetch_add(p, v, __ATOMIC_RELAXED, __HIP_MEMORY_SCOPE_AGENT); }
__device__ __forceinline__ unsigned xb_xcc_id() { return (unsigned)__builtin_amdgcn_s_getreg((3 << 11) | 20) & 0xFu; }
#define XB_SPIN(cond, bar) do { unsigned _sp = 0; while (cond) { __builtin_amdgcn_s_sleep(1); \
    if ((++_sp & 255u) == 0u) { if (xb_ld(&(bar)[XB_TMO])) break; if (_sp > XB_SPIN_CAP) { atomicAdd(&(bar)[XB_TMO], 1u); break; } } } } while (0)

struct XcdBarrier {
    unsigned* bar; unsigned x;
    volatile LAS unsigned* st;
};

__device__ __forceinline__ XcdBarrier xcd_barrier_post(unsigned* bar, volatile LAS unsigned* st) {
    XcdBarrier b; b.bar = bar; b.x = xb_xcc_id(); b.st = st;
    if (threadIdx.x == 0) (void)xb_add(&bar[XB_XCNT(b.x)], 1u);
    return b;
}
__device__ __forceinline__ void xcd_barrier_complete(unsigned* bar, unsigned x, unsigned& nloc, unsigned& nx) {
    const unsigned G = gridDim.x * gridDim.y * gridDim.z;
    unsigned sum, cnt, mine, sp = 0u;
    for (;;) {
        sum = 0u; cnt = 0u; mine = 0u;
#pragma unroll
        for (unsigned j = 0; j < 16; ++j) { const unsigned c = xb_ld(&bar[XB_XCNT(j)]); sum += c; cnt += (c > 0u) ? 1u : 0u; mine = (j == x) ? c : mine; }
        if (sum == G) break;
        __builtin_amdgcn_s_sleep(1);
        if ((++sp & 255u) == 0u) { if (xb_ld(&bar[XB_TMO])) break; if (sp > XB_SPIN_CAP) { atomicAdd(&bar[XB_TMO], 1u); break; } }
    }
    nloc = mine > 0u ? mine : 1u; nx = cnt > 0u ? cnt : 1u;
}

__device__ __forceinline__ void xcd_barrier(const XcdBarrier& b) {
    asm volatile("s_waitcnt vmcnt(0)" ::: "memory");
    __syncthreads();
    if (threadIdx.x == 0) {
        unsigned* bar = b.bar;
        __builtin_amdgcn_s_waitcnt(0);
        unsigned nloc = b.st[0], nx = b.st[1];
        if (nloc == 0u) { xcd_barrier_complete(bar, b.x, nloc, nx); b.st[0] = nloc; b.st[1] = nx; }
        const unsigned old = xb_add(&bar[XB_XSUB(b.x)], 1u);
        const unsigned gen = old / nloc;
        if (old + 1u == (gen + 1u) * nloc) {
            __builtin_amdgcn_fence(__ATOMIC_RELEASE, "agent");
            asm volatile("s_waitcnt vmcnt(0)" ::: "memory");
            const unsigned og = xb_add(&bar[XB_TOP], 1u);
            const unsigned tg = og / nx;
            if (og + 1u == (tg + 1u) * nx) xb_add(&bar[XB_TOPGEN], 1u);
            else XB_SPIN(xb_ld(&bar[XB_TOPGEN]) == tg, bar);
            __builtin_amdgcn_fence(__ATOMIC_ACQUIRE, "agent");
            xb_add(&bar[XB_XGEN(b.x)], 1u);
            asm volatile("s_waitcnt vmcnt(0)" ::: "memory");
        } else {
            XB_SPIN(xb_ld(&bar[XB_XGEN(b.x)]) == gen, bar);
            __builtin_amdgcn_fence(__ATOMIC_ACQUIRE, "agent");
            asm volatile("s_waitcnt vmcnt(0)" ::: "memory");
        }
    }
    __syncthreads();
}

struct Args { const float* in[25]; float* out; unsigned char* ws; int ph_lo, ph_hi; };
typedef const __attribute__((address_space(4))) Args* ArgsP;
__device__ __forceinline__ ArgsP args_here() { ArgsP p = (ArgsP)__builtin_amdgcn_kernarg_segment_ptr(); asm volatile("" : "+s"(p)); return p; }
struct Frame { LAS unsigned char* lds; volatile LAS unsigned* MISC; unsigned* ctl; int tid, lane, wave, G, bid; };

template <class Src>
__device__ __forceinline__ void tr_item(const Src src, int K, int N, bf16* WT, LAS float* scr, int item, int lane) {
    const int nblk = N >> 5, kb = item / nblk, nb = item - kb * nblk, k0 = kb << 6, n0 = nb << 5;
    float tv[32];
#pragma unroll
    for (int i = 0; i < 32; ++i) tv[i] = src(k0 + 2 * i + (lane >> 5), n0 + (lane & 31));
#pragma unroll
    for (int i = 0; i < 32; ++i) scr[(2 * i + (lane >> 5)) * 33 + (lane & 31)] = tv[i];
    LDS_WAIT();
    const int c = lane & 7;
#pragma unroll
    for (int j = 0; j < 4; ++j) { const int n = (lane >> 3) + 8 * j; const LAS float* s = scr + (8 * c) * 33 + n;
        u32x4 o; o.x = pk2(s[0], s[33]); o.y = pk2(s[66], s[99]); o.z = pk2(s[132], s[165]); o.w = pk2(s[198], s[231]);
        *(u32x4*)(WT + (size_t)(n0 + n) * K + k0 + 8 * c) = o; }
    LDS_WAIT();
}
struct SrcPlain { const float* p; int ld; __device__ __forceinline__ float operator()(int k, int n) const { return p[(size_t)k * ld + n]; } };
struct SrcWin { const float* p;
    __device__ __forceinline__ float operator()(int k, int n) const {
        int c;
        if (n < 1280) c = n; else if (n < 2048) c = n + 24; else if (n < 2304) c = n + 24; else if (n < 2816) c = n + 32;
        else if (n < 2840) c = n - 2816 + 1280; else if (n < 2844) c = n - 2840 + 2328; else if (n < 2848) c = n - 2844 + 2332; else return 0.f;
        return p[(size_t)k * DIN + c]; } };
struct SrcGU { const float* wg; const float* wu;
    __device__ __forceinline__ float operator()(int k, int n) const { const int q = n >> 3, r = n & 7; const ptrdiff_t d = (r < 4) ? (ptrdiff_t)0 : (wu - wg); return wg[d + (ptrdiff_t)k * FF + 4 * q + (r & 3)]; } };

__device__ __forceinline__ void phase_weights(const Frame& F, ArgsP a, int l) {
    unsigned char* wl = a->ws + WS_WL;
    LAS float* scr = (LAS float*)(F.lds + F.wave * 16384);
    const int gw = F.bid * NWAVES + F.wave, NGW = F.G * NWAVES;
    constexpr int I_WIN = 16 * 96, I_WOUT = 16 * 32, I_GU1 = 16 * 32, I_GU = NEXP * I_GU1, I_DN1 = 8 * 32, I_DN = NEXP * I_DN1, I_W1 = 2 * 32 * 4, I_W2 = 2 * 2 * 2, I_WR = 36, I_B1 = 256;
    constexpr int NITEMS = I_WIN + I_WOUT + I_GU + I_DN + I_W1 + I_W2 + I_WR + I_B1;
    for (int it = gw; it < NITEMS; it += NGW) {
        int r = it;
        if (r < I_GU) { const int e = r / I_GU1; SrcGU s{a->in[22] + ((size_t)l * NEXP + e) * DM * FF, a->in[23] + ((size_t)l * NEXP + e) * DM * FF};
            tr_item(s, DM, 1024, (bf16*)(wl + WL_WGU) + (size_t)e * 1024 * DM, scr, r - e * I_GU1, F.lane); continue; } r -= I_GU;
        if (r < I_DN) { const int e = r / I_DN1; SrcPlain s{a->in[24] + ((size_t)l * NEXP + e) * FF * DM, DM};
            tr_item(s, FF, DM, (bf16*)(wl + WL_WDN) + (size_t)e * DM * FF, scr, r - e * I_DN1, F.lane); continue; } r -= I_DN;
        if (r < I_WIN) { SrcWin s{a->in[1] + (size_t)l * DM * DIN}; tr_item(s, DM, DINP, (bf16*)(wl + WL_WIN), scr, r, F.lane); continue; } r -= I_WIN;
        if (r < I_WOUT) { SrcPlain s{a->in[2] + (size_t)l * DM * DM, DM}; tr_item(s, DM, DM, (bf16*)(wl + WL_WOUT), scr, r, F.lane); continue; } r -= I_WOUT;
        if (r < I_W1) { const int kv = r / 128; SrcPlain s{a->in[4] + ((size_t)l * 2 + kv) * 2048 * 128, 128};
            tr_item(s, 2048, 128, (bf16*)(wl + WL_W1) + (size_t)kv * 128 * 2048, scr, r - kv * 128, F.lane); continue; } r -= I_W1;
        if (r < I_W2) { const int kv = r / 4; SrcPlain s{a->in[5] + ((size_t)l * 2 + kv) * 128 * 64, 64};
            tr_item(s, 128, 64, (bf16*)(wl + WL_W2) + (size_t)kv * 64 * 128, scr, r - kv * 4, F.lane); continue; } r -= I_W2;
        if (r < I_WR) {
            float* wr = (float*)(wl + WL_WR) + (size_t)r * DM;
            for (int k = F.lane; k < DM; k += 64) wr[k] = (r < 4) ? a->in[18][((size_t)l * DM + k) * 4 + r] : a->in[20][((size_t)l * DM + k) * NEXP + (r - 4)];
            continue; } r -= I_WR;
        {
            const int kv = r >> 7, n = r & 127; const float* pe = a->in[3] + ((size_t)l * 2 + kv) * 2048; const float* w1 = a->in[4] + ((size_t)l * 2 + kv) * 2048 * 128;
            float s = 0.f; for (int k = F.lane; k < 2048; k += 64) s += pe[k] * w1[(size_t)k * 128 + n];
            s = wave_sum(s); if (F.lane == 0) ((float*)(wl + WL_BIAS1))[r] = s;
        }
    }
}

__device__ __forceinline__ void phase_prologue(const Frame& F, ArgsP a) {
    const size_t gt = (size_t)F.bid * NTHR + F.tid, NGT = (size_t)F.G * NTHR;
    float* rope = (float*)(a->ws + WS_ROPE);
    for (size_t i = gt; i < (size_t)SEQ * 8; i += NGT) { const int t = (int)(i >> 3), f = (int)(i & 7);
        const float invt[8] = {1.0f, 0.19392274f, 0.03760603f, 0.0072926646f, 0.0014142136f, 0.0002742482f, 5.3182957e-05f, 1.0313385e-05f};
        float inv = invt[0];
#pragma unroll
        for (int q = 1; q < 8; ++q) inv = (f == q) ? invt[q] : inv;
        const float ang = (float)t * inv;
        const double rev = (double)ang * 0.15915494309189535; const float fr = (float)(rev - __builtin_rint(rev));
        rope[t * 16 + f] = __builtin_amdgcn_cosf(fr); rope[t * 16 + 8 + f] = __builtin_amdgcn_sinf(fr); }
    const f32x4* x4 = (const f32x4*)a->in[0]; u32x4* xb = (u32x4*)(a->ws + WS_XB);
    for (size_t i = gt; i < (size_t)T * DM / 8; i += NGT) { const f32x4 v0 = x4[2 * i], v1 = x4[2 * i + 1];
        u32x4 w; w.x = pk2(v0[0], v0[1]); w.y = pk2(v0[2], v0[3]); w.z = pk2(v1[0], v1[1]); w.w = pk2(v1[2], v1[3]); xb[i] = w; }
}

template <bool DRY>
__device__ __forceinline__ void phase_ln1_router(const Frame& F, ArgsP a, int l) {
    float* X1 = (float*)(a->ws + WS_X1); bf16* XB = (bf16*)(a->ws + WS_XB);
    const float* WR = (const float*)(a->ws + WS_WL + WL_WR);
    const float* lw = a->in[14] + (size_t)l * DM; const float* lb = a->in[15] + (size_t)l * DM;
    const float* bg = a->in[19] + l * 4; const float* be = a->in[21] + l * NEXP;
    int* route_e = (int*)(a->ws + WS_SLOT + SL_RE); int* route_p = (int*)(a->ws + WS_SLOT + SL_RP); float* route_w = (float*)(a->ws + WS_SLOT + SL_RW);
    unsigned* cnt = F.ctl + CW_CNT + (DRY ? l + 4 : l) * 512;
    const int gw = F.bid * NWAVES + F.wave, NGW = F.G * NWAVES, lane = F.lane;
    const float mybias = lane < 4 ? bg[lane] : (lane < 36 ? be[lane - 4] : 0.f);
    for (int tg = gw; tg < T / 4; tg += NGW) {
        f32x4 v[4][4];
#pragma unroll
        for (int tk = 0; tk < 4; ++tk) { const f32x4* row = (const f32x4*)(X1 + (size_t)(4 * tg + tk) * DM) + lane;
#pragma unroll
            for (int j = 0; j < 4; ++j) v[tk][j] = row[64 * j]; }
#pragma unroll
        for (int tk = 0; tk < 4; ++tk) {
            float s = 0.f;
#pragma unroll
            for (int j = 0; j < 4; ++j) s += (v[tk][j][0] + v[tk][j][1]) + (v[tk][j][2] + v[tk][j][3]);
            const float mean = wave_sum(s) * (1.f / DM); float q = 0.f;
#pragma unroll
            for (int j = 0; j < 4; ++j) { v[tk][j] = v[tk][j] - mean; q += (v[tk][j][0] * v[tk][j][0] + v[tk][j][1] * v[tk][j][1]) + (v[tk][j][2] * v[tk][j][2] + v[tk][j][3] * v[tk][j][3]); }
            const float rstd = 1.f / sqrtf(wave_sum(q) * (1.f / DM) + LN_EPS);
            f32x4* orow = (f32x4*)(X1 + (size_t)(4 * tg + tk) * DM) + lane; u32x2* brow = (u32x2*)(XB + (size_t)(4 * tg + tk) * DM) + lane;
#pragma unroll
            for (int j = 0; j < 4; ++j) { const f32x4 w4 = ((const f32x4*)lw)[lane + 64 * j], b4 = ((const f32x4*)lb)[lane + 64 * j];
                v[tk][j] = v[tk][j] * rstd * w4 + b4; if (!DRY) orow[64 * j] = v[tk][j];
                u32x2 w; w.x = pk2(v[tk][j][0], v[tk][j][1]); w.y = pk2(v[tk][j][2], v[tk][j][3]); if (!DRY) brow[64 * j] = w; }
        }
        float lg[4] = {0.f, 0.f, 0.f, 0.f};
#pragma unroll 4
        for (int j36 = 0; j36 < 36; ++j36) {
            const f32x4* wr = (const f32x4*)(WR + (size_t)j36 * DM) + lane;
            const f32x4 w0 = wr[0], w1 = wr[64], w2 = wr[128], w3 = wr[192];
#pragma unroll
            for (int tk = 0; tk < 4; ++tk) {
                f32x4 p = v[tk][0] * w0; p = p + v[tk][1] * w1; p = p + v[tk][2] * w2; p = p + v[tk][3] * w3;
                const float d = wave_sum((p[0] + p[1]) + (p[2] + p[3]));
                lg[tk] = (lane == j36) ? d : lg[tk];
            }
        }
        int my_e = 0; float my_w = 0.f;
#pragma unroll
        for (int tk = 0; tk < 4; ++tk) {
            const float lgb = lg[tk] + mybias;
            float gl[4];
#pragma unroll
            for (int i = 0; i < 4; ++i) gl[i] = __int_as_float(__builtin_amdgcn_readlane(__float_as_int(lgb), i));
            int gi = 0; float gm = gl[0];
#pragma unroll
            for (int i = 1; i < 4; ++i) if (gl[i] > gm) { gm = gl[i]; gi = i; }
            float gs = 0.f;
#pragma unroll
            for (int i = 0; i < 4; ++i) gs += __expf(gl[i] - gm);
            const float g_w = 1.f / gs;
            float ev[8];
#pragma unroll
            for (int i = 0; i < 8; ++i) ev[i] = __int_as_float(__builtin_amdgcn_readlane(__float_as_int(lgb), 4 + gi * 8 + i));
            int i1 = 0; float v1 = ev[0];
#pragma unroll
            for (int i = 1; i < 8; ++i) if (ev[i] > v1) { v1 = ev[i]; i1 = i; }
            int i2 = -1; float v2 = -3.0e38f;
#pragma unroll
            for (int i = 0; i < 8; ++i) if (i != i1 && ev[i] > v2) { v2 = ev[i]; i2 = i; }
            const float e2 = __expf(v2 - v1), w1 = g_w / (1.f + e2), w2 = g_w - w1;
            if (lane == 2 * tk) { my_e = gi * 8 + i1; my_w = w1; }
            if (lane == 2 * tk + 1) { my_e = gi * 8 + i2; my_w = w2; }
        }
        if (lane < 8) {
            const unsigned pos = __hip_atomic_fetch_add(cnt + my_e * 16, 1u, __ATOMIC_RELAXED, __HIP_MEMORY_SCOPE_AGENT);
            const size_t si = (size_t)tg * 8 + lane; if (!DRY) { route_e[si] = my_e; route_p[si] = (int)pos; route_w[si] = my_w; }
        }
    }
}

__device__ __forceinline__ void phase_gather(const Frame& F, ArgsP a, int l) {
    LAS int* pstart = (LAS int*)F.lds;
    unsigned* cnt = F.ctl + CW_CNT + l * 512;
    int* meta = (int*)(a->ws + WS_META) + l * 512;
    int* slot_tok = (int*)(a->ws + WS_SLOT + SL_TOK); float* slot_w = (float*)(a->ws + WS_SLOT + SL_W);
    const int* route_e = (const int*)(a->ws + WS_SLOT + SL_RE); const int* route_p = (const int*)(a->ws + WS_SLOT + SL_RP); const float* route_w = (const float*)(a->ws + WS_SLOT + SL_RW);
    if (F.tid < 64) {
        const int c = F.tid < 32 ? (int)__hip_atomic_load(cnt + F.tid * 16, __ATOMIC_RELAXED, __HIP_MEMORY_SCOPE_AGENT) : 0;
        const int pad = (c + 255) & ~255; int inc = pad;
#pragma unroll
        for (int o = 1; o < 64; o <<= 1) { const int t = __shfl_up(inc, o); if (F.lane >= o) inc += t; }
        const int st = inc - pad;
        if (F.tid < 32) { pstart[F.tid] = st;
            if (F.bid == 0) { for (int t = st >> 8; t < (st + pad) >> 8; ++t) meta[64 + t] = F.tid; if (F.tid == 31) meta[0] = (st + pad) >> 8; }
            if ((F.tid % F.G) == F.bid) for (int r = st + c; r < st + pad; ++r) { slot_tok[r] = -1; slot_w[r] = 0.f; }
        }
    }
    __syncthreads();
    const bf16* XB = (const bf16*)(a->ws + WS_XB); bf16* BUF = (bf16*)(a->ws + WS_H);
    const int gw = F.bid * NWAVES + F.wave, NGW = F.G * NWAVES;
    for (int s = gw; s < T * 2; s += NGW) {
        const int e = route_e[s], dest = pstart[e] + route_p[s];
        const u32x4* src = (const u32x4*)(XB + (size_t)(s >> 1) * DM) + F.lane; u32x4* dst = (u32x4*)(BUF + (size_t)dest * DM) + F.lane;
        const u32x4 v0 = src[0], v1 = src[64]; dst[0] = v0; dst[64] = v1;
        if (F.lane == 0) { slot_tok[dest] = s; slot_w[dest] = route_w[s]; }
    }
    __syncthreads();
}

__device__ __forceinline__ void phase_ln2(const Frame& F, ArgsP a, int l) {
    const float* X1 = (const float*)(a->ws + WS_X1); const bf16* Y2 = (const bf16*)(a->ws + WS_Y2); bf16* XB = (bf16*)(a->ws + WS_XB); float* out = a->out;
    const float* lw = a->in[16] + (size_t)l * DM; const float* lb = a->in[17] + (size_t)l * DM;
    const int gw = F.bid * NWAVES + F.wave, NGW = F.G * NWAVES, lane = F.lane;
    for (int t = gw; t < T; t += NGW) {
        const f32x4* row = (const f32x4*)(X1 + (size_t)t * DM) + lane; const u32x2* ya = (const u32x2*)(Y2 + (size_t)(2 * t) * DM) + lane; const u32x2* yb = (const u32x2*)(Y2 + (size_t)(2 * t + 1) * DM) + lane;
        f32x4 v[4]; float s = 0.f;
#pragma unroll
        for (int j = 0; j < 4; ++j) { const f32x4 x = row[64 * j]; const u32x2 p = ya[64 * j], q = yb[64 * j];
            v[j][0] = x[0] * DN_ALPHA + (bf2f(p.x & 0xffffu) + bf2f(q.x & 0xffffu)); v[j][1] = x[1] * DN_ALPHA + (bf2f(p.x >> 16) + bf2f(q.x >> 16));
            v[j][2] = x[2] * DN_ALPHA + (bf2f(p.y & 0xffffu) + bf2f(q.y & 0xffffu)); v[j][3] = x[3] * DN_ALPHA + (bf2f(p.y >> 16) + bf2f(q.y >> 16));
            s += (v[j][0] + v[j][1]) + (v[j][2] + v[j][3]); }
        const float mean = wave_sum(s) * (1.f / DM); float q2 = 0.f;
#pragma unroll
        for (int j = 0; j < 4; ++j) { v[j] = v[j] - mean; q2 += (v[j][0] * v[j][0] + v[j][1] * v[j][1]) + (v[j][2] * v[j][2] + v[j][3] * v[j][3]); }
        const float rstd = 1.f / sqrtf(wave_sum(q2) * (1.f / DM) + LN_EPS);
        f32x4* orow = (f32x4*)(out + (size_t)t * DM) + lane; u32x2* brow = (u32x2*)(XB + (size_t)t * DM) + lane;
#pragma unroll
        for (int j = 0; j < 4; ++j) { const f32x4 w4 = ((const f32x4*)lw)[lane + 64 * j], b4 = ((const f32x4*)lb)[lane + 64 * j];
            const f32x4 o = v[j] * rstd * w4 + b4; orow[64 * j] = o; u32x2 w; w.x = pk2(o[0], o[1]); w.y = pk2(o[2], o[3]); brow[64 * j] = w; }
    }
}

__device__ __forceinline__ int tsw(int row, int col) { return row * 128 + ((((col >> 3) ^ (row >> 1)) & 7) << 4) + ((col & 7) << 1); }
__device__ __forceinline__ f32x4 mfma16(bf16x8 a, bf16x8 b, f32x4 c) { return __builtin_amdgcn_mfma_f32_16x16x32_bf16(a, b, c, 0, 0, 0); }
__device__ __forceinline__ f32x16 mfma32(bf16x8 a, bf16x8 b, f32x16 c) { return __builtin_amdgcn_mfma_f32_32x32x16_bf16(a, b, c, 0, 0, 0); }
__device__ __forceinline__ bf16x8 as_bf16x8(u32x4 v) { return __builtin_bit_cast(bf16x8, v); }

__device__ __forceinline__ void conformer_item(const Frame& F, ArgsP a, int l, int it) {
    const int b = it >> 6, s0 = (it & 63) * 64; const size_t tok0 = (size_t)b * SEQ + s0;
    const bf16* H = (const bf16*)(a->ws + WS_H); bf16* Y = (bf16*)(a->ws + WS_Y);
    LAS bf16* ut = (LAS bf16*)F.lds;
    LAS float* co = (LAS float*)(F.lds + 49152);
    for (int idx = F.tid; idx < 94 * 32; idx += NTHR) {
        const int r = idx >> 5, c8 = (idx & 31) * 8, s = s0 - 30 + r; u32x4 w = {0u, 0u, 0u, 0u};
        if (s >= 0) { const bf16* hp = H + ((size_t)b * SEQ + s) * HLD + 2304 + c8; const u32x4 v = *(const u32x4*)hp, g = *(const u32x4*)(hp + 256);
#pragma unroll
            for (int e = 0; e < 4; ++e) { const float v0 = bf2f(v[e] & 0xffffu) * fsigmoid(bf2f(g[e] & 0xffffu)), v1 = bf2f(v[e] >> 16) * fsigmoid(bf2f(g[e] >> 16)); w[e] = pk2(v0, v1); } }
        *(LAS u32x4*)(ut + r * 256 + c8) = w;
    }
    __syncthreads();
    {
        const int c = F.tid & 255, half = F.tid >> 8; const float* dw = a->in[10] + (size_t)l * 31 * 256 + c; const float bias = a->in[11][l * 256 + c];
        float w[31], ur[62];
#pragma unroll
        for (int k = 0; k < 31; ++k) w[k] = dw[k * 256];
#pragma unroll
        for (int i = 0; i < 62; ++i) ur[i] = bf2f(ut[(32 * half + i) * 256 + c]);
#pragma unroll
        for (int tt = 0; tt < 32; ++tt) { float acc = bias;
#pragma unroll
            for (int k = 0; k < 31; ++k) acc += w[k] * ur[tt + k];
            co[(32 * half + tt) * 256 + c] = acc; }
    }
    __syncthreads();
    {
        const float* lw = a->in[12] + l * 256; const float* lb = a->in[13] + l * 256; const f32x4 w4 = ((const f32x4*)lw)[F.lane], b4 = ((const f32x4*)lb)[F.lane];
#pragma unroll
        for (int i = 0; i < 8; ++i) { const int tl = 8 * F.wave + i; f32x4 v = *(LAS f32x4*)(co + tl * 256 + 4 * F.lane);
            const float mean = wave_sum((v[0] + v[1]) + (v[2] + v[3])) * (1.f / 256.f); v = v - mean;
            const float rstd = 1.f / sqrtf(wave_sum((v[0] * v[0] + v[1] * v[1]) + (v[2] * v[2] + v[3] * v[3])) * (1.f / 256.f) + LN_EPS);
            v = v * rstd * w4 + b4; u32x2 o; o.x = pk2(fsilu(v[0]), fsilu(v[1])); o.y = pk2(fsilu(v[2]), fsilu(v[3]));
            *(u32x2*)(Y + (tok0 + tl) * DM + 768 + 4 * F.lane) = o; }
    }
    __syncthreads();
}

__device__ __forceinline__ void compress_item(const Frame& F, ArgsP a, int it) {
    const int kv = it >> 6, bh = (it >> 2) & 15, b = bh >> 1, hh = bh & 1, i0 = (it & 3) * 64;
    const bf16* H = (const bf16*)(a->ws + WS_H); const bf16* w1t = (const bf16*)(a->ws + WS_WL + WL_W1) + (size_t)kv * 128 * 2048; const bf16* w2t = (const bf16*)(a->ws + WS_WL + WL_W2) + (size_t)kv * 64 * 128;
    const float* bias1 = (const float*)(a->ws + WS_WL + WL_BIAS1) + kv * 128; bf16* outp = (bf16*)(a->ws + (kv ? WS_VC : WS_KC)) + (size_t)bh * 256 * 64;
    LAS bf16* hid = (LAS bf16*)F.lds;
    const int lane = F.lane, li = lane & 15, g = lane >> 4, rt = F.wave & 3, ch = F.wave >> 2;
    const int i = i0 + 16 * rt + li; const bf16* arow = H + (size_t)b * SEQ * HLD + 512 + kv * 128 + hh * 64 + 8 * g;
    const bf16* brow = w1t + (size_t)(64 * ch + li) * 2048 + 8 * g;
    f32x4 acc[4] = {{0.f, 0.f, 0.f, 0.f}, {0.f, 0.f, 0.f, 0.f}, {0.f, 0.f, 0.f, 0.f}, {0.f, 0.f, 0.f, 0.f}};
#pragma unroll 4
    for (int ks = 0; ks < 64; ++ks) {
        int s = 16 * i + (ks >> 1); s = s > SEQ - 1 ? SEQ - 1 : s;
        const bf16x8 af = *(const bf16x8*)(arow + (size_t)s * HLD + (ks & 1) * 32);
#pragma unroll
        for (int nt = 0; nt < 4; ++nt) { const bf16x8 bfr = *(const bf16x8*)(brow + (size_t)nt * 16 * 2048 + ks * 32); acc[nt] = mfma16(af, bfr, acc[nt]); }
    }
#pragma unroll
    for (int nt = 0; nt < 4; ++nt) { const int n = 64 * ch + 16 * nt + li; const float bs = bias1[n];
#pragma unroll
        for (int r = 0; r < 4; ++r) hid[(16 * rt + 4 * g + r) * 136 + n] = (bf16)f2bf(fsilu(acc[nt][r] + bs)); }
    __syncthreads();
    f32x4 o2[2] = {{0.f, 0.f, 0.f, 0.f}, {0.f, 0.f, 0.f, 0.f}};
#pragma unroll
    for (int ks = 0; ks < 4; ++ks) { const bf16x8 af = *(LAS bf16x8*)(hid + (16 * rt + li) * 136 + 32 * ks + 8 * g);
#pragma unroll
        for (int nt = 0; nt < 2; ++nt) { const bf16x8 bfr = *(const bf16x8*)(w2t + (size_t)(32 * ch + 16 * nt + li) * 128 + 32 * ks + 8 * g); o2[nt] = mfma16(af, bfr, o2[nt]); } }
#pragma unroll
    for (int nt = 0; nt < 2; ++nt)
#pragma unroll
        for (int r = 0; r < 4; ++r) { const int io = i0 + 16 * rt + 4 * g + r; outp[(size_t)io * 64 + 32 * ch + 16 * nt + li] = (bf16)(io < 255 ? f2bf(o2[nt][r]) : 0u); }
    __syncthreads();
}

__host__ __device__ constexpr int tri_off(int i) { int s = 0; for (int k = 0; k < i; ++k) s += (k + 3) >> 2; return 4 * s; }
__device__ __forceinline__ int tri_off_rt(int i) { const int m = i - 1, V = (m + 3) >> 2; return i <= 0 ? 0 : 4 * (2 * V * (V - 1) + V * (m - 4 * V + 4)); }

template <int I> struct GdnSolveRow {
    __device__ static __forceinline__ void run(const LAS float* Ap, float (&x)[64]) {
        if constexpr (I < 64) {
            constexpr int off = tri_off(I), nb = (I + 3) >> 2;
            float a0 = x[I];
#pragma unroll
            for (int jb = 0; jb < nb; ++jb) { const f32x4 a4 = *(const LAS f32x4*)(Ap + off + 4 * jb);
#pragma unroll
                for (int jj = 0; jj < 4; ++jj) { if (4 * jb + jj < I) a0 -= a4[jj] * x[4 * jb + jj]; } }
            x[I] = a0;
            if constexpr ((I & 3) == 3) SBAR();
            GdnSolveRow<I + 1>::run(Ap, x);
        }
    }
};

__device__ __forceinline__ void gdn_prep_chunk(const Frame& F, ArgsP a, int l, int ci, LAS unsigned char* wl) {
    int lane_ = F.lane; asm volatile("" : "+v"(lane_));
    const int lane = lane_, li = lane & 15, g = lane >> 4; const int bh = ci >> 6, n = ci & 63, b = bh >> 2, h = bh & 3; const size_t tok0 = (size_t)b * SEQ + 64 * n;
    const bf16* H = (const bf16*)(a->ws + WS_H); const float* side = (const float*)(a->ws + WS_SIDE);
    unsigned char* rec = a->ws + WS_GPREP + (size_t)ci * GCH;
    bf16* R0 = (bf16*)(rec + GC_UT); bf16* R1 = (bf16*)(rec + GC_W); bf16* QKm = (bf16*)(rec + GC_QK); bf16* QD = (bf16*)(rec + GC_QD); bf16* KDT = (bf16*)(rec + GC_KDT); bf16* ZT = (bf16*)(rec + GC_ZT);
    const int pc = (lane & 32) | (((lane & 15) >> 2) << 3) | (((lane >> 4) & 1) << 2) | (lane & 3);
    LAS unsigned char* qt = wl; LAS unsigned char* kt = wl + 8192; LAS float* Ap = (LAS float*)wl;
    const float beta = side[(tok0 + lane) * 32 + 24 + h]; const float av = side[(tok0 + lane) * 32 + 28 + h] + a->in[8][l * 4 + h];
    const float sp = av > 20.f ? av : log1pf(__expf(av)); float gc = -__expf(a->in[7][l * 4 + h]) * sp;
#pragma unroll
    for (int o = 1; o < 64; o <<= 1) { const float t = __shfl_up(gc, o); if (lane >= o) gc += t; }
    const float gl = __shfl(gc, 63); const float eg = __expf(gc), ekd = __expf(gl - gc);
    if (lane == 0) ((float*)(a->ws + WS_GL))[ci] = __expf(gl);
    const float* cw = a->in[6] + (size_t)l * 4 * 768 + h * 64 + lane; float wq[4], wk[4], wv[4];
#pragma unroll
    for (int k = 0; k < 4; ++k) { wq[k] = cw[k * 768]; wk[k] = cw[k * 768 + 256]; wv[k] = cw[k * 768 + 512]; }
    const bf16* hp = H + tok0 * HLD + 1280 + h * 64 + lane; float hq[3], hk[3], hv[3];
#pragma unroll
    for (int j = 0; j < 3; ++j) { const bool ok = (64 * n - 3 + j) >= 0; const bf16* p = hp + (ptrdiff_t)(j - 3) * HLD;
        hq[j] = ok ? bf2f(p[0]) : 0.f; hk[j] = ok ? bf2f(p[256]) : 0.f; hv[j] = ok ? bf2f(p[512]) : 0.f; }
    for (int t8 = 0; t8 < 8; ++t8) {
        unsigned kdp[4];
        const bf16* p = hp + (size_t)(8 * t8) * HLD; bf16* qd8 = QD + (8 * t8) * 64 + pc; bf16* r08 = R0 + (8 * t8) * 64 + lane; bf16* r18 = R1 + (8 * t8) * 64 + lane;
        asm volatile("" : "+v"(p), "+v"(qd8), "+v"(r08), "+v"(r18));
#pragma unroll
        for (int tt = 0; tt < 8; ++tt) { const int t = 8 * t8 + tt;
            const float rq = bf2f(p[0]), rk = bf2f(p[256]), rv = bf2f(p[512]);
            const float cq = wq[0] * hq[0] + wq[1] * hq[1] + wq[2] * hq[2] + wq[3] * rq, ck = wk[0] * hk[0] + wk[1] * hk[1] + wk[2] * hk[2] + wk[3] * rk, cv = wv[0] * hv[0] + wv[1] * hv[1] + wv[2] * hv[2] + wv[3] * rv;
            hq[0] = hq[1]; hq[1] = hq[2]; hq[2] = rq; hk[0] = hk[1]; hk[1] = hk[2]; hk[2] = rk; hv[0] = hv[1]; hv[1] = hv[2]; hv[2] = rv;
            const float qs = fsilu(cq), ks_ = fsilu(ck), vs = fsilu(cv);
            const float qn = qs * __builtin_amdgcn_rsqf(wave_sum(qs * qs) + 1e-6f) * 0.125f, kn = ks_ * __builtin_amdgcn_rsqf(wave_sum(ks_ * ks_) + 1e-6f);
            const float bt = __shfl(beta, t), egt = __shfl(eg, t), ekt = __shfl(ekd, t);
            *(LAS bf16*)(qt + tsw(t, lane)) = (bf16)f2bf(qn); *(LAS bf16*)(kt + tsw(t, lane)) = (bf16)f2bf(kn);
            qd8[tt * 64] = (bf16)f2bf(qn * egt); r08[tt * 64] = (bf16)f2bf(bt * vs); r18[tt * 64] = (bf16)f2bf(bt * egt * kn);
            const unsigned kd = f2bf(kn * ekt); if (tt & 1) kdp[tt >> 1] |= kd << 16; else kdp[tt >> 1] = kd;
            p += HLD; asm volatile("" : "+v"(p)); }
        { const int c0 = (8 * t8) & 31, gg = (c0 & 15) >> 2, hh = c0 >> 4; bf16* kr = KDT + lane * 64 + ((8 * t8) & 32) + 4 * hh;
          u32x2 w0, w1; w0.x = kdp[0]; w0.y = kdp[1]; w1.x = kdp[2]; w1.y = kdp[3]; *(u32x2*)(kr + 8 * gg) = w0; *(u32x2*)(kr + 8 * gg + 8) = w1; }
    }
    {
        const float nwl = a->in[9][l * 64 + lane];
        for (int t8 = 0; t8 < 8; ++t8) { unsigned zp[4];
#pragma unroll
            for (int tt = 0; tt < 8; ++tt) { const unsigned zg = f2bf(fsilu(bf2f(hp[(size_t)(8 * t8 + tt) * HLD + 768])) * nwl); if (tt & 1) zp[tt >> 1] |= zg << 16; else zp[tt >> 1] = zg; }
            u32x4 wz; wz.x = zp[0]; wz.y = zp[1]; wz.z = zp[2]; wz.w = zp[3]; *(u32x4*)(ZT + lane * 64 + 8 * t8) = wz; }
    }
    LDS_WAIT();
    float gcj[4][4];
#pragma unroll
    for (int mt = 0; mt < 4; ++mt)
#pragma unroll
        for (int r = 0; r < 4; ++r) gcj[mt][r] = __shfl(gc, 16 * mt + 4 * g + r);
    f32x4 ahold[4][4];
#pragma unroll
    for (int nt = 0; nt < 4; ++nt) {
        const int i = 16 * nt + li; const float gci = __shfl(gc, i), bi = __shfl(beta, i);
        bf16x8 kB[2], qB[2];
#pragma unroll
        for (int ks = 0; ks < 2; ++ks) { kB[ks] = *(LAS bf16x8*)(kt + tsw(i, 32 * ks + 8 * g)); qB[ks] = *(LAS bf16x8*)(qt + tsw(i, 32 * ks + 8 * g)); }
#pragma unroll
        for (int mt = 0; mt < 4; ++mt) {
            u32x2 qw = {0u, 0u};
            if (mt <= nt) {
                const bf16x8 kA0 = *(LAS bf16x8*)(kt + tsw(16 * mt + li, 8 * g)), kA1 = *(LAS bf16x8*)(kt + tsw(16 * mt + li, 32 + 8 * g));
                f32x4 ckk = {0.f, 0.f, 0.f, 0.f}, cqk = {0.f, 0.f, 0.f, 0.f};
                ckk = mfma16(kA0, kB[0], ckk); ckk = mfma16(kA1, kB[1], ckk); cqk = mfma16(kA0, qB[0], cqk); cqk = mfma16(kA1, qB[1], cqk);
                float qv[4];
#pragma unroll
                for (int r = 0; r < 4; ++r) { const int j = 16 * mt + 4 * g + r; const float dec = __expf(fminf(gci - gcj[mt][r], 0.f));
                    ahold[nt][mt][r] = bi * ckk[r] * dec; qv[r] = (j <= i) ? cqk[r] * dec : 0.f; }
                qw.x = pk2(qv[0], qv[1]); qw.y = pk2(qv[2], qv[3]);
            }
            *(u32x2*)(QKm + i * 64 + 32 * (mt >> 1) + 8 * g + 4 * (mt & 1)) = qw;
        }
    }
    LDS_WAIT(); SBAR();
#pragma unroll
    for (int nt = 0; nt < 4; ++nt) { const int i = 16 * nt + li; const int ro = tri_off_rt(i);
#pragma unroll
        for (int mt = 0; mt < 4; ++mt) if (mt <= nt) {
#pragma unroll
            for (int r = 0; r < 4; ++r) { const int j = 16 * mt + 4 * g + r; if (j < i) Ap[ro + j] = ahold[nt][mt][r]; } } }
    VM_WAIT(); LDS_WAIT();
#pragma unroll 1
    for (int pass = 0; pass < 2; ++pass) {
        bf16* Rp = pass ? R1 : R0; float x[64];
#pragma unroll
        for (int i = 0; i < 64; ++i) x[i] = bf2f(Rp[i * 64 + lane]);
        VM_WAIT();
        GdnSolveRow<1>::run(Ap, x);
        if (pass == 0) {
#pragma unroll
            for (int i8 = 0; i8 < 8; ++i8) { u32x4 w; w.x = pk2(x[8 * i8], x[8 * i8 + 1]); w.y = pk2(x[8 * i8 + 2], x[8 * i8 + 3]); w.z = pk2(x[8 * i8 + 4], x[8 * i8 + 5]); w.w = pk2(x[8 * i8 + 6], x[8 * i8 + 7]);
                *(u32x4*)(Rp + lane * 64 + 8 * i8) = w; }
        } else {
#pragma unroll
            for (int i = 0; i < 64; ++i) Rp[i * 64 + pc] = (bf16)f2bf(x[i]);
        }
    }
    LDS_WAIT();
}

__device__ __forceinline__ float row16_sum(float x) {
    x += __int_as_float(__builtin_amdgcn_update_dpp(0, __float_as_int(x), 0xB1, 0xf, 0xf, true));
    x += __int_as_float(__builtin_amdgcn_update_dpp(0, __float_as_int(x), 0x4E, 0xf, 0xf, true));
    x += __int_as_float(__builtin_amdgcn_update_dpp(0, __float_as_int(x), 0x141, 0xf, 0xf, true));
    x += __int_as_float(__builtin_amdgcn_update_dpp(0, __float_as_int(x), 0x140, 0xf, 0xf, true));
    return x;
}
__device__ __forceinline__ bf16x8 scan_frag(const unsigned char* mat, int mt, int ks, int li, int g) { return *(const bf16x8*)(mat + (16 * mt + li) * 128 + (32 * ks + 8 * g) * 2); }
__device__ __forceinline__ bf16x8 pack_c2(f32x4 a, f32x4 b) { u32x4 w; w.x = pk2(a[0], a[1]); w.y = pk2(a[2], a[3]); w.z = pk2(b[0], b[1]); w.w = pk2(b[2], b[3]); return as_bf16x8(w); }
struct ScanFr { bf16x8 W[4][2], KD[4][2]; u32x2 uu[4]; float egl; };
__device__ __forceinline__ void scan_load(ScanFr& f, const unsigned char* rec, float egl_, int dv0, int li, int g) {
#pragma unroll
    for (int mt = 0; mt < 4; ++mt) { f.W[mt][0] = scan_frag(rec + GC_W, mt, 0, li, g); f.W[mt][1] = scan_frag(rec + GC_W, mt, 1, li, g); f.uu[mt] = *(const u32x2*)(rec + GC_UT + (dv0 + li) * 128 + (16 * mt + 4 * g) * 2); }
#pragma unroll
    for (int mt = 0; mt < 4; ++mt) { f.KD[mt][0] = scan_frag(rec + GC_KDT, mt, 0, li, g); f.KD[mt][1] = scan_frag(rec + GC_KDT, mt, 1, li, g); }
    f.egl = egl_;
}
__device__ __forceinline__ void scan_step(const ScanFr& f, f32x4 (&S)[4], unsigned char* rec, int sl, int lane) {
    const bf16x8 Sb0 = pack_c2(S[0], S[1]), Sb1 = pack_c2(S[2], S[3]);
    bf16x8* ss = (bf16x8*)(rec + GC_SS + sl * 2048) + lane; ss[0] = Sb0; ss[64] = Sb1;
    f32x4 vn[4];
#pragma unroll
    for (int mt = 0; mt < 4; ++mt) {
        f32x4 acc = {0.f, 0.f, 0.f, 0.f};
        acc = mfma16(f.W[mt][0], Sb0, acc); acc = mfma16(f.W[mt][1], Sb1, acc);
        vn[mt][0] = bf2f(f.uu[mt].x & 0xffffu) - acc[0]; vn[mt][1] = bf2f(f.uu[mt].x >> 16) - acc[1]; vn[mt][2] = bf2f(f.uu[mt].y & 0xffffu) - acc[2]; vn[mt][3] = bf2f(f.uu[mt].y >> 16) - acc[3];
    }
    const bf16x8 Vb0 = pack_c2(vn[0], vn[1]), Vb1 = pack_c2(vn[2], vn[3]);
    bf16x8* vb = (bf16x8*)(rec + GC_VB + sl * 2048) + lane; vb[0] = Vb0; vb[64] = Vb1;
#pragma unroll
    for (int mt = 0; mt < 4; ++mt) { f32x4 acc = S[mt] * f.egl; acc = mfma16(f.KD[mt][0], Vb0, acc); acc = mfma16(f.KD[mt][1], Vb1, acc); S[mt] = acc; }
}
__device__ __forceinline__ void gdn_scan(const Frame& F, ArgsP a, int l) {
    const int lane = F.lane, li = lane & 15, g = lane >> 4, pr = F.wave >> 2, sl = F.wave & 3; const int bh = F.bid * 2 + pr, dv0 = 16 * sl;
    const float* GL = (const float*)(a->ws + WS_GL) + bh * 64; unsigned char* rec0 = a->ws + WS_GPREP + (size_t)bh * 64 * GCH;
    f32x4 S[4] = {{0.f, 0.f, 0.f, 0.f}, {0.f, 0.f, 0.f, 0.f}, {0.f, 0.f, 0.f, 0.f}, {0.f, 0.f, 0.f, 0.f}};
    ScanFr fa, fb;
    scan_load(fa, rec0, GL[0], dv0, li, g);
    unsigned tch = 0u;
#define SCAN_TOUCH(ptr) do { const void* tp_ = (const void*)(ptr); asm volatile("global_load_dword %0, %1, off" : "+v"(tch) : "v"(tp_) : "memory"); } while (0)
    for (int n = 0; n < 64; n += 2) {
        unsigned char* rn = rec0 + (size_t)n * GCH;
        { const unsigned char* t3 = rec0 + (size_t)(n + 3 < 64 ? n + 3 : 63) * GCH; SCAN_TOUCH(t3 + GC_W + lane * 128); SCAN_TOUCH(t3 + GC_KDT + lane * 128); SCAN_TOUCH(t3 + GC_UT + (dv0 + li) * 128); }
        scan_load(fb, rn + GCH, GL[n + 1], dv0, li, g);
        scan_step(fa, S, rn, sl, lane);
        { const unsigned char* t4 = rec0 + (size_t)(n + 4 < 64 ? n + 4 : 63) * GCH; SCAN_TOUCH(t4 + GC_W + lane * 128); SCAN_TOUCH(t4 + GC_KDT + lane * 128); SCAN_TOUCH(t4 + GC_UT + (dv0 + li) * 128); }
        if (n + 2 < 64) scan_load(fa, rn + 2 * (size_t)GCH, GL[n + 2], dv0, li, g);
        scan_step(fb, S, rn + GCH, sl, lane);
    }
#undef SCAN_TOUCH
    asm volatile("s_waitcnt vmcnt(0)" ::: "memory"); asm volatile("" :: "v"(tch));
}

__device__ __forceinline__ void gdn_out_chunk(const Frame& F, ArgsP a, int ci, LAS unsigned char* wl) {
    int lane_ = F.lane; asm volatile("" : "+v"(lane_)); const int lane = lane_, li = lane & 15, g = lane >> 4; const int bh = ci >> 6, n = ci & 63, b = bh >> 2, h = bh & 3;
    const unsigned char* rec = a->ws + WS_GPREP + (size_t)ci * GCH; bf16* Y = (bf16*)(a->ws + WS_Y);
    bf16x8 QDf[4][2], QKf[4][2];
#pragma unroll
    for (int mt = 0; mt < 4; ++mt) { QDf[mt][0] = scan_frag(rec + GC_QD, mt, 0, li, g); QDf[mt][1] = scan_frag(rec + GC_QD, mt, 1, li, g); QKf[mt][0] = scan_frag(rec + GC_QK, mt, 0, li, g); QKf[mt][1] = scan_frag(rec + GC_QK, mt, 1, li, g); }
    float ssq[4][4];
#pragma unroll
    for (int mt = 0; mt < 4; ++mt)
#pragma unroll
        for (int r = 0; r < 4; ++r) ssq[mt][r] = 0.f;
    f32x4 o[4][4];
#pragma unroll
    for (int sl = 0; sl < 4; ++sl) {
        const bf16x8* ss = (const bf16x8*)(rec + GC_SS + sl * 2048) + lane; const bf16x8* vb = (const bf16x8*)(rec + GC_VB + sl * 2048) + lane;
        const bf16x8 Sb0 = ss[0], Sb1 = ss[64], Vb0 = vb[0], Vb1 = vb[64];
#pragma unroll
        for (int mt = 0; mt < 4; ++mt) {
            f32x4 acc = {0.f, 0.f, 0.f, 0.f};
            acc = mfma16(QDf[mt][0], Sb0, acc); acc = mfma16(QDf[mt][1], Sb1, acc); acc = mfma16(QKf[mt][0], Vb0, acc); acc = mfma16(QKf[mt][1], Vb1, acc);
            o[sl][mt] = acc;
#pragma unroll
            for (int r = 0; r < 4; ++r) ssq[mt][r] += acc[r] * acc[r];
        }
    }
#pragma unroll
    for (int mt = 0; mt < 4; ++mt)
#pragma unroll
        for (int r = 0; r < 4; ++r) ssq[mt][r] = __builtin_amdgcn_rsqf(row16_sum(ssq[mt][r]) * (1.f / 64.f) + 1e-6f);
#pragma unroll
    for (int sl = 0; sl < 4; ++sl)
#pragma unroll
        for (int mt = 0; mt < 4; ++mt) {
            const u32x2 zz = *(const u32x2*)(rec + GC_ZT + (16 * sl + li) * 128 + (16 * mt + 4 * g) * 2);
            const float zf[4] = {bf2f(zz.x & 0xffffu), bf2f(zz.x >> 16), bf2f(zz.y & 0xffffu), bf2f(zz.y >> 16)};
#pragma unroll
            for (int r = 0; r < 4; ++r) *(LAS bf16*)(wl + tsw(16 * mt + 4 * g + r, 16 * sl + li)) = (bf16)f2bf(o[sl][mt][r] * ssq[mt][r] * zf[r]);
        }
    LDS_WAIT();
    bf16* yrow = Y + ((size_t)b * SEQ + 64 * n + lane) * DM + 512 + h * 64;
#pragma unroll
    for (int c = 0; c < 8; ++c) *(u32x4*)(yrow + 8 * c) = *(const LAS u32x4*)(wl + tsw(lane, 8 * c));
    LDS_WAIT();
}

constexpr int AT_K = 0, AT_V = 16384, AT_IMP = 32768, AT_SELM = AT_IMP + 64 * 68 * 4, AT_UNI = AT_SELM + 512;
__device__ __forceinline__ s16x4 tr_read0(unsigned addr) { s16x4 r; asm volatile("ds_read_b64_tr_b16 %0, %1" : "=&v"(r) : "v"(addr) : "memory"); return r; }

struct AttnStage { u32x4 kr, vr; };
__device__ __forceinline__ void at_gload(AttnStage& st, const bf16* Kb, const bf16* Vb, size_t stride, int j, int tid) {
    const int row = tid >> 3, ch = tid & 7; const size_t off = (size_t)(64 * j + row) * stride + 8 * ch;
    st.kr = *(const u32x4*)(Kb + off); st.vr = *(const u32x4*)(Vb + off);
}
__device__ __forceinline__ void at_swrite(const AttnStage& st, LAS unsigned char* lds, int buf, int tid) {
    const int row = tid >> 3, ch = tid & 7; const int o = row * 128 + (((ch ^ (row >> 1)) & 7) << 4);
    *(LAS u32x4*)(lds + AT_K + buf * 8192 + o) = st.kr; *(LAS u32x4*)(lds + AT_V + buf * 8192 + o) = st.vr;
}
__device__ __forceinline__ void at_qk(const LAS unsigned char* Kt, const bf16x8 (&Qf)[4], int r, int hf, f32x16 (&s)[2]) {
    const int swz = (r >> 1) & 7;
#pragma unroll
    for (int kt = 0; kt < 2; ++kt) {
        f32x16 acc;
#pragma unroll
        for (int e = 0; e < 16; ++e) acc[e] = 0.f;
#pragma unroll
        for (int ks = 0; ks < 4; ++ks) { const bf16x8 kf = *(const LAS bf16x8*)(Kt + (32 * kt + r) * 128 + (((2 * ks + hf) ^ swz) << 4)); acc = mfma32(kf, Qf[ks], acc); }
        s[kt] = acc;
    }
}
__device__ __forceinline__ void at_pv(unsigned vbase, const unsigned (&voff)[2][2], const f32x16 (&p)[2], f32x16 (&o)[2]) {
#pragma unroll
    for (int kt = 0; kt < 2; ++kt) {
        s16x4 vr[2][2][2];
#pragma unroll
        for (int s = 0; s < 2; ++s) { const unsigned co = vbase + (unsigned)(4096 * kt + 2048 * s);
            vr[s][0][0] = tr_read0(co + voff[0][0]); vr[s][1][0] = tr_read0(co + voff[1][0]); vr[s][0][1] = tr_read0(co + voff[0][1]); vr[s][1][1] = tr_read0(co + voff[1][1]); }
        bf16x8 pb[2];
#pragma unroll
        for (int s = 0; s < 2; ++s) { u32x4 pw; pw.x = pk2(p[kt][8 * s + 0], p[kt][8 * s + 1]); pw.y = pk2(p[kt][8 * s + 2], p[kt][8 * s + 3]); pw.z = pk2(p[kt][8 * s + 4], p[kt][8 * s + 5]); pw.w = pk2(p[kt][8 * s + 6], p[kt][8 * s + 7]); pb[s] = as_bf16x8(pw); }
        asm volatile("s_waitcnt lgkmcnt(0)" ::: "memory"); SBAR();
#pragma unroll
        for (int s = 0; s < 2; ++s) {
            const s16x4 l0 = vr[s][0][0], h0 = vr[s][1][0], l1 = vr[s][0][1], h1 = vr[s][1][1];
            const bf16x8 v0 = {l0[0], l0[1], l0[2], l0[3], h0[0], h0[1], h0[2], h0[3]}, v1 = {l1[0], l1[1], l1[2], l1[3], h1[0], h1[1], h1[2], h1[3]};
            o[0] = mfma32(v0, pb[s], o[0]); o[1] = mfma32(v1, pb[s], o[1]);
        }
    }
}

struct AttnRow { int r, hf, tt, t, qb, wave; unsigned long long wave_union; float m, lpart; };
template <int MODE>
__device__ __forceinline__ void at_branch(const Frame& F, unsigned long long mask, const bf16* Kb, const bf16* Vb, size_t stride, const bf16x8 (&Qf)[4], AttnRow& R, const unsigned (&voff)[2][2],
                                          f32x16 (&o)[2], float mfin, float invl) {
    LAS unsigned char* lds = F.lds; const int tid = F.tid;
    if (mask == 0ull) return;
    AttnStage st; int buf = 0;
    { const int j0 = __builtin_ctzll(mask); at_gload(st, Kb, Vb, stride, j0, tid); at_swrite(st, lds, 0, tid); }
    __syncthreads();
    while (mask) {
        const int j = __builtin_ctzll(mask); mask &= mask - 1ull; const int jn = mask ? __builtin_ctzll(mask) : -1;
        if (jn >= 0) at_gload(st, Kb, Vb, stride, jn, tid);
        bool work = true;
        if (MODE == 2) work = (R.wave_union >> j) & 1ull;
        if (work) {
            f32x16 s[2]; at_qk(lds + AT_K + buf * 8192, Qf, R.r, R.hf, s);
            int hi = 1000, lo = -1000; bool rowok = true, edge = false;
            if (MODE <= 1) { hi = ((R.t - 31) >> 4) - 64 * j - 4 * R.hf; edge = (64 * j + 63) > ((64 * R.qb + 8 * R.wave - 31) >> 4); }
            if (MODE == 2) { const unsigned long long sm = *(const LAS unsigned long long*)(lds + AT_SELM + 8 * R.tt); rowok = (sm >> j) & 1ull; if (j == R.qb) { hi = R.tt - 4 * R.hf; edge = true; } }
            if (MODE == 3) { if (j == R.qb) { hi = R.tt - 4 * R.hf; edge = true; } if (j == R.qb - 8) { lo = R.tt + 1 - 4 * R.hf; edge = true; } }
            if (MODE == 1) {
                if (edge) {
#pragma unroll
                    for (int kt = 0; kt < 2; ++kt)
#pragma unroll
                        for (int e = 0; e < 16; ++e) { const int cst = 32 * kt + (e & 3) + 8 * (e >> 2); s[kt][e] = (cst <= hi) ? fexp2(s[kt][e] - mfin) * invl : 0.f; }
                } else {
#pragma unroll
                    for (int kt = 0; kt < 2; ++kt)
#pragma unroll
                        for (int e = 0; e < 16; ++e) s[kt][e] = fexp2(s[kt][e] - mfin) * invl;
                }
                LAS float* imp = (LAS float*)(lds + AT_IMP) + R.tt * 68;
#pragma unroll
                for (int kt = 0; kt < 2; ++kt)
#pragma unroll
                    for (int rg = 0; rg < 4; ++rg) {
                        float av = 2.f * (s[kt][4 * rg] + s[kt][4 * rg + 1] + s[kt][4 * rg + 2]) + s[kt][4 * rg + 3], bv = s[kt][4 * rg + 3];
                        av += __shfl_xor(av, 1); av += __shfl_xor(av, 2); bv += __shfl_xor(bv, 1); bv += __shfl_xor(bv, 2);
                        if ((R.r & 3) == 0) { const int jb = 16 * j + 8 * kt + 2 * rg + R.hf; __hip_atomic_fetch_add(imp + jb, av, __ATOMIC_RELAXED, __HIP_MEMORY_SCOPE_WORKGROUP); __hip_atomic_fetch_add(imp + jb + 1, bv, __ATOMIC_RELAXED, __HIP_MEMORY_SCOPE_WORKGROUP); }
                    }
                at_pv((unsigned)(size_t)(lds + AT_V + buf * 8192), voff, s, o);
            } else {
                float tmax = -INFINITY;
                if (edge) {
#pragma unroll
                    for (int kt = 0; kt < 2; ++kt)
#pragma unroll
                        for (int e = 0; e < 16; ++e) { const int cst = 32 * kt + (e & 3) + 8 * (e >> 2); const bool ok = (cst <= hi) && (cst >= lo); s[kt][e] = ok ? s[kt][e] : -INFINITY; }
                }
#pragma unroll
                for (int kt = 0; kt < 2; ++kt)
#pragma unroll
                    for (int e = 0; e < 16; e += 2) tmax = fmaxf(tmax, fmaxf(s[kt][e], s[kt][e + 1]));
                tmax = fmaxf(tmax, __shfl_xor(tmax, 32));
                const float mn = rowok ? fmaxf(R.m, tmax) : R.m, alpha = fexp2(R.m - mn); R.m = mn;
                const float negm = rowok ? -mn : -INFINITY;
                float ps = 0.f;
#pragma unroll
                for (int kt = 0; kt < 2; ++kt)
#pragma unroll
                    for (int e = 0; e < 16; ++e) { s[kt][e] = fexp2(s[kt][e] + negm); ps += s[kt][e]; }
                R.lpart = R.lpart * alpha + ps;
                if (MODE >= 2) {
                    if (__any(alpha < 1.f)) {
#pragma unroll
                        for (int e = 0; e < 16; ++e) { o[0][e] *= alpha; o[1][e] *= alpha; } }
                    at_pv((unsigned)(size_t)(lds + AT_V + buf * 8192), voff, s, o);
                }
            }
        }
        if (jn >= 0) at_swrite(st, lds, buf ^ 1, tid);
        __syncthreads();
        buf ^= 1;
    }
}

__device__ __forceinline__ void attn_item(const Frame& F, ArgsP a, int l, int item) {
    const int qb = 63 - (item >> 4), bh = item & 15, b = bh >> 1, hk = bh & 1; const int lane = F.lane, wave = F.wave;
    const bf16* H = (const bf16*)(a->ws + WS_H); const float* side = (const float*)(a->ws + WS_SIDE); bf16* Y = (bf16*)(a->ws + WS_Y);
    LAS unsigned char* lds = F.lds;
    AttnRow R; R.r = lane & 31; R.hf = lane >> 5; R.tt = 8 * wave + (R.r >> 2); R.t = 64 * qb + R.tt; R.qb = qb; R.wave = wave; R.wave_union = 0ull;
    const int head = hk * 4 + (R.r & 3); const size_t tok = (size_t)b * SEQ + R.t;
    bf16x8 Qf[4];
#pragma unroll
    for (int ks = 0; ks < 4; ++ks) Qf[ks] = *(const bf16x8*)(H + tok * HLD + head * 64 + 16 * ks + 8 * R.hf);
    const float g_cmp = side[tok * 32 + head * 3], g_sel = side[tok * 32 + head * 3 + 1], g_win = side[tok * 32 + head * 3 + 2];
    unsigned voff[2][2];
    { const int li = lane & 15, q = li >> 2, p = li & 3, gi1 = (lane >> 4) & 1;
#pragma unroll
      for (int jh = 0; jh < 2; ++jh)
#pragma unroll
          for (int dt = 0; dt < 2; ++dt) voff[jh][dt] = (unsigned)((8 * jh + 4 * R.hf + q) * 128 + ((((4 * dt + 2 * gi1 + (p >> 1)) ^ (4 * jh + 2 * R.hf + (q >> 1))) & 7) << 4) + (p & 1) * 8); }
    { LAS float* imp = (LAS float*)(lds + AT_IMP) + (8 * wave) * 68; for (int i = lane; i < 8 * 68; i += 64) imp[i] = 0.f; if (F.tid == 0) { *(LAS unsigned*)(lds + AT_UNI) = 0u; *(LAS unsigned*)(lds + AT_UNI + 4) = 0u; } }
    f32x16 ysum[2], o[2];
#pragma unroll
    for (int e = 0; e < 16; ++e) { ysum[0][e] = 0.f; ysum[1][e] = 0.f; o[0][e] = 0.f; o[1][e] = 0.f; }
    {
        const bf16* Kc = (const bf16*)(a->ws + WS_KC) + (size_t)bh * 256 * 64; const bf16* Vc = (const bf16*)(a->ws + WS_VC) + (size_t)bh * 256 * 64;
        const int ntc = (4 * qb + 3 + 63) >> 6; const unsigned long long mc = (ntc >= 64) ? ~0ull : ((1ull << ntc) - 1ull);
        R.m = -1e30f; R.lpart = 0.f;
        at_branch<0>(F, mc, Kc, Vc, 64, Qf, R, voff, o, 0.f, 0.f);
        const float lsum = R.lpart + __shfl_xor(R.lpart, 32); const float invl = 1.f / fmaxf(lsum, 1e-30f);
        at_branch<1>(F, mc, Kc, Vc, 64, Qf, R, voff, o, R.m, invl);
#pragma unroll
        for (int e = 0; e < 16; ++e) { ysum[0][e] = g_cmp * o[0][e]; ysum[1][e] = g_cmp * o[1][e]; o[0][e] = 0.f; o[1][e] = 0.f; }
    }
    LDS_WAIT();
    {
        unsigned long long wu = 0ull;
        for (int qi = 0; qi < 8; ++qi) {
            unsigned long long selm;
            if (qb < 16) selm = (2ull << qb) - 1ull;
            else {
                const float v = ((const LAS float*)(lds + AT_IMP))[(8 * wave + qi) * 68 + lane];
                const bool cand = (lane >= 1) && (lane <= qb - 2); const unsigned key = cand ? __float_as_uint(fmaxf(v, 0.f)) : 0u;
                unsigned thr = 0u;
                for (int bit = 30; bit >= 0; --bit) { const unsigned tr = thr | (1u << bit); const int c = __popcll(__ballot(cand && key >= tr)); if (c >= 13) thr = tr; }
                const unsigned long long gt = __ballot(cand && key > thr), eq = __ballot(cand && key == thr);
                int need = 13 - __popcll(gt); unsigned long long eqs = 0ull, e2 = eq;
                while (need > 0 && e2) { const unsigned long long low = e2 & (~e2 + 1ull); eqs |= low; e2 ^= low; --need; }
                selm = gt | eqs | 1ull | (1ull << qb) | (1ull << (qb - 1));
            }
            if (lane == 0) *(LAS unsigned long long*)(lds + AT_SELM + 8 * (8 * wave + qi)) = selm;
            wu |= selm;
        }
        R.wave_union = wu;
        if (lane == 0) { __hip_atomic_fetch_or((LAS unsigned*)(lds + AT_UNI), (unsigned)wu, __ATOMIC_RELAXED, __HIP_MEMORY_SCOPE_WORKGROUP); __hip_atomic_fetch_or((LAS unsigned*)(lds + AT_UNI + 4), (unsigned)(wu >> 32), __ATOMIC_RELAXED, __HIP_MEMORY_SCOPE_WORKGROUP); }
    }
    __syncthreads();
    const unsigned long long bunion = (unsigned long long)*(const LAS unsigned*)(lds + AT_UNI) | ((unsigned long long)*(const LAS unsigned*)(lds + AT_UNI + 4) << 32);
    const bf16* Hb = H + (size_t)b * SEQ * HLD;
    {
        R.m = -1e30f; R.lpart = 0.f;
        at_branch<2>(F, bunion, Hb + 512 + 2 * 128 + hk * 64, Hb + 512 + 3 * 128 + hk * 64, HLD, Qf, R, voff, o, 0.f, 0.f);
        const float lsum = R.lpart + __shfl_xor(R.lpart, 32); const float sc = g_sel / fmaxf(lsum, 1e-30f);
#pragma unroll
        for (int e = 0; e < 16; ++e) { ysum[0][e] += sc * o[0][e]; ysum[1][e] += sc * o[1][e]; o[0][e] = 0.f; o[1][e] = 0.f; }
    }
    {
        const int lo = qb - 8 > 0 ? qb - 8 : 0; const unsigned long long mw = ((2ull << qb) - 1ull) & ~((1ull << lo) - 1ull);
        R.m = -1e30f; R.lpart = 0.f;
        at_branch<3>(F, mw, Hb + 512 + 4 * 128 + hk * 64, Hb + 512 + 5 * 128 + hk * 64, HLD, Qf, R, voff, o, 0.f, 0.f);
        const float lsum = R.lpart + __shfl_xor(R.lpart, 32); const float sc = g_win / fmaxf(lsum, 1e-30f);
#pragma unroll
        for (int e = 0; e < 16; ++e) { ysum[0][e] += sc * o[0][e]; ysum[1][e] += sc * o[1][e]; }
    }
    bf16* yrow = Y + tok * DM + head * 64 + 4 * R.hf;
#pragma unroll
    for (int dt = 0; dt < 2; ++dt)
#pragma unroll
        for (int rg = 0; rg < 4; ++rg) { u32x2 w; w.x = pk2(ysum[dt][4 * rg], ysum[dt][4 * rg + 1]); w.y = pk2(ysum[dt][4 * rg + 2], ysum[dt][4 * rg + 3]); *(u32x2*)(yrow + 32 * dt + 8 * rg) = w; }
}

__device__ __forceinline__ void phase_mix_a(const Frame& F, ArgsP a, int l) {
    constexpr int N_CMP = 128, N_GDN = 256, N_CONF = 512;
    for (int it = F.bid; it < N_CMP + N_GDN + N_CONF; it += F.G) {
        if (it < N_CMP) compress_item(F, a, it);
        else if (it < N_CMP + N_GDN) { gdn_prep_chunk(F, a, l, (it - N_CMP) * 8 + F.wave, F.lds + F.wave * 16384); __syncthreads(); }
        else conformer_item(F, a, l, it - N_CMP - N_GDN);
    }
}
__device__ __forceinline__ void phase_mix_b(const Frame& F, ArgsP a, int l, int rep) {
    unsigned* q = F.ctl + CW_QUEUE + l * 64 + rep * 32;
    for (;;) {
        if (F.tid == 0) F.MISC[0] = __hip_atomic_fetch_add(q, 1u, __ATOMIC_RELAXED, __HIP_MEMORY_SCOPE_AGENT);
        __syncthreads();
        const int item = (int)F.MISC[0];
        __syncthreads();
        if (item >= 1024) break;
        attn_item(F, a, l, item);
    }
}

#ifndef MK_MULTI
#define MK_MULTI 0
#endif
#ifndef PROBE_REPEAT
#define PROBE_REPEAT 0
#endif
constexpr int N_PHASES = 1 + 10 * NL;
__device__ __forceinline__ Frame make_frame() {
    extern __shared__ __attribute__((aligned(16))) unsigned char lds_raw[];
    Frame F; F.lds = (LAS unsigned char*)lds_raw; F.MISC = (volatile LAS unsigned*)(F.lds + MISC_OFF);
    int tid = threadIdx.x, G = gridDim.x, bid = blockIdx.x; unsigned lb = (unsigned)(size_t)F.lds;
    asm volatile("" : "+v"(tid), "+s"(G), "+s"(bid), "+s"(lb));
    F.lds = (LAS unsigned char*)(size_t)lb; F.MISC = (volatile LAS unsigned*)(F.lds + MISC_OFF);
    F.tid = tid; F.lane = F.tid & 63; F.wave = __builtin_amdgcn_readfirstlane(F.tid >> 6); F.G = G; F.bid = bid;
    F.ctl = (unsigned*)(args_here()->ws + WS_CTL); return F;
}
__device__ __forceinline__ void ph_prologue(int) { const Frame F = make_frame(); phase_prologue(F, args_here()); phase_weights(F, args_here(), 0); }
__device__ __forceinline__ void ph_inproj(int) { const Frame F = make_frame(); unsigned char* ws = args_here()->ws;
    pg8::Gemm g{(const bf16*)(ws + WS_XB), (const bf16*)(ws + WS_WL + WL_WIN), T, DINP, DM}; pg8::StaticOrder S; S.init(T, DINP, F.G, F.bid);
    pg8::EpiInProj E{(bf16*)(ws + WS_H), (float*)(ws + WS_SIDE), (const float*)(ws + WS_ROPE)};
    pg8::gemm_phase<pg8::EpiInProj, pg8::StaticOrder, false>(F.lds, g, S, E, nullptr); }
__device__ __forceinline__ void ph_compress(int l) { const Frame F = make_frame(); for (int it = F.bid; it < 128; it += F.G) compress_item(F, args_here(), it); }
__device__ __forceinline__ void ph_gdnprep(int l) { const Frame F = make_frame(); for (int it = (F.bid + 128) % F.G; it < 256; it += F.G) { gdn_prep_chunk(F, args_here(), l, it * 8 + F.wave, F.lds + F.wave * 16384); __syncthreads(); } }
__device__ __forceinline__ void ph_conformer(int l) { const Frame F = make_frame(); for (int it = F.bid; it < 512; it += F.G) conformer_item(F, args_here(), l, it); }
__device__ __forceinline__ void ph_gdnout(int l) { const Frame F = make_frame(); for (int ci = F.bid * NWAVES + F.wave; ci < 2048; ci += F.G * NWAVES) gdn_out_chunk(F, args_here(), ci, F.lds + F.wave * 8192); }
__device__ __forceinline__ void ph_scan(int l) { const Frame F = make_frame(); if (F.bid < 16) gdn_scan(F, args_here(), l); }
__device__ __forceinline__ void ph_attn(int l, int rep) { const Frame F = make_frame(); phase_mix_b(F, args_here(), l, rep); }
__device__ __forceinline__ void ph_outproj(int l) { const Frame F = make_frame(); ArgsP ap = args_here(); unsigned char* ws = ap->ws;
    pg8::Gemm g{(const bf16*)(ws + WS_Y), (const bf16*)(ws + WS_WL + WL_WOUT), T, DM, DM}; pg8::StaticOrder S; S.init(T, DM, F.G, F.bid);
    pg8::EpiOutProj E{l == 0 ? ap->in[0] : (const float*)ap->out, (float*)(ws + WS_X1), DN_ALPHA};
    pg8::gemm_phase<pg8::EpiOutProj, pg8::StaticOrder, false>(F.lds, g, S, E, nullptr); }
__device__ __forceinline__ void ph_ln1(int l) { const Frame F = make_frame(); phase_ln1_router<false>(F, args_here(), l); }
__device__ __forceinline__ void ph_ln1_dry(int l) { const Frame F = make_frame(); phase_ln1_router<true>(F, args_here(), l); }
__device__ __forceinline__ void ph_gather(int l) { const Frame F = make_frame(); phase_gather(F, args_here(), l); }
__device__ __forceinline__ void ph_moeup(int l) { const Frame F = make_frame(); unsigned char* ws = args_here()->ws;
    pg8::Gemm g{(const bf16*)(ws + WS_H), (const bf16*)(ws + WS_WL + WL_WGU), 0, 0, DM}; pg8::MoeOrder S{(const int*)(ws + WS_META) + l * 512, F.G, F.bid};
    pg8::EpiSwiGLU E{(bf16*)(ws + WS_HID)};
    pg8::gemm_phase<pg8::EpiSwiGLU, pg8::MoeOrder, false>(F.lds, g, S, E, nullptr); }
__device__ __forceinline__ void ph_moedown(int l) { const Frame F = make_frame(); unsigned char* ws = args_here()->ws;
    pg8::Gemm g{(const bf16*)(ws + WS_HID), (const bf16*)(ws + WS_WL + WL_WDN), 0, 0, FF}; pg8::MoeOrder S{(const int*)(ws + WS_META) + l * 512, F.G, F.bid};
    pg8::EpiDown E{(bf16*)(ws + WS_Y2), (const int*)(ws + WS_SLOT + SL_TOK), (const float*)(ws + WS_SLOT + SL_W)};
    pg8::gemm_phase<pg8::EpiDown, pg8::MoeOrder, false>(F.lds, g, S, E, nullptr); }
__device__ __forceinline__ void ph_ln2(int l) { const Frame F = make_frame(); phase_ln2(F, args_here(), l); }
__device__ __forceinline__ void ph_weights(int l) { const Frame F = make_frame(); if (l + 1 < NL) phase_weights(F, args_here(), l + 1); }

__global__ void __launch_bounds__(NTHR, 2) fwd_kernel(Args args) {
    extern __shared__ __attribute__((aligned(16))) unsigned char lds_raw[];
    (void)lds_raw; const Frame F = make_frame();
    if (F.tid < 64) F.MISC[F.tid] = 0u;
    __syncthreads();
    XcdBarrier bar = xcd_barrier_post(F.ctl + CW_BAR, F.MISC + 8);
    const int lo = args_here()->ph_lo, hi = args_here()->ph_hi;
#define IN(k) (lo <= (k) && (k) < hi)
#define SEAM(k) do { if (IN(k) && IN((k) + 1)) { XcdBarrier bb = bar; asm volatile("" : "+s"(bb.bar)); xcd_barrier(bb); } } while (0)
#define RPT(bit, call) do { call; if (PROBE_REPEAT & (1u << (bit))) { XcdBarrier bb = bar; asm volatile("" : "+s"(bb.bar)); xcd_barrier(bb); call; } } while (0)
    if (IN(0)) ph_prologue(0);
    SEAM(0);
    for (int l = 0; l < NL; ++l) {
        const int pb = 1 + 10 * l;
        if (IN(pb + 0)) RPT(0, ph_inproj(l));
        SEAM(pb + 0);
        if (IN(pb + 1)) { RPT(16, ph_compress(l)); RPT(17, ph_gdnprep(l)); RPT(18, ph_conformer(l)); }
        SEAM(pb + 1);
        if (IN(pb + 2)) { RPT(19, ph_scan(l)); ph_attn(l, 0); if (PROBE_REPEAT & (1u << 20)) { XcdBarrier bb = bar; asm volatile("" : "+s"(bb.bar)); xcd_barrier(bb); ph_attn(l, 1); } }
        SEAM(pb + 2);
        if (IN(pb + 3)) RPT(24, ph_gdnout(l));
        SEAM(pb + 3);
        if (IN(pb + 4)) RPT(3, ph_outproj(l));
        SEAM(pb + 4);
        if (IN(pb + 5)) { ph_ln1(l); if (PROBE_REPEAT & (1u << 4)) { XcdBarrier bb = bar; asm volatile("" : "+s"(bb.bar)); xcd_barrier(bb); ph_ln1_dry(l); }
            if (PROBE_REPEAT & (1u << 23)) { for (int rr = 0; rr < 4; ++rr) { XcdBarrier bb = bar; asm volatile("" : "+s"(bb.bar)); xcd_barrier(bb); } } }
        SEAM(pb + 5);
        if (IN(pb + 6)) RPT(5, ph_gather(l));
        SEAM(pb + 6);
        if (IN(pb + 7)) RPT(6, ph_moeup(l));
        SEAM(pb + 7);
        if (IN(pb + 8)) RPT(7, ph_moedown(l));
        SEAM(pb + 8);
        if (IN(pb + 9)) { RPT(22, ph_ln2(l)); RPT(21, ph_weights(l)); }
        SEAM(pb + 9);
    }
#undef RPT
#undef IN
#undef SEAM
}

extern "C" void kernel_launch(void* const* d_in, const int* in_sizes, int n_in, void* d_out, int out_size, void* d_ws, size_t ws_size, hipStream_t stream) {
    static int grid = 0;
    if (grid == 0) {
        if (n_in != 25 || in_sizes[0] != T * DM || out_size != T * DM || ws_size < WS_END) { fprintf(stderr, "kernel_launch: shape/workspace mismatch (n_in %d, in0 %d, out %d, ws %zu < %zu); nothing launched\n", n_in, n_in > 0 ? in_sizes[0] : -1, out_size, ws_size, (size_t)WS_END); grid = -1; return; }
        int dev = 0, cus = 0, per_cu = 0;
        if (hipGetDevice(&dev) != hipSuccess || hipDeviceGetAttribute(&cus, hipDeviceAttributeMultiprocessorCount, dev) != hipSuccess) { grid = -1; return; }
        if (hipFuncSetAttribute((const void*)fwd_kernel, hipFuncAttributeMaxDynamicSharedMemorySize, LDS_BYTES) != hipSuccess) { fprintf(stderr, "kernel_launch: hipFuncSetAttribute failed\n"); grid = -1; return; }
        if (hipOccupancyMaxActiveBlocksPerMultiprocessor(&per_cu, (const void*)fwd_kernel, NTHR, LDS_BYTES) != hipSuccess || per_cu < 1)
            fprintf(stderr, "kernel_launch: note: occupancy query reports %d workgroups per CU\n", per_cu);
        (void)hipGetLastError();
        grid = cus;
        if (grid < 32 || (grid & 7)) { fprintf(stderr, "kernel_launch: unexpected CU count %d\n", cus); }
    }
    if (grid < 0) return;
    if (hipMemsetAsync((char*)d_ws + WS_CTL, 0, CTL_ZERO_BYTES, stream) != hipSuccess) return;
    Args a{};
    for (int i = 0; i < 25; ++i) a.in[i] = (const float*)d_in[i];
    a.out = (float*)d_out; a.ws = (unsigned char*)d_ws;
#if MK_MULTI
    for (int p = 0; p < N_PHASES; ++p) { a.ph_lo = p; a.ph_hi = p + 1; hipLaunchKernelGGL(fwd_kernel, dim3(grid), dim3(NTHR), LDS_BYTES, stream, a); }
#else
    a.ph_lo = 0; a.ph_hi = N_PHASES;
    hipLaunchKernelGGL(fwd_kernel, dim3(grid), dim3(NTHR), LDS_BYTES, stream, a);
#endif
}
```

```cpp
#include <hip/hip_runtime.h>
#include <cstdio>
#include <cstdint>
namespace pg8 {
#define PG8_LAS __attribute__((address_space(3)))
typedef unsigned short bf16_t;
typedef short bf16x8 __attribute__((ext_vector_type(8)));
typedef float f32x4 __attribute__((ext_vector_type(4)));
typedef unsigned u32x4 __attribute__((ext_vector_type(4)));
constexpr int BM = 256, BK = 64, HALF = 128, HTB = HALF * BK * 2  , STAGE_BYTES = 8 * HTB, NXCD = 8, WGM = 8;

__host__ __device__ __forceinline__ int lds_byte(int r, int c) { const int st = (r >> 4) * 2 + (c >> 5), rr = r & 15, cc = c & 31, ob = rr * 64 + cc * 2; return st * 1024 + (ob ^ (((ob >> 9) & 1) << 5)); }
__host__ __device__ __forceinline__ void stage_rc(int b, int& R, int& C) { const int st = b / 1024, sb = b % 1024, swz = sb ^ (((sb >> 9) & 1) << 5); R = (st >> 1) * 16 + swz / 64; C = (st & 1) * 32 + (swz % 64) / 2; }
__host__ __device__ __forceinline__ int perm32(int rho) { const int n = rho >> 4, i = rho & 15; return 8 * (i >> 2) + 4 * n + (i & 3); }

struct Unit { int pm, pn; };
struct Gemm { const bf16_t* A; const bf16_t* Bt; int M, N, K; };

struct StaticOrder {
    int nM, nN, nwg, G, c;
    __host__ __device__ void init(int M, int N, int G_, int c_) { nM = M / BM; nN = N / BM; nwg = nM * nN; G = G_; c = c_; }
    __host__ __device__ bool next(int i, Unit& u) const {
        const long L = (long)i * G + c; if (L >= nwg) return false;
        int wgid = (int)L; { const int q = nwg / NXCD, r = nwg % NXCD, xcd = wgid % NXCD, off = wgid / NXCD; wgid = (xcd < r ? xcd * (q + 1) : r * (q + 1) + (xcd - r) * q) + off; }
        const int nig = WGM * nN, gid = wgid / nig, fm = gid * WGM, gsz = (nM - fm) < WGM ? (nM - fm) : WGM;
        u.pm = fm + ((wgid % nig) % gsz); u.pn = (wgid % nig) / gsz; return true;
    }
    __device__ __forceinline__ void a_ready(const Unit&) const {}
    __device__ __forceinline__ void done(const Unit&) const {}
};

__device__ __forceinline__ unsigned cvt_pk_bf16(float lo, float hi) { unsigned r; asm volatile("v_cvt_pk_bf16_f32 %0, %1, %2" : "=v"(r) : "v"(lo), "v"(hi)); return r; }
__device__ __forceinline__ float fast_sigmoid(float x) { return __builtin_amdgcn_rcpf(1.0f + __builtin_amdgcn_exp2f(-1.44269504089f * x)); }

constexpr int HLD = 2816;
constexpr float QSCALE = 0.125f * 1.44269504089f;

struct EpiInProj {
    static constexpr bool PERM = true, AFTER_DRAIN = false, GATHER = false;
    bf16_t* H; float* side; const float* rope;
    __device__ __forceinline__ void operator()(const f32x4 (&acc)[2][2][4][2], const Unit& u, int wr, int wc, int fr, int fq) const {
        const int row0 = u.pm * BM + wr * 64 + fr; const int pn = u.pn;
        if (pn <= 4) {
#pragma unroll
            for (int ai = 0; ai < 2; ++ai)
#pragma unroll
                for (int m = 0; m < 4; ++m) {
                    const int row = row0 + ai * HALF + m * 16; const float* rp = rope + (size_t)(row & 4095) * 16;
                    const f32x4 c0 = *(const f32x4*)(rp), c1 = *(const f32x4*)(rp + 4), s0 = *(const f32x4*)(rp + 8), s1 = *(const f32x4*)(rp + 12);
#pragma unroll
                    for (int bj = 0; bj < 2; ++bj) {
                        f32x4 v0 = acc[ai][bj][m][0], v1 = acc[ai][bj][m][1];
                        const bool ropeb = (pn < 2) || (bj == 0);
                        if (ropeb) {
                            f32x4 p0, p1;
#pragma unroll
                            for (int e = 0; e < 4; ++e) { p0[e] = __shfl_xor(v0[e], 16); p1[e] = __shfl_xor(v1[e], 16); }
                            if (((wc & 1) == 0) && fq < 2) { const float sg = fq ? 1.f : -1.f; v0 = v0 * c0 + (p0 * s0) * sg; v1 = v1 * c1 + (p1 * s1) * sg; }
                        }
                        if (pn < 2) { v0 = v0 * QSCALE; v1 = v1 * QSCALE; }
                        u32x4 w; w.x = cvt_pk_bf16(v0[0], v0[1]); w.y = cvt_pk_bf16(v0[2], v0[3]); w.z = cvt_pk_bf16(v1[0], v1[1]); w.w = cvt_pk_bf16(v1[2], v1[3]);
                        *(u32x4*)(H + (size_t)row * HLD + pn * BM + bj * HALF + wc * 32 + 8 * fq) = w;
                    }
                }
        } else if (pn < 11) {
#pragma unroll
            for (int ai = 0; ai < 2; ++ai)
#pragma unroll
                for (int m = 0; m < 4; ++m) {
                    const int row = row0 + ai * HALF + m * 16;
#pragma unroll
                    for (int bj = 0; bj < 2; ++bj) {
                        const f32x4 v0 = acc[ai][bj][m][0], v1 = acc[ai][bj][m][1];
                        u32x4 w; w.x = cvt_pk_bf16(v0[0], v0[1]); w.y = cvt_pk_bf16(v0[2], v0[3]); w.z = cvt_pk_bf16(v1[0], v1[1]); w.w = cvt_pk_bf16(v1[2], v1[3]);
                        *(u32x4*)(H + (size_t)row * HLD + pn * BM + bj * HALF + wc * 32 + 8 * fq) = w;
                    }
                }
        } else if (wc == 0) {
#pragma unroll
            for (int ai = 0; ai < 2; ++ai)
#pragma unroll
                for (int m = 0; m < 4; ++m) {
                    const int row = row0 + ai * HALF + m * 16;
                    f32x4 v0 = acc[ai][0][m][0], v1 = acc[ai][0][m][1];
#pragma unroll
                    for (int e = 0; e < 4; ++e) { v0[e] = fast_sigmoid(v0[e]); if (fq < 3) v1[e] = fast_sigmoid(v1[e]); }
                    *(f32x4*)(side + (size_t)row * 32 + 8 * fq) = v0; *(f32x4*)(side + (size_t)row * 32 + 8 * fq + 4) = v1;
                }
        }
    }
};
struct EpiOutProj {
    static constexpr bool PERM = false, AFTER_DRAIN = false, GATHER = false;
    const float* res; float* out; float alpha;
    __device__ __forceinline__ void operator()(const f32x4 (&acc)[2][2][4][2], const Unit& u, int wr, int wc, int fr, int fq) const {
        const int row0 = u.pm * BM + wr * 64 + fr, col0 = u.pn * BM + wc * 32 + 4 * fq;
#pragma unroll
        for (int ai = 0; ai < 2; ++ai)
#pragma unroll
            for (int m = 0; m < 4; ++m) { const size_t off = (size_t)(row0 + ai * HALF + m * 16) * 1024 + col0;
#pragma unroll
                for (int bj = 0; bj < 2; ++bj)
#pragma unroll
                    for (int n = 0; n < 2; ++n) { const f32x4 r = *(const f32x4*)(res + off + bj * HALF + n * 16); *(f32x4*)(out + off + bj * HALF + n * 16) = r * alpha + acc[ai][bj][m][n]; }
                asm volatile("" ::: "memory"); }
    }
};
struct EpiSwiGLU {
    static constexpr bool PERM = true, AFTER_DRAIN = false, GATHER = true;
    bf16_t* hid; const int* rowmap; int rowshift;
    __device__ __forceinline__ void operator()(const f32x4 (&acc)[2][2][4][2], const Unit& u, int wr, int wc, int fr, int fq) const {
        const int row0 = u.pm * BM + wr * 64 + fr, hc0 = (u.pn & 3) * 128 + wc * 16 + 4 * fq;
#pragma unroll
        for (int ai = 0; ai < 2; ++ai)
#pragma unroll
            for (int m = 0; m < 4; ++m) { bf16_t* rowp = hid + (size_t)(row0 + ai * HALF + m * 16) * 512 + hc0;
#pragma unroll
                for (int bj = 0; bj < 2; ++bj) { const f32x4 g = acc[ai][bj][m][0], up = acc[ai][bj][m][1]; f32x4 h;
#pragma unroll
                    for (int e = 0; e < 4; ++e) h[e] = g[e] * fast_sigmoid(g[e]) * up[e];
                    typedef unsigned u32x2 __attribute__((ext_vector_type(2)));
                    u32x2 w; w.x = cvt_pk_bf16(h[0], h[1]); w.y = cvt_pk_bf16(h[2], h[3]);
                    *(u32x2*)(rowp + bj * 64) = w; } }
    }
};
struct EpiDown {
    static constexpr bool PERM = true, AFTER_DRAIN = false, GATHER = false;
    bf16_t* y2; const int* slot_tok; const float* slot_w;
    __device__ __forceinline__ void operator()(const f32x4 (&acc)[2][2][4][2], const Unit& u, int wr, int wc, int fr, int fq) const {
        const int row0 = u.pm * BM + wr * 64 + fr, col0 = (u.pn & 3) * BM + wc * 32 + 8 * fq;
#pragma unroll
        for (int ai = 0; ai < 2; ++ai)
#pragma unroll
            for (int m = 0; m < 4; ++m) { const int row = row0 + ai * HALF + m * 16; const int st = slot_tok[row]; const float sw = slot_w[row];
                if (st >= 0) { bf16_t* rowp = y2 + (size_t)st * 1024 + col0;
#pragma unroll
                    for (int bj = 0; bj < 2; ++bj) { const f32x4 v0 = acc[ai][bj][m][0] * sw, v1 = acc[ai][bj][m][1] * sw;
                        u32x4 w; w.x = cvt_pk_bf16(v0[0], v0[1]); w.y = cvt_pk_bf16(v0[2], v0[3]); w.z = cvt_pk_bf16(v1[0], v1[1]); w.w = cvt_pk_bf16(v1[2], v1[3]);
                        *(u32x4*)(rowp + bj * HALF) = w; } } }
    }
};
struct MoeOrder {
    const int* meta; int G, c;
    __device__ __forceinline__ bool next(int i, Unit& u) const {
        const int per = G >> 3; const int idx = (G & 7) ? (i * G + c) : ((i * 8 + (c & 7)) * per + (c >> 3));
        const int nt = meta[0]; if (idx >= nt * 4) return false;
        const int pm = idx >> 2; u.pm = pm; u.pn = meta[64 + pm] * 4 + (idx & 3); return true;
    }
    __device__ __forceinline__ void a_ready(const Unit&) const {}
    __device__ __forceinline__ void done(const Unit&) const {}
};
template <class Epi, class Sched, bool STAMP = false>
__device__ __forceinline__ void gemm_phase(PG8_LAS unsigned char* lds, const Gemm g, const Sched& S, const Epi& E, unsigned long long* stamps, int tid_in) {
    int tid_ = tid_in; asm volatile("" : "+v"(tid_));
    const int tid = tid_, wid = __builtin_amdgcn_readfirstlane(tid >> 6), lane = tid & 63, wr = wid >> 2, wc = wid & 3, fr = lane & 15, fq = lane >> 4;
    const int K = g.K, nt = K / BK;
    int ts_lo = 0, ts_hi = 0, nts = 0; const unsigned long long rt_entry = STAMP ? (unsigned long long)wall_clock64() : 0ull;
#define PG8_STAMP() do { if (STAMP && wid == 0 && nts < 64) { const unsigned long long _c = (unsigned long long)clock64(); \
        ts_lo = (lane == nts) ? (int)(unsigned)_c : ts_lo; ts_hi = (lane == nts) ? (int)(unsigned)(_c >> 32) : ts_hi; ++nts; } } while (0)
    PG8_STAMP();
    unsigned voffA[2], voffB[2];
#pragma unroll
    for (int i = 0; i < 2; ++i) { int R, C; stage_rc(tid * 16 + i * 8192, R, C); const int Rb = Epi::PERM ? ((R & ~31) + perm32(R & 31)) : R;
        voffA[i] = (unsigned)(R * K + C) * 2u; voffB[i] = (unsigned)(Rb * K + C) * 2u; }
    unsigned offAc[2][2], offAn[2][2];
    PG8_LAS unsigned char* gidx = lds + STAGE_BYTES + (unsigned)wid * 1024u;
#define PG8_IDX_DMA(par, pm_) do { int t2_ = tid; asm volatile("" : "+v"(t2_)); _Pragma("unroll") for (int i_ = 0; i_ < 2; ++i_) { int R_, C_; stage_rc(t2_ * 16 + i_ * 8192, R_, C_); (void)C_; \
        _Pragma("unroll") for (int h_ = 0; h_ < 2; ++h_) __builtin_amdgcn_global_load_lds((const unsigned*)(E.rowmap + (size_t)(pm_) * BM + h_ * HALF + R_), (PG8_LAS unsigned*)(gidx + (par) * 512 + (h_ * 2 + i_) * 256), 4, 0, 0); } } while (0)
#define PG8_IDX_READ(dst, par) do { int t2_ = tid; asm volatile("" : "+v"(t2_)); _Pragma("unroll") for (int i_ = 0; i_ < 2; ++i_) { int R_, C_; stage_rc(t2_ * 16 + i_ * 8192, R_, C_); (void)R_; \
        _Pragma("unroll") for (int h_ = 0; h_ < 2; ++h_) { int r_ = *(const PG8_LAS int*)(gidx + (par) * 512 + (h_ * 2 + i_) * 256 + (t2_ & 63) * 4); r_ = r_ < 0 ? 0 : (r_ >> E.rowshift); dst[h_][i_] = (unsigned)r_ * (unsigned)(K * 2) + (unsigned)C_ * 2u; } } } while (0)
    const size_t kstep = (size_t)(BK * 2);
    const size_t hstep = (size_t)HALF * K * 2;
    const size_t tstep = 2 * hstep;
    const unsigned ldsw = (unsigned)wid * 1024u;
    const int aoff = lds_byte(wr * 64 + fr, fq * 8), boff = lds_byte(wc * 32 + fr, fq * 8);
#define PG8_SA(b, h) (((b) * 2 + (h)) * HTB)
#define PG8_SB(b, h) ((4 + (b) * 2 + (h)) * HTB)
#define PG8_STAGE(bufoff, gbase, voff) do { _Pragma("unroll") for (int _i = 0; _i < 2; ++_i) \
        __builtin_amdgcn_global_load_lds((const unsigned*)((const char*)(gbase) + (voff)[_i]), (PG8_LAS unsigned*)(lds + (bufoff) + ldsw + _i * 8192), 16, 0, 0); } while (0)
#define PG8_STAGE_A(bufoff, kt_, h_, nx_) do { if constexpr (Epi::GATHER) { _Pragma("unroll") for (int _i = 0; _i < 2; ++_i) { const unsigned o_ = (nx_) ? offAn[h_][_i] : offAc[h_][_i]; \
            __builtin_amdgcn_global_load_lds((const unsigned*)((const char*)g.A + (size_t)(kt_) * kstep + o_), (PG8_LAS unsigned*)(lds + (bufoff) + ldsw + _i * 8192), 16, 0, 0); } } \
        else { PG8_STAGE(bufoff, ((nx_) ? nA : cA) + (size_t)(kt_) * kstep + (h_) * hstep, voffA); } } while (0)
#define PG8_LDA(dst, b, h) do { _Pragma("unroll") for (int m = 0; m < 4; ++m) _Pragma("unroll") for (int k = 0; k < 2; ++k) dst[m][k] = *(const PG8_LAS bf16x8*)(lds + PG8_SA(b, h) + aoff + m * 2048 + k * 1024); } while (0)
#define PG8_LDB(dst, b, h) do { _Pragma("unroll") for (int n = 0; n < 2; ++n) _Pragma("unroll") for (int k = 0; k < 2; ++k) dst[n][k] = *(const PG8_LAS bf16x8*)(lds + PG8_SB(b, h) + boff + n * 2048 + k * 1024); } while (0)
#define PG8_MMA(ai, bj, At, Bt) do { __builtin_amdgcn_s_setprio(1); _Pragma("unroll") for (int m = 0; m < 4; ++m) _Pragma("unroll") for (int n = 0; n < 2; ++n) _Pragma("unroll") for (int k = 0; k < 2; ++k) \
        acc[ai][bj][m][n] = __builtin_amdgcn_mfma_f32_16x16x32_bf16(Bt[n][k], At[m][k], acc[ai][bj][m][n], 0, 0, 0); __builtin_amdgcn_s_setprio(0); } while (0)
#define PG8_WAIT_V(n) asm volatile("s_waitcnt vmcnt(" #n ")" ::: "memory")
#define PG8_WAIT_L(n) asm volatile("s_waitcnt lgkmcnt(" #n ")" ::: "memory")
#define PG8_BAR __builtin_amdgcn_s_barrier()
#define PG8_SCHED __builtin_amdgcn_sched_barrier(0)
    Unit cur, nxt; int ui = 0;
    if (!S.next(0, cur)) return;
    f32x4 acc[2][2][4][2];
    float zf_ = 0.f; asm volatile("" : "+v"(zf_));
#pragma unroll
    for (int a = 0; a < 2; ++a)
#pragma unroll
        for (int b = 0; b < 2; ++b)
#pragma unroll
            for (int m = 0; m < 4; ++m)
#pragma unroll
                for (int n = 0; n < 2; ++n) acc[a][b][m][n] = (f32x4){zf_, zf_, zf_, zf_};
    bf16x8 At[4][2], B0[2][2], B1[2][2];
    const char* cA = (const char*)g.A + (size_t)cur.pm * tstep; const char* cB = (const char*)g.Bt + (size_t)cur.pn * tstep;
    S.a_ready(cur);
    if constexpr (Epi::GATHER) { PG8_IDX_DMA(0, cur.pm); asm volatile("s_waitcnt vmcnt(0)" ::: "memory"); PG8_IDX_READ(offAc, 0); asm volatile("s_waitcnt lgkmcnt(0)" ::: "memory"); }
    const char* nA = cA;
    PG8_STAGE(PG8_SB(0, 0), cB, voffB); PG8_STAGE_A(PG8_SA(0, 0), 0, 0, false); PG8_STAGE(PG8_SB(0, 1), cB + hstep, voffB); PG8_STAGE_A(PG8_SA(0, 1), 0, 1, false);
    if (wr == 1) PG8_BAR;
    PG8_WAIT_V(4); PG8_BAR;
    PG8_STAGE(PG8_SB(1, 0), cB + kstep, voffB); PG8_STAGE_A(PG8_SA(1, 0), 1, 0, false); PG8_STAGE(PG8_SB(1, 1), cB + hstep + kstep, voffB);
    PG8_WAIT_V(6); PG8_BAR;
    PG8_STAMP();
    for (;;) {
        const bool has_next = S.next(ui + 1, nxt);
        nA = has_next ? (const char*)g.A + (size_t)nxt.pm * tstep : cA; const char* nB = has_next ? (const char*)g.Bt + (size_t)nxt.pn * tstep : cB;
        if constexpr (Epi::GATHER) { if (has_next) PG8_IDX_DMA((ui + 1) & 1, nxt.pm); }
        for (int t = 0; t < nt; t += 2) {
            const bool last = (t == nt - 2);
            const char* b2 = last ? nB : cB + (size_t)(t + 2) * kstep;
            const char* b3 = b2 + kstep;
            const int kt2 = last ? 0 : t + 2;
            if constexpr (Epi::GATHER) { if (last) { if (has_next) PG8_IDX_READ(offAn, (ui + 1) & 1); else { offAn[0][0] = offAc[0][0]; offAn[0][1] = offAc[0][1]; offAn[1][0] = offAc[1][0]; offAn[1][1] = offAc[1][1]; } } }
            if (last && has_next) S.a_ready(nxt);
            PG8_LDB(B0, 0, 0); PG8_SCHED; PG8_LDA(At, 0, 0); PG8_STAGE_A(PG8_SA(1, 1), t + 1, 1, false);
            PG8_WAIT_L(8); PG8_BAR; PG8_WAIT_L(0); PG8_MMA(0, 0, At, B0); PG8_BAR; PG8_SCHED;
            PG8_LDB(B1, 0, 1); PG8_STAGE(PG8_SB(0, 0), b2, voffB);
            PG8_BAR; PG8_WAIT_L(0); PG8_MMA(0, 1, At, B1); PG8_BAR;
            PG8_LDA(At, 0, 1); PG8_STAGE_A(PG8_SA(0, 0), kt2, 0, last);
            PG8_BAR; PG8_WAIT_L(0); PG8_MMA(1, 0, At, B0); PG8_BAR; PG8_SCHED;
            PG8_STAGE(PG8_SB(0, 1), b2 + hstep, voffB);
            PG8_WAIT_V(6); PG8_BAR; PG8_MMA(1, 1, At, B1); PG8_BAR;
            PG8_LDB(B0, 1, 0); PG8_SCHED; PG8_LDA(At, 1, 0); PG8_STAGE_A(PG8_SA(0, 1), kt2, 1, last);
            PG8_WAIT_L(8); PG8_BAR; PG8_WAIT_L(0); PG8_MMA(0, 0, At, B0); PG8_BAR; PG8_SCHED;
            PG8_LDB(B1, 1, 1); PG8_STAGE(PG8_SB(1, 0), b3, voffB);
            PG8_BAR; PG8_WAIT_L(0); PG8_MMA(0, 1, At, B1); PG8_BAR;
            PG8_LDA(At, 1, 1); PG8_STAGE_A(PG8_SA(1, 0), kt2 + 1, 0, last);
            PG8_BAR; PG8_WAIT_L(0); PG8_MMA(1, 0, At, B0); PG8_BAR; PG8_SCHED;
            PG8_STAGE(PG8_SB(1, 1), b3 + hstep, voffB);
            PG8_WAIT_V(6); PG8_BAR; PG8_MMA(1, 1, At, B1); PG8_BAR;
        }
        PG8_STAMP();
        if constexpr (!Epi::AFTER_DRAIN) { E(acc, cur, wr, wc, fr, fq); S.done(cur); }
        PG8_STAMP();
        if (!has_next) break;
#pragma unroll
        for (int a = 0; a < 2; ++a)
#pragma unroll
            for (int b = 0; b < 2; ++b)
#pragma unroll
                for (int m = 0; m < 4; ++m)
#pragma unroll
                    for (int n = 0; n < 2; ++n) acc[a][b][m][n] = (f32x4){zf_, zf_, zf_, zf_};
        cur = nxt; cA = nA; cB = nB; ++ui;
        if constexpr (Epi::GATHER) { offAc[0][0] = offAn[0][0]; offAc[0][1] = offAn[0][1]; offAc[1][0] = offAn[1][0]; offAc[1][1] = offAn[1][1]; }
    }
    PG8_WAIT_V(0);
    if (wr == 0) PG8_BAR;
    PG8_BAR;
    if constexpr (Epi::AFTER_DRAIN) { E.fused(acc, cur, wr, wc, fr, fq, lds, wid, lane); S.done(cur); }
    PG8_STAMP();
    if (STAMP && wid == 0) { stamps[lane] = lane < nts ? (((unsigned long long)(unsigned)ts_hi << 32) | (unsigned)ts_lo) : 0ull;
        if (lane == 62) stamps[62] = rt_entry; if (lane == 63) stamps[63] = (unsigned long long)wall_clock64(); }
#undef PG8_STAMP
#undef PG8_SA
#undef PG8_SB
#undef PG8_STAGE
#undef PG8_STAGE_A
#undef PG8_IDX_DMA
#undef PG8_IDX_READ
#undef PG8_LDA
#undef PG8_LDB
#undef PG8_MMA
#undef PG8_WAIT_V
#undef PG8_WAIT_L
#undef PG8_BAR
#undef PG8_SCHED
}
}

#ifndef SELFCHECK
#define SELFCHECK 0
#endif
#ifndef PROBE_ATTN_VAR
#define PROBE_ATTN_VAR 0
#endif
constexpr int NB = 8, SEQ = 4096, DM = 1024, NL = 4, T = NB * SEQ;
constexpr int DIN = 2848, DINP = 3072, HLD = pg8::HLD;
constexpr int NEXP = 32, FF = 512, NTILE_MAX = 288;
constexpr float LN_EPS = 1e-5f;
constexpr float DN_ALPHA = 1.6817928305074290f;
constexpr int NWAVES = 8, NTHR = 512;

constexpr size_t MiB = 1u << 20, KiB = 1u << 10;
constexpr size_t WS_CTL = 0, CTL_ZERO_BYTES = 128 * KiB;
constexpr size_t WS_ROPE = 1 * MiB;
constexpr size_t WS_META = 1 * MiB + 512 * KiB;
constexpr size_t WS_GL = WS_META + 16 * KiB;
constexpr size_t WS_WL = 2 * MiB;
constexpr size_t WL_WIN = 0, WL_WOUT = 6 * MiB, WL_WGU = 8 * MiB, WL_WDN = 72 * MiB, WL_W1 = 104 * MiB, WL_W2 = 105 * MiB, WL_BIAS1 = 105 * MiB + 64 * KiB, WL_WR = 105 * MiB + 128 * KiB;
constexpr size_t WS_XB = 108 * MiB;
constexpr size_t WS_X1 = 172 * MiB;
constexpr size_t WS_H = 300 * MiB;
constexpr size_t WS_SIDE = 476 * MiB;
constexpr size_t WS_Y = 480 * MiB;
constexpr size_t WS_GPREP = 544 * MiB;
constexpr size_t WS_Y2 = 672 * MiB;
constexpr size_t WS_HID = 800 * MiB;
constexpr size_t WS_KC = 872 * MiB, WS_VC = WS_KC + 512 * KiB;
constexpr size_t WS_SLOT = 873 * MiB;
constexpr size_t SL_TOK = 0, SL_W = 512 * KiB, SL_RE = 1024 * KiB, SL_RP = 1280 * KiB, SL_RW = 1536 * KiB;
constexpr size_t WS_END = 876 * MiB;
constexpr int GCH = 65536;
constexpr int GC_UT = 0, GC_W = 8192, GC_QK = 16384, GC_QD = 24576, GC_KDT = 32768, GC_ZT = 40960, GC_SS = 49152, GC_VB = 57344;
constexpr int CW_TMO = 0;
constexpr int CW_BAR = 4096;
constexpr int CW_CNT = 8192;
constexpr int CW_QUEUE = 12288;
static_assert((CW_QUEUE + NL * 64) * 4 <= (int)CTL_ZERO_BYTES, "CTL words inside the memset region");

constexpr int SCR_BYTES = 143360;
constexpr int MISC_OFF = SCR_BYTES;
constexpr int LDS_BYTES = 147456;

#define GAS __attribute__((address_space(1)))
#define LAS __attribute__((address_space(3)))
typedef unsigned short bf16;
typedef float f32x4 __attribute__((ext_vector_type(4)));
typedef float f32x2 __attribute__((ext_vector_type(2)));
typedef float f32x16 __attribute__((ext_vector_type(16)));
typedef short bf16x8 __attribute__((ext_vector_type(8)));
typedef short s16x4 __attribute__((ext_vector_type(4)));
typedef unsigned u32x4 __attribute__((ext_vector_type(4)));
typedef unsigned u32x2 __attribute__((ext_vector_type(2)));
#define LDS_WAIT() asm volatile("s_waitcnt lgkmcnt(0)" ::: "memory")
#define VM_WAIT() asm volatile("s_waitcnt vmcnt(0)" ::: "memory")
#define SBAR() __builtin_amdgcn_sched_barrier(0)
__device__ __forceinline__ float bf2f(unsigned b) { return __uint_as_float(b << 16); }
__device__ __forceinline__ unsigned f2bf(float f) { unsigned u = __float_as_uint(f); return (u + 0x7fffu + ((u >> 16) & 1u)) >> 16; }
__device__ __forceinline__ unsigned pk2(float lo, float hi) { return pg8::cvt_pk_bf16(lo, hi); }
__device__ __forceinline__ float row16_sum(float x) {
    x += __int_as_float(__builtin_amdgcn_update_dpp(0, __float_as_int(x), 0xB1, 0xf, 0xf, true));
    x += __int_as_float(__builtin_amdgcn_update_dpp(0, __float_as_int(x), 0x4E, 0xf, 0xf, true));
    x += __int_as_float(__builtin_amdgcn_update_dpp(0, __float_as_int(x), 0x141, 0xf, 0xf, true));
    x += __int_as_float(__builtin_amdgcn_update_dpp(0, __float_as_int(x), 0x140, 0xf, 0xf, true));
    return x;
}
__device__ __forceinline__ float wave_sum(float v) {
    const int r = __float_as_int(row16_sum(v));
    return (__int_as_float(__builtin_amdgcn_readlane(r, 0)) + __int_as_float(__builtin_amdgcn_readlane(r, 16))) + (__int_as_float(__builtin_amdgcn_readlane(r, 32)) + __int_as_float(__builtin_amdgcn_readlane(r, 48)));
}
__device__ __forceinline__ float fsigmoid(float x) { return pg8::fast_sigmoid(x); }
__device__ __forceinline__ float fsilu(float x) { return x * pg8::fast_sigmoid(x); }
__device__ __forceinline__ float fexp2(float x) { return __builtin_amdgcn_exp2f(x); }

#define XB_TMO      128
#define XB_XCNT(j)  (256  + 64 * (j))
#define XB_XSUB(j)  (1280 + 64 * (j))
#define XB_XGEN(j)  (2304 + 64 * (j))
#define XB_TOP      3328
#define XB_TOPGEN   3392
#define XCD_BAR_WORDS 3456
#define XB_SPIN_CAP (1u << 18)
#define LAS __attribute__((address_space(3)))

__device__ __forceinline__ unsigned xb_ld(unsigned* p)              { return __hip_atomic_load(p, __ATOMIC_RELAXED, __HIP_MEMORY_SCOPE_AGENT); }
__device__ __forceinline__ unsigned xb_add(unsigned* p, unsigned v) { return __hip_atomic_fetch_add(p, v, __ATOMIC_RELAXED, __HIP_MEMORY_SCOPE_AGENT); }
__device__ __forceinline__ unsigned xb_xcc_id() { return (unsigned)__builtin_amdgcn_s_getreg((3 << 11) | 20) & 0xFu; }
#define XB_SPIN(cond, bar) do { unsigned _sp = 0; while (cond) { __builtin_amdgcn_s_sleep(1); \
    if ((++_sp & 255u) == 0u) { if (xb_ld(&(bar)[XB_TMO])) break; if (_sp > XB_SPIN_CAP) { atomicAdd(&(bar)[XB_TMO], 1u); break; } } } } while (0)

struct XcdBarrier {
    unsigned* bar; unsigned x;
    volatile LAS unsigned* st;
};

__device__ __forceinline__ XcdBarrier xcd_barrier_post(unsigned* bar, volatile LAS unsigned* st) {
    XcdBarrier b; b.bar = bar; b.x = xb_xcc_id(); b.st = st;
    if (threadIdx.x == 0) (void)xb_add(&bar[XB_XCNT(b.x)], 1u);
    return b;
}
__device__ __forceinline__ void xcd_barrier_complete(unsigned* bar, unsigned x, unsigned& nloc, unsigned& nx) {
    const unsigned G = gridDim.x * gridDim.y * gridDim.z;
    unsigned sum, cnt, mine, sp = 0u;
    for (;;) {
        sum = 0u; cnt = 0u; mine = 0u;
#pragma unroll
        for (unsigned j = 0; j < 16; ++j) { const unsigned c = xb_ld(&bar[XB_XCNT(j)]); sum += c; cnt += (c > 0u) ? 1u : 0u; mine = (j == x) ? c : mine; }
        if (sum == G) break;
        __builtin_amdgcn_s_sleep(1);
        if ((++sp & 255u) == 0u) { if (xb_ld(&bar[XB_TMO])) break; if (sp > XB_SPIN_CAP) { atomicAdd(&bar[XB_TMO], 1u); break; } }
    }
    nloc = mine > 0u ? mine : 1u; nx = cnt > 0u ? cnt : 1u;
}

__device__ __forceinline__ void xcd_barrier(const XcdBarrier& b) {
    asm volatile("s_waitcnt vmcnt(0)" ::: "memory");
    __syncthreads();
    if (threadIdx.x == 0) {
        unsigned* bar = b.bar;
        __builtin_amdgcn_s_waitcnt(0);
        unsigned nloc = b.st[0], nx = b.st[1];
        if (nloc == 0u) { xcd_barrier_complete(bar, b.x, nloc, nx); b.st[0] = nloc; b.st[1] = nx; }
        const unsigned old = xb_add(&bar[XB_XSUB(b.x)], 1u);
        const unsigned gen = old / nloc;
        if (old + 1u == (gen + 1u) * nloc) {
            __builtin_amdgcn_fence(__ATOMIC_RELEASE, "agent");
            asm volatile("s_waitcnt vmcnt(0)" ::: "memory");
            const unsigned og = xb_add(&bar[XB_TOP], 1u);
            const unsigned tg = og / nx;
            if (og + 1u == (tg + 1u) * nx) xb_add(&bar[XB_TOPGEN], 1u);
            else XB_SPIN(xb_ld(&bar[XB_TOPGEN]) == tg, bar);
            __builtin_amdgcn_fence(__ATOMIC_ACQUIRE, "agent");
            xb_add(&bar[XB_XGEN(b.x)], 1u);
            asm volatile("s_waitcnt vmcnt(0)" ::: "memory");
        } else {
            XB_SPIN(xb_ld(&bar[XB_XGEN(b.x)]) == gen, bar);
            __builtin_amdgcn_fence(__ATOMIC_ACQUIRE, "agent");
            asm volatile("s_waitcnt vmcnt(0)" ::: "memory");
        }
    }
    __syncthreads();
}

struct Args { const float* in[25]; float* out; unsigned char* ws; int ph_lo, ph_hi; };
typedef const __attribute__((address_space(4))) Args* ArgsP;
__device__ __forceinline__ ArgsP args_here() { ArgsP p = (ArgsP)__builtin_amdgcn_kernarg_segment_ptr(); asm volatile("" : "+s"(p)); return p; }
struct Frame { LAS unsigned char* lds; volatile LAS unsigned* MISC; unsigned* ctl; int tid, lane, wave, G, bid; };

template <class Src>
__device__ __forceinline__ void tr_item(const Src src, int K, int N, bf16* WT, LAS float* scr, int item, int lane) {
    const int nblk = N >> 5, kb = item / nblk, nb = item - kb * nblk, k0 = kb << 6, n0 = nb << 5;
    float tv[32];
#pragma unroll
    for (int i = 0; i < 32; ++i) tv[i] = src(k0 + 2 * i + (lane >> 5), n0 + (lane & 31));
#pragma unroll
    for (int i = 0; i < 32; ++i) scr[(2 * i + (lane >> 5)) * 33 + (lane & 31)] = tv[i];
    LDS_WAIT();
    const int c = lane & 7;
#pragma unroll
    for (int j = 0; j < 4; ++j) { const int n = (lane >> 3) + 8 * j; const LAS float* s = scr + (8 * c) * 33 + n;
        u32x4 o; o.x = pk2(s[0], s[33]); o.y = pk2(s[66], s[99]); o.z = pk2(s[132], s[165]); o.w = pk2(s[198], s[231]);
        *(u32x4*)(WT + (size_t)(n0 + n) * K + k0 + 8 * c) = o; }
    LDS_WAIT();
}
struct SrcPlain { const float* p; int ld; __device__ __forceinline__ float operator()(int k, int n) const { return p[(size_t)k * ld + n]; } };
struct SrcWin { const float* p;
    __device__ __forceinline__ float operator()(int k, int n) const {
        int c;
        if (n < 1280) c = n; else if (n < 2048) c = n + 24; else if (n < 2304) c = n + 24; else if (n < 2816) c = n + 32;
        else if (n < 2840) c = n - 2816 + 1280; else if (n < 2844) c = n - 2840 + 2328; else if (n < 2848) c = n - 2844 + 2332; else return 0.f;
        return p[(size_t)k * DIN + c]; } };
struct SrcGU { const float* wg; const float* wu;
    __device__ __forceinline__ float operator()(int k, int n) const { const int q = n >> 3, r = n & 7; const ptrdiff_t d = (r < 4) ? (ptrdiff_t)0 : (wu - wg); return wg[d + (ptrdiff_t)k * FF + 4 * q + (r & 3)]; } };

__device__ __forceinline__ void phase_weights(const Frame& F, ArgsP a, int l) {
    unsigned char* wl = a->ws + WS_WL;
    LAS float* scr = (LAS float*)(F.lds + F.wave * 16384);
    const int gw = F.bid * NWAVES + F.wave, NGW = F.G * NWAVES;
    constexpr int I_WIN = 16 * 96, I_WOUT = 16 * 32, I_GU1 = 16 * 32, I_GU = NEXP * I_GU1, I_DN1 = 8 * 32, I_DN = NEXP * I_DN1, I_W1 = 2 * 32 * 4, I_W2 = 2 * 2 * 2, I_WR = 36, I_B1 = 256;
    constexpr int NITEMS = I_WIN + I_WOUT + I_GU + I_DN + I_W1 + I_W2 + I_WR + I_B1;
    for (int it = gw; it < NITEMS; it += NGW) {
        int r = it;
        if (r < I_GU) { const int e = r / I_GU1; SrcGU s{a->in[22] + ((size_t)l * NEXP + e) * DM * FF, a->in[23] + ((size_t)l * NEXP + e) * DM * FF};
            tr_item(s, DM, 1024, (bf16*)(wl + WL_WGU) + (size_t)e * 1024 * DM, scr, r - e * I_GU1, F.lane); continue; } r -= I_GU;
        if (r < I_DN) { const int e = r / I_DN1; SrcPlain s{a->in[24] + ((size_t)l * NEXP + e) * FF * DM, DM};
            tr_item(s, FF, DM, (bf16*)(wl + WL_WDN) + (size_t)e * DM * FF, scr, r - e * I_DN1, F.lane); continue; } r -= I_DN;
        if (r < I_WIN) { SrcWin s{a->in[1] + (size_t)l * DM * DIN}; tr_item(s, DM, DINP, (bf16*)(wl + WL_WIN), scr, r, F.lane); continue; } r -= I_WIN;
        if (r < I_WOUT) { SrcPlain s{a->in[2] + (size_t)l * DM * DM, DM}; tr_item(s, DM, DM, (bf16*)(wl + WL_WOUT), scr, r, F.lane); continue; } r -= I_WOUT;
        if (r < I_W1) { const int kv = r / 128; SrcPlain s{a->in[4] + ((size_t)l * 2 + kv) * 2048 * 128, 128};
            tr_item(s, 2048, 128, (bf16*)(wl + WL_W1) + (size_t)kv * 128 * 2048, scr, r - kv * 128, F.lane); continue; } r -= I_W1;
        if (r < I_W2) { const int kv = r / 4; SrcPlain s{a->in[5] + ((size_t)l * 2 + kv) * 128 * 64, 64};
            tr_item(s, 128, 64, (bf16*)(wl + WL_W2) + (size_t)kv * 64 * 128, scr, r - kv * 4, F.lane); continue; } r -= I_W2;
        if (r < I_WR) {
            float* wr = (float*)(wl + WL_WR) + (size_t)r * DM;
            for (int k = F.lane; k < DM; k += 64) wr[k] = (r < 4) ? a->in[18][((size_t)l * DM + k) * 4 + r] : a->in[20][((size_t)l * DM + k) * NEXP + (r - 4)];
            continue; } r -= I_WR;
        {
            const int kv = r >> 7, n = r & 127; const float* pe = a->in[3] + ((size_t)l * 2 + kv) * 2048; const float* w1 = a->in[4] + ((size_t)l * 2 + kv) * 2048 * 128;
            float s = 0.f; for (int k = F.lane; k < 2048; k += 64) s += pe[k] * w1[(size_t)k * 128 + n];
            s = wave_sum(s); if (F.lane == 0) ((float*)(wl + WL_BIAS1))[r] = s;
        }
    }
}

__device__ __forceinline__ void phase_prologue(const Frame& F, ArgsP a) {
    const size_t gt = (size_t)F.bid * NTHR + F.tid, NGT = (size_t)F.G * NTHR;
    float* rope = (float*)(a->ws + WS_ROPE);
    for (size_t i = gt; i < (size_t)SEQ * 8; i += NGT) { const int t = (int)(i >> 3), f = (int)(i & 7);
        const float invt[8] = {1.0f, 0.19392274f, 0.03760603f, 0.0072926646f, 0.0014142136f, 0.0002742482f, 5.3182957e-05f, 1.0313385e-05f};
        float inv = invt[0];
#pragma unroll
        for (int q = 1; q < 8; ++q) inv = (f == q) ? invt[q] : inv;
        const float ang = (float)t * inv;
        const double rev = (double)ang * 0.15915494309189535; const float fr = (float)(rev - __builtin_rint(rev));
        rope[t * 16 + f] = __builtin_amdgcn_cosf(fr); rope[t * 16 + 8 + f] = __builtin_amdgcn_sinf(fr); }
    const f32x4* x4 = (const f32x4*)a->in[0]; u32x4* xb = (u32x4*)(a->ws + WS_XB);
    for (size_t i = gt; i < (size_t)T * DM / 8; i += NGT) { const f32x4 v0 = x4[2 * i], v1 = x4[2 * i + 1];
        u32x4 w; w.x = pk2(v0[0], v0[1]); w.y = pk2(v0[2], v0[3]); w.z = pk2(v1[0], v1[1]); w.w = pk2(v1[2], v1[3]); xb[i] = w; }
}

template <bool DRY>
__device__ __forceinline__ void phase_ln1_router(const Frame& F, ArgsP a, int l) {
    float* X1 = (float*)(a->ws + WS_X1); bf16* XB = (bf16*)(a->ws + WS_XB);
    const float* WR = (const float*)(a->ws + WS_WL + WL_WR);
    const float* lw = a->in[14] + (size_t)l * DM; const float* lb = a->in[15] + (size_t)l * DM;
    const float* bg = a->in[19] + l * 4; const float* be = a->in[21] + l * NEXP;
    int* route_e = (int*)(a->ws + WS_SLOT + SL_RE); int* route_p = (int*)(a->ws + WS_SLOT + SL_RP); float* route_w = (float*)(a->ws + WS_SLOT + SL_RW);
    unsigned* cnt = F.ctl + CW_CNT + (DRY ? l + 4 : l) * 512;
    const int gw = F.bid * NWAVES + F.wave, NGW = F.G * NWAVES, lane = F.lane;
    LAS float* wgl = (LAS float*)F.lds;
    for (int i = F.tid; i < 4 * DM; i += NTHR) wgl[i] = WR[i];
    __syncthreads();
    const float bg0 = bg[0], bg1 = bg[1], bg2 = bg[2], bg3 = bg[3];
    for (int tg = gw; tg < T / 4; tg += NGW) {
        f32x4 v[4][4];
#pragma unroll
        for (int tk = 0; tk < 4; ++tk) { const f32x4* row = (const f32x4*)(X1 + (size_t)(4 * tg + tk) * DM) + lane;
#pragma unroll
            for (int j = 0; j < 4; ++j) v[tk][j] = row[64 * j]; }
#pragma unroll
        for (int tk = 0; tk < 4; ++tk) {
            float s = 0.f;
#pragma unroll
            for (int j = 0; j < 4; ++j) s += (v[tk][j][0] + v[tk][j][1]) + (v[tk][j][2] + v[tk][j][3]);
            const float mean = wave_sum(s) * (1.f / DM); float q = 0.f;
#pragma unroll
            for (int j = 0; j < 4; ++j) { v[tk][j] = v[tk][j] - mean; q += (v[tk][j][0] * v[tk][j][0] + v[tk][j][1] * v[tk][j][1]) + (v[tk][j][2] * v[tk][j][2] + v[tk][j][3] * v[tk][j][3]); }
            const float rstd = 1.f / sqrtf(wave_sum(q) * (1.f / DM) + LN_EPS);
            f32x4* orow = (f32x4*)(X1 + (size_t)(4 * tg + tk) * DM) + lane; u32x2* brow = (u32x2*)(XB + (size_t)(4 * tg + tk) * DM) + lane;
#pragma unroll
            for (int j = 0; j < 4; ++j) { const f32x4 w4 = ((const f32x4*)lw)[lane + 64 * j], b4 = ((const f32x4*)lb)[lane + 64 * j];
                v[tk][j] = v[tk][j] * rstd * w4 + b4; if (!DRY) orow[64 * j] = v[tk][j];
                u32x2 w; w.x = pk2(v[tk][j][0], v[tk][j][1]); w.y = pk2(v[tk][j][2], v[tk][j][3]); if (!DRY) brow[64 * j] = w; }
        }
        float glg[4][4];
#pragma unroll
        for (int j = 0; j < 4; ++j) { const LAS f32x4* wr = (const LAS f32x4*)(wgl + j * DM) + lane; const f32x4 w0 = wr[0], w1 = wr[64], w2 = wr[128], w3 = wr[192];
#pragma unroll
            for (int tk = 0; tk < 4; ++tk) { f32x4 p = v[tk][0] * w0; p = p + v[tk][1] * w1; p = p + v[tk][2] * w2; p = p + v[tk][3] * w3; glg[tk][j] = wave_sum((p[0] + p[1]) + (p[2] + p[3])); } }
        int my_e = 0; float my_w = 0.f;
#pragma unroll
        for (int tk = 0; tk < 4; ++tk) {
            const float g0 = glg[tk][0] + bg0, g1 = glg[tk][1] + bg1, g2 = glg[tk][2] + bg2, g3 = glg[tk][3] + bg3;
            int gi = 0; float gm = g0; if (g1 > gm) { gm = g1; gi = 1; } if (g2 > gm) { gm = g2; gi = 2; } if (g3 > gm) { gm = g3; gi = 3; }
            gi = __builtin_amdgcn_readfirstlane(gi);
            const float g_w = 1.f / (__expf(g0 - gm) + __expf(g1 - gm) + __expf(g2 - gm) + __expf(g3 - gm));
            const float* wbase = WR + (size_t)(4 + gi * 8) * DM; float ev[8];
#pragma unroll
            for (int i4 = 0; i4 < 2; ++i4) { f32x4 w[4][4];
#pragma unroll
                for (int i = 0; i < 4; ++i) { const f32x4* wr = (const f32x4*)(wbase + (size_t)(4 * i4 + i) * DM) + lane; w[i][0] = wr[0]; w[i][1] = wr[64]; w[i][2] = wr[128]; w[i][3] = wr[192]; }
#pragma unroll
                for (int i = 0; i < 4; ++i) { f32x4 p = v[tk][0] * w[i][0]; p = p + v[tk][1] * w[i][1]; p = p + v[tk][2] * w[i][2]; p = p + v[tk][3] * w[i][3];
                    ev[4 * i4 + i] = wave_sum((p[0] + p[1]) + (p[2] + p[3])) + be[gi * 8 + 4 * i4 + i]; } }
            int i1 = 0; float v1 = ev[0];
#pragma unroll
            for (int i = 1; i < 8; ++i) if (ev[i] > v1) { v1 = ev[i]; i1 = i; }
            int i2 = -1; float v2 = -3.0e38f;
#pragma unroll
            for (int i = 0; i < 8; ++i) if (i != i1 && ev[i] > v2) { v2 = ev[i]; i2 = i; }
            const float e2 = __expf(v2 - v1), w1 = g_w / (1.f + e2), w2 = g_w - w1;
            if (lane == 2 * tk) { my_e = gi * 8 + i1; my_w = w1; }
            if (lane == 2 * tk + 1) { my_e = gi * 8 + i2; my_w = w2; }
        }
        if (lane < 8) {
            const unsigned pos = __hip_atomic_fetch_add(cnt + my_e * 16, 1u, __ATOMIC_RELAXED, __HIP_MEMORY_SCOPE_AGENT);
            const size_t si = (size_t)tg * 8 + lane; if (!DRY) { route_e[si] = my_e; route_p[si] = (int)pos; route_w[si] = my_w; }
        }
    }
    __syncthreads();
}

__device__ __forceinline__ void phase_gather(const Frame& F, ArgsP a, int l) {
    LAS int* pstart = (LAS int*)F.lds;
    unsigned* cnt = F.ctl + CW_CNT + l * 512;
    int* meta = (int*)(a->ws + WS_META) + l * 512;
    int* slot_tok = (int*)(a->ws + WS_SLOT + SL_TOK); float* slot_w = (float*)(a->ws + WS_SLOT + SL_W);
    const int* route_e = (const int*)(a->ws + WS_SLOT + SL_RE); const int* route_p = (const int*)(a->ws + WS_SLOT + SL_RP); const float* route_w = (const float*)(a->ws + WS_SLOT + SL_RW);
    if (F.tid < 64) {
        const int c = F.tid < 32 ? (int)__hip_atomic_load(cnt + F.tid * 16, __ATOMIC_RELAXED, __HIP_MEMORY_SCOPE_AGENT) : 0;
        const int pad = (c + 255) & ~255; int inc = pad;
#pragma unroll
        for (int o = 1; o < 64; o <<= 1) { const int t = __shfl_up(inc, o); if (F.lane >= o) inc += t; }
        const int st = inc - pad;
        if (F.tid < 32) { pstart[F.tid] = st;
            if (F.bid == 0) { for (int t = st >> 8; t < (st + pad) >> 8; ++t) meta[64 + t] = F.tid; if (F.tid == 31) meta[0] = (st + pad) >> 8; }
            if ((F.tid % F.G) == F.bid) for (int r = st + c; r < st + pad; ++r) { slot_tok[r] = -1; slot_w[r] = 0.f; }
        }
    }
    __syncthreads();
    for (int s = F.bid * NTHR + F.tid; s < T * 2; s += F.G * NTHR) {
        const int dest = pstart[route_e[s]] + route_p[s]; slot_tok[dest] = s; slot_w[dest] = route_w[s];
    }
    __syncthreads();
}

__device__ __forceinline__ void phase_ln2(const Frame& F, ArgsP a, int l) {
    const float* X1 = (const float*)(a->ws + WS_X1); const bf16* Y2 = (const bf16*)(a->ws + WS_Y2); bf16* XB = (bf16*)(a->ws + WS_XB); float* out = a->out;
    const float* lw = a->in[16] + (size_t)l * DM; const float* lb = a->in[17] + (size_t)l * DM;
    const int gw = F.bid * NWAVES + F.wave, NGW = F.G * NWAVES, lane = F.lane;
    for (int t = gw; t < T; t += NGW) {
        const f32x4* row = (const f32x4*)(X1 + (size_t)t * DM) + lane; const u32x2* ya = (const u32x2*)(Y2 + (size_t)(2 * t) * DM) + lane; const u32x2* yb = (const u32x2*)(Y2 + (size_t)(2 * t + 1) * DM) + lane;
        f32x4 v[4]; float s = 0.f;
#pragma unroll
        for (int j = 0; j < 4; ++j) { const f32x4 x = row[64 * j]; const u32x2 p = ya[64 * j], q = yb[64 * j];
            v[j][0] = x[0] * DN_ALPHA + (bf2f(p.x & 0xffffu) + bf2f(q.x & 0xffffu)); v[j][1] = x[1] * DN_ALPHA + (bf2f(p.x >> 16) + bf2f(q.x >> 16));
            v[j][2] = x[2] * DN_ALPHA + (bf2f(p.y & 0xffffu) + bf2f(q.y & 0xffffu)); v[j][3] = x[3] * DN_ALPHA + (bf2f(p.y >> 16) + bf2f(q.y >> 16));
            s += (v[j][0] + v[j][1]) + (v[j][2] + v[j][3]); }
        const float mean = wave_sum(s) * (1.f / DM); float q2 = 0.f;
#pragma unroll
        for (int j = 0; j < 4; ++j) { v[j] = v[j] - mean; q2 += (v[j][0] * v[j][0] + v[j][1] * v[j][1]) + (v[j][2] * v[j][2] + v[j][3] * v[j][3]); }
        const float rstd = 1.f / sqrtf(wave_sum(q2) * (1.f / DM) + LN_EPS);
        f32x4* orow = (f32x4*)(out + (size_t)t * DM) + lane; u32x2* brow = (u32x2*)(XB + (size_t)t * DM) + lane;
#pragma unroll
        for (int j = 0; j < 4; ++j) { const f32x4 w4 = ((const f32x4*)lw)[lane + 64 * j], b4 = ((const f32x4*)lb)[lane + 64 * j];
            const f32x4 o = v[j] * rstd * w4 + b4; orow[64 * j] = o; u32x2 w; w.x = pk2(o[0], o[1]); w.y = pk2(o[2], o[3]); brow[64 * j] = w; }
    }
}

__device__ __forceinline__ int tsw(int row, int col) { return row * 128 + ((((col >> 3) ^ (row >> 1)) & 7) << 4) + ((col & 7) << 1); }
__device__ __forceinline__ f32x4 mfma16(bf16x8 a, bf16x8 b, f32x4 c) { return __builtin_amdgcn_mfma_f32_16x16x32_bf16(a, b, c, 0, 0, 0); }
__device__ __forceinline__ f32x16 mfma32(bf16x8 a, bf16x8 b, f32x16 c) { return __builtin_amdgcn_mfma_f32_32x32x16_bf16(a, b, c, 0, 0, 0); }
__device__ __forceinline__ bf16x8 as_bf16x8(u32x4 v) { return __builtin_bit_cast(bf16x8, v); }

__device__ __forceinline__ void conformer_item(const Frame& F, ArgsP a, int l, int it) {
    const int b = it >> 6, s0 = (it & 63) * 64; const size_t tok0 = (size_t)b * SEQ + s0;
    const bf16* H = (const bf16*)(a->ws + WS_H); bf16* Y = (bf16*)(a->ws + WS_Y);
    LAS bf16* ut = (LAS bf16*)F.lds;
    LAS float* co = (LAS float*)(F.lds + 49152);
    for (int idx = F.tid; idx < 94 * 32; idx += NTHR) {
        const int r = idx >> 5, c8 = (idx & 31) * 8, s = s0 - 30 + r; u32x4 w = {0u, 0u, 0u, 0u};
        if (s >= 0) { const bf16* hp = H + ((size_t)b * SEQ + s) * HLD + 2304 + c8; const u32x4 v = *(const u32x4*)hp, g = *(const u32x4*)(hp + 256);
#pragma unroll
            for (int e = 0; e < 4; ++e) { const float v0 = bf2f(v[e] & 0xffffu) * fsigmoid(bf2f(g[e] & 0xffffu)), v1 = bf2f(v[e] >> 16) * fsigmoid(bf2f(g[e] >> 16)); w[e] = pk2(v0, v1); } }
        *(LAS u32x4*)(ut + r * 256 + c8) = w;
    }
    __syncthreads();
    {
        const int c = F.tid & 255, half = F.tid >> 8; const float* dw = a->in[10] + (size_t)l * 31 * 256 + c; const float bias = a->in[11][l * 256 + c];
        float w[31], ur[62];
#pragma unroll
        for (int k = 0; k < 31; ++k) w[k] = dw[k * 256];
#pragma unroll
        for (int i = 0; i < 62; ++i) ur[i] = bf2f(ut[(32 * half + i) * 256 + c]);
#pragma unroll
        for (int tt = 0; tt < 32; ++tt) { float acc = bias;
#pragma unroll
            for (int k = 0; k < 31; ++k) acc += w[k] * ur[tt + k];
            co[(32 * half + tt) * 256 + c] = acc; }
    }
    __syncthreads();
    {
        const float* lw = a->in[12] + l * 256; const float* lb = a->in[13] + l * 256; const f32x4 w4 = ((const f32x4*)lw)[F.lane], b4 = ((const f32x4*)lb)[F.lane];
#pragma unroll
        for (int i = 0; i < 8; ++i) { const int tl = 8 * F.wave + i; f32x4 v = *(LAS f32x4*)(co + tl * 256 + 4 * F.lane);
            const float mean = wave_sum((v[0] + v[1]) + (v[2] + v[3])) * (1.f / 256.f); v = v - mean;
            const float rstd = 1.f / sqrtf(wave_sum((v[0] * v[0] + v[1] * v[1]) + (v[2] * v[2] + v[3] * v[3])) * (1.f / 256.f) + LN_EPS);
            v = v * rstd * w4 + b4; u32x2 o; o.x = pk2(fsilu(v[0]), fsilu(v[1])); o.y = pk2(fsilu(v[2]), fsilu(v[3]));
            *(u32x2*)(Y + (tok0 + tl) * DM + 768 + 4 * F.lane) = o; }
    }
    __syncthreads();
}

__device__ __forceinline__ void compress_item(const Frame& F, ArgsP a, int it) {
    const int kv = it >> 7, bh = (it >> 3) & 15, b = bh >> 1, hh = bh & 1, i0 = (it & 7) * 32;
    const bf16* H = (const bf16*)(a->ws + WS_H); const bf16* w1t = (const bf16*)(a->ws + WS_WL + WL_W1) + (size_t)kv * 128 * 2048; const bf16* w2t = (const bf16*)(a->ws + WS_WL + WL_W2) + (size_t)kv * 64 * 128;
    const float* bias1 = (const float*)(a->ws + WS_WL + WL_BIAS1) + kv * 128; bf16* outp = (bf16*)(a->ws + (kv ? WS_VC : WS_KC)) + (size_t)bh * 256 * 64;
    LAS bf16* hid = (LAS bf16*)F.lds;
    const int lane = F.lane, li = lane & 15, g = lane >> 4, rt = F.wave & 1, cq = F.wave >> 1;
    const int i = i0 + 16 * rt + li; const bf16* arow = H + (size_t)b * SEQ * HLD + 512 + kv * 128 + hh * 64 + 8 * g;
    const bf16* brow = w1t + (size_t)(32 * cq + li) * 2048 + 8 * g;
    f32x4 acc[2] = {{0.f, 0.f, 0.f, 0.f}, {0.f, 0.f, 0.f, 0.f}};
#pragma unroll 1
    for (int k8 = 0; k8 < 64; k8 += 8) {
        bf16x8 af[8], bfr[8][2];
#pragma unroll
        for (int u = 0; u < 8; ++u) { const int ks = k8 + u; int s = 16 * i + (ks >> 1); s = s > SEQ - 1 ? SEQ - 1 : s;
            af[u] = *(const bf16x8*)(arow + (size_t)s * HLD + (ks & 1) * 32); bfr[u][0] = *(const bf16x8*)(brow + ks * 32); bfr[u][1] = *(const bf16x8*)(brow + (size_t)16 * 2048 + ks * 32); }
#pragma unroll
        for (int u = 0; u < 8; ++u) { acc[0] = mfma16(af[u], bfr[u][0], acc[0]); acc[1] = mfma16(af[u], bfr[u][1], acc[1]); }
    }
#pragma unroll
    for (int nt = 0; nt < 2; ++nt) { const int n = 32 * cq + 16 * nt + li; const float bs = bias1[n];
#pragma unroll
        for (int r = 0; r < 4; ++r) hid[(16 * rt + 4 * g + r) * 136 + n] = (bf16)f2bf(fsilu(acc[nt][r] + bs)); }
    __syncthreads();
    f32x4 o2 = {0.f, 0.f, 0.f, 0.f};
#pragma unroll
    for (int ks = 0; ks < 4; ++ks) { const bf16x8 af = *(LAS bf16x8*)(hid + (16 * rt + li) * 136 + 32 * ks + 8 * g);
        const bf16x8 bfr = *(const bf16x8*)(w2t + (size_t)(16 * cq + li) * 128 + 32 * ks + 8 * g); o2 = mfma16(af, bfr, o2); }
#pragma unroll
    for (int r = 0; r < 4; ++r) { const int io = i0 + 16 * rt + 4 * g + r; outp[(size_t)io * 64 + 16 * cq + li] = (bf16)(io < 255 ? f2bf(o2[r]) : 0u); }
    __syncthreads();
}

__host__ __device__ constexpr int tri_off(int i) { int s = 0; for (int k = 0; k < i; ++k) s += (k + 3) >> 2; return 4 * s; }
__device__ __forceinline__ int tri_off_rt(int i) { const int m = i - 1, V = (m + 3) >> 2; return i <= 0 ? 0 : 4 * (2 * V * (V - 1) + V * (m - 4 * V + 4)); }

template <int I> struct GdnSolveRow {
    __device__ static __forceinline__ void run(const LAS float* Ap, float (&x)[64]) {
        if constexpr (I < 64) {
            constexpr int off = tri_off(I), nb = (I + 3) >> 2;
            float a0 = x[I];
#pragma unroll
            for (int jb = 0; jb < nb; ++jb) { const f32x4 a4 = *(const LAS f32x4*)(Ap + off + 4 * jb);
#pragma unroll
                for (int jj = 0; jj < 4; ++jj) { if (4 * jb + jj < I) a0 -= a4[jj] * x[4 * jb + jj]; } }
            x[I] = a0;
            if constexpr ((I & 3) == 3) SBAR();
            GdnSolveRow<I + 1>::run(Ap, x);
        }
    }
};

__device__ __forceinline__ void gdn_prep_chunk(const Frame& F, ArgsP a, int l, int ci, LAS unsigned char* wl) {
    int lane_ = F.lane; asm volatile("" : "+v"(lane_));
    const int lane = lane_, li = lane & 15, g = lane >> 4; const int bh = ci >> 6, n = ci & 63, b = bh >> 2, h = bh & 3; const size_t tok0 = (size_t)b * SEQ + 64 * n;
    const bf16* H = (const bf16*)(a->ws + WS_H); const float* side = (const float*)(a->ws + WS_SIDE);
    unsigned char* rec = a->ws + WS_GPREP + (size_t)ci * GCH;
    bf16* R0 = (bf16*)(rec + GC_UT); bf16* R1 = (bf16*)(rec + GC_W); bf16* QKm = (bf16*)(rec + GC_QK); bf16* QD = (bf16*)(rec + GC_QD); bf16* KDT = (bf16*)(rec + GC_KDT); bf16* ZT = (bf16*)(rec + GC_ZT);
    const int pc = (lane & 32) | (((lane & 15) >> 2) << 3) | (((lane >> 4) & 1) << 2) | (lane & 3);
    LAS unsigned char* qt = wl; LAS unsigned char* kt = wl + 8192; LAS float* Ap = (LAS float*)wl;
    const float beta = side[(tok0 + lane) * 32 + 24 + h]; const float av = side[(tok0 + lane) * 32 + 28 + h] + a->in[8][l * 4 + h];
    const float sp = av > 20.f ? av : log1pf(__expf(av)); float gc = -__expf(a->in[7][l * 4 + h]) * sp;
#pragma unroll
    for (int o = 1; o < 64; o <<= 1) { const float t = __shfl_up(gc, o); if (lane >= o) gc += t; }
    const float gl = __shfl(gc, 63); const float eg = __expf(gc), ekd = __expf(gl - gc);
    if (lane == 0) ((float*)(a->ws + WS_GL))[ci] = __expf(gl);
    const float* cw = a->in[6] + (size_t)l * 4 * 768 + h * 64 + lane; float wq[4], wk[4], wv[4];
#pragma unroll
    for (int k = 0; k < 4; ++k) { wq[k] = cw[k * 768]; wk[k] = cw[k * 768 + 256]; wv[k] = cw[k * 768 + 512]; }
    const bf16* hp = H + tok0 * HLD + 1280 + h * 64 + lane; float hq[3], hk[3], hv[3];
#pragma unroll
    for (int j = 0; j < 3; ++j) { const bool ok = (64 * n - 3 + j) >= 0; const bf16* p = hp + (ptrdiff_t)(j - 3) * HLD;
        hq[j] = ok ? bf2f(p[0]) : 0.f; hk[j] = ok ? bf2f(p[256]) : 0.f; hv[j] = ok ? bf2f(p[512]) : 0.f; }
    unsigned short ra[8][3], rb[8][3];
#define GDN_LOADBLK(dst, t8_) do { const bf16* pl_ = hp + (size_t)(8 * (t8_)) * HLD; asm volatile("" : "+v"(pl_)); _Pragma("unroll") for (int tt = 0; tt < 8; ++tt) { const bf16* q_ = pl_ + (size_t)tt * HLD; dst[tt][0] = q_[0]; dst[tt][1] = q_[256]; dst[tt][2] = q_[512]; } } while (0)
#define GDN_CONVBLK(src, t8_) do { const int t8 = (t8_); unsigned kdp[4]; \
        bf16* qd8 = QD + (8 * t8) * 64 + pc; bf16* r08 = R0 + (8 * t8) * 64 + lane; bf16* r18 = R1 + (8 * t8) * 64 + lane; asm volatile("" : "+v"(qd8), "+v"(r08), "+v"(r18)); \
        _Pragma("unroll") for (int tt = 0; tt < 8; ++tt) { const int t = 8 * t8 + tt; \
            const float rq = bf2f(src[tt][0]), rk = bf2f(src[tt][1]), rv = bf2f(src[tt][2]); \
            const float cq = wq[0] * hq[0] + wq[1] * hq[1] + wq[2] * hq[2] + wq[3] * rq, ck = wk[0] * hk[0] + wk[1] * hk[1] + wk[2] * hk[2] + wk[3] * rk, cv = wv[0] * hv[0] + wv[1] * hv[1] + wv[2] * hv[2] + wv[3] * rv; \
            hq[0] = hq[1]; hq[1] = hq[2]; hq[2] = rq; hk[0] = hk[1]; hk[1] = hk[2]; hk[2] = rk; hv[0] = hv[1]; hv[1] = hv[2]; hv[2] = rv; \
            const float qs = fsilu(cq), ks_ = fsilu(ck), vs = fsilu(cv); \
            const float qn = qs * __builtin_amdgcn_rsqf(wave_sum(qs * qs) + 1e-6f) * 0.125f, kn = ks_ * __builtin_amdgcn_rsqf(wave_sum(ks_ * ks_) + 1e-6f); \
            const float bt = __int_as_float(__builtin_amdgcn_readlane(__float_as_int(beta), t)), egt = __int_as_float(__builtin_amdgcn_readlane(__float_as_int(eg), t)), ekt = __int_as_float(__builtin_amdgcn_readlane(__float_as_int(ekd), t)); \
            *(LAS bf16*)(qt + tsw(t, lane)) = (bf16)f2bf(qn); *(LAS bf16*)(kt + tsw(t, lane)) = (bf16)f2bf(kn); \
            qd8[tt * 64] = (bf16)f2bf(qn * egt); r08[tt * 64] = (bf16)f2bf(bt * vs); r18[tt * 64] = (bf16)f2bf(bt * egt * kn); \
            const unsigned kd = f2bf(kn * ekt); if (tt & 1) kdp[tt >> 1] |= kd << 16; else kdp[tt >> 1] = kd; } \
        { const int c0 = (8 * t8) & 31, gg = (c0 & 15) >> 2, hh = c0 >> 4; bf16* kr = KDT + lane * 64 + ((8 * t8) & 32) + 4 * hh; \
          u32x2 w0, w1; w0.x = kdp[0]; w0.y = kdp[1]; w1.x = kdp[2]; w1.y = kdp[3]; *(u32x2*)(kr + 8 * gg) = w0; *(u32x2*)(kr + 8 * gg + 8) = w1; } } while (0)
    GDN_LOADBLK(ra, 0);
#pragma unroll 1
    for (int t16 = 0; t16 < 4; ++t16) {
        GDN_LOADBLK(rb, 2 * t16 + 1);
        GDN_CONVBLK(ra, 2 * t16);
        if (t16 < 3) GDN_LOADBLK(ra, 2 * t16 + 2);
        GDN_CONVBLK(rb, 2 * t16 + 1);
    }
#undef GDN_LOADBLK
#undef GDN_CONVBLK
    {
        const float nwl = a->in[9][l * 64 + lane];
        for (int t8 = 0; t8 < 8; ++t8) { unsigned zp[4];
#pragma unroll
            for (int tt = 0; tt < 8; ++tt) { const unsigned zg = f2bf(fsilu(bf2f(hp[(size_t)(8 * t8 + tt) * HLD + 768])) * nwl); if (tt & 1) zp[tt >> 1] |= zg << 16; else zp[tt >> 1] = zg; }
            u32x4 wz; wz.x = zp[0]; wz.y = zp[1]; wz.z = zp[2]; wz.w = zp[3]; *(u32x4*)(ZT + lane * 64 + 8 * t8) = wz; }
    }
    LDS_WAIT();
    float gcj[4][4];
#pragma unroll
    for (int mt = 0; mt < 4; ++mt)
#pragma unroll
        for (int r = 0; r < 4; ++r) gcj[mt][r] = __shfl(gc, 16 * mt + 4 * g + r);
    f32x4 ahold[4][4];
#pragma unroll
    for (int nt = 0; nt < 4; ++nt) {
        const int i = 16 * nt + li; const float gci = __shfl(gc, i), bi = __shfl(beta, i);
        bf16x8 kB[2], qB[2];
#pragma unroll
        for (int ks = 0; ks < 2; ++ks) { kB[ks] = *(LAS bf16x8*)(kt + tsw(i, 32 * ks + 8 * g)); qB[ks] = *(LAS bf16x8*)(qt + tsw(i, 32 * ks + 8 * g)); }
#pragma unroll
        for (int mt = 0; mt < 4; ++mt) {
            u32x2 qw = {0u, 0u};
            if (mt <= nt) {
                const bf16x8 kA0 = *(LAS bf16x8*)(kt + tsw(16 * mt + li, 8 * g)), kA1 = *(LAS bf16x8*)(kt + tsw(16 * mt + li, 32 + 8 * g));
                f32x4 ckk = {0.f, 0.f, 0.f, 0.f}, cqk = {0.f, 0.f, 0.f, 0.f};
                ckk = mfma16(kA0, kB[0], ckk); ckk = mfma16(kA1, kB[1], ckk); cqk = mfma16(kA0, qB[0], cqk); cqk = mfma16(kA1, qB[1], cqk);
                float qv[4];
#pragma unroll
                for (int r = 0; r < 4; ++r) { const int j = 16 * mt + 4 * g + r; const float dec = __expf(fminf(gci - gcj[mt][r], 0.f));
                    ahold[nt][mt][r] = bi * ckk[r] * dec; qv[r] = (j <= i) ? cqk[r] * dec : 0.f; }
                qw.x = pk2(qv[0], qv[1]); qw.y = pk2(qv[2], qv[3]);
            }
            *(u32x2*)(QKm + i * 64 + 32 * (mt >> 1) + 8 * g + 4 * (mt & 1)) = qw;
        }
    }
    LDS_WAIT(); SBAR();
#pragma unroll
    for (int nt = 0; nt < 4; ++nt) { const int i = 16 * nt + li; const int ro = tri_off_rt(i);
#pragma unroll
        for (int mt = 0; mt < 4; ++mt) if (mt <= nt) {
#pragma unroll
            for (int r = 0; r < 4; ++r) { const int j = 16 * mt + 4 * g + r; if (j < i) Ap[ro + j] = ahold[nt][mt][r]; } } }
    VM_WAIT(); LDS_WAIT();
#pragma unroll 1
    for (int pass = 0; pass < 2; ++pass) {
        bf16* Rp = pass ? R1 : R0; float x[64];
#pragma unroll
        for (int i = 0; i < 64; ++i) x[i] = bf2f(Rp[i * 64 + lane]);
        VM_WAIT();
        GdnSolveRow<1>::run(Ap, x);
        if (pass == 0) {
#pragma unroll
            for (int i8 = 0; i8 < 8; ++i8) { u32x4 w; w.x = pk2(x[8 * i8], x[8 * i8 + 1]); w.y = pk2(x[8 * i8 + 2], x[8 * i8 + 3]); w.z = pk2(x[8 * i8 + 4], x[8 * i8 + 5]); w.w = pk2(x[8 * i8 + 6], x[8 * i8 + 7]);
                *(u32x4*)(Rp + lane * 64 + 8 * i8) = w; }
        } else {
#pragma unroll
            for (int i = 0; i < 64; ++i) Rp[i * 64 + pc] = (bf16)f2bf(x[i]);
        }
    }
    LDS_WAIT();
}

__device__ __forceinline__ bf16x8 scan_frag(const unsigned char* mat, int mt, int ks, int li, int g) { return *(const bf16x8*)(mat + (16 * mt + li) * 128 + (32 * ks + 8 * g) * 2); }
__device__ __forceinline__ bf16x8 pack_c2(f32x4 a, f32x4 b) { u32x4 w; w.x = pk2(a[0], a[1]); w.y = pk2(a[2], a[3]); w.z = pk2(b[0], b[1]); w.w = pk2(b[2], b[3]); return as_bf16x8(w); }
struct ScanFr { bf16x8 W[4][2], KD[4][2]; u32x2 uu[4]; float egl; };
__device__ __forceinline__ void scan_load(ScanFr& f, const unsigned char* rec, float egl_, int dv0, int li, int g) {
#pragma unroll
    for (int mt = 0; mt < 4; ++mt) { f.W[mt][0] = scan_frag(rec + GC_W, mt, 0, li, g); f.W[mt][1] = scan_frag(rec + GC_W, mt, 1, li, g); f.uu[mt] = *(const u32x2*)(rec + GC_UT + (dv0 + li) * 128 + (16 * mt + 4 * g) * 2); }
#pragma unroll
    for (int mt = 0; mt < 4; ++mt) { f.KD[mt][0] = scan_frag(rec + GC_KDT, mt, 0, li, g); f.KD[mt][1] = scan_frag(rec + GC_KDT, mt, 1, li, g); }
    f.egl = egl_;
}
__device__ __forceinline__ void scan_step(const ScanFr& f, f32x4 (&S)[4], unsigned char* rec, int sl, int lane) {
    const bf16x8 Sb0 = pack_c2(S[0], S[1]), Sb1 = pack_c2(S[2], S[3]);
    bf16x8* ss = (bf16x8*)(rec + GC_SS + sl * 2048) + lane; ss[0] = Sb0; ss[64] = Sb1;
    f32x4 vn[4];
#pragma unroll
    for (int mt = 0; mt < 4; ++mt) {
        f32x4 acc = {0.f, 0.f, 0.f, 0.f};
        acc = mfma16(f.W[mt][0], Sb0, acc); acc = mfma16(f.W[mt][1], Sb1, acc);
        vn[mt][0] = bf2f(f.uu[mt].x & 0xffffu) - acc[0]; vn[mt][1] = bf2f(f.uu[mt].x >> 16) - acc[1]; vn[mt][2] = bf2f(f.uu[mt].y & 0xffffu) - acc[2]; vn[mt][3] = bf2f(f.uu[mt].y >> 16) - acc[3];
    }
    const bf16x8 Vb0 = pack_c2(vn[0], vn[1]), Vb1 = pack_c2(vn[2], vn[3]);
    bf16x8* vb = (bf16x8*)(rec + GC_VB + sl * 2048) + lane; vb[0] = Vb0; vb[64] = Vb1;
#pragma unroll
    for (int mt = 0; mt < 4; ++mt) { f32x4 acc = S[mt] * f.egl; acc = mfma16(f.KD[mt][0], Vb0, acc); acc = mfma16(f.KD[mt][1], Vb1, acc); S[mt] = acc; }
}
__device__ __forceinline__ void gdn_scan(const Frame& F, ArgsP a, int l) {
    const int lane = F.lane, li = lane & 15, g = lane >> 4, pr = F.wave >> 2, sl = F.wave & 3; const int bh = F.bid * 2 + pr, dv0 = 16 * sl;
    const float* GL = (const float*)(a->ws + WS_GL) + bh * 64; unsigned char* rec0 = a->ws + WS_GPREP + (size_t)bh * 64 * GCH;
    f32x4 S[4] = {{0.f, 0.f, 0.f, 0.f}, {0.f, 0.f, 0.f, 0.f}, {0.f, 0.f, 0.f, 0.f}, {0.f, 0.f, 0.f, 0.f}};
    ScanFr fa, fb;
    scan_load(fa, rec0, GL[0], dv0, li, g);
    unsigned tch = 0u;
#define SCAN_TOUCH(ptr) do { const void* tp_ = (const void*)(ptr); asm volatile("global_load_dword %0, %1, off" : "+v"(tch) : "v"(tp_) : "memory"); } while (0)
    for (int n = 0; n < 64; n += 2) {
        unsigned char* rn = rec0 + (size_t)n * GCH;
        { const unsigned char* t3 = rec0 + (size_t)(n + 3 < 64 ? n + 3 : 63) * GCH; SCAN_TOUCH(t3 + GC_W + lane * 128); SCAN_TOUCH(t3 + GC_KDT + lane * 128); SCAN_TOUCH(t3 + GC_UT + (dv0 + li) * 128); }
        scan_load(fb, rn + GCH, GL[n + 1], dv0, li, g);
        scan_step(fa, S, rn, sl, lane);
        { const unsigned char* t4 = rec0 + (size_t)(n + 4 < 64 ? n + 4 : 63) * GCH; SCAN_TOUCH(t4 + GC_W + lane * 128); SCAN_TOUCH(t4 + GC_KDT + lane * 128); SCAN_TOUCH(t4 + GC_UT + (dv0 + li) * 128); }
        if (n + 2 < 64) scan_load(fa, rn + 2 * (size_t)GCH, GL[n + 2], dv0, li, g);
        scan_step(fb, S, rn + GCH, sl, lane);
    }
#undef SCAN_TOUCH
    asm volatile("s_waitcnt vmcnt(0)" ::: "memory"); asm volatile("" :: "v"(tch));
}

__device__ __forceinline__ void gdn_out_chunk(const Frame& F, ArgsP a, int ci, LAS unsigned char* wl) {
    int lane_ = F.lane; asm volatile("" : "+v"(lane_)); const int lane = lane_, li = lane & 15, g = lane >> 4; const int bh = ci >> 6, n = ci & 63, b = bh >> 2, h = bh & 3;
    const unsigned char* rec = a->ws + WS_GPREP + (size_t)ci * GCH; bf16* Y = (bf16*)(a->ws + WS_Y);
    bf16x8 QDf[4][2], QKf[4][2];
#pragma unroll
    for (int mt = 0; mt < 4; ++mt) { QDf[mt][0] = scan_frag(rec + GC_QD, mt, 0, li, g); QDf[mt][1] = scan_frag(rec + GC_QD, mt, 1, li, g); QKf[mt][0] = scan_frag(rec + GC_QK, mt, 0, li, g); QKf[mt][1] = scan_frag(rec + GC_QK, mt, 1, li, g); }
    float ssq[4][4];
#pragma unroll
    for (int mt = 0; mt < 4; ++mt)
#pragma unroll
        for (int r = 0; r < 4; ++r) ssq[mt][r] = 0.f;
    f32x4 o[4][4];
#pragma unroll
    for (int sl = 0; sl < 4; ++sl) {
        const bf16x8* ss = (const bf16x8*)(rec + GC_SS + sl * 2048) + lane; const bf16x8* vb = (const bf16x8*)(rec + GC_VB + sl * 2048) + lane;
        const bf16x8 Sb0 = ss[0], Sb1 = ss[64], Vb0 = vb[0], Vb1 = vb[64];
#pragma unroll
        for (int mt = 0; mt < 4; ++mt) {
            f32x4 acc = {0.f, 0.f, 0.f, 0.f};
            acc = mfma16(QDf[mt][0], Sb0, acc); acc = mfma16(QDf[mt][1], Sb1, acc); acc = mfma16(QKf[mt][0], Vb0, acc); acc = mfma16(QKf[mt][1], Vb1, acc);
            o[sl][mt] = acc;
#pragma unroll
            for (int r = 0; r < 4; ++r) ssq[mt][r] += acc[r] * acc[r];
        }
    }
#pragma unroll
    for (int mt = 0; mt < 4; ++mt)
#pragma unroll
        for (int r = 0; r < 4; ++r) ssq[mt][r] = __builtin_amdgcn_rsqf(row16_sum(ssq[mt][r]) * (1.f / 64.f) + 1e-6f);
#pragma unroll
    for (int sl = 0; sl < 4; ++sl)
#pragma unroll
        for (int mt = 0; mt < 4; ++mt) {
            const u32x2 zz = *(const u32x2*)(rec + GC_ZT + (16 * sl + li) * 128 + (16 * mt + 4 * g) * 2);
            const float zf[4] = {bf2f(zz.x & 0xffffu), bf2f(zz.x >> 16), bf2f(zz.y & 0xffffu), bf2f(zz.y >> 16)};
#pragma unroll
            for (int r = 0; r < 4; ++r) *(LAS bf16*)(wl + tsw(16 * mt + 4 * g + r, 16 * sl + li)) = (bf16)f2bf(o[sl][mt][r] * ssq[mt][r] * zf[r]);
        }
    LDS_WAIT();
    bf16* yrow = Y + ((size_t)b * SEQ + 64 * n + lane) * DM + 512 + h * 64;
#pragma unroll
    for (int c = 0; c < 8; ++c) *(u32x4*)(yrow + 8 * c) = *(const LAS u32x4*)(wl + tsw(lane, 8 * c));
    LDS_WAIT();
}

constexpr int AT_K = 0, AT_V = 32768, AT_IMP = 65536, AT_SELM = AT_IMP + 64 * 68 * 4, AT_UNI = AT_SELM + 512;
__device__ __forceinline__ s16x4 tr_read0(unsigned addr) { s16x4 r; asm volatile("ds_read_b64_tr_b16 %0, %1" : "=&v"(r) : "v"(addr) : "memory"); return r; }

__device__ __forceinline__ float half_max(float x) { auto rr = __builtin_amdgcn_permlane32_swap(__float_as_uint(x), __float_as_uint(x), false, false); return fmaxf(__uint_as_float(rr[0]), __uint_as_float(rr[1])); }
__device__ __forceinline__ float half_sum(float x) { auto rr = __builtin_amdgcn_permlane32_swap(__float_as_uint(x), __float_as_uint(x), false, false); return __uint_as_float(rr[0]) + __uint_as_float(rr[1]); }
struct AttnStage { u32x4 kr, vr; };
__device__ __forceinline__ void at_gload(AttnStage& st, const bf16* Kb, const bf16* Vb, size_t stride, int j, int tid) {
    const int row = tid >> 3, ch = tid & 7; const size_t off = (size_t)(64 * j + row) * stride + 8 * ch;
    st.kr = *(const u32x4*)(Kb + off); st.vr = *(const u32x4*)(Vb + off);
}
__device__ __forceinline__ void at_swrite(const AttnStage& st, LAS unsigned char* lds, int buf, int tid) {
    const int row = tid >> 3, ch = tid & 7; const int o = row * 128 + (((ch ^ (row >> 1)) & 7) << 4);
    *(LAS u32x4*)(lds + AT_K + buf * 8192 + o) = st.kr; *(LAS u32x4*)(lds + AT_V + buf * 8192 + o) = st.vr;
}
__device__ __forceinline__ void at_qk(const LAS unsigned char* Kt, const bf16x8 (&Qf)[4], int r, int hf, f32x16 (&s)[2]) {
    const int swz = (r >> 1) & 7;
#pragma unroll
    for (int kt = 0; kt < 2; ++kt) {
        f32x16 acc;
#pragma unroll
        for (int e = 0; e < 16; ++e) acc[e] = 0.f;
#pragma unroll
        for (int ks = 0; ks < 4; ++ks) { const bf16x8 kf = *(const LAS bf16x8*)(Kt + (32 * kt + r) * 128 + (((2 * ks + hf) ^ swz) << 4)); acc = mfma32(kf, Qf[ks], acc); }
        s[kt] = acc;
    }
}
__device__ __forceinline__ void at_pv(unsigned vbase, const unsigned (&voff)[2][2], const f32x16 (&p)[2], f32x16 (&o)[2]) {
#pragma unroll
    for (int kt = 0; kt < 2; ++kt) {
        s16x4 vr[2][2][2];
#pragma unroll
        for (int s = 0; s < 2; ++s) { const unsigned co = vbase + (unsigned)(4096 * kt + 2048 * s);
            vr[s][0][0] = tr_read0(co + voff[0][0]); vr[s][1][0] = tr_read0(co + voff[1][0]); vr[s][0][1] = tr_read0(co + voff[0][1]); vr[s][1][1] = tr_read0(co + voff[1][1]); }
        bf16x8 pb[2];
#pragma unroll
        for (int s = 0; s < 2; ++s) { u32x4 pw; pw.x = pk2(p[kt][8 * s + 0], p[kt][8 * s + 1]); pw.y = pk2(p[kt][8 * s + 2], p[kt][8 * s + 3]); pw.z = pk2(p[kt][8 * s + 4], p[kt][8 * s + 5]); pw.w = pk2(p[kt][8 * s + 6], p[kt][8 * s + 7]); pb[s] = as_bf16x8(pw); }
        asm volatile("s_waitcnt lgkmcnt(0)" ::: "memory"); SBAR();
#pragma unroll
        for (int s = 0; s < 2; ++s) {
            const s16x4 l0 = vr[s][0][0], h0 = vr[s][1][0], l1 = vr[s][0][1], h1 = vr[s][1][1];
            const bf16x8 v0 = {l0[0], l0[1], l0[2], l0[3], h0[0], h0[1], h0[2], h0[3]}, v1 = {l1[0], l1[1], l1[2], l1[3], h1[0], h1[1], h1[2], h1[3]};
            o[0] = mfma32(v0, pb[s], o[0]); o[1] = mfma32(v1, pb[s], o[1]);
        }
    }
}

struct AttnRow { int r, hf, tt, t, qb, wave; unsigned long long wave_union; float m, lpart; };
template <int MODE>
__device__ __forceinline__ void at_tile(const Frame& F, int j, int stg, const bf16x8 (&Qf)[4], AttnRow& R, const unsigned (&voff)[2][2], f32x16 (&o)[2], float mfin, float invl) {
    LAS unsigned char* lds = F.lds;
        bool work = true;
        if (MODE == 2) work = (R.wave_union >> j) & 1ull;
        if (work) {
            f32x16 s[2]; at_qk(lds + AT_K + stg * 8192, Qf, R.r, R.hf, s);
            int hi = 1000, lo = -1000; bool rowok = true, edge = false;
            if (MODE <= 1) { hi = ((R.t - 31) >> 4) - 64 * j - 4 * R.hf; edge = (64 * j + 63) > ((64 * R.qb + 8 * R.wave - 31) >> 4); }
            if (MODE == 2) { const unsigned long long sm = *(const LAS unsigned long long*)(lds + AT_SELM + 8 * R.tt); rowok = (sm >> j) & 1ull; if (j == R.qb) { hi = R.tt - 4 * R.hf; edge = true; } }
            if (MODE == 3) { if (j == R.qb) { hi = R.tt - 4 * R.hf; edge = true; } if (j == R.qb - 8) { lo = R.tt + 1 - 4 * R.hf; edge = true; } }
            if (MODE == 1) {
                if (edge) {
#pragma unroll
                    for (int kt = 0; kt < 2; ++kt)
#pragma unroll
                        for (int e = 0; e < 16; ++e) { const int cst = 32 * kt + (e & 3) + 8 * (e >> 2); s[kt][e] = (cst <= hi) ? fexp2(s[kt][e] - mfin) * invl : 0.f; }
                } else {
#pragma unroll
                    for (int kt = 0; kt < 2; ++kt)
#pragma unroll
                        for (int e = 0; e < 16; ++e) s[kt][e] = fexp2(s[kt][e] - mfin) * invl;
                }
                LAS float* imp = (LAS float*)(lds + AT_IMP) + R.tt * 68;
#pragma unroll
                for (int kt = 0; kt < 2; ++kt)
#pragma unroll
                    for (int rg = 0; rg < 4; ++rg) {
                        float av = 2.f * (s[kt][4 * rg] + s[kt][4 * rg + 1] + s[kt][4 * rg + 2]) + s[kt][4 * rg + 3], bv = s[kt][4 * rg + 3];
                        av += __int_as_float(__builtin_amdgcn_update_dpp(0, __float_as_int(av), 0xB1, 0xf, 0xf, true)); av += __int_as_float(__builtin_amdgcn_update_dpp(0, __float_as_int(av), 0x4E, 0xf, 0xf, true));
                        bv += __int_as_float(__builtin_amdgcn_update_dpp(0, __float_as_int(bv), 0xB1, 0xf, 0xf, true)); bv += __int_as_float(__builtin_amdgcn_update_dpp(0, __float_as_int(bv), 0x4E, 0xf, 0xf, true));
                        if ((R.r & 3) == 0) { const int jb = 16 * j + 8 * kt + 2 * rg + R.hf; (void)__hip_atomic_fetch_add(imp + jb, av, __ATOMIC_RELAXED, __HIP_MEMORY_SCOPE_WORKGROUP); (void)__hip_atomic_fetch_add(imp + jb + 1, bv, __ATOMIC_RELAXED, __HIP_MEMORY_SCOPE_WORKGROUP); }
                    }
                at_pv((unsigned)(size_t)(lds + AT_V + stg * 8192), voff, s, o);
            } else {
                float tmax = -INFINITY;
                if (edge) {
#pragma unroll
                    for (int kt = 0; kt < 2; ++kt)
#pragma unroll
                        for (int e = 0; e < 16; ++e) { const int cst = 32 * kt + (e & 3) + 8 * (e >> 2); const bool ok = (cst <= hi) && (cst >= lo); s[kt][e] = ok ? s[kt][e] : -INFINITY; }
                }
#pragma unroll
                for (int kt = 0; kt < 2; ++kt)
#pragma unroll
                    for (int e = 0; e < 16; e += 2) tmax = fmaxf(tmax, fmaxf(s[kt][e], s[kt][e + 1]));
                tmax = half_max(tmax);
                const float mn = rowok ? fmaxf(R.m, tmax) : R.m, alpha = fexp2(R.m - mn); R.m = mn;
                const float negm = rowok ? -mn : -INFINITY;
                float ps = 0.f;
#pragma unroll
                for (int kt = 0; kt < 2; ++kt)
#pragma unroll
                    for (int e = 0; e < 16; ++e) { s[kt][e] = fexp2(s[kt][e] + negm); ps += s[kt][e]; }
                R.lpart = R.lpart * alpha + ps;
                if (MODE >= 2) {
                    if (__any(alpha < 1.f)) {
#pragma unroll
                        for (int e = 0; e < 16; ++e) { o[0][e] *= alpha; o[1][e] *= alpha; } }
                    at_pv((unsigned)(size_t)(lds + AT_V + stg * 8192), voff, s, o);
                }
            }
        }
}
template <int MODE>
__device__ __forceinline__ void at_branch(const Frame& F, unsigned long long mask, const bf16* Kb, const bf16* Vb, size_t stride, const bf16x8 (&Qf)[4], AttnRow& R, const unsigned (&voff)[2][2],
                                          f32x16 (&o)[2], float mfin, float invl) {
    LAS unsigned char* lds = F.lds; const int tid = F.tid;
    if (mask == 0ull) return;
    AttnStage st0, st1; int sg = 0;
    { const int j0 = __builtin_ctzll(mask); at_gload(st0, Kb, Vb, stride, j0, tid); at_swrite(st0, lds, 0, tid);
      const unsigned long long m1 = mask & (mask - 1ull); if (m1) { at_gload(st1, Kb, Vb, stride, __builtin_ctzll(m1), tid); at_swrite(st1, lds, 1, tid); } }
    __syncthreads();
    while (mask) {
        const int j0 = __builtin_ctzll(mask); mask &= mask - 1ull;
        int j1 = -1; if (mask) { j1 = __builtin_ctzll(mask); mask &= mask - 1ull; }
        int n0 = -1, n1 = -1; { unsigned long long mm = mask; if (mm) { n0 = __builtin_ctzll(mm); mm &= mm - 1ull; if (mm) n1 = __builtin_ctzll(mm); } }
        if (n0 >= 0) at_gload(st0, Kb, Vb, stride, n0, tid);
        if (n1 >= 0) at_gload(st1, Kb, Vb, stride, n1, tid);
        at_tile<MODE>(F, j0, sg, Qf, R, voff, o, mfin, invl);
        if (j1 >= 0) at_tile<MODE>(F, j1, sg + 1, Qf, R, voff, o, mfin, invl);
        if (n0 >= 0) at_swrite(st0, lds, (sg + 2) & 3, tid);
        if (n1 >= 0) at_swrite(st1, lds, (sg + 3) & 3, tid);
        __syncthreads();
        sg = (sg + 2) & 3;
    }
}

template <int VAR>
__device__ __forceinline__ void attn_item(const Frame& F, ArgsP a, int l, int item) {
    const int qb = 63 - (item >> 4), bh = item & 15, b = bh >> 1, hk = bh & 1; const int lane = F.lane, wave = F.wave;
    const bf16* H = (const bf16*)(a->ws + WS_H); const float* side = (const float*)(a->ws + WS_SIDE); bf16* Y = (bf16*)(a->ws + WS_Y);
    LAS unsigned char* lds = F.lds;
    AttnRow R; R.r = lane & 31; R.hf = lane >> 5; R.tt = 8 * wave + (R.r >> 2); R.t = 64 * qb + R.tt; R.qb = qb; R.wave = wave; R.wave_union = 0ull;
    const int head = hk * 4 + (R.r & 3); const size_t tok = (size_t)b * SEQ + R.t;
    bf16x8 Qf[4];
#pragma unroll
    for (int ks = 0; ks < 4; ++ks) Qf[ks] = *(const bf16x8*)(H + tok * HLD + head * 64 + 16 * ks + 8 * R.hf);
    const float g_cmp = side[tok * 32 + head * 3], g_sel = side[tok * 32 + head * 3 + 1], g_win = side[tok * 32 + head * 3 + 2];
    unsigned voff[2][2];
    { const int li = lane & 15, q = li >> 2, p = li & 3, gi1 = (lane >> 4) & 1;
#pragma unroll
      for (int jh = 0; jh < 2; ++jh)
#pragma unroll
          for (int dt = 0; dt < 2; ++dt) voff[jh][dt] = (unsigned)((8 * jh + 4 * R.hf + q) * 128 + ((((4 * dt + 2 * gi1 + (p >> 1)) ^ (4 * jh + 2 * R.hf + (q >> 1))) & 7) << 4) + (p & 1) * 8); }
    { LAS float* imp = (LAS float*)(lds + AT_IMP) + (8 * wave) * 68; for (int i = lane; i < 8 * 68; i += 64) imp[i] = 0.f; if (F.tid == 0) { *(LAS unsigned*)(lds + AT_UNI) = 0u; *(LAS unsigned*)(lds + AT_UNI + 4) = 0u; } }
    f32x16 ysum[2], o[2];
#pragma unroll
    for (int e = 0; e < 16; ++e) { ysum[0][e] = 0.f; ysum[1][e] = 0.f; o[0][e] = 0.f; o[1][e] = 0.f; }
    {
        const bf16* Kc = (const bf16*)(a->ws + WS_KC) + (size_t)bh * 256 * 64; const bf16* Vc = (const bf16*)(a->ws + WS_VC) + (size_t)bh * 256 * 64;
        const int ntc = (4 * qb + 3 + 63) >> 6; const unsigned long long mc = (ntc >= 64) ? ~0ull : ((1ull << ntc) - 1ull);
        R.m = -1e30f; R.lpart = 0.f;
        if (!(VAR & 8)) at_branch<0>(F, mc, Kc, Vc, 64, Qf, R, voff, o, 0.f, 0.f);
        const float lsum = half_sum(R.lpart); const float invl = 1.f / fmaxf(lsum, 1e-30f);
        if (!(VAR & 8)) at_branch<1>(F, mc, Kc, Vc, 64, Qf, R, voff, o, R.m, invl);
#pragma unroll
        for (int e = 0; e < 16; ++e) { ysum[0][e] = g_cmp * o[0][e]; ysum[1][e] = g_cmp * o[1][e]; o[0][e] = 0.f; o[1][e] = 0.f; }
    }
    LDS_WAIT();
    {
        unsigned long long wu = 0ull;
        for (int qi = 0; qi < 8; ++qi) {
            unsigned long long selm;
            if (qb < 16) selm = (2ull << qb) - 1ull;
            else {
                const float v = ((const LAS float*)(lds + AT_IMP))[(8 * wave + qi) * 68 + lane];
                const bool cand = (lane >= 1) && (lane <= qb - 2); const unsigned key = cand ? __float_as_uint(fmaxf(v, 0.f)) : 0u;
                unsigned thr = 0u;
                for (int bit = 30; bit >= 0; --bit) { const unsigned tr = thr | (1u << bit); const int c = __popcll(__ballot(cand && key >= tr)); if (c >= 13) thr = tr; }
                const unsigned long long gt = __ballot(cand && key > thr), eq = __ballot(cand && key == thr);
                int need = 13 - __popcll(gt); unsigned long long eqs = 0ull, e2 = eq;
                while (need > 0 && e2) { const unsigned long long low = e2 & (~e2 + 1ull); eqs |= low; e2 ^= low; --need; }
                selm = gt | eqs | 1ull | (1ull << qb) | (1ull << (qb - 1));
            }
            if (lane == 0) *(LAS unsigned long long*)(lds + AT_SELM + 8 * (8 * wave + qi)) = selm;
#if defined(SELFCHECK) && SELFCHECK == 1
            if (lane == 0 && l == 1) ((unsigned long long*)(a->ws + (size_t)880 * MiB + 64 * KiB))[(size_t)bh * SEQ + 64 * qb + 8 * wave + qi] = selm;
#endif
            wu |= selm;
        }
        R.wave_union = wu;
        if (lane == 0) { __hip_atomic_fetch_or((LAS unsigned*)(lds + AT_UNI), (unsigned)wu, __ATOMIC_RELAXED, __HIP_MEMORY_SCOPE_WORKGROUP); __hip_atomic_fetch_or((LAS unsigned*)(lds + AT_UNI + 4), (unsigned)(wu >> 32), __ATOMIC_RELAXED, __HIP_MEMORY_SCOPE_WORKGROUP); }
    }
    __syncthreads();
    const unsigned long long bunion = (unsigned long long)*(const LAS unsigned*)(lds + AT_UNI) | ((unsigned long long)*(const LAS unsigned*)(lds + AT_UNI + 4) << 32);
    const bf16* Hb = H + (size_t)b * SEQ * HLD;
    {
        R.m = -1e30f; R.lpart = 0.f;
        if (!(VAR & 2)) at_branch<2>(F, bunion, Hb + 512 + 2 * 128 + hk * 64, Hb + 512 + 3 * 128 + hk * 64, HLD, Qf, R, voff, o, 0.f, 0.f);
        const float lsum = half_sum(R.lpart); const float sc = g_sel / fmaxf(lsum, 1e-30f);
#pragma unroll
        for (int e = 0; e < 16; ++e) { ysum[0][e] += sc * o[0][e]; ysum[1][e] += sc * o[1][e]; o[0][e] = 0.f; o[1][e] = 0.f; }
    }
    {
        const int lo = qb - 8 > 0 ? qb - 8 : 0; const unsigned long long mw = ((2ull << qb) - 1ull) & ~((1ull << lo) - 1ull);
        R.m = -1e30f; R.lpart = 0.f;
        if (!(VAR & 4)) at_branch<3>(F, mw, Hb + 512 + 4 * 128 + hk * 64, Hb + 512 + 5 * 128 + hk * 64, HLD, Qf, R, voff, o, 0.f, 0.f);
        const float lsum = half_sum(R.lpart); const float sc = g_win / fmaxf(lsum, 1e-30f);
#pragma unroll
        for (int e = 0; e < 16; ++e) { ysum[0][e] += sc * o[0][e]; ysum[1][e] += sc * o[1][e]; }
    }
    if (VAR & 1) { asm volatile("" :: "v"(ysum[0][0]), "v"(ysum[1][5])); return; }
    bf16* yrow = Y + tok * DM + head * 64 + 4 * R.hf;
#pragma unroll
    for (int dt = 0; dt < 2; ++dt)
#pragma unroll
        for (int rg = 0; rg < 4; ++rg) { u32x2 w; w.x = pk2(ysum[dt][4 * rg], ysum[dt][4 * rg + 1]); w.y = pk2(ysum[dt][4 * rg + 2], ysum[dt][4 * rg + 3]); *(u32x2*)(yrow + 32 * dt + 8 * rg) = w; }
}

__device__ __forceinline__ void phase_mix_b(const Frame& F, ArgsP a, int l, int rep) {
    unsigned* q = F.ctl + CW_QUEUE + l * 64 + rep * 32;
    for (;;) {
        if (F.tid == 0) F.MISC[0] = __hip_atomic_fetch_add(q, 1u, __ATOMIC_RELAXED, __HIP_MEMORY_SCOPE_AGENT);
        __syncthreads();
        const int item = (int)F.MISC[0];
        __syncthreads();
        if (item >= 1024) break;
        if (rep == 0) attn_item<0>(F, a, l, item); else attn_item<PROBE_ATTN_VAR>(F, a, l, item);
    }
}

constexpr size_t WS_DBG = 880 * MiB;
constexpr int CHECK_LAYER = 1;
__device__ __forceinline__ void dbg_add(ArgsP a, int i, float v) { atomicAdd((float*)(a->ws + WS_DBG) + i, v); }

__device__ __forceinline__ void check_nsa(const Frame& F, ArgsP a) {
    const bf16* H = (const bf16*)(a->ws + WS_H); const float* side = (const float*)(a->ws + WS_SIDE); const bf16* Y = (const bf16*)(a->ws + WS_Y);
    const unsigned long long* SELM = (const unsigned long long*)(a->ws + WS_DBG + 64 * KiB);
    const int lane = F.lane; const int tv[16] = {5, 40, 63, 64, 100, 511, 512, 1023, 1024, 1500, 2047, 2048, 3000, 3333, 4000, 4095};
    for (int s = F.bid * NWAVES + F.wave; s < 256; s += F.G * NWAVES) {
        int t = tv[0];
#pragma unroll
        for (int q = 1; q < 16; ++q) t = ((s & 15) == q) ? tv[q] : t;
        const int b = (s >> 4) & 7, hq = ((s >> 7) * 5 + (s & 7)) & 7, hk = hq >> 2; const size_t tok = (size_t)b * SEQ + t; const int bhk = b * 2 + hk;
        const bf16* KC = (const bf16*)(a->ws + WS_KC) + (size_t)bhk * 256 * 64; const bf16* VC = (const bf16*)(a->ws + WS_VC) + (size_t)bhk * 256 * 64;
        const float g_cmp = side[tok * 32 + hq * 3], g_sel = side[tok * 32 + hq * 3 + 1], g_win = side[tok * 32 + hq * 3 + 2];
        const int cmax = (t - 31) >> 4; float imp = 0.f, ocmp = 0.f;
        for (int gh = 0; gh < 4; ++gh) {
            const int head = hk * 4 + gh; const float qd = bf2f(H[tok * HLD + head * 64 + lane]);
            float m = -INFINITY, l = 0.f;
            for (int c = 0; c <= cmax; ++c) m = fmaxf(m, wave_sum(qd * bf2f(KC[c * 64 + lane])));
            for (int c = 0; c <= cmax; ++c) l += fexp2(wave_sum(qd * bf2f(KC[c * 64 + lane])) - m);
            for (int c = 0; c <= cmax; ++c) { const float p = fexp2(wave_sum(qd * bf2f(KC[c * 64 + lane])) - m) / l; const int j = c >> 2, e = c & 3;
                if (lane == j) imp += (e < 3 ? 2.f : 1.f) * p; if (e == 3 && lane == j + 1) imp += p;
                if (head == hq) ocmp += p * bf2f(VC[c * 64 + lane]); }
        }
        const int cur = t >> 6; const bool causal = lane <= cur, forced = (lane == 0) || (lane == cur) || (lane == cur - 1);
        const float key = causal ? (imp + (forced ? 1.0e4f : 0.f)) : -INFINITY; int rank = 0;
        for (int i = 0; i < 64; ++i) { const float ki = __shfl(key, i); rank += ((ki > key) || (ki == key && i < lane)) ? 1 : 0; }
        const unsigned long long refm = __ballot(causal && rank < 16), stm = SELM[(size_t)bhk * SEQ + t];
        if (lane == 0) { dbg_add(a, 2, (float)__popcll(refm ^ stm)); dbg_add(a, 3, 16.f); }
        const float qd = bf2f(H[tok * HLD + hq * 64 + lane]); const bf16* Hb = H + (size_t)b * SEQ * HLD + hk * 64 + lane;
        float m = -INFINITY, l = 0.f, osel = 0.f;
        for (int j = 0; j <= cur; ++j) if ((stm >> j) & 1ull) for (int kk = 0; kk < 64; ++kk) { const int p = 64 * j + kk; if (p > t) break;
            const float sc = wave_sum(qd * bf2f(Hb[(size_t)p * HLD + 512 + 2 * 128])); const float mn = fmaxf(m, sc), al = fexp2(m - mn), pp = fexp2(sc - mn);
            l = l * al + pp; osel = osel * al + pp * bf2f(Hb[(size_t)p * HLD + 512 + 3 * 128]); m = mn; }
        const float ysel = osel / fmaxf(l, 1e-30f);
        m = -INFINITY; l = 0.f; float owin = 0.f;
        for (int p = (t - 511 > 0 ? t - 511 : 0); p <= t; ++p) { const float sc = wave_sum(qd * bf2f(Hb[(size_t)p * HLD + 512 + 4 * 128])); const float mn = fmaxf(m, sc), al = fexp2(m - mn), pp = fexp2(sc - mn);
            l = l * al + pp; owin = owin * al + pp * bf2f(Hb[(size_t)p * HLD + 512 + 5 * 128]); m = mn; }
        const float ref = g_cmp * ocmp + g_sel * ysel + g_win * owin / fmaxf(l, 1e-30f), got = bf2f(Y[tok * DM + hq * 64 + lane]);
        const float e2 = wave_sum((ref - got) * (ref - got)), r2 = wave_sum(ref * ref);
        if (lane == 0) { dbg_add(a, 0, e2); dbg_add(a, 1, r2); }
    }
}

__device__ __forceinline__ void check_gdn(const Frame& F, ArgsP a, int l) {
    if (F.bid >= 8) return;
    const bf16* H = (const bf16*)(a->ws + WS_H); const float* side = (const float*)(a->ws + WS_SIDE); const bf16* Y = (const bf16*)(a->ws + WS_Y);
    const int b = F.bid, h = (F.bid * 3) & 3, tid = F.tid, lane = F.lane, col = tid & 63, rg = tid >> 6;
    LAS float* S = (LAS float*)F.lds; LAS float* qv = S + 64 * 65; LAS float* kv = qv + 64; LAS float* vv = kv + 64; LAS float* sc = vv + 64; LAS float* part = sc + 64;
    for (int i = tid; i < 64 * 65; i += NTHR) S[i] = 0.f;
    float hq[3] = {0.f, 0.f, 0.f}, hk[3] = {0.f, 0.f, 0.f}, hv[3] = {0.f, 0.f, 0.f}, wq[4], wk[4], wv[4];
    { const float* cw = a->in[6] + (size_t)l * 4 * 768 + h * 64 + lane;
#pragma unroll
      for (int k = 0; k < 4; ++k) { wq[k] = cw[k * 768]; wk[k] = cw[k * 768 + 256]; wv[k] = cw[k * 768 + 512]; } }
    const float Aexp = __expf(a->in[7][l * 4 + h]), dtb = a->in[8][l * 4 + h], nw = a->in[9][l * 64 + lane];
    __syncthreads();
    for (int t = 0; t < 192; ++t) {
        const size_t tok = (size_t)b * SEQ + t;
        if (F.wave == 0) { const bf16* p = H + tok * HLD + 1280 + h * 64 + lane; const float rq = bf2f(p[0]), rk = bf2f(p[256]), rv = bf2f(p[512]);
            const float cq = wq[0] * hq[0] + wq[1] * hq[1] + wq[2] * hq[2] + wq[3] * rq, ck = wk[0] * hk[0] + wk[1] * hk[1] + wk[2] * hk[2] + wk[3] * rk, cv = wv[0] * hv[0] + wv[1] * hv[1] + wv[2] * hv[2] + wv[3] * rv;
            hq[0] = hq[1]; hq[1] = hq[2]; hq[2] = rq; hk[0] = hk[1]; hk[1] = hk[2]; hk[2] = rk; hv[0] = hv[1]; hv[1] = hv[2]; hv[2] = rv;
            const float qs = cq / (1.f + __expf(-cq)), ks = ck / (1.f + __expf(-ck)), vs = cv / (1.f + __expf(-cv));
            qv[lane] = qs / sqrtf(wave_sum(qs * qs) + 1e-6f); kv[lane] = ks / sqrtf(wave_sum(ks * ks) + 1e-6f); vv[lane] = vs;
            if (lane == 0) { const float av = side[tok * 32 + 28 + h] + dtb; const float sp = av > 20.f ? av : log1pf(__expf(av)); sc[0] = __expf(-Aexp * sp); sc[1] = side[tok * 32 + 24 + h]; } }
        __syncthreads();
        { float ps = 0.f;
#pragma unroll
          for (int r = 0; r < 8; ++r) ps += kv[8 * rg + r] * S[(8 * rg + r) * 65 + col];
          part[rg * 64 + col] = ps; }
        __syncthreads();
        { float ks = 0.f;
#pragma unroll
          for (int r = 0; r < 8; ++r) ks += part[r * 64 + col];
          const float eg = sc[0], be = sc[1]; float po = 0.f;
          __syncthreads();
#pragma unroll
          for (int r = 0; r < 8; ++r) { const int dk = 8 * rg + r; const float sn = eg * (S[dk * 65 + col] - be * kv[dk] * ks) + be * kv[dk] * vv[col]; S[dk * 65 + col] = sn; po += sn * qv[dk]; }
          part[rg * 64 + col] = po; }
        __syncthreads();
        if (F.wave == 0) { float o = 0.f;
#pragma unroll
            for (int r = 0; r < 8; ++r) o += part[r * 64 + lane];
            o *= 0.125f; const float rs = 1.f / sqrtf(wave_sum(o * o) * (1.f / 64.f) + 1e-6f); const float z = bf2f(H[tok * HLD + 2048 + h * 64 + lane]);
            const float ref = o * rs * nw * (z / (1.f + __expf(-z))), got = bf2f(Y[tok * DM + 512 + h * 64 + lane]);
            const float e2 = wave_sum((ref - got) * (ref - got)), r2 = wave_sum(ref * ref);
            if (lane == 0) { dbg_add(a, 4, e2); dbg_add(a, 5, r2); } }
        __syncthreads();
    }
}

__device__ __forceinline__ void check_moe(const Frame& F, ArgsP a, int l) {
    const float* X1 = (const float*)(a->ws + WS_X1); const bf16* Y2 = (const bf16*)(a->ws + WS_Y2);
    const int* route_e = (const int*)(a->ws + WS_SLOT + SL_RE); const float* route_w = (const float*)(a->ws + WS_SLOT + SL_RW);
    LAS float* x = (LAS float*)F.lds; LAS float* hid = x + 1024; LAS float* lg = hid + 512; LAS float* yr = lg + 64;
    const int tid = F.tid, lane = F.lane;
    for (int s = F.bid; s < 256; s += F.G) {
        const int t = (s * 4099 + 17) & (T - 1);
        for (int i = tid; i < 1024; i += NTHR) { x[i] = X1[(size_t)t * DM + i]; yr[i] = 0.f; }
        __syncthreads();
        for (int j = F.wave; j < 36; j += NWAVES) { float d = 0.f; for (int k = lane; k < DM; k += 64) d += x[k] * (j < 4 ? a->in[18][((size_t)l * DM + k) * 4 + j] : a->in[20][((size_t)l * DM + k) * NEXP + j - 4]);
            d = wave_sum(d); if (lane == 0) lg[j] = d + (j < 4 ? a->in[19][l * 4 + j] : a->in[21][l * NEXP + j - 4]); }
        __syncthreads();
        if (tid == 0) { int gi = 0; for (int i = 1; i < 4; ++i) if (lg[i] > lg[gi]) gi = i; float gs = 0.f; for (int i = 0; i < 4; ++i) gs += __expf(lg[i] - lg[gi]); const float gw = 1.f / gs;
            int i1 = 0; for (int i = 1; i < 8; ++i) if (lg[4 + gi * 8 + i] > lg[4 + gi * 8 + i1]) i1 = i; int i2 = -1; for (int i = 0; i < 8; ++i) if (i != i1 && (i2 < 0 || lg[4 + gi * 8 + i] > lg[4 + gi * 8 + i2])) i2 = i;
            const float e2 = __expf(lg[4 + gi * 8 + i2] - lg[4 + gi * 8 + i1]), w1 = gw / (1.f + e2), w2 = gw - w1;
            const int se1 = route_e[2 * t], se2 = route_e[2 * t + 1]; const float sw1 = route_w[2 * t], sw2 = route_w[2 * t + 1];
            dbg_add(a, 8, (se1 != gi * 8 + i1 ? 1.f : 0.f) + (se2 != gi * 8 + i2 ? 1.f : 0.f)); dbg_add(a, 9, 2.f);
            if (se1 == gi * 8 + i1 && se2 == gi * 8 + i2) { dbg_add(a, 10, (sw1 - w1) * (sw1 - w1) + (sw2 - w2) * (sw2 - w2)); dbg_add(a, 11, w1 * w1 + w2 * w2); } }
        for (int k2 = 0; k2 < 2; ++k2) {
            const int e = route_e[2 * t + k2]; const float rw = route_w[2 * t + k2];
            const float* wg = a->in[22] + ((size_t)l * NEXP + e) * DM * FF; const float* wu = a->in[23] + ((size_t)l * NEXP + e) * DM * FF; const float* wd = a->in[24] + ((size_t)l * NEXP + e) * FF * DM;
            { float g = 0.f, u = 0.f; for (int k = 0; k < DM; ++k) { g += x[k] * wg[(size_t)k * FF + tid]; u += x[k] * wu[(size_t)k * FF + tid]; } hid[tid] = g / (1.f + __expf(-g)) * u; }
            __syncthreads();
            for (int d = tid; d < DM; d += NTHR) { float y = 0.f; for (int f = 0; f < FF; ++f) y += hid[f] * wd[(size_t)f * DM + d]; yr[d] += y * rw; }
            __syncthreads();
        }
        float e2 = 0.f, r2 = 0.f;
        for (int d = tid; d < DM; d += NTHR) { const float got = bf2f(Y2[(size_t)(2 * t) * DM + d]) + bf2f(Y2[(size_t)(2 * t + 1) * DM + d]); e2 += (yr[d] - got) * (yr[d] - got); r2 += yr[d] * yr[d]; }
        e2 = wave_sum(e2); r2 = wave_sum(r2); if (lane == 0) { dbg_add(a, 6, e2); dbg_add(a, 7, r2); }
        __syncthreads();
    }
}

__device__ __forceinline__ void check_inproj(const Frame& F, ArgsP a, int l) {
    const bf16* H = (const bf16*)(a->ws + WS_H); const float* xin = (l == 0) ? a->in[0] : (const float*)a->out; const float* win = a->in[1] + (size_t)l * DM * DIN;
    const int lane = F.lane;
    for (int s = F.bid * NWAVES + F.wave; s < 1024; s += F.G * NWAVES) {
        const int tok = (s * 7919 + 13) & (T - 1), grp = s % 14, t = tok & (SEQ - 1);
        const int col0 = grp < 8 ? grp * 64 : 512 + (grp - 8) * 128 + ((s >> 4) & 1) * 64; const bool isq = grp < 8, rope = isq || ((grp - 8) % 2 == 0);
        float d = 0.f; for (int k = 0; k < DM; ++k) d += xin[(size_t)tok * DM + k] * win[(size_t)k * DIN + col0 + lane];
        if (rope) { const float inv[8] = {1.0f, 0.19392274f, 0.03760603f, 0.0072926646f, 0.0014142136f, 0.0002742482f, 5.3182957e-05f, 1.0313385e-05f};
            float iv = inv[0];
#pragma unroll
            for (int q = 1; q < 8; ++q) iv = ((lane & 7) == q) ? inv[q] : iv;
            const float ang = (float)t * iv, c = cosf(ang), sn = sinf(ang), other = __shfl_xor(d, 8);
            if (lane < 8) d = d * c - other * sn; else if (lane < 16) d = d * c + other * sn; }
        if (isq) d *= pg8::QSCALE;
        const float got = bf2f(H[(size_t)tok * HLD + col0 + lane]); const float e2 = wave_sum((d - got) * (d - got)), r2 = wave_sum(d * d);
        if (lane == 0) { dbg_add(a, 12, e2); dbg_add(a, 13, r2); }
    }
}
__device__ __forceinline__ void check_compress(const Frame& F, ArgsP a, int l) {
    const bf16* H = (const bf16*)(a->ws + WS_H); const int lane = F.lane;
    for (int s = F.bid * NWAVES + F.wave; s < 512; s += F.G * NWAVES) {
        const int kv = s & 1, bh = (s >> 1) & 15, b = bh >> 1, hh = bh & 1, i = (s * 53 + 7) % 255;
        const float* pe = a->in[3] + ((size_t)l * 2 + kv) * 2048; const float* w1 = a->in[4] + ((size_t)l * 2 + kv) * 2048 * 128; const float* w2 = a->in[5] + ((size_t)l * 2 + kv) * 128 * 64;
        float h0 = 0.f, h1 = 0.f;
        for (int k = 0; k < 2048; ++k) { const int p = k >> 6, d = k & 63; const float x = bf2f(H[((size_t)b * SEQ + 16 * i + p) * HLD + 512 + kv * 128 + hh * 64 + d]) + pe[k];
            h0 += x * w1[(size_t)k * 128 + lane]; h1 += x * w1[(size_t)k * 128 + 64 + lane]; }
        h0 = h0 / (1.f + __expf(-h0)); h1 = h1 / (1.f + __expf(-h1));
        float o = 0.f;
        for (int n = 0; n < 64; ++n) { o += __shfl(h0, n) * w2[(size_t)n * 64 + lane] + __shfl(h1, n) * w2[(size_t)(64 + n) * 64 + lane]; }
        const float got = bf2f(((const bf16*)(a->ws + (kv ? WS_VC : WS_KC)))[((size_t)bh * 256 + i) * 64 + lane]);
        const float e2 = wave_sum((o - got) * (o - got)), r2 = wave_sum(o * o); if (lane == 0) { dbg_add(a, 14, e2); dbg_add(a, 15, r2); }
    }
}
__device__ __forceinline__ void check_conformer(const Frame& F, ArgsP a, int l) {
    const bf16* H = (const bf16*)(a->ws + WS_H); const bf16* Y = (const bf16*)(a->ws + WS_Y); const int lane = F.lane;
    for (int s = F.bid * NWAVES + F.wave; s < 1024; s += F.G * NWAVES) {
        const int tok = (s * 6151 + 3) & (T - 1), t = tok & (SEQ - 1); float u[4];
#pragma unroll
        for (int j = 0; j < 4; ++j) { const int c = lane + 64 * j; float acc = a->in[11][l * 256 + c];
            for (int k = 0; k < 31; ++k) { const int sp = t - 30 + k; if (sp >= 0) { const bf16* hp = H + (size_t)(tok - 30 + k) * HLD + 2304 + c; const float g = bf2f(hp[256]); acc += a->in[10][((size_t)l * 31 + k) * 256 + c] * (bf2f(hp[0]) / (1.f + __expf(-g))); } }
            u[j] = acc; }
        const float mean = wave_sum(u[0] + u[1] + u[2] + u[3]) * (1.f / 256.f); float q = 0.f;
#pragma unroll
        for (int j = 0; j < 4; ++j) { u[j] -= mean; q += u[j] * u[j]; }
        const float rstd = 1.f / sqrtf(wave_sum(q) * (1.f / 256.f) + LN_EPS); float e2 = 0.f, r2 = 0.f;
#pragma unroll
        for (int j = 0; j < 4; ++j) { const int c = lane + 64 * j; const float v = u[j] * rstd * a->in[12][l * 256 + c] + a->in[13][l * 256 + c]; const float ref = v / (1.f + __expf(-v)), got = bf2f(Y[(size_t)tok * DM + 768 + c]);
            e2 += (ref - got) * (ref - got); r2 += ref * ref; }
        e2 = wave_sum(e2); r2 = wave_sum(r2); if (lane == 0) { dbg_add(a, 16, e2); dbg_add(a, 17, r2); }
    }
}
__device__ __forceinline__ void check_inject(const Frame& F, ArgsP a) {
    if (F.bid == 0 && F.tid == 0) { const float* d = (const float*)(a->ws + WS_DBG); float e0 = 0.f, e1 = 0.f;
        if (SELFCHECK == 1) { e0 = 1000.f * sqrtf(d[0] / d[1]); e1 = 1.0e4f * d[2] / d[3]; }
        if (SELFCHECK == 2) { e0 = 1000.f * sqrtf(d[4] / d[5]); }
        if (SELFCHECK == 3) { e0 = 1000.f * sqrtf(d[6] / d[7]); e1 = 1.0e4f * d[8] / d[9] + 1000.f * sqrtf(d[10] / fmaxf(d[11], 1e-30f)); }
        if (SELFCHECK == 4) { e0 = 1000.f * sqrtf(d[12] / d[13]); }
        if (SELFCHECK == 5) { e0 = 1000.f * sqrtf(d[14] / d[15]); e1 = 1000.f * sqrtf(d[16] / d[17]); }
        a->out[0] += e0; a->out[1] += e1; }
}


#ifndef MK_MULTI
#define MK_MULTI 0
#endif
#ifndef PROBE_REPEAT
#define PROBE_REPEAT 0
#endif
constexpr int N_PHASES = 1 + 10 * NL;
__device__ __forceinline__ Frame make_frame(int wave_s) {
    extern __shared__ __attribute__((aligned(16))) unsigned char lds_raw[];
    Frame F; F.lds = (LAS unsigned char*)lds_raw; F.MISC = (volatile LAS unsigned*)(F.lds + MISC_OFF);
    int tid = threadIdx.x, G = gridDim.x, bid = blockIdx.x; unsigned lb = (unsigned)(size_t)F.lds; (void)wave_s;
    asm volatile("" : "+v"(tid), "+s"(G), "+s"(bid), "+s"(lb));
    F.lds = (LAS unsigned char*)(size_t)lb; F.MISC = (volatile LAS unsigned*)(F.lds + MISC_OFF);
    F.tid = tid; F.lane = F.tid & 63; F.wave = __builtin_amdgcn_readfirstlane(F.tid >> 6); F.G = G; F.bid = bid;
    F.ctl = (unsigned*)(args_here()->ws + WS_CTL); return F;
}
__device__ __forceinline__ void ph_prologue(int, int wv) { const Frame F = make_frame(wv); phase_prologue(F, args_here()); phase_weights(F, args_here(), 0);
#if SELFCHECK
    if (F.bid == 0 && F.tid < 64) ((float*)(args_here()->ws + WS_DBG))[F.tid] = 0.f;
#endif
}
__device__ __forceinline__ void ph_inproj(int, int wv) { const Frame F = make_frame(wv); unsigned char* ws = args_here()->ws;
    pg8::Gemm g{(const bf16*)(ws + WS_XB), (const bf16*)(ws + WS_WL + WL_WIN), T, DINP, DM}; pg8::StaticOrder S; S.init(T, DINP, F.G, F.bid);
    pg8::EpiInProj E{(bf16*)(ws + WS_H), (float*)(ws + WS_SIDE), (const float*)(ws + WS_ROPE)};
    pg8::gemm_phase<pg8::EpiInProj, pg8::StaticOrder, false>(F.lds, g, S, E, nullptr, F.tid); }
__device__ __forceinline__ void ph_compress(int l, int wv) { const Frame F = make_frame(wv); for (int it = F.bid; it < 256; it += F.G) compress_item(F, args_here(), it); }
__device__ __forceinline__ void ph_gdnprep(int l, int wv) { const Frame F = make_frame(wv); for (int it = F.bid; it < 256; it += F.G) { gdn_prep_chunk(F, args_here(), l, it * 8 + F.wave, F.lds + F.wave * 16384); __syncthreads(); } }
__device__ __forceinline__ void ph_conformer(int l, int wv) { const Frame F = make_frame(wv); for (int it = F.bid; it < 512; it += F.G) conformer_item(F, args_here(), l, it); }
__device__ __forceinline__ void ph_gdnout(int l, int wv) { const Frame F = make_frame(wv); for (int ci = F.bid * NWAVES + F.wave; ci < 2048; ci += F.G * NWAVES) gdn_out_chunk(F, args_here(), ci, F.lds + F.wave * 8192); }
__device__ __forceinline__ void ph_scan(int l, int wv) { const Frame F = make_frame(wv); if (F.bid < 16) gdn_scan(F, args_here(), l); }
__device__ __forceinline__ void ph_attn(int l, int rep, int wv) { const Frame F = make_frame(wv); phase_mix_b(F, args_here(), l, rep); }
__device__ __forceinline__ void ph_outproj(int l, int wv) { const Frame F = make_frame(wv); ArgsP ap = args_here(); unsigned char* ws = ap->ws;
    pg8::Gemm g{(const bf16*)(ws + WS_Y), (const bf16*)(ws + WS_WL + WL_WOUT), T, DM, DM}; pg8::StaticOrder S; S.init(T, DM, F.G, F.bid);
    pg8::EpiOutProj E{l == 0 ? ap->in[0] : (const float*)ap->out, (float*)(ws + WS_X1), DN_ALPHA};
    pg8::gemm_phase<pg8::EpiOutProj, pg8::StaticOrder, false>(F.lds, g, S, E, nullptr, F.tid); }
__device__ __forceinline__ void ph_ln1(int l, int wv) { const Frame F = make_frame(wv); phase_ln1_router<false>(F, args_here(), l); }
__device__ __forceinline__ void ph_ln1_dry(int l, int wv) { const Frame F = make_frame(wv); phase_ln1_router<true>(F, args_here(), l); }
__device__ __forceinline__ void ph_gather(int l, int wv) { const Frame F = make_frame(wv); phase_gather(F, args_here(), l); }
__device__ __forceinline__ void ph_moeup(int l, int wv) { const Frame F = make_frame(wv); unsigned char* ws = args_here()->ws;
    pg8::Gemm g{(const bf16*)(ws + WS_XB), (const bf16*)(ws + WS_WL + WL_WGU), 0, 0, DM}; pg8::MoeOrder S{(const int*)(ws + WS_META) + l * 512, F.G, F.bid};
    pg8::EpiSwiGLU E{(bf16*)(ws + WS_HID), (const int*)(ws + WS_SLOT + SL_TOK), 1};
    pg8::gemm_phase<pg8::EpiSwiGLU, pg8::MoeOrder, false>(F.lds, g, S, E, nullptr, F.tid); }
__device__ __forceinline__ void ph_moedown(int l, int wv) { const Frame F = make_frame(wv); unsigned char* ws = args_here()->ws;
    pg8::Gemm g{(const bf16*)(ws + WS_HID), (const bf16*)(ws + WS_WL + WL_WDN), 0, 0, FF}; pg8::MoeOrder S{(const int*)(ws + WS_META) + l * 512, F.G, F.bid};
    pg8::EpiDown E{(bf16*)(ws + WS_Y2), (const int*)(ws + WS_SLOT + SL_TOK), (const float*)(ws + WS_SLOT + SL_W)};
    pg8::gemm_phase<pg8::EpiDown, pg8::MoeOrder, false>(F.lds, g, S, E, nullptr, F.tid); }
__device__ __forceinline__ void ph_ln2(int l, int wv) { const Frame F = make_frame(wv); phase_ln2(F, args_here(), l); }
__device__ __forceinline__ void ph_weights(int l, int wv) { const Frame F = make_frame(wv); if (l + 1 < NL) phase_weights(F, args_here(), l + 1); }

__global__ void __launch_bounds__(NTHR, 2) fwd_kernel(Args args) {
    extern __shared__ __attribute__((aligned(16))) unsigned char lds_raw[];
    (void)lds_raw; const int wv = 0; const Frame F = make_frame(wv);
    if (F.tid < 64) F.MISC[F.tid] = 0u;
    __syncthreads();
    XcdBarrier bar = xcd_barrier_post(F.ctl + CW_BAR, F.MISC + 8);
    const int lo = args_here()->ph_lo, hi = args_here()->ph_hi;
#define IN(k) (lo <= (k) && (k) < hi)
#define SEAM(k) do { if (IN(k) && IN((k) + 1)) { XcdBarrier bb = bar; asm volatile("" : "+s"(bb.bar)); xcd_barrier(bb); } } while (0)
#define RPT(bit, call) do { call; if (PROBE_REPEAT & (1u << (bit))) { XcdBarrier bb = bar; asm volatile("" : "+s"(bb.bar)); xcd_barrier(bb); call; } } while (0)
    if (IN(0)) ph_prologue(0, wv);
    SEAM(0);
#define LAYER_BODY(l) do { \
        const int pb = 1 + 10 * l; \
        if (IN(pb + 0)) RPT(0, ph_inproj(l, wv)); \
        SEAM(pb + 0); \
        if constexpr (SELFCHECK == 4) { \
        if (l == CHECK_LAYER) { { const Frame F2 = make_frame(wv); check_inproj(F2, args_here(), l); } XcdBarrier bb = bar; asm volatile("" : "+s"(bb.bar)); xcd_barrier(bb); } \
        } \
        if (IN(pb + 1)) { RPT(16, ph_compress(l, wv)); RPT(17, ph_gdnprep(l, wv)); RPT(18, ph_conformer(l, wv)); } \
        SEAM(pb + 1); \
        if (IN(pb + 2)) { RPT(19, ph_scan(l, wv)); ph_attn(l, 0, wv); if (PROBE_REPEAT & (1u << 20)) { XcdBarrier bb = bar; asm volatile("" : "+s"(bb.bar)); xcd_barrier(bb); ph_attn(l, 1, wv); } } \
        SEAM(pb + 2); \
        if (IN(pb + 3)) RPT(24, ph_gdnout(l, wv)); \
        SEAM(pb + 3); \
        if constexpr (SELFCHECK == 1 || SELFCHECK == 2 || SELFCHECK == 5) { \
        if (l == CHECK_LAYER) { { const Frame F2 = make_frame(wv); if (SELFCHECK == 1) check_nsa(F2, args_here()); else if (SELFCHECK == 2) check_gdn(F2, args_here(), l); else { check_compress(F2, args_here(), l); check_conformer(F2, args_here(), l); } } XcdBarrier bb = bar; asm volatile("" : "+s"(bb.bar)); xcd_barrier(bb); } \
        } \
        if (IN(pb + 4)) RPT(3, ph_outproj(l, wv)); \
        SEAM(pb + 4); \
        if (IN(pb + 5)) { ph_ln1(l, wv); if (PROBE_REPEAT & (1u << 4)) { XcdBarrier bb = bar; asm volatile("" : "+s"(bb.bar)); xcd_barrier(bb); ph_ln1_dry(l, wv); } \
            if (PROBE_REPEAT & (1u << 23)) { for (int rr = 0; rr < 4; ++rr) { XcdBarrier bb = bar; asm volatile("" : "+s"(bb.bar)); xcd_barrier(bb); } } } \
        SEAM(pb + 5); \
        if (IN(pb + 6)) RPT(5, ph_gather(l, wv)); \
        SEAM(pb + 6); \
        if (IN(pb + 7)) RPT(6, ph_moeup(l, wv)); \
        SEAM(pb + 7); \
        if (IN(pb + 8)) RPT(7, ph_moedown(l, wv)); \
        SEAM(pb + 8); \
        if constexpr (SELFCHECK == 3) { \
        if (l == CHECK_LAYER) { { const Frame F2 = make_frame(wv); check_moe(F2, args_here(), l); } XcdBarrier bb = bar; asm volatile("" : "+s"(bb.bar)); xcd_barrier(bb); } \
        } \
        if (IN(pb + 9)) { RPT(22, ph_ln2(l, wv)); RPT(21, ph_weights(l, wv)); } \
        SEAM(pb + 9); \
     \
    } while (0)
    LAYER_BODY(0); LAYER_BODY(1); LAYER_BODY(2); LAYER_BODY(3);
#undef LAYER_BODY
#undef RPT
#if SELFCHECK
    { XcdBarrier bb = bar; asm volatile("" : "+s"(bb.bar)); xcd_barrier(bb); const Frame F2 = make_frame(wv); check_inject(F2, args_here()); }
#endif
#undef IN
#undef SEAM
}

extern "C" void kernel_launch(void* const* d_in, const int* in_sizes, int n_in, void* d_out, int out_size, void* d_ws, size_t ws_size, hipStream_t stream) {
    static int grid = 0;
    if (grid == 0) {
        if (n_in != 25 || in_sizes[0] != T * DM || out_size != T * DM || ws_size < WS_END) { fprintf(stderr, "kernel_launch: shape/workspace mismatch (n_in %d, in0 %d, out %d, ws %zu < %zu); nothing launched\n", n_in, n_in > 0 ? in_sizes[0] : -1, out_size, ws_size, (size_t)WS_END); grid = -1; return; }
        int dev = 0, cus = 0, per_cu = 0;
        if (hipGetDevice(&dev) != hipSuccess || hipDeviceGetAttribute(&cus, hipDeviceAttributeMultiprocessorCount, dev) != hipSuccess) { grid = -1; return; }
        if (hipFuncSetAttribute((const void*)fwd_kernel, hipFuncAttributeMaxDynamicSharedMemorySize, LDS_BYTES) != hipSuccess) { fprintf(stderr, "kernel_launch: hipFuncSetAttribute failed\n"); grid = -1; return; }
        if (hipOccupancyMaxActiveBlocksPerMultiprocessor(&per_cu, (const void*)fwd_kernel, NTHR, LDS_BYTES) != hipSuccess || per_cu < 1)
            fprintf(stderr, "kernel_launch: note: occupancy query reports %d workgroups per CU\n", per_cu);
        (void)hipGetLastError();
        grid = cus;
        if (grid < 32 || (grid & 7)) { fprintf(stderr, "kernel_launch: unexpected CU count %d\n", cus); }
    }
    if (grid < 0) return;
    if (hipMemsetAsync((char*)d_ws + WS_CTL, 0, CTL_ZERO_BYTES, stream) != hipSuccess) return;
    Args a{};
    for (int i = 0; i < 25; ++i) a.in[i] = (const float*)d_in[i];
    a.out = (float*)d_out; a.ws = (unsigned char*)d_ws;
#if MK_MULTI
    for (int p = 0; p < N_PHASES; ++p) { a.ph_lo = p; a.ph_hi = p + 1; hipLaunchKernelGGL(fwd_kernel, dim3(grid), dim3(NTHR), LDS_BYTES, stream, a); }
#else
    a.ph_lo = 0; a.ph_hi = N_PHASES;
    hipLaunchKernelGGL(fwd_kernel, dim3(grid), dim3(NTHR), LDS_BYTES, stream, a);
#endif
}
```

```cpp
#include <hip/hip_runtime.h>
#include <cstdio>
#include <cstdint>
namespace pg8 {
#define PG8_LAS __attribute__((address_space(3)))
typedef unsigned short bf16_t;
typedef short bf16x8 __attribute__((ext_vector_type(8)));
typedef float f32x4 __attribute__((ext_vector_type(4)));
typedef unsigned u32x4 __attribute__((ext_vector_type(4)));
constexpr int BM = 256, BK = 64, HALF = 128, HTB = HALF * BK * 2  , STAGE_BYTES = 8 * HTB, NXCD = 8, WGM = 8;

__host__ __device__ __forceinline__ int lds_byte(int r, int c) { const int st = (r >> 4) * 2 + (c >> 5), rr = r & 15, cc = c & 31, ob = rr * 64 + cc * 2; return st * 1024 + (ob ^ (((ob >> 9) & 1) << 5)); }
__host__ __device__ __forceinline__ void stage_rc(int b, int& R, int& C) { const int st = b / 1024, sb = b % 1024, swz = sb ^ (((sb >> 9) & 1) << 5); R = (st >> 1) * 16 + swz / 64; C = (st & 1) * 32 + (swz % 64) / 2; }
__host__ __device__ __forceinline__ int perm32(int rho) { const int n = rho >> 4, i = rho & 15; return 8 * (i >> 2) + 4 * n + (i & 3); }

struct Unit { int pm, pn; };
struct Gemm { const bf16_t* A; const bf16_t* Bt; int M, N, K; };

struct StaticOrder {
    int nM, nN, nwg, G, c;
    __host__ __device__ void init(int M, int N, int G_, int c_) { nM = M / BM; nN = N / BM; nwg = nM * nN; G = G_; c = c_; }
    __host__ __device__ bool next(int i, Unit& u) const {
        const long L = (long)i * G + c; if (L >= nwg) return false;
        int wgid = (int)L; { const int q = nwg / NXCD, r = nwg % NXCD, xcd = wgid % NXCD, off = wgid / NXCD; wgid = (xcd < r ? xcd * (q + 1) : r * (q + 1) + (xcd - r) * q) + off; }
        const int nig = WGM * nN, gid = wgid / nig, fm = gid * WGM, gsz = (nM - fm) < WGM ? (nM - fm) : WGM;
        u.pm = fm + ((wgid % nig) % gsz); u.pn = (wgid % nig) / gsz; return true;
    }
    __device__ __forceinline__ void a_ready(const Unit&) const {}
    __device__ __forceinline__ void done(const Unit&) const {}
};

__device__ __forceinline__ unsigned cvt_pk_bf16(float lo, float hi) { unsigned r; asm volatile("v_cvt_pk_bf16_f32 %0, %1, %2" : "=v"(r) : "v"(lo), "v"(hi)); return r; }
__device__ __forceinline__ float fast_sigmoid(float x) { return __builtin_amdgcn_rcpf(1.0f + __builtin_amdgcn_exp2f(-1.44269504089f * x)); }

constexpr int HLD = 2816;
constexpr float QSCALE = 0.125f * 1.44269504089f;

struct EpiInProj {
    static constexpr bool PERM = true, AFTER_DRAIN = false, GATHER = false;
    bf16_t* H; float* side; const float* rope;
    __device__ __forceinline__ void operator()(const f32x4 (&acc)[2][2][4][2], const Unit& u, int wr, int wc, int fr, int fq) const {
        const int row0 = u.pm * BM + wr * 64 + fr; const int pn = u.pn;
        if (pn <= 4) {
#pragma unroll
            for (int ai = 0; ai < 2; ++ai)
#pragma unroll
                for (int m = 0; m < 4; ++m) {
                    const int row = row0 + ai * HALF + m * 16; const float* rp = rope + (size_t)(row & 4095) * 16;
                    const f32x4 c0 = *(const f32x4*)(rp), c1 = *(const f32x4*)(rp + 4), s0 = *(const f32x4*)(rp + 8), s1 = *(const f32x4*)(rp + 12);
#pragma unroll
                    for (int bj = 0; bj < 2; ++bj) {
                        f32x4 v0 = acc[ai][bj][m][0], v1 = acc[ai][bj][m][1];
                        const bool ropeb = (pn < 2) || (bj == 0);
                        if (ropeb) {
                            f32x4 p0, p1;
#pragma unroll
                            for (int e = 0; e < 4; ++e) { p0[e] = __shfl_xor(v0[e], 16); p1[e] = __shfl_xor(v1[e], 16); }
                            if (((wc & 1) == 0) && fq < 2) { const float sg = fq ? 1.f : -1.f; v0 = v0 * c0 + (p0 * s0) * sg; v1 = v1 * c1 + (p1 * s1) * sg; }
                        }
                        if (pn < 2) { v0 = v0 * QSCALE; v1 = v1 * QSCALE; }
                        u32x4 w; w.x = cvt_pk_bf16(v0[0], v0[1]); w.y = cvt_pk_bf16(v0[2], v0[3]); w.z = cvt_pk_bf16(v1[0], v1[1]); w.w = cvt_pk_bf16(v1[2], v1[3]);
                        *(u32x4*)(H + (size_t)row * HLD + pn * BM + bj * HALF + wc * 32 + 8 * fq) = w;
                    }
                }
        } else if (pn < 11) {
#pragma unroll
            for (int ai = 0; ai < 2; ++ai)
#pragma unroll
                for (int m = 0; m < 4; ++m) {
                    const int row = row0 + ai * HALF + m * 16;
#pragma unroll
                    for (int bj = 0; bj < 2; ++bj) {
                        const f32x4 v0 = acc[ai][bj][m][0], v1 = acc[ai][bj][m][1];
                        u32x4 w; w.x = cvt_pk_bf16(v0[0], v0[1]); w.y = cvt_pk_bf16(v0[2], v0[3]); w.z = cvt_pk_bf16(v1[0], v1[1]); w.w = cvt_pk_bf16(v1[2], v1[3]);
                        *(u32x4*)(H + (size_t)row * HLD + pn * BM + bj * HALF + wc * 32 + 8 * fq) = w;
                    }
                }
        } else if (wc == 0) {
#pragma unroll
            for (int ai = 0; ai < 2; ++ai)
#pragma unroll
                for (int m = 0; m < 4; ++m) {
                    const int row = row0 + ai * HALF + m * 16;
                    f32x4 v0 = acc[ai][0][m][0], v1 = acc[ai][0][m][1];
#pragma unroll
                    for (int e = 0; e < 4; ++e) { v0[e] = fast_sigmoid(v0[e]); if (fq < 3) v1[e] = fast_sigmoid(v1[e]); }
                    *(f32x4*)(side + (size_t)row * 32 + 8 * fq) = v0; *(f32x4*)(side + (size_t)row * 32 + 8 * fq + 4) = v1;
                }
        }
    }
};
struct EpiOutProj {
    static constexpr bool PERM = false, AFTER_DRAIN = false, GATHER = false;
    const float* res; float* out; float alpha;
    __device__ __forceinline__ void operator()(const f32x4 (&acc)[2][2][4][2], const Unit& u, int wr, int wc, int fr, int fq) const {
        const int row0 = u.pm * BM + wr * 64 + fr, col0 = u.pn * BM + wc * 32 + 4 * fq;
#pragma unroll
        for (int ai = 0; ai < 2; ++ai)
#pragma unroll
            for (int m = 0; m < 4; ++m) { const size_t off = (size_t)(row0 + ai * HALF + m * 16) * 1024 + col0;
#pragma unroll
                for (int bj = 0; bj < 2; ++bj)
#pragma unroll
                    for (int n = 0; n < 2; ++n) { const f32x4 r = *(const f32x4*)(res + off + bj * HALF + n * 16); *(f32x4*)(out + off + bj * HALF + n * 16) = r * alpha + acc[ai][bj][m][n]; }
                asm volatile("" ::: "memory"); }
    }
};
struct EpiSwiGLU {
    static constexpr bool PERM = true, AFTER_DRAIN = false, GATHER = true;
    bf16_t* hid; const int* rowmap; int rowshift;
    __device__ __forceinline__ void operator()(const f32x4 (&acc)[2][2][4][2], const Unit& u, int wr, int wc, int fr, int fq) const {
        const int row0 = u.pm * BM + wr * 64 + fr, hc0 = (u.pn & 3) * 128 + wc * 16 + 4 * fq;
#pragma unroll
        for (int ai = 0; ai < 2; ++ai)
#pragma unroll
            for (int m = 0; m < 4; ++m) { bf16_t* rowp = hid + (size_t)(row0 + ai * HALF + m * 16) * 512 + hc0;
#pragma unroll
                for (int bj = 0; bj < 2; ++bj) { const f32x4 g = acc[ai][bj][m][0], up = acc[ai][bj][m][1]; f32x4 h;
#pragma unroll
                    for (int e = 0; e < 4; ++e) h[e] = g[e] * fast_sigmoid(g[e]) * up[e];
                    typedef unsigned u32x2 __attribute__((ext_vector_type(2)));
                    u32x2 w; w.x = cvt_pk_bf16(h[0], h[1]); w.y = cvt_pk_bf16(h[2], h[3]);
                    *(u32x2*)(rowp + bj * 64) = w; } }
    }
};
struct EpiDown {
    static constexpr bool PERM = true, AFTER_DRAIN = false, GATHER = false;
    bf16_t* y2; const int* slot_tok; const float* slot_w;
    __device__ __forceinline__ void operator()(const f32x4 (&acc)[2][2][4][2], const Unit& u, int wr, int wc, int fr, int fq) const {
        const int row0 = u.pm * BM + wr * 64 + fr, col0 = (u.pn & 3) * BM + wc * 32 + 8 * fq;
#pragma unroll
        for (int ai = 0; ai < 2; ++ai)
#pragma unroll
            for (int m = 0; m < 4; ++m) { const int row = row0 + ai * HALF + m * 16; const int st = slot_tok[row]; const float sw = slot_w[row];
                if (st >= 0) { bf16_t* rowp = y2 + (size_t)st * 1024 + col0;
#pragma unroll
                    for (int bj = 0; bj < 2; ++bj) { const f32x4 v0 = acc[ai][bj][m][0] * sw, v1 = acc[ai][bj][m][1] * sw;
                        u32x4 w; w.x = cvt_pk_bf16(v0[0], v0[1]); w.y = cvt_pk_bf16(v0[2], v0[3]); w.z = cvt_pk_bf16(v1[0], v1[1]); w.w = cvt_pk_bf16(v1[2], v1[3]);
                        *(u32x4*)(rowp + bj * HALF) = w; } } }
    }
};
struct MoeOrder {
    const int* meta; int G, c;
    __device__ __forceinline__ bool next(int i, Unit& u) const {
        const int per = G >> 3; const int idx = (G & 7) ? (i * G + c) : ((i * 8 + (c & 7)) * per + (c >> 3));
        const int nt = meta[0]; if (idx >= nt * 4) return false;
        const int pm = idx >> 2; u.pm = pm; u.pn = meta[64 + pm] * 4 + (idx & 3); return true;
    }
    __device__ __forceinline__ void a_ready(const Unit&) const {}
    __device__ __forceinline__ void done(const Unit&) const {}
};
template <class Epi, class Sched, bool STAMP = false>
__device__ __forceinline__ void gemm_phase(PG8_LAS unsigned char* lds, const Gemm g, const Sched& S, const Epi& E, unsigned long long* stamps, int tid_in) {
    int tid_ = tid_in; asm volatile("" : "+v"(tid_));
    const int tid = tid_, wid = __builtin_amdgcn_readfirstlane(tid >> 6), lane = tid & 63, wr = wid >> 2, wc = wid & 3, fr = lane & 15, fq = lane >> 4;
    const int K = g.K, nt = K / BK;
    int ts_lo = 0, ts_hi = 0, nts = 0; const unsigned long long rt_entry = STAMP ? (unsigned long long)wall_clock64() : 0ull;
#define PG8_STAMP() do { if (STAMP && wid == 0 && nts < 64) { const unsigned long long _c = (unsigned long long)clock64(); \
        ts_lo = (lane == nts) ? (int)(unsigned)_c : ts_lo; ts_hi = (lane == nts) ? (int)(unsigned)(_c >> 32) : ts_hi; ++nts; } } while (0)
    PG8_STAMP();
    unsigned voffA[2], voffB[2];
#pragma unroll
    for (int i = 0; i < 2; ++i) { int R, C; stage_rc(tid * 16 + i * 8192, R, C); const int Rb = Epi::PERM ? ((R & ~31) + perm32(R & 31)) : R;
        voffA[i] = (unsigned)(R * K + C) * 2u; voffB[i] = (unsigned)(Rb * K + C) * 2u; }
    unsigned offAc[2][2], offAn[2][2];
    PG8_LAS unsigned char* gidx = lds + STAGE_BYTES + (unsigned)wid * 1024u;
#define PG8_IDX_DMA(par, pm_) do { int t2_ = tid; asm volatile("" : "+v"(t2_)); _Pragma("unroll") for (int i_ = 0; i_ < 2; ++i_) { int R_, C_; stage_rc(t2_ * 16 + i_ * 8192, R_, C_); (void)C_; \
        _Pragma("unroll") for (int h_ = 0; h_ < 2; ++h_) __builtin_amdgcn_global_load_lds((const unsigned*)(E.rowmap + (size_t)(pm_) * BM + h_ * HALF + R_), (PG8_LAS unsigned*)(gidx + (par) * 512 + (h_ * 2 + i_) * 256), 4, 0, 0); } } while (0)
#define PG8_IDX_READ(dst, par) do { int t2_ = tid; asm volatile("" : "+v"(t2_)); _Pragma("unroll") for (int i_ = 0; i_ < 2; ++i_) { int R_, C_; stage_rc(t2_ * 16 + i_ * 8192, R_, C_); (void)R_; \
        _Pragma("unroll") for (int h_ = 0; h_ < 2; ++h_) { int r_ = *(const PG8_LAS int*)(gidx + (par) * 512 + (h_ * 2 + i_) * 256 + (t2_ & 63) * 4); r_ = r_ < 0 ? 0 : (r_ >> E.rowshift); dst[h_][i_] = (unsigned)r_ * (unsigned)(K * 2) + (unsigned)C_ * 2u; } } } while (0)
    const size_t kstep = (size_t)(BK * 2);
    const size_t hstep = (size_t)HALF * K * 2;
    const size_t tstep = 2 * hstep;
    const unsigned ldsw = (unsigned)wid * 1024u;
    const int aoff = lds_byte(wr * 64 + fr, fq * 8), boff = lds_byte(wc * 32 + fr, fq * 8);
#define PG8_SA(b, h) (((b) * 2 + (h)) * HTB)
#define PG8_SB(b, h) ((4 + (b) * 2 + (h)) * HTB)
#define PG8_STAGE(bufoff, gbase, voff) do { _Pragma("unroll") for (int _i = 0; _i < 2; ++_i) \
        __builtin_amdgcn_global_load_lds((const unsigned*)((const char*)(gbase) + (voff)[_i]), (PG8_LAS unsigned*)(lds + (bufoff) + ldsw + _i * 8192), 16, 0, 0); } while (0)
#define PG8_STAGE_A(bufoff, kt_, h_, nx_) do { if constexpr (Epi::GATHER) { _Pragma("unroll") for (int _i = 0; _i < 2; ++_i) { const unsigned o_ = (nx_) ? offAn[h_][_i] : offAc[h_][_i]; \
            __builtin_amdgcn_global_load_lds((const unsigned*)((const char*)g.A + (size_t)(kt_) * kstep + o_), (PG8_LAS unsigned*)(lds + (bufoff) + ldsw + _i * 8192), 16, 0, 0); } } \
        else { PG8_STAGE(bufoff, ((nx_) ? nA : cA) + (size_t)(kt_) * kstep + (h_) * hstep, voffA); } } while (0)
#define PG8_LDA(dst, b, h) do { _Pragma("unroll") for (int m = 0; m < 4; ++m) _Pragma("unroll") for (int k = 0; k < 2; ++k) dst[m][k] = *(const PG8_LAS bf16x8*)(lds + PG8_SA(b, h) + aoff + m * 2048 + k * 1024); } while (0)
#define PG8_LDB(dst, b, h) do { _Pragma("unroll") for (int n = 0; n < 2; ++n) _Pragma("unroll") for (int k = 0; k < 2; ++k) dst[n][k] = *(const PG8_LAS bf16x8*)(lds + PG8_SB(b, h) + boff + n * 2048 + k * 1024); } while (0)
#define PG8_MMA(ai, bj, At, Bt) do { __builtin_amdgcn_s_setprio(1); _Pragma("unroll") for (int m = 0; m < 4; ++m) _Pragma("unroll") for (int n = 0; n < 2; ++n) _Pragma("unroll") for (int k = 0; k < 2; ++k) \
        acc[ai][bj][m][n] = __builtin_amdgcn_mfma_f32_16x16x32_bf16(Bt[n][k], At[m][k], acc[ai][bj][m][n], 0, 0, 0); __builtin_amdgcn_s_setprio(0); } while (0)
#define PG8_WAIT_V(n) asm volatile("s_waitcnt vmcnt(" #n ")" ::: "memory")
#define PG8_WAIT_L(n) asm volatile("s_waitcnt lgkmcnt(" #n ")" ::: "memory")
#define PG8_BAR __builtin_amdgcn_s_barrier()
#define PG8_SCHED __builtin_amdgcn_sched_barrier(0)
    Unit cur, nxt; int ui = 0;
    if (!S.next(0, cur)) return;
    f32x4 acc[2][2][4][2];
    float zf_ = 0.f; asm volatile("" : "+v"(zf_));
#pragma unroll
    for (int a = 0; a < 2; ++a)
#pragma unroll
        for (int b = 0; b < 2; ++b)
#pragma unroll
            for (int m = 0; m < 4; ++m)
#pragma unroll
                for (int n = 0; n < 2; ++n) acc[a][b][m][n] = (f32x4){zf_, zf_, zf_, zf_};
    bf16x8 At[4][2], B0[2][2], B1[2][2];
    const char* cA = (const char*)g.A + (size_t)cur.pm * tstep; const char* cB = (const char*)g.Bt + (size_t)cur.pn * tstep;
    S.a_ready(cur);
    if constexpr (Epi::GATHER) { PG8_IDX_DMA(0, cur.pm); asm volatile("s_waitcnt vmcnt(0)" ::: "memory"); PG8_IDX_READ(offAc, 0); asm volatile("s_waitcnt lgkmcnt(0)" ::: "memory"); }
    const char* nA = cA;
    PG8_STAGE(PG8_SB(0, 0), cB, voffB); PG8_STAGE_A(PG8_SA(0, 0), 0, 0, false); PG8_STAGE(PG8_SB(0, 1), cB + hstep, voffB); PG8_STAGE_A(PG8_SA(0, 1), 0, 1, false);
    if (wr == 1) PG8_BAR;
    PG8_WAIT_V(4); PG8_BAR;
    PG8_STAGE(PG8_SB(1, 0), cB + kstep, voffB); PG8_STAGE_A(PG8_SA(1, 0), 1, 0, false); PG8_STAGE(PG8_SB(1, 1), cB + hstep + kstep, voffB);
    PG8_WAIT_V(6); PG8_BAR;
    PG8_STAMP();
    for (;;) {
        const bool has_next = S.next(ui + 1, nxt);
        nA = has_next ? (const char*)g.A + (size_t)nxt.pm * tstep : cA; const char* nB = has_next ? (const char*)g.Bt + (size_t)nxt.pn * tstep : cB;
        if constexpr (Epi::GATHER) { if (has_next) PG8_IDX_DMA((ui + 1) & 1, nxt.pm); }
        for (int t = 0; t < nt; t += 2) {
            const bool last = (t == nt - 2);
            const char* b2 = last ? nB : cB + (size_t)(t + 2) * kstep;
            const char* b3 = b2 + kstep;
            const int kt2 = last ? 0 : t + 2;
            if constexpr (Epi::GATHER) { if (last) { if (has_next) PG8_IDX_READ(offAn, (ui + 1) & 1); else { offAn[0][0] = offAc[0][0]; offAn[0][1] = offAc[0][1]; offAn[1][0] = offAc[1][0]; offAn[1][1] = offAc[1][1]; } } }
            if (last && has_next) S.a_ready(nxt);
            PG8_LDB(B0, 0, 0); PG8_SCHED; PG8_LDA(At, 0, 0); PG8_STAGE_A(PG8_SA(1, 1), t + 1, 1, false);
            PG8_WAIT_L(8); PG8_BAR; PG8_WAIT_L(0); PG8_MMA(0, 0, At, B0); PG8_BAR; PG8_SCHED;
            PG8_LDB(B1, 0, 1); PG8_STAGE(PG8_SB(0, 0), b2, voffB);
            PG8_BAR; PG8_WAIT_L(0); PG8_MMA(0, 1, At, B1); PG8_BAR;
            PG8_LDA(At, 0, 1); PG8_STAGE_A(PG8_SA(0, 0), kt2, 0, last);
            PG8_BAR; PG8_WAIT_L(0); PG8_MMA(1, 0, At, B0); PG8_BAR; PG8_SCHED;
            PG8_STAGE(PG8_SB(0, 1), b2 + hstep, voffB);
            PG8_WAIT_V(6); PG8_BAR; PG8_MMA(1, 1, At, B1); PG8_BAR;
            PG8_LDB(B0, 1, 0); PG8_SCHED; PG8_LDA(At, 1, 0); PG8_STAGE_A(PG8_SA(0, 1), kt2, 1, last);
            PG8_WAIT_L(8); PG8_BAR; PG8_WAIT_L(0); PG8_MMA(0, 0, At, B0); PG8_BAR; PG8_SCHED;
            PG8_LDB(B1, 1, 1); PG8_STAGE(PG8_SB(1, 0), b3, voffB);
            PG8_BAR; PG8_WAIT_L(0); PG8_MMA(0, 1, At, B1); PG8_BAR;
            PG8_LDA(At, 1, 1); PG8_STAGE_A(PG8_SA(1, 0), kt2 + 1, 0, last);
            PG8_BAR; PG8_WAIT_L(0); PG8_MMA(1, 0, At, B0); PG8_BAR; PG8_SCHED;
            PG8_STAGE(PG8_SB(1, 1), b3 + hstep, voffB);
            PG8_WAIT_V(6); PG8_BAR; PG8_MMA(1, 1, At, B1); PG8_BAR;
        }
        PG8_STAMP();
        if constexpr (!Epi::AFTER_DRAIN) { E(acc, cur, wr, wc, fr, fq); S.done(cur); }
        PG8_STAMP();
        if (!has_next) break;
#pragma unroll
        for (int a = 0; a < 2; ++a)
#pragma unroll
            for (int b = 0; b < 2; ++b)
#pragma unroll
                for (int m = 0; m < 4; ++m)
#pragma unroll
                    for (int n = 0; n < 2; ++n) acc[a][b][m][n] = (f32x4){zf_, zf_, zf_, zf_};
        cur = nxt; cA = nA; cB = nB; ++ui;
        if constexpr (Epi::GATHER) { offAc[0][0] = offAn[0][0]; offAc[0][1] = offAn[0][1]; offAc[1][0] = offAn[1][0]; offAc[1][1] = offAn[1][1]; }
    }
    PG8_WAIT_V(0);
    if (wr == 0) PG8_BAR;
    PG8_BAR;
    if constexpr (Epi::AFTER_DRAIN) { E.fused(acc, cur, wr, wc, fr, fq, lds, wid, lane); S.done(cur); }
    PG8_STAMP();
    if (STAMP && wid == 0) { stamps[lane] = lane < nts ? (((unsigned long long)(unsigned)ts_hi << 32) | (unsigned)ts_lo) : 0ull;
        if (lane == 62) stamps[62] = rt_entry; if (lane == 63) stamps[63] = (unsigned long long)wall_clock64(); }
#undef PG8_STAMP
#undef PG8_SA
#undef PG8_SB
#undef PG8_STAGE
#undef PG8_STAGE_A
#undef PG8_IDX_DMA
#undef PG8_IDX_READ
#undef PG8_LDA
#undef PG8_LDB
#undef PG8_MMA
#undef PG8_WAIT_V
#undef PG8_WAIT_L
#undef PG8_BAR
#undef PG8_SCHED
}
}

#ifndef SELFCHECK
#define SELFCHECK 0
#endif
#ifndef PROBE_ATTN_VAR
#define PROBE_ATTN_VAR 0
#endif
constexpr int NB = 8, SEQ = 4096, DM = 1024, NL = 4, T = NB * SEQ;
constexpr int DIN = 2848, DINP = 3072, HLD = pg8::HLD;
constexpr int NEXP = 32, FF = 512, NTILE_MAX = 288;
constexpr float LN_EPS = 1e-5f;
constexpr float DN_ALPHA = 1.6817928305074290f;
constexpr int NWAVES = 8, NTHR = 512;

constexpr size_t MiB = 1u << 20, KiB = 1u << 10;
constexpr size_t WS_CTL = 0, CTL_ZERO_BYTES = 128 * KiB;
constexpr size_t WS_ROPE = 1 * MiB;
constexpr size_t WS_META = 1 * MiB + 512 * KiB;
constexpr size_t WS_GL = WS_META + 16 * KiB;
constexpr size_t WS_WL = 2 * MiB;
constexpr size_t WL_WIN = 0, WL_WOUT = 6 * MiB, WL_WGU = 8 * MiB, WL_WDN = 72 * MiB, WL_W1 = 104 * MiB, WL_W2 = 105 * MiB, WL_BIAS1 = 105 * MiB + 64 * KiB, WL_WR = 105 * MiB + 128 * KiB;
constexpr size_t WS_XB = 108 * MiB;
constexpr size_t WS_X1 = 172 * MiB;
constexpr size_t WS_H = 300 * MiB;
constexpr size_t WS_SIDE = 476 * MiB;
constexpr size_t WS_Y = 480 * MiB;
constexpr size_t WS_GPREP = 544 * MiB;
constexpr size_t WS_Y2 = 672 * MiB;
constexpr size_t WS_HID = 800 * MiB;
constexpr size_t WS_KC = 872 * MiB, WS_VC = WS_KC + 512 * KiB;
constexpr size_t WS_SLOT = 873 * MiB;
constexpr size_t SL_TOK = 0, SL_W = 512 * KiB, SL_RE = 1024 * KiB, SL_RP = 1280 * KiB, SL_RW = 1536 * KiB;
constexpr size_t WS_END = 876 * MiB;
constexpr int GCH = 65536;
constexpr int GC_UT = 0, GC_W = 8192, GC_QK = 16384, GC_QD = 24576, GC_KDT = 32768, GC_ZT = 40960, GC_SS = 49152, GC_VB = 57344;
constexpr int CW_TMO = 0;
constexpr int CW_BAR = 4096;
constexpr int CW_CNT = 8192;
constexpr int CW_QUEUE = 12288;
static_assert((CW_QUEUE + NL * 64) * 4 <= (int)CTL_ZERO_BYTES, "CTL words inside the memset region");

constexpr int SCR_BYTES = 159744;
constexpr int MISC_OFF = SCR_BYTES;
constexpr int LDS_BYTES = 163840;

#define GAS __attribute__((address_space(1)))
#define LAS __attribute__((address_space(3)))
typedef unsigned short bf16;
typedef float f32x4 __attribute__((ext_vector_type(4)));
typedef float f32x2 __attribute__((ext_vector_type(2)));
typedef float f32x16 __attribute__((ext_vector_type(16)));
typedef short bf16x8 __attribute__((ext_vector_type(8)));
typedef short s16x4 __attribute__((ext_vector_type(4)));
typedef unsigned u32x4 __attribute__((ext_vector_type(4)));
typedef unsigned u32x2 __attribute__((ext_vector_type(2)));
#define LDS_WAIT() asm volatile("s_waitcnt lgkmcnt(0)" ::: "memory")
#define VM_WAIT() asm volatile("s_waitcnt vmcnt(0)" ::: "memory")
#define SBAR() __builtin_amdgcn_sched_barrier(0)
__device__ __forceinline__ float bf2f(unsigned b) { return __uint_as_float(b << 16); }
__device__ __forceinline__ unsigned f2bf(float f) { unsigned u = __float_as_uint(f); return (u + 0x7fffu + ((u >> 16) & 1u)) >> 16; }
__device__ __forceinline__ unsigned pk2(float lo, float hi) { return pg8::cvt_pk_bf16(lo, hi); }
__device__ __forceinline__ float row16_sum(float x) {
    x += __int_as_float(__builtin_amdgcn_update_dpp(0, __float_as_int(x), 0xB1, 0xf, 0xf, true));
    x += __int_as_float(__builtin_amdgcn_update_dpp(0, __float_as_int(x), 0x4E, 0xf, 0xf, true));
    x += __int_as_float(__builtin_amdgcn_update_dpp(0, __float_as_int(x), 0x141, 0xf, 0xf, true));
    x += __int_as_float(__builtin_amdgcn_update_dpp(0, __float_as_int(x), 0x140, 0xf, 0xf, true));
    return x;
}
__device__ __forceinline__ float wave_sum(float v) {
    const int r = __float_as_int(row16_sum(v));
    return (__int_as_float(__builtin_amdgcn_readlane(r, 0)) + __int_as_float(__builtin_amdgcn_readlane(r, 16))) + (__int_as_float(__builtin_amdgcn_readlane(r, 32)) + __int_as_float(__builtin_amdgcn_readlane(r, 48)));
}
__device__ __forceinline__ float fsigmoid(float x) { return pg8::fast_sigmoid(x); }
__device__ __forceinline__ float fsilu(float x) { return x * pg8::fast_sigmoid(x); }
__device__ __forceinline__ float fexp2(float x) { return __builtin_amdgcn_exp2f(x); }

#define XB_TMO      128
#define XB_XCNT(j)  (256  + 64 * (j))
#define XB_XSUB(j)  (1280 + 64 * (j))
#define XB_XGEN(j)  (2304 + 64 * (j))
#define XB_TOP      3328
#define XB_TOPGEN   3392
#define XCD_BAR_WORDS 3456
#define XB_SPIN_CAP (1u << 18)
#define LAS __attribute__((address_space(3)))

__device__ __forceinline__ unsigned xb_ld(unsigned* p)              { return __hip_atomic_load(p, __ATOMIC_RELAXED, __HIP_MEMORY_SCOPE_AGENT); }
__device__ __forceinline__ unsigned xb_add(unsigned* p, unsigned v) { return __hip_atomic_fetch_add(p, v, __ATOMIC_RELAXED, __HIP_MEMORY_SCOPE_AGENT); }
__device__ __forceinline__ unsigned xb_xcc_id() { return (unsigned)__builtin_amdgcn_s_getreg((3 << 11) | 20) & 0xFu; }
#define XB_SPIN(cond, bar) do { unsigned _sp = 0; while (cond) { __builtin_amdgcn_s_sleep(1); \
    if ((++_sp & 255u) == 0u) { if (xb_ld(&(bar)[XB_TMO])) break; if (_sp > XB_SPIN_CAP) { atomicAdd(&(bar)[XB_TMO], 1u); break; } } } } while (0)

struct XcdBarrier {
    unsigned* bar; unsigned x;
    volatile LAS unsigned* st;
};

__device__ __forceinline__ XcdBarrier xcd_barrier_post(unsigned* bar, volatile LAS unsigned* st) {
    XcdBarrier b; b.bar = bar; b.x = xb_xcc_id(); b.st = st;
    if (threadIdx.x == 0) (void)xb_add(&bar[XB_XCNT(b.x)], 1u);
    return b;
}
__device__ __forceinline__ void xcd_barrier_complete(unsigned* bar, unsigned x, unsigned& nloc, unsigned& nx) {
    const unsigned G = gridDim.x * gridDim.y * gridDim.z;
    unsigned sum, cnt, mine, sp = 0u;
    for (;;) {
        sum = 0u; cnt = 0u; mine = 0u;
#pragma unroll
        for (unsigned j = 0; j < 16; ++j) { const unsigned c = xb_ld(&bar[XB_XCNT(j)]); sum += c; cnt += (c > 0u) ? 1u : 0u; mine = (j == x) ? c : mine; }
        if (sum == G) break;
        __builtin_amdgcn_s_sleep(1);
        if ((++sp & 255u) == 0u) { if (xb_ld(&bar[XB_TMO])) break; if (sp > XB_SPIN_CAP) { atomicAdd(&bar[XB_TMO], 1u); break; } }
    }
    nloc = mine > 0u ? mine : 1u; nx = cnt > 0u ? cnt : 1u;
}

__device__ __forceinline__ void xcd_barrier(const XcdBarrier& b) {
    asm volatile("s_waitcnt vmcnt(0)" ::: "memory");
    __syncthreads();
    if (threadIdx.x == 0) {
        unsigned* bar = b.bar;
        __builtin_amdgcn_s_waitcnt(0);
        unsigned nloc = b.st[0], nx = b.st[1];
        if (nloc == 0u) { xcd_barrier_complete(bar, b.x, nloc, nx); b.st[0] = nloc; b.st[1] = nx; }
        const unsigned old = xb_add(&bar[XB_XSUB(b.x)], 1u);
        const unsigned gen = old / nloc;
        if (old + 1u == (gen + 1u) * nloc) {
            __builtin_amdgcn_fence(__ATOMIC_RELEASE, "agent");
            asm volatile("s_waitcnt vmcnt(0)" ::: "memory");
            const unsigned og = xb_add(&bar[XB_TOP], 1u);
            const unsigned tg = og / nx;
            if (og + 1u == (tg + 1u) * nx) xb_add(&bar[XB_TOPGEN], 1u);
            else XB_SPIN(xb_ld(&bar[XB_TOPGEN]) == tg, bar);
            __builtin_amdgcn_fence(__ATOMIC_ACQUIRE, "agent");
            xb_add(&bar[XB_XGEN(b.x)], 1u);
            asm volatile("s_waitcnt vmcnt(0)" ::: "memory");
        } else {
            XB_SPIN(xb_ld(&bar[XB_XGEN(b.x)]) == gen, bar);
            __builtin_amdgcn_fence(__ATOMIC_ACQUIRE, "agent");
            asm volatile("s_waitcnt vmcnt(0)" ::: "memory");
        }
    }
    __syncthreads();
}

struct Args { const float* in[25]; float* out; unsigned char* ws; int ph_lo, ph_hi; };
typedef const __attribute__((address_space(4))) Args* ArgsP;
__device__ __forceinline__ ArgsP args_here() { ArgsP p = (ArgsP)__builtin_amdgcn_kernarg_segment_ptr(); asm volatile("" : "+s"(p)); return p; }
struct Frame { LAS unsigned char* lds; volatile LAS unsigned* MISC; unsigned* ctl; int tid, lane, wave, G, bid; };

template <class Src>
__device__ __forceinline__ void tr_item(const Src src, int K, int N, bf16* WT, LAS float* scr, int item, int lane) {
    const int nblk = N >> 5, kb = item / nblk, nb = item - kb * nblk, k0 = kb << 6, n0 = nb << 5;
    float tv[32];
#pragma unroll
    for (int i = 0; i < 32; ++i) tv[i] = src(k0 + 2 * i + (lane >> 5), n0 + (lane & 31));
#pragma unroll
    for (int i = 0; i < 32; ++i) scr[(2 * i + (lane >> 5)) * 33 + (lane & 31)] = tv[i];
    LDS_WAIT();
    const int c = lane & 7;
#pragma unroll
    for (int j = 0; j < 4; ++j) { const int n = (lane >> 3) + 8 * j; const LAS float* s = scr + (8 * c) * 33 + n;
        u32x4 o; o.x = pk2(s[0], s[33]); o.y = pk2(s[66], s[99]); o.z = pk2(s[132], s[165]); o.w = pk2(s[198], s[231]);
        *(u32x4*)(WT + (size_t)(n0 + n) * K + k0 + 8 * c) = o; }
    LDS_WAIT();
}
struct SrcPlain { const float* p; int ld; __device__ __forceinline__ float operator()(int k, int n) const { return p[(size_t)k * ld + n]; } };
struct SrcWin { const float* p;
    __device__ __forceinline__ float operator()(int k, int n) const {
        int c;
        if (n < 1280) c = n; else if (n < 2048) c = n + 24; else if (n < 2304) c = n + 24; else if (n < 2816) c = n + 32;
        else if (n < 2840) c = n - 2816 + 1280; else if (n < 2844) c = n - 2840 + 2328; else if (n < 2848) c = n - 2844 + 2332; else return 0.f;
        return p[(size_t)k * DIN + c]; } };
struct SrcGU { const float* wg; const float* wu;
    __device__ __forceinline__ float operator()(int k, int n) const { const int q = n >> 3, r = n & 7; const ptrdiff_t d = (r < 4) ? (ptrdiff_t)0 : (wu - wg); return wg[d + (ptrdiff_t)k * FF + 4 * q + (r & 3)]; } };

__device__ __forceinline__ void phase_weights(const Frame& F, ArgsP a, int l) {
    unsigned char* wl = a->ws + WS_WL;
    LAS float* scr = (LAS float*)(F.lds + F.wave * 16384);
    const int gw = F.bid * NWAVES + F.wave, NGW = F.G * NWAVES;
    constexpr int I_WIN = 16 * 96, I_WOUT = 16 * 32, I_GU1 = 16 * 32, I_GU = NEXP * I_GU1, I_DN1 = 8 * 32, I_DN = NEXP * I_DN1, I_W1 = 2 * 32 * 4, I_W2 = 2 * 2 * 2, I_WR = 36, I_B1 = 256;
    constexpr int NITEMS = I_WIN + I_WOUT + I_GU + I_DN + I_W1 + I_W2 + I_WR + I_B1;
    for (int it = gw; it < NITEMS; it += NGW) {
        int r = it;
        if (r < I_GU) { const int e = r / I_GU1; SrcGU s{a->in[22] + ((size_t)l * NEXP + e) * DM * FF, a->in[23] + ((size_t)l * NEXP + e) * DM * FF};
            tr_item(s, DM, 1024, (bf16*)(wl + WL_WGU) + (size_t)e * 1024 * DM, scr, r - e * I_GU1, F.lane); continue; } r -= I_GU;
        if (r < I_DN) { const int e = r / I_DN1; SrcPlain s{a->in[24] + ((size_t)l * NEXP + e) * FF * DM, DM};
            tr_item(s, FF, DM, (bf16*)(wl + WL_WDN) + (size_t)e * DM * FF, scr, r - e * I_DN1, F.lane); continue; } r -= I_DN;
        if (r < I_WIN) { SrcWin s{a->in[1] + (size_t)l * DM * DIN}; tr_item(s, DM, DINP, (bf16*)(wl + WL_WIN), scr, r, F.lane); continue; } r -= I_WIN;
        if (r < I_WOUT) { SrcPlain s{a->in[2] + (size_t)l * DM * DM, DM}; tr_item(s, DM, DM, (bf16*)(wl + WL_WOUT), scr, r, F.lane); continue; } r -= I_WOUT;
        if (r < I_W1) { const int kv = r / 128; SrcPlain s{a->in[4] + ((size_t)l * 2 + kv) * 2048 * 128, 128};
            tr_item(s, 2048, 128, (bf16*)(wl + WL_W1) + (size_t)kv * 128 * 2048, scr, r - kv * 128, F.lane); continue; } r -= I_W1;
        if (r < I_W2) { const int kv = r / 4; SrcPlain s{a->in[5] + ((size_t)l * 2 + kv) * 128 * 64, 64};
            tr_item(s, 128, 64, (bf16*)(wl + WL_W2) + (size_t)kv * 64 * 128, scr, r - kv * 4, F.lane); continue; } r -= I_W2;
        if (r < I_WR) {
            float* wr = (float*)(wl + WL_WR) + (size_t)r * DM;
            for (int k = F.lane; k < DM; k += 64) wr[k] = (r < 4) ? a->in[18][((size_t)l * DM + k) * 4 + r] : a->in[20][((size_t)l * DM + k) * NEXP + (r - 4)];
            continue; } r -= I_WR;
        {
            const int kv = r >> 7, n = r & 127; const float* pe = a->in[3] + ((size_t)l * 2 + kv) * 2048; const float* w1 = a->in[4] + ((size_t)l * 2 + kv) * 2048 * 128;
            float s = 0.f; for (int k = F.lane; k < 2048; k += 64) s += pe[k] * w1[(size_t)k * 128 + n];
            s = wave_sum(s); if (F.lane == 0) ((float*)(wl + WL_BIAS1))[r] = s;
        }
    }
}

__device__ __forceinline__ void phase_prologue(const Frame& F, ArgsP a) {
    const size_t gt = (size_t)F.bid * NTHR + F.tid, NGT = (size_t)F.G * NTHR;
    float* rope = (float*)(a->ws + WS_ROPE);
    for (size_t i = gt; i < (size_t)SEQ * 8; i += NGT) { const int t = (int)(i >> 3), f = (int)(i & 7);
        const float invt[8] = {1.0f, 0.19392274f, 0.03760603f, 0.0072926646f, 0.0014142136f, 0.0002742482f, 5.3182957e-05f, 1.0313385e-05f};
        float inv = invt[0];
#pragma unroll
        for (int q = 1; q < 8; ++q) inv = (f == q) ? invt[q] : inv;
        const float ang = (float)t * inv;
        const double rev = (double)ang * 0.15915494309189535; const float fr = (float)(rev - __builtin_rint(rev));
        rope[t * 16 + f] = __builtin_amdgcn_cosf(fr); rope[t * 16 + 8 + f] = __builtin_amdgcn_sinf(fr); }
    const f32x4* x4 = (const f32x4*)a->in[0]; u32x4* xb = (u32x4*)(a->ws + WS_XB);
    for (size_t i = gt; i < (size_t)T * DM / 8; i += NGT) { const f32x4 v0 = x4[2 * i], v1 = x4[2 * i + 1];
        u32x4 w; w.x = pk2(v0[0], v0[1]); w.y = pk2(v0[2], v0[3]); w.z = pk2(v1[0], v1[1]); w.w = pk2(v1[2], v1[3]); xb[i] = w; }
}

template <bool DRY>
__device__ __forceinline__ void phase_ln1_router(const Frame& F, ArgsP a, int l) {
    float* X1 = (float*)(a->ws + WS_X1); bf16* XB = (bf16*)(a->ws + WS_XB);
    const float* WR = (const float*)(a->ws + WS_WL + WL_WR);
    const float* lw = a->in[14] + (size_t)l * DM; const float* lb = a->in[15] + (size_t)l * DM;
    const float* bg = a->in[19] + l * 4; const float* be = a->in[21] + l * NEXP;
    int* route_e = (int*)(a->ws + WS_SLOT + SL_RE); int* route_p = (int*)(a->ws + WS_SLOT + SL_RP); float* route_w = (float*)(a->ws + WS_SLOT + SL_RW);
    unsigned* cnt = F.ctl + CW_CNT + (DRY ? l + 4 : l) * 512;
    const int gw = F.bid * NWAVES + F.wave, NGW = F.G * NWAVES, lane = F.lane;
    LAS float* wgl = (LAS float*)F.lds;
    for (int i = F.tid; i < 4 * DM; i += NTHR) wgl[i] = WR[i];
    __syncthreads();
    const float bg0 = bg[0], bg1 = bg[1], bg2 = bg[2], bg3 = bg[3];
    for (int tg = gw; tg < T / 4; tg += NGW) {
        f32x4 v[4][4];
#pragma unroll
        for (int tk = 0; tk < 4; ++tk) { const f32x4* row = (const f32x4*)(X1 + (size_t)(4 * tg + tk) * DM) + lane;
#pragma unroll
            for (int j = 0; j < 4; ++j) v[tk][j] = row[64 * j]; }
#pragma unroll
        for (int tk = 0; tk < 4; ++tk) {
            float s = 0.f;
#pragma unroll
            for (int j = 0; j < 4; ++j) s += (v[tk][j][0] + v[tk][j][1]) + (v[tk][j][2] + v[tk][j][3]);
            const float mean = wave_sum(s) * (1.f / DM); float q = 0.f;
#pragma unroll
            for (int j = 0; j < 4; ++j) { v[tk][j] = v[tk][j] - mean; q += (v[tk][j][0] * v[tk][j][0] + v[tk][j][1] * v[tk][j][1]) + (v[tk][j][2] * v[tk][j][2] + v[tk][j][3] * v[tk][j][3]); }
            const float rstd = 1.f / sqrtf(wave_sum(q) * (1.f / DM) + LN_EPS);
            f32x4* orow = (f32x4*)(X1 + (size_t)(4 * tg + tk) * DM) + lane; u32x2* brow = (u32x2*)(XB + (size_t)(4 * tg + tk) * DM) + lane;
#pragma unroll
            for (int j = 0; j < 4; ++j) { const f32x4 w4 = ((const f32x4*)lw)[lane + 64 * j], b4 = ((const f32x4*)lb)[lane + 64 * j];
                v[tk][j] = v[tk][j] * rstd * w4 + b4; if (!DRY) orow[64 * j] = v[tk][j];
                u32x2 w; w.x = pk2(v[tk][j][0], v[tk][j][1]); w.y = pk2(v[tk][j][2], v[tk][j][3]); if (!DRY) brow[64 * j] = w; }
        }
        float glg[4][4];
#pragma unroll
        for (int j = 0; j < 4; ++j) { const LAS f32x4* wr = (const LAS f32x4*)(wgl + j * DM) + lane; const f32x4 w0 = wr[0], w1 = wr[64], w2 = wr[128], w3 = wr[192];
#pragma unroll
            for (int tk = 0; tk < 4; ++tk) { f32x4 p = v[tk][0] * w0; p = p + v[tk][1] * w1; p = p + v[tk][2] * w2; p = p + v[tk][3] * w3; glg[tk][j] = wave_sum((p[0] + p[1]) + (p[2] + p[3])); } }
        int my_e = 0; float my_w = 0.f;
#pragma unroll
        for (int tk = 0; tk < 4; ++tk) {
            const float g0 = glg[tk][0] + bg0, g1 = glg[tk][1] + bg1, g2 = glg[tk][2] + bg2, g3 = glg[tk][3] + bg3;
            int gi = 0; float gm = g0; if (g1 > gm) { gm = g1; gi = 1; } if (g2 > gm) { gm = g2; gi = 2; } if (g3 > gm) { gm = g3; gi = 3; }
            gi = __builtin_amdgcn_readfirstlane(gi);
            const float g_w = 1.f / (__expf(g0 - gm) + __expf(g1 - gm) + __expf(g2 - gm) + __expf(g3 - gm));
            const float* wbase = WR + (size_t)(4 + gi * 8) * DM; float ev[8];
#pragma unroll
            for (int i4 = 0; i4 < 2; ++i4) { f32x4 w[4][4];
#pragma unroll
                for (int i = 0; i < 4; ++i) { const f32x4* wr = (const f32x4*)(wbase + (size_t)(4 * i4 + i) * DM) + lane; w[i][0] = wr[0]; w[i][1] = wr[64]; w[i][2] = wr[128]; w[i][3] = wr[192]; }
#pragma unroll
                for (int i = 0; i < 4; ++i) { f32x4 p = v[tk][0] * w[i][0]; p = p + v[tk][1] * w[i][1]; p = p + v[tk][2] * w[i][2]; p = p + v[tk][3] * w[i][3];
                    ev[4 * i4 + i] = wave_sum((p[0] + p[1]) + (p[2] + p[3])) + be[gi * 8 + 4 * i4 + i]; } }
            int i1 = 0; float v1 = ev[0];
#pragma unroll
            for (int i = 1; i < 8; ++i) if (ev[i] > v1) { v1 = ev[i]; i1 = i; }
            int i2 = -1; float v2 = -3.0e38f;
#pragma unroll
            for (int i = 0; i < 8; ++i) if (i != i1 && ev[i] > v2) { v2 = ev[i]; i2 = i; }
            const float e2 = __expf(v2 - v1), w1 = g_w / (1.f + e2), w2 = g_w - w1;
            if (lane == 2 * tk) { my_e = gi * 8 + i1; my_w = w1; }
            if (lane == 2 * tk + 1) { my_e = gi * 8 + i2; my_w = w2; }
        }
        if (lane < 8) {
            const unsigned pos = __hip_atomic_fetch_add(cnt + my_e * 16, 1u, __ATOMIC_RELAXED, __HIP_MEMORY_SCOPE_AGENT);
            const size_t si = (size_t)tg * 8 + lane; if (!DRY) { route_e[si] = my_e; route_p[si] = (int)pos; route_w[si] = my_w; }
        }
    }
    __syncthreads();
}

__device__ __forceinline__ void phase_gather(const Frame& F, ArgsP a, int l) {
    LAS int* pstart = (LAS int*)F.lds;
    unsigned* cnt = F.ctl + CW_CNT + l * 512;
    int* meta = (int*)(a->ws + WS_META) + l * 512;
    int* slot_tok = (int*)(a->ws + WS_SLOT + SL_TOK); float* slot_w = (float*)(a->ws + WS_SLOT + SL_W);
    const int* route_e = (const int*)(a->ws + WS_SLOT + SL_RE); const int* route_p = (const int*)(a->ws + WS_SLOT + SL_RP); const float* route_w = (const float*)(a->ws + WS_SLOT + SL_RW);
    if (F.tid < 64) {
        const int c = F.tid < 32 ? (int)__hip_atomic_load(cnt + F.tid * 16, __ATOMIC_RELAXED, __HIP_MEMORY_SCOPE_AGENT) : 0;
        const int pad = (c + 255) & ~255; int inc = pad;
#pragma unroll
        for (int o = 1; o < 64; o <<= 1) { const int t = __shfl_up(inc, o); if (F.lane >= o) inc += t; }
        const int st = inc - pad;
        if (F.tid < 32) { pstart[F.tid] = st;
            if (F.bid == 0) { for (int t = st >> 8; t < (st + pad) >> 8; ++t) meta[64 + t] = F.tid; if (F.tid == 31) meta[0] = (st + pad) >> 8; }
            if ((F.tid % F.G) == F.bid) for (int r = st + c; r < st + pad; ++r) { slot_tok[r] = -1; slot_w[r] = 0.f; }
        }
    }
    __syncthreads();
    for (int s = F.bid * NTHR + F.tid; s < T * 2; s += F.G * NTHR) {
        const int dest = pstart[route_e[s]] + route_p[s]; slot_tok[dest] = s; slot_w[dest] = route_w[s];
    }
    __syncthreads();
}

__device__ __forceinline__ void phase_ln2(const Frame& F, ArgsP a, int l) {
    const float* X1 = (const float*)(a->ws + WS_X1); const bf16* Y2 = (const bf16*)(a->ws + WS_Y2); bf16* XB = (bf16*)(a->ws + WS_XB); float* out = a->out;
    const float* lw = a->in[16] + (size_t)l * DM; const float* lb = a->in[17] + (size_t)l * DM;
    const int gw = F.bid * NWAVES + F.wave, NGW = F.G * NWAVES, lane = F.lane;
    for (int t = gw; t < T; t += NGW) {
        const f32x4* row = (const f32x4*)(X1 + (size_t)t * DM) + lane; const u32x2* ya = (const u32x2*)(Y2 + (size_t)(2 * t) * DM) + lane; const u32x2* yb = (const u32x2*)(Y2 + (size_t)(2 * t + 1) * DM) + lane;
        f32x4 v[4]; float s = 0.f;
#pragma unroll
        for (int j = 0; j < 4; ++j) { const f32x4 x = row[64 * j]; const u32x2 p = ya[64 * j], q = yb[64 * j];
            v[j][0] = x[0] * DN_ALPHA + (bf2f(p.x & 0xffffu) + bf2f(q.x & 0xffffu)); v[j][1] = x[1] * DN_ALPHA + (bf2f(p.x >> 16) + bf2f(q.x >> 16));
            v[j][2] = x[2] * DN_ALPHA + (bf2f(p.y & 0xffffu) + bf2f(q.y & 0xffffu)); v[j][3] = x[3] * DN_ALPHA + (bf2f(p.y >> 16) + bf2f(q.y >> 16));
            s += (v[j][0] + v[j][1]) + (v[j][2] + v[j][3]); }
        const float mean = wave_sum(s) * (1.f / DM); float q2 = 0.f;
#pragma unroll
        for (int j = 0; j < 4; ++j) { v[j] = v[j] - mean; q2 += (v[j][0] * v[j][0] + v[j][1] * v[j][1]) + (v[j][2] * v[j][2] + v[j][3] * v[j][3]); }
        const float rstd = 1.f / sqrtf(wave_sum(q2) * (1.f / DM) + LN_EPS);
        f32x4* orow = (f32x4*)(out + (size_t)t * DM) + lane; u32x2* brow = (u32x2*)(XB + (size_t)t * DM) + lane;
#pragma unroll
        for (int j = 0; j < 4; ++j) { const f32x4 w4 = ((const f32x4*)lw)[lane + 64 * j], b4 = ((const f32x4*)lb)[lane + 64 * j];
            const f32x4 o = v[j] * rstd * w4 + b4; orow[64 * j] = o; u32x2 w; w.x = pk2(o[0], o[1]); w.y = pk2(o[2], o[3]); brow[64 * j] = w; }
    }
}

__device__ __forceinline__ int tsw(int row, int col) { return row * 128 + ((((col >> 3) ^ (row >> 1)) & 7) << 4) + ((col & 7) << 1); }
__device__ __forceinline__ f32x4 mfma16(bf16x8 a, bf16x8 b, f32x4 c) { return __builtin_amdgcn_mfma_f32_16x16x32_bf16(a, b, c, 0, 0, 0); }
__device__ __forceinline__ f32x16 mfma32(bf16x8 a, bf16x8 b, f32x16 c) { return __builtin_amdgcn_mfma_f32_32x32x16_bf16(a, b, c, 0, 0, 0); }
__device__ __forceinline__ bf16x8 as_bf16x8(u32x4 v) { return __builtin_bit_cast(bf16x8, v); }

__device__ __forceinline__ void conformer_item(const Frame& F, ArgsP a, int l, int it) {
    const int b = it >> 6, s0 = (it & 63) * 64; const size_t tok0 = (size_t)b * SEQ + s0;
    const bf16* H = (const bf16*)(a->ws + WS_H); bf16* Y = (bf16*)(a->ws + WS_Y);
    LAS bf16* ut = (LAS bf16*)F.lds;
    LAS float* co = (LAS float*)(F.lds + 49152);
    for (int idx = F.tid; idx < 94 * 32; idx += NTHR) {
        const int r = idx >> 5, c8 = (idx & 31) * 8, s = s0 - 30 + r; u32x4 w = {0u, 0u, 0u, 0u};
        if (s >= 0) { const bf16* hp = H + ((size_t)b * SEQ + s) * HLD + 2304 + c8; const u32x4 v = *(const u32x4*)hp, g = *(const u32x4*)(hp + 256);
#pragma unroll
            for (int e = 0; e < 4; ++e) { const float v0 = bf2f(v[e] & 0xffffu) * fsigmoid(bf2f(g[e] & 0xffffu)), v1 = bf2f(v[e] >> 16) * fsigmoid(bf2f(g[e] >> 16)); w[e] = pk2(v0, v1); } }
        *(LAS u32x4*)(ut + r * 256 + c8) = w;
    }
    __syncthreads();
    {
        const int c = F.tid & 255, half = F.tid >> 8; const float* dw = a->in[10] + (size_t)l * 31 * 256 + c; const float bias = a->in[11][l * 256 + c];
        float w[31], ur[62];
#pragma unroll
        for (int k = 0; k < 31; ++k) w[k] = dw[k * 256];
#pragma unroll
        for (int i = 0; i < 62; ++i) ur[i] = bf2f(ut[(32 * half + i) * 256 + c]);
#pragma unroll
        for (int tt = 0; tt < 32; ++tt) { float acc = bias;
#pragma unroll
            for (int k = 0; k < 31; ++k) acc += w[k] * ur[tt + k];
            co[(32 * half + tt) * 256 + c] = acc; }
    }
    __syncthreads();
    {
        const float* lw = a->in[12] + l * 256; const float* lb = a->in[13] + l * 256; const f32x4 w4 = ((const f32x4*)lw)[F.lane], b4 = ((const f32x4*)lb)[F.lane];
#pragma unroll
        for (int i = 0; i < 8; ++i) { const int tl = 8 * F.wave + i; f32x4 v = *(LAS f32x4*)(co + tl * 256 + 4 * F.lane);
            const float mean = wave_sum((v[0] + v[1]) + (v[2] + v[3])) * (1.f / 256.f); v = v - mean;
            const float rstd = 1.f / sqrtf(wave_sum((v[0] * v[0] + v[1] * v[1]) + (v[2] * v[2] + v[3] * v[3])) * (1.f / 256.f) + LN_EPS);
            v = v * rstd * w4 + b4; u32x2 o; o.x = pk2(fsilu(v[0]), fsilu(v[1])); o.y = pk2(fsilu(v[2]), fsilu(v[3]));
            *(u32x2*)(Y + (tok0 + tl) * DM + 768 + 4 * F.lane) = o; }
    }
    __syncthreads();
}

__device__ __forceinline__ void compress_item(const Frame& F, ArgsP a, int it) {
    const int kv = it >> 7, bh = (it >> 3) & 15, b = bh >> 1, hh = bh & 1, i0 = (it & 7) * 32;
    const bf16* H = (const bf16*)(a->ws + WS_H); const bf16* w1t = (const bf16*)(a->ws + WS_WL + WL_W1) + (size_t)kv * 128 * 2048; const bf16* w2t = (const bf16*)(a->ws + WS_WL + WL_W2) + (size_t)kv * 64 * 128;
    const float* bias1 = (const float*)(a->ws + WS_WL + WL_BIAS1) + kv * 128; bf16* outp = (bf16*)(a->ws + (kv ? WS_VC : WS_KC)) + (size_t)bh * 256 * 64;
    LAS bf16* hid = (LAS bf16*)F.lds;
    const int lane = F.lane, li = lane & 15, g = lane >> 4, rt = F.wave & 1, cq = F.wave >> 1;
    const int i = i0 + 16 * rt + li; const bf16* arow = H + (size_t)b * SEQ * HLD + 512 + kv * 128 + hh * 64 + 8 * g;
    const bf16* brow = w1t + (size_t)(32 * cq + li) * 2048 + 8 * g;
    f32x4 acc[2] = {{0.f, 0.f, 0.f, 0.f}, {0.f, 0.f, 0.f, 0.f}};
#pragma unroll 1
    for (int k8 = 0; k8 < 64; k8 += 8) {
        bf16x8 af[8], bfr[8][2];
#pragma unroll
        for (int u = 0; u < 8; ++u) { const int ks = k8 + u; int s = 16 * i + (ks >> 1); s = s > SEQ - 1 ? SEQ - 1 : s;
            af[u] = *(const bf16x8*)(arow + (size_t)s * HLD + (ks & 1) * 32); bfr[u][0] = *(const bf16x8*)(brow + ks * 32); bfr[u][1] = *(const bf16x8*)(brow + (size_t)16 * 2048 + ks * 32); }
#pragma unroll
        for (int u = 0; u < 8; ++u) { acc[0] = mfma16(af[u], bfr[u][0], acc[0]); acc[1] = mfma16(af[u], bfr[u][1], acc[1]); }
    }
#pragma unroll
    for (int nt = 0; nt < 2; ++nt) { const int n = 32 * cq + 16 * nt + li; const float bs = bias1[n];
#pragma unroll
        for (int r = 0; r < 4; ++r) hid[(16 * rt + 4 * g + r) * 136 + n] = (bf16)f2bf(fsilu(acc[nt][r] + bs)); }
    __syncthreads();
    f32x4 o2 = {0.f, 0.f, 0.f, 0.f};
#pragma unroll
    for (int ks = 0; ks < 4; ++ks) { const bf16x8 af = *(LAS bf16x8*)(hid + (16 * rt + li) * 136 + 32 * ks + 8 * g);
        const bf16x8 bfr = *(const bf16x8*)(w2t + (size_t)(16 * cq + li) * 128 + 32 * ks + 8 * g); o2 = mfma16(af, bfr, o2); }
#pragma unroll
    for (int r = 0; r < 4; ++r) { const int io = i0 + 16 * rt + 4 * g + r; outp[(size_t)io * 64 + 16 * cq + li] = (bf16)(io < 255 ? f2bf(o2[r]) : 0u); }
    __syncthreads();
}

__host__ __device__ constexpr int tri_off(int i) { int s = 0; for (int k = 0; k < i; ++k) s += (k + 3) >> 2; return 4 * s; }
__device__ __forceinline__ int tri_off_rt(int i) { const int m = i - 1, V = (m + 3) >> 2; return i <= 0 ? 0 : 4 * (2 * V * (V - 1) + V * (m - 4 * V + 4)); }

template <int I> struct GdnSolveRow {
    __device__ static __forceinline__ void run(const LAS float* Ap, float (&x)[64]) {
        if constexpr (I < 64) {
            constexpr int off = tri_off(I), nb = (I + 3) >> 2;
            float a0 = x[I];
#pragma unroll
            for (int jb = 0; jb < nb; ++jb) { const f32x4 a4 = *(const LAS f32x4*)(Ap + off + 4 * jb);
#pragma unroll
                for (int jj = 0; jj < 4; ++jj) { if (4 * jb + jj < I) a0 -= a4[jj] * x[4 * jb + jj]; } }
            x[I] = a0;
            if constexpr ((I & 3) == 3) SBAR();
            GdnSolveRow<I + 1>::run(Ap, x);
        }
    }
};

__device__ __forceinline__ void gdn_prep_chunk(const Frame& F, ArgsP a, int l, int ci, LAS unsigned char* wl) {
    int lane_ = F.lane; asm volatile("" : "+v"(lane_));
    const int lane = lane_, li = lane & 15, g = lane >> 4; const int bh = ci >> 6, n = ci & 63, b = bh >> 2, h = bh & 3; const size_t tok0 = (size_t)b * SEQ + 64 * n;
    const bf16* H = (const bf16*)(a->ws + WS_H); const float* side = (const float*)(a->ws + WS_SIDE);
    unsigned char* rec = a->ws + WS_GPREP + (size_t)ci * GCH;
    bf16* R0 = (bf16*)(rec + GC_UT); bf16* R1 = (bf16*)(rec + GC_W); bf16* QKm = (bf16*)(rec + GC_QK); bf16* QD = (bf16*)(rec + GC_QD); bf16* KDT = (bf16*)(rec + GC_KDT); bf16* ZT = (bf16*)(rec + GC_ZT);
    const int pc = (lane & 32) | (((lane & 15) >> 2) << 3) | (((lane >> 4) & 1) << 2) | (lane & 3);
    LAS unsigned char* qt = wl; LAS unsigned char* kt = wl + 8192; LAS float* Ap = (LAS float*)wl;
    const float beta = side[(tok0 + lane) * 32 + 24 + h]; const float av = side[(tok0 + lane) * 32 + 28 + h] + a->in[8][l * 4 + h];
    const float sp = av > 20.f ? av : log1pf(__expf(av)); float gc = -__expf(a->in[7][l * 4 + h]) * sp;
#pragma unroll
    for (int o = 1; o < 64; o <<= 1) { const float t = __shfl_up(gc, o); if (lane >= o) gc += t; }
    const float gl = __shfl(gc, 63); const float eg = __expf(gc), ekd = __expf(gl - gc);
    if (lane == 0) ((float*)(a->ws + WS_GL))[ci] = __expf(gl);
    const float* cw = a->in[6] + (size_t)l * 4 * 768 + h * 64 + lane; float wq[4], wk[4], wv[4];
#pragma unroll
    for (int k = 0; k < 4; ++k) { wq[k] = cw[k * 768]; wk[k] = cw[k * 768 + 256]; wv[k] = cw[k * 768 + 512]; }
    const bf16* hp = H + tok0 * HLD + 1280 + h * 64 + lane; float hq[3], hk[3], hv[3];
#pragma unroll
    for (int j = 0; j < 3; ++j) { const bool ok = (64 * n - 3 + j) >= 0; const bf16* p = hp + (ptrdiff_t)(j - 3) * HLD;
        hq[j] = ok ? bf2f(p[0]) : 0.f; hk[j] = ok ? bf2f(p[256]) : 0.f; hv[j] = ok ? bf2f(p[512]) : 0.f; }
    unsigned short ra[8][3], rb[8][3];
#define GDN_LOADBLK(dst, t8_) do { const bf16* pl_ = hp + (size_t)(8 * (t8_)) * HLD; asm volatile("" : "+v"(pl_)); _Pragma("unroll") for (int tt = 0; tt < 8; ++tt) { const bf16* q_ = pl_ + (size_t)tt * HLD; dst[tt][0] = q_[0]; dst[tt][1] = q_[256]; dst[tt][2] = q_[512]; } } while (0)
#define GDN_CONVBLK(src, t8_) do { const int t8 = (t8_); unsigned kdp[4]; \
        bf16* qd8 = QD + (8 * t8) * 64 + pc; bf16* r08 = R0 + (8 * t8) * 64 + lane; bf16* r18 = R1 + (8 * t8) * 64 + lane; asm volatile("" : "+v"(qd8), "+v"(r08), "+v"(r18)); \
        _Pragma("unroll") for (int tt = 0; tt < 8; ++tt) { const int t = 8 * t8 + tt; \
            const float rq = bf2f(src[tt][0]), rk = bf2f(src[tt][1]), rv = bf2f(src[tt][2]); \
            const float cq = wq[0] * hq[0] + wq[1] * hq[1] + wq[2] * hq[2] + wq[3] * rq, ck = wk[0] * hk[0] + wk[1] * hk[1] + wk[2] * hk[2] + wk[3] * rk, cv = wv[0] * hv[0] + wv[1] * hv[1] + wv[2] * hv[2] + wv[3] * rv; \
            hq[0] = hq[1]; hq[1] = hq[2]; hq[2] = rq; hk[0] = hk[1]; hk[1] = hk[2]; hk[2] = rk; hv[0] = hv[1]; hv[1] = hv[2]; hv[2] = rv; \
            const float qs = fsilu(cq), ks_ = fsilu(ck), vs = fsilu(cv); \
            const float qn = qs * __builtin_amdgcn_rsqf(wave_sum(qs * qs) + 1e-6f) * 0.125f, kn = ks_ * __builtin_amdgcn_rsqf(wave_sum(ks_ * ks_) + 1e-6f); \
            const float bt = __int_as_float(__builtin_amdgcn_readlane(__float_as_int(beta), t)), egt = __int_as_float(__builtin_amdgcn_readlane(__float_as_int(eg), t)), ekt = __int_as_float(__builtin_amdgcn_readlane(__float_as_int(ekd), t)); \
            *(LAS bf16*)(qt + tsw(t, lane)) = (bf16)f2bf(qn); *(LAS bf16*)(kt + tsw(t, lane)) = (bf16)f2bf(kn); \
            qd8[tt * 64] = (bf16)f2bf(qn * egt); r08[tt * 64] = (bf16)f2bf(bt * vs); r18[tt * 64] = (bf16)f2bf(bt * egt * kn); \
            const unsigned kd = f2bf(kn * ekt); if (tt & 1) kdp[tt >> 1] |= kd << 16; else kdp[tt >> 1] = kd; } \
        { const int c0 = (8 * t8) & 31, gg = (c0 & 15) >> 2, hh = c0 >> 4; bf16* kr = KDT + lane * 64 + ((8 * t8) & 32) + 4 * hh; \
          u32x2 w0, w1; w0.x = kdp[0]; w0.y = kdp[1]; w1.x = kdp[2]; w1.y = kdp[3]; *(u32x2*)(kr + 8 * gg) = w0; *(u32x2*)(kr + 8 * gg + 8) = w1; } } while (0)
    GDN_LOADBLK(ra, 0);
#pragma unroll 1
    for (int t16 = 0; t16 < 4; ++t16) {
        GDN_LOADBLK(rb, 2 * t16 + 1);
        GDN_CONVBLK(ra, 2 * t16);
        if (t16 < 3) GDN_LOADBLK(ra, 2 * t16 + 2);
        GDN_CONVBLK(rb, 2 * t16 + 1);
    }
#undef GDN_LOADBLK
#undef GDN_CONVBLK
    {
        const float nwl = a->in[9][l * 64 + lane];
        for (int t8 = 0; t8 < 8; ++t8) { unsigned zp[4];
#pragma unroll
            for (int tt = 0; tt < 8; ++tt) { const unsigned zg = f2bf(fsilu(bf2f(hp[(size_t)(8 * t8 + tt) * HLD + 768])) * nwl); if (tt & 1) zp[tt >> 1] |= zg << 16; else zp[tt >> 1] = zg; }
            u32x4 wz; wz.x = zp[0]; wz.y = zp[1]; wz.z = zp[2]; wz.w = zp[3]; *(u32x4*)(ZT + lane * 64 + 8 * t8) = wz; }
    }
    LDS_WAIT();
    float gcj[4][4];
#pragma unroll
    for (int mt = 0; mt < 4; ++mt)
#pragma unroll
        for (int r = 0; r < 4; ++r) gcj[mt][r] = __shfl(gc, 16 * mt + 4 * g + r);
    f32x4 ahold[4][4];
#pragma unroll
    for (int nt = 0; nt < 4; ++nt) {
        const int i = 16 * nt + li; const float gci = __shfl(gc, i), bi = __shfl(beta, i);
        bf16x8 kB[2], qB[2];
#pragma unroll
        for (int ks = 0; ks < 2; ++ks) { kB[ks] = *(LAS bf16x8*)(kt + tsw(i, 32 * ks + 8 * g)); qB[ks] = *(LAS bf16x8*)(qt + tsw(i, 32 * ks + 8 * g)); }
#pragma unroll
        for (int mt = 0; mt < 4; ++mt) {
            u32x2 qw = {0u, 0u};
            if (mt <= nt) {
                const bf16x8 kA0 = *(LAS bf16x8*)(kt + tsw(16 * mt + li, 8 * g)), kA1 = *(LAS bf16x8*)(kt + tsw(16 * mt + li, 32 + 8 * g));
                f32x4 ckk = {0.f, 0.f, 0.f, 0.f}, cqk = {0.f, 0.f, 0.f, 0.f};
                ckk = mfma16(kA0, kB[0], ckk); ckk = mfma16(kA1, kB[1], ckk); cqk = mfma16(kA0, qB[0], cqk); cqk = mfma16(kA1, qB[1], cqk);
                float qv[4];
#pragma unroll
                for (int r = 0; r < 4; ++r) { const int j = 16 * mt + 4 * g + r; const float dec = __expf(fminf(gci - gcj[mt][r], 0.f));
                    ahold[nt][mt][r] = bi * ckk[r] * dec; qv[r] = (j <= i) ? cqk[r] * dec : 0.f; }
                qw.x = pk2(qv[0], qv[1]); qw.y = pk2(qv[2], qv[3]);
            }
            *(u32x2*)(QKm + i * 64 + 32 * (mt >> 1) + 8 * g + 4 * (mt & 1)) = qw;
        }
    }
    LDS_WAIT(); SBAR();
#pragma unroll
    for (int nt = 0; nt < 4; ++nt) { const int i = 16 * nt + li; const int ro = tri_off_rt(i);
#pragma unroll
        for (int mt = 0; mt < 4; ++mt) if (mt <= nt) {
#pragma unroll
            for (int r = 0; r < 4; ++r) { const int j = 16 * mt + 4 * g + r; if (j < i) Ap[ro + j] = ahold[nt][mt][r]; } } }
    VM_WAIT(); LDS_WAIT();
#pragma unroll 1
    for (int pass = 0; pass < 2; ++pass) {
        bf16* Rp = pass ? R1 : R0; float x[64];
#pragma unroll
        for (int i = 0; i < 64; ++i) x[i] = bf2f(Rp[i * 64 + lane]);
        VM_WAIT();
        GdnSolveRow<1>::run(Ap, x);
        if (pass == 0) {
#pragma unroll
            for (int i8 = 0; i8 < 8; ++i8) { u32x4 w; w.x = pk2(x[8 * i8], x[8 * i8 + 1]); w.y = pk2(x[8 * i8 + 2], x[8 * i8 + 3]); w.z = pk2(x[8 * i8 + 4], x[8 * i8 + 5]); w.w = pk2(x[8 * i8 + 6], x[8 * i8 + 7]);
                *(u32x4*)(Rp + lane * 64 + 8 * i8) = w; }
        } else {
#pragma unroll
            for (int i = 0; i < 64; ++i) Rp[i * 64 + pc] = (bf16)f2bf(x[i]);
        }
    }
    LDS_WAIT();
}

__device__ __forceinline__ bf16x8 scan_frag(const unsigned char* mat, int mt, int ks, int li, int g) { return *(const bf16x8*)(mat + (16 * mt + li) * 128 + (32 * ks + 8 * g) * 2); }
__device__ __forceinline__ bf16x8 pack_c2(f32x4 a, f32x4 b) { u32x4 w; w.x = pk2(a[0], a[1]); w.y = pk2(a[2], a[3]); w.z = pk2(b[0], b[1]); w.w = pk2(b[2], b[3]); return as_bf16x8(w); }
struct ScanFr { bf16x8 W[4][2], KD[4][2]; u32x2 uu[4]; float egl; };
__device__ __forceinline__ void scan_load(ScanFr& f, const unsigned char* rec, float egl_, int dv0, int li, int g) {
#pragma unroll
    for (int mt = 0; mt < 4; ++mt) { f.W[mt][0] = scan_frag(rec + GC_W, mt, 0, li, g); f.W[mt][1] = scan_frag(rec + GC_W, mt, 1, li, g); f.uu[mt] = *(const u32x2*)(rec + GC_UT + (dv0 + li) * 128 + (16 * mt + 4 * g) * 2); }
#pragma unroll
    for (int mt = 0; mt < 4; ++mt) { f.KD[mt][0] = scan_frag(rec + GC_KDT, mt, 0, li, g); f.KD[mt][1] = scan_frag(rec + GC_KDT, mt, 1, li, g); }
    f.egl = egl_;
}
__device__ __forceinline__ void scan_step(const ScanFr& f, f32x4 (&S)[4], unsigned char* rec, int sl, int lane) {
    const bf16x8 Sb0 = pack_c2(S[0], S[1]), Sb1 = pack_c2(S[2], S[3]);
    bf16x8* ss = (bf16x8*)(rec + GC_SS + sl * 2048) + lane; ss[0] = Sb0; ss[64] = Sb1;
    f32x4 vn[4];
#pragma unroll
    for (int mt = 0; mt < 4; ++mt) {
        f32x4 acc = {0.f, 0.f, 0.f, 0.f};
        acc = mfma16(f.W[mt][0], Sb0, acc); acc = mfma16(f.W[mt][1], Sb1, acc);
        vn[mt][0] = bf2f(f.uu[mt].x & 0xffffu) - acc[0]; vn[mt][1] = bf2f(f.uu[mt].x >> 16) - acc[1]; vn[mt][2] = bf2f(f.uu[mt].y & 0xffffu) - acc[2]; vn[mt][3] = bf2f(f.uu[mt].y >> 16) - acc[3];
    }
    const bf16x8 Vb0 = pack_c2(vn[0], vn[1]), Vb1 = pack_c2(vn[2], vn[3]);
    bf16x8* vb = (bf16x8*)(rec + GC_VB + sl * 2048) + lane; vb[0] = Vb0; vb[64] = Vb1;
#pragma unroll
    for (int mt = 0; mt < 4; ++mt) { f32x4 acc = S[mt] * f.egl; acc = mfma16(f.KD[mt][0], Vb0, acc); acc = mfma16(f.KD[mt][1], Vb1, acc); S[mt] = acc; }
}
__device__ __forceinline__ void gdn_scan(const Frame& F, ArgsP a, int l) {
    const int lane = F.lane, li = lane & 15, g = lane >> 4, pr = F.wave >> 2, sl = F.wave & 3; const int bh = F.bid * 2 + pr, dv0 = 16 * sl;
    const float* GL = (const float*)(a->ws + WS_GL) + bh * 64; unsigned char* rec0 = a->ws + WS_GPREP + (size_t)bh * 64 * GCH;
    f32x4 S[4] = {{0.f, 0.f, 0.f, 0.f}, {0.f, 0.f, 0.f, 0.f}, {0.f, 0.f, 0.f, 0.f}, {0.f, 0.f, 0.f, 0.f}};
    ScanFr fa, fb;
    scan_load(fa, rec0, GL[0], dv0, li, g);
    unsigned tch = 0u;
#define SCAN_TOUCH(ptr) do { const void* tp_ = (const void*)(ptr); asm volatile("global_load_dword %0, %1, off" : "+v"(tch) : "v"(tp_) : "memory"); } while (0)
    for (int n = 0; n < 64; n += 2) {
        unsigned char* rn = rec0 + (size_t)n * GCH;
        { const unsigned char* t3 = rec0 + (size_t)(n + 3 < 64 ? n + 3 : 63) * GCH; SCAN_TOUCH(t3 + GC_W + lane * 128); SCAN_TOUCH(t3 + GC_KDT + lane * 128); SCAN_TOUCH(t3 + GC_UT + (dv0 + li) * 128); }
        scan_load(fb, rn + GCH, GL[n + 1], dv0, li, g);
        scan_step(fa, S, rn, sl, lane);
        { const unsigned char* t4 = rec0 + (size_t)(n + 4 < 64 ? n + 4 : 63) * GCH; SCAN_TOUCH(t4 + GC_W + lane * 128); SCAN_TOUCH(t4 + GC_KDT + lane * 128); SCAN_TOUCH(t4 + GC_UT + (dv0 + li) * 128); }
        if (n + 2 < 64) scan_load(fa, rn + 2 * (size_t)GCH, GL[n + 2], dv0, li, g);
        scan_step(fb, S, rn + GCH, sl, lane);
    }
#undef SCAN_TOUCH
    asm volatile("s_waitcnt vmcnt(0)" ::: "memory"); asm volatile("" :: "v"(tch));
}

__device__ __forceinline__ void gdn_out_chunk(const Frame& F, ArgsP a, int ci, LAS unsigned char* wl) {
    int lane_ = F.lane; asm volatile("" : "+v"(lane_)); const int lane = lane_, li = lane & 15, g = lane >> 4; const int bh = ci >> 6, n = ci & 63, b = bh >> 2, h = bh & 3;
    const unsigned char* rec = a->ws + WS_GPREP + (size_t)ci * GCH; bf16* Y = (bf16*)(a->ws + WS_Y);
    bf16x8 QDf[4][2], QKf[4][2];
#pragma unroll
    for (int mt = 0; mt < 4; ++mt) { QDf[mt][0] = scan_frag(rec + GC_QD, mt, 0, li, g); QDf[mt][1] = scan_frag(rec + GC_QD, mt, 1, li, g); QKf[mt][0] = scan_frag(rec + GC_QK, mt, 0, li, g); QKf[mt][1] = scan_frag(rec + GC_QK, mt, 1, li, g); }
    float ssq[4][4];
#pragma unroll
    for (int mt = 0; mt < 4; ++mt)
#pragma unroll
        for (int r = 0; r < 4; ++r) ssq[mt][r] = 0.f;
    f32x4 o[4][4];
#pragma unroll
    for (int sl = 0; sl < 4; ++sl) {
        const bf16x8* ss = (const bf16x8*)(rec + GC_SS + sl * 2048) + lane; const bf16x8* vb = (const bf16x8*)(rec + GC_VB + sl * 2048) + lane;
        const bf16x8 Sb0 = ss[0], Sb1 = ss[64], Vb0 = vb[0], Vb1 = vb[64];
#pragma unroll
        for (int mt = 0; mt < 4; ++mt) {
            f32x4 acc = {0.f, 0.f, 0.f, 0.f};
            acc = mfma16(QDf[mt][0], Sb0, acc); acc = mfma16(QDf[mt][1], Sb1, acc); acc = mfma16(QKf[mt][0], Vb0, acc); acc = mfma16(QKf[mt][1], Vb1, acc);
            o[sl][mt] = acc;
#pragma unroll
            for (int r = 0; r < 4; ++r) ssq[mt][r] += acc[r] * acc[r];
        }
    }
#pragma unroll
    for (int mt = 0; mt < 4; ++mt)
#pragma unroll
        for (int r = 0; r < 4; ++r) ssq[mt][r] = __builtin_amdgcn_rsqf(row16_sum(ssq[mt][r]) * (1.f / 64.f) + 1e-6f);
#pragma unroll
    for (int sl = 0; sl < 4; ++sl)
#pragma unroll
        for (int mt = 0; mt < 4; ++mt) {
            const u32x2 zz = *(const u32x2*)(rec + GC_ZT + (16 * sl + li) * 128 + (16 * mt + 4 * g) * 2);
            const float zf[4] = {bf2f(zz.x & 0xffffu), bf2f(zz.x >> 16), bf2f(zz.y & 0xffffu), bf2f(zz.y >> 16)};
#pragma unroll
            for (int r = 0; r < 4; ++r) *(LAS bf16*)(wl + tsw(16 * mt + 4 * g + r, 16 * sl + li)) = (bf16)f2bf(o[sl][mt][r] * ssq[mt][r] * zf[r]);
        }
    LDS_WAIT();
    bf16* yrow = Y + ((size_t)b * SEQ + 64 * n + lane) * DM + 512 + h * 64;
#pragma unroll
    for (int c = 0; c < 8; ++c) *(u32x4*)(yrow + 8 * c) = *(const LAS u32x4*)(wl + tsw(lane, 8 * c));
    LDS_WAIT();
}

constexpr int AT_K = 0, AT_V = 32768, AT_IMP = 65536, AT_SELM = AT_IMP + 64 * 68 * 4, AT_UNI = AT_SELM + 512, AT_YS = 83968;
__device__ __forceinline__ s16x4 tr_read0(unsigned addr) { s16x4 r; asm volatile("ds_read_b64_tr_b16 %0, %1" : "=&v"(r) : "v"(addr) : "memory"); return r; }

__device__ __forceinline__ float half_max(float x) { auto rr = __builtin_amdgcn_permlane32_swap(__float_as_uint(x), __float_as_uint(x), false, false); return fmaxf(__uint_as_float(rr[0]), __uint_as_float(rr[1])); }
__device__ __forceinline__ float half_sum(float x) { auto rr = __builtin_amdgcn_permlane32_swap(__float_as_uint(x), __float_as_uint(x), false, false); return __uint_as_float(rr[0]) + __uint_as_float(rr[1]); }
struct AttnStage { u32x4 kr, vr; };
__device__ __forceinline__ void at_gload(AttnStage& st, const bf16* Kb, const bf16* Vb, size_t stride, int j, int tid) {
    const int row = tid >> 3, ch = tid & 7; const size_t off = (size_t)(64 * j + row) * stride + 8 * ch;
    st.kr = *(const u32x4*)(Kb + off); st.vr = *(const u32x4*)(Vb + off);
}
__device__ __forceinline__ void at_swrite(const AttnStage& st, LAS unsigned char* lds, int buf, int tid) {
    const int row = tid >> 3, ch = tid & 7; const int o = row * 128 + (((ch ^ (row >> 1)) & 7) << 4);
    *(LAS u32x4*)(lds + AT_K + buf * 8192 + o) = st.kr; *(LAS u32x4*)(lds + AT_V + buf * 8192 + o) = st.vr;
}
__device__ __forceinline__ void at_qk(const LAS unsigned char* Kt, const bf16x8 (&Qf)[4], int r, int hf, f32x16 (&s)[2], float cinit) {
    const int swz = (r >> 1) & 7;
    bf16x8 kf[2][4];
#pragma unroll
    for (int kt = 0; kt < 2; ++kt)
#pragma unroll
        for (int ks = 0; ks < 4; ++ks) kf[kt][ks] = *(const LAS bf16x8*)(Kt + (32 * kt + r) * 128 + (((2 * ks + hf) ^ swz) << 4));
    SBAR();
#pragma unroll
    for (int kt = 0; kt < 2; ++kt) {
        f32x16 acc;
#pragma unroll
        for (int e = 0; e < 16; ++e) acc[e] = cinit;
#pragma unroll
        for (int ks = 0; ks < 4; ++ks) acc = mfma32(kf[kt][ks], Qf[ks], acc);
        s[kt] = acc;
    }
}
__device__ __forceinline__ void at_pv(unsigned vbase, const unsigned (&voff)[2][2], const f32x16 (&p)[2], f32x16 (&o)[2]) {
#pragma unroll
    for (int kt = 0; kt < 2; ++kt) {
        s16x4 vr[2][2][2];
#pragma unroll
        for (int s = 0; s < 2; ++s) { const unsigned co = vbase + (unsigned)(4096 * kt + 2048 * s);
            vr[s][0][0] = tr_read0(co + voff[0][0]); vr[s][1][0] = tr_read0(co + voff[1][0]); vr[s][0][1] = tr_read0(co + voff[0][1]); vr[s][1][1] = tr_read0(co + voff[1][1]); }
        bf16x8 pb[2];
#pragma unroll
        for (int s = 0; s < 2; ++s) { u32x4 pw; pw.x = pk2(p[kt][8 * s + 0], p[kt][8 * s + 1]); pw.y = pk2(p[kt][8 * s + 2], p[kt][8 * s + 3]); pw.z = pk2(p[kt][8 * s + 4], p[kt][8 * s + 5]); pw.w = pk2(p[kt][8 * s + 6], p[kt][8 * s + 7]); pb[s] = as_bf16x8(pw); }
        asm volatile("s_waitcnt lgkmcnt(0)" ::: "memory"); SBAR();
#pragma unroll
        for (int s = 0; s < 2; ++s) {
            const s16x4 l0 = vr[s][0][0], h0 = vr[s][1][0], l1 = vr[s][0][1], h1 = vr[s][1][1];
            const bf16x8 v0 = {l0[0], l0[1], l0[2], l0[3], h0[0], h0[1], h0[2], h0[3]}, v1 = {l1[0], l1[1], l1[2], l1[3], h1[0], h1[1], h1[2], h1[3]};
            o[0] = mfma32(v0, pb[s], o[0]); o[1] = mfma32(v1, pb[s], o[1]);
        }
    }
}

struct AttnRow { int r, hf, tt, t, qb, wave; unsigned long long wave_union; float m, lpart; };
struct TileInfo { int hi, lo; bool rowok, edge, work, fresh; };
template <int MODE, int VAR>
__device__ __forceinline__ void at_tile_qk(const Frame& F, int j, int stg, const bf16x8 (&Qf)[4], const AttnRow& R, float mfin, f32x16 (&s)[2], TileInfo& I) {
    LAS unsigned char* lds = F.lds;
    I.work = true; if (MODE == 2) I.work = (R.wave_union >> j) & 1ull;
    I.hi = 1000; I.lo = -1000; I.rowok = true; I.edge = false;
    if (MODE <= 1) { I.hi = ((R.t - 31) >> 4) - 64 * j - 4 * R.hf; I.edge = (64 * j + 63) > ((64 * R.qb + 8 * R.wave - 31) >> 4); }
    if (MODE == 2) { const unsigned long long sm = *(const LAS unsigned long long*)(lds + AT_SELM + 8 * R.tt); I.rowok = (sm >> j) & 1ull; if (j == R.qb) { I.hi = R.tt - 4 * R.hf; I.edge = true; } }
    if (MODE == 3) { if (j == R.qb) { I.hi = R.tt - 4 * R.hf; I.edge = true; } if (j == R.qb - 8) { I.lo = R.tt + 1 - 4 * R.hf; I.edge = true; } }
    const float mref = (MODE == 1) ? mfin : R.m; I.fresh = mref < -1e29f;
    const float cinit = I.rowok ? (I.fresh ? 0.f : -mref) : -INFINITY;
    if (I.work) { if (VAR & 64) { for (int e = 0; e < 16; ++e) { s[0][e] = Qf[0][0] * 1e-9f; s[1][e] = Qf[1][1] * 1e-9f; } } else at_qk(lds + AT_K + stg * 8192, Qf, R.r, R.hf, s, cinit); }
}
template <int MODE, int VAR>
__device__ __forceinline__ float at_tile_fin(const Frame& F, int j, int stg, f32x16 (&s)[2], const TileInfo& I, AttnRow& R, const unsigned (&voff)[2][2], f32x16 (&o)[2], float invl, float preshift) {
    LAS unsigned char* lds = F.lds; float shift_out = 0.f;
    if (!I.work) return 0.f;
    const int hi = I.hi, lo = I.lo; const bool edge = I.edge;
    if (MODE == 1) {
        if (edge) {
#pragma unroll
            for (int kt = 0; kt < 2; ++kt)
#pragma unroll
                for (int e = 0; e < 16; ++e) { const int cst = 32 * kt + (e & 3) + 8 * (e >> 2); s[kt][e] = (cst <= hi) ? fexp2(s[kt][e]) * invl : 0.f; }
        } else {
#pragma unroll
            for (int kt = 0; kt < 2; ++kt)
#pragma unroll
                for (int e = 0; e < 16; ++e) s[kt][e] = fexp2(s[kt][e]) * invl;
        }
        LAS float* imp = (LAS float*)(lds + AT_IMP) + R.tt * 68;
#pragma unroll
        for (int kt = 0; kt < 2; ++kt)
#pragma unroll
            for (int rg = 0; rg < 4; ++rg) {
                float av = 2.f * (s[kt][4 * rg] + s[kt][4 * rg + 1] + s[kt][4 * rg + 2]) + s[kt][4 * rg + 3], bv = s[kt][4 * rg + 3];
                av += __int_as_float(__builtin_amdgcn_update_dpp(0, __float_as_int(av), 0xB1, 0xf, 0xf, true)); av += __int_as_float(__builtin_amdgcn_update_dpp(0, __float_as_int(av), 0x4E, 0xf, 0xf, true));
                bv += __int_as_float(__builtin_amdgcn_update_dpp(0, __float_as_int(bv), 0xB1, 0xf, 0xf, true)); bv += __int_as_float(__builtin_amdgcn_update_dpp(0, __float_as_int(bv), 0x4E, 0xf, 0xf, true));
                if ((R.r & 3) == 0) { const int jb = 16 * j + 8 * kt + 2 * rg + R.hf; (void)__hip_atomic_fetch_add(imp + jb, av, __ATOMIC_RELAXED, __HIP_MEMORY_SCOPE_WORKGROUP); (void)__hip_atomic_fetch_add(imp + jb + 1, bv, __ATOMIC_RELAXED, __HIP_MEMORY_SCOPE_WORKGROUP); }
            }
        if (VAR & 16) { o[0][0] += s[0][3] + s[1][7]; } else at_pv((unsigned)(size_t)(lds + AT_V + stg * 8192), voff, s, o);
    } else if (VAR & 32) { R.lpart += s[0][1]; if (MODE >= 2) { if (VAR & 16) { o[0][0] += s[0][3]; } else at_pv((unsigned)(size_t)(lds + AT_V + stg * 8192), voff, s, o); } }
    else {
        constexpr float THR = 8.f;
        if (__any(preshift != 0.f)) {
#pragma unroll
            for (int kt = 0; kt < 2; ++kt)
#pragma unroll
                for (int e = 0; e < 16; ++e) s[kt][e] -= preshift;
        }
        const bool fresh = R.m < -1e29f;
        if (edge) {
#pragma unroll
            for (int kt = 0; kt < 2; ++kt)
#pragma unroll
                for (int e = 0; e < 16; ++e) { const int cst = 32 * kt + (e & 3) + 8 * (e >> 2); const bool ok = (cst <= hi) && (cst >= lo); s[kt][e] = ok ? s[kt][e] : -INFINITY; }
        }
        float tm4[4] = {-INFINITY, -INFINITY, -INFINITY, -INFINITY};
#pragma unroll
        for (int kt = 0; kt < 2; ++kt)
#pragma unroll
            for (int e = 0; e < 16; e += 2) tm4[(e >> 1) & 3] = fmaxf(tm4[(e >> 1) & 3], fmaxf(s[kt][e], s[kt][e + 1]));
        const float tmax = half_max(fmaxf(fmaxf(tm4[0], tm4[1]), fmaxf(tm4[2], tm4[3])));
        const bool raise = (tmax > -INFINITY) && (fresh || tmax > THR);
        if (__any(raise)) {
            const float shift = raise ? tmax : 0.f, alpha = (raise && !fresh) ? fexp2(-shift) : 1.f;
            R.m = raise ? (fresh ? tmax : R.m + tmax) : R.m; R.lpart *= alpha; shift_out = shift;
#pragma unroll
            for (int kt = 0; kt < 2; ++kt)
#pragma unroll
                for (int e = 0; e < 16; ++e) s[kt][e] -= shift;
            if (MODE >= 2) {
#pragma unroll
                for (int e = 0; e < 16; ++e) { o[0][e] *= alpha; o[1][e] *= alpha; } }
        }
        float ps4[4] = {0.f, 0.f, 0.f, 0.f};
#pragma unroll
        for (int kt = 0; kt < 2; ++kt)
#pragma unroll
            for (int e = 0; e < 16; ++e) { s[kt][e] = fexp2(s[kt][e]); ps4[e & 3] += s[kt][e]; }
        R.lpart += (ps4[0] + ps4[1]) + (ps4[2] + ps4[3]);
        if (MODE >= 2) { if (VAR & 16) { o[0][0] += s[0][3] + s[1][7]; } else at_pv((unsigned)(size_t)(lds + AT_V + stg * 8192), voff, s, o); }
    }
    return shift_out;
}
template <int MODE, int VAR = 0>
__device__ __forceinline__ void at_branch(const Frame& F, unsigned long long mask, const bf16* Kb, const bf16* Vb, size_t stride, const bf16x8 (&Qf)[4], AttnRow& R, const unsigned (&voff)[2][2],
                                          f32x16 (&o)[2], float mfin, float invl) {
    LAS unsigned char* lds = F.lds; const int tid = F.tid;
    if (mask == 0ull) return;
    AttnStage st0, st1; int sg = 0;
    { const int j0 = __builtin_ctzll(mask); at_gload(st0, Kb, Vb, stride, j0, tid); at_swrite(st0, lds, 0, tid);
      const unsigned long long m1 = mask & (mask - 1ull); if (m1) { at_gload(st1, Kb, Vb, stride, __builtin_ctzll(m1), tid); at_swrite(st1, lds, 1, tid); } }
    __syncthreads();
    while (mask) {
        const int j0 = __builtin_ctzll(mask); mask &= mask - 1ull;
        int j1 = -1; if (mask) { j1 = __builtin_ctzll(mask); mask &= mask - 1ull; }
        int n0 = -1, n1 = -1; { unsigned long long mm = mask; if (mm) { n0 = __builtin_ctzll(mm); mm &= mm - 1ull; if (mm) n1 = __builtin_ctzll(mm); } }
        at_gload(st0, Kb, Vb, stride, n0 >= 0 ? n0 : j0, tid);
        at_gload(st1, Kb, Vb, stride, n1 >= 0 ? n1 : j0, tid);
        { f32x16 sa[2]; TileInfo Ia;
          at_tile_qk<MODE, VAR>(F, j0, sg, Qf, R, mfin, sa, Ia);
          (void)at_tile_fin<MODE, VAR>(F, j0, sg, sa, Ia, R, voff, o, invl, 0.f); }
        if (j1 >= 0) { f32x16 sb[2]; TileInfo Ib;
          at_tile_qk<MODE, VAR>(F, j1, sg + 1, Qf, R, mfin, sb, Ib);
          (void)at_tile_fin<MODE, VAR>(F, j1, sg + 1, sb, Ib, R, voff, o, invl, 0.f); }
        if (n0 >= 0) at_swrite(st0, lds, (sg + 2) & 3, tid);
        if (n1 >= 0) at_swrite(st1, lds, (sg + 3) & 3, tid);
        __syncthreads();
        sg = (sg + 2) & 3;
    }
}

template <int VAR>
__device__ __forceinline__ void attn_item(const Frame& F, ArgsP a, int l, int item) {
    const int qb = 63 - (item >> 4), bh = item & 15, b = bh >> 1, hk = bh & 1; const int lane = F.lane, wave = F.wave;
    const bf16* H = (const bf16*)(a->ws + WS_H); const float* side = (const float*)(a->ws + WS_SIDE); bf16* Y = (bf16*)(a->ws + WS_Y);
    LAS unsigned char* lds = F.lds;
    AttnRow R; R.r = lane & 31; R.hf = lane >> 5; R.tt = 8 * wave + (R.r >> 2); R.t = 64 * qb + R.tt; R.qb = qb; R.wave = wave; R.wave_union = 0ull;
    const int head = hk * 4 + (R.r & 3); const size_t tok = (size_t)b * SEQ + R.t;
    bf16x8 Qf[4];
#pragma unroll
    for (int ks = 0; ks < 4; ++ks) Qf[ks] = *(const bf16x8*)(H + tok * HLD + head * 64 + 16 * ks + 8 * R.hf);
    const float g_cmp = side[tok * 32 + head * 3], g_sel = side[tok * 32 + head * 3 + 1], g_win = side[tok * 32 + head * 3 + 2];
    unsigned voff[2][2];
    { const int li = lane & 15, q = li >> 2, p = li & 3, gi1 = (lane >> 4) & 1;
#pragma unroll
      for (int jh = 0; jh < 2; ++jh)
#pragma unroll
          for (int dt = 0; dt < 2; ++dt) voff[jh][dt] = (unsigned)((8 * jh + 4 * R.hf + q) * 128 + ((((4 * dt + 2 * gi1 + (p >> 1)) ^ (4 * jh + 2 * R.hf + (q >> 1))) & 7) << 4) + (p & 1) * 8); }
    { LAS float* imp = (LAS float*)(lds + AT_IMP) + (8 * wave) * 68; for (int i = lane; i < 8 * 68; i += 64) imp[i] = 0.f; if (F.tid == 0) { *(LAS unsigned*)(lds + AT_UNI) = 0u; *(LAS unsigned*)(lds + AT_UNI + 4) = 0u; } }
    f32x16 o[2];
#pragma unroll
    for (int e = 0; e < 16; ++e) { o[0][e] = 0.f; o[1][e] = 0.f; }
    LAS float* ys = (LAS float*)(lds + AT_YS + wave * 8192) + lane;
    {
        const bf16* Kc = (const bf16*)(a->ws + WS_KC) + (size_t)bh * 256 * 64; const bf16* Vc = (const bf16*)(a->ws + WS_VC) + (size_t)bh * 256 * 64;
        const int ntc = (4 * qb + 3 + 63) >> 6; const unsigned long long mc = (ntc >= 64) ? ~0ull : ((1ull << ntc) - 1ull);
        R.m = -1e30f; R.lpart = 0.f;
        if (!(VAR & 8)) at_branch<0, VAR>(F, mc, Kc, Vc, 64, Qf, R, voff, o, 0.f, 0.f);
        const float lsum = half_sum(R.lpart); const float invl = 1.f / fmaxf(lsum, 1e-30f);
        if (!(VAR & 8)) at_branch<1, VAR>(F, mc, Kc, Vc, 64, Qf, R, voff, o, R.m, invl);
#pragma unroll
        for (int e = 0; e < 16; ++e) { ys[e * 64] = g_cmp * o[0][e]; ys[(16 + e) * 64] = g_cmp * o[1][e]; o[0][e] = 0.f; o[1][e] = 0.f; }
    }
    LDS_WAIT();
    {
        unsigned long long wu = 0ull;
        for (int qi = 0; qi < 8; ++qi) {
            unsigned long long selm;
            if (qb < 16) selm = (2ull << qb) - 1ull;
            else {
                const float v = ((const LAS float*)(lds + AT_IMP))[(8 * wave + qi) * 68 + lane];
                const bool cand = (lane >= 1) && (lane <= qb - 2); const unsigned key = cand ? __float_as_uint(fmaxf(v, 0.f)) : 0u;
                unsigned thr = 0u;
                for (int bit = 30; bit >= 0; --bit) { const unsigned tr = thr | (1u << bit); const int c = __popcll(__ballot(cand && key >= tr)); if (c >= 13) thr = tr; }
                const unsigned long long gt = __ballot(cand && key > thr), eq = __ballot(cand && key == thr);
                int need = 13 - __popcll(gt); unsigned long long eqs = 0ull, e2 = eq;
                while (need > 0 && e2) { const unsigned long long low = e2 & (~e2 + 1ull); eqs |= low; e2 ^= low; --need; }
                selm = gt | eqs | 1ull | (1ull << qb) | (1ull << (qb - 1));
            }
            if (lane == 0) *(LAS unsigned long long*)(lds + AT_SELM + 8 * (8 * wave + qi)) = selm;
#if defined(SELFCHECK) && SELFCHECK == 1
            if (lane == 0 && l == 1) ((unsigned long long*)(a->ws + (size_t)880 * MiB + 64 * KiB))[(size_t)bh * SEQ + 64 * qb + 8 * wave + qi] = selm;
#endif
            wu |= selm;
        }
        R.wave_union = wu;
        if (lane == 0) { __hip_atomic_fetch_or((LAS unsigned*)(lds + AT_UNI), (unsigned)wu, __ATOMIC_RELAXED, __HIP_MEMORY_SCOPE_WORKGROUP); __hip_atomic_fetch_or((LAS unsigned*)(lds + AT_UNI + 4), (unsigned)(wu >> 32), __ATOMIC_RELAXED, __HIP_MEMORY_SCOPE_WORKGROUP); }
    }
    __syncthreads();
    const unsigned long long bunion = (unsigned long long)*(const LAS unsigned*)(lds + AT_UNI) | ((unsigned long long)*(const LAS unsigned*)(lds + AT_UNI + 4) << 32);
    const bf16* Hb = H + (size_t)b * SEQ * HLD;
    {
        R.m = -1e30f; R.lpart = 0.f;
        if (!(VAR & 2)) at_branch<2, VAR>(F, bunion, Hb + 512 + 2 * 128 + hk * 64, Hb + 512 + 3 * 128 + hk * 64, HLD, Qf, R, voff, o, 0.f, 0.f);
        const float lsum = half_sum(R.lpart); const float sc = g_sel / fmaxf(lsum, 1e-30f);
#pragma unroll
        for (int e = 0; e < 16; ++e) { ys[e * 64] += sc * o[0][e]; ys[(16 + e) * 64] += sc * o[1][e]; o[0][e] = 0.f; o[1][e] = 0.f; }
    }
    {
        const int lo = qb - 8 > 0 ? qb - 8 : 0; const unsigned long long mw = ((2ull << qb) - 1ull) & ~((1ull << lo) - 1ull);
        R.m = -1e30f; R.lpart = 0.f;
        if (!(VAR & 4)) at_branch<3, VAR>(F, mw, Hb + 512 + 4 * 128 + hk * 64, Hb + 512 + 5 * 128 + hk * 64, HLD, Qf, R, voff, o, 0.f, 0.f);
        const float lsum = half_sum(R.lpart); const float sc = g_win / fmaxf(lsum, 1e-30f);
#pragma unroll
        for (int e = 0; e < 16; ++e) { o[0][e] = ys[e * 64] + sc * o[0][e]; o[1][e] = ys[(16 + e) * 64] + sc * o[1][e]; }
    }
    if (VAR & 1) { asm volatile("" :: "v"(o[0][0]), "v"(o[1][5])); return; }
    bf16* yrow = Y + tok * DM + head * 64 + 4 * R.hf;
#pragma unroll
    for (int dt = 0; dt < 2; ++dt)
#pragma unroll
        for (int rg = 0; rg < 4; ++rg) { u32x2 w; w.x = pk2(o[dt][4 * rg], o[dt][4 * rg + 1]); w.y = pk2(o[dt][4 * rg + 2], o[dt][4 * rg + 3]); *(u32x2*)(yrow + 32 * dt + 8 * rg) = w; }
}

__device__ __forceinline__ void phase_mix_b(const Frame& F, ArgsP a, int l, int rep) {
    unsigned* q = F.ctl + CW_QUEUE + l * 64 + rep * 32;
    for (;;) {
        if (F.tid == 0) F.MISC[0] = __hip_atomic_fetch_add(q, 1u, __ATOMIC_RELAXED, __HIP_MEMORY_SCOPE_AGENT);
        __syncthreads();
        const int item = (int)F.MISC[0];
        __syncthreads();
        if (item >= 1024) break;
        if (rep == 0) attn_item<0>(F, a, l, item); else attn_item<PROBE_ATTN_VAR>(F, a, l, item);
    }
}

constexpr size_t WS_DBG = 880 * MiB;
constexpr int CHECK_LAYER = 1;
__device__ __forceinline__ void dbg_add(ArgsP a, int i, float v) { atomicAdd((float*)(a->ws + WS_DBG) + i, v); }

__device__ __forceinline__ void check_nsa(const Frame& F, ArgsP a) {
    const bf16* H = (const bf16*)(a->ws + WS_H); const float* side = (const float*)(a->ws + WS_SIDE); const bf16* Y = (const bf16*)(a->ws + WS_Y);
    const unsigned long long* SELM = (const unsigned long long*)(a->ws + WS_DBG + 64 * KiB);
    const int lane = F.lane; const int tv[16] = {5, 40, 63, 64, 100, 511, 512, 1023, 1024, 1500, 2047, 2048, 3000, 3333, 4000, 4095};
    for (int s = F.bid * NWAVES + F.wave; s < 256; s += F.G * NWAVES) {
        int t = tv[0];
#pragma unroll
        for (int q = 1; q < 16; ++q) t = ((s & 15) == q) ? tv[q] : t;
        const int b = (s >> 4) & 7, hq = ((s >> 7) * 5 + (s & 7)) & 7, hk = hq >> 2; const size_t tok = (size_t)b * SEQ + t; const int bhk = b * 2 + hk;
        const bf16* KC = (const bf16*)(a->ws + WS_KC) + (size_t)bhk * 256 * 64; const bf16* VC = (const bf16*)(a->ws + WS_VC) + (size_t)bhk * 256 * 64;
        const float g_cmp = side[tok * 32 + hq * 3], g_sel = side[tok * 32 + hq * 3 + 1], g_win = side[tok * 32 + hq * 3 + 2];
        const int cmax = (t - 31) >> 4; float imp = 0.f, ocmp = 0.f;
        for (int gh = 0; gh < 4; ++gh) {
            const int head = hk * 4 + gh; const float qd = bf2f(H[tok * HLD + head * 64 + lane]);
            float m = -INFINITY, l = 0.f;
            for (int c = 0; c <= cmax; ++c) m = fmaxf(m, wave_sum(qd * bf2f(KC[c * 64 + lane])));
            for (int c = 0; c <= cmax; ++c) l += fexp2(wave_sum(qd * bf2f(KC[c * 64 + lane])) - m);
            for (int c = 0; c <= cmax; ++c) { const float p = fexp2(wave_sum(qd * bf2f(KC[c * 64 + lane])) - m) / l; const int j = c >> 2, e = c & 3;
                if (lane == j) imp += (e < 3 ? 2.f : 1.f) * p; if (e == 3 && lane == j + 1) imp += p;
                if (head == hq) ocmp += p * bf2f(VC[c * 64 + lane]); }
        }
        const int cur = t >> 6; const bool causal = lane <= cur, forced = (lane == 0) || (lane == cur) || (lane == cur - 1);
        const float key = causal ? (imp + (forced ? 1.0e4f : 0.f)) : -INFINITY; int rank = 0;
        for (int i = 0; i < 64; ++i) { const float ki = __shfl(key, i); rank += ((ki > key) || (ki == key && i < lane)) ? 1 : 0; }
        const unsigned long long refm = __ballot(causal && rank < 16), stm = SELM[(size_t)bhk * SEQ + t];
        if (lane == 0) { dbg_add(a, 2, (float)__popcll(refm ^ stm)); dbg_add(a, 3, 16.f); }
        const float qd = bf2f(H[tok * HLD + hq * 64 + lane]); const bf16* Hb = H + (size_t)b * SEQ * HLD + hk * 64 + lane;
        float m = -INFINITY, l = 0.f, osel = 0.f;
        for (int j = 0; j <= cur; ++j) if ((stm >> j) & 1ull) for (int kk = 0; kk < 64; ++kk) { const int p = 64 * j + kk; if (p > t) break;
            const float sc = wave_sum(qd * bf2f(Hb[(size_t)p * HLD + 512 + 2 * 128])); const float mn = fmaxf(m, sc), al = fexp2(m - mn), pp = fexp2(sc - mn);
            l = l * al + pp; osel = osel * al + pp * bf2f(Hb[(size_t)p * HLD + 512 + 3 * 128]); m = mn; }
        const float ysel = osel / fmaxf(l, 1e-30f);
        m = -INFINITY; l = 0.f; float owin = 0.f;
        for (int p = (t - 511 > 0 ? t - 511 : 0); p <= t; ++p) { const float sc = wave_sum(qd * bf2f(Hb[(size_t)p * HLD + 512 + 4 * 128])); const float mn = fmaxf(m, sc), al = fexp2(m - mn), pp = fexp2(sc - mn);
            l = l * al + pp; owin = owin * al + pp * bf2f(Hb[(size_t)p * HLD + 512 + 5 * 128]); m = mn; }
        const float ref = g_cmp * ocmp + g_sel * ysel + g_win * owin / fmaxf(l, 1e-30f), got = bf2f(Y[tok * DM + hq * 64 + lane]);
        const float e2 = wave_sum((ref - got) * (ref - got)), r2 = wave_sum(ref * ref);
        if (lane == 0) { dbg_add(a, 0, e2); dbg_add(a, 1, r2); }
    }
}

__device__ __forceinline__ void check_gdn(const Frame& F, ArgsP a, int l) {
    if (F.bid >= 8) return;
    const bf16* H = (const bf16*)(a->ws + WS_H); const float* side = (const float*)(a->ws + WS_SIDE); const bf16* Y = (const bf16*)(a->ws + WS_Y);
    const int b = F.bid, h = (F.bid * 3) & 3, tid = F.tid, lane = F.lane, col = tid & 63, rg = tid >> 6;
    LAS float* S = (LAS float*)F.lds; LAS float* qv = S + 64 * 65; LAS float* kv = qv + 64; LAS float* vv = kv + 64; LAS float* sc = vv + 64; LAS float* part = sc + 64;
    for (int i = tid; i < 64 * 65; i += NTHR) S[i] = 0.f;
    float hq[3] = {0.f, 0.f, 0.f}, hk[3] = {0.f, 0.f, 0.f}, hv[3] = {0.f, 0.f, 0.f}, wq[4], wk[4], wv[4];
    { const float* cw = a->in[6] + (size_t)l * 4 * 768 + h * 64 + lane;
#pragma unroll
      for (int k = 0; k < 4; ++k) { wq[k] = cw[k * 768]; wk[k] = cw[k * 768 + 256]; wv[k] = cw[k * 768 + 512]; } }
    const float Aexp = __expf(a->in[7][l * 4 + h]), dtb = a->in[8][l * 4 + h], nw = a->in[9][l * 64 + lane];
    __syncthreads();
    for (int t = 0; t < 192; ++t) {
        const size_t tok = (size_t)b * SEQ + t;
        if (F.wave == 0) { const bf16* p = H + tok * HLD + 1280 + h * 64 + lane; const float rq = bf2f(p[0]), rk = bf2f(p[256]), rv = bf2f(p[512]);
            const float cq = wq[0] * hq[0] + wq[1] * hq[1] + wq[2] * hq[2] + wq[3] * rq, ck = wk[0] * hk[0] + wk[1] * hk[1] + wk[2] * hk[2] + wk[3] * rk, cv = wv[0] * hv[0] + wv[1] * hv[1] + wv[2] * hv[2] + wv[3] * rv;
            hq[0] = hq[1]; hq[1] = hq[2]; hq[2] = rq; hk[0] = hk[1]; hk[1] = hk[2]; hk[2] = rk; hv[0] = hv[1]; hv[1] = hv[2]; hv[2] = rv;
            const float qs = cq / (1.f + __expf(-cq)), ks = ck / (1.f + __expf(-ck)), vs = cv / (1.f + __expf(-cv));
            qv[lane] = qs / sqrtf(wave_sum(qs * qs) + 1e-6f); kv[lane] = ks / sqrtf(wave_sum(ks * ks) + 1e-6f); vv[lane] = vs;
            if (lane == 0) { const float av = side[tok * 32 + 28 + h] + dtb; const float sp = av > 20.f ? av : log1pf(__expf(av)); sc[0] = __expf(-Aexp * sp); sc[1] = side[tok * 32 + 24 + h]; } }
        __syncthreads();
        { float ps = 0.f;
#pragma unroll
          for (int r = 0; r < 8; ++r) ps += kv[8 * rg + r] * S[(8 * rg + r) * 65 + col];
          part[rg * 64 + col] = ps; }
        __syncthreads();
        { float ks = 0.f;
#pragma unroll
          for (int r = 0; r < 8; ++r) ks += part[r * 64 + col];
          const float eg = sc[0], be = sc[1]; float po = 0.f;
          __syncthreads();
#pragma unroll
          for (int r = 0; r < 8; ++r) { const int dk = 8 * rg + r; const float sn = eg * (S[dk * 65 + col] - be * kv[dk] * ks) + be * kv[dk] * vv[col]; S[dk * 65 + col] = sn; po += sn * qv[dk]; }
          part[rg * 64 + col] = po; }
        __syncthreads();
        if (F.wave == 0) { float o = 0.f;
#pragma unroll
            for (int r = 0; r < 8; ++r) o += part[r * 64 + lane];
            o *= 0.125f; const float rs = 1.f / sqrtf(wave_sum(o * o) * (1.f / 64.f) + 1e-6f); const float z = bf2f(H[tok * HLD + 2048 + h * 64 + lane]);
            const float ref = o * rs * nw * (z / (1.f + __expf(-z))), got = bf2f(Y[tok * DM + 512 + h * 64 + lane]);
            const float e2 = wave_sum((ref - got) * (ref - got)), r2 = wave_sum(ref * ref);
            if (lane == 0) { dbg_add(a, 4, e2); dbg_add(a, 5, r2); } }
        __syncthreads();
    }
}

__device__ __forceinline__ void check_moe(const Frame& F, ArgsP a, int l) {
    const float* X1 = (const float*)(a->ws + WS_X1); const bf16* Y2 = (const bf16*)(a->ws + WS_Y2);
    const int* route_e = (const int*)(a->ws + WS_SLOT + SL_RE); const float* route_w = (const float*)(a->ws + WS_SLOT + SL_RW);
    LAS float* x = (LAS float*)F.lds; LAS float* hid = x + 1024; LAS float* lg = hid + 512; LAS float* yr = lg + 64;
    const int tid = F.tid, lane = F.lane;
    for (int s = F.bid; s < 256; s += F.G) {
        const int t = (s * 4099 + 17) & (T - 1);
        for (int i = tid; i < 1024; i += NTHR) { x[i] = X1[(size_t)t * DM + i]; yr[i] = 0.f; }
        __syncthreads();
        for (int j = F.wave; j < 36; j += NWAVES) { float d = 0.f; for (int k = lane; k < DM; k += 64) d += x[k] * (j < 4 ? a->in[18][((size_t)l * DM + k) * 4 + j] : a->in[20][((size_t)l * DM + k) * NEXP + j - 4]);
            d = wave_sum(d); if (lane == 0) lg[j] = d + (j < 4 ? a->in[19][l * 4 + j] : a->in[21][l * NEXP + j - 4]); }
        __syncthreads();
        if (tid == 0) { int gi = 0; for (int i = 1; i < 4; ++i) if (lg[i] > lg[gi]) gi = i; float gs = 0.f; for (int i = 0; i < 4; ++i) gs += __expf(lg[i] - lg[gi]); const float gw = 1.f / gs;
            int i1 = 0; for (int i = 1; i < 8; ++i) if (lg[4 + gi * 8 + i] > lg[4 + gi * 8 + i1]) i1 = i; int i2 = -1; for (int i = 0; i < 8; ++i) if (i != i1 && (i2 < 0 || lg[4 + gi * 8 + i] > lg[4 + gi * 8 + i2])) i2 = i;
            const float e2 = __expf(lg[4 + gi * 8 + i2] - lg[4 + gi * 8 + i1]), w1 = gw / (1.f + e2), w2 = gw - w1;
            const int se1 = route_e[2 * t], se2 = route_e[2 * t + 1]; const float sw1 = route_w[2 * t], sw2 = route_w[2 * t + 1];
            dbg_add(a, 8, (se1 != gi * 8 + i1 ? 1.f : 0.f) + (se2 != gi * 8 + i2 ? 1.f : 0.f)); dbg_add(a, 9, 2.f);
            if (se1 == gi * 8 + i1 && se2 == gi * 8 + i2) { dbg_add(a, 10, (sw1 - w1) * (sw1 - w1) + (sw2 - w2) * (sw2 - w2)); dbg_add(a, 11, w1 * w1 + w2 * w2); } }
        for (int k2 = 0; k2 < 2; ++k2) {
            const int e = route_e[2 * t + k2]; const float rw = route_w[2 * t + k2];
            const float* wg = a->in[22] + ((size_t)l * NEXP + e) * DM * FF; const float* wu = a->in[23] + ((size_t)l * NEXP + e) * DM * FF; const float* wd = a->in[24] + ((size_t)l * NEXP + e) * FF * DM;
            { float g = 0.f, u = 0.f; for (int k = 0; k < DM; ++k) { g += x[k] * wg[(size_t)k * FF + tid]; u += x[k] * wu[(size_t)k * FF + tid]; } hid[tid] = g / (1.f + __expf(-g)) * u; }
            __syncthreads();
            for (int d = tid; d < DM; d += NTHR) { float y = 0.f; for (int f = 0; f < FF; ++f) y += hid[f] * wd[(size_t)f * DM + d]; yr[d] += y * rw; }
            __syncthreads();
        }
        float e2 = 0.f, r2 = 0.f;
        for (int d = tid; d < DM; d += NTHR) { const float got = bf2f(Y2[(size_t)(2 * t) * DM + d]) + bf2f(Y2[(size_t)(2 * t + 1) * DM + d]); e2 += (yr[d] - got) * (yr[d] - got); r2 += yr[d] * yr[d]; }
        e2 = wave_sum(e2); r2 = wave_sum(r2); if (lane == 0) { dbg_add(a, 6, e2); dbg_add(a, 7, r2); }
        __syncthreads();
    }
}

__device__ __forceinline__ void check_inproj(const Frame& F, ArgsP a, int l) {
    const bf16* H = (const bf16*)(a->ws + WS_H); const float* xin = (l == 0) ? a->in[0] : (const float*)a->out; const float* win = a->in[1] + (size_t)l * DM * DIN;
    const int lane = F.lane;
    for (int s = F.bid * NWAVES + F.wave; s < 1024; s += F.G * NWAVES) {
        const int tok = (s * 7919 + 13) & (T - 1), grp = s % 14, t = tok & (SEQ - 1);
        const int col0 = grp < 8 ? grp * 64 : 512 + (grp - 8) * 128 + ((s >> 4) & 1) * 64; const bool isq = grp < 8, rope = isq || ((grp - 8) % 2 == 0);
        float d = 0.f; for (int k = 0; k < DM; ++k) d += xin[(size_t)tok * DM + k] * win[(size_t)k * DIN + col0 + lane];
        if (rope) { const float inv[8] = {1.0f, 0.19392274f, 0.03760603f, 0.0072926646f, 0.0014142136f, 0.0002742482f, 5.3182957e-05f, 1.0313385e-05f};
            float iv = inv[0];
#pragma unroll
            for (int q = 1; q < 8; ++q) iv = ((lane & 7) == q) ? inv[q] : iv;
            const float ang = (float)t * iv, c = cosf(ang), sn = sinf(ang), other = __shfl_xor(d, 8);
            if (lane < 8) d = d * c - other * sn; else if (lane < 16) d = d * c + other * sn; }
        if (isq) d *= pg8::QSCALE;
        const float got = bf2f(H[(size_t)tok * HLD + col0 + lane]); const float e2 = wave_sum((d - got) * (d - got)), r2 = wave_sum(d * d);
        if (lane == 0) { dbg_add(a, 12, e2); dbg_add(a, 13, r2); }
    }
}
__device__ __forceinline__ void check_compress(const Frame& F, ArgsP a, int l) {
    const bf16* H = (const bf16*)(a->ws + WS_H); const int lane = F.lane;
    for (int s = F.bid * NWAVES + F.wave; s < 512; s += F.G * NWAVES) {
        const int kv = s & 1, bh = (s >> 1) & 15, b = bh >> 1, hh = bh & 1, i = (s * 53 + 7) % 255;
        const float* pe = a->in[3] + ((size_t)l * 2 + kv) * 2048; const float* w1 = a->in[4] + ((size_t)l * 2 + kv) * 2048 * 128; const float* w2 = a->in[5] + ((size_t)l * 2 + kv) * 128 * 64;
        float h0 = 0.f, h1 = 0.f;
        for (int k = 0; k < 2048; ++k) { const int p = k >> 6, d = k & 63; const float x = bf2f(H[((size_t)b * SEQ + 16 * i + p) * HLD + 512 + kv * 128 + hh * 64 + d]) + pe[k];
            h0 += x * w1[(size_t)k * 128 + lane]; h1 += x * w1[(size_t)k * 128 + 64 + lane]; }
        h0 = h0 / (1.f + __expf(-h0)); h1 = h1 / (1.f + __expf(-h1));
        float o = 0.f;
        for (int n = 0; n < 64; ++n) { o += __shfl(h0, n) * w2[(size_t)n * 64 + lane] + __shfl(h1, n) * w2[(size_t)(64 + n) * 64 + lane]; }
        const float got = bf2f(((const bf16*)(a->ws + (kv ? WS_VC : WS_KC)))[((size_t)bh * 256 + i) * 64 + lane]);
        const float e2 = wave_sum((o - got) * (o - got)), r2 = wave_sum(o * o); if (lane == 0) { dbg_add(a, 14, e2); dbg_add(a, 15, r2); }
    }
}
__device__ __forceinline__ void check_conformer(const Frame& F, ArgsP a, int l) {
    const bf16* H = (const bf16*)(a->ws + WS_H); const bf16* Y = (const bf16*)(a->ws + WS_Y); const int lane = F.lane;
    for (int s = F.bid * NWAVES + F.wave; s < 1024; s += F.G * NWAVES) {
        const int tok = (s * 6151 + 3) & (T - 1), t = tok & (SEQ - 1); float u[4];
#pragma unroll
        for (int j = 0; j < 4; ++j) { const int c = lane + 64 * j; float acc = a->in[11][l * 256 + c];
            for (int k = 0; k < 31; ++k) { const int sp = t - 30 + k; if (sp >= 0) { const bf16* hp = H + (size_t)(tok - 30 + k) * HLD + 2304 + c; const float g = bf2f(hp[256]); acc += a->in[10][((size_t)l * 31 + k) * 256 + c] * (bf2f(hp[0]) / (1.f + __expf(-g))); } }
            u[j] = acc; }
        const float mean = wave_sum(u[0] + u[1] + u[2] + u[3]) * (1.f / 256.f); float q = 0.f;
#pragma unroll
        for (int j = 0; j < 4; ++j) { u[j] -= mean; q += u[j] * u[j]; }
        const float rstd = 1.f / sqrtf(wave_sum(q) * (1.f / 256.f) + LN_EPS); float e2 = 0.f, r2 = 0.f;
#pragma unroll
        for (int j = 0; j < 4; ++j) { const int c = lane + 64 * j; const float v = u[j] * rstd * a->in[12][l * 256 + c] + a->in[13][l * 256 + c]; const float ref = v / (1.f + __expf(-v)), got = bf2f(Y[(size_t)tok * DM + 768 + c]);
            e2 += (ref - got) * (ref - got); r2 += ref * ref; }
        e2 = wave_sum(e2); r2 = wave_sum(r2); if (lane == 0) { dbg_add(a, 16, e2); dbg_add(a, 17, r2); }
    }
}
__device__ __forceinline__ void check_inject(const Frame& F, ArgsP a) {
    if (F.bid == 0 && F.tid == 0) { const float* d = (const float*)(a->ws + WS_DBG); float e0 = 0.f, e1 = 0.f;
        if (SELFCHECK == 1) { e0 = 1000.f * sqrtf(d[0] / d[1]); e1 = 1.0e4f * d[2] / d[3]; }
        if (SELFCHECK == 2) { e0 = 1000.f * sqrtf(d[4] / d[5]); }
        if (SELFCHECK == 3) { e0 = 1000.f * sqrtf(d[6] / d[7]); e1 = 1.0e4f * d[8] / d[9] + 1000.f * sqrtf(d[10] / fmaxf(d[11], 1e-30f)); }
        if (SELFCHECK == 4) { e0 = 1000.f * sqrtf(d[12] / d[13]); }
        if (SELFCHECK == 5) { e0 = 1000.f * sqrtf(d[14] / d[15]); e1 = 1000.f * sqrtf(d[16] / d[17]); }
        a->out[0] += e0; a->out[1] += e1; }
}


#ifndef MK_MULTI
#define MK_MULTI 0
#endif
#ifndef PROBE_REPEAT
#define PROBE_REPEAT 0
#endif
constexpr int N_PHASES = 1 + 10 * NL;
__device__ __forceinline__ Frame make_frame(int wave_s) {
    extern __shared__ __attribute__((aligned(16))) unsigned char lds_raw[];
    Frame F; F.lds = (LAS unsigned char*)lds_raw; F.MISC = (volatile LAS unsigned*)(F.lds + MISC_OFF);
    int tid = threadIdx.x, G = gridDim.x, bid = blockIdx.x; unsigned lb = (unsigned)(size_t)F.lds; (void)wave_s;
    asm volatile("" : "+v"(tid), "+s"(G), "+s"(bid), "+s"(lb));
    F.lds = (LAS unsigned char*)(size_t)lb; F.MISC = (volatile LAS unsigned*)(F.lds + MISC_OFF);
    F.tid = tid; F.lane = F.tid & 63; F.wave = __builtin_amdgcn_readfirstlane(F.tid >> 6); F.G = G; F.bid = bid;
    F.ctl = (unsigned*)(args_here()->ws + WS_CTL); return F;
}
__device__ __forceinline__ void ph_prologue(int, int wv) { const Frame F = make_frame(wv); phase_prologue(F, args_here()); phase_weights(F, args_here(), 0);
#if SELFCHECK
    if (F.bid == 0 && F.tid < 64) ((float*)(args_here()->ws + WS_DBG))[F.tid] = 0.f;
#endif
}
__device__ __forceinline__ void ph_inproj(int, int wv) { const Frame F = make_frame(wv); unsigned char* ws = args_here()->ws;
    pg8::Gemm g{(const bf16*)(ws + WS_XB), (const bf16*)(ws + WS_WL + WL_WIN), T, DINP, DM}; pg8::StaticOrder S; S.init(T, DINP, F.G, F.bid);
    pg8::EpiInProj E{(bf16*)(ws + WS_H), (float*)(ws + WS_SIDE), (const float*)(ws + WS_ROPE)};
    pg8::gemm_phase<pg8::EpiInProj, pg8::StaticOrder, false>(F.lds, g, S, E, nullptr, F.tid); }
__device__ __forceinline__ void ph_compress(int l, int wv) { const Frame F = make_frame(wv); for (int it = F.bid; it < 256; it += F.G) compress_item(F, args_here(), it); }
__device__ __forceinline__ void ph_gdnprep(int l, int wv) { const Frame F = make_frame(wv); for (int it = F.bid; it < 256; it += F.G) { gdn_prep_chunk(F, args_here(), l, it * 8 + F.wave, F.lds + F.wave * 16384); __syncthreads(); } }
__device__ __forceinline__ void ph_conformer(int l, int wv) { const Frame F = make_frame(wv); for (int it = F.bid; it < 512; it += F.G) conformer_item(F, args_here(), l, it); }
__device__ __forceinline__ void ph_gdnout(int l, int wv) { const Frame F = make_frame(wv); for (int ci = F.bid * NWAVES + F.wave; ci < 2048; ci += F.G * NWAVES) gdn_out_chunk(F, args_here(), ci, F.lds + F.wave * 8192); }
__device__ __forceinline__ void ph_scan(int l, int wv) { const Frame F = make_frame(wv); if (F.bid < 16) gdn_scan(F, args_here(), l); }
__device__ __forceinline__ void ph_attn(int l, int rep, int wv) { const Frame F = make_frame(wv); phase_mix_b(F, args_here(), l, rep); }
__device__ __forceinline__ void ph_outproj(int l, int wv) { const Frame F = make_frame(wv); ArgsP ap = args_here(); unsigned char* ws = ap->ws;
    pg8::Gemm g{(const bf16*)(ws + WS_Y), (const bf16*)(ws + WS_WL + WL_WOUT), T, DM, DM}; pg8::StaticOrder S; S.init(T, DM, F.G, F.bid);
    pg8::EpiOutProj E{l == 0 ? ap->in[0] : (const float*)ap->out, (float*)(ws + WS_X1), DN_ALPHA};
    pg8::gemm_phase<pg8::EpiOutProj, pg8::StaticOrder, false>(F.lds, g, S, E, nullptr, F.tid); }
__device__ __forceinline__ void ph_ln1(int l, int wv) { const Frame F = make_frame(wv); phase_ln1_router<false>(F, args_here(), l); }
__device__ __forceinline__ void ph_ln1_dry(int l, int wv) { const Frame F = make_frame(wv); phase_ln1_router<true>(F, args_here(), l); }
__device__ __forceinline__ void ph_gather(int l, int wv) { const Frame F = make_frame(wv); phase_gather(F, args_here(), l); }
__device__ __forceinline__ void ph_moeup(int l, int wv) { const Frame F = make_frame(wv); unsigned char* ws = args_here()->ws;
    pg8::Gemm g{(const bf16*)(ws + WS_XB), (const bf16*)(ws + WS_WL + WL_WGU), 0, 0, DM}; pg8::MoeOrder S{(const int*)(ws + WS_META) + l * 512, F.G, F.bid};
    pg8::EpiSwiGLU E{(bf16*)(ws + WS_HID), (const int*)(ws + WS_SLOT + SL_TOK), 1};
    pg8::gemm_phase<pg8::EpiSwiGLU, pg8::MoeOrder, false>(F.lds, g, S, E, nullptr, F.tid); }
__device__ __forceinline__ void ph_moedown(int l, int wv) { const Frame F = make_frame(wv); unsigned char* ws = args_here()->ws;
    pg8::Gemm g{(const bf16*)(ws + WS_HID), (const bf16*)(ws + WS_WL + WL_WDN), 0, 0, FF}; pg8::MoeOrder S{(const int*)(ws + WS_META) + l * 512, F.G, F.bid};
    pg8::EpiDown E{(bf16*)(ws + WS_Y2), (const int*)(ws + WS_SLOT + SL_TOK), (const float*)(ws + WS_SLOT + SL_W)};
    pg8::gemm_phase<pg8::EpiDown, pg8::MoeOrder, false>(F.lds, g, S, E, nullptr, F.tid); }
__device__ __forceinline__ void ph_ln2(int l, int wv) { const Frame F = make_frame(wv); phase_ln2(F, args_here(), l); }
__device__ __forceinline__ void ph_weights(int l, int wv) { const Frame F = make_frame(wv); if (l + 1 < NL) phase_weights(F, args_here(), l + 1); }

__global__ void __launch_bounds__(NTHR, 2) fwd_kernel(Args args) {
    extern __shared__ __attribute__((aligned(16))) unsigned char lds_raw[];
    (void)lds_raw; const int wv = 0; const Frame F = make_frame(wv);
    if (F.tid < 64) F.MISC[F.tid] = 0u;
    __syncthreads();
    XcdBarrier bar = xcd_barrier_post(F.ctl + CW_BAR, F.MISC + 8);
    const int lo = args_here()->ph_lo, hi = args_here()->ph_hi;
#define IN(k) (lo <= (k) && (k) < hi)
#define SEAM(k) do { if (IN(k) && IN((k) + 1)) { XcdBarrier bb = bar; asm volatile("" : "+s"(bb.bar)); xcd_barrier(bb); } } while (0)
#define RPT(bit, call) do { call; if (PROBE_REPEAT & (1u << (bit))) { XcdBarrier bb = bar; asm volatile("" : "+s"(bb.bar)); xcd_barrier(bb); call; } } while (0)
    if (IN(0)) ph_prologue(0, wv);
    SEAM(0);
#define LAYER_BODY(l) do { \
        const int pb = 1 + 10 * l; \
        if (IN(pb + 0)) RPT(0, ph_inproj(l, wv)); \
        SEAM(pb + 0); \
        if constexpr (SELFCHECK == 4) { \
        if (l == CHECK_LAYER) { { const Frame F2 = make_frame(wv); check_inproj(F2, args_here(), l); } XcdBarrier bb = bar; asm volatile("" : "+s"(bb.bar)); xcd_barrier(bb); } \
        } \
        if (IN(pb + 1)) { RPT(16, ph_compress(l, wv)); RPT(17, ph_gdnprep(l, wv)); RPT(18, ph_conformer(l, wv)); } \
        SEAM(pb + 1); \
        if (IN(pb + 2)) { RPT(19, ph_scan(l, wv)); ph_attn(l, 0, wv); if (PROBE_REPEAT & (1u << 20)) { XcdBarrier bb = bar; asm volatile("" : "+s"(bb.bar)); xcd_barrier(bb); ph_attn(l, 1, wv); } } \
        SEAM(pb + 2); \
        if (IN(pb + 3)) RPT(24, ph_gdnout(l, wv)); \
        SEAM(pb + 3); \
        if constexpr (SELFCHECK == 1 || SELFCHECK == 2 || SELFCHECK == 5) { \
        if (l == CHECK_LAYER) { { const Frame F2 = make_frame(wv); if (SELFCHECK == 1) check_nsa(F2, args_here()); else if (SELFCHECK == 2) check_gdn(F2, args_here(), l); else { check_compress(F2, args_here(), l); check_conformer(F2, args_here(), l); } } XcdBarrier bb = bar; asm volatile("" : "+s"(bb.bar)); xcd_barrier(bb); } \
        } \
        if (IN(pb + 4)) RPT(3, ph_outproj(l, wv)); \
        SEAM(pb + 4); \
        if (IN(pb + 5)) { ph_ln1(l, wv); if (PROBE_REPEAT & (1u << 4)) { XcdBarrier bb = bar; asm volatile("" : "+s"(bb.bar)); xcd_barrier(bb); ph_ln1_dry(l, wv); } \
            if (PROBE_REPEAT & (1u << 23)) { for (int rr = 0; rr < 4; ++rr) { XcdBarrier bb = bar; asm volatile("" : "+s"(bb.bar)); xcd_barrier(bb); } } } \
        SEAM(pb + 5); \
        if (IN(pb + 6)) RPT(5, ph_gather(l, wv)); \
        SEAM(pb + 6); \
        if (IN(pb + 7)) RPT(6, ph_moeup(l, wv)); \
        SEAM(pb + 7); \
        if (IN(pb + 8)) RPT(7, ph_moedown(l, wv)); \
        SEAM(pb + 8); \
        if constexpr (SELFCHECK == 3) { \
        if (l == CHECK_LAYER) { { const Frame F2 = make_frame(wv); check_moe(F2, args_here(), l); } XcdBarrier bb = bar; asm volatile("" : "+s"(bb.bar)); xcd_barrier(bb); } \
        } \
        if (IN(pb + 9)) { RPT(22, ph_ln2(l, wv)); RPT(21, ph_weights(l, wv)); } \
        SEAM(pb + 9); \
     \
    } while (0)
    LAYER_BODY(0); LAYER_BODY(1); LAYER_BODY(2); LAYER_BODY(3);
#undef LAYER_BODY
#undef RPT
#if SELFCHECK
    { XcdBarrier bb = bar; asm volatile("" : "+s"(bb.bar)); xcd_barrier(bb); const Frame F2 = make_frame(wv); check_inject(F2, args_here()); }
#endif
#undef IN
#undef SEAM
}

extern "C" void kernel_launch(void* const* d_in, const int* in_sizes, int n_in, void* d_out, int out_size, void* d_ws, size_t ws_size, hipStream_t stream) {
    static int grid = 0;
    if (grid == 0) {
        if (n_in != 25 || in_sizes[0] != T * DM || out_size != T * DM || ws_size < WS_END) { fprintf(stderr, "kernel_launch: shape/workspace mismatch (n_in %d, in0 %d, out %d, ws %zu < %zu); nothing launched\n", n_in, n_in > 0 ? in_sizes[0] : -1, out_size, ws_size, (size_t)WS_END); grid = -1; return; }
        int dev = 0, cus = 0, per_cu = 0;
        if (hipGetDevice(&dev) != hipSuccess || hipDeviceGetAttribute(&cus, hipDeviceAttributeMultiprocessorCount, dev) != hipSuccess) { grid = -1; return; }
        if (hipFuncSetAttribute((const void*)fwd_kernel, hipFuncAttributeMaxDynamicSharedMemorySize, LDS_BYTES) != hipSuccess) { fprintf(stderr, "kernel_launch: hipFuncSetAttribute failed\n"); grid = -1; return; }
        if (hipOccupancyMaxActiveBlocksPerMultiprocessor(&per_cu, (const void*)fwd_kernel, NTHR, LDS_BYTES) != hipSuccess || per_cu < 1)
            fprintf(stderr, "kernel_launch: note: occupancy query reports %d workgroups per CU\n", per_cu);
        (void)hipGetLastError();
        grid = cus;
        if (grid < 32 || (grid & 7)) { fprintf(stderr, "kernel_launch: unexpected CU count %d\n", cus); }
    }
    if (grid < 0) return;
    if (hipMemsetAsync((char*)d_ws + WS_CTL, 0, CTL_ZERO_BYTES, stream) != hipSuccess) return;
    Args a{};
    for (int i = 0; i < 25; ++i) a.in[i] = (const float*)d_in[i];
    a.out = (float*)d_out; a.ws = (unsigned char*)d_ws;
#if MK_MULTI
    for (int p = 0; p < N_PHASES; ++p) { a.ph_lo = p; a.ph_hi = p + 1; hipLaunchKernelGGL(fwd_kernel, dim3(grid), dim3(NTHR), LDS_BYTES, stream, a); }
#else
    a.ph_lo = 0; a.ph_hi = N_PHASES;
    hipLaunchKernelGGL(fwd_kernel, dim3(grid), dim3(NTHR), LDS_BYTES, stream, a);
#endif
}
```

```cpp
#include <hip/hip_runtime.h>
#include <cstdio>
#include <cstdint>
namespace pg8 {
#define PG8_LAS __attribute__((address_space(3)))
typedef unsigned short bf16_t;
typedef short bf16x8 __attribute__((ext_vector_type(8)));
typedef float f32x4 __attribute__((ext_vector_type(4)));
typedef unsigned u32x4 __attribute__((ext_vector_type(4)));
constexpr int BM = 256, BK = 64, HALF = 128, HTB = HALF * BK * 2  , STAGE_BYTES = 8 * HTB, NXCD = 8, WGM = 8;

__host__ __device__ __forceinline__ int lds_byte(int r, int c) { const int st = (r >> 4) * 2 + (c >> 5), rr = r & 15, cc = c & 31, ob = rr * 64 + cc * 2; return st * 1024 + (ob ^ (((ob >> 9) & 1) << 5)); }
__host__ __device__ __forceinline__ void stage_rc(int b, int& R, int& C) { const int st = b / 1024, sb = b % 1024, swz = sb ^ (((sb >> 9) & 1) << 5); R = (st >> 1) * 16 + swz / 64; C = (st & 1) * 32 + (swz % 64) / 2; }
__host__ __device__ __forceinline__ int perm32(int rho) { const int n = rho >> 4, i = rho & 15; return 8 * (i >> 2) + 4 * n + (i & 3); }

struct Unit { int pm, pn; };
struct Gemm { const bf16_t* A; const bf16_t* Bt; int M, N, K; };

struct StaticOrder {
    int nM, nN, nwg, G, c;
    __host__ __device__ void init(int M, int N, int G_, int c_) { nM = M / BM; nN = N / BM; nwg = nM * nN; G = G_; c = c_; }
    __host__ __device__ bool next(int i, Unit& u) const {
        const long L = (long)i * G + c; if (L >= nwg) return false;
        int wgid = (int)L; { const int q = nwg / NXCD, r = nwg % NXCD, xcd = wgid % NXCD, off = wgid / NXCD; wgid = (xcd < r ? xcd * (q + 1) : r * (q + 1) + (xcd - r) * q) + off; }
        const int nig = WGM * nN, gid = wgid / nig, fm = gid * WGM, gsz = (nM - fm) < WGM ? (nM - fm) : WGM;
        u.pm = fm + ((wgid % nig) % gsz); u.pn = (wgid % nig) / gsz; return true;
    }
    __device__ __forceinline__ void a_ready(const Unit&) const {}
    __device__ __forceinline__ void done(const Unit&) const {}
};

__device__ __forceinline__ unsigned cvt_pk_bf16(float lo, float hi) { unsigned r; asm volatile("v_cvt_pk_bf16_f32 %0, %1, %2" : "=v"(r) : "v"(lo), "v"(hi)); return r; }
__device__ __forceinline__ float fast_sigmoid(float x) { return __builtin_amdgcn_rcpf(1.0f + __builtin_amdgcn_exp2f(-1.44269504089f * x)); }

constexpr int HLD = 2816;
constexpr float QSCALE = 0.125f * 1.44269504089f;

struct EpiInProj {
    static constexpr bool PERM = true, AFTER_DRAIN = false, GATHER = false;
    bf16_t* H; float* side; const float* rope;
    __device__ __forceinline__ void operator()(const f32x4 (&acc)[2][2][4][2], const Unit& u, int wr, int wc, int fr, int fq) const {
        const int row0 = u.pm * BM + wr * 64 + fr; const int pn = u.pn;
        if (pn <= 4) {
#pragma unroll
            for (int ai = 0; ai < 2; ++ai)
#pragma unroll
                for (int m = 0; m < 4; ++m) {
                    const int row = row0 + ai * HALF + m * 16; const float* rp = rope + (size_t)(row & 4095) * 16;
                    const f32x4 c0 = *(const f32x4*)(rp), c1 = *(const f32x4*)(rp + 4), s0 = *(const f32x4*)(rp + 8), s1 = *(const f32x4*)(rp + 12);
#pragma unroll
                    for (int bj = 0; bj < 2; ++bj) {
                        f32x4 v0 = acc[ai][bj][m][0], v1 = acc[ai][bj][m][1];
                        const bool ropeb = (pn < 2) || (bj == 0);
                        if (ropeb) {
                            f32x4 p0, p1;
#pragma unroll
                            for (int e = 0; e < 4; ++e) { p0[e] = __shfl_xor(v0[e], 16); p1[e] = __shfl_xor(v1[e], 16); }
                            if (((wc & 1) == 0) && fq < 2) { const float sg = fq ? 1.f : -1.f; v0 = v0 * c0 + (p0 * s0) * sg; v1 = v1 * c1 + (p1 * s1) * sg; }
                        }
                        if (pn < 2) { v0 = v0 * QSCALE; v1 = v1 * QSCALE; }
                        u32x4 w; w.x = cvt_pk_bf16(v0[0], v0[1]); w.y = cvt_pk_bf16(v0[2], v0[3]); w.z = cvt_pk_bf16(v1[0], v1[1]); w.w = cvt_pk_bf16(v1[2], v1[3]);
                        *(u32x4*)(H + (size_t)row * HLD + pn * BM + bj * HALF + wc * 32 + 8 * fq) = w;
                    }
                }
        } else if (pn < 11) {
#pragma unroll
            for (int ai = 0; ai < 2; ++ai)
#pragma unroll
                for (int m = 0; m < 4; ++m) {
                    const int row = row0 + ai * HALF + m * 16;
#pragma unroll
                    for (int bj = 0; bj < 2; ++bj) {
                        const f32x4 v0 = acc[ai][bj][m][0], v1 = acc[ai][bj][m][1];
                        u32x4 w; w.x = cvt_pk_bf16(v0[0], v0[1]); w.y = cvt_pk_bf16(v0[2], v0[3]); w.z = cvt_pk_bf16(v1[0], v1[1]); w.w = cvt_pk_bf16(v1[2], v1[3]);
                        *(u32x4*)(H + (size_t)row * HLD + pn * BM + bj * HALF + wc * 32 + 8 * fq) = w;
                    }
                }
        } else if (wc == 0) {
#pragma unroll
            for (int ai = 0; ai < 2; ++ai)
#pragma unroll
                for (int m = 0; m < 4; ++m) {
                    const int row = row0 + ai * HALF + m * 16;
                    f32x4 v0 = acc[ai][0][m][0], v1 = acc[ai][0][m][1];
#pragma unroll
                    for (int e = 0; e < 4; ++e) { v0[e] = fast_sigmoid(v0[e]); if (fq < 3) v1[e] = fast_sigmoid(v1[e]); }
                    *(f32x4*)(side + (size_t)row * 32 + 8 * fq) = v0; *(f32x4*)(side + (size_t)row * 32 + 8 * fq + 4) = v1;
                }
        }
    }
};
struct EpiOutProj {
    static constexpr bool PERM = false, AFTER_DRAIN = false, GATHER = false;
    const bf16_t* res; float* out; float alpha;
    __device__ __forceinline__ void operator()(const f32x4 (&acc)[2][2][4][2], const Unit& u, int wr, int wc, int fr, int fq) const {
        typedef unsigned u32x2 __attribute__((ext_vector_type(2)));
        const int row0 = u.pm * BM + wr * 64 + fr, col0 = u.pn * BM + wc * 32 + 4 * fq;
#pragma unroll
        for (int ai = 0; ai < 2; ++ai)
#pragma unroll
            for (int m = 0; m < 4; ++m) { const size_t off = (size_t)(row0 + ai * HALF + m * 16) * 1024 + col0;
#pragma unroll
                for (int bj = 0; bj < 2; ++bj)
#pragma unroll
                    for (int n = 0; n < 2; ++n) { const u32x2 rb = *(const u32x2*)(res + off + bj * HALF + n * 16);
                        f32x4 r; r[0] = __uint_as_float(rb.x << 16); r[1] = __uint_as_float(rb.x & 0xffff0000u); r[2] = __uint_as_float(rb.y << 16); r[3] = __uint_as_float(rb.y & 0xffff0000u);
                        *(f32x4*)(out + off + bj * HALF + n * 16) = r * alpha + acc[ai][bj][m][n]; }
                asm volatile("" ::: "memory"); }
    }
};
struct EpiSwiGLU {
    static constexpr bool PERM = true, AFTER_DRAIN = false, GATHER = true;
    bf16_t* hid; const int* rowmap; int rowshift;
    __device__ __forceinline__ void operator()(const f32x4 (&acc)[2][2][4][2], const Unit& u, int wr, int wc, int fr, int fq) const {
        const int row0 = u.pm * BM + wr * 64 + fr, hc0 = (u.pn & 3) * 128 + wc * 16 + 4 * fq;
#pragma unroll
        for (int ai = 0; ai < 2; ++ai)
#pragma unroll
            for (int m = 0; m < 4; ++m) { bf16_t* rowp = hid + (size_t)(row0 + ai * HALF + m * 16) * 512 + hc0;
#pragma unroll
                for (int bj = 0; bj < 2; ++bj) { const f32x4 g = acc[ai][bj][m][0], up = acc[ai][bj][m][1]; f32x4 h;
#pragma unroll
                    for (int e = 0; e < 4; ++e) h[e] = g[e] * fast_sigmoid(g[e]) * up[e];
                    typedef unsigned u32x2 __attribute__((ext_vector_type(2)));
                    u32x2 w; w.x = cvt_pk_bf16(h[0], h[1]); w.y = cvt_pk_bf16(h[2], h[3]);
                    *(u32x2*)(rowp + bj * 64) = w; } }
    }
};
struct EpiDown {
    static constexpr bool PERM = true, AFTER_DRAIN = false, GATHER = false;
    bf16_t* y2; const int* slot_tok; const float* slot_w;
    __device__ __forceinline__ void operator()(const f32x4 (&acc)[2][2][4][2], const Unit& u, int wr, int wc, int fr, int fq) const {
        const int row0 = u.pm * BM + wr * 64 + fr, col0 = (u.pn & 3) * BM + wc * 32 + 8 * fq;
#pragma unroll
        for (int ai = 0; ai < 2; ++ai)
#pragma unroll
            for (int m = 0; m < 4; ++m) { const int row = row0 + ai * HALF + m * 16; const int st = slot_tok[row]; const float sw = slot_w[row];
                if (st >= 0) { bf16_t* rowp = y2 + (size_t)st * 1024 + col0;
#pragma unroll
                    for (int bj = 0; bj < 2; ++bj) { const f32x4 v0 = acc[ai][bj][m][0] * sw, v1 = acc[ai][bj][m][1] * sw;
                        u32x4 w; w.x = cvt_pk_bf16(v0[0], v0[1]); w.y = cvt_pk_bf16(v0[2], v0[3]); w.z = cvt_pk_bf16(v1[0], v1[1]); w.w = cvt_pk_bf16(v1[2], v1[3]);
                        *(u32x4*)(rowp + bj * HALF) = w; } } }
    }
};
struct MoeOrder {
    const int* meta; int G, c;
    __device__ __forceinline__ bool next(int i, Unit& u) const {
        const int per = G >> 3; const int idx = (G & 7) ? (i * G + c) : ((i * 8 + (c & 7)) * per + (c >> 3));
        const int nt = meta[0]; if (idx >= nt * 4) return false;
        const int pm = idx >> 2; u.pm = pm; u.pn = meta[64 + pm] * 4 + (idx & 3); return true;
    }
    __device__ __forceinline__ void a_ready(const Unit&) const {}
    __device__ __forceinline__ void done(const Unit&) const {}
};
template <class Epi, class Sched, bool STAMP = false>
__device__ __forceinline__ void gemm_phase(PG8_LAS unsigned char* lds, const Gemm g, const Sched& S, const Epi& E, unsigned long long* stamps, int tid_in) {
    int tid_ = tid_in; asm volatile("" : "+v"(tid_));
    const int tid = tid_, wid = __builtin_amdgcn_readfirstlane(tid >> 6), lane = tid & 63, wr = wid >> 2, wc = wid & 3, fr = lane & 15, fq = lane >> 4;
    const int K = g.K, nt = K / BK;
    int ts_lo = 0, ts_hi = 0, nts = 0; const unsigned long long rt_entry = STAMP ? (unsigned long long)wall_clock64() : 0ull;
#define PG8_STAMP() do { if (STAMP && wid == 0 && nts < 64) { const unsigned long long _c = (unsigned long long)clock64(); \
        ts_lo = (lane == nts) ? (int)(unsigned)_c : ts_lo; ts_hi = (lane == nts) ? (int)(unsigned)(_c >> 32) : ts_hi; ++nts; } } while (0)
    PG8_STAMP();
    unsigned voffA[2], voffB[2];
#pragma unroll
    for (int i = 0; i < 2; ++i) { int R, C; stage_rc(tid * 16 + i * 8192, R, C); const int Rb = Epi::PERM ? ((R & ~31) + perm32(R & 31)) : R;
        voffA[i] = (unsigned)(R * K + C) * 2u; voffB[i] = (unsigned)(Rb * K + C) * 2u; }
    unsigned offAc[2][2], offAn[2][2];
    PG8_LAS unsigned char* gidx = lds + STAGE_BYTES + (unsigned)wid * 1024u;
#define PG8_IDX_DMA(par, pm_) do { int t2_ = tid; asm volatile("" : "+v"(t2_)); _Pragma("unroll") for (int i_ = 0; i_ < 2; ++i_) { int R_, C_; stage_rc(t2_ * 16 + i_ * 8192, R_, C_); (void)C_; \
        _Pragma("unroll") for (int h_ = 0; h_ < 2; ++h_) __builtin_amdgcn_global_load_lds((const unsigned*)(E.rowmap + (size_t)(pm_) * BM + h_ * HALF + R_), (PG8_LAS unsigned*)(gidx + (par) * 512 + (h_ * 2 + i_) * 256), 4, 0, 0); } } while (0)
#define PG8_IDX_READ(dst, par) do { int t2_ = tid; asm volatile("" : "+v"(t2_)); _Pragma("unroll") for (int i_ = 0; i_ < 2; ++i_) { int R_, C_; stage_rc(t2_ * 16 + i_ * 8192, R_, C_); (void)R_; \
        _Pragma("unroll") for (int h_ = 0; h_ < 2; ++h_) { int r_ = *(const PG8_LAS int*)(gidx + (par) * 512 + (h_ * 2 + i_) * 256 + (t2_ & 63) * 4); r_ = r_ < 0 ? 0 : (r_ >> E.rowshift); dst[h_][i_] = (unsigned)r_ * (unsigned)(K * 2) + (unsigned)C_ * 2u; } } } while (0)
    const size_t kstep = (size_t)(BK * 2);
    const size_t hstep = (size_t)HALF * K * 2;
    const size_t tstep = 2 * hstep;
    const unsigned ldsw = (unsigned)wid * 1024u;
    const int aoff = lds_byte(wr * 64 + fr, fq * 8), boff = lds_byte(wc * 32 + fr, fq * 8);
#define PG8_SA(b, h) (((b) * 2 + (h)) * HTB)
#define PG8_SB(b, h) ((4 + (b) * 2 + (h)) * HTB)
#define PG8_STAGE(bufoff, gbase, voff) do { _Pragma("unroll") for (int _i = 0; _i < 2; ++_i) \
        __builtin_amdgcn_global_load_lds((const unsigned*)((const char*)(gbase) + (voff)[_i]), (PG8_LAS unsigned*)(lds + (bufoff) + ldsw + _i * 8192), 16, 0, 0); } while (0)
#define PG8_STAGE_A(bufoff, kt_, h_, nx_) do { if constexpr (Epi::GATHER) { _Pragma("unroll") for (int _i = 0; _i < 2; ++_i) { const unsigned o_ = (nx_) ? offAn[h_][_i] : offAc[h_][_i]; \
            __builtin_amdgcn_global_load_lds((const unsigned*)((const char*)g.A + (size_t)(kt_) * kstep + o_), (PG8_LAS unsigned*)(lds + (bufoff) + ldsw + _i * 8192), 16, 0, 0); } } \
        else { PG8_STAGE(bufoff, ((nx_) ? nA : cA) + (size_t)(kt_) * kstep + (h_) * hstep, voffA); } } while (0)
#define PG8_LDA(dst, b, h) do { _Pragma("unroll") for (int m = 0; m < 4; ++m) _Pragma("unroll") for (int k = 0; k < 2; ++k) dst[m][k] = *(const PG8_LAS bf16x8*)(lds + PG8_SA(b, h) + aoff + m * 2048 + k * 1024); } while (0)
#define PG8_LDB(dst, b, h) do { _Pragma("unroll") for (int n = 0; n < 2; ++n) _Pragma("unroll") for (int k = 0; k < 2; ++k) dst[n][k] = *(const PG8_LAS bf16x8*)(lds + PG8_SB(b, h) + boff + n * 2048 + k * 1024); } while (0)
#define PG8_MMA(ai, bj, At, Bt) do { __builtin_amdgcn_s_setprio(1); _Pragma("unroll") for (int m = 0; m < 4; ++m) _Pragma("unroll") for (int n = 0; n < 2; ++n) _Pragma("unroll") for (int k = 0; k < 2; ++k) \
        acc[ai][bj][m][n] = __builtin_amdgcn_mfma_f32_16x16x32_bf16(Bt[n][k], At[m][k], acc[ai][bj][m][n], 0, 0, 0); __builtin_amdgcn_s_setprio(0); } while (0)
#define PG8_WAIT_V(n) asm volatile("s_waitcnt vmcnt(" #n ")" ::: "memory")
#define PG8_WAIT_L(n) asm volatile("s_waitcnt lgkmcnt(" #n ")" ::: "memory")
#define PG8_BAR __builtin_amdgcn_s_barrier()
#define PG8_SCHED __builtin_amdgcn_sched_barrier(0)
    Unit cur, nxt; int ui = 0;
    if (!S.next(0, cur)) return;
    f32x4 acc[2][2][4][2];
    float zf_ = 0.f; asm volatile("" : "+v"(zf_));
#pragma unroll
    for (int a = 0; a < 2; ++a)
#pragma unroll
        for (int b = 0; b < 2; ++b)
#pragma unroll
            for (int m = 0; m < 4; ++m)
#pragma unroll
                for (int n = 0; n < 2; ++n) acc[a][b][m][n] = (f32x4){zf_, zf_, zf_, zf_};
    bf16x8 At[4][2], B0[2][2], B1[2][2];
    const char* cA = (const char*)g.A + (size_t)cur.pm * tstep; const char* cB = (const char*)g.Bt + (size_t)cur.pn * tstep;
    S.a_ready(cur);
    if constexpr (Epi::GATHER) { PG8_IDX_DMA(0, cur.pm); asm volatile("s_waitcnt vmcnt(0)" ::: "memory"); PG8_IDX_READ(offAc, 0); asm volatile("s_waitcnt lgkmcnt(0)" ::: "memory"); }
    const char* nA = cA;
    PG8_STAGE(PG8_SB(0, 0), cB, voffB); PG8_STAGE_A(PG8_SA(0, 0), 0, 0, false); PG8_STAGE(PG8_SB(0, 1), cB + hstep, voffB); PG8_STAGE_A(PG8_SA(0, 1), 0, 1, false);
    if (wr == 1) PG8_BAR;
    PG8_WAIT_V(4); PG8_BAR;
    PG8_STAGE(PG8_SB(1, 0), cB + kstep, voffB); PG8_STAGE_A(PG8_SA(1, 0), 1, 0, false); PG8_STAGE(PG8_SB(1, 1), cB + hstep + kstep, voffB);
    PG8_WAIT_V(6); PG8_BAR;
    PG8_STAMP();
    for (;;) {
        const bool has_next = S.next(ui + 1, nxt);
        nA = has_next ? (const char*)g.A + (size_t)nxt.pm * tstep : cA; const char* nB = has_next ? (const char*)g.Bt + (size_t)nxt.pn * tstep : cB;
        if constexpr (Epi::GATHER) { if (has_next) PG8_IDX_DMA((ui + 1) & 1, nxt.pm); }
        for (int t = 0; t < nt; t += 2) {
            const bool last = (t == nt - 2);
            const char* b2 = last ? nB : cB + (size_t)(t + 2) * kstep;
            const char* b3 = b2 + kstep;
            const int kt2 = last ? 0 : t + 2;
            if constexpr (Epi::GATHER) { if (last) { if (has_next) PG8_IDX_READ(offAn, (ui + 1) & 1); else { offAn[0][0] = offAc[0][0]; offAn[0][1] = offAc[0][1]; offAn[1][0] = offAc[1][0]; offAn[1][1] = offAc[1][1]; } } }
            if (last && has_next) S.a_ready(nxt);
            PG8_LDB(B0, 0, 0); PG8_SCHED; PG8_LDA(At, 0, 0); PG8_STAGE_A(PG8_SA(1, 1), t + 1, 1, false);
            PG8_WAIT_L(8); PG8_BAR; PG8_WAIT_L(0); PG8_MMA(0, 0, At, B0); PG8_BAR; PG8_SCHED;
            PG8_LDB(B1, 0, 1); PG8_STAGE(PG8_SB(0, 0), b2, voffB);
            PG8_BAR; PG8_WAIT_L(0); PG8_MMA(0, 1, At, B1); PG8_BAR;
            PG8_LDA(At, 0, 1); PG8_STAGE_A(PG8_SA(0, 0), kt2, 0, last);
            PG8_BAR; PG8_WAIT_L(0); PG8_MMA(1, 0, At, B0); PG8_BAR; PG8_SCHED;
            PG8_STAGE(PG8_SB(0, 1), b2 + hstep, voffB);
            PG8_WAIT_V(6); PG8_BAR; PG8_MMA(1, 1, At, B1); PG8_BAR;
            PG8_LDB(B0, 1, 0); PG8_SCHED; PG8_LDA(At, 1, 0); PG8_STAGE_A(PG8_SA(0, 1), kt2, 1, last);
            PG8_WAIT_L(8); PG8_BAR; PG8_WAIT_L(0); PG8_MMA(0, 0, At, B0); PG8_BAR; PG8_SCHED;
            PG8_LDB(B1, 1, 1); PG8_STAGE(PG8_SB(1, 0), b3, voffB);
            PG8_BAR; PG8_WAIT_L(0); PG8_MMA(0, 1, At, B1); PG8_BAR;
            PG8_LDA(At, 1, 1); PG8_STAGE_A(PG8_SA(1, 0), kt2 + 1, 0, last);
            PG8_BAR; PG8_WAIT_L(0); PG8_MMA(1, 0, At, B0); PG8_BAR; PG8_SCHED;
            PG8_STAGE(PG8_SB(1, 1), b3 + hstep, voffB);
            PG8_WAIT_V(6); PG8_BAR; PG8_MMA(1, 1, At, B1); PG8_BAR;
        }
        PG8_STAMP();
        if constexpr (!Epi::AFTER_DRAIN) { E(acc, cur, wr, wc, fr, fq); S.done(cur); }
        PG8_STAMP();
        if (!has_next) break;
#pragma unroll
        for (int a = 0; a < 2; ++a)
#pragma unroll
            for (int b = 0; b < 2; ++b)
#pragma unroll
                for (int m = 0; m < 4; ++m)
#pragma unroll
                    for (int n = 0; n < 2; ++n) acc[a][b][m][n] = (f32x4){zf_, zf_, zf_, zf_};
        cur = nxt; cA = nA; cB = nB; ++ui;
        if constexpr (Epi::GATHER) { offAc[0][0] = offAn[0][0]; offAc[0][1] = offAn[0][1]; offAc[1][0] = offAn[1][0]; offAc[1][1] = offAn[1][1]; }
    }
    PG8_WAIT_V(0);
    if (wr == 0) PG8_BAR;
    PG8_BAR;
    if constexpr (Epi::AFTER_DRAIN) { E.fused(acc, cur, wr, wc, fr, fq, lds, wid, lane); S.done(cur); }
    PG8_STAMP();
    if (STAMP && wid == 0) { stamps[lane] = lane < nts ? (((unsigned long long)(unsigned)ts_hi << 32) | (unsigned)ts_lo) : 0ull;
        if (lane == 62) stamps[62] = rt_entry; if (lane == 63) stamps[63] = (unsigned long long)wall_clock64(); }
#undef PG8_STAMP
#undef PG8_SA
#undef PG8_SB
#undef PG8_STAGE
#undef PG8_STAGE_A
#undef PG8_IDX_DMA
#undef PG8_IDX_READ
#undef PG8_LDA
#undef PG8_LDB
#undef PG8_MMA
#undef PG8_WAIT_V
#undef PG8_WAIT_L
#undef PG8_BAR
#undef PG8_SCHED
}
}

#ifndef SELFCHECK
#define SELFCHECK 0
#endif
#ifndef PROBE_SCAN_VAR
#define PROBE_SCAN_VAR 0
#endif
#ifndef PROBE_ATTN_VAR
#define PROBE_ATTN_VAR 0
#endif
constexpr int NB = 8, SEQ = 4096, DM = 1024, NL = 4, T = NB * SEQ;
constexpr int DIN = 2848, DINP = 3072, HLD = pg8::HLD;
constexpr int NEXP = 32, FF = 512, NTILE_MAX = 288;
constexpr float LN_EPS = 1e-5f;
constexpr float DN_ALPHA = 1.6817928305074290f;
constexpr int NWAVES = 8, NTHR = 512;

constexpr size_t MiB = 1u << 20, KiB = 1u << 10;
constexpr size_t WS_CTL = 0, CTL_ZERO_BYTES = 128 * KiB;
constexpr size_t WS_ROPE = 1 * MiB;
constexpr size_t WS_META = 1 * MiB + 512 * KiB;
constexpr size_t WS_GL = WS_META + 16 * KiB;
constexpr size_t WS_WL = 2 * MiB;
constexpr size_t WL_WIN = 0, WL_WOUT = 6 * MiB, WL_WGU = 8 * MiB, WL_WDN = 72 * MiB, WL_W1 = 104 * MiB, WL_W2 = 105 * MiB, WL_BIAS1 = 105 * MiB + 64 * KiB, WL_WR = 105 * MiB + 128 * KiB;
constexpr size_t WS_XB = 108 * MiB;
constexpr size_t WS_X1 = 172 * MiB;
constexpr size_t WS_H = 300 * MiB;
constexpr size_t WS_SIDE = 476 * MiB;
constexpr size_t WS_Y = 480 * MiB;
constexpr size_t WS_GPREP = 544 * MiB;
constexpr size_t WS_Y2 = 672 * MiB;
constexpr size_t WS_HID = 800 * MiB;
constexpr size_t WS_KC = 872 * MiB, WS_VC = WS_KC + 512 * KiB;
constexpr size_t WS_SLOT = 873 * MiB;
constexpr size_t SL_TOK = 0, SL_W = 512 * KiB, SL_RE = 1024 * KiB, SL_RP = 1280 * KiB, SL_RW = 1536 * KiB;
constexpr size_t WS_END = 876 * MiB;
constexpr int GCH = 65536;
constexpr int GC_UT = 0, GC_W = 8192, GC_QK = 16384, GC_QD = 24576, GC_KDT = 32768, GC_ZT = 40960, GC_SS = 49152, GC_VB = 57344;
constexpr int CW_TMO = 0;
constexpr int CW_BAR = 4096;
constexpr int CW_CNT = 8192;
constexpr int CW_QUEUE = 12288;
static_assert((CW_QUEUE + NL * 64) * 4 <= (int)CTL_ZERO_BYTES, "CTL words inside the memset region");

constexpr int SCR_BYTES = 159744;
constexpr int MISC_OFF = SCR_BYTES;
constexpr int LDS_BYTES = 163840;

#define GAS __attribute__((address_space(1)))
#define LAS __attribute__((address_space(3)))
typedef unsigned short bf16;
typedef float f32x4 __attribute__((ext_vector_type(4)));
typedef float f32x2 __attribute__((ext_vector_type(2)));
typedef float f32x16 __attribute__((ext_vector_type(16)));
typedef short bf16x8 __attribute__((ext_vector_type(8)));
typedef short s16x4 __attribute__((ext_vector_type(4)));
typedef unsigned u32x4 __attribute__((ext_vector_type(4)));
typedef unsigned u32x2 __attribute__((ext_vector_type(2)));
#define LDS_WAIT() asm volatile("s_waitcnt lgkmcnt(0)" ::: "memory")
#define VM_WAIT() asm volatile("s_waitcnt vmcnt(0)" ::: "memory")
#define SBAR() __builtin_amdgcn_sched_barrier(0)
__device__ __forceinline__ float bf2f(unsigned b) { return __uint_as_float(b << 16); }
__device__ __forceinline__ unsigned f2bf(float f) { unsigned u = __float_as_uint(f); return (u + 0x7fffu + ((u >> 16) & 1u)) >> 16; }
__device__ __forceinline__ unsigned pk2(float lo, float hi) { return pg8::cvt_pk_bf16(lo, hi); }
__device__ __forceinline__ float row16_sum(float x) {
    x += __int_as_float(__builtin_amdgcn_update_dpp(0, __float_as_int(x), 0xB1, 0xf, 0xf, true));
    x += __int_as_float(__builtin_amdgcn_update_dpp(0, __float_as_int(x), 0x4E, 0xf, 0xf, true));
    x += __int_as_float(__builtin_amdgcn_update_dpp(0, __float_as_int(x), 0x141, 0xf, 0xf, true));
    x += __int_as_float(__builtin_amdgcn_update_dpp(0, __float_as_int(x), 0x140, 0xf, 0xf, true));
    return x;
}
__device__ __forceinline__ float wave_sum(float v) {
    const int r = __float_as_int(row16_sum(v));
    return (__int_as_float(__builtin_amdgcn_readlane(r, 0)) + __int_as_float(__builtin_amdgcn_readlane(r, 16))) + (__int_as_float(__builtin_amdgcn_readlane(r, 32)) + __int_as_float(__builtin_amdgcn_readlane(r, 48)));
}
__device__ __forceinline__ float fsigmoid(float x) { return pg8::fast_sigmoid(x); }
__device__ __forceinline__ float fsilu(float x) { return x * pg8::fast_sigmoid(x); }
__device__ __forceinline__ float fexp2(float x) { return __builtin_amdgcn_exp2f(x); }

#define XB_TMO      128
#define XB_XCNT(j)  (256  + 64 * (j))
#define XB_XSUB(j)  (1280 + 64 * (j))
#define XB_XGEN(j)  (2304 + 64 * (j))
#define XB_TOP      3328
#define XB_TOPGEN   3392
#define XCD_BAR_WORDS 3456
#define XB_SPIN_CAP (1u << 18)
#define LAS __attribute__((address_space(3)))

__device__ __forceinline__ unsigned xb_ld(unsigned* p)              { return __hip_atomic_load(p, __ATOMIC_RELAXED, __HIP_MEMORY_SCOPE_AGENT); }
__device__ __forceinline__ unsigned xb_add(unsigned* p, unsigned v) { return __hip_atomic_fetch_add(p, v, __ATOMIC_RELAXED, __HIP_MEMORY_SCOPE_AGENT); }
__device__ __forceinline__ unsigned xb_xcc_id() { return (unsigned)__builtin_amdgcn_s_getreg((3 << 11) | 20) & 0xFu; }
#define XB_SPIN(cond, bar) do { unsigned _sp = 0; while (cond) { __builtin_amdgcn_s_sleep(1); \
    if ((++_sp & 255u) == 0u) { if (xb_ld(&(bar)[XB_TMO])) break; if (_sp > XB_SPIN_CAP) { atomicAdd(&(bar)[XB_TMO], 1u); break; } } } } while (0)

struct XcdBarrier {
    unsigned* bar; unsigned x;
    volatile LAS unsigned* st;
};

__device__ __forceinline__ XcdBarrier xcd_barrier_post(unsigned* bar, volatile LAS unsigned* st) {
    XcdBarrier b; b.bar = bar; b.x = xb_xcc_id(); b.st = st;
    if (threadIdx.x == 0) (void)xb_add(&bar[XB_XCNT(b.x)], 1u);
    return b;
}
__device__ __forceinline__ void xcd_barrier_complete(unsigned* bar, unsigned x, unsigned& nloc, unsigned& nx) {
    const unsigned G = gridDim.x * gridDim.y * gridDim.z;
    unsigned sum, cnt, mine, sp = 0u;
    for (;;) {
        sum = 0u; cnt = 0u; mine = 0u;
#pragma unroll
        for (unsigned j = 0; j < 16; ++j) { const unsigned c = xb_ld(&bar[XB_XCNT(j)]); sum += c; cnt += (c > 0u) ? 1u : 0u; mine = (j == x) ? c : mine; }
        if (sum == G) break;
        __builtin_amdgcn_s_sleep(1);
        if ((++sp & 255u) == 0u) { if (xb_ld(&bar[XB_TMO])) break; if (sp > XB_SPIN_CAP) { atomicAdd(&bar[XB_TMO], 1u); break; } }
    }
    nloc = mine > 0u ? mine : 1u; nx = cnt > 0u ? cnt : 1u;
}

__device__ __forceinline__ void xcd_barrier(const XcdBarrier& b) {
    asm volatile("s_waitcnt vmcnt(0)" ::: "memory");
    __syncthreads();
    if (threadIdx.x == 0) {
        unsigned* bar = b.bar;
        __builtin_amdgcn_s_waitcnt(0);
        unsigned nloc = b.st[0], nx = b.st[1];
        if (nloc == 0u) { xcd_barrier_complete(bar, b.x, nloc, nx); b.st[0] = nloc; b.st[1] = nx; }
        const unsigned old = xb_add(&bar[XB_XSUB(b.x)], 1u);
        const unsigned gen = old / nloc;
        if (old + 1u == (gen + 1u) * nloc) {
            __builtin_amdgcn_fence(__ATOMIC_RELEASE, "agent");
            asm volatile("s_waitcnt vmcnt(0)" ::: "memory");
            const unsigned og = xb_add(&bar[XB_TOP], 1u);
            const unsigned tg = og / nx;
            if (og + 1u == (tg + 1u) * nx) xb_add(&bar[XB_TOPGEN], 1u);
            else XB_SPIN(xb_ld(&bar[XB_TOPGEN]) == tg, bar);
            __builtin_amdgcn_fence(__ATOMIC_ACQUIRE, "agent");
            xb_add(&bar[XB_XGEN(b.x)], 1u);
            asm volatile("s_waitcnt vmcnt(0)" ::: "memory");
        } else {
            XB_SPIN(xb_ld(&bar[XB_XGEN(b.x)]) == gen, bar);
            __builtin_amdgcn_fence(__ATOMIC_ACQUIRE, "agent");
            asm volatile("s_waitcnt vmcnt(0)" ::: "memory");
        }
    }
    __syncthreads();
}

struct Args { const float* in[25]; float* out; unsigned char* ws; int ph_lo, ph_hi; };
typedef const __attribute__((address_space(4))) Args* ArgsP;
__device__ __forceinline__ ArgsP args_here() { ArgsP p = (ArgsP)__builtin_amdgcn_kernarg_segment_ptr(); asm volatile("" : "+s"(p)); return p; }
struct Frame { LAS unsigned char* lds; volatile LAS unsigned* MISC; unsigned* ctl; int tid, lane, wave, G, bid; };

template <class Src>
__device__ __forceinline__ void tr_item(const Src src, int K, int N, bf16* WT, LAS float* scr, int item, int lane) {
    const int nblk = N >> 5, kb = item / nblk, nb = item - kb * nblk, k0 = kb << 6, n0 = nb << 5;
    float tv[32];
#pragma unroll
    for (int i = 0; i < 32; ++i) tv[i] = src(k0 + 2 * i + (lane >> 5), n0 + (lane & 31));
#pragma unroll
    for (int i = 0; i < 32; ++i) scr[(2 * i + (lane >> 5)) * 33 + (lane & 31)] = tv[i];
    LDS_WAIT();
    const int c = lane & 7;
#pragma unroll
    for (int j = 0; j < 4; ++j) { const int n = (lane >> 3) + 8 * j; const LAS float* s = scr + (8 * c) * 33 + n;
        u32x4 o; o.x = pk2(s[0], s[33]); o.y = pk2(s[66], s[99]); o.z = pk2(s[132], s[165]); o.w = pk2(s[198], s[231]);
        *(u32x4*)(WT + (size_t)(n0 + n) * K + k0 + 8 * c) = o; }
    LDS_WAIT();
}
struct SrcPlain { const float* p; int ld; __device__ __forceinline__ float operator()(int k, int n) const { return p[(size_t)k * ld + n]; } };
struct SrcWin { const float* p;
    __device__ __forceinline__ float operator()(int k, int n) const {
        int c;
        if (n < 1280) c = n; else if (n < 2048) c = n + 24; else if (n < 2304) c = n + 24; else if (n < 2816) c = n + 32;
        else if (n < 2840) c = n - 2816 + 1280; else if (n < 2844) c = n - 2840 + 2328; else if (n < 2848) c = n - 2844 + 2332; else return 0.f;
        return p[(size_t)k * DIN + c]; } };
struct SrcGU { const float* wg; const float* wu;
    __device__ __forceinline__ float operator()(int k, int n) const { const int q = n >> 3, r = n & 7; const ptrdiff_t d = (r < 4) ? (ptrdiff_t)0 : (wu - wg); return wg[d + (ptrdiff_t)k * FF + 4 * q + (r & 3)]; } };

__device__ __forceinline__ void phase_weights(const Frame& F, ArgsP a, int l) {
    unsigned char* wl = a->ws + WS_WL;
    LAS float* scr = (LAS float*)(F.lds + F.wave * 16384);
    const int gw = F.bid * NWAVES + F.wave, NGW = F.G * NWAVES;
    constexpr int I_WIN = 16 * 96, I_WOUT = 16 * 32, I_GU1 = 16 * 32, I_GU = NEXP * I_GU1, I_DN1 = 8 * 32, I_DN = NEXP * I_DN1, I_W1 = 2 * 32 * 4, I_W2 = 2 * 2 * 2, I_WR = 36, I_B1 = 256;
    constexpr int NITEMS = I_WIN + I_WOUT + I_GU + I_DN + I_W1 + I_W2 + I_WR + I_B1;
    for (int it = gw; it < NITEMS; it += NGW) {
        int r = it;
        if (r < I_GU) { const int e = r / I_GU1; SrcGU s{a->in[22] + ((size_t)l * NEXP + e) * DM * FF, a->in[23] + ((size_t)l * NEXP + e) * DM * FF};
            tr_item(s, DM, 1024, (bf16*)(wl + WL_WGU) + (size_t)e * 1024 * DM, scr, r - e * I_GU1, F.lane); continue; } r -= I_GU;
        if (r < I_DN) { const int e = r / I_DN1; SrcPlain s{a->in[24] + ((size_t)l * NEXP + e) * FF * DM, DM};
            tr_item(s, FF, DM, (bf16*)(wl + WL_WDN) + (size_t)e * DM * FF, scr, r - e * I_DN1, F.lane); continue; } r -= I_DN;
        if (r < I_WIN) { SrcWin s{a->in[1] + (size_t)l * DM * DIN}; tr_item(s, DM, DINP, (bf16*)(wl + WL_WIN), scr, r, F.lane); continue; } r -= I_WIN;
        if (r < I_WOUT) { SrcPlain s{a->in[2] + (size_t)l * DM * DM, DM}; tr_item(s, DM, DM, (bf16*)(wl + WL_WOUT), scr, r, F.lane); continue; } r -= I_WOUT;
        if (r < I_W1) { const int kv = r / 128; SrcPlain s{a->in[4] + ((size_t)l * 2 + kv) * 2048 * 128, 128};
            tr_item(s, 2048, 128, (bf16*)(wl + WL_W1) + (size_t)kv * 128 * 2048, scr, r - kv * 128, F.lane); continue; } r -= I_W1;
        if (r < I_W2) { const int kv = r / 4; SrcPlain s{a->in[5] + ((size_t)l * 2 + kv) * 128 * 64, 64};
            tr_item(s, 128, 64, (bf16*)(wl + WL_W2) + (size_t)kv * 64 * 128, scr, r - kv * 4, F.lane); continue; } r -= I_W2;
        if (r < I_WR) {
            float* wr = (float*)(wl + WL_WR) + (size_t)r * DM;
            for (int k = F.lane; k < DM; k += 64) wr[k] = (r < 4) ? a->in[18][((size_t)l * DM + k) * 4 + r] : a->in[20][((size_t)l * DM + k) * NEXP + (r - 4)];
            continue; } r -= I_WR;
        {
            const int kv = r >> 7, n = r & 127; const float* pe = a->in[3] + ((size_t)l * 2 + kv) * 2048; const float* w1 = a->in[4] + ((size_t)l * 2 + kv) * 2048 * 128;
            float s = 0.f; for (int k = F.lane; k < 2048; k += 64) s += pe[k] * w1[(size_t)k * 128 + n];
            s = wave_sum(s); if (F.lane == 0) ((float*)(wl + WL_BIAS1))[r] = s;
        }
    }
}

__device__ __forceinline__ void phase_prologue(const Frame& F, ArgsP a) {
    const size_t gt = (size_t)F.bid * NTHR + F.tid, NGT = (size_t)F.G * NTHR;
    float* rope = (float*)(a->ws + WS_ROPE);
    for (size_t i = gt; i < (size_t)SEQ * 8; i += NGT) { const int t = (int)(i >> 3), f = (int)(i & 7);
        const float invt[8] = {1.0f, 0.19392274f, 0.03760603f, 0.0072926646f, 0.0014142136f, 0.0002742482f, 5.3182957e-05f, 1.0313385e-05f};
        float inv = invt[0];
#pragma unroll
        for (int q = 1; q < 8; ++q) inv = (f == q) ? invt[q] : inv;
        const float ang = (float)t * inv;
        const double rev = (double)ang * 0.15915494309189535; const float fr = (float)(rev - __builtin_rint(rev));
        rope[t * 16 + f] = __builtin_amdgcn_cosf(fr); rope[t * 16 + 8 + f] = __builtin_amdgcn_sinf(fr); }
    const f32x4* x4 = (const f32x4*)a->in[0]; u32x4* xb = (u32x4*)(a->ws + WS_XB);
    for (size_t i = gt; i < (size_t)T * DM / 8; i += NGT) { const f32x4 v0 = x4[2 * i], v1 = x4[2 * i + 1];
        u32x4 w; w.x = pk2(v0[0], v0[1]); w.y = pk2(v0[2], v0[3]); w.z = pk2(v1[0], v1[1]); w.w = pk2(v1[2], v1[3]); xb[i] = w; }
}

template <bool DRY>
__device__ __forceinline__ void phase_ln1_router(const Frame& F, ArgsP a, int l) {
    float* X1 = (float*)(a->ws + WS_X1); bf16* XB = (bf16*)(a->ws + WS_XB);
    const float* WR = (const float*)(a->ws + WS_WL + WL_WR);
    const float* lw = a->in[14] + (size_t)l * DM; const float* lb = a->in[15] + (size_t)l * DM;
    const float* bg = a->in[19] + l * 4; const float* be = a->in[21] + l * NEXP;
    int* route_e = (int*)(a->ws + WS_SLOT + SL_RE); int* route_p = (int*)(a->ws + WS_SLOT + SL_RP); float* route_w = (float*)(a->ws + WS_SLOT + SL_RW);
    unsigned* cnt = F.ctl + CW_CNT + (DRY ? l + 4 : l) * 512;
    const int gw = F.bid * NWAVES + F.wave, NGW = F.G * NWAVES, lane = F.lane;
    LAS float* wgl = (LAS float*)F.lds;
    for (int i = F.tid; i < 4 * DM; i += NTHR) wgl[i] = WR[i];
    __syncthreads();
    const float bg0 = bg[0], bg1 = bg[1], bg2 = bg[2], bg3 = bg[3];
    for (int tg = gw; tg < T / 4; tg += NGW) {
        f32x4 v[4][4];
#pragma unroll
        for (int tk = 0; tk < 4; ++tk) { const f32x4* row = (const f32x4*)(X1 + (size_t)(4 * tg + tk) * DM) + lane;
#pragma unroll
            for (int j = 0; j < 4; ++j) v[tk][j] = row[64 * j]; }
#pragma unroll
        for (int tk = 0; tk < 4; ++tk) {
            float s = 0.f;
#pragma unroll
            for (int j = 0; j < 4; ++j) s += (v[tk][j][0] + v[tk][j][1]) + (v[tk][j][2] + v[tk][j][3]);
            const float mean = wave_sum(s) * (1.f / DM); float q = 0.f;
#pragma unroll
            for (int j = 0; j < 4; ++j) { v[tk][j] = v[tk][j] - mean; q += (v[tk][j][0] * v[tk][j][0] + v[tk][j][1] * v[tk][j][1]) + (v[tk][j][2] * v[tk][j][2] + v[tk][j][3] * v[tk][j][3]); }
            const float rstd = 1.f / sqrtf(wave_sum(q) * (1.f / DM) + LN_EPS);
            u32x2* brow = (u32x2*)(XB + (size_t)(4 * tg + tk) * DM) + lane;
#pragma unroll
            for (int j = 0; j < 4; ++j) { const f32x4 w4 = ((const f32x4*)lw)[lane + 64 * j], b4 = ((const f32x4*)lb)[lane + 64 * j];
                v[tk][j] = v[tk][j] * rstd * w4 + b4;
                u32x2 w; w.x = pk2(v[tk][j][0], v[tk][j][1]); w.y = pk2(v[tk][j][2], v[tk][j][3]); if (!DRY) brow[64 * j] = w; }
        }
        float glg[4][4];
#pragma unroll
        for (int j = 0; j < 4; ++j) { const LAS f32x4* wr = (const LAS f32x4*)(wgl + j * DM) + lane; const f32x4 w0 = wr[0], w1 = wr[64], w2 = wr[128], w3 = wr[192];
#pragma unroll
            for (int tk = 0; tk < 4; ++tk) { f32x4 p = v[tk][0] * w0; p = p + v[tk][1] * w1; p = p + v[tk][2] * w2; p = p + v[tk][3] * w3; glg[tk][j] = wave_sum((p[0] + p[1]) + (p[2] + p[3])); } }
        int my_e = 0; float my_w = 0.f;
#pragma unroll
        for (int tk = 0; tk < 4; ++tk) {
            const float g0 = glg[tk][0] + bg0, g1 = glg[tk][1] + bg1, g2 = glg[tk][2] + bg2, g3 = glg[tk][3] + bg3;
            int gi = 0; float gm = g0; if (g1 > gm) { gm = g1; gi = 1; } if (g2 > gm) { gm = g2; gi = 2; } if (g3 > gm) { gm = g3; gi = 3; }
            gi = __builtin_amdgcn_readfirstlane(gi);
            const float g_w = 1.f / (__expf(g0 - gm) + __expf(g1 - gm) + __expf(g2 - gm) + __expf(g3 - gm));
            const float* wbase = WR + (size_t)(4 + gi * 8) * DM; float ev[8];
#pragma unroll
            for (int i4 = 0; i4 < 2; ++i4) { f32x4 w[4][4];
#pragma unroll
                for (int i = 0; i < 4; ++i) { const f32x4* wr = (const f32x4*)(wbase + (size_t)(4 * i4 + i) * DM) + lane; w[i][0] = wr[0]; w[i][1] = wr[64]; w[i][2] = wr[128]; w[i][3] = wr[192]; }
#pragma unroll
                for (int i = 0; i < 4; ++i) { f32x4 p = v[tk][0] * w[i][0]; p = p + v[tk][1] * w[i][1]; p = p + v[tk][2] * w[i][2]; p = p + v[tk][3] * w[i][3];
                    ev[4 * i4 + i] = wave_sum((p[0] + p[1]) + (p[2] + p[3])) + be[gi * 8 + 4 * i4 + i]; } }
            int i1 = 0; float v1 = ev[0];
#pragma unroll
            for (int i = 1; i < 8; ++i) if (ev[i] > v1) { v1 = ev[i]; i1 = i; }
            int i2 = -1; float v2 = -3.0e38f;
#pragma unroll
            for (int i = 0; i < 8; ++i) if (i != i1 && ev[i] > v2) { v2 = ev[i]; i2 = i; }
            const float e2 = __expf(v2 - v1), w1 = g_w / (1.f + e2), w2 = g_w - w1;
            if (lane == 2 * tk) { my_e = gi * 8 + i1; my_w = w1; }
            if (lane == 2 * tk + 1) { my_e = gi * 8 + i2; my_w = w2; }
        }
        if (lane < 8) {
            const unsigned pos = __hip_atomic_fetch_add(cnt + my_e * 16, 1u, __ATOMIC_RELAXED, __HIP_MEMORY_SCOPE_AGENT);
            const size_t si = (size_t)tg * 8 + lane; if (!DRY) { route_e[si] = my_e; route_p[si] = (int)pos; route_w[si] = my_w; }
        }
    }
    __syncthreads();
}

__device__ __forceinline__ void phase_gather(const Frame& F, ArgsP a, int l) {
    LAS int* pstart = (LAS int*)F.lds;
    unsigned* cnt = F.ctl + CW_CNT + l * 512;
    int* meta = (int*)(a->ws + WS_META) + l * 512;
    int* slot_tok = (int*)(a->ws + WS_SLOT + SL_TOK); float* slot_w = (float*)(a->ws + WS_SLOT + SL_W);
    const int* route_e = (const int*)(a->ws + WS_SLOT + SL_RE); const int* route_p = (const int*)(a->ws + WS_SLOT + SL_RP); const float* route_w = (const float*)(a->ws + WS_SLOT + SL_RW);
    if (F.tid < 64) {
        const int c = F.tid < 32 ? (int)__hip_atomic_load(cnt + F.tid * 16, __ATOMIC_RELAXED, __HIP_MEMORY_SCOPE_AGENT) : 0;
        const int pad = (c + 255) & ~255; int inc = pad;
#pragma unroll
        for (int o = 1; o < 64; o <<= 1) { const int t = __shfl_up(inc, o); if (F.lane >= o) inc += t; }
        const int st = inc - pad;
        if (F.tid < 32) { pstart[F.tid] = st;
            if (F.bid == 0) { for (int t = st >> 8; t < (st + pad) >> 8; ++t) meta[64 + t] = F.tid; if (F.tid == 31) meta[0] = (st + pad) >> 8; }
            if ((F.tid % F.G) == F.bid) for (int r = st + c; r < st + pad; ++r) { slot_tok[r] = -1; slot_w[r] = 0.f; }
        }
    }
    __syncthreads();
    for (int s = F.bid * NTHR + F.tid; s < T * 2; s += F.G * NTHR) {
        const int dest = pstart[route_e[s]] + route_p[s]; slot_tok[dest] = s; slot_w[dest] = route_w[s];
    }
    __syncthreads();
}

__device__ __forceinline__ void phase_ln2(const Frame& F, ArgsP a, int l) {
    const bf16* Y2 = (const bf16*)(a->ws + WS_Y2); bf16* XB = (bf16*)(a->ws + WS_XB); float* out = a->out;
    const float* lw = a->in[16] + (size_t)l * DM; const float* lb = a->in[17] + (size_t)l * DM;
    const int gw = F.bid * NWAVES + F.wave, NGW = F.G * NWAVES, lane = F.lane; const bool last = (l == NL - 1);
    for (int t = gw; t < T; t += NGW) {
        const u32x2* xr = (const u32x2*)(XB + (size_t)t * DM) + lane; const u32x2* ya = (const u32x2*)(Y2 + (size_t)(2 * t) * DM) + lane; const u32x2* yb = (const u32x2*)(Y2 + (size_t)(2 * t + 1) * DM) + lane;
        f32x4 v[4]; float s = 0.f;
#pragma unroll
        for (int j = 0; j < 4; ++j) { const u32x2 x = xr[64 * j], p = ya[64 * j], q = yb[64 * j];
            v[j][0] = bf2f(x.x & 0xffffu) * DN_ALPHA + (bf2f(p.x & 0xffffu) + bf2f(q.x & 0xffffu)); v[j][1] = bf2f(x.x >> 16) * DN_ALPHA + (bf2f(p.x >> 16) + bf2f(q.x >> 16));
            v[j][2] = bf2f(x.y & 0xffffu) * DN_ALPHA + (bf2f(p.y & 0xffffu) + bf2f(q.y & 0xffffu)); v[j][3] = bf2f(x.y >> 16) * DN_ALPHA + (bf2f(p.y >> 16) + bf2f(q.y >> 16));
            s += (v[j][0] + v[j][1]) + (v[j][2] + v[j][3]); }
        const float mean = wave_sum(s) * (1.f / DM); float q2 = 0.f;
#pragma unroll
        for (int j = 0; j < 4; ++j) { v[j] = v[j] - mean; q2 += (v[j][0] * v[j][0] + v[j][1] * v[j][1]) + (v[j][2] * v[j][2] + v[j][3] * v[j][3]); }
        const float rstd = 1.f / sqrtf(wave_sum(q2) * (1.f / DM) + LN_EPS);
        f32x4* orow = (f32x4*)(out + (size_t)t * DM) + lane; u32x2* brow = (u32x2*)(XB + (size_t)t * DM) + lane;
#pragma unroll
        for (int j = 0; j < 4; ++j) { const f32x4 w4 = ((const f32x4*)lw)[lane + 64 * j], b4 = ((const f32x4*)lb)[lane + 64 * j];
            const f32x4 o = v[j] * rstd * w4 + b4; if (last) orow[64 * j] = o; u32x2 w; w.x = pk2(o[0], o[1]); w.y = pk2(o[2], o[3]); brow[64 * j] = w; }
    }
}

__device__ __forceinline__ int tsw(int row, int col) { return row * 128 + ((((col >> 3) ^ (row >> 1)) & 7) << 4) + ((col & 7) << 1); }
__device__ __forceinline__ f32x4 mfma16(bf16x8 a, bf16x8 b, f32x4 c) { return __builtin_amdgcn_mfma_f32_16x16x32_bf16(a, b, c, 0, 0, 0); }
__device__ __forceinline__ f32x16 mfma32(bf16x8 a, bf16x8 b, f32x16 c) { return __builtin_amdgcn_mfma_f32_32x32x16_bf16(a, b, c, 0, 0, 0); }
__device__ __forceinline__ bf16x8 as_bf16x8(u32x4 v) { return __builtin_bit_cast(bf16x8, v); }

__device__ __forceinline__ void conformer_item(const Frame& F, ArgsP a, int l, int it) {
    const int b = it >> 6, s0 = (it & 63) * 64; const size_t tok0 = (size_t)b * SEQ + s0;
    const bf16* H = (const bf16*)(a->ws + WS_H); bf16* Y = (bf16*)(a->ws + WS_Y);
    LAS bf16* ut = (LAS bf16*)F.lds;
    LAS float* co = (LAS float*)(F.lds + 49152);
    for (int idx = F.tid; idx < 94 * 32; idx += NTHR) {
        const int r = idx >> 5, c8 = (idx & 31) * 8, s = s0 - 30 + r; u32x4 w = {0u, 0u, 0u, 0u};
        if (s >= 0) { const bf16* hp = H + ((size_t)b * SEQ + s) * HLD + 2304 + c8; const u32x4 v = *(const u32x4*)hp, g = *(const u32x4*)(hp + 256);
#pragma unroll
            for (int e = 0; e < 4; ++e) { const float v0 = bf2f(v[e] & 0xffffu) * fsigmoid(bf2f(g[e] & 0xffffu)), v1 = bf2f(v[e] >> 16) * fsigmoid(bf2f(g[e] >> 16)); w[e] = pk2(v0, v1); } }
        *(LAS u32x4*)(ut + r * 256 + c8) = w;
    }
    __syncthreads();
    {
        const int c = F.tid & 255, half = F.tid >> 8; const float* dw = a->in[10] + (size_t)l * 31 * 256 + c; const float bias = a->in[11][l * 256 + c];
        float w[31], ur[62];
#pragma unroll
        for (int k = 0; k < 31; ++k) w[k] = dw[k * 256];
#pragma unroll
        for (int i = 0; i < 62; ++i) ur[i] = bf2f(ut[(32 * half + i) * 256 + c]);
#pragma unroll
        for (int tt = 0; tt < 32; ++tt) { float acc = bias;
#pragma unroll
            for (int k = 0; k < 31; ++k) acc += w[k] * ur[tt + k];
            co[(32 * half + tt) * 256 + c] = acc; }
    }
    __syncthreads();
    {
        const float* lw = a->in[12] + l * 256; const float* lb = a->in[13] + l * 256; const f32x4 w4 = ((const f32x4*)lw)[F.lane], b4 = ((const f32x4*)lb)[F.lane];
#pragma unroll
        for (int i = 0; i < 8; ++i) { const int tl = 8 * F.wave + i; f32x4 v = *(LAS f32x4*)(co + tl * 256 + 4 * F.lane);
            const float mean = wave_sum((v[0] + v[1]) + (v[2] + v[3])) * (1.f / 256.f); v = v - mean;
            const float rstd = 1.f / sqrtf(wave_sum((v[0] * v[0] + v[1] * v[1]) + (v[2] * v[2] + v[3] * v[3])) * (1.f / 256.f) + LN_EPS);
            v = v * rstd * w4 + b4; u32x2 o; o.x = pk2(fsilu(v[0]), fsilu(v[1])); o.y = pk2(fsilu(v[2]), fsilu(v[3]));
            *(u32x2*)(Y + (tok0 + tl) * DM + 768 + 4 * F.lane) = o; }
    }
    __syncthreads();
}

__device__ __forceinline__ void compress_item(const Frame& F, ArgsP a, int it) {
    const int kv = it >> 7, bh = (it >> 3) & 15, b = bh >> 1, hh = bh & 1, i0 = (it & 7) * 32;
    const bf16* H = (const bf16*)(a->ws + WS_H); const bf16* w1t = (const bf16*)(a->ws + WS_WL + WL_W1) + (size_t)kv * 128 * 2048; const bf16* w2t = (const bf16*)(a->ws + WS_WL + WL_W2) + (size_t)kv * 64 * 128;
    const float* bias1 = (const float*)(a->ws + WS_WL + WL_BIAS1) + kv * 128; bf16* outp = (bf16*)(a->ws + (kv ? WS_VC : WS_KC)) + (size_t)bh * 256 * 64;
    LAS bf16* hid = (LAS bf16*)F.lds;
    const int lane = F.lane, li = lane & 15, g = lane >> 4, rt = F.wave & 1, cq = F.wave >> 1;
    const int i = i0 + 16 * rt + li; const bf16* arow = H + (size_t)b * SEQ * HLD + 512 + kv * 128 + hh * 64 + 8 * g;
    const bf16* brow = w1t + (size_t)(32 * cq + li) * 2048 + 8 * g;
    f32x4 acc[2] = {{0.f, 0.f, 0.f, 0.f}, {0.f, 0.f, 0.f, 0.f}};
#pragma unroll 1
    for (int k8 = 0; k8 < 64; k8 += 8) {
        bf16x8 af[8], bfr[8][2];
#pragma unroll
        for (int u = 0; u < 8; ++u) { const int ks = k8 + u; int s = 16 * i + (ks >> 1); s = s > SEQ - 1 ? SEQ - 1 : s;
            af[u] = *(const bf16x8*)(arow + (size_t)s * HLD + (ks & 1) * 32); bfr[u][0] = *(const bf16x8*)(brow + ks * 32); bfr[u][1] = *(const bf16x8*)(brow + (size_t)16 * 2048 + ks * 32); }
#pragma unroll
        for (int u = 0; u < 8; ++u) { acc[0] = mfma16(af[u], bfr[u][0], acc[0]); acc[1] = mfma16(af[u], bfr[u][1], acc[1]); }
    }
#pragma unroll
    for (int nt = 0; nt < 2; ++nt) { const int n = 32 * cq + 16 * nt + li; const float bs = bias1[n];
#pragma unroll
        for (int r = 0; r < 4; ++r) hid[(16 * rt + 4 * g + r) * 136 + n] = (bf16)f2bf(fsilu(acc[nt][r] + bs)); }
    __syncthreads();
    f32x4 o2 = {0.f, 0.f, 0.f, 0.f};
#pragma unroll
    for (int ks = 0; ks < 4; ++ks) { const bf16x8 af = *(LAS bf16x8*)(hid + (16 * rt + li) * 136 + 32 * ks + 8 * g);
        const bf16x8 bfr = *(const bf16x8*)(w2t + (size_t)(16 * cq + li) * 128 + 32 * ks + 8 * g); o2 = mfma16(af, bfr, o2); }
#pragma unroll
    for (int r = 0; r < 4; ++r) { const int io = i0 + 16 * rt + 4 * g + r; outp[(size_t)io * 64 + 16 * cq + li] = (bf16)(io < 255 ? f2bf(o2[r]) : 0u); }
    __syncthreads();
}

__host__ __device__ constexpr int tri_off(int i) { int s = 0; for (int k = 0; k < i; ++k) s += (k + 3) >> 2; return 4 * s; }
__device__ __forceinline__ int tri_off_rt(int i) { const int m = i - 1, V = (m + 3) >> 2; return i <= 0 ? 0 : 4 * (2 * V * (V - 1) + V * (m - 4 * V + 4)); }

template <int I> struct GdnSolveRow {
    __device__ static __forceinline__ void run(const LAS float* Ap, float (&x)[64]) {
        if constexpr (I < 64) {
            constexpr int off = tri_off(I), nb = (I + 3) >> 2;
            float a0 = x[I];
#pragma unroll
            for (int jb = 0; jb < nb; ++jb) { const f32x4 a4 = *(const LAS f32x4*)(Ap + off + 4 * jb);
#pragma unroll
                for (int jj = 0; jj < 4; ++jj) { if (4 * jb + jj < I) a0 -= a4[jj] * x[4 * jb + jj]; } }
            x[I] = a0;
            if constexpr ((I & 3) == 3) SBAR();
            GdnSolveRow<I + 1>::run(Ap, x);
        }
    }
};

__device__ __forceinline__ void gdn_prep_chunk(const Frame& F, ArgsP a, int l, int ci, LAS unsigned char* wl) {
    int lane_ = F.lane; asm volatile("" : "+v"(lane_));
    const int lane = lane_, li = lane & 15, g = lane >> 4; const int bh = ci >> 6, n = ci & 63, b = bh >> 2, h = bh & 3; const size_t tok0 = (size_t)b * SEQ + 64 * n;
    const bf16* H = (const bf16*)(a->ws + WS_H); const float* side = (const float*)(a->ws + WS_SIDE);
    unsigned char* rec = a->ws + WS_GPREP + (size_t)ci * GCH;
    bf16* R0 = (bf16*)(rec + GC_UT); bf16* R1 = (bf16*)(rec + GC_W); bf16* QKm = (bf16*)(rec + GC_QK); bf16* QD = (bf16*)(rec + GC_QD); bf16* KDT = (bf16*)(rec + GC_KDT); bf16* ZT = (bf16*)(rec + GC_ZT);
    const int pc = (lane & 32) | (((lane & 15) >> 2) << 3) | (((lane >> 4) & 1) << 2) | (lane & 3);
    LAS unsigned char* qt = wl; LAS unsigned char* kt = wl + 8192; LAS float* Ap = (LAS float*)wl;
    const float beta = side[(tok0 + lane) * 32 + 24 + h]; const float av = side[(tok0 + lane) * 32 + 28 + h] + a->in[8][l * 4 + h];
    const float sp = av > 20.f ? av : log1pf(__expf(av)); float gc = -__expf(a->in[7][l * 4 + h]) * sp;
#pragma unroll
    for (int o = 1; o < 64; o <<= 1) { const float t = __shfl_up(gc, o); if (lane >= o) gc += t; }
    const float gl = __shfl(gc, 63); const float eg = __expf(gc), ekd = __expf(gl - gc);
    if (lane == 0) ((float*)(a->ws + WS_GL))[ci] = __expf(gl);
    const float* cw = a->in[6] + (size_t)l * 4 * 768 + h * 64 + lane; float wq[4], wk[4], wv[4];
#pragma unroll
    for (int k = 0; k < 4; ++k) { wq[k] = cw[k * 768]; wk[k] = cw[k * 768 + 256]; wv[k] = cw[k * 768 + 512]; }
    const bf16* hp = H + tok0 * HLD + 1280 + h * 64 + lane; float hq[3], hk[3], hv[3];
#pragma unroll
    for (int j = 0; j < 3; ++j) { const bool ok = (64 * n - 3 + j) >= 0; const bf16* p = hp + (ptrdiff_t)(j - 3) * HLD;
        hq[j] = ok ? bf2f(p[0]) : 0.f; hk[j] = ok ? bf2f(p[256]) : 0.f; hv[j] = ok ? bf2f(p[512]) : 0.f; }
    unsigned short ra[8][3], rb[8][3];
#define GDN_LOADBLK(dst, t8_) do { const bf16* pl_ = hp + (size_t)(8 * (t8_)) * HLD; asm volatile("" : "+v"(pl_)); _Pragma("unroll") for (int tt = 0; tt < 8; ++tt) { const bf16* q_ = pl_ + (size_t)tt * HLD; dst[tt][0] = q_[0]; dst[tt][1] = q_[256]; dst[tt][2] = q_[512]; } } while (0)
#define GDN_CONVBLK(src, t8_) do { const int t8 = (t8_); unsigned kdp[4]; \
        bf16* qd8 = QD + (8 * t8) * 64 + pc; bf16* r08 = R0 + (8 * t8) * 64 + lane; bf16* r18 = R1 + (8 * t8) * 64 + lane; asm volatile("" : "+v"(qd8), "+v"(r08), "+v"(r18)); \
        _Pragma("unroll") for (int tt = 0; tt < 8; ++tt) { const int t = 8 * t8 + tt; \
            const float rq = bf2f(src[tt][0]), rk = bf2f(src[tt][1]), rv = bf2f(src[tt][2]); \
            const float cq = wq[0] * hq[0] + wq[1] * hq[1] + wq[2] * hq[2] + wq[3] * rq, ck = wk[0] * hk[0] + wk[1] * hk[1] + wk[2] * hk[2] + wk[3] * rk, cv = wv[0] * hv[0] + wv[1] * hv[1] + wv[2] * hv[2] + wv[3] * rv; \
            hq[0] = hq[1]; hq[1] = hq[2]; hq[2] = rq; hk[0] = hk[1]; hk[1] = hk[2]; hk[2] = rk; hv[0] = hv[1]; hv[1] = hv[2]; hv[2] = rv; \
            const float qs = fsilu(cq), ks_ = fsilu(ck), vs = fsilu(cv); \
            const float qn = qs * __builtin_amdgcn_rsqf(wave_sum(qs * qs) + 1e-6f) * 0.125f, kn = ks_ * __builtin_amdgcn_rsqf(wave_sum(ks_ * ks_) + 1e-6f); \
            const float bt = __int_as_float(__builtin_amdgcn_readlane(__float_as_int(beta), t)), egt = __int_as_float(__builtin_amdgcn_readlane(__float_as_int(eg), t)), ekt = __int_as_float(__builtin_amdgcn_readlane(__float_as_int(ekd), t)); \
            *(LAS bf16*)(qt + tsw(t, lane)) = (bf16)f2bf(qn); *(LAS bf16*)(kt + tsw(t, lane)) = (bf16)f2bf(kn); \
            qd8[tt * 64] = (bf16)f2bf(qn * egt); r08[tt * 64] = (bf16)f2bf(bt * vs); r18[tt * 64] = (bf16)f2bf(bt * egt * kn); \
            const unsigned kd = f2bf(kn * ekt); if (tt & 1) kdp[tt >> 1] |= kd << 16; else kdp[tt >> 1] = kd; } \
        { const int c0 = (8 * t8) & 31, gg = (c0 & 15) >> 2, hh = c0 >> 4; bf16* kr = KDT + lane * 64 + ((8 * t8) & 32) + 4 * hh; \
          u32x2 w0, w1; w0.x = kdp[0]; w0.y = kdp[1]; w1.x = kdp[2]; w1.y = kdp[3]; *(u32x2*)(kr + 8 * gg) = w0; *(u32x2*)(kr + 8 * gg + 8) = w1; } } while (0)
    GDN_LOADBLK(ra, 0);
#pragma unroll 1
    for (int t16 = 0; t16 < 4; ++t16) {
        GDN_LOADBLK(rb, 2 * t16 + 1);
        GDN_CONVBLK(ra, 2 * t16);
        if (t16 < 3) GDN_LOADBLK(ra, 2 * t16 + 2);
        GDN_CONVBLK(rb, 2 * t16 + 1);
    }
#undef GDN_LOADBLK
#undef GDN_CONVBLK
    {
        const float nwl = a->in[9][l * 64 + lane];
        for (int t8 = 0; t8 < 8; ++t8) { unsigned zp[4];
#pragma unroll
            for (int tt = 0; tt < 8; ++tt) { const unsigned zg = f2bf(fsilu(bf2f(hp[(size_t)(8 * t8 + tt) * HLD + 768])) * nwl); if (tt & 1) zp[tt >> 1] |= zg << 16; else zp[tt >> 1] = zg; }
            u32x4 wz; wz.x = zp[0]; wz.y = zp[1]; wz.z = zp[2]; wz.w = zp[3]; *(u32x4*)(ZT + lane * 64 + 8 * t8) = wz; }
    }
    LDS_WAIT();
    float gcj[4][4];
#pragma unroll
    for (int mt = 0; mt < 4; ++mt)
#pragma unroll
        for (int r = 0; r < 4; ++r) gcj[mt][r] = __shfl(gc, 16 * mt + 4 * g + r);
    f32x4 ahold[4][4];
#pragma unroll
    for (int nt = 0; nt < 4; ++nt) {
        const int i = 16 * nt + li; const float gci = __shfl(gc, i), bi = __shfl(beta, i);
        bf16x8 kB[2], qB[2];
#pragma unroll
        for (int ks = 0; ks < 2; ++ks) { kB[ks] = *(LAS bf16x8*)(kt + tsw(i, 32 * ks + 8 * g)); qB[ks] = *(LAS bf16x8*)(qt + tsw(i, 32 * ks + 8 * g)); }
#pragma unroll
        for (int mt = 0; mt < 4; ++mt) {
            u32x2 qw = {0u, 0u};
            if (mt <= nt) {
                const bf16x8 kA0 = *(LAS bf16x8*)(kt + tsw(16 * mt + li, 8 * g)), kA1 = *(LAS bf16x8*)(kt + tsw(16 * mt + li, 32 + 8 * g));
                f32x4 ckk = {0.f, 0.f, 0.f, 0.f}, cqk = {0.f, 0.f, 0.f, 0.f};
                ckk = mfma16(kA0, kB[0], ckk); ckk = mfma16(kA1, kB[1], ckk); cqk = mfma16(kA0, qB[0], cqk); cqk = mfma16(kA1, qB[1], cqk);
                float qv[4];
#pragma unroll
                for (int r = 0; r < 4; ++r) { const int j = 16 * mt + 4 * g + r; const float dec = __expf(fminf(gci - gcj[mt][r], 0.f));
                    ahold[nt][mt][r] = bi * ckk[r] * dec; qv[r] = (j <= i) ? cqk[r] * dec : 0.f; }
                qw.x = pk2(qv[0], qv[1]); qw.y = pk2(qv[2], qv[3]);
            }
            *(u32x2*)(QKm + i * 64 + 32 * (mt >> 1) + 8 * g + 4 * (mt & 1)) = qw;
        }
    }
    LDS_WAIT(); SBAR();
#pragma unroll
    for (int nt = 0; nt < 4; ++nt) { const int i = 16 * nt + li; const int ro = tri_off_rt(i);
#pragma unroll
        for (int mt = 0; mt < 4; ++mt) if (mt <= nt) {
#pragma unroll
            for (int r = 0; r < 4; ++r) { const int j = 16 * mt + 4 * g + r; if (j < i) Ap[ro + j] = ahold[nt][mt][r]; } } }
    VM_WAIT(); LDS_WAIT();
#pragma unroll 1
    for (int pass = 0; pass < 2; ++pass) {
        bf16* Rp = pass ? R1 : R0; float x[64];
#pragma unroll
        for (int i = 0; i < 64; ++i) x[i] = bf2f(Rp[i * 64 + lane]);
        VM_WAIT();
        GdnSolveRow<1>::run(Ap, x);
        if (pass == 0) {
#pragma unroll
            for (int i8 = 0; i8 < 8; ++i8) { u32x4 w; w.x = pk2(x[8 * i8], x[8 * i8 + 1]); w.y = pk2(x[8 * i8 + 2], x[8 * i8 + 3]); w.z = pk2(x[8 * i8 + 4], x[8 * i8 + 5]); w.w = pk2(x[8 * i8 + 6], x[8 * i8 + 7]);
                *(u32x4*)(Rp + lane * 64 + 8 * i8) = w; }
        } else {
#pragma unroll
            for (int i = 0; i < 64; ++i) Rp[i * 64 + pc] = (bf16)f2bf(x[i]);
        }
    }
    LDS_WAIT();
}

__device__ __forceinline__ bf16x8 scan_frag(const unsigned char* mat, int mt, int ks, int li, int g) { return *(const bf16x8*)(mat + (16 * mt + li) * 128 + (32 * ks + 8 * g) * 2); }
__device__ __forceinline__ bf16x8 pack_c2(f32x4 a, f32x4 b) { u32x4 w; w.x = pk2(a[0], a[1]); w.y = pk2(a[2], a[3]); w.z = pk2(b[0], b[1]); w.w = pk2(b[2], b[3]); return as_bf16x8(w); }
constexpr int SC_SLOT = 24576;
__device__ __forceinline__ void scan_dma(LAS unsigned char* slot, const unsigned char* rec, int sl, int lane) {
#pragma unroll
    for (int m = 0; m < 3; ++m) { const int goff = (m == 0) ? GC_W : (m == 1 ? GC_KDT : GC_UT);
#pragma unroll
        for (int i = 0; i < 2; ++i) { const int row = 16 * sl + 8 * i + (lane >> 3), ch = (lane & 7) ^ ((row >> 1) & 7);
            __builtin_amdgcn_global_load_lds((const unsigned*)(rec + goff + row * 128 + ch * 16), (LAS unsigned*)(slot + m * 8192 + (16 * sl + 8 * i) * 128), 16, 0, 0); } }
}
__device__ __forceinline__ bf16x8 scan_lfrag(const LAS unsigned char* mat, int mt, int ks, int li, int g) { const int row = 16 * mt + li; return *(const LAS bf16x8*)(mat + row * 128 + ((((4 * ks + g) ^ (row >> 1)) & 7) << 4)); }
template <int SV>
__device__ __forceinline__ void gdn_scan(const Frame& F, ArgsP a, int l) {
    const int lane = F.lane, li = lane & 15, g = lane >> 4, pr = F.wave >> 2, sl = F.wave & 3; const int bh = F.bid * 2 + pr, dv0 = 16 * sl;
    const float* GL = (const float*)(a->ws + WS_GL) + bh * 64; unsigned char* rec0 = a->ws + WS_GPREP + (size_t)bh * 64 * GCH;
    LAS unsigned char* ring = F.lds + pr * (3 * SC_SLOT);
    f32x4 S[4] = {{0.f, 0.f, 0.f, 0.f}, {0.f, 0.f, 0.f, 0.f}, {0.f, 0.f, 0.f, 0.f}, {0.f, 0.f, 0.f, 0.f}};
    const float glv = GL[lane];
    asm volatile("s_waitcnt vmcnt(0)" ::: "memory");
    scan_dma(ring, rec0, sl, lane); scan_dma(ring + SC_SLOT, rec0 + GCH, sl, lane);
#pragma unroll 1
    for (int n = 0; n < 64; ++n) {
        unsigned char* rn = rec0 + (size_t)n * GCH; const LAS unsigned char* slot = ring + (n % 3) * SC_SLOT;
        if (n == 0) asm volatile("s_waitcnt vmcnt(6)" ::: "memory"); else asm volatile("s_waitcnt vmcnt(14)" ::: "memory");
        __builtin_amdgcn_s_barrier(); asm volatile("" ::: "memory");
        if (n + 2 < 64) scan_dma(ring + ((n + 2) % 3) * SC_SLOT, rn + 2 * (size_t)GCH, sl, lane);
        else { asm volatile("" ::: "memory"); }
        const float egl = __int_as_float(__builtin_amdgcn_readlane(__float_as_int(glv), n));
        const bf16x8 Sb0 = pack_c2(S[0], S[1]), Sb1 = pack_c2(S[2], S[3]);
        if (!(SV & 1)) { bf16x8* ss = (bf16x8*)(rn + GC_SS + sl * 2048) + lane; ss[0] = Sb0; ss[64] = Sb1; }
        f32x4 vn[4];
#pragma unroll
        for (int mt = 0; mt < 4; ++mt) {
            f32x4 acc = {0.f, 0.f, 0.f, 0.f};
            acc = mfma16(scan_lfrag(slot, mt, 0, li, g), Sb0, acc); acc = mfma16(scan_lfrag(slot, mt, 1, li, g), Sb1, acc);
            const int urow = dv0 + li; const u32x2 uu = *(const LAS u32x2*)(slot + 16384 + urow * 128 + (((((16 * mt + 4 * g) >> 3) ^ (urow >> 1)) & 7) << 4) + (((16 * mt + 4 * g) & 7) << 1));
            vn[mt][0] = bf2f(uu.x & 0xffffu) - acc[0]; vn[mt][1] = bf2f(uu.x >> 16) - acc[1]; vn[mt][2] = bf2f(uu.y & 0xffffu) - acc[2]; vn[mt][3] = bf2f(uu.y >> 16) - acc[3];
        }
        const bf16x8 Vb0 = pack_c2(vn[0], vn[1]), Vb1 = pack_c2(vn[2], vn[3]);
        if (!(SV & 1)) { bf16x8* vb = (bf16x8*)(rn + GC_VB + sl * 2048) + lane; vb[0] = Vb0; vb[64] = Vb1; }
#pragma unroll
        for (int mt = 0; mt < 4; ++mt) { f32x4 acc = S[mt] * egl; acc = mfma16(scan_lfrag(slot + 8192, mt, 0, li, g), Vb0, acc); acc = mfma16(scan_lfrag(slot + 8192, mt, 1, li, g), Vb1, acc); S[mt] = acc; }
        if ((SV & 1) || n + 2 >= 64) { }
    }
    asm volatile("s_waitcnt vmcnt(0)" ::: "memory"); asm volatile("" :: "v"(S[0][0]), "v"(S[1][1]), "v"(S[2][2]), "v"(S[3][3]));
    __syncthreads();
}

__device__ __forceinline__ void gdn_out_chunk(const Frame& F, ArgsP a, int ci, LAS unsigned char* wl) {
    int lane_ = F.lane; asm volatile("" : "+v"(lane_)); const int lane = lane_, li = lane & 15, g = lane >> 4; const int bh = ci >> 6, n = ci & 63, b = bh >> 2, h = bh & 3;
    const unsigned char* rec = a->ws + WS_GPREP + (size_t)ci * GCH; bf16* Y = (bf16*)(a->ws + WS_Y);
    bf16x8 QDf[4][2], QKf[4][2];
#pragma unroll
    for (int mt = 0; mt < 4; ++mt) { QDf[mt][0] = scan_frag(rec + GC_QD, mt, 0, li, g); QDf[mt][1] = scan_frag(rec + GC_QD, mt, 1, li, g); QKf[mt][0] = scan_frag(rec + GC_QK, mt, 0, li, g); QKf[mt][1] = scan_frag(rec + GC_QK, mt, 1, li, g); }
    float ssq[4][4];
#pragma unroll
    for (int mt = 0; mt < 4; ++mt)
#pragma unroll
        for (int r = 0; r < 4; ++r) ssq[mt][r] = 0.f;
    f32x4 o[4][4];
#pragma unroll
    for (int sl = 0; sl < 4; ++sl) {
        const bf16x8* ss = (const bf16x8*)(rec + GC_SS + sl * 2048) + lane; const bf16x8* vb = (const bf16x8*)(rec + GC_VB + sl * 2048) + lane;
        const bf16x8 Sb0 = ss[0], Sb1 = ss[64], Vb0 = vb[0], Vb1 = vb[64];
#pragma unroll
        for (int mt = 0; mt < 4; ++mt) {
            f32x4 acc = {0.f, 0.f, 0.f, 0.f};
            acc = mfma16(QDf[mt][0], Sb0, acc); acc = mfma16(QDf[mt][1], Sb1, acc); acc = mfma16(QKf[mt][0], Vb0, acc); acc = mfma16(QKf[mt][1], Vb1, acc);
            o[sl][mt] = acc;
#pragma unroll
            for (int r = 0; r < 4; ++r) ssq[mt][r] += acc[r] * acc[r];
        }
    }
#pragma unroll
    for (int mt = 0; mt < 4; ++mt)
#pragma unroll
        for (int r = 0; r < 4; ++r) ssq[mt][r] = __builtin_amdgcn_rsqf(row16_sum(ssq[mt][r]) * (1.f / 64.f) + 1e-6f);
#pragma unroll
    for (int sl = 0; sl < 4; ++sl)
#pragma unroll
        for (int mt = 0; mt < 4; ++mt) {
            const u32x2 zz = *(const u32x2*)(rec + GC_ZT + (16 * sl + li) * 128 + (16 * mt + 4 * g) * 2);
            const float zf[4] = {bf2f(zz.x & 0xffffu), bf2f(zz.x >> 16), bf2f(zz.y & 0xffffu), bf2f(zz.y >> 16)};
#pragma unroll
            for (int r = 0; r < 4; ++r) *(LAS bf16*)(wl + tsw(16 * mt + 4 * g + r, 16 * sl + li)) = (bf16)f2bf(o[sl][mt][r] * ssq[mt][r] * zf[r]);
        }
    LDS_WAIT();
    bf16* yrow = Y + ((size_t)b * SEQ + 64 * n + lane) * DM + 512 + h * 64;
#pragma unroll
    for (int c = 0; c < 8; ++c) *(u32x4*)(yrow + 8 * c) = *(const LAS u32x4*)(wl + tsw(lane, 8 * c));
    LDS_WAIT();
}

constexpr int AT_K = 0, AT_V = 32768, AT_IMP = 65536, AT_SELM = AT_IMP + 64 * 68 * 4, AT_UNI = AT_SELM + 512, AT_YS = 83968;
__device__ __forceinline__ s16x4 tr_read0(unsigned addr) { s16x4 r; asm volatile("ds_read_b64_tr_b16 %0, %1" : "=&v"(r) : "v"(addr) : "memory"); return r; }

__device__ __forceinline__ float half_max(float x) { auto rr = __builtin_amdgcn_permlane32_swap(__float_as_uint(x), __float_as_uint(x), false, false); return fmaxf(__uint_as_float(rr[0]), __uint_as_float(rr[1])); }
__device__ __forceinline__ float half_sum(float x) { auto rr = __builtin_amdgcn_permlane32_swap(__float_as_uint(x), __float_as_uint(x), false, false); return __uint_as_float(rr[0]) + __uint_as_float(rr[1]); }
struct AttnStage { u32x4 kr, vr; };
__device__ __forceinline__ void at_gload(AttnStage& st, const bf16* Kb, const bf16* Vb, size_t stride, int j, int tid) {
    const int row = tid >> 3, ch = tid & 7; const size_t off = (size_t)(64 * j + row) * stride + 8 * ch;
    st.kr = *(const u32x4*)(Kb + off); st.vr = *(const u32x4*)(Vb + off);
}
__device__ __forceinline__ void at_swrite(const AttnStage& st, LAS unsigned char* lds, int buf, int tid) {
    const int row = tid >> 3, ch = tid & 7; const int o = row * 128 + (((ch ^ (row >> 1)) & 7) << 4);
    *(LAS u32x4*)(lds + AT_K + buf * 8192 + o) = st.kr; *(LAS u32x4*)(lds + AT_V + buf * 8192 + o) = st.vr;
}
__device__ __forceinline__ void at_qk(const LAS unsigned char* Kt, const bf16x8 (&Qf)[4], int r, int hf, f32x16 (&s)[2], float cinit) {
    const int swz = (r >> 1) & 7;
    bf16x8 kf[2][4];
#pragma unroll
    for (int kt = 0; kt < 2; ++kt)
#pragma unroll
        for (int ks = 0; ks < 4; ++ks) kf[kt][ks] = *(const LAS bf16x8*)(Kt + (32 * kt + r) * 128 + (((2 * ks + hf) ^ swz) << 4));
    SBAR();
#pragma unroll
    for (int kt = 0; kt < 2; ++kt) {
        f32x16 acc;
#pragma unroll
        for (int e = 0; e < 16; ++e) acc[e] = cinit;
#pragma unroll
        for (int ks = 0; ks < 4; ++ks) acc = mfma32(kf[kt][ks], Qf[ks], acc);
        s[kt] = acc;
    }
}
__device__ __forceinline__ void at_pv(unsigned vbase, const unsigned (&voff)[2][2], const f32x16 (&p)[2], f32x16 (&o)[2]) {
#pragma unroll
    for (int kt = 0; kt < 2; ++kt) {
        s16x4 vr[2][2][2];
#pragma unroll
        for (int s = 0; s < 2; ++s) { const unsigned co = vbase + (unsigned)(4096 * kt + 2048 * s);
            vr[s][0][0] = tr_read0(co + voff[0][0]); vr[s][1][0] = tr_read0(co + voff[1][0]); vr[s][0][1] = tr_read0(co + voff[0][1]); vr[s][1][1] = tr_read0(co + voff[1][1]); }
        bf16x8 pb[2];
#pragma unroll
        for (int s = 0; s < 2; ++s) { u32x4 pw; pw.x = pk2(p[kt][8 * s + 0], p[kt][8 * s + 1]); pw.y = pk2(p[kt][8 * s + 2], p[kt][8 * s + 3]); pw.z = pk2(p[kt][8 * s + 4], p[kt][8 * s + 5]); pw.w = pk2(p[kt][8 * s + 6], p[kt][8 * s + 7]); pb[s] = as_bf16x8(pw); }
        asm volatile("s_waitcnt lgkmcnt(0)" ::: "memory"); SBAR();
#pragma unroll
        for (int s = 0; s < 2; ++s) {
            const s16x4 l0 = vr[s][0][0], h0 = vr[s][1][0], l1 = vr[s][0][1], h1 = vr[s][1][1];
            const bf16x8 v0 = {l0[0], l0[1], l0[2], l0[3], h0[0], h0[1], h0[2], h0[3]}, v1 = {l1[0], l1[1], l1[2], l1[3], h1[0], h1[1], h1[2], h1[3]};
            o[0] = mfma32(v0, pb[s], o[0]); o[1] = mfma32(v1, pb[s], o[1]);
        }
    }
}

struct AttnRow { int r, hf, tt, t, qb, wave; unsigned long long wave_union; float m, lpart; };
struct TileInfo { int hi, lo; bool rowok, edge, work, fresh; };
template <int MODE, int VAR>
__device__ __forceinline__ void at_tile_qk(const Frame& F, int j, int stg, const bf16x8 (&Qf)[4], const AttnRow& R, float mfin, f32x16 (&s)[2], TileInfo& I) {
    LAS unsigned char* lds = F.lds;
    I.work = true; if (MODE == 2) I.work = (R.wave_union >> j) & 1ull;
    I.hi = 1000; I.lo = -1000; I.rowok = true; I.edge = false;
    if (MODE <= 1) { I.hi = ((R.t - 31) >> 4) - 64 * j - 4 * R.hf; I.edge = (64 * j + 63) > ((64 * R.qb + 8 * R.wave - 31) >> 4); }
    if (MODE == 2) { const unsigned long long sm = *(const LAS unsigned long long*)(lds + AT_SELM + 8 * R.tt); I.rowok = (sm >> j) & 1ull; if (j == R.qb) { I.hi = R.tt - 4 * R.hf; I.edge = true; } }
    if (MODE == 3) { if (j == R.qb) { I.hi = R.tt - 4 * R.hf; I.edge = true; } if (j == R.qb - 8) { I.lo = R.tt + 1 - 4 * R.hf; I.edge = true; } }
    const float mref = (MODE == 1) ? mfin : R.m; I.fresh = mref < -1e29f;
    const float cinit = I.rowok ? (I.fresh ? 0.f : -mref) : -INFINITY;
    if (I.work) { if (VAR & 64) { for (int e = 0; e < 16; ++e) { s[0][e] = Qf[0][0] * 1e-9f; s[1][e] = Qf[1][1] * 1e-9f; } } else at_qk(lds + AT_K + stg * 8192, Qf, R.r, R.hf, s, cinit); }
}
template <int MODE, int VAR>
__device__ __forceinline__ float at_tile_fin(const Frame& F, int j, int stg, f32x16 (&s)[2], const TileInfo& I, AttnRow& R, const unsigned (&voff)[2][2], f32x16 (&o)[2], float invl, float preshift) {
    LAS unsigned char* lds = F.lds; float shift_out = 0.f;
    if (!I.work) return 0.f;
    const int hi = I.hi, lo = I.lo; const bool edge = I.edge;
    if (MODE == 1) {
        if (edge) {
#pragma unroll
            for (int kt = 0; kt < 2; ++kt)
#pragma unroll
                for (int e = 0; e < 16; ++e) { const int cst = 32 * kt + (e & 3) + 8 * (e >> 2); s[kt][e] = (cst <= hi) ? fexp2(s[kt][e]) * invl : 0.f; }
        } else {
#pragma unroll
            for (int kt = 0; kt < 2; ++kt)
#pragma unroll
                for (int e = 0; e < 16; ++e) s[kt][e] = fexp2(s[kt][e]) * invl;
        }
        LAS float* imp = (LAS float*)(lds + AT_IMP) + R.tt * 68;
#pragma unroll
        for (int kt = 0; kt < 2; ++kt)
#pragma unroll
            for (int rg = 0; rg < 4; ++rg) {
                float av = 2.f * (s[kt][4 * rg] + s[kt][4 * rg + 1] + s[kt][4 * rg + 2]) + s[kt][4 * rg + 3], bv = s[kt][4 * rg + 3];
                av += __int_as_float(__builtin_amdgcn_update_dpp(0, __float_as_int(av), 0xB1, 0xf, 0xf, true)); av += __int_as_float(__builtin_amdgcn_update_dpp(0, __float_as_int(av), 0x4E, 0xf, 0xf, true));
                bv += __int_as_float(__builtin_amdgcn_update_dpp(0, __float_as_int(bv), 0xB1, 0xf, 0xf, true)); bv += __int_as_float(__builtin_amdgcn_update_dpp(0, __float_as_int(bv), 0x4E, 0xf, 0xf, true));
                if ((R.r & 3) == 0) { const int jb = 16 * j + 8 * kt + 2 * rg + R.hf; (void)__hip_atomic_fetch_add(imp + jb, av, __ATOMIC_RELAXED, __HIP_MEMORY_SCOPE_WORKGROUP); (void)__hip_atomic_fetch_add(imp + jb + 1, bv, __ATOMIC_RELAXED, __HIP_MEMORY_SCOPE_WORKGROUP); }
            }
        if (VAR & 16) { o[0][0] += s[0][3] + s[1][7]; } else at_pv((unsigned)(size_t)(lds + AT_V + stg * 8192), voff, s, o);
    } else if (VAR & 32) { R.lpart += s[0][1]; if (MODE >= 2) { if (VAR & 16) { o[0][0] += s[0][3]; } else at_pv((unsigned)(size_t)(lds + AT_V + stg * 8192), voff, s, o); } }
    else {
        constexpr float THR = 8.f;
        if (__any(preshift != 0.f)) {
#pragma unroll
            for (int kt = 0; kt < 2; ++kt)
#pragma unroll
                for (int e = 0; e < 16; ++e) s[kt][e] -= preshift;
        }
        const bool fresh = R.m < -1e29f;
        if (edge) {
#pragma unroll
            for (int kt = 0; kt < 2; ++kt)
#pragma unroll
                for (int e = 0; e < 16; ++e) { const int cst = 32 * kt + (e & 3) + 8 * (e >> 2); const bool ok = (cst <= hi) && (cst >= lo); s[kt][e] = ok ? s[kt][e] : -INFINITY; }
        }
        float tm4[4] = {-INFINITY, -INFINITY, -INFINITY, -INFINITY};
#pragma unroll
        for (int kt = 0; kt < 2; ++kt)
#pragma unroll
            for (int e = 0; e < 16; e += 2) tm4[(e >> 1) & 3] = fmaxf(tm4[(e >> 1) & 3], fmaxf(s[kt][e], s[kt][e + 1]));
        const float tmax = half_max(fmaxf(fmaxf(tm4[0], tm4[1]), fmaxf(tm4[2], tm4[3])));
        const bool raise = (tmax > -INFINITY) && (fresh || tmax > THR);
        if (__any(raise)) {
            const float shift = raise ? tmax : 0.f, alpha = (raise && !fresh) ? fexp2(-shift) : 1.f;
            R.m = raise ? (fresh ? tmax : R.m + tmax) : R.m; R.lpart *= alpha; shift_out = shift;
#pragma unroll
            for (int kt = 0; kt < 2; ++kt)
#pragma unroll
                for (int e = 0; e < 16; ++e) s[kt][e] -= shift;
            if (MODE >= 2) {
#pragma unroll
                for (int e = 0; e < 16; ++e) { o[0][e] *= alpha; o[1][e] *= alpha; } }
        }
        float ps4[4] = {0.f, 0.f, 0.f, 0.f};
#pragma unroll
        for (int kt = 0; kt < 2; ++kt)
#pragma unroll
            for (int e = 0; e < 16; ++e) { s[kt][e] = fexp2(s[kt][e]); ps4[e & 3] += s[kt][e]; }
        R.lpart += (ps4[0] + ps4[1]) + (ps4[2] + ps4[3]);
        if (MODE >= 2) { if (VAR & 16) { o[0][0] += s[0][3] + s[1][7]; } else at_pv((unsigned)(size_t)(lds + AT_V + stg * 8192), voff, s, o); }
    }
    return shift_out;
}
template <int MODE, int VAR = 0>
__device__ __forceinline__ void at_branch(const Frame& F, unsigned long long mask, const bf16* Kb, const bf16* Vb, size_t stride, const bf16x8 (&Qf)[4], AttnRow& R, const unsigned (&voff)[2][2],
                                          f32x16 (&o)[2], float mfin, float invl) {
    LAS unsigned char* lds = F.lds; const int tid = F.tid;
    if (mask == 0ull) return;
    AttnStage st0, st1; int sg = 0;
    { const int j0 = __builtin_ctzll(mask); at_gload(st0, Kb, Vb, stride, j0, tid); at_swrite(st0, lds, 0, tid);
      const unsigned long long m1 = mask & (mask - 1ull); if (m1) { at_gload(st1, Kb, Vb, stride, __builtin_ctzll(m1), tid); at_swrite(st1, lds, 1, tid); } }
    __syncthreads();
    while (mask) {
        const int j0 = __builtin_ctzll(mask); mask &= mask - 1ull;
        int j1 = -1; if (mask) { j1 = __builtin_ctzll(mask); mask &= mask - 1ull; }
        int n0 = -1, n1 = -1; { unsigned long long mm = mask; if (mm) { n0 = __builtin_ctzll(mm); mm &= mm - 1ull; if (mm) n1 = __builtin_ctzll(mm); } }
        at_gload(st0, Kb, Vb, stride, n0 >= 0 ? n0 : j0, tid);
        at_gload(st1, Kb, Vb, stride, n1 >= 0 ? n1 : j0, tid);
        { f32x16 sa[2]; TileInfo Ia;
          at_tile_qk<MODE, VAR>(F, j0, sg, Qf, R, mfin, sa, Ia);
          (void)at_tile_fin<MODE, VAR>(F, j0, sg, sa, Ia, R, voff, o, invl, 0.f); }
        if (j1 >= 0) { f32x16 sb[2]; TileInfo Ib;
          at_tile_qk<MODE, VAR>(F, j1, sg + 1, Qf, R, mfin, sb, Ib);
          (void)at_tile_fin<MODE, VAR>(F, j1, sg + 1, sb, Ib, R, voff, o, invl, 0.f); }
        if (n0 >= 0) at_swrite(st0, lds, (sg + 2) & 3, tid);
        if (n1 >= 0) at_swrite(st1, lds, (sg + 3) & 3, tid);
        __syncthreads();
        sg = (sg + 2) & 3;
    }
}

template <int VAR>
__device__ __forceinline__ void attn_item(const Frame& F, ArgsP a, int l, int item) {
    const int qb = 63 - (item >> 4), bh = item & 15, b = bh >> 1, hk = bh & 1; const int lane = F.lane, wave = F.wave;
    const bf16* H = (const bf16*)(a->ws + WS_H); const float* side = (const float*)(a->ws + WS_SIDE); bf16* Y = (bf16*)(a->ws + WS_Y);
    LAS unsigned char* lds = F.lds;
    AttnRow R; R.r = lane & 31; R.hf = lane >> 5; R.tt = 8 * wave + (R.r >> 2); R.t = 64 * qb + R.tt; R.qb = qb; R.wave = wave; R.wave_union = 0ull;
    const int head = hk * 4 + (R.r & 3); const size_t tok = (size_t)b * SEQ + R.t;
    bf16x8 Qf[4];
#pragma unroll
    for (int ks = 0; ks < 4; ++ks) Qf[ks] = *(const bf16x8*)(H + tok * HLD + head * 64 + 16 * ks + 8 * R.hf);
    const float g_cmp = side[tok * 32 + head * 3], g_sel = side[tok * 32 + head * 3 + 1], g_win = side[tok * 32 + head * 3 + 2];
    unsigned voff[2][2];
    { const int li = lane & 15, q = li >> 2, p = li & 3, gi1 = (lane >> 4) & 1;
#pragma unroll
      for (int jh = 0; jh < 2; ++jh)
#pragma unroll
          for (int dt = 0; dt < 2; ++dt) voff[jh][dt] = (unsigned)((8 * jh + 4 * R.hf + q) * 128 + ((((4 * dt + 2 * gi1 + (p >> 1)) ^ (4 * jh + 2 * R.hf + (q >> 1))) & 7) << 4) + (p & 1) * 8); }
    { LAS float* imp = (LAS float*)(lds + AT_IMP) + (8 * wave) * 68; for (int i = lane; i < 8 * 68; i += 64) imp[i] = 0.f; if (F.tid == 0) { *(LAS unsigned*)(lds + AT_UNI) = 0u; *(LAS unsigned*)(lds + AT_UNI + 4) = 0u; } }
    f32x16 o[2];
#pragma unroll
    for (int e = 0; e < 16; ++e) { o[0][e] = 0.f; o[1][e] = 0.f; }
    LAS float* ys = (LAS float*)(lds + AT_YS + wave * 8192) + lane;
    {
        const bf16* Kc = (const bf16*)(a->ws + WS_KC) + (size_t)bh * 256 * 64; const bf16* Vc = (const bf16*)(a->ws + WS_VC) + (size_t)bh * 256 * 64;
        const int ntc = (4 * qb + 3 + 63) >> 6; const unsigned long long mc = (ntc >= 64) ? ~0ull : ((1ull << ntc) - 1ull);
        R.m = -1e30f; R.lpart = 0.f;
        if (!(VAR & 8)) at_branch<0, VAR>(F, mc, Kc, Vc, 64, Qf, R, voff, o, 0.f, 0.f);
        const float lsum = half_sum(R.lpart); const float invl = 1.f / fmaxf(lsum, 1e-30f);
        if (!(VAR & 8)) at_branch<1, VAR>(F, mc, Kc, Vc, 64, Qf, R, voff, o, R.m, invl);
#pragma unroll
        for (int e = 0; e < 16; ++e) { ys[e * 64] = g_cmp * o[0][e]; ys[(16 + e) * 64] = g_cmp * o[1][e]; o[0][e] = 0.f; o[1][e] = 0.f; }
    }
    LDS_WAIT();
    {
        unsigned long long wu = 0ull;
        for (int qi = 0; qi < 8; ++qi) {
            unsigned long long selm;
            if (qb < 16) selm = (2ull << qb) - 1ull;
            else {
                const float v = ((const LAS float*)(lds + AT_IMP))[(8 * wave + qi) * 68 + lane];
                const bool cand = (lane >= 1) && (lane <= qb - 2); const unsigned key = cand ? __float_as_uint(fmaxf(v, 0.f)) : 0u;
                unsigned thr = 0u;
                for (int bit = 30; bit >= 0; --bit) { const unsigned tr = thr | (1u << bit); const int c = __popcll(__ballot(cand && key >= tr)); if (c >= 13) thr = tr; }
                const unsigned long long gt = __ballot(cand && key > thr), eq = __ballot(cand && key == thr);
                int need = 13 - __popcll(gt); unsigned long long eqs = 0ull, e2 = eq;
                while (need > 0 && e2) { const unsigned long long low = e2 & (~e2 + 1ull); eqs |= low; e2 ^= low; --need; }
                selm = gt | eqs | 1ull | (1ull << qb) | (1ull << (qb - 1));
            }
            if (lane == 0) *(LAS unsigned long long*)(lds + AT_SELM + 8 * (8 * wave + qi)) = selm;
#if defined(SELFCHECK) && SELFCHECK == 1
            if (lane == 0 && l == 1) ((unsigned long long*)(a->ws + (size_t)880 * MiB + 64 * KiB))[(size_t)bh * SEQ + 64 * qb + 8 * wave + qi] = selm;
#endif
            wu |= selm;
        }
        R.wave_union = wu;
        if (lane == 0) { __hip_atomic_fetch_or((LAS unsigned*)(lds + AT_UNI), (unsigned)wu, __ATOMIC_RELAXED, __HIP_MEMORY_SCOPE_WORKGROUP); __hip_atomic_fetch_or((LAS unsigned*)(lds + AT_UNI + 4), (unsigned)(wu >> 32), __ATOMIC_RELAXED, __HIP_MEMORY_SCOPE_WORKGROUP); }
    }
    __syncthreads();
    const unsigned long long bunion = (unsigned long long)*(const LAS unsigned*)(lds + AT_UNI) | ((unsigned long long)*(const LAS unsigned*)(lds + AT_UNI + 4) << 32);
    const bf16* Hb = H + (size_t)b * SEQ * HLD;
    {
        R.m = -1e30f; R.lpart = 0.f;
        if (!(VAR & 2)) at_branch<2, VAR>(F, bunion, Hb + 512 + 2 * 128 + hk * 64, Hb + 512 + 3 * 128 + hk * 64, HLD, Qf, R, voff, o, 0.f, 0.f);
        const float lsum = half_sum(R.lpart); const float sc = g_sel / fmaxf(lsum, 1e-30f);
#pragma unroll
        for (int e = 0; e < 16; ++e) { ys[e * 64] += sc * o[0][e]; ys[(16 + e) * 64] += sc * o[1][e]; o[0][e] = 0.f; o[1][e] = 0.f; }
    }
    {
        const int lo = qb - 8 > 0 ? qb - 8 : 0; const unsigned long long mw = ((2ull << qb) - 1ull) & ~((1ull << lo) - 1ull);
        R.m = -1e30f; R.lpart = 0.f;
        if (!(VAR & 4)) at_branch<3, VAR>(F, mw, Hb + 512 + 4 * 128 + hk * 64, Hb + 512 + 5 * 128 + hk * 64, HLD, Qf, R, voff, o, 0.f, 0.f);
        const float lsum = half_sum(R.lpart); const float sc = g_win / fmaxf(lsum, 1e-30f);
#pragma unroll
        for (int e = 0; e < 16; ++e) { o[0][e] = ys[e * 64] + sc * o[0][e]; o[1][e] = ys[(16 + e) * 64] + sc * o[1][e]; }
    }
    if (VAR & 1) { asm volatile("" :: "v"(o[0][0]), "v"(o[1][5])); return; }
    bf16* yrow = Y + tok * DM + head * 64 + 4 * R.hf;
#pragma unroll
    for (int dt = 0; dt < 2; ++dt)
#pragma unroll
        for (int rg = 0; rg < 4; ++rg) { u32x2 w; w.x = pk2(o[dt][4 * rg], o[dt][4 * rg + 1]); w.y = pk2(o[dt][4 * rg + 2], o[dt][4 * rg + 3]); *(u32x2*)(yrow + 32 * dt + 8 * rg) = w; }
}

__device__ __forceinline__ void phase_mix_b(const Frame& F, ArgsP a, int l, int rep) {
    unsigned* q = F.ctl + CW_QUEUE + l * 64 + rep * 32;
    for (;;) {
        if (F.tid == 0) F.MISC[0] = __hip_atomic_fetch_add(q, 1u, __ATOMIC_RELAXED, __HIP_MEMORY_SCOPE_AGENT);
        __syncthreads();
        const int item = (int)F.MISC[0];
        __syncthreads();
        if (item >= 1024) break;
        if (rep == 0) attn_item<0>(F, a, l, item); else attn_item<PROBE_ATTN_VAR>(F, a, l, item);
    }
}

constexpr size_t WS_DBG = 880 * MiB;
constexpr int CHECK_LAYER = 1;
__device__ __forceinline__ void dbg_add(ArgsP a, int i, float v) { atomicAdd((float*)(a->ws + WS_DBG) + i, v); }

__device__ __forceinline__ void check_nsa(const Frame& F, ArgsP a) {
    const bf16* H = (const bf16*)(a->ws + WS_H); const float* side = (const float*)(a->ws + WS_SIDE); const bf16* Y = (const bf16*)(a->ws + WS_Y);
    const unsigned long long* SELM = (const unsigned long long*)(a->ws + WS_DBG + 64 * KiB);
    const int lane = F.lane; const int tv[16] = {5, 40, 63, 64, 100, 511, 512, 1023, 1024, 1500, 2047, 2048, 3000, 3333, 4000, 4095};
    for (int s = F.bid * NWAVES + F.wave; s < 256; s += F.G * NWAVES) {
        int t = tv[0];
#pragma unroll
        for (int q = 1; q < 16; ++q) t = ((s & 15) == q) ? tv[q] : t;
        const int b = (s >> 4) & 7, hq = ((s >> 7) * 5 + (s & 7)) & 7, hk = hq >> 2; const size_t tok = (size_t)b * SEQ + t; const int bhk = b * 2 + hk;
        const bf16* KC = (const bf16*)(a->ws + WS_KC) + (size_t)bhk * 256 * 64; const bf16* VC = (const bf16*)(a->ws + WS_VC) + (size_t)bhk * 256 * 64;
        const float g_cmp = side[tok * 32 + hq * 3], g_sel = side[tok * 32 + hq * 3 + 1], g_win = side[tok * 32 + hq * 3 + 2];
        const int cmax = (t - 31) >> 4; float imp = 0.f, ocmp = 0.f;
        for (int gh = 0; gh < 4; ++gh) {
            const int head = hk * 4 + gh; const float qd = bf2f(H[tok * HLD + head * 64 + lane]);
            float m = -INFINITY, l = 0.f;
            for (int c = 0; c <= cmax; ++c) m = fmaxf(m, wave_sum(qd * bf2f(KC[c * 64 + lane])));
            for (int c = 0; c <= cmax; ++c) l += fexp2(wave_sum(qd * bf2f(KC[c * 64 + lane])) - m);
            for (int c = 0; c <= cmax; ++c) { const float p = fexp2(wave_sum(qd * bf2f(KC[c * 64 + lane])) - m) / l; const int j = c >> 2, e = c & 3;
                if (lane == j) imp += (e < 3 ? 2.f : 1.f) * p; if (e == 3 && lane == j + 1) imp += p;
                if (head == hq) ocmp += p * bf2f(VC[c * 64 + lane]); }
        }
        const int cur = t >> 6; const bool causal = lane <= cur, forced = (lane == 0) || (lane == cur) || (lane == cur - 1);
        const float key = causal ? (imp + (forced ? 1.0e4f : 0.f)) : -INFINITY; int rank = 0;
        for (int i = 0; i < 64; ++i) { const float ki = __shfl(key, i); rank += ((ki > key) || (ki == key && i < lane)) ? 1 : 0; }
        const unsigned long long refm = __ballot(causal && rank < 16), stm = SELM[(size_t)bhk * SEQ + t];
        if (lane == 0) { dbg_add(a, 2, (float)__popcll(refm ^ stm)); dbg_add(a, 3, 16.f); }
        const float qd = bf2f(H[tok * HLD + hq * 64 + lane]); const bf16* Hb = H + (size_t)b * SEQ * HLD + hk * 64 + lane;
        float m = -INFINITY, l = 0.f, osel = 0.f;
        for (int j = 0; j <= cur; ++j) if ((stm >> j) & 1ull) for (int kk = 0; kk < 64; ++kk) { const int p = 64 * j + kk; if (p > t) break;
            const float sc = wave_sum(qd * bf2f(Hb[(size_t)p * HLD + 512 + 2 * 128])); const float mn = fmaxf(m, sc), al = fexp2(m - mn), pp = fexp2(sc - mn);
            l = l * al + pp; osel = osel * al + pp * bf2f(Hb[(size_t)p * HLD + 512 + 3 * 128]); m = mn; }
        const float ysel = osel / fmaxf(l, 1e-30f);
        m = -INFINITY; l = 0.f; float owin = 0.f;
        for (int p = (t - 511 > 0 ? t - 511 : 0); p <= t; ++p) { const float sc = wave_sum(qd * bf2f(Hb[(size_t)p * HLD + 512 + 4 * 128])); const float mn = fmaxf(m, sc), al = fexp2(m - mn), pp = fexp2(sc - mn);
            l = l * al + pp; owin = owin * al + pp * bf2f(Hb[(size_t)p * HLD + 512 + 5 * 128]); m = mn; }
        const float ref = g_cmp * ocmp + g_sel * ysel + g_win * owin / fmaxf(l, 1e-30f), got = bf2f(Y[tok * DM + hq * 64 + lane]);
        const float e2 = wave_sum((ref - got) * (ref - got)), r2 = wave_sum(ref * ref);
        if (lane == 0) { dbg_add(a, 0, e2); dbg_add(a, 1, r2); }
    }
}

__device__ __forceinline__ void check_gdn(const Frame& F, ArgsP a, int l) {
    if (F.bid >= 8) return;
    const bf16* H = (const bf16*)(a->ws + WS_H); const float* side = (const float*)(a->ws + WS_SIDE); const bf16* Y = (const bf16*)(a->ws + WS_Y);
    const int b = F.bid, h = (F.bid * 3) & 3, tid = F.tid, lane = F.lane, col = tid & 63, rg = tid >> 6;
    LAS float* S = (LAS float*)F.lds; LAS float* qv = S + 64 * 65; LAS float* kv = qv + 64; LAS float* vv = kv + 64; LAS float* sc = vv + 64; LAS float* part = sc + 64;
    for (int i = tid; i < 64 * 65; i += NTHR) S[i] = 0.f;
    float hq[3] = {0.f, 0.f, 0.f}, hk[3] = {0.f, 0.f, 0.f}, hv[3] = {0.f, 0.f, 0.f}, wq[4], wk[4], wv[4];
    { const float* cw = a->in[6] + (size_t)l * 4 * 768 + h * 64 + lane;
#pragma unroll
      for (int k = 0; k < 4; ++k) { wq[k] = cw[k * 768]; wk[k] = cw[k * 768 + 256]; wv[k] = cw[k * 768 + 512]; } }
    const float Aexp = __expf(a->in[7][l * 4 + h]), dtb = a->in[8][l * 4 + h], nw = a->in[9][l * 64 + lane];
    __syncthreads();
    for (int t = 0; t < 192; ++t) {
        const size_t tok = (size_t)b * SEQ + t;
        if (F.wave == 0) { const bf16* p = H + tok * HLD + 1280 + h * 64 + lane; const float rq = bf2f(p[0]), rk = bf2f(p[256]), rv = bf2f(p[512]);
            const float cq = wq[0] * hq[0] + wq[1] * hq[1] + wq[2] * hq[2] + wq[3] * rq, ck = wk[0] * hk[0] + wk[1] * hk[1] + wk[2] * hk[2] + wk[3] * rk, cv = wv[0] * hv[0] + wv[1] * hv[1] + wv[2] * hv[2] + wv[3] * rv;
            hq[0] = hq[1]; hq[1] = hq[2]; hq[2] = rq; hk[0] = hk[1]; hk[1] = hk[2]; hk[2] = rk; hv[0] = hv[1]; hv[1] = hv[2]; hv[2] = rv;
            const float qs = cq / (1.f + __expf(-cq)), ks = ck / (1.f + __expf(-ck)), vs = cv / (1.f + __expf(-cv));
            qv[lane] = qs / sqrtf(wave_sum(qs * qs) + 1e-6f); kv[lane] = ks / sqrtf(wave_sum(ks * ks) + 1e-6f); vv[lane] = vs;
            if (lane == 0) { const float av = side[tok * 32 + 28 + h] + dtb; const float sp = av > 20.f ? av : log1pf(__expf(av)); sc[0] = __expf(-Aexp * sp); sc[1] = side[tok * 32 + 24 + h]; } }
        __syncthreads();
        { float ps = 0.f;
#pragma unroll
          for (int r = 0; r < 8; ++r) ps += kv[8 * rg + r] * S[(8 * rg + r) * 65 + col];
          part[rg * 64 + col] = ps; }
        __syncthreads();
        { float ks = 0.f;
#pragma unroll
          for (int r = 0; r < 8; ++r) ks += part[r * 64 + col];
          const float eg = sc[0], be = sc[1]; float po = 0.f;
          __syncthreads();
#pragma unroll
          for (int r = 0; r < 8; ++r) { const int dk = 8 * rg + r; const float sn = eg * (S[dk * 65 + col] - be * kv[dk] * ks) + be * kv[dk] * vv[col]; S[dk * 65 + col] = sn; po += sn * qv[dk]; }
          part[rg * 64 + col] = po; }
        __syncthreads();
        if (F.wave == 0) { float o = 0.f;
#pragma unroll
            for (int r = 0; r < 8; ++r) o += part[r * 64 + lane];
            o *= 0.125f; const float rs = 1.f / sqrtf(wave_sum(o * o) * (1.f / 64.f) + 1e-6f); const float z = bf2f(H[tok * HLD + 2048 + h * 64 + lane]);
            const float ref = o * rs * nw * (z / (1.f + __expf(-z))), got = bf2f(Y[tok * DM + 512 + h * 64 + lane]);
            const float e2 = wave_sum((ref - got) * (ref - got)), r2 = wave_sum(ref * ref);
            if (lane == 0) { dbg_add(a, 4, e2); dbg_add(a, 5, r2); } }
        __syncthreads();
    }
}

__device__ __forceinline__ void check_moe(const Frame& F, ArgsP a, int l) {
    const float* X1 = (const float*)(a->ws + WS_X1); const bf16* Y2 = (const bf16*)(a->ws + WS_Y2);
    const int* route_e = (const int*)(a->ws + WS_SLOT + SL_RE); const float* route_w = (const float*)(a->ws + WS_SLOT + SL_RW);
    LAS float* x = (LAS float*)F.lds; LAS float* hid = x + 1024; LAS float* lg = hid + 512; LAS float* yr = lg + 64;
    const int tid = F.tid, lane = F.lane;
    for (int s = F.bid; s < 256; s += F.G) {
        const int t = (s * 4099 + 17) & (T - 1);
        for (int i = tid; i < 1024; i += NTHR) { x[i] = X1[(size_t)t * DM + i]; yr[i] = 0.f; }
        __syncthreads();
        for (int j = F.wave; j < 36; j += NWAVES) { float d = 0.f; for (int k = lane; k < DM; k += 64) d += x[k] * (j < 4 ? a->in[18][((size_t)l * DM + k) * 4 + j] : a->in[20][((size_t)l * DM + k) * NEXP + j - 4]);
            d = wave_sum(d); if (lane == 0) lg[j] = d + (j < 4 ? a->in[19][l * 4 + j] : a->in[21][l * NEXP + j - 4]); }
        __syncthreads();
        if (tid == 0) { int gi = 0; for (int i = 1; i < 4; ++i) if (lg[i] > lg[gi]) gi = i; float gs = 0.f; for (int i = 0; i < 4; ++i) gs += __expf(lg[i] - lg[gi]); const float gw = 1.f / gs;
            int i1 = 0; for (int i = 1; i < 8; ++i) if (lg[4 + gi * 8 + i] > lg[4 + gi * 8 + i1]) i1 = i; int i2 = -1; for (int i = 0; i < 8; ++i) if (i != i1 && (i2 < 0 || lg[4 + gi * 8 + i] > lg[4 + gi * 8 + i2])) i2 = i;
            const float e2 = __expf(lg[4 + gi * 8 + i2] - lg[4 + gi * 8 + i1]), w1 = gw / (1.f + e2), w2 = gw - w1;
            const int se1 = route_e[2 * t], se2 = route_e[2 * t + 1]; const float sw1 = route_w[2 * t], sw2 = route_w[2 * t + 1];
            dbg_add(a, 8, (se1 != gi * 8 + i1 ? 1.f : 0.f) + (se2 != gi * 8 + i2 ? 1.f : 0.f)); dbg_add(a, 9, 2.f);
            if (se1 == gi * 8 + i1 && se2 == gi * 8 + i2) { dbg_add(a, 10, (sw1 - w1) * (sw1 - w1) + (sw2 - w2) * (sw2 - w2)); dbg_add(a, 11, w1 * w1 + w2 * w2); } }
        for (int k2 = 0; k2 < 2; ++k2) {
            const int e = route_e[2 * t + k2]; const float rw = route_w[2 * t + k2];
            const float* wg = a->in[22] + ((size_t)l * NEXP + e) * DM * FF; const float* wu = a->in[23] + ((size_t)l * NEXP + e) * DM * FF; const float* wd = a->in[24] + ((size_t)l * NEXP + e) * FF * DM;
            { float g = 0.f, u = 0.f; for (int k = 0; k < DM; ++k) { g += x[k] * wg[(size_t)k * FF + tid]; u += x[k] * wu[(size_t)k * FF + tid]; } hid[tid] = g / (1.f + __expf(-g)) * u; }
            __syncthreads();
            for (int d = tid; d < DM; d += NTHR) { float y = 0.f; for (int f = 0; f < FF; ++f) y += hid[f] * wd[(size_t)f * DM + d]; yr[d] += y * rw; }
            __syncthreads();
        }
        float e2 = 0.f, r2 = 0.f;
        for (int d = tid; d < DM; d += NTHR) { const float got = bf2f(Y2[(size_t)(2 * t) * DM + d]) + bf2f(Y2[(size_t)(2 * t + 1) * DM + d]); e2 += (yr[d] - got) * (yr[d] - got); r2 += yr[d] * yr[d]; }
        e2 = wave_sum(e2); r2 = wave_sum(r2); if (lane == 0) { dbg_add(a, 6, e2); dbg_add(a, 7, r2); }
        __syncthreads();
    }
}

__device__ __forceinline__ void check_inproj(const Frame& F, ArgsP a, int l) {
    const bf16* H = (const bf16*)(a->ws + WS_H); const float* xin = (l == 0) ? a->in[0] : (const float*)a->out; const float* win = a->in[1] + (size_t)l * DM * DIN;
    const int lane = F.lane;
    for (int s = F.bid * NWAVES + F.wave; s < 1024; s += F.G * NWAVES) {
        const int tok = (s * 7919 + 13) & (T - 1), grp = s % 14, t = tok & (SEQ - 1);
        const int col0 = grp < 8 ? grp * 64 : 512 + (grp - 8) * 128 + ((s >> 4) & 1) * 64; const bool isq = grp < 8, rope = isq || ((grp - 8) % 2 == 0);
        float d = 0.f; for (int k = 0; k < DM; ++k) d += xin[(size_t)tok * DM + k] * win[(size_t)k * DIN + col0 + lane];
        if (rope) { const float inv[8] = {1.0f, 0.19392274f, 0.03760603f, 0.0072926646f, 0.0014142136f, 0.0002742482f, 5.3182957e-05f, 1.0313385e-05f};
            float iv = inv[0];
#pragma unroll
            for (int q = 1; q < 8; ++q) iv = ((lane & 7) == q) ? inv[q] : iv;
            const float ang = (float)t * iv, c = cosf(ang), sn = sinf(ang), other = __shfl_xor(d, 8);
            if (lane < 8) d = d * c - other * sn; else if (lane < 16) d = d * c + other * sn; }
        if (isq) d *= pg8::QSCALE;
        const float got = bf2f(H[(size_t)tok * HLD + col0 + lane]); const float e2 = wave_sum((d - got) * (d - got)), r2 = wave_sum(d * d);
        if (lane == 0) { dbg_add(a, 12, e2); dbg_add(a, 13, r2); }
    }
}
__device__ __forceinline__ void check_compress(const Frame& F, ArgsP a, int l) {
    const bf16* H = (const bf16*)(a->ws + WS_H); const int lane = F.lane;
    for (int s = F.bid * NWAVES + F.wave; s < 512; s += F.G * NWAVES) {
        const int kv = s & 1, bh = (s >> 1) & 15, b = bh >> 1, hh = bh & 1, i = (s * 53 + 7) % 255;
        const float* pe = a->in[3] + ((size_t)l * 2 + kv) * 2048; const float* w1 = a->in[4] + ((size_t)l * 2 + kv) * 2048 * 128; const float* w2 = a->in[5] + ((size_t)l * 2 + kv) * 128 * 64;
        float h0 = 0.f, h1 = 0.f;
        for (int k = 0; k < 2048; ++k) { const int p = k >> 6, d = k & 63; const float x = bf2f(H[((size_t)b * SEQ + 16 * i + p) * HLD + 512 + kv * 128 + hh * 64 + d]) + pe[k];
            h0 += x * w1[(size_t)k * 128 + lane]; h1 += x * w1[(size_t)k * 128 + 64 + lane]; }
        h0 = h0 / (1.f + __expf(-h0)); h1 = h1 / (1.f + __expf(-h1));
        float o = 0.f;
        for (int n = 0; n < 64; ++n) { o += __shfl(h0, n) * w2[(size_t)n * 64 + lane] + __shfl(h1, n) * w2[(size_t)(64 + n) * 64 + lane]; }
        const float got = bf2f(((const bf16*)(a->ws + (kv ? WS_VC : WS_KC)))[((size_t)bh * 256 + i) * 64 + lane]);
        const float e2 = wave_sum((o - got) * (o - got)), r2 = wave_sum(o * o); if (lane == 0) { dbg_add(a, 14, e2); dbg_add(a, 15, r2); }
    }
}
__device__ __forceinline__ void check_conformer(const Frame& F, ArgsP a, int l) {
    const bf16* H = (const bf16*)(a->ws + WS_H); const bf16* Y = (const bf16*)(a->ws + WS_Y); const int lane = F.lane;
    for (int s = F.bid * NWAVES + F.wave; s < 1024; s += F.G * NWAVES) {
        const int tok = (s * 6151 + 3) & (T - 1), t = tok & (SEQ - 1); float u[4];
#pragma unroll
        for (int j = 0; j < 4; ++j) { const int c = lane + 64 * j; float acc = a->in[11][l * 256 + c];
            for (int k = 0; k < 31; ++k) { const int sp = t - 30 + k; if (sp >= 0) { const bf16* hp = H + (size_t)(tok - 30 + k) * HLD + 2304 + c; const float g = bf2f(hp[256]); acc += a->in[10][((size_t)l * 31 + k) * 256 + c] * (bf2f(hp[0]) / (1.f + __expf(-g))); } }
            u[j] = acc; }
        const float mean = wave_sum(u[0] + u[1] + u[2] + u[3]) * (1.f / 256.f); float q = 0.f;
#pragma unroll
        for (int j = 0; j < 4; ++j) { u[j] -= mean; q += u[j] * u[j]; }
        const float rstd = 1.f / sqrtf(wave_sum(q) * (1.f / 256.f) + LN_EPS); float e2 = 0.f, r2 = 0.f;
#pragma unroll
        for (int j = 0; j < 4; ++j) { const int c = lane + 64 * j; const float v = u[j] * rstd * a->in[12][l * 256 + c] + a->in[13][l * 256 + c]; const float ref = v / (1.f + __expf(-v)), got = bf2f(Y[(size_t)tok * DM + 768 + c]);
            e2 += (ref - got) * (ref - got); r2 += ref * ref; }
        e2 = wave_sum(e2); r2 = wave_sum(r2); if (lane == 0) { dbg_add(a, 16, e2); dbg_add(a, 17, r2); }
    }
}
__device__ __forceinline__ void check_inject(const Frame& F, ArgsP a) {
    if (F.bid == 0 && F.tid == 0) { const float* d = (const float*)(a->ws + WS_DBG); float e0 = 0.f, e1 = 0.f;
        if (SELFCHECK == 1) { e0 = 1000.f * sqrtf(d[0] / d[1]); e1 = 1.0e4f * d[2] / d[3]; }
        if (SELFCHECK == 2) { e0 = 1000.f * sqrtf(d[4] / d[5]); }
        if (SELFCHECK == 3) { e0 = 1000.f * sqrtf(d[6] / d[7]); e1 = 1.0e4f * d[8] / d[9] + 1000.f * sqrtf(d[10] / fmaxf(d[11], 1e-30f)); }
        if (SELFCHECK == 4) { e0 = 1000.f * sqrtf(d[12] / d[13]); }
        if (SELFCHECK == 5) { e0 = 1000.f * sqrtf(d[14] / d[15]); e1 = 1000.f * sqrtf(d[16] / d[17]); }
        a->out[0] += e0; a->out[1] += e1; }
}


#ifndef MK_MULTI
#define MK_MULTI 0
#endif
#ifndef PROBE_REPEAT
#define PROBE_REPEAT 0
#endif
constexpr int N_PHASES = 1 + 10 * NL;
__device__ __forceinline__ Frame make_frame(int wave_s) {
    extern __shared__ __attribute__((aligned(16))) unsigned char lds_raw[];
    Frame F; F.lds = (LAS unsigned char*)lds_raw; F.MISC = (volatile LAS unsigned*)(F.lds + MISC_OFF);
    int tid = threadIdx.x, G = gridDim.x, bid = blockIdx.x; unsigned lb = (unsigned)(size_t)F.lds; (void)wave_s;
    asm volatile("" : "+v"(tid), "+s"(G), "+s"(bid), "+s"(lb));
    F.lds = (LAS unsigned char*)(size_t)lb; F.MISC = (volatile LAS unsigned*)(F.lds + MISC_OFF);
    F.tid = tid; F.lane = F.tid & 63; F.wave = __builtin_amdgcn_readfirstlane(F.tid >> 6); F.G = G; F.bid = bid;
    F.ctl = (unsigned*)(args_here()->ws + WS_CTL); return F;
}
__device__ __forceinline__ void ph_prologue(int, int wv) { const Frame F = make_frame(wv); phase_prologue(F, args_here()); phase_weights(F, args_here(), 0);
#if SELFCHECK
    if (F.bid == 0 && F.tid < 64) ((float*)(args_here()->ws + WS_DBG))[F.tid] = 0.f;
#endif
}
__device__ __forceinline__ void ph_inproj(int, int wv) { const Frame F = make_frame(wv); unsigned char* ws = args_here()->ws;
    pg8::Gemm g{(const bf16*)(ws + WS_XB), (const bf16*)(ws + WS_WL + WL_WIN), T, DINP, DM}; pg8::StaticOrder S; S.init(T, DINP, F.G, F.bid);
    pg8::EpiInProj E{(bf16*)(ws + WS_H), (float*)(ws + WS_SIDE), (const float*)(ws + WS_ROPE)};
    pg8::gemm_phase<pg8::EpiInProj, pg8::StaticOrder, false>(F.lds, g, S, E, nullptr, F.tid); }
__device__ __forceinline__ void ph_compress(int l, int wv) { const Frame F = make_frame(wv); for (int it = F.bid; it < 256; it += F.G) compress_item(F, args_here(), it); }
__device__ __forceinline__ void ph_gdnprep(int l, int wv) { const Frame F = make_frame(wv); for (int it = F.bid; it < 256; it += F.G) { gdn_prep_chunk(F, args_here(), l, it * 8 + F.wave, F.lds + F.wave * 16384); __syncthreads(); } }
__device__ __forceinline__ void ph_conformer(int l, int wv) { const Frame F = make_frame(wv); for (int it = F.bid; it < 512; it += F.G) conformer_item(F, args_here(), l, it); }
__device__ __forceinline__ void ph_gdnout(int l, int wv) { const Frame F = make_frame(wv); for (int ci = F.bid * NWAVES + F.wave; ci < 2048; ci += F.G * NWAVES) gdn_out_chunk(F, args_here(), ci, F.lds + F.wave * 8192); }
__device__ __forceinline__ void ph_scan(int l, int wv) { const Frame F = make_frame(wv); if (F.bid < 16) gdn_scan<0>(F, args_here(), l); }
__device__ __forceinline__ void ph_scan_var(int l, int wv) { const Frame F = make_frame(wv); if (F.bid < 16) gdn_scan<(PROBE_SCAN_VAR & 1)>(F, args_here(), l); }
__device__ __forceinline__ void ph_attn(int l, int rep, int wv) { const Frame F = make_frame(wv); phase_mix_b(F, args_here(), l, rep); }
__device__ __forceinline__ void ph_outproj(int l, int wv) { const Frame F = make_frame(wv); ArgsP ap = args_here(); unsigned char* ws = ap->ws;
    pg8::Gemm g{(const bf16*)(ws + WS_Y), (const bf16*)(ws + WS_WL + WL_WOUT), T, DM, DM}; pg8::StaticOrder S; S.init(T, DM, F.G, F.bid);
    pg8::EpiOutProj E{(const bf16*)(ws + WS_XB), (float*)(ws + WS_X1), DN_ALPHA};
    pg8::gemm_phase<pg8::EpiOutProj, pg8::StaticOrder, false>(F.lds, g, S, E, nullptr, F.tid); }
__device__ __forceinline__ void ph_ln1(int l, int wv) { const Frame F = make_frame(wv); phase_ln1_router<false>(F, args_here(), l); }
__device__ __forceinline__ void ph_ln1_dry(int l, int wv) { const Frame F = make_frame(wv); phase_ln1_router<true>(F, args_here(), l); }
__device__ __forceinline__ void ph_gather(int l, int wv) { const Frame F = make_frame(wv); phase_gather(F, args_here(), l); }
__device__ __forceinline__ void ph_moeup(int l, int wv) { const Frame F = make_frame(wv); unsigned char* ws = args_here()->ws;
    pg8::Gemm g{(const bf16*)(ws + WS_XB), (const bf16*)(ws + WS_WL + WL_WGU), 0, 0, DM}; pg8::MoeOrder S{(const int*)(ws + WS_META) + l * 512, F.G, F.bid};
    pg8::EpiSwiGLU E{(bf16*)(ws + WS_HID), (const int*)(ws + WS_SLOT + SL_TOK), 1};
    pg8::gemm_phase<pg8::EpiSwiGLU, pg8::MoeOrder, false>(F.lds, g, S, E, nullptr, F.tid); }
__device__ __forceinline__ void ph_moedown(int l, int wv) { const Frame F = make_frame(wv); unsigned char* ws = args_here()->ws;
    pg8::Gemm g{(const bf16*)(ws + WS_HID), (const bf16*)(ws + WS_WL + WL_WDN), 0, 0, FF}; pg8::MoeOrder S{(const int*)(ws + WS_META) + l * 512, F.G, F.bid};
    pg8::EpiDown E{(bf16*)(ws + WS_Y2), (const int*)(ws + WS_SLOT + SL_TOK), (const float*)(ws + WS_SLOT + SL_W)};
    pg8::gemm_phase<pg8::EpiDown, pg8::MoeOrder, false>(F.lds, g, S, E, nullptr, F.tid); }
__device__ __forceinline__ void ph_ln2(int l, int wv) { const Frame F = make_frame(wv); phase_ln2(F, args_here(), l); }
__device__ __forceinline__ void ph_weights(int l, int wv) { const Frame F = make_frame(wv); if (l + 1 < NL) phase_weights(F, args_here(), l + 1); }

__global__ void __launch_bounds__(NTHR, 2) fwd_kernel(Args args) {
    extern __shared__ __attribute__((aligned(16))) unsigned char lds_raw[];
    (void)lds_raw; const int wv = 0; const Frame F = make_frame(wv);
    if (F.tid < 64) F.MISC[F.tid] = 0u;
    __syncthreads();
    XcdBarrier bar = xcd_barrier_post(F.ctl + CW_BAR, F.MISC + 8);
    const int lo = args_here()->ph_lo, hi = args_here()->ph_hi;
#define IN(k) (lo <= (k) && (k) < hi)
#define SEAM(k) do { if (IN(k) && IN((k) + 1)) { XcdBarrier bb = bar; asm volatile("" : "+s"(bb.bar)); xcd_barrier(bb); } } while (0)
#define RPT(bit, call) do { call; if (PROBE_REPEAT & (1u << (bit))) { XcdBarrier bb = bar; asm volatile("" : "+s"(bb.bar)); xcd_barrier(bb); call; } } while (0)
    if (IN(0)) ph_prologue(0, wv);
    SEAM(0);
#define LAYER_BODY(l) do { \
        const int pb = 1 + 10 * l; \
        if (IN(pb + 0)) RPT(0, ph_inproj(l, wv)); \
        SEAM(pb + 0); \
        if constexpr (SELFCHECK == 4) { \
        if (l == CHECK_LAYER) { { const Frame F2 = make_frame(wv); check_inproj(F2, args_here(), l); } XcdBarrier bb = bar; asm volatile("" : "+s"(bb.bar)); xcd_barrier(bb); } \
        } \
        if (IN(pb + 1)) { RPT(16, ph_compress(l, wv)); RPT(17, ph_gdnprep(l, wv)); RPT(18, ph_conformer(l, wv)); } \
        SEAM(pb + 1); \
        if (IN(pb + 2)) { ph_scan(l, wv); if (PROBE_REPEAT & (1u << 19)) { XcdBarrier bb = bar; asm volatile("" : "+s"(bb.bar)); xcd_barrier(bb); ph_scan_var(l, wv); XcdBarrier bb2 = bar; asm volatile("" : "+s"(bb2.bar)); xcd_barrier(bb2); } ph_attn(l, 0, wv); if (PROBE_REPEAT & (1u << 20)) { XcdBarrier bb = bar; asm volatile("" : "+s"(bb.bar)); xcd_barrier(bb); ph_attn(l, 1, wv); } } \
        SEAM(pb + 2); \
        if (IN(pb + 3)) RPT(24, ph_gdnout(l, wv)); \
        SEAM(pb + 3); \
        if constexpr (SELFCHECK == 1 || SELFCHECK == 2 || SELFCHECK == 5) { \
        if (l == CHECK_LAYER) { { const Frame F2 = make_frame(wv); if (SELFCHECK == 1) check_nsa(F2, args_here()); else if (SELFCHECK == 2) check_gdn(F2, args_here(), l); else { check_compress(F2, args_here(), l); check_conformer(F2, args_here(), l); } } XcdBarrier bb = bar; asm volatile("" : "+s"(bb.bar)); xcd_barrier(bb); } \
        } \
        if (IN(pb + 4)) RPT(3, ph_outproj(l, wv)); \
        SEAM(pb + 4); \
        if (IN(pb + 5)) { ph_ln1(l, wv); if (PROBE_REPEAT & (1u << 4)) { XcdBarrier bb = bar; asm volatile("" : "+s"(bb.bar)); xcd_barrier(bb); ph_ln1_dry(l, wv); } \
            if (PROBE_REPEAT & (1u << 23)) { for (int rr = 0; rr < 4; ++rr) { XcdBarrier bb = bar; asm volatile("" : "+s"(bb.bar)); xcd_barrier(bb); } } } \
        SEAM(pb + 5); \
        if (IN(pb + 6)) RPT(5, ph_gather(l, wv)); \
        SEAM(pb + 6); \
        if (IN(pb + 7)) RPT(6, ph_moeup(l, wv)); \
        SEAM(pb + 7); \
        if (IN(pb + 8)) RPT(7, ph_moedown(l, wv)); \
        SEAM(pb + 8); \
        if constexpr (SELFCHECK == 3) { \
        if (l == CHECK_LAYER) { { const Frame F2 = make_frame(wv); check_moe(F2, args_here(), l); } XcdBarrier bb = bar; asm volatile("" : "+s"(bb.bar)); xcd_barrier(bb); } \
        } \
        if (IN(pb + 9)) { RPT(22, ph_ln2(l, wv)); RPT(21, ph_weights(l, wv)); } \
        SEAM(pb + 9); \
     \
    } while (0)
    LAYER_BODY(0); LAYER_BODY(1); LAYER_BODY(2); LAYER_BODY(3);
#undef LAYER_BODY
#undef RPT
#if SELFCHECK
    { XcdBarrier bb = bar; asm volatile("" : "+s"(bb.bar)); xcd_barrier(bb); const Frame F2 = make_frame(wv); check_inject(F2, args_here()); }
#endif
#undef IN
#undef SEAM
}

extern "C" void kernel_launch(void* const* d_in, const int* in_sizes, int n_in, void* d_out, int out_size, void* d_ws, size_t ws_size, hipStream_t stream) {
    static int grid = 0;
    if (grid == 0) {
        if (n_in != 25 || in_sizes[0] != T * DM || out_size != T * DM || ws_size < WS_END) { fprintf(stderr, "kernel_launch: shape/workspace mismatch (n_in %d, in0 %d, out %d, ws %zu < %zu); nothing launched\n", n_in, n_in > 0 ? in_sizes[0] : -1, out_size, ws_size, (size_t)WS_END); grid = -1; return; }
        int dev = 0, cus = 0, per_cu = 0;
        if (hipGetDevice(&dev) != hipSuccess || hipDeviceGetAttribute(&cus, hipDeviceAttributeMultiprocessorCount, dev) != hipSuccess) { grid = -1; return; }
        if (hipFuncSetAttribute((const void*)fwd_kernel, hipFuncAttributeMaxDynamicSharedMemorySize, LDS_BYTES) != hipSuccess) { fprintf(stderr, "kernel_launch: hipFuncSetAttribute failed\n"); grid = -1; return; }
        if (hipOccupancyMaxActiveBlocksPerMultiprocessor(&per_cu, (const void*)fwd_kernel, NTHR, LDS_BYTES) != hipSuccess || per_cu < 1)
            fprintf(stderr, "kernel_launch: note: occupancy query reports %d workgroups per CU\n", per_cu);
        (void)hipGetLastError();
        grid = cus;
        if (grid < 32 || (grid & 7)) { fprintf(stderr, "kernel_launch: unexpected CU count %d\n", cus); }
    }
    if (grid < 0) return;
    if (hipMemsetAsync((char*)d_ws + WS_CTL, 0, CTL_ZERO_BYTES, stream) != hipSuccess) return;
    Args a{};
    for (int i = 0; i < 25; ++i) a.in[i] = (const float*)d_in[i];
    a.out = (float*)d_out; a.ws = (unsigned char*)d_ws;
#if MK_MULTI
    for (int p = 0; p < N_PHASES; ++p) { a.ph_lo = p; a.ph_hi = p + 1; hipLaunchKernelGGL(fwd_kernel, dim3(grid), dim3(NTHR), LDS_BYTES, stream, a); }
#else
    a.ph_lo = 0; a.ph_hi = N_PHASES;
    hipLaunchKernelGGL(fwd_kernel, dim3(grid), dim3(NTHR), LDS_BYTES, stream, a);
#endif
}
```

```cpp
#include <hip/hip_runtime.h>
#include <cstdio>
#include <cstdint>
namespace pg8 {
#define PG8_LAS __attribute__((address_space(3)))
typedef unsigned short bf16_t;
typedef short bf16x8 __attribute__((ext_vector_type(8)));
typedef float f32x4 __attribute__((ext_vector_type(4)));
typedef unsigned u32x4 __attribute__((ext_vector_type(4)));
constexpr int BM = 256, BK = 64, HALF = 128, HTB = HALF * BK * 2  , STAGE_BYTES = 8 * HTB, NXCD = 8, WGM = 8;

__host__ __device__ __forceinline__ int lds_byte(int r, int c) { const int st = (r >> 4) * 2 + (c >> 5), rr = r & 15, cc = c & 31, ob = rr * 64 + cc * 2; return st * 1024 + (ob ^ (((ob >> 9) & 1) << 5)); }
__host__ __device__ __forceinline__ void stage_rc(int b, int& R, int& C) { const int st = b / 1024, sb = b % 1024, swz = sb ^ (((sb >> 9) & 1) << 5); R = (st >> 1) * 16 + swz / 64; C = (st & 1) * 32 + (swz % 64) / 2; }
__host__ __device__ __forceinline__ int perm32(int rho) { const int n = rho >> 4, i = rho & 15; return 8 * (i >> 2) + 4 * n + (i & 3); }

struct Unit { int pm, pn; };
struct Gemm { const bf16_t* A; const bf16_t* Bt; int M, N, K; };

struct StaticOrder {
    int nM, nN, nwg, G, c;
    __host__ __device__ void init(int M, int N, int G_, int c_) { nM = M / BM; nN = N / BM; nwg = nM * nN; G = G_; c = c_; }
    __host__ __device__ bool next(int i, Unit& u) const {
        const long L = (long)i * G + c; if (L >= nwg) return false;
        int wgid = (int)L; { const int q = nwg / NXCD, r = nwg % NXCD, xcd = wgid % NXCD, off = wgid / NXCD; wgid = (xcd < r ? xcd * (q + 1) : r * (q + 1) + (xcd - r) * q) + off; }
        const int nig = WGM * nN, gid = wgid / nig, fm = gid * WGM, gsz = (nM - fm) < WGM ? (nM - fm) : WGM;
        u.pm = fm + ((wgid % nig) % gsz); u.pn = (wgid % nig) / gsz; return true;
    }
    __device__ __forceinline__ void a_ready(const Unit&) const {}
    __device__ __forceinline__ void done(const Unit&) const {}
};

__device__ __forceinline__ unsigned cvt_pk_bf16(float lo, float hi) { unsigned r; asm volatile("v_cvt_pk_bf16_f32 %0, %1, %2" : "=v"(r) : "v"(lo), "v"(hi)); return r; }
__device__ __forceinline__ float fast_sigmoid(float x) { return __builtin_amdgcn_rcpf(1.0f + __builtin_amdgcn_exp2f(-1.44269504089f * x)); }

constexpr int HLD = 2816;
constexpr float QSCALE = 0.125f * 1.44269504089f;

struct EpiInProj {
    static constexpr bool PERM = true, AFTER_DRAIN = false, GATHER = false, FP8 = false;
    bf16_t* H; float* side; const float* rope;
    __device__ __forceinline__ void operator()(const f32x4 (&acc)[2][2][4][2], const Unit& u, int wr, int wc, int fr, int fq) const {
        const int row0 = u.pm * BM + wr * 64 + fr; const int pn = u.pn;
        if (pn <= 4) {
#pragma unroll
            for (int ai = 0; ai < 2; ++ai)
#pragma unroll
                for (int m = 0; m < 4; ++m) {
                    const int row = row0 + ai * HALF + m * 16; const float* rp = rope + (size_t)(row & 4095) * 16;
                    const f32x4 c0 = *(const f32x4*)(rp), c1 = *(const f32x4*)(rp + 4), s0 = *(const f32x4*)(rp + 8), s1 = *(const f32x4*)(rp + 12);
#pragma unroll
                    for (int bj = 0; bj < 2; ++bj) {
                        f32x4 v0 = acc[ai][bj][m][0], v1 = acc[ai][bj][m][1];
                        const bool ropeb = (pn < 2) || (bj == 0);
                        if (ropeb) {
                            f32x4 p0, p1;
#pragma unroll
                            for (int e = 0; e < 4; ++e) { p0[e] = __shfl_xor(v0[e], 16); p1[e] = __shfl_xor(v1[e], 16); }
                            if (((wc & 1) == 0) && fq < 2) { const float sg = fq ? 1.f : -1.f; v0 = v0 * c0 + (p0 * s0) * sg; v1 = v1 * c1 + (p1 * s1) * sg; }
                        }
                        if (pn < 2) { v0 = v0 * QSCALE; v1 = v1 * QSCALE; }
                        u32x4 w; w.x = cvt_pk_bf16(v0[0], v0[1]); w.y = cvt_pk_bf16(v0[2], v0[3]); w.z = cvt_pk_bf16(v1[0], v1[1]); w.w = cvt_pk_bf16(v1[2], v1[3]);
                        *(u32x4*)(H + (size_t)row * HLD + pn * BM + bj * HALF + wc * 32 + 8 * fq) = w;
                    }
                }
        } else if (pn < 11) {
#pragma unroll
            for (int ai = 0; ai < 2; ++ai)
#pragma unroll
                for (int m = 0; m < 4; ++m) {
                    const int row = row0 + ai * HALF + m * 16;
#pragma unroll
                    for (int bj = 0; bj < 2; ++bj) {
                        const f32x4 v0 = acc[ai][bj][m][0], v1 = acc[ai][bj][m][1];
                        u32x4 w; w.x = cvt_pk_bf16(v0[0], v0[1]); w.y = cvt_pk_bf16(v0[2], v0[3]); w.z = cvt_pk_bf16(v1[0], v1[1]); w.w = cvt_pk_bf16(v1[2], v1[3]);
                        *(u32x4*)(H + (size_t)row * HLD + pn * BM + bj * HALF + wc * 32 + 8 * fq) = w;
                    }
                }
        } else if (wc == 0) {
#pragma unroll
            for (int ai = 0; ai < 2; ++ai)
#pragma unroll
                for (int m = 0; m < 4; ++m) {
                    const int row = row0 + ai * HALF + m * 16;
                    f32x4 v0 = acc[ai][0][m][0], v1 = acc[ai][0][m][1];
#pragma unroll
                    for (int e = 0; e < 4; ++e) { v0[e] = fast_sigmoid(v0[e]); if (fq < 3) v1[e] = fast_sigmoid(v1[e]); }
                    *(f32x4*)(side + (size_t)row * 32 + 8 * fq) = v0; *(f32x4*)(side + (size_t)row * 32 + 8 * fq + 4) = v1;
                }
        }
    }
};
struct EpiOutProj {
    static constexpr bool PERM = false, AFTER_DRAIN = false, GATHER = false, FP8 = false;
    const bf16_t* res; float* out; float alpha;
    __device__ __forceinline__ void operator()(const f32x4 (&acc)[2][2][4][2], const Unit& u, int wr, int wc, int fr, int fq) const {
        typedef unsigned u32x2 __attribute__((ext_vector_type(2)));
        const int row0 = u.pm * BM + wr * 64 + fr, col0 = u.pn * BM + wc * 32 + 4 * fq;
#pragma unroll
        for (int ai = 0; ai < 2; ++ai)
#pragma unroll
            for (int m = 0; m < 4; ++m) { const size_t off = (size_t)(row0 + ai * HALF + m * 16) * 1024 + col0;
#pragma unroll
                for (int bj = 0; bj < 2; ++bj)
#pragma unroll
                    for (int n = 0; n < 2; ++n) { const u32x2 rb = *(const u32x2*)(res + off + bj * HALF + n * 16);
                        f32x4 r; r[0] = __uint_as_float(rb.x << 16); r[1] = __uint_as_float(rb.x & 0xffff0000u); r[2] = __uint_as_float(rb.y << 16); r[3] = __uint_as_float(rb.y & 0xffff0000u);
                        *(f32x4*)(out + off + bj * HALF + n * 16) = r * alpha + acc[ai][bj][m][n]; }
                asm volatile("" ::: "memory"); }
    }
};
struct EpiSwiGLU {
    static constexpr bool PERM = true, AFTER_DRAIN = false, GATHER = true, FP8 = true;
    unsigned char* hid; const int* rowmap; int rowshift;
    __device__ __forceinline__ void operator()(const f32x4 (&acc)[2][2][4][2], const Unit& u, int wr, int wc, int fr, int fq) const {
        const int row0 = u.pm * BM + wr * 64 + fr, hc0 = (u.pn & 3) * 128 + wc * 16 + 4 * fq;
#pragma unroll
        for (int ai = 0; ai < 2; ++ai)
#pragma unroll
            for (int m = 0; m < 4; ++m) { unsigned char* rowp = hid + (size_t)(row0 + ai * HALF + m * 16) * 512 + hc0;
#pragma unroll
                for (int bj = 0; bj < 2; ++bj) { const f32x4 g = acc[ai][bj][m][0] * 0.03125f, up = acc[ai][bj][m][1] * 0.03125f; f32x4 h;
#pragma unroll
                    for (int e = 0; e < 4; ++e) h[e] = __builtin_amdgcn_fmed3f(g[e] * fast_sigmoid(g[e]) * up[e], -440.f, 440.f);
                    int w = 0; w = __builtin_amdgcn_cvt_pk_fp8_f32(h[0], h[1], w, false); w = __builtin_amdgcn_cvt_pk_fp8_f32(h[2], h[3], w, true);
                    *(int*)(rowp + bj * 64) = w; } }
    }
};
struct EpiDown {
    static constexpr bool PERM = true, AFTER_DRAIN = false, GATHER = false, FP8 = true;
    bf16_t* y2; const int* slot_tok; const float* slot_w;
    __device__ __forceinline__ void operator()(const f32x4 (&acc)[2][2][4][2], const Unit& u, int wr, int wc, int fr, int fq) const {
        const int row0 = u.pm * BM + wr * 64 + fr, col0 = (u.pn & 3) * BM + wc * 32 + 8 * fq;
#pragma unroll
        for (int ai = 0; ai < 2; ++ai)
#pragma unroll
            for (int m = 0; m < 4; ++m) { const int row = row0 + ai * HALF + m * 16; const int st = slot_tok[row]; const float sw = slot_w[row] * 0.015625f;
                if (st >= 0) { bf16_t* rowp = y2 + (size_t)st * 1024 + col0;
#pragma unroll
                    for (int bj = 0; bj < 2; ++bj) { const f32x4 v0 = acc[ai][bj][m][0] * sw, v1 = acc[ai][bj][m][1] * sw;
                        u32x4 w; w.x = cvt_pk_bf16(v0[0], v0[1]); w.y = cvt_pk_bf16(v0[2], v0[3]); w.z = cvt_pk_bf16(v1[0], v1[1]); w.w = cvt_pk_bf16(v1[2], v1[3]);
                        *(u32x4*)(rowp + bj * HALF) = w; } } }
    }
};
struct MoeOrder {
    const int* meta; int G, c;
    __device__ __forceinline__ bool next(int i, Unit& u) const {
        const int per = G >> 3; const int idx = (G & 7) ? (i * G + c) : ((i * 8 + (c & 7)) * per + (c >> 3));
        const int nt = __builtin_amdgcn_readfirstlane(meta[0]); if (idx >= nt * 4) return false;
        const int pm = idx >> 2; u.pm = pm; u.pn = __builtin_amdgcn_readfirstlane(meta[64 + pm]) * 4 + (idx & 3); return true;
    }
    __device__ __forceinline__ void a_ready(const Unit&) const {}
    __device__ __forceinline__ void done(const Unit&) const {}
};
typedef int v4i_ __attribute__((ext_vector_type(4)));
typedef int v8i_ __attribute__((ext_vector_type(8)));
template <class Epi, class Sched, bool STAMP = false>
__device__ __forceinline__ void gemm_phase(PG8_LAS unsigned char* lds, const Gemm g, const Sched& S, const Epi& E, unsigned long long* stamps, int tid_in) {
    int tid_ = tid_in; asm volatile("" : "+v"(tid_));
    const int tid = tid_, wid = __builtin_amdgcn_readfirstlane(tid >> 6), lane = tid & 63, wr = wid >> 2, wc = wid & 3, fr = lane & 15, fq = lane >> 4;
    const int K = g.K, nt = K / BK;
    int ts_lo = 0, ts_hi = 0, nts = 0; const unsigned long long rt_entry = STAMP ? (unsigned long long)wall_clock64() : 0ull;
#define PG8_STAMP() do { if (STAMP && wid == 0 && nts < 64) { const unsigned long long _c = (unsigned long long)clock64(); \
        ts_lo = (lane == nts) ? (int)(unsigned)_c : ts_lo; ts_hi = (lane == nts) ? (int)(unsigned)(_c >> 32) : ts_hi; ++nts; } } while (0)
    PG8_STAMP();
    unsigned voffA[2], voffB[2];
#pragma unroll
    for (int i = 0; i < 2; ++i) { int R, C; stage_rc(tid * 16 + i * 8192, R, C); const int Rb = Epi::PERM ? ((R & ~31) + perm32(R & 31)) : R;
        voffA[i] = (unsigned)(R * K + C) * 2u; voffB[i] = (unsigned)(Rb * K + C) * 2u; }
    unsigned offAc[2][2], offAn[2][2];
    PG8_LAS unsigned char* gidx = lds + STAGE_BYTES + (unsigned)wid * 1024u;
#define PG8_IDX_DMA(par, pm_) do { int t2_ = tid; asm volatile("" : "+v"(t2_)); _Pragma("unroll") for (int i_ = 0; i_ < 2; ++i_) { int R_, C_; stage_rc(t2_ * 16 + i_ * 8192, R_, C_); (void)C_; \
        _Pragma("unroll") for (int h_ = 0; h_ < 2; ++h_) __builtin_amdgcn_global_load_lds((const unsigned*)(E.rowmap + (size_t)(pm_) * BM + h_ * HALF + R_), (PG8_LAS unsigned*)(gidx + (par) * 512 + (h_ * 2 + i_) * 256), 4, 0, 0); } } while (0)
#define PG8_IDX_READ(dst, par) do { int t2_ = tid; asm volatile("" : "+v"(t2_)); _Pragma("unroll") for (int i_ = 0; i_ < 2; ++i_) { int R_, C_; stage_rc(t2_ * 16 + i_ * 8192, R_, C_); (void)R_; \
        _Pragma("unroll") for (int h_ = 0; h_ < 2; ++h_) { int r_ = *(const PG8_LAS int*)(gidx + (par) * 512 + (h_ * 2 + i_) * 256 + (t2_ & 63) * 4); r_ = r_ < 0 ? 0 : (r_ >> E.rowshift); dst[h_][i_] = (unsigned)r_ * (unsigned)(K * 2) + (unsigned)C_ * 2u; } } } while (0)
    const size_t kstep = (size_t)(BK * 2);
    const size_t hstep = (size_t)HALF * K * 2;
    const size_t tstep = 2 * hstep;
    const unsigned ldsw = (unsigned)wid * 1024u;
    const int aoff = lds_byte(wr * 64 + fr, fq * 8), boff = lds_byte(wc * 32 + fr, fq * 8);
#define PG8_SA(b, h) (((b) * 2 + (h)) * HTB)
#define PG8_SB(b, h) ((4 + (b) * 2 + (h)) * HTB)
#define PG8_STAGE(bufoff, gbase, voff) do { _Pragma("unroll") for (int _i = 0; _i < 2; ++_i) \
        __builtin_amdgcn_global_load_lds((const unsigned*)((const char*)(gbase) + (voff)[_i]), (PG8_LAS unsigned*)(lds + (bufoff) + ldsw + _i * 8192), 16, 0, 0); } while (0)
#define PG8_STAGE_A(bufoff, kt_, h_, nx_) do { if constexpr (Epi::GATHER) { _Pragma("unroll") for (int _i = 0; _i < 2; ++_i) { const unsigned o_ = (nx_) ? offAn[h_][_i] : offAc[h_][_i]; \
            __builtin_amdgcn_global_load_lds((const unsigned*)((const char*)g.A + (size_t)(kt_) * kstep + o_), (PG8_LAS unsigned*)(lds + (bufoff) + ldsw + _i * 8192), 16, 0, 0); } } \
        else { PG8_STAGE(bufoff, ((nx_) ? nA : cA) + (size_t)(kt_) * kstep + (h_) * hstep, voffA); } } while (0)
#define PG8_LDA(dst, b, h) do { _Pragma("unroll") for (int m = 0; m < 4; ++m) _Pragma("unroll") for (int k = 0; k < 2; ++k) dst[m][k] = *(const PG8_LAS bf16x8*)(lds + PG8_SA(b, h) + aoff + m * 2048 + k * 1024); } while (0)
#define PG8_LDB(dst, b, h) do { _Pragma("unroll") for (int n = 0; n < 2; ++n) _Pragma("unroll") for (int k = 0; k < 2; ++k) dst[n][k] = *(const PG8_LAS bf16x8*)(lds + PG8_SB(b, h) + boff + n * 2048 + k * 1024); } while (0)
#define PG8_MMA(ai, bj, At, Bt) do { __builtin_amdgcn_s_setprio(1); \
        if constexpr (Epi::FP8) {   \
            _Pragma("unroll") for (int m = 0; m < 4; ++m) _Pragma("unroll") for (int n = 0; n < 2; ++n) \
                { const v8i_ b8_ = __builtin_shufflevector(__builtin_bit_cast(v4i_, Bt[n][0]), __builtin_bit_cast(v4i_, Bt[n][1]), 0, 1, 2, 3, 4, 5, 6, 7), \
                             a8_ = __builtin_shufflevector(__builtin_bit_cast(v4i_, At[m][0]), __builtin_bit_cast(v4i_, At[m][1]), 0, 1, 2, 3, 4, 5, 6, 7); \
                    \
                  asm volatile("v_mfma_f32_16x16x128_f8f6f4 %0, %1, %2, %0" : "+v"(acc[ai][bj][m][n]) : "v"(b8_), "v"(a8_)); } } \
        else { _Pragma("unroll") for (int m = 0; m < 4; ++m) _Pragma("unroll") for (int n = 0; n < 2; ++n) _Pragma("unroll") for (int k = 0; k < 2; ++k) \
            acc[ai][bj][m][n] = __builtin_amdgcn_mfma_f32_16x16x32_bf16(Bt[n][k], At[m][k], acc[ai][bj][m][n], 0, 0, 0); } \
        __builtin_amdgcn_s_setprio(0); } while (0)
#define PG8_WAIT_V(n) asm volatile("s_waitcnt vmcnt(" #n ")" ::: "memory")
#define PG8_WAIT_L(n) asm volatile("s_waitcnt lgkmcnt(" #n ")" ::: "memory")
#define PG8_BAR __builtin_amdgcn_s_barrier()
#define PG8_SCHED __builtin_amdgcn_sched_barrier(0)
    Unit cur, nxt; int ui = 0;
    if (!S.next(0, cur)) return;
    f32x4 acc[2][2][4][2];
    float zf_ = 0.f; asm volatile("" : "+v"(zf_));
#pragma unroll
    for (int a = 0; a < 2; ++a)
#pragma unroll
        for (int b = 0; b < 2; ++b)
#pragma unroll
            for (int m = 0; m < 4; ++m)
#pragma unroll
                for (int n = 0; n < 2; ++n) acc[a][b][m][n] = (f32x4){zf_, zf_, zf_, zf_};
    bf16x8 At[4][2], B0[2][2], B1[2][2];
    const char* cA = (const char*)g.A + (size_t)cur.pm * tstep; const char* cB = (const char*)g.Bt + (size_t)cur.pn * tstep;
    S.a_ready(cur);
    if constexpr (Epi::GATHER) { PG8_IDX_DMA(0, cur.pm); asm volatile("s_waitcnt vmcnt(0)" ::: "memory"); PG8_IDX_READ(offAc, 0); asm volatile("s_waitcnt lgkmcnt(0)" ::: "memory"); }
    const char* nA = cA;
    PG8_STAGE(PG8_SB(0, 0), cB, voffB); PG8_STAGE_A(PG8_SA(0, 0), 0, 0, false); PG8_STAGE(PG8_SB(0, 1), cB + hstep, voffB); PG8_STAGE_A(PG8_SA(0, 1), 0, 1, false);
    if (wr == 1) PG8_BAR;
    PG8_WAIT_V(4); PG8_BAR;
    PG8_STAGE(PG8_SB(1, 0), cB + kstep, voffB); PG8_STAGE_A(PG8_SA(1, 0), 1, 0, false); PG8_STAGE(PG8_SB(1, 1), cB + hstep + kstep, voffB);
    PG8_WAIT_V(6); PG8_BAR;
    PG8_STAMP();
    for (;;) {
        const bool has_next = S.next(ui + 1, nxt);
        nA = has_next ? (const char*)g.A + (size_t)nxt.pm * tstep : cA; const char* nB = has_next ? (const char*)g.Bt + (size_t)nxt.pn * tstep : cB;
        if constexpr (Epi::GATHER) { if (has_next) PG8_IDX_DMA((ui + 1) & 1, nxt.pm); }
#pragma unroll 1
        for (int t = 0; t < nt; t += 2) {
            const bool last = (t == nt - 2);
            const char* b2 = last ? nB : cB + (size_t)(t + 2) * kstep;
            const char* b3 = b2 + kstep;
            const int kt2 = last ? 0 : t + 2;
            if constexpr (Epi::GATHER) { if (last) { if (has_next) PG8_IDX_READ(offAn, (ui + 1) & 1); else { offAn[0][0] = offAc[0][0]; offAn[0][1] = offAc[0][1]; offAn[1][0] = offAc[1][0]; offAn[1][1] = offAc[1][1]; } } }
            if (last && has_next) S.a_ready(nxt);
            PG8_LDB(B0, 0, 0); PG8_SCHED; PG8_LDA(At, 0, 0); PG8_STAGE_A(PG8_SA(1, 1), t + 1, 1, false);
            PG8_WAIT_L(8); PG8_BAR; PG8_WAIT_L(0); PG8_MMA(0, 0, At, B0); PG8_BAR; PG8_SCHED;
            PG8_LDB(B1, 0, 1); PG8_STAGE(PG8_SB(0, 0), b2, voffB);
            PG8_BAR; PG8_WAIT_L(0); PG8_MMA(0, 1, At, B1); PG8_BAR;
            PG8_LDA(At, 0, 1); PG8_STAGE_A(PG8_SA(0, 0), kt2, 0, last);
            PG8_BAR; PG8_WAIT_L(0); PG8_MMA(1, 0, At, B0); PG8_BAR; PG8_SCHED;
            PG8_STAGE(PG8_SB(0, 1), b2 + hstep, voffB);
            PG8_WAIT_V(6); PG8_BAR; PG8_MMA(1, 1, At, B1); PG8_BAR;
            PG8_LDB(B0, 1, 0); PG8_SCHED; PG8_LDA(At, 1, 0); PG8_STAGE_A(PG8_SA(0, 1), kt2, 1, last);
            PG8_WAIT_L(8); PG8_BAR; PG8_WAIT_L(0); PG8_MMA(0, 0, At, B0); PG8_BAR; PG8_SCHED;
            PG8_LDB(B1, 1, 1); PG8_STAGE(PG8_SB(1, 0), b3, voffB);
            PG8_BAR; PG8_WAIT_L(0); PG8_MMA(0, 1, At, B1); PG8_BAR;
            PG8_LDA(At, 1, 1); PG8_STAGE_A(PG8_SA(1, 0), kt2 + 1, 0, last);
            PG8_BAR; PG8_WAIT_L(0); PG8_MMA(1, 0, At, B0); PG8_BAR; PG8_SCHED;
            PG8_STAGE(PG8_SB(1, 1), b3 + hstep, voffB);
            PG8_WAIT_V(6); PG8_BAR; PG8_MMA(1, 1, At, B1); PG8_BAR;
        }
        PG8_STAMP();
        if constexpr (Epi::FP8) asm volatile("s_nop 15\n\ts_nop 15" ::: "memory");
        if constexpr (!Epi::AFTER_DRAIN) { E(acc, cur, wr, wc, fr, fq); S.done(cur); }
        PG8_STAMP();
        if (!has_next) break;
#pragma unroll
        for (int a = 0; a < 2; ++a)
#pragma unroll
            for (int b = 0; b < 2; ++b)
#pragma unroll
                for (int m = 0; m < 4; ++m)
#pragma unroll
                    for (int n = 0; n < 2; ++n) acc[a][b][m][n] = (f32x4){zf_, zf_, zf_, zf_};
        cur = nxt; cA = nA; cB = nB; ++ui;
        if constexpr (Epi::GATHER) { offAc[0][0] = offAn[0][0]; offAc[0][1] = offAn[0][1]; offAc[1][0] = offAn[1][0]; offAc[1][1] = offAn[1][1]; }
    }
    PG8_WAIT_V(0);
    if (wr == 0) PG8_BAR;
    PG8_BAR;
    if constexpr (Epi::AFTER_DRAIN) { E.fused(acc, cur, wr, wc, fr, fq, lds, wid, lane); S.done(cur); }
    PG8_STAMP();
    if (STAMP && wid == 0) { stamps[lane] = lane < nts ? (((unsigned long long)(unsigned)ts_hi << 32) | (unsigned)ts_lo) : 0ull;
        if (lane == 62) stamps[62] = rt_entry; if (lane == 63) stamps[63] = (unsigned long long)wall_clock64(); }
#undef PG8_STAMP
#undef PG8_SA
#undef PG8_SB
#undef PG8_STAGE
#undef PG8_STAGE_A
#undef PG8_IDX_DMA
#undef PG8_IDX_READ
#undef PG8_LDA
#undef PG8_LDB
#undef PG8_MMA
#undef PG8_WAIT_V
#undef PG8_WAIT_L
#undef PG8_BAR
#undef PG8_SCHED
}
}

#ifndef SELFCHECK
#define SELFCHECK 0
#endif
#ifndef PROBE_GDN_VAR
#define PROBE_GDN_VAR 0
#endif
#ifndef PROBE_SCAN_VAR
#define PROBE_SCAN_VAR 0
#endif
#ifndef PROBE_ATTN_VAR
#define PROBE_ATTN_VAR 0
#endif
constexpr int NB = 8, SEQ = 4096, DM = 1024, NL = 4, T = NB * SEQ;
constexpr int DIN = 2848, DINP = 3072, HLD = pg8::HLD;
constexpr int NEXP = 32, FF = 512, NTILE_MAX = 288;
constexpr float LN_EPS = 1e-5f;
constexpr float DN_ALPHA = 1.6817928305074290f;
constexpr int NWAVES = 8, NTHR = 512;

constexpr size_t MiB = 1u << 20, KiB = 1u << 10;
constexpr size_t WS_CTL = 0, CTL_ZERO_BYTES = 128 * KiB;
constexpr size_t WS_ROPE = 1 * MiB;
constexpr size_t WS_META = 1 * MiB + 512 * KiB;
constexpr size_t WS_GL = WS_META + 16 * KiB;
constexpr size_t WS_WL = 2 * MiB;
constexpr size_t WL_WIN = 0, WL_WOUT = 6 * MiB, WL_WGU = 8 * MiB, WL_WDN = 72 * MiB, WL_W1 = 104 * MiB, WL_W2 = 105 * MiB, WL_BIAS1 = 105 * MiB + 64 * KiB, WL_WR = 105 * MiB + 128 * KiB;
constexpr size_t WS_XB = 108 * MiB;
constexpr size_t WS_X1 = 172 * MiB;
constexpr size_t WS_H = 300 * MiB;
constexpr size_t WS_SIDE = 476 * MiB;
constexpr size_t WS_Y = 480 * MiB;
constexpr size_t WS_GPREP = 544 * MiB;
constexpr size_t WS_Y2 = 672 * MiB;
constexpr size_t WS_HID = 800 * MiB;
constexpr size_t WS_KC = 872 * MiB, WS_VC = WS_KC + 512 * KiB;
constexpr size_t WS_SLOT = 873 * MiB;
constexpr size_t SL_TOK = 0, SL_W = 512 * KiB, SL_RE = 1024 * KiB, SL_RP = 1280 * KiB, SL_RW = 1536 * KiB;
constexpr size_t WS_END = 876 * MiB;
constexpr int GCH = 65536;
constexpr int GC_UT = 0, GC_W = 8192, GC_QK = 16384, GC_QD = 24576, GC_KDT = 32768, GC_ZT = 40960, GC_SS = 49152, GC_VB = 57344;
constexpr int CW_TMO = 0;
constexpr int CW_BAR = 4096;
constexpr int CW_CNT = 8192;
constexpr int CW_QUEUE = 12288;
static_assert((CW_QUEUE + NL * 64) * 4 <= (int)CTL_ZERO_BYTES, "CTL words inside the memset region");

constexpr int SCR_BYTES = 159744;
constexpr int MISC_OFF = SCR_BYTES;
constexpr int LDS_BYTES = 163840;

#define GAS __attribute__((address_space(1)))
#define LAS __attribute__((address_space(3)))
typedef unsigned short bf16;
typedef float f32x4 __attribute__((ext_vector_type(4)));
typedef float f32x2 __attribute__((ext_vector_type(2)));
typedef float f32x16 __attribute__((ext_vector_type(16)));
typedef short bf16x8 __attribute__((ext_vector_type(8)));
typedef short s16x4 __attribute__((ext_vector_type(4)));
typedef unsigned u32x4 __attribute__((ext_vector_type(4)));
typedef unsigned u32x2 __attribute__((ext_vector_type(2)));
#define LDS_WAIT() asm volatile("s_waitcnt lgkmcnt(0)" ::: "memory")
#define VM_WAIT() asm volatile("s_waitcnt vmcnt(0)" ::: "memory")
#define SBAR() __builtin_amdgcn_sched_barrier(0)
__device__ __forceinline__ float bf2f(unsigned b) { return __uint_as_float(b << 16); }
__device__ __forceinline__ unsigned f2bf(float f) { unsigned u = __float_as_uint(f); return (u + 0x7fffu + ((u >> 16) & 1u)) >> 16; }
__device__ __forceinline__ unsigned pk2(float lo, float hi) { return pg8::cvt_pk_bf16(lo, hi); }
__device__ __forceinline__ float row16_sum(float x) {
    x += __int_as_float(__builtin_amdgcn_update_dpp(0, __float_as_int(x), 0xB1, 0xf, 0xf, true));
    x += __int_as_float(__builtin_amdgcn_update_dpp(0, __float_as_int(x), 0x4E, 0xf, 0xf, true));
    x += __int_as_float(__builtin_amdgcn_update_dpp(0, __float_as_int(x), 0x141, 0xf, 0xf, true));
    x += __int_as_float(__builtin_amdgcn_update_dpp(0, __float_as_int(x), 0x140, 0xf, 0xf, true));
    return x;
}
__device__ __forceinline__ float wave_sum(float v) {
    const int r = __float_as_int(row16_sum(v));
    return (__int_as_float(__builtin_amdgcn_readlane(r, 0)) + __int_as_float(__builtin_amdgcn_readlane(r, 16))) + (__int_as_float(__builtin_amdgcn_readlane(r, 32)) + __int_as_float(__builtin_amdgcn_readlane(r, 48)));
}
__device__ __forceinline__ float fsigmoid(float x) { return pg8::fast_sigmoid(x); }
__device__ __forceinline__ float fsilu(float x) { return x * pg8::fast_sigmoid(x); }
__device__ __forceinline__ float fexp2(float x) { return __builtin_amdgcn_exp2f(x); }

#define XB_TMO      128
#define XB_XCNT(j)  (256  + 64 * (j))
#define XB_XSUB(j)  (1280 + 64 * (j))
#define XB_XGEN(j)  (2304 + 64 * (j))
#define XB_TOP      3328
#define XB_TOPGEN   3392
#define XCD_BAR_WORDS 3456
#define XB_SPIN_CAP (1u << 18)
#define LAS __attribute__((address_space(3)))

__device__ __forceinline__ unsigned xb_ld(unsigned* p)              { return __hip_atomic_load(p, __ATOMIC_RELAXED, __HIP_MEMORY_SCOPE_AGENT); }
__device__ __forceinline__ unsigned xb_add(unsigned* p, unsigned v) { return __hip_atomic_fetch_add(p, v, __ATOMIC_RELAXED, __HIP_MEMORY_SCOPE_AGENT); }
__device__ __forceinline__ unsigned xb_xcc_id() { return (unsigned)__builtin_amdgcn_s_getreg((3 << 11) | 20) & 0xFu; }
#define XB_SPIN(cond, bar) do { unsigned _sp = 0; while (cond) { __builtin_amdgcn_s_sleep(1); \
    if ((++_sp & 255u) == 0u) { if (xb_ld(&(bar)[XB_TMO])) break; if (_sp > XB_SPIN_CAP) { atomicAdd(&(bar)[XB_TMO], 1u); break; } } } } while (0)

struct XcdBarrier {
    unsigned* bar; unsigned x;
    volatile LAS unsigned* st;
};

__device__ __forceinline__ XcdBarrier xcd_barrier_post(unsigned* bar, volatile LAS unsigned* st) {
    XcdBarrier b; b.bar = bar; b.x = xb_xcc_id(); b.st = st;
    if (threadIdx.x == 0) (void)xb_add(&bar[XB_XCNT(b.x)], 1u);
    return b;
}
__device__ __forceinline__ void xcd_barrier_complete(unsigned* bar, unsigned x, unsigned& nloc, unsigned& nx) {
    const unsigned G = gridDim.x * gridDim.y * gridDim.z;
    unsigned sum, cnt, mine, sp = 0u;
    for (;;) {
        sum = 0u; cnt = 0u; mine = 0u;
#pragma unroll
        for (unsigned j = 0; j < 16; ++j) { const unsigned c = xb_ld(&bar[XB_XCNT(j)]); sum += c; cnt += (c > 0u) ? 1u : 0u; mine = (j == x) ? c : mine; }
        if (sum == G) break;
        __builtin_amdgcn_s_sleep(1);
        if ((++sp & 255u) == 0u) { if (xb_ld(&bar[XB_TMO])) break; if (sp > XB_SPIN_CAP) { atomicAdd(&bar[XB_TMO], 1u); break; } }
    }
    nloc = mine > 0u ? mine : 1u; nx = cnt > 0u ? cnt : 1u;
}

__device__ __forceinline__ void xcd_barrier(const XcdBarrier& b) {
    asm volatile("s_waitcnt vmcnt(0)" ::: "memory");
    __syncthreads();
    if (threadIdx.x == 0) {
        unsigned* bar = b.bar;
        __builtin_amdgcn_s_waitcnt(0);
        unsigned nloc = b.st[0], nx = b.st[1];
        if (nloc == 0u) { xcd_barrier_complete(bar, b.x, nloc, nx); b.st[0] = nloc; b.st[1] = nx; }
        const unsigned old = xb_add(&bar[XB_XSUB(b.x)], 1u);
        const unsigned gen = old / nloc;
        if (old + 1u == (gen + 1u) * nloc) {
            __builtin_amdgcn_fence(__ATOMIC_RELEASE, "agent");
            asm volatile("s_waitcnt vmcnt(0)" ::: "memory");
            const unsigned og = xb_add(&bar[XB_TOP], 1u);
            const unsigned tg = og / nx;
            if (og + 1u == (tg + 1u) * nx) xb_add(&bar[XB_TOPGEN], 1u);
            else XB_SPIN(xb_ld(&bar[XB_TOPGEN]) == tg, bar);
            __builtin_amdgcn_fence(__ATOMIC_ACQUIRE, "agent");
            xb_add(&bar[XB_XGEN(b.x)], 1u);
            asm volatile("s_waitcnt vmcnt(0)" ::: "memory");
        } else {
            XB_SPIN(xb_ld(&bar[XB_XGEN(b.x)]) == gen, bar);
            __builtin_amdgcn_fence(__ATOMIC_ACQUIRE, "agent");
            asm volatile("s_waitcnt vmcnt(0)" ::: "memory");
        }
    }
    __syncthreads();
}

struct Args { const float* in[25]; float* out; unsigned char* ws; int ph_lo, ph_hi; };
typedef const __attribute__((address_space(4))) Args* ArgsP;
__device__ __forceinline__ ArgsP args_here() { ArgsP p = (ArgsP)__builtin_amdgcn_kernarg_segment_ptr(); asm volatile("" : "+s"(p)); return p; }
struct Frame { LAS unsigned char* lds; volatile LAS unsigned* MISC; unsigned* ctl; int tid, lane, wave, G, bid; };

template <class Src>
__device__ __forceinline__ void tr_item(const Src src, int K, int N, bf16* WT, LAS float* scr, int item, int lane) {
    const int nblk = N >> 5, kb = item / nblk, nb = item - kb * nblk, k0 = kb << 6, n0 = nb << 5;
    float tv[32];
#pragma unroll
    for (int i = 0; i < 32; ++i) tv[i] = src(k0 + 2 * i + (lane >> 5), n0 + (lane & 31));
#pragma unroll
    for (int i = 0; i < 32; ++i) scr[(2 * i + (lane >> 5)) * 33 + (lane & 31)] = tv[i];
    LDS_WAIT();
    const int c = lane & 7;
#pragma unroll
    for (int j = 0; j < 4; ++j) { const int n = (lane >> 3) + 8 * j; const LAS float* s = scr + (8 * c) * 33 + n;
        u32x4 o; o.x = pk2(s[0], s[33]); o.y = pk2(s[66], s[99]); o.z = pk2(s[132], s[165]); o.w = pk2(s[198], s[231]);
        *(u32x4*)(WT + (size_t)(n0 + n) * K + k0 + 8 * c) = o; }
    LDS_WAIT();
}
template <class Src>
__device__ __forceinline__ void tr_item_fp8(const Src src, int K, int N, unsigned char* WT, float mul, LAS float* scr, int item, int lane) {
    const int nblk = N >> 5, kb = item / nblk, nb = item - kb * nblk, k0 = kb << 6, n0 = nb << 5;
    float tv[32];
#pragma unroll
    for (int i = 0; i < 32; ++i) tv[i] = src(k0 + 2 * i + (lane >> 5), n0 + (lane & 31));
#pragma unroll
    for (int i = 0; i < 32; ++i) scr[(2 * i + (lane >> 5)) * 33 + (lane & 31)] = tv[i];
    LDS_WAIT();
    const int n = lane >> 1, kh = (lane & 1) * 32; const LAS float* sp = scr + kh * 33 + n;
#pragma unroll
    for (int q = 0; q < 2; ++q) { u32x4 o;
#pragma unroll
        for (int d = 0; d < 4; ++d) { const LAS float* s4 = sp + (16 * q + 4 * d) * 33; int w = 0;
            w = __builtin_amdgcn_cvt_pk_fp8_f32(s4[0] * mul, s4[33] * mul, w, false); w = __builtin_amdgcn_cvt_pk_fp8_f32(s4[66] * mul, s4[99] * mul, w, true); o[d] = (unsigned)w; }
        *(u32x4*)(WT + (size_t)(n0 + n) * K + k0 + kh + 16 * q) = o; }
    LDS_WAIT();
}
struct SrcPlain { const float* p; int ld; __device__ __forceinline__ float operator()(int k, int n) const { return p[(size_t)k * ld + n]; } };
struct SrcWin { const float* p;
    __device__ __forceinline__ float operator()(int k, int n) const {
        int c;
        if (n < 1280) c = n; else if (n < 2048) c = n + 24; else if (n < 2304) c = n + 24; else if (n < 2816) c = n + 32;
        else if (n < 2840) c = n - 2816 + 1280; else if (n < 2844) c = n - 2840 + 2328; else if (n < 2848) c = n - 2844 + 2332; else return 0.f;
        return p[(size_t)k * DIN + c]; } };
struct SrcGU { const float* wg; const float* wu;
    __device__ __forceinline__ float operator()(int k, int n) const { const int q = n >> 3, r = n & 7; const ptrdiff_t d = (r < 4) ? (ptrdiff_t)0 : (wu - wg); return wg[d + (ptrdiff_t)k * FF + 4 * q + (r & 3)]; } };

__device__ __forceinline__ void phase_weights(const Frame& F, ArgsP a, int l) {
    unsigned char* wl = a->ws + WS_WL;
    LAS float* scr = (LAS float*)(F.lds + F.wave * 16384);
    const int gw = F.bid * NWAVES + F.wave, NGW = F.G * NWAVES;
    constexpr int I_WIN = 16 * 96, I_WOUT = 16 * 32, I_GU1 = 16 * 32, I_GU = NEXP * I_GU1, I_DN1 = 8 * 32, I_DN = NEXP * I_DN1, I_W1 = 2 * 32 * 4, I_W2 = 2 * 2 * 2, I_WR = 36, I_B1 = 256;
    constexpr int NITEMS = I_WIN + I_WOUT + I_GU + I_DN + I_W1 + I_W2 + I_WR + I_B1;
    for (int it = gw; it < NITEMS; it += NGW) {
        int r = it;
        if (r < I_GU) { const int e = r / I_GU1; SrcGU s{a->in[22] + ((size_t)l * NEXP + e) * DM * FF, a->in[23] + ((size_t)l * NEXP + e) * DM * FF};
            tr_item_fp8(s, DM, 1024, wl + WL_WGU + (size_t)e * 1024 * DM, 32.f, scr, r - e * I_GU1, F.lane); continue; } r -= I_GU;
        if (r < I_DN) { const int e = r / I_DN1; SrcPlain s{a->in[24] + ((size_t)l * NEXP + e) * FF * DM, DM};
            tr_item_fp8(s, FF, DM, wl + WL_WDN + (size_t)e * DM * FF, 64.f, scr, r - e * I_DN1, F.lane); continue; } r -= I_DN;
        if (r < I_WIN) { SrcWin s{a->in[1] + (size_t)l * DM * DIN}; tr_item(s, DM, DINP, (bf16*)(wl + WL_WIN), scr, r, F.lane); continue; } r -= I_WIN;
        if (r < I_WOUT) { SrcPlain s{a->in[2] + (size_t)l * DM * DM, DM}; tr_item(s, DM, DM, (bf16*)(wl + WL_WOUT), scr, r, F.lane); continue; } r -= I_WOUT;
        if (r < I_W1) { const int kv = r / 128; SrcPlain s{a->in[4] + ((size_t)l * 2 + kv) * 2048 * 128, 128};
            tr_item(s, 2048, 128, (bf16*)(wl + WL_W1) + (size_t)kv * 128 * 2048, scr, r - kv * 128, F.lane); continue; } r -= I_W1;
        if (r < I_W2) { const int kv = r / 4; SrcPlain s{a->in[5] + ((size_t)l * 2 + kv) * 128 * 64, 64};
            tr_item(s, 128, 64, (bf16*)(wl + WL_W2) + (size_t)kv * 64 * 128, scr, r - kv * 4, F.lane); continue; } r -= I_W2;
        if (r < I_WR) {
            float* wr = (float*)(wl + WL_WR) + (size_t)r * DM;
            for (int k = F.lane; k < DM; k += 64) wr[k] = (r < 4) ? a->in[18][((size_t)l * DM + k) * 4 + r] : a->in[20][((size_t)l * DM + k) * NEXP + (r - 4)];
            continue; } r -= I_WR;
        {
            const int kv = r >> 7, n = r & 127; const float* pe = a->in[3] + ((size_t)l * 2 + kv) * 2048; const float* w1 = a->in[4] + ((size_t)l * 2 + kv) * 2048 * 128;
            float s = 0.f; for (int k = F.lane; k < 2048; k += 64) s += pe[k] * w1[(size_t)k * 128 + n];
            s = wave_sum(s); if (F.lane == 0) ((float*)(wl + WL_BIAS1))[r] = s;
        }
    }
}

__device__ __forceinline__ void phase_prologue(const Frame& F, ArgsP a) {
    const size_t gt = (size_t)F.bid * NTHR + F.tid, NGT = (size_t)F.G * NTHR;
    float* rope = (float*)(a->ws + WS_ROPE);
    for (size_t i = gt; i < (size_t)SEQ * 8; i += NGT) { const int t = (int)(i >> 3), f = (int)(i & 7);
        const float invt[8] = {1.0f, 0.19392274f, 0.03760603f, 0.0072926646f, 0.0014142136f, 0.0002742482f, 5.3182957e-05f, 1.0313385e-05f};
        float inv = invt[0];
#pragma unroll
        for (int q = 1; q < 8; ++q) inv = (f == q) ? invt[q] : inv;
        const float ang = (float)t * inv;
        const double rev = (double)ang * 0.15915494309189535; const float fr = (float)(rev - __builtin_rint(rev));
        rope[t * 16 + f] = __builtin_amdgcn_cosf(fr); rope[t * 16 + 8 + f] = __builtin_amdgcn_sinf(fr); }
    const f32x4* x4 = (const f32x4*)a->in[0]; u32x4* xb = (u32x4*)(a->ws + WS_XB);
    for (size_t i = gt; i < (size_t)T * DM / 8; i += NGT) { const f32x4 v0 = x4[2 * i], v1 = x4[2 * i + 1];
        u32x4 w; w.x = pk2(v0[0], v0[1]); w.y = pk2(v0[2], v0[3]); w.z = pk2(v1[0], v1[1]); w.w = pk2(v1[2], v1[3]); xb[i] = w; }
}

template <bool DRY>
__device__ __forceinline__ void phase_ln1_router(const Frame& F, ArgsP a, int l) {
    float* X1 = (float*)(a->ws + WS_X1); bf16* XB = (bf16*)(a->ws + WS_XB); unsigned char* XB8 = a->ws + WS_H;
    const float* WR = (const float*)(a->ws + WS_WL + WL_WR);
    const float* lw = a->in[14] + (size_t)l * DM; const float* lb = a->in[15] + (size_t)l * DM;
    const float* bg = a->in[19] + l * 4; const float* be = a->in[21] + l * NEXP;
    int* route_e = (int*)(a->ws + WS_SLOT + SL_RE); int* route_p = (int*)(a->ws + WS_SLOT + SL_RP); float* route_w = (float*)(a->ws + WS_SLOT + SL_RW);
    unsigned* cnt = F.ctl + CW_CNT + (DRY ? l + 4 : l) * 512;
    const int gw = F.bid * NWAVES + F.wave, NGW = F.G * NWAVES, lane = F.lane;
    LAS float* wgl = (LAS float*)F.lds;
    for (int i = F.tid; i < 4 * DM; i += NTHR) wgl[i] = WR[i];
    __syncthreads();
    const float bg0 = bg[0], bg1 = bg[1], bg2 = bg[2], bg3 = bg[3];
    for (int tg = gw; tg < T / 4; tg += NGW) {
        f32x4 v[4][4];
#pragma unroll
        for (int tk = 0; tk < 4; ++tk) { const f32x4* row = (const f32x4*)(X1 + (size_t)(4 * tg + tk) * DM) + lane;
#pragma unroll
            for (int j = 0; j < 4; ++j) v[tk][j] = row[64 * j]; }
#pragma unroll
        for (int tk = 0; tk < 4; ++tk) {
            float s = 0.f;
#pragma unroll
            for (int j = 0; j < 4; ++j) s += (v[tk][j][0] + v[tk][j][1]) + (v[tk][j][2] + v[tk][j][3]);
            const float mean = wave_sum(s) * (1.f / DM); float q = 0.f;
#pragma unroll
            for (int j = 0; j < 4; ++j) { v[tk][j] = v[tk][j] - mean; q += (v[tk][j][0] * v[tk][j][0] + v[tk][j][1] * v[tk][j][1]) + (v[tk][j][2] * v[tk][j][2] + v[tk][j][3] * v[tk][j][3]); }
            const float rstd = 1.f / sqrtf(wave_sum(q) * (1.f / DM) + LN_EPS);
            u32x2* brow = (u32x2*)(XB + (size_t)(4 * tg + tk) * DM) + lane;
#pragma unroll
            for (int j = 0; j < 4; ++j) { const f32x4 w4 = ((const f32x4*)lw)[lane + 64 * j], b4 = ((const f32x4*)lb)[lane + 64 * j];
                v[tk][j] = v[tk][j] * rstd * w4 + b4;
                u32x2 w; w.x = pk2(v[tk][j][0], v[tk][j][1]); w.y = pk2(v[tk][j][2], v[tk][j][3]); if (!DRY) brow[64 * j] = w;
                int w8 = 0; w8 = __builtin_amdgcn_cvt_pk_fp8_f32(v[tk][j][0], v[tk][j][1], w8, false); w8 = __builtin_amdgcn_cvt_pk_fp8_f32(v[tk][j][2], v[tk][j][3], w8, true);
                if (!DRY) ((int*)(XB8 + (size_t)(4 * tg + tk) * DM))[lane + 64 * j] = w8; }
        }
        float glg[4][4];
#pragma unroll
        for (int j = 0; j < 4; ++j) { const LAS f32x4* wr = (const LAS f32x4*)(wgl + j * DM) + lane; const f32x4 w0 = wr[0], w1 = wr[64], w2 = wr[128], w3 = wr[192];
#pragma unroll
            for (int tk = 0; tk < 4; ++tk) { f32x4 p = v[tk][0] * w0; p = p + v[tk][1] * w1; p = p + v[tk][2] * w2; p = p + v[tk][3] * w3; glg[tk][j] = wave_sum((p[0] + p[1]) + (p[2] + p[3])); } }
        int my_e = 0; float my_w = 0.f;
#pragma unroll
        for (int tk = 0; tk < 4; ++tk) {
            const float g0 = glg[tk][0] + bg0, g1 = glg[tk][1] + bg1, g2 = glg[tk][2] + bg2, g3 = glg[tk][3] + bg3;
            int gi = 0; float gm = g0; if (g1 > gm) { gm = g1; gi = 1; } if (g2 > gm) { gm = g2; gi = 2; } if (g3 > gm) { gm = g3; gi = 3; }
            gi = __builtin_amdgcn_readfirstlane(gi);
            const float g_w = 1.f / (__expf(g0 - gm) + __expf(g1 - gm) + __expf(g2 - gm) + __expf(g3 - gm));
            const float* wbase = WR + (size_t)(4 + gi * 8) * DM; float ev[8];
#pragma unroll
            for (int i4 = 0; i4 < 2; ++i4) { f32x4 w[4][4];
#pragma unroll
                for (int i = 0; i < 4; ++i) { const f32x4* wr = (const f32x4*)(wbase + (size_t)(4 * i4 + i) * DM) + lane; w[i][0] = wr[0]; w[i][1] = wr[64]; w[i][2] = wr[128]; w[i][3] = wr[192]; }
#pragma unroll
                for (int i = 0; i < 4; ++i) { f32x4 p = v[tk][0] * w[i][0]; p = p + v[tk][1] * w[i][1]; p = p + v[tk][2] * w[i][2]; p = p + v[tk][3] * w[i][3];
                    ev[4 * i4 + i] = wave_sum((p[0] + p[1]) + (p[2] + p[3])) + be[gi * 8 + 4 * i4 + i]; } }
            int i1 = 0; float v1 = ev[0];
#pragma unroll
            for (int i = 1; i < 8; ++i) if (ev[i] > v1) { v1 = ev[i]; i1 = i; }
            int i2 = -1; float v2 = -3.0e38f;
#pragma unroll
            for (int i = 0; i < 8; ++i) if (i != i1 && ev[i] > v2) { v2 = ev[i]; i2 = i; }
            const float e2 = __expf(v2 - v1), w1 = g_w / (1.f + e2), w2 = g_w - w1;
            if (lane == 2 * tk) { my_e = gi * 8 + i1; my_w = w1; }
            if (lane == 2 * tk + 1) { my_e = gi * 8 + i2; my_w = w2; }
        }
        if (lane < 8) {
            const unsigned pos = __hip_atomic_fetch_add(cnt + my_e * 16, 1u, __ATOMIC_RELAXED, __HIP_MEMORY_SCOPE_AGENT);
            const size_t si = (size_t)tg * 8 + lane; if (!DRY) { route_e[si] = my_e; route_p[si] = (int)pos; route_w[si] = my_w; }
        }
    }
    __syncthreads();
}

__device__ __forceinline__ void phase_gather(const Frame& F, ArgsP a, int l) {
    LAS int* pstart = (LAS int*)F.lds;
    unsigned* cnt = F.ctl + CW_CNT + l * 512;
    int* meta = (int*)(a->ws + WS_META) + l * 512;
    int* slot_tok = (int*)(a->ws + WS_SLOT + SL_TOK); float* slot_w = (float*)(a->ws + WS_SLOT + SL_W);
    const int* route_e = (const int*)(a->ws + WS_SLOT + SL_RE); const int* route_p = (const int*)(a->ws + WS_SLOT + SL_RP); const float* route_w = (const float*)(a->ws + WS_SLOT + SL_RW);
    if (F.tid < 64) {
        const int c = F.tid < 32 ? (int)__hip_atomic_load(cnt + F.tid * 16, __ATOMIC_RELAXED, __HIP_MEMORY_SCOPE_AGENT) : 0;
        const int pad = (c + 255) & ~255; int inc = pad;
#pragma unroll
        for (int o = 1; o < 64; o <<= 1) { const int t = __shfl_up(inc, o); if (F.lane >= o) inc += t; }
        const int st = inc - pad;
        if (F.tid < 32) { pstart[F.tid] = st;
            if (F.bid == 0) { for (int t = st >> 8; t < (st + pad) >> 8; ++t) meta[64 + t] = F.tid; if (F.tid == 31) meta[0] = (st + pad) >> 8; }
            if ((F.tid % F.G) == F.bid) for (int r = st + c; r < st + pad; ++r) { slot_tok[r] = -1; slot_w[r] = 0.f; }
        }
    }
    __syncthreads();
    for (int s = F.bid * NTHR + F.tid; s < T * 2; s += F.G * NTHR) {
        const int dest = pstart[route_e[s]] + route_p[s]; slot_tok[dest] = s; slot_w[dest] = route_w[s];
    }
    __syncthreads();
}

__device__ __forceinline__ void phase_ln2(const Frame& F, ArgsP a, int l) {
    const bf16* Y2 = (const bf16*)(a->ws + WS_Y2); bf16* XB = (bf16*)(a->ws + WS_XB); float* out = a->out;
    const float* lw = a->in[16] + (size_t)l * DM; const float* lb = a->in[17] + (size_t)l * DM;
    const int gw = F.bid * NWAVES + F.wave, NGW = F.G * NWAVES, lane = F.lane; const bool last = (l == NL - 1);
    for (int t = gw; t < T; t += NGW) {
        const u32x2* xr = (const u32x2*)(XB + (size_t)t * DM) + lane; const u32x2* ya = (const u32x2*)(Y2 + (size_t)(2 * t) * DM) + lane; const u32x2* yb = (const u32x2*)(Y2 + (size_t)(2 * t + 1) * DM) + lane;
        f32x4 v[4]; float s = 0.f;
#pragma unroll
        for (int j = 0; j < 4; ++j) { const u32x2 x = xr[64 * j], p = ya[64 * j], q = yb[64 * j];
            v[j][0] = bf2f(x.x & 0xffffu) * DN_ALPHA + (bf2f(p.x & 0xffffu) + bf2f(q.x & 0xffffu)); v[j][1] = bf2f(x.x >> 16) * DN_ALPHA + (bf2f(p.x >> 16) + bf2f(q.x >> 16));
            v[j][2] = bf2f(x.y & 0xffffu) * DN_ALPHA + (bf2f(p.y & 0xffffu) + bf2f(q.y & 0xffffu)); v[j][3] = bf2f(x.y >> 16) * DN_ALPHA + (bf2f(p.y >> 16) + bf2f(q.y >> 16));
            s += (v[j][0] + v[j][1]) + (v[j][2] + v[j][3]); }
        const float mean = wave_sum(s) * (1.f / DM); float q2 = 0.f;
#pragma unroll
        for (int j = 0; j < 4; ++j) { v[j] = v[j] - mean; q2 += (v[j][0] * v[j][0] + v[j][1] * v[j][1]) + (v[j][2] * v[j][2] + v[j][3] * v[j][3]); }
        const float rstd = 1.f / sqrtf(wave_sum(q2) * (1.f / DM) + LN_EPS);
        f32x4* orow = (f32x4*)(out + (size_t)t * DM) + lane; u32x2* brow = (u32x2*)(XB + (size_t)t * DM) + lane;
#pragma unroll
        for (int j = 0; j < 4; ++j) { const f32x4 w4 = ((const f32x4*)lw)[lane + 64 * j], b4 = ((const f32x4*)lb)[lane + 64 * j];
            const f32x4 o = v[j] * rstd * w4 + b4; if (last) orow[64 * j] = o; u32x2 w; w.x = pk2(o[0], o[1]); w.y = pk2(o[2], o[3]); brow[64 * j] = w; }
    }
}

__device__ __forceinline__ int tsw(int row, int col) { return row * 128 + ((((col >> 3) ^ (row >> 1)) & 7) << 4) + ((col & 7) << 1); }
__device__ __forceinline__ f32x4 mfma16(bf16x8 a, bf16x8 b, f32x4 c) { return __builtin_amdgcn_mfma_f32_16x16x32_bf16(a, b, c, 0, 0, 0); }
__device__ __forceinline__ f32x16 mfma32(bf16x8 a, bf16x8 b, f32x16 c) { return __builtin_amdgcn_mfma_f32_32x32x16_bf16(a, b, c, 0, 0, 0); }
__device__ __forceinline__ bf16x8 as_bf16x8(u32x4 v) { return __builtin_bit_cast(bf16x8, v); }

__device__ __forceinline__ void conformer_item(const Frame& F, ArgsP a, int l, int it) {
    const int b = it >> 6, s0 = (it & 63) * 64; const size_t tok0 = (size_t)b * SEQ + s0;
    const bf16* H = (const bf16*)(a->ws + WS_H); bf16* Y = (bf16*)(a->ws + WS_Y);
    LAS bf16* ut = (LAS bf16*)F.lds;
    LAS float* co = (LAS float*)(F.lds + 49152);
    for (int idx = F.tid; idx < 94 * 32; idx += NTHR) {
        const int r = idx >> 5, c8 = (idx & 31) * 8, s = s0 - 30 + r; u32x4 w = {0u, 0u, 0u, 0u};
        if (s >= 0) { const bf16* hp = H + ((size_t)b * SEQ + s) * HLD + 2304 + c8; const u32x4 v = *(const u32x4*)hp, g = *(const u32x4*)(hp + 256);
#pragma unroll
            for (int e = 0; e < 4; ++e) { const float v0 = bf2f(v[e] & 0xffffu) * fsigmoid(bf2f(g[e] & 0xffffu)), v1 = bf2f(v[e] >> 16) * fsigmoid(bf2f(g[e] >> 16)); w[e] = pk2(v0, v1); } }
        *(LAS u32x4*)(ut + r * 256 + c8) = w;
    }
    __syncthreads();
    {
        const int c = F.tid & 255, half = F.tid >> 8; const float* dw = a->in[10] + (size_t)l * 31 * 256 + c; const float bias = a->in[11][l * 256 + c];
        float w[31], ur[62];
#pragma unroll
        for (int k = 0; k < 31; ++k) w[k] = dw[k * 256];
#pragma unroll
        for (int i = 0; i < 62; ++i) ur[i] = bf2f(ut[(32 * half + i) * 256 + c]);
#pragma unroll
        for (int tt = 0; tt < 32; ++tt) { float acc = bias;
#pragma unroll
            for (int k = 0; k < 31; ++k) acc += w[k] * ur[tt + k];
            co[(32 * half + tt) * 256 + c] = acc; }
    }
    __syncthreads();
    {
        const float* lw = a->in[12] + l * 256; const float* lb = a->in[13] + l * 256; const f32x4 w4 = ((const f32x4*)lw)[F.lane], b4 = ((const f32x4*)lb)[F.lane];
#pragma unroll
        for (int i = 0; i < 8; ++i) { const int tl = 8 * F.wave + i; f32x4 v = *(LAS f32x4*)(co + tl * 256 + 4 * F.lane);
            const float mean = wave_sum((v[0] + v[1]) + (v[2] + v[3])) * (1.f / 256.f); v = v - mean;
            const float rstd = 1.f / sqrtf(wave_sum((v[0] * v[0] + v[1] * v[1]) + (v[2] * v[2] + v[3] * v[3])) * (1.f / 256.f) + LN_EPS);
            v = v * rstd * w4 + b4; u32x2 o; o.x = pk2(fsilu(v[0]), fsilu(v[1])); o.y = pk2(fsilu(v[2]), fsilu(v[3]));
            *(u32x2*)(Y + (tok0 + tl) * DM + 768 + 4 * F.lane) = o; }
    }
    __syncthreads();
}

__device__ __forceinline__ void compress_item(const Frame& F, ArgsP a, int it) {
    const int kv = it >> 7, bh = (it >> 3) & 15, b = bh >> 1, hh = bh & 1, i0 = (it & 7) * 32;
    const bf16* H = (const bf16*)(a->ws + WS_H); const bf16* w1t = (const bf16*)(a->ws + WS_WL + WL_W1) + (size_t)kv * 128 * 2048; const bf16* w2t = (const bf16*)(a->ws + WS_WL + WL_W2) + (size_t)kv * 64 * 128;
    const float* bias1 = (const float*)(a->ws + WS_WL + WL_BIAS1) + kv * 128; bf16* outp = (bf16*)(a->ws + (kv ? WS_VC : WS_KC)) + (size_t)bh * 256 * 64;
    LAS bf16* hid = (LAS bf16*)F.lds;
    const int lane = F.lane, li = lane & 15, g = lane >> 4, rt = F.wave & 1, cq = F.wave >> 1;
    const int i = i0 + 16 * rt + li; const bf16* arow = H + (size_t)b * SEQ * HLD + 512 + kv * 128 + hh * 64 + 8 * g;
    const bf16* brow = w1t + (size_t)(32 * cq + li) * 2048 + 8 * g;
    f32x4 acc[2] = {{0.f, 0.f, 0.f, 0.f}, {0.f, 0.f, 0.f, 0.f}};
#pragma unroll 1
    for (int k8 = 0; k8 < 64; k8 += 8) {
        bf16x8 af[8], bfr[8][2];
#pragma unroll
        for (int u = 0; u < 8; ++u) { const int ks = k8 + u; int s = 16 * i + (ks >> 1); s = s > SEQ - 1 ? SEQ - 1 : s;
            af[u] = *(const bf16x8*)(arow + (size_t)s * HLD + (ks & 1) * 32); bfr[u][0] = *(const bf16x8*)(brow + ks * 32); bfr[u][1] = *(const bf16x8*)(brow + (size_t)16 * 2048 + ks * 32); }
#pragma unroll
        for (int u = 0; u < 8; ++u) { acc[0] = mfma16(af[u], bfr[u][0], acc[0]); acc[1] = mfma16(af[u], bfr[u][1], acc[1]); }
    }
#pragma unroll
    for (int nt = 0; nt < 2; ++nt) { const int n = 32 * cq + 16 * nt + li; const float bs = bias1[n];
#pragma unroll
        for (int r = 0; r < 4; ++r) hid[(16 * rt + 4 * g + r) * 136 + n] = (bf16)f2bf(fsilu(acc[nt][r] + bs)); }
    __syncthreads();
    f32x4 o2 = {0.f, 0.f, 0.f, 0.f};
#pragma unroll
    for (int ks = 0; ks < 4; ++ks) { const bf16x8 af = *(LAS bf16x8*)(hid + (16 * rt + li) * 136 + 32 * ks + 8 * g);
        const bf16x8 bfr = *(const bf16x8*)(w2t + (size_t)(16 * cq + li) * 128 + 32 * ks + 8 * g); o2 = mfma16(af, bfr, o2); }
#pragma unroll
    for (int r = 0; r < 4; ++r) { const int io = i0 + 16 * rt + 4 * g + r; outp[(size_t)io * 64 + 16 * cq + li] = (bf16)(io < 255 ? f2bf(o2[r]) : 0u); }
    __syncthreads();
}

__host__ __device__ constexpr int tri_off(int i) { int s = 0; for (int k = 0; k < i; ++k) s += (k + 3) >> 2; return 4 * s; }
__device__ __forceinline__ int tri_off_rt(int i) { const int m = i - 1, V = (m + 3) >> 2; return i <= 0 ? 0 : 4 * (2 * V * (V - 1) + V * (m - 4 * V + 4)); }

template <int I> struct GdnSolveRow {
    __device__ static __forceinline__ void run(const LAS float* Ap, float (&x)[64]) {
        if constexpr (I < 64) {
            constexpr int off = tri_off(I), nb = (I + 3) >> 2;
            float s4[4] = {0.f, 0.f, 0.f, 0.f};
#pragma unroll
            for (int jb = 0; jb < nb; ++jb) { const f32x4 a4 = *(const LAS f32x4*)(Ap + off + 4 * jb);
#pragma unroll
                for (int jj = 0; jj < 4; ++jj) { if (4 * jb + jj < I) s4[jj] += a4[jj] * x[4 * jb + jj]; } }
            x[I] -= (s4[0] + s4[1]) + (s4[2] + s4[3]);
            if constexpr ((I & 3) == 3) SBAR();
            GdnSolveRow<I + 1>::run(Ap, x);
        }
    }
};

template <int GV>
__device__ __forceinline__ void gdn_prep_chunk(const Frame& F, ArgsP a, int l, int ci, LAS unsigned char* wl) {
    int lane_ = F.lane; asm volatile("" : "+v"(lane_));
    const int lane = lane_, li = lane & 15, g = lane >> 4; const int bh = ci >> 6, n = ci & 63, b = bh >> 2, h = bh & 3; const size_t tok0 = (size_t)b * SEQ + 64 * n;
    const bf16* H = (const bf16*)(a->ws + WS_H); const float* side = (const float*)(a->ws + WS_SIDE);
    unsigned char* rec = a->ws + ((GV & 1) ? WS_Y2 : WS_GPREP) + (size_t)ci * GCH;
    bf16* R0 = (bf16*)(rec + GC_UT); bf16* R1 = (bf16*)(rec + GC_W); bf16* QKm = (bf16*)(rec + GC_QK); bf16* QD = (bf16*)(rec + GC_QD); bf16* KDT = (bf16*)(rec + GC_KDT); bf16* ZT = (bf16*)(rec + GC_ZT);
    const int pc = (lane & 32) | (((lane & 15) >> 2) << 3) | (((lane >> 4) & 1) << 2) | (lane & 3);
    LAS unsigned char* qt = wl; LAS unsigned char* kt = wl + 8192; LAS float* Ap = (LAS float*)wl;
    const float beta = side[(tok0 + lane) * 32 + 24 + h]; const float av = side[(tok0 + lane) * 32 + 28 + h] + a->in[8][l * 4 + h];
    const float sp = av > 20.f ? av : log1pf(__expf(av)); float gc = -__expf(a->in[7][l * 4 + h]) * sp;
#pragma unroll
    for (int o = 1; o < 64; o <<= 1) { const float t = __shfl_up(gc, o); if (lane >= o) gc += t; }
    const float gl = __shfl(gc, 63); const float eg = __expf(gc), ekd = __expf(gl - gc);
    if (lane == 0 && !(GV & 1)) ((float*)(a->ws + WS_GL))[ci] = __expf(gl);
    const float* cw = a->in[6] + (size_t)l * 4 * 768 + h * 64 + lane; float wq[4], wk[4], wv[4];
#pragma unroll
    for (int k = 0; k < 4; ++k) { wq[k] = cw[k * 768]; wk[k] = cw[k * 768 + 256]; wv[k] = cw[k * 768 + 512]; }
    const bf16* hp = H + tok0 * HLD + 1280 + h * 64 + lane; float hq[3], hk[3], hv[3];
#pragma unroll
    for (int j = 0; j < 3; ++j) { const bool ok = (64 * n - 3 + j) >= 0; const bf16* p = hp + (ptrdiff_t)(j - 3) * HLD;
        hq[j] = ok ? bf2f(p[0]) : 0.f; hk[j] = ok ? bf2f(p[256]) : 0.f; hv[j] = ok ? bf2f(p[512]) : 0.f; }
    unsigned short ra[8][3], rb[8][3];
#define GDN_LOADBLK(dst, t8_) do { const bf16* pl_ = hp + (size_t)(8 * (t8_)) * HLD; asm volatile("" : "+v"(pl_)); _Pragma("unroll") for (int tt = 0; tt < 8; ++tt) { const bf16* q_ = pl_ + (size_t)tt * HLD; dst[tt][0] = q_[0]; dst[tt][1] = q_[256]; dst[tt][2] = q_[512]; } } while (0)
#define GDN_CONVBLK(src, t8_) do { const int t8 = (t8_); unsigned kdp[4]; \
        bf16* qd8 = QD + (8 * t8) * 64 + pc; bf16* r08 = R0 + (8 * t8) * 64 + lane; bf16* r18 = R1 + (8 * t8) * 64 + lane; asm volatile("" : "+v"(qd8), "+v"(r08), "+v"(r18)); \
        _Pragma("unroll") for (int tt = 0; tt < 8; ++tt) { const int t = 8 * t8 + tt; \
            const float rq = bf2f(src[tt][0]), rk = bf2f(src[tt][1]), rv = bf2f(src[tt][2]); \
            const float cq = wq[0] * hq[0] + wq[1] * hq[1] + wq[2] * hq[2] + wq[3] * rq, ck = wk[0] * hk[0] + wk[1] * hk[1] + wk[2] * hk[2] + wk[3] * rk, cv = wv[0] * hv[0] + wv[1] * hv[1] + wv[2] * hv[2] + wv[3] * rv; \
            hq[0] = hq[1]; hq[1] = hq[2]; hq[2] = rq; hk[0] = hk[1]; hk[1] = hk[2]; hk[2] = rk; hv[0] = hv[1]; hv[1] = hv[2]; hv[2] = rv; \
            const float qs = fsilu(cq), ks_ = fsilu(ck), vs = fsilu(cv); \
            const float qn = qs * __builtin_amdgcn_rsqf(wave_sum(qs * qs) + 1e-6f) * 0.125f, kn = ks_ * __builtin_amdgcn_rsqf(wave_sum(ks_ * ks_) + 1e-6f); \
            const float bt = __int_as_float(__builtin_amdgcn_readlane(__float_as_int(beta), t)), egt = __int_as_float(__builtin_amdgcn_readlane(__float_as_int(eg), t)), ekt = __int_as_float(__builtin_amdgcn_readlane(__float_as_int(ekd), t)); \
            *(LAS bf16*)(qt + tsw(t, lane)) = (bf16)f2bf(qn); *(LAS bf16*)(kt + tsw(t, lane)) = (bf16)f2bf(kn); \
            qd8[tt * 64] = (bf16)f2bf(qn * egt); r08[tt * 64] = (bf16)f2bf(bt * vs); r18[tt * 64] = (bf16)f2bf(bt * egt * kn); \
            const unsigned kd = f2bf(kn * ekt); if (tt & 1) kdp[tt >> 1] |= kd << 16; else kdp[tt >> 1] = kd; } \
        { const int c0 = (8 * t8) & 31, gg = (c0 & 15) >> 2, hh = c0 >> 4; bf16* kr = KDT + lane * 64 + ((8 * t8) & 32) + 4 * hh; \
          u32x2 w0, w1; w0.x = kdp[0]; w0.y = kdp[1]; w1.x = kdp[2]; w1.y = kdp[3]; *(u32x2*)(kr + 8 * gg) = w0; *(u32x2*)(kr + 8 * gg + 8) = w1; } } while (0)
    if (!(GV & 2)) {
    GDN_LOADBLK(ra, 0);
#pragma unroll 1
    for (int t16 = 0; t16 < 4; ++t16) {
        GDN_LOADBLK(rb, 2 * t16 + 1);
        GDN_CONVBLK(ra, 2 * t16);
        if (t16 < 3) GDN_LOADBLK(ra, 2 * t16 + 2);
        GDN_CONVBLK(rb, 2 * t16 + 1);
    }
    }
#undef GDN_LOADBLK
#undef GDN_CONVBLK
    {
        const float nwl = a->in[9][l * 64 + lane];
        for (int t8 = 0; t8 < 8; ++t8) { unsigned zp[4];
#pragma unroll
            for (int tt = 0; tt < 8; ++tt) { const unsigned zg = f2bf(fsilu(bf2f(hp[(size_t)(8 * t8 + tt) * HLD + 768])) * nwl); if (tt & 1) zp[tt >> 1] |= zg << 16; else zp[tt >> 1] = zg; }
            u32x4 wz; wz.x = zp[0]; wz.y = zp[1]; wz.z = zp[2]; wz.w = zp[3]; *(u32x4*)(ZT + lane * 64 + 8 * t8) = wz; }
    }
    LDS_WAIT();
    if (!(GV & 4)) {
    float gcj[4][4];
#pragma unroll
    for (int mt = 0; mt < 4; ++mt)
#pragma unroll
        for (int r = 0; r < 4; ++r) gcj[mt][r] = __shfl(gc, 16 * mt + 4 * g + r);
    f32x4 ahold[4][4];
#pragma unroll
    for (int nt = 0; nt < 4; ++nt) {
        const int i = 16 * nt + li; const float gci = __shfl(gc, i), bi = __shfl(beta, i);
        bf16x8 kB[2], qB[2];
#pragma unroll
        for (int ks = 0; ks < 2; ++ks) { kB[ks] = *(LAS bf16x8*)(kt + tsw(i, 32 * ks + 8 * g)); qB[ks] = *(LAS bf16x8*)(qt + tsw(i, 32 * ks + 8 * g)); }
#pragma unroll
        for (int mt = 0; mt < 4; ++mt) {
            u32x2 qw = {0u, 0u};
            if (mt <= nt) {
                const bf16x8 kA0 = *(LAS bf16x8*)(kt + tsw(16 * mt + li, 8 * g)), kA1 = *(LAS bf16x8*)(kt + tsw(16 * mt + li, 32 + 8 * g));
                f32x4 ckk = {0.f, 0.f, 0.f, 0.f}, cqk = {0.f, 0.f, 0.f, 0.f};
                ckk = mfma16(kA0, kB[0], ckk); ckk = mfma16(kA1, kB[1], ckk); cqk = mfma16(kA0, qB[0], cqk); cqk = mfma16(kA1, qB[1], cqk);
                float qv[4];
#pragma unroll
                for (int r = 0; r < 4; ++r) { const int j = 16 * mt + 4 * g + r; const float dec = __expf(fminf(gci - gcj[mt][r], 0.f));
                    ahold[nt][mt][r] = bi * ckk[r] * dec; qv[r] = (j <= i) ? cqk[r] * dec : 0.f; }
                qw.x = pk2(qv[0], qv[1]); qw.y = pk2(qv[2], qv[3]);
            }
            *(u32x2*)(QKm + i * 64 + 32 * (mt >> 1) + 8 * g + 4 * (mt & 1)) = qw;
        }
    }
    LDS_WAIT(); SBAR();
#pragma unroll
    for (int nt = 0; nt < 4; ++nt) { const int i = 16 * nt + li; const int ro = tri_off_rt(i);
#pragma unroll
        for (int mt = 0; mt < 4; ++mt) if (mt <= nt) {
#pragma unroll
            for (int r = 0; r < 4; ++r) { const int j = 16 * mt + 4 * g + r; if (j < i) Ap[ro + j] = ahold[nt][mt][r]; } } }
    }
    VM_WAIT(); LDS_WAIT();
#pragma unroll 1
    for (int pass = 0; pass < 2; ++pass) {
        bf16* Rp = pass ? R1 : R0; float x[64];
#pragma unroll
        for (int i = 0; i < 64; ++i) x[i] = bf2f(Rp[i * 64 + lane]);
        VM_WAIT();
        if (!(GV & 8)) GdnSolveRow<1>::run(Ap, x);
        if (pass == 0) {
#pragma unroll
            for (int i8 = 0; i8 < 8; ++i8) { u32x4 w; w.x = pk2(x[8 * i8], x[8 * i8 + 1]); w.y = pk2(x[8 * i8 + 2], x[8 * i8 + 3]); w.z = pk2(x[8 * i8 + 4], x[8 * i8 + 5]); w.w = pk2(x[8 * i8 + 6], x[8 * i8 + 7]);
                *(u32x4*)(Rp + lane * 64 + 8 * i8) = w; }
        } else {
#pragma unroll
            for (int i = 0; i < 64; ++i) Rp[i * 64 + pc] = (bf16)f2bf(x[i]);
        }
    }
    LDS_WAIT();
}

__device__ __forceinline__ bf16x8 scan_frag(const unsigned char* mat, int mt, int ks, int li, int g) { return *(const bf16x8*)(mat + (16 * mt + li) * 128 + (32 * ks + 8 * g) * 2); }
__device__ __forceinline__ bf16x8 pack_c2(f32x4 a, f32x4 b) { u32x4 w; w.x = pk2(a[0], a[1]); w.y = pk2(a[2], a[3]); w.z = pk2(b[0], b[1]); w.w = pk2(b[2], b[3]); return as_bf16x8(w); }
constexpr int SC_SLOT = 24576;
__device__ __forceinline__ void scan_dma(LAS unsigned char* slot, const unsigned char* rec, int sl, int lane) {
#pragma unroll
    for (int m = 0; m < 3; ++m) { const int goff = (m == 0) ? GC_W : (m == 1 ? GC_KDT : GC_UT);
#pragma unroll
        for (int i = 0; i < 2; ++i) { const int row = 16 * sl + 8 * i + (lane >> 3), ch = (lane & 7) ^ ((row >> 1) & 7);
            __builtin_amdgcn_global_load_lds((const unsigned*)(rec + goff + row * 128 + ch * 16), (LAS unsigned*)(slot + m * 8192 + (16 * sl + 8 * i) * 128), 16, 0, 0); } }
}
__device__ __forceinline__ bf16x8 scan_lfrag(const LAS unsigned char* mat, int mt, int ks, int li, int g) { const int row = 16 * mt + li; return *(const LAS bf16x8*)(mat + row * 128 + ((((4 * ks + g) ^ (row >> 1)) & 7) << 4)); }
template <int SV>
__device__ __forceinline__ void gdn_scan(const Frame& F, ArgsP a, int l) {
    const int lane = F.lane, li = lane & 15, g = lane >> 4, pr = F.wave >> 2, sl = F.wave & 3; const int bh = F.bid * 2 + pr, dv0 = 16 * sl;
    const float* GL = (const float*)(a->ws + WS_GL) + bh * 64; unsigned char* rec0 = a->ws + WS_GPREP + (size_t)bh * 64 * GCH;
    LAS unsigned char* ring = F.lds + pr * (3 * SC_SLOT);
    f32x4 S[4] = {{0.f, 0.f, 0.f, 0.f}, {0.f, 0.f, 0.f, 0.f}, {0.f, 0.f, 0.f, 0.f}, {0.f, 0.f, 0.f, 0.f}};
    const float glv = GL[lane];
    asm volatile("s_waitcnt vmcnt(0)" ::: "memory");
    scan_dma(ring, rec0, sl, lane); scan_dma(ring + SC_SLOT, rec0 + GCH, sl, lane);
#pragma unroll 1
    for (int n = 0; n < 64; ++n) {
        unsigned char* rn = rec0 + (size_t)n * GCH; const LAS unsigned char* slot = ring + (n % 3) * SC_SLOT;
        if (n == 0) asm volatile("s_waitcnt vmcnt(6)" ::: "memory"); else asm volatile("s_waitcnt vmcnt(14)" ::: "memory");
        __builtin_amdgcn_s_barrier(); asm volatile("" ::: "memory");
        if (n + 2 < 64) scan_dma(ring + ((n + 2) % 3) * SC_SLOT, rn + 2 * (size_t)GCH, sl, lane);
        else { asm volatile("" ::: "memory"); }
        const float egl = __int_as_float(__builtin_amdgcn_readlane(__float_as_int(glv), n));
        const bf16x8 Sb0 = pack_c2(S[0], S[1]), Sb1 = pack_c2(S[2], S[3]);
        if (!(SV & 1)) { bf16x8* ss = (bf16x8*)(rn + GC_SS + sl * 2048) + lane; ss[0] = Sb0; ss[64] = Sb1; }
        f32x4 vn[4];
#pragma unroll
        for (int mt = 0; mt < 4; ++mt) {
            f32x4 acc = {0.f, 0.f, 0.f, 0.f};
            acc = mfma16(scan_lfrag(slot, mt, 0, li, g), Sb0, acc); acc = mfma16(scan_lfrag(slot, mt, 1, li, g), Sb1, acc);
            const int urow = dv0 + li; const u32x2 uu = *(const LAS u32x2*)(slot + 16384 + urow * 128 + (((((16 * mt + 4 * g) >> 3) ^ (urow >> 1)) & 7) << 4) + (((16 * mt + 4 * g) & 7) << 1));
            vn[mt][0] = bf2f(uu.x & 0xffffu) - acc[0]; vn[mt][1] = bf2f(uu.x >> 16) - acc[1]; vn[mt][2] = bf2f(uu.y & 0xffffu) - acc[2]; vn[mt][3] = bf2f(uu.y >> 16) - acc[3];
        }
        const bf16x8 Vb0 = pack_c2(vn[0], vn[1]), Vb1 = pack_c2(vn[2], vn[3]);
        if (!(SV & 1)) { bf16x8* vb = (bf16x8*)(rn + GC_VB + sl * 2048) + lane; vb[0] = Vb0; vb[64] = Vb1; }
#pragma unroll
        for (int mt = 0; mt < 4; ++mt) { f32x4 acc = S[mt] * egl; acc = mfma16(scan_lfrag(slot + 8192, mt, 0, li, g), Vb0, acc); acc = mfma16(scan_lfrag(slot + 8192, mt, 1, li, g), Vb1, acc); S[mt] = acc; }
        if ((SV & 1) || n + 2 >= 64) { }
    }
    asm volatile("s_waitcnt vmcnt(0)" ::: "memory"); asm volatile("" :: "v"(S[0][0]), "v"(S[1][1]), "v"(S[2][2]), "v"(S[3][3]));
    __syncthreads();
}

__device__ __forceinline__ void gdn_out_chunk(const Frame& F, ArgsP a, int ci, LAS unsigned char* wl) {
    int lane_ = F.lane; asm volatile("" : "+v"(lane_)); const int lane = lane_, li = lane & 15, g = lane >> 4; const int bh = ci >> 6, n = ci & 63, b = bh >> 2, h = bh & 3;
    const unsigned char* rec = a->ws + WS_GPREP + (size_t)ci * GCH; bf16* Y = (bf16*)(a->ws + WS_Y);
    bf16x8 QDf[4][2], QKf[4][2];
#pragma unroll
    for (int mt = 0; mt < 4; ++mt) { QDf[mt][0] = scan_frag(rec + GC_QD, mt, 0, li, g); QDf[mt][1] = scan_frag(rec + GC_QD, mt, 1, li, g); QKf[mt][0] = scan_frag(rec + GC_QK, mt, 0, li, g); QKf[mt][1] = scan_frag(rec + GC_QK, mt, 1, li, g); }
    float ssq[4][4];
#pragma unroll
    for (int mt = 0; mt < 4; ++mt)
#pragma unroll
        for (int r = 0; r < 4; ++r) ssq[mt][r] = 0.f;
    f32x4 o[4][4];
#pragma unroll
    for (int sl = 0; sl < 4; ++sl) {
        const bf16x8* ss = (const bf16x8*)(rec + GC_SS + sl * 2048) + lane; const bf16x8* vb = (const bf16x8*)(rec + GC_VB + sl * 2048) + lane;
        const bf16x8 Sb0 = ss[0], Sb1 = ss[64], Vb0 = vb[0], Vb1 = vb[64];
#pragma unroll
        for (int mt = 0; mt < 4; ++mt) {
            f32x4 acc = {0.f, 0.f, 0.f, 0.f};
            acc = mfma16(QDf[mt][0], Sb0, acc); acc = mfma16(QDf[mt][1], Sb1, acc); acc = mfma16(QKf[mt][0], Vb0, acc); acc = mfma16(QKf[mt][1], Vb1, acc);
            o[sl][mt] = acc;
#pragma unroll
            for (int r = 0; r < 4; ++r) ssq[mt][r] += acc[r] * acc[r];
        }
    }
#pragma unroll
    for (int mt = 0; mt < 4; ++mt)
#pragma unroll
        for (int r = 0; r < 4; ++r) ssq[mt][r] = __builtin_amdgcn_rsqf(row16_sum(ssq[mt][r]) * (1.f / 64.f) + 1e-6f);
#pragma unroll
    for (int sl = 0; sl < 4; ++sl)
#pragma unroll
        for (int mt = 0; mt < 4; ++mt) {
            const u32x2 zz = *(const u32x2*)(rec + GC_ZT + (16 * sl + li) * 128 + (16 * mt + 4 * g) * 2);
            const float zf[4] = {bf2f(zz.x & 0xffffu), bf2f(zz.x >> 16), bf2f(zz.y & 0xffffu), bf2f(zz.y >> 16)};
#pragma unroll
            for (int r = 0; r < 4; ++r) *(LAS bf16*)(wl + tsw(16 * mt + 4 * g + r, 16 * sl + li)) = (bf16)f2bf(o[sl][mt][r] * ssq[mt][r] * zf[r]);
        }
    LDS_WAIT();
    bf16* yrow = Y + ((size_t)b * SEQ + 64 * n + lane) * DM + 512 + h * 64;
#pragma unroll
    for (int c = 0; c < 8; ++c) *(u32x4*)(yrow + 8 * c) = *(const LAS u32x4*)(wl + tsw(lane, 8 * c));
    LDS_WAIT();
}

constexpr int AT_K = 0, AT_V = 32768, AT_IMP = 65536, AT_SELM = AT_IMP + 64 * 68 * 4, AT_UNI = AT_SELM + 512, AT_YS = 83968;
__device__ __forceinline__ s16x4 tr_read0(unsigned addr) { s16x4 r; asm volatile("ds_read_b64_tr_b16 %0, %1" : "=&v"(r) : "v"(addr) : "memory"); return r; }

__device__ __forceinline__ float half_max(float x) { auto rr = __builtin_amdgcn_permlane32_swap(__float_as_uint(x), __float_as_uint(x), false, false); return fmaxf(__uint_as_float(rr[0]), __uint_as_float(rr[1])); }
__device__ __forceinline__ float half_sum(float x) { auto rr = __builtin_amdgcn_permlane32_swap(__float_as_uint(x), __float_as_uint(x), false, false); return __uint_as_float(rr[0]) + __uint_as_float(rr[1]); }
struct AttnStage { u32x4 kr, vr; };
__device__ __forceinline__ void at_gload(AttnStage& st, const bf16* Kb, const bf16* Vb, size_t stride, int j, int tid) {
    const int row = tid >> 3, ch = tid & 7; const size_t off = (size_t)(64 * j + row) * stride + 8 * ch;
    st.kr = *(const u32x4*)(Kb + off); st.vr = *(const u32x4*)(Vb + off);
}
__device__ __forceinline__ void at_swrite(const AttnStage& st, LAS unsigned char* lds, int buf, int tid) {
    const int row = tid >> 3, ch = tid & 7; const int o = row * 128 + (((ch ^ (row >> 1)) & 7) << 4);
    *(LAS u32x4*)(lds + AT_K + buf * 8192 + o) = st.kr; *(LAS u32x4*)(lds + AT_V + buf * 8192 + o) = st.vr;
}
__device__ __forceinline__ void at_qk(const LAS unsigned char* Kt, const bf16x8 (&Qf)[4], int r, int hf, f32x16 (&s)[2], float cinit) {
    const int swz = (r >> 1) & 7;
    bf16x8 kf[2][4];
#pragma unroll
    for (int kt = 0; kt < 2; ++kt)
#pragma unroll
        for (int ks = 0; ks < 4; ++ks) kf[kt][ks] = *(const LAS bf16x8*)(Kt + (32 * kt + r) * 128 + (((2 * ks + hf) ^ swz) << 4));
    SBAR();
#pragma unroll
    for (int kt = 0; kt < 2; ++kt) {
        f32x16 acc;
#pragma unroll
        for (int e = 0; e < 16; ++e) acc[e] = cinit;
#pragma unroll
        for (int ks = 0; ks < 4; ++ks) acc = mfma32(kf[kt][ks], Qf[ks], acc);
        s[kt] = acc;
    }
}
__device__ __forceinline__ void at_pv(unsigned vbase, const unsigned (&voff)[2][2], const f32x16 (&p)[2], f32x16 (&o)[2]) {
#pragma unroll
    for (int kt = 0; kt < 2; ++kt) {
        s16x4 vr[2][2][2];
#pragma unroll
        for (int s = 0; s < 2; ++s) { const unsigned co = vbase + (unsigned)(4096 * kt + 2048 * s);
            vr[s][0][0] = tr_read0(co + voff[0][0]); vr[s][1][0] = tr_read0(co + voff[1][0]); vr[s][0][1] = tr_read0(co + voff[0][1]); vr[s][1][1] = tr_read0(co + voff[1][1]); }
        bf16x8 pb[2];
#pragma unroll
        for (int s = 0; s < 2; ++s) { u32x4 pw; pw.x = pk2(p[kt][8 * s + 0], p[kt][8 * s + 1]); pw.y = pk2(p[kt][8 * s + 2], p[kt][8 * s + 3]); pw.z = pk2(p[kt][8 * s + 4], p[kt][8 * s + 5]); pw.w = pk2(p[kt][8 * s + 6], p[kt][8 * s + 7]); pb[s] = as_bf16x8(pw); }
        asm volatile("s_waitcnt lgkmcnt(0)" ::: "memory"); SBAR();
#pragma unroll
        for (int s = 0; s < 2; ++s) {
            const s16x4 l0 = vr[s][0][0], h0 = vr[s][1][0], l1 = vr[s][0][1], h1 = vr[s][1][1];
            const bf16x8 v0 = {l0[0], l0[1], l0[2], l0[3], h0[0], h0[1], h0[2], h0[3]}, v1 = {l1[0], l1[1], l1[2], l1[3], h1[0], h1[1], h1[2], h1[3]};
            o[0] = mfma32(v0, pb[s], o[0]); o[1] = mfma32(v1, pb[s], o[1]);
        }
    }
}

struct AttnRow { int r, hf, tt, t, qb, wave; unsigned long long wave_union; float m, lpart; };
struct TileInfo { int hi, lo; bool rowok, edge, work, fresh; };
template <int MODE, int VAR>
__device__ __forceinline__ void at_tile_qk(const Frame& F, int j, int stg, const bf16x8 (&Qf)[4], const AttnRow& R, float mfin, f32x16 (&s)[2], TileInfo& I) {
    LAS unsigned char* lds = F.lds;
    I.work = true; if (MODE == 2) I.work = (R.wave_union >> j) & 1ull;
    I.hi = 1000; I.lo = -1000; I.rowok = true; I.edge = false;
    if (MODE <= 1) { I.hi = ((R.t - 31) >> 4) - 64 * j - 4 * R.hf; I.edge = (64 * j + 63) > ((64 * R.qb + 8 * R.wave - 31) >> 4); }
    if (MODE == 2) { const unsigned long long sm = *(const LAS unsigned long long*)(lds + AT_SELM + 8 * R.tt); I.rowok = (sm >> j) & 1ull; if (j == R.qb) { I.hi = R.tt - 4 * R.hf; I.edge = true; } }
    if (MODE == 3) { if (j == R.qb) { I.hi = R.tt - 4 * R.hf; I.edge = true; } if (j == R.qb - 8) { I.lo = R.tt + 1 - 4 * R.hf; I.edge = true; } }
    const float mref = (MODE == 1) ? mfin : R.m; I.fresh = mref < -1e29f;
    const float cinit = I.rowok ? (I.fresh ? 0.f : -mref) : -INFINITY;
    if (I.work) { if (VAR & 64) { for (int e = 0; e < 16; ++e) { s[0][e] = Qf[0][0] * 1e-9f; s[1][e] = Qf[1][1] * 1e-9f; } } else at_qk(lds + AT_K + stg * 8192, Qf, R.r, R.hf, s, cinit); }
}
template <int MODE, int VAR>
__device__ __forceinline__ float at_tile_fin(const Frame& F, int j, int stg, f32x16 (&s)[2], const TileInfo& I, AttnRow& R, const unsigned (&voff)[2][2], f32x16 (&o)[2], float invl, float preshift) {
    LAS unsigned char* lds = F.lds; float shift_out = 0.f;
    if (!I.work) return 0.f;
    const int hi = I.hi, lo = I.lo; const bool edge = I.edge;
    if (MODE == 1) {
        if (edge) {
#pragma unroll
            for (int kt = 0; kt < 2; ++kt)
#pragma unroll
                for (int e = 0; e < 16; ++e) { const int cst = 32 * kt + (e & 3) + 8 * (e >> 2); s[kt][e] = (cst <= hi) ? fexp2(s[kt][e]) * invl : 0.f; }
        } else {
#pragma unroll
            for (int kt = 0; kt < 2; ++kt)
#pragma unroll
                for (int e = 0; e < 16; ++e) s[kt][e] = fexp2(s[kt][e]) * invl;
        }
        LAS float* imp = (LAS float*)(lds + AT_IMP) + R.tt * 68;
#pragma unroll
        for (int kt = 0; kt < 2; ++kt)
#pragma unroll
            for (int rg = 0; rg < 4; ++rg) {
                float av = 2.f * (s[kt][4 * rg] + s[kt][4 * rg + 1] + s[kt][4 * rg + 2]) + s[kt][4 * rg + 3], bv = s[kt][4 * rg + 3];
                av += __int_as_float(__builtin_amdgcn_update_dpp(0, __float_as_int(av), 0xB1, 0xf, 0xf, true)); av += __int_as_float(__builtin_amdgcn_update_dpp(0, __float_as_int(av), 0x4E, 0xf, 0xf, true));
                bv += __int_as_float(__builtin_amdgcn_update_dpp(0, __float_as_int(bv), 0xB1, 0xf, 0xf, true)); bv += __int_as_float(__builtin_amdgcn_update_dpp(0, __float_as_int(bv), 0x4E, 0xf, 0xf, true));
                if ((R.r & 3) == 0) { const int jb = 16 * j + 8 * kt + 2 * rg + R.hf; (void)__hip_atomic_fetch_add(imp + jb, av, __ATOMIC_RELAXED, __HIP_MEMORY_SCOPE_WORKGROUP); (void)__hip_atomic_fetch_add(imp + jb + 1, bv, __ATOMIC_RELAXED, __HIP_MEMORY_SCOPE_WORKGROUP); }
            }
        if (VAR & 16) { o[0][0] += s[0][3] + s[1][7]; } else at_pv((unsigned)(size_t)(lds + AT_V + stg * 8192), voff, s, o);
    } else if (VAR & 32) { R.lpart += s[0][1]; if (MODE >= 2) { if (VAR & 16) { o[0][0] += s[0][3]; } else at_pv((unsigned)(size_t)(lds + AT_V + stg * 8192), voff, s, o); } }
    else {
        constexpr float THR = 8.f;
        if (__any(preshift != 0.f)) {
#pragma unroll
            for (int kt = 0; kt < 2; ++kt)
#pragma unroll
                for (int e = 0; e < 16; ++e) s[kt][e] -= preshift;
        }
        const bool fresh = R.m < -1e29f;
        if (edge) {
#pragma unroll
            for (int kt = 0; kt < 2; ++kt)
#pragma unroll
                for (int e = 0; e < 16; ++e) { const int cst = 32 * kt + (e & 3) + 8 * (e >> 2); const bool ok = (cst <= hi) && (cst >= lo); s[kt][e] = ok ? s[kt][e] : -INFINITY; }
        }
        float tm4[4] = {-INFINITY, -INFINITY, -INFINITY, -INFINITY};
#pragma unroll
        for (int kt = 0; kt < 2; ++kt)
#pragma unroll
            for (int e = 0; e < 16; e += 2) tm4[(e >> 1) & 3] = fmaxf(tm4[(e >> 1) & 3], fmaxf(s[kt][e], s[kt][e + 1]));
        const float tmax = half_max(fmaxf(fmaxf(tm4[0], tm4[1]), fmaxf(tm4[2], tm4[3])));
        const bool raise = (tmax > -INFINITY) && (fresh || tmax > THR);
        if (__any(raise)) {
            const float shift = raise ? tmax : 0.f, alpha = (raise && !fresh) ? fexp2(-shift) : 1.f;
            R.m = raise ? (fresh ? tmax : R.m + tmax) : R.m; R.lpart *= alpha; shift_out = shift;
#pragma unroll
            for (int kt = 0; kt < 2; ++kt)
#pragma unroll
                for (int e = 0; e < 16; ++e) s[kt][e] -= shift;
            if (MODE >= 2) {
#pragma unroll
                for (int e = 0; e < 16; ++e) { o[0][e] *= alpha; o[1][e] *= alpha; } }
        }
        float ps4[4] = {0.f, 0.f, 0.f, 0.f};
#pragma unroll
        for (int kt = 0; kt < 2; ++kt)
#pragma unroll
            for (int e = 0; e < 16; ++e) { s[kt][e] = fexp2(s[kt][e]); ps4[e & 3] += s[kt][e]; }
        R.lpart += (ps4[0] + ps4[1]) + (ps4[2] + ps4[3]);
        if (MODE >= 2) { if (VAR & 16) { o[0][0] += s[0][3] + s[1][7]; } else at_pv((unsigned)(size_t)(lds + AT_V + stg * 8192), voff, s, o); }
    }
    return shift_out;
}
template <int MODE, int VAR = 0>
__device__ __forceinline__ void at_branch(const Frame& F, unsigned long long mask, const bf16* Kb, const bf16* Vb, size_t stride, const bf16x8 (&Qf)[4], AttnRow& R, const unsigned (&voff)[2][2],
                                          f32x16 (&o)[2], float mfin, float invl) {
    LAS unsigned char* lds = F.lds; const int tid = F.tid;
    if (mask == 0ull) return;
    AttnStage st0, st1; int sg = 0;
    { const int j0 = __builtin_ctzll(mask); at_gload(st0, Kb, Vb, stride, j0, tid); at_swrite(st0, lds, 0, tid);
      const unsigned long long m1 = mask & (mask - 1ull); if (m1) { at_gload(st1, Kb, Vb, stride, __builtin_ctzll(m1), tid); at_swrite(st1, lds, 1, tid); } }
    __syncthreads();
    while (mask) {
        const int j0 = __builtin_ctzll(mask); mask &= mask - 1ull;
        int j1 = -1; if (mask) { j1 = __builtin_ctzll(mask); mask &= mask - 1ull; }
        int n0 = -1, n1 = -1; { unsigned long long mm = mask; if (mm) { n0 = __builtin_ctzll(mm); mm &= mm - 1ull; if (mm) n1 = __builtin_ctzll(mm); } }
        at_gload(st0, Kb, Vb, stride, n0 >= 0 ? n0 : j0, tid);
        at_gload(st1, Kb, Vb, stride, n1 >= 0 ? n1 : j0, tid);
        { f32x16 sa[2]; TileInfo Ia;
          at_tile_qk<MODE, VAR>(F, j0, sg, Qf, R, mfin, sa, Ia);
          (void)at_tile_fin<MODE, VAR>(F, j0, sg, sa, Ia, R, voff, o, invl, 0.f); }
        if (j1 >= 0) { f32x16 sb[2]; TileInfo Ib;
          at_tile_qk<MODE, VAR>(F, j1, sg + 1, Qf, R, mfin, sb, Ib);
          (void)at_tile_fin<MODE, VAR>(F, j1, sg + 1, sb, Ib, R, voff, o, invl, 0.f); }
        if (n0 >= 0) at_swrite(st0, lds, (sg + 2) & 3, tid);
        if (n1 >= 0) at_swrite(st1, lds, (sg + 3) & 3, tid);
        __syncthreads();
        sg = (sg + 2) & 3;
    }
}

template <int VAR>
__device__ __forceinline__ void attn_item(const Frame& F, ArgsP a, int l, int item) {
    const int qb = 63 - (item >> 4), bh = item & 15, b = bh >> 1, hk = bh & 1; const int lane = F.lane, wave = F.wave;
    const bf16* H = (const bf16*)(a->ws + WS_H); const float* side = (const float*)(a->ws + WS_SIDE); bf16* Y = (bf16*)(a->ws + WS_Y);
    LAS unsigned char* lds = F.lds;
    AttnRow R; R.r = lane & 31; R.hf = lane >> 5; R.tt = 8 * wave + (R.r >> 2); R.t = 64 * qb + R.tt; R.qb = qb; R.wave = wave; R.wave_union = 0ull;
    const int head = hk * 4 + (R.r & 3); const size_t tok = (size_t)b * SEQ + R.t;
    bf16x8 Qf[4];
#pragma unroll
    for (int ks = 0; ks < 4; ++ks) Qf[ks] = *(const bf16x8*)(H + tok * HLD + head * 64 + 16 * ks + 8 * R.hf);
    const float g_cmp = side[tok * 32 + head * 3], g_sel = side[tok * 32 + head * 3 + 1], g_win = side[tok * 32 + head * 3 + 2];
    unsigned voff[2][2];
    { const int li = lane & 15, q = li >> 2, p = li & 3, gi1 = (lane >> 4) & 1;
#pragma unroll
      for (int jh = 0; jh < 2; ++jh)
#pragma unroll
          for (int dt = 0; dt < 2; ++dt) voff[jh][dt] = (unsigned)((8 * jh + 4 * R.hf + q) * 128 + ((((4 * dt + 2 * gi1 + (p >> 1)) ^ (4 * jh + 2 * R.hf + (q >> 1))) & 7) << 4) + (p & 1) * 8); }
    { LAS float* imp = (LAS float*)(lds + AT_IMP) + (8 * wave) * 68; for (int i = lane; i < 8 * 68; i += 64) imp[i] = 0.f; if (F.tid == 0) { *(LAS unsigned*)(lds + AT_UNI) = 0u; *(LAS unsigned*)(lds + AT_UNI + 4) = 0u; } }
    f32x16 o[2];
#pragma unroll
    for (int e = 0; e < 16; ++e) { o[0][e] = 0.f; o[1][e] = 0.f; }
    LAS float* ys = (LAS float*)(lds + AT_YS + wave * 8192) + lane;
    {
        const bf16* Kc = (const bf16*)(a->ws + WS_KC) + (size_t)bh * 256 * 64; const bf16* Vc = (const bf16*)(a->ws + WS_VC) + (size_t)bh * 256 * 64;
        const int ntc = (4 * qb + 3 + 63) >> 6; const unsigned long long mc = (ntc >= 64) ? ~0ull : ((1ull << ntc) - 1ull);
        R.m = -1e30f; R.lpart = 0.f;
        if (!(VAR & 8)) at_branch<0, VAR>(F, mc, Kc, Vc, 64, Qf, R, voff, o, 0.f, 0.f);
        const float lsum = half_sum(R.lpart); const float invl = 1.f / fmaxf(lsum, 1e-30f);
        if (!(VAR & 8)) at_branch<1, VAR>(F, mc, Kc, Vc, 64, Qf, R, voff, o, R.m, invl);
#pragma unroll
        for (int e = 0; e < 16; ++e) { ys[e * 64] = g_cmp * o[0][e]; ys[(16 + e) * 64] = g_cmp * o[1][e]; o[0][e] = 0.f; o[1][e] = 0.f; }
    }
    LDS_WAIT();
    {
        unsigned long long wu = 0ull;
        for (int qi = 0; qi < 8; ++qi) {
            unsigned long long selm;
            if (qb < 16) selm = (2ull << qb) - 1ull;
            else {
                const float v = ((const LAS float*)(lds + AT_IMP))[(8 * wave + qi) * 68 + lane];
                const bool cand = (lane >= 1) && (lane <= qb - 2); const unsigned key = cand ? __float_as_uint(fmaxf(v, 0.f)) : 0u;
                unsigned thr = 0u;
                for (int bit = 30; bit >= 0; --bit) { const unsigned tr = thr | (1u << bit); const int c = __popcll(__ballot(cand && key >= tr)); if (c >= 13) thr = tr; }
                const unsigned long long gt = __ballot(cand && key > thr), eq = __ballot(cand && key == thr);
                int need = 13 - __popcll(gt); unsigned long long eqs = 0ull, e2 = eq;
                while (need > 0 && e2) { const unsigned long long low = e2 & (~e2 + 1ull); eqs |= low; e2 ^= low; --need; }
                selm = gt | eqs | 1ull | (1ull << qb) | (1ull << (qb - 1));
            }
            if (lane == 0) *(LAS unsigned long long*)(lds + AT_SELM + 8 * (8 * wave + qi)) = selm;
#if defined(SELFCHECK) && SELFCHECK == 1
            if (lane == 0 && l == 1) ((unsigned long long*)(a->ws + (size_t)880 * MiB + 64 * KiB))[(size_t)bh * SEQ + 64 * qb + 8 * wave + qi] = selm;
#endif
            wu |= selm;
        }
        R.wave_union = wu;
        if (lane == 0) { __hip_atomic_fetch_or((LAS unsigned*)(lds + AT_UNI), (unsigned)wu, __ATOMIC_RELAXED, __HIP_MEMORY_SCOPE_WORKGROUP); __hip_atomic_fetch_or((LAS unsigned*)(lds + AT_UNI + 4), (unsigned)(wu >> 32), __ATOMIC_RELAXED, __HIP_MEMORY_SCOPE_WORKGROUP); }
    }
    __syncthreads();
    const unsigned long long bunion = (unsigned long long)*(const LAS unsigned*)(lds + AT_UNI) | ((unsigned long long)*(const LAS unsigned*)(lds + AT_UNI + 4) << 32);
    const bf16* Hb = H + (size_t)b * SEQ * HLD;
    {
        R.m = -1e30f; R.lpart = 0.f;
        if (!(VAR & 2)) at_branch<2, VAR>(F, bunion, Hb + 512 + 2 * 128 + hk * 64, Hb + 512 + 3 * 128 + hk * 64, HLD, Qf, R, voff, o, 0.f, 0.f);
        const float lsum = half_sum(R.lpart); const float sc = g_sel / fmaxf(lsum, 1e-30f);
#pragma unroll
        for (int e = 0; e < 16; ++e) { ys[e * 64] += sc * o[0][e]; ys[(16 + e) * 64] += sc * o[1][e]; o[0][e] = 0.f; o[1][e] = 0.f; }
    }
    {
        const int lo = qb - 8 > 0 ? qb - 8 : 0; const unsigned long long mw = ((2ull << qb) - 1ull) & ~((1ull << lo) - 1ull);
        R.m = -1e30f; R.lpart = 0.f;
        if (!(VAR & 4)) at_branch<3, VAR>(F, mw, Hb + 512 + 4 * 128 + hk * 64, Hb + 512 + 5 * 128 + hk * 64, HLD, Qf, R, voff, o, 0.f, 0.f);
        const float lsum = half_sum(R.lpart); const float sc = g_win / fmaxf(lsum, 1e-30f);
#pragma unroll
        for (int e = 0; e < 16; ++e) { o[0][e] = ys[e * 64] + sc * o[0][e]; o[1][e] = ys[(16 + e) * 64] + sc * o[1][e]; }
    }
    if (VAR & 1) { asm volatile("" :: "v"(o[0][0]), "v"(o[1][5])); return; }
    bf16* yrow = Y + tok * DM + head * 64 + 4 * R.hf;
#pragma unroll
    for (int dt = 0; dt < 2; ++dt)
#pragma unroll
        for (int rg = 0; rg < 4; ++rg) { u32x2 w; w.x = pk2(o[dt][4 * rg], o[dt][4 * rg + 1]); w.y = pk2(o[dt][4 * rg + 2], o[dt][4 * rg + 3]); *(u32x2*)(yrow + 32 * dt + 8 * rg) = w; }
}

__device__ __forceinline__ void phase_mix_b(const Frame& F, ArgsP a, int l, int rep) {
    unsigned* q = F.ctl + CW_QUEUE + l * 64 + rep * 32;
    for (;;) {
        if (F.tid == 0) F.MISC[0] = __hip_atomic_fetch_add(q, 1u, __ATOMIC_RELAXED, __HIP_MEMORY_SCOPE_AGENT);
        __syncthreads();
        const int item = (int)F.MISC[0];
        __syncthreads();
        if (item >= 1024) break;
        if (rep == 0) attn_item<0>(F, a, l, item); else attn_item<PROBE_ATTN_VAR>(F, a, l, item);
    }
}

constexpr size_t WS_DBG = 880 * MiB;
constexpr int CHECK_LAYER = 1;
__device__ __forceinline__ void dbg_add(ArgsP a, int i, float v) { atomicAdd((float*)(a->ws + WS_DBG) + i, v); }

__device__ __forceinline__ void check_nsa(const Frame& F, ArgsP a) {
    const bf16* H = (const bf16*)(a->ws + WS_H); const float* side = (const float*)(a->ws + WS_SIDE); const bf16* Y = (const bf16*)(a->ws + WS_Y);
    const unsigned long long* SELM = (const unsigned long long*)(a->ws + WS_DBG + 64 * KiB);
    const int lane = F.lane; const int tv[16] = {5, 40, 63, 64, 100, 511, 512, 1023, 1024, 1500, 2047, 2048, 3000, 3333, 4000, 4095};
    for (int s = F.bid * NWAVES + F.wave; s < 256; s += F.G * NWAVES) {
        int t = tv[0];
#pragma unroll
        for (int q = 1; q < 16; ++q) t = ((s & 15) == q) ? tv[q] : t;
        const int b = (s >> 4) & 7, hq = ((s >> 7) * 5 + (s & 7)) & 7, hk = hq >> 2; const size_t tok = (size_t)b * SEQ + t; const int bhk = b * 2 + hk;
        const bf16* KC = (const bf16*)(a->ws + WS_KC) + (size_t)bhk * 256 * 64; const bf16* VC = (const bf16*)(a->ws + WS_VC) + (size_t)bhk * 256 * 64;
        const float g_cmp = side[tok * 32 + hq * 3], g_sel = side[tok * 32 + hq * 3 + 1], g_win = side[tok * 32 + hq * 3 + 2];
        const int cmax = (t - 31) >> 4; float imp = 0.f, ocmp = 0.f;
        for (int gh = 0; gh < 4; ++gh) {
            const int head = hk * 4 + gh; const float qd = bf2f(H[tok * HLD + head * 64 + lane]);
            float m = -INFINITY, l = 0.f;
            for (int c = 0; c <= cmax; ++c) m = fmaxf(m, wave_sum(qd * bf2f(KC[c * 64 + lane])));
            for (int c = 0; c <= cmax; ++c) l += fexp2(wave_sum(qd * bf2f(KC[c * 64 + lane])) - m);
            for (int c = 0; c <= cmax; ++c) { const float p = fexp2(wave_sum(qd * bf2f(KC[c * 64 + lane])) - m) / l; const int j = c >> 2, e = c & 3;
                if (lane == j) imp += (e < 3 ? 2.f : 1.f) * p; if (e == 3 && lane == j + 1) imp += p;
                if (head == hq) ocmp += p * bf2f(VC[c * 64 + lane]); }
        }
        const int cur = t >> 6; const bool causal = lane <= cur, forced = (lane == 0) || (lane == cur) || (lane == cur - 1);
        const float key = causal ? (imp + (forced ? 1.0e4f : 0.f)) : -INFINITY; int rank = 0;
        for (int i = 0; i < 64; ++i) { const float ki = __shfl(key, i); rank += ((ki > key) || (ki == key && i < lane)) ? 1 : 0; }
        const unsigned long long refm = __ballot(causal && rank < 16), stm = SELM[(size_t)bhk * SEQ + t];
        if (lane == 0) { dbg_add(a, 2, (float)__popcll(refm ^ stm)); dbg_add(a, 3, 16.f); }
        const float qd = bf2f(H[tok * HLD + hq * 64 + lane]); const bf16* Hb = H + (size_t)b * SEQ * HLD + hk * 64 + lane;
        float m = -INFINITY, l = 0.f, osel = 0.f;
        for (int j = 0; j <= cur; ++j) if ((stm >> j) & 1ull) for (int kk = 0; kk < 64; ++kk) { const int p = 64 * j + kk; if (p > t) break;
            const float sc = wave_sum(qd * bf2f(Hb[(size_t)p * HLD + 512 + 2 * 128])); const float mn = fmaxf(m, sc), al = fexp2(m - mn), pp = fexp2(sc - mn);
            l = l * al + pp; osel = osel * al + pp * bf2f(Hb[(size_t)p * HLD + 512 + 3 * 128]); m = mn; }
        const float ysel = osel / fmaxf(l, 1e-30f);
        m = -INFINITY; l = 0.f; float owin = 0.f;
        for (int p = (t - 511 > 0 ? t - 511 : 0); p <= t; ++p) { const float sc = wave_sum(qd * bf2f(Hb[(size_t)p * HLD + 512 + 4 * 128])); const float mn = fmaxf(m, sc), al = fexp2(m - mn), pp = fexp2(sc - mn);
            l = l * al + pp; owin = owin * al + pp * bf2f(Hb[(size_t)p * HLD + 512 + 5 * 128]); m = mn; }
        const float ref = g_cmp * ocmp + g_sel * ysel + g_win * owin / fmaxf(l, 1e-30f), got = bf2f(Y[tok * DM + hq * 64 + lane]);
        const float e2 = wave_sum((ref - got) * (ref - got)), r2 = wave_sum(ref * ref);
        if (lane == 0) { dbg_add(a, 0, e2); dbg_add(a, 1, r2); }
    }
}

__device__ __forceinline__ void check_gdn(const Frame& F, ArgsP a, int l) {
    if (F.bid >= 8) return;
    const bf16* H = (const bf16*)(a->ws + WS_H); const float* side = (const float*)(a->ws + WS_SIDE); const bf16* Y = (const bf16*)(a->ws + WS_Y);
    const int b = F.bid, h = (F.bid * 3) & 3, tid = F.tid, lane = F.lane, col = tid & 63, rg = tid >> 6;
    LAS float* S = (LAS float*)F.lds; LAS float* qv = S + 64 * 65; LAS float* kv = qv + 64; LAS float* vv = kv + 64; LAS float* sc = vv + 64; LAS float* part = sc + 64;
    for (int i = tid; i < 64 * 65; i += NTHR) S[i] = 0.f;
    float hq[3] = {0.f, 0.f, 0.f}, hk[3] = {0.f, 0.f, 0.f}, hv[3] = {0.f, 0.f, 0.f}, wq[4], wk[4], wv[4];
    { const float* cw = a->in[6] + (size_t)l * 4 * 768 + h * 64 + lane;
#pragma unroll
      for (int k = 0; k < 4; ++k) { wq[k] = cw[k * 768]; wk[k] = cw[k * 768 + 256]; wv[k] = cw[k * 768 + 512]; } }
    const float Aexp = __expf(a->in[7][l * 4 + h]), dtb = a->in[8][l * 4 + h], nw = a->in[9][l * 64 + lane];
    __syncthreads();
    for (int t = 0; t < 192; ++t) {
        const size_t tok = (size_t)b * SEQ + t;
        if (F.wave == 0) { const bf16* p = H + tok * HLD + 1280 + h * 64 + lane; const float rq = bf2f(p[0]), rk = bf2f(p[256]), rv = bf2f(p[512]);
            const float cq = wq[0] * hq[0] + wq[1] * hq[1] + wq[2] * hq[2] + wq[3] * rq, ck = wk[0] * hk[0] + wk[1] * hk[1] + wk[2] * hk[2] + wk[3] * rk, cv = wv[0] * hv[0] + wv[1] * hv[1] + wv[2] * hv[2] + wv[3] * rv;
            hq[0] = hq[1]; hq[1] = hq[2]; hq[2] = rq; hk[0] = hk[1]; hk[1] = hk[2]; hk[2] = rk; hv[0] = hv[1]; hv[1] = hv[2]; hv[2] = rv;
            const float qs = cq / (1.f + __expf(-cq)), ks = ck / (1.f + __expf(-ck)), vs = cv / (1.f + __expf(-cv));
            qv[lane] = qs / sqrtf(wave_sum(qs * qs) + 1e-6f); kv[lane] = ks / sqrtf(wave_sum(ks * ks) + 1e-6f); vv[lane] = vs;
            if (lane == 0) { const float av = side[tok * 32 + 28 + h] + dtb; const float sp = av > 20.f ? av : log1pf(__expf(av)); sc[0] = __expf(-Aexp * sp); sc[1] = side[tok * 32 + 24 + h]; } }
        __syncthreads();
        { float ps = 0.f;
#pragma unroll
          for (int r = 0; r < 8; ++r) ps += kv[8 * rg + r] * S[(8 * rg + r) * 65 + col];
          part[rg * 64 + col] = ps; }
        __syncthreads();
        { float ks = 0.f;
#pragma unroll
          for (int r = 0; r < 8; ++r) ks += part[r * 64 + col];
          const float eg = sc[0], be = sc[1]; float po = 0.f;
          __syncthreads();
#pragma unroll
          for (int r = 0; r < 8; ++r) { const int dk = 8 * rg + r; const float sn = eg * (S[dk * 65 + col] - be * kv[dk] * ks) + be * kv[dk] * vv[col]; S[dk * 65 + col] = sn; po += sn * qv[dk]; }
          part[rg * 64 + col] = po; }
        __syncthreads();
        if (F.wave == 0) { float o = 0.f;
#pragma unroll
            for (int r = 0; r < 8; ++r) o += part[r * 64 + lane];
            o *= 0.125f; const float rs = 1.f / sqrtf(wave_sum(o * o) * (1.f / 64.f) + 1e-6f); const float z = bf2f(H[tok * HLD + 2048 + h * 64 + lane]);
            const float ref = o * rs * nw * (z / (1.f + __expf(-z))), got = bf2f(Y[tok * DM + 512 + h * 64 + lane]);
            const float e2 = wave_sum((ref - got) * (ref - got)), r2 = wave_sum(ref * ref);
            if (lane == 0) { dbg_add(a, 4, e2); dbg_add(a, 5, r2); } }
        __syncthreads();
    }
}

__device__ __forceinline__ void check_moe(const Frame& F, ArgsP a, int l) {
    const bf16* XBc = (const bf16*)(a->ws + WS_XB); const bf16* Y2 = (const bf16*)(a->ws + WS_Y2);
    const int* route_e = (const int*)(a->ws + WS_SLOT + SL_RE); const float* route_w = (const float*)(a->ws + WS_SLOT + SL_RW);
    LAS float* x = (LAS float*)F.lds; LAS float* hid = x + 1024; LAS float* lg = hid + 512; LAS float* yr = lg + 64;
    const int tid = F.tid, lane = F.lane;
    for (int s = F.bid; s < 256; s += F.G) {
        const int t = (s * 4099 + 17) & (T - 1);
        for (int i = tid; i < 1024; i += NTHR) { x[i] = bf2f(XBc[(size_t)t * DM + i]); yr[i] = 0.f; }
        __syncthreads();
        for (int j = F.wave; j < 36; j += NWAVES) { float d = 0.f; for (int k = lane; k < DM; k += 64) d += x[k] * (j < 4 ? a->in[18][((size_t)l * DM + k) * 4 + j] : a->in[20][((size_t)l * DM + k) * NEXP + j - 4]);
            d = wave_sum(d); if (lane == 0) lg[j] = d + (j < 4 ? a->in[19][l * 4 + j] : a->in[21][l * NEXP + j - 4]); }
        __syncthreads();
        if (tid == 0) { int gi = 0; for (int i = 1; i < 4; ++i) if (lg[i] > lg[gi]) gi = i; float gs = 0.f; for (int i = 0; i < 4; ++i) gs += __expf(lg[i] - lg[gi]); const float gw = 1.f / gs;
            int i1 = 0; for (int i = 1; i < 8; ++i) if (lg[4 + gi * 8 + i] > lg[4 + gi * 8 + i1]) i1 = i; int i2 = -1; for (int i = 0; i < 8; ++i) if (i != i1 && (i2 < 0 || lg[4 + gi * 8 + i] > lg[4 + gi * 8 + i2])) i2 = i;
            const float e2 = __expf(lg[4 + gi * 8 + i2] - lg[4 + gi * 8 + i1]), w1 = gw / (1.f + e2), w2 = gw - w1;
            const int se1 = route_e[2 * t], se2 = route_e[2 * t + 1]; const float sw1 = route_w[2 * t], sw2 = route_w[2 * t + 1];
            dbg_add(a, 8, (se1 != gi * 8 + i1 ? 1.f : 0.f) + (se2 != gi * 8 + i2 ? 1.f : 0.f)); dbg_add(a, 9, 2.f);
            if (se1 == gi * 8 + i1 && se2 == gi * 8 + i2) { dbg_add(a, 10, (sw1 - w1) * (sw1 - w1) + (sw2 - w2) * (sw2 - w2)); dbg_add(a, 11, w1 * w1 + w2 * w2); } }
        for (int k2 = 0; k2 < 2; ++k2) {
            const int e = route_e[2 * t + k2]; const float rw = route_w[2 * t + k2];
            const float* wg = a->in[22] + ((size_t)l * NEXP + e) * DM * FF; const float* wu = a->in[23] + ((size_t)l * NEXP + e) * DM * FF; const float* wd = a->in[24] + ((size_t)l * NEXP + e) * FF * DM;
            { float g = 0.f, u = 0.f; for (int k = 0; k < DM; ++k) { g += x[k] * wg[(size_t)k * FF + tid]; u += x[k] * wu[(size_t)k * FF + tid]; } hid[tid] = g / (1.f + __expf(-g)) * u; }
            __syncthreads();
            for (int d = tid; d < DM; d += NTHR) { float y = 0.f; for (int f = 0; f < FF; ++f) y += hid[f] * wd[(size_t)f * DM + d]; yr[d] += y * rw; }
            __syncthreads();
        }
        float e2 = 0.f, r2 = 0.f;
        for (int d = tid; d < DM; d += NTHR) { const float got = bf2f(Y2[(size_t)(2 * t) * DM + d]) + bf2f(Y2[(size_t)(2 * t + 1) * DM + d]); e2 += (yr[d] - got) * (yr[d] - got); r2 += yr[d] * yr[d]; }
        e2 = wave_sum(e2); r2 = wave_sum(r2); if (lane == 0) { dbg_add(a, 6, e2); dbg_add(a, 7, r2); }
        __syncthreads();
    }
}

__device__ __forceinline__ void check_inproj(const Frame& F, ArgsP a, int l) {
    const bf16* H = (const bf16*)(a->ws + WS_H); const float* xin = (l == 0) ? a->in[0] : (const float*)a->out; const float* win = a->in[1] + (size_t)l * DM * DIN;
    const int lane = F.lane;
    for (int s = F.bid * NWAVES + F.wave; s < 1024; s += F.G * NWAVES) {
        const int tok = (s * 7919 + 13) & (T - 1), grp = s % 14, t = tok & (SEQ - 1);
        const int col0 = grp < 8 ? grp * 64 : 512 + (grp - 8) * 128 + ((s >> 4) & 1) * 64; const bool isq = grp < 8, rope = isq || ((grp - 8) % 2 == 0);
        float d = 0.f; for (int k = 0; k < DM; ++k) d += xin[(size_t)tok * DM + k] * win[(size_t)k * DIN + col0 + lane];
        if (rope) { const float inv[8] = {1.0f, 0.19392274f, 0.03760603f, 0.0072926646f, 0.0014142136f, 0.0002742482f, 5.3182957e-05f, 1.0313385e-05f};
            float iv = inv[0];
#pragma unroll
            for (int q = 1; q < 8; ++q) iv = ((lane & 7) == q) ? inv[q] : iv;
            const float ang = (float)t * iv, c = cosf(ang), sn = sinf(ang), other = __shfl_xor(d, 8);
            if (lane < 8) d = d * c - other * sn; else if (lane < 16) d = d * c + other * sn; }
        if (isq) d *= pg8::QSCALE;
        const float got = bf2f(H[(size_t)tok * HLD + col0 + lane]); const float e2 = wave_sum((d - got) * (d - got)), r2 = wave_sum(d * d);
        if (lane == 0) { dbg_add(a, 12, e2); dbg_add(a, 13, r2); }
    }
}
__device__ __forceinline__ void check_compress(const Frame& F, ArgsP a, int l) {
    const bf16* H = (const bf16*)(a->ws + WS_H); const int lane = F.lane;
    for (int s = F.bid * NWAVES + F.wave; s < 512; s += F.G * NWAVES) {
        const int kv = s & 1, bh = (s >> 1) & 15, b = bh >> 1, hh = bh & 1, i = (s * 53 + 7) % 255;
        const float* pe = a->in[3] + ((size_t)l * 2 + kv) * 2048; const float* w1 = a->in[4] + ((size_t)l * 2 + kv) * 2048 * 128; const float* w2 = a->in[5] + ((size_t)l * 2 + kv) * 128 * 64;
        float h0 = 0.f, h1 = 0.f;
        for (int k = 0; k < 2048; ++k) { const int p = k >> 6, d = k & 63; const float x = bf2f(H[((size_t)b * SEQ + 16 * i + p) * HLD + 512 + kv * 128 + hh * 64 + d]) + pe[k];
            h0 += x * w1[(size_t)k * 128 + lane]; h1 += x * w1[(size_t)k * 128 + 64 + lane]; }
        h0 = h0 / (1.f + __expf(-h0)); h1 = h1 / (1.f + __expf(-h1));
        float o = 0.f;
        for (int n = 0; n < 64; ++n) { o += __shfl(h0, n) * w2[(size_t)n * 64 + lane] + __shfl(h1, n) * w2[(size_t)(64 + n) * 64 + lane]; }
        const float got = bf2f(((const bf16*)(a->ws + (kv ? WS_VC : WS_KC)))[((size_t)bh * 256 + i) * 64 + lane]);
        const float e2 = wave_sum((o - got) * (o - got)), r2 = wave_sum(o * o); if (lane == 0) { dbg_add(a, 14, e2); dbg_add(a, 15, r2); }
    }
}
__device__ __forceinline__ void check_conformer(const Frame& F, ArgsP a, int l) {
    const bf16* H = (const bf16*)(a->ws + WS_H); const bf16* Y = (const bf16*)(a->ws + WS_Y); const int lane = F.lane;
    for (int s = F.bid * NWAVES + F.wave; s < 1024; s += F.G * NWAVES) {
        const int tok = (s * 6151 + 3) & (T - 1), t = tok & (SEQ - 1); float u[4];
#pragma unroll
        for (int j = 0; j < 4; ++j) { const int c = lane + 64 * j; float acc = a->in[11][l * 256 + c];
            for (int k = 0; k < 31; ++k) { const int sp = t - 30 + k; if (sp >= 0) { const bf16* hp = H + (size_t)(tok - 30 + k) * HLD + 2304 + c; const float g = bf2f(hp[256]); acc += a->in[10][((size_t)l * 31 + k) * 256 + c] * (bf2f(hp[0]) / (1.f + __expf(-g))); } }
            u[j] = acc; }
        const float mean = wave_sum(u[0] + u[1] + u[2] + u[3]) * (1.f / 256.f); float q = 0.f;
#pragma unroll
        for (int j = 0; j < 4; ++j) { u[j] -= mean; q += u[j] * u[j]; }
        const float rstd = 1.f / sqrtf(wave_sum(q) * (1.f / 256.f) + LN_EPS); float e2 = 0.f, r2 = 0.f;
#pragma unroll
        for (int j = 0; j < 4; ++j) { const int c = lane + 64 * j; const float v = u[j] * rstd * a->in[12][l * 256 + c] + a->in[13][l * 256 + c]; const float ref = v / (1.f + __expf(-v)), got = bf2f(Y[(size_t)tok * DM + 768 + c]);
            e2 += (ref - got) * (ref - got); r2 += ref * ref; }
        e2 = wave_sum(e2); r2 = wave_sum(r2); if (lane == 0) { dbg_add(a, 16, e2); dbg_add(a, 17, r2); }
    }
}
__device__ __forceinline__ void check_inject(const Frame& F, ArgsP a) {
    if (F.bid == 0 && F.tid == 0) { const float* d = (const float*)(a->ws + WS_DBG); float e0 = 0.f, e1 = 0.f;
        if (SELFCHECK == 1) { e0 = 1000.f * sqrtf(d[0] / d[1]); e1 = 1.0e4f * d[2] / d[3]; }
        if (SELFCHECK == 2) { e0 = 1000.f * sqrtf(d[4] / d[5]); }
        if (SELFCHECK == 3) { e0 = 1000.f * sqrtf(d[6] / d[7]); e1 = 1.0e4f * d[8] / d[9] + 1000.f * sqrtf(d[10] / fmaxf(d[11], 1e-30f)); }
        if (SELFCHECK == 4) { e0 = 1000.f * sqrtf(d[12] / d[13]); }
        if (SELFCHECK == 5) { e0 = 1000.f * sqrtf(d[14] / d[15]); e1 = 1000.f * sqrtf(d[16] / d[17]); }
        a->out[0] += e0; a->out[1] += e1; }
}


#ifndef MK_MULTI
#define MK_MULTI 0
#endif
#ifndef PROBE_REPEAT
#define PROBE_REPEAT 0
#endif
constexpr int N_PHASES = 1 + 10 * NL;
__device__ __forceinline__ Frame make_frame(int wave_s) {
    extern __shared__ __attribute__((aligned(16))) unsigned char lds_raw[];
    Frame F; F.lds = (LAS unsigned char*)lds_raw; F.MISC = (volatile LAS unsigned*)(F.lds + MISC_OFF);
    int tid = threadIdx.x, G = gridDim.x, bid = blockIdx.x; unsigned lb = (unsigned)(size_t)F.lds; (void)wave_s;
    asm volatile("" : "+v"(tid), "+s"(G), "+s"(bid), "+s"(lb));
    F.lds = (LAS unsigned char*)(size_t)lb; F.MISC = (volatile LAS unsigned*)(F.lds + MISC_OFF);
    F.tid = tid; F.lane = F.tid & 63; F.wave = __builtin_amdgcn_readfirstlane(F.tid >> 6); F.G = G; F.bid = bid;
    F.ctl = (unsigned*)(args_here()->ws + WS_CTL); return F;
}
__device__ __forceinline__ void ph_prologue(int, int wv) { const Frame F = make_frame(wv); phase_prologue(F, args_here()); phase_weights(F, args_here(), 0);
#if SELFCHECK
    if (F.bid == 0 && F.tid < 64) ((float*)(args_here()->ws + WS_DBG))[F.tid] = 0.f;
#endif
}
__device__ __forceinline__ void ph_inproj(int, int wv) { const Frame F = make_frame(wv); unsigned char* ws = args_here()->ws;
    pg8::Gemm g{(const bf16*)(ws + WS_XB), (const bf16*)(ws + WS_WL + WL_WIN), T, DINP, DM}; pg8::StaticOrder S; S.init(T, DINP, F.G, F.bid);
    pg8::EpiInProj E{(bf16*)(ws + WS_H), (float*)(ws + WS_SIDE), (const float*)(ws + WS_ROPE)};
    pg8::gemm_phase<pg8::EpiInProj, pg8::StaticOrder, false>(F.lds, g, S, E, nullptr, F.tid); }
__device__ __forceinline__ void ph_compress(int l, int wv) { const Frame F = make_frame(wv); for (int it = F.bid; it < 256; it += F.G) compress_item(F, args_here(), it); }
__device__ __forceinline__ void ph_gdnprep(int l, int wv) { const Frame F = make_frame(wv); for (int it = F.bid; it < 256; it += F.G) { gdn_prep_chunk<0>(F, args_here(), l, it * 8 + F.wave, F.lds + F.wave * 16384); __syncthreads(); } }
__device__ __forceinline__ void ph_gdnprep_var(int l, int wv) { const Frame F = make_frame(wv); for (int it = F.bid; it < 256; it += F.G) { gdn_prep_chunk<PROBE_GDN_VAR | 1>(F, args_here(), l, it * 8 + F.wave, F.lds + F.wave * 16384); __syncthreads(); } }
__device__ __forceinline__ void ph_conformer(int l, int wv) { const Frame F = make_frame(wv); for (int it = F.bid; it < 512; it += F.G) conformer_item(F, args_here(), l, it); }
__device__ __forceinline__ void ph_gdnout(int l, int wv) { const Frame F = make_frame(wv); for (int ci = F.bid * NWAVES + F.wave; ci < 2048; ci += F.G * NWAVES) gdn_out_chunk(F, args_here(), ci, F.lds + F.wave * 8192); }
__device__ __forceinline__ void ph_scan(int l, int wv) { const Frame F = make_frame(wv); if (F.bid < 16) gdn_scan<0>(F, args_here(), l); }
__device__ __forceinline__ void ph_scan_var(int l, int wv) { const Frame F = make_frame(wv); if (F.bid < 16) gdn_scan<(PROBE_SCAN_VAR & 1)>(F, args_here(), l); }
__device__ __forceinline__ void ph_attn(int l, int rep, int wv) { const Frame F = make_frame(wv); phase_mix_b(F, args_here(), l, rep); }
__device__ __forceinline__ void ph_outproj(int l, int wv) { const Frame F = make_frame(wv); ArgsP ap = args_here(); unsigned char* ws = ap->ws;
    pg8::Gemm g{(const bf16*)(ws + WS_Y), (const bf16*)(ws + WS_WL + WL_WOUT), T, DM, DM}; pg8::StaticOrder S; S.init(T, DM, F.G, F.bid);
    pg8::EpiOutProj E{(const bf16*)(ws + WS_XB), (float*)(ws + WS_X1), DN_ALPHA};
    pg8::gemm_phase<pg8::EpiOutProj, pg8::StaticOrder, false>(F.lds, g, S, E, nullptr, F.tid); }
__device__ __forceinline__ void ph_ln1(int l, int wv) { const Frame F = make_frame(wv); phase_ln1_router<false>(F, args_here(), l); }
__device__ __forceinline__ void ph_ln1_dry(int l, int wv) { const Frame F = make_frame(wv); phase_ln1_router<true>(F, args_here(), l); }
__device__ __forceinline__ void ph_gather(int l, int wv) { const Frame F = make_frame(wv); phase_gather(F, args_here(), l); }
__device__ __forceinline__ void ph_moeup(int l, int wv) { const Frame F = make_frame(wv); unsigned char* ws = args_here()->ws;
    pg8::Gemm g{(const bf16*)(ws + WS_H), (const bf16*)(ws + WS_WL + WL_WGU), 0, 0, DM / 2};   pg8::MoeOrder S{(const int*)(ws + WS_META) + l * 512, F.G, F.bid};
    pg8::EpiSwiGLU E{ws + WS_HID, (const int*)(ws + WS_SLOT + SL_TOK), 1};
    pg8::gemm_phase<pg8::EpiSwiGLU, pg8::MoeOrder, false>(F.lds, g, S, E, nullptr, F.tid); }
__device__ __forceinline__ void ph_moedown(int l, int wv) { const Frame F = make_frame(wv); unsigned char* ws = args_here()->ws;
    pg8::Gemm g{(const bf16*)(ws + WS_HID), (const bf16*)(ws + WS_WL + WL_WDN), 0, 0, FF / 2}; pg8::MoeOrder S{(const int*)(ws + WS_META) + l * 512, F.G, F.bid};
    pg8::EpiDown E{(bf16*)(ws + WS_Y2), (const int*)(ws + WS_SLOT + SL_TOK), (const float*)(ws + WS_SLOT + SL_W)};
    pg8::gemm_phase<pg8::EpiDown, pg8::MoeOrder, false>(F.lds, g, S, E, nullptr, F.tid); }
__device__ __forceinline__ void ph_ln2(int l, int wv) { const Frame F = make_frame(wv); phase_ln2(F, args_here(), l); }
__device__ __forceinline__ void ph_weights(int l, int wv) { const Frame F = make_frame(wv); if (l + 1 < NL) phase_weights(F, args_here(), l + 1); }

__global__ void __launch_bounds__(NTHR, 2) fwd_kernel(Args args) {
    extern __shared__ __attribute__((aligned(16))) unsigned char lds_raw[];
    (void)lds_raw; const int wv = 0; const Frame F = make_frame(wv);
    if (F.tid < 64) F.MISC[F.tid] = 0u;
    __syncthreads();
    XcdBarrier bar = xcd_barrier_post(F.ctl + CW_BAR, F.MISC + 8);
    const int lo = args_here()->ph_lo, hi = args_here()->ph_hi;
#define IN(k) (lo <= (k) && (k) < hi)
#define SEAM(k) do { if (IN(k) && IN((k) + 1)) { XcdBarrier bb = bar; asm volatile("" : "+s"(bb.bar)); xcd_barrier(bb); } } while (0)
#define RPT(bit, call) do { call; if (PROBE_REPEAT & (1u << (bit))) { XcdBarrier bb = bar; asm volatile("" : "+s"(bb.bar)); xcd_barrier(bb); call; } } while (0)
    if (IN(0)) ph_prologue(0, wv);
    SEAM(0);
#define LAYER_BODY(l) do { \
        const int pb = 1 + 10 * l; \
        if (IN(pb + 0)) RPT(0, ph_inproj(l, wv)); \
        SEAM(pb + 0); \
        if constexpr (SELFCHECK == 4) { \
        if (l == CHECK_LAYER) { { const Frame F2 = make_frame(wv); check_inproj(F2, args_here(), l); } XcdBarrier bb = bar; asm volatile("" : "+s"(bb.bar)); xcd_barrier(bb); } \
        } \
        if (IN(pb + 1)) { RPT(16, ph_compress(l, wv)); ph_gdnprep(l, wv); if (PROBE_REPEAT & (1u << 17)) { XcdBarrier bb = bar; asm volatile("" : "+s"(bb.bar)); xcd_barrier(bb); ph_gdnprep_var(l, wv); } RPT(18, ph_conformer(l, wv)); } \
        SEAM(pb + 1); \
        if (IN(pb + 2)) { ph_scan(l, wv); if (PROBE_REPEAT & (1u << 19)) { XcdBarrier bb = bar; asm volatile("" : "+s"(bb.bar)); xcd_barrier(bb); ph_scan_var(l, wv); XcdBarrier bb2 = bar; asm volatile("" : "+s"(bb2.bar)); xcd_barrier(bb2); } ph_attn(l, 0, wv); if (PROBE_REPEAT & (1u << 20)) { XcdBarrier bb = bar; asm volatile("" : "+s"(bb.bar)); xcd_barrier(bb); ph_attn(l, 1, wv); } } \
        SEAM(pb + 2); \
        if (IN(pb + 3)) RPT(24, ph_gdnout(l, wv)); \
        SEAM(pb + 3); \
        if constexpr (SELFCHECK == 1 || SELFCHECK == 2 || SELFCHECK == 5) { \
        if (l == CHECK_LAYER) { { const Frame F2 = make_frame(wv); if (SELFCHECK == 1) check_nsa(F2, args_here()); else if (SELFCHECK == 2) check_gdn(F2, args_here(), l); else { check_compress(F2, args_here(), l); check_conformer(F2, args_here(), l); } } XcdBarrier bb = bar; asm volatile("" : "+s"(bb.bar)); xcd_barrier(bb); } \
        } \
        if (IN(pb + 4)) RPT(3, ph_outproj(l, wv)); \
        SEAM(pb + 4); \
        if (IN(pb + 5)) { ph_ln1(l, wv); if (PROBE_REPEAT & (1u << 4)) { XcdBarrier bb = bar; asm volatile("" : "+s"(bb.bar)); xcd_barrier(bb); ph_ln1_dry(l, wv); } \
            if (PROBE_REPEAT & (1u << 23)) { for (int rr = 0; rr < 4; ++rr) { XcdBarrier bb = bar; asm volatile("" : "+s"(bb.bar)); xcd_barrier(bb); } } } \
        SEAM(pb + 5); \
        if (IN(pb + 6)) RPT(5, ph_gather(l, wv)); \
        SEAM(pb + 6); \
        if (IN(pb + 7)) RPT(6, ph_moeup(l, wv)); \
        SEAM(pb + 7); \
        if (IN(pb + 8)) RPT(7, ph_moedown(l, wv)); \
        SEAM(pb + 8); \
        if constexpr (SELFCHECK == 3) { \
        if (l == CHECK_LAYER) { { const Frame F2 = make_frame(wv); check_moe(F2, args_here(), l); } XcdBarrier bb = bar; asm volatile("" : "+s"(bb.bar)); xcd_barrier(bb); } \
        } \
        if (IN(pb + 9)) { RPT(22, ph_ln2(l, wv)); RPT(21, ph_weights(l, wv)); } \
        SEAM(pb + 9); \
     \
    } while (0)
    LAYER_BODY(0); LAYER_BODY(1); LAYER_BODY(2); LAYER_BODY(3);
#undef LAYER_BODY
#undef RPT
#if SELFCHECK
    { XcdBarrier bb = bar; asm volatile("" : "+s"(bb.bar)); xcd_barrier(bb); const Frame F2 = make_frame(wv); check_inject(F2, args_here()); }
#endif
#undef IN
#undef SEAM
}

extern "C" void kernel_launch(void* const* d_in, const int* in_sizes, int n_in, void* d_out, int out_size, void* d_ws, size_t ws_size, hipStream_t stream) {
    static int grid = 0;
    if (grid == 0) {
        if (n_in != 25 || in_sizes[0] != T * DM || out_size != T * DM || ws_size < WS_END) { fprintf(stderr, "kernel_launch: shape/workspace mismatch (n_in %d, in0 %d, out %d, ws %zu < %zu); nothing launched\n", n_in, n_in > 0 ? in_sizes[0] : -1, out_size, ws_size, (size_t)WS_END); grid = -1; return; }
        int dev = 0, cus = 0, per_cu = 0;
        if (hipGetDevice(&dev) != hipSuccess || hipDeviceGetAttribute(&cus, hipDeviceAttributeMultiprocessorCount, dev) != hipSuccess) { grid = -1; return; }
        if (hipFuncSetAttribute((const void*)fwd_kernel, hipFuncAttributeMaxDynamicSharedMemorySize, LDS_BYTES) != hipSuccess) { fprintf(stderr, "kernel_launch: hipFuncSetAttribute failed\n"); grid = -1; return; }
        if (hipOccupancyMaxActiveBlocksPerMultiprocessor(&per_cu, (const void*)fwd_kernel, NTHR, LDS_BYTES) != hipSuccess || per_cu < 1)
            fprintf(stderr, "kernel_launch: note: occupancy query reports %d workgroups per CU\n", per_cu);
        (void)hipGetLastError();
        grid = cus;
        if (grid < 32 || (grid & 7)) { fprintf(stderr, "kernel_launch: unexpected CU count %d\n", cus); }
    }
    if (grid < 0) return;
    if (hipMemsetAsync((char*)d_ws + WS_CTL, 0, CTL_ZERO_BYTES, stream) != hipSuccess) return;
    Args a{};
    for (int i = 0; i < 25; ++i) a.in[i] = (const float*)d_in[i];
    a.out = (float*)d_out; a.ws = (unsigned char*)d_ws;
#if MK_MULTI
    for (int p = 0; p < N_PHASES; ++p) { a.ph_lo = p; a.ph_hi = p + 1; hipLaunchKernelGGL(fwd_kernel, dim3(grid), dim3(NTHR), LDS_BYTES, stream, a); }
#else
    a.ph_lo = 0; a.ph_hi = N_PHASES;
    hipLaunchKernelGGL(fwd_kernel, dim3(grid), dim3(NTHR), LDS_BYTES, stream, a);
#endif
}
```

```cpp
#include <hip/hip_runtime.h>
#include <cstdio>
#include <cstdint>
namespace pg8 {
#define PG8_LAS __attribute__((address_space(3)))
typedef unsigned short bf16_t;
typedef short bf16x8 __attribute__((ext_vector_type(8)));
typedef float f32x4 __attribute__((ext_vector_type(4)));
typedef unsigned u32x4 __attribute__((ext_vector_type(4)));
constexpr int BM = 256, BK = 64, HALF = 128, HTB = HALF * BK * 2  , STAGE_BYTES = 8 * HTB, NXCD = 8, WGM = 8;

__host__ __device__ __forceinline__ int lds_byte(int r, int c) { const int st = (r >> 4) * 2 + (c >> 5), rr = r & 15, cc = c & 31, ob = rr * 64 + cc * 2; return st * 1024 + (ob ^ (((ob >> 9) & 1) << 5)); }
__host__ __device__ __forceinline__ void stage_rc(int b, int& R, int& C) { const int st = b / 1024, sb = b % 1024, swz = sb ^ (((sb >> 9) & 1) << 5); R = (st >> 1) * 16 + swz / 64; C = (st & 1) * 32 + (swz % 64) / 2; }
__host__ __device__ __forceinline__ int perm32(int rho) { const int n = rho >> 4, i = rho & 15; return 8 * (i >> 2) + 4 * n + (i & 3); }

struct Unit { int pm, pn; };
struct Gemm { const bf16_t* A; const bf16_t* Bt; int M, N, K; };

struct StaticOrder {
    int nM, nN, nwg, G, c;
    __host__ __device__ void init(int M, int N, int G_, int c_) { nM = M / BM; nN = N / BM; nwg = nM * nN; G = G_; c = c_; }
    __host__ __device__ bool next(int i, Unit& u) const {
        const long L = (long)i * G + c; if (L >= nwg) return false;
        int wgid = (int)L; { const int q = nwg / NXCD, r = nwg % NXCD, xcd = wgid % NXCD, off = wgid / NXCD; wgid = (xcd < r ? xcd * (q + 1) : r * (q + 1) + (xcd - r) * q) + off; }
        const int nig = WGM * nN, gid = wgid / nig, fm = gid * WGM, gsz = (nM - fm) < WGM ? (nM - fm) : WGM;
        u.pm = fm + ((wgid % nig) % gsz); u.pn = (wgid % nig) / gsz; return true;
    }
    __device__ __forceinline__ void a_ready(const Unit&) const {}
    __device__ __forceinline__ void done(const Unit&) const {}
};

__device__ __forceinline__ unsigned cvt_pk_bf16(float lo, float hi) { unsigned r; asm volatile("v_cvt_pk_bf16_f32 %0, %1, %2" : "=v"(r) : "v"(lo), "v"(hi)); return r; }
__device__ __forceinline__ float fast_sigmoid(float x) { return __builtin_amdgcn_rcpf(1.0f + __builtin_amdgcn_exp2f(-1.44269504089f * x)); }

constexpr int HLD = 2816;
constexpr float QSCALE = 0.125f * 1.44269504089f;

struct EpiInProj {
    static constexpr bool PERM = true, AFTER_DRAIN = false, GATHER = false, FP8 = false;
    bf16_t* H; float* side; const float* rope;
    __device__ __forceinline__ void operator()(const f32x4 (&acc)[2][2][4][2], const Unit& u, int wr, int wc, int fr, int fq) const {
        const int row0 = u.pm * BM + wr * 64 + fr; const int pn = u.pn;
        if (pn <= 4) {
#pragma unroll
            for (int ai = 0; ai < 2; ++ai)
#pragma unroll
                for (int m = 0; m < 4; ++m) {
                    const int row = row0 + ai * HALF + m * 16; const float* rp = rope + (size_t)(row & 4095) * 16;
                    const f32x4 c0 = *(const f32x4*)(rp), c1 = *(const f32x4*)(rp + 4), s0 = *(const f32x4*)(rp + 8), s1 = *(const f32x4*)(rp + 12);
#pragma unroll
                    for (int bj = 0; bj < 2; ++bj) {
                        f32x4 v0 = acc[ai][bj][m][0], v1 = acc[ai][bj][m][1];
                        const bool ropeb = (pn < 2) || (bj == 0);
                        if (ropeb) {
                            f32x4 p0, p1;
#pragma unroll
                            for (int e = 0; e < 4; ++e) { p0[e] = __shfl_xor(v0[e], 16); p1[e] = __shfl_xor(v1[e], 16); }
                            if (((wc & 1) == 0) && fq < 2) { const float sg = fq ? 1.f : -1.f; v0 = v0 * c0 + (p0 * s0) * sg; v1 = v1 * c1 + (p1 * s1) * sg; }
                        }
                        if (pn < 2) { v0 = v0 * QSCALE; v1 = v1 * QSCALE; }
                        u32x4 w; w.x = cvt_pk_bf16(v0[0], v0[1]); w.y = cvt_pk_bf16(v0[2], v0[3]); w.z = cvt_pk_bf16(v1[0], v1[1]); w.w = cvt_pk_bf16(v1[2], v1[3]);
                        *(u32x4*)(H + (size_t)row * HLD + pn * BM + bj * HALF + wc * 32 + 8 * fq) = w;
                    }
                }
        } else if (pn < 11) {
#pragma unroll
            for (int ai = 0; ai < 2; ++ai)
#pragma unroll
                for (int m = 0; m < 4; ++m) {
                    const int row = row0 + ai * HALF + m * 16;
#pragma unroll
                    for (int bj = 0; bj < 2; ++bj) {
                        const f32x4 v0 = acc[ai][bj][m][0], v1 = acc[ai][bj][m][1];
                        u32x4 w; w.x = cvt_pk_bf16(v0[0], v0[1]); w.y = cvt_pk_bf16(v0[2], v0[3]); w.z = cvt_pk_bf16(v1[0], v1[1]); w.w = cvt_pk_bf16(v1[2], v1[3]);
                        *(u32x4*)(H + (size_t)row * HLD + pn * BM + bj * HALF + wc * 32 + 8 * fq) = w;
                    }
                }
        } else if (wc == 0) {
#pragma unroll
            for (int ai = 0; ai < 2; ++ai)
#pragma unroll
                for (int m = 0; m < 4; ++m) {
                    const int row = row0 + ai * HALF + m * 16;
                    f32x4 v0 = acc[ai][0][m][0], v1 = acc[ai][0][m][1];
#pragma unroll
                    for (int e = 0; e < 4; ++e) { v0[e] = fast_sigmoid(v0[e]); if (fq < 3) v1[e] = fast_sigmoid(v1[e]); }
                    *(f32x4*)(side + (size_t)row * 32 + 8 * fq) = v0; *(f32x4*)(side + (size_t)row * 32 + 8 * fq + 4) = v1;
                }
        }
    }
};
struct EpiOutProj {
    static constexpr bool PERM = false, AFTER_DRAIN = false, GATHER = false, FP8 = false;
    const bf16_t* res; float* out; float alpha;
    __device__ __forceinline__ void operator()(const f32x4 (&acc)[2][2][4][2], const Unit& u, int wr, int wc, int fr, int fq) const {
        typedef unsigned u32x2 __attribute__((ext_vector_type(2)));
        const int row0 = u.pm * BM + wr * 64 + fr, col0 = u.pn * BM + wc * 32 + 4 * fq;
#pragma unroll
        for (int ai = 0; ai < 2; ++ai)
#pragma unroll
            for (int m = 0; m < 4; ++m) { const size_t off = (size_t)(row0 + ai * HALF + m * 16) * 1024 + col0;
#pragma unroll
                for (int bj = 0; bj < 2; ++bj)
#pragma unroll
                    for (int n = 0; n < 2; ++n) { const u32x2 rb = *(const u32x2*)(res + off + bj * HALF + n * 16);
                        f32x4 r; r[0] = __uint_as_float(rb.x << 16); r[1] = __uint_as_float(rb.x & 0xffff0000u); r[2] = __uint_as_float(rb.y << 16); r[3] = __uint_as_float(rb.y & 0xffff0000u);
                        *(f32x4*)(out + off + bj * HALF + n * 16) = r * alpha + acc[ai][bj][m][n]; }
                asm volatile("" ::: "memory"); }
    }
};
struct EpiSwiGLU {
    static constexpr bool PERM = true, AFTER_DRAIN = false, GATHER = true, FP8 = true;
    unsigned char* hid; const int* rowmap; int rowshift;
    __device__ __forceinline__ void operator()(const f32x4 (&acc)[2][2][4][2], const Unit& u, int wr, int wc, int fr, int fq) const {
        const int row0 = u.pm * BM + wr * 64 + fr, hc0 = (u.pn & 3) * 128 + wc * 16 + 4 * fq;
#pragma unroll
        for (int ai = 0; ai < 2; ++ai)
#pragma unroll
            for (int m = 0; m < 4; ++m) { unsigned char* rowp = hid + (size_t)(row0 + ai * HALF + m * 16) * 512 + hc0;
#pragma unroll
                for (int bj = 0; bj < 2; ++bj) { const f32x4 g = acc[ai][bj][m][0] * 0.03125f, up = acc[ai][bj][m][1] * 0.03125f; f32x4 h;
#pragma unroll
                    for (int e = 0; e < 4; ++e) h[e] = __builtin_amdgcn_fmed3f(g[e] * fast_sigmoid(g[e]) * up[e], -440.f, 440.f);
                    int w = 0; w = __builtin_amdgcn_cvt_pk_fp8_f32(h[0], h[1], w, false); w = __builtin_amdgcn_cvt_pk_fp8_f32(h[2], h[3], w, true);
                    *(int*)(rowp + bj * 64) = w; } }
    }
};
struct EpiDown {
    static constexpr bool PERM = true, AFTER_DRAIN = false, GATHER = false, FP8 = true;
    bf16_t* y2; const int* slot_tok; const float* slot_w;
    __device__ __forceinline__ void operator()(const f32x4 (&acc)[2][2][4][2], const Unit& u, int wr, int wc, int fr, int fq) const {
        const int row0 = u.pm * BM + wr * 64 + fr, col0 = (u.pn & 3) * BM + wc * 32 + 8 * fq;
#pragma unroll
        for (int ai = 0; ai < 2; ++ai)
#pragma unroll
            for (int m = 0; m < 4; ++m) { const int row = row0 + ai * HALF + m * 16; const int st = slot_tok[row]; const float sw = slot_w[row] * 0.015625f;
                if (st >= 0) { bf16_t* rowp = y2 + (size_t)st * 1024 + col0;
#pragma unroll
                    for (int bj = 0; bj < 2; ++bj) { const f32x4 v0 = acc[ai][bj][m][0] * sw, v1 = acc[ai][bj][m][1] * sw;
                        u32x4 w; w.x = cvt_pk_bf16(v0[0], v0[1]); w.y = cvt_pk_bf16(v0[2], v0[3]); w.z = cvt_pk_bf16(v1[0], v1[1]); w.w = cvt_pk_bf16(v1[2], v1[3]);
                        *(u32x4*)(rowp + bj * HALF) = w; } } }
    }
};
struct MoeOrder {
    const int* meta; int G, c;
    __device__ __forceinline__ bool next(int i, Unit& u) const {
        const int per = G >> 3; const int idx = (G & 7) ? (i * G + c) : ((i * 8 + (c & 7)) * per + (c >> 3));
        const int nt = __builtin_amdgcn_readfirstlane(meta[0]); if (idx >= nt * 4) return false;
        const int pm = idx >> 2; u.pm = pm; u.pn = __builtin_amdgcn_readfirstlane(meta[64 + pm]) * 4 + (idx & 3); return true;
    }
    __device__ __forceinline__ void a_ready(const Unit&) const {}
    __device__ __forceinline__ void done(const Unit&) const {}
};
typedef int v4i_ __attribute__((ext_vector_type(4)));
typedef int v8i_ __attribute__((ext_vector_type(8)));
template <class Epi, class Sched, bool STAMP = false>
__device__ __forceinline__ void gemm_phase(PG8_LAS unsigned char* lds, const Gemm g, const Sched& S, const Epi& E, unsigned long long* stamps, int tid_in) {
    int tid_ = tid_in; asm volatile("" : "+v"(tid_));
    const int tid = tid_, wid = __builtin_amdgcn_readfirstlane(tid >> 6), lane = tid & 63, wr = wid >> 2, wc = wid & 3, fr = lane & 15, fq = lane >> 4;
    const int K = g.K, nt = K / BK;
    int ts_lo = 0, ts_hi = 0, nts = 0; const unsigned long long rt_entry = STAMP ? (unsigned long long)wall_clock64() : 0ull;
#define PG8_STAMP() do { if (STAMP && wid == 0 && nts < 64) { const unsigned long long _c = (unsigned long long)clock64(); \
        ts_lo = (lane == nts) ? (int)(unsigned)_c : ts_lo; ts_hi = (lane == nts) ? (int)(unsigned)(_c >> 32) : ts_hi; ++nts; } } while (0)
    PG8_STAMP();
    unsigned voffA[2], voffB[2];
#pragma unroll
    for (int i = 0; i < 2; ++i) { int R, C; stage_rc(tid * 16 + i * 8192, R, C); const int Rb = Epi::PERM ? ((R & ~31) + perm32(R & 31)) : R;
        voffA[i] = (unsigned)(R * K + C) * 2u; voffB[i] = (unsigned)(Rb * K + C) * 2u; }
    unsigned offAc[2][2], offAn[2][2];
    PG8_LAS unsigned char* gidx = lds + STAGE_BYTES + (unsigned)wid * 1024u;
#define PG8_IDX_DMA(par, pm_) do { int t2_ = tid; asm volatile("" : "+v"(t2_)); _Pragma("unroll") for (int i_ = 0; i_ < 2; ++i_) { int R_, C_; stage_rc(t2_ * 16 + i_ * 8192, R_, C_); (void)C_; \
        _Pragma("unroll") for (int h_ = 0; h_ < 2; ++h_) __builtin_amdgcn_global_load_lds((const unsigned*)(E.rowmap + (size_t)(pm_) * BM + h_ * HALF + R_), (PG8_LAS unsigned*)(gidx + (par) * 512 + (h_ * 2 + i_) * 256), 4, 0, 0); } } while (0)
#define PG8_IDX_READ(dst, par) do { int t2_ = tid; asm volatile("" : "+v"(t2_)); _Pragma("unroll") for (int i_ = 0; i_ < 2; ++i_) { int R_, C_; stage_rc(t2_ * 16 + i_ * 8192, R_, C_); (void)R_; \
        _Pragma("unroll") for (int h_ = 0; h_ < 2; ++h_) { int r_ = *(const PG8_LAS int*)(gidx + (par) * 512 + (h_ * 2 + i_) * 256 + (t2_ & 63) * 4); r_ = r_ < 0 ? 0 : (r_ >> E.rowshift); dst[h_][i_] = (unsigned)r_ * (unsigned)(K * 2) + (unsigned)C_ * 2u; } } } while (0)
    const size_t kstep = (size_t)(BK * 2);
    const size_t hstep = (size_t)HALF * K * 2;
    const size_t tstep = 2 * hstep;
    const unsigned ldsw = (unsigned)wid * 1024u;
    const int aoff = lds_byte(wr * 64 + fr, fq * 8), boff = lds_byte(wc * 32 + fr, fq * 8);
#define PG8_SA(b, h) (((b) * 2 + (h)) * HTB)
#define PG8_SB(b, h) ((4 + (b) * 2 + (h)) * HTB)
#define PG8_STAGE(bufoff, gbase, voff) do { _Pragma("unroll") for (int _i = 0; _i < 2; ++_i) \
        __builtin_amdgcn_global_load_lds((const unsigned*)((const char*)(gbase) + (voff)[_i]), (PG8_LAS unsigned*)(lds + (bufoff) + ldsw + _i * 8192), 16, 0, 0); } while (0)
#define PG8_STAGE_A(bufoff, kt_, h_, nx_) do { if constexpr (Epi::GATHER) { _Pragma("unroll") for (int _i = 0; _i < 2; ++_i) { const unsigned o_ = (nx_) ? offAn[h_][_i] : offAc[h_][_i]; \
            __builtin_amdgcn_global_load_lds((const unsigned*)((const char*)g.A + (size_t)(kt_) * kstep + o_), (PG8_LAS unsigned*)(lds + (bufoff) + ldsw + _i * 8192), 16, 0, 0); } } \
        else { PG8_STAGE(bufoff, ((nx_) ? nA : cA) + (size_t)(kt_) * kstep + (h_) * hstep, voffA); } } while (0)
#define PG8_LDA(dst, b, h) do { _Pragma("unroll") for (int m = 0; m < 4; ++m) _Pragma("unroll") for (int k = 0; k < 2; ++k) dst[m][k] = *(const PG8_LAS bf16x8*)(lds + PG8_SA(b, h) + aoff + m * 2048 + k * 1024); } while (0)
#define PG8_LDB(dst, b, h) do { _Pragma("unroll") for (int n = 0; n < 2; ++n) _Pragma("unroll") for (int k = 0; k < 2; ++k) dst[n][k] = *(const PG8_LAS bf16x8*)(lds + PG8_SB(b, h) + boff + n * 2048 + k * 1024); } while (0)
#define PG8_MMA(ai, bj, At, Bt) do { __builtin_amdgcn_s_setprio(1); \
        if constexpr (Epi::FP8) {   \
            _Pragma("unroll") for (int m = 0; m < 4; ++m) _Pragma("unroll") for (int n = 0; n < 2; ++n) \
                { const v8i_ b8_ = __builtin_shufflevector(__builtin_bit_cast(v4i_, Bt[n][0]), __builtin_bit_cast(v4i_, Bt[n][1]), 0, 1, 2, 3, 4, 5, 6, 7), \
                             a8_ = __builtin_shufflevector(__builtin_bit_cast(v4i_, At[m][0]), __builtin_bit_cast(v4i_, At[m][1]), 0, 1, 2, 3, 4, 5, 6, 7); \
                    \
                  asm volatile("v_mfma_f32_16x16x128_f8f6f4 %0, %1, %2, %0" : "+v"(acc[ai][bj][m][n]) : "v"(b8_), "v"(a8_)); } } \
        else { _Pragma("unroll") for (int m = 0; m < 4; ++m) _Pragma("unroll") for (int n = 0; n < 2; ++n) _Pragma("unroll") for (int k = 0; k < 2; ++k) \
            acc[ai][bj][m][n] = __builtin_amdgcn_mfma_f32_16x16x32_bf16(Bt[n][k], At[m][k], acc[ai][bj][m][n], 0, 0, 0); } \
        __builtin_amdgcn_s_setprio(0); } while (0)
#define PG8_WAIT_V(n) asm volatile("s_waitcnt vmcnt(" #n ")" ::: "memory")
#define PG8_WAIT_L(n) asm volatile("s_waitcnt lgkmcnt(" #n ")" ::: "memory")
#define PG8_BAR __builtin_amdgcn_s_barrier()
#define PG8_SCHED __builtin_amdgcn_sched_barrier(0)
    Unit cur, nxt; int ui = 0;
    if (!S.next(0, cur)) return;
    f32x4 acc[2][2][4][2];
    float zf_ = 0.f; asm volatile("" : "+v"(zf_));
#pragma unroll
    for (int a = 0; a < 2; ++a)
#pragma unroll
        for (int b = 0; b < 2; ++b)
#pragma unroll
            for (int m = 0; m < 4; ++m)
#pragma unroll
                for (int n = 0; n < 2; ++n) acc[a][b][m][n] = (f32x4){zf_, zf_, zf_, zf_};
    bf16x8 At[4][2], B0[2][2], B1[2][2];
    const char* cA = (const char*)g.A + (size_t)cur.pm * tstep; const char* cB = (const char*)g.Bt + (size_t)cur.pn * tstep;
    S.a_ready(cur);
    if constexpr (Epi::GATHER) { PG8_IDX_DMA(0, cur.pm); asm volatile("s_waitcnt vmcnt(0)" ::: "memory"); PG8_IDX_READ(offAc, 0); asm volatile("s_waitcnt lgkmcnt(0)" ::: "memory"); }
    const char* nA = cA;
    PG8_STAGE(PG8_SB(0, 0), cB, voffB); PG8_STAGE_A(PG8_SA(0, 0), 0, 0, false); PG8_STAGE(PG8_SB(0, 1), cB + hstep, voffB); PG8_STAGE_A(PG8_SA(0, 1), 0, 1, false);
    if (wr == 1) PG8_BAR;
    PG8_WAIT_V(4); PG8_BAR;
    PG8_STAGE(PG8_SB(1, 0), cB + kstep, voffB); PG8_STAGE_A(PG8_SA(1, 0), 1, 0, false); PG8_STAGE(PG8_SB(1, 1), cB + hstep + kstep, voffB);
    PG8_WAIT_V(6); PG8_BAR;
    PG8_STAMP();
    for (;;) {
        const bool has_next = S.next(ui + 1, nxt);
        nA = has_next ? (const char*)g.A + (size_t)nxt.pm * tstep : cA; const char* nB = has_next ? (const char*)g.Bt + (size_t)nxt.pn * tstep : cB;
        if constexpr (Epi::GATHER) { if (has_next) PG8_IDX_DMA((ui + 1) & 1, nxt.pm); }
#pragma unroll 1
        for (int t = 0; t < nt; t += 2) {
            const bool last = (t == nt - 2);
            const char* b2 = last ? nB : cB + (size_t)(t + 2) * kstep;
            const char* b3 = b2 + kstep;
            const int kt2 = last ? 0 : t + 2;
            if constexpr (Epi::GATHER) { if (last) { if (has_next) PG8_IDX_READ(offAn, (ui + 1) & 1); else { offAn[0][0] = offAc[0][0]; offAn[0][1] = offAc[0][1]; offAn[1][0] = offAc[1][0]; offAn[1][1] = offAc[1][1]; } } }
            if (last && has_next) S.a_ready(nxt);
            PG8_LDB(B0, 0, 0); PG8_SCHED; PG8_LDA(At, 0, 0); PG8_STAGE_A(PG8_SA(1, 1), t + 1, 1, false);
            PG8_WAIT_L(8); PG8_BAR; PG8_WAIT_L(0); PG8_MMA(0, 0, At, B0); PG8_BAR; PG8_SCHED;
            PG8_LDB(B1, 0, 1); PG8_STAGE(PG8_SB(0, 0), b2, voffB);
            PG8_BAR; PG8_WAIT_L(0); PG8_MMA(0, 1, At, B1); PG8_BAR;
            PG8_LDA(At, 0, 1); PG8_STAGE_A(PG8_SA(0, 0), kt2, 0, last);
            PG8_BAR; PG8_WAIT_L(0); PG8_MMA(1, 0, At, B0); PG8_BAR; PG8_SCHED;
            PG8_STAGE(PG8_SB(0, 1), b2 + hstep, voffB);
            PG8_WAIT_V(6); PG8_BAR; PG8_MMA(1, 1, At, B1); PG8_BAR;
            PG8_LDB(B0, 1, 0); PG8_SCHED; PG8_LDA(At, 1, 0); PG8_STAGE_A(PG8_SA(0, 1), kt2, 1, last);
            PG8_WAIT_L(8); PG8_BAR; PG8_WAIT_L(0); PG8_MMA(0, 0, At, B0); PG8_BAR; PG8_SCHED;
            PG8_LDB(B1, 1, 1); PG8_STAGE(PG8_SB(1, 0), b3, voffB);
            PG8_BAR; PG8_WAIT_L(0); PG8_MMA(0, 1, At, B1); PG8_BAR;
            PG8_LDA(At, 1, 1); PG8_STAGE_A(PG8_SA(1, 0), kt2 + 1, 0, last);
            PG8_BAR; PG8_WAIT_L(0); PG8_MMA(1, 0, At, B0); PG8_BAR; PG8_SCHED;
            PG8_STAGE(PG8_SB(1, 1), b3 + hstep, voffB);
            PG8_WAIT_V(6); PG8_BAR; PG8_MMA(1, 1, At, B1); PG8_BAR;
        }
        PG8_STAMP();
        if constexpr (Epi::FP8) asm volatile("s_nop 15\n\ts_nop 15" ::: "memory");
        if constexpr (!Epi::AFTER_DRAIN) { E(acc, cur, wr, wc, fr, fq); S.done(cur); }
        PG8_STAMP();
        if (!has_next) break;
#pragma unroll
        for (int a = 0; a < 2; ++a)
#pragma unroll
            for (int b = 0; b < 2; ++b)
#pragma unroll
                for (int m = 0; m < 4; ++m)
#pragma unroll
                    for (int n = 0; n < 2; ++n) acc[a][b][m][n] = (f32x4){zf_, zf_, zf_, zf_};
        cur = nxt; cA = nA; cB = nB; ++ui;
        if constexpr (Epi::GATHER) { offAc[0][0] = offAn[0][0]; offAc[0][1] = offAn[0][1]; offAc[1][0] = offAn[1][0]; offAc[1][1] = offAn[1][1]; }
    }
    PG8_WAIT_V(0);
    if (wr == 0) PG8_BAR;
    PG8_BAR;
    if constexpr (Epi::AFTER_DRAIN) { E.fused(acc, cur, wr, wc, fr, fq, lds, wid, lane); S.done(cur); }
    PG8_STAMP();
    if (STAMP && wid == 0) { stamps[lane] = lane < nts ? (((unsigned long long)(unsigned)ts_hi << 32) | (unsigned)ts_lo) : 0ull;
        if (lane == 62) stamps[62] = rt_entry; if (lane == 63) stamps[63] = (unsigned long long)wall_clock64(); }
#undef PG8_STAMP
#undef PG8_SA
#undef PG8_SB
#undef PG8_STAGE
#undef PG8_STAGE_A
#undef PG8_IDX_DMA
#undef PG8_IDX_READ
#undef PG8_LDA
#undef PG8_LDB
#undef PG8_MMA
#undef PG8_WAIT_V
#undef PG8_WAIT_L
#undef PG8_BAR
#undef PG8_SCHED
}
}

#ifndef SELFCHECK
#define SELFCHECK 0
#endif
#ifndef PROBE_GDN_VAR
#define PROBE_GDN_VAR 0
#endif
#ifndef PROBE_SCAN_VAR
#define PROBE_SCAN_VAR 0
#endif
#ifndef PROBE_ATTN_VAR
#define PROBE_ATTN_VAR 0
#endif
constexpr int NB = 8, SEQ = 4096, DM = 1024, NL = 4, T = NB * SEQ;
constexpr int DIN = 2848, DINP = 3072, HLD = pg8::HLD;
constexpr int NEXP = 32, FF = 512, NTILE_MAX = 288;
constexpr float LN_EPS = 1e-5f;
constexpr float DN_ALPHA = 1.6817928305074290f;
constexpr int NWAVES = 8, NTHR = 512;

constexpr size_t MiB = 1u << 20, KiB = 1u << 10;
constexpr size_t WS_CTL = 0, CTL_ZERO_BYTES = 128 * KiB;
constexpr size_t WS_ROPE = 1 * MiB;
constexpr size_t WS_META = 1 * MiB + 512 * KiB;
constexpr size_t WS_GL = WS_META + 16 * KiB;
constexpr size_t WS_WL = 2 * MiB;
constexpr size_t WL_WIN = 0, WL_WOUT = 6 * MiB, WL_WGU = 8 * MiB, WL_WDN = 72 * MiB, WL_W1 = 104 * MiB, WL_W2 = 105 * MiB, WL_BIAS1 = 105 * MiB + 64 * KiB, WL_WR = 105 * MiB + 128 * KiB;
constexpr size_t WS_XB = 108 * MiB;
constexpr size_t WS_X1 = 172 * MiB;
constexpr size_t WS_H = 300 * MiB;
constexpr size_t WS_SIDE = 476 * MiB;
constexpr size_t WS_Y = 480 * MiB;
constexpr size_t WS_GPREP = 544 * MiB;
constexpr size_t WS_Y2 = 672 * MiB;
constexpr size_t WS_HID = 800 * MiB;
constexpr size_t WS_KC = 872 * MiB, WS_VC = WS_KC + 512 * KiB;
constexpr size_t WS_SLOT = 873 * MiB;
constexpr size_t SL_TOK = 0, SL_W = 512 * KiB, SL_RE = 1024 * KiB, SL_RP = 1280 * KiB, SL_RW = 1536 * KiB;
constexpr size_t WS_WL2 = 876 * MiB;
constexpr size_t WS_END = 982 * MiB;
#define WLBASE(ws_, l_) ((ws_) + (((l_) & 1) ? WS_WL2 : WS_WL))
constexpr int GCH = 65536;
constexpr int GC_UT = 0, GC_W = 8192, GC_QK = 16384, GC_QD = 24576, GC_KDT = 32768, GC_ZT = 40960, GC_SS = 49152, GC_VB = 57344;
constexpr int CW_TMO = 0;
constexpr int CW_BAR = 4096;
constexpr int CW_CNT = 8192;
constexpr int CW_QUEUE = 12288;
static_assert((CW_QUEUE + NL * 64) * 4 <= (int)CTL_ZERO_BYTES, "CTL words inside the memset region");

constexpr int SCR_BYTES = 159744;
constexpr int MISC_OFF = SCR_BYTES;
constexpr int LDS_BYTES = 163840;

#define GAS __attribute__((address_space(1)))
#define LAS __attribute__((address_space(3)))
typedef unsigned short bf16;
typedef float f32x4 __attribute__((ext_vector_type(4)));
typedef float f32x2 __attribute__((ext_vector_type(2)));
typedef float f32x16 __attribute__((ext_vector_type(16)));
typedef short bf16x8 __attribute__((ext_vector_type(8)));
typedef short s16x4 __attribute__((ext_vector_type(4)));
typedef unsigned u32x4 __attribute__((ext_vector_type(4)));
typedef unsigned u32x2 __attribute__((ext_vector_type(2)));
#define LDS_WAIT() asm volatile("s_waitcnt lgkmcnt(0)" ::: "memory")
#define VM_WAIT() asm volatile("s_waitcnt vmcnt(0)" ::: "memory")
#define SBAR() __builtin_amdgcn_sched_barrier(0)
__device__ __forceinline__ float bf2f(unsigned b) { return __uint_as_float(b << 16); }
__device__ __forceinline__ unsigned f2bf(float f) { unsigned u = __float_as_uint(f); return (u + 0x7fffu + ((u >> 16) & 1u)) >> 16; }
__device__ __forceinline__ unsigned pk2(float lo, float hi) { return pg8::cvt_pk_bf16(lo, hi); }
__device__ __forceinline__ float row16_sum(float x) {
    x += __int_as_float(__builtin_amdgcn_update_dpp(0, __float_as_int(x), 0xB1, 0xf, 0xf, true));
    x += __int_as_float(__builtin_amdgcn_update_dpp(0, __float_as_int(x), 0x4E, 0xf, 0xf, true));
    x += __int_as_float(__builtin_amdgcn_update_dpp(0, __float_as_int(x), 0x141, 0xf, 0xf, true));
    x += __int_as_float(__builtin_amdgcn_update_dpp(0, __float_as_int(x), 0x140, 0xf, 0xf, true));
    return x;
}
__device__ __forceinline__ float wave_sum(float v) {
    const int r = __float_as_int(row16_sum(v));
    return (__int_as_float(__builtin_amdgcn_readlane(r, 0)) + __int_as_float(__builtin_amdgcn_readlane(r, 16))) + (__int_as_float(__builtin_amdgcn_readlane(r, 32)) + __int_as_float(__builtin_amdgcn_readlane(r, 48)));
}
__device__ __forceinline__ float fsigmoid(float x) { return pg8::fast_sigmoid(x); }
__device__ __forceinline__ float fsilu(float x) { return x * pg8::fast_sigmoid(x); }
__device__ __forceinline__ float fexp2(float x) { return __builtin_amdgcn_exp2f(x); }

#define XB_TMO      128
#define XB_XCNT(j)  (256  + 64 * (j))
#define XB_XSUB(j)  (1280 + 64 * (j))
#define XB_XGEN(j)  (2304 + 64 * (j))
#define XB_TOP      3328
#define XB_TOPGEN   3392
#define XCD_BAR_WORDS 3456
#define XB_SPIN_CAP (1u << 18)
#define LAS __attribute__((address_space(3)))

__device__ __forceinline__ unsigned xb_ld(unsigned* p)              { return __hip_atomic_load(p, __ATOMIC_RELAXED, __HIP_MEMORY_SCOPE_AGENT); }
__device__ __forceinline__ unsigned xb_add(unsigned* p, unsigned v) { return __hip_atomic_fetch_add(p, v, __ATOMIC_RELAXED, __HIP_MEMORY_SCOPE_AGENT); }
__device__ __forceinline__ unsigned xb_xcc_id() { return (unsigned)__builtin_amdgcn_s_getreg((3 << 11) | 20) & 0xFu; }
#define XB_SPIN(cond, bar) do { unsigned _sp = 0; while (cond) { __builtin_amdgcn_s_sleep(1); \
    if ((++_sp & 255u) == 0u) { if (xb_ld(&(bar)[XB_TMO])) break; if (_sp > XB_SPIN_CAP) { atomicAdd(&(bar)[XB_TMO], 1u); break; } } } } while (0)

struct XcdBarrier {
    unsigned* bar; unsigned x;
    volatile LAS unsigned* st;
};

__device__ __forceinline__ XcdBarrier xcd_barrier_post(unsigned* bar, volatile LAS unsigned* st) {
    XcdBarrier b; b.bar = bar; b.x = xb_xcc_id(); b.st = st;
    if (threadIdx.x == 0) (void)xb_add(&bar[XB_XCNT(b.x)], 1u);
    return b;
}
__device__ __forceinline__ void xcd_barrier_complete(unsigned* bar, unsigned x, unsigned& nloc, unsigned& nx) {
    const unsigned G = gridDim.x * gridDim.y * gridDim.z;
    unsigned sum, cnt, mine, sp = 0u;
    for (;;) {
        sum = 0u; cnt = 0u; mine = 0u;
#pragma unroll
        for (unsigned j = 0; j < 16; ++j) { const unsigned c = xb_ld(&bar[XB_XCNT(j)]); sum += c; cnt += (c > 0u) ? 1u : 0u; mine = (j == x) ? c : mine; }
        if (sum == G) break;
        __builtin_amdgcn_s_sleep(1);
        if ((++sp & 255u) == 0u) { if (xb_ld(&bar[XB_TMO])) break; if (sp > XB_SPIN_CAP) { atomicAdd(&bar[XB_TMO], 1u); break; } }
    }
    nloc = mine > 0u ? mine : 1u; nx = cnt > 0u ? cnt : 1u;
}

__device__ __forceinline__ void xcd_barrier(const XcdBarrier& b) {
    asm volatile("s_waitcnt vmcnt(0)" ::: "memory");
    __syncthreads();
    if (threadIdx.x == 0) {
        unsigned* bar = b.bar;
        __builtin_amdgcn_s_waitcnt(0);
        unsigned nloc = b.st[0], nx = b.st[1];
        if (nloc == 0u) { xcd_barrier_complete(bar, b.x, nloc, nx); b.st[0] = nloc; b.st[1] = nx; }
        const unsigned old = xb_add(&bar[XB_XSUB(b.x)], 1u);
        const unsigned gen = old / nloc;
        if (old + 1u == (gen + 1u) * nloc) {
            __builtin_amdgcn_fence(__ATOMIC_RELEASE, "agent");
            asm volatile("s_waitcnt vmcnt(0)" ::: "memory");
            const unsigned og = xb_add(&bar[XB_TOP], 1u);
            const unsigned tg = og / nx;
            if (og + 1u == (tg + 1u) * nx) xb_add(&bar[XB_TOPGEN], 1u);
            else XB_SPIN(xb_ld(&bar[XB_TOPGEN]) == tg, bar);
            __builtin_amdgcn_fence(__ATOMIC_ACQUIRE, "agent");
            xb_add(&bar[XB_XGEN(b.x)], 1u);
            asm volatile("s_waitcnt vmcnt(0)" ::: "memory");
        } else {
            XB_SPIN(xb_ld(&bar[XB_XGEN(b.x)]) == gen, bar);
            __builtin_amdgcn_fence(__ATOMIC_ACQUIRE, "agent");
            asm volatile("s_waitcnt vmcnt(0)" ::: "memory");
        }
    }
    __syncthreads();
}

struct Args { const float* in[25]; float* out; unsigned char* ws; int ph_lo, ph_hi; };
typedef const __attribute__((address_space(4))) Args* ArgsP;
__device__ __forceinline__ ArgsP args_here() { ArgsP p = (ArgsP)__builtin_amdgcn_kernarg_segment_ptr(); asm volatile("" : "+s"(p)); return p; }
struct Frame { LAS unsigned char* lds; volatile LAS unsigned* MISC; unsigned* ctl; int tid, lane, wave, G, bid; };

template <class Src>
__device__ __forceinline__ void tr_item(const Src src, int K, int N, bf16* WT, LAS float* scr, int item, int lane) {
    const int nblk = N >> 5, kb = item / nblk, nb = item - kb * nblk, k0 = kb << 6, n0 = nb << 5;
    float tv[32];
#pragma unroll
    for (int i = 0; i < 32; ++i) tv[i] = src(k0 + 2 * i + (lane >> 5), n0 + (lane & 31));
#pragma unroll
    for (int i = 0; i < 32; ++i) scr[(2 * i + (lane >> 5)) * 33 + (lane & 31)] = tv[i];
    LDS_WAIT();
    const int c = lane & 7;
#pragma unroll
    for (int j = 0; j < 4; ++j) { const int n = (lane >> 3) + 8 * j; const LAS float* s = scr + (8 * c) * 33 + n;
        u32x4 o; o.x = pk2(s[0], s[33]); o.y = pk2(s[66], s[99]); o.z = pk2(s[132], s[165]); o.w = pk2(s[198], s[231]);
        *(u32x4*)(WT + (size_t)(n0 + n) * K + k0 + 8 * c) = o; }
    LDS_WAIT();
}
template <class Src>
__device__ __forceinline__ void tr8_load(const Src src, int N, int item, int lane, float (&tv)[32]) {
    const int nblk = N >> 5, kb = item / nblk, nb = item - kb * nblk, k0 = kb << 6, n0 = nb << 5;
#pragma unroll
    for (int i = 0; i < 32; ++i) tv[i] = src(k0 + 2 * i + (lane >> 5), n0 + (lane & 31));
}
__device__ __forceinline__ void tr8_finish(const float (&tv)[32], int K, int N, unsigned char* WT, float mul, LAS float* scr, int item, int lane) {
    const int nblk = N >> 5, kb = item / nblk, nb = item - kb * nblk, k0 = kb << 6, n0 = nb << 5;
#pragma unroll
    for (int i = 0; i < 32; ++i) scr[(2 * i + (lane >> 5)) * 33 + (lane & 31)] = tv[i];
    LDS_WAIT();
    const int n = lane >> 1, kh = (lane & 1) * 32; const LAS float* sp = scr + kh * 33 + n;
#pragma unroll
    for (int q = 0; q < 2; ++q) { u32x4 o;
#pragma unroll
        for (int d = 0; d < 4; ++d) { const LAS float* s4 = sp + (16 * q + 4 * d) * 33; int w = 0;
            w = __builtin_amdgcn_cvt_pk_fp8_f32(s4[0] * mul, s4[33] * mul, w, false); w = __builtin_amdgcn_cvt_pk_fp8_f32(s4[66] * mul, s4[99] * mul, w, true); o[d] = (unsigned)w; }
        *(u32x4*)(WT + (size_t)(n0 + n) * K + k0 + kh + 16 * q) = o; }
    LDS_WAIT();
}
struct SrcPlain { const float* p; int ld; __device__ __forceinline__ float operator()(int k, int n) const { return p[(size_t)k * ld + n]; } };
struct SrcWin { const float* p;
    __device__ __forceinline__ float operator()(int k, int n) const {
        int c;
        if (n < 1280) c = n; else if (n < 2048) c = n + 24; else if (n < 2304) c = n + 24; else if (n < 2816) c = n + 32;
        else if (n < 2840) c = n - 2816 + 1280; else if (n < 2844) c = n - 2840 + 2328; else if (n < 2848) c = n - 2844 + 2332; else return 0.f;
        return p[(size_t)k * DIN + c]; } };
struct SrcGU { const float* wg; const float* wu;
    __device__ __forceinline__ float operator()(int k, int n) const { const int q = n >> 3, r = n & 7; const ptrdiff_t d = (r < 4) ? (ptrdiff_t)0 : (wu - wg); return wg[d + (ptrdiff_t)k * FF + 4 * q + (r & 3)]; } };

__device__ __forceinline__ void phase_weights(const Frame& F, ArgsP a, int l, int parts, int nblk, int lds_off) {
    unsigned char* wl = WLBASE(a->ws, l);
    LAS float* scr = (LAS float*)(F.lds + lds_off + F.wave * 8448);
    const int gw = F.bid * NWAVES + F.wave, NGW = nblk * NWAVES;
    constexpr int I_WIN = 16 * 96, I_WOUT = 16 * 32, I_GU1 = 16 * 32, I_GU = NEXP * I_GU1, I_DN1 = 8 * 32, I_DN = NEXP * I_DN1, I_W1 = 2 * 32 * 4, I_W2 = 2 * 2 * 2, I_WR = 36, I_B1 = 256;
    constexpr int NITEMS = I_WIN + I_WOUT + I_GU + I_DN + I_W1 + I_W2 + I_WR + I_B1;
    if (parts & 1) {
        for (int r = gw; r < I_GU; r += 2 * NGW) { const int r2 = r + NGW; const bool two = r2 < I_GU; const int e = r / I_GU1, e2 = (two ? r2 : r) / I_GU1; float tva[32], tvb[32];
            SrcGU sa{a->in[22] + ((size_t)l * NEXP + e) * DM * FF, a->in[23] + ((size_t)l * NEXP + e) * DM * FF}, sb{a->in[22] + ((size_t)l * NEXP + e2) * DM * FF, a->in[23] + ((size_t)l * NEXP + e2) * DM * FF};
            tr8_load(sa, 1024, r - e * I_GU1, F.lane, tva); tr8_load(sb, 1024, (two ? r2 : r) - e2 * I_GU1, F.lane, tvb);
            tr8_finish(tva, DM, 1024, wl + WL_WGU + (size_t)e * 1024 * DM, 32.f, scr, r - e * I_GU1, F.lane);
            if (two) tr8_finish(tvb, DM, 1024, wl + WL_WGU + (size_t)e2 * 1024 * DM, 32.f, scr, r2 - e2 * I_GU1, F.lane); }
        for (int r = gw; r < I_DN; r += 2 * NGW) { const int r2 = r + NGW; const bool two = r2 < I_DN; const int e = r / I_DN1, e2 = (two ? r2 : r) / I_DN1; float tva[32], tvb[32];
            SrcPlain sa{a->in[24] + ((size_t)l * NEXP + e) * FF * DM, DM}, sb{a->in[24] + ((size_t)l * NEXP + e2) * FF * DM, DM};
            tr8_load(sa, DM, r - e * I_DN1, F.lane, tva); tr8_load(sb, DM, (two ? r2 : r) - e2 * I_DN1, F.lane, tvb);
            tr8_finish(tva, FF, DM, wl + WL_WDN + (size_t)e * DM * FF, 64.f, scr, r - e * I_DN1, F.lane);
            if (two) tr8_finish(tvb, FF, DM, wl + WL_WDN + (size_t)e2 * DM * FF, 64.f, scr, r2 - e2 * I_DN1, F.lane); }
    }
    if (!(parts & 2)) return;
    for (int it = I_GU + I_DN + gw; it < NITEMS; it += NGW) {
        int r = it - I_GU - I_DN;
        if (r < I_WIN) { SrcWin s{a->in[1] + (size_t)l * DM * DIN}; tr_item(s, DM, DINP, (bf16*)(wl + WL_WIN), scr, r, F.lane); continue; } r -= I_WIN;
        if (r < I_WOUT) { SrcPlain s{a->in[2] + (size_t)l * DM * DM, DM}; tr_item(s, DM, DM, (bf16*)(wl + WL_WOUT), scr, r, F.lane); continue; } r -= I_WOUT;
        if (r < I_W1) { const int kv = r / 128; SrcPlain s{a->in[4] + ((size_t)l * 2 + kv) * 2048 * 128, 128};
            tr_item(s, 2048, 128, (bf16*)(wl + WL_W1) + (size_t)kv * 128 * 2048, scr, r - kv * 128, F.lane); continue; } r -= I_W1;
        if (r < I_W2) { const int kv = r / 4; SrcPlain s{a->in[5] + ((size_t)l * 2 + kv) * 128 * 64, 64};
            tr_item(s, 128, 64, (bf16*)(wl + WL_W2) + (size_t)kv * 64 * 128, scr, r - kv * 4, F.lane); continue; } r -= I_W2;
        if (r < I_WR) {
            float* wr = (float*)(wl + WL_WR) + (size_t)r * DM;
            for (int k = F.lane; k < DM; k += 64) wr[k] = (r < 4) ? a->in[18][((size_t)l * DM + k) * 4 + r] : a->in[20][((size_t)l * DM + k) * NEXP + (r - 4)];
            continue; } r -= I_WR;
        {
            const int kv = r >> 7, n = r & 127; const float* pe = a->in[3] + ((size_t)l * 2 + kv) * 2048; const float* w1 = a->in[4] + ((size_t)l * 2 + kv) * 2048 * 128;
            float s = 0.f; for (int k = F.lane; k < 2048; k += 64) s += pe[k] * w1[(size_t)k * 128 + n];
            s = wave_sum(s); if (F.lane == 0) ((float*)(wl + WL_BIAS1))[r] = s;
        }
    }
}

__device__ __forceinline__ void phase_prologue(const Frame& F, ArgsP a) {
    const size_t gt = (size_t)F.bid * NTHR + F.tid, NGT = (size_t)F.G * NTHR;
    float* rope = (float*)(a->ws + WS_ROPE);
    for (size_t i = gt; i < (size_t)SEQ * 8; i += NGT) { const int t = (int)(i >> 3), f = (int)(i & 7);
        const float invt[8] = {1.0f, 0.19392274f, 0.03760603f, 0.0072926646f, 0.0014142136f, 0.0002742482f, 5.3182957e-05f, 1.0313385e-05f};
        float inv = invt[0];
#pragma unroll
        for (int q = 1; q < 8; ++q) inv = (f == q) ? invt[q] : inv;
        const float ang = (float)t * inv;
        const double rev = (double)ang * 0.15915494309189535; const float fr = (float)(rev - __builtin_rint(rev));
        rope[t * 16 + f] = __builtin_amdgcn_cosf(fr); rope[t * 16 + 8 + f] = __builtin_amdgcn_sinf(fr); }
    const f32x4* x4 = (const f32x4*)a->in[0]; u32x4* xb = (u32x4*)(a->ws + WS_XB);
    for (size_t i = gt; i < (size_t)T * DM / 8; i += NGT) { const f32x4 v0 = x4[2 * i], v1 = x4[2 * i + 1];
        u32x4 w; w.x = pk2(v0[0], v0[1]); w.y = pk2(v0[2], v0[3]); w.z = pk2(v1[0], v1[1]); w.w = pk2(v1[2], v1[3]); xb[i] = w; }
}

template <bool DRY>
__device__ __forceinline__ void phase_ln1_router(const Frame& F, ArgsP a, int l) {
    float* X1 = (float*)(a->ws + WS_X1); bf16* XB = (bf16*)(a->ws + WS_XB); unsigned char* XB8 = a->ws + WS_H;
    const float* WR = (const float*)(WLBASE(a->ws, l) + WL_WR);
    const float* lw = a->in[14] + (size_t)l * DM; const float* lb = a->in[15] + (size_t)l * DM;
    const float* bg = a->in[19] + l * 4; const float* be = a->in[21] + l * NEXP;
    int* route_e = (int*)(a->ws + WS_SLOT + SL_RE); int* route_p = (int*)(a->ws + WS_SLOT + SL_RP); float* route_w = (float*)(a->ws + WS_SLOT + SL_RW);
    unsigned* cnt = F.ctl + CW_CNT + (DRY ? l + 4 : l) * 512;
    const int gw = F.bid * NWAVES + F.wave, NGW = F.G * NWAVES, lane = F.lane;
    LAS float* wgl = (LAS float*)F.lds;
    for (int i = F.tid; i < 4 * DM; i += NTHR) wgl[i] = WR[i];
    __syncthreads();
    const float bg0 = bg[0], bg1 = bg[1], bg2 = bg[2], bg3 = bg[3];
    for (int tg = gw; tg < T / 4; tg += NGW) {
        f32x4 v[4][4];
#pragma unroll
        for (int tk = 0; tk < 4; ++tk) { const f32x4* row = (const f32x4*)(X1 + (size_t)(4 * tg + tk) * DM) + lane;
#pragma unroll
            for (int j = 0; j < 4; ++j) v[tk][j] = row[64 * j]; }
#pragma unroll
        for (int tk = 0; tk < 4; ++tk) {
            float s = 0.f;
#pragma unroll
            for (int j = 0; j < 4; ++j) s += (v[tk][j][0] + v[tk][j][1]) + (v[tk][j][2] + v[tk][j][3]);
            const float mean = wave_sum(s) * (1.f / DM); float q = 0.f;
#pragma unroll
            for (int j = 0; j < 4; ++j) { v[tk][j] = v[tk][j] - mean; q += (v[tk][j][0] * v[tk][j][0] + v[tk][j][1] * v[tk][j][1]) + (v[tk][j][2] * v[tk][j][2] + v[tk][j][3] * v[tk][j][3]); }
            const float rstd = 1.f / sqrtf(wave_sum(q) * (1.f / DM) + LN_EPS);
            u32x2* brow = (u32x2*)(XB + (size_t)(4 * tg + tk) * DM) + lane;
#pragma unroll
            for (int j = 0; j < 4; ++j) { const f32x4 w4 = ((const f32x4*)lw)[lane + 64 * j], b4 = ((const f32x4*)lb)[lane + 64 * j];
                v[tk][j] = v[tk][j] * rstd * w4 + b4;
                u32x2 w; w.x = pk2(v[tk][j][0], v[tk][j][1]); w.y = pk2(v[tk][j][2], v[tk][j][3]); if (!DRY) brow[64 * j] = w;
                int w8 = 0; w8 = __builtin_amdgcn_cvt_pk_fp8_f32(v[tk][j][0], v[tk][j][1], w8, false); w8 = __builtin_amdgcn_cvt_pk_fp8_f32(v[tk][j][2], v[tk][j][3], w8, true);
                if (!DRY) ((int*)(XB8 + (size_t)(4 * tg + tk) * DM))[lane + 64 * j] = w8; }
        }
        float glg[4][4];
#pragma unroll
        for (int j = 0; j < 4; ++j) { const LAS f32x4* wr = (const LAS f32x4*)(wgl + j * DM) + lane; const f32x4 w0 = wr[0], w1 = wr[64], w2 = wr[128], w3 = wr[192];
#pragma unroll
            for (int tk = 0; tk < 4; ++tk) { f32x4 p = v[tk][0] * w0; p = p + v[tk][1] * w1; p = p + v[tk][2] * w2; p = p + v[tk][3] * w3; glg[tk][j] = wave_sum((p[0] + p[1]) + (p[2] + p[3])); } }
        int my_e = 0; float my_w = 0.f;
#pragma unroll
        for (int tk = 0; tk < 4; ++tk) {
            const float g0 = glg[tk][0] + bg0, g1 = glg[tk][1] + bg1, g2 = glg[tk][2] + bg2, g3 = glg[tk][3] + bg3;
            int gi = 0; float gm = g0; if (g1 > gm) { gm = g1; gi = 1; } if (g2 > gm) { gm = g2; gi = 2; } if (g3 > gm) { gm = g3; gi = 3; }
            gi = __builtin_amdgcn_readfirstlane(gi);
            const float g_w = 1.f / (__expf(g0 - gm) + __expf(g1 - gm) + __expf(g2 - gm) + __expf(g3 - gm));
            const float* wbase = WR + (size_t)(4 + gi * 8) * DM; float ev[8];
#pragma unroll
            for (int i4 = 0; i4 < 2; ++i4) { f32x4 w[4][4];
#pragma unroll
                for (int i = 0; i < 4; ++i) { const f32x4* wr = (const f32x4*)(wbase + (size_t)(4 * i4 + i) * DM) + lane; w[i][0] = wr[0]; w[i][1] = wr[64]; w[i][2] = wr[128]; w[i][3] = wr[192]; }
#pragma unroll
                for (int i = 0; i < 4; ++i) { f32x4 p = v[tk][0] * w[i][0]; p = p + v[tk][1] * w[i][1]; p = p + v[tk][2] * w[i][2]; p = p + v[tk][3] * w[i][3];
                    ev[4 * i4 + i] = wave_sum((p[0] + p[1]) + (p[2] + p[3])) + be[gi * 8 + 4 * i4 + i]; } }
            int i1 = 0; float v1 = ev[0];
#pragma unroll
            for (int i = 1; i < 8; ++i) if (ev[i] > v1) { v1 = ev[i]; i1 = i; }
            int i2 = -1; float v2 = -3.0e38f;
#pragma unroll
            for (int i = 0; i < 8; ++i) if (i != i1 && ev[i] > v2) { v2 = ev[i]; i2 = i; }
            const float e2 = __expf(v2 - v1), w1 = g_w / (1.f + e2), w2 = g_w - w1;
            if (lane == 2 * tk) { my_e = gi * 8 + i1; my_w = w1; }
            if (lane == 2 * tk + 1) { my_e = gi * 8 + i2; my_w = w2; }
        }
        if (lane < 8) {
            const unsigned pos = __hip_atomic_fetch_add(cnt + my_e * 16, 1u, __ATOMIC_RELAXED, __HIP_MEMORY_SCOPE_AGENT);
            const size_t si = (size_t)tg * 8 + lane; if (!DRY) { route_e[si] = my_e; route_p[si] = (int)pos; route_w[si] = my_w; }
        }
    }
    __syncthreads();
}

__device__ __forceinline__ void phase_gather(const Frame& F, ArgsP a, int l) {
    LAS int* pstart = (LAS int*)F.lds;
    unsigned* cnt = F.ctl + CW_CNT + l * 512;
    int* meta = (int*)(a->ws + WS_META) + l * 512;
    int* slot_tok = (int*)(a->ws + WS_SLOT + SL_TOK); float* slot_w = (float*)(a->ws + WS_SLOT + SL_W);
    const int* route_e = (const int*)(a->ws + WS_SLOT + SL_RE); const int* route_p = (const int*)(a->ws + WS_SLOT + SL_RP); const float* route_w = (const float*)(a->ws + WS_SLOT + SL_RW);
    if (F.tid < 64) {
        const int c = F.tid < 32 ? (int)__hip_atomic_load(cnt + F.tid * 16, __ATOMIC_RELAXED, __HIP_MEMORY_SCOPE_AGENT) : 0;
        const int pad = (c + 255) & ~255; int inc = pad;
#pragma unroll
        for (int o = 1; o < 64; o <<= 1) { const int t = __shfl_up(inc, o); if (F.lane >= o) inc += t; }
        const int st = inc - pad;
        if (F.tid < 32) { pstart[F.tid] = st;
            if (F.bid == 0) { for (int t = st >> 8; t < (st + pad) >> 8; ++t) meta[64 + t] = F.tid; if (F.tid == 31) meta[0] = (st + pad) >> 8; }
            if ((F.tid % F.G) == F.bid) for (int r = st + c; r < st + pad; ++r) { slot_tok[r] = -1; slot_w[r] = 0.f; }
        }
    }
    __syncthreads();
    for (int s = F.bid * NTHR + F.tid; s < T * 2; s += F.G * NTHR) {
        const int dest = pstart[route_e[s]] + route_p[s]; slot_tok[dest] = s; slot_w[dest] = route_w[s];
    }
    __syncthreads();
}

__device__ __forceinline__ void phase_ln2(const Frame& F, ArgsP a, int l) {
    const bf16* Y2 = (const bf16*)(a->ws + WS_Y2); bf16* XB = (bf16*)(a->ws + WS_XB); float* out = a->out;
    const float* lw = a->in[16] + (size_t)l * DM; const float* lb = a->in[17] + (size_t)l * DM;
    const int gw = F.bid * NWAVES + F.wave, NGW = F.G * NWAVES, lane = F.lane; const bool last = (l == NL - 1);
    for (int t0 = 2 * gw; t0 < T; t0 += 2 * NGW) {
        u32x2 xr[2][4], pa[2][4], pb[2][4];
#pragma unroll
        for (int u = 0; u < 2; ++u) { const int t = t0 + u; const u32x2* x_ = (const u32x2*)(XB + (size_t)t * DM) + lane; const u32x2* a_ = (const u32x2*)(Y2 + (size_t)(2 * t) * DM) + lane; const u32x2* b_ = (const u32x2*)(Y2 + (size_t)(2 * t + 1) * DM) + lane;
#pragma unroll
            for (int j = 0; j < 4; ++j) { xr[u][j] = x_[64 * j]; pa[u][j] = a_[64 * j]; pb[u][j] = b_[64 * j]; } }
#pragma unroll
        for (int u = 0; u < 2; ++u) { const int t = t0 + u;
            f32x4 v[4]; float s = 0.f;
#pragma unroll
            for (int j = 0; j < 4; ++j) { const u32x2 x = xr[u][j], p = pa[u][j], q = pb[u][j];
                v[j][0] = bf2f(x.x & 0xffffu) * DN_ALPHA + (bf2f(p.x & 0xffffu) + bf2f(q.x & 0xffffu)); v[j][1] = bf2f(x.x >> 16) * DN_ALPHA + (bf2f(p.x >> 16) + bf2f(q.x >> 16));
                v[j][2] = bf2f(x.y & 0xffffu) * DN_ALPHA + (bf2f(p.y & 0xffffu) + bf2f(q.y & 0xffffu)); v[j][3] = bf2f(x.y >> 16) * DN_ALPHA + (bf2f(p.y >> 16) + bf2f(q.y >> 16));
                s += (v[j][0] + v[j][1]) + (v[j][2] + v[j][3]); }
            const float mean = wave_sum(s) * (1.f / DM); float q2 = 0.f;
#pragma unroll
            for (int j = 0; j < 4; ++j) { v[j] = v[j] - mean; q2 += (v[j][0] * v[j][0] + v[j][1] * v[j][1]) + (v[j][2] * v[j][2] + v[j][3] * v[j][3]); }
            const float rstd = 1.f / sqrtf(wave_sum(q2) * (1.f / DM) + LN_EPS);
            f32x4* orow = (f32x4*)(out + (size_t)t * DM) + lane; u32x2* brow = (u32x2*)(XB + (size_t)t * DM) + lane;
#pragma unroll
            for (int j = 0; j < 4; ++j) { const f32x4 w4 = ((const f32x4*)lw)[lane + 64 * j], b4 = ((const f32x4*)lb)[lane + 64 * j];
                const f32x4 o = v[j] * rstd * w4 + b4; if (last) orow[64 * j] = o; u32x2 w; w.x = pk2(o[0], o[1]); w.y = pk2(o[2], o[3]); brow[64 * j] = w; } }
    }
}

__device__ __forceinline__ int tsw(int row, int col) { return row * 128 + ((((col >> 3) ^ (row >> 1)) & 7) << 4) + ((col & 7) << 1); }
__device__ __forceinline__ f32x4 mfma16(bf16x8 a, bf16x8 b, f32x4 c) { return __builtin_amdgcn_mfma_f32_16x16x32_bf16(a, b, c, 0, 0, 0); }
__device__ __forceinline__ f32x16 mfma32(bf16x8 a, bf16x8 b, f32x16 c) { return __builtin_amdgcn_mfma_f32_32x32x16_bf16(a, b, c, 0, 0, 0); }
__device__ __forceinline__ bf16x8 as_bf16x8(u32x4 v) { return __builtin_bit_cast(bf16x8, v); }

__device__ __forceinline__ void conformer_item(const Frame& F, ArgsP a, int l, int it) {
    const int b = it >> 6, s0 = (it & 63) * 64; const size_t tok0 = (size_t)b * SEQ + s0;
    const bf16* H = (const bf16*)(a->ws + WS_H); bf16* Y = (bf16*)(a->ws + WS_Y);
    LAS bf16* ut = (LAS bf16*)F.lds;
    LAS float* co = (LAS float*)(F.lds + 49152);
    for (int idx = F.tid; idx < 94 * 32; idx += NTHR) {
        const int r = idx >> 5, c8 = (idx & 31) * 8, s = s0 - 30 + r; u32x4 w = {0u, 0u, 0u, 0u};
        if (s >= 0) { const bf16* hp = H + ((size_t)b * SEQ + s) * HLD + 2304 + c8; const u32x4 v = *(const u32x4*)hp, g = *(const u32x4*)(hp + 256);
#pragma unroll
            for (int e = 0; e < 4; ++e) { const float v0 = bf2f(v[e] & 0xffffu) * fsigmoid(bf2f(g[e] & 0xffffu)), v1 = bf2f(v[e] >> 16) * fsigmoid(bf2f(g[e] >> 16)); w[e] = pk2(v0, v1); } }
        *(LAS u32x4*)(ut + r * 256 + c8) = w;
    }
    __syncthreads();
    {
        const int c = F.tid & 255, half = F.tid >> 8; const float* dw = a->in[10] + (size_t)l * 31 * 256 + c; const float bias = a->in[11][l * 256 + c];
        float w[31], ur[62];
#pragma unroll
        for (int k = 0; k < 31; ++k) w[k] = dw[k * 256];
#pragma unroll
        for (int i = 0; i < 62; ++i) ur[i] = bf2f(ut[(32 * half + i) * 256 + c]);
#pragma unroll
        for (int tt = 0; tt < 32; ++tt) { float acc = bias;
#pragma unroll
            for (int k = 0; k < 31; ++k) acc += w[k] * ur[tt + k];
            co[(32 * half + tt) * 256 + c] = acc; }
    }
    __syncthreads();
    {
        const float* lw = a->in[12] + l * 256; const float* lb = a->in[13] + l * 256; const f32x4 w4 = ((const f32x4*)lw)[F.lane], b4 = ((const f32x4*)lb)[F.lane];
#pragma unroll
        for (int i = 0; i < 8; ++i) { const int tl = 8 * F.wave + i; f32x4 v = *(LAS f32x4*)(co + tl * 256 + 4 * F.lane);
            const float mean = wave_sum((v[0] + v[1]) + (v[2] + v[3])) * (1.f / 256.f); v = v - mean;
            const float rstd = 1.f / sqrtf(wave_sum((v[0] * v[0] + v[1] * v[1]) + (v[2] * v[2] + v[3] * v[3])) * (1.f / 256.f) + LN_EPS);
            v = v * rstd * w4 + b4; u32x2 o; o.x = pk2(fsilu(v[0]), fsilu(v[1])); o.y = pk2(fsilu(v[2]), fsilu(v[3]));
            *(u32x2*)(Y + (tok0 + tl) * DM + 768 + 4 * F.lane) = o; }
    }
    __syncthreads();
}

__device__ __forceinline__ void compress_item(const Frame& F, ArgsP a, int l, int it) {
    const int kv = it >> 7, bh = (it >> 3) & 15, b = bh >> 1, hh = bh & 1, i0 = (it & 7) * 32;
    const bf16* H = (const bf16*)(a->ws + WS_H); const bf16* w1t = (const bf16*)(WLBASE(a->ws, l) + WL_W1) + (size_t)kv * 128 * 2048; const bf16* w2t = (const bf16*)(WLBASE(a->ws, l) + WL_W2) + (size_t)kv * 64 * 128;
    const float* bias1 = (const float*)(WLBASE(a->ws, l) + WL_BIAS1) + kv * 128; bf16* outp = (bf16*)(a->ws + (kv ? WS_VC : WS_KC)) + (size_t)bh * 256 * 64;
    LAS bf16* hid = (LAS bf16*)F.lds;
    const int lane = F.lane, li = lane & 15, g = lane >> 4, rt = F.wave & 1, cq = F.wave >> 1;
    const int i = i0 + 16 * rt + li; const bf16* arow = H + (size_t)b * SEQ * HLD + 512 + kv * 128 + hh * 64 + 8 * g;
    const bf16* brow = w1t + (size_t)(32 * cq + li) * 2048 + 8 * g;
    f32x4 acc[2] = {{0.f, 0.f, 0.f, 0.f}, {0.f, 0.f, 0.f, 0.f}};
#pragma unroll 1
    for (int k8 = 0; k8 < 64; k8 += 8) {
        bf16x8 af[8], bfr[8][2];
#pragma unroll
        for (int u = 0; u < 8; ++u) { const int ks = k8 + u; int s = 16 * i + (ks >> 1); s = s > SEQ - 1 ? SEQ - 1 : s;
            af[u] = *(const bf16x8*)(arow + (size_t)s * HLD + (ks & 1) * 32); bfr[u][0] = *(const bf16x8*)(brow + ks * 32); bfr[u][1] = *(const bf16x8*)(brow + (size_t)16 * 2048 + ks * 32); }
#pragma unroll
        for (int u = 0; u < 8; ++u) { acc[0] = mfma16(af[u], bfr[u][0], acc[0]); acc[1] = mfma16(af[u], bfr[u][1], acc[1]); }
    }
#pragma unroll
    for (int nt = 0; nt < 2; ++nt) { const int n = 32 * cq + 16 * nt + li; const float bs = bias1[n];
#pragma unroll
        for (int r = 0; r < 4; ++r) hid[(16 * rt + 4 * g + r) * 136 + n] = (bf16)f2bf(fsilu(acc[nt][r] + bs)); }
    __syncthreads();
    f32x4 o2 = {0.f, 0.f, 0.f, 0.f};
#pragma unroll
    for (int ks = 0; ks < 4; ++ks) { const bf16x8 af = *(LAS bf16x8*)(hid + (16 * rt + li) * 136 + 32 * ks + 8 * g);
        const bf16x8 bfr = *(const bf16x8*)(w2t + (size_t)(16 * cq + li) * 128 + 32 * ks + 8 * g); o2 = mfma16(af, bfr, o2); }
#pragma unroll
    for (int r = 0; r < 4; ++r) { const int io = i0 + 16 * rt + 4 * g + r; outp[(size_t)io * 64 + 16 * cq + li] = (bf16)(io < 255 ? f2bf(o2[r]) : 0u); }
    __syncthreads();
}

__host__ __device__ constexpr int tri_off(int i) { int s = 0; for (int k = 0; k < i; ++k) s += (k + 3) >> 2; return 4 * s; }
__device__ __forceinline__ int tri_off_rt(int i) { const int m = i - 1, V = (m + 3) >> 2; return i <= 0 ? 0 : 4 * (2 * V * (V - 1) + V * (m - 4 * V + 4)); }

template <int I> struct GdnSolveRow {
    __device__ static __forceinline__ void run(const LAS float* Ap, float (&x)[64]) {
        if constexpr (I < 64) {
            constexpr int off = tri_off(I), nb = (I + 3) >> 2;
            float s4[4] = {0.f, 0.f, 0.f, 0.f};
#pragma unroll
            for (int jb = 0; jb < nb; ++jb) { const f32x4 a4 = *(const LAS f32x4*)(Ap + off + 4 * jb);
#pragma unroll
                for (int jj = 0; jj < 4; ++jj) { if (4 * jb + jj < I) s4[jj] += a4[jj] * x[4 * jb + jj]; } }
            x[I] -= (s4[0] + s4[1]) + (s4[2] + s4[3]);
            if constexpr ((I & 3) == 3) SBAR();
            GdnSolveRow<I + 1>::run(Ap, x);
        }
    }
};

template <int GV>
__device__ __forceinline__ void gdn_prep_chunk(const Frame& F, ArgsP a, int l, int ci, LAS unsigned char* wl) {
    int lane_ = F.lane; asm volatile("" : "+v"(lane_));
    const int lane = lane_, li = lane & 15, g = lane >> 4; const int bh = ci >> 6, n = ci & 63, b = bh >> 2, h = bh & 3; const size_t tok0 = (size_t)b * SEQ + 64 * n;
    const bf16* H = (const bf16*)(a->ws + WS_H); const float* side = (const float*)(a->ws + WS_SIDE);
    unsigned char* rec = a->ws + ((GV & 1) ? WS_Y2 : WS_GPREP) + (size_t)ci * GCH;
    bf16* R0 = (bf16*)(rec + GC_UT); bf16* R1 = (bf16*)(rec + GC_W); bf16* QKm = (bf16*)(rec + GC_QK); bf16* QD = (bf16*)(rec + GC_QD); bf16* KDT = (bf16*)(rec + GC_KDT); bf16* ZT = (bf16*)(rec + GC_ZT);
    const int pc = (lane & 32) | (((lane & 15) >> 2) << 3) | (((lane >> 4) & 1) << 2) | (lane & 3);
    LAS unsigned char* qt = wl; LAS unsigned char* kt = wl + 8192; LAS float* Ap = (LAS float*)wl;
    const float beta = side[(tok0 + lane) * 32 + 24 + h]; const float av = side[(tok0 + lane) * 32 + 28 + h] + a->in[8][l * 4 + h];
    const float sp = av > 20.f ? av : log1pf(__expf(av)); float gc = -__expf(a->in[7][l * 4 + h]) * sp;
#pragma unroll
    for (int o = 1; o < 64; o <<= 1) { const float t = __shfl_up(gc, o); if (lane >= o) gc += t; }
    const float gl = __shfl(gc, 63); const float eg = __expf(gc), ekd = __expf(gl - gc);
    if (lane == 0 && !(GV & 1)) ((float*)(a->ws + WS_GL))[ci] = __expf(gl);
    const float* cw = a->in[6] + (size_t)l * 4 * 768 + h * 64 + lane; float wq[4], wk[4], wv[4];
#pragma unroll
    for (int k = 0; k < 4; ++k) { wq[k] = cw[k * 768]; wk[k] = cw[k * 768 + 256]; wv[k] = cw[k * 768 + 512]; }
    const bf16* hp = H + tok0 * HLD + 1280 + h * 64 + lane; float hq[3], hk[3], hv[3];
#pragma unroll
    for (int j = 0; j < 3; ++j) { const bool ok = (64 * n - 3 + j) >= 0; const bf16* p = hp + (ptrdiff_t)(j - 3) * HLD;
        hq[j] = ok ? bf2f(p[0]) : 0.f; hk[j] = ok ? bf2f(p[256]) : 0.f; hv[j] = ok ? bf2f(p[512]) : 0.f; }
    unsigned short ra[8][4], rb[8][4]; const float nwl = a->in[9][l * 64 + lane];
#define GDN_LOADBLK(dst, t8_) do { const bf16* pl_ = hp + (size_t)(8 * (t8_)) * HLD; asm volatile("" : "+v"(pl_)); _Pragma("unroll") for (int tt = 0; tt < 8; ++tt) { const bf16* q_ = pl_ + (size_t)tt * HLD; dst[tt][0] = q_[0]; dst[tt][1] = q_[256]; dst[tt][2] = q_[512]; dst[tt][3] = q_[768]; } } while (0)
#define GDN_CONVBLK(src, t8_) do { const int t8 = (t8_); unsigned kdp[4], zp[4]; \
        bf16* qd8 = QD + (8 * t8) * 64 + pc; bf16* r08 = R0 + (8 * t8) * 64 + lane; bf16* r18 = R1 + (8 * t8) * 64 + lane; asm volatile("" : "+v"(qd8), "+v"(r08), "+v"(r18)); \
        _Pragma("unroll") for (int tt = 0; tt < 8; ++tt) { const int t = 8 * t8 + tt; \
            const float rq = bf2f(src[tt][0]), rk = bf2f(src[tt][1]), rv = bf2f(src[tt][2]); \
            const float cq = wq[0] * hq[0] + wq[1] * hq[1] + wq[2] * hq[2] + wq[3] * rq, ck = wk[0] * hk[0] + wk[1] * hk[1] + wk[2] * hk[2] + wk[3] * rk, cv = wv[0] * hv[0] + wv[1] * hv[1] + wv[2] * hv[2] + wv[3] * rv; \
            hq[0] = hq[1]; hq[1] = hq[2]; hq[2] = rq; hk[0] = hk[1]; hk[1] = hk[2]; hk[2] = rk; hv[0] = hv[1]; hv[1] = hv[2]; hv[2] = rv; \
            const float qs = fsilu(cq), ks_ = fsilu(ck), vs = fsilu(cv); \
            const float qn = qs * __builtin_amdgcn_rsqf(wave_sum(qs * qs) + 1e-6f) * 0.125f, kn = ks_ * __builtin_amdgcn_rsqf(wave_sum(ks_ * ks_) + 1e-6f); \
            const float bt = __int_as_float(__builtin_amdgcn_readlane(__float_as_int(beta), t)), egt = __int_as_float(__builtin_amdgcn_readlane(__float_as_int(eg), t)), ekt = __int_as_float(__builtin_amdgcn_readlane(__float_as_int(ekd), t)); \
            *(LAS bf16*)(qt + tsw(t, lane)) = (bf16)f2bf(qn); *(LAS bf16*)(kt + tsw(t, lane)) = (bf16)f2bf(kn); \
            qd8[tt * 64] = (bf16)f2bf(qn * egt); r08[tt * 64] = (bf16)f2bf(bt * vs); r18[tt * 64] = (bf16)f2bf(bt * egt * kn); \
            const unsigned kd = f2bf(kn * ekt); if (tt & 1) kdp[tt >> 1] |= kd << 16; else kdp[tt >> 1] = kd; \
            const unsigned zg = f2bf(fsilu(bf2f(src[tt][3])) * nwl); if (tt & 1) zp[tt >> 1] |= zg << 16; else zp[tt >> 1] = zg; } \
        { u32x4 wz; wz.x = zp[0]; wz.y = zp[1]; wz.z = zp[2]; wz.w = zp[3]; *(u32x4*)(ZT + lane * 64 + 8 * t8) = wz; } \
        { const int c0 = (8 * t8) & 31, gg = (c0 & 15) >> 2, hh = c0 >> 4; bf16* kr = KDT + lane * 64 + ((8 * t8) & 32) + 4 * hh; \
          u32x2 w0, w1; w0.x = kdp[0]; w0.y = kdp[1]; w1.x = kdp[2]; w1.y = kdp[3]; *(u32x2*)(kr + 8 * gg) = w0; *(u32x2*)(kr + 8 * gg + 8) = w1; } } while (0)
    if (!(GV & 2)) {
    GDN_LOADBLK(ra, 0);
#pragma unroll 1
    for (int t16 = 0; t16 < 4; ++t16) {
        GDN_LOADBLK(rb, 2 * t16 + 1);
        GDN_CONVBLK(ra, 2 * t16);
        if (t16 < 3) GDN_LOADBLK(ra, 2 * t16 + 2);
        GDN_CONVBLK(rb, 2 * t16 + 1);
    }
    }
#undef GDN_LOADBLK
#undef GDN_CONVBLK
    LDS_WAIT();
    if (!(GV & 4)) {
    float gcj[4][4];
#pragma unroll
    for (int mt = 0; mt < 4; ++mt)
#pragma unroll
        for (int r = 0; r < 4; ++r) gcj[mt][r] = __shfl(gc, 16 * mt + 4 * g + r);
    f32x4 ahold[4][4];
#pragma unroll
    for (int nt = 0; nt < 4; ++nt) {
        const int i = 16 * nt + li; const float gci = __shfl(gc, i), bi = __shfl(beta, i);
        bf16x8 kB[2], qB[2];
#pragma unroll
        for (int ks = 0; ks < 2; ++ks) { kB[ks] = *(LAS bf16x8*)(kt + tsw(i, 32 * ks + 8 * g)); qB[ks] = *(LAS bf16x8*)(qt + tsw(i, 32 * ks + 8 * g)); }
#pragma unroll
        for (int mt = 0; mt < 4; ++mt) {
            u32x2 qw = {0u, 0u};
            if (mt <= nt) {
                const bf16x8 kA0 = *(LAS bf16x8*)(kt + tsw(16 * mt + li, 8 * g)), kA1 = *(LAS bf16x8*)(kt + tsw(16 * mt + li, 32 + 8 * g));
                f32x4 ckk = {0.f, 0.f, 0.f, 0.f}, cqk = {0.f, 0.f, 0.f, 0.f};
                ckk = mfma16(kA0, kB[0], ckk); ckk = mfma16(kA1, kB[1], ckk); cqk = mfma16(kA0, qB[0], cqk); cqk = mfma16(kA1, qB[1], cqk);
                float qv[4];
#pragma unroll
                for (int r = 0; r < 4; ++r) { const int j = 16 * mt + 4 * g + r; const float dec = __expf(fminf(gci - gcj[mt][r], 0.f));
                    ahold[nt][mt][r] = bi * ckk[r] * dec; qv[r] = (j <= i) ? cqk[r] * dec : 0.f; }
                qw.x = pk2(qv[0], qv[1]); qw.y = pk2(qv[2], qv[3]);
            }
            *(u32x2*)(QKm + i * 64 + 32 * (mt >> 1) + 8 * g + 4 * (mt & 1)) = qw;
        }
    }
    LDS_WAIT(); SBAR();
#pragma unroll
    for (int nt = 0; nt < 4; ++nt) { const int i = 16 * nt + li; const int ro = tri_off_rt(i);
#pragma unroll
        for (int mt = 0; mt < 4; ++mt) if (mt <= nt) {
#pragma unroll
            for (int r = 0; r < 4; ++r) { const int j = 16 * mt + 4 * g + r; if (j < i) Ap[ro + j] = ahold[nt][mt][r]; } } }
    }
    VM_WAIT(); LDS_WAIT();
#pragma unroll 1
    for (int pass = 0; pass < 2; ++pass) {
        bf16* Rp = pass ? R1 : R0; float x[64];
#pragma unroll
        for (int i = 0; i < 64; ++i) x[i] = bf2f(Rp[i * 64 + lane]);
        VM_WAIT();
        if (!(GV & 8)) GdnSolveRow<1>::run(Ap, x);
        if (pass == 0) {
#pragma unroll
            for (int i8 = 0; i8 < 8; ++i8) { u32x4 w; w.x = pk2(x[8 * i8], x[8 * i8 + 1]); w.y = pk2(x[8 * i8 + 2], x[8 * i8 + 3]); w.z = pk2(x[8 * i8 + 4], x[8 * i8 + 5]); w.w = pk2(x[8 * i8 + 6], x[8 * i8 + 7]);
                *(u32x4*)(Rp + lane * 64 + 8 * i8) = w; }
        } else {
#pragma unroll
            for (int i = 0; i < 64; ++i) Rp[i * 64 + pc] = (bf16)f2bf(x[i]);
        }
    }
    LDS_WAIT();
}

__device__ __forceinline__ bf16x8 scan_frag(const unsigned char* mat, int mt, int ks, int li, int g) { return *(const bf16x8*)(mat + (16 * mt + li) * 128 + (32 * ks + 8 * g) * 2); }
__device__ __forceinline__ bf16x8 pack_c2(f32x4 a, f32x4 b) { u32x4 w; w.x = pk2(a[0], a[1]); w.y = pk2(a[2], a[3]); w.z = pk2(b[0], b[1]); w.w = pk2(b[2], b[3]); return as_bf16x8(w); }
constexpr int SC_SLOT = 24576;
__device__ __forceinline__ void scan_dma(LAS unsigned char* slot, const unsigned char* rec, int sl, int lane) {
#pragma unroll
    for (int m = 0; m < 3; ++m) { const int goff = (m == 0) ? GC_W : (m == 1 ? GC_KDT : GC_UT);
#pragma unroll
        for (int i = 0; i < 2; ++i) { const int row = 16 * sl + 8 * i + (lane >> 3), ch = (lane & 7) ^ ((row >> 1) & 7);
            __builtin_amdgcn_global_load_lds((const unsigned*)(rec + goff + row * 128 + ch * 16), (LAS unsigned*)(slot + m * 8192 + (16 * sl + 8 * i) * 128), 16, 0, 0); } }
}
__device__ __forceinline__ bf16x8 scan_lfrag(const LAS unsigned char* mat, int mt, int ks, int li, int g) { const int row = 16 * mt + li; return *(const LAS bf16x8*)(mat + row * 128 + ((((4 * ks + g) ^ (row >> 1)) & 7) << 4)); }
template <int SV>
__device__ __forceinline__ void gdn_scan(const Frame& F, ArgsP a, int l) {
    const int lane = F.lane, li = lane & 15, g = lane >> 4, pr = F.wave >> 2, sl = F.wave & 3; const int bh = F.bid * 2 + pr, dv0 = 16 * sl;
    const float* GL = (const float*)(a->ws + WS_GL) + bh * 64; unsigned char* rec0 = a->ws + WS_GPREP + (size_t)bh * 64 * GCH;
    LAS unsigned char* ring = F.lds + pr * (3 * SC_SLOT);
    f32x4 S[4] = {{0.f, 0.f, 0.f, 0.f}, {0.f, 0.f, 0.f, 0.f}, {0.f, 0.f, 0.f, 0.f}, {0.f, 0.f, 0.f, 0.f}};
    const float glv = GL[lane];
    asm volatile("s_waitcnt vmcnt(0)" ::: "memory");
    scan_dma(ring, rec0, sl, lane); scan_dma(ring + SC_SLOT, rec0 + GCH, sl, lane);
#pragma unroll 1
    for (int n = 0; n < 64; ++n) {
        unsigned char* rn = rec0 + (size_t)n * GCH; const LAS unsigned char* slot = ring + (n % 3) * SC_SLOT;
        if (n == 0) asm volatile("s_waitcnt vmcnt(6)" ::: "memory"); else asm volatile("s_waitcnt vmcnt(14)" ::: "memory");
        __builtin_amdgcn_s_barrier(); asm volatile("" ::: "memory");
        if (n + 2 < 64) scan_dma(ring + ((n + 2) % 3) * SC_SLOT, rn + 2 * (size_t)GCH, sl, lane);
        else { asm volatile("" ::: "memory"); }
        const float egl = __int_as_float(__builtin_amdgcn_readlane(__float_as_int(glv), n));
        const bf16x8 Sb0 = pack_c2(S[0], S[1]), Sb1 = pack_c2(S[2], S[3]);
        if (!(SV & 1)) { bf16x8* ss = (bf16x8*)(rn + GC_SS + sl * 2048) + lane; ss[0] = Sb0; ss[64] = Sb1; }
        f32x4 vn[4];
#pragma unroll
        for (int mt = 0; mt < 4; ++mt) {
            f32x4 acc = {0.f, 0.f, 0.f, 0.f};
            acc = mfma16(scan_lfrag(slot, mt, 0, li, g), Sb0, acc); acc = mfma16(scan_lfrag(slot, mt, 1, li, g), Sb1, acc);
            const int urow = dv0 + li; const u32x2 uu = *(const LAS u32x2*)(slot + 16384 + urow * 128 + (((((16 * mt + 4 * g) >> 3) ^ (urow >> 1)) & 7) << 4) + (((16 * mt + 4 * g) & 7) << 1));
            vn[mt][0] = bf2f(uu.x & 0xffffu) - acc[0]; vn[mt][1] = bf2f(uu.x >> 16) - acc[1]; vn[mt][2] = bf2f(uu.y & 0xffffu) - acc[2]; vn[mt][3] = bf2f(uu.y >> 16) - acc[3];
        }
        const bf16x8 Vb0 = pack_c2(vn[0], vn[1]), Vb1 = pack_c2(vn[2], vn[3]);
        if (!(SV & 1)) { bf16x8* vb = (bf16x8*)(rn + GC_VB + sl * 2048) + lane; vb[0] = Vb0; vb[64] = Vb1; }
#pragma unroll
        for (int mt = 0; mt < 4; ++mt) { f32x4 acc = S[mt] * egl; acc = mfma16(scan_lfrag(slot + 8192, mt, 0, li, g), Vb0, acc); acc = mfma16(scan_lfrag(slot + 8192, mt, 1, li, g), Vb1, acc); S[mt] = acc; }
        if ((SV & 1) || n + 2 >= 64) { }
    }
    asm volatile("s_waitcnt vmcnt(0)" ::: "memory"); asm volatile("" :: "v"(S[0][0]), "v"(S[1][1]), "v"(S[2][2]), "v"(S[3][3]));
    __syncthreads();
}

__device__ __forceinline__ void gdn_out_chunk(const Frame& F, ArgsP a, int ci, LAS unsigned char* wl) {
    int lane_ = F.lane; asm volatile("" : "+v"(lane_)); const int lane = lane_, li = lane & 15, g = lane >> 4; const int bh = ci >> 6, n = ci & 63, b = bh >> 2, h = bh & 3;
    const unsigned char* rec = a->ws + WS_GPREP + (size_t)ci * GCH; bf16* Y = (bf16*)(a->ws + WS_Y);
    bf16x8 QDf[4][2], QKf[4][2];
#pragma unroll
    for (int mt = 0; mt < 4; ++mt) { QDf[mt][0] = scan_frag(rec + GC_QD, mt, 0, li, g); QDf[mt][1] = scan_frag(rec + GC_QD, mt, 1, li, g); QKf[mt][0] = scan_frag(rec + GC_QK, mt, 0, li, g); QKf[mt][1] = scan_frag(rec + GC_QK, mt, 1, li, g); }
    float ssq[4][4];
#pragma unroll
    for (int mt = 0; mt < 4; ++mt)
#pragma unroll
        for (int r = 0; r < 4; ++r) ssq[mt][r] = 0.f;
    f32x4 o[4][4];
#pragma unroll
    for (int sl = 0; sl < 4; ++sl) {
        const bf16x8* ss = (const bf16x8*)(rec + GC_SS + sl * 2048) + lane; const bf16x8* vb = (const bf16x8*)(rec + GC_VB + sl * 2048) + lane;
        const bf16x8 Sb0 = ss[0], Sb1 = ss[64], Vb0 = vb[0], Vb1 = vb[64];
#pragma unroll
        for (int mt = 0; mt < 4; ++mt) {
            f32x4 acc = {0.f, 0.f, 0.f, 0.f};
            acc = mfma16(QDf[mt][0], Sb0, acc); acc = mfma16(QDf[mt][1], Sb1, acc); acc = mfma16(QKf[mt][0], Vb0, acc); acc = mfma16(QKf[mt][1], Vb1, acc);
            o[sl][mt] = acc;
#pragma unroll
            for (int r = 0; r < 4; ++r) ssq[mt][r] += acc[r] * acc[r];
        }
    }
#pragma unroll
    for (int mt = 0; mt < 4; ++mt)
#pragma unroll
        for (int r = 0; r < 4; ++r) ssq[mt][r] = __builtin_amdgcn_rsqf(row16_sum(ssq[mt][r]) * (1.f / 64.f) + 1e-6f);
#pragma unroll
    for (int sl = 0; sl < 4; ++sl)
#pragma unroll
        for (int mt = 0; mt < 4; ++mt) {
            const u32x2 zz = *(const u32x2*)(rec + GC_ZT + (16 * sl + li) * 128 + (16 * mt + 4 * g) * 2);
            const float zf[4] = {bf2f(zz.x & 0xffffu), bf2f(zz.x >> 16), bf2f(zz.y & 0xffffu), bf2f(zz.y >> 16)};
#pragma unroll
            for (int r = 0; r < 4; ++r) *(LAS bf16*)(wl + tsw(16 * mt + 4 * g + r, 16 * sl + li)) = (bf16)f2bf(o[sl][mt][r] * ssq[mt][r] * zf[r]);
        }
    LDS_WAIT();
    bf16* yrow = Y + ((size_t)b * SEQ + 64 * n + lane) * DM + 512 + h * 64;
#pragma unroll
    for (int c = 0; c < 8; ++c) *(u32x4*)(yrow + 8 * c) = *(const LAS u32x4*)(wl + tsw(lane, 8 * c));
    LDS_WAIT();
}

constexpr int AT_K = 0, AT_V = 32768, AT_IMP = 65536, AT_SELM = AT_IMP + 64 * 68 * 4, AT_UNI = AT_SELM + 512, AT_YS = 83968;
__device__ __forceinline__ s16x4 tr_read0(unsigned addr) { s16x4 r; asm volatile("ds_read_b64_tr_b16 %0, %1" : "=&v"(r) : "v"(addr) : "memory"); return r; }

__device__ __forceinline__ float half_max(float x) { auto rr = __builtin_amdgcn_permlane32_swap(__float_as_uint(x), __float_as_uint(x), false, false); return fmaxf(__uint_as_float(rr[0]), __uint_as_float(rr[1])); }
__device__ __forceinline__ float half_sum(float x) { auto rr = __builtin_amdgcn_permlane32_swap(__float_as_uint(x), __float_as_uint(x), false, false); return __uint_as_float(rr[0]) + __uint_as_float(rr[1]); }
struct AttnStage { u32x4 kr, vr; };
__device__ __forceinline__ void at_gload(AttnStage& st, const bf16* Kb, const bf16* Vb, size_t stride, int j, int tid) {
    const int row = tid >> 3, ch = tid & 7; const size_t off = (size_t)(64 * j + row) * stride + 8 * ch;
    st.kr = *(const u32x4*)(Kb + off); st.vr = *(const u32x4*)(Vb + off);
}
__device__ __forceinline__ void at_swrite(const AttnStage& st, LAS unsigned char* lds, int buf, int tid) {
    const int row = tid >> 3, ch = tid & 7; const int o = row * 128 + (((ch ^ (row >> 1)) & 7) << 4);
    *(LAS u32x4*)(lds + AT_K + buf * 8192 + o) = st.kr; *(LAS u32x4*)(lds + AT_V + buf * 8192 + o) = st.vr;
}
__device__ __forceinline__ void at_qk(const LAS unsigned char* Kt, const bf16x8 (&Qf)[4], int r, int hf, f32x16 (&s)[2], float cinit) {
    const int swz = (r >> 1) & 7;
    bf16x8 kf[2][4];
#pragma unroll
    for (int kt = 0; kt < 2; ++kt)
#pragma unroll
        for (int ks = 0; ks < 4; ++ks) kf[kt][ks] = *(const LAS bf16x8*)(Kt + (32 * kt + r) * 128 + (((2 * ks + hf) ^ swz) << 4));
    SBAR();
#pragma unroll
    for (int kt = 0; kt < 2; ++kt) {
        f32x16 acc;
#pragma unroll
        for (int e = 0; e < 16; ++e) acc[e] = cinit;
#pragma unroll
        for (int ks = 0; ks < 4; ++ks) acc = mfma32(kf[kt][ks], Qf[ks], acc);
        s[kt] = acc;
    }
}
__device__ __forceinline__ void at_pv(unsigned vbase, const unsigned (&voff)[2][2], const f32x16 (&p)[2], f32x16 (&o)[2]) {
#pragma unroll
    for (int kt = 0; kt < 2; ++kt) {
        s16x4 vr[2][2][2];
#pragma unroll
        for (int s = 0; s < 2; ++s) { const unsigned co = vbase + (unsigned)(4096 * kt + 2048 * s);
            vr[s][0][0] = tr_read0(co + voff[0][0]); vr[s][1][0] = tr_read0(co + voff[1][0]); vr[s][0][1] = tr_read0(co + voff[0][1]); vr[s][1][1] = tr_read0(co + voff[1][1]); }
        bf16x8 pb[2];
#pragma unroll
        for (int s = 0; s < 2; ++s) { u32x4 pw; pw.x = pk2(p[kt][8 * s + 0], p[kt][8 * s + 1]); pw.y = pk2(p[kt][8 * s + 2], p[kt][8 * s + 3]); pw.z = pk2(p[kt][8 * s + 4], p[kt][8 * s + 5]); pw.w = pk2(p[kt][8 * s + 6], p[kt][8 * s + 7]); pb[s] = as_bf16x8(pw); }
        asm volatile("s_waitcnt lgkmcnt(0)" ::: "memory"); SBAR();
#pragma unroll
        for (int s = 0; s < 2; ++s) {
            const s16x4 l0 = vr[s][0][0], h0 = vr[s][1][0], l1 = vr[s][0][1], h1 = vr[s][1][1];
            const bf16x8 v0 = {l0[0], l0[1], l0[2], l0[3], h0[0], h0[1], h0[2], h0[3]}, v1 = {l1[0], l1[1], l1[2], l1[3], h1[0], h1[1], h1[2], h1[3]};
            o[0] = mfma32(v0, pb[s], o[0]); o[1] = mfma32(v1, pb[s], o[1]);
        }
    }
}

struct AttnRow { int r, hf, tt, t, qb, wave; unsigned long long wave_union; float m, lpart; };
struct TileInfo { int hi, lo; bool rowok, edge, work, fresh; };
template <int MODE, int VAR>
__device__ __forceinline__ void at_tile_qk(const Frame& F, int j, int stg, const bf16x8 (&Qf)[4], const AttnRow& R, float mfin, f32x16 (&s)[2], TileInfo& I) {
    LAS unsigned char* lds = F.lds;
    I.work = true; if (MODE == 2) I.work = (R.wave_union >> j) & 1ull;
    I.hi = 1000; I.lo = -1000; I.rowok = true; I.edge = false;
    if (MODE <= 1) { I.hi = ((R.t - 31) >> 4) - 64 * j - 4 * R.hf; I.edge = (64 * j + 63) > ((64 * R.qb + 8 * R.wave - 31) >> 4); }
    if (MODE == 2) { const unsigned long long sm = *(const LAS unsigned long long*)(lds + AT_SELM + 8 * R.tt); I.rowok = (sm >> j) & 1ull; if (j == R.qb) { I.hi = R.tt - 4 * R.hf; I.edge = true; } }
    if (MODE == 3) { if (j == R.qb) { I.hi = R.tt - 4 * R.hf; I.edge = true; } if (j == R.qb - 8) { I.lo = R.tt + 1 - 4 * R.hf; I.edge = true; } }
    const float mref = (MODE == 1) ? mfin : R.m; I.fresh = mref < -1e29f;
    const float cinit = I.rowok ? (I.fresh ? 0.f : -mref) : -INFINITY;
    if (I.work) { if (VAR & 64) { for (int e = 0; e < 16; ++e) { s[0][e] = Qf[0][0] * 1e-9f; s[1][e] = Qf[1][1] * 1e-9f; } } else at_qk(lds + AT_K + stg * 8192, Qf, R.r, R.hf, s, cinit); }
}
template <int MODE, int VAR>
__device__ __forceinline__ float at_tile_fin(const Frame& F, int j, int stg, f32x16 (&s)[2], const TileInfo& I, AttnRow& R, const unsigned (&voff)[2][2], f32x16 (&o)[2], float invl, float preshift) {
    LAS unsigned char* lds = F.lds; float shift_out = 0.f;
    if (!I.work) return 0.f;
    const int hi = I.hi, lo = I.lo; const bool edge = I.edge;
    if (MODE == 1) {
        if (edge) {
#pragma unroll
            for (int kt = 0; kt < 2; ++kt)
#pragma unroll
                for (int e = 0; e < 16; ++e) { const int cst = 32 * kt + (e & 3) + 8 * (e >> 2); s[kt][e] = (cst <= hi) ? fexp2(s[kt][e]) * invl : 0.f; }
        } else {
#pragma unroll
            for (int kt = 0; kt < 2; ++kt)
#pragma unroll
                for (int e = 0; e < 16; ++e) s[kt][e] = fexp2(s[kt][e]) * invl;
        }
        LAS float* imp = (LAS float*)(lds + AT_IMP) + R.tt * 68;
#pragma unroll
        for (int kt = 0; kt < 2; ++kt)
#pragma unroll
            for (int rg = 0; rg < 4; ++rg) {
                float av = 2.f * (s[kt][4 * rg] + s[kt][4 * rg + 1] + s[kt][4 * rg + 2]) + s[kt][4 * rg + 3], bv = s[kt][4 * rg + 3];
                av += __int_as_float(__builtin_amdgcn_update_dpp(0, __float_as_int(av), 0xB1, 0xf, 0xf, true)); av += __int_as_float(__builtin_amdgcn_update_dpp(0, __float_as_int(av), 0x4E, 0xf, 0xf, true));
                bv += __int_as_float(__builtin_amdgcn_update_dpp(0, __float_as_int(bv), 0xB1, 0xf, 0xf, true)); bv += __int_as_float(__builtin_amdgcn_update_dpp(0, __float_as_int(bv), 0x4E, 0xf, 0xf, true));
                if ((R.r & 3) == 0) { const int jb = 16 * j + 8 * kt + 2 * rg + R.hf; (void)__hip_atomic_fetch_add(imp + jb, av, __ATOMIC_RELAXED, __HIP_MEMORY_SCOPE_WORKGROUP); (void)__hip_atomic_fetch_add(imp + jb + 1, bv, __ATOMIC_RELAXED, __HIP_MEMORY_SCOPE_WORKGROUP); }
            }
        if (VAR & 16) { o[0][0] += s[0][3] + s[1][7]; } else at_pv((unsigned)(size_t)(lds + AT_V + stg * 8192), voff, s, o);
    } else if (VAR & 32) { R.lpart += s[0][1]; if (MODE >= 2) { if (VAR & 16) { o[0][0] += s[0][3]; } else at_pv((unsigned)(size_t)(lds + AT_V + stg * 8192), voff, s, o); } }
    else {
        constexpr float THR = 8.f;
        if (__any(preshift != 0.f)) {
#pragma unroll
            for (int kt = 0; kt < 2; ++kt)
#pragma unroll
                for (int e = 0; e < 16; ++e) s[kt][e] -= preshift;
        }
        const bool fresh = R.m < -1e29f;
        if (edge) {
#pragma unroll
            for (int kt = 0; kt < 2; ++kt)
#pragma unroll
                for (int e = 0; e < 16; ++e) { const int cst = 32 * kt + (e & 3) + 8 * (e >> 2); const bool ok = (cst <= hi) && (cst >= lo); s[kt][e] = ok ? s[kt][e] : -INFINITY; }
        }
        float tm4[4] = {-INFINITY, -INFINITY, -INFINITY, -INFINITY};
#pragma unroll
        for (int kt = 0; kt < 2; ++kt)
#pragma unroll
            for (int e = 0; e < 16; e += 2) tm4[(e >> 1) & 3] = fmaxf(tm4[(e >> 1) & 3], fmaxf(s[kt][e], s[kt][e + 1]));
        const float tmax = half_max(fmaxf(fmaxf(tm4[0], tm4[1]), fmaxf(tm4[2], tm4[3])));
        const bool raise = (tmax > -INFINITY) && (fresh || tmax > THR);
        if (__any(raise)) {
            const float shift = raise ? tmax : 0.f, alpha = (raise && !fresh) ? fexp2(-shift) : 1.f;
            R.m = raise ? (fresh ? tmax : R.m + tmax) : R.m; R.lpart *= alpha; shift_out = shift;
#pragma unroll
            for (int kt = 0; kt < 2; ++kt)
#pragma unroll
                for (int e = 0; e < 16; ++e) s[kt][e] -= shift;
            if (MODE >= 2) {
#pragma unroll
                for (int e = 0; e < 16; ++e) { o[0][e] *= alpha; o[1][e] *= alpha; } }
        }
        float ps4[4] = {0.f, 0.f, 0.f, 0.f};
#pragma unroll
        for (int kt = 0; kt < 2; ++kt)
#pragma unroll
            for (int e = 0; e < 16; ++e) { s[kt][e] = fexp2(s[kt][e]); ps4[e & 3] += s[kt][e]; }
        R.lpart += (ps4[0] + ps4[1]) + (ps4[2] + ps4[3]);
        if (MODE >= 2) { if (VAR & 16) { o[0][0] += s[0][3] + s[1][7]; } else at_pv((unsigned)(size_t)(lds + AT_V + stg * 8192), voff, s, o); }
    }
    return shift_out;
}
template <int MODE, int VAR = 0>
__device__ __forceinline__ void at_branch(const Frame& F, unsigned long long mask, const bf16* Kb, const bf16* Vb, size_t stride, const bf16x8 (&Qf)[4], AttnRow& R, const unsigned (&voff)[2][2],
                                          f32x16 (&o)[2], float mfin, float invl) {
    LAS unsigned char* lds = F.lds; const int tid = F.tid;
    if (mask == 0ull) return;
    AttnStage st0, st1; int sg = 0;
    { const int j0 = __builtin_ctzll(mask); at_gload(st0, Kb, Vb, stride, j0, tid); at_swrite(st0, lds, 0, tid);
      const unsigned long long m1 = mask & (mask - 1ull); if (m1) { at_gload(st1, Kb, Vb, stride, __builtin_ctzll(m1), tid); at_swrite(st1, lds, 1, tid); } }
    __syncthreads();
    while (mask) {
        const int j0 = __builtin_ctzll(mask); mask &= mask - 1ull;
        int j1 = -1; if (mask) { j1 = __builtin_ctzll(mask); mask &= mask - 1ull; }
        int n0 = -1, n1 = -1; { unsigned long long mm = mask; if (mm) { n0 = __builtin_ctzll(mm); mm &= mm - 1ull; if (mm) n1 = __builtin_ctzll(mm); } }
        at_gload(st0, Kb, Vb, stride, n0 >= 0 ? n0 : j0, tid);
        at_gload(st1, Kb, Vb, stride, n1 >= 0 ? n1 : j0, tid);
        { f32x16 sa[2]; TileInfo Ia;
          at_tile_qk<MODE, VAR>(F, j0, sg, Qf, R, mfin, sa, Ia);
          (void)at_tile_fin<MODE, VAR>(F, j0, sg, sa, Ia, R, voff, o, invl, 0.f); }
        if (j1 >= 0) { f32x16 sb[2]; TileInfo Ib;
          at_tile_qk<MODE, VAR>(F, j1, sg + 1, Qf, R, mfin, sb, Ib);
          (void)at_tile_fin<MODE, VAR>(F, j1, sg + 1, sb, Ib, R, voff, o, invl, 0.f); }
        if (n0 >= 0) at_swrite(st0, lds, (sg + 2) & 3, tid);
        if (n1 >= 0) at_swrite(st1, lds, (sg + 3) & 3, tid);
        __syncthreads();
        sg = (sg + 2) & 3;
    }
}

template <int VAR>
__device__ __forceinline__ void attn_item(const Frame& F, ArgsP a, int l, int item) {
    const int qb = 63 - (item >> 4), bh = item & 15, b = bh >> 1, hk = bh & 1; const int lane = F.lane, wave = F.wave;
    const bf16* H = (const bf16*)(a->ws + WS_H); const float* side = (const float*)(a->ws + WS_SIDE); bf16* Y = (bf16*)(a->ws + WS_Y);
    LAS unsigned char* lds = F.lds;
    AttnRow R; R.r = lane & 31; R.hf = lane >> 5; R.tt = 8 * wave + (R.r >> 2); R.t = 64 * qb + R.tt; R.qb = qb; R.wave = wave; R.wave_union = 0ull;
    const int head = hk * 4 + (R.r & 3); const size_t tok = (size_t)b * SEQ + R.t;
    bf16x8 Qf[4];
#pragma unroll
    for (int ks = 0; ks < 4; ++ks) Qf[ks] = *(const bf16x8*)(H + tok * HLD + head * 64 + 16 * ks + 8 * R.hf);
    const float g_cmp = side[tok * 32 + head * 3], g_sel = side[tok * 32 + head * 3 + 1], g_win = side[tok * 32 + head * 3 + 2];
    unsigned voff[2][2];
    { const int li = lane & 15, q = li >> 2, p = li & 3, gi1 = (lane >> 4) & 1;
#pragma unroll
      for (int jh = 0; jh < 2; ++jh)
#pragma unroll
          for (int dt = 0; dt < 2; ++dt) voff[jh][dt] = (unsigned)((8 * jh + 4 * R.hf + q) * 128 + ((((4 * dt + 2 * gi1 + (p >> 1)) ^ (4 * jh + 2 * R.hf + (q >> 1))) & 7) << 4) + (p & 1) * 8); }
    { LAS float* imp = (LAS float*)(lds + AT_IMP) + (8 * wave) * 68; for (int i = lane; i < 8 * 68; i += 64) imp[i] = 0.f; if (F.tid == 0) { *(LAS unsigned*)(lds + AT_UNI) = 0u; *(LAS unsigned*)(lds + AT_UNI + 4) = 0u; } }
    f32x16 o[2];
#pragma unroll
    for (int e = 0; e < 16; ++e) { o[0][e] = 0.f; o[1][e] = 0.f; }
    LAS float* ys = (LAS float*)(lds + AT_YS + wave * 8192) + lane;
    {
        const bf16* Kc = (const bf16*)(a->ws + WS_KC) + (size_t)bh * 256 * 64; const bf16* Vc = (const bf16*)(a->ws + WS_VC) + (size_t)bh * 256 * 64;
        const int ntc = (4 * qb + 3 + 63) >> 6; const unsigned long long mc = (ntc >= 64) ? ~0ull : ((1ull << ntc) - 1ull);
        R.m = -1e30f; R.lpart = 0.f;
        if (!(VAR & 8)) at_branch<0, VAR>(F, mc, Kc, Vc, 64, Qf, R, voff, o, 0.f, 0.f);
        const float lsum = half_sum(R.lpart); const float invl = 1.f / fmaxf(lsum, 1e-30f);
        if (!(VAR & 8)) at_branch<1, VAR>(F, mc, Kc, Vc, 64, Qf, R, voff, o, R.m, invl);
#pragma unroll
        for (int e = 0; e < 16; ++e) { ys[e * 64] = g_cmp * o[0][e]; ys[(16 + e) * 64] = g_cmp * o[1][e]; o[0][e] = 0.f; o[1][e] = 0.f; }
    }
    LDS_WAIT();
    {
        unsigned long long wu = 0ull;
        for (int qi = 0; qi < 8; ++qi) {
            unsigned long long selm;
            if (qb < 16) selm = (2ull << qb) - 1ull;
            else {
                const float v = ((const LAS float*)(lds + AT_IMP))[(8 * wave + qi) * 68 + lane];
                const bool cand = (lane >= 1) && (lane <= qb - 2); const unsigned key = cand ? __float_as_uint(fmaxf(v, 0.f)) : 0u;
                unsigned thr = 0u;
                for (int bit = 30; bit >= 0; --bit) { const unsigned tr = thr | (1u << bit); const int c = __popcll(__ballot(cand && key >= tr)); if (c >= 13) thr = tr; }
                const unsigned long long gt = __ballot(cand && key > thr), eq = __ballot(cand && key == thr);
                int need = 13 - __popcll(gt); unsigned long long eqs = 0ull, e2 = eq;
                while (need > 0 && e2) { const unsigned long long low = e2 & (~e2 + 1ull); eqs |= low; e2 ^= low; --need; }
                selm = gt | eqs | 1ull | (1ull << qb) | (1ull << (qb - 1));
            }
            if (lane == 0) *(LAS unsigned long long*)(lds + AT_SELM + 8 * (8 * wave + qi)) = selm;
#if defined(SELFCHECK) && SELFCHECK == 1
            if (lane == 0 && l == 1) ((unsigned long long*)(a->ws + (size_t)984 * MiB + 64 * KiB))[(size_t)bh * SEQ + 64 * qb + 8 * wave + qi] = selm;
#endif
            wu |= selm;
        }
        R.wave_union = wu;
        if (lane == 0) { __hip_atomic_fetch_or((LAS unsigned*)(lds + AT_UNI), (unsigned)wu, __ATOMIC_RELAXED, __HIP_MEMORY_SCOPE_WORKGROUP); __hip_atomic_fetch_or((LAS unsigned*)(lds + AT_UNI + 4), (unsigned)(wu >> 32), __ATOMIC_RELAXED, __HIP_MEMORY_SCOPE_WORKGROUP); }
    }
    __syncthreads();
    const unsigned long long bunion = (unsigned long long)*(const LAS unsigned*)(lds + AT_UNI) | ((unsigned long long)*(const LAS unsigned*)(lds + AT_UNI + 4) << 32);
    const bf16* Hb = H + (size_t)b * SEQ * HLD;
    {
        R.m = -1e30f; R.lpart = 0.f;
        if (!(VAR & 2)) at_branch<2, VAR>(F, bunion, Hb + 512 + 2 * 128 + hk * 64, Hb + 512 + 3 * 128 + hk * 64, HLD, Qf, R, voff, o, 0.f, 0.f);
        const float lsum = half_sum(R.lpart); const float sc = g_sel / fmaxf(lsum, 1e-30f);
#pragma unroll
        for (int e = 0; e < 16; ++e) { ys[e * 64] += sc * o[0][e]; ys[(16 + e) * 64] += sc * o[1][e]; o[0][e] = 0.f; o[1][e] = 0.f; }
    }
    {
        const int lo = qb - 8 > 0 ? qb - 8 : 0; const unsigned long long mw = ((2ull << qb) - 1ull) & ~((1ull << lo) - 1ull);
        R.m = -1e30f; R.lpart = 0.f;
        if (!(VAR & 4)) at_branch<3, VAR>(F, mw, Hb + 512 + 4 * 128 + hk * 64, Hb + 512 + 5 * 128 + hk * 64, HLD, Qf, R, voff, o, 0.f, 0.f);
        const float lsum = half_sum(R.lpart); const float sc = g_win / fmaxf(lsum, 1e-30f);
#pragma unroll
        for (int e = 0; e < 16; ++e) { o[0][e] = ys[e * 64] + sc * o[0][e]; o[1][e] = ys[(16 + e) * 64] + sc * o[1][e]; }
    }
    if (VAR & 1) { asm volatile("" :: "v"(o[0][0]), "v"(o[1][5])); return; }
    bf16* yrow = Y + tok * DM + head * 64 + 4 * R.hf;
#pragma unroll
    for (int dt = 0; dt < 2; ++dt)
#pragma unroll
        for (int rg = 0; rg < 4; ++rg) { u32x2 w; w.x = pk2(o[dt][4 * rg], o[dt][4 * rg + 1]); w.y = pk2(o[dt][4 * rg + 2], o[dt][4 * rg + 3]); *(u32x2*)(yrow + 32 * dt + 8 * rg) = w; }
}

__device__ __forceinline__ void phase_mix_b(const Frame& F, ArgsP a, int l, int rep) {
    unsigned* q = F.ctl + CW_QUEUE + l * 64 + rep * 32;
    for (;;) {
        if (F.tid == 0) F.MISC[0] = __hip_atomic_fetch_add(q, 1u, __ATOMIC_RELAXED, __HIP_MEMORY_SCOPE_AGENT);
        __syncthreads();
        const int item = (int)F.MISC[0];
        __syncthreads();
        if (item >= 1024) break;
        if (rep == 0) attn_item<0>(F, a, l, item); else attn_item<PROBE_ATTN_VAR>(F, a, l, item);
    }
}

constexpr size_t WS_DBG = 984 * MiB;
constexpr int CHECK_LAYER = 1;
__device__ __forceinline__ void dbg_add(ArgsP a, int i, float v) { atomicAdd((float*)(a->ws + WS_DBG) + i, v); }

__device__ __forceinline__ void check_nsa(const Frame& F, ArgsP a) {
    const bf16* H = (const bf16*)(a->ws + WS_H); const float* side = (const float*)(a->ws + WS_SIDE); const bf16* Y = (const bf16*)(a->ws + WS_Y);
    const unsigned long long* SELM = (const unsigned long long*)(a->ws + WS_DBG + 64 * KiB);
    const int lane = F.lane; const int tv[16] = {5, 40, 63, 64, 100, 511, 512, 1023, 1024, 1500, 2047, 2048, 3000, 3333, 4000, 4095};
    for (int s = F.bid * NWAVES + F.wave; s < 256; s += F.G * NWAVES) {
        int t = tv[0];
#pragma unroll
        for (int q = 1; q < 16; ++q) t = ((s & 15) == q) ? tv[q] : t;
        const int b = (s >> 4) & 7, hq = ((s >> 7) * 5 + (s & 7)) & 7, hk = hq >> 2; const size_t tok = (size_t)b * SEQ + t; const int bhk = b * 2 + hk;
        const bf16* KC = (const bf16*)(a->ws + WS_KC) + (size_t)bhk * 256 * 64; const bf16* VC = (const bf16*)(a->ws + WS_VC) + (size_t)bhk * 256 * 64;
        const float g_cmp = side[tok * 32 + hq * 3], g_sel = side[tok * 32 + hq * 3 + 1], g_win = side[tok * 32 + hq * 3 + 2];
        const int cmax = (t - 31) >> 4; float imp = 0.f, ocmp = 0.f;
        for (int gh = 0; gh < 4; ++gh) {
            const int head = hk * 4 + gh; const float qd = bf2f(H[tok * HLD + head * 64 + lane]);
            float m = -INFINITY, l = 0.f;
            for (int c = 0; c <= cmax; ++c) m = fmaxf(m, wave_sum(qd * bf2f(KC[c * 64 + lane])));
            for (int c = 0; c <= cmax; ++c) l += fexp2(wave_sum(qd * bf2f(KC[c * 64 + lane])) - m);
            for (int c = 0; c <= cmax; ++c) { const float p = fexp2(wave_sum(qd * bf2f(KC[c * 64 + lane])) - m) / l; const int j = c >> 2, e = c & 3;
                if (lane == j) imp += (e < 3 ? 2.f : 1.f) * p; if (e == 3 && lane == j + 1) imp += p;
                if (head == hq) ocmp += p * bf2f(VC[c * 64 + lane]); }
        }
        const int cur = t >> 6; const bool causal = lane <= cur, forced = (lane == 0) || (lane == cur) || (lane == cur - 1);
        const float key = causal ? (imp + (forced ? 1.0e4f : 0.f)) : -INFINITY; int rank = 0;
        for (int i = 0; i < 64; ++i) { const float ki = __shfl(key, i); rank += ((ki > key) || (ki == key && i < lane)) ? 1 : 0; }
        const unsigned long long refm = __ballot(causal && rank < 16), stm = SELM[(size_t)bhk * SEQ + t];
        if (lane == 0) { dbg_add(a, 2, (float)__popcll(refm ^ stm)); dbg_add(a, 3, 16.f); }
        const float qd = bf2f(H[tok * HLD + hq * 64 + lane]); const bf16* Hb = H + (size_t)b * SEQ * HLD + hk * 64 + lane;
        float m = -INFINITY, l = 0.f, osel = 0.f;
        for (int j = 0; j <= cur; ++j) if ((stm >> j) & 1ull) for (int kk = 0; kk < 64; ++kk) { const int p = 64 * j + kk; if (p > t) break;
            const float sc = wave_sum(qd * bf2f(Hb[(size_t)p * HLD + 512 + 2 * 128])); const float mn = fmaxf(m, sc), al = fexp2(m - mn), pp = fexp2(sc - mn);
            l = l * al + pp; osel = osel * al + pp * bf2f(Hb[(size_t)p * HLD + 512 + 3 * 128]); m = mn; }
        const float ysel = osel / fmaxf(l, 1e-30f);
        m = -INFINITY; l = 0.f; float owin = 0.f;
        for (int p = (t - 511 > 0 ? t - 511 : 0); p <= t; ++p) { const float sc = wave_sum(qd * bf2f(Hb[(size_t)p * HLD + 512 + 4 * 128])); const float mn = fmaxf(m, sc), al = fexp2(m - mn), pp = fexp2(sc - mn);
            l = l * al + pp; owin = owin * al + pp * bf2f(Hb[(size_t)p * HLD + 512 + 5 * 128]); m = mn; }
        const float ref = g_cmp * ocmp + g_sel * ysel + g_win * owin / fmaxf(l, 1e-30f), got = bf2f(Y[tok * DM + hq * 64 + lane]);
        const float e2 = wave_sum((ref - got) * (ref - got)), r2 = wave_sum(ref * ref);
        if (lane == 0) { dbg_add(a, 0, e2); dbg_add(a, 1, r2); }
    }
}

__device__ __forceinline__ void check_gdn(const Frame& F, ArgsP a, int l) {
    if (F.bid >= 8) return;
    const bf16* H = (const bf16*)(a->ws + WS_H); const float* side = (const float*)(a->ws + WS_SIDE); const bf16* Y = (const bf16*)(a->ws + WS_Y);
    const int b = F.bid, h = (F.bid * 3) & 3, tid = F.tid, lane = F.lane, col = tid & 63, rg = tid >> 6;
    LAS float* S = (LAS float*)F.lds; LAS float* qv = S + 64 * 65; LAS float* kv = qv + 64; LAS float* vv = kv + 64; LAS float* sc = vv + 64; LAS float* part = sc + 64;
    for (int i = tid; i < 64 * 65; i += NTHR) S[i] = 0.f;
    float hq[3] = {0.f, 0.f, 0.f}, hk[3] = {0.f, 0.f, 0.f}, hv[3] = {0.f, 0.f, 0.f}, wq[4], wk[4], wv[4];
    { const float* cw = a->in[6] + (size_t)l * 4 * 768 + h * 64 + lane;
#pragma unroll
      for (int k = 0; k < 4; ++k) { wq[k] = cw[k * 768]; wk[k] = cw[k * 768 + 256]; wv[k] = cw[k * 768 + 512]; } }
    const float Aexp = __expf(a->in[7][l * 4 + h]), dtb = a->in[8][l * 4 + h], nw = a->in[9][l * 64 + lane];
    __syncthreads();
    for (int t = 0; t < 192; ++t) {
        const size_t tok = (size_t)b * SEQ + t;
        if (F.wave == 0) { const bf16* p = H + tok * HLD + 1280 + h * 64 + lane; const float rq = bf2f(p[0]), rk = bf2f(p[256]), rv = bf2f(p[512]);
            const float cq = wq[0] * hq[0] + wq[1] * hq[1] + wq[2] * hq[2] + wq[3] * rq, ck = wk[0] * hk[0] + wk[1] * hk[1] + wk[2] * hk[2] + wk[3] * rk, cv = wv[0] * hv[0] + wv[1] * hv[1] + wv[2] * hv[2] + wv[3] * rv;
            hq[0] = hq[1]; hq[1] = hq[2]; hq[2] = rq; hk[0] = hk[1]; hk[1] = hk[2]; hk[2] = rk; hv[0] = hv[1]; hv[1] = hv[2]; hv[2] = rv;
            const float qs = cq / (1.f + __expf(-cq)), ks = ck / (1.f + __expf(-ck)), vs = cv / (1.f + __expf(-cv));
            qv[lane] = qs / sqrtf(wave_sum(qs * qs) + 1e-6f); kv[lane] = ks / sqrtf(wave_sum(ks * ks) + 1e-6f); vv[lane] = vs;
            if (lane == 0) { const float av = side[tok * 32 + 28 + h] + dtb; const float sp = av > 20.f ? av : log1pf(__expf(av)); sc[0] = __expf(-Aexp * sp); sc[1] = side[tok * 32 + 24 + h]; } }
        __syncthreads();
        { float ps = 0.f;
#pragma unroll
          for (int r = 0; r < 8; ++r) ps += kv[8 * rg + r] * S[(8 * rg + r) * 65 + col];
          part[rg * 64 + col] = ps; }
        __syncthreads();
        { float ks = 0.f;
#pragma unroll
          for (int r = 0; r < 8; ++r) ks += part[r * 64 + col];
          const float eg = sc[0], be = sc[1]; float po = 0.f;
          __syncthreads();
#pragma unroll
          for (int r = 0; r < 8; ++r) { const int dk = 8 * rg + r; const float sn = eg * (S[dk * 65 + col] - be * kv[dk] * ks) + be * kv[dk] * vv[col]; S[dk * 65 + col] = sn; po += sn * qv[dk]; }
          part[rg * 64 + col] = po; }
        __syncthreads();
        if (F.wave == 0) { float o = 0.f;
#pragma unroll
            for (int r = 0; r < 8; ++r) o += part[r * 64 + lane];
            o *= 0.125f; const float rs = 1.f / sqrtf(wave_sum(o * o) * (1.f / 64.f) + 1e-6f); const float z = bf2f(H[tok * HLD + 2048 + h * 64 + lane]);
            const float ref = o * rs * nw * (z / (1.f + __expf(-z))), got = bf2f(Y[tok * DM + 512 + h * 64 + lane]);
            const float e2 = wave_sum((ref - got) * (ref - got)), r2 = wave_sum(ref * ref);
            if (lane == 0) { dbg_add(a, 4, e2); dbg_add(a, 5, r2); } }
        __syncthreads();
    }
}

__device__ __forceinline__ void check_moe(const Frame& F, ArgsP a, int l) {
    const bf16* XBc = (const bf16*)(a->ws + WS_XB); const bf16* Y2 = (const bf16*)(a->ws + WS_Y2);
    const int* route_e = (const int*)(a->ws + WS_SLOT + SL_RE); const float* route_w = (const float*)(a->ws + WS_SLOT + SL_RW);
    LAS float* x = (LAS float*)F.lds; LAS float* hid = x + 1024; LAS float* lg = hid + 512; LAS float* yr = lg + 64;
    const int tid = F.tid, lane = F.lane;
    for (int s = F.bid; s < 256; s += F.G) {
        const int t = (s * 4099 + 17) & (T - 1);
        for (int i = tid; i < 1024; i += NTHR) { x[i] = bf2f(XBc[(size_t)t * DM + i]); yr[i] = 0.f; }
        __syncthreads();
        for (int j = F.wave; j < 36; j += NWAVES) { float d = 0.f; for (int k = lane; k < DM; k += 64) d += x[k] * (j < 4 ? a->in[18][((size_t)l * DM + k) * 4 + j] : a->in[20][((size_t)l * DM + k) * NEXP + j - 4]);
            d = wave_sum(d); if (lane == 0) lg[j] = d + (j < 4 ? a->in[19][l * 4 + j] : a->in[21][l * NEXP + j - 4]); }
        __syncthreads();
        if (tid == 0) { int gi = 0; for (int i = 1; i < 4; ++i) if (lg[i] > lg[gi]) gi = i; float gs = 0.f; for (int i = 0; i < 4; ++i) gs += __expf(lg[i] - lg[gi]); const float gw = 1.f / gs;
            int i1 = 0; for (int i = 1; i < 8; ++i) if (lg[4 + gi * 8 + i] > lg[4 + gi * 8 + i1]) i1 = i; int i2 = -1; for (int i = 0; i < 8; ++i) if (i != i1 && (i2 < 0 || lg[4 + gi * 8 + i] > lg[4 + gi * 8 + i2])) i2 = i;
            const float e2 = __expf(lg[4 + gi * 8 + i2] - lg[4 + gi * 8 + i1]), w1 = gw / (1.f + e2), w2 = gw - w1;
            const int se1 = route_e[2 * t], se2 = route_e[2 * t + 1]; const float sw1 = route_w[2 * t], sw2 = route_w[2 * t + 1];
            dbg_add(a, 8, (se1 != gi * 8 + i1 ? 1.f : 0.f) + (se2 != gi * 8 + i2 ? 1.f : 0.f)); dbg_add(a, 9, 2.f);
            if (se1 == gi * 8 + i1 && se2 == gi * 8 + i2) { dbg_add(a, 10, (sw1 - w1) * (sw1 - w1) + (sw2 - w2) * (sw2 - w2)); dbg_add(a, 11, w1 * w1 + w2 * w2); } }
        for (int k2 = 0; k2 < 2; ++k2) {
            const int e = route_e[2 * t + k2]; const float rw = route_w[2 * t + k2];
            const float* wg = a->in[22] + ((size_t)l * NEXP + e) * DM * FF; const float* wu = a->in[23] + ((size_t)l * NEXP + e) * DM * FF; const float* wd = a->in[24] + ((size_t)l * NEXP + e) * FF * DM;
            { float g = 0.f, u = 0.f; for (int k = 0; k < DM; ++k) { g += x[k] * wg[(size_t)k * FF + tid]; u += x[k] * wu[(size_t)k * FF + tid]; } hid[tid] = g / (1.f + __expf(-g)) * u; }
            __syncthreads();
            for (int d = tid; d < DM; d += NTHR) { float y = 0.f; for (int f = 0; f < FF; ++f) y += hid[f] * wd[(size_t)f * DM + d]; yr[d] += y * rw; }
            __syncthreads();
        }
        float e2 = 0.f, r2 = 0.f;
        for (int d = tid; d < DM; d += NTHR) { const float got = bf2f(Y2[(size_t)(2 * t) * DM + d]) + bf2f(Y2[(size_t)(2 * t + 1) * DM + d]); e2 += (yr[d] - got) * (yr[d] - got); r2 += yr[d] * yr[d]; }
        e2 = wave_sum(e2); r2 = wave_sum(r2); if (lane == 0) { dbg_add(a, 6, e2); dbg_add(a, 7, r2); }
        __syncthreads();
    }
}

__device__ __forceinline__ void check_inproj(const Frame& F, ArgsP a, int l) {
    const bf16* H = (const bf16*)(a->ws + WS_H); const float* xin = (l == 0) ? a->in[0] : (const float*)a->out; const float* win = a->in[1] + (size_t)l * DM * DIN;
    const int lane = F.lane;
    for (int s = F.bid * NWAVES + F.wave; s < 1024; s += F.G * NWAVES) {
        const int tok = (s * 7919 + 13) & (T - 1), grp = s % 14, t = tok & (SEQ - 1);
        const int col0 = grp < 8 ? grp * 64 : 512 + (grp - 8) * 128 + ((s >> 4) & 1) * 64; const bool isq = grp < 8, rope = isq || ((grp - 8) % 2 == 0);
        float d = 0.f; for (int k = 0; k < DM; ++k) d += xin[(size_t)tok * DM + k] * win[(size_t)k * DIN + col0 + lane];
        if (rope) { const float inv[8] = {1.0f, 0.19392274f, 0.03760603f, 0.0072926646f, 0.0014142136f, 0.0002742482f, 5.3182957e-05f, 1.0313385e-05f};
            float iv = inv[0];
#pragma unroll
            for (int q = 1; q < 8; ++q) iv = ((lane & 7) == q) ? inv[q] : iv;
            const float ang = (float)t * iv, c = cosf(ang), sn = sinf(ang), other = __shfl_xor(d, 8);
            if (lane < 8) d = d * c - other * sn; else if (lane < 16) d = d * c + other * sn; }
        if (isq) d *= pg8::QSCALE;
        const float got = bf2f(H[(size_t)tok * HLD + col0 + lane]); const float e2 = wave_sum((d - got) * (d - got)), r2 = wave_sum(d * d);
        if (lane == 0) { dbg_add(a, 12, e2); dbg_add(a, 13, r2); }
    }
}
__device__ __forceinline__ void check_compress(const Frame& F, ArgsP a, int l) {
    const bf16* H = (const bf16*)(a->ws + WS_H); const int lane = F.lane;
    for (int s = F.bid * NWAVES + F.wave; s < 512; s += F.G * NWAVES) {
        const int kv = s & 1, bh = (s >> 1) & 15, b = bh >> 1, hh = bh & 1, i = (s * 53 + 7) % 255;
        const float* pe = a->in[3] + ((size_t)l * 2 + kv) * 2048; const float* w1 = a->in[4] + ((size_t)l * 2 + kv) * 2048 * 128; const float* w2 = a->in[5] + ((size_t)l * 2 + kv) * 128 * 64;
        float h0 = 0.f, h1 = 0.f;
        for (int k = 0; k < 2048; ++k) { const int p = k >> 6, d = k & 63; const float x = bf2f(H[((size_t)b * SEQ + 16 * i + p) * HLD + 512 + kv * 128 + hh * 64 + d]) + pe[k];
            h0 += x * w1[(size_t)k * 128 + lane]; h1 += x * w1[(size_t)k * 128 + 64 + lane]; }
        h0 = h0 / (1.f + __expf(-h0)); h1 = h1 / (1.f + __expf(-h1));
        float o = 0.f;
        for (int n = 0; n < 64; ++n) { o += __shfl(h0, n) * w2[(size_t)n * 64 + lane] + __shfl(h1, n) * w2[(size_t)(64 + n) * 64 + lane]; }
        const float got = bf2f(((const bf16*)(a->ws + (kv ? WS_VC : WS_KC)))[((size_t)bh * 256 + i) * 64 + lane]);
        const float e2 = wave_sum((o - got) * (o - got)), r2 = wave_sum(o * o); if (lane == 0) { dbg_add(a, 14, e2); dbg_add(a, 15, r2); }
    }
}
__device__ __forceinline__ void check_conformer(const Frame& F, ArgsP a, int l) {
    const bf16* H = (const bf16*)(a->ws + WS_H); const bf16* Y = (const bf16*)(a->ws + WS_Y); const int lane = F.lane;
    for (int s = F.bid * NWAVES + F.wave; s < 1024; s += F.G * NWAVES) {
        const int tok = (s * 6151 + 3) & (T - 1), t = tok & (SEQ - 1); float u[4];
#pragma unroll
        for (int j = 0; j < 4; ++j) { const int c = lane + 64 * j; float acc = a->in[11][l * 256 + c];
            for (int k = 0; k < 31; ++k) { const int sp = t - 30 + k; if (sp >= 0) { const bf16* hp = H + (size_t)(tok - 30 + k) * HLD + 2304 + c; const float g = bf2f(hp[256]); acc += a->in[10][((size_t)l * 31 + k) * 256 + c] * (bf2f(hp[0]) / (1.f + __expf(-g))); } }
            u[j] = acc; }
        const float mean = wave_sum(u[0] + u[1] + u[2] + u[3]) * (1.f / 256.f); float q = 0.f;
#pragma unroll
        for (int j = 0; j < 4; ++j) { u[j] -= mean; q += u[j] * u[j]; }
        const float rstd = 1.f / sqrtf(wave_sum(q) * (1.f / 256.f) + LN_EPS); float e2 = 0.f, r2 = 0.f;
#pragma unroll
        for (int j = 0; j < 4; ++j) { const int c = lane + 64 * j; const float v = u[j] * rstd * a->in[12][l * 256 + c] + a->in[13][l * 256 + c]; const float ref = v / (1.f + __expf(-v)), got = bf2f(Y[(size_t)tok * DM + 768 + c]);
            e2 += (ref - got) * (ref - got); r2 += ref * ref; }
        e2 = wave_sum(e2); r2 = wave_sum(r2); if (lane == 0) { dbg_add(a, 16, e2); dbg_add(a, 17, r2); }
    }
}
__device__ __forceinline__ void check_inject(const Frame& F, ArgsP a) {
    if (F.bid == 0 && F.tid == 0) { const float* d = (const float*)(a->ws + WS_DBG); float e0 = 0.f, e1 = 0.f;
        if (SELFCHECK == 1) { e0 = 1000.f * sqrtf(d[0] / d[1]); e1 = 1.0e4f * d[2] / d[3]; }
        if (SELFCHECK == 2) { e0 = 1000.f * sqrtf(d[4] / d[5]); }
        if (SELFCHECK == 3) { e0 = 1000.f * sqrtf(d[6] / d[7]); e1 = 1.0e4f * d[8] / d[9] + 1000.f * sqrtf(d[10] / fmaxf(d[11], 1e-30f)); }
        if (SELFCHECK == 4) { e0 = 1000.f * sqrtf(d[12] / d[13]); }
        if (SELFCHECK == 5) { e0 = 1000.f * sqrtf(d[14] / d[15]); e1 = 1000.f * sqrtf(d[16] / d[17]); }
        a->out[0] += e0; a->out[1] += e1; }
}


#ifndef MK_MULTI
#define MK_MULTI 0
#endif
#ifndef PROBE_REPEAT
#define PROBE_REPEAT 0
#endif
constexpr int N_PHASES = 1 + 10 * NL;
__device__ __forceinline__ Frame make_frame(int wave_s) {
    extern __shared__ __attribute__((aligned(16))) unsigned char lds_raw[];
    Frame F; F.lds = (LAS unsigned char*)lds_raw; F.MISC = (volatile LAS unsigned*)(F.lds + MISC_OFF);
    int tid = threadIdx.x, G = gridDim.x, bid = blockIdx.x; unsigned lb = (unsigned)(size_t)F.lds; (void)wave_s;
    asm volatile("" : "+v"(tid), "+s"(G), "+s"(bid), "+s"(lb));
    F.lds = (LAS unsigned char*)(size_t)lb; F.MISC = (volatile LAS unsigned*)(F.lds + MISC_OFF);
    F.tid = tid; F.lane = F.tid & 63; F.wave = __builtin_amdgcn_readfirstlane(F.tid >> 6); F.G = G; F.bid = bid;
    F.ctl = (unsigned*)(args_here()->ws + WS_CTL); return F;
}
__device__ __forceinline__ void ph_prologue(int, int wv) { const Frame F = make_frame(wv); phase_prologue(F, args_here()); phase_weights(F, args_here(), 0, 2, F.G, 0);
#if SELFCHECK
    if (F.bid == 0 && F.tid < 64) ((float*)(args_here()->ws + WS_DBG))[F.tid] = 0.f;
#endif
}
__device__ __forceinline__ void ph_inproj(int l, int wv) { const Frame F = make_frame(wv); unsigned char* ws = args_here()->ws;
    pg8::Gemm g{(const bf16*)(ws + WS_XB), (const bf16*)(WLBASE(ws, l) + WL_WIN), T, DINP, DM}; pg8::StaticOrder S; S.init(T, DINP, F.G, F.bid);
    pg8::EpiInProj E{(bf16*)(ws + WS_H), (float*)(ws + WS_SIDE), (const float*)(ws + WS_ROPE)};
    pg8::gemm_phase<pg8::EpiInProj, pg8::StaticOrder, false>(F.lds, g, S, E, nullptr, F.tid); }
__device__ __forceinline__ void ph_compress(int l, int wv) { const Frame F = make_frame(wv); for (int it = F.bid; it < 256; it += F.G) compress_item(F, args_here(), l, it); }
__device__ __forceinline__ void ph_gdnprep(int l, int wv) { const Frame F = make_frame(wv); for (int it = F.bid; it < 256; it += F.G) { gdn_prep_chunk<0>(F, args_here(), l, it * 8 + F.wave, F.lds + F.wave * 16384); __syncthreads(); } }
__device__ __forceinline__ void ph_gdnprep_var(int l, int wv) { const Frame F = make_frame(wv); for (int it = F.bid; it < 256; it += F.G) { gdn_prep_chunk<PROBE_GDN_VAR | 1>(F, args_here(), l, it * 8 + F.wave, F.lds + F.wave * 16384); __syncthreads(); } }
__device__ __forceinline__ void ph_conformer(int l, int wv) { const Frame F = make_frame(wv); for (int it = F.bid; it < 512; it += F.G) conformer_item(F, args_here(), l, it); }
__device__ __forceinline__ void ph_gdnout(int l, int wv) { const Frame F = make_frame(wv); for (int ci = F.bid * NWAVES + F.wave; ci < 2048; ci += F.G * NWAVES) gdn_out_chunk(F, args_here(), ci, F.lds + F.wave * 8192); }
constexpr int NCONV = 64;
__device__ __forceinline__ void ph_scan(int l, int wv) { const Frame F = make_frame(wv); if (F.bid < 16) gdn_scan<0>(F, args_here(), l); }
__device__ __forceinline__ void ph_bgweights(int l, int wv) { const Frame F = make_frame(wv);
    if (F.bid < NCONV) { if (l == 0) phase_weights(F, args_here(), 0, 1, NCONV, 0); if (l + 1 < NL) phase_weights(F, args_here(), l + 1, 3, NCONV, 0); __syncthreads(); } }
__device__ __forceinline__ void ph_scan_var(int l, int wv) { const Frame F = make_frame(wv); if (F.bid < 16) gdn_scan<(PROBE_SCAN_VAR & 1)>(F, args_here(), l); }
__device__ __forceinline__ void ph_attn(int l, int rep, int wv) { const Frame F = make_frame(wv); phase_mix_b(F, args_here(), l, rep); }
__device__ __forceinline__ void ph_outproj(int l, int wv) { const Frame F = make_frame(wv); ArgsP ap = args_here(); unsigned char* ws = ap->ws;
    pg8::Gemm g{(const bf16*)(ws + WS_Y), (const bf16*)(WLBASE(ws, l) + WL_WOUT), T, DM, DM}; pg8::StaticOrder S; S.init(T, DM, F.G, F.bid);
    pg8::EpiOutProj E{(const bf16*)(ws + WS_XB), (float*)(ws + WS_X1), DN_ALPHA};
    pg8::gemm_phase<pg8::EpiOutProj, pg8::StaticOrder, false>(F.lds, g, S, E, nullptr, F.tid); }
__device__ __forceinline__ void ph_ln1(int l, int wv) { const Frame F = make_frame(wv); phase_ln1_router<false>(F, args_here(), l); }
__device__ __forceinline__ void ph_ln1_dry(int l, int wv) { const Frame F = make_frame(wv); phase_ln1_router<true>(F, args_here(), l); }
__device__ __forceinline__ void ph_gather(int l, int wv) { const Frame F = make_frame(wv); phase_gather(F, args_here(), l); }
__device__ __forceinline__ void ph_moeup(int l, int wv) { const Frame F = make_frame(wv); unsigned char* ws = args_here()->ws;
    pg8::Gemm g{(const bf16*)(ws + WS_H), (const bf16*)(WLBASE(ws, l) + WL_WGU), 0, 0, DM / 2};   pg8::MoeOrder S{(const int*)(ws + WS_META) + l * 512, F.G, F.bid};
    pg8::EpiSwiGLU E{ws + WS_HID, (const int*)(ws + WS_SLOT + SL_TOK), 1};
    pg8::gemm_phase<pg8::EpiSwiGLU, pg8::MoeOrder, false>(F.lds, g, S, E, nullptr, F.tid); }
__device__ __forceinline__ void ph_moedown(int l, int wv) { const Frame F = make_frame(wv); unsigned char* ws = args_here()->ws;
    pg8::Gemm g{(const bf16*)(ws + WS_HID), (const bf16*)(WLBASE(ws, l) + WL_WDN), 0, 0, FF / 2}; pg8::MoeOrder S{(const int*)(ws + WS_META) + l * 512, F.G, F.bid};
    pg8::EpiDown E{(bf16*)(ws + WS_Y2), (const int*)(ws + WS_SLOT + SL_TOK), (const float*)(ws + WS_SLOT + SL_W)};
    pg8::gemm_phase<pg8::EpiDown, pg8::MoeOrder, false>(F.lds, g, S, E, nullptr, F.tid); }
__device__ __forceinline__ void ph_ln2(int l, int wv) { const Frame F = make_frame(wv); phase_ln2(F, args_here(), l); }

__global__ void __launch_bounds__(NTHR, 2) fwd_kernel(Args args) {
    extern __shared__ __attribute__((aligned(16))) unsigned char lds_raw[];
    (void)lds_raw; const int wv = 0; const Frame F = make_frame(wv);
    if (F.tid < 64) F.MISC[F.tid] = 0u;
    __syncthreads();
    XcdBarrier bar = xcd_barrier_post(F.ctl + CW_BAR, F.MISC + 8);
    const int lo = args_here()->ph_lo, hi = args_here()->ph_hi;
#define IN(k) (lo <= (k) && (k) < hi)
#define SEAM(k) do { if (IN(k) && IN((k) + 1)) { XcdBarrier bb = bar; asm volatile("" : "+s"(bb.bar)); xcd_barrier(bb); } } while (0)
#define RPT(bit, call) do { call; if (PROBE_REPEAT & (1u << (bit))) { XcdBarrier bb = bar; asm volatile("" : "+s"(bb.bar)); xcd_barrier(bb); call; } } while (0)
    if (IN(0)) ph_prologue(0, wv);
    SEAM(0);
#define LAYER_BODY(l) do { \
        const int pb = 1 + 10 * l; \
        if (IN(pb + 0)) RPT(0, ph_inproj(l, wv)); \
        SEAM(pb + 0); \
        if constexpr (SELFCHECK == 4) { \
        if (l == CHECK_LAYER) { { const Frame F2 = make_frame(wv); check_inproj(F2, args_here(), l); } XcdBarrier bb = bar; asm volatile("" : "+s"(bb.bar)); xcd_barrier(bb); } \
        } \
        if (IN(pb + 1)) { RPT(16, ph_compress(l, wv)); ph_gdnprep(l, wv); if (PROBE_REPEAT & (1u << 17)) { XcdBarrier bb = bar; asm volatile("" : "+s"(bb.bar)); xcd_barrier(bb); ph_gdnprep_var(l, wv); } RPT(18, ph_conformer(l, wv)); } \
        SEAM(pb + 1); \
        if (IN(pb + 2)) { ph_scan(l, wv); ph_bgweights(l, wv); if (PROBE_REPEAT & (1u << 19)) { XcdBarrier bb = bar; asm volatile("" : "+s"(bb.bar)); xcd_barrier(bb); ph_scan_var(l, wv); XcdBarrier bb2 = bar; asm volatile("" : "+s"(bb2.bar)); xcd_barrier(bb2); } ph_attn(l, 0, wv); if (PROBE_REPEAT & (1u << 20)) { XcdBarrier bb = bar; asm volatile("" : "+s"(bb.bar)); xcd_barrier(bb); ph_attn(l, 1, wv); } } \
        SEAM(pb + 2); \
        if (IN(pb + 3)) RPT(24, ph_gdnout(l, wv)); \
        SEAM(pb + 3); \
        if constexpr (SELFCHECK == 1 || SELFCHECK == 2 || SELFCHECK == 5) { \
        if (l == CHECK_LAYER) { { const Frame F2 = make_frame(wv); if (SELFCHECK == 1) check_nsa(F2, args_here()); else if (SELFCHECK == 2) check_gdn(F2, args_here(), l); else { check_compress(F2, args_here(), l); check_conformer(F2, args_here(), l); } } XcdBarrier bb = bar; asm volatile("" : "+s"(bb.bar)); xcd_barrier(bb); } \
        } \
        if (IN(pb + 4)) RPT(3, ph_outproj(l, wv)); \
        SEAM(pb + 4); \
        if (IN(pb + 5)) { ph_ln1(l, wv); if (PROBE_REPEAT & (1u << 4)) { XcdBarrier bb = bar; asm volatile("" : "+s"(bb.bar)); xcd_barrier(bb); ph_ln1_dry(l, wv); } \
            if (PROBE_REPEAT & (1u << 23)) { for (int rr = 0; rr < 4; ++rr) { XcdBarrier bb = bar; asm volatile("" : "+s"(bb.bar)); xcd_barrier(bb); } } } \
        SEAM(pb + 5); \
        if (IN(pb + 6)) RPT(5, ph_gather(l, wv)); \
        SEAM(pb + 6); \
        if (IN(pb + 7)) RPT(6, ph_moeup(l, wv)); \
        SEAM(pb + 7); \
        if (IN(pb + 8)) RPT(7, ph_moedown(l, wv)); \
        SEAM(pb + 8); \
        if constexpr (SELFCHECK == 3) { \
        if (l == CHECK_LAYER) { { const Frame F2 = make_frame(wv); check_moe(F2, args_here(), l); } XcdBarrier bb = bar; asm volatile("" : "+s"(bb.bar)); xcd_barrier(bb); } \
        } \
        if (IN(pb + 9)) { ph_ln2(l, wv); } \
        SEAM(pb + 9); \
     \
    } while (0)
    LAYER_BODY(0); LAYER_BODY(1); LAYER_BODY(2); LAYER_BODY(3);
#undef LAYER_BODY
#undef RPT
#if SELFCHECK
    { XcdBarrier bb = bar; asm volatile("" : "+s"(bb.bar)); xcd_barrier(bb); const Frame F2 = make_frame(wv); check_inject(F2, args_here()); }
#endif
#undef IN
#undef SEAM
}

extern "C" void kernel_launch(void* const* d_in, const int* in_sizes, int n_in, void* d_out, int out_size, void* d_ws, size_t ws_size, hipStream_t stream) {
    static int grid = 0;
    if (grid == 0) {
        if (n_in != 25 || in_sizes[0] != T * DM || out_size != T * DM || ws_size < WS_END) { fprintf(stderr, "kernel_launch: shape/workspace mismatch (n_in %d, in0 %d, out %d, ws %zu < %zu); nothing launched\n", n_in, n_in > 0 ? in_sizes[0] : -1, out_size, ws_size, (size_t)WS_END); grid = -1; return; }
        int dev = 0, cus = 0, per_cu = 0;
        if (hipGetDevice(&dev) != hipSuccess || hipDeviceGetAttribute(&cus, hipDeviceAttributeMultiprocessorCount, dev) != hipSuccess) { grid = -1; return; }
        if (hipFuncSetAttribute((const void*)fwd_kernel, hipFuncAttributeMaxDynamicSharedMemorySize, LDS_BYTES) != hipSuccess) { fprintf(stderr, "kernel_launch: hipFuncSetAttribute failed\n"); grid = -1; return; }
        if (hipOccupancyMaxActiveBlocksPerMultiprocessor(&per_cu, (const void*)fwd_kernel, NTHR, LDS_BYTES) != hipSuccess || per_cu < 1)
            fprintf(stderr, "kernel_launch: note: occupancy query reports %d workgroups per CU\n", per_cu);
        (void)hipGetLastError();
        grid = cus;
        if (grid < 32 || (grid & 7)) { fprintf(stderr, "kernel_launch: unexpected CU count %d\n", cus); }
    }
    if (grid < 0) return;
    if (hipMemsetAsync((char*)d_ws + WS_CTL, 0, CTL_ZERO_BYTES, stream) != hipSuccess) return;
    Args a{};
    for (int i = 0; i < 25; ++i) a.in[i] = (const float*)d_in[i];
    a.out = (float*)d_out; a.ws = (unsigned char*)d_ws;
#if MK_MULTI
    for (int p = 0; p < N_PHASES; ++p) { a.ph_lo = p; a.ph_hi = p + 1; hipLaunchKernelGGL(fwd_kernel, dim3(grid), dim3(NTHR), LDS_BYTES, stream, a); }
#else
    a.ph_lo = 0; a.ph_hi = N_PHASES;
    hipLaunchKernelGGL(fwd_kernel, dim3(grid), dim3(NTHR), LDS_BYTES, stream, a);
#endif
}
```

```cpp
#include <hip/hip_runtime.h>
#include <cstdio>
#include <cstdint>
namespace pg8 {
#define PG8_LAS __attribute__((address_space(3)))
typedef unsigned short bf16_t;
typedef short bf16x8 __attribute__((ext_vector_type(8)));
typedef float f32x4 __attribute__((ext_vector_type(4)));
typedef unsigned u32x4 __attribute__((ext_vector_type(4)));
constexpr int BM = 256, BK = 64, HALF = 128, HTB = HALF * BK * 2  , STAGE_BYTES = 8 * HTB, NXCD = 8, WGM = 8;

__host__ __device__ __forceinline__ int lds_byte(int r, int c) { const int st = (r >> 4) * 2 + (c >> 5), rr = r & 15, cc = c & 31, ob = rr * 64 + cc * 2; return st * 1024 + (ob ^ (((ob >> 9) & 1) << 5)); }
__host__ __device__ __forceinline__ void stage_rc(int b, int& R, int& C) { const int st = b / 1024, sb = b % 1024, swz = sb ^ (((sb >> 9) & 1) << 5); R = (st >> 1) * 16 + swz / 64; C = (st & 1) * 32 + (swz % 64) / 2; }
__host__ __device__ __forceinline__ int perm32(int rho) { const int n = rho >> 4, i = rho & 15; return 8 * (i >> 2) + 4 * n + (i & 3); }

struct Unit { int pm, pn; };
struct Gemm { const bf16_t* A; const bf16_t* Bt; int M, N, K; };

struct StaticOrder {
    int nM, nN, nwg, G, c;
    __host__ __device__ void init(int M, int N, int G_, int c_) { nM = M / BM; nN = N / BM; nwg = nM * nN; G = G_; c = c_; }
    __host__ __device__ bool next(int i, Unit& u) const {
        const long L = (long)i * G + c; if (L >= nwg) return false;
        int wgid = (int)L; { const int q = nwg / NXCD, r = nwg % NXCD, xcd = wgid % NXCD, off = wgid / NXCD; wgid = (xcd < r ? xcd * (q + 1) : r * (q + 1) + (xcd - r) * q) + off; }
        const int nig = WGM * nN, gid = wgid / nig, fm = gid * WGM, gsz = (nM - fm) < WGM ? (nM - fm) : WGM;
        u.pm = fm + ((wgid % nig) % gsz); u.pn = (wgid % nig) / gsz; return true;
    }
    __device__ __forceinline__ void a_ready(const Unit&) const {}
    __device__ __forceinline__ void done(const Unit&) const {}
};

__device__ __forceinline__ unsigned cvt_pk_bf16(float lo, float hi) { unsigned r; asm volatile("v_cvt_pk_bf16_f32 %0, %1, %2" : "=v"(r) : "v"(lo), "v"(hi)); return r; }
__device__ __forceinline__ float fast_sigmoid(float x) { return __builtin_amdgcn_rcpf(1.0f + __builtin_amdgcn_exp2f(-1.44269504089f * x)); }

constexpr int HLD = 2816;
constexpr float QSCALE = 0.125f * 1.44269504089f;

struct EpiInProj {
    static constexpr bool PERM = true, AFTER_DRAIN = false, GATHER = false, FP8 = false;
    bf16_t* H; float* side; const float* rope;
    __device__ __forceinline__ void operator()(const f32x4 (&acc)[2][2][4][2], const Unit& u, int wr, int wc, int fr, int fq) const {
        const int row0 = u.pm * BM + wr * 64 + fr; const int pn = u.pn;
        if (pn <= 4) {
#pragma unroll
            for (int ai = 0; ai < 2; ++ai)
#pragma unroll
                for (int m = 0; m < 4; ++m) {
                    const int row = row0 + ai * HALF + m * 16; const float* rp = rope + (size_t)(row & 4095) * 16;
                    const f32x4 c0 = *(const f32x4*)(rp), c1 = *(const f32x4*)(rp + 4), s0 = *(const f32x4*)(rp + 8), s1 = *(const f32x4*)(rp + 12);
#pragma unroll
                    for (int bj = 0; bj < 2; ++bj) {
                        f32x4 v0 = acc[ai][bj][m][0], v1 = acc[ai][bj][m][1];
                        const bool ropeb = (pn < 2) || (bj == 0);
                        if (ropeb) {
                            f32x4 p0, p1;
#pragma unroll
                            for (int e = 0; e < 4; ++e) { p0[e] = __shfl_xor(v0[e], 16); p1[e] = __shfl_xor(v1[e], 16); }
                            if (((wc & 1) == 0) && fq < 2) { const float sg = fq ? 1.f : -1.f; v0 = v0 * c0 + (p0 * s0) * sg; v1 = v1 * c1 + (p1 * s1) * sg; }
                        }
                        if (pn < 2) { v0 = v0 * QSCALE; v1 = v1 * QSCALE; }
                        u32x4 w; w.x = cvt_pk_bf16(v0[0], v0[1]); w.y = cvt_pk_bf16(v0[2], v0[3]); w.z = cvt_pk_bf16(v1[0], v1[1]); w.w = cvt_pk_bf16(v1[2], v1[3]);
                        *(u32x4*)(H + (size_t)row * HLD + pn * BM + bj * HALF + wc * 32 + 8 * fq) = w;
                    }
                }
        } else if (pn < 11) {
#pragma unroll
            for (int ai = 0; ai < 2; ++ai)
#pragma unroll
                for (int m = 0; m < 4; ++m) {
                    const int row = row0 + ai * HALF + m * 16;
#pragma unroll
                    for (int bj = 0; bj < 2; ++bj) {
                        const f32x4 v0 = acc[ai][bj][m][0], v1 = acc[ai][bj][m][1];
                        u32x4 w; w.x = cvt_pk_bf16(v0[0], v0[1]); w.y = cvt_pk_bf16(v0[2], v0[3]); w.z = cvt_pk_bf16(v1[0], v1[1]); w.w = cvt_pk_bf16(v1[2], v1[3]);
                        *(u32x4*)(H + (size_t)row * HLD + pn * BM + bj * HALF + wc * 32 + 8 * fq) = w;
                    }
                }
        } else if (wc == 0) {
#pragma unroll
            for (int ai = 0; ai < 2; ++ai)
#pragma unroll
                for (int m = 0; m < 4; ++m) {
                    const int row = row0 + ai * HALF + m * 16;
                    f32x4 v0 = acc[ai][0][m][0], v1 = acc[ai][0][m][1];
#pragma unroll
                    for (int e = 0; e < 4; ++e) { v0[e] = fast_sigmoid(v0[e]); if (fq < 3) v1[e] = fast_sigmoid(v1[e]); }
                    *(f32x4*)(side + (size_t)row * 32 + 8 * fq) = v0; *(f32x4*)(side + (size_t)row * 32 + 8 * fq + 4) = v1;
                }
        }
    }
};
struct EpiOutProj {
    static constexpr bool PERM = false, AFTER_DRAIN = false, GATHER = false, FP8 = false;
    const bf16_t* res; float* out; float alpha;
    __device__ __forceinline__ void operator()(const f32x4 (&acc)[2][2][4][2], const Unit& u, int wr, int wc, int fr, int fq) const {
        typedef unsigned u32x2 __attribute__((ext_vector_type(2)));
        const int row0 = u.pm * BM + wr * 64 + fr, col0 = u.pn * BM + wc * 32 + 4 * fq;
#pragma unroll
        for (int ai = 0; ai < 2; ++ai)
#pragma unroll
            for (int m = 0; m < 4; ++m) { const size_t off = (size_t)(row0 + ai * HALF + m * 16) * 1024 + col0;
#pragma unroll
                for (int bj = 0; bj < 2; ++bj)
#pragma unroll
                    for (int n = 0; n < 2; ++n) { const u32x2 rb = *(const u32x2*)(res + off + bj * HALF + n * 16);
                        f32x4 r; r[0] = __uint_as_float(rb.x << 16); r[1] = __uint_as_float(rb.x & 0xffff0000u); r[2] = __uint_as_float(rb.y << 16); r[3] = __uint_as_float(rb.y & 0xffff0000u);
                        *(f32x4*)(out + off + bj * HALF + n * 16) = r * alpha + acc[ai][bj][m][n]; }
                asm volatile("" ::: "memory"); }
    }
};
struct EpiSwiGLU {
    static constexpr bool PERM = true, AFTER_DRAIN = false, GATHER = true, FP8 = true;
    unsigned char* hid; const int* rowmap; int rowshift;
    __device__ __forceinline__ void operator()(const f32x4 (&acc)[2][2][4][2], const Unit& u, int wr, int wc, int fr, int fq) const {
        const int row0 = u.pm * BM + wr * 64 + fr, hc0 = (u.pn & 3) * 128 + wc * 16 + 4 * fq;
#pragma unroll
        for (int ai = 0; ai < 2; ++ai)
#pragma unroll
            for (int m = 0; m < 4; ++m) { unsigned char* rowp = hid + (size_t)(row0 + ai * HALF + m * 16) * 512 + hc0;
#pragma unroll
                for (int bj = 0; bj < 2; ++bj) { const f32x4 g = acc[ai][bj][m][0] * 0.03125f, up = acc[ai][bj][m][1] * 0.03125f; f32x4 h;
#pragma unroll
                    for (int e = 0; e < 4; ++e) h[e] = __builtin_amdgcn_fmed3f(g[e] * fast_sigmoid(g[e]) * up[e], -440.f, 440.f);
                    int w = 0; w = __builtin_amdgcn_cvt_pk_fp8_f32(h[0], h[1], w, false); w = __builtin_amdgcn_cvt_pk_fp8_f32(h[2], h[3], w, true);
                    *(int*)(rowp + bj * 64) = w; } }
    }
};
struct EpiDown {
    static constexpr bool PERM = true, AFTER_DRAIN = false, GATHER = false, FP8 = true;
    bf16_t* y2; const int* slot_tok; const float* slot_w;
    __device__ __forceinline__ void operator()(const f32x4 (&acc)[2][2][4][2], const Unit& u, int wr, int wc, int fr, int fq) const {
        const int row0 = u.pm * BM + wr * 64 + fr, col0 = (u.pn & 3) * BM + wc * 32 + 8 * fq;
#pragma unroll
        for (int ai = 0; ai < 2; ++ai)
#pragma unroll
            for (int m = 0; m < 4; ++m) { const int row = row0 + ai * HALF + m * 16; const int st = slot_tok[row]; const float sw = slot_w[row] * 0.015625f;
                if (st >= 0) { bf16_t* rowp = y2 + (size_t)st * 1024 + col0;
#pragma unroll
                    for (int bj = 0; bj < 2; ++bj) { const f32x4 v0 = acc[ai][bj][m][0] * sw, v1 = acc[ai][bj][m][1] * sw;
                        u32x4 w; w.x = cvt_pk_bf16(v0[0], v0[1]); w.y = cvt_pk_bf16(v0[2], v0[3]); w.z = cvt_pk_bf16(v1[0], v1[1]); w.w = cvt_pk_bf16(v1[2], v1[3]);
                        *(u32x4*)(rowp + bj * HALF) = w; } } }
    }
};
struct MoeOrder {
    const int* meta; int G, c;
    __device__ __forceinline__ bool next(int i, Unit& u) const {
        const int per = G >> 3; const int idx = (G & 7) ? (i * G + c) : ((i * 8 + (c & 7)) * per + (c >> 3));
        const int nt = __builtin_amdgcn_readfirstlane(meta[0]); if (idx >= nt * 4) return false;
        const int pm = idx >> 2; u.pm = pm; u.pn = __builtin_amdgcn_readfirstlane(meta[64 + pm]) * 4 + (idx & 3); return true;
    }
    __device__ __forceinline__ void a_ready(const Unit&) const {}
    __device__ __forceinline__ void done(const Unit&) const {}
};
typedef int v4i_ __attribute__((ext_vector_type(4)));
typedef int v8i_ __attribute__((ext_vector_type(8)));
template <class Epi, class Sched, bool STAMP = false>
__device__ __forceinline__ void gemm_phase(PG8_LAS unsigned char* lds, const Gemm g, const Sched& S, const Epi& E, unsigned long long* stamps, int tid_in) {
    int tid_ = tid_in; asm volatile("" : "+v"(tid_));
    const int tid = tid_, wid = __builtin_amdgcn_readfirstlane(tid >> 6), lane = tid & 63, wr = wid >> 2, wc = wid & 3, fr = lane & 15, fq = lane >> 4;
    const int K = g.K, nt = K / BK;
    int ts_lo = 0, ts_hi = 0, nts = 0; const unsigned long long rt_entry = STAMP ? (unsigned long long)wall_clock64() : 0ull;
#define PG8_STAMP() do { if (STAMP && wid == 0 && nts < 64) { const unsigned long long _c = (unsigned long long)clock64(); \
        ts_lo = (lane == nts) ? (int)(unsigned)_c : ts_lo; ts_hi = (lane == nts) ? (int)(unsigned)(_c >> 32) : ts_hi; ++nts; } } while (0)
    PG8_STAMP();
    unsigned voffA[2], voffB[2];
#pragma unroll
    for (int i = 0; i < 2; ++i) { int R, C; stage_rc(tid * 16 + i * 8192, R, C); const int Rb = Epi::PERM ? ((R & ~31) + perm32(R & 31)) : R;
        voffA[i] = (unsigned)(R * K + C) * 2u; voffB[i] = (unsigned)(Rb * K + C) * 2u; }
    unsigned offAc[2][2], offAn[2][2];
    PG8_LAS unsigned char* gidx = lds + STAGE_BYTES + (unsigned)wid * 1024u;
#define PG8_IDX_DMA(par, pm_) do { int t2_ = tid; asm volatile("" : "+v"(t2_)); _Pragma("unroll") for (int i_ = 0; i_ < 2; ++i_) { int R_, C_; stage_rc(t2_ * 16 + i_ * 8192, R_, C_); (void)C_; \
        _Pragma("unroll") for (int h_ = 0; h_ < 2; ++h_) __builtin_amdgcn_global_load_lds((const unsigned*)(E.rowmap + (size_t)(pm_) * BM + h_ * HALF + R_), (PG8_LAS unsigned*)(gidx + (par) * 512 + (h_ * 2 + i_) * 256), 4, 0, 0); } } while (0)
#define PG8_IDX_READ(dst, par) do { int t2_ = tid; asm volatile("" : "+v"(t2_)); _Pragma("unroll") for (int i_ = 0; i_ < 2; ++i_) { int R_, C_; stage_rc(t2_ * 16 + i_ * 8192, R_, C_); (void)R_; \
        _Pragma("unroll") for (int h_ = 0; h_ < 2; ++h_) { int r_ = *(const PG8_LAS int*)(gidx + (par) * 512 + (h_ * 2 + i_) * 256 + (t2_ & 63) * 4); r_ = r_ < 0 ? 0 : (r_ >> E.rowshift); dst[h_][i_] = (unsigned)r_ * (unsigned)(K * 2) + (unsigned)C_ * 2u; } } } while (0)
    const size_t kstep = (size_t)(BK * 2);
    const size_t hstep = (size_t)HALF * K * 2;
    const size_t tstep = 2 * hstep;
    const unsigned ldsw = (unsigned)wid * 1024u;
    const int aoff = lds_byte(wr * 64 + fr, fq * 8), boff = lds_byte(wc * 32 + fr, fq * 8);
#define PG8_SA(b, h) (((b) * 2 + (h)) * HTB)
#define PG8_SB(b, h) ((4 + (b) * 2 + (h)) * HTB)
#define PG8_STAGE(bufoff, gbase, voff) do { _Pragma("unroll") for (int _i = 0; _i < 2; ++_i) \
        __builtin_amdgcn_global_load_lds((const unsigned*)((const char*)(gbase) + (voff)[_i]), (PG8_LAS unsigned*)(lds + (bufoff) + ldsw + _i * 8192), 16, 0, 0); } while (0)
#define PG8_STAGE_A(bufoff, kt_, h_, nx_) do { if constexpr (Epi::GATHER) { _Pragma("unroll") for (int _i = 0; _i < 2; ++_i) { const unsigned o_ = (nx_) ? offAn[h_][_i] : offAc[h_][_i]; \
            __builtin_amdgcn_global_load_lds((const unsigned*)((const char*)g.A + (size_t)(kt_) * kstep + o_), (PG8_LAS unsigned*)(lds + (bufoff) + ldsw + _i * 8192), 16, 0, 0); } } \
        else { PG8_STAGE(bufoff, ((nx_) ? nA : cA) + (size_t)(kt_) * kstep + (h_) * hstep, voffA); } } while (0)
#define PG8_LDA(dst, b, h) do { _Pragma("unroll") for (int m = 0; m < 4; ++m) _Pragma("unroll") for (int k = 0; k < 2; ++k) dst[m][k] = *(const PG8_LAS bf16x8*)(lds + PG8_SA(b, h) + aoff + m * 2048 + k * 1024); } while (0)
#define PG8_LDB(dst, b, h) do { _Pragma("unroll") for (int n = 0; n < 2; ++n) _Pragma("unroll") for (int k = 0; k < 2; ++k) dst[n][k] = *(const PG8_LAS bf16x8*)(lds + PG8_SB(b, h) + boff + n * 2048 + k * 1024); } while (0)
#define PG8_MMA(ai, bj, At, Bt) do { __builtin_amdgcn_s_setprio(1); \
        if constexpr (Epi::FP8) {   \
            _Pragma("unroll") for (int m = 0; m < 4; ++m) _Pragma("unroll") for (int n = 0; n < 2; ++n) \
                { const v8i_ b8_ = __builtin_shufflevector(__builtin_bit_cast(v4i_, Bt[n][0]), __builtin_bit_cast(v4i_, Bt[n][1]), 0, 1, 2, 3, 4, 5, 6, 7), \
                             a8_ = __builtin_shufflevector(__builtin_bit_cast(v4i_, At[m][0]), __builtin_bit_cast(v4i_, At[m][1]), 0, 1, 2, 3, 4, 5, 6, 7); \
                    \
                  asm volatile("v_mfma_f32_16x16x128_f8f6f4 %0, %1, %2, %0" : "+v"(acc[ai][bj][m][n]) : "v"(b8_), "v"(a8_)); } } \
        else { _Pragma("unroll") for (int m = 0; m < 4; ++m) _Pragma("unroll") for (int n = 0; n < 2; ++n) _Pragma("unroll") for (int k = 0; k < 2; ++k) \
            acc[ai][bj][m][n] = __builtin_amdgcn_mfma_f32_16x16x32_bf16(Bt[n][k], At[m][k], acc[ai][bj][m][n], 0, 0, 0); } \
        __builtin_amdgcn_s_setprio(0); } while (0)
#define PG8_WAIT_V(n) asm volatile("s_waitcnt vmcnt(" #n ")" ::: "memory")
#define PG8_WAIT_L(n) asm volatile("s_waitcnt lgkmcnt(" #n ")" ::: "memory")
#define PG8_BAR __builtin_amdgcn_s_barrier()
#define PG8_SCHED __builtin_amdgcn_sched_barrier(0)
    Unit cur, nxt; int ui = 0;
    if (!S.next(0, cur)) return;
    f32x4 acc[2][2][4][2];
    float zf_ = 0.f; asm volatile("" : "+v"(zf_));
#pragma unroll
    for (int a = 0; a < 2; ++a)
#pragma unroll
        for (int b = 0; b < 2; ++b)
#pragma unroll
            for (int m = 0; m < 4; ++m)
#pragma unroll
                for (int n = 0; n < 2; ++n) acc[a][b][m][n] = (f32x4){zf_, zf_, zf_, zf_};
    bf16x8 At[4][2], B0[2][2], B1[2][2];
    const char* cA = (const char*)g.A + (size_t)cur.pm * tstep; const char* cB = (const char*)g.Bt + (size_t)cur.pn * tstep;
    S.a_ready(cur);
    if constexpr (Epi::GATHER) { PG8_IDX_DMA(0, cur.pm); asm volatile("s_waitcnt vmcnt(0)" ::: "memory"); PG8_IDX_READ(offAc, 0); asm volatile("s_waitcnt lgkmcnt(0)" ::: "memory"); }
    const char* nA = cA;
    PG8_STAGE(PG8_SB(0, 0), cB, voffB); PG8_STAGE_A(PG8_SA(0, 0), 0, 0, false); PG8_STAGE(PG8_SB(0, 1), cB + hstep, voffB); PG8_STAGE_A(PG8_SA(0, 1), 0, 1, false);
    if (wr == 1) PG8_BAR;
    PG8_WAIT_V(4); PG8_BAR;
    PG8_STAGE(PG8_SB(1, 0), cB + kstep, voffB); PG8_STAGE_A(PG8_SA(1, 0), 1, 0, false); PG8_STAGE(PG8_SB(1, 1), cB + hstep + kstep, voffB);
    PG8_WAIT_V(6); PG8_BAR;
    PG8_STAMP();
    for (;;) {
        const bool has_next = S.next(ui + 1, nxt);
        nA = has_next ? (const char*)g.A + (size_t)nxt.pm * tstep : cA; const char* nB = has_next ? (const char*)g.Bt + (size_t)nxt.pn * tstep : cB;
        if constexpr (Epi::GATHER) { if (has_next) PG8_IDX_DMA((ui + 1) & 1, nxt.pm); }
#pragma unroll 1
        for (int t = 0; t < nt; t += 2) {
            const bool last = (t == nt - 2);
            const char* b2 = last ? nB : cB + (size_t)(t + 2) * kstep;
            const char* b3 = b2 + kstep;
            const int kt2 = last ? 0 : t + 2;
            if constexpr (Epi::GATHER) { if (last) { if (has_next) PG8_IDX_READ(offAn, (ui + 1) & 1); else { offAn[0][0] = offAc[0][0]; offAn[0][1] = offAc[0][1]; offAn[1][0] = offAc[1][0]; offAn[1][1] = offAc[1][1]; } } }
            if (last && has_next) S.a_ready(nxt);
            PG8_LDB(B0, 0, 0); PG8_SCHED; PG8_LDA(At, 0, 0); PG8_STAGE_A(PG8_SA(1, 1), t + 1, 1, false);
            PG8_WAIT_L(8); PG8_BAR; PG8_WAIT_L(0); PG8_MMA(0, 0, At, B0); PG8_BAR; PG8_SCHED;
            PG8_LDB(B1, 0, 1); PG8_STAGE(PG8_SB(0, 0), b2, voffB);
            PG8_BAR; PG8_WAIT_L(0); PG8_MMA(0, 1, At, B1); PG8_BAR;
            PG8_LDA(At, 0, 1); PG8_STAGE_A(PG8_SA(0, 0), kt2, 0, last);
            PG8_BAR; PG8_WAIT_L(0); PG8_MMA(1, 0, At, B0); PG8_BAR; PG8_SCHED;
            PG8_STAGE(PG8_SB(0, 1), b2 + hstep, voffB);
            PG8_WAIT_V(6); PG8_BAR; PG8_MMA(1, 1, At, B1); PG8_BAR;
            PG8_LDB(B0, 1, 0); PG8_SCHED; PG8_LDA(At, 1, 0); PG8_STAGE_A(PG8_SA(0, 1), kt2, 1, last);
            PG8_WAIT_L(8); PG8_BAR; PG8_WAIT_L(0); PG8_MMA(0, 0, At, B0); PG8_BAR; PG8_SCHED;
            PG8_LDB(B1, 1, 1); PG8_STAGE(PG8_SB(1, 0), b3, voffB);
            PG8_BAR; PG8_WAIT_L(0); PG8_MMA(0, 1, At, B1); PG8_BAR;
            PG8_LDA(At, 1, 1); PG8_STAGE_A(PG8_SA(1, 0), kt2 + 1, 0, last);
            PG8_BAR; PG8_WAIT_L(0); PG8_MMA(1, 0, At, B0); PG8_BAR; PG8_SCHED;
            PG8_STAGE(PG8_SB(1, 1), b3 + hstep, voffB);
            PG8_WAIT_V(6); PG8_BAR; PG8_MMA(1, 1, At, B1); PG8_BAR;
        }
        PG8_STAMP();
        if constexpr (Epi::FP8) asm volatile("s_nop 15\n\ts_nop 15" ::: "memory");
        if constexpr (!Epi::AFTER_DRAIN) { E(acc, cur, wr, wc, fr, fq); S.done(cur); }
        PG8_STAMP();
        if (!has_next) break;
#pragma unroll
        for (int a = 0; a < 2; ++a)
#pragma unroll
            for (int b = 0; b < 2; ++b)
#pragma unroll
                for (int m = 0; m < 4; ++m)
#pragma unroll
                    for (int n = 0; n < 2; ++n) acc[a][b][m][n] = (f32x4){zf_, zf_, zf_, zf_};
        cur = nxt; cA = nA; cB = nB; ++ui;
        if constexpr (Epi::GATHER) { offAc[0][0] = offAn[0][0]; offAc[0][1] = offAn[0][1]; offAc[1][0] = offAn[1][0]; offAc[1][1] = offAn[1][1]; }
    }
    PG8_WAIT_V(0);
    if (wr == 0) PG8_BAR;
    PG8_BAR;
    if constexpr (Epi::AFTER_DRAIN) { E.fused(acc, cur, wr, wc, fr, fq, lds, wid, lane); S.done(cur); }
    PG8_STAMP();
    if (STAMP && wid == 0) { stamps[lane] = lane < nts ? (((unsigned long long)(unsigned)ts_hi << 32) | (unsigned)ts_lo) : 0ull;
        if (lane == 62) stamps[62] = rt_entry; if (lane == 63) stamps[63] = (unsigned long long)wall_clock64(); }
#undef PG8_STAMP
#undef PG8_SA
#undef PG8_SB
#undef PG8_STAGE
#undef PG8_STAGE_A
#undef PG8_IDX_DMA
#undef PG8_IDX_READ
#undef PG8_LDA
#undef PG8_LDB
#undef PG8_MMA
#undef PG8_WAIT_V
#undef PG8_WAIT_L
#undef PG8_BAR
#undef PG8_SCHED
}
}

#ifndef SELFCHECK
#define SELFCHECK 0
#endif
#ifndef PROBE_GDN_VAR
#define PROBE_GDN_VAR 0
#endif
#ifndef PROBE_SCAN_VAR
#define PROBE_SCAN_VAR 0
#endif
#ifndef PROBE_ATTN_VAR
#define PROBE_ATTN_VAR 0
#endif
constexpr int NB = 8, SEQ = 4096, DM = 1024, NL = 4, T = NB * SEQ;
constexpr int DIN = 2848, DINP = 3072, HLD = pg8::HLD;
constexpr int NEXP = 32, FF = 512, NTILE_MAX = 288;
constexpr float LN_EPS = 1e-5f;
constexpr float DN_ALPHA = 1.6817928305074290f;
constexpr int NWAVES = 8, NTHR = 512;

constexpr size_t MiB = 1u << 20, KiB = 1u << 10;
constexpr size_t WS_CTL = 0, CTL_ZERO_BYTES = 128 * KiB;
constexpr size_t WS_ROPE = 1 * MiB;
constexpr size_t WS_META = 1 * MiB + 512 * KiB;
constexpr size_t WS_GL = WS_META + 16 * KiB;
constexpr size_t WS_WL = 2 * MiB;
constexpr size_t WL_WIN = 0, WL_WOUT = 6 * MiB, WL_WGU = 8 * MiB, WL_WDN = 72 * MiB, WL_W1 = 104 * MiB, WL_W2 = 105 * MiB, WL_BIAS1 = 105 * MiB + 64 * KiB, WL_WR = 105 * MiB + 128 * KiB;
constexpr size_t WS_XB = 108 * MiB;
constexpr size_t WS_X1 = 172 * MiB;
constexpr size_t WS_H = 300 * MiB;
constexpr size_t WS_SIDE = 476 * MiB;
constexpr size_t WS_Y = 480 * MiB;
constexpr size_t WS_GPREP = 544 * MiB;
constexpr size_t WS_Y2 = 672 * MiB;
constexpr size_t WS_HID = 800 * MiB;
constexpr size_t WS_KC = 872 * MiB, WS_VC = WS_KC + 512 * KiB;
constexpr size_t WS_SLOT = 873 * MiB;
constexpr size_t SL_TOK = 0, SL_W = 512 * KiB, SL_RE = 1024 * KiB, SL_RP = 1280 * KiB, SL_RW = 1536 * KiB;
constexpr size_t WS_WL2 = 876 * MiB;
constexpr size_t WS_END = 982 * MiB;
#define WLBASE(ws_, l_) ((ws_) + (((l_) & 1) ? WS_WL2 : WS_WL))
constexpr int GCH = 65536;
constexpr int GC_UT = 0, GC_W = 8192, GC_QK = 16384, GC_QD = 24576, GC_KDT = 32768, GC_ZT = 40960, GC_SS = 49152, GC_VB = 57344;
constexpr int CW_TMO = 0;
constexpr int CW_BAR = 4096;
constexpr int CW_CNT = 8192;
constexpr int CW_QUEUE = 12288;
static_assert((CW_QUEUE + NL * 64) * 4 <= (int)CTL_ZERO_BYTES, "CTL words inside the memset region");

constexpr int SCR_BYTES = 159744;
constexpr int MISC_OFF = SCR_BYTES;
constexpr int LDS_BYTES = 163840;

#define GAS __attribute__((address_space(1)))
#define LAS __attribute__((address_space(3)))
typedef unsigned short bf16;
typedef float f32x4 __attribute__((ext_vector_type(4)));
typedef float f32x2 __attribute__((ext_vector_type(2)));
typedef float f32x16 __attribute__((ext_vector_type(16)));
typedef short bf16x8 __attribute__((ext_vector_type(8)));
typedef short s16x4 __attribute__((ext_vector_type(4)));
typedef unsigned u32x4 __attribute__((ext_vector_type(4)));
typedef unsigned u32x2 __attribute__((ext_vector_type(2)));
#define LDS_WAIT() asm volatile("s_waitcnt lgkmcnt(0)" ::: "memory")
#define VM_WAIT() asm volatile("s_waitcnt vmcnt(0)" ::: "memory")
#define SBAR() __builtin_amdgcn_sched_barrier(0)
__device__ __forceinline__ float bf2f(unsigned b) { return __uint_as_float(b << 16); }
__device__ __forceinline__ unsigned pk2(float lo, float hi) { return pg8::cvt_pk_bf16(lo, hi); }
__device__ __forceinline__ unsigned f2bf_sw(float f) { unsigned u = __float_as_uint(f); return (u + 0x7fffu + ((u >> 16) & 1u)) >> 16; }
__device__ __forceinline__ unsigned f2bf(float f) { unsigned r; asm("v_cvt_pk_bf16_f32 %0, %1, %1" : "=v"(r) : "v"(f)); return r & 0xffffu; }
__device__ __forceinline__ float row16_sum(float x) {
    x += __int_as_float(__builtin_amdgcn_update_dpp(0, __float_as_int(x), 0xB1, 0xf, 0xf, true));
    x += __int_as_float(__builtin_amdgcn_update_dpp(0, __float_as_int(x), 0x4E, 0xf, 0xf, true));
    x += __int_as_float(__builtin_amdgcn_update_dpp(0, __float_as_int(x), 0x141, 0xf, 0xf, true));
    x += __int_as_float(__builtin_amdgcn_update_dpp(0, __float_as_int(x), 0x140, 0xf, 0xf, true));
    return x;
}
__device__ __forceinline__ float wave_sum(float v) {
    const int r = __float_as_int(row16_sum(v));
    return (__int_as_float(__builtin_amdgcn_readlane(r, 0)) + __int_as_float(__builtin_amdgcn_readlane(r, 16))) + (__int_as_float(__builtin_amdgcn_readlane(r, 32)) + __int_as_float(__builtin_amdgcn_readlane(r, 48)));
}
__device__ __forceinline__ float fsigmoid(float x) { return pg8::fast_sigmoid(x); }
__device__ __forceinline__ float fsilu(float x) { return x * pg8::fast_sigmoid(x); }
__device__ __forceinline__ float fexp2(float x) { return __builtin_amdgcn_exp2f(x); }

#define XB_TMO      128
#define XB_XCNT(j)  (256  + 64 * (j))
#define XB_XSUB(j)  (1280 + 64 * (j))
#define XB_XGEN(j)  (2304 + 64 * (j))
#define XB_TOP      3328
#define XB_TOPGEN   3392
#define XCD_BAR_WORDS 3456
#define XB_SPIN_CAP (1u << 18)
#define LAS __attribute__((address_space(3)))

__device__ __forceinline__ unsigned xb_ld(unsigned* p)              { return __hip_atomic_load(p, __ATOMIC_RELAXED, __HIP_MEMORY_SCOPE_AGENT); }
__device__ __forceinline__ unsigned xb_add(unsigned* p, unsigned v) { return __hip_atomic_fetch_add(p, v, __ATOMIC_RELAXED, __HIP_MEMORY_SCOPE_AGENT); }
__device__ __forceinline__ unsigned xb_xcc_id() { return (unsigned)__builtin_amdgcn_s_getreg((3 << 11) | 20) & 0xFu; }
#define XB_SPIN(cond, bar) do { unsigned _sp = 0; while (cond) { __builtin_amdgcn_s_sleep(1); \
    if ((++_sp & 255u) == 0u) { if (xb_ld(&(bar)[XB_TMO])) break; if (_sp > XB_SPIN_CAP) { atomicAdd(&(bar)[XB_TMO], 1u); break; } } } } while (0)

struct XcdBarrier {
    unsigned* bar; unsigned x;
    volatile LAS unsigned* st;
};

__device__ __forceinline__ XcdBarrier xcd_barrier_post(unsigned* bar, volatile LAS unsigned* st) {
    XcdBarrier b; b.bar = bar; b.x = xb_xcc_id(); b.st = st;
    if (threadIdx.x == 0) (void)xb_add(&bar[XB_XCNT(b.x)], 1u);
    return b;
}
__device__ __forceinline__ void xcd_barrier_complete(unsigned* bar, unsigned x, unsigned& nloc, unsigned& nx) {
    const unsigned G = gridDim.x * gridDim.y * gridDim.z;
    unsigned sum, cnt, mine, sp = 0u;
    for (;;) {
        sum = 0u; cnt = 0u; mine = 0u;
#pragma unroll
        for (unsigned j = 0; j < 16; ++j) { const unsigned c = xb_ld(&bar[XB_XCNT(j)]); sum += c; cnt += (c > 0u) ? 1u : 0u; mine = (j == x) ? c : mine; }
        if (sum == G) break;
        __builtin_amdgcn_s_sleep(1);
        if ((++sp & 255u) == 0u) { if (xb_ld(&bar[XB_TMO])) break; if (sp > XB_SPIN_CAP) { atomicAdd(&bar[XB_TMO], 1u); break; } }
    }
    nloc = mine > 0u ? mine : 1u; nx = cnt > 0u ? cnt : 1u;
}

__device__ __forceinline__ void xcd_barrier(const XcdBarrier& b) {
    asm volatile("s_waitcnt vmcnt(0)" ::: "memory");
    __syncthreads();
    if (threadIdx.x == 0) {
        unsigned* bar = b.bar;
        __builtin_amdgcn_s_waitcnt(0);
        unsigned nloc = b.st[0], nx = b.st[1];
        if (nloc == 0u) { xcd_barrier_complete(bar, b.x, nloc, nx); b.st[0] = nloc; b.st[1] = nx; }
        const unsigned old = xb_add(&bar[XB_XSUB(b.x)], 1u);
        const unsigned gen = old / nloc;
        if (old + 1u == (gen + 1u) * nloc) {
            __builtin_amdgcn_fence(__ATOMIC_RELEASE, "agent");
            asm volatile("s_waitcnt vmcnt(0)" ::: "memory");
            const unsigned og = xb_add(&bar[XB_TOP], 1u);
            const unsigned tg = og / nx;
            if (og + 1u == (tg + 1u) * nx) xb_add(&bar[XB_TOPGEN], 1u);
            else XB_SPIN(xb_ld(&bar[XB_TOPGEN]) == tg, bar);
            __builtin_amdgcn_fence(__ATOMIC_ACQUIRE, "agent");
            xb_add(&bar[XB_XGEN(b.x)], 1u);
            asm volatile("s_waitcnt vmcnt(0)" ::: "memory");
        } else {
            XB_SPIN(xb_ld(&bar[XB_XGEN(b.x)]) == gen, bar);
            __builtin_amdgcn_fence(__ATOMIC_ACQUIRE, "agent");
            asm volatile("s_waitcnt vmcnt(0)" ::: "memory");
        }
    }
    __syncthreads();
}

struct Args { const float* in[25]; float* out; unsigned char* ws; int ph_lo, ph_hi; };
typedef const __attribute__((address_space(4))) Args* ArgsP;
__device__ __forceinline__ ArgsP args_here() { ArgsP p = (ArgsP)__builtin_amdgcn_kernarg_segment_ptr(); asm volatile("" : "+s"(p)); return p; }
struct Frame { LAS unsigned char* lds; volatile LAS unsigned* MISC; unsigned* ctl; int tid, lane, wave, G, bid; };

template <class Src>
__device__ __forceinline__ void tr_item(const Src src, int K, int N, bf16* WT, LAS float* scr, int item, int lane) {
    const int nblk = N >> 5, kb = item / nblk, nb = item - kb * nblk, k0 = kb << 6, n0 = nb << 5;
    float tv[32];
#pragma unroll
    for (int i = 0; i < 32; ++i) tv[i] = src(k0 + 2 * i + (lane >> 5), n0 + (lane & 31));
#pragma unroll
    for (int i = 0; i < 32; ++i) scr[(2 * i + (lane >> 5)) * 33 + (lane & 31)] = tv[i];
    LDS_WAIT();
    const int c = lane & 7;
#pragma unroll
    for (int j = 0; j < 4; ++j) { const int n = (lane >> 3) + 8 * j; const LAS float* s = scr + (8 * c) * 33 + n;
        u32x4 o; o.x = pk2(s[0], s[33]); o.y = pk2(s[66], s[99]); o.z = pk2(s[132], s[165]); o.w = pk2(s[198], s[231]);
        *(u32x4*)(WT + (size_t)(n0 + n) * K + k0 + 8 * c) = o; }
    LDS_WAIT();
}
template <class Src>
__device__ __forceinline__ void tr8_load(const Src src, int N, int item, int lane, float (&tv)[32]) {
    const int nblk = N >> 5, kb = item / nblk, nb = item - kb * nblk, k0 = kb << 6, n0 = nb << 5;
#pragma unroll
    for (int i = 0; i < 32; ++i) tv[i] = src(k0 + 2 * i + (lane >> 5), n0 + (lane & 31));
}
__device__ __forceinline__ void tr8_finish(const float (&tv)[32], int K, int N, unsigned char* WT, float mul, LAS float* scr, int item, int lane) {
    const int nblk = N >> 5, kb = item / nblk, nb = item - kb * nblk, k0 = kb << 6, n0 = nb << 5;
#pragma unroll
    for (int i = 0; i < 32; ++i) scr[(2 * i + (lane >> 5)) * 33 + (lane & 31)] = tv[i];
    LDS_WAIT();
    const int n = lane >> 1, kh = (lane & 1) * 32; const LAS float* sp = scr + kh * 33 + n;
#pragma unroll
    for (int q = 0; q < 2; ++q) { u32x4 o;
#pragma unroll
        for (int d = 0; d < 4; ++d) { const LAS float* s4 = sp + (16 * q + 4 * d) * 33; int w = 0;
            w = __builtin_amdgcn_cvt_pk_fp8_f32(s4[0] * mul, s4[33] * mul, w, false); w = __builtin_amdgcn_cvt_pk_fp8_f32(s4[66] * mul, s4[99] * mul, w, true); o[d] = (unsigned)w; }
        *(u32x4*)(WT + (size_t)(n0 + n) * K + k0 + kh + 16 * q) = o; }
    LDS_WAIT();
}
struct SrcPlain { const float* p; int ld; __device__ __forceinline__ float operator()(int k, int n) const { return p[(size_t)k * ld + n]; } };
struct SrcWin { const float* p;
    __device__ __forceinline__ float operator()(int k, int n) const {
        int c;
        if (n < 1280) c = n; else if (n < 2048) c = n + 24; else if (n < 2304) c = n + 24; else if (n < 2816) c = n + 32;
        else if (n < 2840) c = n - 2816 + 1280; else if (n < 2844) c = n - 2840 + 2328; else if (n < 2848) c = n - 2844 + 2332; else return 0.f;
        return p[(size_t)k * DIN + c]; } };
struct SrcGU { const float* wg; const float* wu;
    __device__ __forceinline__ float operator()(int k, int n) const { const int q = n >> 3, r = n & 7; const ptrdiff_t d = (r < 4) ? (ptrdiff_t)0 : (wu - wg); return wg[d + (ptrdiff_t)k * FF + 4 * q + (r & 3)]; } };

__device__ __forceinline__ void phase_weights(const Frame& F, ArgsP a, int l, int parts, int nblk, int lds_off) {
    unsigned char* wl = WLBASE(a->ws, l);
    LAS float* scr = (LAS float*)(F.lds + lds_off + F.wave * 8448);
    const int gw = F.bid * NWAVES + F.wave, NGW = nblk * NWAVES;
    constexpr int I_WIN = 16 * 96, I_WOUT = 16 * 32, I_GU1 = 16 * 32, I_GU = NEXP * I_GU1, I_DN1 = 8 * 32, I_DN = NEXP * I_DN1, I_W1 = 2 * 32 * 4, I_W2 = 2 * 2 * 2, I_WR = 36, I_B1 = 256;
    constexpr int NITEMS = I_WIN + I_WOUT + I_GU + I_DN + I_W1 + I_W2 + I_WR + I_B1;
    if (parts & 1) {
        for (int r = gw; r < I_GU; r += 2 * NGW) { const int r2 = r + NGW; const bool two = r2 < I_GU; const int e = r / I_GU1, e2 = (two ? r2 : r) / I_GU1; float tva[32], tvb[32];
            SrcGU sa{a->in[22] + ((size_t)l * NEXP + e) * DM * FF, a->in[23] + ((size_t)l * NEXP + e) * DM * FF}, sb{a->in[22] + ((size_t)l * NEXP + e2) * DM * FF, a->in[23] + ((size_t)l * NEXP + e2) * DM * FF};
            tr8_load(sa, 1024, r - e * I_GU1, F.lane, tva); tr8_load(sb, 1024, (two ? r2 : r) - e2 * I_GU1, F.lane, tvb);
            tr8_finish(tva, DM, 1024, wl + WL_WGU + (size_t)e * 1024 * DM, 32.f, scr, r - e * I_GU1, F.lane);
            if (two) tr8_finish(tvb, DM, 1024, wl + WL_WGU + (size_t)e2 * 1024 * DM, 32.f, scr, r2 - e2 * I_GU1, F.lane); }
        for (int r = gw; r < I_DN; r += 2 * NGW) { const int r2 = r + NGW; const bool two = r2 < I_DN; const int e = r / I_DN1, e2 = (two ? r2 : r) / I_DN1; float tva[32], tvb[32];
            SrcPlain sa{a->in[24] + ((size_t)l * NEXP + e) * FF * DM, DM}, sb{a->in[24] + ((size_t)l * NEXP + e2) * FF * DM, DM};
            tr8_load(sa, DM, r - e * I_DN1, F.lane, tva); tr8_load(sb, DM, (two ? r2 : r) - e2 * I_DN1, F.lane, tvb);
            tr8_finish(tva, FF, DM, wl + WL_WDN + (size_t)e * DM * FF, 64.f, scr, r - e * I_DN1, F.lane);
            if (two) tr8_finish(tvb, FF, DM, wl + WL_WDN + (size_t)e2 * DM * FF, 64.f, scr, r2 - e2 * I_DN1, F.lane); }
    }
    if (!(parts & 2)) return;
    for (int it = I_GU + I_DN + gw; it < NITEMS; it += NGW) {
        int r = it - I_GU - I_DN;
        if (r < I_WIN) { SrcWin s{a->in[1] + (size_t)l * DM * DIN}; tr_item(s, DM, DINP, (bf16*)(wl + WL_WIN), scr, r, F.lane); continue; } r -= I_WIN;
        if (r < I_WOUT) { SrcPlain s{a->in[2] + (size_t)l * DM * DM, DM}; tr_item(s, DM, DM, (bf16*)(wl + WL_WOUT), scr, r, F.lane); continue; } r -= I_WOUT;
        if (r < I_W1) { const int kv = r / 128; SrcPlain s{a->in[4] + ((size_t)l * 2 + kv) * 2048 * 128, 128};
            tr_item(s, 2048, 128, (bf16*)(wl + WL_W1) + (size_t)kv * 128 * 2048, scr, r - kv * 128, F.lane); continue; } r -= I_W1;
        if (r < I_W2) { const int kv = r / 4; SrcPlain s{a->in[5] + ((size_t)l * 2 + kv) * 128 * 64, 64};
            tr_item(s, 128, 64, (bf16*)(wl + WL_W2) + (size_t)kv * 64 * 128, scr, r - kv * 4, F.lane); continue; } r -= I_W2;
        if (r < I_WR) {
            float* wr = (float*)(wl + WL_WR) + (size_t)r * DM;
            for (int k = F.lane; k < DM; k += 64) wr[k] = (r < 4) ? a->in[18][((size_t)l * DM + k) * 4 + r] : a->in[20][((size_t)l * DM + k) * NEXP + (r - 4)];
            continue; } r -= I_WR;
        {
            const int kv = r >> 7, n = r & 127; const float* pe = a->in[3] + ((size_t)l * 2 + kv) * 2048; const float* w1 = a->in[4] + ((size_t)l * 2 + kv) * 2048 * 128;
            float s = 0.f; for (int k = F.lane; k < 2048; k += 64) s += pe[k] * w1[(size_t)k * 128 + n];
            s = wave_sum(s); if (F.lane == 0) ((float*)(wl + WL_BIAS1))[r] = s;
        }
    }
}

__device__ __forceinline__ void phase_prologue(const Frame& F, ArgsP a) {
    const size_t gt = (size_t)F.bid * NTHR + F.tid, NGT = (size_t)F.G * NTHR;
    float* rope = (float*)(a->ws + WS_ROPE);
    for (size_t i = gt; i < (size_t)SEQ * 8; i += NGT) { const int t = (int)(i >> 3), f = (int)(i & 7);
        const float invt[8] = {1.0f, 0.19392274f, 0.03760603f, 0.0072926646f, 0.0014142136f, 0.0002742482f, 5.3182957e-05f, 1.0313385e-05f};
        float inv = invt[0];
#pragma unroll
        for (int q = 1; q < 8; ++q) inv = (f == q) ? invt[q] : inv;
        const float ang = (float)t * inv;
        const double rev = (double)ang * 0.15915494309189535; const float fr = (float)(rev - __builtin_rint(rev));
        rope[t * 16 + f] = __builtin_amdgcn_cosf(fr); rope[t * 16 + 8 + f] = __builtin_amdgcn_sinf(fr); }
    const f32x4* x4 = (const f32x4*)a->in[0]; u32x4* xb = (u32x4*)(a->ws + WS_XB);
    for (size_t i = gt; i < (size_t)T * DM / 8; i += NGT) { const f32x4 v0 = x4[2 * i], v1 = x4[2 * i + 1];
        u32x4 w; w.x = pk2(v0[0], v0[1]); w.y = pk2(v0[2], v0[3]); w.z = pk2(v1[0], v1[1]); w.w = pk2(v1[2], v1[3]); xb[i] = w; }
}

template <bool DRY>
__device__ __forceinline__ void phase_ln1_router(const Frame& F, ArgsP a, int l) {
    float* X1 = (float*)(a->ws + WS_X1); bf16* XB = (bf16*)(a->ws + WS_XB); unsigned char* XB8 = a->ws + WS_H;
    const float* WR = (const float*)(WLBASE(a->ws, l) + WL_WR);
    const float* lw = a->in[14] + (size_t)l * DM; const float* lb = a->in[15] + (size_t)l * DM;
    const float* bg = a->in[19] + l * 4; const float* be = a->in[21] + l * NEXP;
    int* route_e = (int*)(a->ws + WS_SLOT + SL_RE); int* route_p = (int*)(a->ws + WS_SLOT + SL_RP); float* route_w = (float*)(a->ws + WS_SLOT + SL_RW);
    unsigned* cnt = F.ctl + CW_CNT + (DRY ? l + 4 : l) * 512;
    const int gw = F.bid * NWAVES + F.wave, NGW = F.G * NWAVES, lane = F.lane;
    LAS float* wgl = (LAS float*)F.lds;
    for (int i = F.tid; i < 4 * DM; i += NTHR) wgl[i] = WR[i];
    __syncthreads();
    const float bg0 = bg[0], bg1 = bg[1], bg2 = bg[2], bg3 = bg[3];
    for (int tg = gw; tg < T / 4; tg += NGW) {
        f32x4 v[4][4];
#pragma unroll
        for (int tk = 0; tk < 4; ++tk) { const f32x4* row = (const f32x4*)(X1 + (size_t)(4 * tg + tk) * DM) + lane;
#pragma unroll
            for (int j = 0; j < 4; ++j) v[tk][j] = row[64 * j]; }
#pragma unroll
        for (int tk = 0; tk < 4; ++tk) {
            float s = 0.f;
#pragma unroll
            for (int j = 0; j < 4; ++j) s += (v[tk][j][0] + v[tk][j][1]) + (v[tk][j][2] + v[tk][j][3]);
            const float mean = wave_sum(s) * (1.f / DM); float q = 0.f;
#pragma unroll
            for (int j = 0; j < 4; ++j) { v[tk][j] = v[tk][j] - mean; q += (v[tk][j][0] * v[tk][j][0] + v[tk][j][1] * v[tk][j][1]) + (v[tk][j][2] * v[tk][j][2] + v[tk][j][3] * v[tk][j][3]); }
            const float rstd = 1.f / sqrtf(wave_sum(q) * (1.f / DM) + LN_EPS);
            u32x2* brow = (u32x2*)(XB + (size_t)(4 * tg + tk) * DM) + lane;
#pragma unroll
            for (int j = 0; j < 4; ++j) { const f32x4 w4 = ((const f32x4*)lw)[lane + 64 * j], b4 = ((const f32x4*)lb)[lane + 64 * j];
                v[tk][j] = v[tk][j] * rstd * w4 + b4;
                u32x2 w; w.x = pk2(v[tk][j][0], v[tk][j][1]); w.y = pk2(v[tk][j][2], v[tk][j][3]); if (!DRY) brow[64 * j] = w;
                int w8 = 0; w8 = __builtin_amdgcn_cvt_pk_fp8_f32(v[tk][j][0], v[tk][j][1], w8, false); w8 = __builtin_amdgcn_cvt_pk_fp8_f32(v[tk][j][2], v[tk][j][3], w8, true);
                if (!DRY) ((int*)(XB8 + (size_t)(4 * tg + tk) * DM))[lane + 64 * j] = w8; }
        }
        float glg[4][4];
#pragma unroll
        for (int j = 0; j < 4; ++j) { const LAS f32x4* wr = (const LAS f32x4*)(wgl + j * DM) + lane; const f32x4 w0 = wr[0], w1 = wr[64], w2 = wr[128], w3 = wr[192];
#pragma unroll
            for (int tk = 0; tk < 4; ++tk) { f32x4 p = v[tk][0] * w0; p = p + v[tk][1] * w1; p = p + v[tk][2] * w2; p = p + v[tk][3] * w3; glg[tk][j] = wave_sum((p[0] + p[1]) + (p[2] + p[3])); } }
        int my_e = 0; float my_w = 0.f;
#pragma unroll
        for (int tk = 0; tk < 4; ++tk) {
            const float g0 = glg[tk][0] + bg0, g1 = glg[tk][1] + bg1, g2 = glg[tk][2] + bg2, g3 = glg[tk][3] + bg3;
            int gi = 0; float gm = g0; if (g1 > gm) { gm = g1; gi = 1; } if (g2 > gm) { gm = g2; gi = 2; } if (g3 > gm) { gm = g3; gi = 3; }
            gi = __builtin_amdgcn_readfirstlane(gi);
            const float g_w = 1.f / (__expf(g0 - gm) + __expf(g1 - gm) + __expf(g2 - gm) + __expf(g3 - gm));
            const float* wbase = WR + (size_t)(4 + gi * 8) * DM; float ev[8];
#pragma unroll
            for (int i4 = 0; i4 < 2; ++i4) { f32x4 w[4][4];
#pragma unroll
                for (int i = 0; i < 4; ++i) { const f32x4* wr = (const f32x4*)(wbase + (size_t)(4 * i4 + i) * DM) + lane; w[i][0] = wr[0]; w[i][1] = wr[64]; w[i][2] = wr[128]; w[i][3] = wr[192]; }
#pragma unroll
                for (int i = 0; i < 4; ++i) { f32x4 p = v[tk][0] * w[i][0]; p = p + v[tk][1] * w[i][1]; p = p + v[tk][2] * w[i][2]; p = p + v[tk][3] * w[i][3];
                    ev[4 * i4 + i] = wave_sum((p[0] + p[1]) + (p[2] + p[3])) + be[gi * 8 + 4 * i4 + i]; } }
            int i1 = 0; float v1 = ev[0];
#pragma unroll
            for (int i = 1; i < 8; ++i) if (ev[i] > v1) { v1 = ev[i]; i1 = i; }
            int i2 = -1; float v2 = -3.0e38f;
#pragma unroll
            for (int i = 0; i < 8; ++i) if (i != i1 && ev[i] > v2) { v2 = ev[i]; i2 = i; }
            const float e2 = __expf(v2 - v1), w1 = g_w / (1.f + e2), w2 = g_w - w1;
            if (lane == 2 * tk) { my_e = gi * 8 + i1; my_w = w1; }
            if (lane == 2 * tk + 1) { my_e = gi * 8 + i2; my_w = w2; }
        }
        if (lane < 8) {
            const unsigned pos = __hip_atomic_fetch_add(cnt + my_e * 16, 1u, __ATOMIC_RELAXED, __HIP_MEMORY_SCOPE_AGENT);
            const size_t si = (size_t)tg * 8 + lane; if (!DRY) { route_e[si] = my_e; route_p[si] = (int)pos; route_w[si] = my_w; }
        }
    }
    __syncthreads();
}

__device__ __forceinline__ void phase_gather(const Frame& F, ArgsP a, int l) {
    LAS int* pstart = (LAS int*)F.lds;
    unsigned* cnt = F.ctl + CW_CNT + l * 512;
    int* meta = (int*)(a->ws + WS_META) + l * 512;
    int* slot_tok = (int*)(a->ws + WS_SLOT + SL_TOK); float* slot_w = (float*)(a->ws + WS_SLOT + SL_W);
    const int* route_e = (const int*)(a->ws + WS_SLOT + SL_RE); const int* route_p = (const int*)(a->ws + WS_SLOT + SL_RP); const float* route_w = (const float*)(a->ws + WS_SLOT + SL_RW);
    if (F.tid < 64) {
        const int c = F.tid < 32 ? (int)__hip_atomic_load(cnt + F.tid * 16, __ATOMIC_RELAXED, __HIP_MEMORY_SCOPE_AGENT) : 0;
        const int pad = (c + 255) & ~255; int inc = pad;
#pragma unroll
        for (int o = 1; o < 64; o <<= 1) { const int t = __shfl_up(inc, o); if (F.lane >= o) inc += t; }
        const int st = inc - pad;
        if (F.tid < 32) { pstart[F.tid] = st;
            if (F.bid == 0) { for (int t = st >> 8; t < (st + pad) >> 8; ++t) meta[64 + t] = F.tid; if (F.tid == 31) meta[0] = (st + pad) >> 8; }
            if ((F.tid % F.G) == F.bid) for (int r = st + c; r < st + pad; ++r) { slot_tok[r] = -1; slot_w[r] = 0.f; }
        }
    }
    __syncthreads();
    for (int s = F.bid * NTHR + F.tid; s < T * 2; s += F.G * NTHR) {
        const int dest = pstart[route_e[s]] + route_p[s]; slot_tok[dest] = s; slot_w[dest] = route_w[s];
    }
    __syncthreads();
}

__device__ __forceinline__ void phase_ln2(const Frame& F, ArgsP a, int l) {
    const bf16* Y2 = (const bf16*)(a->ws + WS_Y2); bf16* XB = (bf16*)(a->ws + WS_XB); float* out = a->out;
    const float* lw = a->in[16] + (size_t)l * DM; const float* lb = a->in[17] + (size_t)l * DM;
    const int gw = F.bid * NWAVES + F.wave, NGW = F.G * NWAVES, lane = F.lane; const bool last = (l == NL - 1);
    for (int t0 = 2 * gw; t0 < T; t0 += 2 * NGW) {
        u32x2 xr[2][4], pa[2][4], pb[2][4];
#pragma unroll
        for (int u = 0; u < 2; ++u) { const int t = t0 + u; const u32x2* x_ = (const u32x2*)(XB + (size_t)t * DM) + lane; const u32x2* a_ = (const u32x2*)(Y2 + (size_t)(2 * t) * DM) + lane; const u32x2* b_ = (const u32x2*)(Y2 + (size_t)(2 * t + 1) * DM) + lane;
#pragma unroll
            for (int j = 0; j < 4; ++j) { xr[u][j] = x_[64 * j]; pa[u][j] = a_[64 * j]; pb[u][j] = b_[64 * j]; } }
#pragma unroll
        for (int u = 0; u < 2; ++u) { const int t = t0 + u;
            f32x4 v[4]; float s = 0.f;
#pragma unroll
            for (int j = 0; j < 4; ++j) { const u32x2 x = xr[u][j], p = pa[u][j], q = pb[u][j];
                v[j][0] = bf2f(x.x & 0xffffu) * DN_ALPHA + (bf2f(p.x & 0xffffu) + bf2f(q.x & 0xffffu)); v[j][1] = bf2f(x.x >> 16) * DN_ALPHA + (bf2f(p.x >> 16) + bf2f(q.x >> 16));
                v[j][2] = bf2f(x.y & 0xffffu) * DN_ALPHA + (bf2f(p.y & 0xffffu) + bf2f(q.y & 0xffffu)); v[j][3] = bf2f(x.y >> 16) * DN_ALPHA + (bf2f(p.y >> 16) + bf2f(q.y >> 16));
                s += (v[j][0] + v[j][1]) + (v[j][2] + v[j][3]); }
            const float mean = wave_sum(s) * (1.f / DM); float q2 = 0.f;
#pragma unroll
            for (int j = 0; j < 4; ++j) { v[j] = v[j] - mean; q2 += (v[j][0] * v[j][0] + v[j][1] * v[j][1]) + (v[j][2] * v[j][2] + v[j][3] * v[j][3]); }
            const float rstd = 1.f / sqrtf(wave_sum(q2) * (1.f / DM) + LN_EPS);
            f32x4* orow = (f32x4*)(out + (size_t)t * DM) + lane; u32x2* brow = (u32x2*)(XB + (size_t)t * DM) + lane;
#pragma unroll
            for (int j = 0; j < 4; ++j) { const f32x4 w4 = ((const f32x4*)lw)[lane + 64 * j], b4 = ((const f32x4*)lb)[lane + 64 * j];
                const f32x4 o = v[j] * rstd * w4 + b4; if (last) orow[64 * j] = o; u32x2 w; w.x = pk2(o[0], o[1]); w.y = pk2(o[2], o[3]); brow[64 * j] = w; } }
    }
}

__device__ __forceinline__ int tsw(int row, int col) { return row * 128 + ((((col >> 3) ^ (row >> 1)) & 7) << 4) + ((col & 7) << 1); }
__device__ __forceinline__ f32x4 mfma16(bf16x8 a, bf16x8 b, f32x4 c) { return __builtin_amdgcn_mfma_f32_16x16x32_bf16(a, b, c, 0, 0, 0); }
__device__ __forceinline__ f32x16 mfma32(bf16x8 a, bf16x8 b, f32x16 c) { return __builtin_amdgcn_mfma_f32_32x32x16_bf16(a, b, c, 0, 0, 0); }
__device__ __forceinline__ bf16x8 as_bf16x8(u32x4 v) { return __builtin_bit_cast(bf16x8, v); }

__device__ __forceinline__ void conformer_item(const Frame& F, ArgsP a, int l, int it) {
    const int b = it >> 6, s0 = (it & 63) * 64; const size_t tok0 = (size_t)b * SEQ + s0;
    const bf16* H = (const bf16*)(a->ws + WS_H); bf16* Y = (bf16*)(a->ws + WS_Y);
    LAS bf16* ut = (LAS bf16*)F.lds;
    LAS float* co = (LAS float*)(F.lds + 49152);
    for (int idx = F.tid; idx < 94 * 32; idx += NTHR) {
        const int r = idx >> 5, c8 = (idx & 31) * 8, s = s0 - 30 + r; u32x4 w = {0u, 0u, 0u, 0u};
        if (s >= 0) { const bf16* hp = H + ((size_t)b * SEQ + s) * HLD + 2304 + c8; const u32x4 v = *(const u32x4*)hp, g = *(const u32x4*)(hp + 256);
#pragma unroll
            for (int e = 0; e < 4; ++e) { const float v0 = bf2f(v[e] & 0xffffu) * fsigmoid(bf2f(g[e] & 0xffffu)), v1 = bf2f(v[e] >> 16) * fsigmoid(bf2f(g[e] >> 16)); w[e] = pk2(v0, v1); } }
        *(LAS u32x4*)(ut + r * 256 + c8) = w;
    }
    __syncthreads();
    {
        const int c = F.tid & 255, half = F.tid >> 8; const float* dw = a->in[10] + (size_t)l * 31 * 256 + c; const float bias = a->in[11][l * 256 + c];
        float w[31], ur[62];
#pragma unroll
        for (int k = 0; k < 31; ++k) w[k] = dw[k * 256];
#pragma unroll
        for (int i = 0; i < 62; ++i) ur[i] = bf2f(ut[(32 * half + i) * 256 + c]);
#pragma unroll
        for (int tt = 0; tt < 32; ++tt) { float acc = bias;
#pragma unroll
            for (int k = 0; k < 31; ++k) acc += w[k] * ur[tt + k];
            co[(32 * half + tt) * 256 + c] = acc; }
    }
    __syncthreads();
    {
        const float* lw = a->in[12] + l * 256; const float* lb = a->in[13] + l * 256; const f32x4 w4 = ((const f32x4*)lw)[F.lane], b4 = ((const f32x4*)lb)[F.lane];
#pragma unroll
        for (int i = 0; i < 8; ++i) { const int tl = 8 * F.wave + i; f32x4 v = *(LAS f32x4*)(co + tl * 256 + 4 * F.lane);
            const float mean = wave_sum((v[0] + v[1]) + (v[2] + v[3])) * (1.f / 256.f); v = v - mean;
            const float rstd = 1.f / sqrtf(wave_sum((v[0] * v[0] + v[1] * v[1]) + (v[2] * v[2] + v[3] * v[3])) * (1.f / 256.f) + LN_EPS);
            v = v * rstd * w4 + b4; u32x2 o; o.x = pk2(fsilu(v[0]), fsilu(v[1])); o.y = pk2(fsilu(v[2]), fsilu(v[3]));
            *(u32x2*)(Y + (tok0 + tl) * DM + 768 + 4 * F.lane) = o; }
    }
    __syncthreads();
}

__device__ __forceinline__ void compress_item(const Frame& F, ArgsP a, int l, int it) {
    const int kv = it >> 7, bh = (it >> 3) & 15, b = bh >> 1, hh = bh & 1, i0 = (it & 7) * 32;
    const bf16* H = (const bf16*)(a->ws + WS_H); const bf16* w1t = (const bf16*)(WLBASE(a->ws, l) + WL_W1) + (size_t)kv * 128 * 2048; const bf16* w2t = (const bf16*)(WLBASE(a->ws, l) + WL_W2) + (size_t)kv * 64 * 128;
    const float* bias1 = (const float*)(WLBASE(a->ws, l) + WL_BIAS1) + kv * 128; bf16* outp = (bf16*)(a->ws + (kv ? WS_VC : WS_KC)) + (size_t)bh * 256 * 64;
    LAS bf16* hid = (LAS bf16*)F.lds;
    const int lane = F.lane, li = lane & 15, g = lane >> 4, rt = F.wave & 1, cq = F.wave >> 1;
    const int i = i0 + 16 * rt + li; const bf16* arow = H + (size_t)b * SEQ * HLD + 512 + kv * 128 + hh * 64 + 8 * g;
    const bf16* brow = w1t + (size_t)(32 * cq + li) * 2048 + 8 * g;
    f32x4 acc[2] = {{0.f, 0.f, 0.f, 0.f}, {0.f, 0.f, 0.f, 0.f}};
#pragma unroll 1
    for (int k8 = 0; k8 < 64; k8 += 8) {
        bf16x8 af[8], bfr[8][2];
#pragma unroll
        for (int u = 0; u < 8; ++u) { const int ks = k8 + u; int s = 16 * i + (ks >> 1); s = s > SEQ - 1 ? SEQ - 1 : s;
            af[u] = *(const bf16x8*)(arow + (size_t)s * HLD + (ks & 1) * 32); bfr[u][0] = *(const bf16x8*)(brow + ks * 32); bfr[u][1] = *(const bf16x8*)(brow + (size_t)16 * 2048 + ks * 32); }
#pragma unroll
        for (int u = 0; u < 8; ++u) { acc[0] = mfma16(af[u], bfr[u][0], acc[0]); acc[1] = mfma16(af[u], bfr[u][1], acc[1]); }
    }
#pragma unroll
    for (int nt = 0; nt < 2; ++nt) { const int n = 32 * cq + 16 * nt + li; const float bs = bias1[n];
#pragma unroll
        for (int r = 0; r < 4; ++r) hid[(16 * rt + 4 * g + r) * 136 + n] = (bf16)f2bf(fsilu(acc[nt][r] + bs)); }
    __syncthreads();
    f32x4 o2 = {0.f, 0.f, 0.f, 0.f};
#pragma unroll
    for (int ks = 0; ks < 4; ++ks) { const bf16x8 af = *(LAS bf16x8*)(hid + (16 * rt + li) * 136 + 32 * ks + 8 * g);
        const bf16x8 bfr = *(const bf16x8*)(w2t + (size_t)(16 * cq + li) * 128 + 32 * ks + 8 * g); o2 = mfma16(af, bfr, o2); }
#pragma unroll
    for (int r = 0; r < 4; ++r) { const int io = i0 + 16 * rt + 4 * g + r; outp[(size_t)io * 64 + 16 * cq + li] = (bf16)(io < 255 ? f2bf_sw(o2[r]) : 0u); }
    __syncthreads();
}

__host__ __device__ constexpr int tri_off(int i) { int s = 0; for (int k = 0; k < i; ++k) s += (k + 3) >> 2; return 4 * s; }
__device__ __forceinline__ int tri_off_rt(int i) { const int m = i - 1, V = (m + 3) >> 2; return i <= 0 ? 0 : 4 * (2 * V * (V - 1) + V * (m - 4 * V + 4)); }

template <int I> struct GdnSolveRow {
    __device__ static __forceinline__ void run(const LAS float* Ap, float (&x)[64]) {
        if constexpr (I < 64) {
            constexpr int off = tri_off(I), nb = (I + 3) >> 2;
            float s4[4] = {0.f, 0.f, 0.f, 0.f};
#pragma unroll
            for (int jb = 0; jb < nb; ++jb) { const f32x4 a4 = *(const LAS f32x4*)(Ap + off + 4 * jb);
#pragma unroll
                for (int jj = 0; jj < 4; ++jj) { if (4 * jb + jj < I) s4[jj] += a4[jj] * x[4 * jb + jj]; } }
            x[I] -= (s4[0] + s4[1]) + (s4[2] + s4[3]);
            if constexpr ((I & 3) == 3) SBAR();
            GdnSolveRow<I + 1>::run(Ap, x);
        }
    }
};

template <int GV>
__device__ __forceinline__ void gdn_prep_chunk(const Frame& F, ArgsP a, int l, int ci, LAS unsigned char* wl) {
    int lane_ = F.lane; asm volatile("" : "+v"(lane_));
    const int lane = lane_, li = lane & 15, g = lane >> 4; const int bh = ci >> 6, n = ci & 63, b = bh >> 2, h = bh & 3; const size_t tok0 = (size_t)b * SEQ + 64 * n;
    const bf16* H = (const bf16*)(a->ws + WS_H); const float* side = (const float*)(a->ws + WS_SIDE);
    unsigned char* rec = a->ws + ((GV & 1) ? WS_Y2 : WS_GPREP) + (size_t)ci * GCH;
    bf16* R0 = (bf16*)(rec + GC_UT); bf16* R1 = (bf16*)(rec + GC_W); bf16* QKm = (bf16*)(rec + GC_QK); bf16* QD = (bf16*)(rec + GC_QD); bf16* KDT = (bf16*)(rec + GC_KDT); bf16* ZT = (bf16*)(rec + GC_ZT);
    const int pc = (lane & 32) | (((lane & 15) >> 2) << 3) | (((lane >> 4) & 1) << 2) | (lane & 3);
    LAS unsigned char* qt = wl; LAS unsigned char* kt = wl + 8192; LAS float* Ap = (LAS float*)wl;
    const float beta = side[(tok0 + lane) * 32 + 24 + h]; const float av = side[(tok0 + lane) * 32 + 28 + h] + a->in[8][l * 4 + h];
    const float sp = av > 20.f ? av : log1pf(__expf(av)); float gc = -__expf(a->in[7][l * 4 + h]) * sp;
#pragma unroll
    for (int o = 1; o < 64; o <<= 1) { const float t = __shfl_up(gc, o); if (lane >= o) gc += t; }
    const float gl = __shfl(gc, 63); const float eg = __expf(gc), ekd = __expf(gl - gc);
    if (lane == 0 && !(GV & 1)) ((float*)(a->ws + WS_GL))[ci] = __expf(gl);
    const float* cw = a->in[6] + (size_t)l * 4 * 768 + h * 64 + lane; float wq[4], wk[4], wv[4];
#pragma unroll
    for (int k = 0; k < 4; ++k) { wq[k] = cw[k * 768]; wk[k] = cw[k * 768 + 256]; wv[k] = cw[k * 768 + 512]; }
    const bf16* hp = H + tok0 * HLD + 1280 + h * 64 + lane; float hq[3], hk[3], hv[3];
#pragma unroll
    for (int j = 0; j < 3; ++j) { const bool ok = (64 * n - 3 + j) >= 0; const bf16* p = hp + (ptrdiff_t)(j - 3) * HLD;
        hq[j] = ok ? bf2f(p[0]) : 0.f; hk[j] = ok ? bf2f(p[256]) : 0.f; hv[j] = ok ? bf2f(p[512]) : 0.f; }
    unsigned short ra[8][4], rb[8][4]; const float nwl = a->in[9][l * 64 + lane];
#define GDN_LOADBLK(dst, t8_) do { const bf16* pl_ = hp + (size_t)(8 * (t8_)) * HLD; asm volatile("" : "+v"(pl_)); _Pragma("unroll") for (int tt = 0; tt < 8; ++tt) { const bf16* q_ = pl_ + (size_t)tt * HLD; dst[tt][0] = q_[0]; dst[tt][1] = q_[256]; dst[tt][2] = q_[512]; dst[tt][3] = q_[768]; } } while (0)
#define GDN_CONVBLK(src, t8_) do { const int t8 = (t8_); unsigned kdp[4], zp[4]; \
        bf16* qd8 = QD + (8 * t8) * 64 + pc; bf16* r08 = R0 + (8 * t8) * 64 + lane; bf16* r18 = R1 + (8 * t8) * 64 + lane; asm volatile("" : "+v"(qd8), "+v"(r08), "+v"(r18)); \
        _Pragma("unroll") for (int tt = 0; tt < 8; ++tt) { const int t = 8 * t8 + tt; \
            const float rq = bf2f(src[tt][0]), rk = bf2f(src[tt][1]), rv = bf2f(src[tt][2]); \
            const float cq = wq[0] * hq[0] + wq[1] * hq[1] + wq[2] * hq[2] + wq[3] * rq, ck = wk[0] * hk[0] + wk[1] * hk[1] + wk[2] * hk[2] + wk[3] * rk, cv = wv[0] * hv[0] + wv[1] * hv[1] + wv[2] * hv[2] + wv[3] * rv; \
            hq[0] = hq[1]; hq[1] = hq[2]; hq[2] = rq; hk[0] = hk[1]; hk[1] = hk[2]; hk[2] = rk; hv[0] = hv[1]; hv[1] = hv[2]; hv[2] = rv; \
            const float qs = fsilu(cq), ks_ = fsilu(ck), vs = fsilu(cv); \
            const float qn = qs * __builtin_amdgcn_rsqf(wave_sum(qs * qs) + 1e-6f) * 0.125f, kn = ks_ * __builtin_amdgcn_rsqf(wave_sum(ks_ * ks_) + 1e-6f); \
            const float bt = __int_as_float(__builtin_amdgcn_readlane(__float_as_int(beta), t)), egt = __int_as_float(__builtin_amdgcn_readlane(__float_as_int(eg), t)), ekt = __int_as_float(__builtin_amdgcn_readlane(__float_as_int(ekd), t)); \
            *(LAS bf16*)(qt + tsw(t, lane)) = (bf16)f2bf(qn); *(LAS bf16*)(kt + tsw(t, lane)) = (bf16)f2bf(kn); \
            qd8[tt * 64] = (bf16)f2bf(qn * egt); r08[tt * 64] = (bf16)f2bf(bt * vs); r18[tt * 64] = (bf16)f2bf(bt * egt * kn); \
            const unsigned kd = f2bf(kn * ekt); if (tt & 1) kdp[tt >> 1] |= kd << 16; else kdp[tt >> 1] = kd; \
            const unsigned zg = f2bf(fsilu(bf2f(src[tt][3])) * nwl); if (tt & 1) zp[tt >> 1] |= zg << 16; else zp[tt >> 1] = zg; } \
        { u32x4 wz; wz.x = zp[0]; wz.y = zp[1]; wz.z = zp[2]; wz.w = zp[3]; *(u32x4*)(ZT + lane * 64 + 8 * t8) = wz; } \
        { const int c0 = (8 * t8) & 31, gg = (c0 & 15) >> 2, hh = c0 >> 4; bf16* kr = KDT + lane * 64 + ((8 * t8) & 32) + 4 * hh; \
          u32x2 w0, w1; w0.x = kdp[0]; w0.y = kdp[1]; w1.x = kdp[2]; w1.y = kdp[3]; *(u32x2*)(kr + 8 * gg) = w0; *(u32x2*)(kr + 8 * gg + 8) = w1; } } while (0)
    if (!(GV & 2)) {
    GDN_LOADBLK(ra, 0);
#pragma unroll 1
    for (int t16 = 0; t16 < 4; ++t16) {
        GDN_LOADBLK(rb, 2 * t16 + 1);
        GDN_CONVBLK(ra, 2 * t16);
        if (t16 < 3) GDN_LOADBLK(ra, 2 * t16 + 2);
        GDN_CONVBLK(rb, 2 * t16 + 1);
    }
    }
#undef GDN_LOADBLK
#undef GDN_CONVBLK
    LDS_WAIT();
    if (!(GV & 4)) {
    float gcj[4][4];
#pragma unroll
    for (int mt = 0; mt < 4; ++mt)
#pragma unroll
        for (int r = 0; r < 4; ++r) gcj[mt][r] = __shfl(gc, 16 * mt + 4 * g + r);
    f32x4 ahold[4][4];
#pragma unroll
    for (int nt = 0; nt < 4; ++nt) {
        const int i = 16 * nt + li; const float gci = __shfl(gc, i), bi = __shfl(beta, i);
        bf16x8 kB[2], qB[2];
#pragma unroll
        for (int ks = 0; ks < 2; ++ks) { kB[ks] = *(LAS bf16x8*)(kt + tsw(i, 32 * ks + 8 * g)); qB[ks] = *(LAS bf16x8*)(qt + tsw(i, 32 * ks + 8 * g)); }
#pragma unroll
        for (int mt = 0; mt < 4; ++mt) {
            u32x2 qw = {0u, 0u};
            if (mt <= nt) {
                const bf16x8 kA0 = *(LAS bf16x8*)(kt + tsw(16 * mt + li, 8 * g)), kA1 = *(LAS bf16x8*)(kt + tsw(16 * mt + li, 32 + 8 * g));
                f32x4 ckk = {0.f, 0.f, 0.f, 0.f}, cqk = {0.f, 0.f, 0.f, 0.f};
                ckk = mfma16(kA0, kB[0], ckk); ckk = mfma16(kA1, kB[1], ckk); cqk = mfma16(kA0, qB[0], cqk); cqk = mfma16(kA1, qB[1], cqk);
                float qv[4];
#pragma unroll
                for (int r = 0; r < 4; ++r) { const int j = 16 * mt + 4 * g + r; const float dec = __expf(fminf(gci - gcj[mt][r], 0.f));
                    ahold[nt][mt][r] = bi * ckk[r] * dec; qv[r] = (j <= i) ? cqk[r] * dec : 0.f; }
                qw.x = pk2(qv[0], qv[1]); qw.y = pk2(qv[2], qv[3]);
            }
            *(u32x2*)(QKm + i * 64 + 32 * (mt >> 1) + 8 * g + 4 * (mt & 1)) = qw;
        }
    }
    LDS_WAIT(); SBAR();
#pragma unroll
    for (int nt = 0; nt < 4; ++nt) { const int i = 16 * nt + li; const int ro = tri_off_rt(i);
#pragma unroll
        for (int mt = 0; mt < 4; ++mt) if (mt <= nt) {
#pragma unroll
            for (int r = 0; r < 4; ++r) { const int j = 16 * mt + 4 * g + r; if (j < i) Ap[ro + j] = ahold[nt][mt][r]; } } }
    }
    VM_WAIT(); LDS_WAIT();
#pragma unroll 1
    for (int pass = 0; pass < 2; ++pass) {
        bf16* Rp = pass ? R1 : R0; float x[64];
#pragma unroll
        for (int i = 0; i < 64; ++i) x[i] = bf2f(Rp[i * 64 + lane]);
        VM_WAIT();
        if (!(GV & 8)) GdnSolveRow<1>::run(Ap, x);
        if (pass == 0) {
#pragma unroll
            for (int i8 = 0; i8 < 8; ++i8) { u32x4 w; w.x = pk2(x[8 * i8], x[8 * i8 + 1]); w.y = pk2(x[8 * i8 + 2], x[8 * i8 + 3]); w.z = pk2(x[8 * i8 + 4], x[8 * i8 + 5]); w.w = pk2(x[8 * i8 + 6], x[8 * i8 + 7]);
                *(u32x4*)(Rp + lane * 64 + 8 * i8) = w; }
        } else {
#pragma unroll
            for (int i = 0; i < 64; ++i) Rp[i * 64 + pc] = (bf16)f2bf(x[i]);
        }
    }
    LDS_WAIT();
}

__device__ __forceinline__ bf16x8 scan_frag(const unsigned char* mat, int mt, int ks, int li, int g) { return *(const bf16x8*)(mat + (16 * mt + li) * 128 + (32 * ks + 8 * g) * 2); }
__device__ __forceinline__ bf16x8 pack_c2(f32x4 a, f32x4 b) { u32x4 w; w.x = pk2(a[0], a[1]); w.y = pk2(a[2], a[3]); w.z = pk2(b[0], b[1]); w.w = pk2(b[2], b[3]); return as_bf16x8(w); }
constexpr int SC_SLOT = 24576;
__device__ __forceinline__ void scan_dma(LAS unsigned char* slot, const unsigned char* rec, int sl, int lane) {
#pragma unroll
    for (int m = 0; m < 3; ++m) { const int goff = (m == 0) ? GC_W : (m == 1 ? GC_KDT : GC_UT);
#pragma unroll
        for (int i = 0; i < 2; ++i) { const int row = 16 * sl + 8 * i + (lane >> 3), ch = (lane & 7) ^ ((row >> 1) & 7);
            __builtin_amdgcn_global_load_lds((const unsigned*)(rec + goff + row * 128 + ch * 16), (LAS unsigned*)(slot + m * 8192 + (16 * sl + 8 * i) * 128), 16, 0, 0); } }
}
__device__ __forceinline__ bf16x8 scan_lfrag(const LAS unsigned char* mat, int mt, int ks, int li, int g) { const int row = 16 * mt + li; return *(const LAS bf16x8*)(mat + row * 128 + ((((4 * ks + g) ^ (row >> 1)) & 7) << 4)); }
template <int SV>
__device__ __forceinline__ void gdn_scan(const Frame& F, ArgsP a, int l) {
    const int lane = F.lane, li = lane & 15, g = lane >> 4, pr = F.wave >> 2, sl = F.wave & 3; const int bh = F.bid * 2 + pr, dv0 = 16 * sl;
    const float* GL = (const float*)(a->ws + WS_GL) + bh * 64; unsigned char* rec0 = a->ws + WS_GPREP + (size_t)bh * 64 * GCH;
    LAS unsigned char* ring = F.lds + pr * (3 * SC_SLOT);
    f32x4 S[4] = {{0.f, 0.f, 0.f, 0.f}, {0.f, 0.f, 0.f, 0.f}, {0.f, 0.f, 0.f, 0.f}, {0.f, 0.f, 0.f, 0.f}};
    const float glv = GL[lane];
    asm volatile("s_waitcnt vmcnt(0)" ::: "memory");
    scan_dma(ring, rec0, sl, lane); scan_dma(ring + SC_SLOT, rec0 + GCH, sl, lane);
#pragma unroll 1
    for (int n = 0; n < 64; ++n) {
        unsigned char* rn = rec0 + (size_t)n * GCH; const LAS unsigned char* slot = ring + (n % 3) * SC_SLOT;
        if (n == 0) asm volatile("s_waitcnt vmcnt(6)" ::: "memory"); else if (n == 1) asm volatile("s_waitcnt vmcnt(10)" ::: "memory");
        else if (n == 63) asm volatile("s_waitcnt vmcnt(8)" ::: "memory"); else asm volatile("s_waitcnt vmcnt(14)" ::: "memory");
        __builtin_amdgcn_s_barrier(); asm volatile("" ::: "memory");
        if (n + 2 < 64) scan_dma(ring + ((n + 2) % 3) * SC_SLOT, rn + 2 * (size_t)GCH, sl, lane);
        else { asm volatile("" ::: "memory"); }
        const float egl = __int_as_float(__builtin_amdgcn_readlane(__float_as_int(glv), n));
        const bf16x8 Sb0 = pack_c2(S[0], S[1]), Sb1 = pack_c2(S[2], S[3]);
        if (!(SV & 1)) { bf16x8* ss = (bf16x8*)(rn + GC_SS + sl * 2048) + lane; ss[0] = Sb0; ss[64] = Sb1; }
        f32x4 vn[4];
#pragma unroll
        for (int mt = 0; mt < 4; ++mt) {
            f32x4 acc = {0.f, 0.f, 0.f, 0.f};
            acc = mfma16(scan_lfrag(slot, mt, 0, li, g), Sb0, acc); acc = mfma16(scan_lfrag(slot, mt, 1, li, g), Sb1, acc);
            const int urow = dv0 + li; const u32x2 uu = *(const LAS u32x2*)(slot + 16384 + urow * 128 + (((((16 * mt + 4 * g) >> 3) ^ (urow >> 1)) & 7) << 4) + (((16 * mt + 4 * g) & 7) << 1));
            vn[mt][0] = bf2f(uu.x & 0xffffu) - acc[0]; vn[mt][1] = bf2f(uu.x >> 16) - acc[1]; vn[mt][2] = bf2f(uu.y & 0xffffu) - acc[2]; vn[mt][3] = bf2f(uu.y >> 16) - acc[3];
        }
        const bf16x8 Vb0 = pack_c2(vn[0], vn[1]), Vb1 = pack_c2(vn[2], vn[3]);
        if (!(SV & 1)) { bf16x8* vb = (bf16x8*)(rn + GC_VB + sl * 2048) + lane; vb[0] = Vb0; vb[64] = Vb1; }
#pragma unroll
        for (int mt = 0; mt < 4; ++mt) { f32x4 acc = S[mt] * egl; acc = mfma16(scan_lfrag(slot + 8192, mt, 0, li, g), Vb0, acc); acc = mfma16(scan_lfrag(slot + 8192, mt, 1, li, g), Vb1, acc); S[mt] = acc; }
        if ((SV & 1) || n + 2 >= 64) { }
    }
    asm volatile("s_waitcnt vmcnt(0)" ::: "memory"); asm volatile("" :: "v"(S[0][0]), "v"(S[1][1]), "v"(S[2][2]), "v"(S[3][3]));
    __syncthreads();
}

__device__ __forceinline__ void gdn_out_chunk(const Frame& F, ArgsP a, int ci, LAS unsigned char* wl) {
    int lane_ = F.lane; asm volatile("" : "+v"(lane_)); const int lane = lane_, li = lane & 15, g = lane >> 4; const int bh = ci >> 6, n = ci & 63, b = bh >> 2, h = bh & 3;
    const unsigned char* rec = a->ws + WS_GPREP + (size_t)ci * GCH; bf16* Y = (bf16*)(a->ws + WS_Y);
    bf16x8 QDf[4][2], QKf[4][2];
#pragma unroll
    for (int mt = 0; mt < 4; ++mt) { QDf[mt][0] = scan_frag(rec + GC_QD, mt, 0, li, g); QDf[mt][1] = scan_frag(rec + GC_QD, mt, 1, li, g); QKf[mt][0] = scan_frag(rec + GC_QK, mt, 0, li, g); QKf[mt][1] = scan_frag(rec + GC_QK, mt, 1, li, g); }
    float ssq[4][4];
#pragma unroll
    for (int mt = 0; mt < 4; ++mt)
#pragma unroll
        for (int r = 0; r < 4; ++r) ssq[mt][r] = 0.f;
    f32x4 o[4][4];
#pragma unroll
    for (int sl = 0; sl < 4; ++sl) {
        const bf16x8* ss = (const bf16x8*)(rec + GC_SS + sl * 2048) + lane; const bf16x8* vb = (const bf16x8*)(rec + GC_VB + sl * 2048) + lane;
        const bf16x8 Sb0 = ss[0], Sb1 = ss[64], Vb0 = vb[0], Vb1 = vb[64];
#pragma unroll
        for (int mt = 0; mt < 4; ++mt) {
            f32x4 acc = {0.f, 0.f, 0.f, 0.f};
            acc = mfma16(QDf[mt][0], Sb0, acc); acc = mfma16(QDf[mt][1], Sb1, acc); acc = mfma16(QKf[mt][0], Vb0, acc); acc = mfma16(QKf[mt][1], Vb1, acc);
            o[sl][mt] = acc;
#pragma unroll
            for (int r = 0; r < 4; ++r) ssq[mt][r] += acc[r] * acc[r];
        }
    }
#pragma unroll
    for (int mt = 0; mt < 4; ++mt)
#pragma unroll
        for (int r = 0; r < 4; ++r) ssq[mt][r] = __builtin_amdgcn_rsqf(row16_sum(ssq[mt][r]) * (1.f / 64.f) + 1e-6f);
#pragma unroll
    for (int sl = 0; sl < 4; ++sl)
#pragma unroll
        for (int mt = 0; mt < 4; ++mt) {
            const u32x2 zz = *(const u32x2*)(rec + GC_ZT + (16 * sl + li) * 128 + (16 * mt + 4 * g) * 2);
            const float zf[4] = {bf2f(zz.x & 0xffffu), bf2f(zz.x >> 16), bf2f(zz.y & 0xffffu), bf2f(zz.y >> 16)};
#pragma unroll
            for (int r = 0; r < 4; ++r) *(LAS bf16*)(wl + tsw(16 * mt + 4 * g + r, 16 * sl + li)) = (bf16)f2bf(o[sl][mt][r] * ssq[mt][r] * zf[r]);
        }
    LDS_WAIT();
    bf16* yrow = Y + ((size_t)b * SEQ + 64 * n + lane) * DM + 512 + h * 64;
#pragma unroll
    for (int c = 0; c < 8; ++c) *(u32x4*)(yrow + 8 * c) = *(const LAS u32x4*)(wl + tsw(lane, 8 * c));
    LDS_WAIT();
}

constexpr int AT_K = 0, AT_V = 32768, AT_IMP = 65536, AT_SELM = AT_IMP + 64 * 68 * 4, AT_UNI = AT_SELM + 512, AT_YS = 83968;
__device__ __forceinline__ s16x4 tr_read0(unsigned addr) { s16x4 r; asm volatile("ds_read_b64_tr_b16 %0, %1" : "=&v"(r) : "v"(addr) : "memory"); return r; }

__device__ __forceinline__ float half_max(float x) { auto rr = __builtin_amdgcn_permlane32_swap(__float_as_uint(x), __float_as_uint(x), false, false); return fmaxf(__uint_as_float(rr[0]), __uint_as_float(rr[1])); }
__device__ __forceinline__ float half_sum(float x) { auto rr = __builtin_amdgcn_permlane32_swap(__float_as_uint(x), __float_as_uint(x), false, false); return __uint_as_float(rr[0]) + __uint_as_float(rr[1]); }
struct AttnStage { u32x4 kr, vr; };
__device__ __forceinline__ void at_gload(AttnStage& st, const bf16* Kb, const bf16* Vb, size_t stride, int j, int tid) {
    const int row = tid >> 3, ch = tid & 7; const size_t off = (size_t)(64 * j + row) * stride + 8 * ch;
    st.kr = *(const u32x4*)(Kb + off); st.vr = *(const u32x4*)(Vb + off);
}
__device__ __forceinline__ void at_swrite(const AttnStage& st, LAS unsigned char* lds, int buf, int tid) {
    const int row = tid >> 3, ch = tid & 7; const int o = row * 128 + (((ch ^ (row >> 1)) & 7) << 4);
    *(LAS u32x4*)(lds + AT_K + buf * 8192 + o) = st.kr; *(LAS u32x4*)(lds + AT_V + buf * 8192 + o) = st.vr;
}
__device__ __forceinline__ void at_qk(const LAS unsigned char* Kt, const bf16x8 (&Qf)[4], int r, int hf, f32x16 (&s)[2], float cinit) {
    const int swz = (r >> 1) & 7;
    bf16x8 kf[2][4];
#pragma unroll
    for (int kt = 0; kt < 2; ++kt)
#pragma unroll
        for (int ks = 0; ks < 4; ++ks) kf[kt][ks] = *(const LAS bf16x8*)(Kt + (32 * kt + r) * 128 + (((2 * ks + hf) ^ swz) << 4));
    SBAR();
#pragma unroll
    for (int kt = 0; kt < 2; ++kt) {
        f32x16 acc;
#pragma unroll
        for (int e = 0; e < 16; ++e) acc[e] = cinit;
#pragma unroll
        for (int ks = 0; ks < 4; ++ks) acc = mfma32(kf[kt][ks], Qf[ks], acc);
        s[kt] = acc;
    }
}
__device__ __forceinline__ void at_pv(unsigned vbase, const unsigned (&voff)[2][2], const f32x16 (&p)[2], f32x16 (&o)[2]) {
#pragma unroll
    for (int kt = 0; kt < 2; ++kt) {
        s16x4 vr[2][2][2];
#pragma unroll
        for (int s = 0; s < 2; ++s) { const unsigned co = vbase + (unsigned)(4096 * kt + 2048 * s);
            vr[s][0][0] = tr_read0(co + voff[0][0]); vr[s][1][0] = tr_read0(co + voff[1][0]); vr[s][0][1] = tr_read0(co + voff[0][1]); vr[s][1][1] = tr_read0(co + voff[1][1]); }
        bf16x8 pb[2];
#pragma unroll
        for (int s = 0; s < 2; ++s) { u32x4 pw; pw.x = pk2(p[kt][8 * s + 0], p[kt][8 * s + 1]); pw.y = pk2(p[kt][8 * s + 2], p[kt][8 * s + 3]); pw.z = pk2(p[kt][8 * s + 4], p[kt][8 * s + 5]); pw.w = pk2(p[kt][8 * s + 6], p[kt][8 * s + 7]); pb[s] = as_bf16x8(pw); }
        asm volatile("s_waitcnt lgkmcnt(0)" ::: "memory"); SBAR();
#pragma unroll
        for (int s = 0; s < 2; ++s) {
            const s16x4 l0 = vr[s][0][0], h0 = vr[s][1][0], l1 = vr[s][0][1], h1 = vr[s][1][1];
            const bf16x8 v0 = {l0[0], l0[1], l0[2], l0[3], h0[0], h0[1], h0[2], h0[3]}, v1 = {l1[0], l1[1], l1[2], l1[3], h1[0], h1[1], h1[2], h1[3]};
            o[0] = mfma32(v0, pb[s], o[0]); o[1] = mfma32(v1, pb[s], o[1]);
        }
    }
}

struct AttnRow { int r, hf, tt, t, qb, wave; unsigned long long wave_union; float m, lpart; };
struct TileInfo { int hi, lo; bool rowok, edge, work, fresh; };
template <int MODE, int VAR>
__device__ __forceinline__ void at_tile_qk(const Frame& F, int j, int stg, const bf16x8 (&Qf)[4], const AttnRow& R, float mfin, f32x16 (&s)[2], TileInfo& I) {
    LAS unsigned char* lds = F.lds;
    I.work = true; if (MODE == 2) I.work = (R.wave_union >> j) & 1ull;
    I.hi = 1000; I.lo = -1000; I.rowok = true; I.edge = false;
    if (MODE <= 1) { I.hi = ((R.t - 31) >> 4) - 64 * j - 4 * R.hf; I.edge = (64 * j + 63) > ((64 * R.qb + 8 * R.wave - 31) >> 4); }
    if (MODE == 2) { const unsigned long long sm = *(const LAS unsigned long long*)(lds + AT_SELM + 8 * R.tt); I.rowok = (sm >> j) & 1ull; if (j == R.qb) { I.hi = R.tt - 4 * R.hf; I.edge = true; } }
    if (MODE == 3) { if (j == R.qb) { I.hi = R.tt - 4 * R.hf; I.edge = true; } if (j == R.qb - 8) { I.lo = R.tt + 1 - 4 * R.hf; I.edge = true; } }
    const float mref = (MODE == 1) ? mfin : R.m; I.fresh = mref < -1e29f;
    const float cinit = I.rowok ? (I.fresh ? 0.f : -mref) : -INFINITY;
    if (I.work) { if (VAR & 64) { for (int e = 0; e < 16; ++e) { s[0][e] = Qf[0][0] * 1e-9f; s[1][e] = Qf[1][1] * 1e-9f; } } else at_qk(lds + AT_K + stg * 8192, Qf, R.r, R.hf, s, cinit); }
}
template <int MODE, int VAR>
__device__ __forceinline__ float at_tile_fin(const Frame& F, int j, int stg, f32x16 (&s)[2], const TileInfo& I, AttnRow& R, const unsigned (&voff)[2][2], f32x16 (&o)[2], float invl, float preshift) {
    LAS unsigned char* lds = F.lds; float shift_out = 0.f;
    if (!I.work) return 0.f;
    const int hi = I.hi, lo = I.lo; const bool edge = I.edge;
    if (MODE == 1) {
        if (edge) {
#pragma unroll
            for (int kt = 0; kt < 2; ++kt)
#pragma unroll
                for (int e = 0; e < 16; ++e) { const int cst = 32 * kt + (e & 3) + 8 * (e >> 2); s[kt][e] = (cst <= hi) ? fexp2(s[kt][e]) * invl : 0.f; }
        } else {
#pragma unroll
            for (int kt = 0; kt < 2; ++kt)
#pragma unroll
                for (int e = 0; e < 16; ++e) s[kt][e] = fexp2(s[kt][e]) * invl;
        }
        LAS float* imp = (LAS float*)(lds + AT_IMP) + R.tt * 68;
#pragma unroll
        for (int kt = 0; kt < 2; ++kt)
#pragma unroll
            for (int rg = 0; rg < 4; ++rg) {
                float av = 2.f * (s[kt][4 * rg] + s[kt][4 * rg + 1] + s[kt][4 * rg + 2]) + s[kt][4 * rg + 3], bv = s[kt][4 * rg + 3];
                av += __int_as_float(__builtin_amdgcn_update_dpp(0, __float_as_int(av), 0xB1, 0xf, 0xf, true)); av += __int_as_float(__builtin_amdgcn_update_dpp(0, __float_as_int(av), 0x4E, 0xf, 0xf, true));
                bv += __int_as_float(__builtin_amdgcn_update_dpp(0, __float_as_int(bv), 0xB1, 0xf, 0xf, true)); bv += __int_as_float(__builtin_amdgcn_update_dpp(0, __float_as_int(bv), 0x4E, 0xf, 0xf, true));
                if ((R.r & 3) == 0) { const int jb = 16 * j + 8 * kt + 2 * rg + R.hf; (void)__hip_atomic_fetch_add(imp + jb, av, __ATOMIC_RELAXED, __HIP_MEMORY_SCOPE_WORKGROUP); (void)__hip_atomic_fetch_add(imp + jb + 1, bv, __ATOMIC_RELAXED, __HIP_MEMORY_SCOPE_WORKGROUP); }
            }
        if (VAR & 16) { o[0][0] += s[0][3] + s[1][7]; } else at_pv((unsigned)(size_t)(lds + AT_V + stg * 8192), voff, s, o);
    } else if (VAR & 32) { R.lpart += s[0][1]; if (MODE >= 2) { if (VAR & 16) { o[0][0] += s[0][3]; } else at_pv((unsigned)(size_t)(lds + AT_V + stg * 8192), voff, s, o); } }
    else {
        constexpr float THR = 8.f;
        if (__any(preshift != 0.f)) {
#pragma unroll
            for (int kt = 0; kt < 2; ++kt)
#pragma unroll
                for (int e = 0; e < 16; ++e) s[kt][e] -= preshift;
        }
        const bool fresh = R.m < -1e29f;
        if (edge) {
#pragma unroll
            for (int kt = 0; kt < 2; ++kt)
#pragma unroll
                for (int e = 0; e < 16; ++e) { const int cst = 32 * kt + (e & 3) + 8 * (e >> 2); const bool ok = (cst <= hi) && (cst >= lo); s[kt][e] = ok ? s[kt][e] : -INFINITY; }
        }
        float tm4[4] = {-INFINITY, -INFINITY, -INFINITY, -INFINITY};
#pragma unroll
        for (int kt = 0; kt < 2; ++kt)
#pragma unroll
            for (int e = 0; e < 16; e += 2) tm4[(e >> 1) & 3] = fmaxf(tm4[(e >> 1) & 3], fmaxf(s[kt][e], s[kt][e + 1]));
        const float tmax = half_max(fmaxf(fmaxf(tm4[0], tm4[1]), fmaxf(tm4[2], tm4[3])));
        const bool raise = (tmax > -INFINITY) && (fresh || tmax > THR);
        if (__any(raise)) {
            const float shift = raise ? tmax : 0.f, alpha = (raise && !fresh) ? fexp2(-shift) : 1.f;
            R.m = raise ? (fresh ? tmax : R.m + tmax) : R.m; R.lpart *= alpha; shift_out = shift;
#pragma unroll
            for (int kt = 0; kt < 2; ++kt)
#pragma unroll
                for (int e = 0; e < 16; ++e) s[kt][e] -= shift;
            if (MODE >= 2) {
#pragma unroll
                for (int e = 0; e < 16; ++e) { o[0][e] *= alpha; o[1][e] *= alpha; } }
        }
        float ps4[4] = {0.f, 0.f, 0.f, 0.f};
#pragma unroll
        for (int kt = 0; kt < 2; ++kt)
#pragma unroll
            for (int e = 0; e < 16; ++e) { s[kt][e] = fexp2(s[kt][e]); ps4[e & 3] += s[kt][e]; }
        R.lpart += (ps4[0] + ps4[1]) + (ps4[2] + ps4[3]);
        if (MODE >= 2) { if (VAR & 16) { o[0][0] += s[0][3] + s[1][7]; } else at_pv((unsigned)(size_t)(lds + AT_V + stg * 8192), voff, s, o); }
    }
    return shift_out;
}
template <int MODE, int VAR = 0>
__device__ __forceinline__ void at_branch(const Frame& F, unsigned long long mask, const bf16* Kb, const bf16* Vb, size_t stride, const bf16x8 (&Qf)[4], AttnRow& R, const unsigned (&voff)[2][2],
                                          f32x16 (&o)[2], float mfin, float invl) {
    LAS unsigned char* lds = F.lds; const int tid = F.tid;
    if (mask == 0ull) return;
    AttnStage st0, st1; int sg = 0;
    { const int j0 = __builtin_ctzll(mask); at_gload(st0, Kb, Vb, stride, j0, tid); at_swrite(st0, lds, 0, tid);
      const unsigned long long m1 = mask & (mask - 1ull); if (m1) { at_gload(st1, Kb, Vb, stride, __builtin_ctzll(m1), tid); at_swrite(st1, lds, 1, tid); } }
    __syncthreads();
    while (mask) {
        const int j0 = __builtin_ctzll(mask); mask &= mask - 1ull;
        int j1 = -1; if (mask) { j1 = __builtin_ctzll(mask); mask &= mask - 1ull; }
        int n0 = -1, n1 = -1; { unsigned long long mm = mask; if (mm) { n0 = __builtin_ctzll(mm); mm &= mm - 1ull; if (mm) n1 = __builtin_ctzll(mm); } }
        at_gload(st0, Kb, Vb, stride, n0 >= 0 ? n0 : j0, tid);
        at_gload(st1, Kb, Vb, stride, n1 >= 0 ? n1 : j0, tid);
        { f32x16 sa[2]; TileInfo Ia;
          at_tile_qk<MODE, VAR>(F, j0, sg, Qf, R, mfin, sa, Ia);
          (void)at_tile_fin<MODE, VAR>(F, j0, sg, sa, Ia, R, voff, o, invl, 0.f); }
        if (j1 >= 0) { f32x16 sb[2]; TileInfo Ib;
          at_tile_qk<MODE, VAR>(F, j1, sg + 1, Qf, R, mfin, sb, Ib);
          (void)at_tile_fin<MODE, VAR>(F, j1, sg + 1, sb, Ib, R, voff, o, invl, 0.f); }
        if (n0 >= 0) at_swrite(st0, lds, (sg + 2) & 3, tid);
        if (n1 >= 0) at_swrite(st1, lds, (sg + 3) & 3, tid);
        __syncthreads();
        sg = (sg + 2) & 3;
    }
}

template <int VAR>
__device__ __forceinline__ void attn_item(const Frame& F, ArgsP a, int l, int item) {
    const int qb = 63 - (item >> 4), bh = item & 15, b = bh >> 1, hk = bh & 1; const int lane = F.lane, wave = F.wave;
    const bf16* H = (const bf16*)(a->ws + WS_H); const float* side = (const float*)(a->ws + WS_SIDE); bf16* Y = (bf16*)(a->ws + WS_Y);
    LAS unsigned char* lds = F.lds;
    AttnRow R; R.r = lane & 31; R.hf = lane >> 5; R.tt = 8 * wave + (R.r >> 2); R.t = 64 * qb + R.tt; R.qb = qb; R.wave = wave; R.wave_union = 0ull;
    const int head = hk * 4 + (R.r & 3); const size_t tok = (size_t)b * SEQ + R.t;
    bf16x8 Qf[4];
#pragma unroll
    for (int ks = 0; ks < 4; ++ks) Qf[ks] = *(const bf16x8*)(H + tok * HLD + head * 64 + 16 * ks + 8 * R.hf);
    const float g_cmp = side[tok * 32 + head * 3], g_sel = side[tok * 32 + head * 3 + 1], g_win = side[tok * 32 + head * 3 + 2];
    unsigned voff[2][2];
    { const int li = lane & 15, q = li >> 2, p = li & 3, gi1 = (lane >> 4) & 1;
#pragma unroll
      for (int jh = 0; jh < 2; ++jh)
#pragma unroll
          for (int dt = 0; dt < 2; ++dt) voff[jh][dt] = (unsigned)((8 * jh + 4 * R.hf + q) * 128 + ((((4 * dt + 2 * gi1 + (p >> 1)) ^ (4 * jh + 2 * R.hf + (q >> 1))) & 7) << 4) + (p & 1) * 8); }
    { LAS float* imp = (LAS float*)(lds + AT_IMP) + (8 * wave) * 68; for (int i = lane; i < 8 * 68; i += 64) imp[i] = 0.f; if (F.tid == 0) { *(LAS unsigned*)(lds + AT_UNI) = 0u; *(LAS unsigned*)(lds + AT_UNI + 4) = 0u; } }
    f32x16 o[2];
#pragma unroll
    for (int e = 0; e < 16; ++e) { o[0][e] = 0.f; o[1][e] = 0.f; }
    LAS float* ys = (LAS float*)(lds + AT_YS + wave * 8192) + lane;
    {
        const bf16* Kc = (const bf16*)(a->ws + WS_KC) + (size_t)bh * 256 * 64; const bf16* Vc = (const bf16*)(a->ws + WS_VC) + (size_t)bh * 256 * 64;
        const int ntc = (4 * qb + 3 + 63) >> 6; const unsigned long long mc = (ntc >= 64) ? ~0ull : ((1ull << ntc) - 1ull);
        R.m = -1e30f; R.lpart = 0.f;
        if (!(VAR & 8)) at_branch<0, VAR>(F, mc, Kc, Vc, 64, Qf, R, voff, o, 0.f, 0.f);
        const float lsum = half_sum(R.lpart); const float invl = 1.f / fmaxf(lsum, 1e-30f);
        if (!(VAR & 8)) at_branch<1, VAR>(F, mc, Kc, Vc, 64, Qf, R, voff, o, R.m, invl);
#pragma unroll
        for (int e = 0; e < 16; ++e) { ys[e * 64] = g_cmp * o[0][e]; ys[(16 + e) * 64] = g_cmp * o[1][e]; o[0][e] = 0.f; o[1][e] = 0.f; }
    }
    LDS_WAIT();
    {
        unsigned long long wu = 0ull;
        for (int qi = 0; qi < 8; ++qi) {
            unsigned long long selm;
            if (qb < 16) selm = (2ull << qb) - 1ull;
            else {
                const float v = ((const LAS float*)(lds + AT_IMP))[(8 * wave + qi) * 68 + lane];
                const bool cand = (lane >= 1) && (lane <= qb - 2); const unsigned key = cand ? __float_as_uint(fmaxf(v, 0.f)) : 0u;
                unsigned thr = 0u;
                for (int bit = 30; bit >= 0; --bit) { const unsigned tr = thr | (1u << bit); const int c = __popcll(__ballot(cand && key >= tr)); if (c >= 13) thr = tr; }
                const unsigned long long gt = __ballot(cand && key > thr), eq = __ballot(cand && key == thr);
                int need = 13 - __popcll(gt); unsigned long long eqs = 0ull, e2 = eq;
                while (need > 0 && e2) { const unsigned long long low = e2 & (~e2 + 1ull); eqs |= low; e2 ^= low; --need; }
                selm = gt | eqs | 1ull | (1ull << qb) | (1ull << (qb - 1));
            }
            if (lane == 0) *(LAS unsigned long long*)(lds + AT_SELM + 8 * (8 * wave + qi)) = selm;
#if defined(SELFCHECK) && SELFCHECK == 1
            if (lane == 0 && l == 1) ((unsigned long long*)(a->ws + (size_t)984 * MiB + 64 * KiB))[(size_t)bh * SEQ + 64 * qb + 8 * wave + qi] = selm;
#endif
            wu |= selm;
        }
        R.wave_union = wu;
        if (lane == 0) { __hip_atomic_fetch_or((LAS unsigned*)(lds + AT_UNI), (unsigned)wu, __ATOMIC_RELAXED, __HIP_MEMORY_SCOPE_WORKGROUP); __hip_atomic_fetch_or((LAS unsigned*)(lds + AT_UNI + 4), (unsigned)(wu >> 32), __ATOMIC_RELAXED, __HIP_MEMORY_SCOPE_WORKGROUP); }
    }
    __syncthreads();
    const unsigned long long bunion = (unsigned long long)*(const LAS unsigned*)(lds + AT_UNI) | ((unsigned long long)*(const LAS unsigned*)(lds + AT_UNI + 4) << 32);
    const bf16* Hb = H + (size_t)b * SEQ * HLD;
    {
        R.m = -1e30f; R.lpart = 0.f;
        if (!(VAR & 2)) at_branch<2, VAR>(F, bunion, Hb + 512 + 2 * 128 + hk * 64, Hb + 512 + 3 * 128 + hk * 64, HLD, Qf, R, voff, o, 0.f, 0.f);
        const float lsum = half_sum(R.lpart); const float sc = g_sel / fmaxf(lsum, 1e-30f);
#pragma unroll
        for (int e = 0; e < 16; ++e) { ys[e * 64] += sc * o[0][e]; ys[(16 + e) * 64] += sc * o[1][e]; o[0][e] = 0.f; o[1][e] = 0.f; }
    }
    {
        const int lo = qb - 8 > 0 ? qb - 8 : 0; const unsigned long long mw = ((2ull << qb) - 1ull) & ~((1ull << lo) - 1ull);
        R.m = -1e30f; R.lpart = 0.f;
        if (!(VAR & 4)) at_branch<3, VAR>(F, mw, Hb + 512 + 4 * 128 + hk * 64, Hb + 512 + 5 * 128 + hk * 64, HLD, Qf, R, voff, o, 0.f, 0.f);
        const float lsum = half_sum(R.lpart); const float sc = g_win / fmaxf(lsum, 1e-30f);
#pragma unroll
        for (int e = 0; e < 16; ++e) { o[0][e] = ys[e * 64] + sc * o[0][e]; o[1][e] = ys[(16 + e) * 64] + sc * o[1][e]; }
    }
    if (VAR & 1) { asm volatile("" :: "v"(o[0][0]), "v"(o[1][5])); return; }
    bf16* yrow = Y + tok * DM + head * 64 + 4 * R.hf;
#pragma unroll
    for (int dt = 0; dt < 2; ++dt)
#pragma unroll
        for (int rg = 0; rg < 4; ++rg) { u32x2 w; w.x = pk2(o[dt][4 * rg], o[dt][4 * rg + 1]); w.y = pk2(o[dt][4 * rg + 2], o[dt][4 * rg + 3]); *(u32x2*)(yrow + 32 * dt + 8 * rg) = w; }
}

__device__ __forceinline__ void phase_mix_b(const Frame& F, ArgsP a, int l, int rep) {
    unsigned* q = F.ctl + CW_QUEUE + l * 64 + rep * 32;
    for (;;) {
        if (F.tid == 0) F.MISC[0] = __hip_atomic_fetch_add(q, 1u, __ATOMIC_RELAXED, __HIP_MEMORY_SCOPE_AGENT);
        __syncthreads();
        const int item = (int)F.MISC[0];
        __syncthreads();
        if (item >= 1024) break;
        if (rep == 0) attn_item<0>(F, a, l, item); else attn_item<PROBE_ATTN_VAR>(F, a, l, item);
    }
}

constexpr size_t WS_DBG = 984 * MiB;
constexpr int CHECK_LAYER = 1;
__device__ __forceinline__ void dbg_add(ArgsP a, int i, float v) { atomicAdd((float*)(a->ws + WS_DBG) + i, v); }

__device__ __forceinline__ void check_nsa(const Frame& F, ArgsP a) {
    const bf16* H = (const bf16*)(a->ws + WS_H); const float* side = (const float*)(a->ws + WS_SIDE); const bf16* Y = (const bf16*)(a->ws + WS_Y);
    const unsigned long long* SELM = (const unsigned long long*)(a->ws + WS_DBG + 64 * KiB);
    const int lane = F.lane; const int tv[16] = {5, 40, 63, 64, 100, 511, 512, 1023, 1024, 1500, 2047, 2048, 3000, 3333, 4000, 4095};
    for (int s = F.bid * NWAVES + F.wave; s < 256; s += F.G * NWAVES) {
        int t = tv[0];
#pragma unroll
        for (int q = 1; q < 16; ++q) t = ((s & 15) == q) ? tv[q] : t;
        const int b = (s >> 4) & 7, hq = ((s >> 7) * 5 + (s & 7)) & 7, hk = hq >> 2; const size_t tok = (size_t)b * SEQ + t; const int bhk = b * 2 + hk;
        const bf16* KC = (const bf16*)(a->ws + WS_KC) + (size_t)bhk * 256 * 64; const bf16* VC = (const bf16*)(a->ws + WS_VC) + (size_t)bhk * 256 * 64;
        const float g_cmp = side[tok * 32 + hq * 3], g_sel = side[tok * 32 + hq * 3 + 1], g_win = side[tok * 32 + hq * 3 + 2];
        const int cmax = (t - 31) >> 4; float imp = 0.f, ocmp = 0.f;
        for (int gh = 0; gh < 4; ++gh) {
            const int head = hk * 4 + gh; const float qd = bf2f(H[tok * HLD + head * 64 + lane]);
            float m = -INFINITY, l = 0.f;
            for (int c = 0; c <= cmax; ++c) m = fmaxf(m, wave_sum(qd * bf2f(KC[c * 64 + lane])));
            for (int c = 0; c <= cmax; ++c) l += fexp2(wave_sum(qd * bf2f(KC[c * 64 + lane])) - m);
            for (int c = 0; c <= cmax; ++c) { const float p = fexp2(wave_sum(qd * bf2f(KC[c * 64 + lane])) - m) / l; const int j = c >> 2, e = c & 3;
                if (lane == j) imp += (e < 3 ? 2.f : 1.f) * p; if (e == 3 && lane == j + 1) imp += p;
                if (head == hq) ocmp += p * bf2f(VC[c * 64 + lane]); }
        }
        const int cur = t >> 6; const bool causal = lane <= cur, forced = (lane == 0) || (lane == cur) || (lane == cur - 1);
        const float key = causal ? (imp + (forced ? 1.0e4f : 0.f)) : -INFINITY; int rank = 0;
        for (int i = 0; i < 64; ++i) { const float ki = __shfl(key, i); rank += ((ki > key) || (ki == key && i < lane)) ? 1 : 0; }
        const unsigned long long refm = __ballot(causal && rank < 16), stm = SELM[(size_t)bhk * SEQ + t];
        if (lane == 0) { dbg_add(a, 2, (float)__popcll(refm ^ stm)); dbg_add(a, 3, 16.f); }
        const float qd = bf2f(H[tok * HLD + hq * 64 + lane]); const bf16* Hb = H + (size_t)b * SEQ * HLD + hk * 64 + lane;
        float m = -INFINITY, l = 0.f, osel = 0.f;
        for (int j = 0; j <= cur; ++j) if ((stm >> j) & 1ull) for (int kk = 0; kk < 64; ++kk) { const int p = 64 * j + kk; if (p > t) break;
            const float sc = wave_sum(qd * bf2f(Hb[(size_t)p * HLD + 512 + 2 * 128])); const float mn = fmaxf(m, sc), al = fexp2(m - mn), pp = fexp2(sc - mn);
            l = l * al + pp; osel = osel * al + pp * bf2f(Hb[(size_t)p * HLD + 512 + 3 * 128]); m = mn; }
        const float ysel = osel / fmaxf(l, 1e-30f);
        m = -INFINITY; l = 0.f; float owin = 0.f;
        for (int p = (t - 511 > 0 ? t - 511 : 0); p <= t; ++p) { const float sc = wave_sum(qd * bf2f(Hb[(size_t)p * HLD + 512 + 4 * 128])); const float mn = fmaxf(m, sc), al = fexp2(m - mn), pp = fexp2(sc - mn);
            l = l * al + pp; owin = owin * al + pp * bf2f(Hb[(size_t)p * HLD + 512 + 5 * 128]); m = mn; }
        const float ref = g_cmp * ocmp + g_sel * ysel + g_win * owin / fmaxf(l, 1e-30f), got = bf2f(Y[tok * DM + hq * 64 + lane]);
        const float e2 = wave_sum((ref - got) * (ref - got)), r2 = wave_sum(ref * ref);
        if (lane == 0) { dbg_add(a, 0, e2); dbg_add(a, 1, r2); }
    }
}

__device__ __forceinline__ void check_gdn(const Frame& F, ArgsP a, int l) {
    if (F.bid >= 8) return;
    const bf16* H = (const bf16*)(a->ws + WS_H); const float* side = (const float*)(a->ws + WS_SIDE); const bf16* Y = (const bf16*)(a->ws + WS_Y);
    const int b = F.bid, h = (F.bid * 3) & 3, tid = F.tid, lane = F.lane, col = tid & 63, rg = tid >> 6;
    LAS float* S = (LAS float*)F.lds; LAS float* qv = S + 64 * 65; LAS float* kv = qv + 64; LAS float* vv = kv + 64; LAS float* sc = vv + 64; LAS float* part = sc + 64;
    for (int i = tid; i < 64 * 65; i += NTHR) S[i] = 0.f;
    float hq[3] = {0.f, 0.f, 0.f}, hk[3] = {0.f, 0.f, 0.f}, hv[3] = {0.f, 0.f, 0.f}, wq[4], wk[4], wv[4];
    { const float* cw = a->in[6] + (size_t)l * 4 * 768 + h * 64 + lane;
#pragma unroll
      for (int k = 0; k < 4; ++k) { wq[k] = cw[k * 768]; wk[k] = cw[k * 768 + 256]; wv[k] = cw[k * 768 + 512]; } }
    const float Aexp = __expf(a->in[7][l * 4 + h]), dtb = a->in[8][l * 4 + h], nw = a->in[9][l * 64 + lane];
    __syncthreads();
    for (int t = 0; t < 192; ++t) {
        const size_t tok = (size_t)b * SEQ + t;
        if (F.wave == 0) { const bf16* p = H + tok * HLD + 1280 + h * 64 + lane; const float rq = bf2f(p[0]), rk = bf2f(p[256]), rv = bf2f(p[512]);
            const float cq = wq[0] * hq[0] + wq[1] * hq[1] + wq[2] * hq[2] + wq[3] * rq, ck = wk[0] * hk[0] + wk[1] * hk[1] + wk[2] * hk[2] + wk[3] * rk, cv = wv[0] * hv[0] + wv[1] * hv[1] + wv[2] * hv[2] + wv[3] * rv;
            hq[0] = hq[1]; hq[1] = hq[2]; hq[2] = rq; hk[0] = hk[1]; hk[1] = hk[2]; hk[2] = rk; hv[0] = hv[1]; hv[1] = hv[2]; hv[2] = rv;
            const float qs = cq / (1.f + __expf(-cq)), ks = ck / (1.f + __expf(-ck)), vs = cv / (1.f + __expf(-cv));
            qv[lane] = qs / sqrtf(wave_sum(qs * qs) + 1e-6f); kv[lane] = ks / sqrtf(wave_sum(ks * ks) + 1e-6f); vv[lane] = vs;
            if (lane == 0) { const float av = side[tok * 32 + 28 + h] + dtb; const float sp = av > 20.f ? av : log1pf(__expf(av)); sc[0] = __expf(-Aexp * sp); sc[1] = side[tok * 32 + 24 + h]; } }
        __syncthreads();
        { float ps = 0.f;
#pragma unroll
          for (int r = 0; r < 8; ++r) ps += kv[8 * rg + r] * S[(8 * rg + r) * 65 + col];
          part[rg * 64 + col] = ps; }
        __syncthreads();
        { float ks = 0.f;
#pragma unroll
          for (int r = 0; r < 8; ++r) ks += part[r * 64 + col];
          const float eg = sc[0], be = sc[1]; float po = 0.f;
          __syncthreads();
#pragma unroll
          for (int r = 0; r < 8; ++r) { const int dk = 8 * rg + r; const float sn = eg * (S[dk * 65 + col] - be * kv[dk] * ks) + be * kv[dk] * vv[col]; S[dk * 65 + col] = sn; po += sn * qv[dk]; }
          part[rg * 64 + col] = po; }
        __syncthreads();
        if (F.wave == 0) { float o = 0.f;
#pragma unroll
            for (int r = 0; r < 8; ++r) o += part[r * 64 + lane];
            o *= 0.125f; const float rs = 1.f / sqrtf(wave_sum(o * o) * (1.f / 64.f) + 1e-6f); const float z = bf2f(H[tok * HLD + 2048 + h * 64 + lane]);
            const float ref = o * rs * nw * (z / (1.f + __expf(-z))), got = bf2f(Y[tok * DM + 512 + h * 64 + lane]);
            const float e2 = wave_sum((ref - got) * (ref - got)), r2 = wave_sum(ref * ref);
            if (lane == 0) { dbg_add(a, 4, e2); dbg_add(a, 5, r2); } }
        __syncthreads();
    }
}

__device__ __forceinline__ void check_moe(const Frame& F, ArgsP a, int l) {
    const bf16* XBc = (const bf16*)(a->ws + WS_XB); const bf16* Y2 = (const bf16*)(a->ws + WS_Y2);
    const int* route_e = (const int*)(a->ws + WS_SLOT + SL_RE); const float* route_w = (const float*)(a->ws + WS_SLOT + SL_RW);
    LAS float* x = (LAS float*)F.lds; LAS float* hid = x + 1024; LAS float* lg = hid + 512; LAS float* yr = lg + 64;
    const int tid = F.tid, lane = F.lane;
    for (int s = F.bid; s < 256; s += F.G) {
        const int t = (s * 4099 + 17) & (T - 1);
        for (int i = tid; i < 1024; i += NTHR) { x[i] = bf2f(XBc[(size_t)t * DM + i]); yr[i] = 0.f; }
        __syncthreads();
        for (int j = F.wave; j < 36; j += NWAVES) { float d = 0.f; for (int k = lane; k < DM; k += 64) d += x[k] * (j < 4 ? a->in[18][((size_t)l * DM + k) * 4 + j] : a->in[20][((size_t)l * DM + k) * NEXP + j - 4]);
            d = wave_sum(d); if (lane == 0) lg[j] = d + (j < 4 ? a->in[19][l * 4 + j] : a->in[21][l * NEXP + j - 4]); }
        __syncthreads();
        if (tid == 0) { int gi = 0; for (int i = 1; i < 4; ++i) if (lg[i] > lg[gi]) gi = i; float gs = 0.f; for (int i = 0; i < 4; ++i) gs += __expf(lg[i] - lg[gi]); const float gw = 1.f / gs;
            int i1 = 0; for (int i = 1; i < 8; ++i) if (lg[4 + gi * 8 + i] > lg[4 + gi * 8 + i1]) i1 = i; int i2 = -1; for (int i = 0; i < 8; ++i) if (i != i1 && (i2 < 0 || lg[4 + gi * 8 + i] > lg[4 + gi * 8 + i2])) i2 = i;
            const float e2 = __expf(lg[4 + gi * 8 + i2] - lg[4 + gi * 8 + i1]), w1 = gw / (1.f + e2), w2 = gw - w1;
            const int se1 = route_e[2 * t], se2 = route_e[2 * t + 1]; const float sw1 = route_w[2 * t], sw2 = route_w[2 * t + 1];
            dbg_add(a, 8, (se1 != gi * 8 + i1 ? 1.f : 0.f) + (se2 != gi * 8 + i2 ? 1.f : 0.f)); dbg_add(a, 9, 2.f);
            if (se1 == gi * 8 + i1 && se2 == gi * 8 + i2) { dbg_add(a, 10, (sw1 - w1) * (sw1 - w1) + (sw2 - w2) * (sw2 - w2)); dbg_add(a, 11, w1 * w1 + w2 * w2); } }
        for (int k2 = 0; k2 < 2; ++k2) {
            const int e = route_e[2 * t + k2]; const float rw = route_w[2 * t + k2];
            const float* wg = a->in[22] + ((size_t)l * NEXP + e) * DM * FF; const float* wu = a->in[23] + ((size_t)l * NEXP + e) * DM * FF; const float* wd = a->in[24] + ((size_t)l * NEXP + e) * FF * DM;
            { float g = 0.f, u = 0.f; for (int k = 0; k < DM; ++k) { g += x[k] * wg[(size_t)k * FF + tid]; u += x[k] * wu[(size_t)k * FF + tid]; } hid[tid] = g / (1.f + __expf(-g)) * u; }
            __syncthreads();
            for (int d = tid; d < DM; d += NTHR) { float y = 0.f; for (int f = 0; f < FF; ++f) y += hid[f] * wd[(size_t)f * DM + d]; yr[d] += y * rw; }
            __syncthreads();
        }
        float e2 = 0.f, r2 = 0.f;
        for (int d = tid; d < DM; d += NTHR) { const float got = bf2f(Y2[(size_t)(2 * t) * DM + d]) + bf2f(Y2[(size_t)(2 * t + 1) * DM + d]); e2 += (yr[d] - got) * (yr[d] - got); r2 += yr[d] * yr[d]; }
        e2 = wave_sum(e2); r2 = wave_sum(r2); if (lane == 0) { dbg_add(a, 6, e2); dbg_add(a, 7, r2); }
        __syncthreads();
    }
}

__device__ __forceinline__ void check_inproj(const Frame& F, ArgsP a, int l) {
    const bf16* H = (const bf16*)(a->ws + WS_H); const float* xin = (l == 0) ? a->in[0] : (const float*)a->out; const float* win = a->in[1] + (size_t)l * DM * DIN;
    const int lane = F.lane;
    for (int s = F.bid * NWAVES + F.wave; s < 1024; s += F.G * NWAVES) {
        const int tok = (s * 7919 + 13) & (T - 1), grp = s % 14, t = tok & (SEQ - 1);
        const int col0 = grp < 8 ? grp * 64 : 512 + (grp - 8) * 128 + ((s >> 4) & 1) * 64; const bool isq = grp < 8, rope = isq || ((grp - 8) % 2 == 0);
        float d = 0.f; for (int k = 0; k < DM; ++k) d += xin[(size_t)tok * DM + k] * win[(size_t)k * DIN + col0 + lane];
        if (rope) { const float inv[8] = {1.0f, 0.19392274f, 0.03760603f, 0.0072926646f, 0.0014142136f, 0.0002742482f, 5.3182957e-05f, 1.0313385e-05f};
            float iv = inv[0];
#pragma unroll
            for (int q = 1; q < 8; ++q) iv = ((lane & 7) == q) ? inv[q] : iv;
            const float ang = (float)t * iv, c = cosf(ang), sn = sinf(ang), other = __shfl_xor(d, 8);
            if (lane < 8) d = d * c - other * sn; else if (lane < 16) d = d * c + other * sn; }
        if (isq) d *= pg8::QSCALE;
        const float got = bf2f(H[(size_t)tok * HLD + col0 + lane]); const float e2 = wave_sum((d - got) * (d - got)), r2 = wave_sum(d * d);
        if (lane == 0) { dbg_add(a, 12, e2); dbg_add(a, 13, r2); }
    }
}
__device__ __forceinline__ void check_compress(const Frame& F, ArgsP a, int l) {
    const bf16* H = (const bf16*)(a->ws + WS_H); const int lane = F.lane;
    for (int s = F.bid * NWAVES + F.wave; s < 512; s += F.G * NWAVES) {
        const int kv = s & 1, bh = (s >> 1) & 15, b = bh >> 1, hh = bh & 1, i = (s * 53 + 7) % 255;
        const float* pe = a->in[3] + ((size_t)l * 2 + kv) * 2048; const float* w1 = a->in[4] + ((size_t)l * 2 + kv) * 2048 * 128; const float* w2 = a->in[5] + ((size_t)l * 2 + kv) * 128 * 64;
        float h0 = 0.f, h1 = 0.f;
        for (int k = 0; k < 2048; ++k) { const int p = k >> 6, d = k & 63; const float x = bf2f(H[((size_t)b * SEQ + 16 * i + p) * HLD + 512 + kv * 128 + hh * 64 + d]) + pe[k];
            h0 += x * w1[(size_t)k * 128 + lane]; h1 += x * w1[(size_t)k * 128 + 64 + lane]; }
        h0 = h0 / (1.f + __expf(-h0)); h1 = h1 / (1.f + __expf(-h1));
        float o = 0.f;
        for (int n = 0; n < 64; ++n) { o += __shfl(h0, n) * w2[(size_t)n * 64 + lane] + __shfl(h1, n) * w2[(size_t)(64 + n) * 64 + lane]; }
        const float got = bf2f(((const bf16*)(a->ws + (kv ? WS_VC : WS_KC)))[((size_t)bh * 256 + i) * 64 + lane]);
        const float e2 = wave_sum((o - got) * (o - got)), r2 = wave_sum(o * o); if (lane == 0) { dbg_add(a, 14, e2); dbg_add(a, 15, r2); }
    }
}
__device__ __forceinline__ void check_conformer(const Frame& F, ArgsP a, int l) {
    const bf16* H = (const bf16*)(a->ws + WS_H); const bf16* Y = (const bf16*)(a->ws + WS_Y); const int lane = F.lane;
    for (int s = F.bid * NWAVES + F.wave; s < 1024; s += F.G * NWAVES) {
        const int tok = (s * 6151 + 3) & (T - 1), t = tok & (SEQ - 1); float u[4];
#pragma unroll
        for (int j = 0; j < 4; ++j) { const int c = lane + 64 * j; float acc = a->in[11][l * 256 + c];
            for (int k = 0; k < 31; ++k) { const int sp = t - 30 + k; if (sp >= 0) { const bf16* hp = H + (size_t)(tok - 30 + k) * HLD + 2304 + c; const float g = bf2f(hp[256]); acc += a->in[10][((size_t)l * 31 + k) * 256 + c] * (bf2f(hp[0]) / (1.f + __expf(-g))); } }
            u[j] = acc; }
        const float mean = wave_sum(u[0] + u[1] + u[2] + u[3]) * (1.f / 256.f); float q = 0.f;
#pragma unroll
        for (int j = 0; j < 4; ++j) { u[j] -= mean; q += u[j] * u[j]; }
        const float rstd = 1.f / sqrtf(wave_sum(q) * (1.f / 256.f) + LN_EPS); float e2 = 0.f, r2 = 0.f;
#pragma unroll
        for (int j = 0; j < 4; ++j) { const int c = lane + 64 * j; const float v = u[j] * rstd * a->in[12][l * 256 + c] + a->in[13][l * 256 + c]; const float ref = v / (1.f + __expf(-v)), got = bf2f(Y[(size_t)tok * DM + 768 + c]);
            e2 += (ref - got) * (ref - got); r2 += ref * ref; }
        e2 = wave_sum(e2); r2 = wave_sum(r2); if (lane == 0) { dbg_add(a, 16, e2); dbg_add(a, 17, r2); }
    }
}
__device__ __forceinline__ void check_inject(const Frame& F, ArgsP a) {
    if (F.bid == 0 && F.tid == 0) { const float* d = (const float*)(a->ws + WS_DBG); float e0 = 0.f, e1 = 0.f;
        if (SELFCHECK == 1) { e0 = 1000.f * sqrtf(d[0] / d[1]); e1 = 1.0e4f * d[2] / d[3]; }
        if (SELFCHECK == 2) { e0 = 1000.f * sqrtf(d[4] / d[5]); }
        if (SELFCHECK == 3) { e0 = 1000.f * sqrtf(d[6] / d[7]); e1 = 1.0e4f * d[8] / d[9] + 1000.f * sqrtf(d[10] / fmaxf(d[11], 1e-30f)); }
        if (SELFCHECK == 4) { e0 = 1000.f * sqrtf(d[12] / d[13]); }
        if (SELFCHECK == 5) { e0 = 1000.f * sqrtf(d[14] / d[15]); e1 = 1000.f * sqrtf(d[16] / d[17]); }
        a->out[0] += e0; a->out[1] += e1; }
}


#ifndef MK_MULTI
#define MK_MULTI 0
#endif
#ifndef PROBE_REPEAT
#define PROBE_REPEAT 0
#endif
constexpr int N_PHASES = 1 + 10 * NL;
__device__ __forceinline__ Frame make_frame(int wave_s) {
    extern __shared__ __attribute__((aligned(16))) unsigned char lds_raw[];
    Frame F; F.lds = (LAS unsigned char*)lds_raw; F.MISC = (volatile LAS unsigned*)(F.lds + MISC_OFF);
    int tid = threadIdx.x, G = gridDim.x, bid = blockIdx.x; unsigned lb = (unsigned)(size_t)F.lds; (void)wave_s;
    asm volatile("" : "+v"(tid), "+s"(G), "+s"(bid), "+s"(lb));
    F.lds = (LAS unsigned char*)(size_t)lb; F.MISC = (volatile LAS unsigned*)(F.lds + MISC_OFF);
    F.tid = tid; F.lane = F.tid & 63; F.wave = __builtin_amdgcn_readfirstlane(F.tid >> 6); F.G = G; F.bid = bid;
    F.ctl = (unsigned*)(args_here()->ws + WS_CTL); return F;
}
__device__ __forceinline__ void ph_prologue(int, int wv) { const Frame F = make_frame(wv); phase_prologue(F, args_here()); phase_weights(F, args_here(), 0, 2, F.G, 0);
#if SELFCHECK
    if (F.bid == 0 && F.tid < 64) ((float*)(args_here()->ws + WS_DBG))[F.tid] = 0.f;
#endif
}
__device__ __forceinline__ void ph_inproj(int l, int wv) { const Frame F = make_frame(wv); unsigned char* ws = args_here()->ws;
    pg8::Gemm g{(const bf16*)(ws + WS_XB), (const bf16*)(WLBASE(ws, l) + WL_WIN), T, DINP, DM}; pg8::StaticOrder S; S.init(T, DINP, F.G, F.bid);
    pg8::EpiInProj E{(bf16*)(ws + WS_H), (float*)(ws + WS_SIDE), (const float*)(ws + WS_ROPE)};
    pg8::gemm_phase<pg8::EpiInProj, pg8::StaticOrder, false>(F.lds, g, S, E, nullptr, F.tid); }
__device__ __forceinline__ void ph_compress(int l, int wv) { const Frame F = make_frame(wv); for (int it = F.bid; it < 256; it += F.G) compress_item(F, args_here(), l, it); }
__device__ __forceinline__ void ph_gdnprep(int l, int wv) { const Frame F = make_frame(wv); for (int it = F.bid; it < 256; it += F.G) { gdn_prep_chunk<0>(F, args_here(), l, it * 8 + F.wave, F.lds + F.wave * 16384); __syncthreads(); } }
__device__ __forceinline__ void ph_gdnprep_var(int l, int wv) { const Frame F = make_frame(wv); for (int it = F.bid; it < 256; it += F.G) { gdn_prep_chunk<PROBE_GDN_VAR | 1>(F, args_here(), l, it * 8 + F.wave, F.lds + F.wave * 16384); __syncthreads(); } }
__device__ __forceinline__ void ph_conformer(int l, int wv) { const Frame F = make_frame(wv); for (int it = F.bid; it < 512; it += F.G) conformer_item(F, args_here(), l, it); }
__device__ __forceinline__ void ph_gdnout(int l, int wv) { const Frame F = make_frame(wv); for (int ci = F.bid * NWAVES + F.wave; ci < 2048; ci += F.G * NWAVES) gdn_out_chunk(F, args_here(), ci, F.lds + F.wave * 8192); }
constexpr int NCONV = 64;
__device__ __forceinline__ void ph_scan(int l, int wv) { const Frame F = make_frame(wv); if (F.bid < 16) gdn_scan<0>(F, args_here(), l); }
__device__ __forceinline__ void ph_bgweights(int l, int wv) { const Frame F = make_frame(wv);
    if (F.bid < NCONV) { if (l == 0) phase_weights(F, args_here(), 0, 1, NCONV, 0); if (l + 1 < NL) phase_weights(F, args_here(), l + 1, 3, NCONV, 0); __syncthreads(); } }
__device__ __forceinline__ void ph_scan_var(int l, int wv) { const Frame F = make_frame(wv); if (F.bid < 16) gdn_scan<(PROBE_SCAN_VAR & 1)>(F, args_here(), l); }
__device__ __forceinline__ void ph_attn(int l, int rep, int wv) { const Frame F = make_frame(wv); phase_mix_b(F, args_here(), l, rep); }
__device__ __forceinline__ void ph_outproj(int l, int wv) { const Frame F = make_frame(wv); ArgsP ap = args_here(); unsigned char* ws = ap->ws;
    pg8::Gemm g{(const bf16*)(ws + WS_Y), (const bf16*)(WLBASE(ws, l) + WL_WOUT), T, DM, DM}; pg8::StaticOrder S; S.init(T, DM, F.G, F.bid);
    pg8::EpiOutProj E{(const bf16*)(ws + WS_XB), (float*)(ws + WS_X1), DN_ALPHA};
    pg8::gemm_phase<pg8::EpiOutProj, pg8::StaticOrder, false>(F.lds, g, S, E, nullptr, F.tid); }
__device__ __forceinline__ void ph_ln1(int l, int wv) { const Frame F = make_frame(wv); phase_ln1_router<false>(F, args_here(), l); }
__device__ __forceinline__ void ph_ln1_dry(int l, int wv) { const Frame F = make_frame(wv); phase_ln1_router<true>(F, args_here(), l); }
__device__ __forceinline__ void ph_gather(int l, int wv) { const Frame F = make_frame(wv); phase_gather(F, args_here(), l); }
__device__ __forceinline__ void ph_moeup(int l, int wv) { const Frame F = make_frame(wv); unsigned char* ws = args_here()->ws;
    pg8::Gemm g{(const bf16*)(ws + WS_H), (const bf16*)(WLBASE(ws, l) + WL_WGU), 0, 0, DM / 2};   pg8::MoeOrder S{(const int*)(ws + WS_META) + l * 512, F.G, F.bid};
    pg8::EpiSwiGLU E{ws + WS_HID, (const int*)(ws + WS_SLOT + SL_TOK), 1};
    pg8::gemm_phase<pg8::EpiSwiGLU, pg8::MoeOrder, false>(F.lds, g, S, E, nullptr, F.tid); }
__device__ __forceinline__ void ph_moedown(int l, int wv) { const Frame F = make_frame(wv); unsigned char* ws = args_here()->ws;
    pg8::Gemm g{(const bf16*)(ws + WS_HID), (const bf16*)(WLBASE(ws, l) + WL_WDN), 0, 0, FF / 2}; pg8::MoeOrder S{(const int*)(ws + WS_META) + l * 512, F.G, F.bid};
    pg8::EpiDown E{(bf16*)(ws + WS_Y2), (const int*)(ws + WS_SLOT + SL_TOK), (const float*)(ws + WS_SLOT + SL_W)};
    pg8::gemm_phase<pg8::EpiDown, pg8::MoeOrder, false>(F.lds, g, S, E, nullptr, F.tid); }
__device__ __forceinline__ void ph_ln2(int l, int wv) { const Frame F = make_frame(wv); phase_ln2(F, args_here(), l); }

__global__ void __launch_bounds__(NTHR, 2) fwd_kernel(Args args) {
    extern __shared__ __attribute__((aligned(16))) unsigned char lds_raw[];
    (void)lds_raw; const int wv = 0; const Frame F = make_frame(wv);
    if (F.tid < 64) F.MISC[F.tid] = 0u;
    __syncthreads();
    XcdBarrier bar = xcd_barrier_post(F.ctl + CW_BAR, F.MISC + 8);
    const int lo = args_here()->ph_lo, hi = args_here()->ph_hi;
#define IN(k) (lo <= (k) && (k) < hi)
#define SEAM(k) do { if (IN(k) && IN((k) + 1)) { XcdBarrier bb = bar; asm volatile("" : "+s"(bb.bar)); xcd_barrier(bb); } } while (0)
#define RPT(bit, call) do { call; if (PROBE_REPEAT & (1u << (bit))) { XcdBarrier bb = bar; asm volatile("" : "+s"(bb.bar)); xcd_barrier(bb); call; } } while (0)
    if (IN(0)) ph_prologue(0, wv);
    SEAM(0);
#define LAYER_BODY(l) do { \
        const int pb = 1 + 10 * l; \
        if (IN(pb + 0)) RPT(0, ph_inproj(l, wv)); \
        SEAM(pb + 0); \
        if constexpr (SELFCHECK == 4) { \
        if (l == CHECK_LAYER) { { const Frame F2 = make_frame(wv); check_inproj(F2, args_here(), l); } XcdBarrier bb = bar; asm volatile("" : "+s"(bb.bar)); xcd_barrier(bb); } \
        } \
        if (IN(pb + 1)) { RPT(16, ph_compress(l, wv)); ph_gdnprep(l, wv); if (PROBE_REPEAT & (1u << 17)) { XcdBarrier bb = bar; asm volatile("" : "+s"(bb.bar)); xcd_barrier(bb); ph_gdnprep_var(l, wv); } RPT(18, ph_conformer(l, wv)); } \
        SEAM(pb + 1); \
        if (IN(pb + 2)) { ph_scan(l, wv); ph_bgweights(l, wv); if (PROBE_REPEAT & (1u << 19)) { XcdBarrier bb = bar; asm volatile("" : "+s"(bb.bar)); xcd_barrier(bb); ph_scan_var(l, wv); XcdBarrier bb2 = bar; asm volatile("" : "+s"(bb2.bar)); xcd_barrier(bb2); } ph_attn(l, 0, wv); if (PROBE_REPEAT & (1u << 20)) { XcdBarrier bb = bar; asm volatile("" : "+s"(bb.bar)); xcd_barrier(bb); ph_attn(l, 1, wv); } } \
        SEAM(pb + 2); \
        if (IN(pb + 3)) RPT(24, ph_gdnout(l, wv)); \
        SEAM(pb + 3); \
        if constexpr (SELFCHECK == 1 || SELFCHECK == 2 || SELFCHECK == 5) { \
        if (l == CHECK_LAYER) { { const Frame F2 = make_frame(wv); if (SELFCHECK == 1) check_nsa(F2, args_here()); else if (SELFCHECK == 2) check_gdn(F2, args_here(), l); else { check_compress(F2, args_here(), l); check_conformer(F2, args_here(), l); } } XcdBarrier bb = bar; asm volatile("" : "+s"(bb.bar)); xcd_barrier(bb); } \
        } \
        if (IN(pb + 4)) RPT(3, ph_outproj(l, wv)); \
        SEAM(pb + 4); \
        if (IN(pb + 5)) { ph_ln1(l, wv); if (PROBE_REPEAT & (1u << 4)) { XcdBarrier bb = bar; asm volatile("" : "+s"(bb.bar)); xcd_barrier(bb); ph_ln1_dry(l, wv); } \
            if (PROBE_REPEAT & (1u << 23)) { for (int rr = 0; rr < 4; ++rr) { XcdBarrier bb = bar; asm volatile("" : "+s"(bb.bar)); xcd_barrier(bb); } } } \
        SEAM(pb + 5); \
        if (IN(pb + 6)) RPT(5, ph_gather(l, wv)); \
        SEAM(pb + 6); \
        if (IN(pb + 7)) RPT(6, ph_moeup(l, wv)); \
        SEAM(pb + 7); \
        if (IN(pb + 8)) RPT(7, ph_moedown(l, wv)); \
        SEAM(pb + 8); \
        if constexpr (SELFCHECK == 3) { \
        if (l == CHECK_LAYER) { { const Frame F2 = make_frame(wv); check_moe(F2, args_here(), l); } XcdBarrier bb = bar; asm volatile("" : "+s"(bb.bar)); xcd_barrier(bb); } \
        } \
        if (IN(pb + 9)) { ph_ln2(l, wv); } \
        SEAM(pb + 9); \
     \
    } while (0)
    LAYER_BODY(0); LAYER_BODY(1); LAYER_BODY(2); LAYER_BODY(3);
#undef LAYER_BODY
#undef RPT
#if SELFCHECK
    { XcdBarrier bb = bar; asm volatile("" : "+s"(bb.bar)); xcd_barrier(bb); const Frame F2 = make_frame(wv); check_inject(F2, args_here()); }
#endif
#undef IN
#undef SEAM
}

extern "C" void kernel_launch(void* const* d_in, const int* in_sizes, int n_in, void* d_out, int out_size, void* d_ws, size_t ws_size, hipStream_t stream) {
    static int grid = 0;
    if (grid == 0) {
        if (n_in != 25 || in_sizes[0] != T * DM || out_size != T * DM || ws_size < WS_END) { fprintf(stderr, "kernel_launch: shape/workspace mismatch (n_in %d, in0 %d, out %d, ws %zu < %zu); nothing launched\n", n_in, n_in > 0 ? in_sizes[0] : -1, out_size, ws_size, (size_t)WS_END); grid = -1; return; }
        int dev = 0, cus = 0, per_cu = 0;
        if (hipGetDevice(&dev) != hipSuccess || hipDeviceGetAttribute(&cus, hipDeviceAttributeMultiprocessorCount, dev) != hipSuccess) { grid = -1; return; }
        if (hipFuncSetAttribute((const void*)fwd_kernel, hipFuncAttributeMaxDynamicSharedMemorySize, LDS_BYTES) != hipSuccess) { fprintf(stderr, "kernel_launch: hipFuncSetAttribute failed\n"); grid = -1; return; }
        if (hipOccupancyMaxActiveBlocksPerMultiprocessor(&per_cu, (const void*)fwd_kernel, NTHR, LDS_BYTES) != hipSuccess || per_cu < 1)
            fprintf(stderr, "kernel_launch: note: occupancy query reports %d workgroups per CU\n", per_cu);
        (void)hipGetLastError();
        grid = cus;
        if (grid < 32 || (grid & 7)) { fprintf(stderr, "kernel_launch: unexpected CU count %d\n", cus); }
    }
    if (grid < 0) return;
    if (hipMemsetAsync((char*)d_ws + WS_CTL, 0, CTL_ZERO_BYTES, stream) != hipSuccess) return;
    Args a{};
    for (int i = 0; i < 25; ++i) a.in[i] = (const float*)d_in[i];
    a.out = (float*)d_out; a.ws = (unsigned char*)d_ws;
#if MK_MULTI
    for (int p = 0; p < N_PHASES; ++p) { a.ph_lo = p; a.ph_hi = p + 1; hipLaunchKernelGGL(fwd_kernel, dim3(grid), dim3(NTHR), LDS_BYTES, stream, a); }
#else
    a.ph_lo = 0; a.ph_hi = N_PHASES;
    hipLaunchKernelGGL(fwd_kernel, dim3(grid), dim3(NTHR), LDS_BYTES, stream, a);
#endif
}
```

```cpp
#include <hip/hip_runtime.h>
#include <cstdio>
#include <cstdint>
namespace pg8 {
#define PG8_LAS __attribute__((address_space(3)))
typedef unsigned short bf16_t;
typedef short bf16x8 __attribute__((ext_vector_type(8)));
typedef float f32x4 __attribute__((ext_vector_type(4)));
typedef unsigned u32x4 __attribute__((ext_vector_type(4)));
constexpr int BM = 256, BK = 64, HALF = 128, HTB = HALF * BK * 2  , STAGE_BYTES = 8 * HTB, NXCD = 8, WGM = 8;

__host__ __device__ __forceinline__ int lds_byte(int r, int c) { const int st = (r >> 4) * 2 + (c >> 5), rr = r & 15, cc = c & 31, ob = rr * 64 + cc * 2; return st * 1024 + (ob ^ (((ob >> 9) & 1) << 5)); }
__host__ __device__ __forceinline__ void stage_rc(int b, int& R, int& C) { const int st = b / 1024, sb = b % 1024, swz = sb ^ (((sb >> 9) & 1) << 5); R = (st >> 1) * 16 + swz / 64; C = (st & 1) * 32 + (swz % 64) / 2; }
__host__ __device__ __forceinline__ int perm32(int rho) { const int n = rho >> 4, i = rho & 15; return 8 * (i >> 2) + 4 * n + (i & 3); }

struct Unit { int pm, pn; };
struct Gemm { const bf16_t* A; const bf16_t* Bt; int M, N, K; };

struct StaticOrder {
    int nM, nN, nwg, G, c;
    __host__ __device__ void init(int M, int N, int G_, int c_) { nM = M / BM; nN = N / BM; nwg = nM * nN; G = G_; c = c_; }
    __host__ __device__ bool next(int i, Unit& u) const {
        const long L = (long)i * G + c; if (L >= nwg) return false;
        int wgid = (int)L; { const int q = nwg / NXCD, r = nwg % NXCD, xcd = wgid % NXCD, off = wgid / NXCD; wgid = (xcd < r ? xcd * (q + 1) : r * (q + 1) + (xcd - r) * q) + off; }
        const int nig = WGM * nN, gid = wgid / nig, fm = gid * WGM, gsz = (nM - fm) < WGM ? (nM - fm) : WGM;
        u.pm = fm + ((wgid % nig) % gsz); u.pn = (wgid % nig) / gsz; return true;
    }
    __device__ __forceinline__ void a_ready(const Unit&) const {}
    __device__ __forceinline__ void done(const Unit&) const {}
};

__device__ __forceinline__ unsigned cvt_pk_bf16(float lo, float hi) { unsigned r; asm volatile("v_cvt_pk_bf16_f32 %0, %1, %2" : "=v"(r) : "v"(lo), "v"(hi)); return r; }
__device__ __forceinline__ float fast_sigmoid(float x) { return __builtin_amdgcn_rcpf(1.0f + __builtin_amdgcn_exp2f(-1.44269504089f * x)); }

constexpr int HLD = 2816;
constexpr float QSCALE = 0.125f * 1.44269504089f;

struct EpiInProj {
    static constexpr bool PERM = true, AFTER_DRAIN = false, GATHER = false, FP8 = false;
    bf16_t* H; float* side; const float* rope;
    __device__ __forceinline__ void operator()(const f32x4 (&acc)[2][2][4][2], const Unit& u, int wr, int wc, int fr, int fq) const {
        const int row0 = u.pm * BM + wr * 64 + fr; const int pn = u.pn;
        if (pn <= 4) {
#pragma unroll
            for (int ai = 0; ai < 2; ++ai)
#pragma unroll
                for (int m = 0; m < 4; ++m) {
                    const int row = row0 + ai * HALF + m * 16; const float* rp = rope + (size_t)(row & 4095) * 16;
                    const f32x4 c0 = *(const f32x4*)(rp), c1 = *(const f32x4*)(rp + 4), s0 = *(const f32x4*)(rp + 8), s1 = *(const f32x4*)(rp + 12);
#pragma unroll
                    for (int bj = 0; bj < 2; ++bj) {
                        f32x4 v0 = acc[ai][bj][m][0], v1 = acc[ai][bj][m][1];
                        const bool ropeb = (pn < 2) || (bj == 0);
                        if (ropeb) {
                            f32x4 p0, p1;
#pragma unroll
                            for (int e = 0; e < 4; ++e) { p0[e] = __shfl_xor(v0[e], 16); p1[e] = __shfl_xor(v1[e], 16); }
                            if (((wc & 1) == 0) && fq < 2) { const float sg = fq ? 1.f : -1.f; v0 = v0 * c0 + (p0 * s0) * sg; v1 = v1 * c1 + (p1 * s1) * sg; }
                        }
                        if (pn < 2) { v0 = v0 * QSCALE; v1 = v1 * QSCALE; }
                        u32x4 w; w.x = cvt_pk_bf16(v0[0], v0[1]); w.y = cvt_pk_bf16(v0[2], v0[3]); w.z = cvt_pk_bf16(v1[0], v1[1]); w.w = cvt_pk_bf16(v1[2], v1[3]);
                        *(u32x4*)(H + (size_t)row * HLD + pn * BM + bj * HALF + wc * 32 + 8 * fq) = w;
                    }
                }
        } else if (pn < 11) {
#pragma unroll
            for (int ai = 0; ai < 2; ++ai)
#pragma unroll
                for (int m = 0; m < 4; ++m) {
                    const int row = row0 + ai * HALF + m * 16;
#pragma unroll
                    for (int bj = 0; bj < 2; ++bj) {
                        const f32x4 v0 = acc[ai][bj][m][0], v1 = acc[ai][bj][m][1];
                        u32x4 w; w.x = cvt_pk_bf16(v0[0], v0[1]); w.y = cvt_pk_bf16(v0[2], v0[3]); w.z = cvt_pk_bf16(v1[0], v1[1]); w.w = cvt_pk_bf16(v1[2], v1[3]);
                        *(u32x4*)(H + (size_t)row * HLD + pn * BM + bj * HALF + wc * 32 + 8 * fq) = w;
                    }
                }
        } else if (wc == 0) {
#pragma unroll
            for (int ai = 0; ai < 2; ++ai)
#pragma unroll
                for (int m = 0; m < 4; ++m) {
                    const int row = row0 + ai * HALF + m * 16;
                    f32x4 v0 = acc[ai][0][m][0], v1 = acc[ai][0][m][1];
#pragma unroll
                    for (int e = 0; e < 4; ++e) { v0[e] = fast_sigmoid(v0[e]); if (fq < 3) v1[e] = fast_sigmoid(v1[e]); }
                    *(f32x4*)(side + (size_t)row * 32 + 8 * fq) = v0; *(f32x4*)(side + (size_t)row * 32 + 8 * fq + 4) = v1;
                }
        }
    }
};
struct EpiOutProj {
    static constexpr bool PERM = true, AFTER_DRAIN = false, GATHER = false, FP8 = false;
    const bf16_t* res; bf16_t* out; float alpha;
    __device__ __forceinline__ void operator()(const f32x4 (&acc)[2][2][4][2], const Unit& u, int wr, int wc, int fr, int fq) const {
        const int row0 = u.pm * BM + wr * 64 + fr, col0 = u.pn * BM + wc * 32 + 8 * fq;
#pragma unroll
        for (int ai = 0; ai < 2; ++ai)
#pragma unroll
            for (int m = 0; m < 4; ++m) { const size_t off = (size_t)(row0 + ai * HALF + m * 16) * 1024 + col0;
#pragma unroll
                for (int bj = 0; bj < 2; ++bj) { const u32x4 rb = *(const u32x4*)(res + off + bj * HALF);
                    f32x4 r0, r1; r0[0] = __uint_as_float(rb.x << 16); r0[1] = __uint_as_float(rb.x & 0xffff0000u); r0[2] = __uint_as_float(rb.y << 16); r0[3] = __uint_as_float(rb.y & 0xffff0000u);
                    r1[0] = __uint_as_float(rb.z << 16); r1[1] = __uint_as_float(rb.z & 0xffff0000u); r1[2] = __uint_as_float(rb.w << 16); r1[3] = __uint_as_float(rb.w & 0xffff0000u);
                    const f32x4 v0 = r0 * alpha + acc[ai][bj][m][0], v1 = r1 * alpha + acc[ai][bj][m][1];
                    u32x4 w; w.x = cvt_pk_bf16(v0[0], v0[1]); w.y = cvt_pk_bf16(v0[2], v0[3]); w.z = cvt_pk_bf16(v1[0], v1[1]); w.w = cvt_pk_bf16(v1[2], v1[3]);
                    *(u32x4*)(out + off + bj * HALF) = w; }
                asm volatile("" ::: "memory"); }
    }
};
struct EpiSwiGLU {
    static constexpr bool PERM = true, AFTER_DRAIN = false, GATHER = true, FP8 = true;
    unsigned char* hid; const int* rowmap; int rowshift;
    __device__ __forceinline__ void operator()(const f32x4 (&acc)[2][2][4][2], const Unit& u, int wr, int wc, int fr, int fq) const {
        const int row0 = u.pm * BM + wr * 64 + fr, hc0 = (u.pn & 3) * 128 + wc * 16 + 4 * fq;
#pragma unroll
        for (int ai = 0; ai < 2; ++ai)
#pragma unroll
            for (int m = 0; m < 4; ++m) { unsigned char* rowp = hid + (size_t)(row0 + ai * HALF + m * 16) * 512 + hc0;
#pragma unroll
                for (int bj = 0; bj < 2; ++bj) { const f32x4 g = acc[ai][bj][m][0] * 0.03125f, up = acc[ai][bj][m][1] * 0.03125f; f32x4 h;
#pragma unroll
                    for (int e = 0; e < 4; ++e) h[e] = __builtin_amdgcn_fmed3f(g[e] * fast_sigmoid(g[e]) * up[e], -440.f, 440.f);
                    int w = 0; w = __builtin_amdgcn_cvt_pk_fp8_f32(h[0], h[1], w, false); w = __builtin_amdgcn_cvt_pk_fp8_f32(h[2], h[3], w, true);
                    *(int*)(rowp + bj * 64) = w; } }
    }
};
struct EpiDown {
    static constexpr bool PERM = true, AFTER_DRAIN = false, GATHER = false, FP8 = true;
    bf16_t* y2; const int* slot_tok; const float* slot_w;
    __device__ __forceinline__ void operator()(const f32x4 (&acc)[2][2][4][2], const Unit& u, int wr, int wc, int fr, int fq) const {
        const int row0 = u.pm * BM + wr * 64 + fr, col0 = (u.pn & 3) * BM + wc * 32 + 8 * fq;
#pragma unroll
        for (int ai = 0; ai < 2; ++ai)
#pragma unroll
            for (int m = 0; m < 4; ++m) { const int row = row0 + ai * HALF + m * 16; const int st = slot_tok[row]; const float sw = slot_w[row] * 0.015625f;
                if (st >= 0) { bf16_t* rowp = y2 + (size_t)st * 1024 + col0;
#pragma unroll
                    for (int bj = 0; bj < 2; ++bj) { const f32x4 v0 = acc[ai][bj][m][0] * sw, v1 = acc[ai][bj][m][1] * sw;
                        u32x4 w; w.x = cvt_pk_bf16(v0[0], v0[1]); w.y = cvt_pk_bf16(v0[2], v0[3]); w.z = cvt_pk_bf16(v1[0], v1[1]); w.w = cvt_pk_bf16(v1[2], v1[3]);
                        *(u32x4*)(rowp + bj * HALF) = w; } } }
    }
};
struct MoeOrder {
    const int* meta; int G, c;
    __device__ __forceinline__ bool next(int i, Unit& u) const {
        const int per = G >> 3; const int idx = (G & 7) ? (i * G + c) : ((i * 8 + (c & 7)) * per + (c >> 3));
        const int nt = __builtin_amdgcn_readfirstlane(meta[0]); if (idx >= nt * 4) return false;
        const int pm = idx >> 2; u.pm = pm; u.pn = __builtin_amdgcn_readfirstlane(meta[64 + pm]) * 4 + (idx & 3); return true;
    }
    __device__ __forceinline__ void a_ready(const Unit&) const {}
    __device__ __forceinline__ void done(const Unit&) const {}
};
typedef int v4i_ __attribute__((ext_vector_type(4)));
typedef int v8i_ __attribute__((ext_vector_type(8)));
template <class Epi, class Sched, bool STAMP = false>
__device__ __forceinline__ void gemm_phase(PG8_LAS unsigned char* lds, const Gemm g, const Sched& S, const Epi& E, unsigned long long* stamps, int tid_in) {
    int tid_ = tid_in; asm volatile("" : "+v"(tid_));
    const int tid = tid_, wid = __builtin_amdgcn_readfirstlane(tid >> 6), lane = tid & 63, wr = wid >> 2, wc = wid & 3, fr = lane & 15, fq = lane >> 4;
    const int K = g.K, nt = K / BK;
    int ts_lo = 0, ts_hi = 0, nts = 0; const unsigned long long rt_entry = STAMP ? (unsigned long long)wall_clock64() : 0ull;
#define PG8_STAMP() do { if (STAMP && wid == 0 && nts < 64) { const unsigned long long _c = (unsigned long long)clock64(); \
        ts_lo = (lane == nts) ? (int)(unsigned)_c : ts_lo; ts_hi = (lane == nts) ? (int)(unsigned)(_c >> 32) : ts_hi; ++nts; } } while (0)
    PG8_STAMP();
    unsigned voffA[2], voffB[2];
#pragma unroll
    for (int i = 0; i < 2; ++i) { int R, C; stage_rc(tid * 16 + i * 8192, R, C); const int Rb = Epi::PERM ? ((R & ~31) + perm32(R & 31)) : R;
        voffA[i] = (unsigned)(R * K + C) * 2u; voffB[i] = (unsigned)(Rb * K + C) * 2u; }
    unsigned offAc[2][2], offAn[2][2];
    PG8_LAS unsigned char* gidx = lds + STAGE_BYTES + (unsigned)wid * 1024u;
#define PG8_IDX_DMA(par, pm_) do { int t2_ = tid; asm volatile("" : "+v"(t2_)); _Pragma("unroll") for (int i_ = 0; i_ < 2; ++i_) { int R_, C_; stage_rc(t2_ * 16 + i_ * 8192, R_, C_); (void)C_; \
        _Pragma("unroll") for (int h_ = 0; h_ < 2; ++h_) __builtin_amdgcn_global_load_lds((const unsigned*)(E.rowmap + (size_t)(pm_) * BM + h_ * HALF + R_), (PG8_LAS unsigned*)(gidx + (par) * 512 + (h_ * 2 + i_) * 256), 4, 0, 0); } } while (0)
#define PG8_IDX_READ(dst, par) do { int t2_ = tid; asm volatile("" : "+v"(t2_)); _Pragma("unroll") for (int i_ = 0; i_ < 2; ++i_) { int R_, C_; stage_rc(t2_ * 16 + i_ * 8192, R_, C_); (void)R_; \
        _Pragma("unroll") for (int h_ = 0; h_ < 2; ++h_) { int r_ = *(const PG8_LAS int*)(gidx + (par) * 512 + (h_ * 2 + i_) * 256 + (t2_ & 63) * 4); r_ = r_ < 0 ? 0 : (r_ >> E.rowshift); dst[h_][i_] = (unsigned)r_ * (unsigned)(K * 2) + (unsigned)C_ * 2u; } } } while (0)
    const size_t kstep = (size_t)(BK * 2);
    const size_t hstep = (size_t)HALF * K * 2;
    const size_t tstep = 2 * hstep;
    const unsigned ldsw = (unsigned)wid * 1024u;
    const int aoff = lds_byte(wr * 64 + fr, fq * 8), boff = lds_byte(wc * 32 + fr, fq * 8);
#define PG8_SA(b, h) (((b) * 2 + (h)) * HTB)
#define PG8_SB(b, h) ((4 + (b) * 2 + (h)) * HTB)
#define PG8_STAGE(bufoff, gbase, voff) do { _Pragma("unroll") for (int _i = 0; _i < 2; ++_i) \
        __builtin_amdgcn_global_load_lds((const unsigned*)((const char*)(gbase) + (voff)[_i]), (PG8_LAS unsigned*)(lds + (bufoff) + ldsw + _i * 8192), 16, 0, 0); } while (0)
#define PG8_STAGE_A(bufoff, kt_, h_, nx_) do { if constexpr (Epi::GATHER) { _Pragma("unroll") for (int _i = 0; _i < 2; ++_i) { const unsigned o_ = (nx_) ? offAn[h_][_i] : offAc[h_][_i]; \
            __builtin_amdgcn_global_load_lds((const unsigned*)((const char*)g.A + (size_t)(kt_) * kstep + o_), (PG8_LAS unsigned*)(lds + (bufoff) + ldsw + _i * 8192), 16, 0, 0); } } \
        else { PG8_STAGE(bufoff, ((nx_) ? nA : cA) + (size_t)(kt_) * kstep + (h_) * hstep, voffA); } } while (0)
#define PG8_LDA(dst, b, h) do { _Pragma("unroll") for (int m = 0; m < 4; ++m) _Pragma("unroll") for (int k = 0; k < 2; ++k) dst[m][k] = *(const PG8_LAS bf16x8*)(lds + PG8_SA(b, h) + aoff + m * 2048 + k * 1024); } while (0)
#define PG8_LDB(dst, b, h) do { _Pragma("unroll") for (int n = 0; n < 2; ++n) _Pragma("unroll") for (int k = 0; k < 2; ++k) dst[n][k] = *(const PG8_LAS bf16x8*)(lds + PG8_SB(b, h) + boff + n * 2048 + k * 1024); } while (0)
#define PG8_MMA(ai, bj, At, Bt) do { __builtin_amdgcn_s_setprio(1); \
        if constexpr (Epi::FP8) {   \
            _Pragma("unroll") for (int m = 0; m < 4; ++m) _Pragma("unroll") for (int n = 0; n < 2; ++n) \
                { const v8i_ b8_ = __builtin_shufflevector(__builtin_bit_cast(v4i_, Bt[n][0]), __builtin_bit_cast(v4i_, Bt[n][1]), 0, 1, 2, 3, 4, 5, 6, 7), \
                             a8_ = __builtin_shufflevector(__builtin_bit_cast(v4i_, At[m][0]), __builtin_bit_cast(v4i_, At[m][1]), 0, 1, 2, 3, 4, 5, 6, 7); \
                    \
                  asm volatile("v_mfma_f32_16x16x128_f8f6f4 %0, %1, %2, %0" : "+v"(acc[ai][bj][m][n]) : "v"(b8_), "v"(a8_)); } } \
        else { _Pragma("unroll") for (int m = 0; m < 4; ++m) _Pragma("unroll") for (int n = 0; n < 2; ++n) _Pragma("unroll") for (int k = 0; k < 2; ++k) \
            acc[ai][bj][m][n] = __builtin_amdgcn_mfma_f32_16x16x32_bf16(Bt[n][k], At[m][k], acc[ai][bj][m][n], 0, 0, 0); } \
        __builtin_amdgcn_s_setprio(0); } while (0)
#define PG8_WAIT_V(n) asm volatile("s_waitcnt vmcnt(" #n ")" ::: "memory")
#define PG8_WAIT_L(n) asm volatile("s_waitcnt lgkmcnt(" #n ")" ::: "memory")
#define PG8_BAR __builtin_amdgcn_s_barrier()
#define PG8_SCHED __builtin_amdgcn_sched_barrier(0)
    Unit cur, nxt; int ui = 0;
    if (!S.next(0, cur)) return;
    f32x4 acc[2][2][4][2];
    float zf_ = 0.f; asm volatile("" : "+v"(zf_));
#pragma unroll
    for (int a = 0; a < 2; ++a)
#pragma unroll
        for (int b = 0; b < 2; ++b)
#pragma unroll
            for (int m = 0; m < 4; ++m)
#pragma unroll
                for (int n = 0; n < 2; ++n) acc[a][b][m][n] = (f32x4){zf_, zf_, zf_, zf_};
    bf16x8 At[4][2], B0[2][2], B1[2][2];
    const char* cA = (const char*)g.A + (size_t)cur.pm * tstep; const char* cB = (const char*)g.Bt + (size_t)cur.pn * tstep;
    S.a_ready(cur);
    if constexpr (Epi::GATHER) { PG8_IDX_DMA(0, cur.pm); asm volatile("s_waitcnt vmcnt(0)" ::: "memory"); PG8_IDX_READ(offAc, 0); asm volatile("s_waitcnt lgkmcnt(0)" ::: "memory"); }
    const char* nA = cA;
    PG8_STAGE(PG8_SB(0, 0), cB, voffB); PG8_STAGE_A(PG8_SA(0, 0), 0, 0, false); PG8_STAGE(PG8_SB(0, 1), cB + hstep, voffB); PG8_STAGE_A(PG8_SA(0, 1), 0, 1, false);
    if (wr == 1) PG8_BAR;
    PG8_WAIT_V(4); PG8_BAR;
    PG8_STAGE(PG8_SB(1, 0), cB + kstep, voffB); PG8_STAGE_A(PG8_SA(1, 0), 1, 0, false); PG8_STAGE(PG8_SB(1, 1), cB + hstep + kstep, voffB);
    PG8_WAIT_V(6); PG8_BAR;
    PG8_STAMP();
    for (;;) {
        const bool has_next = S.next(ui + 1, nxt);
        nA = has_next ? (const char*)g.A + (size_t)nxt.pm * tstep : cA; const char* nB = has_next ? (const char*)g.Bt + (size_t)nxt.pn * tstep : cB;
        if constexpr (Epi::GATHER) { if (has_next) PG8_IDX_DMA((ui + 1) & 1, nxt.pm); }
#pragma unroll 1
        for (int t = 0; t < nt; t += 2) {
            const bool last = (t == nt - 2);
            const char* b2 = last ? nB : cB + (size_t)(t + 2) * kstep;
            const char* b3 = b2 + kstep;
            const int kt2 = last ? 0 : t + 2;
            if constexpr (Epi::GATHER) { if (last) { if (has_next) PG8_IDX_READ(offAn, (ui + 1) & 1); else { offAn[0][0] = offAc[0][0]; offAn[0][1] = offAc[0][1]; offAn[1][0] = offAc[1][0]; offAn[1][1] = offAc[1][1]; } } }
            if (last && has_next) S.a_ready(nxt);
            PG8_LDB(B0, 0, 0); PG8_SCHED; PG8_LDA(At, 0, 0); PG8_STAGE_A(PG8_SA(1, 1), t + 1, 1, false);
            PG8_WAIT_L(8); PG8_BAR; PG8_WAIT_L(0); PG8_MMA(0, 0, At, B0); PG8_BAR; PG8_SCHED;
            PG8_LDB(B1, 0, 1); PG8_STAGE(PG8_SB(0, 0), b2, voffB);
            PG8_BAR; PG8_WAIT_L(0); PG8_MMA(0, 1, At, B1); PG8_BAR;
            PG8_LDA(At, 0, 1); PG8_STAGE_A(PG8_SA(0, 0), kt2, 0, last);
            PG8_BAR; PG8_WAIT_L(0); PG8_MMA(1, 0, At, B0); PG8_BAR; PG8_SCHED;
            PG8_STAGE(PG8_SB(0, 1), b2 + hstep, voffB);
            PG8_WAIT_V(6); PG8_BAR; PG8_MMA(1, 1, At, B1); PG8_BAR;
            PG8_LDB(B0, 1, 0); PG8_SCHED; PG8_LDA(At, 1, 0); PG8_STAGE_A(PG8_SA(0, 1), kt2, 1, last);
            PG8_WAIT_L(8); PG8_BAR; PG8_WAIT_L(0); PG8_MMA(0, 0, At, B0); PG8_BAR; PG8_SCHED;
            PG8_LDB(B1, 1, 1); PG8_STAGE(PG8_SB(1, 0), b3, voffB);
            PG8_BAR; PG8_WAIT_L(0); PG8_MMA(0, 1, At, B1); PG8_BAR;
            PG8_LDA(At, 1, 1); PG8_STAGE_A(PG8_SA(1, 0), kt2 + 1, 0, last);
            PG8_BAR; PG8_WAIT_L(0); PG8_MMA(1, 0, At, B0); PG8_BAR; PG8_SCHED;
            PG8_STAGE(PG8_SB(1, 1), b3 + hstep, voffB);
            PG8_WAIT_V(6); PG8_BAR; PG8_MMA(1, 1, At, B1); PG8_BAR;
        }
        PG8_STAMP();
        if constexpr (Epi::FP8) asm volatile("s_nop 15\n\ts_nop 15" ::: "memory");
        if constexpr (!Epi::AFTER_DRAIN) { E(acc, cur, wr, wc, fr, fq); S.done(cur); }
        PG8_STAMP();
        if (!has_next) break;
#pragma unroll
        for (int a = 0; a < 2; ++a)
#pragma unroll
            for (int b = 0; b < 2; ++b)
#pragma unroll
                for (int m = 0; m < 4; ++m)
#pragma unroll
                    for (int n = 0; n < 2; ++n) acc[a][b][m][n] = (f32x4){zf_, zf_, zf_, zf_};
        cur = nxt; cA = nA; cB = nB; ++ui;
        if constexpr (Epi::GATHER) { offAc[0][0] = offAn[0][0]; offAc[0][1] = offAn[0][1]; offAc[1][0] = offAn[1][0]; offAc[1][1] = offAn[1][1]; }
    }
    PG8_WAIT_V(0);
    if (wr == 0) PG8_BAR;
    PG8_BAR;
    if constexpr (Epi::AFTER_DRAIN) { E.fused(acc, cur, wr, wc, fr, fq, lds, wid, lane); S.done(cur); }
    PG8_STAMP();
    if (STAMP && wid == 0) { stamps[lane] = lane < nts ? (((unsigned long long)(unsigned)ts_hi << 32) | (unsigned)ts_lo) : 0ull;
        if (lane == 62) stamps[62] = rt_entry; if (lane == 63) stamps[63] = (unsigned long long)wall_clock64(); }
#undef PG8_STAMP
#undef PG8_SA
#undef PG8_SB
#undef PG8_STAGE
#undef PG8_STAGE_A
#undef PG8_IDX_DMA
#undef PG8_IDX_READ
#undef PG8_LDA
#undef PG8_LDB
#undef PG8_MMA
#undef PG8_WAIT_V
#undef PG8_WAIT_L
#undef PG8_BAR
#undef PG8_SCHED
}
}

#ifndef SELFCHECK
#define SELFCHECK 0
#endif
#ifndef PROBE_GDN_VAR
#define PROBE_GDN_VAR 0
#endif
#ifndef PROBE_SCAN_VAR
#define PROBE_SCAN_VAR 0
#endif
#ifndef PROBE_ATTN_VAR
#define PROBE_ATTN_VAR 0
#endif
constexpr int NB = 8, SEQ = 4096, DM = 1024, NL = 4, T = NB * SEQ;
constexpr int DIN = 2848, DINP = 3072, HLD = pg8::HLD;
constexpr int NEXP = 32, FF = 512, NTILE_MAX = 288;
constexpr float LN_EPS = 1e-5f;
constexpr float DN_ALPHA = 1.6817928305074290f;
constexpr int NWAVES = 8, NTHR = 512;

constexpr size_t MiB = 1u << 20, KiB = 1u << 10;
constexpr size_t WS_CTL = 0, CTL_ZERO_BYTES = 128 * KiB;
constexpr size_t WS_ROPE = 1 * MiB;
constexpr size_t WS_META = 1 * MiB + 512 * KiB;
constexpr size_t WS_GL = WS_META + 16 * KiB;
constexpr size_t WS_WL = 2 * MiB;
constexpr size_t WL_WIN = 0, WL_WOUT = 6 * MiB, WL_WGU = 8 * MiB, WL_WDN = 72 * MiB, WL_W1 = 104 * MiB, WL_W2 = 105 * MiB, WL_BIAS1 = 105 * MiB + 64 * KiB, WL_WR = 105 * MiB + 128 * KiB;
constexpr size_t WS_XB = 108 * MiB;
constexpr size_t WS_X1 = 172 * MiB;
constexpr size_t WS_H = 300 * MiB;
constexpr size_t WS_SIDE = 476 * MiB;
constexpr size_t WS_Y = 480 * MiB;
constexpr size_t WS_GPREP = 544 * MiB;
constexpr size_t WS_Y2 = 672 * MiB;
constexpr size_t WS_HID = 800 * MiB;
constexpr size_t WS_KC = 872 * MiB, WS_VC = WS_KC + 512 * KiB;
constexpr size_t WS_SLOT = 873 * MiB;
constexpr size_t SL_TOK = 0, SL_W = 512 * KiB, SL_RE = 1024 * KiB, SL_RP = 1280 * KiB, SL_RW = 1536 * KiB;
constexpr size_t WS_WL2 = 876 * MiB;
constexpr size_t WS_END = 982 * MiB;
#define WLBASE(ws_, l_) ((ws_) + (((l_) & 1) ? WS_WL2 : WS_WL))
constexpr int GCH = 65536;
constexpr int GC_UT = 0, GC_W = 8192, GC_QK = 16384, GC_QD = 24576, GC_KDT = 32768, GC_ZT = 40960, GC_SS = 49152, GC_VB = 57344;
constexpr int CW_TMO = 0;
constexpr int CW_BAR = 4096;
constexpr int CW_CNT = 8192;
constexpr int CW_QUEUE = 12288;
static_assert((CW_QUEUE + NL * 64) * 4 <= (int)CTL_ZERO_BYTES, "CTL words inside the memset region");

constexpr int SCR_BYTES = 159744;
constexpr int MISC_OFF = SCR_BYTES;
constexpr int LDS_BYTES = 163840;

#define GAS __attribute__((address_space(1)))
#define LAS __attribute__((address_space(3)))
typedef unsigned short bf16;
typedef float f32x4 __attribute__((ext_vector_type(4)));
typedef float f32x2 __attribute__((ext_vector_type(2)));
typedef float f32x16 __attribute__((ext_vector_type(16)));
typedef short bf16x8 __attribute__((ext_vector_type(8)));
typedef short s16x4 __attribute__((ext_vector_type(4)));
typedef unsigned u32x4 __attribute__((ext_vector_type(4)));
typedef unsigned u32x2 __attribute__((ext_vector_type(2)));
#define LDS_WAIT() asm volatile("s_waitcnt lgkmcnt(0)" ::: "memory")
#define VM_WAIT() asm volatile("s_waitcnt vmcnt(0)" ::: "memory")
#define SBAR() __builtin_amdgcn_sched_barrier(0)
__device__ __forceinline__ float bf2f(unsigned b) { return __uint_as_float(b << 16); }
__device__ __forceinline__ unsigned pk2(float lo, float hi) { return pg8::cvt_pk_bf16(lo, hi); }
__device__ __forceinline__ unsigned f2bf_sw(float f) { unsigned u = __float_as_uint(f); return (u + 0x7fffu + ((u >> 16) & 1u)) >> 16; }
__device__ __forceinline__ unsigned f2bf(float f) { unsigned r; asm("v_cvt_pk_bf16_f32 %0, %1, %1" : "=v"(r) : "v"(f)); return r & 0xffffu; }
__device__ __forceinline__ float row16_sum(float x) {
    x += __int_as_float(__builtin_amdgcn_update_dpp(0, __float_as_int(x), 0xB1, 0xf, 0xf, true));
    x += __int_as_float(__builtin_amdgcn_update_dpp(0, __float_as_int(x), 0x4E, 0xf, 0xf, true));
    x += __int_as_float(__builtin_amdgcn_update_dpp(0, __float_as_int(x), 0x141, 0xf, 0xf, true));
    x += __int_as_float(__builtin_amdgcn_update_dpp(0, __float_as_int(x), 0x140, 0xf, 0xf, true));
    return x;
}
__device__ __forceinline__ float wave_sum(float v) {
    const int r = __float_as_int(row16_sum(v));
    return (__int_as_float(__builtin_amdgcn_readlane(r, 0)) + __int_as_float(__builtin_amdgcn_readlane(r, 16))) + (__int_as_float(__builtin_amdgcn_readlane(r, 32)) + __int_as_float(__builtin_amdgcn_readlane(r, 48)));
}
__device__ __forceinline__ float fsigmoid(float x) { return pg8::fast_sigmoid(x); }
__device__ __forceinline__ float fsilu(float x) { return x * pg8::fast_sigmoid(x); }
__device__ __forceinline__ float fexp2(float x) { return __builtin_amdgcn_exp2f(x); }

#define XB_TMO      128
#define XB_XCNT(j)  (256  + 64 * (j))
#define XB_XSUB(j)  (1280 + 64 * (j))
#define XB_XGEN(j)  (2304 + 64 * (j))
#define XB_TOP      3328
#define XB_TOPGEN   3392
#define XCD_BAR_WORDS 3456
#define XB_SPIN_CAP (1u << 18)
#define LAS __attribute__((address_space(3)))

__device__ __forceinline__ unsigned xb_ld(unsigned* p)              { return __hip_atomic_load(p, __ATOMIC_RELAXED, __HIP_MEMORY_SCOPE_AGENT); }
__device__ __forceinline__ unsigned xb_add(unsigned* p, unsigned v) { return __hip_atomic_fetch_add(p, v, __ATOMIC_RELAXED, __HIP_MEMORY_SCOPE_AGENT); }
__device__ __forceinline__ unsigned xb_xcc_id() { return (unsigned)__builtin_amdgcn_s_getreg((3 << 11) | 20) & 0xFu; }
#define XB_SPIN(cond, bar) do { unsigned _sp = 0; while (cond) { __builtin_amdgcn_s_sleep(1); \
    if ((++_sp & 255u) == 0u) { if (xb_ld(&(bar)[XB_TMO])) break; if (_sp > XB_SPIN_CAP) { atomicAdd(&(bar)[XB_TMO], 1u); break; } } } } while (0)

struct XcdBarrier {
    unsigned* bar; unsigned x;
    volatile LAS unsigned* st;
};

__device__ __forceinline__ XcdBarrier xcd_barrier_post(unsigned* bar, volatile LAS unsigned* st) {
    XcdBarrier b; b.bar = bar; b.x = xb_xcc_id(); b.st = st;
    if (threadIdx.x == 0) (void)xb_add(&bar[XB_XCNT(b.x)], 1u);
    return b;
}
__device__ __forceinline__ void xcd_barrier_complete(unsigned* bar, unsigned x, unsigned& nloc, unsigned& nx) {
    const unsigned G = gridDim.x * gridDim.y * gridDim.z;
    unsigned sum, cnt, mine, sp = 0u;
    for (;;) {
        sum = 0u; cnt = 0u; mine = 0u;
#pragma unroll
        for (unsigned j = 0; j < 16; ++j) { const unsigned c = xb_ld(&bar[XB_XCNT(j)]); sum += c; cnt += (c > 0u) ? 1u : 0u; mine = (j == x) ? c : mine; }
        if (sum == G) break;
        __builtin_amdgcn_s_sleep(1);
        if ((++sp & 255u) == 0u) { if (xb_ld(&bar[XB_TMO])) break; if (sp > XB_SPIN_CAP) { atomicAdd(&bar[XB_TMO], 1u); break; } }
    }
    nloc = mine > 0u ? mine : 1u; nx = cnt > 0u ? cnt : 1u;
}

__device__ __forceinline__ void xcd_barrier(const XcdBarrier& b) {
    asm volatile("s_waitcnt vmcnt(0)" ::: "memory");
    __syncthreads();
    if (threadIdx.x == 0) {
        unsigned* bar = b.bar;
        __builtin_amdgcn_s_waitcnt(0);
        unsigned nloc = b.st[0], nx = b.st[1];
        if (nloc == 0u) { xcd_barrier_complete(bar, b.x, nloc, nx); b.st[0] = nloc; b.st[1] = nx; }
        const unsigned old = xb_add(&bar[XB_XSUB(b.x)], 1u);
        const unsigned gen = old / nloc;
        if (old + 1u == (gen + 1u) * nloc) {
            __builtin_amdgcn_fence(__ATOMIC_RELEASE, "agent");
            asm volatile("s_waitcnt vmcnt(0)" ::: "memory");
            const unsigned og = xb_add(&bar[XB_TOP], 1u);
            const unsigned tg = og / nx;
            if (og + 1u == (tg + 1u) * nx) xb_add(&bar[XB_TOPGEN], 1u);
            else XB_SPIN(xb_ld(&bar[XB_TOPGEN]) == tg, bar);
            __builtin_amdgcn_fence(__ATOMIC_ACQUIRE, "agent");
            xb_add(&bar[XB_XGEN(b.x)], 1u);
            asm volatile("s_waitcnt vmcnt(0)" ::: "memory");
        } else {
            XB_SPIN(xb_ld(&bar[XB_XGEN(b.x)]) == gen, bar);
            __builtin_amdgcn_fence(__ATOMIC_ACQUIRE, "agent");
            asm volatile("s_waitcnt vmcnt(0)" ::: "memory");
        }
    }
    __syncthreads();
}

struct Args { const float* in[25]; float* out; unsigned char* ws; int ph_lo, ph_hi; };
typedef const __attribute__((address_space(4))) Args* ArgsP;
__device__ __forceinline__ ArgsP args_here() { ArgsP p = (ArgsP)__builtin_amdgcn_kernarg_segment_ptr(); asm volatile("" : "+s"(p)); return p; }
struct Frame { LAS unsigned char* lds; volatile LAS unsigned* MISC; unsigned* ctl; int tid, lane, wave, G, bid; };

template <class Src>
__device__ __forceinline__ void tr_item(const Src src, int K, int N, bf16* WT, LAS float* scr, int item, int lane) {
    const int nblk = N >> 5, kb = item / nblk, nb = item - kb * nblk, k0 = kb << 6, n0 = nb << 5;
    float tv[32];
#pragma unroll
    for (int i = 0; i < 32; ++i) tv[i] = src(k0 + 2 * i + (lane >> 5), n0 + (lane & 31));
#pragma unroll
    for (int i = 0; i < 32; ++i) scr[(2 * i + (lane >> 5)) * 33 + (lane & 31)] = tv[i];
    LDS_WAIT();
    const int c = lane & 7;
#pragma unroll
    for (int j = 0; j < 4; ++j) { const int n = (lane >> 3) + 8 * j; const LAS float* s = scr + (8 * c) * 33 + n;
        u32x4 o; o.x = pk2(s[0], s[33]); o.y = pk2(s[66], s[99]); o.z = pk2(s[132], s[165]); o.w = pk2(s[198], s[231]);
        *(u32x4*)(WT + (size_t)(n0 + n) * K + k0 + 8 * c) = o; }
    LDS_WAIT();
}
template <class Src>
__device__ __forceinline__ void tr8_load(const Src src, int N, int item, int lane, float (&tv)[32]) {
    const int nblk = N >> 5, kb = item / nblk, nb = item - kb * nblk, k0 = kb << 6, n0 = nb << 5;
#pragma unroll
    for (int i = 0; i < 32; ++i) tv[i] = src(k0 + 2 * i + (lane >> 5), n0 + (lane & 31));
}
__device__ __forceinline__ void tr8_finish(const float (&tv)[32], int K, int N, unsigned char* WT, float mul, LAS float* scr, int item, int lane) {
    const int nblk = N >> 5, kb = item / nblk, nb = item - kb * nblk, k0 = kb << 6, n0 = nb << 5;
#pragma unroll
    for (int i = 0; i < 32; ++i) scr[(2 * i + (lane >> 5)) * 33 + (lane & 31)] = tv[i];
    LDS_WAIT();
    const int n = lane >> 1, kh = (lane & 1) * 32; const LAS float* sp = scr + kh * 33 + n;
#pragma unroll
    for (int q = 0; q < 2; ++q) { u32x4 o;
#pragma unroll
        for (int d = 0; d < 4; ++d) { const LAS float* s4 = sp + (16 * q + 4 * d) * 33; int w = 0;
            w = __builtin_amdgcn_cvt_pk_fp8_f32(s4[0] * mul, s4[33] * mul, w, false); w = __builtin_amdgcn_cvt_pk_fp8_f32(s4[66] * mul, s4[99] * mul, w, true); o[d] = (unsigned)w; }
        *(u32x4*)(WT + (size_t)(n0 + n) * K + k0 + kh + 16 * q) = o; }
    LDS_WAIT();
}
struct SrcPlain { const float* p; int ld; __device__ __forceinline__ float operator()(int k, int n) const { return p[(size_t)k * ld + n]; } };
struct SrcWin { const float* p;
    __device__ __forceinline__ float operator()(int k, int n) const {
        int c;
        if (n < 1280) c = n; else if (n < 2048) c = n + 24; else if (n < 2304) c = n + 24; else if (n < 2816) c = n + 32;
        else if (n < 2840) c = n - 2816 + 1280; else if (n < 2844) c = n - 2840 + 2328; else if (n < 2848) c = n - 2844 + 2332; else return 0.f;
        return p[(size_t)k * DIN + c]; } };
struct SrcGU { const float* wg; const float* wu;
    __device__ __forceinline__ float operator()(int k, int n) const { const int q = n >> 3, r = n & 7; const ptrdiff_t d = (r < 4) ? (ptrdiff_t)0 : (wu - wg); return wg[d + (ptrdiff_t)k * FF + 4 * q + (r & 3)]; } };

__device__ __forceinline__ void phase_weights(const Frame& F, ArgsP a, int l, int parts, int nblk, int lds_off) {
    unsigned char* wl = WLBASE(a->ws, l);
    LAS float* scr = (LAS float*)(F.lds + lds_off + F.wave * 8448);
    const int gw = F.bid * NWAVES + F.wave, NGW = nblk * NWAVES;
    constexpr int I_WIN = 16 * 96, I_WOUT = 16 * 32, I_GU1 = 16 * 32, I_GU = NEXP * I_GU1, I_DN1 = 8 * 32, I_DN = NEXP * I_DN1, I_W1 = 2 * 32 * 4, I_W2 = 2 * 2 * 2, I_WR = 36, I_B1 = 256;
    constexpr int NITEMS = I_WIN + I_WOUT + I_GU + I_DN + I_W1 + I_W2 + I_WR + I_B1;
    if (parts & 1) {
        for (int r = gw; r < I_GU; r += 2 * NGW) { const int r2 = r + NGW; const bool two = r2 < I_GU; const int e = r / I_GU1, e2 = (two ? r2 : r) / I_GU1; float tva[32], tvb[32];
            SrcGU sa{a->in[22] + ((size_t)l * NEXP + e) * DM * FF, a->in[23] + ((size_t)l * NEXP + e) * DM * FF}, sb{a->in[22] + ((size_t)l * NEXP + e2) * DM * FF, a->in[23] + ((size_t)l * NEXP + e2) * DM * FF};
            tr8_load(sa, 1024, r - e * I_GU1, F.lane, tva); tr8_load(sb, 1024, (two ? r2 : r) - e2 * I_GU1, F.lane, tvb);
            tr8_finish(tva, DM, 1024, wl + WL_WGU + (size_t)e * 1024 * DM, 32.f, scr, r - e * I_GU1, F.lane);
            if (two) tr8_finish(tvb, DM, 1024, wl + WL_WGU + (size_t)e2 * 1024 * DM, 32.f, scr, r2 - e2 * I_GU1, F.lane); }
        for (int r = gw; r < I_DN; r += 2 * NGW) { const int r2 = r + NGW; const bool two = r2 < I_DN; const int e = r / I_DN1, e2 = (two ? r2 : r) / I_DN1; float tva[32], tvb[32];
            SrcPlain sa{a->in[24] + ((size_t)l * NEXP + e) * FF * DM, DM}, sb{a->in[24] + ((size_t)l * NEXP + e2) * FF * DM, DM};
            tr8_load(sa, DM, r - e * I_DN1, F.lane, tva); tr8_load(sb, DM, (two ? r2 : r) - e2 * I_DN1, F.lane, tvb);
            tr8_finish(tva, FF, DM, wl + WL_WDN + (size_t)e * DM * FF, 64.f, scr, r - e * I_DN1, F.lane);
            if (two) tr8_finish(tvb, FF, DM, wl + WL_WDN + (size_t)e2 * DM * FF, 64.f, scr, r2 - e2 * I_DN1, F.lane); }
    }
    if (!(parts & 2)) return;
    for (int it = I_GU + I_DN + gw; it < NITEMS; it += NGW) {
        int r = it - I_GU - I_DN;
        if (r < I_WIN) { SrcWin s{a->in[1] + (size_t)l * DM * DIN}; tr_item(s, DM, DINP, (bf16*)(wl + WL_WIN), scr, r, F.lane); continue; } r -= I_WIN;
        if (r < I_WOUT) { SrcPlain s{a->in[2] + (size_t)l * DM * DM, DM}; tr_item(s, DM, DM, (bf16*)(wl + WL_WOUT), scr, r, F.lane); continue; } r -= I_WOUT;
        if (r < I_W1) { const int kv = r / 128; SrcPlain s{a->in[4] + ((size_t)l * 2 + kv) * 2048 * 128, 128};
            tr_item(s, 2048, 128, (bf16*)(wl + WL_W1) + (size_t)kv * 128 * 2048, scr, r - kv * 128, F.lane); continue; } r -= I_W1;
        if (r < I_W2) { const int kv = r / 4; SrcPlain s{a->in[5] + ((size_t)l * 2 + kv) * 128 * 64, 64};
            tr_item(s, 128, 64, (bf16*)(wl + WL_W2) + (size_t)kv * 64 * 128, scr, r - kv * 4, F.lane); continue; } r -= I_W2;
        if (r < I_WR) {
            float* wr = (float*)(wl + WL_WR) + (size_t)r * DM;
            for (int k = F.lane; k < DM; k += 64) wr[k] = (r < 4) ? a->in[18][((size_t)l * DM + k) * 4 + r] : a->in[20][((size_t)l * DM + k) * NEXP + (r - 4)];
            continue; } r -= I_WR;
        {
            const int kv = r >> 7, n = r & 127; const float* pe = a->in[3] + ((size_t)l * 2 + kv) * 2048; const float* w1 = a->in[4] + ((size_t)l * 2 + kv) * 2048 * 128;
            float s = 0.f; for (int k = F.lane; k < 2048; k += 64) s += pe[k] * w1[(size_t)k * 128 + n];
            s = wave_sum(s); if (F.lane == 0) ((float*)(wl + WL_BIAS1))[r] = s;
        }
    }
}

__device__ __forceinline__ void phase_prologue(const Frame& F, ArgsP a) {
    const size_t gt = (size_t)F.bid * NTHR + F.tid, NGT = (size_t)F.G * NTHR;
    float* rope = (float*)(a->ws + WS_ROPE);
    for (size_t i = gt; i < (size_t)SEQ * 8; i += NGT) { const int t = (int)(i >> 3), f = (int)(i & 7);
        const float invt[8] = {1.0f, 0.19392274f, 0.03760603f, 0.0072926646f, 0.0014142136f, 0.0002742482f, 5.3182957e-05f, 1.0313385e-05f};
        float inv = invt[0];
#pragma unroll
        for (int q = 1; q < 8; ++q) inv = (f == q) ? invt[q] : inv;
        const float ang = (float)t * inv;
        const double rev = (double)ang * 0.15915494309189535; const float fr = (float)(rev - __builtin_rint(rev));
        rope[t * 16 + f] = __builtin_amdgcn_cosf(fr); rope[t * 16 + 8 + f] = __builtin_amdgcn_sinf(fr); }
    const f32x4* x4 = (const f32x4*)a->in[0]; u32x4* xb = (u32x4*)(a->ws + WS_XB);
    for (size_t i = gt; i < (size_t)T * DM / 8; i += NGT) { const f32x4 v0 = x4[2 * i], v1 = x4[2 * i + 1];
        u32x4 w; w.x = pk2(v0[0], v0[1]); w.y = pk2(v0[2], v0[3]); w.z = pk2(v1[0], v1[1]); w.w = pk2(v1[2], v1[3]); xb[i] = w; }
}

template <bool DRY>
__device__ __forceinline__ void phase_ln1_router(const Frame& F, ArgsP a, int l) {
    const bf16* X1 = (const bf16*)(a->ws + WS_X1); bf16* XB = (bf16*)(a->ws + WS_XB); unsigned char* XB8 = a->ws + WS_H;
    const float* WR = (const float*)(WLBASE(a->ws, l) + WL_WR);
    const float* lw = a->in[14] + (size_t)l * DM; const float* lb = a->in[15] + (size_t)l * DM;
    const float* bg = a->in[19] + l * 4; const float* be = a->in[21] + l * NEXP;
    int* route_e = (int*)(a->ws + WS_SLOT + SL_RE); int* route_p = (int*)(a->ws + WS_SLOT + SL_RP); float* route_w = (float*)(a->ws + WS_SLOT + SL_RW);
    unsigned* cnt = F.ctl + CW_CNT + (DRY ? l + 4 : l) * 512;
    const int gw = F.bid * NWAVES + F.wave, NGW = F.G * NWAVES, lane = F.lane;
    LAS float* wgl = (LAS float*)F.lds;
    for (int i = F.tid; i < 4 * DM; i += NTHR) wgl[i] = WR[i];
    __syncthreads();
    const float bg0 = bg[0], bg1 = bg[1], bg2 = bg[2], bg3 = bg[3];
    for (int tg = gw; tg < T / 4; tg += NGW) {
        f32x4 v[4][4];
#pragma unroll
        for (int tk = 0; tk < 4; ++tk) { const u32x2* row = (const u32x2*)(X1 + (size_t)(4 * tg + tk) * DM) + lane;
            u32x2 raw[4];
#pragma unroll
            for (int j = 0; j < 4; ++j) raw[j] = row[64 * j];
#pragma unroll
            for (int j = 0; j < 4; ++j) { v[tk][j][0] = bf2f(raw[j].x & 0xffffu); v[tk][j][1] = __uint_as_float(raw[j].x & 0xffff0000u); v[tk][j][2] = bf2f(raw[j].y & 0xffffu); v[tk][j][3] = __uint_as_float(raw[j].y & 0xffff0000u); } }
#pragma unroll
        for (int tk = 0; tk < 4; ++tk) {
            float s = 0.f;
#pragma unroll
            for (int j = 0; j < 4; ++j) s += (v[tk][j][0] + v[tk][j][1]) + (v[tk][j][2] + v[tk][j][3]);
            const float mean = wave_sum(s) * (1.f / DM); float q = 0.f;
#pragma unroll
            for (int j = 0; j < 4; ++j) { v[tk][j] = v[tk][j] - mean; q += (v[tk][j][0] * v[tk][j][0] + v[tk][j][1] * v[tk][j][1]) + (v[tk][j][2] * v[tk][j][2] + v[tk][j][3] * v[tk][j][3]); }
            const float rstd = 1.f / sqrtf(wave_sum(q) * (1.f / DM) + LN_EPS);
            u32x2* brow = (u32x2*)(XB + (size_t)(4 * tg + tk) * DM) + lane;
#pragma unroll
            for (int j = 0; j < 4; ++j) { const f32x4 w4 = ((const f32x4*)lw)[lane + 64 * j], b4 = ((const f32x4*)lb)[lane + 64 * j];
                v[tk][j] = v[tk][j] * rstd * w4 + b4;
                u32x2 w; w.x = pk2(v[tk][j][0], v[tk][j][1]); w.y = pk2(v[tk][j][2], v[tk][j][3]); if (!DRY) brow[64 * j] = w;
                int w8 = 0; w8 = __builtin_amdgcn_cvt_pk_fp8_f32(v[tk][j][0], v[tk][j][1], w8, false); w8 = __builtin_amdgcn_cvt_pk_fp8_f32(v[tk][j][2], v[tk][j][3], w8, true);
                if (!DRY) ((int*)(XB8 + (size_t)(4 * tg + tk) * DM))[lane + 64 * j] = w8; }
        }
        float glg[4][4];
#pragma unroll
        for (int j = 0; j < 4; ++j) { const LAS f32x4* wr = (const LAS f32x4*)(wgl + j * DM) + lane; const f32x4 w0 = wr[0], w1 = wr[64], w2 = wr[128], w3 = wr[192];
#pragma unroll
            for (int tk = 0; tk < 4; ++tk) { f32x4 p = v[tk][0] * w0; p = p + v[tk][1] * w1; p = p + v[tk][2] * w2; p = p + v[tk][3] * w3; glg[tk][j] = wave_sum((p[0] + p[1]) + (p[2] + p[3])); } }
        int my_e = 0; float my_w = 0.f;
#pragma unroll
        for (int tk = 0; tk < 4; ++tk) {
            const float g0 = glg[tk][0] + bg0, g1 = glg[tk][1] + bg1, g2 = glg[tk][2] + bg2, g3 = glg[tk][3] + bg3;
            int gi = 0; float gm = g0; if (g1 > gm) { gm = g1; gi = 1; } if (g2 > gm) { gm = g2; gi = 2; } if (g3 > gm) { gm = g3; gi = 3; }
            gi = __builtin_amdgcn_readfirstlane(gi);
            const float g_w = 1.f / (__expf(g0 - gm) + __expf(g1 - gm) + __expf(g2 - gm) + __expf(g3 - gm));
            const float* wbase = WR + (size_t)(4 + gi * 8) * DM; float ev[8];
#pragma unroll
            for (int i4 = 0; i4 < 2; ++i4) { f32x4 w[4][4];
#pragma unroll
                for (int i = 0; i < 4; ++i) { const f32x4* wr = (const f32x4*)(wbase + (size_t)(4 * i4 + i) * DM) + lane; w[i][0] = wr[0]; w[i][1] = wr[64]; w[i][2] = wr[128]; w[i][3] = wr[192]; }
#pragma unroll
                for (int i = 0; i < 4; ++i) { f32x4 p = v[tk][0] * w[i][0]; p = p + v[tk][1] * w[i][1]; p = p + v[tk][2] * w[i][2]; p = p + v[tk][3] * w[i][3];
                    ev[4 * i4 + i] = wave_sum((p[0] + p[1]) + (p[2] + p[3])) + be[gi * 8 + 4 * i4 + i]; } }
            int i1 = 0; float v1 = ev[0];
#pragma unroll
            for (int i = 1; i < 8; ++i) if (ev[i] > v1) { v1 = ev[i]; i1 = i; }
            int i2 = -1; float v2 = -3.0e38f;
#pragma unroll
            for (int i = 0; i < 8; ++i) if (i != i1 && ev[i] > v2) { v2 = ev[i]; i2 = i; }
            const float e2 = __expf(v2 - v1), w1 = g_w / (1.f + e2), w2 = g_w - w1;
            if (lane == 2 * tk) { my_e = gi * 8 + i1; my_w = w1; }
            if (lane == 2 * tk + 1) { my_e = gi * 8 + i2; my_w = w2; }
        }
        if (lane < 8) {
            const unsigned pos = __hip_atomic_fetch_add(cnt + my_e * 16, 1u, __ATOMIC_RELAXED, __HIP_MEMORY_SCOPE_AGENT);
            const size_t si = (size_t)tg * 8 + lane; if (!DRY) { route_e[si] = my_e; route_p[si] = (int)pos; route_w[si] = my_w; }
        }
    }
    __syncthreads();
}

__device__ __forceinline__ void phase_gather(const Frame& F, ArgsP a, int l) {
    LAS int* pstart = (LAS int*)F.lds;
    unsigned* cnt = F.ctl + CW_CNT + l * 512;
    int* meta = (int*)(a->ws + WS_META) + l * 512;
    int* slot_tok = (int*)(a->ws + WS_SLOT + SL_TOK); float* slot_w = (float*)(a->ws + WS_SLOT + SL_W);
    const int* route_e = (const int*)(a->ws + WS_SLOT + SL_RE); const int* route_p = (const int*)(a->ws + WS_SLOT + SL_RP); const float* route_w = (const float*)(a->ws + WS_SLOT + SL_RW);
    if (F.tid < 64) {
        const int c = F.tid < 32 ? (int)__hip_atomic_load(cnt + F.tid * 16, __ATOMIC_RELAXED, __HIP_MEMORY_SCOPE_AGENT) : 0;
        const int pad = (c + 255) & ~255; int inc = pad;
#pragma unroll
        for (int o = 1; o < 64; o <<= 1) { const int t = __shfl_up(inc, o); if (F.lane >= o) inc += t; }
        const int st = inc - pad;
        if (F.tid < 32) { pstart[F.tid] = st;
            if (F.bid == 0) { for (int t = st >> 8; t < (st + pad) >> 8; ++t) meta[64 + t] = F.tid; if (F.tid == 31) meta[0] = (st + pad) >> 8; }
            if ((F.tid % F.G) == F.bid) for (int r = st + c; r < st + pad; ++r) { slot_tok[r] = -1; slot_w[r] = 0.f; }
        }
    }
    __syncthreads();
    for (int s = F.bid * NTHR + F.tid; s < T * 2; s += F.G * NTHR) {
        const int dest = pstart[route_e[s]] + route_p[s]; slot_tok[dest] = s; slot_w[dest] = route_w[s];
    }
    __syncthreads();
}

__device__ __forceinline__ void phase_ln2(const Frame& F, ArgsP a, int l) {
    const bf16* Y2 = (const bf16*)(a->ws + WS_Y2); bf16* XB = (bf16*)(a->ws + WS_XB); float* out = a->out;
    const float* lw = a->in[16] + (size_t)l * DM; const float* lb = a->in[17] + (size_t)l * DM;
    const int gw = F.bid * NWAVES + F.wave, NGW = F.G * NWAVES, lane = F.lane; const bool last = (l == NL - 1);
    for (int t0 = 2 * gw; t0 < T; t0 += 2 * NGW) {
        u32x2 xr[2][4], pa[2][4], pb[2][4];
#pragma unroll
        for (int u = 0; u < 2; ++u) { const int t = t0 + u; const u32x2* x_ = (const u32x2*)(XB + (size_t)t * DM) + lane; const u32x2* a_ = (const u32x2*)(Y2 + (size_t)(2 * t) * DM) + lane; const u32x2* b_ = (const u32x2*)(Y2 + (size_t)(2 * t + 1) * DM) + lane;
#pragma unroll
            for (int j = 0; j < 4; ++j) { xr[u][j] = x_[64 * j]; pa[u][j] = a_[64 * j]; pb[u][j] = b_[64 * j]; } }
#pragma unroll
        for (int u = 0; u < 2; ++u) { const int t = t0 + u;
            f32x4 v[4]; float s = 0.f;
#pragma unroll
            for (int j = 0; j < 4; ++j) { const u32x2 x = xr[u][j], p = pa[u][j], q = pb[u][j];
                v[j][0] = bf2f(x.x & 0xffffu) * DN_ALPHA + (bf2f(p.x & 0xffffu) + bf2f(q.x & 0xffffu)); v[j][1] = bf2f(x.x >> 16) * DN_ALPHA + (bf2f(p.x >> 16) + bf2f(q.x >> 16));
                v[j][2] = bf2f(x.y & 0xffffu) * DN_ALPHA + (bf2f(p.y & 0xffffu) + bf2f(q.y & 0xffffu)); v[j][3] = bf2f(x.y >> 16) * DN_ALPHA + (bf2f(p.y >> 16) + bf2f(q.y >> 16));
                s += (v[j][0] + v[j][1]) + (v[j][2] + v[j][3]); }
            const float mean = wave_sum(s) * (1.f / DM); float q2 = 0.f;
#pragma unroll
            for (int j = 0; j < 4; ++j) { v[j] = v[j] - mean; q2 += (v[j][0] * v[j][0] + v[j][1] * v[j][1]) + (v[j][2] * v[j][2] + v[j][3] * v[j][3]); }
            const float rstd = 1.f / sqrtf(wave_sum(q2) * (1.f / DM) + LN_EPS);
            f32x4* orow = (f32x4*)(out + (size_t)t * DM) + lane; u32x2* brow = (u32x2*)(XB + (size_t)t * DM) + lane;
#pragma unroll
            for (int j = 0; j < 4; ++j) { const f32x4 w4 = ((const f32x4*)lw)[lane + 64 * j], b4 = ((const f32x4*)lb)[lane + 64 * j];
                const f32x4 o = v[j] * rstd * w4 + b4; if (last) orow[64 * j] = o; u32x2 w; w.x = pk2(o[0], o[1]); w.y = pk2(o[2], o[3]); brow[64 * j] = w; } }
    }
}

__device__ __forceinline__ int tsw(int row, int col) { return row * 128 + ((((col >> 3) ^ (row >> 1)) & 7) << 4) + ((col & 7) << 1); }
__device__ __forceinline__ f32x4 mfma16(bf16x8 a, bf16x8 b, f32x4 c) { return __builtin_amdgcn_mfma_f32_16x16x32_bf16(a, b, c, 0, 0, 0); }
__device__ __forceinline__ f32x16 mfma32(bf16x8 a, bf16x8 b, f32x16 c) { return __builtin_amdgcn_mfma_f32_32x32x16_bf16(a, b, c, 0, 0, 0); }
__device__ __forceinline__ bf16x8 as_bf16x8(u32x4 v) { return __builtin_bit_cast(bf16x8, v); }

__device__ __forceinline__ void conformer_item(const Frame& F, ArgsP a, int l, int it) {
    const int b = it >> 6, s0 = (it & 63) * 64; const size_t tok0 = (size_t)b * SEQ + s0;
    const bf16* H = (const bf16*)(a->ws + WS_H); bf16* Y = (bf16*)(a->ws + WS_Y);
    LAS bf16* ut = (LAS bf16*)F.lds;
    LAS float* co = (LAS float*)(F.lds + 49152);
    for (int idx = F.tid; idx < 94 * 32; idx += NTHR) {
        const int r = idx >> 5, c8 = (idx & 31) * 8, s = s0 - 30 + r; u32x4 w = {0u, 0u, 0u, 0u};
        if (s >= 0) { const bf16* hp = H + ((size_t)b * SEQ + s) * HLD + 2304 + c8; const u32x4 v = *(const u32x4*)hp, g = *(const u32x4*)(hp + 256);
#pragma unroll
            for (int e = 0; e < 4; ++e) { const float v0 = bf2f(v[e] & 0xffffu) * fsigmoid(bf2f(g[e] & 0xffffu)), v1 = bf2f(v[e] >> 16) * fsigmoid(bf2f(g[e] >> 16)); w[e] = pk2(v0, v1); } }
        *(LAS u32x4*)(ut + r * 256 + c8) = w;
    }
    __syncthreads();
    {
        const int c = F.tid & 255, half = F.tid >> 8; const float* dw = a->in[10] + (size_t)l * 31 * 256 + c; const float bias = a->in[11][l * 256 + c];
        float w[31], ur[62];
#pragma unroll
        for (int k = 0; k < 31; ++k) w[k] = dw[k * 256];
#pragma unroll
        for (int i = 0; i < 62; ++i) ur[i] = bf2f(ut[(32 * half + i) * 256 + c]);
#pragma unroll
        for (int tt = 0; tt < 32; ++tt) { float acc = bias;
#pragma unroll
            for (int k = 0; k < 31; ++k) acc += w[k] * ur[tt + k];
            co[(32 * half + tt) * 256 + c] = acc; }
    }
    __syncthreads();
    {
        const float* lw = a->in[12] + l * 256; const float* lb = a->in[13] + l * 256; const f32x4 w4 = ((const f32x4*)lw)[F.lane], b4 = ((const f32x4*)lb)[F.lane];
#pragma unroll
        for (int i = 0; i < 8; ++i) { const int tl = 8 * F.wave + i; f32x4 v = *(LAS f32x4*)(co + tl * 256 + 4 * F.lane);
            const float mean = wave_sum((v[0] + v[1]) + (v[2] + v[3])) * (1.f / 256.f); v = v - mean;
            const float rstd = 1.f / sqrtf(wave_sum((v[0] * v[0] + v[1] * v[1]) + (v[2] * v[2] + v[3] * v[3])) * (1.f / 256.f) + LN_EPS);
            v = v * rstd * w4 + b4; u32x2 o; o.x = pk2(fsilu(v[0]), fsilu(v[1])); o.y = pk2(fsilu(v[2]), fsilu(v[3]));
            *(u32x2*)(Y + (tok0 + tl) * DM + 768 + 4 * F.lane) = o; }
    }
    __syncthreads();
}

__device__ __forceinline__ void compress_item(const Frame& F, ArgsP a, int l, int it) {
    const int kv = it >> 7, bh = (it >> 3) & 15, b = bh >> 1, hh = bh & 1, i0 = (it & 7) * 32;
    const bf16* H = (const bf16*)(a->ws + WS_H); const bf16* w1t = (const bf16*)(WLBASE(a->ws, l) + WL_W1) + (size_t)kv * 128 * 2048; const bf16* w2t = (const bf16*)(WLBASE(a->ws, l) + WL_W2) + (size_t)kv * 64 * 128;
    const float* bias1 = (const float*)(WLBASE(a->ws, l) + WL_BIAS1) + kv * 128; bf16* outp = (bf16*)(a->ws + (kv ? WS_VC : WS_KC)) + (size_t)bh * 256 * 64;
    LAS bf16* hid = (LAS bf16*)F.lds;
    const int lane = F.lane, li = lane & 15, g = lane >> 4, rt = F.wave & 1, cq = F.wave >> 1;
    const int i = i0 + 16 * rt + li; const bf16* arow = H + (size_t)b * SEQ * HLD + 512 + kv * 128 + hh * 64 + 8 * g;
    const bf16* brow = w1t + (size_t)(32 * cq + li) * 2048 + 8 * g;
    f32x4 acc[2] = {{0.f, 0.f, 0.f, 0.f}, {0.f, 0.f, 0.f, 0.f}};
#pragma unroll 1
    for (int k8 = 0; k8 < 64; k8 += 8) {
        bf16x8 af[8], bfr[8][2];
#pragma unroll
        for (int u = 0; u < 8; ++u) { const int ks = k8 + u; int s = 16 * i + (ks >> 1); s = s > SEQ - 1 ? SEQ - 1 : s;
            af[u] = *(const bf16x8*)(arow + (size_t)s * HLD + (ks & 1) * 32); bfr[u][0] = *(const bf16x8*)(brow + ks * 32); bfr[u][1] = *(const bf16x8*)(brow + (size_t)16 * 2048 + ks * 32); }
#pragma unroll
        for (int u = 0; u < 8; ++u) { acc[0] = mfma16(af[u], bfr[u][0], acc[0]); acc[1] = mfma16(af[u], bfr[u][1], acc[1]); }
    }
#pragma unroll
    for (int nt = 0; nt < 2; ++nt) { const int n = 32 * cq + 16 * nt + li; const float bs = bias1[n];
#pragma unroll
        for (int r = 0; r < 4; ++r) hid[(16 * rt + 4 * g + r) * 136 + n] = (bf16)f2bf(fsilu(acc[nt][r] + bs)); }
    __syncthreads();
    f32x4 o2 = {0.f, 0.f, 0.f, 0.f};
#pragma unroll
    for (int ks = 0; ks < 4; ++ks) { const bf16x8 af = *(LAS bf16x8*)(hid + (16 * rt + li) * 136 + 32 * ks + 8 * g);
        const bf16x8 bfr = *(const bf16x8*)(w2t + (size_t)(16 * cq + li) * 128 + 32 * ks + 8 * g); o2 = mfma16(af, bfr, o2); }
#pragma unroll
    for (int r = 0; r < 4; ++r) { const int io = i0 + 16 * rt + 4 * g + r; outp[(size_t)io * 64 + 16 * cq + li] = (bf16)(io < 255 ? f2bf_sw(o2[r]) : 0u); }
    __syncthreads();
}

__host__ __device__ constexpr int tri_off(int i) { int s = 0; for (int k = 0; k < i; ++k) s += (k + 3) >> 2; return 4 * s; }
__device__ __forceinline__ int tri_off_rt(int i) { const int m = i - 1, V = (m + 3) >> 2; return i <= 0 ? 0 : 4 * (2 * V * (V - 1) + V * (m - 4 * V + 4)); }

template <int I> struct GdnSolveRow {
    __device__ static __forceinline__ void run(const LAS float* Ap, float (&x)[64]) {
        if constexpr (I < 64) {
            constexpr int off = tri_off(I), nb = (I + 3) >> 2;
            float s4[4] = {0.f, 0.f, 0.f, 0.f};
#pragma unroll
            for (int jb = 0; jb < nb; ++jb) { const f32x4 a4 = *(const LAS f32x4*)(Ap + off + 4 * jb);
#pragma unroll
                for (int jj = 0; jj < 4; ++jj) { if (4 * jb + jj < I) s4[jj] += a4[jj] * x[4 * jb + jj]; } }
            x[I] -= (s4[0] + s4[1]) + (s4[2] + s4[3]);
            if constexpr ((I & 3) == 3) SBAR();
            GdnSolveRow<I + 1>::run(Ap, x);
        }
    }
};

template <int GV>
__device__ __forceinline__ void gdn_prep_chunk(const Frame& F, ArgsP a, int l, int ci, LAS unsigned char* wl) {
    int lane_ = F.lane; asm volatile("" : "+v"(lane_));
    const int lane = lane_, li = lane & 15, g = lane >> 4; const int bh = ci >> 6, n = ci & 63, b = bh >> 2, h = bh & 3; const size_t tok0 = (size_t)b * SEQ + 64 * n;
    const bf16* H = (const bf16*)(a->ws + WS_H); const float* side = (const float*)(a->ws + WS_SIDE);
    unsigned char* rec = a->ws + ((GV & 1) ? WS_Y2 : WS_GPREP) + (size_t)ci * GCH;
    bf16* R0 = (bf16*)(rec + GC_UT); bf16* R1 = (bf16*)(rec + GC_W); bf16* QKm = (bf16*)(rec + GC_QK); bf16* QD = (bf16*)(rec + GC_QD); bf16* KDT = (bf16*)(rec + GC_KDT); bf16* ZT = (bf16*)(rec + GC_ZT);
    const int pc = (lane & 32) | (((lane & 15) >> 2) << 3) | (((lane >> 4) & 1) << 2) | (lane & 3);
    LAS unsigned char* qt = wl; LAS unsigned char* kt = wl + 8192; LAS float* Ap = (LAS float*)wl;
    const float beta = side[(tok0 + lane) * 32 + 24 + h]; const float av = side[(tok0 + lane) * 32 + 28 + h] + a->in[8][l * 4 + h];
    const float sp = av > 20.f ? av : log1pf(__expf(av)); float gc = -__expf(a->in[7][l * 4 + h]) * sp;
#pragma unroll
    for (int o = 1; o < 64; o <<= 1) { const float t = __shfl_up(gc, o); if (lane >= o) gc += t; }
    const float gl = __shfl(gc, 63); const float eg = __expf(gc), ekd = __expf(gl - gc);
    if (lane == 0 && !(GV & 1)) ((float*)(a->ws + WS_GL))[ci] = __expf(gl);
    const float* cw = a->in[6] + (size_t)l * 4 * 768 + h * 64 + lane; float wq[4], wk[4], wv[4];
#pragma unroll
    for (int k = 0; k < 4; ++k) { wq[k] = cw[k * 768]; wk[k] = cw[k * 768 + 256]; wv[k] = cw[k * 768 + 512]; }
    const bf16* hp = H + tok0 * HLD + 1280 + h * 64 + lane; float hq[3], hk[3], hv[3];
#pragma unroll
    for (int j = 0; j < 3; ++j) { const bool ok = (64 * n - 3 + j) >= 0; const bf16* p = hp + (ptrdiff_t)(j - 3) * HLD;
        hq[j] = ok ? bf2f(p[0]) : 0.f; hk[j] = ok ? bf2f(p[256]) : 0.f; hv[j] = ok ? bf2f(p[512]) : 0.f; }
    unsigned short ra[8][4], rb[8][4]; const float nwl = a->in[9][l * 64 + lane];
#define GDN_LOADBLK(dst, t8_) do { const bf16* pl_ = hp + (size_t)(8 * (t8_)) * HLD; asm volatile("" : "+v"(pl_)); _Pragma("unroll") for (int tt = 0; tt < 8; ++tt) { const bf16* q_ = pl_ + (size_t)tt * HLD; dst[tt][0] = q_[0]; dst[tt][1] = q_[256]; dst[tt][2] = q_[512]; dst[tt][3] = q_[768]; } } while (0)
#define GDN_CONVBLK(src, t8_) do { const int t8 = (t8_); unsigned kdp[4], zp[4]; \
        bf16* qd8 = QD + (8 * t8) * 64 + pc; bf16* r08 = R0 + (8 * t8) * 64 + lane; bf16* r18 = R1 + (8 * t8) * 64 + lane; asm volatile("" : "+v"(qd8), "+v"(r08), "+v"(r18)); \
        _Pragma("unroll") for (int tt = 0; tt < 8; ++tt) { const int t = 8 * t8 + tt; \
            const float rq = bf2f(src[tt][0]), rk = bf2f(src[tt][1]), rv = bf2f(src[tt][2]); \
            const float cq = wq[0] * hq[0] + wq[1] * hq[1] + wq[2] * hq[2] + wq[3] * rq, ck = wk[0] * hk[0] + wk[1] * hk[1] + wk[2] * hk[2] + wk[3] * rk, cv = wv[0] * hv[0] + wv[1] * hv[1] + wv[2] * hv[2] + wv[3] * rv; \
            hq[0] = hq[1]; hq[1] = hq[2]; hq[2] = rq; hk[0] = hk[1]; hk[1] = hk[2]; hk[2] = rk; hv[0] = hv[1]; hv[1] = hv[2]; hv[2] = rv; \
            const float qs = fsilu(cq), ks_ = fsilu(ck), vs = fsilu(cv); \
            const float qn = qs * __builtin_amdgcn_rsqf(wave_sum(qs * qs) + 1e-6f) * 0.125f, kn = ks_ * __builtin_amdgcn_rsqf(wave_sum(ks_ * ks_) + 1e-6f); \
            const float bt = __int_as_float(__builtin_amdgcn_readlane(__float_as_int(beta), t)), egt = __int_as_float(__builtin_amdgcn_readlane(__float_as_int(eg), t)), ekt = __int_as_float(__builtin_amdgcn_readlane(__float_as_int(ekd), t)); \
            *(LAS bf16*)(qt + tsw(t, lane)) = (bf16)f2bf(qn); *(LAS bf16*)(kt + tsw(t, lane)) = (bf16)f2bf(kn); \
            qd8[tt * 64] = (bf16)f2bf(qn * egt); r08[tt * 64] = (bf16)f2bf(bt * vs); r18[tt * 64] = (bf16)f2bf(bt * egt * kn); \
            const unsigned kd = f2bf(kn * ekt); if (tt & 1) kdp[tt >> 1] |= kd << 16; else kdp[tt >> 1] = kd; \
            const unsigned zg = f2bf(fsilu(bf2f(src[tt][3])) * nwl); if (tt & 1) zp[tt >> 1] |= zg << 16; else zp[tt >> 1] = zg; } \
        { u32x4 wz; wz.x = zp[0]; wz.y = zp[1]; wz.z = zp[2]; wz.w = zp[3]; *(u32x4*)(ZT + lane * 64 + 8 * t8) = wz; } \
        { const int c0 = (8 * t8) & 31, gg = (c0 & 15) >> 2, hh = c0 >> 4; bf16* kr = KDT + lane * 64 + ((8 * t8) & 32) + 4 * hh; \
          u32x2 w0, w1; w0.x = kdp[0]; w0.y = kdp[1]; w1.x = kdp[2]; w1.y = kdp[3]; *(u32x2*)(kr + 8 * gg) = w0; *(u32x2*)(kr + 8 * gg + 8) = w1; } } while (0)
    if (!(GV & 2)) {
    GDN_LOADBLK(ra, 0);
#pragma unroll 1
    for (int t16 = 0; t16 < 4; ++t16) {
        GDN_LOADBLK(rb, 2 * t16 + 1);
        GDN_CONVBLK(ra, 2 * t16);
        if (t16 < 3) GDN_LOADBLK(ra, 2 * t16 + 2);
        GDN_CONVBLK(rb, 2 * t16 + 1);
    }
    }
#undef GDN_LOADBLK
#undef GDN_CONVBLK
    LDS_WAIT();
    if (!(GV & 4)) {
    float gcj[4][4];
#pragma unroll
    for (int mt = 0; mt < 4; ++mt)
#pragma unroll
        for (int r = 0; r < 4; ++r) gcj[mt][r] = __shfl(gc, 16 * mt + 4 * g + r);
    f32x4 ahold[4][4];
#pragma unroll
    for (int nt = 0; nt < 4; ++nt) {
        const int i = 16 * nt + li; const float gci = __shfl(gc, i), bi = __shfl(beta, i);
        bf16x8 kB[2], qB[2];
#pragma unroll
        for (int ks = 0; ks < 2; ++ks) { kB[ks] = *(LAS bf16x8*)(kt + tsw(i, 32 * ks + 8 * g)); qB[ks] = *(LAS bf16x8*)(qt + tsw(i, 32 * ks + 8 * g)); }
#pragma unroll
        for (int mt = 0; mt < 4; ++mt) {
            u32x2 qw = {0u, 0u};
            if (mt <= nt) {
                const bf16x8 kA0 = *(LAS bf16x8*)(kt + tsw(16 * mt + li, 8 * g)), kA1 = *(LAS bf16x8*)(kt + tsw(16 * mt + li, 32 + 8 * g));
                f32x4 ckk = {0.f, 0.f, 0.f, 0.f}, cqk = {0.f, 0.f, 0.f, 0.f};
                ckk = mfma16(kA0, kB[0], ckk); ckk = mfma16(kA1, kB[1], ckk); cqk = mfma16(kA0, qB[0], cqk); cqk = mfma16(kA1, qB[1], cqk);
                float qv[4];
#pragma unroll
                for (int r = 0; r < 4; ++r) { const int j = 16 * mt + 4 * g + r; const float dec = __expf(fminf(gci - gcj[mt][r], 0.f));
                    ahold[nt][mt][r] = bi * ckk[r] * dec; qv[r] = (j <= i) ? cqk[r] * dec : 0.f; }
                qw.x = pk2(qv[0], qv[1]); qw.y = pk2(qv[2], qv[3]);
            }
            *(u32x2*)(QKm + i * 64 + 32 * (mt >> 1) + 8 * g + 4 * (mt & 1)) = qw;
        }
    }
    LDS_WAIT(); SBAR();
#pragma unroll
    for (int nt = 0; nt < 4; ++nt) { const int i = 16 * nt + li; const int ro = tri_off_rt(i);
#pragma unroll
        for (int mt = 0; mt < 4; ++mt) if (mt <= nt) {
#pragma unroll
            for (int r = 0; r < 4; ++r) { const int j = 16 * mt + 4 * g + r; if (j < i) Ap[ro + j] = ahold[nt][mt][r]; } } }
    }
    VM_WAIT(); LDS_WAIT();
#pragma unroll 1
    for (int pass = 0; pass < 2; ++pass) {
        bf16* Rp = pass ? R1 : R0; float x[64];
#pragma unroll
        for (int i = 0; i < 64; ++i) x[i] = bf2f(Rp[i * 64 + lane]);
        VM_WAIT();
        if (!(GV & 8)) GdnSolveRow<1>::run(Ap, x);
        if (pass == 0) {
#pragma unroll
            for (int i8 = 0; i8 < 8; ++i8) { u32x4 w; w.x = pk2(x[8 * i8], x[8 * i8 + 1]); w.y = pk2(x[8 * i8 + 2], x[8 * i8 + 3]); w.z = pk2(x[8 * i8 + 4], x[8 * i8 + 5]); w.w = pk2(x[8 * i8 + 6], x[8 * i8 + 7]);
                *(u32x4*)(Rp + lane * 64 + 8 * i8) = w; }
        } else {
#pragma unroll
            for (int i = 0; i < 64; ++i) Rp[i * 64 + pc] = (bf16)f2bf(x[i]);
        }
    }
    LDS_WAIT();
}

__device__ __forceinline__ bf16x8 scan_frag(const unsigned char* mat, int mt, int ks, int li, int g) { return *(const bf16x8*)(mat + (16 * mt + li) * 128 + (32 * ks + 8 * g) * 2); }
__device__ __forceinline__ bf16x8 pack_c2(f32x4 a, f32x4 b) { u32x4 w; w.x = pk2(a[0], a[1]); w.y = pk2(a[2], a[3]); w.z = pk2(b[0], b[1]); w.w = pk2(b[2], b[3]); return as_bf16x8(w); }
constexpr int SC_SLOT = 24576;
__device__ __forceinline__ void scan_dma(LAS unsigned char* slot, const unsigned char* rec, int sl, int lane) {
#pragma unroll
    for (int m = 0; m < 3; ++m) { const int goff = (m == 0) ? GC_W : (m == 1 ? GC_KDT : GC_UT);
#pragma unroll
        for (int i = 0; i < 2; ++i) { const int row = 16 * sl + 8 * i + (lane >> 3), ch = (lane & 7) ^ ((row >> 1) & 7);
            __builtin_amdgcn_global_load_lds((const unsigned*)(rec + goff + row * 128 + ch * 16), (LAS unsigned*)(slot + m * 8192 + (16 * sl + 8 * i) * 128), 16, 0, 0); } }
}
__device__ __forceinline__ bf16x8 scan_lfrag(const LAS unsigned char* mat, int mt, int ks, int li, int g) { const int row = 16 * mt + li; return *(const LAS bf16x8*)(mat + row * 128 + ((((4 * ks + g) ^ (row >> 1)) & 7) << 4)); }
template <int SV>
__device__ __forceinline__ void gdn_scan(const Frame& F, ArgsP a, int l) {
    const int lane = F.lane, li = lane & 15, g = lane >> 4, pr = F.wave >> 2, sl = F.wave & 3; const int bh = F.bid * 2 + pr, dv0 = 16 * sl;
    const float* GL = (const float*)(a->ws + WS_GL) + bh * 64; unsigned char* rec0 = a->ws + WS_GPREP + (size_t)bh * 64 * GCH;
    LAS unsigned char* ring = F.lds + pr * (3 * SC_SLOT);
    f32x4 S[4] = {{0.f, 0.f, 0.f, 0.f}, {0.f, 0.f, 0.f, 0.f}, {0.f, 0.f, 0.f, 0.f}, {0.f, 0.f, 0.f, 0.f}};
    const float glv = GL[lane];
    asm volatile("s_waitcnt vmcnt(0)" ::: "memory");
    scan_dma(ring, rec0, sl, lane); scan_dma(ring + SC_SLOT, rec0 + GCH, sl, lane);
#pragma unroll 1
    for (int n = 0; n < 64; ++n) {
        unsigned char* rn = rec0 + (size_t)n * GCH; const LAS unsigned char* slot = ring + (n % 3) * SC_SLOT;
        if (n == 0) asm volatile("s_waitcnt vmcnt(6)" ::: "memory"); else if (n == 1) asm volatile("s_waitcnt vmcnt(10)" ::: "memory");
        else if (n == 63) asm volatile("s_waitcnt vmcnt(8)" ::: "memory"); else asm volatile("s_waitcnt vmcnt(14)" ::: "memory");
        __builtin_amdgcn_s_barrier(); asm volatile("" ::: "memory");
        if (n + 2 < 64) scan_dma(ring + ((n + 2) % 3) * SC_SLOT, rn + 2 * (size_t)GCH, sl, lane);
        else { asm volatile("" ::: "memory"); }
        const float egl = __int_as_float(__builtin_amdgcn_readlane(__float_as_int(glv), n));
        const bf16x8 Sb0 = pack_c2(S[0], S[1]), Sb1 = pack_c2(S[2], S[3]);
        if (!(SV & 1)) { bf16x8* ss = (bf16x8*)(rn + GC_SS + sl * 2048) + lane; ss[0] = Sb0; ss[64] = Sb1; }
        f32x4 vn[4];
#pragma unroll
        for (int mt = 0; mt < 4; ++mt) {
            f32x4 acc = {0.f, 0.f, 0.f, 0.f};
            acc = mfma16(scan_lfrag(slot, mt, 0, li, g), Sb0, acc); acc = mfma16(scan_lfrag(slot, mt, 1, li, g), Sb1, acc);
            const int urow = dv0 + li; const u32x2 uu = *(const LAS u32x2*)(slot + 16384 + urow * 128 + (((((16 * mt + 4 * g) >> 3) ^ (urow >> 1)) & 7) << 4) + (((16 * mt + 4 * g) & 7) << 1));
            vn[mt][0] = bf2f(uu.x & 0xffffu) - acc[0]; vn[mt][1] = bf2f(uu.x >> 16) - acc[1]; vn[mt][2] = bf2f(uu.y & 0xffffu) - acc[2]; vn[mt][3] = bf2f(uu.y >> 16) - acc[3];
        }
        const bf16x8 Vb0 = pack_c2(vn[0], vn[1]), Vb1 = pack_c2(vn[2], vn[3]);
        if (!(SV & 1)) { bf16x8* vb = (bf16x8*)(rn + GC_VB + sl * 2048) + lane; vb[0] = Vb0; vb[64] = Vb1; }
#pragma unroll
        for (int mt = 0; mt < 4; ++mt) { f32x4 acc = S[mt] * egl; acc = mfma16(scan_lfrag(slot + 8192, mt, 0, li, g), Vb0, acc); acc = mfma16(scan_lfrag(slot + 8192, mt, 1, li, g), Vb1, acc); S[mt] = acc; }
        if ((SV & 1) || n + 2 >= 64) { }
    }
    asm volatile("s_waitcnt vmcnt(0)" ::: "memory"); asm volatile("" :: "v"(S[0][0]), "v"(S[1][1]), "v"(S[2][2]), "v"(S[3][3]));
    __syncthreads();
}

__device__ __forceinline__ void gdn_out_chunk(const Frame& F, ArgsP a, int ci, LAS unsigned char* wl) {
    int lane_ = F.lane; asm volatile("" : "+v"(lane_)); const int lane = lane_, li = lane & 15, g = lane >> 4; const int bh = ci >> 6, n = ci & 63, b = bh >> 2, h = bh & 3;
    const unsigned char* rec = a->ws + WS_GPREP + (size_t)ci * GCH; bf16* Y = (bf16*)(a->ws + WS_Y);
    bf16x8 QDf[4][2], QKf[4][2];
#pragma unroll
    for (int mt = 0; mt < 4; ++mt) { QDf[mt][0] = scan_frag(rec + GC_QD, mt, 0, li, g); QDf[mt][1] = scan_frag(rec + GC_QD, mt, 1, li, g); QKf[mt][0] = scan_frag(rec + GC_QK, mt, 0, li, g); QKf[mt][1] = scan_frag(rec + GC_QK, mt, 1, li, g); }
    float ssq[4][4];
#pragma unroll
    for (int mt = 0; mt < 4; ++mt)
#pragma unroll
        for (int r = 0; r < 4; ++r) ssq[mt][r] = 0.f;
    f32x4 o[4][4];
#pragma unroll
    for (int sl = 0; sl < 4; ++sl) {
        const bf16x8* ss = (const bf16x8*)(rec + GC_SS + sl * 2048) + lane; const bf16x8* vb = (const bf16x8*)(rec + GC_VB + sl * 2048) + lane;
        const bf16x8 Sb0 = ss[0], Sb1 = ss[64], Vb0 = vb[0], Vb1 = vb[64];
#pragma unroll
        for (int mt = 0; mt < 4; ++mt) {
            f32x4 acc = {0.f, 0.f, 0.f, 0.f};
            acc = mfma16(QDf[mt][0], Sb0, acc); acc = mfma16(QDf[mt][1], Sb1, acc); acc = mfma16(QKf[mt][0], Vb0, acc); acc = mfma16(QKf[mt][1], Vb1, acc);
            o[sl][mt] = acc;
#pragma unroll
            for (int r = 0; r < 4; ++r) ssq[mt][r] += acc[r] * acc[r];
        }
    }
#pragma unroll
    for (int mt = 0; mt < 4; ++mt)
#pragma unroll
        for (int r = 0; r < 4; ++r) ssq[mt][r] = __builtin_amdgcn_rsqf(row16_sum(ssq[mt][r]) * (1.f / 64.f) + 1e-6f);
#pragma unroll
    for (int sl = 0; sl < 4; ++sl)
#pragma unroll
        for (int mt = 0; mt < 4; ++mt) {
            const u32x2 zz = *(const u32x2*)(rec + GC_ZT + (16 * sl + li) * 128 + (16 * mt + 4 * g) * 2);
            const float zf[4] = {bf2f(zz.x & 0xffffu), bf2f(zz.x >> 16), bf2f(zz.y & 0xffffu), bf2f(zz.y >> 16)};
#pragma unroll
            for (int r = 0; r < 4; ++r) *(LAS bf16*)(wl + tsw(16 * mt + 4 * g + r, 16 * sl + li)) = (bf16)f2bf(o[sl][mt][r] * ssq[mt][r] * zf[r]);
        }
    LDS_WAIT();
    bf16* yrow = Y + ((size_t)b * SEQ + 64 * n + lane) * DM + 512 + h * 64;
#pragma unroll
    for (int c = 0; c < 8; ++c) *(u32x4*)(yrow + 8 * c) = *(const LAS u32x4*)(wl + tsw(lane, 8 * c));
    LDS_WAIT();
}

constexpr int AT_K = 0, AT_V = 32768, AT_IMP = 65536, AT_SELM = AT_IMP + 64 * 68 * 4, AT_UNI = AT_SELM + 512, AT_YS = 83968;
__device__ __forceinline__ s16x4 tr_read0(unsigned addr) { s16x4 r; asm volatile("ds_read_b64_tr_b16 %0, %1" : "=&v"(r) : "v"(addr) : "memory"); return r; }

__device__ __forceinline__ float half_max(float x) { auto rr = __builtin_amdgcn_permlane32_swap(__float_as_uint(x), __float_as_uint(x), false, false); return fmaxf(__uint_as_float(rr[0]), __uint_as_float(rr[1])); }
__device__ __forceinline__ float half_sum(float x) { auto rr = __builtin_amdgcn_permlane32_swap(__float_as_uint(x), __float_as_uint(x), false, false); return __uint_as_float(rr[0]) + __uint_as_float(rr[1]); }
struct AttnStage { u32x4 kr, vr; };
__device__ __forceinline__ void at_gload(AttnStage& st, const bf16* Kb, const bf16* Vb, size_t stride, int j, int tid) {
    const int row = tid >> 3, ch = tid & 7; const size_t off = (size_t)(64 * j + row) * stride + 8 * ch;
    st.kr = *(const u32x4*)(Kb + off); st.vr = *(const u32x4*)(Vb + off);
}
__device__ __forceinline__ void at_swrite(const AttnStage& st, LAS unsigned char* lds, int buf, int tid) {
    const int row = tid >> 3, ch = tid & 7; const int o = row * 128 + (((ch ^ (row >> 1)) & 7) << 4);
    *(LAS u32x4*)(lds + AT_K + buf * 8192 + o) = st.kr; *(LAS u32x4*)(lds + AT_V + buf * 8192 + o) = st.vr;
}
__device__ __forceinline__ void at_qk(const LAS unsigned char* Kt, const bf16x8 (&Qf)[4], int r, int hf, f32x16 (&s)[2], float cinit) {
    const int swz = (r >> 1) & 7;
    bf16x8 kf[2][4];
#pragma unroll
    for (int kt = 0; kt < 2; ++kt)
#pragma unroll
        for (int ks = 0; ks < 4; ++ks) kf[kt][ks] = *(const LAS bf16x8*)(Kt + (32 * kt + r) * 128 + (((2 * ks + hf) ^ swz) << 4));
    SBAR();
#pragma unroll
    for (int kt = 0; kt < 2; ++kt) {
        f32x16 acc;
#pragma unroll
        for (int e = 0; e < 16; ++e) acc[e] = cinit;
#pragma unroll
        for (int ks = 0; ks < 4; ++ks) acc = mfma32(kf[kt][ks], Qf[ks], acc);
        s[kt] = acc;
    }
}
__device__ __forceinline__ void at_pv(unsigned vbase, const unsigned (&voff)[2][2], const f32x16 (&p)[2], f32x16 (&o)[2]) {
#pragma unroll
    for (int kt = 0; kt < 2; ++kt) {
        s16x4 vr[2][2][2];
#pragma unroll
        for (int s = 0; s < 2; ++s) { const unsigned co = vbase + (unsigned)(4096 * kt + 2048 * s);
            vr[s][0][0] = tr_read0(co + voff[0][0]); vr[s][1][0] = tr_read0(co + voff[1][0]); vr[s][0][1] = tr_read0(co + voff[0][1]); vr[s][1][1] = tr_read0(co + voff[1][1]); }
        bf16x8 pb[2];
#pragma unroll
        for (int s = 0; s < 2; ++s) { u32x4 pw; pw.x = pk2(p[kt][8 * s + 0], p[kt][8 * s + 1]); pw.y = pk2(p[kt][8 * s + 2], p[kt][8 * s + 3]); pw.z = pk2(p[kt][8 * s + 4], p[kt][8 * s + 5]); pw.w = pk2(p[kt][8 * s + 6], p[kt][8 * s + 7]); pb[s] = as_bf16x8(pw); }
        asm volatile("s_waitcnt lgkmcnt(0)" ::: "memory"); SBAR();
#pragma unroll
        for (int s = 0; s < 2; ++s) {
            const s16x4 l0 = vr[s][0][0], h0 = vr[s][1][0], l1 = vr[s][0][1], h1 = vr[s][1][1];
            const bf16x8 v0 = {l0[0], l0[1], l0[2], l0[3], h0[0], h0[1], h0[2], h0[3]}, v1 = {l1[0], l1[1], l1[2], l1[3], h1[0], h1[1], h1[2], h1[3]};
            o[0] = mfma32(v0, pb[s], o[0]); o[1] = mfma32(v1, pb[s], o[1]);
        }
    }
}

struct AttnRow { int r, hf, tt, t, qb, wave; unsigned long long wave_union; float m, lpart; };
struct TileInfo { int hi, lo; bool rowok, edge, work, fresh; };
template <int MODE, int VAR>
__device__ __forceinline__ void at_tile_qk(const Frame& F, int j, int stg, const bf16x8 (&Qf)[4], const AttnRow& R, float mfin, f32x16 (&s)[2], TileInfo& I) {
    LAS unsigned char* lds = F.lds;
    I.work = true; if (MODE == 2) I.work = (R.wave_union >> j) & 1ull;
    I.hi = 1000; I.lo = -1000; I.rowok = true; I.edge = false;
    if (MODE <= 1) { I.hi = ((R.t - 31) >> 4) - 64 * j - 4 * R.hf; I.edge = (64 * j + 63) > ((64 * R.qb + 8 * R.wave - 31) >> 4); }
    if (MODE == 2) { const unsigned long long sm = *(const LAS unsigned long long*)(lds + AT_SELM + 8 * R.tt); I.rowok = (sm >> j) & 1ull; if (j == R.qb) { I.hi = R.tt - 4 * R.hf; I.edge = true; } }
    if (MODE == 3) { if (j == R.qb) { I.hi = R.tt - 4 * R.hf; I.edge = true; } if (j == R.qb - 8) { I.lo = R.tt + 1 - 4 * R.hf; I.edge = true; } }
    const float mref = (MODE == 1) ? mfin : R.m; I.fresh = mref < -1e29f;
    const float cinit = I.rowok ? (I.fresh ? 0.f : -mref) : -INFINITY;
    if (I.work) { if (VAR & 64) { for (int e = 0; e < 16; ++e) { s[0][e] = Qf[0][0] * 1e-9f; s[1][e] = Qf[1][1] * 1e-9f; } } else at_qk(lds + AT_K + stg * 8192, Qf, R.r, R.hf, s, cinit); }
}
template <int MODE, int VAR>
__device__ __forceinline__ float at_tile_fin(const Frame& F, int j, int stg, f32x16 (&s)[2], const TileInfo& I, AttnRow& R, const unsigned (&voff)[2][2], f32x16 (&o)[2], float invl, float preshift) {
    LAS unsigned char* lds = F.lds; float shift_out = 0.f;
    if (!I.work) return 0.f;
    const int hi = I.hi, lo = I.lo; const bool edge = I.edge;
    if (MODE == 1) {
        if (edge) {
#pragma unroll
            for (int kt = 0; kt < 2; ++kt)
#pragma unroll
                for (int e = 0; e < 16; ++e) { const int cst = 32 * kt + (e & 3) + 8 * (e >> 2); s[kt][e] = (cst <= hi) ? fexp2(s[kt][e]) * invl : 0.f; }
        } else {
#pragma unroll
            for (int kt = 0; kt < 2; ++kt)
#pragma unroll
                for (int e = 0; e < 16; ++e) s[kt][e] = fexp2(s[kt][e]) * invl;
        }
        LAS float* imp = (LAS float*)(lds + AT_IMP) + R.tt * 68;
#pragma unroll
        for (int kt = 0; kt < 2; ++kt)
#pragma unroll
            for (int rg = 0; rg < 4; ++rg) {
                float av = 2.f * (s[kt][4 * rg] + s[kt][4 * rg + 1] + s[kt][4 * rg + 2]) + s[kt][4 * rg + 3], bv = s[kt][4 * rg + 3];
                av += __int_as_float(__builtin_amdgcn_update_dpp(0, __float_as_int(av), 0xB1, 0xf, 0xf, true)); av += __int_as_float(__builtin_amdgcn_update_dpp(0, __float_as_int(av), 0x4E, 0xf, 0xf, true));
                bv += __int_as_float(__builtin_amdgcn_update_dpp(0, __float_as_int(bv), 0xB1, 0xf, 0xf, true)); bv += __int_as_float(__builtin_amdgcn_update_dpp(0, __float_as_int(bv), 0x4E, 0xf, 0xf, true));
                if ((R.r & 3) == 0) { const int jb = 16 * j + 8 * kt + 2 * rg + R.hf; (void)__hip_atomic_fetch_add(imp + jb, av, __ATOMIC_RELAXED, __HIP_MEMORY_SCOPE_WORKGROUP); (void)__hip_atomic_fetch_add(imp + jb + 1, bv, __ATOMIC_RELAXED, __HIP_MEMORY_SCOPE_WORKGROUP); }
            }
        if (VAR & 16) { o[0][0] += s[0][3] + s[1][7]; } else at_pv((unsigned)(size_t)(lds + AT_V + stg * 8192), voff, s, o);
    } else if (VAR & 32) { R.lpart += s[0][1]; if (MODE >= 2) { if (VAR & 16) { o[0][0] += s[0][3]; } else at_pv((unsigned)(size_t)(lds + AT_V + stg * 8192), voff, s, o); } }
    else {
        constexpr float THR = 8.f;
        if (__any(preshift != 0.f)) {
#pragma unroll
            for (int kt = 0; kt < 2; ++kt)
#pragma unroll
                for (int e = 0; e < 16; ++e) s[kt][e] -= preshift;
        }
        const bool fresh = R.m < -1e29f;
        if (edge) {
#pragma unroll
            for (int kt = 0; kt < 2; ++kt)
#pragma unroll
                for (int e = 0; e < 16; ++e) { const int cst = 32 * kt + (e & 3) + 8 * (e >> 2); const bool ok = (cst <= hi) && (cst >= lo); s[kt][e] = ok ? s[kt][e] : -INFINITY; }
        }
        float tm4[4] = {-INFINITY, -INFINITY, -INFINITY, -INFINITY};
#pragma unroll
        for (int kt = 0; kt < 2; ++kt)
#pragma unroll
            for (int e = 0; e < 16; e += 2) tm4[(e >> 1) & 3] = fmaxf(tm4[(e >> 1) & 3], fmaxf(s[kt][e], s[kt][e + 1]));
        const float tmax = half_max(fmaxf(fmaxf(tm4[0], tm4[1]), fmaxf(tm4[2], tm4[3])));
        const bool raise = (tmax > -INFINITY) && (fresh || tmax > THR);
        if (__any(raise)) {
            const float shift = raise ? tmax : 0.f, alpha = (raise && !fresh) ? fexp2(-shift) : 1.f;
            R.m = raise ? (fresh ? tmax : R.m + tmax) : R.m; R.lpart *= alpha; shift_out = shift;
#pragma unroll
            for (int kt = 0; kt < 2; ++kt)
#pragma unroll
                for (int e = 0; e < 16; ++e) s[kt][e] -= shift;
            if (MODE >= 2) {
#pragma unroll
                for (int e = 0; e < 16; ++e) { o[0][e] *= alpha; o[1][e] *= alpha; } }
        }
        float ps4[4] = {0.f, 0.f, 0.f, 0.f};
#pragma unroll
        for (int kt = 0; kt < 2; ++kt)
#pragma unroll
            for (int e = 0; e < 16; ++e) { s[kt][e] = fexp2(s[kt][e]); ps4[e & 3] += s[kt][e]; }
        R.lpart += (ps4[0] + ps4[1]) + (ps4[2] + ps4[3]);
        if (MODE >= 2) { if (VAR & 16) { o[0][0] += s[0][3] + s[1][7]; } else at_pv((unsigned)(size_t)(lds + AT_V + stg * 8192), voff, s, o); }
    }
    return shift_out;
}
template <int MODE, int VAR = 0>
__device__ __forceinline__ void at_branch(const Frame& F, unsigned long long mask, const bf16* Kb, const bf16* Vb, size_t stride, const bf16x8 (&Qf)[4], AttnRow& R, const unsigned (&voff)[2][2],
                                          f32x16 (&o)[2], float mfin, float invl) {
    LAS unsigned char* lds = F.lds; const int tid = F.tid;
    if (mask == 0ull) return;
    AttnStage st0, st1; int sg = 0;
    { const int j0 = __builtin_ctzll(mask); at_gload(st0, Kb, Vb, stride, j0, tid); at_swrite(st0, lds, 0, tid);
      const unsigned long long m1 = mask & (mask - 1ull); if (m1) { at_gload(st1, Kb, Vb, stride, __builtin_ctzll(m1), tid); at_swrite(st1, lds, 1, tid); } }
    __syncthreads();
    while (mask) {
        const int j0 = __builtin_ctzll(mask); mask &= mask - 1ull;
        int j1 = -1; if (mask) { j1 = __builtin_ctzll(mask); mask &= mask - 1ull; }
        int n0 = -1, n1 = -1; { unsigned long long mm = mask; if (mm) { n0 = __builtin_ctzll(mm); mm &= mm - 1ull; if (mm) n1 = __builtin_ctzll(mm); } }
        at_gload(st0, Kb, Vb, stride, n0 >= 0 ? n0 : j0, tid);
        at_gload(st1, Kb, Vb, stride, n1 >= 0 ? n1 : j0, tid);
        { f32x16 sa[2]; TileInfo Ia;
          at_tile_qk<MODE, VAR>(F, j0, sg, Qf, R, mfin, sa, Ia);
          (void)at_tile_fin<MODE, VAR>(F, j0, sg, sa, Ia, R, voff, o, invl, 0.f); }
        if (j1 >= 0) { f32x16 sb[2]; TileInfo Ib;
          at_tile_qk<MODE, VAR>(F, j1, sg + 1, Qf, R, mfin, sb, Ib);
          (void)at_tile_fin<MODE, VAR>(F, j1, sg + 1, sb, Ib, R, voff, o, invl, 0.f); }
        if (n0 >= 0) at_swrite(st0, lds, (sg + 2) & 3, tid);
        if (n1 >= 0) at_swrite(st1, lds, (sg + 3) & 3, tid);
        __syncthreads();
        sg = (sg + 2) & 3;
    }
}

template <int VAR>
__device__ __forceinline__ void attn_item(const Frame& F, ArgsP a, int l, int item) {
    const int qb = 63 - (item >> 4), bh = item & 15, b = bh >> 1, hk = bh & 1; const int lane = F.lane, wave = F.wave;
    const bf16* H = (const bf16*)(a->ws + WS_H); const float* side = (const float*)(a->ws + WS_SIDE); bf16* Y = (bf16*)(a->ws + WS_Y);
    LAS unsigned char* lds = F.lds;
    AttnRow R; R.r = lane & 31; R.hf = lane >> 5; R.tt = 8 * wave + (R.r >> 2); R.t = 64 * qb + R.tt; R.qb = qb; R.wave = wave; R.wave_union = 0ull;
    const int head = hk * 4 + (R.r & 3); const size_t tok = (size_t)b * SEQ + R.t;
    bf16x8 Qf[4];
#pragma unroll
    for (int ks = 0; ks < 4; ++ks) Qf[ks] = *(const bf16x8*)(H + tok * HLD + head * 64 + 16 * ks + 8 * R.hf);
    const float g_cmp = side[tok * 32 + head * 3], g_sel = side[tok * 32 + head * 3 + 1], g_win = side[tok * 32 + head * 3 + 2];
    unsigned voff[2][2];
    { const int li = lane & 15, q = li >> 2, p = li & 3, gi1 = (lane >> 4) & 1;
#pragma unroll
      for (int jh = 0; jh < 2; ++jh)
#pragma unroll
          for (int dt = 0; dt < 2; ++dt) voff[jh][dt] = (unsigned)((8 * jh + 4 * R.hf + q) * 128 + ((((4 * dt + 2 * gi1 + (p >> 1)) ^ (4 * jh + 2 * R.hf + (q >> 1))) & 7) << 4) + (p & 1) * 8); }
    { LAS float* imp = (LAS float*)(lds + AT_IMP) + (8 * wave) * 68; for (int i = lane; i < 8 * 68; i += 64) imp[i] = 0.f; if (F.tid == 0) { *(LAS unsigned*)(lds + AT_UNI) = 0u; *(LAS unsigned*)(lds + AT_UNI + 4) = 0u; } }
    f32x16 o[2];
#pragma unroll
    for (int e = 0; e < 16; ++e) { o[0][e] = 0.f; o[1][e] = 0.f; }
    LAS float* ys = (LAS float*)(lds + AT_YS + wave * 8192) + lane;
    {
        const bf16* Kc = (const bf16*)(a->ws + WS_KC) + (size_t)bh * 256 * 64; const bf16* Vc = (const bf16*)(a->ws + WS_VC) + (size_t)bh * 256 * 64;
        const int ntc = (4 * qb + 3 + 63) >> 6; const unsigned long long mc = (ntc >= 64) ? ~0ull : ((1ull << ntc) - 1ull);
        R.m = -1e30f; R.lpart = 0.f;
        if (!(VAR & 8)) at_branch<0, VAR>(F, mc, Kc, Vc, 64, Qf, R, voff, o, 0.f, 0.f);
        const float lsum = half_sum(R.lpart); const float invl = 1.f / fmaxf(lsum, 1e-30f);
        if (!(VAR & 8)) at_branch<1, VAR>(F, mc, Kc, Vc, 64, Qf, R, voff, o, R.m, invl);
#pragma unroll
        for (int e = 0; e < 16; ++e) { ys[e * 64] = g_cmp * o[0][e]; ys[(16 + e) * 64] = g_cmp * o[1][e]; o[0][e] = 0.f; o[1][e] = 0.f; }
    }
    LDS_WAIT();
    {
        unsigned long long wu = 0ull;
        for (int qi = 0; qi < 8; ++qi) {
            unsigned long long selm;
            if (qb < 16) selm = (2ull << qb) - 1ull;
            else {
                const float v = ((const LAS float*)(lds + AT_IMP))[(8 * wave + qi) * 68 + lane];
                const bool cand = (lane >= 1) && (lane <= qb - 2); const unsigned key = cand ? __float_as_uint(fmaxf(v, 0.f)) : 0u;
                unsigned thr = 0u;
                for (int bit = 30; bit >= 0; --bit) { const unsigned tr = thr | (1u << bit); const int c = __popcll(__ballot(cand && key >= tr)); if (c >= 13) thr = tr; }
                const unsigned long long gt = __ballot(cand && key > thr), eq = __ballot(cand && key == thr);
                int need = 13 - __popcll(gt); unsigned long long eqs = 0ull, e2 = eq;
                while (need > 0 && e2) { const unsigned long long low = e2 & (~e2 + 1ull); eqs |= low; e2 ^= low; --need; }
                selm = gt | eqs | 1ull | (1ull << qb) | (1ull << (qb - 1));
            }
            if (lane == 0) *(LAS unsigned long long*)(lds + AT_SELM + 8 * (8 * wave + qi)) = selm;
#if defined(SELFCHECK) && SELFCHECK == 1
            if (lane == 0 && l == 1) ((unsigned long long*)(a->ws + (size_t)984 * MiB + 64 * KiB))[(size_t)bh * SEQ + 64 * qb + 8 * wave + qi] = selm;
#endif
            wu |= selm;
        }
        R.wave_union = wu;
        if (lane == 0) { __hip_atomic_fetch_or((LAS unsigned*)(lds + AT_UNI), (unsigned)wu, __ATOMIC_RELAXED, __HIP_MEMORY_SCOPE_WORKGROUP); __hip_atomic_fetch_or((LAS unsigned*)(lds + AT_UNI + 4), (unsigned)(wu >> 32), __ATOMIC_RELAXED, __HIP_MEMORY_SCOPE_WORKGROUP); }
    }
    __syncthreads();
    const unsigned long long bunion = (unsigned long long)*(const LAS unsigned*)(lds + AT_UNI) | ((unsigned long long)*(const LAS unsigned*)(lds + AT_UNI + 4) << 32);
    const bf16* Hb = H + (size_t)b * SEQ * HLD;
    {
        R.m = -1e30f; R.lpart = 0.f;
        if (!(VAR & 2)) at_branch<2, VAR>(F, bunion, Hb + 512 + 2 * 128 + hk * 64, Hb + 512 + 3 * 128 + hk * 64, HLD, Qf, R, voff, o, 0.f, 0.f);
        const float lsum = half_sum(R.lpart); const float sc = g_sel / fmaxf(lsum, 1e-30f);
#pragma unroll
        for (int e = 0; e < 16; ++e) { ys[e * 64] += sc * o[0][e]; ys[(16 + e) * 64] += sc * o[1][e]; o[0][e] = 0.f; o[1][e] = 0.f; }
    }
    {
        const int lo = qb - 8 > 0 ? qb - 8 : 0; const unsigned long long mw = ((2ull << qb) - 1ull) & ~((1ull << lo) - 1ull);
        R.m = -1e30f; R.lpart = 0.f;
        if (!(VAR & 4)) at_branch<3, VAR>(F, mw, Hb + 512 + 4 * 128 + hk * 64, Hb + 512 + 5 * 128 + hk * 64, HLD, Qf, R, voff, o, 0.f, 0.f);
        const float lsum = half_sum(R.lpart); const float sc = g_win / fmaxf(lsum, 1e-30f);
#pragma unroll
        for (int e = 0; e < 16; ++e) { o[0][e] = ys[e * 64] + sc * o[0][e]; o[1][e] = ys[(16 + e) * 64] + sc * o[1][e]; }
    }
    if (VAR & 1) { asm volatile("" :: "v"(o[0][0]), "v"(o[1][5])); return; }
    bf16* yrow = Y + tok * DM + head * 64 + 4 * R.hf;
#pragma unroll
    for (int dt = 0; dt < 2; ++dt)
#pragma unroll
        for (int rg = 0; rg < 4; ++rg) { u32x2 w; w.x = pk2(o[dt][4 * rg], o[dt][4 * rg + 1]); w.y = pk2(o[dt][4 * rg + 2], o[dt][4 * rg + 3]); *(u32x2*)(yrow + 32 * dt + 8 * rg) = w; }
}

__device__ __forceinline__ void phase_mix_b(const Frame& F, ArgsP a, int l, int rep) {
    unsigned* q = F.ctl + CW_QUEUE + l * 64 + rep * 32;
    for (;;) {
        if (F.tid == 0) F.MISC[0] = __hip_atomic_fetch_add(q, 1u, __ATOMIC_RELAXED, __HIP_MEMORY_SCOPE_AGENT);
        __syncthreads();
        const int item = (int)F.MISC[0];
        __syncthreads();
        if (item >= 1024) break;
        if (rep == 0) attn_item<0>(F, a, l, item); else attn_item<PROBE_ATTN_VAR>(F, a, l, item);
    }
}

constexpr size_t WS_DBG = 984 * MiB;
constexpr int CHECK_LAYER = 1;
__device__ __forceinline__ void dbg_add(ArgsP a, int i, float v) { atomicAdd((float*)(a->ws + WS_DBG) + i, v); }

__device__ __forceinline__ void check_nsa(const Frame& F, ArgsP a) {
    const bf16* H = (const bf16*)(a->ws + WS_H); const float* side = (const float*)(a->ws + WS_SIDE); const bf16* Y = (const bf16*)(a->ws + WS_Y);
    const unsigned long long* SELM = (const unsigned long long*)(a->ws + WS_DBG + 64 * KiB);
    const int lane = F.lane; const int tv[16] = {5, 40, 63, 64, 100, 511, 512, 1023, 1024, 1500, 2047, 2048, 3000, 3333, 4000, 4095};
    for (int s = F.bid * NWAVES + F.wave; s < 256; s += F.G * NWAVES) {
        int t = tv[0];
#pragma unroll
        for (int q = 1; q < 16; ++q) t = ((s & 15) == q) ? tv[q] : t;
        const int b = (s >> 4) & 7, hq = ((s >> 7) * 5 + (s & 7)) & 7, hk = hq >> 2; const size_t tok = (size_t)b * SEQ + t; const int bhk = b * 2 + hk;
        const bf16* KC = (const bf16*)(a->ws + WS_KC) + (size_t)bhk * 256 * 64; const bf16* VC = (const bf16*)(a->ws + WS_VC) + (size_t)bhk * 256 * 64;
        const float g_cmp = side[tok * 32 + hq * 3], g_sel = side[tok * 32 + hq * 3 + 1], g_win = side[tok * 32 + hq * 3 + 2];
        const int cmax = (t - 31) >> 4; float imp = 0.f, ocmp = 0.f;
        for (int gh = 0; gh < 4; ++gh) {
            const int head = hk * 4 + gh; const float qd = bf2f(H[tok * HLD + head * 64 + lane]);
            float m = -INFINITY, l = 0.f;
            for (int c = 0; c <= cmax; ++c) m = fmaxf(m, wave_sum(qd * bf2f(KC[c * 64 + lane])));
            for (int c = 0; c <= cmax; ++c) l += fexp2(wave_sum(qd * bf2f(KC[c * 64 + lane])) - m);
            for (int c = 0; c <= cmax; ++c) { const float p = fexp2(wave_sum(qd * bf2f(KC[c * 64 + lane])) - m) / l; const int j = c >> 2, e = c & 3;
                if (lane == j) imp += (e < 3 ? 2.f : 1.f) * p; if (e == 3 && lane == j + 1) imp += p;
                if (head == hq) ocmp += p * bf2f(VC[c * 64 + lane]); }
        }
        const int cur = t >> 6; const bool causal = lane <= cur, forced = (lane == 0) || (lane == cur) || (lane == cur - 1);
        const float key = causal ? (imp + (forced ? 1.0e4f : 0.f)) : -INFINITY; int rank = 0;
        for (int i = 0; i < 64; ++i) { const float ki = __shfl(key, i); rank += ((ki > key) || (ki == key && i < lane)) ? 1 : 0; }
        const unsigned long long refm = __ballot(causal && rank < 16), stm = SELM[(size_t)bhk * SEQ + t];
        if (lane == 0) { dbg_add(a, 2, (float)__popcll(refm ^ stm)); dbg_add(a, 3, 16.f); }
        const float qd = bf2f(H[tok * HLD + hq * 64 + lane]); const bf16* Hb = H + (size_t)b * SEQ * HLD + hk * 64 + lane;
        float m = -INFINITY, l = 0.f, osel = 0.f;
        for (int j = 0; j <= cur; ++j) if ((stm >> j) & 1ull) for (int kk = 0; kk < 64; ++kk) { const int p = 64 * j + kk; if (p > t) break;
            const float sc = wave_sum(qd * bf2f(Hb[(size_t)p * HLD + 512 + 2 * 128])); const float mn = fmaxf(m, sc), al = fexp2(m - mn), pp = fexp2(sc - mn);
            l = l * al + pp; osel = osel * al + pp * bf2f(Hb[(size_t)p * HLD + 512 + 3 * 128]); m = mn; }
        const float ysel = osel / fmaxf(l, 1e-30f);
        m = -INFINITY; l = 0.f; float owin = 0.f;
        for (int p = (t - 511 > 0 ? t - 511 : 0); p <= t; ++p) { const float sc = wave_sum(qd * bf2f(Hb[(size_t)p * HLD + 512 + 4 * 128])); const float mn = fmaxf(m, sc), al = fexp2(m - mn), pp = fexp2(sc - mn);
            l = l * al + pp; owin = owin * al + pp * bf2f(Hb[(size_t)p * HLD + 512 + 5 * 128]); m = mn; }
        const float ref = g_cmp * ocmp + g_sel * ysel + g_win * owin / fmaxf(l, 1e-30f), got = bf2f(Y[tok * DM + hq * 64 + lane]);
        const float e2 = wave_sum((ref - got) * (ref - got)), r2 = wave_sum(ref * ref);
        if (lane == 0) { dbg_add(a, 0, e2); dbg_add(a, 1, r2); }
    }
}

__device__ __forceinline__ void check_gdn(const Frame& F, ArgsP a, int l) {
    if (F.bid >= 8) return;
    const bf16* H = (const bf16*)(a->ws + WS_H); const float* side = (const float*)(a->ws + WS_SIDE); const bf16* Y = (const bf16*)(a->ws + WS_Y);
    const int b = F.bid, h = (F.bid * 3) & 3, tid = F.tid, lane = F.lane, col = tid & 63, rg = tid >> 6;
    LAS float* S = (LAS float*)F.lds; LAS float* qv = S + 64 * 65; LAS float* kv = qv + 64; LAS float* vv = kv + 64; LAS float* sc = vv + 64; LAS float* part = sc + 64;
    for (int i = tid; i < 64 * 65; i += NTHR) S[i] = 0.f;
    float hq[3] = {0.f, 0.f, 0.f}, hk[3] = {0.f, 0.f, 0.f}, hv[3] = {0.f, 0.f, 0.f}, wq[4], wk[4], wv[4];
    { const float* cw = a->in[6] + (size_t)l * 4 * 768 + h * 64 + lane;
#pragma unroll
      for (int k = 0; k < 4; ++k) { wq[k] = cw[k * 768]; wk[k] = cw[k * 768 + 256]; wv[k] = cw[k * 768 + 512]; } }
    const float Aexp = __expf(a->in[7][l * 4 + h]), dtb = a->in[8][l * 4 + h], nw = a->in[9][l * 64 + lane];
    __syncthreads();
    for (int t = 0; t < 192; ++t) {
        const size_t tok = (size_t)b * SEQ + t;
        if (F.wave == 0) { const bf16* p = H + tok * HLD + 1280 + h * 64 + lane; const float rq = bf2f(p[0]), rk = bf2f(p[256]), rv = bf2f(p[512]);
            const float cq = wq[0] * hq[0] + wq[1] * hq[1] + wq[2] * hq[2] + wq[3] * rq, ck = wk[0] * hk[0] + wk[1] * hk[1] + wk[2] * hk[2] + wk[3] * rk, cv = wv[0] * hv[0] + wv[1] * hv[1] + wv[2] * hv[2] + wv[3] * rv;
            hq[0] = hq[1]; hq[1] = hq[2]; hq[2] = rq; hk[0] = hk[1]; hk[1] = hk[2]; hk[2] = rk; hv[0] = hv[1]; hv[1] = hv[2]; hv[2] = rv;
            const float qs = cq / (1.f + __expf(-cq)), ks = ck / (1.f + __expf(-ck)), vs = cv / (1.f + __expf(-cv));
            qv[lane] = qs / sqrtf(wave_sum(qs * qs) + 1e-6f); kv[lane] = ks / sqrtf(wave_sum(ks * ks) + 1e-6f); vv[lane] = vs;
            if (lane == 0) { const float av = side[tok * 32 + 28 + h] + dtb; const float sp = av > 20.f ? av : log1pf(__expf(av)); sc[0] = __expf(-Aexp * sp); sc[1] = side[tok * 32 + 24 + h]; } }
        __syncthreads();
        { float ps = 0.f;
#pragma unroll
          for (int r = 0; r < 8; ++r) ps += kv[8 * rg + r] * S[(8 * rg + r) * 65 + col];
          part[rg * 64 + col] = ps; }
        __syncthreads();
        { float ks = 0.f;
#pragma unroll
          for (int r = 0; r < 8; ++r) ks += part[r * 64 + col];
          const float eg = sc[0], be = sc[1]; float po = 0.f;
          __syncthreads();
#pragma unroll
          for (int r = 0; r < 8; ++r) { const int dk = 8 * rg + r; const float sn = eg * (S[dk * 65 + col] - be * kv[dk] * ks) + be * kv[dk] * vv[col]; S[dk * 65 + col] = sn; po += sn * qv[dk]; }
          part[rg * 64 + col] = po; }
        __syncthreads();
        if (F.wave == 0) { float o = 0.f;
#pragma unroll
            for (int r = 0; r < 8; ++r) o += part[r * 64 + lane];
            o *= 0.125f; const float rs = 1.f / sqrtf(wave_sum(o * o) * (1.f / 64.f) + 1e-6f); const float z = bf2f(H[tok * HLD + 2048 + h * 64 + lane]);
            const float ref = o * rs * nw * (z / (1.f + __expf(-z))), got = bf2f(Y[tok * DM + 512 + h * 64 + lane]);
            const float e2 = wave_sum((ref - got) * (ref - got)), r2 = wave_sum(ref * ref);
            if (lane == 0) { dbg_add(a, 4, e2); dbg_add(a, 5, r2); } }
        __syncthreads();
    }
}

__device__ __forceinline__ void check_moe(const Frame& F, ArgsP a, int l) {
    const bf16* XBc = (const bf16*)(a->ws + WS_XB); const bf16* Y2 = (const bf16*)(a->ws + WS_Y2);
    const int* route_e = (const int*)(a->ws + WS_SLOT + SL_RE); const float* route_w = (const float*)(a->ws + WS_SLOT + SL_RW);
    LAS float* x = (LAS float*)F.lds; LAS float* hid = x + 1024; LAS float* lg = hid + 512; LAS float* yr = lg + 64;
    const int tid = F.tid, lane = F.lane;
    for (int s = F.bid; s < 256; s += F.G) {
        const int t = (s * 4099 + 17) & (T - 1);
        for (int i = tid; i < 1024; i += NTHR) { x[i] = bf2f(XBc[(size_t)t * DM + i]); yr[i] = 0.f; }
        __syncthreads();
        for (int j = F.wave; j < 36; j += NWAVES) { float d = 0.f; for (int k = lane; k < DM; k += 64) d += x[k] * (j < 4 ? a->in[18][((size_t)l * DM + k) * 4 + j] : a->in[20][((size_t)l * DM + k) * NEXP + j - 4]);
            d = wave_sum(d); if (lane == 0) lg[j] = d + (j < 4 ? a->in[19][l * 4 + j] : a->in[21][l * NEXP + j - 4]); }
        __syncthreads();
        if (tid == 0) { int gi = 0; for (int i = 1; i < 4; ++i) if (lg[i] > lg[gi]) gi = i; float gs = 0.f; for (int i = 0; i < 4; ++i) gs += __expf(lg[i] - lg[gi]); const float gw = 1.f / gs;
            int i1 = 0; for (int i = 1; i < 8; ++i) if (lg[4 + gi * 8 + i] > lg[4 + gi * 8 + i1]) i1 = i; int i2 = -1; for (int i = 0; i < 8; ++i) if (i != i1 && (i2 < 0 || lg[4 + gi * 8 + i] > lg[4 + gi * 8 + i2])) i2 = i;
            const float e2 = __expf(lg[4 + gi * 8 + i2] - lg[4 + gi * 8 + i1]), w1 = gw / (1.f + e2), w2 = gw - w1;
            const int se1 = route_e[2 * t], se2 = route_e[2 * t + 1]; const float sw1 = route_w[2 * t], sw2 = route_w[2 * t + 1];
            dbg_add(a, 8, (se1 != gi * 8 + i1 ? 1.f : 0.f) + (se2 != gi * 8 + i2 ? 1.f : 0.f)); dbg_add(a, 9, 2.f);
            if (se1 == gi * 8 + i1 && se2 == gi * 8 + i2) { dbg_add(a, 10, (sw1 - w1) * (sw1 - w1) + (sw2 - w2) * (sw2 - w2)); dbg_add(a, 11, w1 * w1 + w2 * w2); } }
        for (int k2 = 0; k2 < 2; ++k2) {
            const int e = route_e[2 * t + k2]; const float rw = route_w[2 * t + k2];
            const float* wg = a->in[22] + ((size_t)l * NEXP + e) * DM * FF; const float* wu = a->in[23] + ((size_t)l * NEXP + e) * DM * FF; const float* wd = a->in[24] + ((size_t)l * NEXP + e) * FF * DM;
            { float g = 0.f, u = 0.f; for (int k = 0; k < DM; ++k) { g += x[k] * wg[(size_t)k * FF + tid]; u += x[k] * wu[(size_t)k * FF + tid]; } hid[tid] = g / (1.f + __expf(-g)) * u; }
            __syncthreads();
            for (int d = tid; d < DM; d += NTHR) { float y = 0.f; for (int f = 0; f < FF; ++f) y += hid[f] * wd[(size_t)f * DM + d]; yr[d] += y * rw; }
            __syncthreads();
        }
        float e2 = 0.f, r2 = 0.f;
        for (int d = tid; d < DM; d += NTHR) { const float got = bf2f(Y2[(size_t)(2 * t) * DM + d]) + bf2f(Y2[(size_t)(2 * t + 1) * DM + d]); e2 += (yr[d] - got) * (yr[d] - got); r2 += yr[d] * yr[d]; }
        e2 = wave_sum(e2); r2 = wave_sum(r2); if (lane == 0) { dbg_add(a, 6, e2); dbg_add(a, 7, r2); }
        __syncthreads();
    }
}

__device__ __forceinline__ void check_inproj(const Frame& F, ArgsP a, int l) {
    const bf16* H = (const bf16*)(a->ws + WS_H); const float* xin = (l == 0) ? a->in[0] : (const float*)a->out; const float* win = a->in[1] + (size_t)l * DM * DIN;
    const int lane = F.lane;
    for (int s = F.bid * NWAVES + F.wave; s < 1024; s += F.G * NWAVES) {
        const int tok = (s * 7919 + 13) & (T - 1), grp = s % 14, t = tok & (SEQ - 1);
        const int col0 = grp < 8 ? grp * 64 : 512 + (grp - 8) * 128 + ((s >> 4) & 1) * 64; const bool isq = grp < 8, rope = isq || ((grp - 8) % 2 == 0);
        float d = 0.f; for (int k = 0; k < DM; ++k) d += xin[(size_t)tok * DM + k] * win[(size_t)k * DIN + col0 + lane];
        if (rope) { const float inv[8] = {1.0f, 0.19392274f, 0.03760603f, 0.0072926646f, 0.0014142136f, 0.0002742482f, 5.3182957e-05f, 1.0313385e-05f};
            float iv = inv[0];
#pragma unroll
            for (int q = 1; q < 8; ++q) iv = ((lane & 7) == q) ? inv[q] : iv;
            const float ang = (float)t * iv, c = cosf(ang), sn = sinf(ang), other = __shfl_xor(d, 8);
            if (lane < 8) d = d * c - other * sn; else if (lane < 16) d = d * c + other * sn; }
        if (isq) d *= pg8::QSCALE;
        const float got = bf2f(H[(size_t)tok * HLD + col0 + lane]); const float e2 = wave_sum((d - got) * (d - got)), r2 = wave_sum(d * d);
        if (lane == 0) { dbg_add(a, 12, e2); dbg_add(a, 13, r2); }
    }
}
__device__ __forceinline__ void check_compress(const Frame& F, ArgsP a, int l) {
    const bf16* H = (const bf16*)(a->ws + WS_H); const int lane = F.lane;
    for (int s = F.bid * NWAVES + F.wave; s < 512; s += F.G * NWAVES) {
        const int kv = s & 1, bh = (s >> 1) & 15, b = bh >> 1, hh = bh & 1, i = (s * 53 + 7) % 255;
        const float* pe = a->in[3] + ((size_t)l * 2 + kv) * 2048; const float* w1 = a->in[4] + ((size_t)l * 2 + kv) * 2048 * 128; const float* w2 = a->in[5] + ((size_t)l * 2 + kv) * 128 * 64;
        float h0 = 0.f, h1 = 0.f;
        for (int k = 0; k < 2048; ++k) { const int p = k >> 6, d = k & 63; const float x = bf2f(H[((size_t)b * SEQ + 16 * i + p) * HLD + 512 + kv * 128 + hh * 64 + d]) + pe[k];
            h0 += x * w1[(size_t)k * 128 + lane]; h1 += x * w1[(size_t)k * 128 + 64 + lane]; }
        h0 = h0 / (1.f + __expf(-h0)); h1 = h1 / (1.f + __expf(-h1));
        float o = 0.f;
        for (int n = 0; n < 64; ++n) { o += __shfl(h0, n) * w2[(size_t)n * 64 + lane] + __shfl(h1, n) * w2[(size_t)(64 + n) * 64 + lane]; }
        const float got = bf2f(((const bf16*)(a->ws + (kv ? WS_VC : WS_KC)))[((size_t)bh * 256 + i) * 64 + lane]);
        const float e2 = wave_sum((o - got) * (o - got)), r2 = wave_sum(o * o); if (lane == 0) { dbg_add(a, 14, e2); dbg_add(a, 15, r2); }
    }
}
__device__ __forceinline__ void check_conformer(const Frame& F, ArgsP a, int l) {
    const bf16* H = (const bf16*)(a->ws + WS_H); const bf16* Y = (const bf16*)(a->ws + WS_Y); const int lane = F.lane;
    for (int s = F.bid * NWAVES + F.wave; s < 1024; s += F.G * NWAVES) {
        const int tok = (s * 6151 + 3) & (T - 1), t = tok & (SEQ - 1); float u[4];
#pragma unroll
        for (int j = 0; j < 4; ++j) { const int c = lane + 64 * j; float acc = a->in[11][l * 256 + c];
            for (int k = 0; k < 31; ++k) { const int sp = t - 30 + k; if (sp >= 0) { const bf16* hp = H + (size_t)(tok - 30 + k) * HLD + 2304 + c; const float g = bf2f(hp[256]); acc += a->in[10][((size_t)l * 31 + k) * 256 + c] * (bf2f(hp[0]) / (1.f + __expf(-g))); } }
            u[j] = acc; }
        const float mean = wave_sum(u[0] + u[1] + u[2] + u[3]) * (1.f / 256.f); float q = 0.f;
#pragma unroll
        for (int j = 0; j < 4; ++j) { u[j] -= mean; q += u[j] * u[j]; }
        const float rstd = 1.f / sqrtf(wave_sum(q) * (1.f / 256.f) + LN_EPS); float e2 = 0.f, r2 = 0.f;
#pragma unroll
        for (int j = 0; j < 4; ++j) { const int c = lane + 64 * j; const float v = u[j] * rstd * a->in[12][l * 256 + c] + a->in[13][l * 256 + c]; const float ref = v / (1.f + __expf(-v)), got = bf2f(Y[(size_t)tok * DM + 768 + c]);
            e2 += (ref - got) * (ref - got); r2 += ref * ref; }
        e2 = wave_sum(e2); r2 = wave_sum(r2); if (lane == 0) { dbg_add(a, 16, e2); dbg_add(a, 17, r2); }
    }
}
__device__ __forceinline__ void check_inject(const Frame& F, ArgsP a) {
    if (F.bid == 0 && F.tid == 0) { const float* d = (const float*)(a->ws + WS_DBG); float e0 = 0.f, e1 = 0.f;
        if (SELFCHECK == 1) { e0 = 1000.f * sqrtf(d[0] / d[1]); e1 = 1.0e4f * d[2] / d[3]; }
        if (SELFCHECK == 2) { e0 = 1000.f * sqrtf(d[4] / d[5]); }
        if (SELFCHECK == 3) { e0 = 1000.f * sqrtf(d[6] / d[7]); e1 = 1.0e4f * d[8] / d[9] + 1000.f * sqrtf(d[10] / fmaxf(d[11], 1e-30f)); }
        if (SELFCHECK == 4) { e0 = 1000.f * sqrtf(d[12] / d[13]); }
        if (SELFCHECK == 5) { e0 = 1000.f * sqrtf(d[14] / d[15]); e1 = 1000.f * sqrtf(d[16] / d[17]); }
        a->out[0] += e0; a->out[1] += e1; }
}


#ifndef MK_MULTI
#define MK_MULTI 0
#endif
#ifndef PROBE_REPEAT
#define PROBE_REPEAT 0
#endif
constexpr int N_PHASES = 1 + 10 * NL;
__device__ __forceinline__ Frame make_frame(int wave_s) {
    extern __shared__ __attribute__((aligned(16))) unsigned char lds_raw[];
    Frame F; F.lds = (LAS unsigned char*)lds_raw; F.MISC = (volatile LAS unsigned*)(F.lds + MISC_OFF);
    int tid = threadIdx.x, G = gridDim.x, bid = blockIdx.x; unsigned lb = (unsigned)(size_t)F.lds; (void)wave_s;
    asm volatile("" : "+v"(tid), "+s"(G), "+s"(bid), "+s"(lb));
    F.lds = (LAS unsigned char*)(size_t)lb; F.MISC = (volatile LAS unsigned*)(F.lds + MISC_OFF);
    F.tid = tid; F.lane = F.tid & 63; F.wave = __builtin_amdgcn_readfirstlane(F.tid >> 6); F.G = G; F.bid = bid;
    F.ctl = (unsigned*)(args_here()->ws + WS_CTL); return F;
}
__device__ __forceinline__ void ph_prologue(int, int wv) { const Frame F = make_frame(wv); phase_prologue(F, args_here()); phase_weights(F, args_here(), 0, 2, F.G, 0);
#if SELFCHECK
    if (F.bid == 0 && F.tid < 64) ((float*)(args_here()->ws + WS_DBG))[F.tid] = 0.f;
#endif
}
__device__ __forceinline__ void ph_inproj(int l, int wv) { const Frame F = make_frame(wv); unsigned char* ws = args_here()->ws;
    pg8::Gemm g{(const bf16*)(ws + WS_XB), (const bf16*)(WLBASE(ws, l) + WL_WIN), T, DINP, DM}; pg8::StaticOrder S; S.init(T, DINP, F.G, F.bid);
    pg8::EpiInProj E{(bf16*)(ws + WS_H), (float*)(ws + WS_SIDE), (const float*)(ws + WS_ROPE)};
    pg8::gemm_phase<pg8::EpiInProj, pg8::StaticOrder, false>(F.lds, g, S, E, nullptr, F.tid); }
__device__ __forceinline__ void ph_compress(int l, int wv) { const Frame F = make_frame(wv); for (int it = F.bid; it < 256; it += F.G) compress_item(F, args_here(), l, it); }
__device__ __forceinline__ void ph_gdnprep(int l, int wv) { const Frame F = make_frame(wv); for (int it = F.bid; it < 256; it += F.G) { gdn_prep_chunk<0>(F, args_here(), l, it * 8 + F.wave, F.lds + F.wave * 16384); __syncthreads(); } }
__device__ __forceinline__ void ph_gdnprep_var(int l, int wv) { const Frame F = make_frame(wv); for (int it = F.bid; it < 256; it += F.G) { gdn_prep_chunk<PROBE_GDN_VAR | 1>(F, args_here(), l, it * 8 + F.wave, F.lds + F.wave * 16384); __syncthreads(); } }
__device__ __forceinline__ void ph_conformer(int l, int wv) { const Frame F = make_frame(wv); for (int it = F.bid; it < 512; it += F.G) conformer_item(F, args_here(), l, it); }
__device__ __forceinline__ void ph_gdnout(int l, int wv) { const Frame F = make_frame(wv); for (int ci = F.bid * NWAVES + F.wave; ci < 2048; ci += F.G * NWAVES) gdn_out_chunk(F, args_here(), ci, F.lds + F.wave * 8192); }
constexpr int NCONV = 64;
__device__ __forceinline__ void ph_scan(int l, int wv) { const Frame F = make_frame(wv); if (F.bid < 16) gdn_scan<0>(F, args_here(), l); }
__device__ __forceinline__ void ph_bgweights(int l, int wv) { const Frame F = make_frame(wv);
    if (F.bid < NCONV) { if (l == 0) phase_weights(F, args_here(), 0, 1, NCONV, 0); if (l + 1 < NL) phase_weights(F, args_here(), l + 1, 3, NCONV, 0); __syncthreads(); } }
__device__ __forceinline__ void ph_scan_var(int l, int wv) { const Frame F = make_frame(wv); if (F.bid < 16) gdn_scan<(PROBE_SCAN_VAR & 1)>(F, args_here(), l); }
__device__ __forceinline__ void ph_attn(int l, int rep, int wv) { const Frame F = make_frame(wv); phase_mix_b(F, args_here(), l, rep); }
__device__ __forceinline__ void ph_outproj(int l, int wv) { const Frame F = make_frame(wv); ArgsP ap = args_here(); unsigned char* ws = ap->ws;
    pg8::Gemm g{(const bf16*)(ws + WS_Y), (const bf16*)(WLBASE(ws, l) + WL_WOUT), T, DM, DM}; pg8::StaticOrder S; S.init(T, DM, F.G, F.bid);
    pg8::EpiOutProj E{(const bf16*)(ws + WS_XB), (bf16*)(ws + WS_X1), DN_ALPHA};
    pg8::gemm_phase<pg8::EpiOutProj, pg8::StaticOrder, false>(F.lds, g, S, E, nullptr, F.tid); }
__device__ __forceinline__ void ph_ln1(int l, int wv) { const Frame F = make_frame(wv); phase_ln1_router<false>(F, args_here(), l); }
__device__ __forceinline__ void ph_ln1_dry(int l, int wv) { const Frame F = make_frame(wv); phase_ln1_router<true>(F, args_here(), l); }
__device__ __forceinline__ void ph_gather(int l, int wv) { const Frame F = make_frame(wv); phase_gather(F, args_here(), l); }
__device__ __forceinline__ void ph_moeup(int l, int wv) { const Frame F = make_frame(wv); unsigned char* ws = args_here()->ws;
    pg8::Gemm g{(const bf16*)(ws + WS_H), (const bf16*)(WLBASE(ws, l) + WL_WGU), 0, 0, DM / 2};   pg8::MoeOrder S{(const int*)(ws + WS_META) + l * 512, F.G, F.bid};
    pg8::EpiSwiGLU E{ws + WS_HID, (const int*)(ws + WS_SLOT + SL_TOK), 1};
    pg8::gemm_phase<pg8::EpiSwiGLU, pg8::MoeOrder, false>(F.lds, g, S, E, nullptr, F.tid); }
__device__ __forceinline__ void ph_moedown(int l, int wv) { const Frame F = make_frame(wv); unsigned char* ws = args_here()->ws;
    pg8::Gemm g{(const bf16*)(ws + WS_HID), (const bf16*)(WLBASE(ws, l) + WL_WDN), 0, 0, FF / 2}; pg8::MoeOrder S{(const int*)(ws + WS_META) + l * 512, F.G, F.bid};
    pg8::EpiDown E{(bf16*)(ws + WS_Y2), (const int*)(ws + WS_SLOT + SL_TOK), (const float*)(ws + WS_SLOT + SL_W)};
    pg8::gemm_phase<pg8::EpiDown, pg8::MoeOrder, false>(F.lds, g, S, E, nullptr, F.tid); }
__device__ __forceinline__ void ph_ln2(int l, int wv) { const Frame F = make_frame(wv); phase_ln2(F, args_here(), l); }

__global__ void __launch_bounds__(NTHR, 2) fwd_kernel(Args args) {
    extern __shared__ __attribute__((aligned(16))) unsigned char lds_raw[];
    (void)lds_raw; const int wv = 0; const Frame F = make_frame(wv);
    if (F.tid < 64) F.MISC[F.tid] = 0u;
    __syncthreads();
    XcdBarrier bar = xcd_barrier_post(F.ctl + CW_BAR, F.MISC + 8);
    const int lo = args_here()->ph_lo, hi = args_here()->ph_hi;
#define IN(k) (lo <= (k) && (k) < hi)
#define SEAM(k) do { if (IN(k) && IN((k) + 1)) { XcdBarrier bb = bar; asm volatile("" : "+s"(bb.bar)); xcd_barrier(bb); } } while (0)
#define RPT(bit, call) do { call; if (PROBE_REPEAT & (1u << (bit))) { XcdBarrier bb = bar; asm volatile("" : "+s"(bb.bar)); xcd_barrier(bb); call; } } while (0)
    if (IN(0)) ph_prologue(0, wv);
    SEAM(0);
#define LAYER_BODY(l) do { \
        const int pb = 1 + 10 * l; \
        if (IN(pb + 0)) RPT(0, ph_inproj(l, wv)); \
        SEAM(pb + 0); \
        if constexpr (SELFCHECK == 4) { \
        if (l == CHECK_LAYER) { { const Frame F2 = make_frame(wv); check_inproj(F2, args_here(), l); } XcdBarrier bb = bar; asm volatile("" : "+s"(bb.bar)); xcd_barrier(bb); } \
        } \
        if (IN(pb + 1)) { RPT(16, ph_compress(l, wv)); ph_gdnprep(l, wv); if (PROBE_REPEAT & (1u << 17)) { XcdBarrier bb = bar; asm volatile("" : "+s"(bb.bar)); xcd_barrier(bb); ph_gdnprep_var(l, wv); } RPT(18, ph_conformer(l, wv)); } \
        SEAM(pb + 1); \
        if (IN(pb + 2)) { ph_scan(l, wv); ph_bgweights(l, wv); if (PROBE_REPEAT & (1u << 19)) { XcdBarrier bb = bar; asm volatile("" : "+s"(bb.bar)); xcd_barrier(bb); ph_scan_var(l, wv); XcdBarrier bb2 = bar; asm volatile("" : "+s"(bb2.bar)); xcd_barrier(bb2); } ph_attn(l, 0, wv); if (PROBE_REPEAT & (1u << 20)) { XcdBarrier bb = bar; asm volatile("" : "+s"(bb.bar)); xcd_barrier(bb); ph_attn(l, 1, wv); } } \
        SEAM(pb + 2); \
        if (IN(pb + 3)) RPT(24, ph_gdnout(l, wv)); \
        SEAM(pb + 3); \
        if constexpr (SELFCHECK == 1 || SELFCHECK == 2 || SELFCHECK == 5) { \
        if (l == CHECK_LAYER) { { const Frame F2 = make_frame(wv); if (SELFCHECK == 1) check_nsa(F2, args_here()); else if (SELFCHECK == 2) check_gdn(F2, args_here(), l); else { check_compress(F2, args_here(), l); check_conformer(F2, args_here(), l); } } XcdBarrier bb = bar; asm volatile("" : "+s"(bb.bar)); xcd_barrier(bb); } \
        } \
        if (IN(pb + 4)) RPT(3, ph_outproj(l, wv)); \
        SEAM(pb + 4); \
        if (IN(pb + 5)) { ph_ln1(l, wv); if (PROBE_REPEAT & (1u << 4)) { XcdBarrier bb = bar; asm volatile("" : "+s"(bb.bar)); xcd_barrier(bb); ph_ln1_dry(l, wv); } \
            if (PROBE_REPEAT & (1u << 23)) { for (int rr = 0; rr < 4; ++rr) { XcdBarrier bb = bar; asm volatile("" : "+s"(bb.bar)); xcd_barrier(bb); } } } \
        SEAM(pb + 5); \
        if (IN(pb + 6)) RPT(5, ph_gather(l, wv)); \
        SEAM(pb + 6); \
        if (IN(pb + 7)) RPT(6, ph_moeup(l, wv)); \
        SEAM(pb + 7); \
        if (IN(pb + 8)) RPT(7, ph_moedown(l, wv)); \
        SEAM(pb + 8); \
        if constexpr (SELFCHECK == 3) { \
        if (l == CHECK_LAYER) { { const Frame F2 = make_frame(wv); check_moe(F2, args_here(), l); } XcdBarrier bb = bar; asm volatile("" : "+s"(bb.bar)); xcd_barrier(bb); } \
        } \
        if (IN(pb + 9)) { ph_ln2(l, wv); } \
        SEAM(pb + 9); \
     \
    } while (0)
    LAYER_BODY(0); LAYER_BODY(1); LAYER_BODY(2); LAYER_BODY(3);
#undef LAYER_BODY
#undef RPT
#if SELFCHECK
    { XcdBarrier bb = bar; asm volatile("" : "+s"(bb.bar)); xcd_barrier(bb); const Frame F2 = make_frame(wv); check_inject(F2, args_here()); }
#endif
#undef IN
#undef SEAM
}

extern "C" void kernel_launch(void* const* d_in, const int* in_sizes, int n_in, void* d_out, int out_size, void* d_ws, size_t ws_size, hipStream_t stream) {
    static int grid = 0;
    if (grid == 0) {
        if (n_in != 25 || in_sizes[0] != T * DM || out_size != T * DM || ws_size < WS_END) { fprintf(stderr, "kernel_launch: shape/workspace mismatch (n_in %d, in0 %d, out %d, ws %zu < %zu); nothing launched\n", n_in, n_in > 0 ? in_sizes[0] : -1, out_size, ws_size, (size_t)WS_END); grid = -1; return; }
        int dev = 0, cus = 0, per_cu = 0;
        if (hipGetDevice(&dev) != hipSuccess || hipDeviceGetAttribute(&cus, hipDeviceAttributeMultiprocessorCount, dev) != hipSuccess) { grid = -1; return; }
        if (hipFuncSetAttribute((const void*)fwd_kernel, hipFuncAttributeMaxDynamicSharedMemorySize, LDS_BYTES) != hipSuccess) { fprintf(stderr, "kernel_launch: hipFuncSetAttribute failed\n"); grid = -1; return; }
        if (hipOccupancyMaxActiveBlocksPerMultiprocessor(&per_cu, (const void*)fwd_kernel, NTHR, LDS_BYTES) != hipSuccess || per_cu < 1)
            fprintf(stderr, "kernel_launch: note: occupancy query reports %d workgroups per CU\n", per_cu);
        (void)hipGetLastError();
        grid = cus;
        if (grid < 32 || (grid & 7)) { fprintf(stderr, "kernel_launch: unexpected CU count %d\n", cus); }
    }
    if (grid < 0) return;
    if (hipMemsetAsync((char*)d_ws + WS_CTL, 0, CTL_ZERO_BYTES, stream) != hipSuccess) return;
    Args a{};
    for (int i = 0; i < 25; ++i) a.in[i] = (const float*)d_in[i];
    a.out = (float*)d_out; a.ws = (unsigned char*)d_ws;
#if MK_MULTI
    for (int p = 0; p < N_PHASES; ++p) { a.ph_lo = p; a.ph_hi = p + 1; hipLaunchKernelGGL(fwd_kernel, dim3(grid), dim3(NTHR), LDS_BYTES, stream, a); }
#else
    a.ph_lo = 0; a.ph_hi = N_PHASES;
    hipLaunchKernelGGL(fwd_kernel, dim3(grid), dim3(NTHR), LDS_BYTES, stream, a);
#endif
}
```

```cpp
#include <hip/hip_runtime.h>
#include <cstdio>
#include <cstdint>
namespace pg8 {
#define PG8_LAS __attribute__((address_space(3)))
typedef unsigned short bf16_t;
typedef short bf16x8 __attribute__((ext_vector_type(8)));
typedef float f32x4 __attribute__((ext_vector_type(4)));
typedef unsigned u32x4 __attribute__((ext_vector_type(4)));
constexpr int BM = 256, BK = 64, HALF = 128, HTB = HALF * BK * 2  , STAGE_BYTES = 8 * HTB, NXCD = 8, WGM = 8;

__host__ __device__ __forceinline__ int lds_byte(int r, int c) { const int st = (r >> 4) * 2 + (c >> 5), rr = r & 15, cc = c & 31, ob = rr * 64 + cc * 2; return st * 1024 + (ob ^ (((ob >> 9) & 1) << 5)); }
__host__ __device__ __forceinline__ void stage_rc(int b, int& R, int& C) { const int st = b / 1024, sb = b % 1024, swz = sb ^ (((sb >> 9) & 1) << 5); R = (st >> 1) * 16 + swz / 64; C = (st & 1) * 32 + (swz % 64) / 2; }
__host__ __device__ __forceinline__ int perm32(int rho) { const int n = rho >> 4, i = rho & 15; return 8 * (i >> 2) + 4 * n + (i & 3); }

struct Unit { int pm, pn; };
struct Gemm { const bf16_t* A; const bf16_t* Bt; int M, N, K; };

struct StaticOrder {
    int nM, nN, nwg, G, c;
    __host__ __device__ void init(int M, int N, int G_, int c_) { nM = M / BM; nN = N / BM; nwg = nM * nN; G = G_; c = c_; }
    __host__ __device__ bool next(int i, Unit& u) const {
        const long L = (long)i * G + c; if (L >= nwg) return false;
        int wgid = (int)L; { const int q = nwg / NXCD, r = nwg % NXCD, xcd = wgid % NXCD, off = wgid / NXCD; wgid = (xcd < r ? xcd * (q + 1) : r * (q + 1) + (xcd - r) * q) + off; }
        const int nig = WGM * nN, gid = wgid / nig, fm = gid * WGM, gsz = (nM - fm) < WGM ? (nM - fm) : WGM;
        u.pm = fm + ((wgid % nig) % gsz); u.pn = (wgid % nig) / gsz; return true;
    }
    __device__ __forceinline__ void a_ready(const Unit&) const {}
    __device__ __forceinline__ void done(const Unit&) const {}
};

__device__ __forceinline__ unsigned cvt_pk_bf16(float lo, float hi) { unsigned r; asm volatile("v_cvt_pk_bf16_f32 %0, %1, %2" : "=v"(r) : "v"(lo), "v"(hi)); return r; }
__device__ __forceinline__ float fast_sigmoid(float x) { return __builtin_amdgcn_rcpf(1.0f + __builtin_amdgcn_exp2f(-1.44269504089f * x)); }

constexpr int HLD = 2816;
constexpr float QSCALE = 0.125f * 1.44269504089f;

struct EpiInProj {
    static constexpr bool PERM = true, AFTER_DRAIN = false, GATHER = false, FP8 = true;
    bf16_t* H; float* side; const float* rope;
    __device__ __forceinline__ void operator()(const f32x4 (&acc)[2][2][4][2], const Unit& u, int wr, int wc, int fr, int fq) const {
        const int row0 = u.pm * BM + wr * 64 + fr; const int pn = u.pn;
        if (pn <= 4) {
#pragma unroll
            for (int ai = 0; ai < 2; ++ai)
#pragma unroll
                for (int m = 0; m < 4; ++m) {
                    const int row = row0 + ai * HALF + m * 16; const float* rp = rope + (size_t)(row & 4095) * 16;
                    const f32x4 c0 = *(const f32x4*)(rp), c1 = *(const f32x4*)(rp + 4), s0 = *(const f32x4*)(rp + 8), s1 = *(const f32x4*)(rp + 12);
#pragma unroll
                    for (int bj = 0; bj < 2; ++bj) {
                        f32x4 v0 = acc[ai][bj][m][0] * 0.03125f, v1 = acc[ai][bj][m][1] * 0.03125f;
                        const bool ropeb = (pn < 2) || (bj == 0);
                        if (ropeb) {
                            f32x4 p0, p1;
#pragma unroll
                            for (int e = 0; e < 4; ++e) { p0[e] = __shfl_xor(v0[e], 16); p1[e] = __shfl_xor(v1[e], 16); }
                            if (((wc & 1) == 0) && fq < 2) { const float sg = fq ? 1.f : -1.f; v0 = v0 * c0 + (p0 * s0) * sg; v1 = v1 * c1 + (p1 * s1) * sg; }
                        }
                        if (pn < 2) { v0 = v0 * QSCALE; v1 = v1 * QSCALE; }
                        u32x4 w; w.x = cvt_pk_bf16(v0[0], v0[1]); w.y = cvt_pk_bf16(v0[2], v0[3]); w.z = cvt_pk_bf16(v1[0], v1[1]); w.w = cvt_pk_bf16(v1[2], v1[3]);
                        *(u32x4*)(H + (size_t)row * HLD + pn * BM + bj * HALF + wc * 32 + 8 * fq) = w;
                    }
                }
        } else if (pn < 11) {
#pragma unroll
            for (int ai = 0; ai < 2; ++ai)
#pragma unroll
                for (int m = 0; m < 4; ++m) {
                    const int row = row0 + ai * HALF + m * 16;
#pragma unroll
                    for (int bj = 0; bj < 2; ++bj) {
                        const f32x4 v0 = acc[ai][bj][m][0] * 0.03125f, v1 = acc[ai][bj][m][1] * 0.03125f;
                        u32x4 w; w.x = cvt_pk_bf16(v0[0], v0[1]); w.y = cvt_pk_bf16(v0[2], v0[3]); w.z = cvt_pk_bf16(v1[0], v1[1]); w.w = cvt_pk_bf16(v1[2], v1[3]);
                        *(u32x4*)(H + (size_t)row * HLD + pn * BM + bj * HALF + wc * 32 + 8 * fq) = w;
                    }
                }
        } else if (wc == 0) {
#pragma unroll
            for (int ai = 0; ai < 2; ++ai)
#pragma unroll
                for (int m = 0; m < 4; ++m) {
                    const int row = row0 + ai * HALF + m * 16;
                    f32x4 v0 = acc[ai][0][m][0] * 0.03125f, v1 = acc[ai][0][m][1] * 0.03125f;
#pragma unroll
                    for (int e = 0; e < 4; ++e) { v0[e] = fast_sigmoid(v0[e]); if (fq < 3) v1[e] = fast_sigmoid(v1[e]); }
                    *(f32x4*)(side + (size_t)row * 32 + 8 * fq) = v0; *(f32x4*)(side + (size_t)row * 32 + 8 * fq + 4) = v1;
                }
        }
    }
};
struct EpiOutProj {
    static constexpr bool PERM = true, AFTER_DRAIN = false, GATHER = false, FP8 = false;
    const bf16_t* res; bf16_t* out; float alpha;
    __device__ __forceinline__ void operator()(const f32x4 (&acc)[2][2][4][2], const Unit& u, int wr, int wc, int fr, int fq) const {
        const int row0 = u.pm * BM + wr * 64 + fr, col0 = u.pn * BM + wc * 32 + 8 * fq;
#pragma unroll
        for (int ai = 0; ai < 2; ++ai)
#pragma unroll
            for (int m = 0; m < 4; ++m) { const size_t off = (size_t)(row0 + ai * HALF + m * 16) * 1024 + col0;
#pragma unroll
                for (int bj = 0; bj < 2; ++bj) { const u32x4 rb = *(const u32x4*)(res + off + bj * HALF);
                    f32x4 r0, r1; r0[0] = __uint_as_float(rb.x << 16); r0[1] = __uint_as_float(rb.x & 0xffff0000u); r0[2] = __uint_as_float(rb.y << 16); r0[3] = __uint_as_float(rb.y & 0xffff0000u);
                    r1[0] = __uint_as_float(rb.z << 16); r1[1] = __uint_as_float(rb.z & 0xffff0000u); r1[2] = __uint_as_float(rb.w << 16); r1[3] = __uint_as_float(rb.w & 0xffff0000u);
                    const f32x4 v0 = r0 * alpha + acc[ai][bj][m][0], v1 = r1 * alpha + acc[ai][bj][m][1];
                    u32x4 w; w.x = cvt_pk_bf16(v0[0], v0[1]); w.y = cvt_pk_bf16(v0[2], v0[3]); w.z = cvt_pk_bf16(v1[0], v1[1]); w.w = cvt_pk_bf16(v1[2], v1[3]);
                    *(u32x4*)(out + off + bj * HALF) = w; }
                asm volatile("" ::: "memory"); }
    }
};
struct EpiSwiGLU {
    static constexpr bool PERM = true, AFTER_DRAIN = false, GATHER = true, FP8 = true;
    unsigned char* hid; const int* rowmap; int rowshift;
    __device__ __forceinline__ void operator()(const f32x4 (&acc)[2][2][4][2], const Unit& u, int wr, int wc, int fr, int fq) const {
        const int row0 = u.pm * BM + wr * 64 + fr, hc0 = (u.pn & 3) * 128 + wc * 16 + 4 * fq;
#pragma unroll
        for (int ai = 0; ai < 2; ++ai)
#pragma unroll
            for (int m = 0; m < 4; ++m) { unsigned char* rowp = hid + (size_t)(row0 + ai * HALF + m * 16) * 512 + hc0;
#pragma unroll
                for (int bj = 0; bj < 2; ++bj) { const f32x4 g = acc[ai][bj][m][0] * 0.03125f, up = acc[ai][bj][m][1] * 0.03125f; f32x4 h;
#pragma unroll
                    for (int e = 0; e < 4; ++e) h[e] = __builtin_amdgcn_fmed3f(g[e] * fast_sigmoid(g[e]) * up[e], -440.f, 440.f);
                    int w = 0; w = __builtin_amdgcn_cvt_pk_fp8_f32(h[0], h[1], w, false); w = __builtin_amdgcn_cvt_pk_fp8_f32(h[2], h[3], w, true);
                    *(int*)(rowp + bj * 64) = w; } }
    }
};
struct EpiDown {
    static constexpr bool PERM = true, AFTER_DRAIN = false, GATHER = false, FP8 = true;
    bf16_t* y2; const int* slot_tok; const float* slot_w;
    __device__ __forceinline__ void operator()(const f32x4 (&acc)[2][2][4][2], const Unit& u, int wr, int wc, int fr, int fq) const {
        const int row0 = u.pm * BM + wr * 64 + fr, col0 = (u.pn & 3) * BM + wc * 32 + 8 * fq;
#pragma unroll
        for (int ai = 0; ai < 2; ++ai)
#pragma unroll
            for (int m = 0; m < 4; ++m) { const int row = row0 + ai * HALF + m * 16; const int st = slot_tok[row]; const float sw = slot_w[row] * 0.015625f;
                if (st >= 0) { bf16_t* rowp = y2 + (size_t)st * 1024 + col0;
#pragma unroll
                    for (int bj = 0; bj < 2; ++bj) { const f32x4 v0 = acc[ai][bj][m][0] * sw, v1 = acc[ai][bj][m][1] * sw;
                        u32x4 w; w.x = cvt_pk_bf16(v0[0], v0[1]); w.y = cvt_pk_bf16(v0[2], v0[3]); w.z = cvt_pk_bf16(v1[0], v1[1]); w.w = cvt_pk_bf16(v1[2], v1[3]);
                        *(u32x4*)(rowp + bj * HALF) = w; } } }
    }
};
struct MoeOrder {
    const int* meta; int G, c;
    __device__ __forceinline__ bool next(int i, Unit& u) const {
        const int per = G >> 3; const int idx = (G & 7) ? (i * G + c) : ((i * 8 + (c & 7)) * per + (c >> 3));
        const int nt = __builtin_amdgcn_readfirstlane(meta[0]); if (idx >= nt * 4) return false;
        const int pm = idx >> 2; u.pm = pm; u.pn = __builtin_amdgcn_readfirstlane(meta[64 + pm]) * 4 + (idx & 3); return true;
    }
    __device__ __forceinline__ void a_ready(const Unit&) const {}
    __device__ __forceinline__ void done(const Unit&) const {}
};
typedef int v4i_ __attribute__((ext_vector_type(4)));
typedef int v8i_ __attribute__((ext_vector_type(8)));
template <class Epi, class Sched, bool STAMP = false>
__device__ __forceinline__ void gemm_phase(PG8_LAS unsigned char* lds, const Gemm g, const Sched& S, const Epi& E, unsigned long long* stamps, int tid_in) {
    int tid_ = tid_in; asm volatile("" : "+v"(tid_));
    const int tid = tid_, wid = __builtin_amdgcn_readfirstlane(tid >> 6), lane = tid & 63, wr = wid >> 2, wc = wid & 3, fr = lane & 15, fq = lane >> 4;
    const int K = g.K, nt = K / BK;
    int ts_lo = 0, ts_hi = 0, nts = 0; const unsigned long long rt_entry = STAMP ? (unsigned long long)wall_clock64() : 0ull;
#define PG8_STAMP() do { if (STAMP && wid == 0 && nts < 64) { const unsigned long long _c = (unsigned long long)clock64(); \
        ts_lo = (lane == nts) ? (int)(unsigned)_c : ts_lo; ts_hi = (lane == nts) ? (int)(unsigned)(_c >> 32) : ts_hi; ++nts; } } while (0)
    PG8_STAMP();
    unsigned voffA[2], voffB[2];
#pragma unroll
    for (int i = 0; i < 2; ++i) { int R, C; stage_rc(tid * 16 + i * 8192, R, C); const int Rb = Epi::PERM ? ((R & ~31) + perm32(R & 31)) : R;
        voffA[i] = (unsigned)(R * K + C) * 2u; voffB[i] = (unsigned)(Rb * K + C) * 2u; }
    unsigned offAc[2][2], offAn[2][2];
    PG8_LAS unsigned char* gidx = lds + STAGE_BYTES + (unsigned)wid * 1024u;
#define PG8_IDX_DMA(par, pm_) do { int t2_ = tid; asm volatile("" : "+v"(t2_)); _Pragma("unroll") for (int i_ = 0; i_ < 2; ++i_) { int R_, C_; stage_rc(t2_ * 16 + i_ * 8192, R_, C_); (void)C_; \
        _Pragma("unroll") for (int h_ = 0; h_ < 2; ++h_) __builtin_amdgcn_global_load_lds((const unsigned*)(E.rowmap + (size_t)(pm_) * BM + h_ * HALF + R_), (PG8_LAS unsigned*)(gidx + (par) * 512 + (h_ * 2 + i_) * 256), 4, 0, 0); } } while (0)
#define PG8_IDX_READ(dst, par) do { int t2_ = tid; asm volatile("" : "+v"(t2_)); _Pragma("unroll") for (int i_ = 0; i_ < 2; ++i_) { int R_, C_; stage_rc(t2_ * 16 + i_ * 8192, R_, C_); (void)R_; \
        _Pragma("unroll") for (int h_ = 0; h_ < 2; ++h_) { int r_ = *(const PG8_LAS int*)(gidx + (par) * 512 + (h_ * 2 + i_) * 256 + (t2_ & 63) * 4); r_ = r_ < 0 ? 0 : (r_ >> E.rowshift); dst[h_][i_] = (unsigned)r_ * (unsigned)(K * 2) + (unsigned)C_ * 2u; } } } while (0)
    const size_t kstep = (size_t)(BK * 2);
    const size_t hstep = (size_t)HALF * K * 2;
    const size_t tstep = 2 * hstep;
    const unsigned ldsw = (unsigned)wid * 1024u;
    const int aoff = lds_byte(wr * 64 + fr, fq * 8), boff = lds_byte(wc * 32 + fr, fq * 8);
#define PG8_SA(b, h) (((b) * 2 + (h)) * HTB)
#define PG8_SB(b, h) ((4 + (b) * 2 + (h)) * HTB)
#define PG8_STAGE(bufoff, gbase, voff) do { _Pragma("unroll") for (int _i = 0; _i < 2; ++_i) \
        __builtin_amdgcn_global_load_lds((const unsigned*)((const char*)(gbase) + (voff)[_i]), (PG8_LAS unsigned*)(lds + (bufoff) + ldsw + _i * 8192), 16, 0, 0); } while (0)
#define PG8_STAGE_A(bufoff, kt_, h_, nx_) do { if constexpr (Epi::GATHER) { _Pragma("unroll") for (int _i = 0; _i < 2; ++_i) { const unsigned o_ = (nx_) ? offAn[h_][_i] : offAc[h_][_i]; \
            __builtin_amdgcn_global_load_lds((const unsigned*)((const char*)g.A + (size_t)(kt_) * kstep + o_), (PG8_LAS unsigned*)(lds + (bufoff) + ldsw + _i * 8192), 16, 0, 0); } } \
        else { PG8_STAGE(bufoff, ((nx_) ? nA : cA) + (size_t)(kt_) * kstep + (h_) * hstep, voffA); } } while (0)
#define PG8_LDA(dst, b, h) do { _Pragma("unroll") for (int m = 0; m < 4; ++m) _Pragma("unroll") for (int k = 0; k < 2; ++k) dst[m][k] = *(const PG8_LAS bf16x8*)(lds + PG8_SA(b, h) + aoff + m * 2048 + k * 1024); } while (0)
#define PG8_LDB(dst, b, h) do { _Pragma("unroll") for (int n = 0; n < 2; ++n) _Pragma("unroll") for (int k = 0; k < 2; ++k) dst[n][k] = *(const PG8_LAS bf16x8*)(lds + PG8_SB(b, h) + boff + n * 2048 + k * 1024); } while (0)
#define PG8_MMA(ai, bj, At, Bt) do { __builtin_amdgcn_s_setprio(1); \
        if constexpr (Epi::FP8) {   \
            _Pragma("unroll") for (int m = 0; m < 4; ++m) _Pragma("unroll") for (int n = 0; n < 2; ++n) \
                { const v8i_ b8_ = __builtin_shufflevector(__builtin_bit_cast(v4i_, Bt[n][0]), __builtin_bit_cast(v4i_, Bt[n][1]), 0, 1, 2, 3, 4, 5, 6, 7), \
                             a8_ = __builtin_shufflevector(__builtin_bit_cast(v4i_, At[m][0]), __builtin_bit_cast(v4i_, At[m][1]), 0, 1, 2, 3, 4, 5, 6, 7); \
                    \
                  asm volatile("v_mfma_f32_16x16x128_f8f6f4 %0, %1, %2, %0" : "+v"(acc[ai][bj][m][n]) : "v"(b8_), "v"(a8_)); } } \
        else { _Pragma("unroll") for (int m = 0; m < 4; ++m) _Pragma("unroll") for (int n = 0; n < 2; ++n) _Pragma("unroll") for (int k = 0; k < 2; ++k) \
            acc[ai][bj][m][n] = __builtin_amdgcn_mfma_f32_16x16x32_bf16(Bt[n][k], At[m][k], acc[ai][bj][m][n], 0, 0, 0); } \
        __builtin_amdgcn_s_setprio(0); } while (0)
#define PG8_WAIT_V(n) asm volatile("s_waitcnt vmcnt(" #n ")" ::: "memory")
#define PG8_WAIT_L(n) asm volatile("s_waitcnt lgkmcnt(" #n ")" ::: "memory")
#define PG8_BAR __builtin_amdgcn_s_barrier()
#define PG8_SCHED __builtin_amdgcn_sched_barrier(0)
    Unit cur, nxt; int ui = 0;
    if (!S.next(0, cur)) return;
    f32x4 acc[2][2][4][2];
    float zf_ = 0.f; asm volatile("" : "+v"(zf_));
#pragma unroll
    for (int a = 0; a < 2; ++a)
#pragma unroll
        for (int b = 0; b < 2; ++b)
#pragma unroll
            for (int m = 0; m < 4; ++m)
#pragma unroll
                for (int n = 0; n < 2; ++n) acc[a][b][m][n] = (f32x4){zf_, zf_, zf_, zf_};
    bf16x8 At[4][2], B0[2][2], B1[2][2];
    const char* cA = (const char*)g.A + (size_t)cur.pm * tstep; const char* cB = (const char*)g.Bt + (size_t)cur.pn * tstep;
    S.a_ready(cur);
    if constexpr (Epi::GATHER) { PG8_IDX_DMA(0, cur.pm); asm volatile("s_waitcnt vmcnt(0)" ::: "memory"); PG8_IDX_READ(offAc, 0); asm volatile("s_waitcnt lgkmcnt(0)" ::: "memory"); }
    const char* nA = cA;
    PG8_STAGE(PG8_SB(0, 0), cB, voffB); PG8_STAGE_A(PG8_SA(0, 0), 0, 0, false); PG8_STAGE(PG8_SB(0, 1), cB + hstep, voffB); PG8_STAGE_A(PG8_SA(0, 1), 0, 1, false);
    if (wr == 1) PG8_BAR;
    PG8_WAIT_V(4); PG8_BAR;
    PG8_STAGE(PG8_SB(1, 0), cB + kstep, voffB); PG8_STAGE_A(PG8_SA(1, 0), 1, 0, false); PG8_STAGE(PG8_SB(1, 1), cB + hstep + kstep, voffB);
    PG8_WAIT_V(6); PG8_BAR;
    PG8_STAMP();
    for (;;) {
        const bool has_next = S.next(ui + 1, nxt);
        nA = has_next ? (const char*)g.A + (size_t)nxt.pm * tstep : cA; const char* nB = has_next ? (const char*)g.Bt + (size_t)nxt.pn * tstep : cB;
        if constexpr (Epi::GATHER) { if (has_next) PG8_IDX_DMA((ui + 1) & 1, nxt.pm); }
#pragma unroll 1
        for (int t = 0; t < nt; t += 2) {
            const bool last = (t == nt - 2);
            const char* b2 = last ? nB : cB + (size_t)(t + 2) * kstep;
            const char* b3 = b2 + kstep;
            const int kt2 = last ? 0 : t + 2;
            if constexpr (Epi::GATHER) { if (last) { if (has_next) PG8_IDX_READ(offAn, (ui + 1) & 1); else { offAn[0][0] = offAc[0][0]; offAn[0][1] = offAc[0][1]; offAn[1][0] = offAc[1][0]; offAn[1][1] = offAc[1][1]; } } }
            if (last && has_next) S.a_ready(nxt);
            PG8_LDB(B0, 0, 0); PG8_SCHED; PG8_LDA(At, 0, 0); PG8_STAGE_A(PG8_SA(1, 1), t + 1, 1, false);
            PG8_WAIT_L(8); PG8_BAR; PG8_WAIT_L(0); PG8_MMA(0, 0, At, B0); PG8_BAR; PG8_SCHED;
            PG8_LDB(B1, 0, 1); PG8_STAGE(PG8_SB(0, 0), b2, voffB);
            PG8_BAR; PG8_WAIT_L(0); PG8_MMA(0, 1, At, B1); PG8_BAR;
            PG8_LDA(At, 0, 1); PG8_STAGE_A(PG8_SA(0, 0), kt2, 0, last);
            PG8_BAR; PG8_WAIT_L(0); PG8_MMA(1, 0, At, B0); PG8_BAR; PG8_SCHED;
            PG8_STAGE(PG8_SB(0, 1), b2 + hstep, voffB);
            PG8_WAIT_V(6); PG8_BAR; PG8_MMA(1, 1, At, B1); PG8_BAR;
            PG8_LDB(B0, 1, 0); PG8_SCHED; PG8_LDA(At, 1, 0); PG8_STAGE_A(PG8_SA(0, 1), kt2, 1, last);
            PG8_WAIT_L(8); PG8_BAR; PG8_WAIT_L(0); PG8_MMA(0, 0, At, B0); PG8_BAR; PG8_SCHED;
            PG8_LDB(B1, 1, 1); PG8_STAGE(PG8_SB(1, 0), b3, voffB);
            PG8_BAR; PG8_WAIT_L(0); PG8_MMA(0, 1, At, B1); PG8_BAR;
            PG8_LDA(At, 1, 1); PG8_STAGE_A(PG8_SA(1, 0), kt2 + 1, 0, last);
            PG8_BAR; PG8_WAIT_L(0); PG8_MMA(1, 0, At, B0); PG8_BAR; PG8_SCHED;
            PG8_STAGE(PG8_SB(1, 1), b3 + hstep, voffB);
            PG8_WAIT_V(6); PG8_BAR; PG8_MMA(1, 1, At, B1); PG8_BAR;
        }
        PG8_STAMP();
        if constexpr (Epi::FP8) asm volatile("s_nop 15\n\ts_nop 15" ::: "memory");
        if constexpr (!Epi::AFTER_DRAIN) { E(acc, cur, wr, wc, fr, fq); S.done(cur); }
        PG8_STAMP();
        if (!has_next) break;
#pragma unroll
        for (int a = 0; a < 2; ++a)
#pragma unroll
            for (int b = 0; b < 2; ++b)
#pragma unroll
                for (int m = 0; m < 4; ++m)
#pragma unroll
                    for (int n = 0; n < 2; ++n) acc[a][b][m][n] = (f32x4){zf_, zf_, zf_, zf_};
        cur = nxt; cA = nA; cB = nB; ++ui;
        if constexpr (Epi::GATHER) { offAc[0][0] = offAn[0][0]; offAc[0][1] = offAn[0][1]; offAc[1][0] = offAn[1][0]; offAc[1][1] = offAn[1][1]; }
    }
    PG8_WAIT_V(0);
    if (wr == 0) PG8_BAR;
    PG8_BAR;
    if constexpr (Epi::AFTER_DRAIN) { E.fused(acc, cur, wr, wc, fr, fq, lds, wid, lane); S.done(cur); }
    PG8_STAMP();
    if (STAMP && wid == 0) { stamps[lane] = lane < nts ? (((unsigned long long)(unsigned)ts_hi << 32) | (unsigned)ts_lo) : 0ull;
        if (lane == 62) stamps[62] = rt_entry; if (lane == 63) stamps[63] = (unsigned long long)wall_clock64(); }
#undef PG8_STAMP
#undef PG8_SA
#undef PG8_SB
#undef PG8_STAGE
#undef PG8_STAGE_A
#undef PG8_IDX_DMA
#undef PG8_IDX_READ
#undef PG8_LDA
#undef PG8_LDB
#undef PG8_MMA
#undef PG8_WAIT_V
#undef PG8_WAIT_L
#undef PG8_BAR
#undef PG8_SCHED
}
}

#ifndef SELFCHECK
#define SELFCHECK 0
#endif
#ifndef PROBE_GDN_VAR
#define PROBE_GDN_VAR 0
#endif
#ifndef PROBE_SCAN_VAR
#define PROBE_SCAN_VAR 0
#endif
#ifndef PROBE_ATTN_VAR
#define PROBE_ATTN_VAR 0
#endif
constexpr int NB = 8, SEQ = 4096, DM = 1024, NL = 4, T = NB * SEQ;
constexpr int DIN = 2848, DINP = 3072, HLD = pg8::HLD;
constexpr int NEXP = 32, FF = 512, NTILE_MAX = 288;
constexpr float LN_EPS = 1e-5f;
constexpr float DN_ALPHA = 1.6817928305074290f;
constexpr int NWAVES = 8, NTHR = 512;

constexpr size_t MiB = 1u << 20, KiB = 1u << 10;
constexpr size_t WS_CTL = 0, CTL_ZERO_BYTES = 128 * KiB;
constexpr size_t WS_ROPE = 1 * MiB;
constexpr size_t WS_META = 1 * MiB + 512 * KiB;
constexpr size_t WS_GL = WS_META + 16 * KiB;
constexpr size_t WS_WL = 2 * MiB;
constexpr size_t WL_WIN = 0, WL_WOUT = 6 * MiB, WL_WGU = 8 * MiB, WL_WDN = 72 * MiB, WL_W1 = 104 * MiB, WL_W2 = 105 * MiB, WL_BIAS1 = 105 * MiB + 64 * KiB, WL_WR = 105 * MiB + 128 * KiB;
constexpr size_t WS_XB = 108 * MiB;
constexpr size_t WS_X1 = 172 * MiB;
constexpr size_t WS_H = 300 * MiB;
constexpr size_t WS_SIDE = 476 * MiB;
constexpr size_t WS_Y = 480 * MiB;
constexpr size_t WS_GPREP = 544 * MiB;
constexpr size_t WS_Y2 = 672 * MiB;
constexpr size_t WS_HID = 800 * MiB;
constexpr size_t WS_X8 = 839 * MiB;
constexpr size_t WS_KC = 872 * MiB, WS_VC = WS_KC + 512 * KiB;
constexpr size_t WS_SLOT = 873 * MiB;
constexpr size_t SL_TOK = 0, SL_W = 512 * KiB, SL_RE = 1024 * KiB, SL_RP = 1280 * KiB, SL_RW = 1536 * KiB;
constexpr size_t WS_WL2 = 876 * MiB;
constexpr size_t WS_END = 982 * MiB;
#define WLBASE(ws_, l_) ((ws_) + (((l_) & 1) ? WS_WL2 : WS_WL))
constexpr int GCH = 65536;
constexpr int GC_UT = 0, GC_W = 8192, GC_QK = 16384, GC_QD = 24576, GC_KDT = 32768, GC_ZT = 40960, GC_SS = 49152, GC_VB = 57344;
constexpr int CW_TMO = 0;
constexpr int CW_BAR = 4096;
constexpr int CW_CNT = 8192;
constexpr int CW_QUEUE = 12288;
static_assert((CW_QUEUE + NL * 64) * 4 <= (int)CTL_ZERO_BYTES, "CTL words inside the memset region");

constexpr int SCR_BYTES = 159744;
constexpr int MISC_OFF = SCR_BYTES;
constexpr int LDS_BYTES = 163840;

#define GAS __attribute__((address_space(1)))
#define LAS __attribute__((address_space(3)))
typedef unsigned short bf16;
typedef float f32x4 __attribute__((ext_vector_type(4)));
typedef float f32x2 __attribute__((ext_vector_type(2)));
typedef float f32x16 __attribute__((ext_vector_type(16)));
typedef short bf16x8 __attribute__((ext_vector_type(8)));
typedef short s16x4 __attribute__((ext_vector_type(4)));
typedef unsigned u32x4 __attribute__((ext_vector_type(4)));
typedef unsigned u32x2 __attribute__((ext_vector_type(2)));
#define LDS_WAIT() asm volatile("s_waitcnt lgkmcnt(0)" ::: "memory")
#define VM_WAIT() asm volatile("s_waitcnt vmcnt(0)" ::: "memory")
#define SBAR() __builtin_amdgcn_sched_barrier(0)
__device__ __forceinline__ float bf2f(unsigned b) { return __uint_as_float(b << 16); }
__device__ __forceinline__ unsigned pk2(float lo, float hi) { return pg8::cvt_pk_bf16(lo, hi); }
__device__ __forceinline__ unsigned f2bf_sw(float f) { unsigned u = __float_as_uint(f); return (u + 0x7fffu + ((u >> 16) & 1u)) >> 16; }
__device__ __forceinline__ unsigned f2bf(float f) { unsigned r; asm("v_cvt_pk_bf16_f32 %0, %1, %1" : "=v"(r) : "v"(f)); return r & 0xffffu; }
__device__ __forceinline__ float row16_sum(float x) {
    x += __int_as_float(__builtin_amdgcn_update_dpp(0, __float_as_int(x), 0xB1, 0xf, 0xf, true));
    x += __int_as_float(__builtin_amdgcn_update_dpp(0, __float_as_int(x), 0x4E, 0xf, 0xf, true));
    x += __int_as_float(__builtin_amdgcn_update_dpp(0, __float_as_int(x), 0x141, 0xf, 0xf, true));
    x += __int_as_float(__builtin_amdgcn_update_dpp(0, __float_as_int(x), 0x140, 0xf, 0xf, true));
    return x;
}
__device__ __forceinline__ float wave_sum(float v) {
    const int r = __float_as_int(row16_sum(v));
    return (__int_as_float(__builtin_amdgcn_readlane(r, 0)) + __int_as_float(__builtin_amdgcn_readlane(r, 16))) + (__int_as_float(__builtin_amdgcn_readlane(r, 32)) + __int_as_float(__builtin_amdgcn_readlane(r, 48)));
}
__device__ __forceinline__ float fsigmoid(float x) { return pg8::fast_sigmoid(x); }
__device__ __forceinline__ float fsilu(float x) { return x * pg8::fast_sigmoid(x); }
__device__ __forceinline__ float fexp2(float x) { return __builtin_amdgcn_exp2f(x); }

#define XB_TMO      128
#define XB_XCNT(j)  (256  + 64 * (j))
#define XB_XSUB(j)  (1280 + 64 * (j))
#define XB_XGEN(j)  (2304 + 64 * (j))
#define XB_TOP      3328
#define XB_TOPGEN   3392
#define XCD_BAR_WORDS 3456
#define XB_SPIN_CAP (1u << 18)
#define LAS __attribute__((address_space(3)))

__device__ __forceinline__ unsigned xb_ld(unsigned* p)              { return __hip_atomic_load(p, __ATOMIC_RELAXED, __HIP_MEMORY_SCOPE_AGENT); }
__device__ __forceinline__ unsigned xb_add(unsigned* p, unsigned v) { return __hip_atomic_fetch_add(p, v, __ATOMIC_RELAXED, __HIP_MEMORY_SCOPE_AGENT); }
__device__ __forceinline__ unsigned xb_xcc_id() { return (unsigned)__builtin_amdgcn_s_getreg((3 << 11) | 20) & 0xFu; }
#define XB_SPIN(cond, bar) do { unsigned _sp = 0; while (cond) { __builtin_amdgcn_s_sleep(1); \
    if ((++_sp & 255u) == 0u) { if (xb_ld(&(bar)[XB_TMO])) break; if (_sp > XB_SPIN_CAP) { atomicAdd(&(bar)[XB_TMO], 1u); break; } } } } while (0)

struct XcdBarrier {
    unsigned* bar; unsigned x;
    volatile LAS unsigned* st;
};

__device__ __forceinline__ XcdBarrier xcd_barrier_post(unsigned* bar, volatile LAS unsigned* st) {
    XcdBarrier b; b.bar = bar; b.x = xb_xcc_id(); b.st = st;
    if (threadIdx.x == 0) (void)xb_add(&bar[XB_XCNT(b.x)], 1u);
    return b;
}
__device__ __forceinline__ void xcd_barrier_complete(unsigned* bar, unsigned x, unsigned& nloc, unsigned& nx) {
    const unsigned G = gridDim.x * gridDim.y * gridDim.z;
    unsigned sum, cnt, mine, sp = 0u;
    for (;;) {
        sum = 0u; cnt = 0u; mine = 0u;
#pragma unroll
        for (unsigned j = 0; j < 16; ++j) { const unsigned c = xb_ld(&bar[XB_XCNT(j)]); sum += c; cnt += (c > 0u) ? 1u : 0u; mine = (j == x) ? c : mine; }
        if (sum == G) break;
        __builtin_amdgcn_s_sleep(1);
        if ((++sp & 255u) == 0u) { if (xb_ld(&bar[XB_TMO])) break; if (sp > XB_SPIN_CAP) { atomicAdd(&bar[XB_TMO], 1u); break; } }
    }
    nloc = mine > 0u ? mine : 1u; nx = cnt > 0u ? cnt : 1u;
}

__device__ __forceinline__ void xcd_barrier(const XcdBarrier& b) {
    asm volatile("s_waitcnt vmcnt(0)" ::: "memory");
    __syncthreads();
    if (threadIdx.x == 0) {
        unsigned* bar = b.bar;
        __builtin_amdgcn_s_waitcnt(0);
        unsigned nloc = b.st[0], nx = b.st[1];
        if (nloc == 0u) { xcd_barrier_complete(bar, b.x, nloc, nx); b.st[0] = nloc; b.st[1] = nx; }
        const unsigned old = xb_add(&bar[XB_XSUB(b.x)], 1u);
        const unsigned gen = old / nloc;
        if (old + 1u == (gen + 1u) * nloc) {
            __builtin_amdgcn_fence(__ATOMIC_RELEASE, "agent");
            asm volatile("s_waitcnt vmcnt(0)" ::: "memory");
            const unsigned og = xb_add(&bar[XB_TOP], 1u);
            const unsigned tg = og / nx;
            if (og + 1u == (tg + 1u) * nx) xb_add(&bar[XB_TOPGEN], 1u);
            else XB_SPIN(xb_ld(&bar[XB_TOPGEN]) == tg, bar);
            __builtin_amdgcn_fence(__ATOMIC_ACQUIRE, "agent");
            xb_add(&bar[XB_XGEN(b.x)], 1u);
            asm volatile("s_waitcnt vmcnt(0)" ::: "memory");
        } else {
            XB_SPIN(xb_ld(&bar[XB_XGEN(b.x)]) == gen, bar);
            __builtin_amdgcn_fence(__ATOMIC_ACQUIRE, "agent");
            asm volatile("s_waitcnt vmcnt(0)" ::: "memory");
        }
    }
    __syncthreads();
}

struct Args { const float* in[25]; float* out; unsigned char* ws; int ph_lo, ph_hi; };
typedef const __attribute__((address_space(4))) Args* ArgsP;
__device__ __forceinline__ ArgsP args_here() { ArgsP p = (ArgsP)__builtin_amdgcn_kernarg_segment_ptr(); asm volatile("" : "+s"(p)); return p; }
struct Frame { LAS unsigned char* lds; volatile LAS unsigned* MISC; unsigned* ctl; int tid, lane, wave, G, bid; };

template <class Src>
__device__ __forceinline__ void tr_item(const Src src, int K, int N, bf16* WT, LAS float* scr, int item, int lane) {
    const int nblk = N >> 5, kb = item / nblk, nb = item - kb * nblk, k0 = kb << 6, n0 = nb << 5;
    float tv[32];
#pragma unroll
    for (int i = 0; i < 32; ++i) tv[i] = src(k0 + 2 * i + (lane >> 5), n0 + (lane & 31));
#pragma unroll
    for (int i = 0; i < 32; ++i) scr[(2 * i + (lane >> 5)) * 33 + (lane & 31)] = tv[i];
    LDS_WAIT();
    const int c = lane & 7;
#pragma unroll
    for (int j = 0; j < 4; ++j) { const int n = (lane >> 3) + 8 * j; const LAS float* s = scr + (8 * c) * 33 + n;
        u32x4 o; o.x = pk2(s[0], s[33]); o.y = pk2(s[66], s[99]); o.z = pk2(s[132], s[165]); o.w = pk2(s[198], s[231]);
        *(u32x4*)(WT + (size_t)(n0 + n) * K + k0 + 8 * c) = o; }
    LDS_WAIT();
}
template <class Src>
__device__ __forceinline__ void tr8_load(const Src src, int N, int item, int lane, float (&tv)[32]) {
    const int nblk = N >> 5, kb = item / nblk, nb = item - kb * nblk, k0 = kb << 6, n0 = nb << 5;
#pragma unroll
    for (int i = 0; i < 32; ++i) tv[i] = src(k0 + 2 * i + (lane >> 5), n0 + (lane & 31));
}
__device__ __forceinline__ void tr8_finish(const float (&tv)[32], int K, int N, unsigned char* WT, float mul, LAS float* scr, int item, int lane) {
    const int nblk = N >> 5, kb = item / nblk, nb = item - kb * nblk, k0 = kb << 6, n0 = nb << 5;
#pragma unroll
    for (int i = 0; i < 32; ++i) scr[(2 * i + (lane >> 5)) * 33 + (lane & 31)] = tv[i];
    LDS_WAIT();
    const int n = lane >> 1, kh = (lane & 1) * 32; const LAS float* sp = scr + kh * 33 + n;
#pragma unroll
    for (int q = 0; q < 2; ++q) { u32x4 o;
#pragma unroll
        for (int d = 0; d < 4; ++d) { const LAS float* s4 = sp + (16 * q + 4 * d) * 33; int w = 0;
            w = __builtin_amdgcn_cvt_pk_fp8_f32(s4[0] * mul, s4[33] * mul, w, false); w = __builtin_amdgcn_cvt_pk_fp8_f32(s4[66] * mul, s4[99] * mul, w, true); o[d] = (unsigned)w; }
        *(u32x4*)(WT + (size_t)(n0 + n) * K + k0 + kh + 16 * q) = o; }
    LDS_WAIT();
}
struct SrcPlain { const float* p; int ld; __device__ __forceinline__ float operator()(int k, int n) const { return p[(size_t)k * ld + n]; } };
struct SrcWin { const float* p;
    __device__ __forceinline__ float operator()(int k, int n) const {
        int c;
        if (n < 1280) c = n; else if (n < 2048) c = n + 24; else if (n < 2304) c = n + 24; else if (n < 2816) c = n + 32;
        else if (n < 2840) c = n - 2816 + 1280; else if (n < 2844) c = n - 2840 + 2328; else if (n < 2848) c = n - 2844 + 2332; else return 0.f;
        return p[(size_t)k * DIN + c]; } };
struct SrcGU { const float* wg; const float* wu;
    __device__ __forceinline__ float operator()(int k, int n) const { const int q = n >> 3, r = n & 7; const ptrdiff_t d = (r < 4) ? (ptrdiff_t)0 : (wu - wg); return wg[d + (ptrdiff_t)k * FF + 4 * q + (r & 3)]; } };

__device__ __forceinline__ void phase_weights(const Frame& F, ArgsP a, int l, int parts, int nblk, int lds_off) {
    unsigned char* wl = WLBASE(a->ws, l);
    LAS float* scr = (LAS float*)(F.lds + lds_off + F.wave * 8448);
    const int gw = F.bid * NWAVES + F.wave, NGW = nblk * NWAVES;
    constexpr int I_WIN = 16 * 96, I_WOUT = 16 * 32, I_GU1 = 16 * 32, I_GU = NEXP * I_GU1, I_DN1 = 8 * 32, I_DN = NEXP * I_DN1, I_W1 = 2 * 32 * 4, I_W2 = 2 * 2 * 2, I_WR = 36, I_B1 = 256;
    constexpr int NITEMS = I_WIN + I_WOUT + I_GU + I_DN + I_W1 + I_W2 + I_WR + I_B1;
    if (parts & 1) {
        for (int r = gw; r < I_GU; r += 2 * NGW) { const int r2 = r + NGW; const bool two = r2 < I_GU; const int e = r / I_GU1, e2 = (two ? r2 : r) / I_GU1; float tva[32], tvb[32];
            SrcGU sa{a->in[22] + ((size_t)l * NEXP + e) * DM * FF, a->in[23] + ((size_t)l * NEXP + e) * DM * FF}, sb{a->in[22] + ((size_t)l * NEXP + e2) * DM * FF, a->in[23] + ((size_t)l * NEXP + e2) * DM * FF};
            tr8_load(sa, 1024, r - e * I_GU1, F.lane, tva); tr8_load(sb, 1024, (two ? r2 : r) - e2 * I_GU1, F.lane, tvb);
            tr8_finish(tva, DM, 1024, wl + WL_WGU + (size_t)e * 1024 * DM, 32.f, scr, r - e * I_GU1, F.lane);
            if (two) tr8_finish(tvb, DM, 1024, wl + WL_WGU + (size_t)e2 * 1024 * DM, 32.f, scr, r2 - e2 * I_GU1, F.lane); }
        for (int r = gw; r < I_DN; r += 2 * NGW) { const int r2 = r + NGW; const bool two = r2 < I_DN; const int e = r / I_DN1, e2 = (two ? r2 : r) / I_DN1; float tva[32], tvb[32];
            SrcPlain sa{a->in[24] + ((size_t)l * NEXP + e) * FF * DM, DM}, sb{a->in[24] + ((size_t)l * NEXP + e2) * FF * DM, DM};
            tr8_load(sa, DM, r - e * I_DN1, F.lane, tva); tr8_load(sb, DM, (two ? r2 : r) - e2 * I_DN1, F.lane, tvb);
            tr8_finish(tva, FF, DM, wl + WL_WDN + (size_t)e * DM * FF, 64.f, scr, r - e * I_DN1, F.lane);
            if (two) tr8_finish(tvb, FF, DM, wl + WL_WDN + (size_t)e2 * DM * FF, 64.f, scr, r2 - e2 * I_DN1, F.lane); }
    }
    if (!(parts & 2)) return;
    for (int it = I_GU + I_DN + gw; it < NITEMS; it += NGW) {
        int r = it - I_GU - I_DN;
        if (r < I_WIN) { SrcWin s{a->in[1] + (size_t)l * DM * DIN}; float tv[32]; tr8_load(s, DINP, r, F.lane, tv); tr8_finish(tv, DM, DINP, wl + WL_WIN, 32.f, scr, r, F.lane); continue; } r -= I_WIN;
        if (r < I_WOUT) { SrcPlain s{a->in[2] + (size_t)l * DM * DM, DM}; tr_item(s, DM, DM, (bf16*)(wl + WL_WOUT), scr, r, F.lane); continue; } r -= I_WOUT;
        if (r < I_W1) { const int kv = r / 128; SrcPlain s{a->in[4] + ((size_t)l * 2 + kv) * 2048 * 128, 128};
            tr_item(s, 2048, 128, (bf16*)(wl + WL_W1) + (size_t)kv * 128 * 2048, scr, r - kv * 128, F.lane); continue; } r -= I_W1;
        if (r < I_W2) { const int kv = r / 4; SrcPlain s{a->in[5] + ((size_t)l * 2 + kv) * 128 * 64, 64};
            tr_item(s, 128, 64, (bf16*)(wl + WL_W2) + (size_t)kv * 64 * 128, scr, r - kv * 4, F.lane); continue; } r -= I_W2;
        if (r < I_WR) {
            float* wr = (float*)(wl + WL_WR) + (size_t)r * DM;
            for (int k = F.lane; k < DM; k += 64) wr[k] = (r < 4) ? a->in[18][((size_t)l * DM + k) * 4 + r] : a->in[20][((size_t)l * DM + k) * NEXP + (r - 4)];
            continue; } r -= I_WR;
        {
            const int kv = r >> 7, n = r & 127; const float* pe = a->in[3] + ((size_t)l * 2 + kv) * 2048; const float* w1 = a->in[4] + ((size_t)l * 2 + kv) * 2048 * 128;
            float s = 0.f; for (int k = F.lane; k < 2048; k += 64) s += pe[k] * w1[(size_t)k * 128 + n];
            s = wave_sum(s); if (F.lane == 0) ((float*)(wl + WL_BIAS1))[r] = s;
        }
    }
}

__device__ __forceinline__ void phase_prologue(const Frame& F, ArgsP a) {
    const size_t gt = (size_t)F.bid * NTHR + F.tid, NGT = (size_t)F.G * NTHR;
    float* rope = (float*)(a->ws + WS_ROPE);
    for (size_t i = gt; i < (size_t)SEQ * 8; i += NGT) { const int t = (int)(i >> 3), f = (int)(i & 7);
        const float invt[8] = {1.0f, 0.19392274f, 0.03760603f, 0.0072926646f, 0.0014142136f, 0.0002742482f, 5.3182957e-05f, 1.0313385e-05f};
        float inv = invt[0];
#pragma unroll
        for (int q = 1; q < 8; ++q) inv = (f == q) ? invt[q] : inv;
        const float ang = (float)t * inv;
        const double rev = (double)ang * 0.15915494309189535; const float fr = (float)(rev - __builtin_rint(rev));
        rope[t * 16 + f] = __builtin_amdgcn_cosf(fr); rope[t * 16 + 8 + f] = __builtin_amdgcn_sinf(fr); }
    const f32x4* x4 = (const f32x4*)a->in[0]; u32x4* xb = (u32x4*)(a->ws + WS_XB);
    for (size_t i = gt; i < (size_t)T * DM / 8; i += NGT) { const f32x4 v0 = x4[2 * i], v1 = x4[2 * i + 1];
        u32x4 w; w.x = pk2(v0[0], v0[1]); w.y = pk2(v0[2], v0[3]); w.z = pk2(v1[0], v1[1]); w.w = pk2(v1[2], v1[3]); xb[i] = w;
        int p0 = 0, p1 = 0; p0 = __builtin_amdgcn_cvt_pk_fp8_f32(v0[0], v0[1], p0, false); p0 = __builtin_amdgcn_cvt_pk_fp8_f32(v0[2], v0[3], p0, true); p1 = __builtin_amdgcn_cvt_pk_fp8_f32(v1[0], v1[1], p1, false); p1 = __builtin_amdgcn_cvt_pk_fp8_f32(v1[2], v1[3], p1, true);
        u32x2 w8; w8.x = (unsigned)p0; w8.y = (unsigned)p1; ((u32x2*)(a->ws + WS_X8))[i] = w8; }
}

template <bool DRY>
__device__ __forceinline__ void phase_ln1_router(const Frame& F, ArgsP a, int l) {
    const bf16* X1 = (const bf16*)(a->ws + WS_X1); bf16* XB = (bf16*)(a->ws + WS_XB); unsigned char* XB8 = a->ws + WS_H;
    const float* WR = (const float*)(WLBASE(a->ws, l) + WL_WR);
    const float* lw = a->in[14] + (size_t)l * DM; const float* lb = a->in[15] + (size_t)l * DM;
    const float* bg = a->in[19] + l * 4; const float* be = a->in[21] + l * NEXP;
    int* route_e = (int*)(a->ws + WS_SLOT + SL_RE); int* route_p = (int*)(a->ws + WS_SLOT + SL_RP); float* route_w = (float*)(a->ws + WS_SLOT + SL_RW);
    unsigned* cnt = F.ctl + CW_CNT + (DRY ? l + 4 : l) * 512;
    const int gw = F.bid * NWAVES + F.wave, NGW = F.G * NWAVES, lane = F.lane;
    LAS float* wgl = (LAS float*)F.lds;
    for (int i = F.tid; i < 4 * DM; i += NTHR) wgl[i] = WR[i];
    __syncthreads();
    const float bg0 = bg[0], bg1 = bg[1], bg2 = bg[2], bg3 = bg[3];
    for (int tg = gw; tg < T / 4; tg += NGW) {
        f32x4 v[4][4];
#pragma unroll
        for (int tk = 0; tk < 4; ++tk) { const u32x2* row = (const u32x2*)(X1 + (size_t)(4 * tg + tk) * DM) + lane;
            u32x2 raw[4];
#pragma unroll
            for (int j = 0; j < 4; ++j) raw[j] = row[64 * j];
#pragma unroll
            for (int j = 0; j < 4; ++j) { v[tk][j][0] = bf2f(raw[j].x & 0xffffu); v[tk][j][1] = __uint_as_float(raw[j].x & 0xffff0000u); v[tk][j][2] = bf2f(raw[j].y & 0xffffu); v[tk][j][3] = __uint_as_float(raw[j].y & 0xffff0000u); } }
#pragma unroll
        for (int tk = 0; tk < 4; ++tk) {
            float s = 0.f;
#pragma unroll
            for (int j = 0; j < 4; ++j) s += (v[tk][j][0] + v[tk][j][1]) + (v[tk][j][2] + v[tk][j][3]);
            const float mean = wave_sum(s) * (1.f / DM); float q = 0.f;
#pragma unroll
            for (int j = 0; j < 4; ++j) { v[tk][j] = v[tk][j] - mean; q += (v[tk][j][0] * v[tk][j][0] + v[tk][j][1] * v[tk][j][1]) + (v[tk][j][2] * v[tk][j][2] + v[tk][j][3] * v[tk][j][3]); }
            const float rstd = 1.f / sqrtf(wave_sum(q) * (1.f / DM) + LN_EPS);
            u32x2* brow = (u32x2*)(XB + (size_t)(4 * tg + tk) * DM) + lane;
#pragma unroll
            for (int j = 0; j < 4; ++j) { const f32x4 w4 = ((const f32x4*)lw)[lane + 64 * j], b4 = ((const f32x4*)lb)[lane + 64 * j];
                v[tk][j] = v[tk][j] * rstd * w4 + b4;
                u32x2 w; w.x = pk2(v[tk][j][0], v[tk][j][1]); w.y = pk2(v[tk][j][2], v[tk][j][3]); if (!DRY) brow[64 * j] = w;
                int w8 = 0; w8 = __builtin_amdgcn_cvt_pk_fp8_f32(v[tk][j][0], v[tk][j][1], w8, false); w8 = __builtin_amdgcn_cvt_pk_fp8_f32(v[tk][j][2], v[tk][j][3], w8, true);
                if (!DRY) ((int*)(XB8 + (size_t)(4 * tg + tk) * DM))[lane + 64 * j] = w8; }
        }
        float glg[4][4];
#pragma unroll
        for (int j = 0; j < 4; ++j) { const LAS f32x4* wr = (const LAS f32x4*)(wgl + j * DM) + lane; const f32x4 w0 = wr[0], w1 = wr[64], w2 = wr[128], w3 = wr[192];
#pragma unroll
            for (int tk = 0; tk < 4; ++tk) { f32x4 p = v[tk][0] * w0; p = p + v[tk][1] * w1; p = p + v[tk][2] * w2; p = p + v[tk][3] * w3; glg[tk][j] = wave_sum((p[0] + p[1]) + (p[2] + p[3])); } }
        int my_e = 0; float my_w = 0.f;
#pragma unroll
        for (int tk = 0; tk < 4; ++tk) {
            const float g0 = glg[tk][0] + bg0, g1 = glg[tk][1] + bg1, g2 = glg[tk][2] + bg2, g3 = glg[tk][3] + bg3;
            int gi = 0; float gm = g0; if (g1 > gm) { gm = g1; gi = 1; } if (g2 > gm) { gm = g2; gi = 2; } if (g3 > gm) { gm = g3; gi = 3; }
            gi = __builtin_amdgcn_readfirstlane(gi);
            const float g_w = 1.f / (__expf(g0 - gm) + __expf(g1 - gm) + __expf(g2 - gm) + __expf(g3 - gm));
            const float* wbase = WR + (size_t)(4 + gi * 8) * DM; float ev[8];
#pragma unroll
            for (int i4 = 0; i4 < 2; ++i4) { f32x4 w[4][4];
#pragma unroll
                for (int i = 0; i < 4; ++i) { const f32x4* wr = (const f32x4*)(wbase + (size_t)(4 * i4 + i) * DM) + lane; w[i][0] = wr[0]; w[i][1] = wr[64]; w[i][2] = wr[128]; w[i][3] = wr[192]; }
#pragma unroll
                for (int i = 0; i < 4; ++i) { f32x4 p = v[tk][0] * w[i][0]; p = p + v[tk][1] * w[i][1]; p = p + v[tk][2] * w[i][2]; p = p + v[tk][3] * w[i][3];
                    ev[4 * i4 + i] = wave_sum((p[0] + p[1]) + (p[2] + p[3])) + be[gi * 8 + 4 * i4 + i]; } }
            int i1 = 0; float v1 = ev[0];
#pragma unroll
            for (int i = 1; i < 8; ++i) if (ev[i] > v1) { v1 = ev[i]; i1 = i; }
            int i2 = -1; float v2 = -3.0e38f;
#pragma unroll
            for (int i = 0; i < 8; ++i) if (i != i1 && ev[i] > v2) { v2 = ev[i]; i2 = i; }
            const float e2 = __expf(v2 - v1), w1 = g_w / (1.f + e2), w2 = g_w - w1;
            if (lane == 2 * tk) { my_e = gi * 8 + i1; my_w = w1; }
            if (lane == 2 * tk + 1) { my_e = gi * 8 + i2; my_w = w2; }
        }
        if (lane < 8) {
            const unsigned pos = __hip_atomic_fetch_add(cnt + my_e * 16, 1u, __ATOMIC_RELAXED, __HIP_MEMORY_SCOPE_AGENT);
            const size_t si = (size_t)tg * 8 + lane; if (!DRY) { route_e[si] = my_e; route_p[si] = (int)pos; route_w[si] = my_w; }
        }
    }
    __syncthreads();
}

__device__ __forceinline__ void phase_gather(const Frame& F, ArgsP a, int l) {
    LAS int* pstart = (LAS int*)F.lds;
    unsigned* cnt = F.ctl + CW_CNT + l * 512;
    int* meta = (int*)(a->ws + WS_META) + l * 512;
    int* slot_tok = (int*)(a->ws + WS_SLOT + SL_TOK); float* slot_w = (float*)(a->ws + WS_SLOT + SL_W);
    const int* route_e = (const int*)(a->ws + WS_SLOT + SL_RE); const int* route_p = (const int*)(a->ws + WS_SLOT + SL_RP); const float* route_w = (const float*)(a->ws + WS_SLOT + SL_RW);
    if (F.tid < 64) {
        const int c = F.tid < 32 ? (int)__hip_atomic_load(cnt + F.tid * 16, __ATOMIC_RELAXED, __HIP_MEMORY_SCOPE_AGENT) : 0;
        const int pad = (c + 255) & ~255; int inc = pad;
#pragma unroll
        for (int o = 1; o < 64; o <<= 1) { const int t = __shfl_up(inc, o); if (F.lane >= o) inc += t; }
        const int st = inc - pad;
        if (F.tid < 32) { pstart[F.tid] = st;
            if (F.bid == 0) { for (int t = st >> 8; t < (st + pad) >> 8; ++t) meta[64 + t] = F.tid; if (F.tid == 31) meta[0] = (st + pad) >> 8; }
            if ((F.tid % F.G) == F.bid) for (int r = st + c; r < st + pad; ++r) { slot_tok[r] = -1; slot_w[r] = 0.f; }
        }
    }
    __syncthreads();
    for (int s = F.bid * NTHR + F.tid; s < T * 2; s += F.G * NTHR) {
        const int dest = pstart[route_e[s]] + route_p[s]; slot_tok[dest] = s; slot_w[dest] = route_w[s];
    }
    __syncthreads();
}

__device__ __forceinline__ void phase_ln2(const Frame& F, ArgsP a, int l) {
    const bf16* Y2 = (const bf16*)(a->ws + WS_Y2); bf16* XB = (bf16*)(a->ws + WS_XB); float* out = a->out;
    const float* lw = a->in[16] + (size_t)l * DM; const float* lb = a->in[17] + (size_t)l * DM;
    const int gw = F.bid * NWAVES + F.wave, NGW = F.G * NWAVES, lane = F.lane; const bool last = (l == NL - 1);
    for (int t0 = 2 * gw; t0 < T; t0 += 2 * NGW) {
        u32x2 xr[2][4], pa[2][4], pb[2][4];
#pragma unroll
        for (int u = 0; u < 2; ++u) { const int t = t0 + u; const u32x2* x_ = (const u32x2*)(XB + (size_t)t * DM) + lane; const u32x2* a_ = (const u32x2*)(Y2 + (size_t)(2 * t) * DM) + lane; const u32x2* b_ = (const u32x2*)(Y2 + (size_t)(2 * t + 1) * DM) + lane;
#pragma unroll
            for (int j = 0; j < 4; ++j) { xr[u][j] = x_[64 * j]; pa[u][j] = a_[64 * j]; pb[u][j] = b_[64 * j]; } }
#pragma unroll
        for (int u = 0; u < 2; ++u) { const int t = t0 + u;
            f32x4 v[4]; float s = 0.f;
#pragma unroll
            for (int j = 0; j < 4; ++j) { const u32x2 x = xr[u][j], p = pa[u][j], q = pb[u][j];
                v[j][0] = bf2f(x.x & 0xffffu) * DN_ALPHA + (bf2f(p.x & 0xffffu) + bf2f(q.x & 0xffffu)); v[j][1] = bf2f(x.x >> 16) * DN_ALPHA + (bf2f(p.x >> 16) + bf2f(q.x >> 16));
                v[j][2] = bf2f(x.y & 0xffffu) * DN_ALPHA + (bf2f(p.y & 0xffffu) + bf2f(q.y & 0xffffu)); v[j][3] = bf2f(x.y >> 16) * DN_ALPHA + (bf2f(p.y >> 16) + bf2f(q.y >> 16));
                s += (v[j][0] + v[j][1]) + (v[j][2] + v[j][3]); }
            const float mean = wave_sum(s) * (1.f / DM); float q2 = 0.f;
#pragma unroll
            for (int j = 0; j < 4; ++j) { v[j] = v[j] - mean; q2 += (v[j][0] * v[j][0] + v[j][1] * v[j][1]) + (v[j][2] * v[j][2] + v[j][3] * v[j][3]); }
            const float rstd = 1.f / sqrtf(wave_sum(q2) * (1.f / DM) + LN_EPS);
            f32x4* orow = (f32x4*)(out + (size_t)t * DM) + lane; u32x2* brow = (u32x2*)(XB + (size_t)t * DM) + lane;
#pragma unroll
            for (int j = 0; j < 4; ++j) { const f32x4 w4 = ((const f32x4*)lw)[lane + 64 * j], b4 = ((const f32x4*)lb)[lane + 64 * j];
                const f32x4 o = v[j] * rstd * w4 + b4; if (last) orow[64 * j] = o; u32x2 w; w.x = pk2(o[0], o[1]); w.y = pk2(o[2], o[3]); brow[64 * j] = w;
                int w8 = 0; w8 = __builtin_amdgcn_cvt_pk_fp8_f32(o[0], o[1], w8, false); w8 = __builtin_amdgcn_cvt_pk_fp8_f32(o[2], o[3], w8, true); if (!last) ((int*)(a->ws + WS_X8 + (size_t)t * DM))[lane + 64 * j] = w8; } }
    }
}

__device__ __forceinline__ int tsw(int row, int col) { return row * 128 + ((((col >> 3) ^ (row >> 1)) & 7) << 4) + ((col & 7) << 1); }
__device__ __forceinline__ f32x4 mfma16(bf16x8 a, bf16x8 b, f32x4 c) { return __builtin_amdgcn_mfma_f32_16x16x32_bf16(a, b, c, 0, 0, 0); }
__device__ __forceinline__ f32x16 mfma32(bf16x8 a, bf16x8 b, f32x16 c) { return __builtin_amdgcn_mfma_f32_32x32x16_bf16(a, b, c, 0, 0, 0); }
__device__ __forceinline__ bf16x8 as_bf16x8(u32x4 v) { return __builtin_bit_cast(bf16x8, v); }

__device__ __forceinline__ void conformer_item(const Frame& F, ArgsP a, int l, int it) {
    const int b = it >> 6, s0 = (it & 63) * 64; const size_t tok0 = (size_t)b * SEQ + s0;
    const bf16* H = (const bf16*)(a->ws + WS_H); bf16* Y = (bf16*)(a->ws + WS_Y);
    LAS bf16* ut = (LAS bf16*)F.lds;
    LAS float* co = (LAS float*)(F.lds + 49152);
    for (int idx = F.tid; idx < 94 * 32; idx += NTHR) {
        const int r = idx >> 5, c8 = (idx & 31) * 8, s = s0 - 30 + r; u32x4 w = {0u, 0u, 0u, 0u};
        if (s >= 0) { const bf16* hp = H + ((size_t)b * SEQ + s) * HLD + 2304 + c8; const u32x4 v = *(const u32x4*)hp, g = *(const u32x4*)(hp + 256);
#pragma unroll
            for (int e = 0; e < 4; ++e) { const float v0 = bf2f(v[e] & 0xffffu) * fsigmoid(bf2f(g[e] & 0xffffu)), v1 = bf2f(v[e] >> 16) * fsigmoid(bf2f(g[e] >> 16)); w[e] = pk2(v0, v1); } }
        *(LAS u32x4*)(ut + r * 256 + c8) = w;
    }
    __syncthreads();
    {
        const int c = F.tid & 255, half = F.tid >> 8; const float* dw = a->in[10] + (size_t)l * 31 * 256 + c; const float bias = a->in[11][l * 256 + c];
        float w[31], ur[62];
#pragma unroll
        for (int k = 0; k < 31; ++k) w[k] = dw[k * 256];
#pragma unroll
        for (int i = 0; i < 62; ++i) ur[i] = bf2f(ut[(32 * half + i) * 256 + c]);
#pragma unroll
        for (int tt = 0; tt < 32; ++tt) { float acc = bias;
#pragma unroll
            for (int k = 0; k < 31; ++k) acc += w[k] * ur[tt + k];
            co[(32 * half + tt) * 256 + c] = acc; }
    }
    __syncthreads();
    {
        const float* lw = a->in[12] + l * 256; const float* lb = a->in[13] + l * 256; const f32x4 w4 = ((const f32x4*)lw)[F.lane], b4 = ((const f32x4*)lb)[F.lane];
#pragma unroll
        for (int i = 0; i < 8; ++i) { const int tl = 8 * F.wave + i; f32x4 v = *(LAS f32x4*)(co + tl * 256 + 4 * F.lane);
            const float mean = wave_sum((v[0] + v[1]) + (v[2] + v[3])) * (1.f / 256.f); v = v - mean;
            const float rstd = 1.f / sqrtf(wave_sum((v[0] * v[0] + v[1] * v[1]) + (v[2] * v[2] + v[3] * v[3])) * (1.f / 256.f) + LN_EPS);
            v = v * rstd * w4 + b4; u32x2 o; o.x = pk2(fsilu(v[0]), fsilu(v[1])); o.y = pk2(fsilu(v[2]), fsilu(v[3]));
            *(u32x2*)(Y + (tok0 + tl) * DM + 768 + 4 * F.lane) = o; }
    }
    __syncthreads();
}

__device__ __forceinline__ void compress_item(const Frame& F, ArgsP a, int l, int it) {
    const int kv = it >> 7, bh = (it >> 3) & 15, b = bh >> 1, hh = bh & 1, i0 = (it & 7) * 32;
    const bf16* H = (const bf16*)(a->ws + WS_H); const bf16* w1t = (const bf16*)(WLBASE(a->ws, l) + WL_W1) + (size_t)kv * 128 * 2048; const bf16* w2t = (const bf16*)(WLBASE(a->ws, l) + WL_W2) + (size_t)kv * 64 * 128;
    const float* bias1 = (const float*)(WLBASE(a->ws, l) + WL_BIAS1) + kv * 128; bf16* outp = (bf16*)(a->ws + (kv ? WS_VC : WS_KC)) + (size_t)bh * 256 * 64;
    LAS bf16* hid = (LAS bf16*)F.lds;
    const int lane = F.lane, li = lane & 15, g = lane >> 4, rt = F.wave & 1, cq = F.wave >> 1;
    const int i = i0 + 16 * rt + li; const bf16* arow = H + (size_t)b * SEQ * HLD + 512 + kv * 128 + hh * 64 + 8 * g;
    const bf16* brow = w1t + (size_t)(32 * cq + li) * 2048 + 8 * g;
    f32x4 acc[2] = {{0.f, 0.f, 0.f, 0.f}, {0.f, 0.f, 0.f, 0.f}};
#pragma unroll 1
    for (int k8 = 0; k8 < 64; k8 += 8) {
        bf16x8 af[8], bfr[8][2];
#pragma unroll
        for (int u = 0; u < 8; ++u) { const int ks = k8 + u; int s = 16 * i + (ks >> 1); s = s > SEQ - 1 ? SEQ - 1 : s;
            af[u] = *(const bf16x8*)(arow + (size_t)s * HLD + (ks & 1) * 32); bfr[u][0] = *(const bf16x8*)(brow + ks * 32); bfr[u][1] = *(const bf16x8*)(brow + (size_t)16 * 2048 + ks * 32); }
#pragma unroll
        for (int u = 0; u < 8; ++u) { acc[0] = mfma16(af[u], bfr[u][0], acc[0]); acc[1] = mfma16(af[u], bfr[u][1], acc[1]); }
    }
#pragma unroll
    for (int nt = 0; nt < 2; ++nt) { const int n = 32 * cq + 16 * nt + li; const float bs = bias1[n];
#pragma unroll
        for (int r = 0; r < 4; ++r) hid[(16 * rt + 4 * g + r) * 136 + n] = (bf16)f2bf(fsilu(acc[nt][r] + bs)); }
    __syncthreads();
    f32x4 o2 = {0.f, 0.f, 0.f, 0.f};
#pragma unroll
    for (int ks = 0; ks < 4; ++ks) { const bf16x8 af = *(LAS bf16x8*)(hid + (16 * rt + li) * 136 + 32 * ks + 8 * g);
        const bf16x8 bfr = *(const bf16x8*)(w2t + (size_t)(16 * cq + li) * 128 + 32 * ks + 8 * g); o2 = mfma16(af, bfr, o2); }
#pragma unroll
    for (int r = 0; r < 4; ++r) { const int io = i0 + 16 * rt + 4 * g + r; outp[(size_t)io * 64 + 16 * cq + li] = (bf16)(io < 255 ? f2bf_sw(o2[r]) : 0u); }
    __syncthreads();
}

__host__ __device__ constexpr int tri_off(int i) { int s = 0; for (int k = 0; k < i; ++k) s += (k + 3) >> 2; return 4 * s; }
__device__ __forceinline__ int tri_off_rt(int i) { const int m = i - 1, V = (m + 3) >> 2; return i <= 0 ? 0 : 4 * (2 * V * (V - 1) + V * (m - 4 * V + 4)); }

template <int I> struct GdnSolveRow {
    __device__ static __forceinline__ void run(const LAS float* Ap, float (&x)[64]) {
        if constexpr (I < 64) {
            constexpr int off = tri_off(I), nb = (I + 3) >> 2;
            float s4[4] = {0.f, 0.f, 0.f, 0.f};
#pragma unroll
            for (int jb = 0; jb < nb; ++jb) { const f32x4 a4 = *(const LAS f32x4*)(Ap + off + 4 * jb);
#pragma unroll
                for (int jj = 0; jj < 4; ++jj) { if (4 * jb + jj < I) s4[jj] += a4[jj] * x[4 * jb + jj]; } }
            x[I] -= (s4[0] + s4[1]) + (s4[2] + s4[3]);
            if constexpr ((I & 3) == 3) SBAR();
            GdnSolveRow<I + 1>::run(Ap, x);
        }
    }
};

template <int GV>
__device__ __forceinline__ void gdn_prep_chunk(const Frame& F, ArgsP a, int l, int ci, LAS unsigned char* wl) {
    int lane_ = F.lane; asm volatile("" : "+v"(lane_));
    const int lane = lane_, li = lane & 15, g = lane >> 4; const int bh = ci >> 6, n = ci & 63, b = bh >> 2, h = bh & 3; const size_t tok0 = (size_t)b * SEQ + 64 * n;
    const bf16* H = (const bf16*)(a->ws + WS_H); const float* side = (const float*)(a->ws + WS_SIDE);
    unsigned char* rec = a->ws + ((GV & 1) ? WS_Y2 : WS_GPREP) + (size_t)ci * GCH;
    bf16* R0 = (bf16*)(rec + GC_UT); bf16* R1 = (bf16*)(rec + GC_W); bf16* QKm = (bf16*)(rec + GC_QK); bf16* QD = (bf16*)(rec + GC_QD); bf16* KDT = (bf16*)(rec + GC_KDT); bf16* ZT = (bf16*)(rec + GC_ZT);
    const int pc = (lane & 32) | (((lane & 15) >> 2) << 3) | (((lane >> 4) & 1) << 2) | (lane & 3);
    LAS unsigned char* qt = wl; LAS unsigned char* kt = wl + 8192; LAS float* Ap = (LAS float*)wl;
    const float beta = side[(tok0 + lane) * 32 + 24 + h]; const float av = side[(tok0 + lane) * 32 + 28 + h] + a->in[8][l * 4 + h];
    const float sp = av > 20.f ? av : log1pf(__expf(av)); float gc = -__expf(a->in[7][l * 4 + h]) * sp;
#pragma unroll
    for (int o = 1; o < 64; o <<= 1) { const float t = __shfl_up(gc, o); if (lane >= o) gc += t; }
    const float gl = __shfl(gc, 63); const float eg = __expf(gc), ekd = __expf(gl - gc);
    if (lane == 0 && !(GV & 1)) ((float*)(a->ws + WS_GL))[ci] = __expf(gl);
    const float* cw = a->in[6] + (size_t)l * 4 * 768 + h * 64 + lane; float wq[4], wk[4], wv[4];
#pragma unroll
    for (int k = 0; k < 4; ++k) { wq[k] = cw[k * 768]; wk[k] = cw[k * 768 + 256]; wv[k] = cw[k * 768 + 512]; }
    const bf16* hp = H + tok0 * HLD + 1280 + h * 64 + lane; float hq[3], hk[3], hv[3];
#pragma unroll
    for (int j = 0; j < 3; ++j) { const bool ok = (64 * n - 3 + j) >= 0; const bf16* p = hp + (ptrdiff_t)(j - 3) * HLD;
        hq[j] = ok ? bf2f(p[0]) : 0.f; hk[j] = ok ? bf2f(p[256]) : 0.f; hv[j] = ok ? bf2f(p[512]) : 0.f; }
    unsigned short ra[8][4], rb[8][4]; const float nwl = a->in[9][l * 64 + lane];
#define GDN_LOADBLK(dst, t8_) do { const bf16* pl_ = hp + (size_t)(8 * (t8_)) * HLD; asm volatile("" : "+v"(pl_)); _Pragma("unroll") for (int tt = 0; tt < 8; ++tt) { const bf16* q_ = pl_ + (size_t)tt * HLD; dst[tt][0] = q_[0]; dst[tt][1] = q_[256]; dst[tt][2] = q_[512]; dst[tt][3] = q_[768]; } } while (0)
#define GDN_CONVBLK(src, t8_) do { const int t8 = (t8_); unsigned kdp[4], zp[4]; \
        bf16* qd8 = QD + (8 * t8) * 64 + pc; bf16* r08 = R0 + (8 * t8) * 64 + lane; bf16* r18 = R1 + (8 * t8) * 64 + lane; asm volatile("" : "+v"(qd8), "+v"(r08), "+v"(r18)); \
        _Pragma("unroll") for (int tt = 0; tt < 8; ++tt) { const int t = 8 * t8 + tt; \
            const float rq = bf2f(src[tt][0]), rk = bf2f(src[tt][1]), rv = bf2f(src[tt][2]); \
            const float cq = wq[0] * hq[0] + wq[1] * hq[1] + wq[2] * hq[2] + wq[3] * rq, ck = wk[0] * hk[0] + wk[1] * hk[1] + wk[2] * hk[2] + wk[3] * rk, cv = wv[0] * hv[0] + wv[1] * hv[1] + wv[2] * hv[2] + wv[3] * rv; \
            hq[0] = hq[1]; hq[1] = hq[2]; hq[2] = rq; hk[0] = hk[1]; hk[1] = hk[2]; hk[2] = rk; hv[0] = hv[1]; hv[1] = hv[2]; hv[2] = rv; \
            const float qs = fsilu(cq), ks_ = fsilu(ck), vs = fsilu(cv); \
            const float qn = qs * __builtin_amdgcn_rsqf(wave_sum(qs * qs) + 1e-6f) * 0.125f, kn = ks_ * __builtin_amdgcn_rsqf(wave_sum(ks_ * ks_) + 1e-6f); \
            const float bt = __int_as_float(__builtin_amdgcn_readlane(__float_as_int(beta), t)), egt = __int_as_float(__builtin_amdgcn_readlane(__float_as_int(eg), t)), ekt = __int_as_float(__builtin_amdgcn_readlane(__float_as_int(ekd), t)); \
            *(LAS bf16*)(qt + tsw(t, lane)) = (bf16)f2bf(qn); *(LAS bf16*)(kt + tsw(t, lane)) = (bf16)f2bf(kn); \
            qd8[tt * 64] = (bf16)f2bf(qn * egt); r08[tt * 64] = (bf16)f2bf(bt * vs); r18[tt * 64] = (bf16)f2bf(bt * egt * kn); \
            const unsigned kd = f2bf(kn * ekt); if (tt & 1) kdp[tt >> 1] |= kd << 16; else kdp[tt >> 1] = kd; \
            const unsigned zg = f2bf(fsilu(bf2f(src[tt][3])) * nwl); if (tt & 1) zp[tt >> 1] |= zg << 16; else zp[tt >> 1] = zg; } \
        { u32x4 wz; wz.x = zp[0]; wz.y = zp[1]; wz.z = zp[2]; wz.w = zp[3]; *(u32x4*)(ZT + lane * 64 + 8 * t8) = wz; } \
        { const int c0 = (8 * t8) & 31, gg = (c0 & 15) >> 2, hh = c0 >> 4; bf16* kr = KDT + lane * 64 + ((8 * t8) & 32) + 4 * hh; \
          u32x2 w0, w1; w0.x = kdp[0]; w0.y = kdp[1]; w1.x = kdp[2]; w1.y = kdp[3]; *(u32x2*)(kr + 8 * gg) = w0; *(u32x2*)(kr + 8 * gg + 8) = w1; } } while (0)
    if (!(GV & 2)) {
    GDN_LOADBLK(ra, 0);
#pragma unroll 1
    for (int t16 = 0; t16 < 4; ++t16) {
        GDN_LOADBLK(rb, 2 * t16 + 1);
        GDN_CONVBLK(ra, 2 * t16);
        if (t16 < 3) GDN_LOADBLK(ra, 2 * t16 + 2);
        GDN_CONVBLK(rb, 2 * t16 + 1);
    }
    }
#undef GDN_LOADBLK
#undef GDN_CONVBLK
    LDS_WAIT();
    if (!(GV & 4)) {
    float gcj[4][4];
#pragma unroll
    for (int mt = 0; mt < 4; ++mt)
#pragma unroll
        for (int r = 0; r < 4; ++r) gcj[mt][r] = __shfl(gc, 16 * mt + 4 * g + r);
    f32x4 ahold[4][4];
#pragma unroll
    for (int nt = 0; nt < 4; ++nt) {
        const int i = 16 * nt + li; const float gci = __shfl(gc, i), bi = __shfl(beta, i);
        bf16x8 kB[2], qB[2];
#pragma unroll
        for (int ks = 0; ks < 2; ++ks) { kB[ks] = *(LAS bf16x8*)(kt + tsw(i, 32 * ks + 8 * g)); qB[ks] = *(LAS bf16x8*)(qt + tsw(i, 32 * ks + 8 * g)); }
#pragma unroll
        for (int mt = 0; mt < 4; ++mt) {
            u32x2 qw = {0u, 0u};
            if (mt <= nt) {
                const bf16x8 kA0 = *(LAS bf16x8*)(kt + tsw(16 * mt + li, 8 * g)), kA1 = *(LAS bf16x8*)(kt + tsw(16 * mt + li, 32 + 8 * g));
                f32x4 ckk = {0.f, 0.f, 0.f, 0.f}, cqk = {0.f, 0.f, 0.f, 0.f};
                ckk = mfma16(kA0, kB[0], ckk); ckk = mfma16(kA1, kB[1], ckk); cqk = mfma16(kA0, qB[0], cqk); cqk = mfma16(kA1, qB[1], cqk);
                float qv[4];
#pragma unroll
                for (int r = 0; r < 4; ++r) { const int j = 16 * mt + 4 * g + r; const float dec = __expf(fminf(gci - gcj[mt][r], 0.f));
                    ahold[nt][mt][r] = bi * ckk[r] * dec; qv[r] = (j <= i) ? cqk[r] * dec : 0.f; }
                qw.x = pk2(qv[0], qv[1]); qw.y = pk2(qv[2], qv[3]);
            }
            *(u32x2*)(QKm + i * 64 + 32 * (mt >> 1) + 8 * g + 4 * (mt & 1)) = qw;
        }
    }
    LDS_WAIT(); SBAR();
#pragma unroll
    for (int nt = 0; nt < 4; ++nt) { const int i = 16 * nt + li; const int ro = tri_off_rt(i);
#pragma unroll
        for (int mt = 0; mt < 4; ++mt) if (mt <= nt) {
#pragma unroll
            for (int r = 0; r < 4; ++r) { const int j = 16 * mt + 4 * g + r; if (j < i) Ap[ro + j] = ahold[nt][mt][r]; } } }
    }
    VM_WAIT(); LDS_WAIT();
#pragma unroll 1
    for (int pass = 0; pass < 2; ++pass) {
        bf16* Rp = pass ? R1 : R0; float x[64];
#pragma unroll
        for (int i = 0; i < 64; ++i) x[i] = bf2f(Rp[i * 64 + lane]);
        VM_WAIT();
        if (!(GV & 8)) GdnSolveRow<1>::run(Ap, x);
        if (pass == 0) {
#pragma unroll
            for (int i8 = 0; i8 < 8; ++i8) { u32x4 w; w.x = pk2(x[8 * i8], x[8 * i8 + 1]); w.y = pk2(x[8 * i8 + 2], x[8 * i8 + 3]); w.z = pk2(x[8 * i8 + 4], x[8 * i8 + 5]); w.w = pk2(x[8 * i8 + 6], x[8 * i8 + 7]);
                *(u32x4*)(Rp + lane * 64 + 8 * i8) = w; }
        } else {
#pragma unroll
            for (int i = 0; i < 64; ++i) Rp[i * 64 + pc] = (bf16)f2bf(x[i]);
        }
    }
    LDS_WAIT();
}

__device__ __forceinline__ bf16x8 scan_frag(const unsigned char* mat, int mt, int ks, int li, int g) { return *(const bf16x8*)(mat + (16 * mt + li) * 128 + (32 * ks + 8 * g) * 2); }
__device__ __forceinline__ bf16x8 pack_c2(f32x4 a, f32x4 b) { u32x4 w; w.x = pk2(a[0], a[1]); w.y = pk2(a[2], a[3]); w.z = pk2(b[0], b[1]); w.w = pk2(b[2], b[3]); return as_bf16x8(w); }
constexpr int SC_SLOT = 24576;
__device__ __forceinline__ void scan_dma(LAS unsigned char* slot, const unsigned char* rec, int sl, int lane) {
#pragma unroll
    for (int m = 0; m < 3; ++m) { const int goff = (m == 0) ? GC_W : (m == 1 ? GC_KDT : GC_UT);
#pragma unroll
        for (int i = 0; i < 2; ++i) { const int row = 16 * sl + 8 * i + (lane >> 3), ch = (lane & 7) ^ ((row >> 1) & 7);
            __builtin_amdgcn_global_load_lds((const unsigned*)(rec + goff + row * 128 + ch * 16), (LAS unsigned*)(slot + m * 8192 + (16 * sl + 8 * i) * 128), 16, 0, 0); } }
}
__device__ __forceinline__ bf16x8 scan_lfrag(const LAS unsigned char* mat, int mt, int ks, int li, int g) { const int row = 16 * mt + li; return *(const LAS bf16x8*)(mat + row * 128 + ((((4 * ks + g) ^ (row >> 1)) & 7) << 4)); }
template <int SV>
__device__ __forceinline__ void gdn_scan(const Frame& F, ArgsP a, int l) {
    const int lane = F.lane, li = lane & 15, g = lane >> 4, pr = F.wave >> 2, sl = F.wave & 3; const int bh = F.bid * 2 + pr, dv0 = 16 * sl;
    const float* GL = (const float*)(a->ws + WS_GL) + bh * 64; unsigned char* rec0 = a->ws + WS_GPREP + (size_t)bh * 64 * GCH;
    LAS unsigned char* ring = F.lds + pr * (3 * SC_SLOT);
    f32x4 S[4] = {{0.f, 0.f, 0.f, 0.f}, {0.f, 0.f, 0.f, 0.f}, {0.f, 0.f, 0.f, 0.f}, {0.f, 0.f, 0.f, 0.f}};
    const float glv = GL[lane];
    asm volatile("s_waitcnt vmcnt(0)" ::: "memory");
    scan_dma(ring, rec0, sl, lane); scan_dma(ring + SC_SLOT, rec0 + GCH, sl, lane);
#pragma unroll 1
    for (int n = 0; n < 64; ++n) {
        unsigned char* rn = rec0 + (size_t)n * GCH; const LAS unsigned char* slot = ring + (n % 3) * SC_SLOT;
        if (n == 0) asm volatile("s_waitcnt vmcnt(6)" ::: "memory"); else if (n == 1) asm volatile("s_waitcnt vmcnt(10)" ::: "memory");
        else if (n == 63) asm volatile("s_waitcnt vmcnt(8)" ::: "memory"); else asm volatile("s_waitcnt vmcnt(14)" ::: "memory");
        __builtin_amdgcn_s_barrier(); asm volatile("" ::: "memory");
        if (n + 2 < 64) scan_dma(ring + ((n + 2) % 3) * SC_SLOT, rn + 2 * (size_t)GCH, sl, lane);
        else { asm volatile("" ::: "memory"); }
        const float egl = __int_as_float(__builtin_amdgcn_readlane(__float_as_int(glv), n));
        const bf16x8 Sb0 = pack_c2(S[0], S[1]), Sb1 = pack_c2(S[2], S[3]);
        if (!(SV & 1)) { bf16x8* ss = (bf16x8*)(rn + GC_SS + sl * 2048) + lane; ss[0] = Sb0; ss[64] = Sb1; }
        f32x4 vn[4];
#pragma unroll
        for (int mt = 0; mt < 4; ++mt) {
            f32x4 acc = {0.f, 0.f, 0.f, 0.f};
            acc = mfma16(scan_lfrag(slot, mt, 0, li, g), Sb0, acc); acc = mfma16(scan_lfrag(slot, mt, 1, li, g), Sb1, acc);
            const int urow = dv0 + li; const u32x2 uu = *(const LAS u32x2*)(slot + 16384 + urow * 128 + (((((16 * mt + 4 * g) >> 3) ^ (urow >> 1)) & 7) << 4) + (((16 * mt + 4 * g) & 7) << 1));
            vn[mt][0] = bf2f(uu.x & 0xffffu) - acc[0]; vn[mt][1] = bf2f(uu.x >> 16) - acc[1]; vn[mt][2] = bf2f(uu.y & 0xffffu) - acc[2]; vn[mt][3] = bf2f(uu.y >> 16) - acc[3];
        }
        const bf16x8 Vb0 = pack_c2(vn[0], vn[1]), Vb1 = pack_c2(vn[2], vn[3]);
        if (!(SV & 1)) { bf16x8* vb = (bf16x8*)(rn + GC_VB + sl * 2048) + lane; vb[0] = Vb0; vb[64] = Vb1; }
#pragma unroll
        for (int mt = 0; mt < 4; ++mt) { f32x4 acc = S[mt] * egl; acc = mfma16(scan_lfrag(slot + 8192, mt, 0, li, g), Vb0, acc); acc = mfma16(scan_lfrag(slot + 8192, mt, 1, li, g), Vb1, acc); S[mt] = acc; }
        if ((SV & 1) || n + 2 >= 64) { }
    }
    asm volatile("s_waitcnt vmcnt(0)" ::: "memory"); asm volatile("" :: "v"(S[0][0]), "v"(S[1][1]), "v"(S[2][2]), "v"(S[3][3]));
    __syncthreads();
}

__device__ __forceinline__ void gdn_out_chunk(const Frame& F, ArgsP a, int ci, LAS unsigned char* wl) {
    int lane_ = F.lane; asm volatile("" : "+v"(lane_)); const int lane = lane_, li = lane & 15, g = lane >> 4; const int bh = ci >> 6, n = ci & 63, b = bh >> 2, h = bh & 3;
    const unsigned char* rec = a->ws + WS_GPREP + (size_t)ci * GCH; bf16* Y = (bf16*)(a->ws + WS_Y);
    bf16x8 QDf[4][2], QKf[4][2];
#pragma unroll
    for (int mt = 0; mt < 4; ++mt) { QDf[mt][0] = scan_frag(rec + GC_QD, mt, 0, li, g); QDf[mt][1] = scan_frag(rec + GC_QD, mt, 1, li, g); QKf[mt][0] = scan_frag(rec + GC_QK, mt, 0, li, g); QKf[mt][1] = scan_frag(rec + GC_QK, mt, 1, li, g); }
    float ssq[4][4];
#pragma unroll
    for (int mt = 0; mt < 4; ++mt)
#pragma unroll
        for (int r = 0; r < 4; ++r) ssq[mt][r] = 0.f;
    f32x4 o[4][4];
#pragma unroll
    for (int sl = 0; sl < 4; ++sl) {
        const bf16x8* ss = (const bf16x8*)(rec + GC_SS + sl * 2048) + lane; const bf16x8* vb = (const bf16x8*)(rec + GC_VB + sl * 2048) + lane;
        const bf16x8 Sb0 = ss[0], Sb1 = ss[64], Vb0 = vb[0], Vb1 = vb[64];
#pragma unroll
        for (int mt = 0; mt < 4; ++mt) {
            f32x4 acc = {0.f, 0.f, 0.f, 0.f};
            acc = mfma16(QDf[mt][0], Sb0, acc); acc = mfma16(QDf[mt][1], Sb1, acc); acc = mfma16(QKf[mt][0], Vb0, acc); acc = mfma16(QKf[mt][1], Vb1, acc);
            o[sl][mt] = acc;
#pragma unroll
            for (int r = 0; r < 4; ++r) ssq[mt][r] += acc[r] * acc[r];
        }
    }
#pragma unroll
    for (int mt = 0; mt < 4; ++mt)
#pragma unroll
        for (int r = 0; r < 4; ++r) ssq[mt][r] = __builtin_amdgcn_rsqf(row16_sum(ssq[mt][r]) * (1.f / 64.f) + 1e-6f);
#pragma unroll
    for (int sl = 0; sl < 4; ++sl)
#pragma unroll
        for (int mt = 0; mt < 4; ++mt) {
            const u32x2 zz = *(const u32x2*)(rec + GC_ZT + (16 * sl + li) * 128 + (16 * mt + 4 * g) * 2);
            const float zf[4] = {bf2f(zz.x & 0xffffu), bf2f(zz.x >> 16), bf2f(zz.y & 0xffffu), bf2f(zz.y >> 16)};
#pragma unroll
            for (int r = 0; r < 4; ++r) *(LAS bf16*)(wl + tsw(16 * mt + 4 * g + r, 16 * sl + li)) = (bf16)f2bf(o[sl][mt][r] * ssq[mt][r] * zf[r]);
        }
    LDS_WAIT();
    bf16* yrow = Y + ((size_t)b * SEQ + 64 * n + lane) * DM + 512 + h * 64;
#pragma unroll
    for (int c = 0; c < 8; ++c) *(u32x4*)(yrow + 8 * c) = *(const LAS u32x4*)(wl + tsw(lane, 8 * c));
    LDS_WAIT();
}

constexpr int AT_K = 0, AT_V = 32768, AT_IMP = 65536, AT_SELM = AT_IMP + 64 * 68 * 4, AT_UNI = AT_SELM + 512, AT_YS = 83968;
__device__ __forceinline__ s16x4 tr_read0(unsigned addr) { s16x4 r; asm volatile("ds_read_b64_tr_b16 %0, %1" : "=&v"(r) : "v"(addr) : "memory"); return r; }

__device__ __forceinline__ float half_max(float x) { auto rr = __builtin_amdgcn_permlane32_swap(__float_as_uint(x), __float_as_uint(x), false, false); return fmaxf(__uint_as_float(rr[0]), __uint_as_float(rr[1])); }
__device__ __forceinline__ float half_sum(float x) { auto rr = __builtin_amdgcn_permlane32_swap(__float_as_uint(x), __float_as_uint(x), false, false); return __uint_as_float(rr[0]) + __uint_as_float(rr[1]); }
struct AttnStage { u32x4 kr, vr; };
__device__ __forceinline__ void at_gload(AttnStage& st, const bf16* Kb, const bf16* Vb, size_t stride, int j, int tid) {
    const int row = tid >> 3, ch = tid & 7; const size_t off = (size_t)(64 * j + row) * stride + 8 * ch;
    st.kr = *(const u32x4*)(Kb + off); st.vr = *(const u32x4*)(Vb + off);
}
__device__ __forceinline__ void at_swrite(const AttnStage& st, LAS unsigned char* lds, int buf, int tid) {
    const int row = tid >> 3, ch = tid & 7; const int o = row * 128 + (((ch ^ (row >> 1)) & 7) << 4);
    *(LAS u32x4*)(lds + AT_K + buf * 8192 + o) = st.kr; *(LAS u32x4*)(lds + AT_V + buf * 8192 + o) = st.vr;
}
__device__ __forceinline__ void at_qk(const LAS unsigned char* Kt, const bf16x8 (&Qf)[4], int r, int hf, f32x16 (&s)[2], float cinit) {
    const int swz = (r >> 1) & 7;
    bf16x8 kf[2][4];
#pragma unroll
    for (int kt = 0; kt < 2; ++kt)
#pragma unroll
        for (int ks = 0; ks < 4; ++ks) kf[kt][ks] = *(const LAS bf16x8*)(Kt + (32 * kt + r) * 128 + (((2 * ks + hf) ^ swz) << 4));
    SBAR();
#pragma unroll
    for (int kt = 0; kt < 2; ++kt) {
        f32x16 acc;
#pragma unroll
        for (int e = 0; e < 16; ++e) acc[e] = cinit;
#pragma unroll
        for (int ks = 0; ks < 4; ++ks) acc = mfma32(kf[kt][ks], Qf[ks], acc);
        s[kt] = acc;
    }
}
__device__ __forceinline__ void at_pv(unsigned vbase, const unsigned (&voff)[2][2], const f32x16 (&p)[2], f32x16 (&o)[2]) {
#pragma unroll
    for (int kt = 0; kt < 2; ++kt) {
        s16x4 vr[2][2][2];
#pragma unroll
        for (int s = 0; s < 2; ++s) { const unsigned co = vbase + (unsigned)(4096 * kt + 2048 * s);
            vr[s][0][0] = tr_read0(co + voff[0][0]); vr[s][1][0] = tr_read0(co + voff[1][0]); vr[s][0][1] = tr_read0(co + voff[0][1]); vr[s][1][1] = tr_read0(co + voff[1][1]); }
        bf16x8 pb[2];
#pragma unroll
        for (int s = 0; s < 2; ++s) { u32x4 pw; pw.x = pk2(p[kt][8 * s + 0], p[kt][8 * s + 1]); pw.y = pk2(p[kt][8 * s + 2], p[kt][8 * s + 3]); pw.z = pk2(p[kt][8 * s + 4], p[kt][8 * s + 5]); pw.w = pk2(p[kt][8 * s + 6], p[kt][8 * s + 7]); pb[s] = as_bf16x8(pw); }
        asm volatile("s_waitcnt lgkmcnt(0)" ::: "memory"); SBAR();
#pragma unroll
        for (int s = 0; s < 2; ++s) {
            const s16x4 l0 = vr[s][0][0], h0 = vr[s][1][0], l1 = vr[s][0][1], h1 = vr[s][1][1];
            const bf16x8 v0 = {l0[0], l0[1], l0[2], l0[3], h0[0], h0[1], h0[2], h0[3]}, v1 = {l1[0], l1[1], l1[2], l1[3], h1[0], h1[1], h1[2], h1[3]};
            o[0] = mfma32(v0, pb[s], o[0]); o[1] = mfma32(v1, pb[s], o[1]);
        }
    }
}

struct AttnRow { int r, hf, tt, t, qb, wave; unsigned long long wave_union; float m, lpart; };
struct TileInfo { int hi, lo; bool rowok, edge, work, fresh; };
template <int MODE, int VAR>
__device__ __forceinline__ void at_tile_qk(const Frame& F, int j, int stg, const bf16x8 (&Qf)[4], const AttnRow& R, float mfin, f32x16 (&s)[2], TileInfo& I) {
    LAS unsigned char* lds = F.lds;
    I.work = true; if (MODE == 2) I.work = (R.wave_union >> j) & 1ull;
    I.hi = 1000; I.lo = -1000; I.rowok = true; I.edge = false;
    if (MODE <= 1) { I.hi = ((R.t - 31) >> 4) - 64 * j - 4 * R.hf; I.edge = (64 * j + 63) > ((64 * R.qb + 8 * R.wave - 31) >> 4); }
    if (MODE == 2) { const unsigned long long sm = *(const LAS unsigned long long*)(lds + AT_SELM + 8 * R.tt); I.rowok = (sm >> j) & 1ull; if (j == R.qb) { I.hi = R.tt - 4 * R.hf; I.edge = true; } }
    if (MODE == 3) { if (j == R.qb) { I.hi = R.tt - 4 * R.hf; I.edge = true; } if (j == R.qb - 8) { I.lo = R.tt + 1 - 4 * R.hf; I.edge = true; } }
    const float mref = (MODE == 1) ? mfin : R.m; I.fresh = mref < -1e29f;
    const float cinit = I.rowok ? (I.fresh ? 0.f : -mref) : -INFINITY;
    if (I.work) { if (VAR & 64) { for (int e = 0; e < 16; ++e) { s[0][e] = Qf[0][0] * 1e-9f; s[1][e] = Qf[1][1] * 1e-9f; } } else at_qk(lds + AT_K + stg * 8192, Qf, R.r, R.hf, s, cinit); }
}
template <int MODE, int VAR>
__device__ __forceinline__ float at_tile_fin(const Frame& F, int j, int stg, f32x16 (&s)[2], const TileInfo& I, AttnRow& R, const unsigned (&voff)[2][2], f32x16 (&o)[2], float invl, float preshift) {
    LAS unsigned char* lds = F.lds; float shift_out = 0.f;
    if (!I.work) return 0.f;
    const int hi = I.hi, lo = I.lo; const bool edge = I.edge;
    if (MODE == 1) {
        if (edge) {
#pragma unroll
            for (int kt = 0; kt < 2; ++kt)
#pragma unroll
                for (int e = 0; e < 16; ++e) { const int cst = 32 * kt + (e & 3) + 8 * (e >> 2); s[kt][e] = (cst <= hi) ? fexp2(s[kt][e]) * invl : 0.f; }
        } else {
#pragma unroll
            for (int kt = 0; kt < 2; ++kt)
#pragma unroll
                for (int e = 0; e < 16; ++e) s[kt][e] = fexp2(s[kt][e]) * invl;
        }
        LAS float* imp = (LAS float*)(lds + AT_IMP) + R.tt * 68;
#pragma unroll
        for (int kt = 0; kt < 2; ++kt)
#pragma unroll
            for (int rg = 0; rg < 4; ++rg) {
                float av = 2.f * (s[kt][4 * rg] + s[kt][4 * rg + 1] + s[kt][4 * rg + 2]) + s[kt][4 * rg + 3], bv = s[kt][4 * rg + 3];
                av += __int_as_float(__builtin_amdgcn_update_dpp(0, __float_as_int(av), 0xB1, 0xf, 0xf, true)); av += __int_as_float(__builtin_amdgcn_update_dpp(0, __float_as_int(av), 0x4E, 0xf, 0xf, true));
                bv += __int_as_float(__builtin_amdgcn_update_dpp(0, __float_as_int(bv), 0xB1, 0xf, 0xf, true)); bv += __int_as_float(__builtin_amdgcn_update_dpp(0, __float_as_int(bv), 0x4E, 0xf, 0xf, true));
                if ((R.r & 3) == 0) { const int jb = 16 * j + 8 * kt + 2 * rg + R.hf; (void)__hip_atomic_fetch_add(imp + jb, av, __ATOMIC_RELAXED, __HIP_MEMORY_SCOPE_WORKGROUP); (void)__hip_atomic_fetch_add(imp + jb + 1, bv, __ATOMIC_RELAXED, __HIP_MEMORY_SCOPE_WORKGROUP); }
            }
        if (VAR & 16) { o[0][0] += s[0][3] + s[1][7]; } else at_pv((unsigned)(size_t)(lds + AT_V + stg * 8192), voff, s, o);
    } else if (VAR & 32) { R.lpart += s[0][1]; if (MODE >= 2) { if (VAR & 16) { o[0][0] += s[0][3]; } else at_pv((unsigned)(size_t)(lds + AT_V + stg * 8192), voff, s, o); } }
    else {
        constexpr float THR = 8.f;
        if (__any(preshift != 0.f)) {
#pragma unroll
            for (int kt = 0; kt < 2; ++kt)
#pragma unroll
                for (int e = 0; e < 16; ++e) s[kt][e] -= preshift;
        }
        const bool fresh = R.m < -1e29f;
        if (edge) {
#pragma unroll
            for (int kt = 0; kt < 2; ++kt)
#pragma unroll
                for (int e = 0; e < 16; ++e) { const int cst = 32 * kt + (e & 3) + 8 * (e >> 2); const bool ok = (cst <= hi) && (cst >= lo); s[kt][e] = ok ? s[kt][e] : -INFINITY; }
        }
        float tm4[4] = {-INFINITY, -INFINITY, -INFINITY, -INFINITY};
#pragma unroll
        for (int kt = 0; kt < 2; ++kt)
#pragma unroll
            for (int e = 0; e < 16; e += 2) tm4[(e >> 1) & 3] = fmaxf(tm4[(e >> 1) & 3], fmaxf(s[kt][e], s[kt][e + 1]));
        const float tmax = half_max(fmaxf(fmaxf(tm4[0], tm4[1]), fmaxf(tm4[2], tm4[3])));
        const bool raise = (tmax > -INFINITY) && (fresh || tmax > THR);
        if (__any(raise)) {
            const float shift = raise ? tmax : 0.f, alpha = (raise && !fresh) ? fexp2(-shift) : 1.f;
            R.m = raise ? (fresh ? tmax : R.m + tmax) : R.m; R.lpart *= alpha; shift_out = shift;
#pragma unroll
            for (int kt = 0; kt < 2; ++kt)
#pragma unroll
                for (int e = 0; e < 16; ++e) s[kt][e] -= shift;
            if (MODE >= 2) {
#pragma unroll
                for (int e = 0; e < 16; ++e) { o[0][e] *= alpha; o[1][e] *= alpha; } }
        }
        float ps4[4] = {0.f, 0.f, 0.f, 0.f};
#pragma unroll
        for (int kt = 0; kt < 2; ++kt)
#pragma unroll
            for (int e = 0; e < 16; ++e) { s[kt][e] = fexp2(s[kt][e]); ps4[e & 3] += s[kt][e]; }
        R.lpart += (ps4[0] + ps4[1]) + (ps4[2] + ps4[3]);
        if (MODE >= 2) { if (VAR & 16) { o[0][0] += s[0][3] + s[1][7]; } else at_pv((unsigned)(size_t)(lds + AT_V + stg * 8192), voff, s, o); }
    }
    return shift_out;
}
template <int MODE, int VAR = 0>
__device__ __forceinline__ void at_branch(const Frame& F, unsigned long long mask, const bf16* Kb, const bf16* Vb, size_t stride, const bf16x8 (&Qf)[4], AttnRow& R, const unsigned (&voff)[2][2],
                                          f32x16 (&o)[2], float mfin, float invl) {
    LAS unsigned char* lds = F.lds; const int tid = F.tid;
    if (mask == 0ull) return;
    AttnStage st0, st1; int sg = 0;
    { const int j0 = __builtin_ctzll(mask); at_gload(st0, Kb, Vb, stride, j0, tid); at_swrite(st0, lds, 0, tid);
      const unsigned long long m1 = mask & (mask - 1ull); if (m1) { at_gload(st1, Kb, Vb, stride, __builtin_ctzll(m1), tid); at_swrite(st1, lds, 1, tid); } }
    __syncthreads();
    while (mask) {
        const int j0 = __builtin_ctzll(mask); mask &= mask - 1ull;
        int j1 = -1; if (mask) { j1 = __builtin_ctzll(mask); mask &= mask - 1ull; }
        int n0 = -1, n1 = -1; { unsigned long long mm = mask; if (mm) { n0 = __builtin_ctzll(mm); mm &= mm - 1ull; if (mm) n1 = __builtin_ctzll(mm); } }
        at_gload(st0, Kb, Vb, stride, n0 >= 0 ? n0 : j0, tid);
        at_gload(st1, Kb, Vb, stride, n1 >= 0 ? n1 : j0, tid);
        { f32x16 sa[2]; TileInfo Ia;
          at_tile_qk<MODE, VAR>(F, j0, sg, Qf, R, mfin, sa, Ia);
          (void)at_tile_fin<MODE, VAR>(F, j0, sg, sa, Ia, R, voff, o, invl, 0.f); }
        if (j1 >= 0) { f32x16 sb[2]; TileInfo Ib;
          at_tile_qk<MODE, VAR>(F, j1, sg + 1, Qf, R, mfin, sb, Ib);
          (void)at_tile_fin<MODE, VAR>(F, j1, sg + 1, sb, Ib, R, voff, o, invl, 0.f); }
        if (n0 >= 0) at_swrite(st0, lds, (sg + 2) & 3, tid);
        if (n1 >= 0) at_swrite(st1, lds, (sg + 3) & 3, tid);
        __syncthreads();
        sg = (sg + 2) & 3;
    }
}

template <int VAR>
__device__ __forceinline__ void attn_item(const Frame& F, ArgsP a, int l, int item) {
    const int qb = 63 - (item >> 4), bh = item & 15, b = bh >> 1, hk = bh & 1; const int lane = F.lane, wave = F.wave;
    const bf16* H = (const bf16*)(a->ws + WS_H); const float* side = (const float*)(a->ws + WS_SIDE); bf16* Y = (bf16*)(a->ws + WS_Y);
    LAS unsigned char* lds = F.lds;
    AttnRow R; R.r = lane & 31; R.hf = lane >> 5; R.tt = 8 * wave + (R.r >> 2); R.t = 64 * qb + R.tt; R.qb = qb; R.wave = wave; R.wave_union = 0ull;
    const int head = hk * 4 + (R.r & 3); const size_t tok = (size_t)b * SEQ + R.t;
    bf16x8 Qf[4];
#pragma unroll
    for (int ks = 0; ks < 4; ++ks) Qf[ks] = *(const bf16x8*)(H + tok * HLD + head * 64 + 16 * ks + 8 * R.hf);
    const float g_cmp = side[tok * 32 + head * 3], g_sel = side[tok * 32 + head * 3 + 1], g_win = side[tok * 32 + head * 3 + 2];
    unsigned voff[2][2];
    { const int li = lane & 15, q = li >> 2, p = li & 3, gi1 = (lane >> 4) & 1;
#pragma unroll
      for (int jh = 0; jh < 2; ++jh)
#pragma unroll
          for (int dt = 0; dt < 2; ++dt) voff[jh][dt] = (unsigned)((8 * jh + 4 * R.hf + q) * 128 + ((((4 * dt + 2 * gi1 + (p >> 1)) ^ (4 * jh + 2 * R.hf + (q >> 1))) & 7) << 4) + (p & 1) * 8); }
    { LAS float* imp = (LAS float*)(lds + AT_IMP) + (8 * wave) * 68; for (int i = lane; i < 8 * 68; i += 64) imp[i] = 0.f; if (F.tid == 0) { *(LAS unsigned*)(lds + AT_UNI) = 0u; *(LAS unsigned*)(lds + AT_UNI + 4) = 0u; } }
    f32x16 o[2];
#pragma unroll
    for (int e = 0; e < 16; ++e) { o[0][e] = 0.f; o[1][e] = 0.f; }
    LAS float* ys = (LAS float*)(lds + AT_YS + wave * 8192) + lane;
    {
        const bf16* Kc = (const bf16*)(a->ws + WS_KC) + (size_t)bh * 256 * 64; const bf16* Vc = (const bf16*)(a->ws + WS_VC) + (size_t)bh * 256 * 64;
        const int ntc = (4 * qb + 3 + 63) >> 6; const unsigned long long mc = (ntc >= 64) ? ~0ull : ((1ull << ntc) - 1ull);
        R.m = -1e30f; R.lpart = 0.f;
        if (!(VAR & 8)) at_branch<0, VAR>(F, mc, Kc, Vc, 64, Qf, R, voff, o, 0.f, 0.f);
        const float lsum = half_sum(R.lpart); const float invl = 1.f / fmaxf(lsum, 1e-30f);
        if (!(VAR & 8)) at_branch<1, VAR>(F, mc, Kc, Vc, 64, Qf, R, voff, o, R.m, invl);
#pragma unroll
        for (int e = 0; e < 16; ++e) { ys[e * 64] = g_cmp * o[0][e]; ys[(16 + e) * 64] = g_cmp * o[1][e]; o[0][e] = 0.f; o[1][e] = 0.f; }
    }
    LDS_WAIT();
    {
        unsigned long long wu = 0ull;
        for (int qi = 0; qi < 8; ++qi) {
            unsigned long long selm;
            if (qb < 16) selm = (2ull << qb) - 1ull;
            else {
                const float v = ((const LAS float*)(lds + AT_IMP))[(8 * wave + qi) * 68 + lane];
                const bool cand = (lane >= 1) && (lane <= qb - 2); const unsigned key = cand ? __float_as_uint(fmaxf(v, 0.f)) : 0u;
                unsigned thr = 0u;
                for (int bit = 30; bit >= 0; --bit) { const unsigned tr = thr | (1u << bit); const int c = __popcll(__ballot(cand && key >= tr)); if (c >= 13) thr = tr; }
                const unsigned long long gt = __ballot(cand && key > thr), eq = __ballot(cand && key == thr);
                int need = 13 - __popcll(gt); unsigned long long eqs = 0ull, e2 = eq;
                while (need > 0 && e2) { const unsigned long long low = e2 & (~e2 + 1ull); eqs |= low; e2 ^= low; --need; }
                selm = gt | eqs | 1ull | (1ull << qb) | (1ull << (qb - 1));
            }
            if (lane == 0) *(LAS unsigned long long*)(lds + AT_SELM + 8 * (8 * wave + qi)) = selm;
#if defined(SELFCHECK) && SELFCHECK == 1
            if (lane == 0 && l == 1) ((unsigned long long*)(a->ws + (size_t)984 * MiB + 64 * KiB))[(size_t)bh * SEQ + 64 * qb + 8 * wave + qi] = selm;
#endif
            wu |= selm;
        }
        R.wave_union = wu;
        if (lane == 0) { __hip_atomic_fetch_or((LAS unsigned*)(lds + AT_UNI), (unsigned)wu, __ATOMIC_RELAXED, __HIP_MEMORY_SCOPE_WORKGROUP); __hip_atomic_fetch_or((LAS unsigned*)(lds + AT_UNI + 4), (unsigned)(wu >> 32), __ATOMIC_RELAXED, __HIP_MEMORY_SCOPE_WORKGROUP); }
    }
    __syncthreads();
    const unsigned long long bunion = (unsigned long long)*(const LAS unsigned*)(lds + AT_UNI) | ((unsigned long long)*(const LAS unsigned*)(lds + AT_UNI + 4) << 32);
    const bf16* Hb = H + (size_t)b * SEQ * HLD;
    {
        R.m = -1e30f; R.lpart = 0.f;
        if (!(VAR & 2)) at_branch<2, VAR>(F, bunion, Hb + 512 + 2 * 128 + hk * 64, Hb + 512 + 3 * 128 + hk * 64, HLD, Qf, R, voff, o, 0.f, 0.f);
        const float lsum = half_sum(R.lpart); const float sc = g_sel / fmaxf(lsum, 1e-30f);
#pragma unroll
        for (int e = 0; e < 16; ++e) { ys[e * 64] += sc * o[0][e]; ys[(16 + e) * 64] += sc * o[1][e]; o[0][e] = 0.f; o[1][e] = 0.f; }
    }
    {
        const int lo = qb - 8 > 0 ? qb - 8 : 0; const unsigned long long mw = ((2ull << qb) - 1ull) & ~((1ull << lo) - 1ull);
        R.m = -1e30f; R.lpart = 0.f;
        if (!(VAR & 4)) at_branch<3, VAR>(F, mw, Hb + 512 + 4 * 128 + hk * 64, Hb + 512 + 5 * 128 + hk * 64, HLD, Qf, R, voff, o, 0.f, 0.f);
        const float lsum = half_sum(R.lpart); const float sc = g_win / fmaxf(lsum, 1e-30f);
#pragma unroll
        for (int e = 0; e < 16; ++e) { o[0][e] = ys[e * 64] + sc * o[0][e]; o[1][e] = ys[(16 + e) * 64] + sc * o[1][e]; }
    }
    if (VAR & 1) { asm volatile("" :: "v"(o[0][0]), "v"(o[1][5])); return; }
    bf16* yrow = Y + tok * DM + head * 64 + 4 * R.hf;
#pragma unroll
    for (int dt = 0; dt < 2; ++dt)
#pragma unroll
        for (int rg = 0; rg < 4; ++rg) { u32x2 w; w.x = pk2(o[dt][4 * rg], o[dt][4 * rg + 1]); w.y = pk2(o[dt][4 * rg + 2], o[dt][4 * rg + 3]); *(u32x2*)(yrow + 32 * dt + 8 * rg) = w; }
}

__device__ __forceinline__ void phase_mix_b(const Frame& F, ArgsP a, int l, int rep) {
    unsigned* q = F.ctl + CW_QUEUE + l * 64 + rep * 32;
    for (;;) {
        if (F.tid == 0) F.MISC[0] = __hip_atomic_fetch_add(q, 1u, __ATOMIC_RELAXED, __HIP_MEMORY_SCOPE_AGENT);
        __syncthreads();
        const int item = (int)F.MISC[0];
        __syncthreads();
        if (item >= 1024) break;
        if (rep == 0) attn_item<0>(F, a, l, item); else attn_item<PROBE_ATTN_VAR>(F, a, l, item);
    }
}

constexpr size_t WS_DBG = 984 * MiB;
constexpr int CHECK_LAYER = 1;
__device__ __forceinline__ void dbg_add(ArgsP a, int i, float v) { atomicAdd((float*)(a->ws + WS_DBG) + i, v); }

__device__ __forceinline__ void check_nsa(const Frame& F, ArgsP a) {
    const bf16* H = (const bf16*)(a->ws + WS_H); const float* side = (const float*)(a->ws + WS_SIDE); const bf16* Y = (const bf16*)(a->ws + WS_Y);
    const unsigned long long* SELM = (const unsigned long long*)(a->ws + WS_DBG + 64 * KiB);
    const int lane = F.lane; const int tv[16] = {5, 40, 63, 64, 100, 511, 512, 1023, 1024, 1500, 2047, 2048, 3000, 3333, 4000, 4095};
    for (int s = F.bid * NWAVES + F.wave; s < 256; s += F.G * NWAVES) {
        int t = tv[0];
#pragma unroll
        for (int q = 1; q < 16; ++q) t = ((s & 15) == q) ? tv[q] : t;
        const int b = (s >> 4) & 7, hq = ((s >> 7) * 5 + (s & 7)) & 7, hk = hq >> 2; const size_t tok = (size_t)b * SEQ + t; const int bhk = b * 2 + hk;
        const bf16* KC = (const bf16*)(a->ws + WS_KC) + (size_t)bhk * 256 * 64; const bf16* VC = (const bf16*)(a->ws + WS_VC) + (size_t)bhk * 256 * 64;
        const float g_cmp = side[tok * 32 + hq * 3], g_sel = side[tok * 32 + hq * 3 + 1], g_win = side[tok * 32 + hq * 3 + 2];
        const int cmax = (t - 31) >> 4; float imp = 0.f, ocmp = 0.f;
        for (int gh = 0; gh < 4; ++gh) {
            const int head = hk * 4 + gh; const float qd = bf2f(H[tok * HLD + head * 64 + lane]);
            float m = -INFINITY, l = 0.f;
            for (int c = 0; c <= cmax; ++c) m = fmaxf(m, wave_sum(qd * bf2f(KC[c * 64 + lane])));
            for (int c = 0; c <= cmax; ++c) l += fexp2(wave_sum(qd * bf2f(KC[c * 64 + lane])) - m);
            for (int c = 0; c <= cmax; ++c) { const float p = fexp2(wave_sum(qd * bf2f(KC[c * 64 + lane])) - m) / l; const int j = c >> 2, e = c & 3;
                if (lane == j) imp += (e < 3 ? 2.f : 1.f) * p; if (e == 3 && lane == j + 1) imp += p;
                if (head == hq) ocmp += p * bf2f(VC[c * 64 + lane]); }
        }
        const int cur = t >> 6; const bool causal = lane <= cur, forced = (lane == 0) || (lane == cur) || (lane == cur - 1);
        const float key = causal ? (imp + (forced ? 1.0e4f : 0.f)) : -INFINITY; int rank = 0;
        for (int i = 0; i < 64; ++i) { const float ki = __shfl(key, i); rank += ((ki > key) || (ki == key && i < lane)) ? 1 : 0; }
        const unsigned long long refm = __ballot(causal && rank < 16), stm = SELM[(size_t)bhk * SEQ + t];
        if (lane == 0) { dbg_add(a, 2, (float)__popcll(refm ^ stm)); dbg_add(a, 3, 16.f); }
        const float qd = bf2f(H[tok * HLD + hq * 64 + lane]); const bf16* Hb = H + (size_t)b * SEQ * HLD + hk * 64 + lane;
        float m = -INFINITY, l = 0.f, osel = 0.f;
        for (int j = 0; j <= cur; ++j) if ((stm >> j) & 1ull) for (int kk = 0; kk < 64; ++kk) { const int p = 64 * j + kk; if (p > t) break;
            const float sc = wave_sum(qd * bf2f(Hb[(size_t)p * HLD + 512 + 2 * 128])); const float mn = fmaxf(m, sc), al = fexp2(m - mn), pp = fexp2(sc - mn);
            l = l * al + pp; osel = osel * al + pp * bf2f(Hb[(size_t)p * HLD + 512 + 3 * 128]); m = mn; }
        const float ysel = osel / fmaxf(l, 1e-30f);
        m = -INFINITY; l = 0.f; float owin = 0.f;
        for (int p = (t - 511 > 0 ? t - 511 : 0); p <= t; ++p) { const float sc = wave_sum(qd * bf2f(Hb[(size_t)p * HLD + 512 + 4 * 128])); const float mn = fmaxf(m, sc), al = fexp2(m - mn), pp = fexp2(sc - mn);
            l = l * al + pp; owin = owin * al + pp * bf2f(Hb[(size_t)p * HLD + 512 + 5 * 128]); m = mn; }
        const float ref = g_cmp * ocmp + g_sel * ysel + g_win * owin / fmaxf(l, 1e-30f), got = bf2f(Y[tok * DM + hq * 64 + lane]);
        const float e2 = wave_sum((ref - got) * (ref - got)), r2 = wave_sum(ref * ref);
        if (lane == 0) { dbg_add(a, 0, e2); dbg_add(a, 1, r2); }
    }
}

__device__ __forceinline__ void check_gdn(const Frame& F, ArgsP a, int l) {
    if (F.bid >= 8) return;
    const bf16* H = (const bf16*)(a->ws + WS_H); const float* side = (const float*)(a->ws + WS_SIDE); const bf16* Y = (const bf16*)(a->ws + WS_Y);
    const int b = F.bid, h = (F.bid * 3) & 3, tid = F.tid, lane = F.lane, col = tid & 63, rg = tid >> 6;
    LAS float* S = (LAS float*)F.lds; LAS float* qv = S + 64 * 65; LAS float* kv = qv + 64; LAS float* vv = kv + 64; LAS float* sc = vv + 64; LAS float* part = sc + 64;
    for (int i = tid; i < 64 * 65; i += NTHR) S[i] = 0.f;
    float hq[3] = {0.f, 0.f, 0.f}, hk[3] = {0.f, 0.f, 0.f}, hv[3] = {0.f, 0.f, 0.f}, wq[4], wk[4], wv[4];
    { const float* cw = a->in[6] + (size_t)l * 4 * 768 + h * 64 + lane;
#pragma unroll
      for (int k = 0; k < 4; ++k) { wq[k] = cw[k * 768]; wk[k] = cw[k * 768 + 256]; wv[k] = cw[k * 768 + 512]; } }
    const float Aexp = __expf(a->in[7][l * 4 + h]), dtb = a->in[8][l * 4 + h], nw = a->in[9][l * 64 + lane];
    __syncthreads();
    for (int t = 0; t < 192; ++t) {
        const size_t tok = (size_t)b * SEQ + t;
        if (F.wave == 0) { const bf16* p = H + tok * HLD + 1280 + h * 64 + lane; const float rq = bf2f(p[0]), rk = bf2f(p[256]), rv = bf2f(p[512]);
            const float cq = wq[0] * hq[0] + wq[1] * hq[1] + wq[2] * hq[2] + wq[3] * rq, ck = wk[0] * hk[0] + wk[1] * hk[1] + wk[2] * hk[2] + wk[3] * rk, cv = wv[0] * hv[0] + wv[1] * hv[1] + wv[2] * hv[2] + wv[3] * rv;
            hq[0] = hq[1]; hq[1] = hq[2]; hq[2] = rq; hk[0] = hk[1]; hk[1] = hk[2]; hk[2] = rk; hv[0] = hv[1]; hv[1] = hv[2]; hv[2] = rv;
            const float qs = cq / (1.f + __expf(-cq)), ks = ck / (1.f + __expf(-ck)), vs = cv / (1.f + __expf(-cv));
            qv[lane] = qs / sqrtf(wave_sum(qs * qs) + 1e-6f); kv[lane] = ks / sqrtf(wave_sum(ks * ks) + 1e-6f); vv[lane] = vs;
            if (lane == 0) { const float av = side[tok * 32 + 28 + h] + dtb; const float sp = av > 20.f ? av : log1pf(__expf(av)); sc[0] = __expf(-Aexp * sp); sc[1] = side[tok * 32 + 24 + h]; } }
        __syncthreads();
        { float ps = 0.f;
#pragma unroll
          for (int r = 0; r < 8; ++r) ps += kv[8 * rg + r] * S[(8 * rg + r) * 65 + col];
          part[rg * 64 + col] = ps; }
        __syncthreads();
        { float ks = 0.f;
#pragma unroll
          for (int r = 0; r < 8; ++r) ks += part[r * 64 + col];
          const float eg = sc[0], be = sc[1]; float po = 0.f;
          __syncthreads();
#pragma unroll
          for (int r = 0; r < 8; ++r) { const int dk = 8 * rg + r; const float sn = eg * (S[dk * 65 + col] - be * kv[dk] * ks) + be * kv[dk] * vv[col]; S[dk * 65 + col] = sn; po += sn * qv[dk]; }
          part[rg * 64 + col] = po; }
        __syncthreads();
        if (F.wave == 0) { float o = 0.f;
#pragma unroll
            for (int r = 0; r < 8; ++r) o += part[r * 64 + lane];
            o *= 0.125f; const float rs = 1.f / sqrtf(wave_sum(o * o) * (1.f / 64.f) + 1e-6f); const float z = bf2f(H[tok * HLD + 2048 + h * 64 + lane]);
            const float ref = o * rs * nw * (z / (1.f + __expf(-z))), got = bf2f(Y[tok * DM + 512 + h * 64 + lane]);
            const float e2 = wave_sum((ref - got) * (ref - got)), r2 = wave_sum(ref * ref);
            if (lane == 0) { dbg_add(a, 4, e2); dbg_add(a, 5, r2); } }
        __syncthreads();
    }
}

__device__ __forceinline__ void check_moe(const Frame& F, ArgsP a, int l) {
    const bf16* XBc = (const bf16*)(a->ws + WS_XB); const bf16* Y2 = (const bf16*)(a->ws + WS_Y2);
    const int* route_e = (const int*)(a->ws + WS_SLOT + SL_RE); const float* route_w = (const float*)(a->ws + WS_SLOT + SL_RW);
    LAS float* x = (LAS float*)F.lds; LAS float* hid = x + 1024; LAS float* lg = hid + 512; LAS float* yr = lg + 64;
    const int tid = F.tid, lane = F.lane;
    for (int s = F.bid; s < 256; s += F.G) {
        const int t = (s * 4099 + 17) & (T - 1);
        for (int i = tid; i < 1024; i += NTHR) { x[i] = bf2f(XBc[(size_t)t * DM + i]); yr[i] = 0.f; }
        __syncthreads();
        for (int j = F.wave; j < 36; j += NWAVES) { float d = 0.f; for (int k = lane; k < DM; k += 64) d += x[k] * (j < 4 ? a->in[18][((size_t)l * DM + k) * 4 + j] : a->in[20][((size_t)l * DM + k) * NEXP + j - 4]);
            d = wave_sum(d); if (lane == 0) lg[j] = d + (j < 4 ? a->in[19][l * 4 + j] : a->in[21][l * NEXP + j - 4]); }
        __syncthreads();
        if (tid == 0) { int gi = 0; for (int i = 1; i < 4; ++i) if (lg[i] > lg[gi]) gi = i; float gs = 0.f; for (int i = 0; i < 4; ++i) gs += __expf(lg[i] - lg[gi]); const float gw = 1.f / gs;
            int i1 = 0; for (int i = 1; i < 8; ++i) if (lg[4 + gi * 8 + i] > lg[4 + gi * 8 + i1]) i1 = i; int i2 = -1; for (int i = 0; i < 8; ++i) if (i != i1 && (i2 < 0 || lg[4 + gi * 8 + i] > lg[4 + gi * 8 + i2])) i2 = i;
            const float e2 = __expf(lg[4 + gi * 8 + i2] - lg[4 + gi * 8 + i1]), w1 = gw / (1.f + e2), w2 = gw - w1;
            const int se1 = route_e[2 * t], se2 = route_e[2 * t + 1]; const float sw1 = route_w[2 * t], sw2 = route_w[2 * t + 1];
            dbg_add(a, 8, (se1 != gi * 8 + i1 ? 1.f : 0.f) + (se2 != gi * 8 + i2 ? 1.f : 0.f)); dbg_add(a, 9, 2.f);
            if (se1 == gi * 8 + i1 && se2 == gi * 8 + i2) { dbg_add(a, 10, (sw1 - w1) * (sw1 - w1) + (sw2 - w2) * (sw2 - w2)); dbg_add(a, 11, w1 * w1 + w2 * w2); } }
        for (int k2 = 0; k2 < 2; ++k2) {
            const int e = route_e[2 * t + k2]; const float rw = route_w[2 * t + k2];
            const float* wg = a->in[22] + ((size_t)l * NEXP + e) * DM * FF; const float* wu = a->in[23] + ((size_t)l * NEXP + e) * DM * FF; const float* wd = a->in[24] + ((size_t)l * NEXP + e) * FF * DM;
            { float g = 0.f, u = 0.f; for (int k = 0; k < DM; ++k) { g += x[k] * wg[(size_t)k * FF + tid]; u += x[k] * wu[(size_t)k * FF + tid]; } hid[tid] = g / (1.f + __expf(-g)) * u; }
            __syncthreads();
            for (int d = tid; d < DM; d += NTHR) { float y = 0.f; for (int f = 0; f < FF; ++f) y += hid[f] * wd[(size_t)f * DM + d]; yr[d] += y * rw; }
            __syncthreads();
        }
        float e2 = 0.f, r2 = 0.f;
        for (int d = tid; d < DM; d += NTHR) { const float got = bf2f(Y2[(size_t)(2 * t) * DM + d]) + bf2f(Y2[(size_t)(2 * t + 1) * DM + d]); e2 += (yr[d] - got) * (yr[d] - got); r2 += yr[d] * yr[d]; }
        e2 = wave_sum(e2); r2 = wave_sum(r2); if (lane == 0) { dbg_add(a, 6, e2); dbg_add(a, 7, r2); }
        __syncthreads();
    }
}

__device__ __forceinline__ void check_inproj(const Frame& F, ArgsP a, int l) {
    const bf16* H = (const bf16*)(a->ws + WS_H); const float* xin = (l == 0) ? a->in[0] : (const float*)a->out; const float* win = a->in[1] + (size_t)l * DM * DIN;
    const int lane = F.lane;
    for (int s = F.bid * NWAVES + F.wave; s < 1024; s += F.G * NWAVES) {
        const int tok = (s * 7919 + 13) & (T - 1), grp = s % 14, t = tok & (SEQ - 1);
        const int col0 = grp < 8 ? grp * 64 : 512 + (grp - 8) * 128 + ((s >> 4) & 1) * 64; const bool isq = grp < 8, rope = isq || ((grp - 8) % 2 == 0);
        float d = 0.f; for (int k = 0; k < DM; ++k) d += xin[(size_t)tok * DM + k] * win[(size_t)k * DIN + col0 + lane];
        if (rope) { const float inv[8] = {1.0f, 0.19392274f, 0.03760603f, 0.0072926646f, 0.0014142136f, 0.0002742482f, 5.3182957e-05f, 1.0313385e-05f};
            float iv = inv[0];
#pragma unroll
            for (int q = 1; q < 8; ++q) iv = ((lane & 7) == q) ? inv[q] : iv;
            const float ang = (float)t * iv, c = cosf(ang), sn = sinf(ang), other = __shfl_xor(d, 8);
            if (lane < 8) d = d * c - other * sn; else if (lane < 16) d = d * c + other * sn; }
        if (isq) d *= pg8::QSCALE;
        const float got = bf2f(H[(size_t)tok * HLD + col0 + lane]); const float e2 = wave_sum((d - got) * (d - got)), r2 = wave_sum(d * d);
        if (lane == 0) { dbg_add(a, 12, e2); dbg_add(a, 13, r2); }
    }
}
__device__ __forceinline__ void check_compress(const Frame& F, ArgsP a, int l) {
    const bf16* H = (const bf16*)(a->ws + WS_H); const int lane = F.lane;
    for (int s = F.bid * NWAVES + F.wave; s < 512; s += F.G * NWAVES) {
        const int kv = s & 1, bh = (s >> 1) & 15, b = bh >> 1, hh = bh & 1, i = (s * 53 + 7) % 255;
        const float* pe = a->in[3] + ((size_t)l * 2 + kv) * 2048; const float* w1 = a->in[4] + ((size_t)l * 2 + kv) * 2048 * 128; const float* w2 = a->in[5] + ((size_t)l * 2 + kv) * 128 * 64;
        float h0 = 0.f, h1 = 0.f;
        for (int k = 0; k < 2048; ++k) { const int p = k >> 6, d = k & 63; const float x = bf2f(H[((size_t)b * SEQ + 16 * i + p) * HLD + 512 + kv * 128 + hh * 64 + d]) + pe[k];
            h0 += x * w1[(size_t)k * 128 + lane]; h1 += x * w1[(size_t)k * 128 + 64 + lane]; }
        h0 = h0 / (1.f + __expf(-h0)); h1 = h1 / (1.f + __expf(-h1));
        float o = 0.f;
        for (int n = 0; n < 64; ++n) { o += __shfl(h0, n) * w2[(size_t)n * 64 + lane] + __shfl(h1, n) * w2[(size_t)(64 + n) * 64 + lane]; }
        const float got = bf2f(((const bf16*)(a->ws + (kv ? WS_VC : WS_KC)))[((size_t)bh * 256 + i) * 64 + lane]);
        const float e2 = wave_sum((o - got) * (o - got)), r2 = wave_sum(o * o); if (lane == 0) { dbg_add(a, 14, e2); dbg_add(a, 15, r2); }
    }
}
__device__ __forceinline__ void check_conformer(const Frame& F, ArgsP a, int l) {
    const bf16* H = (const bf16*)(a->ws + WS_H); const bf16* Y = (const bf16*)(a->ws + WS_Y); const int lane = F.lane;
    for (int s = F.bid * NWAVES + F.wave; s < 1024; s += F.G * NWAVES) {
        const int tok = (s * 6151 + 3) & (T - 1), t = tok & (SEQ - 1); float u[4];
#pragma unroll
        for (int j = 0; j < 4; ++j) { const int c = lane + 64 * j; float acc = a->in[11][l * 256 + c];
            for (int k = 0; k < 31; ++k) { const int sp = t - 30 + k; if (sp >= 0) { const bf16* hp = H + (size_t)(tok - 30 + k) * HLD + 2304 + c; const float g = bf2f(hp[256]); acc += a->in[10][((size_t)l * 31 + k) * 256 + c] * (bf2f(hp[0]) / (1.f + __expf(-g))); } }
            u[j] = acc; }
        const float mean = wave_sum(u[0] + u[1] + u[2] + u[3]) * (1.f / 256.f); float q = 0.f;
#pragma unroll
        for (int j = 0; j < 4; ++j) { u[j] -= mean; q += u[j] * u[j]; }
        const float rstd = 1.f / sqrtf(wave_sum(q) * (1.f / 256.f) + LN_EPS); float e2 = 0.f, r2 = 0.f;
#pragma unroll
        for (int j = 0; j < 4; ++j) { const int c = lane + 64 * j; const float v = u[j] * rstd * a->in[12][l * 256 + c] + a->in[13][l * 256 + c]; const float ref = v / (1.f + __expf(-v)), got = bf2f(Y[(size_t)tok * DM + 768 + c]);
            e2 += (ref - got) * (ref - got); r2 += ref * ref; }
        e2 = wave_sum(e2); r2 = wave_sum(r2); if (lane == 0) { dbg_add(a, 16, e2); dbg_add(a, 17, r2); }
    }
}
__device__ __forceinline__ void check_inject(const Frame& F, ArgsP a) {
    if (F.bid == 0 && F.tid == 0) { const float* d = (const float*)(a->ws + WS_DBG); float e0 = 0.f, e1 = 0.f;
        if (SELFCHECK == 1) { e0 = 1000.f * sqrtf(d[0] / d[1]); e1 = 1.0e4f * d[2] / d[3]; }
        if (SELFCHECK == 2) { e0 = 1000.f * sqrtf(d[4] / d[5]); }
        if (SELFCHECK == 3) { e0 = 1000.f * sqrtf(d[6] / d[7]); e1 = 1.0e4f * d[8] / d[9] + 1000.f * sqrtf(d[10] / fmaxf(d[11], 1e-30f)); }
        if (SELFCHECK == 4) { e0 = 1000.f * sqrtf(d[12] / d[13]); }
        if (SELFCHECK == 5) { e0 = 1000.f * sqrtf(d[14] / d[15]); e1 = 1000.f * sqrtf(d[16] / d[17]); }
        a->out[0] += e0; a->out[1] += e1; }
}


#ifndef MK_MULTI
#define MK_MULTI 0
#endif
#ifndef PROBE_REPEAT
#define PROBE_REPEAT 0
#endif
constexpr int N_PHASES = 1 + 10 * NL;
#ifndef TIMING
#define TIMING 0
#endif
#ifndef TA_LO
#define TA_LO 0
#define TA_HI 1
#define TB_LO 0
#define TB_HI 1
#endif
#define TSTAMP(i) do { if (TIMING) { if (F.bid == 0 && F.tid == 0) ((unsigned long long*)(args_here()->ws + (size_t)985 * MiB))[i] = __builtin_amdgcn_s_memrealtime(); } } while (0)
__device__ __forceinline__ Frame make_frame(int wave_s) {
    extern __shared__ __attribute__((aligned(16))) unsigned char lds_raw[];
    Frame F; F.lds = (LAS unsigned char*)lds_raw; F.MISC = (volatile LAS unsigned*)(F.lds + MISC_OFF);
    int tid = threadIdx.x, G = gridDim.x, bid = blockIdx.x; unsigned lb = (unsigned)(size_t)F.lds; (void)wave_s;
    asm volatile("" : "+v"(tid), "+s"(G), "+s"(bid), "+s"(lb));
    F.lds = (LAS unsigned char*)(size_t)lb; F.MISC = (volatile LAS unsigned*)(F.lds + MISC_OFF);
    F.tid = tid; F.lane = F.tid & 63; F.wave = __builtin_amdgcn_readfirstlane(F.tid >> 6); F.G = G; F.bid = bid;
    F.ctl = (unsigned*)(args_here()->ws + WS_CTL); return F;
}
__device__ __forceinline__ void ph_prologue(int, int wv) { const Frame F = make_frame(wv); phase_prologue(F, args_here()); phase_weights(F, args_here(), 0, 2, F.G, 0);
#if SELFCHECK
    if (F.bid == 0 && F.tid < 64) ((float*)(args_here()->ws + WS_DBG))[F.tid] = 0.f;
#endif
}
__device__ __forceinline__ void ph_inproj(int l, int wv) { const Frame F = make_frame(wv); unsigned char* ws = args_here()->ws;
    pg8::Gemm g{(const bf16*)(ws + WS_X8), (const bf16*)(WLBASE(ws, l) + WL_WIN), T, DINP, DM / 2};   pg8::StaticOrder S; S.init(T, DINP, F.G, F.bid);
    pg8::EpiInProj E{(bf16*)(ws + WS_H), (float*)(ws + WS_SIDE), (const float*)(ws + WS_ROPE)};
    pg8::gemm_phase<pg8::EpiInProj, pg8::StaticOrder, false>(F.lds, g, S, E, nullptr, F.tid); }
__device__ __forceinline__ void ph_compress(int l, int wv) { const Frame F = make_frame(wv); for (int it = F.bid; it < 256; it += F.G) compress_item(F, args_here(), l, it); }
__device__ __forceinline__ void ph_gdnprep(int l, int wv) { const Frame F = make_frame(wv); for (int it = F.bid; it < 256; it += F.G) { gdn_prep_chunk<0>(F, args_here(), l, it * 8 + F.wave, F.lds + F.wave * 16384); __syncthreads(); } }
__device__ __forceinline__ void ph_gdnprep_var(int l, int wv) { const Frame F = make_frame(wv); for (int it = F.bid; it < 256; it += F.G) { gdn_prep_chunk<PROBE_GDN_VAR | 1>(F, args_here(), l, it * 8 + F.wave, F.lds + F.wave * 16384); __syncthreads(); } }
__device__ __forceinline__ void ph_conformer(int l, int wv) { const Frame F = make_frame(wv); for (int it = F.bid; it < 512; it += F.G) conformer_item(F, args_here(), l, it); }
__device__ __forceinline__ void ph_gdnout(int l, int wv) { const Frame F = make_frame(wv); for (int ci = F.bid * NWAVES + F.wave; ci < 2048; ci += F.G * NWAVES) gdn_out_chunk(F, args_here(), ci, F.lds + F.wave * 8192); }
constexpr int NCONV = 64;
__device__ __forceinline__ void ph_scan(int l, int wv) { const Frame F = make_frame(wv); if (F.bid < 16) gdn_scan<0>(F, args_here(), l); }
__device__ __forceinline__ void ph_bgweights(int l, int wv) { const Frame F = make_frame(wv);
    if (F.bid < NCONV) { if (l == 0) phase_weights(F, args_here(), 0, 1, NCONV, 0); if (l + 1 < NL) phase_weights(F, args_here(), l + 1, 3, NCONV, 0); __syncthreads(); } }
__device__ __forceinline__ void ph_scan_var(int l, int wv) { const Frame F = make_frame(wv); if (F.bid < 16) gdn_scan<(PROBE_SCAN_VAR & 1)>(F, args_here(), l); }
__device__ __forceinline__ void ph_attn(int l, int rep, int wv) { const Frame F = make_frame(wv); phase_mix_b(F, args_here(), l, rep); }
__device__ __forceinline__ void ph_outproj(int l, int wv) { const Frame F = make_frame(wv); ArgsP ap = args_here(); unsigned char* ws = ap->ws;
    pg8::Gemm g{(const bf16*)(ws + WS_Y), (const bf16*)(WLBASE(ws, l) + WL_WOUT), T, DM, DM}; pg8::StaticOrder S; S.init(T, DM, F.G, F.bid);
    pg8::EpiOutProj E{(const bf16*)(ws + WS_XB), (bf16*)(ws + WS_X1), DN_ALPHA};
    pg8::gemm_phase<pg8::EpiOutProj, pg8::StaticOrder, false>(F.lds, g, S, E, nullptr, F.tid); }
__device__ __forceinline__ void ph_ln1(int l, int wv) { const Frame F = make_frame(wv); phase_ln1_router<false>(F, args_here(), l); }
__device__ __forceinline__ void ph_ln1_dry(int l, int wv) { const Frame F = make_frame(wv); phase_ln1_router<true>(F, args_here(), l); }
__device__ __forceinline__ void ph_gather(int l, int wv) { const Frame F = make_frame(wv); phase_gather(F, args_here(), l); }
__device__ __forceinline__ void ph_moeup(int l, int wv) { const Frame F = make_frame(wv); unsigned char* ws = args_here()->ws;
    pg8::Gemm g{(const bf16*)(ws + WS_H), (const bf16*)(WLBASE(ws, l) + WL_WGU), 0, 0, DM / 2};   pg8::MoeOrder S{(const int*)(ws + WS_META) + l * 512, F.G, F.bid};
    pg8::EpiSwiGLU E{ws + WS_HID, (const int*)(ws + WS_SLOT + SL_TOK), 1};
    pg8::gemm_phase<pg8::EpiSwiGLU, pg8::MoeOrder, false>(F.lds, g, S, E, nullptr, F.tid); }
__device__ __forceinline__ void ph_moedown(int l, int wv) { const Frame F = make_frame(wv); unsigned char* ws = args_here()->ws;
    pg8::Gemm g{(const bf16*)(ws + WS_HID), (const bf16*)(WLBASE(ws, l) + WL_WDN), 0, 0, FF / 2}; pg8::MoeOrder S{(const int*)(ws + WS_META) + l * 512, F.G, F.bid};
    pg8::EpiDown E{(bf16*)(ws + WS_Y2), (const int*)(ws + WS_SLOT + SL_TOK), (const float*)(ws + WS_SLOT + SL_W)};
    pg8::gemm_phase<pg8::EpiDown, pg8::MoeOrder, false>(F.lds, g, S, E, nullptr, F.tid); }
__device__ __forceinline__ void ph_ln2(int l, int wv) { const Frame F = make_frame(wv); phase_ln2(F, args_here(), l); }

__global__ void __launch_bounds__(NTHR, 2) fwd_kernel(Args args) {
    extern __shared__ __attribute__((aligned(16))) unsigned char lds_raw[];
    (void)lds_raw; const int wv = 0; const Frame F = make_frame(wv);
    if (F.tid < 64) F.MISC[F.tid] = 0u;
    __syncthreads();
    XcdBarrier bar = xcd_barrier_post(F.ctl + CW_BAR, F.MISC + 8);
    const int lo = args_here()->ph_lo, hi = args_here()->ph_hi;
#define IN(k) (lo <= (k) && (k) < hi)
#define SEAM(k) do { if (IN(k) && IN((k) + 1)) { XcdBarrier bb = bar; asm volatile("" : "+s"(bb.bar)); xcd_barrier(bb); } TSTAMP((k) + 1); } while (0)
#define RPT(bit, call) do { call; if (PROBE_REPEAT & (1u << (bit))) { XcdBarrier bb = bar; asm volatile("" : "+s"(bb.bar)); xcd_barrier(bb); call; } } while (0)
    TSTAMP(0);
    if (IN(0)) ph_prologue(0, wv);
    SEAM(0);
#define LAYER_BODY(l) do { \
        const int pb = 1 + 10 * l; \
        if (IN(pb + 0)) RPT(0, ph_inproj(l, wv)); \
        SEAM(pb + 0); \
        if constexpr (SELFCHECK == 4) { \
        if (l == CHECK_LAYER) { { const Frame F2 = make_frame(wv); check_inproj(F2, args_here(), l); } XcdBarrier bb = bar; asm volatile("" : "+s"(bb.bar)); xcd_barrier(bb); } \
        } \
        if (IN(pb + 1)) { RPT(16, ph_compress(l, wv)); ph_gdnprep(l, wv); if (PROBE_REPEAT & (1u << 17)) { XcdBarrier bb = bar; asm volatile("" : "+s"(bb.bar)); xcd_barrier(bb); ph_gdnprep_var(l, wv); } RPT(18, ph_conformer(l, wv)); } \
        SEAM(pb + 1); \
        if (IN(pb + 2)) { ph_scan(l, wv); ph_bgweights(l, wv); if (PROBE_REPEAT & (1u << 19)) { XcdBarrier bb = bar; asm volatile("" : "+s"(bb.bar)); xcd_barrier(bb); ph_scan_var(l, wv); XcdBarrier bb2 = bar; asm volatile("" : "+s"(bb2.bar)); xcd_barrier(bb2); } ph_attn(l, 0, wv); if (PROBE_REPEAT & (1u << 20)) { XcdBarrier bb = bar; asm volatile("" : "+s"(bb.bar)); xcd_barrier(bb); ph_attn(l, 1, wv); } } \
        SEAM(pb + 2); \
        if (IN(pb + 3)) RPT(24, ph_gdnout(l, wv)); \
        SEAM(pb + 3); \
        if constexpr (SELFCHECK == 1 || SELFCHECK == 2 || SELFCHECK == 5) { \
        if (l == CHECK_LAYER) { { const Frame F2 = make_frame(wv); if (SELFCHECK == 1) check_nsa(F2, args_here()); else if (SELFCHECK == 2) check_gdn(F2, args_here(), l); else { check_compress(F2, args_here(), l); check_conformer(F2, args_here(), l); } } XcdBarrier bb = bar; asm volatile("" : "+s"(bb.bar)); xcd_barrier(bb); } \
        } \
        if (IN(pb + 4)) RPT(3, ph_outproj(l, wv)); \
        SEAM(pb + 4); \
        if (IN(pb + 5)) { ph_ln1(l, wv); if (PROBE_REPEAT & (1u << 4)) { XcdBarrier bb = bar; asm volatile("" : "+s"(bb.bar)); xcd_barrier(bb); ph_ln1_dry(l, wv); } \
            if (PROBE_REPEAT & (1u << 23)) { for (int rr = 0; rr < 4; ++rr) { XcdBarrier bb = bar; asm volatile("" : "+s"(bb.bar)); xcd_barrier(bb); } } } \
        SEAM(pb + 5); \
        if (IN(pb + 6)) RPT(5, ph_gather(l, wv)); \
        SEAM(pb + 6); \
        if (IN(pb + 7)) RPT(6, ph_moeup(l, wv)); \
        SEAM(pb + 7); \
        if (IN(pb + 8)) RPT(7, ph_moedown(l, wv)); \
        SEAM(pb + 8); \
        if constexpr (SELFCHECK == 3) { \
        if (l == CHECK_LAYER) { { const Frame F2 = make_frame(wv); check_moe(F2, args_here(), l); } XcdBarrier bb = bar; asm volatile("" : "+s"(bb.bar)); xcd_barrier(bb); } \
        } \
        if (IN(pb + 9)) { ph_ln2(l, wv); } \
        SEAM(pb + 9); \
     \
    } while (0)
    LAYER_BODY(0); LAYER_BODY(1); LAYER_BODY(2); LAYER_BODY(3);
#undef LAYER_BODY
#undef RPT
#if SELFCHECK
    { XcdBarrier bb = bar; asm volatile("" : "+s"(bb.bar)); xcd_barrier(bb); const Frame F2 = make_frame(wv); check_inject(F2, args_here()); }
#endif
#if TIMING
    { XcdBarrier bb = bar; asm volatile("" : "+s"(bb.bar)); xcd_barrier(bb); const Frame F2 = make_frame(wv);
      const unsigned long long* ts = (const unsigned long long*)(args_here()->ws + (size_t)985 * MiB);
      const float ta = (float)(ts[TA_HI] - ts[TA_LO]) * 0.01f, tb = (float)(ts[TB_HI] - ts[TB_LO]) * 0.01f;
      float* out = args_here()->out;
      for (int i = F2.bid * NTHR + F2.tid; i < (1 << 20); i += F2.G * NTHR) out[i] = (i == 0) ? ta : tb; }
#endif
#undef IN
#undef SEAM
}

extern "C" void kernel_launch(void* const* d_in, const int* in_sizes, int n_in, void* d_out, int out_size, void* d_ws, size_t ws_size, hipStream_t stream) {
    static int grid = 0;
    if (grid == 0) {
        if (n_in != 25 || in_sizes[0] != T * DM || out_size != T * DM || ws_size < WS_END) { fprintf(stderr, "kernel_launch: shape/workspace mismatch (n_in %d, in0 %d, out %d, ws %zu < %zu); nothing launched\n", n_in, n_in > 0 ? in_sizes[0] : -1, out_size, ws_size, (size_t)WS_END); grid = -1; return; }
        int dev = 0, cus = 0, per_cu = 0;
        if (hipGetDevice(&dev) != hipSuccess || hipDeviceGetAttribute(&cus, hipDeviceAttributeMultiprocessorCount, dev) != hipSuccess) { grid = -1; return; }
        if (hipFuncSetAttribute((const void*)fwd_kernel, hipFuncAttributeMaxDynamicSharedMemorySize, LDS_BYTES) != hipSuccess) { fprintf(stderr, "kernel_launch: hipFuncSetAttribute failed\n"); grid = -1; return; }
        if (hipOccupancyMaxActiveBlocksPerMultiprocessor(&per_cu, (const void*)fwd_kernel, NTHR, LDS_BYTES) != hipSuccess || per_cu < 1)
            fprintf(stderr, "kernel_launch: note: occupancy query reports %d workgroups per CU\n", per_cu);
        (void)hipGetLastError();
        grid = cus;
        if (grid < 32 || (grid & 7)) { fprintf(stderr, "kernel_launch: unexpected CU count %d\n", cus); }
    }
    if (grid < 0) return;
    if (hipMemsetAsync((char*)d_ws + WS_CTL, 0, CTL_ZERO_BYTES, stream) != hipSuccess) return;
    Args a{};
    for (int i = 0; i < 25; ++i) a.in[i] = (const float*)d_in[i];
    a.out = (float*)d_out; a.ws = (unsigned char*)d_ws;
#if MK_MULTI
    for (int p = 0; p < N_PHASES; ++p) { a.ph_lo = p; a.ph_hi = p + 1; hipLaunchKernelGGL(fwd_kernel, dim3(grid), dim3(NTHR), LDS_BYTES, stream, a); }
#else
    a.ph_lo = 0; a.ph_hi = N_PHASES;
    hipLaunchKernelGGL(fwd_kernel, dim3(grid), dim3(NTHR), LDS_BYTES, stream, a);
#endif
}
```

```cpp
#include <hip/hip_runtime.h>
#include <cstdio>
#include <cstdint>
namespace pg8 {
#define PG8_LAS __attribute__((address_space(3)))
typedef unsigned short bf16_t;
typedef short bf16x8 __attribute__((ext_vector_type(8)));
typedef float f32x4 __attribute__((ext_vector_type(4)));
typedef unsigned u32x4 __attribute__((ext_vector_type(4)));
constexpr int BM = 256, BK = 64, HALF = 128, HTB = HALF * BK * 2  , STAGE_BYTES = 8 * HTB, NXCD = 8, WGM = 8;

__host__ __device__ __forceinline__ int lds_byte(int r, int c) { const int st = (r >> 4) * 2 + (c >> 5), rr = r & 15, cc = c & 31, ob = rr * 64 + cc * 2; return st * 1024 + (ob ^ (((ob >> 9) & 1) << 5)); }
__host__ __device__ __forceinline__ void stage_rc(int b, int& R, int& C) { const int st = b / 1024, sb = b % 1024, swz = sb ^ (((sb >> 9) & 1) << 5); R = (st >> 1) * 16 + swz / 64; C = (st & 1) * 32 + (swz % 64) / 2; }
__host__ __device__ __forceinline__ int perm32(int rho) { const int n = rho >> 4, i = rho & 15; return 8 * (i >> 2) + 4 * n + (i & 3); }

struct Unit { int pm, pn; };
struct Gemm { const bf16_t* A; const bf16_t* Bt; int M, N, K; };

struct StaticOrder {
    int nM, nN, nwg, G, c;
    __host__ __device__ void init(int M, int N, int G_, int c_) { nM = M / BM; nN = N / BM; nwg = nM * nN; G = G_; c = c_; }
    __host__ __device__ bool next(int i, Unit& u) const {
        const long L = (long)i * G + c; if (L >= nwg) return false;
        int wgid = (int)L; { const int q = nwg / NXCD, r = nwg % NXCD, xcd = wgid % NXCD, off = wgid / NXCD; wgid = (xcd < r ? xcd * (q + 1) : r * (q + 1) + (xcd - r) * q) + off; }
        const int nig = WGM * nN, gid = wgid / nig, fm = gid * WGM, gsz = (nM - fm) < WGM ? (nM - fm) : WGM;
        u.pm = fm + ((wgid % nig) % gsz); u.pn = (wgid % nig) / gsz; return true;
    }
    __device__ __forceinline__ void a_ready(const Unit&) const {}
    __device__ __forceinline__ void done(const Unit&) const {}
};

__device__ __forceinline__ unsigned cvt_pk_bf16(float lo, float hi) { unsigned r; asm volatile("v_cvt_pk_bf16_f32 %0, %1, %2" : "=v"(r) : "v"(lo), "v"(hi)); return r; }
__device__ __forceinline__ float fast_sigmoid(float x) { return __builtin_amdgcn_rcpf(1.0f + __builtin_amdgcn_exp2f(-1.44269504089f * x)); }

constexpr int HLD = 2816;
constexpr float QSCALE = 0.125f * 1.44269504089f;

struct EpiInProj {
    static constexpr bool PERM = true, AFTER_DRAIN = false, GATHER = false, FP8 = true;
    bf16_t* H; float* side; const float* rope;
    __device__ __forceinline__ void operator()(const f32x4 (&acc)[2][2][4][2], const Unit& u, int wr, int wc, int fr, int fq) const {
        const int row0 = u.pm * BM + wr * 64 + fr; const int pn = u.pn;
        if (pn <= 4) {
#pragma unroll
            for (int ai = 0; ai < 2; ++ai)
#pragma unroll
                for (int m = 0; m < 4; ++m) {
                    const int row = row0 + ai * HALF + m * 16; const float* rp = rope + (size_t)(row & 4095) * 16;
                    const f32x4 c0 = *(const f32x4*)(rp), c1 = *(const f32x4*)(rp + 4), s0 = *(const f32x4*)(rp + 8), s1 = *(const f32x4*)(rp + 12);
#pragma unroll
                    for (int bj = 0; bj < 2; ++bj) {
                        f32x4 v0 = acc[ai][bj][m][0] * 0.03125f, v1 = acc[ai][bj][m][1] * 0.03125f;
                        const bool ropeb = (pn < 2) || (bj == 0);
                        if (ropeb) {
                            f32x4 p0, p1;
#pragma unroll
                            for (int e = 0; e < 4; ++e) { p0[e] = __shfl_xor(v0[e], 16); p1[e] = __shfl_xor(v1[e], 16); }
                            if (((wc & 1) == 0) && fq < 2) { const float sg = fq ? 1.f : -1.f; v0 = v0 * c0 + (p0 * s0) * sg; v1 = v1 * c1 + (p1 * s1) * sg; }
                        }
                        if (pn < 2) { v0 = v0 * QSCALE; v1 = v1 * QSCALE; }
                        u32x4 w; w.x = cvt_pk_bf16(v0[0], v0[1]); w.y = cvt_pk_bf16(v0[2], v0[3]); w.z = cvt_pk_bf16(v1[0], v1[1]); w.w = cvt_pk_bf16(v1[2], v1[3]);
                        *(u32x4*)(H + (size_t)row * HLD + pn * BM + bj * HALF + wc * 32 + 8 * fq) = w;
                    }
                }
        } else if (pn < 11) {
#pragma unroll
            for (int ai = 0; ai < 2; ++ai)
#pragma unroll
                for (int m = 0; m < 4; ++m) {
                    const int row = row0 + ai * HALF + m * 16;
#pragma unroll
                    for (int bj = 0; bj < 2; ++bj) {
                        const f32x4 v0 = acc[ai][bj][m][0] * 0.03125f, v1 = acc[ai][bj][m][1] * 0.03125f;
                        u32x4 w; w.x = cvt_pk_bf16(v0[0], v0[1]); w.y = cvt_pk_bf16(v0[2], v0[3]); w.z = cvt_pk_bf16(v1[0], v1[1]); w.w = cvt_pk_bf16(v1[2], v1[3]);
                        *(u32x4*)(H + (size_t)row * HLD + pn * BM + bj * HALF + wc * 32 + 8 * fq) = w;
                    }
                }
        } else if (wc == 0) {
#pragma unroll
            for (int ai = 0; ai < 2; ++ai)
#pragma unroll
                for (int m = 0; m < 4; ++m) {
                    const int row = row0 + ai * HALF + m * 16;
                    f32x4 v0 = acc[ai][0][m][0] * 0.03125f, v1 = acc[ai][0][m][1] * 0.03125f;
#pragma unroll
                    for (int e = 0; e < 4; ++e) { v0[e] = fast_sigmoid(v0[e]); if (fq < 3) v1[e] = fast_sigmoid(v1[e]); }
                    *(f32x4*)(side + (size_t)row * 32 + 8 * fq) = v0; *(f32x4*)(side + (size_t)row * 32 + 8 * fq + 4) = v1;
                }
        }
    }
};
struct EpiOutProj {
    static constexpr bool PERM = true, AFTER_DRAIN = false, GATHER = false, FP8 = false;
    const bf16_t* res; bf16_t* out; float alpha;
    __device__ __forceinline__ void operator()(const f32x4 (&acc)[2][2][4][2], const Unit& u, int wr, int wc, int fr, int fq) const {
        const int row0 = u.pm * BM + wr * 64 + fr, col0 = u.pn * BM + wc * 32 + 8 * fq;
#pragma unroll
        for (int ai = 0; ai < 2; ++ai)
#pragma unroll
            for (int m = 0; m < 4; ++m) { const size_t off = (size_t)(row0 + ai * HALF + m * 16) * 1024 + col0;
#pragma unroll
                for (int bj = 0; bj < 2; ++bj) { const u32x4 rb = *(const u32x4*)(res + off + bj * HALF);
                    f32x4 r0, r1; r0[0] = __uint_as_float(rb.x << 16); r0[1] = __uint_as_float(rb.x & 0xffff0000u); r0[2] = __uint_as_float(rb.y << 16); r0[3] = __uint_as_float(rb.y & 0xffff0000u);
                    r1[0] = __uint_as_float(rb.z << 16); r1[1] = __uint_as_float(rb.z & 0xffff0000u); r1[2] = __uint_as_float(rb.w << 16); r1[3] = __uint_as_float(rb.w & 0xffff0000u);
                    const f32x4 v0 = r0 * alpha + acc[ai][bj][m][0], v1 = r1 * alpha + acc[ai][bj][m][1];
                    u32x4 w; w.x = cvt_pk_bf16(v0[0], v0[1]); w.y = cvt_pk_bf16(v0[2], v0[3]); w.z = cvt_pk_bf16(v1[0], v1[1]); w.w = cvt_pk_bf16(v1[2], v1[3]);
                    *(u32x4*)(out + off + bj * HALF) = w; }
                asm volatile("" ::: "memory"); }
    }
};
struct EpiSwiGLU {
    static constexpr bool PERM = true, AFTER_DRAIN = false, GATHER = true, FP8 = true;
    unsigned char* hid; const int* rowmap; int rowshift;
    __device__ __forceinline__ void operator()(const f32x4 (&acc)[2][2][4][2], const Unit& u, int wr, int wc, int fr, int fq) const {
        const int row0 = u.pm * BM + wr * 64 + fr, hc0 = (u.pn & 3) * 128 + wc * 16 + 4 * fq;
#pragma unroll
        for (int ai = 0; ai < 2; ++ai)
#pragma unroll
            for (int m = 0; m < 4; ++m) { unsigned char* rowp = hid + (size_t)(row0 + ai * HALF + m * 16) * 512 + hc0;
#pragma unroll
                for (int bj = 0; bj < 2; ++bj) { const f32x4 g = acc[ai][bj][m][0] * 0.03125f, up = acc[ai][bj][m][1] * 0.03125f; f32x4 h;
#pragma unroll
                    for (int e = 0; e < 4; ++e) h[e] = __builtin_amdgcn_fmed3f(g[e] * fast_sigmoid(g[e]) * up[e], -440.f, 440.f);
                    int w = 0; w = __builtin_amdgcn_cvt_pk_fp8_f32(h[0], h[1], w, false); w = __builtin_amdgcn_cvt_pk_fp8_f32(h[2], h[3], w, true);
                    *(int*)(rowp + bj * 64) = w; } }
    }
};
struct EpiDown {
    static constexpr bool PERM = true, AFTER_DRAIN = false, GATHER = false, FP8 = true;
    bf16_t* y2; const int* slot_tok; const float* slot_w;
    __device__ __forceinline__ void operator()(const f32x4 (&acc)[2][2][4][2], const Unit& u, int wr, int wc, int fr, int fq) const {
        const int row0 = u.pm * BM + wr * 64 + fr, col0 = (u.pn & 3) * BM + wc * 32 + 8 * fq;
#pragma unroll
        for (int ai = 0; ai < 2; ++ai)
#pragma unroll
            for (int m = 0; m < 4; ++m) { const int row = row0 + ai * HALF + m * 16; const int st = slot_tok[row]; const float sw = slot_w[row] * 0.015625f;
                if (st >= 0) { bf16_t* rowp = y2 + (size_t)st * 1024 + col0;
#pragma unroll
                    for (int bj = 0; bj < 2; ++bj) { const f32x4 v0 = acc[ai][bj][m][0] * sw, v1 = acc[ai][bj][m][1] * sw;
                        u32x4 w; w.x = cvt_pk_bf16(v0[0], v0[1]); w.y = cvt_pk_bf16(v0[2], v0[3]); w.z = cvt_pk_bf16(v1[0], v1[1]); w.w = cvt_pk_bf16(v1[2], v1[3]);
                        *(u32x4*)(rowp + bj * HALF) = w; } } }
    }
};
struct MoeOrder {
    const int* meta; int G, c;
    __device__ __forceinline__ bool next(int i, Unit& u) const {
        const int per = G >> 3; const int idx = (G & 7) ? (i * G + c) : ((i * 8 + (c & 7)) * per + (c >> 3));
        const int nt = __builtin_amdgcn_readfirstlane(meta[0]); if (idx >= nt * 4) return false;
        const int pm = idx >> 2; u.pm = pm; u.pn = __builtin_amdgcn_readfirstlane(meta[64 + pm]) * 4 + (idx & 3); return true;
    }
    __device__ __forceinline__ void a_ready(const Unit&) const {}
    __device__ __forceinline__ void done(const Unit&) const {}
};
typedef int v4i_ __attribute__((ext_vector_type(4)));
typedef int v8i_ __attribute__((ext_vector_type(8)));
template <class Epi, class Sched, bool STAMP = false>
__device__ __forceinline__ void gemm_phase(PG8_LAS unsigned char* lds, const Gemm g, const Sched& S, const Epi& E, unsigned long long* stamps, int tid_in) {
    int tid_ = tid_in; asm volatile("" : "+v"(tid_));
    const int tid = tid_, wid = __builtin_amdgcn_readfirstlane(tid >> 6), lane = tid & 63, wr = wid >> 2, wc = wid & 3, fr = lane & 15, fq = lane >> 4;
    const int K = g.K, nt = K / BK;
    int ts_lo = 0, ts_hi = 0, nts = 0; const unsigned long long rt_entry = STAMP ? (unsigned long long)wall_clock64() : 0ull;
#define PG8_STAMP() do { if (STAMP && wid == 0 && nts < 64) { const unsigned long long _c = (unsigned long long)clock64(); \
        ts_lo = (lane == nts) ? (int)(unsigned)_c : ts_lo; ts_hi = (lane == nts) ? (int)(unsigned)(_c >> 32) : ts_hi; ++nts; } } while (0)
    PG8_STAMP();
    unsigned voffA[2], voffB[2];
#pragma unroll
    for (int i = 0; i < 2; ++i) { int R, C; stage_rc(tid * 16 + i * 8192, R, C); const int Rb = Epi::PERM ? ((R & ~31) + perm32(R & 31)) : R;
        voffA[i] = (unsigned)(R * K + C) * 2u; voffB[i] = (unsigned)(Rb * K + C) * 2u; }
    unsigned offAc[2][2], offAn[2][2];
    PG8_LAS unsigned char* gidx = lds + STAGE_BYTES + (unsigned)wid * 1024u;
#define PG8_IDX_DMA(par, pm_) do { int t2_ = tid; asm volatile("" : "+v"(t2_)); _Pragma("unroll") for (int i_ = 0; i_ < 2; ++i_) { int R_, C_; stage_rc(t2_ * 16 + i_ * 8192, R_, C_); (void)C_; \
        _Pragma("unroll") for (int h_ = 0; h_ < 2; ++h_) __builtin_amdgcn_global_load_lds((const unsigned*)(E.rowmap + (size_t)(pm_) * BM + h_ * HALF + R_), (PG8_LAS unsigned*)(gidx + (par) * 512 + (h_ * 2 + i_) * 256), 4, 0, 0); } } while (0)
#define PG8_IDX_READ(dst, par) do { int t2_ = tid; asm volatile("" : "+v"(t2_)); _Pragma("unroll") for (int i_ = 0; i_ < 2; ++i_) { int R_, C_; stage_rc(t2_ * 16 + i_ * 8192, R_, C_); (void)R_; \
        _Pragma("unroll") for (int h_ = 0; h_ < 2; ++h_) { int r_ = *(const PG8_LAS int*)(gidx + (par) * 512 + (h_ * 2 + i_) * 256 + (t2_ & 63) * 4); r_ = r_ < 0 ? 0 : (r_ >> E.rowshift); dst[h_][i_] = (unsigned)r_ * (unsigned)(K * 2) + (unsigned)C_ * 2u; } } } while (0)
    const size_t kstep = (size_t)(BK * 2);
    const size_t hstep = (size_t)HALF * K * 2;
    const size_t tstep = 2 * hstep;
    const unsigned ldsw = (unsigned)wid * 1024u;
    const int aoff = lds_byte(wr * 64 + fr, fq * 8), boff = lds_byte(wc * 32 + fr, fq * 8);
#define PG8_SA(b, h) (((b) * 2 + (h)) * HTB)
#define PG8_SB(b, h) ((4 + (b) * 2 + (h)) * HTB)
#define PG8_STAGE(bufoff, gbase, voff) do { _Pragma("unroll") for (int _i = 0; _i < 2; ++_i) \
        __builtin_amdgcn_global_load_lds((const unsigned*)((const char*)(gbase) + (voff)[_i]), (PG8_LAS unsigned*)(lds + (bufoff) + ldsw + _i * 8192), 16, 0, 0); } while (0)
#define PG8_STAGE_A(bufoff, kt_, h_, nx_) do { if constexpr (Epi::GATHER) { _Pragma("unroll") for (int _i = 0; _i < 2; ++_i) { const unsigned o_ = (nx_) ? offAn[h_][_i] : offAc[h_][_i]; \
            __builtin_amdgcn_global_load_lds((const unsigned*)((const char*)g.A + (size_t)(kt_) * kstep + o_), (PG8_LAS unsigned*)(lds + (bufoff) + ldsw + _i * 8192), 16, 0, 0); } } \
        else { PG8_STAGE(bufoff, ((nx_) ? nA : cA) + (size_t)(kt_) * kstep + (h_) * hstep, voffA); } } while (0)
#define PG8_LDA(dst, b, h) do { _Pragma("unroll") for (int m = 0; m < 4; ++m) _Pragma("unroll") for (int k = 0; k < 2; ++k) dst[m][k] = *(const PG8_LAS bf16x8*)(lds + PG8_SA(b, h) + aoff + m * 2048 + k * 1024); } while (0)
#define PG8_LDB(dst, b, h) do { _Pragma("unroll") for (int n = 0; n < 2; ++n) _Pragma("unroll") for (int k = 0; k < 2; ++k) dst[n][k] = *(const PG8_LAS bf16x8*)(lds + PG8_SB(b, h) + boff + n * 2048 + k * 1024); } while (0)
#define PG8_MMA(ai, bj, At, Bt) do { __builtin_amdgcn_s_setprio(1); \
        if constexpr (Epi::FP8) {   \
            _Pragma("unroll") for (int m = 0; m < 4; ++m) _Pragma("unroll") for (int n = 0; n < 2; ++n) \
                { const v8i_ b8_ = __builtin_shufflevector(__builtin_bit_cast(v4i_, Bt[n][0]), __builtin_bit_cast(v4i_, Bt[n][1]), 0, 1, 2, 3, 4, 5, 6, 7), \
                             a8_ = __builtin_shufflevector(__builtin_bit_cast(v4i_, At[m][0]), __builtin_bit_cast(v4i_, At[m][1]), 0, 1, 2, 3, 4, 5, 6, 7); \
                    \
                  asm volatile("v_mfma_f32_16x16x128_f8f6f4 %0, %1, %2, %0" : "+v"(acc[ai][bj][m][n]) : "v"(b8_), "v"(a8_)); } } \
        else { _Pragma("unroll") for (int m = 0; m < 4; ++m) _Pragma("unroll") for (int n = 0; n < 2; ++n) _Pragma("unroll") for (int k = 0; k < 2; ++k) \
            acc[ai][bj][m][n] = __builtin_amdgcn_mfma_f32_16x16x32_bf16(Bt[n][k], At[m][k], acc[ai][bj][m][n], 0, 0, 0); } \
        __builtin_amdgcn_s_setprio(0); } while (0)
#define PG8_WAIT_V(n) asm volatile("s_waitcnt vmcnt(" #n ")" ::: "memory")
#define PG8_WAIT_L(n) asm volatile("s_waitcnt lgkmcnt(" #n ")" ::: "memory")
#define PG8_BAR __builtin_amdgcn_s_barrier()
#define PG8_SCHED __builtin_amdgcn_sched_barrier(0)
    Unit cur, nxt; int ui = 0;
    if (!S.next(0, cur)) return;
    f32x4 acc[2][2][4][2];
    float zf_ = 0.f; asm volatile("" : "+v"(zf_));
#pragma unroll
    for (int a = 0; a < 2; ++a)
#pragma unroll
        for (int b = 0; b < 2; ++b)
#pragma unroll
            for (int m = 0; m < 4; ++m)
#pragma unroll
                for (int n = 0; n < 2; ++n) acc[a][b][m][n] = (f32x4){zf_, zf_, zf_, zf_};
    bf16x8 At[4][2], B0[2][2], B1[2][2];
    const char* cA = (const char*)g.A + (size_t)cur.pm * tstep; const char* cB = (const char*)g.Bt + (size_t)cur.pn * tstep;
    S.a_ready(cur);
    if constexpr (Epi::GATHER) { PG8_IDX_DMA(0, cur.pm); asm volatile("s_waitcnt vmcnt(0)" ::: "memory"); PG8_IDX_READ(offAc, 0); asm volatile("s_waitcnt lgkmcnt(0)" ::: "memory"); }
    const char* nA = cA;
    PG8_STAGE(PG8_SB(0, 0), cB, voffB); PG8_STAGE_A(PG8_SA(0, 0), 0, 0, false); PG8_STAGE(PG8_SB(0, 1), cB + hstep, voffB); PG8_STAGE_A(PG8_SA(0, 1), 0, 1, false);
    if (wr == 1) PG8_BAR;
    PG8_WAIT_V(4); PG8_BAR;
    PG8_STAGE(PG8_SB(1, 0), cB + kstep, voffB); PG8_STAGE_A(PG8_SA(1, 0), 1, 0, false); PG8_STAGE(PG8_SB(1, 1), cB + hstep + kstep, voffB);
    PG8_WAIT_V(6); PG8_BAR;
    PG8_STAMP();
    for (;;) {
        const bool has_next = S.next(ui + 1, nxt);
        nA = has_next ? (const char*)g.A + (size_t)nxt.pm * tstep : cA; const char* nB = has_next ? (const char*)g.Bt + (size_t)nxt.pn * tstep : cB;
        if constexpr (Epi::GATHER) { if (has_next) PG8_IDX_DMA((ui + 1) & 1, nxt.pm); }
#pragma unroll 1
        for (int t = 0; t < nt; t += 2) {
            const bool last = (t == nt - 2);
            const char* b2 = last ? nB : cB + (size_t)(t + 2) * kstep;
            const char* b3 = b2 + kstep;
            const int kt2 = last ? 0 : t + 2;
            if constexpr (Epi::GATHER) { if (last) { if (has_next) PG8_IDX_READ(offAn, (ui + 1) & 1); else { offAn[0][0] = offAc[0][0]; offAn[0][1] = offAc[0][1]; offAn[1][0] = offAc[1][0]; offAn[1][1] = offAc[1][1]; } } }
            if (last && has_next) S.a_ready(nxt);
            PG8_LDB(B0, 0, 0); PG8_SCHED; PG8_LDA(At, 0, 0); PG8_STAGE_A(PG8_SA(1, 1), t + 1, 1, false);
            PG8_WAIT_L(8); PG8_BAR; PG8_WAIT_L(0); PG8_MMA(0, 0, At, B0); PG8_BAR; PG8_SCHED;
            PG8_LDB(B1, 0, 1); PG8_STAGE(PG8_SB(0, 0), b2, voffB);
            PG8_BAR; PG8_WAIT_L(0); PG8_MMA(0, 1, At, B1); PG8_BAR;
            PG8_LDA(At, 0, 1); PG8_STAGE_A(PG8_SA(0, 0), kt2, 0, last);
            PG8_BAR; PG8_WAIT_L(0); PG8_MMA(1, 0, At, B0); PG8_BAR; PG8_SCHED;
            PG8_STAGE(PG8_SB(0, 1), b2 + hstep, voffB);
            PG8_WAIT_V(6); PG8_BAR; PG8_MMA(1, 1, At, B1); PG8_BAR;
            PG8_LDB(B0, 1, 0); PG8_SCHED; PG8_LDA(At, 1, 0); PG8_STAGE_A(PG8_SA(0, 1), kt2, 1, last);
            PG8_WAIT_L(8); PG8_BAR; PG8_WAIT_L(0); PG8_MMA(0, 0, At, B0); PG8_BAR; PG8_SCHED;
            PG8_LDB(B1, 1, 1); PG8_STAGE(PG8_SB(1, 0), b3, voffB);
            PG8_BAR; PG8_WAIT_L(0); PG8_MMA(0, 1, At, B1); PG8_BAR;
            PG8_LDA(At, 1, 1); PG8_STAGE_A(PG8_SA(1, 0), kt2 + 1, 0, last);
            PG8_BAR; PG8_WAIT_L(0); PG8_MMA(1, 0, At, B0); PG8_BAR; PG8_SCHED;
            PG8_STAGE(PG8_SB(1, 1), b3 + hstep, voffB);
            PG8_WAIT_V(6); PG8_BAR; PG8_MMA(1, 1, At, B1); PG8_BAR;
        }
        PG8_STAMP();
        if constexpr (Epi::FP8) asm volatile("s_nop 15\n\ts_nop 15" ::: "memory");
        if constexpr (!Epi::AFTER_DRAIN) { E(acc, cur, wr, wc, fr, fq); S.done(cur); }
        PG8_STAMP();
        if (!has_next) break;
#pragma unroll
        for (int a = 0; a < 2; ++a)
#pragma unroll
            for (int b = 0; b < 2; ++b)
#pragma unroll
                for (int m = 0; m < 4; ++m)
#pragma unroll
                    for (int n = 0; n < 2; ++n) acc[a][b][m][n] = (f32x4){zf_, zf_, zf_, zf_};
        cur = nxt; cA = nA; cB = nB; ++ui;
        if constexpr (Epi::GATHER) { offAc[0][0] = offAn[0][0]; offAc[0][1] = offAn[0][1]; offAc[1][0] = offAn[1][0]; offAc[1][1] = offAn[1][1]; }
    }
    PG8_WAIT_V(0);
    if (wr == 0) PG8_BAR;
    PG8_BAR;
    if constexpr (Epi::AFTER_DRAIN) { E.fused(acc, cur, wr, wc, fr, fq, lds, wid, lane); S.done(cur); }
    PG8_STAMP();
    if (STAMP && wid == 0) { stamps[lane] = lane < nts ? (((unsigned long long)(unsigned)ts_hi << 32) | (unsigned)ts_lo) : 0ull;
        if (lane == 62) stamps[62] = rt_entry; if (lane == 63) stamps[63] = (unsigned long long)wall_clock64(); }
#undef PG8_STAMP
#undef PG8_SA
#undef PG8_SB
#undef PG8_STAGE
#undef PG8_STAGE_A
#undef PG8_IDX_DMA
#undef PG8_IDX_READ
#undef PG8_LDA
#undef PG8_LDB
#undef PG8_MMA
#undef PG8_WAIT_V
#undef PG8_WAIT_L
#undef PG8_BAR
#undef PG8_SCHED
}
}

#ifndef SELFCHECK
#define SELFCHECK 0
#endif
#ifndef PROBE_GDN_VAR
#define PROBE_GDN_VAR 0
#endif
#ifndef PROBE_SCAN_VAR
#define PROBE_SCAN_VAR 0
#endif
#ifndef PROBE_ATTN_VAR
#define PROBE_ATTN_VAR 0
#endif
constexpr int NB = 8, SEQ = 4096, DM = 1024, NL = 4, T = NB * SEQ;
constexpr int DIN = 2848, DINP = 3072, HLD = pg8::HLD;
constexpr int NEXP = 32, FF = 512, NTILE_MAX = 288;
constexpr float LN_EPS = 1e-5f;
constexpr float DN_ALPHA = 1.6817928305074290f;
constexpr int NWAVES = 8, NTHR = 512;

constexpr size_t MiB = 1u << 20, KiB = 1u << 10;
constexpr size_t WS_CTL = 0, CTL_ZERO_BYTES = 128 * KiB;
constexpr size_t WS_ROPE = 1 * MiB;
constexpr size_t WS_META = 1 * MiB + 512 * KiB;
constexpr size_t WS_GL = WS_META + 16 * KiB;
constexpr size_t WS_WL = 2 * MiB;
constexpr size_t WL_WIN = 0, WL_WOUT = 6 * MiB, WL_WGU = 8 * MiB, WL_WDN = 72 * MiB, WL_W1 = 104 * MiB, WL_W2 = 105 * MiB, WL_BIAS1 = 105 * MiB + 64 * KiB, WL_WR = 105 * MiB + 128 * KiB;
constexpr size_t WS_XB = 108 * MiB;
constexpr size_t WS_X1 = 172 * MiB;
constexpr size_t WS_H = 300 * MiB;
constexpr size_t WS_SIDE = 476 * MiB;
constexpr size_t WS_Y = 480 * MiB;
constexpr size_t WS_GPREP = 544 * MiB;
constexpr size_t WS_Y2 = 672 * MiB;
constexpr size_t WS_HID = 800 * MiB;
constexpr size_t WS_X8 = 839 * MiB;
constexpr size_t WS_KC = 872 * MiB, WS_VC = WS_KC + 512 * KiB;
constexpr size_t WS_SLOT = 873 * MiB;
constexpr size_t SL_TOK = 0, SL_W = 512 * KiB, SL_RE = 1024 * KiB, SL_RP = 1280 * KiB, SL_RW = 1536 * KiB;
constexpr size_t WS_WL2 = 876 * MiB;
constexpr size_t WS_END = 982 * MiB;
#define WLBASE(ws_, l_) ((ws_) + (((l_) & 1) ? WS_WL2 : WS_WL))
constexpr int GCH = 65536;
constexpr int GC_UT = 0, GC_W = 8192, GC_QK = 16384, GC_QD = 24576, GC_KDT = 32768, GC_ZT = 40960, GC_SS = 49152, GC_VB = 57344;
constexpr int CW_TMO = 0;
constexpr int CW_BAR = 4096;
constexpr int CW_CNT = 8192;
constexpr int CW_QUEUE = 12288;
static_assert((CW_QUEUE + NL * 64) * 4 <= (int)CTL_ZERO_BYTES, "CTL words inside the memset region");

constexpr int SCR_BYTES = 159744;
constexpr int MISC_OFF = SCR_BYTES;
constexpr int LDS_BYTES = 163840;

#define GAS __attribute__((address_space(1)))
#define LAS __attribute__((address_space(3)))
typedef unsigned short bf16;
typedef float f32x4 __attribute__((ext_vector_type(4)));
typedef float f32x2 __attribute__((ext_vector_type(2)));
typedef float f32x16 __attribute__((ext_vector_type(16)));
typedef short bf16x8 __attribute__((ext_vector_type(8)));
typedef short s16x4 __attribute__((ext_vector_type(4)));
typedef unsigned u32x4 __attribute__((ext_vector_type(4)));
typedef unsigned u32x2 __attribute__((ext_vector_type(2)));
#define LDS_WAIT() asm volatile("s_waitcnt lgkmcnt(0)" ::: "memory")
#define VM_WAIT() asm volatile("s_waitcnt vmcnt(0)" ::: "memory")
#define SBAR() __builtin_amdgcn_sched_barrier(0)
__device__ __forceinline__ float bf2f(unsigned b) { return __uint_as_float(b << 16); }
__device__ __forceinline__ unsigned pk2(float lo, float hi) { return pg8::cvt_pk_bf16(lo, hi); }
__device__ __forceinline__ unsigned f2bf_sw(float f) { unsigned u = __float_as_uint(f); return (u + 0x7fffu + ((u >> 16) & 1u)) >> 16; }
__device__ __forceinline__ unsigned f2bf(float f) { unsigned r; asm("v_cvt_pk_bf16_f32 %0, %1, %1" : "=v"(r) : "v"(f)); return r & 0xffffu; }
__device__ __forceinline__ float row16_sum(float x) {
    x += __int_as_float(__builtin_amdgcn_update_dpp(0, __float_as_int(x), 0xB1, 0xf, 0xf, true));
    x += __int_as_float(__builtin_amdgcn_update_dpp(0, __float_as_int(x), 0x4E, 0xf, 0xf, true));
    x += __int_as_float(__builtin_amdgcn_update_dpp(0, __float_as_int(x), 0x141, 0xf, 0xf, true));
    x += __int_as_float(__builtin_amdgcn_update_dpp(0, __float_as_int(x), 0x140, 0xf, 0xf, true));
    return x;
}
__device__ __forceinline__ float wave_sum(float v) {
    const int r = __float_as_int(row16_sum(v));
    return (__int_as_float(__builtin_amdgcn_readlane(r, 0)) + __int_as_float(__builtin_amdgcn_readlane(r, 16))) + (__int_as_float(__builtin_amdgcn_readlane(r, 32)) + __int_as_float(__builtin_amdgcn_readlane(r, 48)));
}
__device__ __forceinline__ float fsigmoid(float x) { return pg8::fast_sigmoid(x); }
__device__ __forceinline__ float fsilu(float x) { return x * pg8::fast_sigmoid(x); }
__device__ __forceinline__ float fexp2(float x) { return __builtin_amdgcn_exp2f(x); }

#define XB_TMO      128
#define XB_XCNT(j)  (256  + 64 * (j))
#define XB_XSUB(j)  (1280 + 64 * (j))
#define XB_XGEN(j)  (2304 + 64 * (j))
#define XB_TOP      3328
#define XB_TOPGEN   3392
#define XCD_BAR_WORDS 3456
#define XB_SPIN_CAP (1u << 18)
#define LAS __attribute__((address_space(3)))

__device__ __forceinline__ unsigned xb_ld(unsigned* p)              { return __hip_atomic_load(p, __ATOMIC_RELAXED, __HIP_MEMORY_SCOPE_AGENT); }
__device__ __forceinline__ unsigned xb_add(unsigned* p, unsigned v) { return __hip_atomic_fetch_add(p, v, __ATOMIC_RELAXED, __HIP_MEMORY_SCOPE_AGENT); }
__device__ __forceinline__ unsigned xb_xcc_id() { return (unsigned)__builtin_amdgcn_s_getreg((3 << 11) | 20) & 0xFu; }
#define XB_SPIN(cond, bar) do { unsigned _sp = 0; while (cond) { __builtin_amdgcn_s_sleep(1); \
    if ((++_sp & 255u) == 0u) { if (xb_ld(&(bar)[XB_TMO])) break; if (_sp > XB_SPIN_CAP) { atomicAdd(&(bar)[XB_TMO], 1u); break; } } } } while (0)

struct XcdBarrier {
    unsigned* bar; unsigned x;
    volatile LAS unsigned* st;
};

__device__ __forceinline__ XcdBarrier xcd_barrier_post(unsigned* bar, volatile LAS unsigned* st) {
    XcdBarrier b; b.bar = bar; b.x = xb_xcc_id(); b.st = st;
    if (threadIdx.x == 0) (void)xb_add(&bar[XB_XCNT(b.x)], 1u);
    return b;
}
__device__ __forceinline__ void xcd_barrier_complete(unsigned* bar, unsigned x, unsigned& nloc, unsigned& nx) {
    const unsigned G = gridDim.x * gridDim.y * gridDim.z;
    unsigned sum, cnt, mine, sp = 0u;
    for (;;) {
        sum = 0u; cnt = 0u; mine = 0u;
#pragma unroll
        for (unsigned j = 0; j < 16; ++j) { const unsigned c = xb_ld(&bar[XB_XCNT(j)]); sum += c; cnt += (c > 0u) ? 1u : 0u; mine = (j == x) ? c : mine; }
        if (sum == G) break;
        __builtin_amdgcn_s_sleep(1);
        if ((++sp & 255u) == 0u) { if (xb_ld(&bar[XB_TMO])) break; if (sp > XB_SPIN_CAP) { atomicAdd(&bar[XB_TMO], 1u); break; } }
    }
    nloc = mine > 0u ? mine : 1u; nx = cnt > 0u ? cnt : 1u;
}

__device__ __forceinline__ void xcd_barrier(const XcdBarrier& b) {
    asm volatile("s_waitcnt vmcnt(0)" ::: "memory");
    __syncthreads();
    if (threadIdx.x == 0) {
        unsigned* bar = b.bar;
        __builtin_amdgcn_s_waitcnt(0);
        unsigned nloc = b.st[0], nx = b.st[1];
        if (nloc == 0u) { xcd_barrier_complete(bar, b.x, nloc, nx); b.st[0] = nloc; b.st[1] = nx; }
        const unsigned old = xb_add(&bar[XB_XSUB(b.x)], 1u);
        const unsigned gen = old / nloc;
        if (old + 1u == (gen + 1u) * nloc) {
            __builtin_amdgcn_fence(__ATOMIC_RELEASE, "agent");
            asm volatile("s_waitcnt vmcnt(0)" ::: "memory");
            const unsigned og = xb_add(&bar[XB_TOP], 1u);
            const unsigned tg = og / nx;
            if (og + 1u == (tg + 1u) * nx) xb_add(&bar[XB_TOPGEN], 1u);
            else XB_SPIN(xb_ld(&bar[XB_TOPGEN]) == tg, bar);
            __builtin_amdgcn_fence(__ATOMIC_ACQUIRE, "agent");
            xb_add(&bar[XB_XGEN(b.x)], 1u);
            asm volatile("s_waitcnt vmcnt(0)" ::: "memory");
        } else {
            XB_SPIN(xb_ld(&bar[XB_XGEN(b.x)]) == gen, bar);
            __builtin_amdgcn_fence(__ATOMIC_ACQUIRE, "agent");
            asm volatile("s_waitcnt vmcnt(0)" ::: "memory");
        }
    }
    __syncthreads();
}

struct Args { const float* in[25]; float* out; unsigned char* ws; int ph_lo, ph_hi; };
typedef const __attribute__((address_space(4))) Args* ArgsP;
__device__ __forceinline__ ArgsP args_here() { ArgsP p = (ArgsP)__builtin_amdgcn_kernarg_segment_ptr(); asm volatile("" : "+s"(p)); return p; }
struct Frame { LAS unsigned char* lds; volatile LAS unsigned* MISC; unsigned* ctl; int tid, lane, wave, G, bid; };

template <class Src>
__device__ __forceinline__ void tr_item(const Src src, int K, int N, bf16* WT, LAS float* scr, int item, int lane) {
    const int nblk = N >> 5, kb = item / nblk, nb = item - kb * nblk, k0 = kb << 6, n0 = nb << 5;
    float tv[32];
#pragma unroll
    for (int i = 0; i < 32; ++i) tv[i] = src(k0 + 2 * i + (lane >> 5), n0 + (lane & 31));
#pragma unroll
    for (int i = 0; i < 32; ++i) scr[(2 * i + (lane >> 5)) * 33 + (lane & 31)] = tv[i];
    LDS_WAIT();
    const int c = lane & 7;
#pragma unroll
    for (int j = 0; j < 4; ++j) { const int n = (lane >> 3) + 8 * j; const LAS float* s = scr + (8 * c) * 33 + n;
        u32x4 o; o.x = pk2(s[0], s[33]); o.y = pk2(s[66], s[99]); o.z = pk2(s[132], s[165]); o.w = pk2(s[198], s[231]);
        *(u32x4*)(WT + (size_t)(n0 + n) * K + k0 + 8 * c) = o; }
    LDS_WAIT();
}
template <class Src>
__device__ __forceinline__ void tr8_load(const Src src, int N, int item, int lane, float (&tv)[32]) {
    const int nblk = N >> 5, kb = item / nblk, nb = item - kb * nblk, k0 = kb << 6, n0 = nb << 5;
#pragma unroll
    for (int i = 0; i < 32; ++i) tv[i] = src(k0 + 2 * i + (lane >> 5), n0 + (lane & 31));
}
__device__ __forceinline__ void tr8_finish(const float (&tv)[32], int K, int N, unsigned char* WT, float mul, LAS float* scr, int item, int lane) {
    const int nblk = N >> 5, kb = item / nblk, nb = item - kb * nblk, k0 = kb << 6, n0 = nb << 5;
#pragma unroll
    for (int i = 0; i < 32; ++i) scr[(2 * i + (lane >> 5)) * 33 + (lane & 31)] = tv[i];
    LDS_WAIT();
    const int n = lane >> 1, kh = (lane & 1) * 32; const LAS float* sp = scr + kh * 33 + n;
#pragma unroll
    for (int q = 0; q < 2; ++q) { u32x4 o;
#pragma unroll
        for (int d = 0; d < 4; ++d) { const LAS float* s4 = sp + (16 * q + 4 * d) * 33; int w = 0;
            w = __builtin_amdgcn_cvt_pk_fp8_f32(s4[0] * mul, s4[33] * mul, w, false); w = __builtin_amdgcn_cvt_pk_fp8_f32(s4[66] * mul, s4[99] * mul, w, true); o[d] = (unsigned)w; }
        *(u32x4*)(WT + (size_t)(n0 + n) * K + k0 + kh + 16 * q) = o; }
    LDS_WAIT();
}
struct SrcPlain { const float* p; int ld; __device__ __forceinline__ float operator()(int k, int n) const { return p[(size_t)k * ld + n]; } };
struct SrcWin { const float* p;
    __device__ __forceinline__ float operator()(int k, int n) const {
        int c;
        if (n < 1280) c = n; else if (n < 2048) c = n + 24; else if (n < 2304) c = n + 24; else if (n < 2816) c = n + 32;
        else if (n < 2840) c = n - 2816 + 1280; else if (n < 2844) c = n - 2840 + 2328; else if (n < 2848) c = n - 2844 + 2332; else return 0.f;
        return p[(size_t)k * DIN + c]; } };
struct SrcGU { const float* wg; const float* wu;
    __device__ __forceinline__ float operator()(int k, int n) const { const int q = n >> 3, r = n & 7; const ptrdiff_t d = (r < 4) ? (ptrdiff_t)0 : (wu - wg); return wg[d + (ptrdiff_t)k * FF + 4 * q + (r & 3)]; } };

__device__ __forceinline__ void phase_weights(const Frame& F, ArgsP a, int l, int parts, int nblk, int lds_off) {
    unsigned char* wl = WLBASE(a->ws, l);
    LAS float* scr = (LAS float*)(F.lds + lds_off + F.wave * 8448);
    const int gw = F.bid * NWAVES + F.wave, NGW = nblk * NWAVES;
    constexpr int I_WIN = 16 * 96, I_WOUT = 16 * 32, I_GU1 = 16 * 32, I_GU = NEXP * I_GU1, I_DN1 = 8 * 32, I_DN = NEXP * I_DN1, I_W1 = 2 * 32 * 4, I_W2 = 2 * 2 * 2, I_WR = 36, I_B1 = 256;
    constexpr int NITEMS = I_WIN + I_WOUT + I_GU + I_DN + I_W1 + I_W2 + I_WR + I_B1;
    if (parts & 1) {
        for (int r = gw; r < I_GU; r += 2 * NGW) { const int r2 = r + NGW; const bool two = r2 < I_GU; const int e = r / I_GU1, e2 = (two ? r2 : r) / I_GU1; float tva[32], tvb[32];
            SrcGU sa{a->in[22] + ((size_t)l * NEXP + e) * DM * FF, a->in[23] + ((size_t)l * NEXP + e) * DM * FF}, sb{a->in[22] + ((size_t)l * NEXP + e2) * DM * FF, a->in[23] + ((size_t)l * NEXP + e2) * DM * FF};
            tr8_load(sa, 1024, r - e * I_GU1, F.lane, tva); tr8_load(sb, 1024, (two ? r2 : r) - e2 * I_GU1, F.lane, tvb);
            tr8_finish(tva, DM, 1024, wl + WL_WGU + (size_t)e * 1024 * DM, 32.f, scr, r - e * I_GU1, F.lane);
            if (two) tr8_finish(tvb, DM, 1024, wl + WL_WGU + (size_t)e2 * 1024 * DM, 32.f, scr, r2 - e2 * I_GU1, F.lane); }
        for (int r = gw; r < I_DN; r += 2 * NGW) { const int r2 = r + NGW; const bool two = r2 < I_DN; const int e = r / I_DN1, e2 = (two ? r2 : r) / I_DN1; float tva[32], tvb[32];
            SrcPlain sa{a->in[24] + ((size_t)l * NEXP + e) * FF * DM, DM}, sb{a->in[24] + ((size_t)l * NEXP + e2) * FF * DM, DM};
            tr8_load(sa, DM, r - e * I_DN1, F.lane, tva); tr8_load(sb, DM, (two ? r2 : r) - e2 * I_DN1, F.lane, tvb);
            tr8_finish(tva, FF, DM, wl + WL_WDN + (size_t)e * DM * FF, 64.f, scr, r - e * I_DN1, F.lane);
            if (two) tr8_finish(tvb, FF, DM, wl + WL_WDN + (size_t)e2 * DM * FF, 64.f, scr, r2 - e2 * I_DN1, F.lane); }
    }
    if (!(parts & 2)) return;
    for (int it = I_GU + I_DN + gw; it < NITEMS; it += NGW) {
        int r = it - I_GU - I_DN;
        if (r < I_WIN) { SrcWin s{a->in[1] + (size_t)l * DM * DIN}; float tv[32]; tr8_load(s, DINP, r, F.lane, tv); tr8_finish(tv, DM, DINP, wl + WL_WIN, 32.f, scr, r, F.lane); continue; } r -= I_WIN;
        if (r < I_WOUT) { SrcPlain s{a->in[2] + (size_t)l * DM * DM, DM}; tr_item(s, DM, DM, (bf16*)(wl + WL_WOUT), scr, r, F.lane); continue; } r -= I_WOUT;
        if (r < I_W1) { const int kv = r / 128; SrcPlain s{a->in[4] + ((size_t)l * 2 + kv) * 2048 * 128, 128};
            tr_item(s, 2048, 128, (bf16*)(wl + WL_W1) + (size_t)kv * 128 * 2048, scr, r - kv * 128, F.lane); continue; } r -= I_W1;
        if (r < I_W2) { const int kv = r / 4; SrcPlain s{a->in[5] + ((size_t)l * 2 + kv) * 128 * 64, 64};
            tr_item(s, 128, 64, (bf16*)(wl + WL_W2) + (size_t)kv * 64 * 128, scr, r - kv * 4, F.lane); continue; } r -= I_W2;
        if (r < I_WR) {
            float* wr = (float*)(wl + WL_WR) + (size_t)r * DM;
            for (int k = F.lane; k < DM; k += 64) wr[k] = (r < 4) ? a->in[18][((size_t)l * DM + k) * 4 + r] : a->in[20][((size_t)l * DM + k) * NEXP + (r - 4)];
            continue; } r -= I_WR;
        {
            const int kv = r >> 7, n = r & 127; const float* pe = a->in[3] + ((size_t)l * 2 + kv) * 2048; const float* w1 = a->in[4] + ((size_t)l * 2 + kv) * 2048 * 128;
            float s = 0.f; for (int k = F.lane; k < 2048; k += 64) s += pe[k] * w1[(size_t)k * 128 + n];
            s = wave_sum(s); if (F.lane == 0) ((float*)(wl + WL_BIAS1))[r] = s;
        }
    }
}

__device__ __forceinline__ void phase_prologue(const Frame& F, ArgsP a) {
    const size_t gt = (size_t)F.bid * NTHR + F.tid, NGT = (size_t)F.G * NTHR;
    float* rope = (float*)(a->ws + WS_ROPE);
    for (size_t i = gt; i < (size_t)SEQ * 8; i += NGT) { const int t = (int)(i >> 3), f = (int)(i & 7);
        const float invt[8] = {1.0f, 0.19392274f, 0.03760603f, 0.0072926646f, 0.0014142136f, 0.0002742482f, 5.3182957e-05f, 1.0313385e-05f};
        float inv = invt[0];
#pragma unroll
        for (int q = 1; q < 8; ++q) inv = (f == q) ? invt[q] : inv;
        const float ang = (float)t * inv;
        const double rev = (double)ang * 0.15915494309189535; const float fr = (float)(rev - __builtin_rint(rev));
        rope[t * 16 + f] = __builtin_amdgcn_cosf(fr); rope[t * 16 + 8 + f] = __builtin_amdgcn_sinf(fr); }
    const f32x4* x4 = (const f32x4*)a->in[0]; u32x4* xb = (u32x4*)(a->ws + WS_XB);
    for (size_t i = gt; i < (size_t)T * DM / 8; i += NGT) { const f32x4 v0 = x4[2 * i], v1 = x4[2 * i + 1];
        u32x4 w; w.x = pk2(v0[0], v0[1]); w.y = pk2(v0[2], v0[3]); w.z = pk2(v1[0], v1[1]); w.w = pk2(v1[2], v1[3]); xb[i] = w;
        int p0 = 0, p1 = 0; p0 = __builtin_amdgcn_cvt_pk_fp8_f32(v0[0], v0[1], p0, false); p0 = __builtin_amdgcn_cvt_pk_fp8_f32(v0[2], v0[3], p0, true); p1 = __builtin_amdgcn_cvt_pk_fp8_f32(v1[0], v1[1], p1, false); p1 = __builtin_amdgcn_cvt_pk_fp8_f32(v1[2], v1[3], p1, true);
        u32x2 w8; w8.x = (unsigned)p0; w8.y = (unsigned)p1; ((u32x2*)(a->ws + WS_X8))[i] = w8; }
}

template <bool DRY>
__device__ __forceinline__ void phase_ln1_router(const Frame& F, ArgsP a, int l) {
    const bf16* X1 = (const bf16*)(a->ws + WS_X1); bf16* XB = (bf16*)(a->ws + WS_XB); unsigned char* XB8 = a->ws + WS_H;
    const float* WR = (const float*)(WLBASE(a->ws, l) + WL_WR);
    const float* lw = a->in[14] + (size_t)l * DM; const float* lb = a->in[15] + (size_t)l * DM;
    const float* bg = a->in[19] + l * 4; const float* be = a->in[21] + l * NEXP;
    int* route_e = (int*)(a->ws + WS_SLOT + SL_RE); int* route_p = (int*)(a->ws + WS_SLOT + SL_RP); float* route_w = (float*)(a->ws + WS_SLOT + SL_RW);
    unsigned* cnt = F.ctl + CW_CNT + (DRY ? l + 4 : l) * 512;
    const int gw = F.bid * NWAVES + F.wave, NGW = F.G * NWAVES, lane = F.lane;
    LAS float* wgl = (LAS float*)F.lds;
    for (int i = F.tid; i < 4 * DM; i += NTHR) wgl[i] = WR[i];
    __syncthreads();
    const float bg0 = bg[0], bg1 = bg[1], bg2 = bg[2], bg3 = bg[3];
    for (int tg = gw; tg < T / 4; tg += NGW) {
        f32x4 v[4][4];
#pragma unroll
        for (int tk = 0; tk < 4; ++tk) { const u32x2* row = (const u32x2*)(X1 + (size_t)(4 * tg + tk) * DM) + lane;
            u32x2 raw[4];
#pragma unroll
            for (int j = 0; j < 4; ++j) raw[j] = row[64 * j];
#pragma unroll
            for (int j = 0; j < 4; ++j) { v[tk][j][0] = bf2f(raw[j].x & 0xffffu); v[tk][j][1] = __uint_as_float(raw[j].x & 0xffff0000u); v[tk][j][2] = bf2f(raw[j].y & 0xffffu); v[tk][j][3] = __uint_as_float(raw[j].y & 0xffff0000u); } }
#pragma unroll
        for (int tk = 0; tk < 4; ++tk) {
            float s = 0.f;
#pragma unroll
            for (int j = 0; j < 4; ++j) s += (v[tk][j][0] + v[tk][j][1]) + (v[tk][j][2] + v[tk][j][3]);
            const float mean = wave_sum(s) * (1.f / DM); float q = 0.f;
#pragma unroll
            for (int j = 0; j < 4; ++j) { v[tk][j] = v[tk][j] - mean; q += (v[tk][j][0] * v[tk][j][0] + v[tk][j][1] * v[tk][j][1]) + (v[tk][j][2] * v[tk][j][2] + v[tk][j][3] * v[tk][j][3]); }
            const float rstd = 1.f / sqrtf(wave_sum(q) * (1.f / DM) + LN_EPS);
            u32x2* brow = (u32x2*)(XB + (size_t)(4 * tg + tk) * DM) + lane;
#pragma unroll
            for (int j = 0; j < 4; ++j) { const f32x4 w4 = ((const f32x4*)lw)[lane + 64 * j], b4 = ((const f32x4*)lb)[lane + 64 * j];
                v[tk][j] = v[tk][j] * rstd * w4 + b4;
                u32x2 w; w.x = pk2(v[tk][j][0], v[tk][j][1]); w.y = pk2(v[tk][j][2], v[tk][j][3]); if (!DRY) brow[64 * j] = w;
                int w8 = 0; w8 = __builtin_amdgcn_cvt_pk_fp8_f32(v[tk][j][0], v[tk][j][1], w8, false); w8 = __builtin_amdgcn_cvt_pk_fp8_f32(v[tk][j][2], v[tk][j][3], w8, true);
                if (!DRY) ((int*)(XB8 + (size_t)(4 * tg + tk) * DM))[lane + 64 * j] = w8; }
        }
        float glg[4][4];
#pragma unroll
        for (int j = 0; j < 4; ++j) { const LAS f32x4* wr = (const LAS f32x4*)(wgl + j * DM) + lane; const f32x4 w0 = wr[0], w1 = wr[64], w2 = wr[128], w3 = wr[192];
#pragma unroll
            for (int tk = 0; tk < 4; ++tk) { f32x4 p = v[tk][0] * w0; p = p + v[tk][1] * w1; p = p + v[tk][2] * w2; p = p + v[tk][3] * w3; glg[tk][j] = wave_sum((p[0] + p[1]) + (p[2] + p[3])); } }
        int my_e = 0; float my_w = 0.f;
#pragma unroll
        for (int tk = 0; tk < 4; ++tk) {
            const float g0 = glg[tk][0] + bg0, g1 = glg[tk][1] + bg1, g2 = glg[tk][2] + bg2, g3 = glg[tk][3] + bg3;
            int gi = 0; float gm = g0; if (g1 > gm) { gm = g1; gi = 1; } if (g2 > gm) { gm = g2; gi = 2; } if (g3 > gm) { gm = g3; gi = 3; }
            gi = __builtin_amdgcn_readfirstlane(gi);
            const float g_w = 1.f / (__expf(g0 - gm) + __expf(g1 - gm) + __expf(g2 - gm) + __expf(g3 - gm));
            const float* wbase = WR + (size_t)(4 + gi * 8) * DM; float ev[8];
#pragma unroll
            for (int i4 = 0; i4 < 2; ++i4) { f32x4 w[4][4];
#pragma unroll
                for (int i = 0; i < 4; ++i) { const f32x4* wr = (const f32x4*)(wbase + (size_t)(4 * i4 + i) * DM) + lane; w[i][0] = wr[0]; w[i][1] = wr[64]; w[i][2] = wr[128]; w[i][3] = wr[192]; }
#pragma unroll
                for (int i = 0; i < 4; ++i) { f32x4 p = v[tk][0] * w[i][0]; p = p + v[tk][1] * w[i][1]; p = p + v[tk][2] * w[i][2]; p = p + v[tk][3] * w[i][3];
                    ev[4 * i4 + i] = wave_sum((p[0] + p[1]) + (p[2] + p[3])) + be[gi * 8 + 4 * i4 + i]; } }
            int i1 = 0; float v1 = ev[0];
#pragma unroll
            for (int i = 1; i < 8; ++i) if (ev[i] > v1) { v1 = ev[i]; i1 = i; }
            int i2 = -1; float v2 = -3.0e38f;
#pragma unroll
            for (int i = 0; i < 8; ++i) if (i != i1 && ev[i] > v2) { v2 = ev[i]; i2 = i; }
            const float e2 = __expf(v2 - v1), w1 = g_w / (1.f + e2), w2 = g_w - w1;
            if (lane == 2 * tk) { my_e = gi * 8 + i1; my_w = w1; }
            if (lane == 2 * tk + 1) { my_e = gi * 8 + i2; my_w = w2; }
        }
        if (lane < 8) {
            const unsigned pos = __hip_atomic_fetch_add(cnt + my_e * 16, 1u, __ATOMIC_RELAXED, __HIP_MEMORY_SCOPE_AGENT);
            const size_t si = (size_t)tg * 8 + lane; if (!DRY) { route_e[si] = my_e; route_p[si] = (int)pos; route_w[si] = my_w; }
        }
    }
    __syncthreads();
}

__device__ __forceinline__ void phase_gather(const Frame& F, ArgsP a, int l) {
    LAS int* pstart = (LAS int*)F.lds;
    unsigned* cnt = F.ctl + CW_CNT + l * 512;
    int* meta = (int*)(a->ws + WS_META) + l * 512;
    int* slot_tok = (int*)(a->ws + WS_SLOT + SL_TOK); float* slot_w = (float*)(a->ws + WS_SLOT + SL_W);
    const int* route_e = (const int*)(a->ws + WS_SLOT + SL_RE); const int* route_p = (const int*)(a->ws + WS_SLOT + SL_RP); const float* route_w = (const float*)(a->ws + WS_SLOT + SL_RW);
    if (F.tid < 64) {
        const int c = F.tid < 32 ? (int)__hip_atomic_load(cnt + F.tid * 16, __ATOMIC_RELAXED, __HIP_MEMORY_SCOPE_AGENT) : 0;
        const int pad = (c + 255) & ~255; int inc = pad;
#pragma unroll
        for (int o = 1; o < 64; o <<= 1) { const int t = __shfl_up(inc, o); if (F.lane >= o) inc += t; }
        const int st = inc - pad;
        if (F.tid < 32) { pstart[F.tid] = st;
            if (F.bid == 0) { for (int t = st >> 8; t < (st + pad) >> 8; ++t) meta[64 + t] = F.tid; if (F.tid == 31) meta[0] = (st + pad) >> 8; }
            if ((F.tid % F.G) == F.bid) for (int r = st + c; r < st + pad; ++r) { slot_tok[r] = -1; slot_w[r] = 0.f; }
        }
    }
    __syncthreads();
    for (int s = F.bid * NTHR + F.tid; s < T * 2; s += F.G * NTHR) {
        const int dest = pstart[route_e[s]] + route_p[s]; slot_tok[dest] = s; slot_w[dest] = route_w[s];
    }
    __syncthreads();
}

__device__ __forceinline__ void phase_ln2(const Frame& F, ArgsP a, int l) {
    const bf16* Y2 = (const bf16*)(a->ws + WS_Y2); bf16* XB = (bf16*)(a->ws + WS_XB); float* out = a->out;
    const float* lw = a->in[16] + (size_t)l * DM; const float* lb = a->in[17] + (size_t)l * DM;
    const int gw = F.bid * NWAVES + F.wave, NGW = F.G * NWAVES, lane = F.lane; const bool last = (l == NL - 1);
    for (int t0 = 2 * gw; t0 < T; t0 += 2 * NGW) {
        u32x2 xr[2][4], pa[2][4], pb[2][4];
#pragma unroll
        for (int u = 0; u < 2; ++u) { const int t = t0 + u; const u32x2* x_ = (const u32x2*)(XB + (size_t)t * DM) + lane; const u32x2* a_ = (const u32x2*)(Y2 + (size_t)(2 * t) * DM) + lane; const u32x2* b_ = (const u32x2*)(Y2 + (size_t)(2 * t + 1) * DM) + lane;
#pragma unroll
            for (int j = 0; j < 4; ++j) { xr[u][j] = x_[64 * j]; pa[u][j] = a_[64 * j]; pb[u][j] = b_[64 * j]; } }
#pragma unroll
        for (int u = 0; u < 2; ++u) { const int t = t0 + u;
            f32x4 v[4]; float s = 0.f;
#pragma unroll
            for (int j = 0; j < 4; ++j) { const u32x2 x = xr[u][j], p = pa[u][j], q = pb[u][j];
                v[j][0] = bf2f(x.x & 0xffffu) * DN_ALPHA + (bf2f(p.x & 0xffffu) + bf2f(q.x & 0xffffu)); v[j][1] = bf2f(x.x >> 16) * DN_ALPHA + (bf2f(p.x >> 16) + bf2f(q.x >> 16));
                v[j][2] = bf2f(x.y & 0xffffu) * DN_ALPHA + (bf2f(p.y & 0xffffu) + bf2f(q.y & 0xffffu)); v[j][3] = bf2f(x.y >> 16) * DN_ALPHA + (bf2f(p.y >> 16) + bf2f(q.y >> 16));
                s += (v[j][0] + v[j][1]) + (v[j][2] + v[j][3]); }
            const float mean = wave_sum(s) * (1.f / DM); float q2 = 0.f;
#pragma unroll
            for (int j = 0; j < 4; ++j) { v[j] = v[j] - mean; q2 += (v[j][0] * v[j][0] + v[j][1] * v[j][1]) + (v[j][2] * v[j][2] + v[j][3] * v[j][3]); }
            const float rstd = 1.f / sqrtf(wave_sum(q2) * (1.f / DM) + LN_EPS);
            f32x4* orow = (f32x4*)(out + (size_t)t * DM) + lane; u32x2* brow = (u32x2*)(XB + (size_t)t * DM) + lane;
#pragma unroll
            for (int j = 0; j < 4; ++j) { const f32x4 w4 = ((const f32x4*)lw)[lane + 64 * j], b4 = ((const f32x4*)lb)[lane + 64 * j];
                const f32x4 o = v[j] * rstd * w4 + b4; if (last) orow[64 * j] = o; u32x2 w; w.x = pk2(o[0], o[1]); w.y = pk2(o[2], o[3]); if (!last) brow[64 * j] = w;
                int w8 = 0; w8 = __builtin_amdgcn_cvt_pk_fp8_f32(o[0], o[1], w8, false); w8 = __builtin_amdgcn_cvt_pk_fp8_f32(o[2], o[3], w8, true); if (!last) ((int*)(a->ws + WS_X8 + (size_t)t * DM))[lane + 64 * j] = w8; } }
    }
}

__device__ __forceinline__ int tsw(int row, int col) { return row * 128 + ((((col >> 3) ^ (row >> 1)) & 7) << 4) + ((col & 7) << 1); }
__device__ __forceinline__ f32x4 mfma16(bf16x8 a, bf16x8 b, f32x4 c) { return __builtin_amdgcn_mfma_f32_16x16x32_bf16(a, b, c, 0, 0, 0); }
__device__ __forceinline__ f32x16 mfma32(bf16x8 a, bf16x8 b, f32x16 c) { return __builtin_amdgcn_mfma_f32_32x32x16_bf16(a, b, c, 0, 0, 0); }
__device__ __forceinline__ bf16x8 as_bf16x8(u32x4 v) { return __builtin_bit_cast(bf16x8, v); }

__device__ __forceinline__ void conformer_item(const Frame& F, ArgsP a, int l, int it) {
    const int b = it >> 6, s0 = (it & 63) * 64; const size_t tok0 = (size_t)b * SEQ + s0;
    const bf16* H = (const bf16*)(a->ws + WS_H); bf16* Y = (bf16*)(a->ws + WS_Y);
    LAS bf16* ut = (LAS bf16*)F.lds;
    LAS float* co = (LAS float*)(F.lds + 49152);
    for (int idx = F.tid; idx < 94 * 32; idx += NTHR) {
        const int r = idx >> 5, c8 = (idx & 31) * 8, s = s0 - 30 + r; u32x4 w = {0u, 0u, 0u, 0u};
        if (s >= 0) { const bf16* hp = H + ((size_t)b * SEQ + s) * HLD + 2304 + c8; const u32x4 v = *(const u32x4*)hp, g = *(const u32x4*)(hp + 256);
#pragma unroll
            for (int e = 0; e < 4; ++e) { const float v0 = bf2f(v[e] & 0xffffu) * fsigmoid(bf2f(g[e] & 0xffffu)), v1 = bf2f(v[e] >> 16) * fsigmoid(bf2f(g[e] >> 16)); w[e] = pk2(v0, v1); } }
        *(LAS u32x4*)(ut + r * 256 + c8) = w;
    }
    __syncthreads();
    {
        const int c = F.tid & 255, half = F.tid >> 8; const float* dw = a->in[10] + (size_t)l * 31 * 256 + c; const float bias = a->in[11][l * 256 + c];
        float w[31], ur[62];
#pragma unroll
        for (int k = 0; k < 31; ++k) w[k] = dw[k * 256];
#pragma unroll
        for (int i = 0; i < 62; ++i) ur[i] = bf2f(ut[(32 * half + i) * 256 + c]);
#pragma unroll
        for (int tt = 0; tt < 32; ++tt) { float acc = bias;
#pragma unroll
            for (int k = 0; k < 31; ++k) acc += w[k] * ur[tt + k];
            co[(32 * half + tt) * 256 + c] = acc; }
    }
    __syncthreads();
    {
        const float* lw = a->in[12] + l * 256; const float* lb = a->in[13] + l * 256; const f32x4 w4 = ((const f32x4*)lw)[F.lane], b4 = ((const f32x4*)lb)[F.lane];
#pragma unroll
        for (int i = 0; i < 8; ++i) { const int tl = 8 * F.wave + i; f32x4 v = *(LAS f32x4*)(co + tl * 256 + 4 * F.lane);
            const float mean = wave_sum((v[0] + v[1]) + (v[2] + v[3])) * (1.f / 256.f); v = v - mean;
            const float rstd = 1.f / sqrtf(wave_sum((v[0] * v[0] + v[1] * v[1]) + (v[2] * v[2] + v[3] * v[3])) * (1.f / 256.f) + LN_EPS);
            v = v * rstd * w4 + b4; u32x2 o; o.x = pk2(fsilu(v[0]), fsilu(v[1])); o.y = pk2(fsilu(v[2]), fsilu(v[3]));
            *(u32x2*)(Y + (tok0 + tl) * DM + 768 + 4 * F.lane) = o; }
    }
    __syncthreads();
}

__device__ __forceinline__ void compress_item(const Frame& F, ArgsP a, int l, int it) {
    const int kv = it >> 7, bh = (it >> 3) & 15, b = bh >> 1, hh = bh & 1, i0 = (it & 7) * 32;
    const bf16* H = (const bf16*)(a->ws + WS_H); const bf16* w1t = (const bf16*)(WLBASE(a->ws, l) + WL_W1) + (size_t)kv * 128 * 2048; const bf16* w2t = (const bf16*)(WLBASE(a->ws, l) + WL_W2) + (size_t)kv * 64 * 128;
    const float* bias1 = (const float*)(WLBASE(a->ws, l) + WL_BIAS1) + kv * 128; bf16* outp = (bf16*)(a->ws + (kv ? WS_VC : WS_KC)) + (size_t)bh * 256 * 64;
    LAS bf16* hid = (LAS bf16*)F.lds;
    const int lane = F.lane, li = lane & 15, g = lane >> 4, rt = F.wave & 1, cq = F.wave >> 1;
    const int i = i0 + 16 * rt + li; const bf16* arow = H + (size_t)b * SEQ * HLD + 512 + kv * 128 + hh * 64 + 8 * g;
    const bf16* brow = w1t + (size_t)(32 * cq + li) * 2048 + 8 * g;
    f32x4 acc[2] = {{0.f, 0.f, 0.f, 0.f}, {0.f, 0.f, 0.f, 0.f}};
#pragma unroll 1
    for (int k8 = 0; k8 < 64; k8 += 8) {
        bf16x8 af[8], bfr[8][2];
#pragma unroll
        for (int u = 0; u < 8; ++u) { const int ks = k8 + u; int s = 16 * i + (ks >> 1); s = s > SEQ - 1 ? SEQ - 1 : s;
            af[u] = *(const bf16x8*)(arow + (size_t)s * HLD + (ks & 1) * 32); bfr[u][0] = *(const bf16x8*)(brow + ks * 32); bfr[u][1] = *(const bf16x8*)(brow + (size_t)16 * 2048 + ks * 32); }
#pragma unroll
        for (int u = 0; u < 8; ++u) { acc[0] = mfma16(af[u], bfr[u][0], acc[0]); acc[1] = mfma16(af[u], bfr[u][1], acc[1]); }
    }
#pragma unroll
    for (int nt = 0; nt < 2; ++nt) { const int n = 32 * cq + 16 * nt + li; const float bs = bias1[n];
#pragma unroll
        for (int r = 0; r < 4; ++r) hid[(16 * rt + 4 * g + r) * 136 + n] = (bf16)f2bf(fsilu(acc[nt][r] + bs)); }
    __syncthreads();
    f32x4 o2 = {0.f, 0.f, 0.f, 0.f};
#pragma unroll
    for (int ks = 0; ks < 4; ++ks) { const bf16x8 af = *(LAS bf16x8*)(hid + (16 * rt + li) * 136 + 32 * ks + 8 * g);
        const bf16x8 bfr = *(const bf16x8*)(w2t + (size_t)(16 * cq + li) * 128 + 32 * ks + 8 * g); o2 = mfma16(af, bfr, o2); }
#pragma unroll
    for (int r = 0; r < 4; ++r) { const int io = i0 + 16 * rt + 4 * g + r; outp[(size_t)io * 64 + 16 * cq + li] = (bf16)(io < 255 ? f2bf_sw(o2[r]) : 0u); }
    __syncthreads();
}

__host__ __device__ constexpr int tri_off(int i) { int s = 0; for (int k = 0; k < i; ++k) s += (k + 3) >> 2; return 4 * s; }
__device__ __forceinline__ int tri_off_rt(int i) { const int m = i - 1, V = (m + 3) >> 2; return i <= 0 ? 0 : 4 * (2 * V * (V - 1) + V * (m - 4 * V + 4)); }

template <int I> struct GdnSolveRow {
    __device__ static __forceinline__ void run(const LAS float* Ap, float (&x)[64]) {
        if constexpr (I < 64) {
            constexpr int off = tri_off(I), nb = (I + 3) >> 2;
            float s4[4] = {0.f, 0.f, 0.f, 0.f};
#pragma unroll
            for (int jb = 0; jb < nb; ++jb) { const f32x4 a4 = *(const LAS f32x4*)(Ap + off + 4 * jb);
#pragma unroll
                for (int jj = 0; jj < 4; ++jj) { if (4 * jb + jj < I) s4[jj] += a4[jj] * x[4 * jb + jj]; } }
            x[I] -= (s4[0] + s4[1]) + (s4[2] + s4[3]);
            if constexpr ((I & 3) == 3) SBAR();
            GdnSolveRow<I + 1>::run(Ap, x);
        }
    }
};

template <int GV>
__device__ __forceinline__ void gdn_prep_chunk(const Frame& F, ArgsP a, int l, int ci, LAS unsigned char* wl) {
    int lane_ = F.lane; asm volatile("" : "+v"(lane_));
    const int lane = lane_, li = lane & 15, g = lane >> 4; const int bh = ci >> 6, n = ci & 63, b = bh >> 2, h = bh & 3; const size_t tok0 = (size_t)b * SEQ + 64 * n;
    const bf16* H = (const bf16*)(a->ws + WS_H); const float* side = (const float*)(a->ws + WS_SIDE);
    unsigned char* rec = a->ws + ((GV & 1) ? WS_Y2 : WS_GPREP) + (size_t)ci * GCH;
    bf16* R0 = (bf16*)(rec + GC_UT); bf16* R1 = (bf16*)(rec + GC_W); bf16* QKm = (bf16*)(rec + GC_QK); bf16* QD = (bf16*)(rec + GC_QD); bf16* KDT = (bf16*)(rec + GC_KDT); bf16* ZT = (bf16*)(rec + GC_ZT);
    const int pc = (lane & 32) | (((lane & 15) >> 2) << 3) | (((lane >> 4) & 1) << 2) | (lane & 3);
    LAS unsigned char* qt = wl; LAS unsigned char* kt = wl + 8192; LAS float* Ap = (LAS float*)wl;
    const float beta = side[(tok0 + lane) * 32 + 24 + h]; const float av = side[(tok0 + lane) * 32 + 28 + h] + a->in[8][l * 4 + h];
    const float sp = av > 20.f ? av : log1pf(__expf(av)); float gc = -__expf(a->in[7][l * 4 + h]) * sp;
#pragma unroll
    for (int o = 1; o < 64; o <<= 1) { const float t = __shfl_up(gc, o); if (lane >= o) gc += t; }
    const float gl = __shfl(gc, 63); const float eg = __expf(gc), ekd = __expf(gl - gc);
    if (lane == 0 && !(GV & 1)) ((float*)(a->ws + WS_GL))[ci] = __expf(gl);
    const float* cw = a->in[6] + (size_t)l * 4 * 768 + h * 64 + lane; float wq[4], wk[4], wv[4];
#pragma unroll
    for (int k = 0; k < 4; ++k) { wq[k] = cw[k * 768]; wk[k] = cw[k * 768 + 256]; wv[k] = cw[k * 768 + 512]; }
    const bf16* hp = H + tok0 * HLD + 1280 + h * 64 + lane; float hq[3], hk[3], hv[3];
#pragma unroll
    for (int j = 0; j < 3; ++j) { const bool ok = (64 * n - 3 + j) >= 0; const bf16* p = hp + (ptrdiff_t)(j - 3) * HLD;
        hq[j] = ok ? bf2f(p[0]) : 0.f; hk[j] = ok ? bf2f(p[256]) : 0.f; hv[j] = ok ? bf2f(p[512]) : 0.f; }
    unsigned short ra[8][4], rb[8][4]; const float nwl = a->in[9][l * 64 + lane];
#define GDN_LOADBLK(dst, t8_) do { const bf16* pl_ = hp + (size_t)(8 * (t8_)) * HLD; asm volatile("" : "+v"(pl_)); _Pragma("unroll") for (int tt = 0; tt < 8; ++tt) { const bf16* q_ = pl_ + (size_t)tt * HLD; dst[tt][0] = q_[0]; dst[tt][1] = q_[256]; dst[tt][2] = q_[512]; dst[tt][3] = q_[768]; } } while (0)
#define GDN_CONVBLK(src, t8_) do { const int t8 = (t8_); unsigned kdp[4], zp[4]; \
        bf16* qd8 = QD + (8 * t8) * 64 + pc; bf16* r08 = R0 + (8 * t8) * 64 + lane; bf16* r18 = R1 + (8 * t8) * 64 + lane; asm volatile("" : "+v"(qd8), "+v"(r08), "+v"(r18)); \
        _Pragma("unroll") for (int tt = 0; tt < 8; ++tt) { const int t = 8 * t8 + tt; \
            const float rq = bf2f(src[tt][0]), rk = bf2f(src[tt][1]), rv = bf2f(src[tt][2]); \
            const float cq = wq[0] * hq[0] + wq[1] * hq[1] + wq[2] * hq[2] + wq[3] * rq, ck = wk[0] * hk[0] + wk[1] * hk[1] + wk[2] * hk[2] + wk[3] * rk, cv = wv[0] * hv[0] + wv[1] * hv[1] + wv[2] * hv[2] + wv[3] * rv; \
            hq[0] = hq[1]; hq[1] = hq[2]; hq[2] = rq; hk[0] = hk[1]; hk[1] = hk[2]; hk[2] = rk; hv[0] = hv[1]; hv[1] = hv[2]; hv[2] = rv; \
            const float qs = fsilu(cq), ks_ = fsilu(ck), vs = fsilu(cv); \
            const float qn = qs * __builtin_amdgcn_rsqf(wave_sum(qs * qs) + 1e-6f) * 0.125f, kn = ks_ * __builtin_amdgcn_rsqf(wave_sum(ks_ * ks_) + 1e-6f); \
            const float bt = __int_as_float(__builtin_amdgcn_readlane(__float_as_int(beta), t)), egt = __int_as_float(__builtin_amdgcn_readlane(__float_as_int(eg), t)), ekt = __int_as_float(__builtin_amdgcn_readlane(__float_as_int(ekd), t)); \
            *(LAS bf16*)(qt + tsw(t, lane)) = (bf16)f2bf(qn); *(LAS bf16*)(kt + tsw(t, lane)) = (bf16)f2bf(kn); \
            qd8[tt * 64] = (bf16)f2bf(qn * egt); r08[tt * 64] = (bf16)f2bf(bt * vs); r18[tt * 64] = (bf16)f2bf(bt * egt * kn); \
            const unsigned kd = f2bf(kn * ekt); if (tt & 1) kdp[tt >> 1] |= kd << 16; else kdp[tt >> 1] = kd; \
            const unsigned zg = f2bf(fsilu(bf2f(src[tt][3])) * nwl); if (tt & 1) zp[tt >> 1] |= zg << 16; else zp[tt >> 1] = zg; } \
        { u32x4 wz; wz.x = zp[0]; wz.y = zp[1]; wz.z = zp[2]; wz.w = zp[3]; *(u32x4*)(ZT + lane * 64 + 8 * t8) = wz; } \
        { const int c0 = (8 * t8) & 31, gg = (c0 & 15) >> 2, hh = c0 >> 4; bf16* kr = KDT + lane * 64 + ((8 * t8) & 32) + 4 * hh; \
          u32x2 w0, w1; w0.x = kdp[0]; w0.y = kdp[1]; w1.x = kdp[2]; w1.y = kdp[3]; *(u32x2*)(kr + 8 * gg) = w0; *(u32x2*)(kr + 8 * gg + 8) = w1; } } while (0)
    if (!(GV & 2)) {
    GDN_LOADBLK(ra, 0);
#pragma unroll 1
    for (int t16 = 0; t16 < 4; ++t16) {
        GDN_LOADBLK(rb, 2 * t16 + 1);
        GDN_CONVBLK(ra, 2 * t16);
        if (t16 < 3) GDN_LOADBLK(ra, 2 * t16 + 2);
        GDN_CONVBLK(rb, 2 * t16 + 1);
    }
    }
#undef GDN_LOADBLK
#undef GDN_CONVBLK
    LDS_WAIT();
    if (!(GV & 4)) {
    float gcj[4][4];
#pragma unroll
    for (int mt = 0; mt < 4; ++mt)
#pragma unroll
        for (int r = 0; r < 4; ++r) gcj[mt][r] = __shfl(gc, 16 * mt + 4 * g + r);
    f32x4 ahold[4][4];
#pragma unroll
    for (int nt = 0; nt < 4; ++nt) {
        const int i = 16 * nt + li; const float gci = __shfl(gc, i), bi = __shfl(beta, i);
        bf16x8 kB[2], qB[2];
#pragma unroll
        for (int ks = 0; ks < 2; ++ks) { kB[ks] = *(LAS bf16x8*)(kt + tsw(i, 32 * ks + 8 * g)); qB[ks] = *(LAS bf16x8*)(qt + tsw(i, 32 * ks + 8 * g)); }
#pragma unroll
        for (int mt = 0; mt < 4; ++mt) {
            u32x2 qw = {0u, 0u};
            if (mt <= nt) {
                const bf16x8 kA0 = *(LAS bf16x8*)(kt + tsw(16 * mt + li, 8 * g)), kA1 = *(LAS bf16x8*)(kt + tsw(16 * mt + li, 32 + 8 * g));
                f32x4 ckk = {0.f, 0.f, 0.f, 0.f}, cqk = {0.f, 0.f, 0.f, 0.f};
                ckk = mfma16(kA0, kB[0], ckk); ckk = mfma16(kA1, kB[1], ckk); cqk = mfma16(kA0, qB[0], cqk); cqk = mfma16(kA1, qB[1], cqk);
                float qv[4];
#pragma unroll
                for (int r = 0; r < 4; ++r) { const int j = 16 * mt + 4 * g + r; const float dec = __expf(fminf(gci - gcj[mt][r], 0.f));
                    ahold[nt][mt][r] = bi * ckk[r] * dec; qv[r] = (j <= i) ? cqk[r] * dec : 0.f; }
                qw.x = pk2(qv[0], qv[1]); qw.y = pk2(qv[2], qv[3]);
            }
            *(u32x2*)(QKm + i * 64 + 32 * (mt >> 1) + 8 * g + 4 * (mt & 1)) = qw;
        }
    }
    LDS_WAIT(); SBAR();
#pragma unroll
    for (int nt = 0; nt < 4; ++nt) { const int i = 16 * nt + li; const int ro = tri_off_rt(i);
#pragma unroll
        for (int mt = 0; mt < 4; ++mt) if (mt <= nt) {
#pragma unroll
            for (int r = 0; r < 4; ++r) { const int j = 16 * mt + 4 * g + r; if (j < i) Ap[ro + j] = ahold[nt][mt][r]; } } }
    }
    VM_WAIT(); LDS_WAIT();
#pragma unroll 1
    for (int pass = 0; pass < 2; ++pass) {
        bf16* Rp = pass ? R1 : R0; float x[64];
#pragma unroll
        for (int i = 0; i < 64; ++i) x[i] = bf2f(Rp[i * 64 + lane]);
        VM_WAIT();
        if (!(GV & 8)) GdnSolveRow<1>::run(Ap, x);
        if (pass == 0) {
#pragma unroll
            for (int i8 = 0; i8 < 8; ++i8) { u32x4 w; w.x = pk2(x[8 * i8], x[8 * i8 + 1]); w.y = pk2(x[8 * i8 + 2], x[8 * i8 + 3]); w.z = pk2(x[8 * i8 + 4], x[8 * i8 + 5]); w.w = pk2(x[8 * i8 + 6], x[8 * i8 + 7]);
                *(u32x4*)(Rp + lane * 64 + 8 * i8) = w; }
        } else {
#pragma unroll
            for (int i = 0; i < 64; ++i) Rp[i * 64 + pc] = (bf16)f2bf(x[i]);
        }
    }
    LDS_WAIT();
}

__device__ __forceinline__ bf16x8 scan_frag(const unsigned char* mat, int mt, int ks, int li, int g) { return *(const bf16x8*)(mat + (16 * mt + li) * 128 + (32 * ks + 8 * g) * 2); }
__device__ __forceinline__ bf16x8 pack_c2(f32x4 a, f32x4 b) { u32x4 w; w.x = pk2(a[0], a[1]); w.y = pk2(a[2], a[3]); w.z = pk2(b[0], b[1]); w.w = pk2(b[2], b[3]); return as_bf16x8(w); }
constexpr int SC_SLOT = 24576;
__device__ __forceinline__ void scan_dma(LAS unsigned char* slot, const unsigned char* rec, int sl, int lane) {
#pragma unroll
    for (int m = 0; m < 3; ++m) { const int goff = (m == 0) ? GC_W : (m == 1 ? GC_KDT : GC_UT);
#pragma unroll
        for (int i = 0; i < 2; ++i) { const int row = 16 * sl + 8 * i + (lane >> 3), ch = (lane & 7) ^ ((row >> 1) & 7);
            __builtin_amdgcn_global_load_lds((const unsigned*)(rec + goff + row * 128 + ch * 16), (LAS unsigned*)(slot + m * 8192 + (16 * sl + 8 * i) * 128), 16, 0, 0); } }
}
__device__ __forceinline__ bf16x8 scan_lfrag(const LAS unsigned char* mat, int mt, int ks, int li, int g) { const int row = 16 * mt + li; return *(const LAS bf16x8*)(mat + row * 128 + ((((4 * ks + g) ^ (row >> 1)) & 7) << 4)); }
template <int SV>
__device__ __forceinline__ void gdn_scan(const Frame& F, ArgsP a, int l) {
    const int lane = F.lane, li = lane & 15, g = lane >> 4, pr = F.wave >> 2, sl = F.wave & 3; const int bh = F.bid * 2 + pr, dv0 = 16 * sl;
    const float* GL = (const float*)(a->ws + WS_GL) + bh * 64; unsigned char* rec0 = a->ws + WS_GPREP + (size_t)bh * 64 * GCH;
    LAS unsigned char* ring = F.lds + pr * (3 * SC_SLOT);
    f32x4 S[4] = {{0.f, 0.f, 0.f, 0.f}, {0.f, 0.f, 0.f, 0.f}, {0.f, 0.f, 0.f, 0.f}, {0.f, 0.f, 0.f, 0.f}};
    const float glv = GL[lane];
    asm volatile("s_waitcnt vmcnt(0)" ::: "memory");
    scan_dma(ring, rec0, sl, lane); scan_dma(ring + SC_SLOT, rec0 + GCH, sl, lane);
#pragma unroll 1
    for (int n = 0; n < 64; ++n) {
        unsigned char* rn = rec0 + (size_t)n * GCH; const LAS unsigned char* slot = ring + (n % 3) * SC_SLOT;
        if (n == 0) asm volatile("s_waitcnt vmcnt(6)" ::: "memory"); else if (n == 1) asm volatile("s_waitcnt vmcnt(10)" ::: "memory");
        else if (n == 63) asm volatile("s_waitcnt vmcnt(8)" ::: "memory"); else asm volatile("s_waitcnt vmcnt(14)" ::: "memory");
        __builtin_amdgcn_s_barrier(); asm volatile("" ::: "memory");
        if (n + 2 < 64) scan_dma(ring + ((n + 2) % 3) * SC_SLOT, rn + 2 * (size_t)GCH, sl, lane);
        else { asm volatile("" ::: "memory"); }
        const float egl = __int_as_float(__builtin_amdgcn_readlane(__float_as_int(glv), n));
        const bf16x8 Sb0 = pack_c2(S[0], S[1]), Sb1 = pack_c2(S[2], S[3]);
        if (!(SV & 1)) { bf16x8* ss = (bf16x8*)(rn + GC_SS + sl * 2048) + lane; ss[0] = Sb0; ss[64] = Sb1; }
        f32x4 vn[4];
#pragma unroll
        for (int mt = 0; mt < 4; ++mt) {
            f32x4 acc = {0.f, 0.f, 0.f, 0.f};
            acc = mfma16(scan_lfrag(slot, mt, 0, li, g), Sb0, acc); acc = mfma16(scan_lfrag(slot, mt, 1, li, g), Sb1, acc);
            const int urow = dv0 + li; const u32x2 uu = *(const LAS u32x2*)(slot + 16384 + urow * 128 + (((((16 * mt + 4 * g) >> 3) ^ (urow >> 1)) & 7) << 4) + (((16 * mt + 4 * g) & 7) << 1));
            vn[mt][0] = bf2f(uu.x & 0xffffu) - acc[0]; vn[mt][1] = bf2f(uu.x >> 16) - acc[1]; vn[mt][2] = bf2f(uu.y & 0xffffu) - acc[2]; vn[mt][3] = bf2f(uu.y >> 16) - acc[3];
        }
        const bf16x8 Vb0 = pack_c2(vn[0], vn[1]), Vb1 = pack_c2(vn[2], vn[3]);
        if (!(SV & 1)) { bf16x8* vb = (bf16x8*)(rn + GC_VB + sl * 2048) + lane; vb[0] = Vb0; vb[64] = Vb1; }
#pragma unroll
        for (int mt = 0; mt < 4; ++mt) { f32x4 acc = S[mt] * egl; acc = mfma16(scan_lfrag(slot + 8192, mt, 0, li, g), Vb0, acc); acc = mfma16(scan_lfrag(slot + 8192, mt, 1, li, g), Vb1, acc); S[mt] = acc; }
        if ((SV & 1) || n + 2 >= 64) { }
    }
    asm volatile("s_waitcnt vmcnt(0)" ::: "memory"); asm volatile("" :: "v"(S[0][0]), "v"(S[1][1]), "v"(S[2][2]), "v"(S[3][3]));
    __syncthreads();
}

__device__ __forceinline__ void gdn_out_chunk(const Frame& F, ArgsP a, int ci, LAS unsigned char* wl) {
    int lane_ = F.lane; asm volatile("" : "+v"(lane_)); const int lane = lane_, li = lane & 15, g = lane >> 4; const int bh = ci >> 6, n = ci & 63, b = bh >> 2, h = bh & 3;
    const unsigned char* rec = a->ws + WS_GPREP + (size_t)ci * GCH; bf16* Y = (bf16*)(a->ws + WS_Y);
    bf16x8 QDf[4][2], QKf[4][2];
#pragma unroll
    for (int mt = 0; mt < 4; ++mt) { QDf[mt][0] = scan_frag(rec + GC_QD, mt, 0, li, g); QDf[mt][1] = scan_frag(rec + GC_QD, mt, 1, li, g); QKf[mt][0] = scan_frag(rec + GC_QK, mt, 0, li, g); QKf[mt][1] = scan_frag(rec + GC_QK, mt, 1, li, g); }
    float ssq[4][4];
#pragma unroll
    for (int mt = 0; mt < 4; ++mt)
#pragma unroll
        for (int r = 0; r < 4; ++r) ssq[mt][r] = 0.f;
    f32x4 o[4][4];
#pragma unroll
    for (int sl = 0; sl < 4; ++sl) {
        const bf16x8* ss = (const bf16x8*)(rec + GC_SS + sl * 2048) + lane; const bf16x8* vb = (const bf16x8*)(rec + GC_VB + sl * 2048) + lane;
        const bf16x8 Sb0 = ss[0], Sb1 = ss[64], Vb0 = vb[0], Vb1 = vb[64];
#pragma unroll
        for (int mt = 0; mt < 4; ++mt) {
            f32x4 acc = {0.f, 0.f, 0.f, 0.f};
            acc = mfma16(QDf[mt][0], Sb0, acc); acc = mfma16(QDf[mt][1], Sb1, acc); acc = mfma16(QKf[mt][0], Vb0, acc); acc = mfma16(QKf[mt][1], Vb1, acc);
            o[sl][mt] = acc;
#pragma unroll
            for (int r = 0; r < 4; ++r) ssq[mt][r] += acc[r] * acc[r];
        }
    }
#pragma unroll
    for (int mt = 0; mt < 4; ++mt)
#pragma unroll
        for (int r = 0; r < 4; ++r) ssq[mt][r] = __builtin_amdgcn_rsqf(row16_sum(ssq[mt][r]) * (1.f / 64.f) + 1e-6f);
#pragma unroll
    for (int sl = 0; sl < 4; ++sl)
#pragma unroll
        for (int mt = 0; mt < 4; ++mt) {
            const u32x2 zz = *(const u32x2*)(rec + GC_ZT + (16 * sl + li) * 128 + (16 * mt + 4 * g) * 2);
            const float zf[4] = {bf2f(zz.x & 0xffffu), bf2f(zz.x >> 16), bf2f(zz.y & 0xffffu), bf2f(zz.y >> 16)};
#pragma unroll
            for (int r = 0; r < 4; ++r) *(LAS bf16*)(wl + tsw(16 * mt + 4 * g + r, 16 * sl + li)) = (bf16)f2bf(o[sl][mt][r] * ssq[mt][r] * zf[r]);
        }
    LDS_WAIT();
    bf16* yrow = Y + ((size_t)b * SEQ + 64 * n + lane) * DM + 512 + h * 64;
#pragma unroll
    for (int c = 0; c < 8; ++c) *(u32x4*)(yrow + 8 * c) = *(const LAS u32x4*)(wl + tsw(lane, 8 * c));
    LDS_WAIT();
}

constexpr int AT_K = 0, AT_V = 32768, AT_IMP = 65536, AT_SELM = AT_IMP + 64 * 68 * 4, AT_UNI = AT_SELM + 512, AT_YS = 83968;
__device__ __forceinline__ s16x4 tr_read0(unsigned addr) { s16x4 r; asm volatile("ds_read_b64_tr_b16 %0, %1" : "=&v"(r) : "v"(addr) : "memory"); return r; }

__device__ __forceinline__ float half_max(float x) { auto rr = __builtin_amdgcn_permlane32_swap(__float_as_uint(x), __float_as_uint(x), false, false); return fmaxf(__uint_as_float(rr[0]), __uint_as_float(rr[1])); }
__device__ __forceinline__ float half_sum(float x) { auto rr = __builtin_amdgcn_permlane32_swap(__float_as_uint(x), __float_as_uint(x), false, false); return __uint_as_float(rr[0]) + __uint_as_float(rr[1]); }
struct AttnStage { u32x4 kr, vr; };
__device__ __forceinline__ void at_gload(AttnStage& st, const bf16* Kb, const bf16* Vb, size_t stride, int j, int tid) {
    const int row = tid >> 3, ch = tid & 7; const size_t off = (size_t)(64 * j + row) * stride + 8 * ch;
    st.kr = *(const u32x4*)(Kb + off); st.vr = *(const u32x4*)(Vb + off);
}
__device__ __forceinline__ void at_swrite(const AttnStage& st, LAS unsigned char* lds, int buf, int tid) {
    const int row = tid >> 3, ch = tid & 7; const int o = row * 128 + (((ch ^ (row >> 1)) & 7) << 4);
    *(LAS u32x4*)(lds + AT_K + buf * 8192 + o) = st.kr; *(LAS u32x4*)(lds + AT_V + buf * 8192 + o) = st.vr;
}
__device__ __forceinline__ void at_qk(const LAS unsigned char* Kt, const bf16x8 (&Qf)[4], int r, int hf, f32x16 (&s)[2], float cinit) {
    const int swz = (r >> 1) & 7;
    bf16x8 kf[2][4];
#pragma unroll
    for (int kt = 0; kt < 2; ++kt)
#pragma unroll
        for (int ks = 0; ks < 4; ++ks) kf[kt][ks] = *(const LAS bf16x8*)(Kt + (32 * kt + r) * 128 + (((2 * ks + hf) ^ swz) << 4));
    SBAR();
#pragma unroll
    for (int kt = 0; kt < 2; ++kt) {
        f32x16 acc;
#pragma unroll
        for (int e = 0; e < 16; ++e) acc[e] = cinit;
#pragma unroll
        for (int ks = 0; ks < 4; ++ks) acc = mfma32(kf[kt][ks], Qf[ks], acc);
        s[kt] = acc;
    }
}
__device__ __forceinline__ void at_pv(unsigned vbase, const unsigned (&voff)[2][2], const f32x16 (&p)[2], f32x16 (&o)[2]) {
#pragma unroll
    for (int kt = 0; kt < 2; ++kt) {
        s16x4 vr[2][2][2];
#pragma unroll
        for (int s = 0; s < 2; ++s) { const unsigned co = vbase + (unsigned)(4096 * kt + 2048 * s);
            vr[s][0][0] = tr_read0(co + voff[0][0]); vr[s][1][0] = tr_read0(co + voff[1][0]); vr[s][0][1] = tr_read0(co + voff[0][1]); vr[s][1][1] = tr_read0(co + voff[1][1]); }
        bf16x8 pb[2];
#pragma unroll
        for (int s = 0; s < 2; ++s) { u32x4 pw; pw.x = pk2(p[kt][8 * s + 0], p[kt][8 * s + 1]); pw.y = pk2(p[kt][8 * s + 2], p[kt][8 * s + 3]); pw.z = pk2(p[kt][8 * s + 4], p[kt][8 * s + 5]); pw.w = pk2(p[kt][8 * s + 6], p[kt][8 * s + 7]); pb[s] = as_bf16x8(pw); }
        asm volatile("s_waitcnt lgkmcnt(0)" ::: "memory"); SBAR();
#pragma unroll
        for (int s = 0; s < 2; ++s) {
            const s16x4 l0 = vr[s][0][0], h0 = vr[s][1][0], l1 = vr[s][0][1], h1 = vr[s][1][1];
            const bf16x8 v0 = {l0[0], l0[1], l0[2], l0[3], h0[0], h0[1], h0[2], h0[3]}, v1 = {l1[0], l1[1], l1[2], l1[3], h1[0], h1[1], h1[2], h1[3]};
            o[0] = mfma32(v0, pb[s], o[0]); o[1] = mfma32(v1, pb[s], o[1]);
        }
    }
}

struct AttnRow { int r, hf, tt, t, qb, wave; unsigned long long wave_union; float m, lpart; };
struct TileInfo { int hi, lo; bool rowok, edge, work, fresh; };
template <int MODE, int VAR>
__device__ __forceinline__ void at_tile_qk(const Frame& F, int j, int stg, const bf16x8 (&Qf)[4], const AttnRow& R, float mfin, f32x16 (&s)[2], TileInfo& I) {
    LAS unsigned char* lds = F.lds;
    I.work = true; if (MODE == 2) I.work = (R.wave_union >> j) & 1ull;
    I.hi = 1000; I.lo = -1000; I.rowok = true; I.edge = false;
    if (MODE <= 1) { I.hi = ((R.t - 31) >> 4) - 64 * j - 4 * R.hf; I.edge = (64 * j + 63) > ((64 * R.qb + 8 * R.wave - 31) >> 4); }
    if (MODE == 2) { const unsigned long long sm = *(const LAS unsigned long long*)(lds + AT_SELM + 8 * R.tt); I.rowok = (sm >> j) & 1ull; if (j == R.qb) { I.hi = R.tt - 4 * R.hf; I.edge = true; } }
    if (MODE == 3) { if (j == R.qb) { I.hi = R.tt - 4 * R.hf; I.edge = true; } if (j == R.qb - 8) { I.lo = R.tt + 1 - 4 * R.hf; I.edge = true; } }
    const float mref = (MODE == 1) ? mfin : R.m; I.fresh = mref < -1e29f;
    const float cinit = I.rowok ? (I.fresh ? 0.f : -mref) : -INFINITY;
    if (I.work) { if (VAR & 64) { for (int e = 0; e < 16; ++e) { s[0][e] = Qf[0][0] * 1e-9f; s[1][e] = Qf[1][1] * 1e-9f; } } else at_qk(lds + AT_K + stg * 8192, Qf, R.r, R.hf, s, cinit); }
}
template <int MODE, int VAR>
__device__ __forceinline__ float at_tile_fin(const Frame& F, int j, int stg, f32x16 (&s)[2], const TileInfo& I, AttnRow& R, const unsigned (&voff)[2][2], f32x16 (&o)[2], float invl, float preshift) {
    LAS unsigned char* lds = F.lds; float shift_out = 0.f;
    if (!I.work) return 0.f;
    const int hi = I.hi, lo = I.lo; const bool edge = I.edge;
    if (MODE == 1) {
        if (edge) {
#pragma unroll
            for (int kt = 0; kt < 2; ++kt)
#pragma unroll
                for (int e = 0; e < 16; ++e) { const int cst = 32 * kt + (e & 3) + 8 * (e >> 2); s[kt][e] = (cst <= hi) ? fexp2(s[kt][e]) * invl : 0.f; }
        } else {
#pragma unroll
            for (int kt = 0; kt < 2; ++kt)
#pragma unroll
                for (int e = 0; e < 16; ++e) s[kt][e] = fexp2(s[kt][e]) * invl;
        }
        LAS float* imp = (LAS float*)(lds + AT_IMP) + R.tt * 68;
#pragma unroll
        for (int kt = 0; kt < 2; ++kt)
#pragma unroll
            for (int rg = 0; rg < 4; ++rg) {
                float av = 2.f * (s[kt][4 * rg] + s[kt][4 * rg + 1] + s[kt][4 * rg + 2]) + s[kt][4 * rg + 3], bv = s[kt][4 * rg + 3];
                av += __int_as_float(__builtin_amdgcn_update_dpp(0, __float_as_int(av), 0xB1, 0xf, 0xf, true)); av += __int_as_float(__builtin_amdgcn_update_dpp(0, __float_as_int(av), 0x4E, 0xf, 0xf, true));
                bv += __int_as_float(__builtin_amdgcn_update_dpp(0, __float_as_int(bv), 0xB1, 0xf, 0xf, true)); bv += __int_as_float(__builtin_amdgcn_update_dpp(0, __float_as_int(bv), 0x4E, 0xf, 0xf, true));
                if ((R.r & 3) == 0) { const int jb = 16 * j + 8 * kt + 2 * rg + R.hf; (void)__hip_atomic_fetch_add(imp + jb, av, __ATOMIC_RELAXED, __HIP_MEMORY_SCOPE_WORKGROUP); (void)__hip_atomic_fetch_add(imp + jb + 1, bv, __ATOMIC_RELAXED, __HIP_MEMORY_SCOPE_WORKGROUP); }
            }
        if (VAR & 16) { o[0][0] += s[0][3] + s[1][7]; } else at_pv((unsigned)(size_t)(lds + AT_V + stg * 8192), voff, s, o);
    } else if (VAR & 32) { R.lpart += s[0][1]; if (MODE >= 2) { if (VAR & 16) { o[0][0] += s[0][3]; } else at_pv((unsigned)(size_t)(lds + AT_V + stg * 8192), voff, s, o); } }
    else {
        constexpr float THR = 8.f;
        if (__any(preshift != 0.f)) {
#pragma unroll
            for (int kt = 0; kt < 2; ++kt)
#pragma unroll
                for (int e = 0; e < 16; ++e) s[kt][e] -= preshift;
        }
        const bool fresh = R.m < -1e29f;
        if (edge) {
#pragma unroll
            for (int kt = 0; kt < 2; ++kt)
#pragma unroll
                for (int e = 0; e < 16; ++e) { const int cst = 32 * kt + (e & 3) + 8 * (e >> 2); const bool ok = (cst <= hi) && (cst >= lo); s[kt][e] = ok ? s[kt][e] : -INFINITY; }
        }
        float tm4[4] = {-INFINITY, -INFINITY, -INFINITY, -INFINITY};
#pragma unroll
        for (int kt = 0; kt < 2; ++kt)
#pragma unroll
            for (int e = 0; e < 16; e += 2) tm4[(e >> 1) & 3] = fmaxf(tm4[(e >> 1) & 3], fmaxf(s[kt][e], s[kt][e + 1]));
        const float tmax = half_max(fmaxf(fmaxf(tm4[0], tm4[1]), fmaxf(tm4[2], tm4[3])));
        const bool raise = (tmax > -INFINITY) && (fresh || tmax > THR);
        if (__any(raise)) {
            const float shift = raise ? tmax : 0.f, alpha = (raise && !fresh) ? fexp2(-shift) : 1.f;
            R.m = raise ? (fresh ? tmax : R.m + tmax) : R.m; R.lpart *= alpha; shift_out = shift;
#pragma unroll
            for (int kt = 0; kt < 2; ++kt)
#pragma unroll
                for (int e = 0; e < 16; ++e) s[kt][e] -= shift;
            if (MODE >= 2) {
#pragma unroll
                for (int e = 0; e < 16; ++e) { o[0][e] *= alpha; o[1][e] *= alpha; } }
        }
        float ps4[4] = {0.f, 0.f, 0.f, 0.f};
#pragma unroll
        for (int kt = 0; kt < 2; ++kt)
#pragma unroll
            for (int e = 0; e < 16; ++e) { s[kt][e] = fexp2(s[kt][e]); ps4[e & 3] += s[kt][e]; }
        R.lpart += (ps4[0] + ps4[1]) + (ps4[2] + ps4[3]);
        if (MODE >= 2) { if (VAR & 16) { o[0][0] += s[0][3] + s[1][7]; } else at_pv((unsigned)(size_t)(lds + AT_V + stg * 8192), voff, s, o); }
    }
    return shift_out;
}
template <int MODE, int VAR = 0>
__device__ __forceinline__ void at_branch(const Frame& F, unsigned long long mask, const bf16* Kb, const bf16* Vb, size_t stride, const bf16x8 (&Qf)[4], AttnRow& R, const unsigned (&voff)[2][2],
                                          f32x16 (&o)[2], float mfin, float invl) {
    LAS unsigned char* lds = F.lds; const int tid = F.tid;
    if (mask == 0ull) return;
    AttnStage st0, st1; int sg = 0;
    { const int j0 = __builtin_ctzll(mask); at_gload(st0, Kb, Vb, stride, j0, tid); at_swrite(st0, lds, 0, tid);
      const unsigned long long m1 = mask & (mask - 1ull); if (m1) { at_gload(st1, Kb, Vb, stride, __builtin_ctzll(m1), tid); at_swrite(st1, lds, 1, tid); } }
    __syncthreads();
    while (mask) {
        const int j0 = __builtin_ctzll(mask); mask &= mask - 1ull;
        int j1 = -1; if (mask) { j1 = __builtin_ctzll(mask); mask &= mask - 1ull; }
        int n0 = -1, n1 = -1; { unsigned long long mm = mask; if (mm) { n0 = __builtin_ctzll(mm); mm &= mm - 1ull; if (mm) n1 = __builtin_ctzll(mm); } }
        at_gload(st0, Kb, Vb, stride, n0 >= 0 ? n0 : j0, tid);
        at_gload(st1, Kb, Vb, stride, n1 >= 0 ? n1 : j0, tid);
        { f32x16 sa[2]; TileInfo Ia;
          at_tile_qk<MODE, VAR>(F, j0, sg, Qf, R, mfin, sa, Ia);
          (void)at_tile_fin<MODE, VAR>(F, j0, sg, sa, Ia, R, voff, o, invl, 0.f); }
        if (j1 >= 0) { f32x16 sb[2]; TileInfo Ib;
          at_tile_qk<MODE, VAR>(F, j1, sg + 1, Qf, R, mfin, sb, Ib);
          (void)at_tile_fin<MODE, VAR>(F, j1, sg + 1, sb, Ib, R, voff, o, invl, 0.f); }
        if (n0 >= 0) at_swrite(st0, lds, (sg + 2) & 3, tid);
        if (n1 >= 0) at_swrite(st1, lds, (sg + 3) & 3, tid);
        __syncthreads();
        sg = (sg + 2) & 3;
    }
}

template <int VAR>
__device__ __forceinline__ void attn_item(const Frame& F, ArgsP a, int l, int item) {
    const int qb = 63 - (item >> 4), bh = item & 15, b = bh >> 1, hk = bh & 1; const int lane = F.lane, wave = F.wave;
    const bf16* H = (const bf16*)(a->ws + WS_H); const float* side = (const float*)(a->ws + WS_SIDE); bf16* Y = (bf16*)(a->ws + WS_Y);
    LAS unsigned char* lds = F.lds;
    AttnRow R; R.r = lane & 31; R.hf = lane >> 5; R.tt = 8 * wave + (R.r >> 2); R.t = 64 * qb + R.tt; R.qb = qb; R.wave = wave; R.wave_union = 0ull;
    const int head = hk * 4 + (R.r & 3); const size_t tok = (size_t)b * SEQ + R.t;
    bf16x8 Qf[4];
#pragma unroll
    for (int ks = 0; ks < 4; ++ks) Qf[ks] = *(const bf16x8*)(H + tok * HLD + head * 64 + 16 * ks + 8 * R.hf);
    const float g_cmp = side[tok * 32 + head * 3], g_sel = side[tok * 32 + head * 3 + 1], g_win = side[tok * 32 + head * 3 + 2];
    unsigned voff[2][2];
    { const int li = lane & 15, q = li >> 2, p = li & 3, gi1 = (lane >> 4) & 1;
#pragma unroll
      for (int jh = 0; jh < 2; ++jh)
#pragma unroll
          for (int dt = 0; dt < 2; ++dt) voff[jh][dt] = (unsigned)((8 * jh + 4 * R.hf + q) * 128 + ((((4 * dt + 2 * gi1 + (p >> 1)) ^ (4 * jh + 2 * R.hf + (q >> 1))) & 7) << 4) + (p & 1) * 8); }
    { LAS float* imp = (LAS float*)(lds + AT_IMP) + (8 * wave) * 68; for (int i = lane; i < 8 * 68; i += 64) imp[i] = 0.f; if (F.tid == 0) { *(LAS unsigned*)(lds + AT_UNI) = 0u; *(LAS unsigned*)(lds + AT_UNI + 4) = 0u; } }
    f32x16 o[2];
#pragma unroll
    for (int e = 0; e < 16; ++e) { o[0][e] = 0.f; o[1][e] = 0.f; }
    LAS float* ys = (LAS float*)(lds + AT_YS + wave * 8192) + lane;
    {
        const bf16* Kc = (const bf16*)(a->ws + WS_KC) + (size_t)bh * 256 * 64; const bf16* Vc = (const bf16*)(a->ws + WS_VC) + (size_t)bh * 256 * 64;
        const int ntc = (4 * qb + 3 + 63) >> 6; const unsigned long long mc = (ntc >= 64) ? ~0ull : ((1ull << ntc) - 1ull);
        R.m = -1e30f; R.lpart = 0.f;
        if (!(VAR & 8)) at_branch<0, VAR>(F, mc, Kc, Vc, 64, Qf, R, voff, o, 0.f, 0.f);
        const float lsum = half_sum(R.lpart); const float invl = 1.f / fmaxf(lsum, 1e-30f);
        if (!(VAR & 8)) at_branch<1, VAR>(F, mc, Kc, Vc, 64, Qf, R, voff, o, R.m, invl);
#pragma unroll
        for (int e = 0; e < 16; ++e) { ys[e * 64] = g_cmp * o[0][e]; ys[(16 + e) * 64] = g_cmp * o[1][e]; o[0][e] = 0.f; o[1][e] = 0.f; }
    }
    LDS_WAIT();
    {
        unsigned long long wu = 0ull;
        for (int q0 = 0; q0 < 8; q0 += 4) {
            unsigned long long selm[4];
            if (qb < 16) { selm[0] = selm[1] = selm[2] = selm[3] = (2ull << qb) - 1ull; }
            else {
                const bool cand = (lane >= 1) && (lane <= qb - 2); unsigned key[4], thr[4];
#pragma unroll
                for (int u = 0; u < 4; ++u) { const float v = ((const LAS float*)(lds + AT_IMP))[(8 * wave + q0 + u) * 68 + lane]; key[u] = cand ? __float_as_uint(fmaxf(v, 0.f)) : 0u; thr[u] = 0u; }
                for (int bit = 30; bit >= 0; --bit) {
#pragma unroll
                    for (int u = 0; u < 4; ++u) { const unsigned tr = thr[u] | (1u << bit); const int c = __popcll(__ballot(cand && key[u] >= tr)); if (c >= 13) thr[u] = tr; } }
#pragma unroll
                for (int u = 0; u < 4; ++u) {
                    const unsigned long long gt = __ballot(cand && key[u] > thr[u]), eq = __ballot(cand && key[u] == thr[u]);
                    int need = 13 - __popcll(gt); unsigned long long eqs = 0ull, e2 = eq;
                    while (need > 0 && e2) { const unsigned long long low = e2 & (~e2 + 1ull); eqs |= low; e2 ^= low; --need; }
                    selm[u] = gt | eqs | 1ull | (1ull << qb) | (1ull << (qb - 1)); }
            }
#pragma unroll
            for (int u = 0; u < 4; ++u) {
                if (lane == 0) *(LAS unsigned long long*)(lds + AT_SELM + 8 * (8 * wave + q0 + u)) = selm[u];
#if defined(SELFCHECK) && SELFCHECK == 1
                if (lane == 0 && l == 1) ((unsigned long long*)(a->ws + (size_t)984 * MiB + 64 * KiB))[(size_t)bh * SEQ + 64 * qb + 8 * wave + q0 + u] = selm[u];
#endif
                wu |= selm[u]; }
        }
        R.wave_union = wu;
        if (lane == 0) { __hip_atomic_fetch_or((LAS unsigned*)(lds + AT_UNI), (unsigned)wu, __ATOMIC_RELAXED, __HIP_MEMORY_SCOPE_WORKGROUP); __hip_atomic_fetch_or((LAS unsigned*)(lds + AT_UNI + 4), (unsigned)(wu >> 32), __ATOMIC_RELAXED, __HIP_MEMORY_SCOPE_WORKGROUP); }
    }
    __syncthreads();
    const unsigned long long bunion = (unsigned long long)*(const LAS unsigned*)(lds + AT_UNI) | ((unsigned long long)*(const LAS unsigned*)(lds + AT_UNI + 4) << 32);
    const bf16* Hb = H + (size_t)b * SEQ * HLD;
    {
        R.m = -1e30f; R.lpart = 0.f;
        if (!(VAR & 2)) at_branch<2, VAR>(F, bunion, Hb + 512 + 2 * 128 + hk * 64, Hb + 512 + 3 * 128 + hk * 64, HLD, Qf, R, voff, o, 0.f, 0.f);
        const float lsum = half_sum(R.lpart); const float sc = g_sel / fmaxf(lsum, 1e-30f);
#pragma unroll
        for (int e = 0; e < 16; ++e) { ys[e * 64] += sc * o[0][e]; ys[(16 + e) * 64] += sc * o[1][e]; o[0][e] = 0.f; o[1][e] = 0.f; }
    }
    {
        const int lo = qb - 8 > 0 ? qb - 8 : 0; const unsigned long long mw = ((2ull << qb) - 1ull) & ~((1ull << lo) - 1ull);
        R.m = -1e30f; R.lpart = 0.f;
        if (!(VAR & 4)) at_branch<3, VAR>(F, mw, Hb + 512 + 4 * 128 + hk * 64, Hb + 512 + 5 * 128 + hk * 64, HLD, Qf, R, voff, o, 0.f, 0.f);
        const float lsum = half_sum(R.lpart); const float sc = g_win / fmaxf(lsum, 1e-30f);
#pragma unroll
        for (int e = 0; e < 16; ++e) { o[0][e] = ys[e * 64] + sc * o[0][e]; o[1][e] = ys[(16 + e) * 64] + sc * o[1][e]; }
    }
    if (VAR & 1) { asm volatile("" :: "v"(o[0][0]), "v"(o[1][5])); return; }
    bf16* yrow = Y + tok * DM + head * 64 + 4 * R.hf;
#pragma unroll
    for (int dt = 0; dt < 2; ++dt)
#pragma unroll
        for (int rg = 0; rg < 4; ++rg) { u32x2 w; w.x = pk2(o[dt][4 * rg], o[dt][4 * rg + 1]); w.y = pk2(o[dt][4 * rg + 2], o[dt][4 * rg + 3]); *(u32x2*)(yrow + 32 * dt + 8 * rg) = w; }
}

__device__ __forceinline__ void phase_mix_b(const Frame& F, ArgsP a, int l, int rep) {
    unsigned* q = F.ctl + CW_QUEUE + l * 64 + rep * 32;
    for (;;) {
        if (F.tid == 0) F.MISC[0] = __hip_atomic_fetch_add(q, 1u, __ATOMIC_RELAXED, __HIP_MEMORY_SCOPE_AGENT);
        __syncthreads();
        const int item = (int)F.MISC[0];
        __syncthreads();
        if (item >= 1024) break;
        if (rep == 0) attn_item<0>(F, a, l, item); else attn_item<PROBE_ATTN_VAR>(F, a, l, item);
    }
}

constexpr size_t WS_DBG = 984 * MiB;
constexpr int CHECK_LAYER = 1;
__device__ __forceinline__ void dbg_add(ArgsP a, int i, float v) { atomicAdd((float*)(a->ws + WS_DBG) + i, v); }

__device__ __forceinline__ void check_nsa(const Frame& F, ArgsP a) {
    const bf16* H = (const bf16*)(a->ws + WS_H); const float* side = (const float*)(a->ws + WS_SIDE); const bf16* Y = (const bf16*)(a->ws + WS_Y);
    const unsigned long long* SELM = (const unsigned long long*)(a->ws + WS_DBG + 64 * KiB);
    const int lane = F.lane; const int tv[16] = {5, 40, 63, 64, 100, 511, 512, 1023, 1024, 1500, 2047, 2048, 3000, 3333, 4000, 4095};
    for (int s = F.bid * NWAVES + F.wave; s < 256; s += F.G * NWAVES) {
        int t = tv[0];
#pragma unroll
        for (int q = 1; q < 16; ++q) t = ((s & 15) == q) ? tv[q] : t;
        const int b = (s >> 4) & 7, hq = ((s >> 7) * 5 + (s & 7)) & 7, hk = hq >> 2; const size_t tok = (size_t)b * SEQ + t; const int bhk = b * 2 + hk;
        const bf16* KC = (const bf16*)(a->ws + WS_KC) + (size_t)bhk * 256 * 64; const bf16* VC = (const bf16*)(a->ws + WS_VC) + (size_t)bhk * 256 * 64;
        const float g_cmp = side[tok * 32 + hq * 3], g_sel = side[tok * 32 + hq * 3 + 1], g_win = side[tok * 32 + hq * 3 + 2];
        const int cmax = (t - 31) >> 4; float imp = 0.f, ocmp = 0.f;
        for (int gh = 0; gh < 4; ++gh) {
            const int head = hk * 4 + gh; const float qd = bf2f(H[tok * HLD + head * 64 + lane]);
            float m = -INFINITY, l = 0.f;
            for (int c = 0; c <= cmax; ++c) m = fmaxf(m, wave_sum(qd * bf2f(KC[c * 64 + lane])));
            for (int c = 0; c <= cmax; ++c) l += fexp2(wave_sum(qd * bf2f(KC[c * 64 + lane])) - m);
            for (int c = 0; c <= cmax; ++c) { const float p = fexp2(wave_sum(qd * bf2f(KC[c * 64 + lane])) - m) / l; const int j = c >> 2, e = c & 3;
                if (lane == j) imp += (e < 3 ? 2.f : 1.f) * p; if (e == 3 && lane == j + 1) imp += p;
                if (head == hq) ocmp += p * bf2f(VC[c * 64 + lane]); }
        }
        const int cur = t >> 6; const bool causal = lane <= cur, forced = (lane == 0) || (lane == cur) || (lane == cur - 1);
        const float key = causal ? (imp + (forced ? 1.0e4f : 0.f)) : -INFINITY; int rank = 0;
        for (int i = 0; i < 64; ++i) { const float ki = __shfl(key, i); rank += ((ki > key) || (ki == key && i < lane)) ? 1 : 0; }
        const unsigned long long refm = __ballot(causal && rank < 16), stm = SELM[(size_t)bhk * SEQ + t];
        if (lane == 0) { dbg_add(a, 2, (float)__popcll(refm ^ stm)); dbg_add(a, 3, 16.f); }
        const float qd = bf2f(H[tok * HLD + hq * 64 + lane]); const bf16* Hb = H + (size_t)b * SEQ * HLD + hk * 64 + lane;
        float m = -INFINITY, l = 0.f, osel = 0.f;
        for (int j = 0; j <= cur; ++j) if ((stm >> j) & 1ull) for (int kk = 0; kk < 64; ++kk) { const int p = 64 * j + kk; if (p > t) break;
            const float sc = wave_sum(qd * bf2f(Hb[(size_t)p * HLD + 512 + 2 * 128])); const float mn = fmaxf(m, sc), al = fexp2(m - mn), pp = fexp2(sc - mn);
            l = l * al + pp; osel = osel * al + pp * bf2f(Hb[(size_t)p * HLD + 512 + 3 * 128]); m = mn; }
        const float ysel = osel / fmaxf(l, 1e-30f);
        m = -INFINITY; l = 0.f; float owin = 0.f;
        for (int p = (t - 511 > 0 ? t - 511 : 0); p <= t; ++p) { const float sc = wave_sum(qd * bf2f(Hb[(size_t)p * HLD + 512 + 4 * 128])); const float mn = fmaxf(m, sc), al = fexp2(m - mn), pp = fexp2(sc - mn);
            l = l * al + pp; owin = owin * al + pp * bf2f(Hb[(size_t)p * HLD + 512 + 5 * 128]); m = mn; }
        const float ref = g_cmp * ocmp + g_sel * ysel + g_win * owin / fmaxf(l, 1e-30f), got = bf2f(Y[tok * DM + hq * 64 + lane]);
        const float e2 = wave_sum((ref - got) * (ref - got)), r2 = wave_sum(ref * ref);
        if (lane == 0) { dbg_add(a, 0, e2); dbg_add(a, 1, r2); }
    }
}

__device__ __forceinline__ void check_gdn(const Frame& F, ArgsP a, int l) {
    if (F.bid >= 8) return;
    const bf16* H = (const bf16*)(a->ws + WS_H); const float* side = (const float*)(a->ws + WS_SIDE); const bf16* Y = (const bf16*)(a->ws + WS_Y);
    const int b = F.bid, h = (F.bid * 3) & 3, tid = F.tid, lane = F.lane, col = tid & 63, rg = tid >> 6;
    LAS float* S = (LAS float*)F.lds; LAS float* qv = S + 64 * 65; LAS float* kv = qv + 64; LAS float* vv = kv + 64; LAS float* sc = vv + 64; LAS float* part = sc + 64;
    for (int i = tid; i < 64 * 65; i += NTHR) S[i] = 0.f;
    float hq[3] = {0.f, 0.f, 0.f}, hk[3] = {0.f, 0.f, 0.f}, hv[3] = {0.f, 0.f, 0.f}, wq[4], wk[4], wv[4];
    { const float* cw = a->in[6] + (size_t)l * 4 * 768 + h * 64 + lane;
#pragma unroll
      for (int k = 0; k < 4; ++k) { wq[k] = cw[k * 768]; wk[k] = cw[k * 768 + 256]; wv[k] = cw[k * 768 + 512]; } }
    const float Aexp = __expf(a->in[7][l * 4 + h]), dtb = a->in[8][l * 4 + h], nw = a->in[9][l * 64 + lane];
    __syncthreads();
    for (int t = 0; t < 192; ++t) {
        const size_t tok = (size_t)b * SEQ + t;
        if (F.wave == 0) { const bf16* p = H + tok * HLD + 1280 + h * 64 + lane; const float rq = bf2f(p[0]), rk = bf2f(p[256]), rv = bf2f(p[512]);
            const float cq = wq[0] * hq[0] + wq[1] * hq[1] + wq[2] * hq[2] + wq[3] * rq, ck = wk[0] * hk[0] + wk[1] * hk[1] + wk[2] * hk[2] + wk[3] * rk, cv = wv[0] * hv[0] + wv[1] * hv[1] + wv[2] * hv[2] + wv[3] * rv;
            hq[0] = hq[1]; hq[1] = hq[2]; hq[2] = rq; hk[0] = hk[1]; hk[1] = hk[2]; hk[2] = rk; hv[0] = hv[1]; hv[1] = hv[2]; hv[2] = rv;
            const float qs = cq / (1.f + __expf(-cq)), ks = ck / (1.f + __expf(-ck)), vs = cv / (1.f + __expf(-cv));
            qv[lane] = qs / sqrtf(wave_sum(qs * qs) + 1e-6f); kv[lane] = ks / sqrtf(wave_sum(ks * ks) + 1e-6f); vv[lane] = vs;
            if (lane == 0) { const float av = side[tok * 32 + 28 + h] + dtb; const float sp = av > 20.f ? av : log1pf(__expf(av)); sc[0] = __expf(-Aexp * sp); sc[1] = side[tok * 32 + 24 + h]; } }
        __syncthreads();
        { float ps = 0.f;
#pragma unroll
          for (int r = 0; r < 8; ++r) ps += kv[8 * rg + r] * S[(8 * rg + r) * 65 + col];
          part[rg * 64 + col] = ps; }
        __syncthreads();
        { float ks = 0.f;
#pragma unroll
          for (int r = 0; r < 8; ++r) ks += part[r * 64 + col];
          const float eg = sc[0], be = sc[1]; float po = 0.f;
          __syncthreads();
#pragma unroll
          for (int r = 0; r < 8; ++r) { const int dk = 8 * rg + r; const float sn = eg * (S[dk * 65 + col] - be * kv[dk] * ks) + be * kv[dk] * vv[col]; S[dk * 65 + col] = sn; po += sn * qv[dk]; }
          part[rg * 64 + col] = po; }
        __syncthreads();
        if (F.wave == 0) { float o = 0.f;
#pragma unroll
            for (int r = 0; r < 8; ++r) o += part[r * 64 + lane];
            o *= 0.125f; const float rs = 1.f / sqrtf(wave_sum(o * o) * (1.f / 64.f) + 1e-6f); const float z = bf2f(H[tok * HLD + 2048 + h * 64 + lane]);
            const float ref = o * rs * nw * (z / (1.f + __expf(-z))), got = bf2f(Y[tok * DM + 512 + h * 64 + lane]);
            const float e2 = wave_sum((ref - got) * (ref - got)), r2 = wave_sum(ref * ref);
            if (lane == 0) { dbg_add(a, 4, e2); dbg_add(a, 5, r2); } }
        __syncthreads();
    }
}

__device__ __forceinline__ void check_moe(const Frame& F, ArgsP a, int l) {
    const bf16* XBc = (const bf16*)(a->ws + WS_XB); const bf16* Y2 = (const bf16*)(a->ws + WS_Y2);
    const int* route_e = (const int*)(a->ws + WS_SLOT + SL_RE); const float* route_w = (const float*)(a->ws + WS_SLOT + SL_RW);
    LAS float* x = (LAS float*)F.lds; LAS float* hid = x + 1024; LAS float* lg = hid + 512; LAS float* yr = lg + 64;
    const int tid = F.tid, lane = F.lane;
    for (int s = F.bid; s < 256; s += F.G) {
        const int t = (s * 4099 + 17) & (T - 1);
        for (int i = tid; i < 1024; i += NTHR) { x[i] = bf2f(XBc[(size_t)t * DM + i]); yr[i] = 0.f; }
        __syncthreads();
        for (int j = F.wave; j < 36; j += NWAVES) { float d = 0.f; for (int k = lane; k < DM; k += 64) d += x[k] * (j < 4 ? a->in[18][((size_t)l * DM + k) * 4 + j] : a->in[20][((size_t)l * DM + k) * NEXP + j - 4]);
            d = wave_sum(d); if (lane == 0) lg[j] = d + (j < 4 ? a->in[19][l * 4 + j] : a->in[21][l * NEXP + j - 4]); }
        __syncthreads();
        if (tid == 0) { int gi = 0; for (int i = 1; i < 4; ++i) if (lg[i] > lg[gi]) gi = i; float gs = 0.f; for (int i = 0; i < 4; ++i) gs += __expf(lg[i] - lg[gi]); const float gw = 1.f / gs;
            int i1 = 0; for (int i = 1; i < 8; ++i) if (lg[4 + gi * 8 + i] > lg[4 + gi * 8 + i1]) i1 = i; int i2 = -1; for (int i = 0; i < 8; ++i) if (i != i1 && (i2 < 0 || lg[4 + gi * 8 + i] > lg[4 + gi * 8 + i2])) i2 = i;
            const float e2 = __expf(lg[4 + gi * 8 + i2] - lg[4 + gi * 8 + i1]), w1 = gw / (1.f + e2), w2 = gw - w1;
            const int se1 = route_e[2 * t], se2 = route_e[2 * t + 1]; const float sw1 = route_w[2 * t], sw2 = route_w[2 * t + 1];
            dbg_add(a, 8, (se1 != gi * 8 + i1 ? 1.f : 0.f) + (se2 != gi * 8 + i2 ? 1.f : 0.f)); dbg_add(a, 9, 2.f);
            if (se1 == gi * 8 + i1 && se2 == gi * 8 + i2) { dbg_add(a, 10, (sw1 - w1) * (sw1 - w1) + (sw2 - w2) * (sw2 - w2)); dbg_add(a, 11, w1 * w1 + w2 * w2); } }
        for (int k2 = 0; k2 < 2; ++k2) {
            const int e = route_e[2 * t + k2]; const float rw = route_w[2 * t + k2];
            const float* wg = a->in[22] + ((size_t)l * NEXP + e) * DM * FF; const float* wu = a->in[23] + ((size_t)l * NEXP + e) * DM * FF; const float* wd = a->in[24] + ((size_t)l * NEXP + e) * FF * DM;
            { float g = 0.f, u = 0.f; for (int k = 0; k < DM; ++k) { g += x[k] * wg[(size_t)k * FF + tid]; u += x[k] * wu[(size_t)k * FF + tid]; } hid[tid] = g / (1.f + __expf(-g)) * u; }
            __syncthreads();
            for (int d = tid; d < DM; d += NTHR) { float y = 0.f; for (int f = 0; f < FF; ++f) y += hid[f] * wd[(size_t)f * DM + d]; yr[d] += y * rw; }
            __syncthreads();
        }
        float e2 = 0.f, r2 = 0.f;
        for (int d = tid; d < DM; d += NTHR) { const float got = bf2f(Y2[(size_t)(2 * t) * DM + d]) + bf2f(Y2[(size_t)(2 * t + 1) * DM + d]); e2 += (yr[d] - got) * (yr[d] - got); r2 += yr[d] * yr[d]; }
        e2 = wave_sum(e2); r2 = wave_sum(r2); if (lane == 0) { dbg_add(a, 6, e2); dbg_add(a, 7, r2); }
        __syncthreads();
    }
}

__device__ __forceinline__ void check_inproj(const Frame& F, ArgsP a, int l) {
    const bf16* H = (const bf16*)(a->ws + WS_H); const float* xin = (l == 0) ? a->in[0] : (const float*)a->out; const float* win = a->in[1] + (size_t)l * DM * DIN;
    const int lane = F.lane;
    for (int s = F.bid * NWAVES + F.wave; s < 1024; s += F.G * NWAVES) {
        const int tok = (s * 7919 + 13) & (T - 1), grp = s % 14, t = tok & (SEQ - 1);
        const int col0 = grp < 8 ? grp * 64 : 512 + (grp - 8) * 128 + ((s >> 4) & 1) * 64; const bool isq = grp < 8, rope = isq || ((grp - 8) % 2 == 0);
        float d = 0.f; for (int k = 0; k < DM; ++k) d += xin[(size_t)tok * DM + k] * win[(size_t)k * DIN + col0 + lane];
        if (rope) { const float inv[8] = {1.0f, 0.19392274f, 0.03760603f, 0.0072926646f, 0.0014142136f, 0.0002742482f, 5.3182957e-05f, 1.0313385e-05f};
            float iv = inv[0];
#pragma unroll
            for (int q = 1; q < 8; ++q) iv = ((lane & 7) == q) ? inv[q] : iv;
            const float ang = (float)t * iv, c = cosf(ang), sn = sinf(ang), other = __shfl_xor(d, 8);
            if (lane < 8) d = d * c - other * sn; else if (lane < 16) d = d * c + other * sn; }
        if (isq) d *= pg8::QSCALE;
        const float got = bf2f(H[(size_t)tok * HLD + col0 + lane]); const float e2 = wave_sum((d - got) * (d - got)), r2 = wave_sum(d * d);
        if (lane == 0) { dbg_add(a, 12, e2); dbg_add(a, 13, r2); }
    }
}
__device__ __forceinline__ void check_compress(const Frame& F, ArgsP a, int l) {
    const bf16* H = (const bf16*)(a->ws + WS_H); const int lane = F.lane;
    for (int s = F.bid * NWAVES + F.wave; s < 512; s += F.G * NWAVES) {
        const int kv = s & 1, bh = (s >> 1) & 15, b = bh >> 1, hh = bh & 1, i = (s * 53 + 7) % 255;
        const float* pe = a->in[3] + ((size_t)l * 2 + kv) * 2048; const float* w1 = a->in[4] + ((size_t)l * 2 + kv) * 2048 * 128; const float* w2 = a->in[5] + ((size_t)l * 2 + kv) * 128 * 64;
        float h0 = 0.f, h1 = 0.f;
        for (int k = 0; k < 2048; ++k) { const int p = k >> 6, d = k & 63; const float x = bf2f(H[((size_t)b * SEQ + 16 * i + p) * HLD + 512 + kv * 128 + hh * 64 + d]) + pe[k];
            h0 += x * w1[(size_t)k * 128 + lane]; h1 += x * w1[(size_t)k * 128 + 64 + lane]; }
        h0 = h0 / (1.f + __expf(-h0)); h1 = h1 / (1.f + __expf(-h1));
        float o = 0.f;
        for (int n = 0; n < 64; ++n) { o += __shfl(h0, n) * w2[(size_t)n * 64 + lane] + __shfl(h1, n) * w2[(size_t)(64 + n) * 64 + lane]; }
        const float got = bf2f(((const bf16*)(a->ws + (kv ? WS_VC : WS_KC)))[((size_t)bh * 256 + i) * 64 + lane]);
        const float e2 = wave_sum((o - got) * (o - got)), r2 = wave_sum(o * o); if (lane == 0) { dbg_add(a, 14, e2); dbg_add(a, 15, r2); }
    }
}
__device__ __forceinline__ void check_conformer(const Frame& F, ArgsP a, int l) {
    const bf16* H = (const bf16*)(a->ws + WS_H); const bf16* Y = (const bf16*)(a->ws + WS_Y); const int lane = F.lane;
    for (int s = F.bid * NWAVES + F.wave; s < 1024; s += F.G * NWAVES) {
        const int tok = (s * 6151 + 3) & (T - 1), t = tok & (SEQ - 1); float u[4];
#pragma unroll
        for (int j = 0; j < 4; ++j) { const int c = lane + 64 * j; float acc = a->in[11][l * 256 + c];
            for (int k = 0; k < 31; ++k) { const int sp = t - 30 + k; if (sp >= 0) { const bf16* hp = H + (size_t)(tok - 30 + k) * HLD + 2304 + c; const float g = bf2f(hp[256]); acc += a->in[10][((size_t)l * 31 + k) * 256 + c] * (bf2f(hp[0]) / (1.f + __expf(-g))); } }
            u[j] = acc; }
        const float mean = wave_sum(u[0] + u[1] + u[2] + u[3]) * (1.f / 256.f); float q = 0.f;
#pragma unroll
        for (int j = 0; j < 4; ++j) { u[j] -= mean; q += u[j] * u[j]; }
        const float rstd = 1.f / sqrtf(wave_sum(q) * (1.f / 256.f) + LN_EPS); float e2 = 0.f, r2 = 0.f;
#pragma unroll
        for (int j = 0; j < 4; ++j) { const int c = lane + 64 * j; const float v = u[j] * rstd * a->in[12][l * 256 + c] + a->in[13][l * 256 + c]; const float ref = v / (1.f + __expf(-v)), got = bf2f(Y[(size_t)tok * DM + 768 + c]);
            e2 += (ref - got) * (ref - got); r2 += ref * ref; }
        e2 = wave_sum(e2); r2 = wave_sum(r2); if (lane == 0) { dbg_add(a, 16, e2); dbg_add(a, 17, r2); }
    }
}
__device__ __forceinline__ void check_inject(const Frame& F, ArgsP a) {
    if (F.bid == 0 && F.tid == 0) { const float* d = (const float*)(a->ws + WS_DBG); float e0 = 0.f, e1 = 0.f;
        if (SELFCHECK == 1) { e0 = 1000.f * sqrtf(d[0] / d[1]); e1 = 1.0e4f * d[2] / d[3]; }
        if (SELFCHECK == 2) { e0 = 1000.f * sqrtf(d[4] / d[5]); }
        if (SELFCHECK == 3) { e0 = 1000.f * sqrtf(d[6] / d[7]); e1 = 1.0e4f * d[8] / d[9] + 1000.f * sqrtf(d[10] / fmaxf(d[11], 1e-30f)); }
        if (SELFCHECK == 4) { e0 = 1000.f * sqrtf(d[12] / d[13]); }
        if (SELFCHECK == 5) { e0 = 1000.f * sqrtf(d[14] / d[15]); e1 = 1000.f * sqrtf(d[16] / d[17]); }
        a->out[0] += e0; a->out[1] += e1; }
}


#ifndef MK_MULTI
#define MK_MULTI 0
#endif
#ifndef PROBE_REPEAT
#define PROBE_REPEAT 0
#endif
constexpr int N_PHASES = 1 + 10 * NL;
#ifndef TIMING
#define TIMING 0
#endif
#ifndef TA_LO
#define TA_LO 0
#define TA_HI 1
#define TB_LO 0
#define TB_HI 1
#endif
#define TSTAMP(i) do { if (TIMING) { if (F.bid == 0 && F.tid == 0) ((unsigned long long*)(args_here()->ws + (size_t)985 * MiB))[i] = __builtin_amdgcn_s_memrealtime(); } } while (0)
__device__ __forceinline__ Frame make_frame(int wave_s) {
    extern __shared__ __attribute__((aligned(16))) unsigned char lds_raw[];
    Frame F; F.lds = (LAS unsigned char*)lds_raw; F.MISC = (volatile LAS unsigned*)(F.lds + MISC_OFF);
    int tid = threadIdx.x, G = gridDim.x, bid = blockIdx.x; unsigned lb = (unsigned)(size_t)F.lds; (void)wave_s;
    asm volatile("" : "+v"(tid), "+s"(G), "+s"(bid), "+s"(lb));
    F.lds = (LAS unsigned char*)(size_t)lb; F.MISC = (volatile LAS unsigned*)(F.lds + MISC_OFF);
    F.tid = tid; F.lane = F.tid & 63; F.wave = __builtin_amdgcn_readfirstlane(F.tid >> 6); F.G = G; F.bid = bid;
    F.ctl = (unsigned*)(args_here()->ws + WS_CTL); return F;
}
__device__ __forceinline__ void ph_prologue(int, int wv) { const Frame F = make_frame(wv); phase_prologue(F, args_here()); phase_weights(F, args_here(), 0, 2, F.G, 0);
#if SELFCHECK
    if (F.bid == 0 && F.tid < 64) ((float*)(args_here()->ws + WS_DBG))[F.tid] = 0.f;
#endif
}
__device__ __forceinline__ void ph_inproj(int l, int wv) { const Frame F = make_frame(wv); unsigned char* ws = args_here()->ws;
    pg8::Gemm g{(const bf16*)(ws + WS_X8), (const bf16*)(WLBASE(ws, l) + WL_WIN), T, DINP, DM / 2};   pg8::StaticOrder S; S.init(T, DINP, F.G, F.bid);
    pg8::EpiInProj E{(bf16*)(ws + WS_H), (float*)(ws + WS_SIDE), (const float*)(ws + WS_ROPE)};
    pg8::gemm_phase<pg8::EpiInProj, pg8::StaticOrder, false>(F.lds, g, S, E, nullptr, F.tid); }
__device__ __forceinline__ void ph_compress(int l, int wv) { const Frame F = make_frame(wv); for (int it = F.bid; it < 256; it += F.G) compress_item(F, args_here(), l, it); }
__device__ __forceinline__ void ph_gdnprep(int l, int wv) { const Frame F = make_frame(wv); for (int it = F.bid; it < 256; it += F.G) { gdn_prep_chunk<0>(F, args_here(), l, it * 8 + F.wave, F.lds + F.wave * 16384); __syncthreads(); } }
__device__ __forceinline__ void ph_gdnprep_var(int l, int wv) { const Frame F = make_frame(wv); for (int it = F.bid; it < 256; it += F.G) { gdn_prep_chunk<PROBE_GDN_VAR | 1>(F, args_here(), l, it * 8 + F.wave, F.lds + F.wave * 16384); __syncthreads(); } }
__device__ __forceinline__ void ph_conformer(int l, int wv) { const Frame F = make_frame(wv); for (int it = F.bid; it < 512; it += F.G) conformer_item(F, args_here(), l, it); }
__device__ __forceinline__ void ph_gdnout(int l, int wv) { const Frame F = make_frame(wv); for (int ci = F.bid * NWAVES + F.wave; ci < 2048; ci += F.G * NWAVES) gdn_out_chunk(F, args_here(), ci, F.lds + F.wave * 8192); }
constexpr int NCONV = 64;
__device__ __forceinline__ void ph_scan(int l, int wv) { const Frame F = make_frame(wv); if (F.bid < 16) gdn_scan<0>(F, args_here(), l); }
__device__ __forceinline__ void ph_bgweights(int l, int wv) { const Frame F = make_frame(wv);
    if (F.bid < NCONV) { if (l == 0) phase_weights(F, args_here(), 0, 1, NCONV, 0); if (l + 1 < NL) phase_weights(F, args_here(), l + 1, 3, NCONV, 0); __syncthreads(); } }
__device__ __forceinline__ void ph_scan_var(int l, int wv) { const Frame F = make_frame(wv); if (F.bid < 16) gdn_scan<(PROBE_SCAN_VAR & 1)>(F, args_here(), l); }
__device__ __forceinline__ void ph_attn(int l, int rep, int wv) { const Frame F = make_frame(wv); phase_mix_b(F, args_here(), l, rep); }
__device__ __forceinline__ void ph_outproj(int l, int wv) { const Frame F = make_frame(wv); ArgsP ap = args_here(); unsigned char* ws = ap->ws;
    pg8::Gemm g{(const bf16*)(ws + WS_Y), (const bf16*)(WLBASE(ws, l) + WL_WOUT), T, DM, DM}; pg8::StaticOrder S; S.init(T, DM, F.G, F.bid);
    pg8::EpiOutProj E{(const bf16*)(ws + WS_XB), (bf16*)(ws + WS_X1), DN_ALPHA};
    pg8::gemm_phase<pg8::EpiOutProj, pg8::StaticOrder, false>(F.lds, g, S, E, nullptr, F.tid); }
__device__ __forceinline__ void ph_ln1(int l, int wv) { const Frame F = make_frame(wv); phase_ln1_router<false>(F, args_here(), l); }
__device__ __forceinline__ void ph_ln1_dry(int l, int wv) { const Frame F = make_frame(wv); phase_ln1_router<true>(F, args_here(), l); }
__device__ __forceinline__ void ph_gather(int l, int wv) { const Frame F = make_frame(wv); phase_gather(F, args_here(), l); }
__device__ __forceinline__ void ph_moeup(int l, int wv) { const Frame F = make_frame(wv); unsigned char* ws = args_here()->ws;
    pg8::Gemm g{(const bf16*)(ws + WS_H), (const bf16*)(WLBASE(ws, l) + WL_WGU), 0, 0, DM / 2};   pg8::MoeOrder S{(const int*)(ws + WS_META) + l * 512, F.G, F.bid};
    pg8::EpiSwiGLU E{ws + WS_HID, (const int*)(ws + WS_SLOT + SL_TOK), 1};
    pg8::gemm_phase<pg8::EpiSwiGLU, pg8::MoeOrder, false>(F.lds, g, S, E, nullptr, F.tid); }
__device__ __forceinline__ void ph_moedown(int l, int wv) { const Frame F = make_frame(wv); unsigned char* ws = args_here()->ws;
    pg8::Gemm g{(const bf16*)(ws + WS_HID), (const bf16*)(WLBASE(ws, l) + WL_WDN), 0, 0, FF / 2}; pg8::MoeOrder S{(const int*)(ws + WS_META) + l * 512, F.G, F.bid};
    pg8::EpiDown E{(bf16*)(ws + WS_Y2), (const int*)(ws + WS_SLOT + SL_TOK), (const float*)(ws + WS_SLOT + SL_W)};
    pg8::gemm_phase<pg8::EpiDown, pg8::MoeOrder, false>(F.lds, g, S, E, nullptr, F.tid); }
__device__ __forceinline__ void ph_ln2(int l, int wv) { const Frame F = make_frame(wv); phase_ln2(F, args_here(), l); }

__global__ void __launch_bounds__(NTHR, 2) fwd_kernel(Args args) {
    extern __shared__ __attribute__((aligned(16))) unsigned char lds_raw[];
    (void)lds_raw; const int wv = 0; const Frame F = make_frame(wv);
    if (F.tid < 64) F.MISC[F.tid] = 0u;
    __syncthreads();
    XcdBarrier bar = xcd_barrier_post(F.ctl + CW_BAR, F.MISC + 8);
    const int lo = args_here()->ph_lo, hi = args_here()->ph_hi;
#define IN(k) (lo <= (k) && (k) < hi)
#define SEAM(k) do { if (IN(k) && IN((k) + 1)) { XcdBarrier bb = bar; asm volatile("" : "+s"(bb.bar)); xcd_barrier(bb); } TSTAMP((k) + 1); } while (0)
#define RPT(bit, call) do { call; if (PROBE_REPEAT & (1u << (bit))) { XcdBarrier bb = bar; asm volatile("" : "+s"(bb.bar)); xcd_barrier(bb); call; } } while (0)
    TSTAMP(0);
    if (IN(0)) ph_prologue(0, wv);
    SEAM(0);
#define LAYER_BODY(l) do { \
        const int pb = 1 + 10 * l; \
        if (IN(pb + 0)) RPT(0, ph_inproj(l, wv)); \
        SEAM(pb + 0); \
        if constexpr (SELFCHECK == 4) { \
        if (l == CHECK_LAYER) { { const Frame F2 = make_frame(wv); check_inproj(F2, args_here(), l); } XcdBarrier bb = bar; asm volatile("" : "+s"(bb.bar)); xcd_barrier(bb); } \
        } \
        if (IN(pb + 1)) { RPT(16, ph_compress(l, wv)); ph_gdnprep(l, wv); if (PROBE_REPEAT & (1u << 17)) { XcdBarrier bb = bar; asm volatile("" : "+s"(bb.bar)); xcd_barrier(bb); ph_gdnprep_var(l, wv); } RPT(18, ph_conformer(l, wv)); } \
        SEAM(pb + 1); \
        if (IN(pb + 2)) { ph_scan(l, wv); ph_bgweights(l, wv); if (PROBE_REPEAT & (1u << 19)) { XcdBarrier bb = bar; asm volatile("" : "+s"(bb.bar)); xcd_barrier(bb); ph_scan_var(l, wv); XcdBarrier bb2 = bar; asm volatile("" : "+s"(bb2.bar)); xcd_barrier(bb2); } ph_attn(l, 0, wv); if (PROBE_REPEAT & (1u << 20)) { XcdBarrier bb = bar; asm volatile("" : "+s"(bb.bar)); xcd_barrier(bb); ph_attn(l, 1, wv); } } \
        SEAM(pb + 2); \
        if (IN(pb + 3)) RPT(24, ph_gdnout(l, wv)); \
        SEAM(pb + 3); \
        if constexpr (SELFCHECK == 1 || SELFCHECK == 2 || SELFCHECK == 5) { \
        if (l == CHECK_LAYER) { { const Frame F2 = make_frame(wv); if (SELFCHECK == 1) check_nsa(F2, args_here()); else if (SELFCHECK == 2) check_gdn(F2, args_here(), l); else { check_compress(F2, args_here(), l); check_conformer(F2, args_here(), l); } } XcdBarrier bb = bar; asm volatile("" : "+s"(bb.bar)); xcd_barrier(bb); } \
        } \
        if (IN(pb + 4)) RPT(3, ph_outproj(l, wv)); \
        SEAM(pb + 4); \
        if (IN(pb + 5)) { ph_ln1(l, wv); if (PROBE_REPEAT & (1u << 4)) { XcdBarrier bb = bar; asm volatile("" : "+s"(bb.bar)); xcd_barrier(bb); ph_ln1_dry(l, wv); } \
            if (PROBE_REPEAT & (1u << 23)) { for (int rr = 0; rr < 4; ++rr) { XcdBarrier bb = bar; asm volatile("" : "+s"(bb.bar)); xcd_barrier(bb); } } } \
        SEAM(pb + 5); \
        if (IN(pb + 6)) RPT(5, ph_gather(l, wv)); \
        SEAM(pb + 6); \
        if (IN(pb + 7)) RPT(6, ph_moeup(l, wv)); \
        SEAM(pb + 7); \
        if (IN(pb + 8)) RPT(7, ph_moedown(l, wv)); \
        SEAM(pb + 8); \
        if constexpr (SELFCHECK == 3) { \
        if (l == CHECK_LAYER) { { const Frame F2 = make_frame(wv); check_moe(F2, args_here(), l); } XcdBarrier bb = bar; asm volatile("" : "+s"(bb.bar)); xcd_barrier(bb); } \
        } \
        if (IN(pb + 9)) { ph_ln2(l, wv); } \
        SEAM(pb + 9); \
     \
    } while (0)
    LAYER_BODY(0); LAYER_BODY(1); LAYER_BODY(2); LAYER_BODY(3);
#undef LAYER_BODY
#undef RPT
#if SELFCHECK
    { XcdBarrier bb = bar; asm volatile("" : "+s"(bb.bar)); xcd_barrier(bb); const Frame F2 = make_frame(wv); check_inject(F2, args_here()); }
#endif
#if TIMING
    { XcdBarrier bb = bar; asm volatile("" : "+s"(bb.bar)); xcd_barrier(bb); const Frame F2 = make_frame(wv);
      const unsigned long long* ts = (const unsigned long long*)(args_here()->ws + (size_t)985 * MiB);
      const float ta = (float)(ts[TA_HI] - ts[TA_LO]) * 0.01f, tb = (float)(ts[TB_HI] - ts[TB_LO]) * 0.01f;
      float* out = args_here()->out;
      for (int i = F2.bid * NTHR + F2.tid; i < (1 << 20); i += F2.G * NTHR) out[i] = (i == 0) ? ta : tb; }
#endif
#undef IN
#undef SEAM
}

extern "C" void kernel_launch(void* const* d_in, const int* in_sizes, int n_in, void* d_out, int out_size, void* d_ws, size_t ws_size, hipStream_t stream) {
    static int grid = 0;
    if (grid == 0) {
        if (n_in != 25 || in_sizes[0] != T * DM || out_size != T * DM || ws_size < WS_END) { fprintf(stderr, "kernel_launch: shape/workspace mismatch (n_in %d, in0 %d, out %d, ws %zu < %zu); nothing launched\n", n_in, n_in > 0 ? in_sizes[0] : -1, out_size, ws_size, (size_t)WS_END); grid = -1; return; }
        int dev = 0, cus = 0, per_cu = 0;
        if (hipGetDevice(&dev) != hipSuccess || hipDeviceGetAttribute(&cus, hipDeviceAttributeMultiprocessorCount, dev) != hipSuccess) { grid = -1; return; }
        if (hipFuncSetAttribute((const void*)fwd_kernel, hipFuncAttributeMaxDynamicSharedMemorySize, LDS_BYTES) != hipSuccess) { fprintf(stderr, "kernel_launch: hipFuncSetAttribute failed\n"); grid = -1; return; }
        if (hipOccupancyMaxActiveBlocksPerMultiprocessor(&per_cu, (const void*)fwd_kernel, NTHR, LDS_BYTES) != hipSuccess || per_cu < 1)
            fprintf(stderr, "kernel_launch: note: occupancy query reports %d workgroups per CU\n", per_cu);
        (void)hipGetLastError();
        grid = cus;
        if (grid < 32 || (grid & 7)) { fprintf(stderr, "kernel_launch: unexpected CU count %d\n", cus); }
    }
    if (grid < 0) return;
    if (hipMemsetAsync((char*)d_ws + WS_CTL, 0, CTL_ZERO_BYTES, stream) != hipSuccess) return;
    Args a{};
    for (int i = 0; i < 25; ++i) a.in[i] = (const float*)d_in[i];
    a.out = (float*)d_out; a.ws = (unsigned char*)d_ws;
#if MK_MULTI
    for (int p = 0; p < N_PHASES; ++p) { a.ph_lo = p; a.ph_hi = p + 1; hipLaunchKernelGGL(fwd_kernel, dim3(grid), dim3(NTHR), LDS_BYTES, stream, a); }
#else
    a.ph_lo = 0; a.ph_hi = N_PHASES;
    hipLaunchKernelGGL(fwd_kernel, dim3(grid), dim3(NTHR), LDS_BYTES, stream, a);
#endif
}
```

```cpp
#include <hip/hip_runtime.h>
#include <cstdio>
#include <cstdint>
namespace pg8 {
#define PG8_LAS __attribute__((address_space(3)))
typedef unsigned short bf16_t;
typedef short bf16x8 __attribute__((ext_vector_type(8)));
typedef float f32x4 __attribute__((ext_vector_type(4)));
typedef unsigned u32x4 __attribute__((ext_vector_type(4)));
constexpr int BM = 256, BK = 64, HALF = 128, HTB = HALF * BK * 2  , STAGE_BYTES = 8 * HTB, NXCD = 8, WGM = 8;

__host__ __device__ __forceinline__ int lds_byte(int r, int c) { const int st = (r >> 4) * 2 + (c >> 5), rr = r & 15, cc = c & 31, ob = rr * 64 + cc * 2; return st * 1024 + (ob ^ (((ob >> 9) & 1) << 5)); }
__host__ __device__ __forceinline__ void stage_rc(int b, int& R, int& C) { const int st = b / 1024, sb = b % 1024, swz = sb ^ (((sb >> 9) & 1) << 5); R = (st >> 1) * 16 + swz / 64; C = (st & 1) * 32 + (swz % 64) / 2; }
__host__ __device__ __forceinline__ int perm32(int rho) { const int n = rho >> 4, i = rho & 15; return 8 * (i >> 2) + 4 * n + (i & 3); }

struct Unit { int pm, pn; };
struct Gemm { const bf16_t* A; const bf16_t* Bt; int M, N, K; };

struct StaticOrder {
    int nM, nN, nwg, G, c;
    __host__ __device__ void init(int M, int N, int G_, int c_) { nM = M / BM; nN = N / BM; nwg = nM * nN; G = G_; c = c_; }
    __host__ __device__ bool next(int i, Unit& u) const {
        const long L = (long)i * G + c; if (L >= nwg) return false;
        int wgid = (int)L; { const int q = nwg / NXCD, r = nwg % NXCD, xcd = wgid % NXCD, off = wgid / NXCD; wgid = (xcd < r ? xcd * (q + 1) : r * (q + 1) + (xcd - r) * q) + off; }
        const int nig = WGM * nN, gid = wgid / nig, fm = gid * WGM, gsz = (nM - fm) < WGM ? (nM - fm) : WGM;
        u.pm = fm + ((wgid % nig) % gsz); u.pn = (wgid % nig) / gsz; return true;
    }
    __device__ __forceinline__ void a_ready(const Unit&) const {}
    __device__ __forceinline__ void done(const Unit&) const {}
};

__device__ __forceinline__ unsigned cvt_pk_bf16(float lo, float hi) { unsigned r; asm volatile("v_cvt_pk_bf16_f32 %0, %1, %2" : "=v"(r) : "v"(lo), "v"(hi)); return r; }
__device__ __forceinline__ float fast_sigmoid(float x) { return __builtin_amdgcn_rcpf(1.0f + __builtin_amdgcn_exp2f(-1.44269504089f * x)); }

constexpr int HLD = 2816;
constexpr float QSCALE = 0.125f * 1.44269504089f;

struct EpiInProj {
    static constexpr bool PERM = true, AFTER_DRAIN = false, GATHER = false, FP8 = true;
    bf16_t* H; float* side; const float* rope;
    __device__ __forceinline__ void operator()(const f32x4 (&acc)[2][2][4][2], const Unit& u, int wr, int wc, int fr, int fq) const {
        const int row0 = u.pm * BM + wr * 64 + fr; const int pn = u.pn;
        if (pn <= 4) {
#pragma unroll
            for (int ai = 0; ai < 2; ++ai)
#pragma unroll
                for (int m = 0; m < 4; ++m) {
                    const int row = row0 + ai * HALF + m * 16; const float* rp = rope + (size_t)(row & 4095) * 16;
                    const f32x4 c0 = *(const f32x4*)(rp), c1 = *(const f32x4*)(rp + 4), s0 = *(const f32x4*)(rp + 8), s1 = *(const f32x4*)(rp + 12);
#pragma unroll
                    for (int bj = 0; bj < 2; ++bj) {
                        f32x4 v0 = acc[ai][bj][m][0] * 0.03125f, v1 = acc[ai][bj][m][1] * 0.03125f;
                        const bool ropeb = (pn < 2) || (bj == 0);
                        if (ropeb) {
                            f32x4 p0, p1;
#pragma unroll
                            for (int e = 0; e < 4; ++e) { p0[e] = __shfl_xor(v0[e], 16); p1[e] = __shfl_xor(v1[e], 16); }
                            if (((wc & 1) == 0) && fq < 2) { const float sg = fq ? 1.f : -1.f; v0 = v0 * c0 + (p0 * s0) * sg; v1 = v1 * c1 + (p1 * s1) * sg; }
                        }
                        if (pn < 2) { v0 = v0 * QSCALE; v1 = v1 * QSCALE; }
                        u32x4 w; w.x = cvt_pk_bf16(v0[0], v0[1]); w.y = cvt_pk_bf16(v0[2], v0[3]); w.z = cvt_pk_bf16(v1[0], v1[1]); w.w = cvt_pk_bf16(v1[2], v1[3]);
                        *(u32x4*)(H + (size_t)row * HLD + pn * BM + bj * HALF + wc * 32 + 8 * fq) = w;
                    }
                }
        } else if (pn < 11) {
#pragma unroll
            for (int ai = 0; ai < 2; ++ai)
#pragma unroll
                for (int m = 0; m < 4; ++m) {
                    const int row = row0 + ai * HALF + m * 16;
#pragma unroll
                    for (int bj = 0; bj < 2; ++bj) {
                        const f32x4 v0 = acc[ai][bj][m][0] * 0.03125f, v1 = acc[ai][bj][m][1] * 0.03125f;
                        u32x4 w; w.x = cvt_pk_bf16(v0[0], v0[1]); w.y = cvt_pk_bf16(v0[2], v0[3]); w.z = cvt_pk_bf16(v1[0], v1[1]); w.w = cvt_pk_bf16(v1[2], v1[3]);
                        *(u32x4*)(H + (size_t)row * HLD + pn * BM + bj * HALF + wc * 32 + 8 * fq) = w;
                    }
                }
        } else if (wc == 0) {
#pragma unroll
            for (int ai = 0; ai < 2; ++ai)
#pragma unroll
                for (int m = 0; m < 4; ++m) {
                    const int row = row0 + ai * HALF + m * 16;
                    f32x4 v0 = acc[ai][0][m][0] * 0.03125f, v1 = acc[ai][0][m][1] * 0.03125f;
#pragma unroll
                    for (int e = 0; e < 4; ++e) { v0[e] = fast_sigmoid(v0[e]); if (fq < 3) v1[e] = fast_sigmoid(v1[e]); }
                    *(f32x4*)(side + (size_t)row * 32 + 8 * fq) = v0; *(f32x4*)(side + (size_t)row * 32 + 8 * fq + 4) = v1;
                }
        }
    }
};
struct EpiOutProj {
    static constexpr bool PERM = true, AFTER_DRAIN = false, GATHER = false, FP8 = false;
    const bf16_t* res; bf16_t* out; float alpha;
    __device__ __forceinline__ void operator()(const f32x4 (&acc)[2][2][4][2], const Unit& u, int wr, int wc, int fr, int fq) const {
        const int row0 = u.pm * BM + wr * 64 + fr, col0 = u.pn * BM + wc * 32 + 8 * fq;
#pragma unroll
        for (int ai = 0; ai < 2; ++ai)
#pragma unroll
            for (int m = 0; m < 4; ++m) { const size_t off = (size_t)(row0 + ai * HALF + m * 16) * 1024 + col0;
#pragma unroll
                for (int bj = 0; bj < 2; ++bj) { const u32x4 rb = *(const u32x4*)(res + off + bj * HALF);
                    f32x4 r0, r1; r0[0] = __uint_as_float(rb.x << 16); r0[1] = __uint_as_float(rb.x & 0xffff0000u); r0[2] = __uint_as_float(rb.y << 16); r0[3] = __uint_as_float(rb.y & 0xffff0000u);
                    r1[0] = __uint_as_float(rb.z << 16); r1[1] = __uint_as_float(rb.z & 0xffff0000u); r1[2] = __uint_as_float(rb.w << 16); r1[3] = __uint_as_float(rb.w & 0xffff0000u);
                    const f32x4 v0 = r0 * alpha + acc[ai][bj][m][0], v1 = r1 * alpha + acc[ai][bj][m][1];
                    u32x4 w; w.x = cvt_pk_bf16(v0[0], v0[1]); w.y = cvt_pk_bf16(v0[2], v0[3]); w.z = cvt_pk_bf16(v1[0], v1[1]); w.w = cvt_pk_bf16(v1[2], v1[3]);
                    *(u32x4*)(out + off + bj * HALF) = w; }
                asm volatile("" ::: "memory"); }
    }
};
struct EpiSwiGLU {
    static constexpr bool PERM = true, AFTER_DRAIN = false, GATHER = true, FP8 = true;
    unsigned char* hid; const int* rowmap; int rowshift;
    __device__ __forceinline__ void operator()(const f32x4 (&acc)[2][2][4][2], const Unit& u, int wr, int wc, int fr, int fq) const {
        const int row0 = u.pm * BM + wr * 64 + fr, hc0 = (u.pn & 3) * 128 + wc * 16 + 4 * fq;
#pragma unroll
        for (int ai = 0; ai < 2; ++ai)
#pragma unroll
            for (int m = 0; m < 4; ++m) { unsigned char* rowp = hid + (size_t)(row0 + ai * HALF + m * 16) * 512 + hc0;
#pragma unroll
                for (int bj = 0; bj < 2; ++bj) { const f32x4 g = acc[ai][bj][m][0] * 0.03125f, up = acc[ai][bj][m][1] * 0.03125f; f32x4 h;
#pragma unroll
                    for (int e = 0; e < 4; ++e) h[e] = __builtin_amdgcn_fmed3f(g[e] * fast_sigmoid(g[e]) * up[e], -440.f, 440.f);
                    int w = 0; w = __builtin_amdgcn_cvt_pk_fp8_f32(h[0], h[1], w, false); w = __builtin_amdgcn_cvt_pk_fp8_f32(h[2], h[3], w, true);
                    *(int*)(rowp + bj * 64) = w; } }
    }
};
struct EpiDown {
    static constexpr bool PERM = true, AFTER_DRAIN = false, GATHER = false, FP8 = true;
    bf16_t* y2; const int* slot_tok; const float* slot_w;
    __device__ __forceinline__ void operator()(const f32x4 (&acc)[2][2][4][2], const Unit& u, int wr, int wc, int fr, int fq) const {
        const int row0 = u.pm * BM + wr * 64 + fr, col0 = (u.pn & 3) * BM + wc * 32 + 8 * fq;
#pragma unroll
        for (int ai = 0; ai < 2; ++ai)
#pragma unroll
            for (int m = 0; m < 4; ++m) { const int row = row0 + ai * HALF + m * 16; const int st = slot_tok[row]; const float sw = slot_w[row] * 0.015625f;
                if (st >= 0) { bf16_t* rowp = y2 + (size_t)st * 1024 + col0;
#pragma unroll
                    for (int bj = 0; bj < 2; ++bj) { const f32x4 v0 = acc[ai][bj][m][0] * sw, v1 = acc[ai][bj][m][1] * sw;
                        u32x4 w; w.x = cvt_pk_bf16(v0[0], v0[1]); w.y = cvt_pk_bf16(v0[2], v0[3]); w.z = cvt_pk_bf16(v1[0], v1[1]); w.w = cvt_pk_bf16(v1[2], v1[3]);
                        *(u32x4*)(rowp + bj * HALF) = w; } } }
    }
};
struct MoeOrder {
    const int* meta; int G, c;
    __device__ __forceinline__ bool next(int i, Unit& u) const {
        const int per = G >> 3; const int idx = (G & 7) ? (i * G + c) : ((i * 8 + (c & 7)) * per + (c >> 3));
        const int nt = __builtin_amdgcn_readfirstlane(meta[0]); if (idx >= nt * 4) return false;
        const int pm = idx >> 2; u.pm = pm; u.pn = __builtin_amdgcn_readfirstlane(meta[64 + pm]) * 4 + (idx & 3); return true;
    }
    __device__ __forceinline__ void a_ready(const Unit&) const {}
    __device__ __forceinline__ void done(const Unit&) const {}
};
typedef int v4i_ __attribute__((ext_vector_type(4)));
typedef int v8i_ __attribute__((ext_vector_type(8)));
template <class Epi, class Sched, bool STAMP = false>
__device__ __forceinline__ void gemm_phase(PG8_LAS unsigned char* lds, const Gemm g, const Sched& S, const Epi& E, unsigned long long* stamps, int tid_in) {
    int tid_ = tid_in; asm volatile("" : "+v"(tid_));
    const int tid = tid_, wid = __builtin_amdgcn_readfirstlane(tid >> 6), lane = tid & 63, wr = wid >> 2, wc = wid & 3, fr = lane & 15, fq = lane >> 4;
    const int K = g.K, nt = K / BK;
    int ts_lo = 0, ts_hi = 0, nts = 0; const unsigned long long rt_entry = STAMP ? (unsigned long long)wall_clock64() : 0ull;
#define PG8_STAMP() do { if (STAMP && wid == 0 && nts < 64) { const unsigned long long _c = (unsigned long long)clock64(); \
        ts_lo = (lane == nts) ? (int)(unsigned)_c : ts_lo; ts_hi = (lane == nts) ? (int)(unsigned)(_c >> 32) : ts_hi; ++nts; } } while (0)
    PG8_STAMP();
    unsigned voffA[2], voffB[2];
#pragma unroll
    for (int i = 0; i < 2; ++i) { int R, C; stage_rc(tid * 16 + i * 8192, R, C); const int Rb = Epi::PERM ? ((R & ~31) + perm32(R & 31)) : R;
        voffA[i] = (unsigned)(R * K + C) * 2u; voffB[i] = (unsigned)(Rb * K + C) * 2u; }
    unsigned offAc[2][2], offAn[2][2];
    PG8_LAS unsigned char* gidx = lds + STAGE_BYTES + (unsigned)wid * 1024u;
#define PG8_IDX_DMA(par, pm_) do { int t2_ = tid; asm volatile("" : "+v"(t2_)); _Pragma("unroll") for (int i_ = 0; i_ < 2; ++i_) { int R_, C_; stage_rc(t2_ * 16 + i_ * 8192, R_, C_); (void)C_; \
        _Pragma("unroll") for (int h_ = 0; h_ < 2; ++h_) __builtin_amdgcn_global_load_lds((const unsigned*)(E.rowmap + (size_t)(pm_) * BM + h_ * HALF + R_), (PG8_LAS unsigned*)(gidx + (par) * 512 + (h_ * 2 + i_) * 256), 4, 0, 0); } } while (0)
#define PG8_IDX_READ(dst, par) do { int t2_ = tid; asm volatile("" : "+v"(t2_)); _Pragma("unroll") for (int i_ = 0; i_ < 2; ++i_) { int R_, C_; stage_rc(t2_ * 16 + i_ * 8192, R_, C_); (void)R_; \
        _Pragma("unroll") for (int h_ = 0; h_ < 2; ++h_) { int r_ = *(const PG8_LAS int*)(gidx + (par) * 512 + (h_ * 2 + i_) * 256 + (t2_ & 63) * 4); r_ = r_ < 0 ? 0 : (r_ >> E.rowshift); dst[h_][i_] = (unsigned)r_ * (unsigned)(K * 2) + (unsigned)C_ * 2u; } } } while (0)
    const size_t kstep = (size_t)(BK * 2);
    const size_t hstep = (size_t)HALF * K * 2;
    const size_t tstep = 2 * hstep;
    const unsigned ldsw = (unsigned)wid * 1024u;
    const int aoff = lds_byte(wr * 64 + fr, fq * 8), boff = lds_byte(wc * 32 + fr, fq * 8);
#define PG8_SA(b, h) (((b) * 2 + (h)) * HTB)
#define PG8_SB(b, h) ((4 + (b) * 2 + (h)) * HTB)
#define PG8_STAGE(bufoff, gbase, voff) do { _Pragma("unroll") for (int _i = 0; _i < 2; ++_i) \
        __builtin_amdgcn_global_load_lds((const unsigned*)((const char*)(gbase) + (voff)[_i]), (PG8_LAS unsigned*)(lds + (bufoff) + ldsw + _i * 8192), 16, 0, 0); } while (0)
#define PG8_STAGE_A(bufoff, kt_, h_, nx_) do { if constexpr (Epi::GATHER) { _Pragma("unroll") for (int _i = 0; _i < 2; ++_i) { const unsigned o_ = (nx_) ? offAn[h_][_i] : offAc[h_][_i]; \
            __builtin_amdgcn_global_load_lds((const unsigned*)((const char*)g.A + (size_t)(kt_) * kstep + o_), (PG8_LAS unsigned*)(lds + (bufoff) + ldsw + _i * 8192), 16, 0, 0); } } \
        else { PG8_STAGE(bufoff, ((nx_) ? nA : cA) + (size_t)(kt_) * kstep + (h_) * hstep, voffA); } } while (0)
#define PG8_LDA(dst, b, h) do { _Pragma("unroll") for (int m = 0; m < 4; ++m) _Pragma("unroll") for (int k = 0; k < 2; ++k) dst[m][k] = *(const PG8_LAS bf16x8*)(lds + PG8_SA(b, h) + aoff + m * 2048 + k * 1024); } while (0)
#define PG8_LDB(dst, b, h) do { _Pragma("unroll") for (int n = 0; n < 2; ++n) _Pragma("unroll") for (int k = 0; k < 2; ++k) dst[n][k] = *(const PG8_LAS bf16x8*)(lds + PG8_SB(b, h) + boff + n * 2048 + k * 1024); } while (0)
#define PG8_MMA(ai, bj, At, Bt) do { __builtin_amdgcn_s_setprio(1); \
        if constexpr (Epi::FP8) {   \
            _Pragma("unroll") for (int m = 0; m < 4; ++m) _Pragma("unroll") for (int n = 0; n < 2; ++n) \
                { const v8i_ b8_ = __builtin_shufflevector(__builtin_bit_cast(v4i_, Bt[n][0]), __builtin_bit_cast(v4i_, Bt[n][1]), 0, 1, 2, 3, 4, 5, 6, 7), \
                             a8_ = __builtin_shufflevector(__builtin_bit_cast(v4i_, At[m][0]), __builtin_bit_cast(v4i_, At[m][1]), 0, 1, 2, 3, 4, 5, 6, 7); \
                    \
                  asm volatile("v_mfma_f32_16x16x128_f8f6f4 %0, %1, %2, %0" : "+v"(acc[ai][bj][m][n]) : "v"(b8_), "v"(a8_)); } } \
        else { _Pragma("unroll") for (int m = 0; m < 4; ++m) _Pragma("unroll") for (int n = 0; n < 2; ++n) _Pragma("unroll") for (int k = 0; k < 2; ++k) \
            acc[ai][bj][m][n] = __builtin_amdgcn_mfma_f32_16x16x32_bf16(Bt[n][k], At[m][k], acc[ai][bj][m][n], 0, 0, 0); } \
        __builtin_amdgcn_s_setprio(0); } while (0)
#define PG8_WAIT_V(n) asm volatile("s_waitcnt vmcnt(" #n ")" ::: "memory")
#define PG8_WAIT_L(n) asm volatile("s_waitcnt lgkmcnt(" #n ")" ::: "memory")
#define PG8_BAR __builtin_amdgcn_s_barrier()
#define PG8_SCHED __builtin_amdgcn_sched_barrier(0)
    Unit cur, nxt; int ui = 0;
    if (!S.next(0, cur)) return;
    f32x4 acc[2][2][4][2];
    float zf_ = 0.f; asm volatile("" : "+v"(zf_));
#pragma unroll
    for (int a = 0; a < 2; ++a)
#pragma unroll
        for (int b = 0; b < 2; ++b)
#pragma unroll
            for (int m = 0; m < 4; ++m)
#pragma unroll
                for (int n = 0; n < 2; ++n) acc[a][b][m][n] = (f32x4){zf_, zf_, zf_, zf_};
    bf16x8 At[4][2], B0[2][2], B1[2][2];
    const char* cA = (const char*)g.A + (size_t)cur.pm * tstep; const char* cB = (const char*)g.Bt + (size_t)cur.pn * tstep;
    S.a_ready(cur);
    if constexpr (Epi::GATHER) { PG8_IDX_DMA(0, cur.pm); asm volatile("s_waitcnt vmcnt(0)" ::: "memory"); PG8_IDX_READ(offAc, 0); asm volatile("s_waitcnt lgkmcnt(0)" ::: "memory"); }
    const char* nA = cA;
    PG8_STAGE(PG8_SB(0, 0), cB, voffB); PG8_STAGE_A(PG8_SA(0, 0), 0, 0, false); PG8_STAGE(PG8_SB(0, 1), cB + hstep, voffB); PG8_STAGE_A(PG8_SA(0, 1), 0, 1, false);
    if (wr == 1) PG8_BAR;
    PG8_WAIT_V(4); PG8_BAR;
    PG8_STAGE(PG8_SB(1, 0), cB + kstep, voffB); PG8_STAGE_A(PG8_SA(1, 0), 1, 0, false); PG8_STAGE(PG8_SB(1, 1), cB + hstep + kstep, voffB);
    PG8_WAIT_V(6); PG8_BAR;
    PG8_STAMP();
    for (;;) {
        const bool has_next = S.next(ui + 1, nxt);
        nA = has_next ? (const char*)g.A + (size_t)nxt.pm * tstep : cA; const char* nB = has_next ? (const char*)g.Bt + (size_t)nxt.pn * tstep : cB;
        if constexpr (Epi::GATHER) { if (has_next) PG8_IDX_DMA((ui + 1) & 1, nxt.pm); }
#pragma unroll 1
        for (int t = 0; t < nt; t += 2) {
            const bool last = (t == nt - 2);
            const char* b2 = last ? nB : cB + (size_t)(t + 2) * kstep;
            const char* b3 = b2 + kstep;
            const int kt2 = last ? 0 : t + 2;
            if constexpr (Epi::GATHER) { if (last) { if (has_next) PG8_IDX_READ(offAn, (ui + 1) & 1); else { offAn[0][0] = offAc[0][0]; offAn[0][1] = offAc[0][1]; offAn[1][0] = offAc[1][0]; offAn[1][1] = offAc[1][1]; } } }
            if (last && has_next) S.a_ready(nxt);
            PG8_LDB(B0, 0, 0); PG8_SCHED; PG8_LDA(At, 0, 0); PG8_STAGE_A(PG8_SA(1, 1), t + 1, 1, false);
            PG8_WAIT_L(8); PG8_BAR; PG8_WAIT_L(0); PG8_MMA(0, 0, At, B0); PG8_BAR; PG8_SCHED;
            PG8_LDB(B1, 0, 1); PG8_STAGE(PG8_SB(0, 0), b2, voffB);
            PG8_BAR; PG8_WAIT_L(0); PG8_MMA(0, 1, At, B1); PG8_BAR;
            PG8_LDA(At, 0, 1); PG8_STAGE_A(PG8_SA(0, 0), kt2, 0, last);
            PG8_BAR; PG8_WAIT_L(0); PG8_MMA(1, 0, At, B0); PG8_BAR; PG8_SCHED;
            PG8_STAGE(PG8_SB(0, 1), b2 + hstep, voffB);
            PG8_WAIT_V(6); PG8_BAR; PG8_MMA(1, 1, At, B1); PG8_BAR;
            PG8_LDB(B0, 1, 0); PG8_SCHED; PG8_LDA(At, 1, 0); PG8_STAGE_A(PG8_SA(0, 1), kt2, 1, last);
            PG8_WAIT_L(8); PG8_BAR; PG8_WAIT_L(0); PG8_MMA(0, 0, At, B0); PG8_BAR; PG8_SCHED;
            PG8_LDB(B1, 1, 1); PG8_STAGE(PG8_SB(1, 0), b3, voffB);
            PG8_BAR; PG8_WAIT_L(0); PG8_MMA(0, 1, At, B1); PG8_BAR;
            PG8_LDA(At, 1, 1); PG8_STAGE_A(PG8_SA(1, 0), kt2 + 1, 0, last);
            PG8_BAR; PG8_WAIT_L(0); PG8_MMA(1, 0, At, B0); PG8_BAR; PG8_SCHED;
            PG8_STAGE(PG8_SB(1, 1), b3 + hstep, voffB);
            PG8_WAIT_V(6); PG8_BAR; PG8_MMA(1, 1, At, B1); PG8_BAR;
        }
        PG8_STAMP();
        if constexpr (Epi::FP8) asm volatile("s_nop 15\n\ts_nop 15" ::: "memory");
        if constexpr (!Epi::AFTER_DRAIN) { E(acc, cur, wr, wc, fr, fq); S.done(cur); }
        PG8_STAMP();
        if (!has_next) break;
#pragma unroll
        for (int a = 0; a < 2; ++a)
#pragma unroll
            for (int b = 0; b < 2; ++b)
#pragma unroll
                for (int m = 0; m < 4; ++m)
#pragma unroll
                    for (int n = 0; n < 2; ++n) acc[a][b][m][n] = (f32x4){zf_, zf_, zf_, zf_};
        cur = nxt; cA = nA; cB = nB; ++ui;
        if constexpr (Epi::GATHER) { offAc[0][0] = offAn[0][0]; offAc[0][1] = offAn[0][1]; offAc[1][0] = offAn[1][0]; offAc[1][1] = offAn[1][1]; }
    }
    PG8_WAIT_V(0);
    if (wr == 0) PG8_BAR;
    PG8_BAR;
    if constexpr (Epi::AFTER_DRAIN) { E.fused(acc, cur, wr, wc, fr, fq, lds, wid, lane); S.done(cur); }
    PG8_STAMP();
    if (STAMP && wid == 0) { stamps[lane] = lane < nts ? (((unsigned long long)(unsigned)ts_hi << 32) | (unsigned)ts_lo) : 0ull;
        if (lane == 62) stamps[62] = rt_entry; if (lane == 63) stamps[63] = (unsigned long long)wall_clock64(); }
#undef PG8_STAMP
#undef PG8_SA
#undef PG8_SB
#undef PG8_STAGE
#undef PG8_STAGE_A
#undef PG8_IDX_DMA
#undef PG8_IDX_READ
#undef PG8_LDA
#undef PG8_LDB
#undef PG8_MMA
#undef PG8_WAIT_V
#undef PG8_WAIT_L
#undef PG8_BAR
#undef PG8_SCHED
}
}

#ifndef SELFCHECK
#define SELFCHECK 0
#endif
#ifndef PROBE_GDN_VAR
#define PROBE_GDN_VAR 0
#endif
#ifndef PROBE_SCAN_VAR
#define PROBE_SCAN_VAR 0
#endif
#ifndef PROBE_ATTN_VAR
#define PROBE_ATTN_VAR 0
#endif
constexpr int NB = 8, SEQ = 4096, DM = 1024, NL = 4, T = NB * SEQ;
constexpr int DIN = 2848, DINP = 3072, HLD = pg8::HLD;
constexpr int NEXP = 32, FF = 512, NTILE_MAX = 288;
constexpr float LN_EPS = 1e-5f;
constexpr float DN_ALPHA = 1.6817928305074290f;
constexpr int NWAVES = 8, NTHR = 512;

constexpr size_t MiB = 1u << 20, KiB = 1u << 10;
constexpr size_t WS_CTL = 0, CTL_ZERO_BYTES = 128 * KiB;
constexpr size_t WS_ROPE = 1 * MiB;
constexpr size_t WS_META = 1 * MiB + 512 * KiB;
constexpr size_t WS_GL = WS_META + 16 * KiB;
constexpr size_t WS_WL = 2 * MiB;
constexpr size_t WL_WIN = 0, WL_WOUT = 6 * MiB, WL_WGU = 8 * MiB, WL_WDN = 72 * MiB, WL_W1 = 104 * MiB, WL_W2 = 105 * MiB, WL_BIAS1 = 105 * MiB + 64 * KiB, WL_WR = 105 * MiB + 128 * KiB;
constexpr size_t WS_XB = 108 * MiB;
constexpr size_t WS_X1 = 172 * MiB;
constexpr size_t WS_H = 300 * MiB;
constexpr size_t WS_SIDE = 476 * MiB;
constexpr size_t WS_Y = 480 * MiB;
constexpr size_t WS_GPREP = 544 * MiB;
constexpr size_t WS_Y2 = 672 * MiB;
constexpr size_t WS_HID = 800 * MiB;
constexpr size_t WS_X8 = 839 * MiB;
constexpr size_t WS_KC = 872 * MiB, WS_VC = WS_KC + 512 * KiB;
constexpr size_t WS_SLOT = 873 * MiB;
constexpr size_t SL_TOK = 0, SL_W = 512 * KiB, SL_RE = 1024 * KiB, SL_RP = 1280 * KiB, SL_RW = 1536 * KiB;
constexpr size_t WS_WL2 = 876 * MiB;
constexpr size_t WS_END = 982 * MiB;
#define WLBASE(ws_, l_) ((ws_) + (((l_) & 1) ? WS_WL2 : WS_WL))
constexpr int GCH = 65536;
constexpr int GC_UT = 0, GC_W = 8192, GC_QK = 16384, GC_QD = 24576, GC_KDT = 32768, GC_ZT = 40960, GC_SS = 49152, GC_VB = 57344;
constexpr int CW_TMO = 0;
constexpr int CW_BAR = 4096;
constexpr int CW_CNT = 8192;
constexpr int CW_QUEUE = 12288;
static_assert((CW_QUEUE + NL * 64) * 4 <= (int)CTL_ZERO_BYTES, "CTL words inside the memset region");

constexpr int SCR_BYTES = 159744;
constexpr int MISC_OFF = SCR_BYTES;
constexpr int LDS_BYTES = 163840;

#define GAS __attribute__((address_space(1)))
#define LAS __attribute__((address_space(3)))
typedef unsigned short bf16;
typedef float f32x4 __attribute__((ext_vector_type(4)));
typedef float f32x2 __attribute__((ext_vector_type(2)));
typedef float f32x16 __attribute__((ext_vector_type(16)));
typedef short bf16x8 __attribute__((ext_vector_type(8)));
typedef short s16x4 __attribute__((ext_vector_type(4)));
typedef unsigned u32x4 __attribute__((ext_vector_type(4)));
typedef unsigned u32x2 __attribute__((ext_vector_type(2)));
#define LDS_WAIT() asm volatile("s_waitcnt lgkmcnt(0)" ::: "memory")
#define VM_WAIT() asm volatile("s_waitcnt vmcnt(0)" ::: "memory")
#define SBAR() __builtin_amdgcn_sched_barrier(0)
__device__ __forceinline__ float bf2f(unsigned b) { return __uint_as_float(b << 16); }
__device__ __forceinline__ unsigned pk2(float lo, float hi) { return pg8::cvt_pk_bf16(lo, hi); }
__device__ __forceinline__ unsigned f2bf_sw(float f) { unsigned u = __float_as_uint(f); return (u + 0x7fffu + ((u >> 16) & 1u)) >> 16; }
__device__ __forceinline__ unsigned f2bf(float f) { unsigned r; asm("v_cvt_pk_bf16_f32 %0, %1, %1" : "=v"(r) : "v"(f)); return r & 0xffffu; }
__device__ __forceinline__ float row16_sum(float x) {
    x += __int_as_float(__builtin_amdgcn_update_dpp(0, __float_as_int(x), 0xB1, 0xf, 0xf, true));
    x += __int_as_float(__builtin_amdgcn_update_dpp(0, __float_as_int(x), 0x4E, 0xf, 0xf, true));
    x += __int_as_float(__builtin_amdgcn_update_dpp(0, __float_as_int(x), 0x141, 0xf, 0xf, true));
    x += __int_as_float(__builtin_amdgcn_update_dpp(0, __float_as_int(x), 0x140, 0xf, 0xf, true));
    return x;
}
__device__ __forceinline__ float wave_sum(float v) {
    const int r = __float_as_int(row16_sum(v));
    return (__int_as_float(__builtin_amdgcn_readlane(r, 0)) + __int_as_float(__builtin_amdgcn_readlane(r, 16))) + (__int_as_float(__builtin_amdgcn_readlane(r, 32)) + __int_as_float(__builtin_amdgcn_readlane(r, 48)));
}
__device__ __forceinline__ float fsigmoid(float x) { return pg8::fast_sigmoid(x); }
__device__ __forceinline__ float fsilu(float x) { return x * pg8::fast_sigmoid(x); }
__device__ __forceinline__ float fexp2(float x) { return __builtin_amdgcn_exp2f(x); }

#define XB_TMO      128
#define XB_XCNT(j)  (256  + 64 * (j))
#define XB_XSUB(j)  (1280 + 64 * (j))
#define XB_XGEN(j)  (2304 + 64 * (j))
#define XB_TOP      3328
#define XB_TOPGEN   3392
#define XCD_BAR_WORDS 3456
#define XB_SPIN_CAP (1u << 18)
#define LAS __attribute__((address_space(3)))

__device__ __forceinline__ unsigned xb_ld(unsigned* p)              { return __hip_atomic_load(p, __ATOMIC_RELAXED, __HIP_MEMORY_SCOPE_AGENT); }
__device__ __forceinline__ unsigned xb_add(unsigned* p, unsigned v) { return __hip_atomic_fetch_add(p, v, __ATOMIC_RELAXED, __HIP_MEMORY_SCOPE_AGENT); }
__device__ __forceinline__ unsigned xb_xcc_id() { return (unsigned)__builtin_amdgcn_s_getreg((3 << 11) | 20) & 0xFu; }
#define XB_SPIN(cond, bar) do { unsigned _sp = 0; while (cond) { __builtin_amdgcn_s_sleep(1); \
    if ((++_sp & 255u) == 0u) { if (xb_ld(&(bar)[XB_TMO])) break; if (_sp > XB_SPIN_CAP) { atomicAdd(&(bar)[XB_TMO], 1u); break; } } } } while (0)

struct XcdBarrier {
    unsigned* bar; unsigned x;
    volatile LAS unsigned* st;
};

__device__ __forceinline__ XcdBarrier xcd_barrier_post(unsigned* bar, volatile LAS unsigned* st) {
    XcdBarrier b; b.bar = bar; b.x = xb_xcc_id(); b.st = st;
    if (threadIdx.x == 0) (void)xb_add(&bar[XB_XCNT(b.x)], 1u);
    return b;
}
__device__ __forceinline__ void xcd_barrier_complete(unsigned* bar, unsigned x, unsigned& nloc, unsigned& nx) {
    const unsigned G = gridDim.x * gridDim.y * gridDim.z;
    unsigned sum, cnt, mine, sp = 0u;
    for (;;) {
        sum = 0u; cnt = 0u; mine = 0u;
#pragma unroll
        for (unsigned j = 0; j < 16; ++j) { const unsigned c = xb_ld(&bar[XB_XCNT(j)]); sum += c; cnt += (c > 0u) ? 1u : 0u; mine = (j == x) ? c : mine; }
        if (sum == G) break;
        __builtin_amdgcn_s_sleep(1);
        if ((++sp & 255u) == 0u) { if (xb_ld(&bar[XB_TMO])) break; if (sp > XB_SPIN_CAP) { atomicAdd(&bar[XB_TMO], 1u); break; } }
    }
    nloc = mine > 0u ? mine : 1u; nx = cnt > 0u ? cnt : 1u;
}

__device__ __forceinline__ void xcd_barrier(const XcdBarrier& b) {
    asm volatile("s_waitcnt vmcnt(0)" ::: "memory");
    __syncthreads();
    if (threadIdx.x == 0) {
        unsigned* bar = b.bar;
        __builtin_amdgcn_s_waitcnt(0);
        unsigned nloc = b.st[0], nx = b.st[1];
        if (nloc == 0u) { xcd_barrier_complete(bar, b.x, nloc, nx); b.st[0] = nloc; b.st[1] = nx; }
        const unsigned old = xb_add(&bar[XB_XSUB(b.x)], 1u);
        const unsigned gen = old / nloc;
        if (old + 1u == (gen + 1u) * nloc) {
            __builtin_amdgcn_fence(__ATOMIC_RELEASE, "agent");
            asm volatile("s_waitcnt vmcnt(0)" ::: "memory");
            const unsigned og = xb_add(&bar[XB_TOP], 1u);
            const unsigned tg = og / nx;
            if (og + 1u == (tg + 1u) * nx) xb_add(&bar[XB_TOPGEN], 1u);
            else XB_SPIN(xb_ld(&bar[XB_TOPGEN]) == tg, bar);
            __builtin_amdgcn_fence(__ATOMIC_ACQUIRE, "agent");
            xb_add(&bar[XB_XGEN(b.x)], 1u);
            asm volatile("s_waitcnt vmcnt(0)" ::: "memory");
        } else {
            XB_SPIN(xb_ld(&bar[XB_XGEN(b.x)]) == gen, bar);
            __builtin_amdgcn_fence(__ATOMIC_ACQUIRE, "agent");
            asm volatile("s_waitcnt vmcnt(0)" ::: "memory");
        }
    }
    __syncthreads();
}

struct Args { const float* in[25]; float* out; unsigned char* ws; int ph_lo, ph_hi; };
typedef const __attribute__((address_space(4))) Args* ArgsP;
__device__ __forceinline__ ArgsP args_here() { ArgsP p = (ArgsP)__builtin_amdgcn_kernarg_segment_ptr(); asm volatile("" : "+s"(p)); return p; }
struct Frame { LAS unsigned char* lds; volatile LAS unsigned* MISC; unsigned* ctl; int tid, lane, wave, G, bid; };

template <class Src>
__device__ __forceinline__ void tr_item(const Src src, int K, int N, bf16* WT, LAS float* scr, int item, int lane) {
    const int nblk = N >> 5, kb = item / nblk, nb = item - kb * nblk, k0 = kb << 6, n0 = nb << 5;
    float tv[32];
#pragma unroll
    for (int i = 0; i < 32; ++i) tv[i] = src(k0 + 2 * i + (lane >> 5), n0 + (lane & 31));
#pragma unroll
    for (int i = 0; i < 32; ++i) scr[(2 * i + (lane >> 5)) * 33 + (lane & 31)] = tv[i];
    LDS_WAIT();
    const int c = lane & 7;
#pragma unroll
    for (int j = 0; j < 4; ++j) { const int n = (lane >> 3) + 8 * j; const LAS float* s = scr + (8 * c) * 33 + n;
        u32x4 o; o.x = pk2(s[0], s[33]); o.y = pk2(s[66], s[99]); o.z = pk2(s[132], s[165]); o.w = pk2(s[198], s[231]);
        *(u32x4*)(WT + (size_t)(n0 + n) * K + k0 + 8 * c) = o; }
    LDS_WAIT();
}
template <class Src>
__device__ __forceinline__ void tr8_load(const Src src, int N, int item, int lane, float (&tv)[32]) {
    const int nblk = N >> 5, kb = item / nblk, nb = item - kb * nblk, k0 = kb << 6, n0 = nb << 5;
#pragma unroll
    for (int i = 0; i < 32; ++i) tv[i] = src(k0 + 2 * i + (lane >> 5), n0 + (lane & 31));
}
__device__ __forceinline__ void tr8_finish(const float (&tv)[32], int K, int N, unsigned char* WT, float mul, LAS float* scr, int item, int lane) {
    const int nblk = N >> 5, kb = item / nblk, nb = item - kb * nblk, k0 = kb << 6, n0 = nb << 5;
#pragma unroll
    for (int i = 0; i < 32; ++i) scr[(2 * i + (lane >> 5)) * 33 + (lane & 31)] = tv[i];
    LDS_WAIT();
    const int n = lane >> 1, kh = (lane & 1) * 32; const LAS float* sp = scr + kh * 33 + n;
#pragma unroll
    for (int q = 0; q < 2; ++q) { u32x4 o;
#pragma unroll
        for (int d = 0; d < 4; ++d) { const LAS float* s4 = sp + (16 * q + 4 * d) * 33; int w = 0;
            w = __builtin_amdgcn_cvt_pk_fp8_f32(s4[0] * mul, s4[33] * mul, w, false); w = __builtin_amdgcn_cvt_pk_fp8_f32(s4[66] * mul, s4[99] * mul, w, true); o[d] = (unsigned)w; }
        *(u32x4*)(WT + (size_t)(n0 + n) * K + k0 + kh + 16 * q) = o; }
    LDS_WAIT();
}
struct SrcPlain { const float* p; int ld; __device__ __forceinline__ float operator()(int k, int n) const { return p[(size_t)k * ld + n]; } };
struct SrcWin { const float* p;
    __device__ __forceinline__ float operator()(int k, int n) const {
        int c;
        if (n < 1280) c = n; else if (n < 2048) c = n + 24; else if (n < 2304) c = n + 24; else if (n < 2816) c = n + 32;
        else if (n < 2840) c = n - 2816 + 1280; else if (n < 2844) c = n - 2840 + 2328; else if (n < 2848) c = n - 2844 + 2332; else return 0.f;
        return p[(size_t)k * DIN + c]; } };
struct SrcGU { const float* wg; const float* wu;
    __device__ __forceinline__ float operator()(int k, int n) const { const int q = n >> 3, r = n & 7; const ptrdiff_t d = (r < 4) ? (ptrdiff_t)0 : (wu - wg); return wg[d + (ptrdiff_t)k * FF + 4 * q + (r & 3)]; } };

__device__ __forceinline__ void phase_weights(const Frame& F, ArgsP a, int l, int parts, int nblk, int lds_off) {
    unsigned char* wl = WLBASE(a->ws, l);
    LAS float* scr = (LAS float*)(F.lds + lds_off + F.wave * 8448);
    const int gw = F.bid * NWAVES + F.wave, NGW = nblk * NWAVES;
    constexpr int I_WIN = 16 * 96, I_WOUT = 16 * 32, I_GU1 = 16 * 32, I_GU = NEXP * I_GU1, I_DN1 = 8 * 32, I_DN = NEXP * I_DN1, I_W1 = 2 * 32 * 4, I_W2 = 2 * 2 * 2, I_WR = 36, I_B1 = 256;
    constexpr int NITEMS = I_WIN + I_WOUT + I_GU + I_DN + I_W1 + I_W2 + I_WR + I_B1;
    if (parts & 1) {
        for (int r = gw; r < I_GU; r += 2 * NGW) { const int r2 = r + NGW; const bool two = r2 < I_GU; const int e = r / I_GU1, e2 = (two ? r2 : r) / I_GU1; float tva[32], tvb[32];
            SrcGU sa{a->in[22] + ((size_t)l * NEXP + e) * DM * FF, a->in[23] + ((size_t)l * NEXP + e) * DM * FF}, sb{a->in[22] + ((size_t)l * NEXP + e2) * DM * FF, a->in[23] + ((size_t)l * NEXP + e2) * DM * FF};
            tr8_load(sa, 1024, r - e * I_GU1, F.lane, tva); tr8_load(sb, 1024, (two ? r2 : r) - e2 * I_GU1, F.lane, tvb);
            tr8_finish(tva, DM, 1024, wl + WL_WGU + (size_t)e * 1024 * DM, 32.f, scr, r - e * I_GU1, F.lane);
            if (two) tr8_finish(tvb, DM, 1024, wl + WL_WGU + (size_t)e2 * 1024 * DM, 32.f, scr, r2 - e2 * I_GU1, F.lane); }
        for (int r = gw; r < I_DN; r += 2 * NGW) { const int r2 = r + NGW; const bool two = r2 < I_DN; const int e = r / I_DN1, e2 = (two ? r2 : r) / I_DN1; float tva[32], tvb[32];
            SrcPlain sa{a->in[24] + ((size_t)l * NEXP + e) * FF * DM, DM}, sb{a->in[24] + ((size_t)l * NEXP + e2) * FF * DM, DM};
            tr8_load(sa, DM, r - e * I_DN1, F.lane, tva); tr8_load(sb, DM, (two ? r2 : r) - e2 * I_DN1, F.lane, tvb);
            tr8_finish(tva, FF, DM, wl + WL_WDN + (size_t)e * DM * FF, 64.f, scr, r - e * I_DN1, F.lane);
            if (two) tr8_finish(tvb, FF, DM, wl + WL_WDN + (size_t)e2 * DM * FF, 64.f, scr, r2 - e2 * I_DN1, F.lane); }
    }
    if (!(parts & 2)) return;
    for (int it = I_GU + I_DN + gw; it < NITEMS; it += NGW) {
        int r = it - I_GU - I_DN;
        if (r < I_WIN) { SrcWin s{a->in[1] + (size_t)l * DM * DIN}; float tv[32]; tr8_load(s, DINP, r, F.lane, tv); tr8_finish(tv, DM, DINP, wl + WL_WIN, 32.f, scr, r, F.lane); continue; } r -= I_WIN;
        if (r < I_WOUT) { SrcPlain s{a->in[2] + (size_t)l * DM * DM, DM}; tr_item(s, DM, DM, (bf16*)(wl + WL_WOUT), scr, r, F.lane); continue; } r -= I_WOUT;
        if (r < I_W1) { const int kv = r / 128; SrcPlain s{a->in[4] + ((size_t)l * 2 + kv) * 2048 * 128, 128};
            tr_item(s, 2048, 128, (bf16*)(wl + WL_W1) + (size_t)kv * 128 * 2048, scr, r - kv * 128, F.lane); continue; } r -= I_W1;
        if (r < I_W2) { const int kv = r / 4; SrcPlain s{a->in[5] + ((size_t)l * 2 + kv) * 128 * 64, 64};
            tr_item(s, 128, 64, (bf16*)(wl + WL_W2) + (size_t)kv * 64 * 128, scr, r - kv * 4, F.lane); continue; } r -= I_W2;
        if (r < I_WR) {
            float* wr = (float*)(wl + WL_WR) + (size_t)r * DM;
            for (int k = F.lane; k < DM; k += 64) wr[k] = (r < 4) ? a->in[18][((size_t)l * DM + k) * 4 + r] : a->in[20][((size_t)l * DM + k) * NEXP + (r - 4)];
            continue; } r -= I_WR;
        {
            const int kv = r >> 7, n = r & 127; const float* pe = a->in[3] + ((size_t)l * 2 + kv) * 2048; const float* w1 = a->in[4] + ((size_t)l * 2 + kv) * 2048 * 128;
            float s = 0.f; for (int k = F.lane; k < 2048; k += 64) s += pe[k] * w1[(size_t)k * 128 + n];
            s = wave_sum(s); if (F.lane == 0) ((float*)(wl + WL_BIAS1))[r] = s;
        }
    }
}

__device__ __forceinline__ void phase_prologue(const Frame& F, ArgsP a) {
    const size_t gt = (size_t)F.bid * NTHR + F.tid, NGT = (size_t)F.G * NTHR;
    float* rope = (float*)(a->ws + WS_ROPE);
    for (size_t i = gt; i < (size_t)SEQ * 8; i += NGT) { const int t = (int)(i >> 3), f = (int)(i & 7);
        const float invt[8] = {1.0f, 0.19392274f, 0.03760603f, 0.0072926646f, 0.0014142136f, 0.0002742482f, 5.3182957e-05f, 1.0313385e-05f};
        float inv = invt[0];
#pragma unroll
        for (int q = 1; q < 8; ++q) inv = (f == q) ? invt[q] : inv;
        const float ang = (float)t * inv;
        const double rev = (double)ang * 0.15915494309189535; const float fr = (float)(rev - __builtin_rint(rev));
        rope[t * 16 + f] = __builtin_amdgcn_cosf(fr); rope[t * 16 + 8 + f] = __builtin_amdgcn_sinf(fr); }
    const f32x4* x4 = (const f32x4*)a->in[0]; u32x4* xb = (u32x4*)(a->ws + WS_XB);
    for (size_t i = gt; i < (size_t)T * DM / 8; i += NGT) { const f32x4 v0 = x4[2 * i], v1 = x4[2 * i + 1];
        u32x4 w; w.x = pk2(v0[0], v0[1]); w.y = pk2(v0[2], v0[3]); w.z = pk2(v1[0], v1[1]); w.w = pk2(v1[2], v1[3]); xb[i] = w;
        int p0 = 0, p1 = 0; p0 = __builtin_amdgcn_cvt_pk_fp8_f32(v0[0], v0[1], p0, false); p0 = __builtin_amdgcn_cvt_pk_fp8_f32(v0[2], v0[3], p0, true); p1 = __builtin_amdgcn_cvt_pk_fp8_f32(v1[0], v1[1], p1, false); p1 = __builtin_amdgcn_cvt_pk_fp8_f32(v1[2], v1[3], p1, true);
        u32x2 w8; w8.x = (unsigned)p0; w8.y = (unsigned)p1; ((u32x2*)(a->ws + WS_X8))[i] = w8; }
}

template <bool DRY>
__device__ __forceinline__ void phase_ln1_router(const Frame& F, ArgsP a, int l) {
    const bf16* X1 = (const bf16*)(a->ws + WS_X1); bf16* XB = (bf16*)(a->ws + WS_XB); unsigned char* XB8 = a->ws + WS_H;
    const float* WR = (const float*)(WLBASE(a->ws, l) + WL_WR);
    const float* lw = a->in[14] + (size_t)l * DM; const float* lb = a->in[15] + (size_t)l * DM;
    const float* bg = a->in[19] + l * 4; const float* be = a->in[21] + l * NEXP;
    int* route_e = (int*)(a->ws + WS_SLOT + SL_RE); int* route_p = (int*)(a->ws + WS_SLOT + SL_RP); float* route_w = (float*)(a->ws + WS_SLOT + SL_RW);
    unsigned* cnt = F.ctl + CW_CNT + (DRY ? l + 4 : l) * 512;
    const int gw = F.bid * NWAVES + F.wave, NGW = F.G * NWAVES, lane = F.lane;
    LAS float* wgl = (LAS float*)F.lds;
    for (int i = F.tid; i < 4 * DM; i += NTHR) wgl[i] = WR[i];
    __syncthreads();
    const float bg0 = bg[0], bg1 = bg[1], bg2 = bg[2], bg3 = bg[3];
    for (int tg = gw; tg < T / 4; tg += NGW) {
        f32x4 v[4][4];
#pragma unroll
        for (int tk = 0; tk < 4; ++tk) { const u32x2* row = (const u32x2*)(X1 + (size_t)(4 * tg + tk) * DM) + lane;
            u32x2 raw[4];
#pragma unroll
            for (int j = 0; j < 4; ++j) raw[j] = row[64 * j];
#pragma unroll
            for (int j = 0; j < 4; ++j) { v[tk][j][0] = bf2f(raw[j].x & 0xffffu); v[tk][j][1] = __uint_as_float(raw[j].x & 0xffff0000u); v[tk][j][2] = bf2f(raw[j].y & 0xffffu); v[tk][j][3] = __uint_as_float(raw[j].y & 0xffff0000u); } }
#pragma unroll
        for (int tk = 0; tk < 4; ++tk) {
            float s = 0.f;
#pragma unroll
            for (int j = 0; j < 4; ++j) s += (v[tk][j][0] + v[tk][j][1]) + (v[tk][j][2] + v[tk][j][3]);
            const float mean = wave_sum(s) * (1.f / DM); float q = 0.f;
#pragma unroll
            for (int j = 0; j < 4; ++j) { v[tk][j] = v[tk][j] - mean; q += (v[tk][j][0] * v[tk][j][0] + v[tk][j][1] * v[tk][j][1]) + (v[tk][j][2] * v[tk][j][2] + v[tk][j][3] * v[tk][j][3]); }
            const float rstd = 1.f / sqrtf(wave_sum(q) * (1.f / DM) + LN_EPS);
            u32x2* brow = (u32x2*)(XB + (size_t)(4 * tg + tk) * DM) + lane;
#pragma unroll
            for (int j = 0; j < 4; ++j) { const f32x4 w4 = ((const f32x4*)lw)[lane + 64 * j], b4 = ((const f32x4*)lb)[lane + 64 * j];
                v[tk][j] = v[tk][j] * rstd * w4 + b4;
                u32x2 w; w.x = pk2(v[tk][j][0], v[tk][j][1]); w.y = pk2(v[tk][j][2], v[tk][j][3]); if (!DRY) brow[64 * j] = w;
                int w8 = 0; w8 = __builtin_amdgcn_cvt_pk_fp8_f32(v[tk][j][0], v[tk][j][1], w8, false); w8 = __builtin_amdgcn_cvt_pk_fp8_f32(v[tk][j][2], v[tk][j][3], w8, true);
                if (!DRY) ((int*)(XB8 + (size_t)(4 * tg + tk) * DM))[lane + 64 * j] = w8; }
        }
        float glg[4][4];
#pragma unroll
        for (int j = 0; j < 4; ++j) { const LAS f32x4* wr = (const LAS f32x4*)(wgl + j * DM) + lane; const f32x4 w0 = wr[0], w1 = wr[64], w2 = wr[128], w3 = wr[192];
#pragma unroll
            for (int tk = 0; tk < 4; ++tk) { f32x4 p = v[tk][0] * w0; p = p + v[tk][1] * w1; p = p + v[tk][2] * w2; p = p + v[tk][3] * w3; glg[tk][j] = wave_sum((p[0] + p[1]) + (p[2] + p[3])); } }
        int my_e = 0; float my_w = 0.f;
#pragma unroll
        for (int tk = 0; tk < 4; ++tk) {
            const float g0 = glg[tk][0] + bg0, g1 = glg[tk][1] + bg1, g2 = glg[tk][2] + bg2, g3 = glg[tk][3] + bg3;
            int gi = 0; float gm = g0; if (g1 > gm) { gm = g1; gi = 1; } if (g2 > gm) { gm = g2; gi = 2; } if (g3 > gm) { gm = g3; gi = 3; }
            gi = __builtin_amdgcn_readfirstlane(gi);
            const float g_w = 1.f / (__expf(g0 - gm) + __expf(g1 - gm) + __expf(g2 - gm) + __expf(g3 - gm));
            const float* wbase = WR + (size_t)(4 + gi * 8) * DM; float ev[8];
#pragma unroll
            for (int i4 = 0; i4 < 2; ++i4) { f32x4 w[4][4];
#pragma unroll
                for (int i = 0; i < 4; ++i) { const f32x4* wr = (const f32x4*)(wbase + (size_t)(4 * i4 + i) * DM) + lane; w[i][0] = wr[0]; w[i][1] = wr[64]; w[i][2] = wr[128]; w[i][3] = wr[192]; }
#pragma unroll
                for (int i = 0; i < 4; ++i) { f32x4 p = v[tk][0] * w[i][0]; p = p + v[tk][1] * w[i][1]; p = p + v[tk][2] * w[i][2]; p = p + v[tk][3] * w[i][3];
                    ev[4 * i4 + i] = wave_sum((p[0] + p[1]) + (p[2] + p[3])) + be[gi * 8 + 4 * i4 + i]; } }
            int i1 = 0; float v1 = ev[0];
#pragma unroll
            for (int i = 1; i < 8; ++i) if (ev[i] > v1) { v1 = ev[i]; i1 = i; }
            int i2 = -1; float v2 = -3.0e38f;
#pragma unroll
            for (int i = 0; i < 8; ++i) if (i != i1 && ev[i] > v2) { v2 = ev[i]; i2 = i; }
            const float e2 = __expf(v2 - v1), w1 = g_w / (1.f + e2), w2 = g_w - w1;
            if (lane == 2 * tk) { my_e = gi * 8 + i1; my_w = w1; }
            if (lane == 2 * tk + 1) { my_e = gi * 8 + i2; my_w = w2; }
        }
        if (lane < 8) {
            const unsigned pos = __hip_atomic_fetch_add(cnt + my_e * 16, 1u, __ATOMIC_RELAXED, __HIP_MEMORY_SCOPE_AGENT);
            const size_t si = (size_t)tg * 8 + lane; if (!DRY) { route_e[si] = my_e; route_p[si] = (int)pos; route_w[si] = my_w; }
        }
    }
    __syncthreads();
}

__device__ __forceinline__ void phase_gather(const Frame& F, ArgsP a, int l) {
    LAS int* pstart = (LAS int*)F.lds;
    unsigned* cnt = F.ctl + CW_CNT + l * 512;
    int* meta = (int*)(a->ws + WS_META) + l * 512;
    int* slot_tok = (int*)(a->ws + WS_SLOT + SL_TOK); float* slot_w = (float*)(a->ws + WS_SLOT + SL_W);
    const int* route_e = (const int*)(a->ws + WS_SLOT + SL_RE); const int* route_p = (const int*)(a->ws + WS_SLOT + SL_RP); const float* route_w = (const float*)(a->ws + WS_SLOT + SL_RW);
    if (F.tid < 64) {
        const int c = F.tid < 32 ? (int)__hip_atomic_load(cnt + F.tid * 16, __ATOMIC_RELAXED, __HIP_MEMORY_SCOPE_AGENT) : 0;
        const int pad = (c + 255) & ~255; int inc = pad;
#pragma unroll
        for (int o = 1; o < 64; o <<= 1) { const int t = __shfl_up(inc, o); if (F.lane >= o) inc += t; }
        const int st = inc - pad;
        if (F.tid < 32) { pstart[F.tid] = st;
            if (F.bid == 0) { for (int t = st >> 8; t < (st + pad) >> 8; ++t) meta[64 + t] = F.tid; if (F.tid == 31) meta[0] = (st + pad) >> 8; }
            if ((F.tid % F.G) == F.bid) for (int r = st + c; r < st + pad; ++r) { slot_tok[r] = -1; slot_w[r] = 0.f; }
        }
    }
    __syncthreads();
    for (int s = F.bid * NTHR + F.tid; s < T * 2; s += F.G * NTHR) {
        const int dest = pstart[route_e[s]] + route_p[s]; slot_tok[dest] = s; slot_w[dest] = route_w[s];
    }
    __syncthreads();
}

__device__ __forceinline__ void phase_ln2(const Frame& F, ArgsP a, int l) {
    const bf16* Y2 = (const bf16*)(a->ws + WS_Y2); bf16* XB = (bf16*)(a->ws + WS_XB); float* out = a->out;
    const float* lw = a->in[16] + (size_t)l * DM; const float* lb = a->in[17] + (size_t)l * DM;
    const int gw = F.bid * NWAVES + F.wave, NGW = F.G * NWAVES, lane = F.lane; const bool last = (l == NL - 1);
    for (int t0 = 2 * gw; t0 < T; t0 += 2 * NGW) {
        u32x2 xr[2][4], pa[2][4], pb[2][4];
#pragma unroll
        for (int u = 0; u < 2; ++u) { const int t = t0 + u; const u32x2* x_ = (const u32x2*)(XB + (size_t)t * DM) + lane; const u32x2* a_ = (const u32x2*)(Y2 + (size_t)(2 * t) * DM) + lane; const u32x2* b_ = (const u32x2*)(Y2 + (size_t)(2 * t + 1) * DM) + lane;
#pragma unroll
            for (int j = 0; j < 4; ++j) { xr[u][j] = x_[64 * j]; pa[u][j] = a_[64 * j]; pb[u][j] = b_[64 * j]; } }
#pragma unroll
        for (int u = 0; u < 2; ++u) { const int t = t0 + u;
            f32x4 v[4]; float s = 0.f;
#pragma unroll
            for (int j = 0; j < 4; ++j) { const u32x2 x = xr[u][j], p = pa[u][j], q = pb[u][j];
                v[j][0] = bf2f(x.x & 0xffffu) * DN_ALPHA + (bf2f(p.x & 0xffffu) + bf2f(q.x & 0xffffu)); v[j][1] = bf2f(x.x >> 16) * DN_ALPHA + (bf2f(p.x >> 16) + bf2f(q.x >> 16));
                v[j][2] = bf2f(x.y & 0xffffu) * DN_ALPHA + (bf2f(p.y & 0xffffu) + bf2f(q.y & 0xffffu)); v[j][3] = bf2f(x.y >> 16) * DN_ALPHA + (bf2f(p.y >> 16) + bf2f(q.y >> 16));
                s += (v[j][0] + v[j][1]) + (v[j][2] + v[j][3]); }
            const float mean = wave_sum(s) * (1.f / DM); float q2 = 0.f;
#pragma unroll
            for (int j = 0; j < 4; ++j) { v[j] = v[j] - mean; q2 += (v[j][0] * v[j][0] + v[j][1] * v[j][1]) + (v[j][2] * v[j][2] + v[j][3] * v[j][3]); }
            const float rstd = 1.f / sqrtf(wave_sum(q2) * (1.f / DM) + LN_EPS);
            f32x4* orow = (f32x4*)(out + (size_t)t * DM) + lane; u32x2* brow = (u32x2*)(XB + (size_t)t * DM) + lane;
#pragma unroll
            for (int j = 0; j < 4; ++j) { const f32x4 w4 = ((const f32x4*)lw)[lane + 64 * j], b4 = ((const f32x4*)lb)[lane + 64 * j];
                const f32x4 o = v[j] * rstd * w4 + b4; if (last) orow[64 * j] = o; u32x2 w; w.x = pk2(o[0], o[1]); w.y = pk2(o[2], o[3]); if (!last) brow[64 * j] = w;
                int w8 = 0; w8 = __builtin_amdgcn_cvt_pk_fp8_f32(o[0], o[1], w8, false); w8 = __builtin_amdgcn_cvt_pk_fp8_f32(o[2], o[3], w8, true); if (!last) ((int*)(a->ws + WS_X8 + (size_t)t * DM))[lane + 64 * j] = w8; } }
    }
}

__device__ __forceinline__ int tsw(int row, int col) { return row * 128 + ((((col >> 3) ^ (row >> 1)) & 7) << 4) + ((col & 7) << 1); }
__device__ __forceinline__ f32x4 mfma16(bf16x8 a, bf16x8 b, f32x4 c) { return __builtin_amdgcn_mfma_f32_16x16x32_bf16(a, b, c, 0, 0, 0); }
__device__ __forceinline__ f32x16 mfma32(bf16x8 a, bf16x8 b, f32x16 c) { return __builtin_amdgcn_mfma_f32_32x32x16_bf16(a, b, c, 0, 0, 0); }
__device__ __forceinline__ bf16x8 as_bf16x8(u32x4 v) { return __builtin_bit_cast(bf16x8, v); }

__device__ __forceinline__ void conformer_item(const Frame& F, ArgsP a, int l, int it) {
    const int b = it >> 6, s0 = (it & 63) * 64; const size_t tok0 = (size_t)b * SEQ + s0;
    const bf16* H = (const bf16*)(a->ws + WS_H); bf16* Y = (bf16*)(a->ws + WS_Y);
    LAS bf16* ut = (LAS bf16*)F.lds;
    LAS float* co = (LAS float*)(F.lds + 49152);
    for (int idx = F.tid; idx < 94 * 32; idx += NTHR) {
        const int r = idx >> 5, c8 = (idx & 31) * 8, s = s0 - 30 + r; u32x4 w = {0u, 0u, 0u, 0u};
        if (s >= 0) { const bf16* hp = H + ((size_t)b * SEQ + s) * HLD + 2304 + c8; const u32x4 v = *(const u32x4*)hp, g = *(const u32x4*)(hp + 256);
#pragma unroll
            for (int e = 0; e < 4; ++e) { const float v0 = bf2f(v[e] & 0xffffu) * fsigmoid(bf2f(g[e] & 0xffffu)), v1 = bf2f(v[e] >> 16) * fsigmoid(bf2f(g[e] >> 16)); w[e] = pk2(v0, v1); } }
        *(LAS u32x4*)(ut + r * 256 + c8) = w;
    }
    __syncthreads();
    {
        const int c = F.tid & 255, half = F.tid >> 8; const float* dw = a->in[10] + (size_t)l * 31 * 256 + c; const float bias = a->in[11][l * 256 + c];
        float w[31], ur[62];
#pragma unroll
        for (int k = 0; k < 31; ++k) w[k] = dw[k * 256];
#pragma unroll
        for (int i = 0; i < 62; ++i) ur[i] = bf2f(ut[(32 * half + i) * 256 + c]);
#pragma unroll
        for (int tt = 0; tt < 32; ++tt) { float acc = bias;
#pragma unroll
            for (int k = 0; k < 31; ++k) acc += w[k] * ur[tt + k];
            co[(32 * half + tt) * 256 + c] = acc; }
    }
    __syncthreads();
    {
        const float* lw = a->in[12] + l * 256; const float* lb = a->in[13] + l * 256; const f32x4 w4 = ((const f32x4*)lw)[F.lane], b4 = ((const f32x4*)lb)[F.lane];
#pragma unroll
        for (int i = 0; i < 8; ++i) { const int tl = 8 * F.wave + i; f32x4 v = *(LAS f32x4*)(co + tl * 256 + 4 * F.lane);
            const float mean = wave_sum((v[0] + v[1]) + (v[2] + v[3])) * (1.f / 256.f); v = v - mean;
            const float rstd = 1.f / sqrtf(wave_sum((v[0] * v[0] + v[1] * v[1]) + (v[2] * v[2] + v[3] * v[3])) * (1.f / 256.f) + LN_EPS);
            v = v * rstd * w4 + b4; u32x2 o; o.x = pk2(fsilu(v[0]), fsilu(v[1])); o.y = pk2(fsilu(v[2]), fsilu(v[3]));
            *(u32x2*)(Y + (tok0 + tl) * DM + 768 + 4 * F.lane) = o; }
    }
    __syncthreads();
}

__device__ __forceinline__ void compress_item(const Frame& F, ArgsP a, int l, int it) {
    const int kv = it >> 7, bh = (it >> 3) & 15, b = bh >> 1, hh = bh & 1, i0 = (it & 7) * 32;
    const bf16* H = (const bf16*)(a->ws + WS_H); const bf16* w1t = (const bf16*)(WLBASE(a->ws, l) + WL_W1) + (size_t)kv * 128 * 2048; const bf16* w2t = (const bf16*)(WLBASE(a->ws, l) + WL_W2) + (size_t)kv * 64 * 128;
    const float* bias1 = (const float*)(WLBASE(a->ws, l) + WL_BIAS1) + kv * 128; bf16* outp = (bf16*)(a->ws + (kv ? WS_VC : WS_KC)) + (size_t)bh * 256 * 64;
    LAS bf16* hid = (LAS bf16*)F.lds;
    const int lane = F.lane, li = lane & 15, g = lane >> 4, rt = F.wave & 1, cq = F.wave >> 1;
    const int i = i0 + 16 * rt + li; const bf16* arow = H + (size_t)b * SEQ * HLD + 512 + kv * 128 + hh * 64 + 8 * g;
    const bf16* brow = w1t + (size_t)(32 * cq + li) * 2048 + 8 * g;
    f32x4 acc[2] = {{0.f, 0.f, 0.f, 0.f}, {0.f, 0.f, 0.f, 0.f}};
#pragma unroll 1
    for (int k8 = 0; k8 < 64; k8 += 8) {
        bf16x8 af[8], bfr[8][2];
#pragma unroll
        for (int u = 0; u < 8; ++u) { const int ks = k8 + u; int s = 16 * i + (ks >> 1); s = s > SEQ - 1 ? SEQ - 1 : s;
            af[u] = *(const bf16x8*)(arow + (size_t)s * HLD + (ks & 1) * 32); bfr[u][0] = *(const bf16x8*)(brow + ks * 32); bfr[u][1] = *(const bf16x8*)(brow + (size_t)16 * 2048 + ks * 32); }
#pragma unroll
        for (int u = 0; u < 8; ++u) { acc[0] = mfma16(af[u], bfr[u][0], acc[0]); acc[1] = mfma16(af[u], bfr[u][1], acc[1]); }
    }
#pragma unroll
    for (int nt = 0; nt < 2; ++nt) { const int n = 32 * cq + 16 * nt + li; const float bs = bias1[n];
#pragma unroll
        for (int r = 0; r < 4; ++r) hid[(16 * rt + 4 * g + r) * 136 + n] = (bf16)f2bf(fsilu(acc[nt][r] + bs)); }
    __syncthreads();
    f32x4 o2 = {0.f, 0.f, 0.f, 0.f};
#pragma unroll
    for (int ks = 0; ks < 4; ++ks) { const bf16x8 af = *(LAS bf16x8*)(hid + (16 * rt + li) * 136 + 32 * ks + 8 * g);
        const bf16x8 bfr = *(const bf16x8*)(w2t + (size_t)(16 * cq + li) * 128 + 32 * ks + 8 * g); o2 = mfma16(af, bfr, o2); }
#pragma unroll
    for (int r = 0; r < 4; ++r) { const int io = i0 + 16 * rt + 4 * g + r; outp[(size_t)io * 64 + 16 * cq + li] = (bf16)(io < 255 ? f2bf_sw(o2[r]) : 0u); }
    __syncthreads();
}

__host__ __device__ constexpr int tri_off(int i) { int s = 0; for (int k = 0; k < i; ++k) s += (k + 3) >> 2; return 4 * s; }
__device__ __forceinline__ int tri_off_rt(int i) { const int m = i - 1, V = (m + 3) >> 2; return i <= 0 ? 0 : 4 * (2 * V * (V - 1) + V * (m - 4 * V + 4)); }

template <int I> struct GdnSolveRow {
    __device__ static __forceinline__ void run(const LAS float* Ap, float (&x)[64]) {
        if constexpr (I < 64) {
            constexpr int off = tri_off(I), nb = (I + 3) >> 2;
            float s4[4] = {0.f, 0.f, 0.f, 0.f};
#pragma unroll
            for (int jb = 0; jb < nb; ++jb) { const f32x4 a4 = *(const LAS f32x4*)(Ap + off + 4 * jb);
#pragma unroll
                for (int jj = 0; jj < 4; ++jj) { if (4 * jb + jj < I) s4[jj] += a4[jj] * x[4 * jb + jj]; } }
            x[I] -= (s4[0] + s4[1]) + (s4[2] + s4[3]);
            if constexpr ((I & 3) == 3) SBAR();
            GdnSolveRow<I + 1>::run(Ap, x);
        }
    }
};

template <int GV>
__device__ __forceinline__ void gdn_prep_chunk(const Frame& F, ArgsP a, int l, int ci, LAS unsigned char* wl) {
    int lane_ = F.lane; asm volatile("" : "+v"(lane_));
    const int lane = lane_, li = lane & 15, g = lane >> 4; const int bh = ci >> 6, n = ci & 63, b = bh >> 2, h = bh & 3; const size_t tok0 = (size_t)b * SEQ + 64 * n;
    const bf16* H = (const bf16*)(a->ws + WS_H); const float* side = (const float*)(a->ws + WS_SIDE);
    unsigned char* rec = a->ws + ((GV & 1) ? WS_Y2 : WS_GPREP) + (size_t)ci * GCH;
    bf16* R0 = (bf16*)(rec + GC_UT); bf16* R1 = (bf16*)(rec + GC_W); bf16* QKm = (bf16*)(rec + GC_QK); bf16* QD = (bf16*)(rec + GC_QD); bf16* KDT = (bf16*)(rec + GC_KDT); bf16* ZT = (bf16*)(rec + GC_ZT);
    const int pc = (lane & 32) | (((lane & 15) >> 2) << 3) | (((lane >> 4) & 1) << 2) | (lane & 3);
    LAS unsigned char* qt = wl; LAS unsigned char* kt = wl + 8192; LAS float* Ap = (LAS float*)wl;
    const float beta = side[(tok0 + lane) * 32 + 24 + h]; const float av = side[(tok0 + lane) * 32 + 28 + h] + a->in[8][l * 4 + h];
    const float sp = av > 20.f ? av : log1pf(__expf(av)); float gc = -__expf(a->in[7][l * 4 + h]) * sp;
#pragma unroll
    for (int o = 1; o < 64; o <<= 1) { const float t = __shfl_up(gc, o); if (lane >= o) gc += t; }
    const float gl = __shfl(gc, 63); const float eg = __expf(gc), ekd = __expf(gl - gc);
    if (lane == 0 && !(GV & 1)) ((float*)(a->ws + WS_GL))[ci] = __expf(gl);
    const float* cw = a->in[6] + (size_t)l * 4 * 768 + h * 64 + lane; float wq[4], wk[4], wv[4];
#pragma unroll
    for (int k = 0; k < 4; ++k) { wq[k] = cw[k * 768]; wk[k] = cw[k * 768 + 256]; wv[k] = cw[k * 768 + 512]; }
    const bf16* hp = H + tok0 * HLD + 1280 + h * 64 + lane; float hq[3], hk[3], hv[3];
#pragma unroll
    for (int j = 0; j < 3; ++j) { const bool ok = (64 * n - 3 + j) >= 0; const bf16* p = hp + (ptrdiff_t)(j - 3) * HLD;
        hq[j] = ok ? bf2f(p[0]) : 0.f; hk[j] = ok ? bf2f(p[256]) : 0.f; hv[j] = ok ? bf2f(p[512]) : 0.f; }
    unsigned short ra[8][4], rb[8][4]; const float nwl = a->in[9][l * 64 + lane];
#define GDN_LOADBLK(dst, t8_) do { const bf16* pl_ = hp + (size_t)(8 * (t8_)) * HLD; asm volatile("" : "+v"(pl_)); _Pragma("unroll") for (int tt = 0; tt < 8; ++tt) { const bf16* q_ = pl_ + (size_t)tt * HLD; dst[tt][0] = q_[0]; dst[tt][1] = q_[256]; dst[tt][2] = q_[512]; dst[tt][3] = q_[768]; } } while (0)
#define GDN_CONVBLK(src, t8_) do { const int t8 = (t8_); unsigned kdp[4], zp[4]; \
        bf16* qd8 = QD + (8 * t8) * 64 + pc; bf16* r08 = R0 + (8 * t8) * 64 + lane; bf16* r18 = R1 + (8 * t8) * 64 + lane; asm volatile("" : "+v"(qd8), "+v"(r08), "+v"(r18)); \
        _Pragma("unroll") for (int tt = 0; tt < 8; ++tt) { const int t = 8 * t8 + tt; \
            const float rq = bf2f(src[tt][0]), rk = bf2f(src[tt][1]), rv = bf2f(src[tt][2]); \
            const float cq = wq[0] * hq[0] + wq[1] * hq[1] + wq[2] * hq[2] + wq[3] * rq, ck = wk[0] * hk[0] + wk[1] * hk[1] + wk[2] * hk[2] + wk[3] * rk, cv = wv[0] * hv[0] + wv[1] * hv[1] + wv[2] * hv[2] + wv[3] * rv; \
            hq[0] = hq[1]; hq[1] = hq[2]; hq[2] = rq; hk[0] = hk[1]; hk[1] = hk[2]; hk[2] = rk; hv[0] = hv[1]; hv[1] = hv[2]; hv[2] = rv; \
            const float qs = fsilu(cq), ks_ = fsilu(ck), vs = fsilu(cv); \
            const float qn = qs * __builtin_amdgcn_rsqf(wave_sum(qs * qs) + 1e-6f) * 0.125f, kn = ks_ * __builtin_amdgcn_rsqf(wave_sum(ks_ * ks_) + 1e-6f); \
            const float bt = __int_as_float(__builtin_amdgcn_readlane(__float_as_int(beta), t)), egt = __int_as_float(__builtin_amdgcn_readlane(__float_as_int(eg), t)), ekt = __int_as_float(__builtin_amdgcn_readlane(__float_as_int(ekd), t)); \
            *(LAS bf16*)(qt + tsw(t, lane)) = (bf16)f2bf(qn); *(LAS bf16*)(kt + tsw(t, lane)) = (bf16)f2bf(kn); \
            qd8[tt * 64] = (bf16)f2bf(qn * egt); r08[tt * 64] = (bf16)f2bf(bt * vs); r18[tt * 64] = (bf16)f2bf(bt * egt * kn); \
            const unsigned kd = f2bf(kn * ekt); if (tt & 1) kdp[tt >> 1] |= kd << 16; else kdp[tt >> 1] = kd; \
            const unsigned zg = f2bf(fsilu(bf2f(src[tt][3])) * nwl); if (tt & 1) zp[tt >> 1] |= zg << 16; else zp[tt >> 1] = zg; } \
        { u32x4 wz; wz.x = zp[0]; wz.y = zp[1]; wz.z = zp[2]; wz.w = zp[3]; *(u32x4*)(ZT + lane * 64 + 8 * t8) = wz; } \
        { const int c0 = (8 * t8) & 31, gg = (c0 & 15) >> 2, hh = c0 >> 4; bf16* kr = KDT + lane * 64 + ((8 * t8) & 32) + 4 * hh; \
          u32x2 w0, w1; w0.x = kdp[0]; w0.y = kdp[1]; w1.x = kdp[2]; w1.y = kdp[3]; *(u32x2*)(kr + 8 * gg) = w0; *(u32x2*)(kr + 8 * gg + 8) = w1; } } while (0)
    if (!(GV & 2)) {
    GDN_LOADBLK(ra, 0);
#pragma unroll 1
    for (int t16 = 0; t16 < 4; ++t16) {
        GDN_LOADBLK(rb, 2 * t16 + 1);
        GDN_CONVBLK(ra, 2 * t16);
        if (t16 < 3) GDN_LOADBLK(ra, 2 * t16 + 2);
        GDN_CONVBLK(rb, 2 * t16 + 1);
    }
    }
#undef GDN_LOADBLK
#undef GDN_CONVBLK
    LDS_WAIT();
    if (!(GV & 4)) {
    float gcj[4][4];
#pragma unroll
    for (int mt = 0; mt < 4; ++mt)
#pragma unroll
        for (int r = 0; r < 4; ++r) gcj[mt][r] = __shfl(gc, 16 * mt + 4 * g + r);
    f32x4 ahold[4][4];
#pragma unroll
    for (int nt = 0; nt < 4; ++nt) {
        const int i = 16 * nt + li; const float gci = __shfl(gc, i), bi = __shfl(beta, i);
        bf16x8 kB[2], qB[2];
#pragma unroll
        for (int ks = 0; ks < 2; ++ks) { kB[ks] = *(LAS bf16x8*)(kt + tsw(i, 32 * ks + 8 * g)); qB[ks] = *(LAS bf16x8*)(qt + tsw(i, 32 * ks + 8 * g)); }
#pragma unroll
        for (int mt = 0; mt < 4; ++mt) {
            u32x2 qw = {0u, 0u};
            if (mt <= nt) {
                const bf16x8 kA0 = *(LAS bf16x8*)(kt + tsw(16 * mt + li, 8 * g)), kA1 = *(LAS bf16x8*)(kt + tsw(16 * mt + li, 32 + 8 * g));
                f32x4 ckk = {0.f, 0.f, 0.f, 0.f}, cqk = {0.f, 0.f, 0.f, 0.f};
                ckk = mfma16(kA0, kB[0], ckk); ckk = mfma16(kA1, kB[1], ckk); cqk = mfma16(kA0, qB[0], cqk); cqk = mfma16(kA1, qB[1], cqk);
                float qv[4];
#pragma unroll
                for (int r = 0; r < 4; ++r) { const int j = 16 * mt + 4 * g + r; const float dec = __expf(fminf(gci - gcj[mt][r], 0.f));
                    ahold[nt][mt][r] = bi * ckk[r] * dec; qv[r] = (j <= i) ? cqk[r] * dec : 0.f; }
                qw.x = pk2(qv[0], qv[1]); qw.y = pk2(qv[2], qv[3]);
            }
            *(u32x2*)(QKm + i * 64 + 32 * (mt >> 1) + 8 * g + 4 * (mt & 1)) = qw;
        }
    }
    LDS_WAIT(); SBAR();
#pragma unroll
    for (int nt = 0; nt < 4; ++nt) { const int i = 16 * nt + li; const int ro = tri_off_rt(i);
#pragma unroll
        for (int mt = 0; mt < 4; ++mt) if (mt <= nt) {
#pragma unroll
            for (int r = 0; r < 4; ++r) { const int j = 16 * mt + 4 * g + r; if (j < i) Ap[ro + j] = ahold[nt][mt][r]; } } }
    }
    VM_WAIT(); LDS_WAIT();
#pragma unroll 1
    for (int pass = 0; pass < 2; ++pass) {
        bf16* Rp = pass ? R1 : R0; float x[64];
#pragma unroll
        for (int i = 0; i < 64; ++i) x[i] = bf2f(Rp[i * 64 + lane]);
        VM_WAIT();
        if (!(GV & 8)) GdnSolveRow<1>::run(Ap, x);
        if (pass == 0) {
#pragma unroll
            for (int i8 = 0; i8 < 8; ++i8) { u32x4 w; w.x = pk2(x[8 * i8], x[8 * i8 + 1]); w.y = pk2(x[8 * i8 + 2], x[8 * i8 + 3]); w.z = pk2(x[8 * i8 + 4], x[8 * i8 + 5]); w.w = pk2(x[8 * i8 + 6], x[8 * i8 + 7]);
                *(u32x4*)(Rp + lane * 64 + 8 * i8) = w; }
        } else {
#pragma unroll
            for (int i = 0; i < 64; ++i) Rp[i * 64 + pc] = (bf16)f2bf(x[i]);
        }
    }
    LDS_WAIT();
}

__device__ __forceinline__ bf16x8 scan_frag(const unsigned char* mat, int mt, int ks, int li, int g) { return *(const bf16x8*)(mat + (16 * mt + li) * 128 + (32 * ks + 8 * g) * 2); }
__device__ __forceinline__ bf16x8 pack_c2(f32x4 a, f32x4 b) { u32x4 w; w.x = pk2(a[0], a[1]); w.y = pk2(a[2], a[3]); w.z = pk2(b[0], b[1]); w.w = pk2(b[2], b[3]); return as_bf16x8(w); }
constexpr int SC_SLOT = 24576;
__device__ __forceinline__ void scan_dma(LAS unsigned char* slot, const unsigned char* rec, int sl, int lane) {
#pragma unroll
    for (int m = 0; m < 3; ++m) { const int goff = (m == 0) ? GC_W : (m == 1 ? GC_KDT : GC_UT);
#pragma unroll
        for (int i = 0; i < 2; ++i) { const int row = 16 * sl + 8 * i + (lane >> 3), ch = (lane & 7) ^ ((row >> 1) & 7);
            __builtin_amdgcn_global_load_lds((const unsigned*)(rec + goff + row * 128 + ch * 16), (LAS unsigned*)(slot + m * 8192 + (16 * sl + 8 * i) * 128), 16, 0, 0); } }
}
__device__ __forceinline__ bf16x8 scan_lfrag(const LAS unsigned char* mat, int mt, int ks, int li, int g) { const int row = 16 * mt + li; return *(const LAS bf16x8*)(mat + row * 128 + ((((4 * ks + g) ^ (row >> 1)) & 7) << 4)); }
template <int SV>
__device__ __forceinline__ void gdn_scan(const Frame& F, ArgsP a, int l) {
    const int lane = F.lane, li = lane & 15, g = lane >> 4, pr = F.wave >> 2, sl = F.wave & 3; const int bh = F.bid * 2 + pr, dv0 = 16 * sl;
    const float* GL = (const float*)(a->ws + WS_GL) + bh * 64; unsigned char* rec0 = a->ws + WS_GPREP + (size_t)bh * 64 * GCH;
    LAS unsigned char* ring = F.lds + pr * (3 * SC_SLOT);
    f32x4 S[4] = {{0.f, 0.f, 0.f, 0.f}, {0.f, 0.f, 0.f, 0.f}, {0.f, 0.f, 0.f, 0.f}, {0.f, 0.f, 0.f, 0.f}};
    const float glv = GL[lane];
    asm volatile("s_waitcnt vmcnt(0)" ::: "memory");
    scan_dma(ring, rec0, sl, lane); scan_dma(ring + SC_SLOT, rec0 + GCH, sl, lane);
#pragma unroll 1
    for (int n = 0; n < 64; ++n) {
        unsigned char* rn = rec0 + (size_t)n * GCH; const LAS unsigned char* slot = ring + (n % 3) * SC_SLOT;
        if (n == 0) asm volatile("s_waitcnt vmcnt(6)" ::: "memory"); else if (n == 1) asm volatile("s_waitcnt vmcnt(10)" ::: "memory");
        else if (n == 63) asm volatile("s_waitcnt vmcnt(8)" ::: "memory"); else asm volatile("s_waitcnt vmcnt(14)" ::: "memory");
        __builtin_amdgcn_s_barrier(); asm volatile("" ::: "memory");
        if (n + 2 < 64) scan_dma(ring + ((n + 2) % 3) * SC_SLOT, rn + 2 * (size_t)GCH, sl, lane);
        else { asm volatile("" ::: "memory"); }
        const float egl = __int_as_float(__builtin_amdgcn_readlane(__float_as_int(glv), n));
        const bf16x8 Sb0 = pack_c2(S[0], S[1]), Sb1 = pack_c2(S[2], S[3]);
        if (!(SV & 1)) { bf16x8* ss = (bf16x8*)(rn + GC_SS + sl * 2048) + lane; ss[0] = Sb0; ss[64] = Sb1; }
        f32x4 vn[4];
#pragma unroll
        for (int mt = 0; mt < 4; ++mt) {
            f32x4 acc = {0.f, 0.f, 0.f, 0.f};
            acc = mfma16(scan_lfrag(slot, mt, 0, li, g), Sb0, acc); acc = mfma16(scan_lfrag(slot, mt, 1, li, g), Sb1, acc);
            const int urow = dv0 + li; const u32x2 uu = *(const LAS u32x2*)(slot + 16384 + urow * 128 + (((((16 * mt + 4 * g) >> 3) ^ (urow >> 1)) & 7) << 4) + (((16 * mt + 4 * g) & 7) << 1));
            vn[mt][0] = bf2f(uu.x & 0xffffu) - acc[0]; vn[mt][1] = bf2f(uu.x >> 16) - acc[1]; vn[mt][2] = bf2f(uu.y & 0xffffu) - acc[2]; vn[mt][3] = bf2f(uu.y >> 16) - acc[3];
        }
        const bf16x8 Vb0 = pack_c2(vn[0], vn[1]), Vb1 = pack_c2(vn[2], vn[3]);
        if (!(SV & 1)) { bf16x8* vb = (bf16x8*)(rn + GC_VB + sl * 2048) + lane; vb[0] = Vb0; vb[64] = Vb1; }
#pragma unroll
        for (int mt = 0; mt < 4; ++mt) { f32x4 acc = S[mt] * egl; acc = mfma16(scan_lfrag(slot + 8192, mt, 0, li, g), Vb0, acc); acc = mfma16(scan_lfrag(slot + 8192, mt, 1, li, g), Vb1, acc); S[mt] = acc; }
        if ((SV & 1) || n + 2 >= 64) { }
    }
    asm volatile("s_waitcnt vmcnt(0)" ::: "memory"); asm volatile("" :: "v"(S[0][0]), "v"(S[1][1]), "v"(S[2][2]), "v"(S[3][3]));
    __syncthreads();
}

__device__ __forceinline__ void gdn_out_chunk(const Frame& F, ArgsP a, int ci, LAS unsigned char* wl) {
    int lane_ = F.lane; asm volatile("" : "+v"(lane_)); const int lane = lane_, li = lane & 15, g = lane >> 4; const int bh = ci >> 6, n = ci & 63, b = bh >> 2, h = bh & 3;
    const unsigned char* rec = a->ws + WS_GPREP + (size_t)ci * GCH; bf16* Y = (bf16*)(a->ws + WS_Y);
    bf16x8 QDf[4][2], QKf[4][2];
#pragma unroll
    for (int mt = 0; mt < 4; ++mt) { QDf[mt][0] = scan_frag(rec + GC_QD, mt, 0, li, g); QDf[mt][1] = scan_frag(rec + GC_QD, mt, 1, li, g); QKf[mt][0] = scan_frag(rec + GC_QK, mt, 0, li, g); QKf[mt][1] = scan_frag(rec + GC_QK, mt, 1, li, g); }
    float ssq[4][4];
#pragma unroll
    for (int mt = 0; mt < 4; ++mt)
#pragma unroll
        for (int r = 0; r < 4; ++r) ssq[mt][r] = 0.f;
    f32x4 o[4][4];
#pragma unroll
    for (int sl = 0; sl < 4; ++sl) {
        const bf16x8* ss = (const bf16x8*)(rec + GC_SS + sl * 2048) + lane; const bf16x8* vb = (const bf16x8*)(rec + GC_VB + sl * 2048) + lane;
        const bf16x8 Sb0 = ss[0], Sb1 = ss[64], Vb0 = vb[0], Vb1 = vb[64];
#pragma unroll
        for (int mt = 0; mt < 4; ++mt) {
            f32x4 acc = {0.f, 0.f, 0.f, 0.f};
            acc = mfma16(QDf[mt][0], Sb0, acc); acc = mfma16(QDf[mt][1], Sb1, acc); acc = mfma16(QKf[mt][0], Vb0, acc); acc = mfma16(QKf[mt][1], Vb1, acc);
            o[sl][mt] = acc;
#pragma unroll
            for (int r = 0; r < 4; ++r) ssq[mt][r] += acc[r] * acc[r];
        }
    }
#pragma unroll
    for (int mt = 0; mt < 4; ++mt)
#pragma unroll
        for (int r = 0; r < 4; ++r) ssq[mt][r] = __builtin_amdgcn_rsqf(row16_sum(ssq[mt][r]) * (1.f / 64.f) + 1e-6f);
#pragma unroll
    for (int sl = 0; sl < 4; ++sl)
#pragma unroll
        for (int mt = 0; mt < 4; ++mt) {
            const u32x2 zz = *(const u32x2*)(rec + GC_ZT + (16 * sl + li) * 128 + (16 * mt + 4 * g) * 2);
            const float zf[4] = {bf2f(zz.x & 0xffffu), bf2f(zz.x >> 16), bf2f(zz.y & 0xffffu), bf2f(zz.y >> 16)};
#pragma unroll
            for (int r = 0; r < 4; ++r) *(LAS bf16*)(wl + tsw(16 * mt + 4 * g + r, 16 * sl + li)) = (bf16)f2bf(o[sl][mt][r] * ssq[mt][r] * zf[r]);
        }
    LDS_WAIT();
    bf16* yrow = Y + ((size_t)b * SEQ + 64 * n + lane) * DM + 512 + h * 64;
#pragma unroll
    for (int c = 0; c < 8; ++c) *(u32x4*)(yrow + 8 * c) = *(const LAS u32x4*)(wl + tsw(lane, 8 * c));
    LDS_WAIT();
}

constexpr int AT_K = 0, AT_V = 32768, AT_IMP = 65536, AT_SELM = AT_IMP + 64 * 68 * 4, AT_UNI = AT_SELM + 512, AT_YS = 83968;
__device__ __forceinline__ s16x4 tr_read0(unsigned addr) { s16x4 r; asm volatile("ds_read_b64_tr_b16 %0, %1" : "=&v"(r) : "v"(addr) : "memory"); return r; }

__device__ __forceinline__ float half_max(float x) { auto rr = __builtin_amdgcn_permlane32_swap(__float_as_uint(x), __float_as_uint(x), false, false); return fmaxf(__uint_as_float(rr[0]), __uint_as_float(rr[1])); }
__device__ __forceinline__ float half_sum(float x) { auto rr = __builtin_amdgcn_permlane32_swap(__float_as_uint(x), __float_as_uint(x), false, false); return __uint_as_float(rr[0]) + __uint_as_float(rr[1]); }
struct AttnStage { u32x4 kr, vr; };
__device__ __forceinline__ void at_gload(AttnStage& st, const bf16* Kb, const bf16* Vb, size_t stride, int j, int tid) {
    const int row = tid >> 3, ch = tid & 7; const size_t off = (size_t)(64 * j + row) * stride + 8 * ch;
    st.kr = *(const u32x4*)(Kb + off); st.vr = *(const u32x4*)(Vb + off);
}
__device__ __forceinline__ void at_swrite(const AttnStage& st, LAS unsigned char* lds, int buf, int tid) {
    const int row = tid >> 3, ch = tid & 7; const int o = row * 128 + (((ch ^ (row >> 1)) & 7) << 4);
    *(LAS u32x4*)(lds + AT_K + buf * 8192 + o) = st.kr; *(LAS u32x4*)(lds + AT_V + buf * 8192 + o) = st.vr;
}
__device__ __forceinline__ void at_qk(const LAS unsigned char* Kt, const bf16x8 (&Qf)[4], int r, int hf, f32x16 (&s)[2], float cinit) {
    const int swz = (r >> 1) & 7;
    bf16x8 kf[2][4];
#pragma unroll
    for (int kt = 0; kt < 2; ++kt)
#pragma unroll
        for (int ks = 0; ks < 4; ++ks) kf[kt][ks] = *(const LAS bf16x8*)(Kt + (32 * kt + r) * 128 + (((2 * ks + hf) ^ swz) << 4));
    SBAR();
#pragma unroll
    for (int kt = 0; kt < 2; ++kt) {
        f32x16 acc;
#pragma unroll
        for (int e = 0; e < 16; ++e) acc[e] = cinit;
#pragma unroll
        for (int ks = 0; ks < 4; ++ks) acc = mfma32(kf[kt][ks], Qf[ks], acc);
        s[kt] = acc;
    }
}
template <bool LSUM>
__device__ __forceinline__ void at_pv(unsigned vbase, const unsigned (&voff)[2][2], const f32x16 (&p)[2], f32x16 (&o)[2], f32x16& lacc) {
    const bf16x8 ones = {0x3F80, 0x3F80, 0x3F80, 0x3F80, 0x3F80, 0x3F80, 0x3F80, 0x3F80};
#pragma unroll
    for (int kt = 0; kt < 2; ++kt) {
        s16x4 vr[2][2][2];
#pragma unroll
        for (int s = 0; s < 2; ++s) { const unsigned co = vbase + (unsigned)(4096 * kt + 2048 * s);
            vr[s][0][0] = tr_read0(co + voff[0][0]); vr[s][1][0] = tr_read0(co + voff[1][0]); vr[s][0][1] = tr_read0(co + voff[0][1]); vr[s][1][1] = tr_read0(co + voff[1][1]); }
        bf16x8 pb[2];
#pragma unroll
        for (int s = 0; s < 2; ++s) { u32x4 pw; pw.x = pk2(p[kt][8 * s + 0], p[kt][8 * s + 1]); pw.y = pk2(p[kt][8 * s + 2], p[kt][8 * s + 3]); pw.z = pk2(p[kt][8 * s + 4], p[kt][8 * s + 5]); pw.w = pk2(p[kt][8 * s + 6], p[kt][8 * s + 7]); pb[s] = as_bf16x8(pw); }
        asm volatile("s_waitcnt lgkmcnt(0)" ::: "memory"); SBAR();
#pragma unroll
        for (int s = 0; s < 2; ++s) {
            const s16x4 l0 = vr[s][0][0], h0 = vr[s][1][0], l1 = vr[s][0][1], h1 = vr[s][1][1];
            const bf16x8 v0 = {l0[0], l0[1], l0[2], l0[3], h0[0], h0[1], h0[2], h0[3]}, v1 = {l1[0], l1[1], l1[2], l1[3], h1[0], h1[1], h1[2], h1[3]};
            o[0] = mfma32(v0, pb[s], o[0]); o[1] = mfma32(v1, pb[s], o[1]);
            if (LSUM) lacc = mfma32(ones, pb[s], lacc);
        }
    }
}

struct AttnRow { int r, hf, tt, t, qb, wave; unsigned long long wave_union; float m, lpart; };
struct TileInfo { int hi, lo; bool rowok, edge, work, fresh; };
template <int MODE, int VAR>
__device__ __forceinline__ void at_tile_qk(const Frame& F, int j, int stg, const bf16x8 (&Qf)[4], const AttnRow& R, float mfin, f32x16 (&s)[2], TileInfo& I) {
    LAS unsigned char* lds = F.lds;
    I.work = true; if (MODE == 2) I.work = (R.wave_union >> j) & 1ull;
    I.hi = 1000; I.lo = -1000; I.rowok = true; I.edge = false;
    if (MODE <= 1) { I.hi = ((R.t - 31) >> 4) - 64 * j - 4 * R.hf; I.edge = (64 * j + 63) > ((64 * R.qb + 8 * R.wave - 31) >> 4); }
    if (MODE == 2) { const unsigned long long sm = *(const LAS unsigned long long*)(lds + AT_SELM + 8 * R.tt); I.rowok = (sm >> j) & 1ull; if (j == R.qb) { I.hi = R.tt - 4 * R.hf; I.edge = true; } }
    if (MODE == 3) { if (j == R.qb) { I.hi = R.tt - 4 * R.hf; I.edge = true; } if (j == R.qb - 8) { I.lo = R.tt + 1 - 4 * R.hf; I.edge = true; } }
    const float mref = (MODE == 1) ? mfin : R.m; I.fresh = mref < -1e29f;
    const float cinit = I.rowok ? (I.fresh ? 0.f : -mref) : -INFINITY;
    if (I.work) { if (VAR & 64) { for (int e = 0; e < 16; ++e) { s[0][e] = Qf[0][0] * 1e-9f; s[1][e] = Qf[1][1] * 1e-9f; } } else at_qk(lds + AT_K + stg * 8192, Qf, R.r, R.hf, s, cinit); }
}
template <int MODE, int VAR>
__device__ __forceinline__ float at_tile_fin(const Frame& F, int j, int stg, f32x16 (&s)[2], const TileInfo& I, AttnRow& R, const unsigned (&voff)[2][2], f32x16 (&o)[2], f32x16& lacc, float invl, float preshift) {
    constexpr bool LS = (MODE >= 2) && (VAR == 0);
    LAS unsigned char* lds = F.lds; float shift_out = 0.f;
    if (!I.work) return 0.f;
    const int hi = I.hi, lo = I.lo; const bool edge = I.edge;
    if (MODE == 1) {
        if (edge) {
#pragma unroll
            for (int kt = 0; kt < 2; ++kt)
#pragma unroll
                for (int e = 0; e < 16; ++e) { const int cst = 32 * kt + (e & 3) + 8 * (e >> 2); s[kt][e] = (cst <= hi) ? fexp2(s[kt][e]) * invl : 0.f; }
        } else {
#pragma unroll
            for (int kt = 0; kt < 2; ++kt)
#pragma unroll
                for (int e = 0; e < 16; ++e) s[kt][e] = fexp2(s[kt][e]) * invl;
        }
        LAS float* imp = (LAS float*)(lds + AT_IMP) + R.tt * 68;
#pragma unroll
        for (int kt = 0; kt < 2; ++kt)
#pragma unroll
            for (int rg = 0; rg < 4; ++rg) {
                float av = 2.f * (s[kt][4 * rg] + s[kt][4 * rg + 1] + s[kt][4 * rg + 2]) + s[kt][4 * rg + 3], bv = s[kt][4 * rg + 3];
                av += __int_as_float(__builtin_amdgcn_update_dpp(0, __float_as_int(av), 0xB1, 0xf, 0xf, true)); av += __int_as_float(__builtin_amdgcn_update_dpp(0, __float_as_int(av), 0x4E, 0xf, 0xf, true));
                bv += __int_as_float(__builtin_amdgcn_update_dpp(0, __float_as_int(bv), 0xB1, 0xf, 0xf, true)); bv += __int_as_float(__builtin_amdgcn_update_dpp(0, __float_as_int(bv), 0x4E, 0xf, 0xf, true));
                if ((R.r & 3) == 0) { const int jb = 16 * j + 8 * kt + 2 * rg + R.hf; (void)__hip_atomic_fetch_add(imp + jb, av, __ATOMIC_RELAXED, __HIP_MEMORY_SCOPE_WORKGROUP); (void)__hip_atomic_fetch_add(imp + jb + 1, bv, __ATOMIC_RELAXED, __HIP_MEMORY_SCOPE_WORKGROUP); }
            }
        if (VAR & 16) { o[0][0] += s[0][3] + s[1][7]; } else at_pv<false>((unsigned)(size_t)(lds + AT_V + stg * 8192), voff, s, o, lacc);
    } else if (VAR & 32) { R.lpart += s[0][1]; if (MODE >= 2) { if (VAR & 16) { o[0][0] += s[0][3]; } else at_pv<false>((unsigned)(size_t)(lds + AT_V + stg * 8192), voff, s, o, lacc); } }
    else {
        constexpr float THR = 8.f;
        if (__any(preshift != 0.f)) {
#pragma unroll
            for (int kt = 0; kt < 2; ++kt)
#pragma unroll
                for (int e = 0; e < 16; ++e) s[kt][e] -= preshift;
        }
        const bool fresh = R.m < -1e29f;
        if (edge) {
#pragma unroll
            for (int kt = 0; kt < 2; ++kt)
#pragma unroll
                for (int e = 0; e < 16; ++e) { const int cst = 32 * kt + (e & 3) + 8 * (e >> 2); const bool ok = (cst <= hi) && (cst >= lo); s[kt][e] = ok ? s[kt][e] : -INFINITY; }
        }
        float tm4[4] = {-INFINITY, -INFINITY, -INFINITY, -INFINITY};
#pragma unroll
        for (int kt = 0; kt < 2; ++kt)
#pragma unroll
            for (int e = 0; e < 16; e += 2) tm4[(e >> 1) & 3] = fmaxf(tm4[(e >> 1) & 3], fmaxf(s[kt][e], s[kt][e + 1]));
        const float tmax = half_max(fmaxf(fmaxf(tm4[0], tm4[1]), fmaxf(tm4[2], tm4[3])));
        const bool raise = (tmax > -INFINITY) && (fresh || tmax > THR);
        if (__any(raise)) {
            const float shift = raise ? tmax : 0.f, alpha = (raise && !fresh) ? fexp2(-shift) : 1.f;
            R.m = raise ? (fresh ? tmax : R.m + tmax) : R.m; R.lpart *= alpha; shift_out = shift;
#pragma unroll
            for (int kt = 0; kt < 2; ++kt)
#pragma unroll
                for (int e = 0; e < 16; ++e) s[kt][e] -= shift;
            if (MODE >= 2) {
#pragma unroll
                for (int e = 0; e < 16; ++e) { o[0][e] *= alpha; o[1][e] *= alpha; if (LS) lacc[e] *= alpha; } }
        }
        if (LS) {
#pragma unroll
            for (int kt = 0; kt < 2; ++kt)
#pragma unroll
                for (int e = 0; e < 16; ++e) s[kt][e] = fexp2(s[kt][e]);
            at_pv<true>((unsigned)(size_t)(lds + AT_V + stg * 8192), voff, s, o, lacc);
        } else {
        float ps4[4] = {0.f, 0.f, 0.f, 0.f};
#pragma unroll
        for (int kt = 0; kt < 2; ++kt)
#pragma unroll
            for (int e = 0; e < 16; ++e) { s[kt][e] = fexp2(s[kt][e]); ps4[e & 3] += s[kt][e]; }
        R.lpart += (ps4[0] + ps4[1]) + (ps4[2] + ps4[3]);
        if (MODE >= 2) { if (VAR & 16) { o[0][0] += s[0][3] + s[1][7]; } else at_pv<false>((unsigned)(size_t)(lds + AT_V + stg * 8192), voff, s, o, lacc); }
        }
    }
    return shift_out;
}
template <int MODE, int VAR = 0>
__device__ __forceinline__ void at_branch(const Frame& F, unsigned long long mask, const bf16* Kb, const bf16* Vb, size_t stride, const bf16x8 (&Qf)[4], AttnRow& R, const unsigned (&voff)[2][2],
                                          f32x16 (&o)[2], f32x16& lacc, float mfin, float invl) {
    LAS unsigned char* lds = F.lds; const int tid = F.tid;
    if (mask == 0ull) return;
    AttnStage st0, st1; int sg = 0;
    { const int j0 = __builtin_ctzll(mask); at_gload(st0, Kb, Vb, stride, j0, tid); at_swrite(st0, lds, 0, tid);
      const unsigned long long m1 = mask & (mask - 1ull); if (m1) { at_gload(st1, Kb, Vb, stride, __builtin_ctzll(m1), tid); at_swrite(st1, lds, 1, tid); } }
    __syncthreads();
    while (mask) {
        const int j0 = __builtin_ctzll(mask); mask &= mask - 1ull;
        int j1 = -1; if (mask) { j1 = __builtin_ctzll(mask); mask &= mask - 1ull; }
        int n0 = -1, n1 = -1; { unsigned long long mm = mask; if (mm) { n0 = __builtin_ctzll(mm); mm &= mm - 1ull; if (mm) n1 = __builtin_ctzll(mm); } }
        at_gload(st0, Kb, Vb, stride, n0 >= 0 ? n0 : j0, tid);
        at_gload(st1, Kb, Vb, stride, n1 >= 0 ? n1 : j0, tid);
        { f32x16 sa[2]; TileInfo Ia;
          at_tile_qk<MODE, VAR>(F, j0, sg, Qf, R, mfin, sa, Ia);
          (void)at_tile_fin<MODE, VAR>(F, j0, sg, sa, Ia, R, voff, o, lacc, invl, 0.f); }
        if (j1 >= 0) { f32x16 sb[2]; TileInfo Ib;
          at_tile_qk<MODE, VAR>(F, j1, sg + 1, Qf, R, mfin, sb, Ib);
          (void)at_tile_fin<MODE, VAR>(F, j1, sg + 1, sb, Ib, R, voff, o, lacc, invl, 0.f); }
        if (n0 >= 0) at_swrite(st0, lds, (sg + 2) & 3, tid);
        if (n1 >= 0) at_swrite(st1, lds, (sg + 3) & 3, tid);
        __syncthreads();
        sg = (sg + 2) & 3;
    }
}

template <int VAR>
__device__ __forceinline__ void attn_item(const Frame& F, ArgsP a, int l, int item) {
    const int qb = 63 - (item >> 4), bh = item & 15, b = bh >> 1, hk = bh & 1; const int lane = F.lane, wave = F.wave;
    const bf16* H = (const bf16*)(a->ws + WS_H); const float* side = (const float*)(a->ws + WS_SIDE); bf16* Y = (bf16*)(a->ws + WS_Y);
    LAS unsigned char* lds = F.lds;
    AttnRow R; R.r = lane & 31; R.hf = lane >> 5; R.tt = 8 * wave + (R.r >> 2); R.t = 64 * qb + R.tt; R.qb = qb; R.wave = wave; R.wave_union = 0ull;
    const int head = hk * 4 + (R.r & 3); const size_t tok = (size_t)b * SEQ + R.t;
    bf16x8 Qf[4];
#pragma unroll
    for (int ks = 0; ks < 4; ++ks) Qf[ks] = *(const bf16x8*)(H + tok * HLD + head * 64 + 16 * ks + 8 * R.hf);
    const float g_cmp = side[tok * 32 + head * 3], g_sel = side[tok * 32 + head * 3 + 1], g_win = side[tok * 32 + head * 3 + 2];
    unsigned voff[2][2];
    { const int li = lane & 15, q = li >> 2, p = li & 3, gi1 = (lane >> 4) & 1;
#pragma unroll
      for (int jh = 0; jh < 2; ++jh)
#pragma unroll
          for (int dt = 0; dt < 2; ++dt) voff[jh][dt] = (unsigned)((8 * jh + 4 * R.hf + q) * 128 + ((((4 * dt + 2 * gi1 + (p >> 1)) ^ (4 * jh + 2 * R.hf + (q >> 1))) & 7) << 4) + (p & 1) * 8); }
    { LAS float* imp = (LAS float*)(lds + AT_IMP) + (8 * wave) * 68; for (int i = lane; i < 8 * 68; i += 64) imp[i] = 0.f; if (F.tid == 0) { *(LAS unsigned*)(lds + AT_UNI) = 0u; *(LAS unsigned*)(lds + AT_UNI + 4) = 0u; } }
    f32x16 o[2], lacc;
#pragma unroll
    for (int e = 0; e < 16; ++e) { o[0][e] = 0.f; o[1][e] = 0.f; lacc[e] = 0.f; }
    LAS float* ys = (LAS float*)(lds + AT_YS + wave * 8192) + lane;
    {
        const bf16* Kc = (const bf16*)(a->ws + WS_KC) + (size_t)bh * 256 * 64; const bf16* Vc = (const bf16*)(a->ws + WS_VC) + (size_t)bh * 256 * 64;
        const int ntc = (4 * qb + 3 + 63) >> 6; const unsigned long long mc = (ntc >= 64) ? ~0ull : ((1ull << ntc) - 1ull);
        R.m = -1e30f; R.lpart = 0.f;
        if (!(VAR & 8)) at_branch<0, VAR>(F, mc, Kc, Vc, 64, Qf, R, voff, o, lacc, 0.f, 0.f);
        const float lsum = half_sum(R.lpart); const float invl = 1.f / fmaxf(lsum, 1e-30f);
        if (!(VAR & 8)) at_branch<1, VAR>(F, mc, Kc, Vc, 64, Qf, R, voff, o, lacc, R.m, invl);
#pragma unroll
        for (int e = 0; e < 16; ++e) { ys[e * 64] = g_cmp * o[0][e]; ys[(16 + e) * 64] = g_cmp * o[1][e]; o[0][e] = 0.f; o[1][e] = 0.f; }
    }
    LDS_WAIT();
    {
        unsigned long long wu = 0ull;
        for (int q0 = 0; q0 < 8; q0 += 4) {
            unsigned long long selm[4];
            if (qb < 16) { selm[0] = selm[1] = selm[2] = selm[3] = (2ull << qb) - 1ull; }
            else {
                const bool cand = (lane >= 1) && (lane <= qb - 2); unsigned key[4], thr[4];
#pragma unroll
                for (int u = 0; u < 4; ++u) { const float v = ((const LAS float*)(lds + AT_IMP))[(8 * wave + q0 + u) * 68 + lane]; key[u] = cand ? __float_as_uint(fmaxf(v, 0.f)) : 0u; thr[u] = 0u; }
                for (int bit = 30; bit >= 0; --bit) {
#pragma unroll
                    for (int u = 0; u < 4; ++u) { const unsigned tr = thr[u] | (1u << bit); const int c = __popcll(__ballot(cand && key[u] >= tr)); if (c >= 13) thr[u] = tr; } }
#pragma unroll
                for (int u = 0; u < 4; ++u) {
                    const unsigned long long gt = __ballot(cand && key[u] > thr[u]), eq = __ballot(cand && key[u] == thr[u]);
                    int need = 13 - __popcll(gt); unsigned long long eqs = 0ull, e2 = eq;
                    while (need > 0 && e2) { const unsigned long long low = e2 & (~e2 + 1ull); eqs |= low; e2 ^= low; --need; }
                    selm[u] = gt | eqs | 1ull | (1ull << qb) | (1ull << (qb - 1)); }
            }
#pragma unroll
            for (int u = 0; u < 4; ++u) {
                if (lane == 0) *(LAS unsigned long long*)(lds + AT_SELM + 8 * (8 * wave + q0 + u)) = selm[u];
#if defined(SELFCHECK) && SELFCHECK == 1
                if (lane == 0 && l == 1) ((unsigned long long*)(a->ws + (size_t)984 * MiB + 64 * KiB))[(size_t)bh * SEQ + 64 * qb + 8 * wave + q0 + u] = selm[u];
#endif
                wu |= selm[u]; }
        }
        R.wave_union = wu;
        if (lane == 0) { __hip_atomic_fetch_or((LAS unsigned*)(lds + AT_UNI), (unsigned)wu, __ATOMIC_RELAXED, __HIP_MEMORY_SCOPE_WORKGROUP); __hip_atomic_fetch_or((LAS unsigned*)(lds + AT_UNI + 4), (unsigned)(wu >> 32), __ATOMIC_RELAXED, __HIP_MEMORY_SCOPE_WORKGROUP); }
    }
    __syncthreads();
    const unsigned long long bunion = (unsigned long long)*(const LAS unsigned*)(lds + AT_UNI) | ((unsigned long long)*(const LAS unsigned*)(lds + AT_UNI + 4) << 32);
    const bf16* Hb = H + (size_t)b * SEQ * HLD;
    {
        R.m = -1e30f; R.lpart = 0.f;
        if (!(VAR & 2)) at_branch<2, VAR>(F, bunion, Hb + 512 + 2 * 128 + hk * 64, Hb + 512 + 3 * 128 + hk * 64, HLD, Qf, R, voff, o, lacc, 0.f, 0.f);
        const float lsum = (VAR == 0) ? lacc[0] : half_sum(R.lpart);
#pragma unroll
        for (int e = 0; e < 16; ++e) lacc[e] = 0.f; const float sc = g_sel / fmaxf(lsum, 1e-30f);
#pragma unroll
        for (int e = 0; e < 16; ++e) { ys[e * 64] += sc * o[0][e]; ys[(16 + e) * 64] += sc * o[1][e]; o[0][e] = 0.f; o[1][e] = 0.f; }
    }
    {
        const int lo = qb - 8 > 0 ? qb - 8 : 0; const unsigned long long mw = ((2ull << qb) - 1ull) & ~((1ull << lo) - 1ull);
        R.m = -1e30f; R.lpart = 0.f;
        if (!(VAR & 4)) at_branch<3, VAR>(F, mw, Hb + 512 + 4 * 128 + hk * 64, Hb + 512 + 5 * 128 + hk * 64, HLD, Qf, R, voff, o, lacc, 0.f, 0.f);
        const float lsum = (VAR == 0) ? lacc[0] : half_sum(R.lpart); const float sc = g_win / fmaxf(lsum, 1e-30f);
#pragma unroll
        for (int e = 0; e < 16; ++e) { o[0][e] = ys[e * 64] + sc * o[0][e]; o[1][e] = ys[(16 + e) * 64] + sc * o[1][e]; }
    }
    if (VAR & 1) { asm volatile("" :: "v"(o[0][0]), "v"(o[1][5])); return; }
    bf16* yrow = Y + tok * DM + head * 64 + 4 * R.hf;
#pragma unroll
    for (int dt = 0; dt < 2; ++dt)
#pragma unroll
        for (int rg = 0; rg < 4; ++rg) { u32x2 w; w.x = pk2(o[dt][4 * rg], o[dt][4 * rg + 1]); w.y = pk2(o[dt][4 * rg + 2], o[dt][4 * rg + 3]); *(u32x2*)(yrow + 32 * dt + 8 * rg) = w; }
}

__device__ __forceinline__ void phase_mix_b(const Frame& F, ArgsP a, int l, int rep) {
    unsigned* q = F.ctl + CW_QUEUE + l * 64 + rep * 32;
    for (;;) {
        if (F.tid == 0) F.MISC[0] = __hip_atomic_fetch_add(q, 1u, __ATOMIC_RELAXED, __HIP_MEMORY_SCOPE_AGENT);
        __syncthreads();
        const int item = (int)F.MISC[0];
        __syncthreads();
        if (item >= 1024) break;
        if (rep == 0) attn_item<0>(F, a, l, item); else attn_item<PROBE_ATTN_VAR>(F, a, l, item);
    }
}

constexpr size_t WS_DBG = 984 * MiB;
constexpr int CHECK_LAYER = 1;
__device__ __forceinline__ void dbg_add(ArgsP a, int i, float v) { atomicAdd((float*)(a->ws + WS_DBG) + i, v); }

__device__ __forceinline__ void check_nsa(const Frame& F, ArgsP a) {
    const bf16* H = (const bf16*)(a->ws + WS_H); const float* side = (const float*)(a->ws + WS_SIDE); const bf16* Y = (const bf16*)(a->ws + WS_Y);
    const unsigned long long* SELM = (const unsigned long long*)(a->ws + WS_DBG + 64 * KiB);
    const int lane = F.lane; const int tv[16] = {5, 40, 63, 64, 100, 511, 512, 1023, 1024, 1500, 2047, 2048, 3000, 3333, 4000, 4095};
    for (int s = F.bid * NWAVES + F.wave; s < 256; s += F.G * NWAVES) {
        int t = tv[0];
#pragma unroll
        for (int q = 1; q < 16; ++q) t = ((s & 15) == q) ? tv[q] : t;
        const int b = (s >> 4) & 7, hq = ((s >> 7) * 5 + (s & 7)) & 7, hk = hq >> 2; const size_t tok = (size_t)b * SEQ + t; const int bhk = b * 2 + hk;
        const bf16* KC = (const bf16*)(a->ws + WS_KC) + (size_t)bhk * 256 * 64; const bf16* VC = (const bf16*)(a->ws + WS_VC) + (size_t)bhk * 256 * 64;
        const float g_cmp = side[tok * 32 + hq * 3], g_sel = side[tok * 32 + hq * 3 + 1], g_win = side[tok * 32 + hq * 3 + 2];
        const int cmax = (t - 31) >> 4; float imp = 0.f, ocmp = 0.f;
        for (int gh = 0; gh < 4; ++gh) {
            const int head = hk * 4 + gh; const float qd = bf2f(H[tok * HLD + head * 64 + lane]);
            float m = -INFINITY, l = 0.f;
            for (int c = 0; c <= cmax; ++c) m = fmaxf(m, wave_sum(qd * bf2f(KC[c * 64 + lane])));
            for (int c = 0; c <= cmax; ++c) l += fexp2(wave_sum(qd * bf2f(KC[c * 64 + lane])) - m);
            for (int c = 0; c <= cmax; ++c) { const float p = fexp2(wave_sum(qd * bf2f(KC[c * 64 + lane])) - m) / l; const int j = c >> 2, e = c & 3;
                if (lane == j) imp += (e < 3 ? 2.f : 1.f) * p; if (e == 3 && lane == j + 1) imp += p;
                if (head == hq) ocmp += p * bf2f(VC[c * 64 + lane]); }
        }
        const int cur = t >> 6; const bool causal = lane <= cur, forced = (lane == 0) || (lane == cur) || (lane == cur - 1);
        const float key = causal ? (imp + (forced ? 1.0e4f : 0.f)) : -INFINITY; int rank = 0;
        for (int i = 0; i < 64; ++i) { const float ki = __shfl(key, i); rank += ((ki > key) || (ki == key && i < lane)) ? 1 : 0; }
        const unsigned long long refm = __ballot(causal && rank < 16), stm = SELM[(size_t)bhk * SEQ + t];
        if (lane == 0) { dbg_add(a, 2, (float)__popcll(refm ^ stm)); dbg_add(a, 3, 16.f); }
        const float qd = bf2f(H[tok * HLD + hq * 64 + lane]); const bf16* Hb = H + (size_t)b * SEQ * HLD + hk * 64 + lane;
        float m = -INFINITY, l = 0.f, osel = 0.f;
        for (int j = 0; j <= cur; ++j) if ((stm >> j) & 1ull) for (int kk = 0; kk < 64; ++kk) { const int p = 64 * j + kk; if (p > t) break;
            const float sc = wave_sum(qd * bf2f(Hb[(size_t)p * HLD + 512 + 2 * 128])); const float mn = fmaxf(m, sc), al = fexp2(m - mn), pp = fexp2(sc - mn);
            l = l * al + pp; osel = osel * al + pp * bf2f(Hb[(size_t)p * HLD + 512 + 3 * 128]); m = mn; }
        const float ysel = osel / fmaxf(l, 1e-30f);
        m = -INFINITY; l = 0.f; float owin = 0.f;
        for (int p = (t - 511 > 0 ? t - 511 : 0); p <= t; ++p) { const float sc = wave_sum(qd * bf2f(Hb[(size_t)p * HLD + 512 + 4 * 128])); const float mn = fmaxf(m, sc), al = fexp2(m - mn), pp = fexp2(sc - mn);
            l = l * al + pp; owin = owin * al + pp * bf2f(Hb[(size_t)p * HLD + 512 + 5 * 128]); m = mn; }
        const float ref = g_cmp * ocmp + g_sel * ysel + g_win * owin / fmaxf(l, 1e-30f), got = bf2f(Y[tok * DM + hq * 64 + lane]);
        const float e2 = wave_sum((ref - got) * (ref - got)), r2 = wave_sum(ref * ref);
        if (lane == 0) { dbg_add(a, 0, e2); dbg_add(a, 1, r2); }
    }
}

__device__ __forceinline__ void check_gdn(const Frame& F, ArgsP a, int l) {
    if (F.bid >= 8) return;
    const bf16* H = (const bf16*)(a->ws + WS_H); const float* side = (const float*)(a->ws + WS_SIDE); const bf16* Y = (const bf16*)(a->ws + WS_Y);
    const int b = F.bid, h = (F.bid * 3) & 3, tid = F.tid, lane = F.lane, col = tid & 63, rg = tid >> 6;
    LAS float* S = (LAS float*)F.lds; LAS float* qv = S + 64 * 65; LAS float* kv = qv + 64; LAS float* vv = kv + 64; LAS float* sc = vv + 64; LAS float* part = sc + 64;
    for (int i = tid; i < 64 * 65; i += NTHR) S[i] = 0.f;
    float hq[3] = {0.f, 0.f, 0.f}, hk[3] = {0.f, 0.f, 0.f}, hv[3] = {0.f, 0.f, 0.f}, wq[4], wk[4], wv[4];
    { const float* cw = a->in[6] + (size_t)l * 4 * 768 + h * 64 + lane;
#pragma unroll
      for (int k = 0; k < 4; ++k) { wq[k] = cw[k * 768]; wk[k] = cw[k * 768 + 256]; wv[k] = cw[k * 768 + 512]; } }
    const float Aexp = __expf(a->in[7][l * 4 + h]), dtb = a->in[8][l * 4 + h], nw = a->in[9][l * 64 + lane];
    __syncthreads();
    for (int t = 0; t < 192; ++t) {
        const size_t tok = (size_t)b * SEQ + t;
        if (F.wave == 0) { const bf16* p = H + tok * HLD + 1280 + h * 64 + lane; const float rq = bf2f(p[0]), rk = bf2f(p[256]), rv = bf2f(p[512]);
            const float cq = wq[0] * hq[0] + wq[1] * hq[1] + wq[2] * hq[2] + wq[3] * rq, ck = wk[0] * hk[0] + wk[1] * hk[1] + wk[2] * hk[2] + wk[3] * rk, cv = wv[0] * hv[0] + wv[1] * hv[1] + wv[2] * hv[2] + wv[3] * rv;
            hq[0] = hq[1]; hq[1] = hq[2]; hq[2] = rq; hk[0] = hk[1]; hk[1] = hk[2]; hk[2] = rk; hv[0] = hv[1]; hv[1] = hv[2]; hv[2] = rv;
            const float qs = cq / (1.f + __expf(-cq)), ks = ck / (1.f + __expf(-ck)), vs = cv / (1.f + __expf(-cv));
            qv[lane] = qs / sqrtf(wave_sum(qs * qs) + 1e-6f); kv[lane] = ks / sqrtf(wave_sum(ks * ks) + 1e-6f); vv[lane] = vs;
            if (lane == 0) { const float av = side[tok * 32 + 28 + h] + dtb; const float sp = av > 20.f ? av : log1pf(__expf(av)); sc[0] = __expf(-Aexp * sp); sc[1] = side[tok * 32 + 24 + h]; } }
        __syncthreads();
        { float ps = 0.f;
#pragma unroll
          for (int r = 0; r < 8; ++r) ps += kv[8 * rg + r] * S[(8 * rg + r) * 65 + col];
          part[rg * 64 + col] = ps; }
        __syncthreads();
        { float ks = 0.f;
#pragma unroll
          for (int r = 0; r < 8; ++r) ks += part[r * 64 + col];
          const float eg = sc[0], be = sc[1]; float po = 0.f;
          __syncthreads();
#pragma unroll
          for (int r = 0; r < 8; ++r) { const int dk = 8 * rg + r; const float sn = eg * (S[dk * 65 + col] - be * kv[dk] * ks) + be * kv[dk] * vv[col]; S[dk * 65 + col] = sn; po += sn * qv[dk]; }
          part[rg * 64 + col] = po; }
        __syncthreads();
        if (F.wave == 0) { float o = 0.f;
#pragma unroll
            for (int r = 0; r < 8; ++r) o += part[r * 64 + lane];
            o *= 0.125f; const float rs = 1.f / sqrtf(wave_sum(o * o) * (1.f / 64.f) + 1e-6f); const float z = bf2f(H[tok * HLD + 2048 + h * 64 + lane]);
            const float ref = o * rs * nw * (z / (1.f + __expf(-z))), got = bf2f(Y[tok * DM + 512 + h * 64 + lane]);
            const float e2 = wave_sum((ref - got) * (ref - got)), r2 = wave_sum(ref * ref);
            if (lane == 0) { dbg_add(a, 4, e2); dbg_add(a, 5, r2); } }
        __syncthreads();
    }
}

__device__ __forceinline__ void check_moe(const Frame& F, ArgsP a, int l) {
    const bf16* XBc = (const bf16*)(a->ws + WS_XB); const bf16* Y2 = (const bf16*)(a->ws + WS_Y2);
    const int* route_e = (const int*)(a->ws + WS_SLOT + SL_RE); const float* route_w = (const float*)(a->ws + WS_SLOT + SL_RW);
    LAS float* x = (LAS float*)F.lds; LAS float* hid = x + 1024; LAS float* lg = hid + 512; LAS float* yr = lg + 64;
    const int tid = F.tid, lane = F.lane;
    for (int s = F.bid; s < 256; s += F.G) {
        const int t = (s * 4099 + 17) & (T - 1);
        for (int i = tid; i < 1024; i += NTHR) { x[i] = bf2f(XBc[(size_t)t * DM + i]); yr[i] = 0.f; }
        __syncthreads();
        for (int j = F.wave; j < 36; j += NWAVES) { float d = 0.f; for (int k = lane; k < DM; k += 64) d += x[k] * (j < 4 ? a->in[18][((size_t)l * DM + k) * 4 + j] : a->in[20][((size_t)l * DM + k) * NEXP + j - 4]);
            d = wave_sum(d); if (lane == 0) lg[j] = d + (j < 4 ? a->in[19][l * 4 + j] : a->in[21][l * NEXP + j - 4]); }
        __syncthreads();
        if (tid == 0) { int gi = 0; for (int i = 1; i < 4; ++i) if (lg[i] > lg[gi]) gi = i; float gs = 0.f; for (int i = 0; i < 4; ++i) gs += __expf(lg[i] - lg[gi]); const float gw = 1.f / gs;
            int i1 = 0; for (int i = 1; i < 8; ++i) if (lg[4 + gi * 8 + i] > lg[4 + gi * 8 + i1]) i1 = i; int i2 = -1; for (int i = 0; i < 8; ++i) if (i != i1 && (i2 < 0 || lg[4 + gi * 8 + i] > lg[4 + gi * 8 + i2])) i2 = i;
            const float e2 = __expf(lg[4 + gi * 8 + i2] - lg[4 + gi * 8 + i1]), w1 = gw / (1.f + e2), w2 = gw - w1;
            const int se1 = route_e[2 * t], se2 = route_e[2 * t + 1]; const float sw1 = route_w[2 * t], sw2 = route_w[2 * t + 1];
            dbg_add(a, 8, (se1 != gi * 8 + i1 ? 1.f : 0.f) + (se2 != gi * 8 + i2 ? 1.f : 0.f)); dbg_add(a, 9, 2.f);
            if (se1 == gi * 8 + i1 && se2 == gi * 8 + i2) { dbg_add(a, 10, (sw1 - w1) * (sw1 - w1) + (sw2 - w2) * (sw2 - w2)); dbg_add(a, 11, w1 * w1 + w2 * w2); } }
        for (int k2 = 0; k2 < 2; ++k2) {
            const int e = route_e[2 * t + k2]; const float rw = route_w[2 * t + k2];
            const float* wg = a->in[22] + ((size_t)l * NEXP + e) * DM * FF; const float* wu = a->in[23] + ((size_t)l * NEXP + e) * DM * FF; const float* wd = a->in[24] + ((size_t)l * NEXP + e) * FF * DM;
            { float g = 0.f, u = 0.f; for (int k = 0; k < DM; ++k) { g += x[k] * wg[(size_t)k * FF + tid]; u += x[k] * wu[(size_t)k * FF + tid]; } hid[tid] = g / (1.f + __expf(-g)) * u; }
            __syncthreads();
            for (int d = tid; d < DM; d += NTHR) { float y = 0.f; for (int f = 0; f < FF; ++f) y += hid[f] * wd[(size_t)f * DM + d]; yr[d] += y * rw; }
            __syncthreads();
        }
        float e2 = 0.f, r2 = 0.f;
        for (int d = tid; d < DM; d += NTHR) { const float got = bf2f(Y2[(size_t)(2 * t) * DM + d]) + bf2f(Y2[(size_t)(2 * t + 1) * DM + d]); e2 += (yr[d] - got) * (yr[d] - got); r2 += yr[d] * yr[d]; }
        e2 = wave_sum(e2); r2 = wave_sum(r2); if (lane == 0) { dbg_add(a, 6, e2); dbg_add(a, 7, r2); }
        __syncthreads();
    }
}

__device__ __forceinline__ void check_inproj(const Frame& F, ArgsP a, int l) {
    const bf16* H = (const bf16*)(a->ws + WS_H); const float* xin = (l == 0) ? a->in[0] : (const float*)a->out; const float* win = a->in[1] + (size_t)l * DM * DIN;
    const int lane = F.lane;
    for (int s = F.bid * NWAVES + F.wave; s < 1024; s += F.G * NWAVES) {
        const int tok = (s * 7919 + 13) & (T - 1), grp = s % 14, t = tok & (SEQ - 1);
        const int col0 = grp < 8 ? grp * 64 : 512 + (grp - 8) * 128 + ((s >> 4) & 1) * 64; const bool isq = grp < 8, rope = isq || ((grp - 8) % 2 == 0);
        float d = 0.f; for (int k = 0; k < DM; ++k) d += xin[(size_t)tok * DM + k] * win[(size_t)k * DIN + col0 + lane];
        if (rope) { const float inv[8] = {1.0f, 0.19392274f, 0.03760603f, 0.0072926646f, 0.0014142136f, 0.0002742482f, 5.3182957e-05f, 1.0313385e-05f};
            float iv = inv[0];
#pragma unroll
            for (int q = 1; q < 8; ++q) iv = ((lane & 7) == q) ? inv[q] : iv;
            const float ang = (float)t * iv, c = cosf(ang), sn = sinf(ang), other = __shfl_xor(d, 8);
            if (lane < 8) d = d * c - other * sn; else if (lane < 16) d = d * c + other * sn; }
        if (isq) d *= pg8::QSCALE;
        const float got = bf2f(H[(size_t)tok * HLD + col0 + lane]); const float e2 = wave_sum((d - got) * (d - got)), r2 = wave_sum(d * d);
        if (lane == 0) { dbg_add(a, 12, e2); dbg_add(a, 13, r2); }
    }
}
__device__ __forceinline__ void check_compress(const Frame& F, ArgsP a, int l) {
    const bf16* H = (const bf16*)(a->ws + WS_H); const int lane = F.lane;
    for (int s = F.bid * NWAVES + F.wave; s < 512; s += F.G * NWAVES) {
        const int kv = s & 1, bh = (s >> 1) & 15, b = bh >> 1, hh = bh & 1, i = (s * 53 + 7) % 255;
        const float* pe = a->in[3] + ((size_t)l * 2 + kv) * 2048; const float* w1 = a->in[4] + ((size_t)l * 2 + kv) * 2048 * 128; const float* w2 = a->in[5] + ((size_t)l * 2 + kv) * 128 * 64;
        float h0 = 0.f, h1 = 0.f;
        for (int k = 0; k < 2048; ++k) { const int p = k >> 6, d = k & 63; const float x = bf2f(H[((size_t)b * SEQ + 16 * i + p) * HLD + 512 + kv * 128 + hh * 64 + d]) + pe[k];
            h0 += x * w1[(size_t)k * 128 + lane]; h1 += x * w1[(size_t)k * 128 + 64 + lane]; }
        h0 = h0 / (1.f + __expf(-h0)); h1 = h1 / (1.f + __expf(-h1));
        float o = 0.f;
        for (int n = 0; n < 64; ++n) { o += __shfl(h0, n) * w2[(size_t)n * 64 + lane] + __shfl(h1, n) * w2[(size_t)(64 + n) * 64 + lane]; }
        const float got = bf2f(((const bf16*)(a->ws + (kv ? WS_VC : WS_KC)))[((size_t)bh * 256 + i) * 64 + lane]);
        const float e2 = wave_sum((o - got) * (o - got)), r2 = wave_sum(o * o); if (lane == 0) { dbg_add(a, 14, e2); dbg_add(a, 15, r2); }
    }
}
__device__ __forceinline__ void check_conformer(const Frame& F, ArgsP a, int l) {
    const bf16* H = (const bf16*)(a->ws + WS_H); const bf16* Y = (const bf16*)(a->ws + WS_Y); const int lane = F.lane;
    for (int s = F.bid * NWAVES + F.wave; s < 1024; s += F.G * NWAVES) {
        const int tok = (s * 6151 + 3) & (T - 1), t = tok & (SEQ - 1); float u[4];
#pragma unroll
        for (int j = 0; j < 4; ++j) { const int c = lane + 64 * j; float acc = a->in[11][l * 256 + c];
            for (int k = 0; k < 31; ++k) { const int sp = t - 30 + k; if (sp >= 0) { const bf16* hp = H + (size_t)(tok - 30 + k) * HLD + 2304 + c; const float g = bf2f(hp[256]); acc += a->in[10][((size_t)l * 31 + k) * 256 + c] * (bf2f(hp[0]) / (1.f + __expf(-g))); } }
            u[j] = acc; }
        const float mean = wave_sum(u[0] + u[1] + u[2] + u[3]) * (1.f / 256.f); float q = 0.f;
#pragma unroll
        for (int j = 0; j < 4; ++j) { u[j] -= mean; q += u[j] * u[j]; }
        const float rstd = 1.f / sqrtf(wave_sum(q) * (1.f / 256.f) + LN_EPS); float e2 = 0.f, r2 = 0.f;
#pragma unroll
        for (int j = 0; j < 4; ++j) { const int c = lane + 64 * j; const float v = u[j] * rstd * a->in[12][l * 256 + c] + a->in[13][l * 256 + c]; const float ref = v / (1.f + __expf(-v)), got = bf2f(Y[(size_t)tok * DM + 768 + c]);
            e2 += (ref - got) * (ref - got); r2 += ref * ref; }
        e2 = wave_sum(e2); r2 = wave_sum(r2); if (lane == 0) { dbg_add(a, 16, e2); dbg_add(a, 17, r2); }
    }
}
__device__ __forceinline__ void check_inject(const Frame& F, ArgsP a) {
    if (F.bid == 0 && F.tid == 0) { const float* d = (const float*)(a->ws + WS_DBG); float e0 = 0.f, e1 = 0.f;
        if (SELFCHECK == 1) { e0 = 1000.f * sqrtf(d[0] / d[1]); e1 = 1.0e4f * d[2] / d[3]; }
        if (SELFCHECK == 2) { e0 = 1000.f * sqrtf(d[4] / d[5]); }
        if (SELFCHECK == 3) { e0 = 1000.f * sqrtf(d[6] / d[7]); e1 = 1.0e4f * d[8] / d[9] + 1000.f * sqrtf(d[10] / fmaxf(d[11], 1e-30f)); }
        if (SELFCHECK == 4) { e0 = 1000.f * sqrtf(d[12] / d[13]); }
        if (SELFCHECK == 5) { e0 = 1000.f * sqrtf(d[14] / d[15]); e1 = 1000.f * sqrtf(d[16] / d[17]); }
        a->out[0] += e0; a->out[1] += e1; }
}


#ifndef MK_MULTI
#define MK_MULTI 0
#endif
#ifndef PROBE_REPEAT
#define PROBE_REPEAT 0
#endif
constexpr int N_PHASES = 1 + 10 * NL;
#ifndef TIMING
#define TIMING 0
#endif
#ifndef TA_LO
#define TA_LO 0
#define TA_HI 1
#define TB_LO 0
#define TB_HI 1
#endif
#define TSTAMP(i) do { if (TIMING) { if (F.bid == 0 && F.tid == 0) ((unsigned long long*)(args_here()->ws + (size_t)985 * MiB))[i] = __builtin_amdgcn_s_memrealtime(); } } while (0)
__device__ __forceinline__ Frame make_frame(int wave_s) {
    extern __shared__ __attribute__((aligned(16))) unsigned char lds_raw[];
    Frame F; F.lds = (LAS unsigned char*)lds_raw; F.MISC = (volatile LAS unsigned*)(F.lds + MISC_OFF);
    int tid = threadIdx.x, G = gridDim.x, bid = blockIdx.x; unsigned lb = (unsigned)(size_t)F.lds; (void)wave_s;
    asm volatile("" : "+v"(tid), "+s"(G), "+s"(bid), "+s"(lb));
    F.lds = (LAS unsigned char*)(size_t)lb; F.MISC = (volatile LAS unsigned*)(F.lds + MISC_OFF);
    F.tid = tid; F.lane = F.tid & 63; F.wave = __builtin_amdgcn_readfirstlane(F.tid >> 6); F.G = G; F.bid = bid;
    F.ctl = (unsigned*)(args_here()->ws + WS_CTL); return F;
}
__device__ __forceinline__ void ph_prologue(int, int wv) { const Frame F = make_frame(wv); phase_prologue(F, args_here()); phase_weights(F, args_here(), 0, 2, F.G, 0);
#if SELFCHECK
    if (F.bid == 0 && F.tid < 64) ((float*)(args_here()->ws + WS_DBG))[F.tid] = 0.f;
#endif
}
__device__ __forceinline__ void ph_inproj(int l, int wv) { const Frame F = make_frame(wv); unsigned char* ws = args_here()->ws;
    pg8::Gemm g{(const bf16*)(ws + WS_X8), (const bf16*)(WLBASE(ws, l) + WL_WIN), T, DINP, DM / 2};   pg8::StaticOrder S; S.init(T, DINP, F.G, F.bid);
    pg8::EpiInProj E{(bf16*)(ws + WS_H), (float*)(ws + WS_SIDE), (const float*)(ws + WS_ROPE)};
    pg8::gemm_phase<pg8::EpiInProj, pg8::StaticOrder, false>(F.lds, g, S, E, nullptr, F.tid); }
__device__ __forceinline__ void ph_compress(int l, int wv) { const Frame F = make_frame(wv); for (int it = F.bid; it < 256; it += F.G) compress_item(F, args_here(), l, it); }
__device__ __forceinline__ void ph_gdnprep(int l, int wv) { const Frame F = make_frame(wv); for (int it = F.bid; it < 256; it += F.G) { gdn_prep_chunk<0>(F, args_here(), l, it * 8 + F.wave, F.lds + F.wave * 16384); __syncthreads(); } }
__device__ __forceinline__ void ph_gdnprep_var(int l, int wv) { const Frame F = make_frame(wv); for (int it = F.bid; it < 256; it += F.G) { gdn_prep_chunk<PROBE_GDN_VAR | 1>(F, args_here(), l, it * 8 + F.wave, F.lds + F.wave * 16384); __syncthreads(); } }
__device__ __forceinline__ void ph_conformer(int l, int wv) { const Frame F = make_frame(wv); for (int it = F.bid; it < 512; it += F.G) conformer_item(F, args_here(), l, it); }
__device__ __forceinline__ void ph_gdnout(int l, int wv) { const Frame F = make_frame(wv); for (int ci = F.bid * NWAVES + F.wave; ci < 2048; ci += F.G * NWAVES) gdn_out_chunk(F, args_here(), ci, F.lds + F.wave * 8192); }
constexpr int NCONV = 64;
__device__ __forceinline__ void ph_scan(int l, int wv) { const Frame F = make_frame(wv); if (F.bid < 16) gdn_scan<0>(F, args_here(), l); }
__device__ __forceinline__ void ph_bgweights(int l, int wv) { const Frame F = make_frame(wv);
    if (F.bid < NCONV) { if (l == 0) phase_weights(F, args_here(), 0, 1, NCONV, 0); if (l + 1 < NL) phase_weights(F, args_here(), l + 1, 3, NCONV, 0); __syncthreads(); } }
__device__ __forceinline__ void ph_scan_var(int l, int wv) { const Frame F = make_frame(wv); if (F.bid < 16) gdn_scan<(PROBE_SCAN_VAR & 1)>(F, args_here(), l); }
__device__ __forceinline__ void ph_attn(int l, int rep, int wv) { const Frame F = make_frame(wv); phase_mix_b(F, args_here(), l, rep); }
__device__ __forceinline__ void ph_outproj(int l, int wv) { const Frame F = make_frame(wv); ArgsP ap = args_here(); unsigned char* ws = ap->ws;
    pg8::Gemm g{(const bf16*)(ws + WS_Y), (const bf16*)(WLBASE(ws, l) + WL_WOUT), T, DM, DM}; pg8::StaticOrder S; S.init(T, DM, F.G, F.bid);
    pg8::EpiOutProj E{(const bf16*)(ws + WS_XB), (bf16*)(ws + WS_X1), DN_ALPHA};
    pg8::gemm_phase<pg8::EpiOutProj, pg8::StaticOrder, false>(F.lds, g, S, E, nullptr, F.tid); }
__device__ __forceinline__ void ph_ln1(int l, int wv) { const Frame F = make_frame(wv); phase_ln1_router<false>(F, args_here(), l); }
__device__ __forceinline__ void ph_ln1_dry(int l, int wv) { const Frame F = make_frame(wv); phase_ln1_router<true>(F, args_here(), l); }
__device__ __forceinline__ void ph_gather(int l, int wv) { const Frame F = make_frame(wv); phase_gather(F, args_here(), l); }
__device__ __forceinline__ void ph_moeup(int l, int wv) { const Frame F = make_frame(wv); unsigned char* ws = args_here()->ws;
    pg8::Gemm g{(const bf16*)(ws + WS_H), (const bf16*)(WLBASE(ws, l) + WL_WGU), 0, 0, DM / 2};   pg8::MoeOrder S{(const int*)(ws + WS_META) + l * 512, F.G, F.bid};
    pg8::EpiSwiGLU E{ws + WS_HID, (const int*)(ws + WS_SLOT + SL_TOK), 1};
    pg8::gemm_phase<pg8::EpiSwiGLU, pg8::MoeOrder, false>(F.lds, g, S, E, nullptr, F.tid); }
__device__ __forceinline__ void ph_moedown(int l, int wv) { const Frame F = make_frame(wv); unsigned char* ws = args_here()->ws;
    pg8::Gemm g{(const bf16*)(ws + WS_HID), (const bf16*)(WLBASE(ws, l) + WL_WDN), 0, 0, FF / 2}; pg8::MoeOrder S{(const int*)(ws + WS_META) + l * 512, F.G, F.bid};
    pg8::EpiDown E{(bf16*)(ws + WS_Y2), (const int*)(ws + WS_SLOT + SL_TOK), (const float*)(ws + WS_SLOT + SL_W)};
    pg8::gemm_phase<pg8::EpiDown, pg8::MoeOrder, false>(F.lds, g, S, E, nullptr, F.tid); }
__device__ __forceinline__ void ph_ln2(int l, int wv) { const Frame F = make_frame(wv); phase_ln2(F, args_here(), l); }

__global__ void __launch_bounds__(NTHR, 2) fwd_kernel(Args args) {
    extern __shared__ __attribute__((aligned(16))) unsigned char lds_raw[];
    (void)lds_raw; const int wv = 0; const Frame F = make_frame(wv);
    if (F.tid < 64) F.MISC[F.tid] = 0u;
    __syncthreads();
    XcdBarrier bar = xcd_barrier_post(F.ctl + CW_BAR, F.MISC + 8);
    const int lo = args_here()->ph_lo, hi = args_here()->ph_hi;
#define IN(k) (lo <= (k) && (k) < hi)
#define SEAM(k) do { if (IN(k) && IN((k) + 1)) { XcdBarrier bb = bar; asm volatile("" : "+s"(bb.bar)); xcd_barrier(bb); } TSTAMP((k) + 1); } while (0)
#define RPT(bit, call) do { call; if (PROBE_REPEAT & (1u << (bit))) { XcdBarrier bb = bar; asm volatile("" : "+s"(bb.bar)); xcd_barrier(bb); call; } } while (0)
    TSTAMP(0);
    if (IN(0)) ph_prologue(0, wv);
    SEAM(0);
#define LAYER_BODY(l) do { \
        const int pb = 1 + 10 * l; \
        if (IN(pb + 0)) RPT(0, ph_inproj(l, wv)); \
        SEAM(pb + 0); \
        if constexpr (SELFCHECK == 4) { \
        if (l == CHECK_LAYER) { { const Frame F2 = make_frame(wv); check_inproj(F2, args_here(), l); } XcdBarrier bb = bar; asm volatile("" : "+s"(bb.bar)); xcd_barrier(bb); } \
        } \
        if (IN(pb + 1)) { RPT(16, ph_compress(l, wv)); ph_gdnprep(l, wv); if (PROBE_REPEAT & (1u << 17)) { XcdBarrier bb = bar; asm volatile("" : "+s"(bb.bar)); xcd_barrier(bb); ph_gdnprep_var(l, wv); } RPT(18, ph_conformer(l, wv)); } \
        SEAM(pb + 1); \
        if (IN(pb + 2)) { ph_scan(l, wv); ph_bgweights(l, wv); if (PROBE_REPEAT & (1u << 19)) { XcdBarrier bb = bar; asm volatile("" : "+s"(bb.bar)); xcd_barrier(bb); ph_scan_var(l, wv); XcdBarrier bb2 = bar; asm volatile("" : "+s"(bb2.bar)); xcd_barrier(bb2); } ph_attn(l, 0, wv); if (PROBE_REPEAT & (1u << 20)) { XcdBarrier bb = bar; asm volatile("" : "+s"(bb.bar)); xcd_barrier(bb); ph_attn(l, 1, wv); } } \
        SEAM(pb + 2); \
        if (IN(pb + 3)) RPT(24, ph_gdnout(l, wv)); \
        SEAM(pb + 3); \
        if constexpr (SELFCHECK == 1 || SELFCHECK == 2 || SELFCHECK == 5) { \
        if (l == CHECK_LAYER) { { const Frame F2 = make_frame(wv); if (SELFCHECK == 1) check_nsa(F2, args_here()); else if (SELFCHECK == 2) check_gdn(F2, args_here(), l); else { check_compress(F2, args_here(), l); check_conformer(F2, args_here(), l); } } XcdBarrier bb = bar; asm volatile("" : "+s"(bb.bar)); xcd_barrier(bb); } \
        } \
        if (IN(pb + 4)) RPT(3, ph_outproj(l, wv)); \
        SEAM(pb + 4); \
        if (IN(pb + 5)) { ph_ln1(l, wv); if (PROBE_REPEAT & (1u << 4)) { XcdBarrier bb = bar; asm volatile("" : "+s"(bb.bar)); xcd_barrier(bb); ph_ln1_dry(l, wv); } \
            if (PROBE_REPEAT & (1u << 23)) { for (int rr = 0; rr < 4; ++rr) { XcdBarrier bb = bar; asm volatile("" : "+s"(bb.bar)); xcd_barrier(bb); } } } \
        SEAM(pb + 5); \
        if (IN(pb + 6)) RPT(5, ph_gather(l, wv)); \
        SEAM(pb + 6); \
        if (IN(pb + 7)) RPT(6, ph_moeup(l, wv)); \
        SEAM(pb + 7); \
        if (IN(pb + 8)) RPT(7, ph_moedown(l, wv)); \
        SEAM(pb + 8); \
        if constexpr (SELFCHECK == 3) { \
        if (l == CHECK_LAYER) { { const Frame F2 = make_frame(wv); check_moe(F2, args_here(), l); } XcdBarrier bb = bar; asm volatile("" : "+s"(bb.bar)); xcd_barrier(bb); } \
        } \
        if (IN(pb + 9)) { ph_ln2(l, wv); } \
        SEAM(pb + 9); \
     \
    } while (0)
    LAYER_BODY(0); LAYER_BODY(1); LAYER_BODY(2); LAYER_BODY(3);
#undef LAYER_BODY
#undef RPT
#if SELFCHECK
    { XcdBarrier bb = bar; asm volatile("" : "+s"(bb.bar)); xcd_barrier(bb); const Frame F2 = make_frame(wv); check_inject(F2, args_here()); }
#endif
#if TIMING
    { XcdBarrier bb = bar; asm volatile("" : "+s"(bb.bar)); xcd_barrier(bb); const Frame F2 = make_frame(wv);
      const unsigned long long* ts = (const unsigned long long*)(args_here()->ws + (size_t)985 * MiB);
      const float ta = (float)(ts[TA_HI] - ts[TA_LO]) * 0.01f, tb = (float)(ts[TB_HI] - ts[TB_LO]) * 0.01f;
      float* out = args_here()->out;
      for (int i = F2.bid * NTHR + F2.tid; i < (1 << 20); i += F2.G * NTHR) out[i] = (i == 0) ? ta : tb; }
#endif
#undef IN
#undef SEAM
}

extern "C" void kernel_launch(void* const* d_in, const int* in_sizes, int n_in, void* d_out, int out_size, void* d_ws, size_t ws_size, hipStream_t stream) {
    static int grid = 0;
    if (grid == 0) {
        if (n_in != 25 || in_sizes[0] != T * DM || out_size != T * DM || ws_size < WS_END) { fprintf(stderr, "kernel_launch: shape/workspace mismatch (n_in %d, in0 %d, out %d, ws %zu < %zu); nothing launched\n", n_in, n_in > 0 ? in_sizes[0] : -1, out_size, ws_size, (size_t)WS_END); grid = -1; return; }
        int dev = 0, cus = 0, per_cu = 0;
        if (hipGetDevice(&dev) != hipSuccess || hipDeviceGetAttribute(&cus, hipDeviceAttributeMultiprocessorCount, dev) != hipSuccess) { grid = -1; return; }
        if (hipFuncSetAttribute((const void*)fwd_kernel, hipFuncAttributeMaxDynamicSharedMemorySize, LDS_BYTES) != hipSuccess) { fprintf(stderr, "kernel_launch: hipFuncSetAttribute failed\n"); grid = -1; return; }
        if (hipOccupancyMaxActiveBlocksPerMultiprocessor(&per_cu, (const void*)fwd_kernel, NTHR, LDS_BYTES) != hipSuccess || per_cu < 1)
            fprintf(stderr, "kernel_launch: note: occupancy query reports %d workgroups per CU\n", per_cu);
        (void)hipGetLastError();
        grid = cus;
        if (grid < 32 || (grid & 7)) { fprintf(stderr, "kernel_launch: unexpected CU count %d\n", cus); }
    }
    if (grid < 0) return;
    if (hipMemsetAsync((char*)d_ws + WS_CTL, 0, CTL_ZERO_BYTES, stream) != hipSuccess) return;
    Args a{};
    for (int i = 0; i < 25; ++i) a.in[i] = (const float*)d_in[i];
    a.out = (float*)d_out; a.ws = (unsigned char*)d_ws;
#if MK_MULTI
    for (int p = 0; p < N_PHASES; ++p) { a.ph_lo = p; a.ph_hi = p + 1; hipLaunchKernelGGL(fwd_kernel, dim3(grid), dim3(NTHR), LDS_BYTES, stream, a); }
#else
    a.ph_lo = 0; a.ph_hi = N_PHASES;
    hipLaunchKernelGGL(fwd_kernel, dim3(grid), dim3(NTHR), LDS_BYTES, stream, a);
#endif
}
```

```cpp
#include <hip/hip_runtime.h>
#include <cstdio>
#include <cstdint>
namespace pg8 {
#define PG8_LAS __attribute__((address_space(3)))
typedef unsigned short bf16_t;
typedef short bf16x8 __attribute__((ext_vector_type(8)));
typedef float f32x4 __attribute__((ext_vector_type(4)));
typedef unsigned u32x4 __attribute__((ext_vector_type(4)));
constexpr int BM = 256, BK = 64, HALF = 128, HTB = HALF * BK * 2  , STAGE_BYTES = 8 * HTB, NXCD = 8, WGM = 8;

__host__ __device__ __forceinline__ int lds_byte(int r, int c) { const int st = (r >> 4) * 2 + (c >> 5), rr = r & 15, cc = c & 31, ob = rr * 64 + cc * 2; return st * 1024 + (ob ^ (((ob >> 9) & 1) << 5)); }
__host__ __device__ __forceinline__ void stage_rc(int b, int& R, int& C) { const int st = b / 1024, sb = b % 1024, swz = sb ^ (((sb >> 9) & 1) << 5); R = (st >> 1) * 16 + swz / 64; C = (st & 1) * 32 + (swz % 64) / 2; }
__host__ __device__ __forceinline__ int perm32(int rho) { const int n = rho >> 4, i = rho & 15; return 8 * (i >> 2) + 4 * n + (i & 3); }

struct Unit { int pm, pn; };
struct Gemm { const bf16_t* A; const bf16_t* Bt; int M, N, K; };

struct StaticOrder {
    int nM, nN, nwg, G, c;
    __host__ __device__ void init(int M, int N, int G_, int c_) { nM = M / BM; nN = N / BM; nwg = nM * nN; G = G_; c = c_; }
    __host__ __device__ bool next(int i, Unit& u) const {
        const long L = (long)i * G + c; if (L >= nwg) return false;
        int wgid = (int)L; { const int q = nwg / NXCD, r = nwg % NXCD, xcd = wgid % NXCD, off = wgid / NXCD; wgid = (xcd < r ? xcd * (q + 1) : r * (q + 1) + (xcd - r) * q) + off; }
        const int nig = WGM * nN, gid = wgid / nig, fm = gid * WGM, gsz = (nM - fm) < WGM ? (nM - fm) : WGM;
        u.pm = fm + ((wgid % nig) % gsz); u.pn = (wgid % nig) / gsz; return true;
    }
    __device__ __forceinline__ void a_ready(const Unit&) const {}
    __device__ __forceinline__ void done(const Unit&) const {}
};

__device__ __forceinline__ unsigned cvt_pk_bf16(float lo, float hi) { unsigned r; asm volatile("v_cvt_pk_bf16_f32 %0, %1, %2" : "=v"(r) : "v"(lo), "v"(hi)); return r; }
__device__ __forceinline__ float fast_sigmoid(float x) { return __builtin_amdgcn_rcpf(1.0f + __builtin_amdgcn_exp2f(-1.44269504089f * x)); }

constexpr int HLD = 2816;
constexpr float QSCALE = 0.125f * 1.44269504089f;

struct EpiInProj {
    static constexpr bool PERM = true, AFTER_DRAIN = false, GATHER = false, FP8 = true;
    bf16_t* H; float* side; const float* rope;
    __device__ __forceinline__ void operator()(const f32x4 (&acc)[2][2][4][2], const Unit& u, int wr, int wc, int fr, int fq) const {
        const int row0 = u.pm * BM + wr * 64 + fr; const int pn = u.pn;
        if (pn <= 4) {
#pragma unroll
            for (int ai = 0; ai < 2; ++ai)
#pragma unroll
                for (int m = 0; m < 4; ++m) {
                    const int row = row0 + ai * HALF + m * 16; const float* rp = rope + (size_t)(row & 4095) * 16;
                    const f32x4 c0 = *(const f32x4*)(rp), c1 = *(const f32x4*)(rp + 4), s0 = *(const f32x4*)(rp + 8), s1 = *(const f32x4*)(rp + 12);
#pragma unroll
                    for (int bj = 0; bj < 2; ++bj) {
                        f32x4 v0 = acc[ai][bj][m][0] * 0.03125f, v1 = acc[ai][bj][m][1] * 0.03125f;
                        const bool ropeb = (pn < 2) || (bj == 0);
                        if (ropeb) {
                            f32x4 p0, p1;
#pragma unroll
                            for (int e = 0; e < 4; ++e) { p0[e] = __shfl_xor(v0[e], 16); p1[e] = __shfl_xor(v1[e], 16); }
                            if (((wc & 1) == 0) && fq < 2) { const float sg = fq ? 1.f : -1.f; v0 = v0 * c0 + (p0 * s0) * sg; v1 = v1 * c1 + (p1 * s1) * sg; }
                        }
                        if (pn < 2) { v0 = v0 * QSCALE; v1 = v1 * QSCALE; }
                        u32x4 w; w.x = cvt_pk_bf16(v0[0], v0[1]); w.y = cvt_pk_bf16(v0[2], v0[3]); w.z = cvt_pk_bf16(v1[0], v1[1]); w.w = cvt_pk_bf16(v1[2], v1[3]);
                        *(u32x4*)(H + (size_t)row * HLD + pn * BM + bj * HALF + wc * 32 + 8 * fq) = w;
                    }
                }
        } else if (pn < 11) {
#pragma unroll
            for (int ai = 0; ai < 2; ++ai)
#pragma unroll
                for (int m = 0; m < 4; ++m) {
                    const int row = row0 + ai * HALF + m * 16;
#pragma unroll
                    for (int bj = 0; bj < 2; ++bj) {
                        const f32x4 v0 = acc[ai][bj][m][0] * 0.03125f, v1 = acc[ai][bj][m][1] * 0.03125f;
                        u32x4 w; w.x = cvt_pk_bf16(v0[0], v0[1]); w.y = cvt_pk_bf16(v0[2], v0[3]); w.z = cvt_pk_bf16(v1[0], v1[1]); w.w = cvt_pk_bf16(v1[2], v1[3]);
                        *(u32x4*)(H + (size_t)row * HLD + pn * BM + bj * HALF + wc * 32 + 8 * fq) = w;
                    }
                }
        } else if (wc == 0) {
#pragma unroll
            for (int ai = 0; ai < 2; ++ai)
#pragma unroll
                for (int m = 0; m < 4; ++m) {
                    const int row = row0 + ai * HALF + m * 16;
                    f32x4 v0 = acc[ai][0][m][0] * 0.03125f, v1 = acc[ai][0][m][1] * 0.03125f;
#pragma unroll
                    for (int e = 0; e < 4; ++e) { v0[e] = fast_sigmoid(v0[e]); if (fq < 3) v1[e] = fast_sigmoid(v1[e]); }
                    *(f32x4*)(side + (size_t)row * 32 + 8 * fq) = v0; *(f32x4*)(side + (size_t)row * 32 + 8 * fq + 4) = v1;
                }
        }
    }
};
struct EpiOutProj {
    static constexpr bool PERM = true, AFTER_DRAIN = false, GATHER = false, FP8 = false;
    const bf16_t* res; bf16_t* out; float alpha;
    __device__ __forceinline__ void operator()(const f32x4 (&acc)[2][2][4][2], const Unit& u, int wr, int wc, int fr, int fq) const {
        const int row0 = u.pm * BM + wr * 64 + fr, col0 = u.pn * BM + wc * 32 + 8 * fq;
#pragma unroll
        for (int ai = 0; ai < 2; ++ai)
#pragma unroll
            for (int m = 0; m < 4; ++m) { const size_t off = (size_t)(row0 + ai * HALF + m * 16) * 1024 + col0;
#pragma unroll
                for (int bj = 0; bj < 2; ++bj) { const u32x4 rb = *(const u32x4*)(res + off + bj * HALF);
                    f32x4 r0, r1; r0[0] = __uint_as_float(rb.x << 16); r0[1] = __uint_as_float(rb.x & 0xffff0000u); r0[2] = __uint_as_float(rb.y << 16); r0[3] = __uint_as_float(rb.y & 0xffff0000u);
                    r1[0] = __uint_as_float(rb.z << 16); r1[1] = __uint_as_float(rb.z & 0xffff0000u); r1[2] = __uint_as_float(rb.w << 16); r1[3] = __uint_as_float(rb.w & 0xffff0000u);
                    const f32x4 v0 = r0 * alpha + acc[ai][bj][m][0], v1 = r1 * alpha + acc[ai][bj][m][1];
                    u32x4 w; w.x = cvt_pk_bf16(v0[0], v0[1]); w.y = cvt_pk_bf16(v0[2], v0[3]); w.z = cvt_pk_bf16(v1[0], v1[1]); w.w = cvt_pk_bf16(v1[2], v1[3]);
                    *(u32x4*)(out + off + bj * HALF) = w; }
                asm volatile("" ::: "memory"); }
    }
};
struct EpiSwiGLU {
    static constexpr bool PERM = true, AFTER_DRAIN = false, GATHER = true, FP8 = true;
    unsigned char* hid; const int* rowmap; int rowshift;
    __device__ __forceinline__ void operator()(const f32x4 (&acc)[2][2][4][2], const Unit& u, int wr, int wc, int fr, int fq) const {
        const int row0 = u.pm * BM + wr * 64 + fr, hc0 = (u.pn & 3) * 128 + wc * 16 + 4 * fq;
#pragma unroll
        for (int ai = 0; ai < 2; ++ai)
#pragma unroll
            for (int m = 0; m < 4; ++m) { unsigned char* rowp = hid + (size_t)(row0 + ai * HALF + m * 16) * 512 + hc0;
#pragma unroll
                for (int bj = 0; bj < 2; ++bj) { const f32x4 g = acc[ai][bj][m][0] * 0.03125f, up = acc[ai][bj][m][1] * 0.03125f; f32x4 h;
#pragma unroll
                    for (int e = 0; e < 4; ++e) h[e] = __builtin_amdgcn_fmed3f(g[e] * fast_sigmoid(g[e]) * up[e], -440.f, 440.f);
                    int w = 0; w = __builtin_amdgcn_cvt_pk_fp8_f32(h[0], h[1], w, false); w = __builtin_amdgcn_cvt_pk_fp8_f32(h[2], h[3], w, true);
                    *(int*)(rowp + bj * 64) = w; } }
    }
};
struct EpiDown {
    static constexpr bool PERM = true, AFTER_DRAIN = false, GATHER = false, FP8 = true;
    bf16_t* y2; const int* slot_tok; const float* slot_w;
    __device__ __forceinline__ void operator()(const f32x4 (&acc)[2][2][4][2], const Unit& u, int wr, int wc, int fr, int fq) const {
        const int row0 = u.pm * BM + wr * 64 + fr, col0 = (u.pn & 3) * BM + wc * 32 + 8 * fq;
#pragma unroll
        for (int ai = 0; ai < 2; ++ai)
#pragma unroll
            for (int m = 0; m < 4; ++m) { const int row = row0 + ai * HALF + m * 16; const int st = slot_tok[row]; const float sw = slot_w[row] * 0.015625f;
                if (st >= 0) { bf16_t* rowp = y2 + (size_t)st * 1024 + col0;
#pragma unroll
                    for (int bj = 0; bj < 2; ++bj) { const f32x4 v0 = acc[ai][bj][m][0] * sw, v1 = acc[ai][bj][m][1] * sw;
                        u32x4 w; w.x = cvt_pk_bf16(v0[0], v0[1]); w.y = cvt_pk_bf16(v0[2], v0[3]); w.z = cvt_pk_bf16(v1[0], v1[1]); w.w = cvt_pk_bf16(v1[2], v1[3]);
                        *(u32x4*)(rowp + bj * HALF) = w; } } }
    }
};
struct MoeOrder {
    const int* meta; int G, c;
    __device__ __forceinline__ bool next(int i, Unit& u) const {
        const int per = G >> 3; const int idx = (G & 7) ? (i * G + c) : ((i * 8 + (c & 7)) * per + (c >> 3));
        const int nt = __builtin_amdgcn_readfirstlane(meta[0]); if (idx >= nt * 4) return false;
        const int pm = idx >> 2; u.pm = pm; u.pn = __builtin_amdgcn_readfirstlane(meta[64 + pm]) * 4 + (idx & 3); return true;
    }
    __device__ __forceinline__ void a_ready(const Unit&) const {}
    __device__ __forceinline__ void done(const Unit&) const {}
};
typedef int v4i_ __attribute__((ext_vector_type(4)));
typedef int v8i_ __attribute__((ext_vector_type(8)));
template <class Epi, class Sched, bool STAMP = false>
__device__ __forceinline__ void gemm_phase(PG8_LAS unsigned char* lds, const Gemm g, const Sched& S, const Epi& E, unsigned long long* stamps, int tid_in) {
    int tid_ = tid_in; asm volatile("" : "+v"(tid_));
    const int tid = tid_, wid = __builtin_amdgcn_readfirstlane(tid >> 6), lane = tid & 63, wr = wid >> 2, wc = wid & 3, fr = lane & 15, fq = lane >> 4;
    const int K = g.K, nt = K / BK;
    int ts_lo = 0, ts_hi = 0, nts = 0; const unsigned long long rt_entry = STAMP ? (unsigned long long)wall_clock64() : 0ull;
#define PG8_STAMP() do { if (STAMP && wid == 0 && nts < 64) { const unsigned long long _c = (unsigned long long)clock64(); \
        ts_lo = (lane == nts) ? (int)(unsigned)_c : ts_lo; ts_hi = (lane == nts) ? (int)(unsigned)(_c >> 32) : ts_hi; ++nts; } } while (0)
    PG8_STAMP();
    unsigned voffA[2], voffB[2];
#pragma unroll
    for (int i = 0; i < 2; ++i) { int R, C; stage_rc(tid * 16 + i * 8192, R, C); const int Rb = Epi::PERM ? ((R & ~31) + perm32(R & 31)) : R;
        voffA[i] = (unsigned)(R * K + C) * 2u; voffB[i] = (unsigned)(Rb * K + C) * 2u; }
    unsigned offAc[2][2], offAn[2][2];
    PG8_LAS unsigned char* gidx = lds + STAGE_BYTES + (unsigned)wid * 1024u;
#define PG8_IDX_DMA(par, pm_) do { int t2_ = tid; asm volatile("" : "+v"(t2_)); _Pragma("unroll") for (int i_ = 0; i_ < 2; ++i_) { int R_, C_; stage_rc(t2_ * 16 + i_ * 8192, R_, C_); (void)C_; \
        _Pragma("unroll") for (int h_ = 0; h_ < 2; ++h_) __builtin_amdgcn_global_load_lds((const unsigned*)(E.rowmap + (size_t)(pm_) * BM + h_ * HALF + R_), (PG8_LAS unsigned*)(gidx + (par) * 512 + (h_ * 2 + i_) * 256), 4, 0, 0); } } while (0)
#define PG8_IDX_READ(dst, par) do { int t2_ = tid; asm volatile("" : "+v"(t2_)); _Pragma("unroll") for (int i_ = 0; i_ < 2; ++i_) { int R_, C_; stage_rc(t2_ * 16 + i_ * 8192, R_, C_); (void)R_; \
        _Pragma("unroll") for (int h_ = 0; h_ < 2; ++h_) { int r_ = *(const PG8_LAS int*)(gidx + (par) * 512 + (h_ * 2 + i_) * 256 + (t2_ & 63) * 4); r_ = r_ < 0 ? 0 : (r_ >> E.rowshift); dst[h_][i_] = (unsigned)r_ * (unsigned)(K * 2) + (unsigned)C_ * 2u; } } } while (0)
    const size_t kstep = (size_t)(BK * 2);
    const size_t hstep = (size_t)HALF * K * 2;
    const size_t tstep = 2 * hstep;
    const unsigned ldsw = (unsigned)wid * 1024u;
    const int aoff = lds_byte(wr * 64 + fr, fq * 8), boff = lds_byte(wc * 32 + fr, fq * 8);
#define PG8_SA(b, h) (((b) * 2 + (h)) * HTB)
#define PG8_SB(b, h) ((4 + (b) * 2 + (h)) * HTB)
#define PG8_STAGE(bufoff, gbase, voff) do { _Pragma("unroll") for (int _i = 0; _i < 2; ++_i) \
        __builtin_amdgcn_global_load_lds((const unsigned*)((const char*)(gbase) + (voff)[_i]), (PG8_LAS unsigned*)(lds + (bufoff) + ldsw + _i * 8192), 16, 0, 0); } while (0)
#define PG8_STAGE_A(bufoff, kt_, h_, nx_) do { if constexpr (Epi::GATHER) { _Pragma("unroll") for (int _i = 0; _i < 2; ++_i) { const unsigned o_ = (nx_) ? offAn[h_][_i] : offAc[h_][_i]; \
            __builtin_amdgcn_global_load_lds((const unsigned*)((const char*)g.A + (size_t)(kt_) * kstep + o_), (PG8_LAS unsigned*)(lds + (bufoff) + ldsw + _i * 8192), 16, 0, 0); } } \
        else { PG8_STAGE(bufoff, ((nx_) ? nA : cA) + (size_t)(kt_) * kstep + (h_) * hstep, voffA); } } while (0)
#define PG8_LDA(dst, b, h) do { _Pragma("unroll") for (int m = 0; m < 4; ++m) _Pragma("unroll") for (int k = 0; k < 2; ++k) dst[m][k] = *(const PG8_LAS bf16x8*)(lds + PG8_SA(b, h) + aoff + m * 2048 + k * 1024); } while (0)
#define PG8_LDB(dst, b, h) do { _Pragma("unroll") for (int n = 0; n < 2; ++n) _Pragma("unroll") for (int k = 0; k < 2; ++k) dst[n][k] = *(const PG8_LAS bf16x8*)(lds + PG8_SB(b, h) + boff + n * 2048 + k * 1024); } while (0)
#define PG8_MMA(ai, bj, At, Bt) do { __builtin_amdgcn_s_setprio(1); \
        if constexpr (Epi::FP8) {   \
            _Pragma("unroll") for (int m = 0; m < 4; ++m) _Pragma("unroll") for (int n = 0; n < 2; ++n) \
                { const v8i_ b8_ = __builtin_shufflevector(__builtin_bit_cast(v4i_, Bt[n][0]), __builtin_bit_cast(v4i_, Bt[n][1]), 0, 1, 2, 3, 4, 5, 6, 7), \
                             a8_ = __builtin_shufflevector(__builtin_bit_cast(v4i_, At[m][0]), __builtin_bit_cast(v4i_, At[m][1]), 0, 1, 2, 3, 4, 5, 6, 7); \
                    \
                  asm volatile("v_mfma_f32_16x16x128_f8f6f4 %0, %1, %2, %0" : "+v"(acc[ai][bj][m][n]) : "v"(b8_), "v"(a8_)); } } \
        else { _Pragma("unroll") for (int m = 0; m < 4; ++m) _Pragma("unroll") for (int n = 0; n < 2; ++n) _Pragma("unroll") for (int k = 0; k < 2; ++k) \
            acc[ai][bj][m][n] = __builtin_amdgcn_mfma_f32_16x16x32_bf16(Bt[n][k], At[m][k], acc[ai][bj][m][n], 0, 0, 0); } \
        __builtin_amdgcn_s_setprio(0); } while (0)
#define PG8_WAIT_V(n) asm volatile("s_waitcnt vmcnt(" #n ")" ::: "memory")
#define PG8_WAIT_L(n) asm volatile("s_waitcnt lgkmcnt(" #n ")" ::: "memory")
#define PG8_BAR __builtin_amdgcn_s_barrier()
#define PG8_SCHED __builtin_amdgcn_sched_barrier(0)
    Unit cur, nxt; int ui = 0;
    if (!S.next(0, cur)) return;
    f32x4 acc[2][2][4][2];
    float zf_ = 0.f; asm volatile("" : "+v"(zf_));
#pragma unroll
    for (int a = 0; a < 2; ++a)
#pragma unroll
        for (int b = 0; b < 2; ++b)
#pragma unroll
            for (int m = 0; m < 4; ++m)
#pragma unroll
                for (int n = 0; n < 2; ++n) acc[a][b][m][n] = (f32x4){zf_, zf_, zf_, zf_};
    bf16x8 At[4][2], B0[2][2], B1[2][2];
    const char* cA = (const char*)g.A + (size_t)cur.pm * tstep; const char* cB = (const char*)g.Bt + (size_t)cur.pn * tstep;
    S.a_ready(cur);
    if constexpr (Epi::GATHER) { PG8_IDX_DMA(0, cur.pm); asm volatile("s_waitcnt vmcnt(0)" ::: "memory"); PG8_IDX_READ(offAc, 0); asm volatile("s_waitcnt lgkmcnt(0)" ::: "memory"); }
    const char* nA = cA;
    PG8_STAGE(PG8_SB(0, 0), cB, voffB); PG8_STAGE_A(PG8_SA(0, 0), 0, 0, false); PG8_STAGE(PG8_SB(0, 1), cB + hstep, voffB); PG8_STAGE_A(PG8_SA(0, 1), 0, 1, false);
    if (wr == 1) PG8_BAR;
    PG8_WAIT_V(4); PG8_BAR;
    PG8_STAGE(PG8_SB(1, 0), cB + kstep, voffB); PG8_STAGE_A(PG8_SA(1, 0), 1, 0, false); PG8_STAGE(PG8_SB(1, 1), cB + hstep + kstep, voffB);
    PG8_WAIT_V(6); PG8_BAR;
    PG8_STAMP();
    for (;;) {
        const bool has_next = S.next(ui + 1, nxt);
        nA = has_next ? (const char*)g.A + (size_t)nxt.pm * tstep : cA; const char* nB = has_next ? (const char*)g.Bt + (size_t)nxt.pn * tstep : cB;
        if constexpr (Epi::GATHER) { if (has_next) PG8_IDX_DMA((ui + 1) & 1, nxt.pm); }
#pragma unroll 1
        for (int t = 0; t < nt; t += 2) {
            const bool last = (t == nt - 2);
            const char* b2 = last ? nB : cB + (size_t)(t + 2) * kstep;
            const char* b3 = b2 + kstep;
            const int kt2 = last ? 0 : t + 2;
            if constexpr (Epi::GATHER) { if (last) { if (has_next) PG8_IDX_READ(offAn, (ui + 1) & 1); else { offAn[0][0] = offAc[0][0]; offAn[0][1] = offAc[0][1]; offAn[1][0] = offAc[1][0]; offAn[1][1] = offAc[1][1]; } } }
            if (last && has_next) S.a_ready(nxt);
            PG8_LDB(B0, 0, 0); PG8_SCHED; PG8_LDA(At, 0, 0); PG8_STAGE_A(PG8_SA(1, 1), t + 1, 1, false);
            PG8_WAIT_L(8); PG8_BAR; PG8_WAIT_L(0); PG8_MMA(0, 0, At, B0); PG8_BAR; PG8_SCHED;
            PG8_LDB(B1, 0, 1); PG8_STAGE(PG8_SB(0, 0), b2, voffB);
            PG8_BAR; PG8_WAIT_L(0); PG8_MMA(0, 1, At, B1); PG8_BAR;
            PG8_LDA(At, 0, 1); PG8_STAGE_A(PG8_SA(0, 0), kt2, 0, last);
            PG8_BAR; PG8_WAIT_L(0); PG8_MMA(1, 0, At, B0); PG8_BAR; PG8_SCHED;
            PG8_STAGE(PG8_SB(0, 1), b2 + hstep, voffB);
            PG8_WAIT_V(6); PG8_BAR; PG8_MMA(1, 1, At, B1); PG8_BAR;
            PG8_LDB(B0, 1, 0); PG8_SCHED; PG8_LDA(At, 1, 0); PG8_STAGE_A(PG8_SA(0, 1), kt2, 1, last);
            PG8_WAIT_L(8); PG8_BAR; PG8_WAIT_L(0); PG8_MMA(0, 0, At, B0); PG8_BAR; PG8_SCHED;
            PG8_LDB(B1, 1, 1); PG8_STAGE(PG8_SB(1, 0), b3, voffB);
            PG8_BAR; PG8_WAIT_L(0); PG8_MMA(0, 1, At, B1); PG8_BAR;
            PG8_LDA(At, 1, 1); PG8_STAGE_A(PG8_SA(1, 0), kt2 + 1, 0, last);
            PG8_BAR; PG8_WAIT_L(0); PG8_MMA(1, 0, At, B0); PG8_BAR; PG8_SCHED;
            PG8_STAGE(PG8_SB(1, 1), b3 + hstep, voffB);
            PG8_WAIT_V(6); PG8_BAR; PG8_MMA(1, 1, At, B1); PG8_BAR;
        }
        PG8_STAMP();
        if constexpr (Epi::FP8) asm volatile("s_nop 15\n\ts_nop 15" ::: "memory");
        if constexpr (!Epi::AFTER_DRAIN) { E(acc, cur, wr, wc, fr, fq); S.done(cur); }
        PG8_STAMP();
        if (!has_next) break;
#pragma unroll
        for (int a = 0; a < 2; ++a)
#pragma unroll
            for (int b = 0; b < 2; ++b)
#pragma unroll
                for (int m = 0; m < 4; ++m)
#pragma unroll
                    for (int n = 0; n < 2; ++n) acc[a][b][m][n] = (f32x4){zf_, zf_, zf_, zf_};
        cur = nxt; cA = nA; cB = nB; ++ui;
        if constexpr (Epi::GATHER) { offAc[0][0] = offAn[0][0]; offAc[0][1] = offAn[0][1]; offAc[1][0] = offAn[1][0]; offAc[1][1] = offAn[1][1]; }
    }
    PG8_WAIT_V(0);
    if (wr == 0) PG8_BAR;
    PG8_BAR;
    if constexpr (Epi::AFTER_DRAIN) { E.fused(acc, cur, wr, wc, fr, fq, lds, wid, lane); S.done(cur); }
    PG8_STAMP();
    if (STAMP && wid == 0) { stamps[lane] = lane < nts ? (((unsigned long long)(unsigned)ts_hi << 32) | (unsigned)ts_lo) : 0ull;
        if (lane == 62) stamps[62] = rt_entry; if (lane == 63) stamps[63] = (unsigned long long)wall_clock64(); }
#undef PG8_STAMP
#undef PG8_SA
#undef PG8_SB
#undef PG8_STAGE
#undef PG8_STAGE_A
#undef PG8_IDX_DMA
#undef PG8_IDX_READ
#undef PG8_LDA
#undef PG8_LDB
#undef PG8_MMA
#undef PG8_WAIT_V
#undef PG8_WAIT_L
#undef PG8_BAR
#undef PG8_SCHED
}
}

#ifndef SELFCHECK
#define SELFCHECK 0
#endif
#ifndef PROBE_GDN_VAR
#define PROBE_GDN_VAR 0
#endif
#ifndef PROBE_SCAN_VAR
#define PROBE_SCAN_VAR 0
#endif
#ifndef PROBE_ATTN_VAR
#define PROBE_ATTN_VAR 0
#endif
constexpr int NB = 8, SEQ = 4096, DM = 1024, NL = 4, T = NB * SEQ;
constexpr int DIN = 2848, DINP = 3072, HLD = pg8::HLD;
constexpr int NEXP = 32, FF = 512, NTILE_MAX = 288;
constexpr float LN_EPS = 1e-5f;
constexpr float DN_ALPHA = 1.6817928305074290f;
constexpr int NWAVES = 8, NTHR = 512;

constexpr size_t MiB = 1u << 20, KiB = 1u << 10;
constexpr size_t WS_CTL = 0, CTL_ZERO_BYTES = 128 * KiB;
constexpr size_t WS_ROPE = 1 * MiB;
constexpr size_t WS_META = 1 * MiB + 512 * KiB;
constexpr size_t WS_GL = WS_META + 16 * KiB;
constexpr size_t WS_WL = 2 * MiB;
constexpr size_t WL_WIN = 0, WL_WOUT = 6 * MiB, WL_WGU = 8 * MiB, WL_WDN = 72 * MiB, WL_W1 = 104 * MiB, WL_W2 = 105 * MiB, WL_BIAS1 = 105 * MiB + 64 * KiB, WL_WR = 105 * MiB + 128 * KiB;
constexpr size_t WS_XB = 108 * MiB;
constexpr size_t WS_X1 = 172 * MiB;
constexpr size_t WS_H = 300 * MiB;
constexpr size_t WS_SIDE = 476 * MiB;
constexpr size_t WS_Y = 480 * MiB;
constexpr size_t WS_GPREP = 544 * MiB;
constexpr size_t WS_Y2 = 672 * MiB;
constexpr size_t WS_HID = 800 * MiB;
constexpr size_t WS_X8 = 839 * MiB;
constexpr size_t WS_KC = 872 * MiB, WS_VC = WS_KC + 512 * KiB;
constexpr size_t WS_SLOT = 873 * MiB;
constexpr size_t SL_TOK = 0, SL_W = 512 * KiB, SL_RE = 1024 * KiB, SL_RP = 1280 * KiB, SL_RW = 1536 * KiB;
constexpr size_t WS_WL2 = 876 * MiB;
constexpr size_t WS_END = 982 * MiB;
#define WLBASE(ws_, l_) ((ws_) + (((l_) & 1) ? WS_WL2 : WS_WL))
constexpr int GCH = 65536;
constexpr int GC_UT = 0, GC_W = 8192, GC_QK = 16384, GC_QD = 24576, GC_KDT = 32768, GC_ZT = 40960, GC_SS = 49152, GC_VB = 57344;
constexpr int CW_TMO = 0;
constexpr int CW_BAR = 4096;
constexpr int CW_CNT = 8192;
constexpr int CW_QUEUE = 12288;
constexpr int CW_KMAX = 13312;
static_assert((CW_KMAX + NL * 64) * 4 <= (int)CTL_ZERO_BYTES, "CTL words inside the memset region");

constexpr int SCR_BYTES = 159744;
constexpr int MISC_OFF = SCR_BYTES;
constexpr int LDS_BYTES = 163840;

#define GAS __attribute__((address_space(1)))
#define LAS __attribute__((address_space(3)))
typedef unsigned short bf16;
typedef float f32x4 __attribute__((ext_vector_type(4)));
typedef float f32x2 __attribute__((ext_vector_type(2)));
typedef float f32x16 __attribute__((ext_vector_type(16)));
typedef short bf16x8 __attribute__((ext_vector_type(8)));
typedef short s16x4 __attribute__((ext_vector_type(4)));
typedef unsigned u32x4 __attribute__((ext_vector_type(4)));
typedef unsigned u32x2 __attribute__((ext_vector_type(2)));
#define LDS_WAIT() asm volatile("s_waitcnt lgkmcnt(0)" ::: "memory")
#define VM_WAIT() asm volatile("s_waitcnt vmcnt(0)" ::: "memory")
#define SBAR() __builtin_amdgcn_sched_barrier(0)
__device__ __forceinline__ float bf2f(unsigned b) { return __uint_as_float(b << 16); }
__device__ __forceinline__ unsigned pk2(float lo, float hi) { return pg8::cvt_pk_bf16(lo, hi); }
__device__ __forceinline__ unsigned f2bf_sw(float f) { unsigned u = __float_as_uint(f); return (u + 0x7fffu + ((u >> 16) & 1u)) >> 16; }
__device__ __forceinline__ unsigned f2bf(float f) { unsigned r; asm("v_cvt_pk_bf16_f32 %0, %1, %1" : "=v"(r) : "v"(f)); return r & 0xffffu; }
__device__ __forceinline__ float row16_sum(float x) {
    x += __int_as_float(__builtin_amdgcn_update_dpp(0, __float_as_int(x), 0xB1, 0xf, 0xf, true));
    x += __int_as_float(__builtin_amdgcn_update_dpp(0, __float_as_int(x), 0x4E, 0xf, 0xf, true));
    x += __int_as_float(__builtin_amdgcn_update_dpp(0, __float_as_int(x), 0x141, 0xf, 0xf, true));
    x += __int_as_float(__builtin_amdgcn_update_dpp(0, __float_as_int(x), 0x140, 0xf, 0xf, true));
    return x;
}
__device__ __forceinline__ float wave_sum(float v) {
    const int r = __float_as_int(row16_sum(v));
    return (__int_as_float(__builtin_amdgcn_readlane(r, 0)) + __int_as_float(__builtin_amdgcn_readlane(r, 16))) + (__int_as_float(__builtin_amdgcn_readlane(r, 32)) + __int_as_float(__builtin_amdgcn_readlane(r, 48)));
}
__device__ __forceinline__ float fsigmoid(float x) { return pg8::fast_sigmoid(x); }
__device__ __forceinline__ float fsilu(float x) { return x * pg8::fast_sigmoid(x); }
__device__ __forceinline__ float fexp2(float x) { return __builtin_amdgcn_exp2f(x); }

#define XB_TMO      128
#define XB_XCNT(j)  (256  + 64 * (j))
#define XB_XSUB(j)  (1280 + 64 * (j))
#define XB_XGEN(j)  (2304 + 64 * (j))
#define XB_TOP      3328
#define XB_TOPGEN   3392
#define XCD_BAR_WORDS 3456
#define XB_SPIN_CAP (1u << 18)
#define LAS __attribute__((address_space(3)))

__device__ __forceinline__ unsigned xb_ld(unsigned* p)              { return __hip_atomic_load(p, __ATOMIC_RELAXED, __HIP_MEMORY_SCOPE_AGENT); }
__device__ __forceinline__ unsigned xb_add(unsigned* p, unsigned v) { return __hip_atomic_fetch_add(p, v, __ATOMIC_RELAXED, __HIP_MEMORY_SCOPE_AGENT); }
__device__ __forceinline__ unsigned xb_xcc_id() { return (unsigned)__builtin_amdgcn_s_getreg((3 << 11) | 20) & 0xFu; }
#define XB_SPIN(cond, bar) do { unsigned _sp = 0; while (cond) { __builtin_amdgcn_s_sleep(1); \
    if ((++_sp & 255u) == 0u) { if (xb_ld(&(bar)[XB_TMO])) break; if (_sp > XB_SPIN_CAP) { atomicAdd(&(bar)[XB_TMO], 1u); break; } } } } while (0)

struct XcdBarrier {
    unsigned* bar; unsigned x;
    volatile LAS unsigned* st;
};

__device__ __forceinline__ XcdBarrier xcd_barrier_post(unsigned* bar, volatile LAS unsigned* st) {
    XcdBarrier b; b.bar = bar; b.x = xb_xcc_id(); b.st = st;
    if (threadIdx.x == 0) (void)xb_add(&bar[XB_XCNT(b.x)], 1u);
    return b;
}
__device__ __forceinline__ void xcd_barrier_complete(unsigned* bar, unsigned x, unsigned& nloc, unsigned& nx) {
    const unsigned G = gridDim.x * gridDim.y * gridDim.z;
    unsigned sum, cnt, mine, sp = 0u;
    for (;;) {
        sum = 0u; cnt = 0u; mine = 0u;
#pragma unroll
        for (unsigned j = 0; j < 16; ++j) { const unsigned c = xb_ld(&bar[XB_XCNT(j)]); sum += c; cnt += (c > 0u) ? 1u : 0u; mine = (j == x) ? c : mine; }
        if (sum == G) break;
        __builtin_amdgcn_s_sleep(1);
        if ((++sp & 255u) == 0u) { if (xb_ld(&bar[XB_TMO])) break; if (sp > XB_SPIN_CAP) { atomicAdd(&bar[XB_TMO], 1u); break; } }
    }
    nloc = mine > 0u ? mine : 1u; nx = cnt > 0u ? cnt : 1u;
}

__device__ __forceinline__ void xcd_barrier(const XcdBarrier& b) {
    asm volatile("s_waitcnt vmcnt(0)" ::: "memory");
    __syncthreads();
    if (threadIdx.x == 0) {
        unsigned* bar = b.bar;
        __builtin_amdgcn_s_waitcnt(0);
        unsigned nloc = b.st[0], nx = b.st[1];
        if (nloc == 0u) { xcd_barrier_complete(bar, b.x, nloc, nx); b.st[0] = nloc; b.st[1] = nx; }
        const unsigned old = xb_add(&bar[XB_XSUB(b.x)], 1u);
        const unsigned gen = old / nloc;
        if (old + 1u == (gen + 1u) * nloc) {
            __builtin_amdgcn_fence(__ATOMIC_RELEASE, "agent");
            asm volatile("s_waitcnt vmcnt(0)" ::: "memory");
            const unsigned og = xb_add(&bar[XB_TOP], 1u);
            const unsigned tg = og / nx;
            if (og + 1u == (tg + 1u) * nx) xb_add(&bar[XB_TOPGEN], 1u);
            else XB_SPIN(xb_ld(&bar[XB_TOPGEN]) == tg, bar);
            __builtin_amdgcn_fence(__ATOMIC_ACQUIRE, "agent");
            xb_add(&bar[XB_XGEN(b.x)], 1u);
            asm volatile("s_waitcnt vmcnt(0)" ::: "memory");
        } else {
            XB_SPIN(xb_ld(&bar[XB_XGEN(b.x)]) == gen, bar);
            __builtin_amdgcn_fence(__ATOMIC_ACQUIRE, "agent");
            asm volatile("s_waitcnt vmcnt(0)" ::: "memory");
        }
    }
    __syncthreads();
}

struct Args { const float* in[25]; float* out; unsigned char* ws; int ph_lo, ph_hi; };
typedef const __attribute__((address_space(4))) Args* ArgsP;
__device__ __forceinline__ ArgsP args_here() { ArgsP p = (ArgsP)__builtin_amdgcn_kernarg_segment_ptr(); asm volatile("" : "+s"(p)); return p; }
struct Frame { LAS unsigned char* lds; volatile LAS unsigned* MISC; unsigned* ctl; int tid, lane, wave, G, bid; };

template <class Src>
__device__ __forceinline__ void tr_item(const Src src, int K, int N, bf16* WT, LAS float* scr, int item, int lane) {
    const int nblk = N >> 5, kb = item / nblk, nb = item - kb * nblk, k0 = kb << 6, n0 = nb << 5;
    float tv[32];
#pragma unroll
    for (int i = 0; i < 32; ++i) tv[i] = src(k0 + 2 * i + (lane >> 5), n0 + (lane & 31));
#pragma unroll
    for (int i = 0; i < 32; ++i) scr[(2 * i + (lane >> 5)) * 33 + (lane & 31)] = tv[i];
    LDS_WAIT();
    const int c = lane & 7;
#pragma unroll
    for (int j = 0; j < 4; ++j) { const int n = (lane >> 3) + 8 * j; const LAS float* s = scr + (8 * c) * 33 + n;
        u32x4 o; o.x = pk2(s[0], s[33]); o.y = pk2(s[66], s[99]); o.z = pk2(s[132], s[165]); o.w = pk2(s[198], s[231]);
        *(u32x4*)(WT + (size_t)(n0 + n) * K + k0 + 8 * c) = o; }
    LDS_WAIT();
}
template <class Src>
__device__ __forceinline__ void tr8_load(const Src src, int N, int item, int lane, float (&tv)[32]) {
    const int nblk = N >> 5, kb = item / nblk, nb = item - kb * nblk, k0 = kb << 6, n0 = nb << 5;
#pragma unroll
    for (int i = 0; i < 32; ++i) tv[i] = src(k0 + 2 * i + (lane >> 5), n0 + (lane & 31));
}
__device__ __forceinline__ void tr8_finish(const float (&tv)[32], int K, int N, unsigned char* WT, float mul, LAS float* scr, int item, int lane) {
    const int nblk = N >> 5, kb = item / nblk, nb = item - kb * nblk, k0 = kb << 6, n0 = nb << 5;
#pragma unroll
    for (int i = 0; i < 32; ++i) scr[(2 * i + (lane >> 5)) * 33 + (lane & 31)] = tv[i];
    LDS_WAIT();
    const int n = lane >> 1, kh = (lane & 1) * 32; const LAS float* sp = scr + kh * 33 + n;
#pragma unroll
    for (int q = 0; q < 2; ++q) { u32x4 o;
#pragma unroll
        for (int d = 0; d < 4; ++d) { const LAS float* s4 = sp + (16 * q + 4 * d) * 33; int w = 0;
            w = __builtin_amdgcn_cvt_pk_fp8_f32(s4[0] * mul, s4[33] * mul, w, false); w = __builtin_amdgcn_cvt_pk_fp8_f32(s4[66] * mul, s4[99] * mul, w, true); o[d] = (unsigned)w; }
        *(u32x4*)(WT + (size_t)(n0 + n) * K + k0 + kh + 16 * q) = o; }
    LDS_WAIT();
}
struct SrcPlain { const float* p; int ld; __device__ __forceinline__ float operator()(int k, int n) const { return p[(size_t)k * ld + n]; } };
struct SrcWin { const float* p;
    __device__ __forceinline__ float operator()(int k, int n) const {
        int c;
        if (n < 1280) c = n; else if (n < 2048) c = n + 24; else if (n < 2304) c = n + 24; else if (n < 2816) c = n + 32;
        else if (n < 2840) c = n - 2816 + 1280; else if (n < 2844) c = n - 2840 + 2328; else if (n < 2848) c = n - 2844 + 2332; else return 0.f;
        return p[(size_t)k * DIN + c]; } };
struct SrcGU { const float* wg; const float* wu;
    __device__ __forceinline__ float operator()(int k, int n) const { const int q = n >> 3, r = n & 7; const ptrdiff_t d = (r < 4) ? (ptrdiff_t)0 : (wu - wg); return wg[d + (ptrdiff_t)k * FF + 4 * q + (r & 3)]; } };

__device__ __forceinline__ void phase_weights(const Frame& F, ArgsP a, int l, int parts, int nblk, int lds_off) {
    unsigned char* wl = WLBASE(a->ws, l);
    LAS float* scr = (LAS float*)(F.lds + lds_off + F.wave * 8448);
    const int gw = F.bid * NWAVES + F.wave, NGW = nblk * NWAVES;
    constexpr int I_WIN = 16 * 96, I_WOUT = 16 * 32, I_GU1 = 16 * 32, I_GU = NEXP * I_GU1, I_DN1 = 8 * 32, I_DN = NEXP * I_DN1, I_W1 = 2 * 32 * 4, I_W2 = 2 * 2 * 2, I_WR = 36, I_B1 = 256;
    constexpr int NITEMS = I_WIN + I_WOUT + I_GU + I_DN + I_W1 + I_W2 + I_WR + I_B1;
    if (parts & 1) {
        for (int r = gw; r < I_GU; r += 2 * NGW) { const int r2 = r + NGW; const bool two = r2 < I_GU; const int e = r / I_GU1, e2 = (two ? r2 : r) / I_GU1; float tva[32], tvb[32];
            SrcGU sa{a->in[22] + ((size_t)l * NEXP + e) * DM * FF, a->in[23] + ((size_t)l * NEXP + e) * DM * FF}, sb{a->in[22] + ((size_t)l * NEXP + e2) * DM * FF, a->in[23] + ((size_t)l * NEXP + e2) * DM * FF};
            tr8_load(sa, 1024, r - e * I_GU1, F.lane, tva); tr8_load(sb, 1024, (two ? r2 : r) - e2 * I_GU1, F.lane, tvb);
            tr8_finish(tva, DM, 1024, wl + WL_WGU + (size_t)e * 1024 * DM, 32.f, scr, r - e * I_GU1, F.lane);
            if (two) tr8_finish(tvb, DM, 1024, wl + WL_WGU + (size_t)e2 * 1024 * DM, 32.f, scr, r2 - e2 * I_GU1, F.lane); }
        for (int r = gw; r < I_DN; r += 2 * NGW) { const int r2 = r + NGW; const bool two = r2 < I_DN; const int e = r / I_DN1, e2 = (two ? r2 : r) / I_DN1; float tva[32], tvb[32];
            SrcPlain sa{a->in[24] + ((size_t)l * NEXP + e) * FF * DM, DM}, sb{a->in[24] + ((size_t)l * NEXP + e2) * FF * DM, DM};
            tr8_load(sa, DM, r - e * I_DN1, F.lane, tva); tr8_load(sb, DM, (two ? r2 : r) - e2 * I_DN1, F.lane, tvb);
            tr8_finish(tva, FF, DM, wl + WL_WDN + (size_t)e * DM * FF, 64.f, scr, r - e * I_DN1, F.lane);
            if (two) tr8_finish(tvb, FF, DM, wl + WL_WDN + (size_t)e2 * DM * FF, 64.f, scr, r2 - e2 * I_DN1, F.lane); }
    }
    if (!(parts & 2)) return;
    for (int it = I_GU + I_DN + gw; it < NITEMS; it += NGW) {
        int r = it - I_GU - I_DN;
        if (r < I_WIN) { SrcWin s{a->in[1] + (size_t)l * DM * DIN}; float tv[32]; tr8_load(s, DINP, r, F.lane, tv); tr8_finish(tv, DM, DINP, wl + WL_WIN, 32.f, scr, r, F.lane); continue; } r -= I_WIN;
        if (r < I_WOUT) { SrcPlain s{a->in[2] + (size_t)l * DM * DM, DM}; tr_item(s, DM, DM, (bf16*)(wl + WL_WOUT), scr, r, F.lane); continue; } r -= I_WOUT;
        if (r < I_W1) { const int kv = r / 128; SrcPlain s{a->in[4] + ((size_t)l * 2 + kv) * 2048 * 128, 128};
            tr_item(s, 2048, 128, (bf16*)(wl + WL_W1) + (size_t)kv * 128 * 2048, scr, r - kv * 128, F.lane); continue; } r -= I_W1;
        if (r < I_W2) { const int kv = r / 4; SrcPlain s{a->in[5] + ((size_t)l * 2 + kv) * 128 * 64, 64};
            tr_item(s, 128, 64, (bf16*)(wl + WL_W2) + (size_t)kv * 64 * 128, scr, r - kv * 4, F.lane); continue; } r -= I_W2;
        if (r < I_WR) {
            float* wr = (float*)(wl + WL_WR) + (size_t)r * DM;
            for (int k = F.lane; k < DM; k += 64) wr[k] = (r < 4) ? a->in[18][((size_t)l * DM + k) * 4 + r] : a->in[20][((size_t)l * DM + k) * NEXP + (r - 4)];
            continue; } r -= I_WR;
        {
            const int kv = r >> 7, n = r & 127; const float* pe = a->in[3] + ((size_t)l * 2 + kv) * 2048; const float* w1 = a->in[4] + ((size_t)l * 2 + kv) * 2048 * 128;
            float s = 0.f; for (int k = F.lane; k < 2048; k += 64) s += pe[k] * w1[(size_t)k * 128 + n];
            s = wave_sum(s); if (F.lane == 0) ((float*)(wl + WL_BIAS1))[r] = s;
        }
    }
}

__device__ __forceinline__ void phase_prologue(const Frame& F, ArgsP a) {
    const size_t gt = (size_t)F.bid * NTHR + F.tid, NGT = (size_t)F.G * NTHR;
    float* rope = (float*)(a->ws + WS_ROPE);
    for (size_t i = gt; i < (size_t)SEQ * 8; i += NGT) { const int t = (int)(i >> 3), f = (int)(i & 7);
        const float invt[8] = {1.0f, 0.19392274f, 0.03760603f, 0.0072926646f, 0.0014142136f, 0.0002742482f, 5.3182957e-05f, 1.0313385e-05f};
        float inv = invt[0];
#pragma unroll
        for (int q = 1; q < 8; ++q) inv = (f == q) ? invt[q] : inv;
        const float ang = (float)t * inv;
        const double rev = (double)ang * 0.15915494309189535; const float fr = (float)(rev - __builtin_rint(rev));
        rope[t * 16 + f] = __builtin_amdgcn_cosf(fr); rope[t * 16 + 8 + f] = __builtin_amdgcn_sinf(fr); }
    const f32x4* x4 = (const f32x4*)a->in[0]; u32x4* xb = (u32x4*)(a->ws + WS_XB);
    for (size_t i = gt; i < (size_t)T * DM / 8; i += NGT) { const f32x4 v0 = x4[2 * i], v1 = x4[2 * i + 1];
        u32x4 w; w.x = pk2(v0[0], v0[1]); w.y = pk2(v0[2], v0[3]); w.z = pk2(v1[0], v1[1]); w.w = pk2(v1[2], v1[3]); xb[i] = w;
        int p0 = 0, p1 = 0; p0 = __builtin_amdgcn_cvt_pk_fp8_f32(v0[0], v0[1], p0, false); p0 = __builtin_amdgcn_cvt_pk_fp8_f32(v0[2], v0[3], p0, true); p1 = __builtin_amdgcn_cvt_pk_fp8_f32(v1[0], v1[1], p1, false); p1 = __builtin_amdgcn_cvt_pk_fp8_f32(v1[2], v1[3], p1, true);
        u32x2 w8; w8.x = (unsigned)p0; w8.y = (unsigned)p1; ((u32x2*)(a->ws + WS_X8))[i] = w8; }
}

template <bool DRY>
__device__ __forceinline__ void phase_ln1_router(const Frame& F, ArgsP a, int l) {
    const bf16* X1 = (const bf16*)(a->ws + WS_X1); bf16* XB = (bf16*)(a->ws + WS_XB); unsigned char* XB8 = a->ws + WS_H;
    const float* WR = (const float*)(WLBASE(a->ws, l) + WL_WR);
    const float* lw = a->in[14] + (size_t)l * DM; const float* lb = a->in[15] + (size_t)l * DM;
    const float* bg = a->in[19] + l * 4; const float* be = a->in[21] + l * NEXP;
    int* route_e = (int*)(a->ws + WS_SLOT + SL_RE); int* route_p = (int*)(a->ws + WS_SLOT + SL_RP); float* route_w = (float*)(a->ws + WS_SLOT + SL_RW);
    unsigned* cnt = F.ctl + CW_CNT + (DRY ? l + 4 : l) * 512;
    const int gw = F.bid * NWAVES + F.wave, NGW = F.G * NWAVES, lane = F.lane;
    LAS float* wgl = (LAS float*)F.lds;
    for (int i = F.tid; i < 4 * DM; i += NTHR) wgl[i] = WR[i];
    __syncthreads();
    const float bg0 = bg[0], bg1 = bg[1], bg2 = bg[2], bg3 = bg[3];
    for (int tg = gw; tg < T / 4; tg += NGW) {
        f32x4 v[4][4];
#pragma unroll
        for (int tk = 0; tk < 4; ++tk) { const u32x2* row = (const u32x2*)(X1 + (size_t)(4 * tg + tk) * DM) + lane;
            u32x2 raw[4];
#pragma unroll
            for (int j = 0; j < 4; ++j) raw[j] = row[64 * j];
#pragma unroll
            for (int j = 0; j < 4; ++j) { v[tk][j][0] = bf2f(raw[j].x & 0xffffu); v[tk][j][1] = __uint_as_float(raw[j].x & 0xffff0000u); v[tk][j][2] = bf2f(raw[j].y & 0xffffu); v[tk][j][3] = __uint_as_float(raw[j].y & 0xffff0000u); } }
#pragma unroll
        for (int tk = 0; tk < 4; ++tk) {
            float s = 0.f;
#pragma unroll
            for (int j = 0; j < 4; ++j) s += (v[tk][j][0] + v[tk][j][1]) + (v[tk][j][2] + v[tk][j][3]);
            const float mean = wave_sum(s) * (1.f / DM); float q = 0.f;
#pragma unroll
            for (int j = 0; j < 4; ++j) { v[tk][j] = v[tk][j] - mean; q += (v[tk][j][0] * v[tk][j][0] + v[tk][j][1] * v[tk][j][1]) + (v[tk][j][2] * v[tk][j][2] + v[tk][j][3] * v[tk][j][3]); }
            const float rstd = 1.f / sqrtf(wave_sum(q) * (1.f / DM) + LN_EPS);
            u32x2* brow = (u32x2*)(XB + (size_t)(4 * tg + tk) * DM) + lane;
#pragma unroll
            for (int j = 0; j < 4; ++j) { const f32x4 w4 = ((const f32x4*)lw)[lane + 64 * j], b4 = ((const f32x4*)lb)[lane + 64 * j];
                v[tk][j] = v[tk][j] * rstd * w4 + b4;
                u32x2 w; w.x = pk2(v[tk][j][0], v[tk][j][1]); w.y = pk2(v[tk][j][2], v[tk][j][3]); if (!DRY) brow[64 * j] = w;
                int w8 = 0; w8 = __builtin_amdgcn_cvt_pk_fp8_f32(v[tk][j][0], v[tk][j][1], w8, false); w8 = __builtin_amdgcn_cvt_pk_fp8_f32(v[tk][j][2], v[tk][j][3], w8, true);
                if (!DRY) ((int*)(XB8 + (size_t)(4 * tg + tk) * DM))[lane + 64 * j] = w8; }
        }
        float glg[4][4];
#pragma unroll
        for (int j = 0; j < 4; ++j) { const LAS f32x4* wr = (const LAS f32x4*)(wgl + j * DM) + lane; const f32x4 w0 = wr[0], w1 = wr[64], w2 = wr[128], w3 = wr[192];
#pragma unroll
            for (int tk = 0; tk < 4; ++tk) { f32x4 p = v[tk][0] * w0; p = p + v[tk][1] * w1; p = p + v[tk][2] * w2; p = p + v[tk][3] * w3; glg[tk][j] = wave_sum((p[0] + p[1]) + (p[2] + p[3])); } }
        int my_e = 0; float my_w = 0.f;
#pragma unroll
        for (int tk = 0; tk < 4; ++tk) {
            const float g0 = glg[tk][0] + bg0, g1 = glg[tk][1] + bg1, g2 = glg[tk][2] + bg2, g3 = glg[tk][3] + bg3;
            int gi = 0; float gm = g0; if (g1 > gm) { gm = g1; gi = 1; } if (g2 > gm) { gm = g2; gi = 2; } if (g3 > gm) { gm = g3; gi = 3; }
            gi = __builtin_amdgcn_readfirstlane(gi);
            const float g_w = 1.f / (__expf(g0 - gm) + __expf(g1 - gm) + __expf(g2 - gm) + __expf(g3 - gm));
            const float* wbase = WR + (size_t)(4 + gi * 8) * DM; float ev[8];
#pragma unroll
            for (int i4 = 0; i4 < 2; ++i4) { f32x4 w[4][4];
#pragma unroll
                for (int i = 0; i < 4; ++i) { const f32x4* wr = (const f32x4*)(wbase + (size_t)(4 * i4 + i) * DM) + lane; w[i][0] = wr[0]; w[i][1] = wr[64]; w[i][2] = wr[128]; w[i][3] = wr[192]; }
#pragma unroll
                for (int i = 0; i < 4; ++i) { f32x4 p = v[tk][0] * w[i][0]; p = p + v[tk][1] * w[i][1]; p = p + v[tk][2] * w[i][2]; p = p + v[tk][3] * w[i][3];
                    ev[4 * i4 + i] = wave_sum((p[0] + p[1]) + (p[2] + p[3])) + be[gi * 8 + 4 * i4 + i]; } }
            int i1 = 0; float v1 = ev[0];
#pragma unroll
            for (int i = 1; i < 8; ++i) if (ev[i] > v1) { v1 = ev[i]; i1 = i; }
            int i2 = -1; float v2 = -3.0e38f;
#pragma unroll
            for (int i = 0; i < 8; ++i) if (i != i1 && ev[i] > v2) { v2 = ev[i]; i2 = i; }
            const float e2 = __expf(v2 - v1), w1 = g_w / (1.f + e2), w2 = g_w - w1;
            if (lane == 2 * tk) { my_e = gi * 8 + i1; my_w = w1; }
            if (lane == 2 * tk + 1) { my_e = gi * 8 + i2; my_w = w2; }
        }
        if (lane < 8) {
            const unsigned pos = __hip_atomic_fetch_add(cnt + my_e * 16, 1u, __ATOMIC_RELAXED, __HIP_MEMORY_SCOPE_AGENT);
            const size_t si = (size_t)tg * 8 + lane; if (!DRY) { route_e[si] = my_e; route_p[si] = (int)pos; route_w[si] = my_w; }
        }
    }
    __syncthreads();
}

__device__ __forceinline__ void phase_gather(const Frame& F, ArgsP a, int l) {
    LAS int* pstart = (LAS int*)F.lds;
    unsigned* cnt = F.ctl + CW_CNT + l * 512;
    int* meta = (int*)(a->ws + WS_META) + l * 512;
    int* slot_tok = (int*)(a->ws + WS_SLOT + SL_TOK); float* slot_w = (float*)(a->ws + WS_SLOT + SL_W);
    const int* route_e = (const int*)(a->ws + WS_SLOT + SL_RE); const int* route_p = (const int*)(a->ws + WS_SLOT + SL_RP); const float* route_w = (const float*)(a->ws + WS_SLOT + SL_RW);
    if (F.tid < 64) {
        const int c = F.tid < 32 ? (int)__hip_atomic_load(cnt + F.tid * 16, __ATOMIC_RELAXED, __HIP_MEMORY_SCOPE_AGENT) : 0;
        const int pad = (c + 255) & ~255; int inc = pad;
#pragma unroll
        for (int o = 1; o < 64; o <<= 1) { const int t = __shfl_up(inc, o); if (F.lane >= o) inc += t; }
        const int st = inc - pad;
        if (F.tid < 32) { pstart[F.tid] = st;
            if (F.bid == 0) { for (int t = st >> 8; t < (st + pad) >> 8; ++t) meta[64 + t] = F.tid; if (F.tid == 31) meta[0] = (st + pad) >> 8; }
            if ((F.tid % F.G) == F.bid) for (int r = st + c; r < st + pad; ++r) { slot_tok[r] = -1; slot_w[r] = 0.f; }
        }
    }
    __syncthreads();
    for (int s = F.bid * NTHR + F.tid; s < T * 2; s += F.G * NTHR) {
        const int dest = pstart[route_e[s]] + route_p[s]; slot_tok[dest] = s; slot_w[dest] = route_w[s];
    }
    __syncthreads();
}

__device__ __forceinline__ void phase_ln2(const Frame& F, ArgsP a, int l) {
    const bf16* Y2 = (const bf16*)(a->ws + WS_Y2); bf16* XB = (bf16*)(a->ws + WS_XB); float* out = a->out;
    const float* lw = a->in[16] + (size_t)l * DM; const float* lb = a->in[17] + (size_t)l * DM;
    const int gw = F.bid * NWAVES + F.wave, NGW = F.G * NWAVES, lane = F.lane; const bool last = (l == NL - 1);
    for (int t0 = 2 * gw; t0 < T; t0 += 2 * NGW) {
        u32x2 xr[2][4], pa[2][4], pb[2][4];
#pragma unroll
        for (int u = 0; u < 2; ++u) { const int t = t0 + u; const u32x2* x_ = (const u32x2*)(XB + (size_t)t * DM) + lane; const u32x2* a_ = (const u32x2*)(Y2 + (size_t)(2 * t) * DM) + lane; const u32x2* b_ = (const u32x2*)(Y2 + (size_t)(2 * t + 1) * DM) + lane;
#pragma unroll
            for (int j = 0; j < 4; ++j) { xr[u][j] = x_[64 * j]; pa[u][j] = a_[64 * j]; pb[u][j] = b_[64 * j]; } }
#pragma unroll
        for (int u = 0; u < 2; ++u) { const int t = t0 + u;
            f32x4 v[4]; float s = 0.f;
#pragma unroll
            for (int j = 0; j < 4; ++j) { const u32x2 x = xr[u][j], p = pa[u][j], q = pb[u][j];
                v[j][0] = bf2f(x.x & 0xffffu) * DN_ALPHA + (bf2f(p.x & 0xffffu) + bf2f(q.x & 0xffffu)); v[j][1] = bf2f(x.x >> 16) * DN_ALPHA + (bf2f(p.x >> 16) + bf2f(q.x >> 16));
                v[j][2] = bf2f(x.y & 0xffffu) * DN_ALPHA + (bf2f(p.y & 0xffffu) + bf2f(q.y & 0xffffu)); v[j][3] = bf2f(x.y >> 16) * DN_ALPHA + (bf2f(p.y >> 16) + bf2f(q.y >> 16));
                s += (v[j][0] + v[j][1]) + (v[j][2] + v[j][3]); }
            const float mean = wave_sum(s) * (1.f / DM); float q2 = 0.f;
#pragma unroll
            for (int j = 0; j < 4; ++j) { v[j] = v[j] - mean; q2 += (v[j][0] * v[j][0] + v[j][1] * v[j][1]) + (v[j][2] * v[j][2] + v[j][3] * v[j][3]); }
            const float rstd = 1.f / sqrtf(wave_sum(q2) * (1.f / DM) + LN_EPS);
            f32x4* orow = (f32x4*)(out + (size_t)t * DM) + lane; u32x2* brow = (u32x2*)(XB + (size_t)t * DM) + lane;
#pragma unroll
            for (int j = 0; j < 4; ++j) { const f32x4 w4 = ((const f32x4*)lw)[lane + 64 * j], b4 = ((const f32x4*)lb)[lane + 64 * j];
                const f32x4 o = v[j] * rstd * w4 + b4; if (last) orow[64 * j] = o; u32x2 w; w.x = pk2(o[0], o[1]); w.y = pk2(o[2], o[3]); if (!last) brow[64 * j] = w;
                int w8 = 0; w8 = __builtin_amdgcn_cvt_pk_fp8_f32(o[0], o[1], w8, false); w8 = __builtin_amdgcn_cvt_pk_fp8_f32(o[2], o[3], w8, true); if (!last) ((int*)(a->ws + WS_X8 + (size_t)t * DM))[lane + 64 * j] = w8; } }
    }
}

__device__ __forceinline__ int tsw(int row, int col) { return row * 128 + ((((col >> 3) ^ (row >> 1)) & 7) << 4) + ((col & 7) << 1); }
__device__ __forceinline__ f32x4 mfma16(bf16x8 a, bf16x8 b, f32x4 c) { return __builtin_amdgcn_mfma_f32_16x16x32_bf16(a, b, c, 0, 0, 0); }
__device__ __forceinline__ f32x16 mfma32(bf16x8 a, bf16x8 b, f32x16 c) { return __builtin_amdgcn_mfma_f32_32x32x16_bf16(a, b, c, 0, 0, 0); }
__device__ __forceinline__ bf16x8 as_bf16x8(u32x4 v) { return __builtin_bit_cast(bf16x8, v); }

__device__ __forceinline__ void conformer_item(const Frame& F, ArgsP a, int l, int it) {
    const int b = it >> 6, s0 = (it & 63) * 64; const size_t tok0 = (size_t)b * SEQ + s0;
    const bf16* H = (const bf16*)(a->ws + WS_H); bf16* Y = (bf16*)(a->ws + WS_Y);
    LAS bf16* ut = (LAS bf16*)F.lds;
    LAS float* co = (LAS float*)(F.lds + 49152);
    for (int idx = F.tid; idx < 94 * 32; idx += NTHR) {
        const int r = idx >> 5, c8 = (idx & 31) * 8, s = s0 - 30 + r; u32x4 w = {0u, 0u, 0u, 0u};
        if (s >= 0) { const bf16* hp = H + ((size_t)b * SEQ + s) * HLD + 2304 + c8; const u32x4 v = *(const u32x4*)hp, g = *(const u32x4*)(hp + 256);
#pragma unroll
            for (int e = 0; e < 4; ++e) { const float v0 = bf2f(v[e] & 0xffffu) * fsigmoid(bf2f(g[e] & 0xffffu)), v1 = bf2f(v[e] >> 16) * fsigmoid(bf2f(g[e] >> 16)); w[e] = pk2(v0, v1); } }
        *(LAS u32x4*)(ut + r * 256 + c8) = w;
    }
    __syncthreads();
    {
        const int c = F.tid & 255, half = F.tid >> 8; const float* dw = a->in[10] + (size_t)l * 31 * 256 + c; const float bias = a->in[11][l * 256 + c];
        float w[31], ur[62];
#pragma unroll
        for (int k = 0; k < 31; ++k) w[k] = dw[k * 256];
#pragma unroll
        for (int i = 0; i < 62; ++i) ur[i] = bf2f(ut[(32 * half + i) * 256 + c]);
#pragma unroll
        for (int tt = 0; tt < 32; ++tt) { float acc = bias;
#pragma unroll
            for (int k = 0; k < 31; ++k) acc += w[k] * ur[tt + k];
            co[(32 * half + tt) * 256 + c] = acc; }
    }
    __syncthreads();
    {
        const float* lw = a->in[12] + l * 256; const float* lb = a->in[13] + l * 256; const f32x4 w4 = ((const f32x4*)lw)[F.lane], b4 = ((const f32x4*)lb)[F.lane];
#pragma unroll
        for (int i = 0; i < 8; ++i) { const int tl = 8 * F.wave + i; f32x4 v = *(LAS f32x4*)(co + tl * 256 + 4 * F.lane);
            const float mean = wave_sum((v[0] + v[1]) + (v[2] + v[3])) * (1.f / 256.f); v = v - mean;
            const float rstd = 1.f / sqrtf(wave_sum((v[0] * v[0] + v[1] * v[1]) + (v[2] * v[2] + v[3] * v[3])) * (1.f / 256.f) + LN_EPS);
            v = v * rstd * w4 + b4; u32x2 o; o.x = pk2(fsilu(v[0]), fsilu(v[1])); o.y = pk2(fsilu(v[2]), fsilu(v[3]));
            *(u32x2*)(Y + (tok0 + tl) * DM + 768 + 4 * F.lane) = o; }
    }
    __syncthreads();
}

__device__ __forceinline__ void compress_item(const Frame& F, ArgsP a, int l, int it) {
    const int kv = it >> 7, bh = (it >> 3) & 15, b = bh >> 1, hh = bh & 1, i0 = (it & 7) * 32;
    const bf16* H = (const bf16*)(a->ws + WS_H); const bf16* w1t = (const bf16*)(WLBASE(a->ws, l) + WL_W1) + (size_t)kv * 128 * 2048; const bf16* w2t = (const bf16*)(WLBASE(a->ws, l) + WL_W2) + (size_t)kv * 64 * 128;
    const float* bias1 = (const float*)(WLBASE(a->ws, l) + WL_BIAS1) + kv * 128; bf16* outp = (bf16*)(a->ws + (kv ? WS_VC : WS_KC)) + (size_t)bh * 256 * 64;
    LAS bf16* hid = (LAS bf16*)F.lds;
    const int lane = F.lane, li = lane & 15, g = lane >> 4, rt = F.wave & 1, cq = F.wave >> 1;
    const int i = i0 + 16 * rt + li; const bf16* arow = H + (size_t)b * SEQ * HLD + 512 + kv * 128 + hh * 64 + 8 * g;
    const bf16* brow = w1t + (size_t)(32 * cq + li) * 2048 + 8 * g;
    f32x4 acc[2] = {{0.f, 0.f, 0.f, 0.f}, {0.f, 0.f, 0.f, 0.f}};
#pragma unroll 1
    for (int k8 = 0; k8 < 64; k8 += 8) {
        bf16x8 af[8], bfr[8][2];
#pragma unroll
        for (int u = 0; u < 8; ++u) { const int ks = k8 + u; int s = 16 * i + (ks >> 1); s = s > SEQ - 1 ? SEQ - 1 : s;
            af[u] = *(const bf16x8*)(arow + (size_t)s * HLD + (ks & 1) * 32); bfr[u][0] = *(const bf16x8*)(brow + ks * 32); bfr[u][1] = *(const bf16x8*)(brow + (size_t)16 * 2048 + ks * 32); }
#pragma unroll
        for (int u = 0; u < 8; ++u) { acc[0] = mfma16(af[u], bfr[u][0], acc[0]); acc[1] = mfma16(af[u], bfr[u][1], acc[1]); }
    }
#pragma unroll
    for (int nt = 0; nt < 2; ++nt) { const int n = 32 * cq + 16 * nt + li; const float bs = bias1[n];
#pragma unroll
        for (int r = 0; r < 4; ++r) hid[(16 * rt + 4 * g + r) * 136 + n] = (bf16)f2bf(fsilu(acc[nt][r] + bs)); }
    __syncthreads();
    f32x4 o2 = {0.f, 0.f, 0.f, 0.f};
#pragma unroll
    for (int ks = 0; ks < 4; ++ks) { const bf16x8 af = *(LAS bf16x8*)(hid + (16 * rt + li) * 136 + 32 * ks + 8 * g);
        const bf16x8 bfr = *(const bf16x8*)(w2t + (size_t)(16 * cq + li) * 128 + 32 * ks + 8 * g); o2 = mfma16(af, bfr, o2); }
#pragma unroll
    for (int r = 0; r < 4; ++r) { const int io = i0 + 16 * rt + 4 * g + r; outp[(size_t)io * 64 + 16 * cq + li] = (bf16)(io < 255 ? f2bf_sw(o2[r]) : 0u); }
    __syncthreads();
}

__device__ __forceinline__ void knorm_pass(const Frame& F, ArgsP a, int l) {
    const bf16* H = (const bf16*)(a->ws + WS_H); unsigned* km = F.ctl + CW_KMAX + l * 64; LAS unsigned* red = (LAS unsigned*)F.lds;
    for (int base = F.bid * NTHR; base < T * 4; base += F.G * NTHR) {
        if (F.tid < 4) red[F.tid] = 0u;
        __syncthreads();
        const int gid = base + F.tid, tok = gid >> 2, v = gid & 3;
        const u32x4* p = (const u32x4*)(H + (size_t)tok * HLD + 512 + (v < 2 ? 2 : 4) * 128 + (v & 1) * 64);
        u32x4 w[8];
#pragma unroll
        for (int c = 0; c < 8; ++c) w[c] = p[c];
        float s0 = 0.f, s1 = 0.f;
#pragma unroll
        for (int c = 0; c < 8; ++c)
#pragma unroll
            for (int e = 0; e < 4; ++e) { const float lo = bf2f(w[c][e] & 0xffffu), hi = __uint_as_float(w[c][e] & 0xffff0000u); s0 += lo * lo; s1 += hi * hi; }
        (void)__hip_atomic_fetch_max(red + v, __float_as_uint(s0 + s1), __ATOMIC_RELAXED, __HIP_MEMORY_SCOPE_WORKGROUP);
        __syncthreads();
        if (F.tid < 4) (void)__hip_atomic_fetch_max(km + (base >> 14) * 4 + F.tid, red[F.tid], __ATOMIC_RELAXED, __HIP_MEMORY_SCOPE_AGENT);
        __syncthreads();
    }
}

__host__ __device__ constexpr int tri_off(int i) { int s = 0; for (int k = 0; k < i; ++k) s += (k + 3) >> 2; return 4 * s; }
__device__ __forceinline__ int tri_off_rt(int i) { const int m = i - 1, V = (m + 3) >> 2; return i <= 0 ? 0 : 4 * (2 * V * (V - 1) + V * (m - 4 * V + 4)); }

template <int I> struct GdnSolveRow {
    __device__ static __forceinline__ void run(const LAS float* Ap, float (&x)[64]) {
        if constexpr (I < 64) {
            constexpr int off = tri_off(I), nb = (I + 3) >> 2;
            float s4[4] = {0.f, 0.f, 0.f, 0.f};
#pragma unroll
            for (int jb = 0; jb < nb; ++jb) { const f32x4 a4 = *(const LAS f32x4*)(Ap + off + 4 * jb);
#pragma unroll
                for (int jj = 0; jj < 4; ++jj) { if (4 * jb + jj < I) s4[jj] += a4[jj] * x[4 * jb + jj]; } }
            x[I] -= (s4[0] + s4[1]) + (s4[2] + s4[3]);
            if constexpr ((I & 3) == 3) SBAR();
            GdnSolveRow<I + 1>::run(Ap, x);
        }
    }
};

template <int GV>
__device__ __forceinline__ void gdn_prep_chunk(const Frame& F, ArgsP a, int l, int ci, LAS unsigned char* wl) {
    int lane_ = F.lane; asm volatile("" : "+v"(lane_));
    const int lane = lane_, li = lane & 15, g = lane >> 4; const int bh = ci >> 6, n = ci & 63, b = bh >> 2, h = bh & 3; const size_t tok0 = (size_t)b * SEQ + 64 * n;
    const bf16* H = (const bf16*)(a->ws + WS_H); const float* side = (const float*)(a->ws + WS_SIDE);
    unsigned char* rec = a->ws + ((GV & 1) ? WS_Y2 : WS_GPREP) + (size_t)ci * GCH;
    bf16* R0 = (bf16*)(rec + GC_UT); bf16* R1 = (bf16*)(rec + GC_W); bf16* QKm = (bf16*)(rec + GC_QK); bf16* QD = (bf16*)(rec + GC_QD); bf16* KDT = (bf16*)(rec + GC_KDT); bf16* ZT = (bf16*)(rec + GC_ZT);
    const int pc = (lane & 32) | (((lane & 15) >> 2) << 3) | (((lane >> 4) & 1) << 2) | (lane & 3);
    LAS unsigned char* qt = wl; LAS unsigned char* kt = wl + 8192; LAS float* Ap = (LAS float*)wl;
    const float beta = side[(tok0 + lane) * 32 + 24 + h]; const float av = side[(tok0 + lane) * 32 + 28 + h] + a->in[8][l * 4 + h];
    const float sp = av > 20.f ? av : log1pf(__expf(av)); float gc = -__expf(a->in[7][l * 4 + h]) * sp;
#pragma unroll
    for (int o = 1; o < 64; o <<= 1) { const float t = __shfl_up(gc, o); if (lane >= o) gc += t; }
    const float gl = __shfl(gc, 63); const float eg = __expf(gc), ekd = __expf(gl - gc);
    if (lane == 0 && !(GV & 1)) ((float*)(a->ws + WS_GL))[ci] = __expf(gl);
    const float* cw = a->in[6] + (size_t)l * 4 * 768 + h * 64 + lane; float wq[4], wk[4], wv[4];
#pragma unroll
    for (int k = 0; k < 4; ++k) { wq[k] = cw[k * 768]; wk[k] = cw[k * 768 + 256]; wv[k] = cw[k * 768 + 512]; }
    const bf16* hp = H + tok0 * HLD + 1280 + h * 64 + lane; float hq[3], hk[3], hv[3];
#pragma unroll
    for (int j = 0; j < 3; ++j) { const bool ok = (64 * n - 3 + j) >= 0; const bf16* p = hp + (ptrdiff_t)(j - 3) * HLD;
        hq[j] = ok ? bf2f(p[0]) : 0.f; hk[j] = ok ? bf2f(p[256]) : 0.f; hv[j] = ok ? bf2f(p[512]) : 0.f; }
    unsigned short ra[8][4], rb[8][4]; const float nwl = a->in[9][l * 64 + lane];
#define GDN_LOADBLK(dst, t8_) do { const bf16* pl_ = hp + (size_t)(8 * (t8_)) * HLD; asm volatile("" : "+v"(pl_)); _Pragma("unroll") for (int tt = 0; tt < 8; ++tt) { const bf16* q_ = pl_ + (size_t)tt * HLD; dst[tt][0] = q_[0]; dst[tt][1] = q_[256]; dst[tt][2] = q_[512]; dst[tt][3] = q_[768]; } } while (0)
#define GDN_CONVBLK(src, t8_) do { const int t8 = (t8_); unsigned kdp[4], zp[4]; \
        bf16* qd8 = QD + (8 * t8) * 64 + pc; bf16* r08 = R0 + (8 * t8) * 64 + lane; bf16* r18 = R1 + (8 * t8) * 64 + lane; asm volatile("" : "+v"(qd8), "+v"(r08), "+v"(r18)); \
        _Pragma("unroll") for (int tt = 0; tt < 8; ++tt) { const int t = 8 * t8 + tt; \
            const float rq = bf2f(src[tt][0]), rk = bf2f(src[tt][1]), rv = bf2f(src[tt][2]); \
            const float cq = wq[0] * hq[0] + wq[1] * hq[1] + wq[2] * hq[2] + wq[3] * rq, ck = wk[0] * hk[0] + wk[1] * hk[1] + wk[2] * hk[2] + wk[3] * rk, cv = wv[0] * hv[0] + wv[1] * hv[1] + wv[2] * hv[2] + wv[3] * rv; \
            hq[0] = hq[1]; hq[1] = hq[2]; hq[2] = rq; hk[0] = hk[1]; hk[1] = hk[2]; hk[2] = rk; hv[0] = hv[1]; hv[1] = hv[2]; hv[2] = rv; \
            const float qs = fsilu(cq), ks_ = fsilu(ck), vs = fsilu(cv); \
            const float qn = qs * __builtin_amdgcn_rsqf(wave_sum(qs * qs) + 1e-6f) * 0.125f, kn = ks_ * __builtin_amdgcn_rsqf(wave_sum(ks_ * ks_) + 1e-6f); \
            const float bt = __int_as_float(__builtin_amdgcn_readlane(__float_as_int(beta), t)), egt = __int_as_float(__builtin_amdgcn_readlane(__float_as_int(eg), t)), ekt = __int_as_float(__builtin_amdgcn_readlane(__float_as_int(ekd), t)); \
            *(LAS bf16*)(qt + tsw(t, lane)) = (bf16)f2bf(qn); *(LAS bf16*)(kt + tsw(t, lane)) = (bf16)f2bf(kn); \
            qd8[tt * 64] = (bf16)f2bf(qn * egt); r08[tt * 64] = (bf16)f2bf(bt * vs); r18[tt * 64] = (bf16)f2bf(bt * egt * kn); \
            const unsigned kd = f2bf(kn * ekt); if (tt & 1) kdp[tt >> 1] |= kd << 16; else kdp[tt >> 1] = kd; \
            const unsigned zg = f2bf(fsilu(bf2f(src[tt][3])) * nwl); if (tt & 1) zp[tt >> 1] |= zg << 16; else zp[tt >> 1] = zg; } \
        { u32x4 wz; wz.x = zp[0]; wz.y = zp[1]; wz.z = zp[2]; wz.w = zp[3]; *(u32x4*)(ZT + lane * 64 + 8 * t8) = wz; } \
        { const int c0 = (8 * t8) & 31, gg = (c0 & 15) >> 2, hh = c0 >> 4; bf16* kr = KDT + lane * 64 + ((8 * t8) & 32) + 4 * hh; \
          u32x2 w0, w1; w0.x = kdp[0]; w0.y = kdp[1]; w1.x = kdp[2]; w1.y = kdp[3]; *(u32x2*)(kr + 8 * gg) = w0; *(u32x2*)(kr + 8 * gg + 8) = w1; } } while (0)
    if (!(GV & 2)) {
    GDN_LOADBLK(ra, 0);
#pragma unroll 1
    for (int t16 = 0; t16 < 4; ++t16) {
        GDN_LOADBLK(rb, 2 * t16 + 1);
        GDN_CONVBLK(ra, 2 * t16);
        if (t16 < 3) GDN_LOADBLK(ra, 2 * t16 + 2);
        GDN_CONVBLK(rb, 2 * t16 + 1);
    }
    }
#undef GDN_LOADBLK
#undef GDN_CONVBLK
    LDS_WAIT();
    if (!(GV & 4)) {
    float gcj[4][4];
#pragma unroll
    for (int mt = 0; mt < 4; ++mt)
#pragma unroll
        for (int r = 0; r < 4; ++r) gcj[mt][r] = __shfl(gc, 16 * mt + 4 * g + r);
    f32x4 ahold[4][4];
#pragma unroll
    for (int nt = 0; nt < 4; ++nt) {
        const int i = 16 * nt + li; const float gci = __shfl(gc, i), bi = __shfl(beta, i);
        bf16x8 kB[2], qB[2];
#pragma unroll
        for (int ks = 0; ks < 2; ++ks) { kB[ks] = *(LAS bf16x8*)(kt + tsw(i, 32 * ks + 8 * g)); qB[ks] = *(LAS bf16x8*)(qt + tsw(i, 32 * ks + 8 * g)); }
#pragma unroll
        for (int mt = 0; mt < 4; ++mt) {
            u32x2 qw = {0u, 0u};
            if (mt <= nt) {
                const bf16x8 kA0 = *(LAS bf16x8*)(kt + tsw(16 * mt + li, 8 * g)), kA1 = *(LAS bf16x8*)(kt + tsw(16 * mt + li, 32 + 8 * g));
                f32x4 ckk = {0.f, 0.f, 0.f, 0.f}, cqk = {0.f, 0.f, 0.f, 0.f};
                ckk = mfma16(kA0, kB[0], ckk); ckk = mfma16(kA1, kB[1], ckk); cqk = mfma16(kA0, qB[0], cqk); cqk = mfma16(kA1, qB[1], cqk);
                float qv[4];
#pragma unroll
                for (int r = 0; r < 4; ++r) { const int j = 16 * mt + 4 * g + r; const float dec = __expf(fminf(gci - gcj[mt][r], 0.f));
                    ahold[nt][mt][r] = bi * ckk[r] * dec; qv[r] = (j <= i) ? cqk[r] * dec : 0.f; }
                qw.x = pk2(qv[0], qv[1]); qw.y = pk2(qv[2], qv[3]);
            }
            *(u32x2*)(QKm + i * 64 + 32 * (mt >> 1) + 8 * g + 4 * (mt & 1)) = qw;
        }
    }
    LDS_WAIT(); SBAR();
#pragma unroll
    for (int nt = 0; nt < 4; ++nt) { const int i = 16 * nt + li; const int ro = tri_off_rt(i);
#pragma unroll
        for (int mt = 0; mt < 4; ++mt) if (mt <= nt) {
#pragma unroll
            for (int r = 0; r < 4; ++r) { const int j = 16 * mt + 4 * g + r; if (j < i) Ap[ro + j] = ahold[nt][mt][r]; } } }
    }
    VM_WAIT(); LDS_WAIT();
#pragma unroll 1
    for (int pass = 0; pass < 2; ++pass) {
        bf16* Rp = pass ? R1 : R0; float x[64];
#pragma unroll
        for (int i = 0; i < 64; ++i) x[i] = bf2f(Rp[i * 64 + lane]);
        VM_WAIT();
        if (!(GV & 8)) GdnSolveRow<1>::run(Ap, x);
        if (pass == 0) {
#pragma unroll
            for (int i8 = 0; i8 < 8; ++i8) { u32x4 w; w.x = pk2(x[8 * i8], x[8 * i8 + 1]); w.y = pk2(x[8 * i8 + 2], x[8 * i8 + 3]); w.z = pk2(x[8 * i8 + 4], x[8 * i8 + 5]); w.w = pk2(x[8 * i8 + 6], x[8 * i8 + 7]);
                *(u32x4*)(Rp + lane * 64 + 8 * i8) = w; }
        } else {
#pragma unroll
            for (int i = 0; i < 64; ++i) Rp[i * 64 + pc] = (bf16)f2bf(x[i]);
        }
    }
    LDS_WAIT();
}

__device__ __forceinline__ bf16x8 scan_frag(const unsigned char* mat, int mt, int ks, int li, int g) { return *(const bf16x8*)(mat + (16 * mt + li) * 128 + (32 * ks + 8 * g) * 2); }
__device__ __forceinline__ bf16x8 pack_c2(f32x4 a, f32x4 b) { u32x4 w; w.x = pk2(a[0], a[1]); w.y = pk2(a[2], a[3]); w.z = pk2(b[0], b[1]); w.w = pk2(b[2], b[3]); return as_bf16x8(w); }
constexpr int SC_SLOT = 24576;
__device__ __forceinline__ void scan_dma(LAS unsigned char* slot, const unsigned char* rec, int sl, int lane) {
#pragma unroll
    for (int m = 0; m < 3; ++m) { const int goff = (m == 0) ? GC_W : (m == 1 ? GC_KDT : GC_UT);
#pragma unroll
        for (int i = 0; i < 2; ++i) { const int row = 16 * sl + 8 * i + (lane >> 3), ch = (lane & 7) ^ ((row >> 1) & 7);
            __builtin_amdgcn_global_load_lds((const unsigned*)(rec + goff + row * 128 + ch * 16), (LAS unsigned*)(slot + m * 8192 + (16 * sl + 8 * i) * 128), 16, 0, 0); } }
}
__device__ __forceinline__ bf16x8 scan_lfrag(const LAS unsigned char* mat, int mt, int ks, int li, int g) { const int row = 16 * mt + li; return *(const LAS bf16x8*)(mat + row * 128 + ((((4 * ks + g) ^ (row >> 1)) & 7) << 4)); }
template <int SV>
__device__ __forceinline__ void gdn_scan(const Frame& F, ArgsP a, int l) {
    const int lane = F.lane, li = lane & 15, g = lane >> 4, pr = F.wave >> 2, sl = F.wave & 3; const int bh = F.bid * 2 + pr, dv0 = 16 * sl;
    const float* GL = (const float*)(a->ws + WS_GL) + bh * 64; unsigned char* rec0 = a->ws + WS_GPREP + (size_t)bh * 64 * GCH;
    LAS unsigned char* ring = F.lds + pr * (3 * SC_SLOT);
    f32x4 S[4] = {{0.f, 0.f, 0.f, 0.f}, {0.f, 0.f, 0.f, 0.f}, {0.f, 0.f, 0.f, 0.f}, {0.f, 0.f, 0.f, 0.f}};
    const float glv = GL[lane];
    asm volatile("s_waitcnt vmcnt(0)" ::: "memory");
    scan_dma(ring, rec0, sl, lane); scan_dma(ring + SC_SLOT, rec0 + GCH, sl, lane);
#pragma unroll 1
    for (int n = 0; n < 64; ++n) {
        unsigned char* rn = rec0 + (size_t)n * GCH; const LAS unsigned char* slot = ring + (n % 3) * SC_SLOT;
        if (n == 0) asm volatile("s_waitcnt vmcnt(6)" ::: "memory"); else if (n == 1) asm volatile("s_waitcnt vmcnt(10)" ::: "memory");
        else if (n == 63) asm volatile("s_waitcnt vmcnt(8)" ::: "memory"); else asm volatile("s_waitcnt vmcnt(14)" ::: "memory");
        __builtin_amdgcn_s_barrier(); asm volatile("" ::: "memory");
        if (n + 2 < 64) scan_dma(ring + ((n + 2) % 3) * SC_SLOT, rn + 2 * (size_t)GCH, sl, lane);
        else { asm volatile("" ::: "memory"); }
        const float egl = __int_as_float(__builtin_amdgcn_readlane(__float_as_int(glv), n));
        const bf16x8 Sb0 = pack_c2(S[0], S[1]), Sb1 = pack_c2(S[2], S[3]);
        if (!(SV & 1)) { bf16x8* ss = (bf16x8*)(rn + GC_SS + sl * 2048) + lane; ss[0] = Sb0; ss[64] = Sb1; }
        f32x4 vn[4];
#pragma unroll
        for (int mt = 0; mt < 4; ++mt) {
            f32x4 acc = {0.f, 0.f, 0.f, 0.f};
            acc = mfma16(scan_lfrag(slot, mt, 0, li, g), Sb0, acc); acc = mfma16(scan_lfrag(slot, mt, 1, li, g), Sb1, acc);
            const int urow = dv0 + li; const u32x2 uu = *(const LAS u32x2*)(slot + 16384 + urow * 128 + (((((16 * mt + 4 * g) >> 3) ^ (urow >> 1)) & 7) << 4) + (((16 * mt + 4 * g) & 7) << 1));
            vn[mt][0] = bf2f(uu.x & 0xffffu) - acc[0]; vn[mt][1] = bf2f(uu.x >> 16) - acc[1]; vn[mt][2] = bf2f(uu.y & 0xffffu) - acc[2]; vn[mt][3] = bf2f(uu.y >> 16) - acc[3];
        }
        const bf16x8 Vb0 = pack_c2(vn[0], vn[1]), Vb1 = pack_c2(vn[2], vn[3]);
        if (!(SV & 1)) { bf16x8* vb = (bf16x8*)(rn + GC_VB + sl * 2048) + lane; vb[0] = Vb0; vb[64] = Vb1; }
#pragma unroll
        for (int mt = 0; mt < 4; ++mt) { f32x4 acc = S[mt] * egl; acc = mfma16(scan_lfrag(slot + 8192, mt, 0, li, g), Vb0, acc); acc = mfma16(scan_lfrag(slot + 8192, mt, 1, li, g), Vb1, acc); S[mt] = acc; }
        if ((SV & 1) || n + 2 >= 64) { }
    }
    asm volatile("s_waitcnt vmcnt(0)" ::: "memory"); asm volatile("" :: "v"(S[0][0]), "v"(S[1][1]), "v"(S[2][2]), "v"(S[3][3]));
    __syncthreads();
}

__device__ __forceinline__ void gdn_out_chunk(const Frame& F, ArgsP a, int ci, LAS unsigned char* wl) {
    int lane_ = F.lane; asm volatile("" : "+v"(lane_)); const int lane = lane_, li = lane & 15, g = lane >> 4; const int bh = ci >> 6, n = ci & 63, b = bh >> 2, h = bh & 3;
    const unsigned char* rec = a->ws + WS_GPREP + (size_t)ci * GCH; bf16* Y = (bf16*)(a->ws + WS_Y);
    bf16x8 QDf[4][2], QKf[4][2];
#pragma unroll
    for (int mt = 0; mt < 4; ++mt) { QDf[mt][0] = scan_frag(rec + GC_QD, mt, 0, li, g); QDf[mt][1] = scan_frag(rec + GC_QD, mt, 1, li, g); QKf[mt][0] = scan_frag(rec + GC_QK, mt, 0, li, g); QKf[mt][1] = scan_frag(rec + GC_QK, mt, 1, li, g); }
    float ssq[4][4];
#pragma unroll
    for (int mt = 0; mt < 4; ++mt)
#pragma unroll
        for (int r = 0; r < 4; ++r) ssq[mt][r] = 0.f;
    f32x4 o[4][4];
#pragma unroll
    for (int sl = 0; sl < 4; ++sl) {
        const bf16x8* ss = (const bf16x8*)(rec + GC_SS + sl * 2048) + lane; const bf16x8* vb = (const bf16x8*)(rec + GC_VB + sl * 2048) + lane;
        const bf16x8 Sb0 = ss[0], Sb1 = ss[64], Vb0 = vb[0], Vb1 = vb[64];
#pragma unroll
        for (int mt = 0; mt < 4; ++mt) {
            f32x4 acc = {0.f, 0.f, 0.f, 0.f};
            acc = mfma16(QDf[mt][0], Sb0, acc); acc = mfma16(QDf[mt][1], Sb1, acc); acc = mfma16(QKf[mt][0], Vb0, acc); acc = mfma16(QKf[mt][1], Vb1, acc);
            o[sl][mt] = acc;
#pragma unroll
            for (int r = 0; r < 4; ++r) ssq[mt][r] += acc[r] * acc[r];
        }
    }
#pragma unroll
    for (int mt = 0; mt < 4; ++mt)
#pragma unroll
        for (int r = 0; r < 4; ++r) ssq[mt][r] = __builtin_amdgcn_rsqf(row16_sum(ssq[mt][r]) * (1.f / 64.f) + 1e-6f);
#pragma unroll
    for (int sl = 0; sl < 4; ++sl)
#pragma unroll
        for (int mt = 0; mt < 4; ++mt) {
            const u32x2 zz = *(const u32x2*)(rec + GC_ZT + (16 * sl + li) * 128 + (16 * mt + 4 * g) * 2);
            const float zf[4] = {bf2f(zz.x & 0xffffu), bf2f(zz.x >> 16), bf2f(zz.y & 0xffffu), bf2f(zz.y >> 16)};
#pragma unroll
            for (int r = 0; r < 4; ++r) *(LAS bf16*)(wl + tsw(16 * mt + 4 * g + r, 16 * sl + li)) = (bf16)f2bf(o[sl][mt][r] * ssq[mt][r] * zf[r]);
        }
    LDS_WAIT();
    bf16* yrow = Y + ((size_t)b * SEQ + 64 * n + lane) * DM + 512 + h * 64;
#pragma unroll
    for (int c = 0; c < 8; ++c) *(u32x4*)(yrow + 8 * c) = *(const LAS u32x4*)(wl + tsw(lane, 8 * c));
    LDS_WAIT();
}

constexpr int AT_K = 0, AT_V = 32768, AT_IMP = 65536, AT_SELM = AT_IMP + 64 * 68 * 4, AT_UNI = AT_SELM + 512, AT_YS = 83968;
__device__ __forceinline__ s16x4 tr_read0(unsigned addr) { s16x4 r; asm volatile("ds_read_b64_tr_b16 %0, %1" : "=&v"(r) : "v"(addr) : "memory"); return r; }

__device__ __forceinline__ float half_max(float x) { auto rr = __builtin_amdgcn_permlane32_swap(__float_as_uint(x), __float_as_uint(x), false, false); return fmaxf(__uint_as_float(rr[0]), __uint_as_float(rr[1])); }
__device__ __forceinline__ float half_sum(float x) { auto rr = __builtin_amdgcn_permlane32_swap(__float_as_uint(x), __float_as_uint(x), false, false); return __uint_as_float(rr[0]) + __uint_as_float(rr[1]); }
struct AttnStage { u32x4 kr, vr; };
__device__ __forceinline__ void at_gload(AttnStage& st, const bf16* Kb, const bf16* Vb, size_t stride, int j, int tid) {
    const int row = tid >> 3, ch = tid & 7; const size_t off = (size_t)(64 * j + row) * stride + 8 * ch;
    st.kr = *(const u32x4*)(Kb + off); st.vr = *(const u32x4*)(Vb + off);
}
__device__ __forceinline__ void at_swrite(const AttnStage& st, LAS unsigned char* lds, int buf, int tid) {
    const int row = tid >> 3, ch = tid & 7; const int o = row * 128 + (((ch ^ (row >> 1)) & 7) << 4);
    *(LAS u32x4*)(lds + AT_K + buf * 8192 + o) = st.kr; *(LAS u32x4*)(lds + AT_V + buf * 8192 + o) = st.vr;
}
__device__ __forceinline__ void at_qk(const LAS unsigned char* Kt, const bf16x8 (&Qf)[4], int r, int hf, f32x16 (&s)[2], float cinit) {
    const int swz = (r >> 1) & 7;
    bf16x8 kf[2][4];
#pragma unroll
    for (int kt = 0; kt < 2; ++kt)
#pragma unroll
        for (int ks = 0; ks < 4; ++ks) kf[kt][ks] = *(const LAS bf16x8*)(Kt + (32 * kt + r) * 128 + (((2 * ks + hf) ^ swz) << 4));
    SBAR();
#pragma unroll
    for (int kt = 0; kt < 2; ++kt) {
        f32x16 acc;
#pragma unroll
        for (int e = 0; e < 16; ++e) acc[e] = cinit;
#pragma unroll
        for (int ks = 0; ks < 4; ++ks) acc = mfma32(kf[kt][ks], Qf[ks], acc);
        s[kt] = acc;
    }
}
template <bool LSUM>
__device__ __forceinline__ void at_pv(unsigned vbase, const unsigned (&voff)[2][2], const f32x16 (&p)[2], f32x16 (&o)[2], f32x16& lacc) {
    const bf16x8 ones = {0x3F80, 0x3F80, 0x3F80, 0x3F80, 0x3F80, 0x3F80, 0x3F80, 0x3F80};
#pragma unroll
    for (int kt = 0; kt < 2; ++kt) {
        s16x4 vr[2][2][2];
#pragma unroll
        for (int s = 0; s < 2; ++s) { const unsigned co = vbase + (unsigned)(4096 * kt + 2048 * s);
            vr[s][0][0] = tr_read0(co + voff[0][0]); vr[s][1][0] = tr_read0(co + voff[1][0]); vr[s][0][1] = tr_read0(co + voff[0][1]); vr[s][1][1] = tr_read0(co + voff[1][1]); }
        bf16x8 pb[2];
#pragma unroll
        for (int s = 0; s < 2; ++s) { u32x4 pw; pw.x = pk2(p[kt][8 * s + 0], p[kt][8 * s + 1]); pw.y = pk2(p[kt][8 * s + 2], p[kt][8 * s + 3]); pw.z = pk2(p[kt][8 * s + 4], p[kt][8 * s + 5]); pw.w = pk2(p[kt][8 * s + 6], p[kt][8 * s + 7]); pb[s] = as_bf16x8(pw); }
        asm volatile("s_waitcnt lgkmcnt(0)" ::: "memory"); SBAR();
#pragma unroll
        for (int s = 0; s < 2; ++s) {
            const s16x4 l0 = vr[s][0][0], h0 = vr[s][1][0], l1 = vr[s][0][1], h1 = vr[s][1][1];
            const bf16x8 v0 = {l0[0], l0[1], l0[2], l0[3], h0[0], h0[1], h0[2], h0[3]}, v1 = {l1[0], l1[1], l1[2], l1[3], h1[0], h1[1], h1[2], h1[3]};
            o[0] = mfma32(v0, pb[s], o[0]); o[1] = mfma32(v1, pb[s], o[1]);
            if (LSUM) lacc = mfma32(ones, pb[s], lacc);
        }
    }
}

struct AttnRow { int r, hf, tt, t, qb, wave; unsigned long long wave_union; float m, lpart; };
struct TileInfo { int hi, lo; bool rowok, edge, work, fresh; };
template <int MODE, int VAR>
__device__ __forceinline__ void at_tile_qk(const Frame& F, int j, int stg, const bf16x8 (&Qf)[4], const AttnRow& R, float mfin, f32x16 (&s)[2], TileInfo& I) {
    LAS unsigned char* lds = F.lds;
    I.work = true; if (MODE == 2) I.work = (R.wave_union >> j) & 1ull;
    I.hi = 1000; I.lo = -1000; I.rowok = true; I.edge = false;
    if (MODE <= 1) { I.hi = ((R.t - 31) >> 4) - 64 * j - 4 * R.hf; I.edge = (64 * j + 63) > ((64 * R.qb + 8 * R.wave - 31) >> 4); }
    if (MODE == 2) { const unsigned long long sm = *(const LAS unsigned long long*)(lds + AT_SELM + 8 * R.tt); I.rowok = (sm >> j) & 1ull; if (j == R.qb) { I.hi = R.tt - 4 * R.hf; I.edge = true; } }
    if (MODE == 3) { if (j == R.qb) { I.hi = R.tt - 4 * R.hf; I.edge = true; } if (j == R.qb - 8) { I.lo = R.tt + 1 - 4 * R.hf; I.edge = true; } }
    const float mref = (MODE == 1) ? mfin : R.m; I.fresh = mref < -1e29f;
    const float cinit = I.rowok ? (I.fresh ? 0.f : -mref) : -INFINITY;
    if (I.work) { if (VAR & 64) { for (int e = 0; e < 16; ++e) { s[0][e] = Qf[0][0] * 1e-9f; s[1][e] = Qf[1][1] * 1e-9f; } } else at_qk(lds + AT_K + stg * 8192, Qf, R.r, R.hf, s, cinit); }
}
template <int MODE, int VAR>
__device__ __forceinline__ float at_tile_fin(const Frame& F, int j, int stg, f32x16 (&s)[2], const TileInfo& I, AttnRow& R, const unsigned (&voff)[2][2], f32x16 (&o)[2], f32x16& lacc, float invl, float preshift) {
    constexpr bool LS = (MODE >= 2) && (VAR == 0);
    LAS unsigned char* lds = F.lds; float shift_out = 0.f;
    if (!I.work) return 0.f;
    const int hi = I.hi, lo = I.lo; const bool edge = I.edge;
    if (LS) {
        if (edge) {
#pragma unroll
            for (int kt = 0; kt < 2; ++kt)
#pragma unroll
                for (int e = 0; e < 16; ++e) { const int cst = 32 * kt + (e & 3) + 8 * (e >> 2); const bool ok = (cst <= hi) && (cst >= lo); s[kt][e] = ok ? s[kt][e] : -INFINITY; }
        }
#pragma unroll
        for (int kt = 0; kt < 2; ++kt)
#pragma unroll
            for (int e = 0; e < 16; ++e) s[kt][e] = fexp2(s[kt][e]);
        at_pv<true>((unsigned)(size_t)(lds + AT_V + stg * 8192), voff, s, o, lacc);
        return 0.f;
    }
    if (MODE == 1) {
        if (edge) {
#pragma unroll
            for (int kt = 0; kt < 2; ++kt)
#pragma unroll
                for (int e = 0; e < 16; ++e) { const int cst = 32 * kt + (e & 3) + 8 * (e >> 2); s[kt][e] = (cst <= hi) ? fexp2(s[kt][e]) * invl : 0.f; }
        } else {
#pragma unroll
            for (int kt = 0; kt < 2; ++kt)
#pragma unroll
                for (int e = 0; e < 16; ++e) s[kt][e] = fexp2(s[kt][e]) * invl;
        }
        LAS float* imp = (LAS float*)(lds + AT_IMP) + R.tt * 68;
#pragma unroll
        for (int kt = 0; kt < 2; ++kt)
#pragma unroll
            for (int rg = 0; rg < 4; ++rg) {
                float av = 2.f * (s[kt][4 * rg] + s[kt][4 * rg + 1] + s[kt][4 * rg + 2]) + s[kt][4 * rg + 3], bv = s[kt][4 * rg + 3];
                av += __int_as_float(__builtin_amdgcn_update_dpp(0, __float_as_int(av), 0xB1, 0xf, 0xf, true)); av += __int_as_float(__builtin_amdgcn_update_dpp(0, __float_as_int(av), 0x4E, 0xf, 0xf, true));
                bv += __int_as_float(__builtin_amdgcn_update_dpp(0, __float_as_int(bv), 0xB1, 0xf, 0xf, true)); bv += __int_as_float(__builtin_amdgcn_update_dpp(0, __float_as_int(bv), 0x4E, 0xf, 0xf, true));
                if ((R.r & 3) == 0) { const int jb = 16 * j + 8 * kt + 2 * rg + R.hf; (void)__hip_atomic_fetch_add(imp + jb, av, __ATOMIC_RELAXED, __HIP_MEMORY_SCOPE_WORKGROUP); (void)__hip_atomic_fetch_add(imp + jb + 1, bv, __ATOMIC_RELAXED, __HIP_MEMORY_SCOPE_WORKGROUP); }
            }
        if (VAR & 16) { o[0][0] += s[0][3] + s[1][7]; } else at_pv<false>((unsigned)(size_t)(lds + AT_V + stg * 8192), voff, s, o, lacc);
    } else if (VAR & 32) { R.lpart += s[0][1]; if (MODE >= 2) { if (VAR & 16) { o[0][0] += s[0][3]; } else at_pv<false>((unsigned)(size_t)(lds + AT_V + stg * 8192), voff, s, o, lacc); } }
    else {
        constexpr float THR = 8.f;
        if (__any(preshift != 0.f)) {
#pragma unroll
            for (int kt = 0; kt < 2; ++kt)
#pragma unroll
                for (int e = 0; e < 16; ++e) s[kt][e] -= preshift;
        }
        const bool fresh = R.m < -1e29f;
        if (edge) {
#pragma unroll
            for (int kt = 0; kt < 2; ++kt)
#pragma unroll
                for (int e = 0; e < 16; ++e) { const int cst = 32 * kt + (e & 3) + 8 * (e >> 2); const bool ok = (cst <= hi) && (cst >= lo); s[kt][e] = ok ? s[kt][e] : -INFINITY; }
        }
        float tm4[4] = {-INFINITY, -INFINITY, -INFINITY, -INFINITY};
#pragma unroll
        for (int kt = 0; kt < 2; ++kt)
#pragma unroll
            for (int e = 0; e < 16; e += 2) tm4[(e >> 1) & 3] = fmaxf(tm4[(e >> 1) & 3], fmaxf(s[kt][e], s[kt][e + 1]));
        const float tmax = half_max(fmaxf(fmaxf(tm4[0], tm4[1]), fmaxf(tm4[2], tm4[3])));
        const bool raise = (tmax > -INFINITY) && (fresh || tmax > THR);
        if (__any(raise)) {
            const float shift = raise ? tmax : 0.f, alpha = (raise && !fresh) ? fexp2(-shift) : 1.f;
            R.m = raise ? (fresh ? tmax : R.m + tmax) : R.m; R.lpart *= alpha; shift_out = shift;
#pragma unroll
            for (int kt = 0; kt < 2; ++kt)
#pragma unroll
                for (int e = 0; e < 16; ++e) s[kt][e] -= shift;
            if (MODE >= 2) {
#pragma unroll
                for (int e = 0; e < 16; ++e) { o[0][e] *= alpha; o[1][e] *= alpha; if (LS) lacc[e] *= alpha; } }
        }
        if (LS) {
#pragma unroll
            for (int kt = 0; kt < 2; ++kt)
#pragma unroll
                for (int e = 0; e < 16; ++e) s[kt][e] = fexp2(s[kt][e]);
            at_pv<true>((unsigned)(size_t)(lds + AT_V + stg * 8192), voff, s, o, lacc);
        } else {
        float ps4[4] = {0.f, 0.f, 0.f, 0.f};
#pragma unroll
        for (int kt = 0; kt < 2; ++kt)
#pragma unroll
            for (int e = 0; e < 16; ++e) { s[kt][e] = fexp2(s[kt][e]); ps4[e & 3] += s[kt][e]; }
        R.lpart += (ps4[0] + ps4[1]) + (ps4[2] + ps4[3]);
        if (MODE >= 2) { if (VAR & 16) { o[0][0] += s[0][3] + s[1][7]; } else at_pv<false>((unsigned)(size_t)(lds + AT_V + stg * 8192), voff, s, o, lacc); }
        }
    }
    return shift_out;
}
template <int MODE, int VAR = 0>
__device__ __forceinline__ void at_branch(const Frame& F, unsigned long long mask, const bf16* Kb, const bf16* Vb, size_t stride, const bf16x8 (&Qf)[4], AttnRow& R, const unsigned (&voff)[2][2],
                                          f32x16 (&o)[2], f32x16& lacc, float mfin, float invl) {
    LAS unsigned char* lds = F.lds; const int tid = F.tid;
    if (mask == 0ull) return;
    AttnStage st0, st1; int sg = 0;
    { const int j0 = __builtin_ctzll(mask); at_gload(st0, Kb, Vb, stride, j0, tid); at_swrite(st0, lds, 0, tid);
      const unsigned long long m1 = mask & (mask - 1ull); if (m1) { at_gload(st1, Kb, Vb, stride, __builtin_ctzll(m1), tid); at_swrite(st1, lds, 1, tid); } }
    __syncthreads();
    while (mask) {
        const int j0 = __builtin_ctzll(mask); mask &= mask - 1ull;
        int j1 = -1; if (mask) { j1 = __builtin_ctzll(mask); mask &= mask - 1ull; }
        int n0 = -1, n1 = -1; { unsigned long long mm = mask; if (mm) { n0 = __builtin_ctzll(mm); mm &= mm - 1ull; if (mm) n1 = __builtin_ctzll(mm); } }
        at_gload(st0, Kb, Vb, stride, n0 >= 0 ? n0 : j0, tid);
        at_gload(st1, Kb, Vb, stride, n1 >= 0 ? n1 : j0, tid);
        { f32x16 sa[2]; TileInfo Ia;
          at_tile_qk<MODE, VAR>(F, j0, sg, Qf, R, mfin, sa, Ia);
          (void)at_tile_fin<MODE, VAR>(F, j0, sg, sa, Ia, R, voff, o, lacc, invl, 0.f); }
        if (j1 >= 0) { f32x16 sb[2]; TileInfo Ib;
          at_tile_qk<MODE, VAR>(F, j1, sg + 1, Qf, R, mfin, sb, Ib);
          (void)at_tile_fin<MODE, VAR>(F, j1, sg + 1, sb, Ib, R, voff, o, lacc, invl, 0.f); }
        if (n0 >= 0) at_swrite(st0, lds, (sg + 2) & 3, tid);
        if (n1 >= 0) at_swrite(st1, lds, (sg + 3) & 3, tid);
        __syncthreads();
        sg = (sg + 2) & 3;
    }
}

template <int VAR>
__device__ __forceinline__ void attn_item(const Frame& F, ArgsP a, int l, int item) {
    const int qb = 63 - (item >> 4), bh = item & 15, b = bh >> 1, hk = bh & 1; const int lane = F.lane, wave = F.wave;
    const bf16* H = (const bf16*)(a->ws + WS_H); const float* side = (const float*)(a->ws + WS_SIDE); bf16* Y = (bf16*)(a->ws + WS_Y);
    LAS unsigned char* lds = F.lds;
    AttnRow R; R.r = lane & 31; R.hf = lane >> 5; R.tt = 8 * wave + (R.r >> 2); R.t = 64 * qb + R.tt; R.qb = qb; R.wave = wave; R.wave_union = 0ull;
    const int head = hk * 4 + (R.r & 3); const size_t tok = (size_t)b * SEQ + R.t;
    bf16x8 Qf[4];
#pragma unroll
    for (int ks = 0; ks < 4; ++ks) Qf[ks] = *(const bf16x8*)(H + tok * HLD + head * 64 + 16 * ks + 8 * R.hf);
    float q2 = 0.f;
#pragma unroll
    for (int ks = 0; ks < 4; ++ks)
#pragma unroll
        for (int e = 0; e < 8; ++e) { const float f = bf2f((unsigned)(unsigned short)Qf[ks][e]); q2 += f * f; }
    const float qn = sqrtf(half_sum(q2));
    const float g_cmp = side[tok * 32 + head * 3], g_sel = side[tok * 32 + head * 3 + 1], g_win = side[tok * 32 + head * 3 + 2];
    unsigned voff[2][2];
    { const int li = lane & 15, q = li >> 2, p = li & 3, gi1 = (lane >> 4) & 1;
#pragma unroll
      for (int jh = 0; jh < 2; ++jh)
#pragma unroll
          for (int dt = 0; dt < 2; ++dt) voff[jh][dt] = (unsigned)((8 * jh + 4 * R.hf + q) * 128 + ((((4 * dt + 2 * gi1 + (p >> 1)) ^ (4 * jh + 2 * R.hf + (q >> 1))) & 7) << 4) + (p & 1) * 8); }
    { LAS float* imp = (LAS float*)(lds + AT_IMP) + (8 * wave) * 68; for (int i = lane; i < 8 * 68; i += 64) imp[i] = 0.f; if (F.tid == 0) { *(LAS unsigned*)(lds + AT_UNI) = 0u; *(LAS unsigned*)(lds + AT_UNI + 4) = 0u; } }
    f32x16 o[2], lacc;
#pragma unroll
    for (int e = 0; e < 16; ++e) { o[0][e] = 0.f; o[1][e] = 0.f; lacc[e] = 0.f; }
    LAS float* ys = (LAS float*)(lds + AT_YS + wave * 8192) + lane;
    {
        const bf16* Kc = (const bf16*)(a->ws + WS_KC) + (size_t)bh * 256 * 64; const bf16* Vc = (const bf16*)(a->ws + WS_VC) + (size_t)bh * 256 * 64;
        const int ntc = (4 * qb + 3 + 63) >> 6; const unsigned long long mc = (ntc >= 64) ? ~0ull : ((1ull << ntc) - 1ull);
        R.m = -1e30f; R.lpart = 0.f;
        if (!(VAR & 8)) at_branch<0, VAR>(F, mc, Kc, Vc, 64, Qf, R, voff, o, lacc, 0.f, 0.f);
        const float lsum = half_sum(R.lpart); const float invl = 1.f / fmaxf(lsum, 1e-30f);
        if (!(VAR & 8)) at_branch<1, VAR>(F, mc, Kc, Vc, 64, Qf, R, voff, o, lacc, R.m, invl);
#pragma unroll
        for (int e = 0; e < 16; ++e) { ys[e * 64] = g_cmp * o[0][e]; ys[(16 + e) * 64] = g_cmp * o[1][e]; o[0][e] = 0.f; o[1][e] = 0.f; }
    }
    LDS_WAIT();
    {
        unsigned long long wu = 0ull;
        for (int q0 = 0; q0 < 8; q0 += 4) {
            unsigned long long selm[4];
            if (qb < 16) { selm[0] = selm[1] = selm[2] = selm[3] = (2ull << qb) - 1ull; }
            else {
                const bool cand = (lane >= 1) && (lane <= qb - 2); unsigned key[4], thr[4];
#pragma unroll
                for (int u = 0; u < 4; ++u) { const float v = ((const LAS float*)(lds + AT_IMP))[(8 * wave + q0 + u) * 68 + lane]; key[u] = cand ? __float_as_uint(fmaxf(v, 0.f)) : 0u; thr[u] = 0u; }
                for (int bit = 30; bit >= 0; --bit) {
#pragma unroll
                    for (int u = 0; u < 4; ++u) { const unsigned tr = thr[u] | (1u << bit); const int c = __popcll(__ballot(cand && key[u] >= tr)); if (c >= 13) thr[u] = tr; } }
#pragma unroll
                for (int u = 0; u < 4; ++u) {
                    const unsigned long long gt = __ballot(cand && key[u] > thr[u]), eq = __ballot(cand && key[u] == thr[u]);
                    int need = 13 - __popcll(gt); unsigned long long eqs = 0ull, e2 = eq;
                    while (need > 0 && e2) { const unsigned long long low = e2 & (~e2 + 1ull); eqs |= low; e2 ^= low; --need; }
                    selm[u] = gt | eqs | 1ull | (1ull << qb) | (1ull << (qb - 1)); }
            }
#pragma unroll
            for (int u = 0; u < 4; ++u) {
                if (lane == 0) *(LAS unsigned long long*)(lds + AT_SELM + 8 * (8 * wave + q0 + u)) = selm[u];
#if defined(SELFCHECK) && SELFCHECK == 1
                if (lane == 0 && l == 1) ((unsigned long long*)(a->ws + (size_t)984 * MiB + 64 * KiB))[(size_t)bh * SEQ + 64 * qb + 8 * wave + q0 + u] = selm[u];
#endif
                wu |= selm[u]; }
        }
        R.wave_union = wu;
        if (lane == 0) { __hip_atomic_fetch_or((LAS unsigned*)(lds + AT_UNI), (unsigned)wu, __ATOMIC_RELAXED, __HIP_MEMORY_SCOPE_WORKGROUP); __hip_atomic_fetch_or((LAS unsigned*)(lds + AT_UNI + 4), (unsigned)(wu >> 32), __ATOMIC_RELAXED, __HIP_MEMORY_SCOPE_WORKGROUP); }
    }
    __syncthreads();
    const unsigned long long bunion = (unsigned long long)*(const LAS unsigned*)(lds + AT_UNI) | ((unsigned long long)*(const LAS unsigned*)(lds + AT_UNI + 4) << 32);
    const bf16* Hb = H + (size_t)b * SEQ * HLD;
    {
        R.m = -1e30f; R.lpart = 0.f;
        if (VAR == 0) R.m = qn * sqrtf(__uint_as_float(__hip_atomic_load(F.ctl + CW_KMAX + l * 64 + b * 4 + hk, __ATOMIC_RELAXED, __HIP_MEMORY_SCOPE_AGENT))) * 1.002f + 1e-3f;
        if (!(VAR & 2)) at_branch<2, VAR>(F, bunion, Hb + 512 + 2 * 128 + hk * 64, Hb + 512 + 3 * 128 + hk * 64, HLD, Qf, R, voff, o, lacc, 0.f, 0.f);
        const float lsum = (VAR == 0) ? lacc[0] : half_sum(R.lpart);
#pragma unroll
        for (int e = 0; e < 16; ++e) lacc[e] = 0.f; const float sc = g_sel / fmaxf(lsum, 1e-30f);
#pragma unroll
        for (int e = 0; e < 16; ++e) { ys[e * 64] += sc * o[0][e]; ys[(16 + e) * 64] += sc * o[1][e]; o[0][e] = 0.f; o[1][e] = 0.f; }
    }
    {
        const int lo = qb - 8 > 0 ? qb - 8 : 0; const unsigned long long mw = ((2ull << qb) - 1ull) & ~((1ull << lo) - 1ull);
        R.m = -1e30f; R.lpart = 0.f;
        if (VAR == 0) R.m = qn * sqrtf(__uint_as_float(__hip_atomic_load(F.ctl + CW_KMAX + l * 64 + b * 4 + 2 + hk, __ATOMIC_RELAXED, __HIP_MEMORY_SCOPE_AGENT))) * 1.002f + 1e-3f;
        if (!(VAR & 4)) at_branch<3, VAR>(F, mw, Hb + 512 + 4 * 128 + hk * 64, Hb + 512 + 5 * 128 + hk * 64, HLD, Qf, R, voff, o, lacc, 0.f, 0.f);
        const float lsum = (VAR == 0) ? lacc[0] : half_sum(R.lpart); const float sc = g_win / fmaxf(lsum, 1e-30f);
#pragma unroll
        for (int e = 0; e < 16; ++e) { o[0][e] = ys[e * 64] + sc * o[0][e]; o[1][e] = ys[(16 + e) * 64] + sc * o[1][e]; }
    }
    if (VAR & 1) { asm volatile("" :: "v"(o[0][0]), "v"(o[1][5])); return; }
    bf16* yrow = Y + tok * DM + head * 64 + 4 * R.hf;
#pragma unroll
    for (int dt = 0; dt < 2; ++dt)
#pragma unroll
        for (int rg = 0; rg < 4; ++rg) { u32x2 w; w.x = pk2(o[dt][4 * rg], o[dt][4 * rg + 1]); w.y = pk2(o[dt][4 * rg + 2], o[dt][4 * rg + 3]); *(u32x2*)(yrow + 32 * dt + 8 * rg) = w; }
}

__device__ __forceinline__ void phase_mix_b(const Frame& F, ArgsP a, int l, int rep) {
    unsigned* q = F.ctl + CW_QUEUE + l * 64 + rep * 32;
    for (;;) {
        if (F.tid == 0) F.MISC[0] = __hip_atomic_fetch_add(q, 1u, __ATOMIC_RELAXED, __HIP_MEMORY_SCOPE_AGENT);
        __syncthreads();
        const int item = (int)F.MISC[0];
        __syncthreads();
        if (item >= 1024) break;
        if (rep == 0) attn_item<0>(F, a, l, item); else attn_item<PROBE_ATTN_VAR>(F, a, l, item);
    }
}

constexpr size_t WS_DBG = 984 * MiB;
constexpr int CHECK_LAYER = 1;
__device__ __forceinline__ void dbg_add(ArgsP a, int i, float v) { atomicAdd((float*)(a->ws + WS_DBG) + i, v); }

__device__ __forceinline__ void check_nsa(const Frame& F, ArgsP a) {
    const bf16* H = (const bf16*)(a->ws + WS_H); const float* side = (const float*)(a->ws + WS_SIDE); const bf16* Y = (const bf16*)(a->ws + WS_Y);
    const unsigned long long* SELM = (const unsigned long long*)(a->ws + WS_DBG + 64 * KiB);
    const int lane = F.lane; const int tv[16] = {5, 40, 63, 64, 100, 511, 512, 1023, 1024, 1500, 2047, 2048, 3000, 3333, 4000, 4095};
    for (int s = F.bid * NWAVES + F.wave; s < 256; s += F.G * NWAVES) {
        int t = tv[0];
#pragma unroll
        for (int q = 1; q < 16; ++q) t = ((s & 15) == q) ? tv[q] : t;
        const int b = (s >> 4) & 7, hq = ((s >> 7) * 5 + (s & 7)) & 7, hk = hq >> 2; const size_t tok = (size_t)b * SEQ + t; const int bhk = b * 2 + hk;
        const bf16* KC = (const bf16*)(a->ws + WS_KC) + (size_t)bhk * 256 * 64; const bf16* VC = (const bf16*)(a->ws + WS_VC) + (size_t)bhk * 256 * 64;
        const float g_cmp = side[tok * 32 + hq * 3], g_sel = side[tok * 32 + hq * 3 + 1], g_win = side[tok * 32 + hq * 3 + 2];
        const int cmax = (t - 31) >> 4; float imp = 0.f, ocmp = 0.f;
        for (int gh = 0; gh < 4; ++gh) {
            const int head = hk * 4 + gh; const float qd = bf2f(H[tok * HLD + head * 64 + lane]);
            float m = -INFINITY, l = 0.f;
            for (int c = 0; c <= cmax; ++c) m = fmaxf(m, wave_sum(qd * bf2f(KC[c * 64 + lane])));
            for (int c = 0; c <= cmax; ++c) l += fexp2(wave_sum(qd * bf2f(KC[c * 64 + lane])) - m);
            for (int c = 0; c <= cmax; ++c) { const float p = fexp2(wave_sum(qd * bf2f(KC[c * 64 + lane])) - m) / l; const int j = c >> 2, e = c & 3;
                if (lane == j) imp += (e < 3 ? 2.f : 1.f) * p; if (e == 3 && lane == j + 1) imp += p;
                if (head == hq) ocmp += p * bf2f(VC[c * 64 + lane]); }
        }
        const int cur = t >> 6; const bool causal = lane <= cur, forced = (lane == 0) || (lane == cur) || (lane == cur - 1);
        const float key = causal ? (imp + (forced ? 1.0e4f : 0.f)) : -INFINITY; int rank = 0;
        for (int i = 0; i < 64; ++i) { const float ki = __shfl(key, i); rank += ((ki > key) || (ki == key && i < lane)) ? 1 : 0; }
        const unsigned long long refm = __ballot(causal && rank < 16), stm = SELM[(size_t)bhk * SEQ + t];
        if (lane == 0) { dbg_add(a, 2, (float)__popcll(refm ^ stm)); dbg_add(a, 3, 16.f); }
        const float qd = bf2f(H[tok * HLD + hq * 64 + lane]); const bf16* Hb = H + (size_t)b * SEQ * HLD + hk * 64 + lane;
        float m = -INFINITY, l = 0.f, osel = 0.f;
        for (int j = 0; j <= cur; ++j) if ((stm >> j) & 1ull) for (int kk = 0; kk < 64; ++kk) { const int p = 64 * j + kk; if (p > t) break;
            const float sc = wave_sum(qd * bf2f(Hb[(size_t)p * HLD + 512 + 2 * 128])); const float mn = fmaxf(m, sc), al = fexp2(m - mn), pp = fexp2(sc - mn);
            l = l * al + pp; osel = osel * al + pp * bf2f(Hb[(size_t)p * HLD + 512 + 3 * 128]); m = mn; }
        const float ysel = osel / fmaxf(l, 1e-30f);
        m = -INFINITY; l = 0.f; float owin = 0.f;
        for (int p = (t - 511 > 0 ? t - 511 : 0); p <= t; ++p) { const float sc = wave_sum(qd * bf2f(Hb[(size_t)p * HLD + 512 + 4 * 128])); const float mn = fmaxf(m, sc), al = fexp2(m - mn), pp = fexp2(sc - mn);
            l = l * al + pp; owin = owin * al + pp * bf2f(Hb[(size_t)p * HLD + 512 + 5 * 128]); m = mn; }
        const float ref = g_cmp * ocmp + g_sel * ysel + g_win * owin / fmaxf(l, 1e-30f), got = bf2f(Y[tok * DM + hq * 64 + lane]);
        const float e2 = wave_sum((ref - got) * (ref - got)), r2 = wave_sum(ref * ref);
        if (lane == 0) { dbg_add(a, 0, e2); dbg_add(a, 1, r2); }
    }
}

__device__ __forceinline__ void check_gdn(const Frame& F, ArgsP a, int l) {
    if (F.bid >= 8) return;
    const bf16* H = (const bf16*)(a->ws + WS_H); const float* side = (const float*)(a->ws + WS_SIDE); const bf16* Y = (const bf16*)(a->ws + WS_Y);
    const int b = F.bid, h = (F.bid * 3) & 3, tid = F.tid, lane = F.lane, col = tid & 63, rg = tid >> 6;
    LAS float* S = (LAS float*)F.lds; LAS float* qv = S + 64 * 65; LAS float* kv = qv + 64; LAS float* vv = kv + 64; LAS float* sc = vv + 64; LAS float* part = sc + 64;
    for (int i = tid; i < 64 * 65; i += NTHR) S[i] = 0.f;
    float hq[3] = {0.f, 0.f, 0.f}, hk[3] = {0.f, 0.f, 0.f}, hv[3] = {0.f, 0.f, 0.f}, wq[4], wk[4], wv[4];
    { const float* cw = a->in[6] + (size_t)l * 4 * 768 + h * 64 + lane;
#pragma unroll
      for (int k = 0; k < 4; ++k) { wq[k] = cw[k * 768]; wk[k] = cw[k * 768 + 256]; wv[k] = cw[k * 768 + 512]; } }
    const float Aexp = __expf(a->in[7][l * 4 + h]), dtb = a->in[8][l * 4 + h], nw = a->in[9][l * 64 + lane];
    __syncthreads();
    for (int t = 0; t < 192; ++t) {
        const size_t tok = (size_t)b * SEQ + t;
        if (F.wave == 0) { const bf16* p = H + tok * HLD + 1280 + h * 64 + lane; const float rq = bf2f(p[0]), rk = bf2f(p[256]), rv = bf2f(p[512]);
            const float cq = wq[0] * hq[0] + wq[1] * hq[1] + wq[2] * hq[2] + wq[3] * rq, ck = wk[0] * hk[0] + wk[1] * hk[1] + wk[2] * hk[2] + wk[3] * rk, cv = wv[0] * hv[0] + wv[1] * hv[1] + wv[2] * hv[2] + wv[3] * rv;
            hq[0] = hq[1]; hq[1] = hq[2]; hq[2] = rq; hk[0] = hk[1]; hk[1] = hk[2]; hk[2] = rk; hv[0] = hv[1]; hv[1] = hv[2]; hv[2] = rv;
            const float qs = cq / (1.f + __expf(-cq)), ks = ck / (1.f + __expf(-ck)), vs = cv / (1.f + __expf(-cv));
            qv[lane] = qs / sqrtf(wave_sum(qs * qs) + 1e-6f); kv[lane] = ks / sqrtf(wave_sum(ks * ks) + 1e-6f); vv[lane] = vs;
            if (lane == 0) { const float av = side[tok * 32 + 28 + h] + dtb; const float sp = av > 20.f ? av : log1pf(__expf(av)); sc[0] = __expf(-Aexp * sp); sc[1] = side[tok * 32 + 24 + h]; } }
        __syncthreads();
        { float ps = 0.f;
#pragma unroll
          for (int r = 0; r < 8; ++r) ps += kv[8 * rg + r] * S[(8 * rg + r) * 65 + col];
          part[rg * 64 + col] = ps; }
        __syncthreads();
        { float ks = 0.f;
#pragma unroll
          for (int r = 0; r < 8; ++r) ks += part[r * 64 + col];
          const float eg = sc[0], be = sc[1]; float po = 0.f;
          __syncthreads();
#pragma unroll
          for (int r = 0; r < 8; ++r) { const int dk = 8 * rg + r; const float sn = eg * (S[dk * 65 + col] - be * kv[dk] * ks) + be * kv[dk] * vv[col]; S[dk * 65 + col] = sn; po += sn * qv[dk]; }
          part[rg * 64 + col] = po; }
        __syncthreads();
        if (F.wave == 0) { float o = 0.f;
#pragma unroll
            for (int r = 0; r < 8; ++r) o += part[r * 64 + lane];
            o *= 0.125f; const float rs = 1.f / sqrtf(wave_sum(o * o) * (1.f / 64.f) + 1e-6f); const float z = bf2f(H[tok * HLD + 2048 + h * 64 + lane]);
            const float ref = o * rs * nw * (z / (1.f + __expf(-z))), got = bf2f(Y[tok * DM + 512 + h * 64 + lane]);
            const float e2 = wave_sum((ref - got) * (ref - got)), r2 = wave_sum(ref * ref);
            if (lane == 0) { dbg_add(a, 4, e2); dbg_add(a, 5, r2); } }
        __syncthreads();
    }
}

__device__ __forceinline__ void check_moe(const Frame& F, ArgsP a, int l) {
    const bf16* XBc = (const bf16*)(a->ws + WS_XB); const bf16* Y2 = (const bf16*)(a->ws + WS_Y2);
    const int* route_e = (const int*)(a->ws + WS_SLOT + SL_RE); const float* route_w = (const float*)(a->ws + WS_SLOT + SL_RW);
    LAS float* x = (LAS float*)F.lds; LAS float* hid = x + 1024; LAS float* lg = hid + 512; LAS float* yr = lg + 64;
    const int tid = F.tid, lane = F.lane;
    for (int s = F.bid; s < 256; s += F.G) {
        const int t = (s * 4099 + 17) & (T - 1);
        for (int i = tid; i < 1024; i += NTHR) { x[i] = bf2f(XBc[(size_t)t * DM + i]); yr[i] = 0.f; }
        __syncthreads();
        for (int j = F.wave; j < 36; j += NWAVES) { float d = 0.f; for (int k = lane; k < DM; k += 64) d += x[k] * (j < 4 ? a->in[18][((size_t)l * DM + k) * 4 + j] : a->in[20][((size_t)l * DM + k) * NEXP + j - 4]);
            d = wave_sum(d); if (lane == 0) lg[j] = d + (j < 4 ? a->in[19][l * 4 + j] : a->in[21][l * NEXP + j - 4]); }
        __syncthreads();
        if (tid == 0) { int gi = 0; for (int i = 1; i < 4; ++i) if (lg[i] > lg[gi]) gi = i; float gs = 0.f; for (int i = 0; i < 4; ++i) gs += __expf(lg[i] - lg[gi]); const float gw = 1.f / gs;
            int i1 = 0; for (int i = 1; i < 8; ++i) if (lg[4 + gi * 8 + i] > lg[4 + gi * 8 + i1]) i1 = i; int i2 = -1; for (int i = 0; i < 8; ++i) if (i != i1 && (i2 < 0 || lg[4 + gi * 8 + i] > lg[4 + gi * 8 + i2])) i2 = i;
            const float e2 = __expf(lg[4 + gi * 8 + i2] - lg[4 + gi * 8 + i1]), w1 = gw / (1.f + e2), w2 = gw - w1;
            const int se1 = route_e[2 * t], se2 = route_e[2 * t + 1]; const float sw1 = route_w[2 * t], sw2 = route_w[2 * t + 1];
            dbg_add(a, 8, (se1 != gi * 8 + i1 ? 1.f : 0.f) + (se2 != gi * 8 + i2 ? 1.f : 0.f)); dbg_add(a, 9, 2.f);
            if (se1 == gi * 8 + i1 && se2 == gi * 8 + i2) { dbg_add(a, 10, (sw1 - w1) * (sw1 - w1) + (sw2 - w2) * (sw2 - w2)); dbg_add(a, 11, w1 * w1 + w2 * w2); } }
        for (int k2 = 0; k2 < 2; ++k2) {
            const int e = route_e[2 * t + k2]; const float rw = route_w[2 * t + k2];
            const float* wg = a->in[22] + ((size_t)l * NEXP + e) * DM * FF; const float* wu = a->in[23] + ((size_t)l * NEXP + e) * DM * FF; const float* wd = a->in[24] + ((size_t)l * NEXP + e) * FF * DM;
            { float g = 0.f, u = 0.f; for (int k = 0; k < DM; ++k) { g += x[k] * wg[(size_t)k * FF + tid]; u += x[k] * wu[(size_t)k * FF + tid]; } hid[tid] = g / (1.f + __expf(-g)) * u; }
            __syncthreads();
            for (int d = tid; d < DM; d += NTHR) { float y = 0.f; for (int f = 0; f < FF; ++f) y += hid[f] * wd[(size_t)f * DM + d]; yr[d] += y * rw; }
            __syncthreads();
        }
        float e2 = 0.f, r2 = 0.f;
        for (int d = tid; d < DM; d += NTHR) { const float got = bf2f(Y2[(size_t)(2 * t) * DM + d]) + bf2f(Y2[(size_t)(2 * t + 1) * DM + d]); e2 += (yr[d] - got) * (yr[d] - got); r2 += yr[d] * yr[d]; }
        e2 = wave_sum(e2); r2 = wave_sum(r2); if (lane == 0) { dbg_add(a, 6, e2); dbg_add(a, 7, r2); }
        __syncthreads();
    }
}

__device__ __forceinline__ void check_inproj(const Frame& F, ArgsP a, int l) {
    const bf16* H = (const bf16*)(a->ws + WS_H); const float* xin = (l == 0) ? a->in[0] : (const float*)a->out; const float* win = a->in[1] + (size_t)l * DM * DIN;
    const int lane = F.lane;
    for (int s = F.bid * NWAVES + F.wave; s < 1024; s += F.G * NWAVES) {
        const int tok = (s * 7919 + 13) & (T - 1), grp = s % 14, t = tok & (SEQ - 1);
        const int col0 = grp < 8 ? grp * 64 : 512 + (grp - 8) * 128 + ((s >> 4) & 1) * 64; const bool isq = grp < 8, rope = isq || ((grp - 8) % 2 == 0);
        float d = 0.f; for (int k = 0; k < DM; ++k) d += xin[(size_t)tok * DM + k] * win[(size_t)k * DIN + col0 + lane];
        if (rope) { const float inv[8] = {1.0f, 0.19392274f, 0.03760603f, 0.0072926646f, 0.0014142136f, 0.0002742482f, 5.3182957e-05f, 1.0313385e-05f};
            float iv = inv[0];
#pragma unroll
            for (int q = 1; q < 8; ++q) iv = ((lane & 7) == q) ? inv[q] : iv;
            const float ang = (float)t * iv, c = cosf(ang), sn = sinf(ang), other = __shfl_xor(d, 8);
            if (lane < 8) d = d * c - other * sn; else if (lane < 16) d = d * c + other * sn; }
        if (isq) d *= pg8::QSCALE;
        const float got = bf2f(H[(size_t)tok * HLD + col0 + lane]); const float e2 = wave_sum((d - got) * (d - got)), r2 = wave_sum(d * d);
        if (lane == 0) { dbg_add(a, 12, e2); dbg_add(a, 13, r2); }
    }
}
__device__ __forceinline__ void check_compress(const Frame& F, ArgsP a, int l) {
    const bf16* H = (const bf16*)(a->ws + WS_H); const int lane = F.lane;
    for (int s = F.bid * NWAVES + F.wave; s < 512; s += F.G * NWAVES) {
        const int kv = s & 1, bh = (s >> 1) & 15, b = bh >> 1, hh = bh & 1, i = (s * 53 + 7) % 255;
        const float* pe = a->in[3] + ((size_t)l * 2 + kv) * 2048; const float* w1 = a->in[4] + ((size_t)l * 2 + kv) * 2048 * 128; const float* w2 = a->in[5] + ((size_t)l * 2 + kv) * 128 * 64;
        float h0 = 0.f, h1 = 0.f;
        for (int k = 0; k < 2048; ++k) { const int p = k >> 6, d = k & 63; const float x = bf2f(H[((size_t)b * SEQ + 16 * i + p) * HLD + 512 + kv * 128 + hh * 64 + d]) + pe[k];
            h0 += x * w1[(size_t)k * 128 + lane]; h1 += x * w1[(size_t)k * 128 + 64 + lane]; }
        h0 = h0 / (1.f + __expf(-h0)); h1 = h1 / (1.f + __expf(-h1));
        float o = 0.f;
        for (int n = 0; n < 64; ++n) { o += __shfl(h0, n) * w2[(size_t)n * 64 + lane] + __shfl(h1, n) * w2[(size_t)(64 + n) * 64 + lane]; }
        const float got = bf2f(((const bf16*)(a->ws + (kv ? WS_VC : WS_KC)))[((size_t)bh * 256 + i) * 64 + lane]);
        const float e2 = wave_sum((o - got) * (o - got)), r2 = wave_sum(o * o); if (lane == 0) { dbg_add(a, 14, e2); dbg_add(a, 15, r2); }
    }
}
__device__ __forceinline__ void check_conformer(const Frame& F, ArgsP a, int l) {
    const bf16* H = (const bf16*)(a->ws + WS_H); const bf16* Y = (const bf16*)(a->ws + WS_Y); const int lane = F.lane;
    for (int s = F.bid * NWAVES + F.wave; s < 1024; s += F.G * NWAVES) {
        const int tok = (s * 6151 + 3) & (T - 1), t = tok & (SEQ - 1); float u[4];
#pragma unroll
        for (int j = 0; j < 4; ++j) { const int c = lane + 64 * j; float acc = a->in[11][l * 256 + c];
            for (int k = 0; k < 31; ++k) { const int sp = t - 30 + k; if (sp >= 0) { const bf16* hp = H + (size_t)(tok - 30 + k) * HLD + 2304 + c; const float g = bf2f(hp[256]); acc += a->in[10][((size_t)l * 31 + k) * 256 + c] * (bf2f(hp[0]) / (1.f + __expf(-g))); } }
            u[j] = acc; }
        const float mean = wave_sum(u[0] + u[1] + u[2] + u[3]) * (1.f / 256.f); float q = 0.f;
#pragma unroll
        for (int j = 0; j < 4; ++j) { u[j] -= mean; q += u[j] * u[j]; }
        const float rstd = 1.f / sqrtf(wave_sum(q) * (1.f / 256.f) + LN_EPS); float e2 = 0.f, r2 = 0.f;
#pragma unroll
        for (int j = 0; j < 4; ++j) { const int c = lane + 64 * j; const float v = u[j] * rstd * a->in[12][l * 256 + c] + a->in[13][l * 256 + c]; const float ref = v / (1.f + __expf(-v)), got = bf2f(Y[(size_t)tok * DM + 768 + c]);
            e2 += (ref - got) * (ref - got); r2 += ref * ref; }
        e2 = wave_sum(e2); r2 = wave_sum(r2); if (lane == 0) { dbg_add(a, 16, e2); dbg_add(a, 17, r2); }
    }
}
__device__ __forceinline__ void check_inject(const Frame& F, ArgsP a) {
    if (F.bid == 0 && F.tid == 0) { const float* d = (const float*)(a->ws + WS_DBG); float e0 = 0.f, e1 = 0.f;
        if (SELFCHECK == 1) { e0 = 1000.f * sqrtf(d[0] / d[1]); e1 = 1.0e4f * d[2] / d[3]; }
        if (SELFCHECK == 2) { e0 = 1000.f * sqrtf(d[4] / d[5]); }
        if (SELFCHECK == 3) { e0 = 1000.f * sqrtf(d[6] / d[7]); e1 = 1.0e4f * d[8] / d[9] + 1000.f * sqrtf(d[10] / fmaxf(d[11], 1e-30f)); }
        if (SELFCHECK == 4) { e0 = 1000.f * sqrtf(d[12] / d[13]); }
        if (SELFCHECK == 5) { e0 = 1000.f * sqrtf(d[14] / d[15]); e1 = 1000.f * sqrtf(d[16] / d[17]); }
        a->out[0] += e0; a->out[1] += e1; }
}


#ifndef MK_MULTI
#define MK_MULTI 0
#endif
#ifndef PROBE_REPEAT
#define PROBE_REPEAT 0
#endif
constexpr int N_PHASES = 1 + 10 * NL;
#ifndef TIMING
#define TIMING 0
#endif
#ifndef TA_LO
#define TA_LO 0
#define TA_HI 1
#define TB_LO 0
#define TB_HI 1
#endif
#define TSTAMP(i) do { if (TIMING) { if (F.bid == 0 && F.tid == 0) ((unsigned long long*)(args_here()->ws + (size_t)985 * MiB))[i] = __builtin_amdgcn_s_memrealtime(); } } while (0)
__device__ __forceinline__ Frame make_frame(int wave_s) {
    extern __shared__ __attribute__((aligned(16))) unsigned char lds_raw[];
    Frame F; F.lds = (LAS unsigned char*)lds_raw; F.MISC = (volatile LAS unsigned*)(F.lds + MISC_OFF);
    int tid = threadIdx.x, G = gridDim.x, bid = blockIdx.x; unsigned lb = (unsigned)(size_t)F.lds; (void)wave_s;
    asm volatile("" : "+v"(tid), "+s"(G), "+s"(bid), "+s"(lb));
    F.lds = (LAS unsigned char*)(size_t)lb; F.MISC = (volatile LAS unsigned*)(F.lds + MISC_OFF);
    F.tid = tid; F.lane = F.tid & 63; F.wave = __builtin_amdgcn_readfirstlane(F.tid >> 6); F.G = G; F.bid = bid;
    F.ctl = (unsigned*)(args_here()->ws + WS_CTL); return F;
}
__device__ __forceinline__ void ph_prologue(int, int wv) { const Frame F = make_frame(wv); phase_prologue(F, args_here()); phase_weights(F, args_here(), 0, 2, F.G, 0);
#if SELFCHECK
    if (F.bid == 0 && F.tid < 64) ((float*)(args_here()->ws + WS_DBG))[F.tid] = 0.f;
#endif
}
__device__ __forceinline__ void ph_inproj(int l, int wv) { const Frame F = make_frame(wv); unsigned char* ws = args_here()->ws;
    pg8::Gemm g{(const bf16*)(ws + WS_X8), (const bf16*)(WLBASE(ws, l) + WL_WIN), T, DINP, DM / 2};   pg8::StaticOrder S; S.init(T, DINP, F.G, F.bid);
    pg8::EpiInProj E{(bf16*)(ws + WS_H), (float*)(ws + WS_SIDE), (const float*)(ws + WS_ROPE)};
    pg8::gemm_phase<pg8::EpiInProj, pg8::StaticOrder, false>(F.lds, g, S, E, nullptr, F.tid); }
__device__ __forceinline__ void ph_compress(int l, int wv) { const Frame F = make_frame(wv); knorm_pass(F, args_here(), l); for (int it = F.bid; it < 256; it += F.G) compress_item(F, args_here(), l, it); }
__device__ __forceinline__ void ph_gdnprep(int l, int wv) { const Frame F = make_frame(wv); for (int it = F.bid; it < 256; it += F.G) { gdn_prep_chunk<0>(F, args_here(), l, it * 8 + F.wave, F.lds + F.wave * 16384); __syncthreads(); } }
__device__ __forceinline__ void ph_gdnprep_var(int l, int wv) { const Frame F = make_frame(wv); for (int it = F.bid; it < 256; it += F.G) { gdn_prep_chunk<PROBE_GDN_VAR | 1>(F, args_here(), l, it * 8 + F.wave, F.lds + F.wave * 16384); __syncthreads(); } }
__device__ __forceinline__ void ph_conformer(int l, int wv) { const Frame F = make_frame(wv); for (int it = F.bid; it < 512; it += F.G) conformer_item(F, args_here(), l, it); }
__device__ __forceinline__ void ph_gdnout(int l, int wv) { const Frame F = make_frame(wv); for (int ci = F.bid * NWAVES + F.wave; ci < 2048; ci += F.G * NWAVES) gdn_out_chunk(F, args_here(), ci, F.lds + F.wave * 8192); }
constexpr int NCONV = 64;
__device__ __forceinline__ void ph_scan(int l, int wv) { const Frame F = make_frame(wv); if (F.bid < 16) gdn_scan<0>(F, args_here(), l); }
__device__ __forceinline__ void ph_bgweights(int l, int wv) { const Frame F = make_frame(wv);
    if (F.bid < NCONV) { if (l == 0) phase_weights(F, args_here(), 0, 1, NCONV, 0); if (l + 1 < NL) phase_weights(F, args_here(), l + 1, 3, NCONV, 0); __syncthreads(); } }
__device__ __forceinline__ void ph_scan_var(int l, int wv) { const Frame F = make_frame(wv); if (F.bid < 16) gdn_scan<(PROBE_SCAN_VAR & 1)>(F, args_here(), l); }
__device__ __forceinline__ void ph_attn(int l, int rep, int wv) { const Frame F = make_frame(wv); phase_mix_b(F, args_here(), l, rep); }
__device__ __forceinline__ void ph_outproj(int l, int wv) { const Frame F = make_frame(wv); ArgsP ap = args_here(); unsigned char* ws = ap->ws;
    pg8::Gemm g{(const bf16*)(ws + WS_Y), (const bf16*)(WLBASE(ws, l) + WL_WOUT), T, DM, DM}; pg8::StaticOrder S; S.init(T, DM, F.G, F.bid);
    pg8::EpiOutProj E{(const bf16*)(ws + WS_XB), (bf16*)(ws + WS_X1), DN_ALPHA};
    pg8::gemm_phase<pg8::EpiOutProj, pg8::StaticOrder, false>(F.lds, g, S, E, nullptr, F.tid); }
__device__ __forceinline__ void ph_ln1(int l, int wv) { const Frame F = make_frame(wv); phase_ln1_router<false>(F, args_here(), l); }
__device__ __forceinline__ void ph_ln1_dry(int l, int wv) { const Frame F = make_frame(wv); phase_ln1_router<true>(F, args_here(), l); }
__device__ __forceinline__ void ph_gather(int l, int wv) { const Frame F = make_frame(wv); phase_gather(F, args_here(), l); }
__device__ __forceinline__ void ph_moeup(int l, int wv) { const Frame F = make_frame(wv); unsigned char* ws = args_here()->ws;
    pg8::Gemm g{(const bf16*)(ws + WS_H), (const bf16*)(WLBASE(ws, l) + WL_WGU), 0, 0, DM / 2};   pg8::MoeOrder S{(const int*)(ws + WS_META) + l * 512, F.G, F.bid};
    pg8::EpiSwiGLU E{ws + WS_HID, (const int*)(ws + WS_SLOT + SL_TOK), 1};
    pg8::gemm_phase<pg8::EpiSwiGLU, pg8::MoeOrder, false>(F.lds, g, S, E, nullptr, F.tid); }
__device__ __forceinline__ void ph_moedown(int l, int wv) { const Frame F = make_frame(wv); unsigned char* ws = args_here()->ws;
    pg8::Gemm g{(const bf16*)(ws + WS_HID), (const bf16*)(WLBASE(ws, l) + WL_WDN), 0, 0, FF / 2}; pg8::MoeOrder S{(const int*)(ws + WS_META) + l * 512, F.G, F.bid};
    pg8::EpiDown E{(bf16*)(ws + WS_Y2), (const int*)(ws + WS_SLOT + SL_TOK), (const float*)(ws + WS_SLOT + SL_W)};
    pg8::gemm_phase<pg8::EpiDown, pg8::MoeOrder, false>(F.lds, g, S, E, nullptr, F.tid); }
__device__ __forceinline__ void ph_ln2(int l, int wv) { const Frame F = make_frame(wv); phase_ln2(F, args_here(), l); }

__global__ void __launch_bounds__(NTHR, 2) fwd_kernel(Args args) {
    extern __shared__ __attribute__((aligned(16))) unsigned char lds_raw[];
    (void)lds_raw; const int wv = 0; const Frame F = make_frame(wv);
    if (F.tid < 64) F.MISC[F.tid] = 0u;
    __syncthreads();
    XcdBarrier bar = xcd_barrier_post(F.ctl + CW_BAR, F.MISC + 8);
    const int lo = args_here()->ph_lo, hi = args_here()->ph_hi;
#define IN(k) (lo <= (k) && (k) < hi)
#define SEAM(k) do { if (IN(k) && IN((k) + 1)) { XcdBarrier bb = bar; asm volatile("" : "+s"(bb.bar)); xcd_barrier(bb); } TSTAMP((k) + 1); } while (0)
#define RPT(bit, call) do { call; if (PROBE_REPEAT & (1u << (bit))) { XcdBarrier bb = bar; asm volatile("" : "+s"(bb.bar)); xcd_barrier(bb); call; } } while (0)
    TSTAMP(0);
    if (IN(0)) ph_prologue(0, wv);
    SEAM(0);
#define LAYER_BODY(l) do { \
        const int pb = 1 + 10 * l; \
        if (IN(pb + 0)) RPT(0, ph_inproj(l, wv)); \
        SEAM(pb + 0); \
        if constexpr (SELFCHECK == 4) { \
        if (l == CHECK_LAYER) { { const Frame F2 = make_frame(wv); check_inproj(F2, args_here(), l); } XcdBarrier bb = bar; asm volatile("" : "+s"(bb.bar)); xcd_barrier(bb); } \
        } \
        if (IN(pb + 1)) { RPT(16, ph_compress(l, wv)); ph_gdnprep(l, wv); if (PROBE_REPEAT & (1u << 17)) { XcdBarrier bb = bar; asm volatile("" : "+s"(bb.bar)); xcd_barrier(bb); ph_gdnprep_var(l, wv); } RPT(18, ph_conformer(l, wv)); } \
        SEAM(pb + 1); \
        if (IN(pb + 2)) { ph_scan(l, wv); ph_bgweights(l, wv); if (PROBE_REPEAT & (1u << 19)) { XcdBarrier bb = bar; asm volatile("" : "+s"(bb.bar)); xcd_barrier(bb); ph_scan_var(l, wv); XcdBarrier bb2 = bar; asm volatile("" : "+s"(bb2.bar)); xcd_barrier(bb2); } ph_attn(l, 0, wv); if (PROBE_REPEAT & (1u << 20)) { XcdBarrier bb = bar; asm volatile("" : "+s"(bb.bar)); xcd_barrier(bb); ph_attn(l, 1, wv); } } \
        SEAM(pb + 2); \
        if (IN(pb + 3)) RPT(24, ph_gdnout(l, wv)); \
        SEAM(pb + 3); \
        if constexpr (SELFCHECK == 1 || SELFCHECK == 2 || SELFCHECK == 5) { \
        if (l == CHECK_LAYER) { { const Frame F2 = make_frame(wv); if (SELFCHECK == 1) check_nsa(F2, args_here()); else if (SELFCHECK == 2) check_gdn(F2, args_here(), l); else { check_compress(F2, args_here(), l); check_conformer(F2, args_here(), l); } } XcdBarrier bb = bar; asm volatile("" : "+s"(bb.bar)); xcd_barrier(bb); } \
        } \
        if (IN(pb + 4)) RPT(3, ph_outproj(l, wv)); \
        SEAM(pb + 4); \
        if (IN(pb + 5)) { ph_ln1(l, wv); if (PROBE_REPEAT & (1u << 4)) { XcdBarrier bb = bar; asm volatile("" : "+s"(bb.bar)); xcd_barrier(bb); ph_ln1_dry(l, wv); } \
            if (PROBE_REPEAT & (1u << 23)) { for (int rr = 0; rr < 4; ++rr) { XcdBarrier bb = bar; asm volatile("" : "+s"(bb.bar)); xcd_barrier(bb); } } } \
        SEAM(pb + 5); \
        if (IN(pb + 6)) RPT(5, ph_gather(l, wv)); \
        SEAM(pb + 6); \
        if (IN(pb + 7)) RPT(6, ph_moeup(l, wv)); \
        SEAM(pb + 7); \
        if (IN(pb + 8)) RPT(7, ph_moedown(l, wv)); \
        SEAM(pb + 8); \
        if constexpr (SELFCHECK == 3) { \
        if (l == CHECK_LAYER) { { const Frame F2 = make_frame(wv); check_moe(F2, args_here(), l); } XcdBarrier bb = bar; asm volatile("" : "+s"(bb.bar)); xcd_barrier(bb); } \
        } \
        if (IN(pb + 9)) { ph_ln2(l, wv); } \
        SEAM(pb + 9); \
     \
    } while (0)
    LAYER_BODY(0); LAYER_BODY(1); LAYER_BODY(2); LAYER_BODY(3);
#undef LAYER_BODY
#undef RPT
#if SELFCHECK
    { XcdBarrier bb = bar; asm volatile("" : "+s"(bb.bar)); xcd_barrier(bb); const Frame F2 = make_frame(wv); check_inject(F2, args_here()); }
#endif
#if TIMING
    { XcdBarrier bb = bar; asm volatile("" : "+s"(bb.bar)); xcd_barrier(bb); const Frame F2 = make_frame(wv);
      const unsigned long long* ts = (const unsigned long long*)(args_here()->ws + (size_t)985 * MiB);
      const float ta = (float)(ts[TA_HI] - ts[TA_LO]) * 0.01f, tb = (float)(ts[TB_HI] - ts[TB_LO]) * 0.01f;
      float* out = args_here()->out;
      for (int i = F2.bid * NTHR + F2.tid; i < (1 << 20); i += F2.G * NTHR) out[i] = (i == 0) ? ta : tb; }
#endif
#undef IN
#undef SEAM
}

extern "C" void kernel_launch(void* const* d_in, const int* in_sizes, int n_in, void* d_out, int out_size, void* d_ws, size_t ws_size, hipStream_t stream) {
    static int grid = 0;
    if (grid == 0) {
        if (n_in != 25 || in_sizes[0] != T * DM || out_size != T * DM || ws_size < WS_END) { fprintf(stderr, "kernel_launch: shape/workspace mismatch (n_in %d, in0 %d, out %d, ws %zu < %zu); nothing launched\n", n_in, n_in > 0 ? in_sizes[0] : -1, out_size, ws_size, (size_t)WS_END); grid = -1; return; }
        int dev = 0, cus = 0, per_cu = 0;
        if (hipGetDevice(&dev) != hipSuccess || hipDeviceGetAttribute(&cus, hipDeviceAttributeMultiprocessorCount, dev) != hipSuccess) { grid = -1; return; }
        if (hipFuncSetAttribute((const void*)fwd_kernel, hipFuncAttributeMaxDynamicSharedMemorySize, LDS_BYTES) != hipSuccess) { fprintf(stderr, "kernel_launch: hipFuncSetAttribute failed\n"); grid = -1; return; }
        if (hipOccupancyMaxActiveBlocksPerMultiprocessor(&per_cu, (const void*)fwd_kernel, NTHR, LDS_BYTES) != hipSuccess || per_cu < 1)
            fprintf(stderr, "kernel_launch: note: occupancy query reports %d workgroups per CU\n", per_cu);
        (void)hipGetLastError();
        grid = cus;
        if (grid < 32 || (grid & 7)) { fprintf(stderr, "kernel_launch: unexpected CU count %d\n", cus); }
    }
    if (grid < 0) return;
    if (hipMemsetAsync((char*)d_ws + WS_CTL, 0, CTL_ZERO_BYTES, stream) != hipSuccess) return;
    Args a{};
    for (int i = 0; i < 25; ++i) a.in[i] = (const float*)d_in[i];
    a.out = (float*)d_out; a.ws = (unsigned char*)d_ws;
#if MK_MULTI
    for (int p = 0; p < N_PHASES; ++p) { a.ph_lo = p; a.ph_hi = p + 1; hipLaunchKernelGGL(fwd_kernel, dim3(grid), dim3(NTHR), LDS_BYTES, stream, a); }
#else
    a.ph_lo = 0; a.ph_hi = N_PHASES;
    hipLaunchKernelGGL(fwd_kernel, dim3(grid), dim3(NTHR), LDS_BYTES, stream, a);
#endif
}
```
